# Optimizing an MI355X kernel written in HIP

```python
import jax
import jax.numpy as jnp
from jax import lax
import numpy as np

D_MODEL = 1024
BATCH = 16
SEQ = 2048
DEPTH = 2

GRID_W = 64
CTX_LEN = 256

CONV_DIM = D_MODEL // 4
CONV_WIDTH = 31
NA_HEADS = 8
NA_HEAD_DIM = 64
NA_DIM = NA_HEADS * NA_HEAD_DIM
NA_ROWS_MAX = 8
NA_COLS = 16
LRU_DIM = D_MODEL // 4
LRU_BLOCKS = 4
LRU_BLOCK = LRU_DIM // LRU_BLOCKS
LRU_CONV = 4
LRU_C = 8.0
MIX_DIM = CONV_DIM + NA_DIM + LRU_DIM
D_FF = 4 * D_MODEL
EPS = 1e-6
NEG_INF = -1e30

SPLITS = [CONV_DIM, 2 * CONV_DIM, 2 * CONV_DIM + NA_DIM, 2 * CONV_DIM + 2 * NA_DIM,
          2 * CONV_DIM + 3 * NA_DIM, 2 * CONV_DIM + 3 * NA_DIM + LRU_DIM]
IN_DIM = 2 * CONV_DIM + 3 * NA_DIM + 2 * LRU_DIM
K_OFF = SPLITS[2]
LX_OFF = SPLITS[4]
LG_OFF = SPLITS[5]

kernel_name = "hybrid_conv_natten_rglru_dit"


def rmsnorm(t, g):
    tf = t.astype(jnp.float32)
    y = tf * lax.rsqrt(jnp.mean(tf * tf, axis=-1, keepdims=True) + EPS)
    return (y * g.astype(jnp.float32)).astype(t.dtype)


def layernorm(t, g, b):
    tf = t.astype(jnp.float32)
    mu = jnp.mean(tf, axis=-1, keepdims=True)
    var = jnp.mean(jnp.square(tf - mu), axis=-1, keepdims=True)
    y = (tf - mu) * lax.rsqrt(var + EPS) * g.astype(jnp.float32) + b.astype(jnp.float32)
    return y.astype(t.dtype)


def modulate(h, shift, scale):
    return h * (1 + scale) + shift


def depthwise_conv(u, w, b, pad_l, pad_r):
    out = lax.conv_general_dilated(
        u, w[:, None, :], window_strides=(1,), padding=[(pad_l, pad_r)],
        dimension_numbers=("NWC", "WIO", "NWC"), feature_group_count=u.shape[-1])
    return out + b


def conformer_conv(val, gate, w, b, ln_g, ln_b):
    u = val * jax.nn.sigmoid(gate)
    u = depthwise_conv(u, w, b, CONV_WIDTH // 2, CONV_WIDTH // 2)
    return jax.nn.silu(layernorm(u, ln_g, ln_b))


def to_heads(t):
    b, n, _ = t.shape
    return t.reshape(b, n, NA_HEADS, NA_HEAD_DIM).transpose(0, 2, 1, 3)


def na_context(q, k, v):
    b, n, _ = q.shape
    qh, kh, vh = to_heads(q), to_heads(k), to_heads(v)
    s = jnp.einsum("bhqd,bhkd->bhqk", qh, kh, preferred_element_type=jnp.float32) * NA_HEAD_DIM ** -0.5
    p = jax.nn.softmax(s, axis=-1).astype(vh.dtype)
    o = jnp.einsum("bhqk,bhkd->bhqd", p, vh)
    return o.transpose(0, 2, 1, 3).reshape(b, n, NA_DIM)


def na_latent(q, k, v, kc, vc, rpb):
    b, n, _ = q.shape
    rows = n // GRID_W
    kr = min(NA_ROWS_MAX, rows)
    grid = lambda t: t.reshape(b, rows, GRID_W, NA_HEADS, NA_HEAD_DIM).transpose(0, 3, 1, 2, 4)
    qg, kg, vg = grid(q), grid(k), grid(v)
    kch, vch = to_heads(kc), to_heads(vc)
    scale = NA_HEAD_DIM ** -0.5
    qcol = jnp.arange(GRID_W)
    col_start = jnp.clip(qcol - NA_COLS // 2, 0, GRID_W - NA_COLS)
    kcol = jnp.arange(GRID_W)
    valid = (kcol[None, :] >= col_start[:, None]) & (kcol[None, :] < col_start[:, None] + NA_COLS)
    cidx = jnp.clip(kcol[None, :] - qcol[:, None], -(NA_COLS - 1), NA_COLS - 1) + NA_COLS - 1

    def row_step(r):
        rs = jnp.clip(r - kr // 2, 0, rows - kr)
        ridx = rs + jnp.arange(kr) - r + NA_ROWS_MAX - 1
        bias = rpb[:, ridx[None, :, None], cidx[:, None, :]]
        bias = jnp.where(valid[:, None, :], bias, NEG_INF)
        qr = lax.dynamic_index_in_dim(qg, r, axis=2, keepdims=False)
        kb = lax.dynamic_slice_in_dim(kg, rs, kr, axis=2)
        vb = lax.dynamic_slice_in_dim(vg, rs, kr, axis=2)
        s_loc = jnp.einsum("bhqd,bhrkd->bhqrk", qr, kb, preferred_element_type=jnp.float32) * scale + bias
        s_loc = s_loc.reshape(b, NA_HEADS, GRID_W, kr * GRID_W)
        s_ctx = jnp.einsum("bhqd,bhcd->bhqc", qr, kch, preferred_element_type=jnp.float32) * scale
        p = jax.nn.softmax(jnp.concatenate([s_loc, s_ctx], axis=-1), axis=-1)
        p_loc = p[..., :kr * GRID_W].reshape(b, NA_HEADS, GRID_W, kr, GRID_W).astype(vb.dtype)
        p_ctx = p[..., kr * GRID_W:].astype(vch.dtype)
        return (jnp.einsum("bhqrk,bhrkd->bhqd", p_loc, vb)
                + jnp.einsum("bhqc,bhcd->bhqd", p_ctx, vch))

    out = lax.map(row_step, jnp.arange(rows))
    return out.transpose(1, 0, 3, 2, 4).reshape(b, n, NA_DIM)


def rglru_coeffs(u, wx, bx, wa, ba, lam):
    b, n, _ = u.shape
    ub = u.reshape(b, n, LRU_BLOCKS, LRU_BLOCK)
    gx = jax.nn.sigmoid(jnp.einsum("bnkd,kde->bnke", ub, wx).reshape(b, n, LRU_DIM) + bx)
    ga = jax.nn.sigmoid((jnp.einsum("bnkd,kde->bnke", ub, wa).reshape(b, n, LRU_DIM) + ba).astype(jnp.float32))
    log_a = -LRU_C * ga * jax.nn.softplus(-lam.astype(jnp.float32))
    a = jnp.exp(log_a)
    coef = jnp.sqrt(-jnp.expm1(2.0 * log_a))
    return a, coef * (gx * u).astype(jnp.float32)


def linear_scan(a, b, h0, reverse):
    def combine(e1, e2):
        a1, b1 = e1
        a2, b2 = e2
        return a1 * a2, a2 * b1 + b2
    a_cum, b_cum = lax.associative_scan(combine, (a, b), reverse=reverse, axis=1)
    return a_cum * h0[:, None, :] + b_cum


def rglru_direction(x_lat, x_ctx, conv_w, conv_b, wx, bx, wa, ba, lam, reverse):
    pad = (0, LRU_CONV - 1) if reverse else (LRU_CONV - 1, 0)
    a_c, b_c = rglru_coeffs(depthwise_conv(x_ctx, conv_w, conv_b, *pad), wx, bx, wa, ba, lam)
    h_c = linear_scan(a_c, b_c, jnp.zeros_like(b_c[:, 0]), reverse)
    h_last = h_c[:, 0] if reverse else h_c[:, -1]
    a_l, b_l = rglru_coeffs(depthwise_conv(x_lat, conv_w, conv_b, *pad), wx, bx, wa, ba, lam)
    h_l = linear_scan(a_l, b_l, h_last, reverse)
    return h_l, h_c


def sq_relu_mlp(h, w1, w2):
    return jnp.square(jax.nn.relu(h @ w1)) @ w2


def setup_inputs(seed: int = 0) -> dict:
    key = jax.random.key(seed)
    ks = jax.random.split(key, 32)
    f32 = jnp.float32

    def nrm(k, shape, scale):
        return jax.random.normal(k, shape, f32) * scale

    u = jax.random.uniform(ks[21], (DEPTH, 2, LRU_DIM), f32, 0.9, 0.999)
    a0 = u ** (1.0 / LRU_C)
    return {
        "x": nrm(ks[0], (BATCH, SEQ, D_MODEL), 1.0),
        "c": nrm(ks[1], (BATCH, D_MODEL), 1.0),
        "ctx": nrm(ks[2], (BATCH, CTX_LEN, D_MODEL), 1.0),
        "c_ctx": nrm(ks[3], (D_MODEL,), 1.0),
        "norm1_g": 1.0 + nrm(ks[4], (DEPTH, D_MODEL), 0.02),
        "norm2_g": 1.0 + nrm(ks[5], (DEPTH, D_MODEL), 0.02),
        "ada_w": nrm(ks[6], (DEPTH, D_MODEL, 6 * D_MODEL), 0.5 * D_MODEL ** -0.5),
        "ada_b": nrm(ks[7], (DEPTH, 6 * D_MODEL), 0.02),
        "w_in": nrm(ks[8], (DEPTH, D_MODEL, IN_DIM), D_MODEL ** -0.5),
        "w_out": nrm(ks[9], (DEPTH, MIX_DIM, D_MODEL), MIX_DIM ** -0.5),
        "conv_w": nrm(ks[10], (DEPTH, CONV_WIDTH, CONV_DIM), CONV_WIDTH ** -0.5),
        "conv_b": nrm(ks[11], (DEPTH, CONV_DIM), 0.02),
        "conv_ln_g": 1.0 + nrm(ks[12], (DEPTH, CONV_DIM), 0.02),
        "conv_ln_b": nrm(ks[13], (DEPTH, CONV_DIM), 0.02),
        "na_rpb": nrm(ks[14], (DEPTH, NA_HEADS, 2 * NA_ROWS_MAX - 1, 2 * NA_COLS - 1), 0.1),
        "lru_conv_w": nrm(ks[15], (DEPTH, 2, LRU_CONV, LRU_DIM), LRU_CONV ** -0.5),
        "lru_conv_b": nrm(ks[16], (DEPTH, 2, LRU_DIM), 0.02),
        "lru_wx": nrm(ks[17], (DEPTH, 2, LRU_BLOCKS, LRU_BLOCK, LRU_BLOCK), LRU_BLOCK ** -0.5),
        "lru_bx": nrm(ks[18], (DEPTH, 2, LRU_DIM), 0.02),
        "lru_wa": nrm(ks[19], (DEPTH, 2, LRU_BLOCKS, LRU_BLOCK, LRU_BLOCK), LRU_BLOCK ** -0.5),
        "lru_ba": nrm(ks[20], (DEPTH, 2, LRU_DIM), 0.02),
        "lru_lambda": jnp.log(a0) - jnp.log1p(-a0),
        "mlp_w1": nrm(ks[22], (DEPTH, D_MODEL, D_FF), D_MODEL ** -0.5),
        "mlp_w2": nrm(ks[23], (DEPTH, D_FF, D_MODEL), D_FF ** -0.5),
        "final_g": 1.0 + nrm(ks[24], (D_MODEL,), 0.02),
    }


def reference(x, c, ctx, c_ctx, norm1_g, norm2_g, ada_w, ada_b, w_in, w_out, conv_w, conv_b,
              conv_ln_g, conv_ln_b, na_rpb, lru_conv_w, lru_conv_b, lru_wx, lru_bx, lru_wa,
              lru_ba, lru_lambda, mlp_w1, mlp_w2, final_g):
    cx = ctx
    for l in range(DEPTH):
        last = l == DEPTH - 1
        mod = jax.nn.silu(c) @ ada_w[l] + ada_b[l]
        sh1, sc1, g1, sh2, sc2, g2 = jnp.split(mod[:, None, :], 6, axis=-1)
        n_cm = 2 if last else 6
        mod_c = jax.nn.silu(c_ctx) @ ada_w[l][:, :n_cm * D_MODEL] + ada_b[l][:n_cm * D_MODEL]
        mod_c = jnp.split(mod_c, n_cm)

        h = modulate(rmsnorm(x, norm1_g[l]), sh1, sc1)
        hc = modulate(rmsnorm(cx, norm1_g[l]), mod_c[0], mod_c[1])
        a_val, a_gate, q, k, v, r_x, r_gate = jnp.split(h @ w_in[l], SPLITS, axis=-1)
        if last:
            ck, cv = jnp.split(hc @ w_in[l][:, K_OFF:LX_OFF], 2, axis=-1)
            cr_x = hc @ w_in[l][:, LX_OFF:LG_OFF]
        else:
            ca_val, ca_gate, cq, ck, cv, cr_x, cr_gate = jnp.split(hc @ w_in[l], SPLITS, axis=-1)

        y_a = conformer_conv(a_val, a_gate, conv_w[l], conv_b[l], conv_ln_g[l], conv_ln_b[l])
        y_b = na_latent(q, k, v, ck, cv, na_rpb[l])
        h_f, hc_f = rglru_direction(r_x, cr_x, lru_conv_w[l, 0], lru_conv_b[l, 0], lru_wx[l, 0],
                                    lru_bx[l, 0], lru_wa[l, 0], lru_ba[l, 0], lru_lambda[l, 0], False)
        h_b, hc_b = rglru_direction(r_x, cr_x, lru_conv_w[l, 1], lru_conv_b[l, 1], lru_wx[l, 1],
                                    lru_bx[l, 1], lru_wa[l, 1], lru_ba[l, 1], lru_lambda[l, 1], True)
        y_c = jax.nn.gelu(r_gate) * (h_f + h_b).astype(r_gate.dtype)

        x = x + g1 * (jnp.concatenate([y_a, y_b, y_c], axis=-1) @ w_out[l])
        h2 = modulate(rmsnorm(x, norm2_g[l]), sh2, sc2)
        x = x + g2 * sq_relu_mlp(h2, mlp_w1[l], mlp_w2[l])

        if not last:
            yc_a = conformer_conv(ca_val, ca_gate, conv_w[l], conv_b[l], conv_ln_g[l], conv_ln_b[l])
            yc_b = na_context(cq, ck, cv)
            yc_c = jax.nn.gelu(cr_gate) * (hc_f + hc_b).astype(cr_gate.dtype)
            cx = cx + mod_c[2] * (jnp.concatenate([yc_a, yc_b, yc_c], axis=-1) @ w_out[l])
            h2c = modulate(rmsnorm(cx, norm2_g[l]), mod_c[3], mod_c[4])
            cx = cx + mod_c[5] * sq_relu_mlp(h2c, mlp_w1[l], mlp_w2[l])
    return rmsnorm(x, final_g)
```

```cpp
#include <hip/hip_runtime.h>
#include <cstdio>
#include <cstdint>

namespace {
constexpr int D = 1024, NB = 16, SEQ = 2048, DEPTH = 2, CTXL = 256;
constexpr int CONVD = 256, CONVW = 31, NH = 8, HD = 64, NAD = 512, LRUD = 256;
constexpr int IND = 2560, FF = 4096;
constexpr int LROWS = SEQ + CTXL;
constexpr float EPS = 1e-6f;

__device__ __forceinline__ float sigmoidf_(float x) { return 1.f / (1.f + expf(-x)); }
__device__ __forceinline__ float siluf_(float x) { return x * sigmoidf_(x); }
__device__ __forceinline__ float gelu_tanh(float x) { return 0.5f * x * (1.f + tanhf(0.7978845608028654f * (x + 0.044715f * x * x * x))); }

__global__ void k_mod(const float* __restrict__ c, const float* __restrict__ cctx, const float* __restrict__ ada_w, const float* __restrict__ ada_b, float* __restrict__ mod) {
    const int j = blockIdx.x * blockDim.x + threadIdx.x, r = blockIdx.y, l = blockIdx.z;
    const float* cv = (r < 16) ? c + (size_t)r * D : cctx;
    const float* w = ada_w + (size_t)l * D * 6 * D;
    float acc = 0.f;
    for (int k = 0; k < D; ++k) acc += siluf_(cv[k]) * w[(size_t)k * 6 * D + j];
    mod[((size_t)l * 17 + r) * 6 * D + j] = acc + ada_b[(size_t)l * 6 * D + j];
}

__global__ void k_norm(const float* __restrict__ xlat, const float* __restrict__ xctx, const float* __restrict__ g, const float* __restrict__ modb, const float* __restrict__ modc, int sh_off, int sc_off, float* __restrict__ out) {
    const int r = blockIdx.x, t = threadIdx.x;
    const float* x = (r < SEQ) ? xlat + (size_t)r * D : xctx + (size_t)(r - SEQ) * D;
    const float* m = (r < SEQ) ? modb : modc;
    float v[4]; float ss = 0.f;
    for (int i = 0; i < 4; ++i) { v[i] = x[t + 256 * i]; ss += v[i] * v[i]; }
    __shared__ float red[256];
    red[t] = ss; __syncthreads();
    for (int s = 128; s > 0; s >>= 1) { if (t < s) red[t] += red[t + s]; __syncthreads(); }
    const float rs = rsqrtf(red[0] / D + EPS);
    for (int i = 0; i < 4; ++i) { const int k = t + 256 * i; out[(size_t)r * D + k] = v[i] * rs * g[k] * (1.f + m[sc_off + k]) + m[sh_off + k]; }
}

template <int MODE>
__global__ void __launch_bounds__(256) k_gemm(const float* __restrict__ A, const float* __restrict__ W, int M, int N, int K, float* __restrict__ C,
                                              float* __restrict__ xlat, float* __restrict__ xctx, const float* __restrict__ gateb, const float* __restrict__ gatec) {
    __shared__ float As[16][64 + 4];
    __shared__ float Ws[16][64 + 4];
    const int tid = threadIdx.x, tx = tid & 15, ty = tid >> 4;
    const int m0 = blockIdx.y * 64, n0 = blockIdx.x * 64;
    float acc[4][4];
    for (int i = 0; i < 4; ++i) for (int j = 0; j < 4; ++j) acc[i][j] = 0.f;
    for (int k0 = 0; k0 < K; k0 += 16) {
        {
            const int r = tid >> 2, c4 = (tid & 3) * 4;
            const float4 a = *(const float4*)(A + (size_t)(m0 + r) * K + k0 + c4);
            As[c4 + 0][r] = a.x; As[c4 + 1][r] = a.y; As[c4 + 2][r] = a.z; As[c4 + 3][r] = a.w;
            const int kr = tid >> 4, n4 = (tid & 15) * 4;
            const float4 w = *(const float4*)(W + (size_t)(k0 + kr) * N + n0 + n4);
            Ws[kr][n4 + 0] = w.x; Ws[kr][n4 + 1] = w.y; Ws[kr][n4 + 2] = w.z; Ws[kr][n4 + 3] = w.w;
        }
        __syncthreads();
#pragma unroll
        for (int kk = 0; kk < 16; ++kk) {
            float a[4], b[4];
#pragma unroll
            for (int i = 0; i < 4; ++i) a[i] = As[kk][ty * 4 + i];
#pragma unroll
            for (int j = 0; j < 4; ++j) b[j] = Ws[kk][tx * 4 + j];
#pragma unroll
            for (int i = 0; i < 4; ++i)
#pragma unroll
                for (int j = 0; j < 4; ++j) acc[i][j] += a[i] * b[j];
        }
        __syncthreads();
    }
#pragma unroll
    for (int i = 0; i < 4; ++i) {
        const int r = m0 + ty * 4 + i;
#pragma unroll
        for (int j = 0; j < 4; ++j) {
            const int cidx = n0 + tx * 4 + j;
            if (MODE == 0) C[(size_t)r * N + cidx] = acc[i][j];
            else if (MODE == 2) { const float v = fmaxf(acc[i][j], 0.f); C[(size_t)r * N + cidx] = v * v; }
            else {
                float* xp = (r < SEQ) ? xlat + (size_t)r * D + cidx : xctx + (size_t)(r - SEQ) * D + cidx;
                const float gt = (r < SEQ) ? gateb[cidx] : gatec[cidx];
                *xp = *xp + gt * acc[i][j];
            }
        }
    }
}

__global__ void k_conv(const float* __restrict__ proj, const float* __restrict__ cw, const float* __restrict__ cb, const float* __restrict__ lg, const float* __restrict__ lb, float* __restrict__ mix) {
    const int r = blockIdx.x, c = threadIdx.x;
    const int lo = (r < SEQ) ? 0 : SEQ, hi = (r < SEQ) ? SEQ : LROWS;
    float acc = cb[c];
    for (int k = 0; k < CONVW; ++k) {
        const int rr = r + k - CONVW / 2;
        if (rr >= lo && rr < hi) { const float v = proj[(size_t)rr * IND + c], gt = proj[(size_t)rr * IND + CONVD + c]; acc += cw[k * CONVD + c] * v * sigmoidf_(gt); }
    }
    __shared__ float red[256];
    red[c] = acc; __syncthreads();
    for (int s = 128; s > 0; s >>= 1) { if (c < s) red[c] += red[c + s]; __syncthreads(); }
    const float mu = red[0] / CONVD; __syncthreads();
    const float dlt = acc - mu;
    red[c] = dlt * dlt; __syncthreads();
    for (int s = 128; s > 0; s >>= 1) { if (c < s) red[c] += red[c + s]; __syncthreads(); }
    const float var = red[0] / CONVD;
    const float y = dlt * rsqrtf(var + EPS) * lg[c] + lb[c];
    mix[(size_t)r * D + c] = siluf_(y);
}

template <bool CTXQ>
__global__ void __launch_bounds__(64) k_na(const float* __restrict__ proj, const float* __restrict__ rpb, float* __restrict__ mix) {
    const int idx = blockIdx.x * blockDim.x + threadIdx.x;
    const int nq = CTXQ ? CTXL : SEQ;
    const int h = idx / nq, t = idx % nq;
    const int qrow = CTXQ ? SEQ + t : t;
    float4 q[16], o[16];
    const float4* qp = (const float4*)(proj + (size_t)qrow * IND + 512 + h * HD);
#pragma unroll
    for (int i = 0; i < 16; ++i) { q[i] = qp[i]; o[i] = make_float4(0.f, 0.f, 0.f, 0.f); }
    float mx = -1e30f, den = 0.f;
    const int nloc = CTXQ ? 0 : 128;
    const int row = t / 64, col = t % 64;
    int rs = row - 4; rs = rs < 0 ? 0 : (rs > 24 ? 24 : rs);
    int cs = col - 8; cs = cs < 0 ? 0 : (cs > 48 ? 48 : cs);
    for (int kk = 0; kk < nloc + CTXL; ++kk) {
        int krow; float bias = 0.f;
        if (kk < nloc) {
            const int j = kk >> 4, kc = cs + (kk & 15);
            krow = (rs + j) * 64 + kc;
            int ci = kc - col; ci = ci < -15 ? -15 : (ci > 15 ? 15 : ci);
            bias = rpb[(h * 15 + (rs + j - row + 7)) * 31 + ci + 15];
        } else krow = SEQ + (kk - nloc);
        const float4* kp = (const float4*)(proj + (size_t)krow * IND + 1024 + h * HD);
        float s = 0.f;
#pragma unroll
        for (int i = 0; i < 16; ++i) { const float4 kv = kp[i]; s += q[i].x * kv.x + q[i].y * kv.y + q[i].z * kv.z + q[i].w * kv.w; }
        s = s * 0.125f + bias;
        const float mn = fmaxf(mx, s);
        const float alpha = expf(mx - mn), p = expf(s - mn);
        den = den * alpha + p; mx = mn;
        const float4* vp = (const float4*)(proj + (size_t)krow * IND + 1536 + h * HD);
#pragma unroll
        for (int i = 0; i < 16; ++i) { const float4 vv = vp[i]; o[i].x = o[i].x * alpha + p * vv.x; o[i].y = o[i].y * alpha + p * vv.y; o[i].z = o[i].z * alpha + p * vv.z; o[i].w = o[i].w * alpha + p * vv.w; }
    }
    const float inv = 1.f / den;
    float4* op = (float4*)(mix + (size_t)qrow * D + 256 + h * HD);
#pragma unroll
    for (int i = 0; i < 16; ++i) op[i] = make_float4(o[i].x * inv, o[i].y * inv, o[i].z * inv, o[i].w * inv);
}

__global__ void k_lru_uc(const float* __restrict__ proj, const float* __restrict__ cw  , const float* __restrict__ cb  , float* __restrict__ uc) {
    const int r = blockIdx.x, c = threadIdx.x, dir = blockIdx.y;
    const int lo = (r < SEQ) ? 0 : SEQ, hi = (r < SEQ) ? SEQ : LROWS;
    float acc = cb[dir * LRUD + c];
    for (int k = 0; k < 4; ++k) { const int rr = dir == 0 ? r + k - 3 : r + k; if (rr >= lo && rr < hi) acc += cw[(dir * 4 + k) * LRUD + c] * proj[(size_t)rr * IND + 2048 + c]; }
    uc[((size_t)dir * LROWS + r) * LRUD + c] = acc;
}
__global__ void k_lru_gate(const float* __restrict__ uc, const float* __restrict__ wx, const float* __restrict__ bx, const float* __restrict__ wa, const float* __restrict__ ba, const float* __restrict__ lam, float* __restrict__ ca, float* __restrict__ cbv) {
    const int r = blockIdx.x, e = threadIdx.x, dir = blockIdx.y;
    const int kb = e >> 6, ee = e & 63;
    const float* u = uc + ((size_t)dir * LROWS + r) * LRUD;
    float sx = 0.f, sa = 0.f;
    for (int d = 0; d < 64; ++d) { const float uv = u[kb * 64 + d]; sx += uv * wx[(((size_t)dir * 4 + kb) * 64 + d) * 64 + ee]; sa += uv * wa[(((size_t)dir * 4 + kb) * 64 + d) * 64 + ee]; }
    const float gx = sigmoidf_(sx + bx[dir * LRUD + e]), ga = sigmoidf_(sa + ba[dir * LRUD + e]);
    const float nl = -lam[dir * LRUD + e];
    const float sp = fmaxf(nl, 0.f) + log1pf(expf(-fabsf(nl)));
    const float log_a = -8.f * ga * sp;
    const float a = expf(log_a);
    const float coef = sqrtf(-expm1f(2.f * log_a));
    ca[((size_t)dir * LROWS + r) * LRUD + e] = a;
    cbv[((size_t)dir * LROWS + r) * LRUD + e] = coef * gx * u[e];
}
__global__ void k_scan(const float* __restrict__ ca, const float* __restrict__ cbv, float* __restrict__ hbuf) {
    const int e = threadIdx.x, dir = blockIdx.x;
    const float* a = ca + (size_t)dir * LROWS * LRUD + e; const float* b = cbv + (size_t)dir * LROWS * LRUD + e; float* hh = hbuf + (size_t)dir * LROWS * LRUD + e;
    float h = 0.f;
    if (dir == 0) {
        for (int j = 0; j < CTXL; ++j) { const size_t o = (size_t)(SEQ + j) * LRUD; h = a[o] * h + b[o]; hh[o] = h; }
        for (int t = 0; t < SEQ; ++t) { const size_t o = (size_t)t * LRUD; h = a[o] * h + b[o]; hh[o] = h; }
    } else {
        for (int j = CTXL - 1; j >= 0; --j) { const size_t o = (size_t)(SEQ + j) * LRUD; h = a[o] * h + b[o]; hh[o] = h; }
        for (int t = SEQ - 1; t >= 0; --t) { const size_t o = (size_t)t * LRUD; h = a[o] * h + b[o]; hh[o] = h; }
    }
}
__global__ void k_lru_out(const float* __restrict__ proj, const float* __restrict__ hbuf, float* __restrict__ mix) {
    const int r = blockIdx.x, e = threadIdx.x;
    const float gt = proj[(size_t)r * IND + 2304 + e];
    mix[(size_t)r * D + 768 + e] = gelu_tanh(gt) * (hbuf[(size_t)r * LRUD + e] + hbuf[((size_t)LROWS + r) * LRUD + e]);
}
__global__ void k_final(float* __restrict__ x, const float* __restrict__ g) {
    const int r = blockIdx.x, t = threadIdx.x;
    float* xr = x + (size_t)r * D;
    float v[4]; float ss = 0.f;
    for (int i = 0; i < 4; ++i) { v[i] = xr[t + 256 * i]; ss += v[i] * v[i]; }
    __shared__ float red[256];
    red[t] = ss; __syncthreads();
    for (int s = 128; s > 0; s >>= 1) { if (t < s) red[t] += red[t + s]; __syncthreads(); }
    const float rs = rsqrtf(red[0] / D + EPS);
    for (int i = 0; i < 4; ++i) xr[t + 256 * i] = v[i] * rs * g[t + 256 * i];
}
}

extern "C" void kernel_launch(void* const* d_in, const int* in_sizes, int n_in, void* d_out, int out_size, void* d_ws, size_t ws_size, hipStream_t stream) {
    const float* x = (const float*)d_in[0]; const float* c = (const float*)d_in[1]; const float* ctx = (const float*)d_in[2]; const float* cctx = (const float*)d_in[3];
    const float* norm1_g = (const float*)d_in[4]; const float* norm2_g = (const float*)d_in[5]; const float* ada_w = (const float*)d_in[6]; const float* ada_b = (const float*)d_in[7];
    const float* w_in = (const float*)d_in[8]; const float* w_out = (const float*)d_in[9]; const float* conv_w = (const float*)d_in[10]; const float* conv_b = (const float*)d_in[11];
    const float* conv_ln_g = (const float*)d_in[12]; const float* conv_ln_b = (const float*)d_in[13]; const float* na_rpb = (const float*)d_in[14];
    const float* lru_conv_w = (const float*)d_in[15]; const float* lru_conv_b = (const float*)d_in[16]; const float* lru_wx = (const float*)d_in[17]; const float* lru_bx = (const float*)d_in[18];
    const float* lru_wa = (const float*)d_in[19]; const float* lru_ba = (const float*)d_in[20]; const float* lru_lambda = (const float*)d_in[21];
    const float* mlp_w1 = (const float*)d_in[22]; const float* mlp_w2 = (const float*)d_in[23]; const float* final_g = (const float*)d_in[24];
    float* out = (float*)d_out;
    char* ws = (char*)d_ws;
    size_t off = 0;
    auto take = [&](size_t bytes) { char* p = ws + off; off += (bytes + 255) & ~(size_t)255; return (float*)p; };
    float* mod = take((size_t)DEPTH * 17 * 6 * D * 4);
    float* CX = take((size_t)NB * CTXL * D * 4);
    float* XN = take((size_t)LROWS * D * 4);
    float* PROJ = take((size_t)LROWS * IND * 4);
    float* MIX = take((size_t)LROWS * D * 4);
    float* HID = take((size_t)LROWS * FF * 4);
    float* UC = take((size_t)2 * LROWS * LRUD * 4);
    float* CA = take((size_t)2 * LROWS * LRUD * 4);
    float* CB = take((size_t)2 * LROWS * LRUD * 4);
    float* HB = take((size_t)2 * LROWS * LRUD * 4);
    if (off > ws_size) { fprintf(stderr, "ws too small\n"); return; }

    (void)hipMemcpyAsync(out, x, (size_t)NB * SEQ * D * 4, hipMemcpyDeviceToDevice, stream);
    (void)hipMemcpyAsync(CX, ctx, (size_t)NB * CTXL * D * 4, hipMemcpyDeviceToDevice, stream);
    k_mod<<<dim3(6 * D / 256, 17, DEPTH), 256, 0, stream>>>(c, cctx, ada_w, ada_b, mod);
    for (int l = 0; l < DEPTH; ++l) {
        const bool last = (l == DEPTH - 1);
        const float* modl = mod + (size_t)l * 17 * 6 * D;
        const float* modc = modl + (size_t)16 * 6 * D;
        for (int b = 0; b < NB; ++b) {
            const float* modb = modl + (size_t)b * 6 * D;
            float* xl = out + (size_t)b * SEQ * D; float* xc = CX + (size_t)b * CTXL * D;
            k_norm<<<LROWS, 256, 0, stream>>>(xl, xc, norm1_g + l * D, modb, modc, 0, D, XN);
            k_gemm<0><<<dim3(IND / 64, LROWS / 64), 256, 0, stream>>>(XN, w_in + (size_t)l * D * IND, LROWS, IND, D, PROJ, nullptr, nullptr, nullptr, nullptr);
            k_conv<<<LROWS, 256, 0, stream>>>(PROJ, conv_w + (size_t)l * CONVW * CONVD, conv_b + l * CONVD, conv_ln_g + l * CONVD, conv_ln_b + l * CONVD, MIX);
            k_na<false><<<NH * SEQ / 64, 64, 0, stream>>>(PROJ, na_rpb + (size_t)l * NH * 15 * 31, MIX);
            if (!last) k_na<true><<<NH * CTXL / 64, 64, 0, stream>>>(PROJ, nullptr, MIX);
            k_lru_uc<<<dim3(LROWS, 2), 256, 0, stream>>>(PROJ, lru_conv_w + (size_t)l * 2 * 4 * LRUD, lru_conv_b + (size_t)l * 2 * LRUD, UC);
            k_lru_gate<<<dim3(LROWS, 2), 256, 0, stream>>>(UC, lru_wx + (size_t)l * 2 * 4 * 64 * 64, lru_bx + (size_t)l * 2 * LRUD, lru_wa + (size_t)l * 2 * 4 * 64 * 64, lru_ba + (size_t)l * 2 * LRUD, lru_lambda + (size_t)l * 2 * LRUD, CA, CB);
            k_scan<<<2, 256, 0, stream>>>(CA, CB, HB);
            k_lru_out<<<LROWS, 256, 0, stream>>>(PROJ, HB, MIX);
            const int Mr = last ? SEQ : LROWS;
            k_gemm<1><<<dim3(D / 64, Mr / 64), 256, 0, stream>>>(MIX, w_out + (size_t)l * D * D, Mr, D, D, nullptr, xl, xc, modb + 2 * D, modc + 2 * D);
            k_norm<<<Mr, 256, 0, stream>>>(xl, xc, norm2_g + l * D, modb, modc, 3 * D, 4 * D, XN);
            k_gemm<2><<<dim3(FF / 64, Mr / 64), 256, 0, stream>>>(XN, mlp_w1 + (size_t)l * D * FF, Mr, FF, D, HID, nullptr, nullptr, nullptr, nullptr);
            k_gemm<1><<<dim3(D / 64, Mr / 64), 256, 0, stream>>>(HID, mlp_w2 + (size_t)l * FF * D, Mr, D, FF, nullptr, xl, xc, modb + 5 * D, modc + 5 * D);
        }
    }
    k_final<<<NB * SEQ, 256, 0, stream>>>(out, final_g);
}
```

```cpp
#include <hip/hip_runtime.h>
#include <cstdio>
#include <cstdint>

constexpr int D = 1024, NB = 16, SEQ = 2048, CTXL = 256, DEPTH = 2;
constexpr int ML = NB * SEQ, MC = NB * CTXL, MT = ML + MC;
constexpr int IND = 2560, FF = 4096, NH = 8, HD = 64;
constexpr int MODW = 6 * D;
constexpr float EPS = 1e-6f;
#ifndef MK_N_LAUNCHES
#define MK_N_LAUNCHES 17
#endif

namespace pg8 {
#define PG8_LAS __attribute__((address_space(3)))
typedef unsigned short bf16_t;
typedef short bf16x8 __attribute__((ext_vector_type(8)));
typedef float f32x4 __attribute__((ext_vector_type(4)));
typedef unsigned u32x4 __attribute__((ext_vector_type(4)));
constexpr int BM = 256, BK = 64, HALF = 128, HTB = HALF * BK * 2, STAGE_BYTES = 8 * HTB, NXCD = 8, WGM = 8;

__host__ __device__ __forceinline__ int lds_byte(int r, int c) { const int st = (r >> 4) * 2 + (c >> 5), rr = r & 15, cc = c & 31, ob = rr * 64 + cc * 2; return st * 1024 + (ob ^ (((ob >> 9) & 1) << 5)); }
__host__ __device__ __forceinline__ void stage_rc(int b, int& R, int& C) { const int st = b / 1024, sb = b % 1024, swz = sb ^ (((sb >> 9) & 1) << 5); R = (st >> 1) * 16 + swz / 64; C = (st & 1) * 32 + (swz % 64) / 2; }
__host__ __device__ __forceinline__ int perm32(int rho) { const int n = rho >> 4, i = rho & 15; return 8 * (i >> 2) + 4 * n + (i & 3); }

struct Unit { int pm, pn; };
struct Gemm { const bf16_t* A; const bf16_t* Bt; int M, N, K; };

__host__ __device__ __forceinline__ void map_tile(int wgid, int nM, int nN, Unit& u) {
    const int nwg = nM * nN;
    { const int q = nwg / NXCD, r = nwg % NXCD, xcd = wgid % NXCD, off = wgid / NXCD; wgid = (xcd < r ? xcd * (q + 1) : r * (q + 1) + (xcd - r) * q) + off; }
    const int nig = WGM * nN, gid = wgid / nig, fm = gid * WGM, gsz = (nM - fm) < WGM ? (nM - fm) : WGM;
    u.pm = fm + ((wgid % nig) % gsz); u.pn = (wgid % nig) / gsz;
}
struct Order {
    int nM, nN, nwg, extra, G, c;
    __host__ __device__ void init(int M, int N, int extra_, int G_, int c_) { nM = M / BM; nN = N / BM; nwg = nM * nN; extra = extra_; G = G_; c = c_; }
    __host__ __device__ bool next(int i, Unit& u) const {
        const long L = (long)i * G + c;
        if (L < nwg) { map_tile((int)L, nM, nN, u); return true; }
        if (L < nwg + extra) { const int q = (int)L - nwg; u.pm = nM + q / 5; u.pn = 4 + q % 5; return true; }
        return false;
    }
    __device__ __forceinline__ void a_ready(const Unit&) const {}
    __device__ __forceinline__ void done(const Unit&) const {}
};

__device__ __forceinline__ unsigned cvt_pk_bf16(float lo, float hi) { unsigned r; asm volatile("v_cvt_pk_bf16_f32 %0, %1, %2" : "=v"(r) : "v"(lo), "v"(hi)); return r; }

__device__ __forceinline__ float row_rs(const float* RSSt, unsigned roff, int fq) {
    const f32x4 p0 = *(const f32x4*)(RSSt + (roff + 8u * (unsigned)fq)), p1 = *(const f32x4*)(RSSt + (roff + 8u * (unsigned)fq + 4u));
    float s = ((p0[0] + p0[1]) + (p0[2] + p0[3])) + ((p1[0] + p1[1]) + (p1[2] + p1[3]));
    s += __shfl_xor(s, 16); s += __shfl_xor(s, 32);
    return rsqrtf(s * (1.0f / D) + EPS);
}
template <int ACT, int LDC> struct EpiScale {
    static constexpr bool PERM = true, AFTER_DRAIN = false;
    bf16_t* O; const float* shw; const float* RSS;
    __device__ __forceinline__ void operator()(const f32x4 (&acc)[2][2][4][2], const Unit& u, int wr, int wc, int fr, int fq) const {
        const int brow = u.pm < ML / BM ? (u.pm >> 3) : NB;
        const float* sp = shw + (size_t)brow * LDC + u.pn * BM;
        bf16_t* Ot = O + (size_t)u.pm * BM * LDC + u.pn * BM;
        const float* RSSt = RSS + (size_t)u.pm * BM * 32;
        unsigned cl = (unsigned)(wc * 32 + 8 * fq);
        unsigned rl0 = (unsigned)(wr * 64 + fr);
        asm volatile("" : "+v"(cl), "+v"(rl0));
#pragma unroll
        for (int bj = 0; bj < 2; ++bj) {
            const f32x4 s0 = *(const f32x4*)(sp + (cl + (unsigned)(bj * HALF))), s1 = *(const f32x4*)(sp + (cl + (unsigned)(bj * HALF + 4)));
#pragma unroll
            for (int ai = 0; ai < 2; ++ai)
#pragma unroll
                for (int m = 0; m < 4; ++m) {
                    const float rs = row_rs(RSSt, (rl0 + (unsigned)(ai * HALF + m * 16)) * 32u, fq);
                    f32x4 v0 = acc[ai][bj][m][0] * rs + s0, v1 = acc[ai][bj][m][1] * rs + s1;
                    if (ACT == 1) {
#pragma unroll
                        for (int e = 0; e < 4; ++e) { const float a = fmaxf(v0[e], 0.f), b = fmaxf(v1[e], 0.f); v0[e] = a * a; v1[e] = b * b; }
                    }
                    u32x4 w; w.x = cvt_pk_bf16(v0[0], v0[1]); w.y = cvt_pk_bf16(v0[2], v0[3]); w.z = cvt_pk_bf16(v1[0], v1[1]); w.w = cvt_pk_bf16(v1[2], v1[3]);
                    *(u32x4*)(Ot + ((rl0 + (unsigned)(ai * HALF + m * 16)) * (unsigned)LDC + cl + (unsigned)(bj * HALF))) = w;
                }
        }
    }
};
struct EpiRes {
    static constexpr bool PERM = true, AFTER_DRAIN = false;
    const float* src_lat; const float* src_ctx; float* dst_lat; float* dst_ctx;
    const float* gate;
    const float* gmg; const float* gmsc;
    bf16_t* XA; float* RSS;
    __device__ __forceinline__ void operator()(const f32x4 (&acc)[2][2][4][2], const Unit& u, int wr, int wc, int fr, int fq) const {
        const bool lat = u.pm < ML / BM;
        const int brow = lat ? (u.pm >> 3) : NB;
        const float* src = (lat ? src_lat + (size_t)u.pm * BM * D : src_ctx + (size_t)(u.pm - ML / BM) * BM * D) + u.pn * BM;
        float* dst = (lat ? dst_lat + (size_t)u.pm * BM * D : dst_ctx + (size_t)(u.pm - ML / BM) * BM * D) + u.pn * BM;
        const float* gt = gate + (size_t)brow * MODW + u.pn * BM;
        const float* gg = gmg + u.pn * BM;
        const float* gs = gmsc + (size_t)brow * MODW + u.pn * BM;
        bf16_t* XAt = XA + (size_t)u.pm * BM * D + u.pn * BM;
        float* RSSt = RSS + (size_t)u.pm * BM * 32 + u.pn * 8 + wc;
        unsigned cl = (unsigned)(wc * 32 + 8 * fq);
        unsigned rl0 = (unsigned)(wr * 64 + fr);
        asm volatile("" : "+v"(cl), "+v"(rl0));
        const bool hasxa = XA != nullptr;
#pragma unroll
        for (int bj = 0; bj < 2; ++bj) {
            const unsigned c = cl + (unsigned)(bj * HALF);
            const f32x4 g0 = *(const f32x4*)(gt + c), g1 = *(const f32x4*)(gt + (c + 4u));
            f32x4 m0 = {0.f, 0.f, 0.f, 0.f}, m1 = {0.f, 0.f, 0.f, 0.f};
            if (hasxa) { m0 = *(const f32x4*)(gg + c) * (*(const f32x4*)(gs + c) + 1.0f); m1 = *(const f32x4*)(gg + (c + 4u)) * (*(const f32x4*)(gs + (c + 4u)) + 1.0f); }
#pragma unroll
            for (int ai = 0; ai < 2; ++ai)
#pragma unroll
                for (int m = 0; m < 4; ++m) {
                    const unsigned rl = rl0 + (unsigned)(ai * HALF + m * 16);
                    const unsigned off = rl * (unsigned)D + c;
                    const f32x4 x0 = *(const f32x4*)(src + off), x1 = *(const f32x4*)(src + (off + 4u));
                    const f32x4 y0 = x0 + g0 * acc[ai][bj][m][0], y1 = x1 + g1 * acc[ai][bj][m][1];
                    *(f32x4*)(dst + off) = y0; *(f32x4*)(dst + (off + 4u)) = y1;
                    float ss = ((y0[0] * y0[0] + y0[1] * y0[1]) + (y0[2] * y0[2] + y0[3] * y0[3])) + ((y1[0] * y1[0] + y1[1] * y1[1]) + (y1[2] * y1[2] + y1[3] * y1[3]));
                    ss += __shfl_xor(ss, 16); ss += __shfl_xor(ss, 32);
                    if (fq == 0) RSSt[rl * 32u + (unsigned)(bj * 4)] = ss;
                    if (hasxa) { const f32x4 a0 = y0 * m0, a1 = y1 * m1;
                        u32x4 w; w.x = cvt_pk_bf16(a0[0], a0[1]); w.y = cvt_pk_bf16(a0[2], a0[3]); w.z = cvt_pk_bf16(a1[0], a1[1]); w.w = cvt_pk_bf16(a1[2], a1[3]);
                        *(u32x4*)(XAt + off) = w; }
                    asm volatile("" ::: "memory");
                }
        }
    }
};

template <class Epi, class Sched, bool ALIGN_EPI = false, bool SP2 = false>
__device__ __forceinline__ void gemm_phase(PG8_LAS unsigned char* lds, const Gemm g, const Sched& S, const Epi& E, const int tid) {
    const int wid = __builtin_amdgcn_readfirstlane(tid >> 6), lane = tid & 63, wr = wid >> 2, wc = wid & 3, fr = lane & 15, fq = lane >> 4;
    const int K = g.K, nt = K / BK;
    unsigned voffA[2], voffB[2];
#pragma unroll
    for (int i = 0; i < 2; ++i) { int R, C; stage_rc(tid * 16 + i * 8192, R, C); const int Rb = Epi::PERM ? ((R & ~31) + perm32(R & 31)) : R;
        voffA[i] = (unsigned)(R * K + C) * 2u; voffB[i] = (unsigned)(Rb * K + C) * 2u; }
    const size_t kstep = (size_t)(BK * 2);
    const size_t hstep = (size_t)HALF * K * 2;
    const size_t tstep = 2 * hstep;
    const unsigned ldsw = (unsigned)wid * 1024u;
    const int aoff = lds_byte(wr * 64 + fr, fq * 8), boff = lds_byte(wc * 32 + fr, fq * 8);
#define PG8_SA(b, h) (((b) * 2 + (h)) * HTB)
#define PG8_SB(b, h) ((4 + (b) * 2 + (h)) * HTB)
#define PG8_STAGE(bufoff, gbase, voff) do { _Pragma("unroll") for (int _i = 0; _i < 2; ++_i) \
        __builtin_amdgcn_global_load_lds((const unsigned*)((const char*)(gbase) + (voff)[_i]), (PG8_LAS unsigned*)(lds + (bufoff) + ldsw + _i * 8192), 16, 0, 0); } while (0)
#define PG8_LDA(dst, b, h) do { _Pragma("unroll") for (int m = 0; m < 4; ++m) _Pragma("unroll") for (int k = 0; k < 2; ++k) dst[m][k] = *(const PG8_LAS bf16x8*)(lds + PG8_SA(b, h) + aoff + m * 2048 + k * 1024); } while (0)
#define PG8_LDB(dst, b, h) do { _Pragma("unroll") for (int n = 0; n < 2; ++n) _Pragma("unroll") for (int k = 0; k < 2; ++k) dst[n][k] = *(const PG8_LAS bf16x8*)(lds + PG8_SB(b, h) + boff + n * 2048 + k * 1024); } while (0)
#define PG8_MMA(ai, bj, At, Bt) do { __builtin_amdgcn_s_setprio(1); _Pragma("unroll") for (int m = 0; m < 4; ++m) _Pragma("unroll") for (int n = 0; n < 2; ++n) _Pragma("unroll") for (int k = 0; k < 2; ++k) \
        acc[ai][bj][m][n] = __builtin_amdgcn_mfma_f32_16x16x32_bf16(Bt[n][k], At[m][k], acc[ai][bj][m][n], 0, 0, 0); __builtin_amdgcn_s_setprio(0); } while (0)
#define PG8_WAIT_V(n) asm volatile("s_waitcnt vmcnt(" #n ")" ::: "memory")
#define PG8_WAIT_L(n) asm volatile("s_waitcnt lgkmcnt(" #n ")" ::: "memory")
#define PG8_BAR __builtin_amdgcn_s_barrier()
#define PG8_SCHED __builtin_amdgcn_sched_barrier(0)
    Unit cur, nxt; int ui = 0;
    if (!S.next(0, cur)) return;
    f32x4 acc[2][2][4][2];
#pragma unroll
    for (int a = 0; a < 2; ++a)
#pragma unroll
        for (int b = 0; b < 2; ++b)
#pragma unroll
            for (int m = 0; m < 4; ++m)
#pragma unroll
                for (int n = 0; n < 2; ++n) acc[a][b][m][n] = (f32x4){0.f, 0.f, 0.f, 0.f};
    bf16x8 At[4][2], B0[2][2], B1[2][2];
    const char* cA = (const char*)g.A + (size_t)cur.pm * tstep; const char* cB = (const char*)g.Bt + (size_t)cur.pn * tstep;
    S.a_ready(cur);
    if constexpr (SP2) {
        PG8_STAGE(PG8_SB(0, 0), cB, voffB); PG8_STAGE(PG8_SB(0, 1), cB + hstep, voffB); PG8_STAGE(PG8_SA(0, 0), cA, voffA); PG8_STAGE(PG8_SA(0, 1), cA + hstep, voffA);
        if (wr == 1) PG8_BAR;
        PG8_WAIT_V(2); PG8_BAR;
        PG8_STAGE(PG8_SB(1, 0), cB + kstep, voffB); PG8_STAGE(PG8_SA(1, 0), cA + kstep, voffA); PG8_STAGE(PG8_SB(1, 1), cB + hstep + kstep, voffB);
        PG8_WAIT_V(6); PG8_BAR;
    } else {
        PG8_STAGE(PG8_SB(0, 0), cB, voffB); PG8_STAGE(PG8_SA(0, 0), cA, voffA); PG8_STAGE(PG8_SB(0, 1), cB + hstep, voffB); PG8_STAGE(PG8_SA(0, 1), cA + hstep, voffA);
        if (wr == 1) PG8_BAR;
        PG8_WAIT_V(4); PG8_BAR;
        PG8_STAGE(PG8_SB(1, 0), cB + kstep, voffB); PG8_STAGE(PG8_SA(1, 0), cA + kstep, voffA); PG8_STAGE(PG8_SB(1, 1), cB + hstep + kstep, voffB);
        PG8_WAIT_V(6); PG8_BAR;
    }
    for (;;) {
        const bool has_next = S.next(ui + 1, nxt);
        const char* nA = has_next ? (const char*)g.A + (size_t)nxt.pm * tstep : cA; const char* nB = has_next ? (const char*)g.Bt + (size_t)nxt.pn * tstep : cB;
        for (int t = 0; t < nt; t += 2) {
            const bool last = (t == nt - 2);
            const char* a1 = cA + (size_t)(t + 1) * kstep;
            const char* a2 = last ? nA : cA + (size_t)(t + 2) * kstep; const char* b2 = last ? nB : cB + (size_t)(t + 2) * kstep;
            const char* a3 = a2 + kstep; const char* b3 = b2 + kstep;
            if (last && has_next) S.a_ready(nxt);
            if constexpr (SP2) {
            PG8_LDB(B0, 0, 0); PG8_LDB(B1, 0, 1); PG8_SCHED; PG8_LDA(At, 0, 0); PG8_STAGE(PG8_SA(1, 1), a1 + hstep, voffA);
            PG8_WAIT_V(8); PG8_WAIT_L(0); PG8_BAR; PG8_MMA(0, 0, At, B0); PG8_MMA(0, 1, At, B1); PG8_BAR; PG8_SCHED;
            PG8_LDA(At, 0, 1); PG8_STAGE(PG8_SB(0, 0), b2, voffB); PG8_STAGE(PG8_SB(0, 1), b2 + hstep, voffB); PG8_STAGE(PG8_SA(0, 0), a2, voffA);
            PG8_WAIT_V(8); PG8_WAIT_L(0); PG8_BAR; PG8_MMA(1, 0, At, B0); PG8_MMA(1, 1, At, B1); PG8_BAR; PG8_SCHED;
            PG8_LDB(B0, 1, 0); PG8_LDB(B1, 1, 1); PG8_SCHED; PG8_LDA(At, 1, 0); PG8_STAGE(PG8_SA(0, 1), a2 + hstep, voffA);
            PG8_WAIT_V(8); PG8_WAIT_L(0); PG8_BAR; PG8_MMA(0, 0, At, B0); PG8_MMA(0, 1, At, B1); PG8_BAR; PG8_SCHED;
            PG8_LDA(At, 1, 1); PG8_STAGE(PG8_SB(1, 0), b3, voffB); PG8_STAGE(PG8_SB(1, 1), b3 + hstep, voffB); PG8_STAGE(PG8_SA(1, 0), a3, voffA);
            PG8_WAIT_V(8); PG8_WAIT_L(0); PG8_BAR; PG8_MMA(1, 0, At, B0); PG8_MMA(1, 1, At, B1); PG8_BAR; PG8_SCHED;
            } else {
            PG8_LDB(B0, 0, 0); PG8_SCHED; PG8_LDA(At, 0, 0); PG8_STAGE(PG8_SA(1, 1), a1 + hstep, voffA);
            PG8_WAIT_L(8); PG8_BAR; PG8_WAIT_L(0); PG8_MMA(0, 0, At, B0); PG8_BAR; PG8_SCHED;
            PG8_LDB(B1, 0, 1); PG8_STAGE(PG8_SB(0, 0), b2, voffB);
            PG8_BAR; PG8_WAIT_L(0); PG8_MMA(0, 1, At, B1); PG8_BAR;
            PG8_LDA(At, 0, 1); PG8_STAGE(PG8_SA(0, 0), a2, voffA);
            PG8_BAR; PG8_WAIT_L(0); PG8_MMA(1, 0, At, B0); PG8_BAR; PG8_SCHED;
            PG8_STAGE(PG8_SB(0, 1), b2 + hstep, voffB);
            PG8_WAIT_V(6); PG8_BAR; PG8_MMA(1, 1, At, B1); PG8_BAR;
            PG8_LDB(B0, 1, 0); PG8_SCHED; PG8_LDA(At, 1, 0); PG8_STAGE(PG8_SA(0, 1), a2 + hstep, voffA);
            PG8_WAIT_L(8); PG8_BAR; PG8_WAIT_L(0); PG8_MMA(0, 0, At, B0); PG8_BAR; PG8_SCHED;
            PG8_LDB(B1, 1, 1); PG8_STAGE(PG8_SB(1, 0), b3, voffB);
            PG8_BAR; PG8_WAIT_L(0); PG8_MMA(0, 1, At, B1); PG8_BAR;
            PG8_LDA(At, 1, 1); PG8_STAGE(PG8_SA(1, 0), a3, voffA);
            PG8_BAR; PG8_WAIT_L(0); PG8_MMA(1, 0, At, B0); PG8_BAR; PG8_SCHED;
            PG8_STAGE(PG8_SB(1, 1), b3 + hstep, voffB);
            PG8_WAIT_V(6); PG8_BAR; PG8_MMA(1, 1, At, B1); PG8_BAR;
            }
        }
        if constexpr (ALIGN_EPI) { if (wr == 0) PG8_BAR; }
        if constexpr (!Epi::AFTER_DRAIN) { E(acc, cur, wr, wc, fr, fq); S.done(cur); }
        if (!has_next) break;
#pragma unroll
        for (int a = 0; a < 2; ++a)
#pragma unroll
            for (int b = 0; b < 2; ++b)
#pragma unroll
                for (int m = 0; m < 4; ++m)
#pragma unroll
                    for (int n = 0; n < 2; ++n) acc[a][b][m][n] = (f32x4){0.f, 0.f, 0.f, 0.f};
        cur = nxt; cA = nA; cB = nB; ++ui;
        if constexpr (ALIGN_EPI) { if (wr == 1) PG8_BAR; }
    }
    PG8_WAIT_V(0);
    if constexpr (!ALIGN_EPI) { if (wr == 0) PG8_BAR; }
    PG8_BAR;
    if constexpr (Epi::AFTER_DRAIN) { E.fused(acc, cur, wr, wc, fr, fq, lds, wid, lane); S.done(cur); }
#undef PG8_SA
#undef PG8_SB
#undef PG8_STAGE
#undef PG8_LDA
#undef PG8_LDB
#undef PG8_MMA
#undef PG8_WAIT_V
#undef PG8_WAIT_L
#undef PG8_BAR
#undef PG8_SCHED
}
}

constexpr size_t MiB = 1u << 20;
constexpr size_t WS_CTL = 0, CTL_ZERO_BYTES = 1 * MiB;
constexpr size_t WS_MOD = 1 * MiB;
constexpr size_t WS_SHW1 = 2 * MiB;
constexpr size_t WS_SHW2 = 3 * MiB;
constexpr size_t WS_RSSA = 4 * MiB;
constexpr size_t WS_RSSB = 9 * MiB;
constexpr size_t WS_TOT = 14 * MiB;
constexpr size_t WS_CARRY = 19 * MiB;
constexpr size_t WS_WIN = 22 * MiB;
constexpr size_t WS_WOUT = 32 * MiB;
constexpr size_t WS_W1 = 36 * MiB;
constexpr size_t WS_W2 = 52 * MiB;
constexpr size_t WS_CX = 68 * MiB;
constexpr size_t WS_XA = 84 * MiB;
constexpr size_t WS_HID = 156 * MiB;
constexpr size_t WS_PROJ = WS_HID;
constexpr size_t WS_MIX = WS_HID + 180 * MiB;
constexpr size_t WS_END = 444 * MiB;
static_assert(WS_MIX + (size_t)MT * D * 2 <= WS_END && WS_HID + (size_t)MT * FF * 2 == WS_END, "ws map");
constexpr int CW_BAR = 4096;

constexpr int NWAVES = 8;
constexpr int RING_OFF = 0, RING_BYTES = 131072;
constexpr int LDSCTL_OFF = RING_BYTES, MISC_OFF = LDSCTL_OFF + 320;
constexpr int LDS_BYTES = 147456;

#define GAS __attribute__((address_space(1)))
#define LAS __attribute__((address_space(3)))
typedef unsigned short bf16;
typedef unsigned v4u __attribute__((ext_vector_type(4)));
typedef unsigned v2u __attribute__((ext_vector_type(2)));
typedef float f32x4 __attribute__((ext_vector_type(4)));
typedef float f32x2 __attribute__((ext_vector_type(2)));
typedef GAS unsigned gu32;
#define LDS_WAIT() asm volatile("s_waitcnt lgkmcnt(0)" ::: "memory")
#define VM_WAIT() asm volatile("s_waitcnt vmcnt(0)" ::: "memory")
__device__ __forceinline__ unsigned f2bf(float f) { unsigned u = __builtin_bit_cast(unsigned, f); return (u + 0x7fffu + ((u >> 16) & 1u)) >> 16; }
__device__ __forceinline__ unsigned pk2(float lo, float hi) { return f2bf(lo) | (f2bf(hi) << 16); }
__device__ __forceinline__ float bflo(unsigned w) { return __uint_as_float(w << 16); }
__device__ __forceinline__ float bfhi(unsigned w) { return __uint_as_float(w & 0xffff0000u); }
__device__ __forceinline__ float bf1(bf16 v) { return __uint_as_float((unsigned)v << 16); }
__device__ __forceinline__ float sigmoidf_(float x) { return 1.f / (1.f + __expf(-x)); }
__device__ __forceinline__ float siluf_(float x) { return x * sigmoidf_(x); }
__device__ __forceinline__ float gelu_tanh(float x) { const float u = 0.7978845608028654f * (x + 0.044715f * x * x * x); return x * sigmoidf_(2.f * u); }
__device__ __forceinline__ float wave_sum(float v) {
#pragma unroll
    for (int o = 1; o < 64; o <<= 1) v += __shfl_xor(v, o);
    return v;
}

#define XB_TMO      128
#define XB_XCNT(j)  (256  + 64 * (j))
#define XB_XSUB(j)  (1280 + 64 * (j))
#define XB_XGEN(j)  (2304 + 64 * (j))
#define XB_TOP      3328
#define XB_TOPGEN   3392
#define XCD_BAR_WORDS 3456
#define XB_SPIN_CAP (1u << 18)

__device__ __forceinline__ unsigned xb_ld(unsigned* p)              { return __hip_atomic_load(p, __ATOMIC_RELAXED, __HIP_MEMORY_SCOPE_AGENT); }
__device__ __forceinline__ unsigned xb_add(unsigned* p, unsigned v) { return __hip_atomic_fetch_add(p, v, __ATOMIC_RELAXED, __HIP_MEMORY_SCOPE_AGENT); }
__device__ __forceinline__ unsigned xb_xcc_id() { return (unsigned)__builtin_amdgcn_s_getreg((3 << 11) | 20) & 0xFu; }
#define XB_SPIN(cond, bar) do { unsigned _sp = 0; while (cond) { __builtin_amdgcn_s_sleep(1); \
    if ((++_sp & 255u) == 0u) { if (xb_ld(&(bar)[XB_TMO])) break; if (_sp > XB_SPIN_CAP) { atomicAdd(&(bar)[XB_TMO], 1u); break; } } } } while (0)

struct XcdBarrier {
    unsigned* bar; unsigned x;
    volatile LAS unsigned* st;
};

__device__ __forceinline__ XcdBarrier xcd_barrier_post(unsigned* bar, volatile LAS unsigned* st) {
    XcdBarrier b; b.bar = bar; b.x = xb_xcc_id(); b.st = st;
    if (threadIdx.x == 0) (void)xb_add(&bar[XB_XCNT(b.x)], 1u);
    return b;
}
__device__ __forceinline__ void xcd_barrier_complete(unsigned* bar, unsigned x, unsigned& nloc, unsigned& nx) {
    const unsigned G = gridDim.x * gridDim.y * gridDim.z;
    unsigned sum, cnt, mine, sp = 0u;
    for (;;) {
        sum = 0u; cnt = 0u; mine = 0u;
#pragma unroll
        for (unsigned j = 0; j < 16; ++j) { const unsigned c = xb_ld(&bar[XB_XCNT(j)]); sum += c; cnt += (c > 0u) ? 1u : 0u; mine = (j == x) ? c : mine; }
        if (sum == G) break;
        __builtin_amdgcn_s_sleep(1);
        if ((++sp & 255u) == 0u) { if (xb_ld(&bar[XB_TMO])) break; if (sp > XB_SPIN_CAP) { atomicAdd(&bar[XB_TMO], 1u); break; } }
    }
    nloc = mine > 0u ? mine : 1u; nx = cnt > 0u ? cnt : 1u;
}

__device__ __forceinline__ void xcd_barrier(const XcdBarrier& b) {
    asm volatile("s_waitcnt vmcnt(0)" ::: "memory");
    __syncthreads();
    if (threadIdx.x == 0) {
        unsigned* bar = b.bar;
        __builtin_amdgcn_s_waitcnt(0);
        unsigned nloc = b.st[0], nx = b.st[1];
        if (nloc == 0u) { xcd_barrier_complete(bar, b.x, nloc, nx); b.st[0] = nloc; b.st[1] = nx; }
        const unsigned old = xb_add(&bar[XB_XSUB(b.x)], 1u);
        const unsigned gen = old / nloc;
        if (old + 1u == (gen + 1u) * nloc) {
            __builtin_amdgcn_fence(__ATOMIC_RELEASE, "agent");
            asm volatile("s_waitcnt vmcnt(0)" ::: "memory");
            const unsigned og = xb_add(&bar[XB_TOP], 1u);
            const unsigned tg = og / nx;
            if (og + 1u == (tg + 1u) * nx) xb_add(&bar[XB_TOPGEN], 1u);
            else XB_SPIN(xb_ld(&bar[XB_TOPGEN]) == tg, bar);
            __builtin_amdgcn_fence(__ATOMIC_ACQUIRE, "agent");
            xb_add(&bar[XB_XGEN(b.x)], 1u);
            asm volatile("s_waitcnt vmcnt(0)" ::: "memory");
        } else {
            XB_SPIN(xb_ld(&bar[XB_XGEN(b.x)]) == gen, bar);
            __builtin_amdgcn_fence(__ATOMIC_ACQUIRE, "agent");
            asm volatile("s_waitcnt vmcnt(0)" ::: "memory");
        }
    }
    __syncthreads();
}

struct Frame {
    LAS unsigned char* lds;
    int tid, lane, wave;
    int vcu, G;
    int gw, NGW;
    const float* in[25]; float* out; unsigned char* ws;
};
#define WSP(T, off) ((T*)(F.ws + (off)))

__device__ __forceinline__ void gemv17_item(Frame& F, const LAS float* tab, LAS float* red, const float* W, int ldw, int n0, const float* bias, float* outp, int ldo) {
    float acc[17];
#pragma unroll
    for (int r = 0; r < 17; ++r) acc[r] = 0.f;
    const int k0 = F.wave * 128;
    const float* wp = W + (size_t)k0 * ldw + n0 + F.lane;
#pragma unroll 4
    for (int k = 0; k < 128; ++k) {
        const float wv = wp[(size_t)k * ldw];
#pragma unroll
        for (int r = 0; r < 17; ++r) acc[r] += tab[r * 1024 + k0 + k] * wv;
    }
#pragma unroll
    for (int r = 0; r < 17; ++r) red[(F.wave * 17 + r) * 64 + F.lane] = acc[r];
    __syncthreads();
    for (int i = F.tid; i < 17 * 64; i += NWAVES * 64) {
        const int r = i >> 6, n = i & 63; float s = bias ? bias[n0 + n] : 0.f;
#pragma unroll
        for (int w = 0; w < 8; ++w) s += red[(w * 17 + r) * 64 + n];
        outp[(size_t)r * ldo + n0 + n] = s;
    }
    __syncthreads();
}

__device__ __forceinline__ void p0_transpose_item(const float* W, int K, int N, bf16* WT, LAS float* scr, int item, int lane) {
    const int nblk = N / 32, kb = item / nblk, nb = item % nblk, k0 = 64 * kb, n0 = 32 * nb;
#pragma unroll 8
    for (int i = 0; i < 32; ++i) { const int kk = 2 * i + (lane >> 5); scr[kk * 33 + (lane & 31)] = W[(size_t)(k0 + kk) * N + n0 + (lane & 31)]; }
    LDS_WAIT(); asm volatile("" ::: "memory");
    const int c = lane & 7;
#pragma unroll
    for (int j = 0; j < 4; ++j) { const int n = (lane >> 3) + 8 * j; const LAS float* s = scr + (8 * c) * 33 + n;
        v4u o; o.x = pk2(s[0 * 33], s[1 * 33]); o.y = pk2(s[2 * 33], s[3 * 33]); o.z = pk2(s[4 * 33], s[5 * 33]); o.w = pk2(s[6 * 33], s[7 * 33]);
        *(GAS v4u*)(WT + (size_t)(n0 + n) * K + k0 + 8 * c) = o; }
    LDS_WAIT(); asm volatile("" ::: "memory");
}

__device__ __forceinline__ void phase_p0a(Frame& F) {
    LAS float* tab = (LAS float*)(F.lds);
    LAS float* red = (LAS float*)(F.lds + 17 * 1024 * 4);
    float* MOD = WSP(float, WS_MOD);
    bool filled = false;
    for (int it = F.vcu; it < 2 * 96; it += F.G) {
        if (!filled) {
            for (int i = F.tid; i < 17 * 1024; i += NWAVES * 64) { const int r = i >> 10, k = i & 1023; const float v = (r < 16) ? F.in[1][r * D + k] : F.in[3][k]; tab[i] = siluf_(v); }
            __syncthreads(); filled = true;
        }
        const int l = it / 96, n0 = (it % 96) * 64;
        gemv17_item(F, tab, red, F.in[6] + (size_t)l * D * MODW, MODW, n0, F.in[7] + (size_t)l * MODW, MOD + (size_t)l * 17 * MODW, MODW);
    }
    __syncthreads();
    LAS float* scr = (LAS float*)(F.lds + F.wave * 16384);
    constexpr int I_IN = (D / 64) * (IND / 32), I_OUT = (D / 64) * (D / 32), I_1 = (D / 64) * (FF / 32), I_2 = (FF / 64) * (D / 32), I_L = I_IN + I_OUT + I_1 + I_2;
    for (int it = F.gw; it < 2 * I_L; it += F.NGW) {
        const int l = it / I_L; int r = it % I_L;
        if (r < I_IN) { p0_transpose_item(F.in[8] + (size_t)l * D * IND, D, IND, WSP(bf16, WS_WIN) + (size_t)l * IND * D, scr, r, F.lane); continue; } r -= I_IN;
        if (r < I_OUT) { p0_transpose_item(F.in[9] + (size_t)l * D * D, D, D, WSP(bf16, WS_WOUT) + (size_t)l * D * D, scr, r, F.lane); continue; } r -= I_OUT;
        if (r < I_1) { p0_transpose_item(F.in[22] + (size_t)l * D * FF, D, FF, WSP(bf16, WS_W1) + (size_t)l * FF * D, scr, r, F.lane); continue; } r -= I_1;
        p0_transpose_item(F.in[23] + (size_t)l * FF * D, FF, D, WSP(bf16, WS_W2) + (size_t)l * D * FF, scr, r, F.lane);
    }
}

__device__ __forceinline__ void phase_p0b(Frame& F) {
    LAS float* tab = (LAS float*)(F.lds);
    LAS float* red = (LAS float*)(F.lds + 17 * 1024 * 4);
    const float* MOD = WSP(const float, WS_MOD);
    for (int it = F.vcu; it < 2 * 104; it += F.G) {
        const int l = it / 104, j = it % 104; const bool first = j < 40;
        const int shoff = first ? 0 : 3 * D;
        __syncthreads();
        for (int i = F.tid; i < 17 * 1024; i += NWAVES * 64) { const int r = i >> 10, k = i & 1023; tab[i] = MOD[((size_t)l * 17 + r) * MODW + shoff + k]; }
        __syncthreads();
        if (first) gemv17_item(F, tab, red, F.in[8] + (size_t)l * D * IND, IND, j * 64, nullptr, WSP(float, WS_SHW1) + (size_t)l * 17 * IND, IND);
        else gemv17_item(F, tab, red, F.in[22] + (size_t)l * D * FF, FF, (j - 40) * 64, nullptr, WSP(float, WS_SHW2) + (size_t)l * 17 * FF, FF);
    }
    bf16* XA = WSP(bf16, WS_XA); float* RSSA = WSP(float, WS_RSSA);
    const float* g1 = F.in[4];
    for (int row = F.gw; row < MT; row += F.NGW) {
        const bool lat = row < ML;
        const float* xr = lat ? F.in[0] + (size_t)row * D : F.in[2] + (size_t)(row - ML) * D;
        const int brow = lat ? (row >> 11) : NB;
        const float* sc = MOD + (size_t)brow * MODW + D;
        f32x4 v[4]; float ss = 0.f;
#pragma unroll
        for (int j = 0; j < 4; ++j) { v[j] = *(const f32x4*)(xr + 4 * F.lane + 256 * j); ss += (v[j][0] * v[j][0] + v[j][1] * v[j][1]) + (v[j][2] * v[j][2] + v[j][3] * v[j][3]); }
        ss = wave_sum(ss);
        if (F.lane < 32) RSSA[(size_t)row * 32 + F.lane] = (F.lane == 0) ? ss : 0.f;
#pragma unroll
        for (int j = 0; j < 4; ++j) { const int k = 4 * F.lane + 256 * j;
            const f32x4 gm = *(const f32x4*)(g1 + k) * (*(const f32x4*)(sc + k) + 1.0f), a = v[j] * gm;
            v2u o; o.x = pk2(a[0], a[1]); o.y = pk2(a[2], a[3]); *(v2u*)(XA + (size_t)row * D + k) = o; }
    }
}

__device__ __forceinline__ void conv_row(Frame& F, int l, int row) {
    const bf16* PROJ = WSP(const bf16, WS_PROJ); bf16* MIX = WSP(bf16, WS_MIX);
    const float* cw = F.in[10] + (size_t)l * 31 * 256; const float* cb = F.in[11] + l * 256; const float* lg = F.in[12] + l * 256; const float* lb = F.in[13] + l * 256;
    int lo, hi; if (row < ML) { lo = row & ~(SEQ - 1); hi = lo + SEQ; } else { lo = row & ~(CTXL - 1); hi = lo + CTXL; }
    const int c0 = 4 * F.lane;
    f32x4 acc = *(const f32x4*)(cb + c0);
    for (int k = 0; k < 31; ++k) {
        const int rr = row + k - 15;
        if (rr >= lo && rr < hi) {
            const v2u vv = *(const v2u*)(PROJ + (size_t)rr * IND + c0), gg = *(const v2u*)(PROJ + (size_t)rr * IND + 256 + c0);
            const f32x4 w = *(const f32x4*)(cw + k * 256 + c0);
            acc[0] += w[0] * bflo(vv.x) * sigmoidf_(bflo(gg.x)); acc[1] += w[1] * bfhi(vv.x) * sigmoidf_(bfhi(gg.x));
            acc[2] += w[2] * bflo(vv.y) * sigmoidf_(bflo(gg.y)); acc[3] += w[3] * bfhi(vv.y) * sigmoidf_(bfhi(gg.y));
        }
    }
    const float mu = wave_sum((acc[0] + acc[1]) + (acc[2] + acc[3])) * (1.f / 256.f);
    const f32x4 d = acc - mu;
    const float var = wave_sum((d[0] * d[0] + d[1] * d[1]) + (d[2] * d[2] + d[3] * d[3])) * (1.f / 256.f);
    const f32x4 y = d * rsqrtf(var + EPS) * *(const f32x4*)(lg + c0) + *(const f32x4*)(lb + c0);
    v2u o; o.x = pk2(siluf_(y[0]), siluf_(y[1])); o.y = pk2(siluf_(y[2]), siluf_(y[3]));
    *(v2u*)(MIX + (size_t)row * D + c0) = o;
}

__device__ __forceinline__ void na_item(Frame& F, int l, int it) {
    const bf16* PROJ = WSP(const bf16, WS_PROJ); bf16* MIX = WSP(bf16, WS_MIX);
    const bool isctx = it >= 4096;
    int b, h, r;
    if (!isctx) { b = it >> 8; h = (it >> 5) & 7; r = it & 31; } else { const int j = it - 4096; b = j >> 5; h = (j >> 2) & 7; r = j & 3; }
    const int lane = F.lane;
    const size_t qrow = isctx ? (size_t)ML + b * CTXL + r * 64 + lane : (size_t)b * SEQ + r * 64 + lane;
    float q[64], o[64];
    {
        const v4u* qp = (const v4u*)(PROJ + qrow * IND + 512 + h * HD);
#pragma unroll
        for (int i = 0; i < 8; ++i) { const v4u w = qp[i];
            q[8 * i + 0] = bflo(w.x) * 0.125f; q[8 * i + 1] = bfhi(w.x) * 0.125f; q[8 * i + 2] = bflo(w.y) * 0.125f; q[8 * i + 3] = bfhi(w.y) * 0.125f;
            q[8 * i + 4] = bflo(w.z) * 0.125f; q[8 * i + 5] = bfhi(w.z) * 0.125f; q[8 * i + 6] = bflo(w.w) * 0.125f; q[8 * i + 7] = bfhi(w.w) * 0.125f; }
#pragma unroll
        for (int i = 0; i < 64; ++i) o[i] = 0.f;
    }
    float mx = -3.0e38f, den = 0.f;
    const int nloc = isctx ? 0 : 128;
    int rs = r - 4; rs = rs < 0 ? 0 : (rs > 24 ? 24 : rs);
    int cs = lane - 8; cs = cs < 0 ? 0 : (cs > 48 ? 48 : cs);
    const float* rpb = F.in[14] + ((size_t)l * NH + h) * 15 * 31;
    for (int kk = 0; kk < nloc + CTXL; ++kk) {
        size_t krow; float bias = 0.f;
        if (kk < nloc) { const int j = kk >> 4, kc = cs + (kk & 15); krow = (size_t)b * SEQ + (rs + j) * 64 + kc; bias = rpb[(rs + j - r + 7) * 31 + (kc - lane + 15)]; }
        else krow = (size_t)ML + b * CTXL + (kk - nloc);
        const v4u* kp = (const v4u*)(PROJ + krow * IND + 1024 + h * HD);
        float s = bias;
#pragma unroll
        for (int i = 0; i < 8; ++i) { const v4u w = kp[i];
            s += q[8 * i + 0] * bflo(w.x) + q[8 * i + 1] * bfhi(w.x) + q[8 * i + 2] * bflo(w.y) + q[8 * i + 3] * bfhi(w.y) + q[8 * i + 4] * bflo(w.z) + q[8 * i + 5] * bfhi(w.z) + q[8 * i + 6] * bflo(w.w) + q[8 * i + 7] * bfhi(w.w); }
        const float mn = fmaxf(mx, s), alpha = __expf(mx - mn), p = __expf(s - mn);
        den = den * alpha + p; mx = mn;
        const v4u* vp = (const v4u*)(PROJ + krow * IND + 1536 + h * HD);
#pragma unroll
        for (int i = 0; i < 8; ++i) { const v4u w = vp[i];
            o[8 * i + 0] = o[8 * i + 0] * alpha + p * bflo(w.x); o[8 * i + 1] = o[8 * i + 1] * alpha + p * bfhi(w.x); o[8 * i + 2] = o[8 * i + 2] * alpha + p * bflo(w.y); o[8 * i + 3] = o[8 * i + 3] * alpha + p * bfhi(w.y);
            o[8 * i + 4] = o[8 * i + 4] * alpha + p * bflo(w.z); o[8 * i + 5] = o[8 * i + 5] * alpha + p * bfhi(w.z); o[8 * i + 6] = o[8 * i + 6] * alpha + p * bflo(w.w); o[8 * i + 7] = o[8 * i + 7] * alpha + p * bfhi(w.w); }
    }
    const float inv = 1.f / den;
    v4u* op = (v4u*)(MIX + qrow * D + 256 + h * HD);
#pragma unroll
    for (int i = 0; i < 8; ++i) { v4u w; w.x = pk2(o[8 * i + 0] * inv, o[8 * i + 1] * inv); w.y = pk2(o[8 * i + 2] * inv, o[8 * i + 3] * inv); w.z = pk2(o[8 * i + 4] * inv, o[8 * i + 5] * inv); w.w = pk2(o[8 * i + 6] * inv, o[8 * i + 7] * inv); op[i] = w; }
}

template <int PASS>
__device__ __forceinline__ void lru_tile(Frame& F, int l, int T) {
    const bf16* PROJ = WSP(const bf16, WS_PROJ);
    LAS unsigned* rxs = (LAS unsigned*)(F.lds);
    LAS float* ucs = (LAS float*)(F.lds + 38 * 128 * 4);
    LAS float* hs = (LAS float*)(F.lds + 38 * 128 * 4 + 65536);
    const int row0 = T * 32;
    int lo, hi; if (row0 < ML) { lo = row0 & ~(SEQ - 1); hi = lo + SEQ; } else { lo = row0 & ~(CTXL - 1); hi = lo + CTXL; }
    __syncthreads();
    for (int i = F.tid; i < 38 * 128; i += NWAVES * 64) { const int rr = i >> 7, cp = i & 127, row = row0 - 3 + rr;
        rxs[i] = (row >= lo && row < hi) ? *(const unsigned*)(PROJ + (size_t)row * IND + 2048 + 2 * cp) : 0u; }
    if (PASS == 1) for (int i = F.tid; i < 32 * 256; i += NWAVES * 64) hs[i] = 0.f;
    __syncthreads();
    const int dir = F.tid >> 8, c = F.tid & 255;
    {
        const float* cw = F.in[15] + ((size_t)(l * 2 + dir) * 4) * 256 + c; const float cbv = F.in[16][(l * 2 + dir) * 256 + c];
        const float w0 = cw[0], w1 = cw[256], w2 = cw[512], w3 = cw[768];
        const LAS bf16* rx = (const LAS bf16*)rxs;
        const int base = dir == 0 ? 0 : 3;
        for (int t = 0; t < 32; ++t) {
            const float u = cbv + w0 * bf1(rx[(t + base + 0) * 256 + c]) + w1 * bf1(rx[(t + base + 1) * 256 + c]) + w2 * bf1(rx[(t + base + 2) * 256 + c]) + w3 * bf1(rx[(t + base + 3) * 256 + c]);
            ucs[(dir * 32 + t) * 256 + c] = u;
        }
    }
    __syncthreads();
    const int kb = c >> 6, ee = c & 63;
    float zx[32], za[32];
    {
        const float bxv = F.in[18][(l * 2 + dir) * 256 + c], bav = F.in[20][(l * 2 + dir) * 256 + c];
#pragma unroll
        for (int tt = 0; tt < 32; ++tt) { zx[tt] = bxv; za[tt] = bav; }
        const float* wx = F.in[17] + (((size_t)(l * 2 + dir) * 4 + kb) * 64) * 64 + ee; const float* wa = F.in[19] + (((size_t)(l * 2 + dir) * 4 + kb) * 64) * 64 + ee;
        const LAS float* ub = ucs + (dir * 32 + (dir == 0 ? 0 : 31)) * 256 + kb * 64;
        const int tstep = dir == 0 ? 256 : -256;
#pragma unroll 2
        for (int d = 0; d < 64; ++d) {
            const float wxv = wx[d * 64], wav = wa[d * 64];
#pragma unroll
            for (int tt = 0; tt < 32; ++tt) { const float u = ub[tt * tstep + d]; zx[tt] += u * wxv; za[tt] += u * wav; }
        }
    }
    const float nl = -F.in[21][(l * 2 + dir) * 256 + c];
    const float sp8 = -8.f * (fmaxf(nl, 0.f) + log1pf(__expf(-fabsf(nl))));
    float h = 0.f, P = 1.f;
    if (PASS == 1) h = WSP(const float, WS_CARRY)[((size_t)dir * 1152 + T) * 256 + c];
    {
        const LAS float* uo = ucs + (dir * 32 + (dir == 0 ? 0 : 31)) * 256 + c;
        LAS float* ho = hs + (dir == 0 ? 0 : 31) * 256 + c;
        const int tstep = dir == 0 ? 256 : -256;
#pragma unroll
        for (int tt = 0; tt < 32; ++tt) {
            const float gx = sigmoidf_(zx[tt]), ga = sigmoidf_(za[tt]);
            const float log_a = sp8 * ga;
            const float a = __expf(log_a);
            const float coef = sqrtf(-expm1f(2.f * log_a));
            h = a * h + coef * gx * uo[tt * tstep];
            if (PASS == 0) P *= a; else __hip_atomic_fetch_add(ho + tt * tstep, h, __ATOMIC_RELAXED, __HIP_MEMORY_SCOPE_WORKGROUP);
        }
    }
    if (PASS == 0) { WSP(f32x2, WS_TOT)[((size_t)dir * 1152 + T) * 256 + c] = (f32x2){P, h}; }
    else {
        __syncthreads();
        bf16* MIX = WSP(bf16, WS_MIX);
        for (int i = F.tid; i < 32 * 128; i += NWAVES * 64) { const int t = i >> 7, cp = i & 127; const size_t row = (size_t)row0 + t;
            const unsigned gw = *(const unsigned*)(PROJ + row * IND + 2304 + 2 * cp);
            *(unsigned*)(MIX + row * D + 768 + 2 * cp) = pk2(gelu_tanh(bflo(gw)) * hs[t * 256 + 2 * cp], gelu_tanh(bfhi(gw)) * hs[t * 256 + 2 * cp + 1]); }
    }
}
__device__ __forceinline__ void lru_carry(Frame& F) {
    const f32x2* TOT = WSP(const f32x2, WS_TOT); float* CARRY = WSP(float, WS_CARRY);
    for (int it = F.gw; it < NB * 2 * 4; it += F.NGW) {
        const int b = it >> 3, dir = (it >> 2) & 1, c = (it & 3) * 64 + F.lane;
        float h = 0.f;
        for (int g = 0; g < 9; ++g) {
            f32x2 ps[8]; int tl[8];
#pragma unroll
            for (int i = 0; i < 8; ++i) { const int s = g * 8 + i;
                int T; if (s < 8) T = 1024 + b * 8 + (dir == 0 ? s : 7 - s); else T = b * 64 + (dir == 0 ? s - 8 : 71 - s);
                tl[i] = T; ps[i] = TOT[((size_t)dir * 1152 + T) * 256 + c]; }
#pragma unroll
            for (int i = 0; i < 8; ++i) { CARRY[((size_t)dir * 1152 + tl[i]) * 256 + c] = h; h = ps[i][0] * h + ps[i][1]; }
        }
    }
}

__device__ __forceinline__ void final_rows(Frame& F) {
    const float* g = F.in[24];
    for (int row = F.gw; row < ML; row += F.NGW) {
        float* xr = F.out + (size_t)row * D;
        f32x4 v[4]; float ss = 0.f;
#pragma unroll
        for (int j = 0; j < 4; ++j) { v[j] = *(const f32x4*)(xr + 4 * F.lane + 256 * j); ss += (v[j][0] * v[j][0] + v[j][1] * v[j][1]) + (v[j][2] * v[j][2] + v[j][3] * v[j][3]); }
        const float rs = rsqrtf(wave_sum(ss) * (1.f / D) + EPS);
#pragma unroll
        for (int j = 0; j < 4; ++j) { const int k = 4 * F.lane + 256 * j; *(f32x4*)(xr + k) = v[j] * rs * *(const f32x4*)(g + k); }
    }
}

constexpr int N_PHASES = 2 + 7 * DEPTH + 1;
struct Args { const float* in[25]; float* out; unsigned char* ws; int ph_lo, ph_hi; };
static_assert(sizeof(Args) == 27 * 8 + 8, "Args has no padding");

__global__ void __launch_bounds__(NWAVES * 64, 2) mega_fwd(Args args) {
    extern __shared__ __attribute__((aligned(16))) unsigned char lds[];
    Frame F;
    F.lds = (LAS unsigned char*)lds;
    F.tid = threadIdx.x; F.lane = F.tid & 63; F.wave = __builtin_amdgcn_readfirstlane(F.tid >> 6);
    F.G = gridDim.x; { const int bx = blockIdx.x; F.vcu = (F.G % 8 == 0) ? (bx % 8) * (F.G / 8) + bx / 8 : bx; }
    F.gw = F.vcu * NWAVES + F.wave; F.NGW = F.G * NWAVES;
#pragma unroll
    for (int i = 0; i < 25; ++i) F.in[i] = args.in[i];
    F.out = args.out; F.ws = args.ws;
    volatile LAS unsigned* MISC = (volatile LAS unsigned*)(F.lds + MISC_OFF);
    for (int u = F.tid; u < (LDS_BYTES - LDSCTL_OFF) / 4; u += NWAVES * 64) ((LAS unsigned*)(F.lds + LDSCTL_OFF))[u] = 0u;
    __syncthreads();
    XcdBarrier bar = xcd_barrier_post((unsigned*)(F.ws + WS_CTL) + CW_BAR, MISC + 8);

    const int lo = args.ph_lo, hi = args.ph_hi;
    for (int ph = lo; ph < hi; ++ph) {
        { int t_ = threadIdx.x; asm volatile("" : "+v"(t_)); F.tid = t_; F.lane = t_ & 63; F.wave = __builtin_amdgcn_readfirstlane(t_ >> 6); F.gw = F.vcu * NWAVES + F.wave; }
        if (ph == 0) {
#ifndef NO_P0
            phase_p0a(F);
#endif
        } else if (ph == 1) {
#ifndef NO_P0
            phase_p0b(F);
#endif
        }
        else if (ph == N_PHASES - 1) final_rows(F);
        else {
            const int l = (ph - 2) / 7, k = (ph - 2) % 7; const bool last = (l == DEPTH - 1);
            const int Mx = last ? ML : MT;
            float* MOD = WSP(float, WS_MOD);
            if (k == 0) {
                pg8::Gemm g{WSP(const bf16, WS_XA), WSP(const bf16, WS_WIN) + (size_t)l * IND * D, MT, IND, D};
                pg8::Order S; if (last) S.init(ML, IND, (MC / 256) * 5, F.G, (int)blockIdx.x); else S.init(MT, IND, 0, F.G, (int)blockIdx.x);
                pg8::EpiScale<0, IND> E{WSP(bf16, WS_PROJ), WSP(const float, WS_SHW1) + (size_t)l * 17 * IND, WSP(const float, WS_RSSA)};

#ifndef NO_G0
                pg8::gemm_phase<pg8::EpiScale<0, IND>, pg8::Order, true, true>(F.lds + RING_OFF, g, S, E, F.tid);
#endif

            } else if (k == 1) {

#ifndef NO_LRU
                for (int T = F.vcu; T < 1152; T += F.G) lru_tile<0>(F, l, T);
#endif

                __syncthreads();
                const int nrows = last ? ML : MT;

#ifndef NO_CONV
                for (int row = F.gw; row < nrows; row += F.NGW) conv_row(F, l, row);
#endif

                const int nna = last ? 4096 : 4096 + 512;

#ifndef NO_NA
                for (int it = F.gw; it < nna; it += F.NGW) na_item(F, l, it);
#endif

            } else if (k == 2) {
                lru_carry(F);
            } else if (k == 3) {

#ifndef NO_LRU
                for (int T = F.vcu; T < (last ? 1024 : 1152); T += F.G) lru_tile<1>(F, l, T);
#endif

            } else if (k == 4) {
                pg8::Gemm g{WSP(const bf16, WS_MIX), WSP(const bf16, WS_WOUT) + (size_t)l * D * D, Mx, D, D};
                pg8::Order S; S.init(Mx, D, 0, F.G, (int)blockIdx.x);
                pg8::EpiRes E{l == 0 ? F.in[0] : F.out, l == 0 ? F.in[2] : WSP(const float, WS_CX), F.out, WSP(float, WS_CX),
                              MOD + (size_t)l * 17 * MODW + 2 * D, F.in[5] + l * D, MOD + (size_t)l * 17 * MODW + 4 * D, WSP(bf16, WS_XA), WSP(float, WS_RSSB)};

#ifndef NO_GR
                pg8::gemm_phase<pg8::EpiRes, pg8::Order, true, true>(F.lds + RING_OFF, g, S, E, F.tid);
#endif

            } else if (k == 5) {
                pg8::Gemm g{WSP(const bf16, WS_XA), WSP(const bf16, WS_W1) + (size_t)l * FF * D, Mx, FF, D};
                pg8::Order S; S.init(Mx, FF, 0, F.G, (int)blockIdx.x);
                pg8::EpiScale<1, FF> E{WSP(bf16, WS_HID), WSP(const float, WS_SHW2) + (size_t)l * 17 * FF, WSP(const float, WS_RSSB)};

#ifndef NO_G1
                pg8::gemm_phase<pg8::EpiScale<1, FF>, pg8::Order, true, true>(F.lds + RING_OFF, g, S, E, F.tid);
#endif

            } else {
                pg8::Gemm g{WSP(const bf16, WS_HID), WSP(const bf16, WS_W2) + (size_t)l * D * FF, Mx, D, FF};
                pg8::Order S; S.init(Mx, D, 0, F.G, (int)blockIdx.x);
                const int ln = last ? l : l + 1;
                pg8::EpiRes E{F.out, WSP(const float, WS_CX), F.out, WSP(float, WS_CX),
                              MOD + (size_t)l * 17 * MODW + 5 * D, F.in[4] + ln * D, MOD + (size_t)ln * 17 * MODW + D, last ? (bf16*)nullptr : WSP(bf16, WS_XA), WSP(float, WS_RSSA)};

#ifndef NO_GR
                pg8::gemm_phase<pg8::EpiRes, pg8::Order, true, true>(F.lds + RING_OFF, g, S, E, F.tid);
#endif

            }
        }
        if (ph + 1 < hi) xcd_barrier(bar);
    }
}

extern "C" void kernel_launch(void* const* d_in, const int* in_sizes, int n_in, void* d_out, int out_size, void* d_ws, size_t ws_size, hipStream_t stream) {
    static int grid = 0;
    if (grid == 0) {
        if (n_in != 25 || out_size != ML * D || ws_size < WS_END) { fprintf(stderr, "kernel_launch: unexpected shapes (n_in %d out %d ws %zu)\n", n_in, out_size, ws_size); grid = -1; return; }
        int dev = 0, cus = 0;
        if (hipGetDevice(&dev) != hipSuccess || hipDeviceGetAttribute(&cus, hipDeviceAttributeMultiprocessorCount, dev) != hipSuccess) { grid = -1; return; }
        if (hipFuncSetAttribute((const void*)mega_fwd, hipFuncAttributeMaxDynamicSharedMemorySize, LDS_BYTES) != hipSuccess) { fprintf(stderr, "kernel_launch: hipFuncSetAttribute failed\n"); grid = -1; return; }
        int per_cu = 0;
        if (hipOccupancyMaxActiveBlocksPerMultiprocessor(&per_cu, (const void*)mega_fwd, NWAVES * 64, LDS_BYTES) != hipSuccess || per_cu < 1) fprintf(stderr, "kernel_launch: occupancy query reports %d\n", per_cu);
        (void)hipGetLastError();
        grid = cus;
    }
    if (grid < 0) return;
    if (hipMemsetAsync((char*)d_ws + WS_CTL, 0, CTL_ZERO_BYTES, stream) != hipSuccess) return;
    Args a{};
    for (int i = 0; i < 25; ++i) a.in[i] = (const float*)d_in[i];
    a.out = (float*)d_out; a.ws = (unsigned char*)d_ws;
#if MK_N_LAUNCHES == 1
    a.ph_lo = 0; a.ph_hi = N_PHASES;
    hipLaunchKernelGGL(mega_fwd, dim3(grid), dim3(NWAVES * 64), LDS_BYTES, stream, a);
#else
    for (int ph = 0; ph < N_PHASES; ++ph) { a.ph_lo = ph; a.ph_hi = ph + 1; hipLaunchKernelGGL(mega_fwd, dim3(grid), dim3(NWAVES * 64), LDS_BYTES, stream, a); }
#endif
}
```

```cpp
#include <hip/hip_runtime.h>
#include <cstdio>
#include <cstdint>

constexpr int D = 1024, NB = 16, SEQ = 2048, CTXL = 256, DEPTH = 2;
constexpr int ML = NB * SEQ, MC = NB * CTXL, MT = ML + MC;
constexpr int IND = 2560, FF = 4096, NH = 8, HD = 64;
constexpr int MODW = 6 * D;
constexpr float EPS = 1e-6f;
#ifndef MK_N_LAUNCHES
#define MK_N_LAUNCHES 1
#endif

namespace pg8 {
#define PG8_LAS __attribute__((address_space(3)))
typedef unsigned short bf16_t;
typedef short bf16x8 __attribute__((ext_vector_type(8)));
typedef float f32x4 __attribute__((ext_vector_type(4)));
typedef unsigned u32x4 __attribute__((ext_vector_type(4)));
constexpr int BM = 256, BK = 64, HALF = 128, HTB = HALF * BK * 2, STAGE_BYTES = 8 * HTB, NXCD = 8, WGM = 8;

__host__ __device__ __forceinline__ int lds_byte(int r, int c) { const int st = (r >> 4) * 2 + (c >> 5), rr = r & 15, cc = c & 31, ob = rr * 64 + cc * 2; return st * 1024 + (ob ^ (((ob >> 9) & 1) << 5)); }
__host__ __device__ __forceinline__ void stage_rc(int b, int& R, int& C) { const int st = b / 1024, sb = b % 1024, swz = sb ^ (((sb >> 9) & 1) << 5); R = (st >> 1) * 16 + swz / 64; C = (st & 1) * 32 + (swz % 64) / 2; }
__host__ __device__ __forceinline__ int perm32(int rho) { const int n = rho >> 4, i = rho & 15; return 8 * (i >> 2) + 4 * n + (i & 3); }

struct Unit { int pm, pn; };
struct Gemm { const bf16_t* A; const bf16_t* Bt; int M, N, K; };

__host__ __device__ __forceinline__ void map_tile(int wgid, int nM, int nN, Unit& u) {
    const int nwg = nM * nN;
    { const int q = nwg / NXCD, r = nwg % NXCD, xcd = wgid % NXCD, off = wgid / NXCD; wgid = (xcd < r ? xcd * (q + 1) : r * (q + 1) + (xcd - r) * q) + off; }
    const int nig = WGM * nN, gid = wgid / nig, fm = gid * WGM, gsz = (nM - fm) < WGM ? (nM - fm) : WGM;
    u.pm = fm + ((wgid % nig) % gsz); u.pn = (wgid % nig) / gsz;
}
struct Order {
    int nM, nN, nwg, extra, G, c;
    __host__ __device__ void init(int M, int N, int extra_, int G_, int c_) { nM = M / BM; nN = N / BM; nwg = nM * nN; extra = extra_; G = G_; c = c_; }
    __host__ __device__ bool next(int i, Unit& u) const {
        const long L = (long)i * G + c;
        if (L < nwg) { map_tile((int)L, nM, nN, u); return true; }
        if (L < nwg + extra) { const int q = (int)L - nwg; u.pm = nM + q / 5; u.pn = 4 + q % 5; return true; }
        return false;
    }
    __device__ __forceinline__ void a_ready(const Unit&) const {}
    __device__ __forceinline__ void done(const Unit&) const {}
};

__device__ __forceinline__ unsigned cvt_pk_bf16(float lo, float hi) { unsigned r; asm volatile("v_cvt_pk_bf16_f32 %0, %1, %2" : "=v"(r) : "v"(lo), "v"(hi)); return r; }

__device__ __forceinline__ float row_rs(const float* RSSt, unsigned roff, int fq) {
    const f32x4 p0 = *(const f32x4*)(RSSt + (roff + 8u * (unsigned)fq)), p1 = *(const f32x4*)(RSSt + (roff + 8u * (unsigned)fq + 4u));
    float s = ((p0[0] + p0[1]) + (p0[2] + p0[3])) + ((p1[0] + p1[1]) + (p1[2] + p1[3]));
    s += __shfl_xor(s, 16); s += __shfl_xor(s, 32);
    return rsqrtf(s * (1.0f / D) + EPS);
}
template <int ACT, int LDC> struct EpiScale {
    static constexpr bool PERM = true, AFTER_DRAIN = false;
    bf16_t* O; const float* shw; const float* RSS;
    __device__ __forceinline__ void operator()(const f32x4 (&acc)[2][2][4][2], const Unit& u, int wr, int wc, int fr, int fq) const {
        const int brow = u.pm < ML / BM ? (u.pm >> 3) : NB;
        const float* sp = shw + (size_t)brow * LDC + u.pn * BM;
        bf16_t* Ot = O + (size_t)u.pm * BM * LDC + u.pn * BM;
        const float* RSSt = RSS + (size_t)u.pm * BM * 32;
        unsigned cl = (unsigned)(wc * 32 + 8 * fq);
        unsigned rl0 = (unsigned)(wr * 64 + fr);
        asm volatile("" : "+v"(cl), "+v"(rl0));
#pragma unroll
        for (int bj = 0; bj < 2; ++bj) {
            const f32x4 s0 = *(const f32x4*)(sp + (cl + (unsigned)(bj * HALF))), s1 = *(const f32x4*)(sp + (cl + (unsigned)(bj * HALF + 4)));
#pragma unroll
            for (int ai = 0; ai < 2; ++ai)
#pragma unroll
                for (int m = 0; m < 4; ++m) {
                    const float rs = row_rs(RSSt, (rl0 + (unsigned)(ai * HALF + m * 16)) * 32u, fq);
                    f32x4 v0 = acc[ai][bj][m][0] * rs + s0, v1 = acc[ai][bj][m][1] * rs + s1;
                    if (ACT == 1) {
#pragma unroll
                        for (int e = 0; e < 4; ++e) { const float a = fmaxf(v0[e], 0.f), b = fmaxf(v1[e], 0.f); v0[e] = a * a; v1[e] = b * b; }
                    }
                    u32x4 w; w.x = cvt_pk_bf16(v0[0], v0[1]); w.y = cvt_pk_bf16(v0[2], v0[3]); w.z = cvt_pk_bf16(v1[0], v1[1]); w.w = cvt_pk_bf16(v1[2], v1[3]);
                    *(u32x4*)(Ot + ((rl0 + (unsigned)(ai * HALF + m * 16)) * (unsigned)LDC + cl + (unsigned)(bj * HALF))) = w;
                }
        }
    }
};
struct EpiRes {
    static constexpr bool PERM = true, AFTER_DRAIN = false;
    const float* src_lat; const float* src_ctx; float* dst_lat; float* dst_ctx;
    const float* gate;
    const float* gmg; const float* gmsc;
    bf16_t* XA; float* RSS;
    __device__ __forceinline__ void operator()(const f32x4 (&acc)[2][2][4][2], const Unit& u, int wr, int wc, int fr, int fq) const {
        const bool lat = u.pm < ML / BM;
        const int brow = lat ? (u.pm >> 3) : NB;
        const float* src = (lat ? src_lat + (size_t)u.pm * BM * D : src_ctx + (size_t)(u.pm - ML / BM) * BM * D) + u.pn * BM;
        float* dst = (lat ? dst_lat + (size_t)u.pm * BM * D : dst_ctx + (size_t)(u.pm - ML / BM) * BM * D) + u.pn * BM;
        const float* gt = gate + (size_t)brow * MODW + u.pn * BM;
        const float* gg = gmg + u.pn * BM;
        const float* gs = gmsc + (size_t)brow * MODW + u.pn * BM;
        bf16_t* XAt = XA + (size_t)u.pm * BM * D + u.pn * BM;
        float* RSSt = RSS + (size_t)u.pm * BM * 32 + u.pn * 8 + wc;
        unsigned cl = (unsigned)(wc * 32 + 8 * fq);
        unsigned rl0 = (unsigned)(wr * 64 + fr);
        asm volatile("" : "+v"(cl), "+v"(rl0));
        const bool hasxa = XA != nullptr;
#pragma unroll
        for (int bj = 0; bj < 2; ++bj) {
            const unsigned c = cl + (unsigned)(bj * HALF);
            const f32x4 g0 = *(const f32x4*)(gt + c), g1 = *(const f32x4*)(gt + (c + 4u));
            f32x4 m0 = {0.f, 0.f, 0.f, 0.f}, m1 = {0.f, 0.f, 0.f, 0.f};
            if (hasxa) { m0 = *(const f32x4*)(gg + c) * (*(const f32x4*)(gs + c) + 1.0f); m1 = *(const f32x4*)(gg + (c + 4u)) * (*(const f32x4*)(gs + (c + 4u)) + 1.0f); }
#pragma unroll
            for (int ai = 0; ai < 2; ++ai)
#pragma unroll
                for (int m = 0; m < 4; ++m) {
                    const unsigned rl = rl0 + (unsigned)(ai * HALF + m * 16);
                    const unsigned off = rl * (unsigned)D + c;
                    const f32x4 x0 = *(const f32x4*)(src + off), x1 = *(const f32x4*)(src + (off + 4u));
                    const f32x4 y0 = x0 + g0 * acc[ai][bj][m][0], y1 = x1 + g1 * acc[ai][bj][m][1];
                    *(f32x4*)(dst + off) = y0; *(f32x4*)(dst + (off + 4u)) = y1;
                    float ss = ((y0[0] * y0[0] + y0[1] * y0[1]) + (y0[2] * y0[2] + y0[3] * y0[3])) + ((y1[0] * y1[0] + y1[1] * y1[1]) + (y1[2] * y1[2] + y1[3] * y1[3]));
                    ss += __shfl_xor(ss, 16); ss += __shfl_xor(ss, 32);
                    if (fq == 0) RSSt[rl * 32u + (unsigned)(bj * 4)] = ss;
                    if (hasxa) { const f32x4 a0 = y0 * m0, a1 = y1 * m1;
                        u32x4 w; w.x = cvt_pk_bf16(a0[0], a0[1]); w.y = cvt_pk_bf16(a0[2], a0[3]); w.z = cvt_pk_bf16(a1[0], a1[1]); w.w = cvt_pk_bf16(a1[2], a1[3]);
                        *(u32x4*)(XAt + off) = w; }
                    asm volatile("" ::: "memory");
                }
        }
    }
};

template <class Epi, class Sched, bool ALIGN_EPI = false, bool SP2 = false>
__device__ __forceinline__ void gemm_phase(PG8_LAS unsigned char* lds, const Gemm g, const Sched& S, const Epi& E, const int tid) {
    const int wid = __builtin_amdgcn_readfirstlane(tid >> 6), lane = tid & 63, wr = wid >> 2, wc = wid & 3, fr = lane & 15, fq = lane >> 4;
    const int K = g.K, nt = K / BK;
    unsigned voffA[2], voffB[2];
#pragma unroll
    for (int i = 0; i < 2; ++i) { int R, C; stage_rc(tid * 16 + i * 8192, R, C); const int Rb = Epi::PERM ? ((R & ~31) + perm32(R & 31)) : R;
        voffA[i] = (unsigned)(R * K + C) * 2u; voffB[i] = (unsigned)(Rb * K + C) * 2u; }
    const size_t kstep = (size_t)(BK * 2);
    const size_t hstep = (size_t)HALF * K * 2;
    const size_t tstep = 2 * hstep;
    const unsigned ldsw = (unsigned)wid * 1024u;
    const int aoff = lds_byte(wr * 64 + fr, fq * 8), boff = lds_byte(wc * 32 + fr, fq * 8);
#define PG8_SA(b, h) (((b) * 2 + (h)) * HTB)
#define PG8_SB(b, h) ((4 + (b) * 2 + (h)) * HTB)
#define PG8_STAGE(bufoff, gbase, voff) do { _Pragma("unroll") for (int _i = 0; _i < 2; ++_i) \
        __builtin_amdgcn_global_load_lds((const unsigned*)((const char*)(gbase) + (voff)[_i]), (PG8_LAS unsigned*)(lds + (bufoff) + ldsw + _i * 8192), 16, 0, 0); } while (0)
#define PG8_LDA(dst, b, h) do { _Pragma("unroll") for (int m = 0; m < 4; ++m) _Pragma("unroll") for (int k = 0; k < 2; ++k) dst[m][k] = *(const PG8_LAS bf16x8*)(lds + PG8_SA(b, h) + aoff + m * 2048 + k * 1024); } while (0)
#define PG8_LDB(dst, b, h) do { _Pragma("unroll") for (int n = 0; n < 2; ++n) _Pragma("unroll") for (int k = 0; k < 2; ++k) dst[n][k] = *(const PG8_LAS bf16x8*)(lds + PG8_SB(b, h) + boff + n * 2048 + k * 1024); } while (0)
#define PG8_MMA(ai, bj, At, Bt) do { __builtin_amdgcn_s_setprio(1); _Pragma("unroll") for (int m = 0; m < 4; ++m) _Pragma("unroll") for (int n = 0; n < 2; ++n) _Pragma("unroll") for (int k = 0; k < 2; ++k) \
        acc[ai][bj][m][n] = __builtin_amdgcn_mfma_f32_16x16x32_bf16(Bt[n][k], At[m][k], acc[ai][bj][m][n], 0, 0, 0); __builtin_amdgcn_s_setprio(0); } while (0)
#define PG8_WAIT_V(n) asm volatile("s_waitcnt vmcnt(" #n ")" ::: "memory")
#define PG8_WAIT_L(n) asm volatile("s_waitcnt lgkmcnt(" #n ")" ::: "memory")
#define PG8_BAR __builtin_amdgcn_s_barrier()
#define PG8_SCHED __builtin_amdgcn_sched_barrier(0)
    Unit cur, nxt; int ui = 0;
    if (!S.next(0, cur)) return;
    f32x4 acc[2][2][4][2];
#pragma unroll
    for (int a = 0; a < 2; ++a)
#pragma unroll
        for (int b = 0; b < 2; ++b)
#pragma unroll
            for (int m = 0; m < 4; ++m)
#pragma unroll
                for (int n = 0; n < 2; ++n) acc[a][b][m][n] = (f32x4){0.f, 0.f, 0.f, 0.f};
    bf16x8 At[4][2], B0[2][2], B1[2][2];
    const char* cA = (const char*)g.A + (size_t)cur.pm * tstep; const char* cB = (const char*)g.Bt + (size_t)cur.pn * tstep;
    S.a_ready(cur);
    if constexpr (SP2) {
        PG8_STAGE(PG8_SB(0, 0), cB, voffB); PG8_STAGE(PG8_SB(0, 1), cB + hstep, voffB); PG8_STAGE(PG8_SA(0, 0), cA, voffA); PG8_STAGE(PG8_SA(0, 1), cA + hstep, voffA);
        if (wr == 1) PG8_BAR;
        PG8_WAIT_V(2); PG8_BAR;
        PG8_STAGE(PG8_SB(1, 0), cB + kstep, voffB); PG8_STAGE(PG8_SA(1, 0), cA + kstep, voffA); PG8_STAGE(PG8_SB(1, 1), cB + hstep + kstep, voffB);
        PG8_WAIT_V(6); PG8_BAR;
    } else {
        PG8_STAGE(PG8_SB(0, 0), cB, voffB); PG8_STAGE(PG8_SA(0, 0), cA, voffA); PG8_STAGE(PG8_SB(0, 1), cB + hstep, voffB); PG8_STAGE(PG8_SA(0, 1), cA + hstep, voffA);
        if (wr == 1) PG8_BAR;
        PG8_WAIT_V(4); PG8_BAR;
        PG8_STAGE(PG8_SB(1, 0), cB + kstep, voffB); PG8_STAGE(PG8_SA(1, 0), cA + kstep, voffA); PG8_STAGE(PG8_SB(1, 1), cB + hstep + kstep, voffB);
        PG8_WAIT_V(6); PG8_BAR;
    }
    for (;;) {
        const bool has_next = S.next(ui + 1, nxt);
        const char* nA = has_next ? (const char*)g.A + (size_t)nxt.pm * tstep : cA; const char* nB = has_next ? (const char*)g.Bt + (size_t)nxt.pn * tstep : cB;
        for (int t = 0; t < nt; t += 2) {
            const bool last = (t == nt - 2);
            const char* a1 = cA + (size_t)(t + 1) * kstep;
            const char* a2 = last ? nA : cA + (size_t)(t + 2) * kstep; const char* b2 = last ? nB : cB + (size_t)(t + 2) * kstep;
            const char* a3 = a2 + kstep; const char* b3 = b2 + kstep;
            if (last && has_next) S.a_ready(nxt);
            if constexpr (SP2) {
            PG8_LDB(B0, 0, 0); PG8_LDB(B1, 0, 1); PG8_SCHED; PG8_LDA(At, 0, 0); PG8_STAGE(PG8_SA(1, 1), a1 + hstep, voffA);
            PG8_WAIT_V(8); PG8_WAIT_L(0); PG8_BAR; PG8_MMA(0, 0, At, B0); PG8_MMA(0, 1, At, B1); PG8_BAR; PG8_SCHED;
            PG8_LDA(At, 0, 1); PG8_STAGE(PG8_SB(0, 0), b2, voffB); PG8_STAGE(PG8_SB(0, 1), b2 + hstep, voffB); PG8_STAGE(PG8_SA(0, 0), a2, voffA);
            PG8_WAIT_V(8); PG8_WAIT_L(0); PG8_BAR; PG8_MMA(1, 0, At, B0); PG8_MMA(1, 1, At, B1); PG8_BAR; PG8_SCHED;
            PG8_LDB(B0, 1, 0); PG8_LDB(B1, 1, 1); PG8_SCHED; PG8_LDA(At, 1, 0); PG8_STAGE(PG8_SA(0, 1), a2 + hstep, voffA);
            PG8_WAIT_V(8); PG8_WAIT_L(0); PG8_BAR; PG8_MMA(0, 0, At, B0); PG8_MMA(0, 1, At, B1); PG8_BAR; PG8_SCHED;
            PG8_LDA(At, 1, 1); PG8_STAGE(PG8_SB(1, 0), b3, voffB); PG8_STAGE(PG8_SB(1, 1), b3 + hstep, voffB); PG8_STAGE(PG8_SA(1, 0), a3, voffA);
            PG8_WAIT_V(8); PG8_WAIT_L(0); PG8_BAR; PG8_MMA(1, 0, At, B0); PG8_MMA(1, 1, At, B1); PG8_BAR; PG8_SCHED;
            } else {
            PG8_LDB(B0, 0, 0); PG8_SCHED; PG8_LDA(At, 0, 0); PG8_STAGE(PG8_SA(1, 1), a1 + hstep, voffA);
            PG8_WAIT_L(8); PG8_BAR; PG8_WAIT_L(0); PG8_MMA(0, 0, At, B0); PG8_BAR; PG8_SCHED;
            PG8_LDB(B1, 0, 1); PG8_STAGE(PG8_SB(0, 0), b2, voffB);
            PG8_BAR; PG8_WAIT_L(0); PG8_MMA(0, 1, At, B1); PG8_BAR;
            PG8_LDA(At, 0, 1); PG8_STAGE(PG8_SA(0, 0), a2, voffA);
            PG8_BAR; PG8_WAIT_L(0); PG8_MMA(1, 0, At, B0); PG8_BAR; PG8_SCHED;
            PG8_STAGE(PG8_SB(0, 1), b2 + hstep, voffB);
            PG8_WAIT_V(6); PG8_BAR; PG8_MMA(1, 1, At, B1); PG8_BAR;
            PG8_LDB(B0, 1, 0); PG8_SCHED; PG8_LDA(At, 1, 0); PG8_STAGE(PG8_SA(0, 1), a2 + hstep, voffA);
            PG8_WAIT_L(8); PG8_BAR; PG8_WAIT_L(0); PG8_MMA(0, 0, At, B0); PG8_BAR; PG8_SCHED;
            PG8_LDB(B1, 1, 1); PG8_STAGE(PG8_SB(1, 0), b3, voffB);
            PG8_BAR; PG8_WAIT_L(0); PG8_MMA(0, 1, At, B1); PG8_BAR;
            PG8_LDA(At, 1, 1); PG8_STAGE(PG8_SA(1, 0), a3, voffA);
            PG8_BAR; PG8_WAIT_L(0); PG8_MMA(1, 0, At, B0); PG8_BAR; PG8_SCHED;
            PG8_STAGE(PG8_SB(1, 1), b3 + hstep, voffB);
            PG8_WAIT_V(6); PG8_BAR; PG8_MMA(1, 1, At, B1); PG8_BAR;
            }
        }
        if constexpr (ALIGN_EPI) { if (wr == 0) PG8_BAR; }
        if constexpr (!Epi::AFTER_DRAIN) { E(acc, cur, wr, wc, fr, fq); S.done(cur); }
        if (!has_next) break;
#pragma unroll
        for (int a = 0; a < 2; ++a)
#pragma unroll
            for (int b = 0; b < 2; ++b)
#pragma unroll
                for (int m = 0; m < 4; ++m)
#pragma unroll
                    for (int n = 0; n < 2; ++n) acc[a][b][m][n] = (f32x4){0.f, 0.f, 0.f, 0.f};
        cur = nxt; cA = nA; cB = nB; ++ui;
        if constexpr (ALIGN_EPI) { if (wr == 1) PG8_BAR; }
    }
    PG8_WAIT_V(0);
    if constexpr (!ALIGN_EPI) { if (wr == 0) PG8_BAR; }
    PG8_BAR;
    if constexpr (Epi::AFTER_DRAIN) { E.fused(acc, cur, wr, wc, fr, fq, lds, wid, lane); S.done(cur); }
#undef PG8_SA
#undef PG8_SB
#undef PG8_STAGE
#undef PG8_LDA
#undef PG8_LDB
#undef PG8_MMA
#undef PG8_WAIT_V
#undef PG8_WAIT_L
#undef PG8_BAR
#undef PG8_SCHED
}
}

constexpr size_t MiB = 1u << 20;
constexpr size_t WS_CTL = 0, CTL_ZERO_BYTES = 1 * MiB;
constexpr size_t WS_MOD = 1 * MiB;
constexpr size_t WS_SHW1 = 2 * MiB;
constexpr size_t WS_SHW2 = 3 * MiB;
constexpr size_t WS_RSSA = 4 * MiB;
constexpr size_t WS_RSSB = 9 * MiB;
constexpr size_t WS_TOT = 14 * MiB;
constexpr size_t WS_CARRY = 19 * MiB;
constexpr size_t WS_WIN = 22 * MiB;
constexpr size_t WS_WOUT = 32 * MiB;
constexpr size_t WS_W1 = 36 * MiB;
constexpr size_t WS_W2 = 52 * MiB;
constexpr size_t WS_CX = 68 * MiB;
constexpr size_t WS_XA = 84 * MiB;
constexpr size_t WS_HID = 156 * MiB;
constexpr size_t WS_PROJ = WS_HID;
constexpr size_t WS_MIX = WS_HID + 180 * MiB;
constexpr size_t WS_END = 444 * MiB;
static_assert(WS_MIX + (size_t)MT * D * 2 <= WS_END && WS_HID + (size_t)MT * FF * 2 == WS_END, "ws map");
constexpr int CW_BAR = 4096;

constexpr int NWAVES = 8;
constexpr int RING_OFF = 0, RING_BYTES = 131072;
constexpr int LDSCTL_OFF = RING_BYTES, MISC_OFF = LDSCTL_OFF + 320;
constexpr int LDS_BYTES = 147456;

#define GAS __attribute__((address_space(1)))
#define LAS __attribute__((address_space(3)))
typedef unsigned short bf16;
typedef unsigned v4u __attribute__((ext_vector_type(4)));
typedef unsigned v2u __attribute__((ext_vector_type(2)));
typedef float f32x4 __attribute__((ext_vector_type(4)));
typedef float f32x2 __attribute__((ext_vector_type(2)));
typedef GAS unsigned gu32;
#define LDS_WAIT() asm volatile("s_waitcnt lgkmcnt(0)" ::: "memory")
#define VM_WAIT() asm volatile("s_waitcnt vmcnt(0)" ::: "memory")
__device__ __forceinline__ unsigned f2bf(float f) { unsigned u = __builtin_bit_cast(unsigned, f); return (u + 0x7fffu + ((u >> 16) & 1u)) >> 16; }
__device__ __forceinline__ unsigned pk2(float lo, float hi) { return f2bf(lo) | (f2bf(hi) << 16); }
__device__ __forceinline__ float bflo(unsigned w) { return __uint_as_float(w << 16); }
__device__ __forceinline__ float bfhi(unsigned w) { return __uint_as_float(w & 0xffff0000u); }
__device__ __forceinline__ float bf1(bf16 v) { return __uint_as_float((unsigned)v << 16); }
__device__ __forceinline__ float sigmoidf_(float x) { return 1.f / (1.f + __expf(-x)); }
__device__ __forceinline__ float siluf_(float x) { return x * sigmoidf_(x); }
__device__ __forceinline__ float gelu_tanh(float x) { const float u = 0.7978845608028654f * (x + 0.044715f * x * x * x); return x * sigmoidf_(2.f * u); }
__device__ __forceinline__ float wave_sum(float v) {
#pragma unroll
    for (int o = 1; o < 64; o <<= 1) v += __shfl_xor(v, o);
    return v;
}

#define XB_TMO      128
#define XB_XCNT(j)  (256  + 64 * (j))
#define XB_XSUB(j)  (1280 + 64 * (j))
#define XB_XGEN(j)  (2304 + 64 * (j))
#define XB_TOP      3328
#define XB_TOPGEN   3392
#define XCD_BAR_WORDS 3456
#define XB_SPIN_CAP (1u << 18)

__device__ __forceinline__ unsigned xb_ld(unsigned* p)              { return __hip_atomic_load(p, __ATOMIC_RELAXED, __HIP_MEMORY_SCOPE_AGENT); }
__device__ __forceinline__ unsigned xb_add(unsigned* p, unsigned v) { return __hip_atomic_fetch_add(p, v, __ATOMIC_RELAXED, __HIP_MEMORY_SCOPE_AGENT); }
__device__ __forceinline__ unsigned xb_xcc_id() { return (unsigned)__builtin_amdgcn_s_getreg((3 << 11) | 20) & 0xFu; }
#define XB_SPIN(cond, bar) do { unsigned _sp = 0; while (cond) { __builtin_amdgcn_s_sleep(1); \
    if ((++_sp & 255u) == 0u) { if (xb_ld(&(bar)[XB_TMO])) break; if (_sp > XB_SPIN_CAP) { atomicAdd(&(bar)[XB_TMO], 1u); break; } } } } while (0)

struct XcdBarrier {
    unsigned* bar; unsigned x;
    volatile LAS unsigned* st;
};

__device__ __forceinline__ XcdBarrier xcd_barrier_post(unsigned* bar, volatile LAS unsigned* st) {
    XcdBarrier b; b.bar = bar; b.x = xb_xcc_id(); b.st = st;
    if (threadIdx.x == 0) (void)xb_add(&bar[XB_XCNT(b.x)], 1u);
    return b;
}
__device__ __forceinline__ void xcd_barrier_complete(unsigned* bar, unsigned x, unsigned& nloc, unsigned& nx) {
    const unsigned G = gridDim.x * gridDim.y * gridDim.z;
    unsigned sum, cnt, mine, sp = 0u;
    for (;;) {
        sum = 0u; cnt = 0u; mine = 0u;
#pragma unroll
        for (unsigned j = 0; j < 16; ++j) { const unsigned c = xb_ld(&bar[XB_XCNT(j)]); sum += c; cnt += (c > 0u) ? 1u : 0u; mine = (j == x) ? c : mine; }
        if (sum == G) break;
        __builtin_amdgcn_s_sleep(1);
        if ((++sp & 255u) == 0u) { if (xb_ld(&bar[XB_TMO])) break; if (sp > XB_SPIN_CAP) { atomicAdd(&bar[XB_TMO], 1u); break; } }
    }
    nloc = mine > 0u ? mine : 1u; nx = cnt > 0u ? cnt : 1u;
}

__device__ __forceinline__ void xcd_barrier(const XcdBarrier& b) {
    asm volatile("s_waitcnt vmcnt(0)" ::: "memory");
    __syncthreads();
    if (threadIdx.x == 0) {
        unsigned* bar = b.bar;
        __builtin_amdgcn_s_waitcnt(0);
        unsigned nloc = b.st[0], nx = b.st[1];
        if (nloc == 0u) { xcd_barrier_complete(bar, b.x, nloc, nx); b.st[0] = nloc; b.st[1] = nx; }
        const unsigned old = xb_add(&bar[XB_XSUB(b.x)], 1u);
        const unsigned gen = old / nloc;
        if (old + 1u == (gen + 1u) * nloc) {
            __builtin_amdgcn_fence(__ATOMIC_RELEASE, "agent");
            asm volatile("s_waitcnt vmcnt(0)" ::: "memory");
            const unsigned og = xb_add(&bar[XB_TOP], 1u);
            const unsigned tg = og / nx;
            if (og + 1u == (tg + 1u) * nx) xb_add(&bar[XB_TOPGEN], 1u);
            else XB_SPIN(xb_ld(&bar[XB_TOPGEN]) == tg, bar);
            __builtin_amdgcn_fence(__ATOMIC_ACQUIRE, "agent");
            xb_add(&bar[XB_XGEN(b.x)], 1u);
            asm volatile("s_waitcnt vmcnt(0)" ::: "memory");
        } else {
            XB_SPIN(xb_ld(&bar[XB_XGEN(b.x)]) == gen, bar);
            __builtin_amdgcn_fence(__ATOMIC_ACQUIRE, "agent");
            asm volatile("s_waitcnt vmcnt(0)" ::: "memory");
        }
    }
    __syncthreads();
}

struct Frame {
    LAS unsigned char* lds;
    int tid, lane, wave;
    int vcu, G;
    int gw, NGW;
    const float* in[25]; float* out; unsigned char* ws;
};
#define WSP(T, off) ((T*)(F.ws + (off)))

__device__ __forceinline__ void gemv17_item(Frame& F, const LAS float* tab, LAS float* red, const float* W, int ldw, int n0, const float* bias, float* outp, int ldo) {
    float acc[17];
#pragma unroll
    for (int r = 0; r < 17; ++r) acc[r] = 0.f;
    const int k0 = F.wave * 128;
    const float* wp = W + (size_t)k0 * ldw + n0 + F.lane;
#pragma unroll 4
    for (int k = 0; k < 128; ++k) {
        const float wv = wp[(size_t)k * ldw];
#pragma unroll
        for (int r = 0; r < 17; ++r) acc[r] += tab[r * 1024 + k0 + k] * wv;
    }
#pragma unroll
    for (int r = 0; r < 17; ++r) red[(F.wave * 17 + r) * 64 + F.lane] = acc[r];
    __syncthreads();
    for (int i = F.tid; i < 17 * 64; i += NWAVES * 64) {
        const int r = i >> 6, n = i & 63; float s = bias ? bias[n0 + n] : 0.f;
#pragma unroll
        for (int w = 0; w < 8; ++w) s += red[(w * 17 + r) * 64 + n];
        outp[(size_t)r * ldo + n0 + n] = s;
    }
    __syncthreads();
}

__device__ __forceinline__ void p0_transpose_item(const float* W, int K, int N, bf16* WT, LAS float* scr, int item, int lane) {
    const int nblk = N / 32, kb = item / nblk, nb = item % nblk, k0 = 64 * kb, n0 = 32 * nb;
#pragma unroll 8
    for (int i = 0; i < 32; ++i) { const int kk = 2 * i + (lane >> 5); scr[kk * 33 + (lane & 31)] = W[(size_t)(k0 + kk) * N + n0 + (lane & 31)]; }
    LDS_WAIT(); asm volatile("" ::: "memory");
    const int c = lane & 7;
#pragma unroll
    for (int j = 0; j < 4; ++j) { const int n = (lane >> 3) + 8 * j; const LAS float* s = scr + (8 * c) * 33 + n;
        v4u o; o.x = pk2(s[0 * 33], s[1 * 33]); o.y = pk2(s[2 * 33], s[3 * 33]); o.z = pk2(s[4 * 33], s[5 * 33]); o.w = pk2(s[6 * 33], s[7 * 33]);
        *(GAS v4u*)(WT + (size_t)(n0 + n) * K + k0 + 8 * c) = o; }
    LDS_WAIT(); asm volatile("" ::: "memory");
}

__device__ __forceinline__ void phase_p0a(Frame& F) {
    LAS float* tab = (LAS float*)(F.lds);
    LAS float* red = (LAS float*)(F.lds + 17 * 1024 * 4);
    float* MOD = WSP(float, WS_MOD);
    bool filled = false;
    for (int it = F.vcu; it < 2 * 96; it += F.G) {
        if (!filled) {
            for (int i = F.tid; i < 17 * 1024; i += NWAVES * 64) { const int r = i >> 10, k = i & 1023; const float v = (r < 16) ? F.in[1][r * D + k] : F.in[3][k]; tab[i] = siluf_(v); }
            __syncthreads(); filled = true;
        }
        const int l = it / 96, n0 = (it % 96) * 64;
        gemv17_item(F, tab, red, F.in[6] + (size_t)l * D * MODW, MODW, n0, F.in[7] + (size_t)l * MODW, MOD + (size_t)l * 17 * MODW, MODW);
    }
    __syncthreads();
    LAS float* scr = (LAS float*)(F.lds + F.wave * 16384);
    constexpr int I_IN = (D / 64) * (IND / 32), I_OUT = (D / 64) * (D / 32), I_1 = (D / 64) * (FF / 32), I_2 = (FF / 64) * (D / 32), I_L = I_IN + I_OUT + I_1 + I_2;
    for (int it = F.gw; it < 2 * I_L; it += F.NGW) {
        const int l = it / I_L; int r = it % I_L;
        if (r < I_IN) { p0_transpose_item(F.in[8] + (size_t)l * D * IND, D, IND, WSP(bf16, WS_WIN) + (size_t)l * IND * D, scr, r, F.lane); continue; } r -= I_IN;
        if (r < I_OUT) { p0_transpose_item(F.in[9] + (size_t)l * D * D, D, D, WSP(bf16, WS_WOUT) + (size_t)l * D * D, scr, r, F.lane); continue; } r -= I_OUT;
        if (r < I_1) { p0_transpose_item(F.in[22] + (size_t)l * D * FF, D, FF, WSP(bf16, WS_W1) + (size_t)l * FF * D, scr, r, F.lane); continue; } r -= I_1;
        p0_transpose_item(F.in[23] + (size_t)l * FF * D, FF, D, WSP(bf16, WS_W2) + (size_t)l * D * FF, scr, r, F.lane);
    }
}

__device__ __forceinline__ void phase_p0b(Frame& F) {
    LAS float* tab = (LAS float*)(F.lds);
    LAS float* red = (LAS float*)(F.lds + 17 * 1024 * 4);
    const float* MOD = WSP(const float, WS_MOD);
    for (int it = F.vcu; it < 2 * 104; it += F.G) {
        const int l = it / 104, j = it % 104; const bool first = j < 40;
        const int shoff = first ? 0 : 3 * D;
        __syncthreads();
        for (int i = F.tid; i < 17 * 1024; i += NWAVES * 64) { const int r = i >> 10, k = i & 1023; tab[i] = MOD[((size_t)l * 17 + r) * MODW + shoff + k]; }
        __syncthreads();
        if (first) gemv17_item(F, tab, red, F.in[8] + (size_t)l * D * IND, IND, j * 64, nullptr, WSP(float, WS_SHW1) + (size_t)l * 17 * IND, IND);
        else gemv17_item(F, tab, red, F.in[22] + (size_t)l * D * FF, FF, (j - 40) * 64, nullptr, WSP(float, WS_SHW2) + (size_t)l * 17 * FF, FF);
    }
    bf16* XA = WSP(bf16, WS_XA); float* RSSA = WSP(float, WS_RSSA);
    const float* g1 = F.in[4];
    for (int row = F.gw; row < MT; row += F.NGW) {
        const bool lat = row < ML;
        const float* xr = lat ? F.in[0] + (size_t)row * D : F.in[2] + (size_t)(row - ML) * D;
        const int brow = lat ? (row >> 11) : NB;
        const float* sc = MOD + (size_t)brow * MODW + D;
        f32x4 v[4]; float ss = 0.f;
#pragma unroll
        for (int j = 0; j < 4; ++j) { v[j] = *(const f32x4*)(xr + 4 * F.lane + 256 * j); ss += (v[j][0] * v[j][0] + v[j][1] * v[j][1]) + (v[j][2] * v[j][2] + v[j][3] * v[j][3]); }
        ss = wave_sum(ss);
        if (F.lane < 32) RSSA[(size_t)row * 32 + F.lane] = (F.lane == 0) ? ss : 0.f;
#pragma unroll
        for (int j = 0; j < 4; ++j) { const int k = 4 * F.lane + 256 * j;
            const f32x4 gm = *(const f32x4*)(g1 + k) * (*(const f32x4*)(sc + k) + 1.0f), a = v[j] * gm;
            v2u o; o.x = pk2(a[0], a[1]); o.y = pk2(a[2], a[3]); *(v2u*)(XA + (size_t)row * D + k) = o; }
    }
}

__device__ __forceinline__ void conv_row(Frame& F, int l, int row) {
    const bf16* PROJ = WSP(const bf16, WS_PROJ); bf16* MIX = WSP(bf16, WS_MIX);
    const float* cw = F.in[10] + (size_t)l * 31 * 256; const float* cb = F.in[11] + l * 256; const float* lg = F.in[12] + l * 256; const float* lb = F.in[13] + l * 256;
    int lo, hi; if (row < ML) { lo = row & ~(SEQ - 1); hi = lo + SEQ; } else { lo = row & ~(CTXL - 1); hi = lo + CTXL; }
    const int c0 = 4 * F.lane;
    f32x4 acc = *(const f32x4*)(cb + c0);
    for (int k = 0; k < 31; ++k) {
        const int rr = row + k - 15;
        if (rr >= lo && rr < hi) {
            const v2u vv = *(const v2u*)(PROJ + (size_t)rr * IND + c0), gg = *(const v2u*)(PROJ + (size_t)rr * IND + 256 + c0);
            const f32x4 w = *(const f32x4*)(cw + k * 256 + c0);
            acc[0] += w[0] * bflo(vv.x) * sigmoidf_(bflo(gg.x)); acc[1] += w[1] * bfhi(vv.x) * sigmoidf_(bfhi(gg.x));
            acc[2] += w[2] * bflo(vv.y) * sigmoidf_(bflo(gg.y)); acc[3] += w[3] * bfhi(vv.y) * sigmoidf_(bfhi(gg.y));
        }
    }
    const float mu = wave_sum((acc[0] + acc[1]) + (acc[2] + acc[3])) * (1.f / 256.f);
    const f32x4 d = acc - mu;
    const float var = wave_sum((d[0] * d[0] + d[1] * d[1]) + (d[2] * d[2] + d[3] * d[3])) * (1.f / 256.f);
    const f32x4 y = d * rsqrtf(var + EPS) * *(const f32x4*)(lg + c0) + *(const f32x4*)(lb + c0);
    v2u o; o.x = pk2(siluf_(y[0]), siluf_(y[1])); o.y = pk2(siluf_(y[2]), siluf_(y[3]));
    *(v2u*)(MIX + (size_t)row * D + c0) = o;
}

__device__ __forceinline__ void na_item(Frame& F, int l, int it) {
    const bf16* PROJ = WSP(const bf16, WS_PROJ); bf16* MIX = WSP(bf16, WS_MIX);
    const bool isctx = it >= 4096;
    int b, h, r;
    if (!isctx) { b = it >> 8; h = (it >> 5) & 7; r = it & 31; } else { const int j = it - 4096; b = j >> 5; h = (j >> 2) & 7; r = j & 3; }
    const int lane = F.lane;
    const size_t qrow = isctx ? (size_t)ML + b * CTXL + r * 64 + lane : (size_t)b * SEQ + r * 64 + lane;
    float q[64], o[64];
    {
        const v4u* qp = (const v4u*)(PROJ + qrow * IND + 512 + h * HD);
#pragma unroll
        for (int i = 0; i < 8; ++i) { const v4u w = qp[i];
            q[8 * i + 0] = bflo(w.x) * 0.125f; q[8 * i + 1] = bfhi(w.x) * 0.125f; q[8 * i + 2] = bflo(w.y) * 0.125f; q[8 * i + 3] = bfhi(w.y) * 0.125f;
            q[8 * i + 4] = bflo(w.z) * 0.125f; q[8 * i + 5] = bfhi(w.z) * 0.125f; q[8 * i + 6] = bflo(w.w) * 0.125f; q[8 * i + 7] = bfhi(w.w) * 0.125f; }
#pragma unroll
        for (int i = 0; i < 64; ++i) o[i] = 0.f;
    }
    float mx = -3.0e38f, den = 0.f;
    const int nloc = isctx ? 0 : 128;
    int rs = r - 4; rs = rs < 0 ? 0 : (rs > 24 ? 24 : rs);
    int cs = lane - 8; cs = cs < 0 ? 0 : (cs > 48 ? 48 : cs);
    const float* rpb = F.in[14] + ((size_t)l * NH + h) * 15 * 31;
    for (int kk = 0; kk < nloc + CTXL; ++kk) {
        size_t krow; float bias = 0.f;
        if (kk < nloc) { const int j = kk >> 4, kc = cs + (kk & 15); krow = (size_t)b * SEQ + (rs + j) * 64 + kc; bias = rpb[(rs + j - r + 7) * 31 + (kc - lane + 15)]; }
        else krow = (size_t)ML + b * CTXL + (kk - nloc);
        const v4u* kp = (const v4u*)(PROJ + krow * IND + 1024 + h * HD);
        float s = bias;
#pragma unroll
        for (int i = 0; i < 8; ++i) { const v4u w = kp[i];
            s += q[8 * i + 0] * bflo(w.x) + q[8 * i + 1] * bfhi(w.x) + q[8 * i + 2] * bflo(w.y) + q[8 * i + 3] * bfhi(w.y) + q[8 * i + 4] * bflo(w.z) + q[8 * i + 5] * bfhi(w.z) + q[8 * i + 6] * bflo(w.w) + q[8 * i + 7] * bfhi(w.w); }
        const float mn = fmaxf(mx, s), alpha = __expf(mx - mn), p = __expf(s - mn);
        den = den * alpha + p; mx = mn;
        const v4u* vp = (const v4u*)(PROJ + krow * IND + 1536 + h * HD);
#pragma unroll
        for (int i = 0; i < 8; ++i) { const v4u w = vp[i];
            o[8 * i + 0] = o[8 * i + 0] * alpha + p * bflo(w.x); o[8 * i + 1] = o[8 * i + 1] * alpha + p * bfhi(w.x); o[8 * i + 2] = o[8 * i + 2] * alpha + p * bflo(w.y); o[8 * i + 3] = o[8 * i + 3] * alpha + p * bfhi(w.y);
            o[8 * i + 4] = o[8 * i + 4] * alpha + p * bflo(w.z); o[8 * i + 5] = o[8 * i + 5] * alpha + p * bfhi(w.z); o[8 * i + 6] = o[8 * i + 6] * alpha + p * bflo(w.w); o[8 * i + 7] = o[8 * i + 7] * alpha + p * bfhi(w.w); }
    }
    const float inv = 1.f / den;
    v4u* op = (v4u*)(MIX + qrow * D + 256 + h * HD);
#pragma unroll
    for (int i = 0; i < 8; ++i) { v4u w; w.x = pk2(o[8 * i + 0] * inv, o[8 * i + 1] * inv); w.y = pk2(o[8 * i + 2] * inv, o[8 * i + 3] * inv); w.z = pk2(o[8 * i + 4] * inv, o[8 * i + 5] * inv); w.w = pk2(o[8 * i + 6] * inv, o[8 * i + 7] * inv); op[i] = w; }
}

template <int PASS>
__device__ __forceinline__ void lru_tile(Frame& F, int l, int T) {
    const bf16* PROJ = WSP(const bf16, WS_PROJ);
    LAS unsigned* rxs = (LAS unsigned*)(F.lds);
    LAS float* ucs = (LAS float*)(F.lds + 38 * 128 * 4);
    LAS float* hs = (LAS float*)(F.lds + 38 * 128 * 4 + 65536);
    const int row0 = T * 32;
    int lo, hi; if (row0 < ML) { lo = row0 & ~(SEQ - 1); hi = lo + SEQ; } else { lo = row0 & ~(CTXL - 1); hi = lo + CTXL; }
    __syncthreads();
    for (int i = F.tid; i < 38 * 128; i += NWAVES * 64) { const int rr = i >> 7, cp = i & 127, row = row0 - 3 + rr;
        rxs[i] = (row >= lo && row < hi) ? *(const unsigned*)(PROJ + (size_t)row * IND + 2048 + 2 * cp) : 0u; }
    if (PASS == 1) for (int i = F.tid; i < 32 * 256; i += NWAVES * 64) hs[i] = 0.f;
    __syncthreads();
    const int dir = F.tid >> 8, c = F.tid & 255;
    {
        const float* cw = F.in[15] + ((size_t)(l * 2 + dir) * 4) * 256 + c; const float cbv = F.in[16][(l * 2 + dir) * 256 + c];
        const float w0 = cw[0], w1 = cw[256], w2 = cw[512], w3 = cw[768];
        const LAS bf16* rx = (const LAS bf16*)rxs;
        const int base = dir == 0 ? 0 : 3;
        for (int t = 0; t < 32; ++t) {
            const float u = cbv + w0 * bf1(rx[(t + base + 0) * 256 + c]) + w1 * bf1(rx[(t + base + 1) * 256 + c]) + w2 * bf1(rx[(t + base + 2) * 256 + c]) + w3 * bf1(rx[(t + base + 3) * 256 + c]);
            ucs[(dir * 32 + t) * 256 + c] = u;
        }
    }
    __syncthreads();
    const int kb = c >> 6, ee = c & 63;
    float zx[32], za[32];
    {
        const float bxv = F.in[18][(l * 2 + dir) * 256 + c], bav = F.in[20][(l * 2 + dir) * 256 + c];
#pragma unroll
        for (int tt = 0; tt < 32; ++tt) { zx[tt] = bxv; za[tt] = bav; }
        const float* wx = F.in[17] + (((size_t)(l * 2 + dir) * 4 + kb) * 64) * 64 + ee; const float* wa = F.in[19] + (((size_t)(l * 2 + dir) * 4 + kb) * 64) * 64 + ee;
        const LAS float* ub = ucs + (dir * 32 + (dir == 0 ? 0 : 31)) * 256 + kb * 64;
        const int tstep = dir == 0 ? 256 : -256;
#pragma unroll 2
        for (int d = 0; d < 64; ++d) {
            const float wxv = wx[d * 64], wav = wa[d * 64];
#pragma unroll
            for (int tt = 0; tt < 32; ++tt) { const float u = ub[tt * tstep + d]; zx[tt] += u * wxv; za[tt] += u * wav; }
        }
    }
    const float nl = -F.in[21][(l * 2 + dir) * 256 + c];
    const float sp8 = -8.f * (fmaxf(nl, 0.f) + log1pf(__expf(-fabsf(nl))));
    float h = 0.f, P = 1.f;
    if (PASS == 1) h = WSP(const float, WS_CARRY)[((size_t)dir * 1152 + T) * 256 + c];
    {
        const LAS float* uo = ucs + (dir * 32 + (dir == 0 ? 0 : 31)) * 256 + c;
        LAS float* ho = hs + (dir == 0 ? 0 : 31) * 256 + c;
        const int tstep = dir == 0 ? 256 : -256;
#pragma unroll
        for (int tt = 0; tt < 32; ++tt) {
            const float gx = sigmoidf_(zx[tt]), ga = sigmoidf_(za[tt]);
            const float log_a = sp8 * ga;
            const float a = __expf(log_a);
            const float coef = sqrtf(-expm1f(2.f * log_a));
            h = a * h + coef * gx * uo[tt * tstep];
            if (PASS == 0) P *= a; else __hip_atomic_fetch_add(ho + tt * tstep, h, __ATOMIC_RELAXED, __HIP_MEMORY_SCOPE_WORKGROUP);
        }
    }
    if (PASS == 0) { WSP(f32x2, WS_TOT)[((size_t)dir * 1152 + T) * 256 + c] = (f32x2){P, h}; }
    else {
        __syncthreads();
        bf16* MIX = WSP(bf16, WS_MIX);
        for (int i = F.tid; i < 32 * 128; i += NWAVES * 64) { const int t = i >> 7, cp = i & 127; const size_t row = (size_t)row0 + t;
            const unsigned gw = *(const unsigned*)(PROJ + row * IND + 2304 + 2 * cp);
            *(unsigned*)(MIX + row * D + 768 + 2 * cp) = pk2(gelu_tanh(bflo(gw)) * hs[t * 256 + 2 * cp], gelu_tanh(bfhi(gw)) * hs[t * 256 + 2 * cp + 1]); }
    }
}
__device__ __forceinline__ void lru_carry(Frame& F) {
    const f32x2* TOT = WSP(const f32x2, WS_TOT); float* CARRY = WSP(float, WS_CARRY);
    for (int it = F.gw; it < NB * 2 * 4; it += F.NGW) {
        const int b = it >> 3, dir = (it >> 2) & 1, c = (it & 3) * 64 + F.lane;
        float h = 0.f;
        for (int g = 0; g < 9; ++g) {
            f32x2 ps[8]; int tl[8];
#pragma unroll
            for (int i = 0; i < 8; ++i) { const int s = g * 8 + i;
                int T; if (s < 8) T = 1024 + b * 8 + (dir == 0 ? s : 7 - s); else T = b * 64 + (dir == 0 ? s - 8 : 71 - s);
                tl[i] = T; ps[i] = TOT[((size_t)dir * 1152 + T) * 256 + c]; }
#pragma unroll
            for (int i = 0; i < 8; ++i) { CARRY[((size_t)dir * 1152 + tl[i]) * 256 + c] = h; h = ps[i][0] * h + ps[i][1]; }
        }
    }
}

__device__ __forceinline__ void final_rows(Frame& F) {
    const float* g = F.in[24];
    for (int row = F.gw; row < ML; row += F.NGW) {
        float* xr = F.out + (size_t)row * D;
        f32x4 v[4]; float ss = 0.f;
#pragma unroll
        for (int j = 0; j < 4; ++j) { v[j] = *(const f32x4*)(xr + 4 * F.lane + 256 * j); ss += (v[j][0] * v[j][0] + v[j][1] * v[j][1]) + (v[j][2] * v[j][2] + v[j][3] * v[j][3]); }
        const float rs = rsqrtf(wave_sum(ss) * (1.f / D) + EPS);
#pragma unroll
        for (int j = 0; j < 4; ++j) { const int k = 4 * F.lane + 256 * j; *(f32x4*)(xr + k) = v[j] * rs * *(const f32x4*)(g + k); }
    }
}

constexpr int N_PHASES = 2 + 7 * DEPTH + 1;
struct Args { const float* in[25]; float* out; unsigned char* ws; int ph_lo, ph_hi; };
static_assert(sizeof(Args) == 27 * 8 + 8, "Args has no padding");

__global__ void __launch_bounds__(NWAVES * 64, 2) mega_fwd(Args args) {
    extern __shared__ __attribute__((aligned(16))) unsigned char lds[];
    Frame F;
    F.lds = (LAS unsigned char*)lds;
    F.tid = threadIdx.x; F.lane = F.tid & 63; F.wave = __builtin_amdgcn_readfirstlane(F.tid >> 6);
    F.G = gridDim.x; { const int bx = blockIdx.x; F.vcu = (F.G % 8 == 0) ? (bx % 8) * (F.G / 8) + bx / 8 : bx; }
    F.gw = F.vcu * NWAVES + F.wave; F.NGW = F.G * NWAVES;
#pragma unroll
    for (int i = 0; i < 25; ++i) F.in[i] = args.in[i];
    F.out = args.out; F.ws = args.ws;
    volatile LAS unsigned* MISC = (volatile LAS unsigned*)(F.lds + MISC_OFF);
    for (int u = F.tid; u < (LDS_BYTES - LDSCTL_OFF) / 4; u += NWAVES * 64) ((LAS unsigned*)(F.lds + LDSCTL_OFF))[u] = 0u;
    __syncthreads();
    XcdBarrier bar = xcd_barrier_post((unsigned*)(F.ws + WS_CTL) + CW_BAR, MISC + 8);

    const int lo = args.ph_lo, hi = args.ph_hi;
    for (int ph = lo; ph < hi; ++ph) {
        { int t_ = threadIdx.x; asm volatile("" : "+v"(t_)); F.tid = t_; F.lane = t_ & 63; F.wave = __builtin_amdgcn_readfirstlane(t_ >> 6); F.gw = F.vcu * NWAVES + F.wave; }
        if (ph == 0) {
#ifndef NO_P0
            phase_p0a(F);
#endif
        } else if (ph == 1) {
#ifndef NO_P0
            phase_p0b(F);
#endif
        }
        else if (ph == N_PHASES - 1) final_rows(F);
        else {
            const int l = (ph - 2) / 7, k = (ph - 2) % 7; const bool last = (l == DEPTH - 1);
            const int Mx = last ? ML : MT;
            float* MOD = WSP(float, WS_MOD);
            if (k == 0) {
                pg8::Gemm g{WSP(const bf16, WS_XA), WSP(const bf16, WS_WIN) + (size_t)l * IND * D, MT, IND, D};
                pg8::Order S; if (last) S.init(ML, IND, (MC / 256) * 5, F.G, (int)blockIdx.x); else S.init(MT, IND, 0, F.G, (int)blockIdx.x);
                pg8::EpiScale<0, IND> E{WSP(bf16, WS_PROJ), WSP(const float, WS_SHW1) + (size_t)l * 17 * IND, WSP(const float, WS_RSSA)};

#ifndef NO_G0
                pg8::gemm_phase<pg8::EpiScale<0, IND>, pg8::Order, true, true>(F.lds + RING_OFF, g, S, E, F.tid);
#endif

            } else if (k == 1) {

#ifndef NO_LRU
                for (int T = F.vcu; T < 1152; T += F.G) lru_tile<0>(F, l, T);
#endif

                __syncthreads();
                const int nrows = last ? ML : MT;

#ifndef NO_CONV
                for (int row = F.gw; row < nrows; row += F.NGW) conv_row(F, l, row);
#endif

                const int nna = last ? 4096 : 4096 + 512;

#ifndef NO_NA
                for (int it = F.gw; it < nna; it += F.NGW) na_item(F, l, it);
#endif

            } else if (k == 2) {
                lru_carry(F);
            } else if (k == 3) {

#ifndef NO_LRU
                for (int T = F.vcu; T < (last ? 1024 : 1152); T += F.G) lru_tile<1>(F, l, T);
#endif

            } else if (k == 4) {
                pg8::Gemm g{WSP(const bf16, WS_MIX), WSP(const bf16, WS_WOUT) + (size_t)l * D * D, Mx, D, D};
                pg8::Order S; S.init(Mx, D, 0, F.G, (int)blockIdx.x);
                pg8::EpiRes E{l == 0 ? F.in[0] : F.out, l == 0 ? F.in[2] : WSP(const float, WS_CX), F.out, WSP(float, WS_CX),
                              MOD + (size_t)l * 17 * MODW + 2 * D, F.in[5] + l * D, MOD + (size_t)l * 17 * MODW + 4 * D, WSP(bf16, WS_XA), WSP(float, WS_RSSB)};

#ifndef NO_GR
                pg8::gemm_phase<pg8::EpiRes, pg8::Order, true, true>(F.lds + RING_OFF, g, S, E, F.tid);
#endif

            } else if (k == 5) {
                pg8::Gemm g{WSP(const bf16, WS_XA), WSP(const bf16, WS_W1) + (size_t)l * FF * D, Mx, FF, D};
                pg8::Order S; S.init(Mx, FF, 0, F.G, (int)blockIdx.x);
                pg8::EpiScale<1, FF> E{WSP(bf16, WS_HID), WSP(const float, WS_SHW2) + (size_t)l * 17 * FF, WSP(const float, WS_RSSB)};

#ifndef NO_G1
                pg8::gemm_phase<pg8::EpiScale<1, FF>, pg8::Order, true, true>(F.lds + RING_OFF, g, S, E, F.tid);
#endif

            } else {
                pg8::Gemm g{WSP(const bf16, WS_HID), WSP(const bf16, WS_W2) + (size_t)l * D * FF, Mx, D, FF};
                pg8::Order S; S.init(Mx, D, 0, F.G, (int)blockIdx.x);
                const int ln = last ? l : l + 1;
                pg8::EpiRes E{F.out, WSP(const float, WS_CX), F.out, WSP(float, WS_CX),
                              MOD + (size_t)l * 17 * MODW + 5 * D, F.in[4] + ln * D, MOD + (size_t)ln * 17 * MODW + D, last ? (bf16*)nullptr : WSP(bf16, WS_XA), WSP(float, WS_RSSA)};

#ifndef NO_GR
                pg8::gemm_phase<pg8::EpiRes, pg8::Order, true, true>(F.lds + RING_OFF, g, S, E, F.tid);
#endif

            }
        }
        if (ph + 1 < hi) xcd_barrier(bar);
    }
}

extern "C" void kernel_launch(void* const* d_in, const int* in_sizes, int n_in, void* d_out, int out_size, void* d_ws, size_t ws_size, hipStream_t stream) {
    static int grid = 0;
    if (grid == 0) {
        if (n_in != 25 || out_size != ML * D || ws_size < WS_END) { fprintf(stderr, "kernel_launch: unexpected shapes (n_in %d out %d ws %zu)\n", n_in, out_size, ws_size); grid = -1; return; }
        int dev = 0, cus = 0;
        if (hipGetDevice(&dev) != hipSuccess || hipDeviceGetAttribute(&cus, hipDeviceAttributeMultiprocessorCount, dev) != hipSuccess) { grid = -1; return; }
        if (hipFuncSetAttribute((const void*)mega_fwd, hipFuncAttributeMaxDynamicSharedMemorySize, LDS_BYTES) != hipSuccess) { fprintf(stderr, "kernel_launch: hipFuncSetAttribute failed\n"); grid = -1; return; }
        int per_cu = 0;
        if (hipOccupancyMaxActiveBlocksPerMultiprocessor(&per_cu, (const void*)mega_fwd, NWAVES * 64, LDS_BYTES) != hipSuccess || per_cu < 1) fprintf(stderr, "kernel_launch: occupancy query reports %d\n", per_cu);
        (void)hipGetLastError();
        grid = cus;
    }
    if (grid < 0) return;
    if (hipMemsetAsync((char*)d_ws + WS_CTL, 0, CTL_ZERO_BYTES, stream) != hipSuccess) return;
    Args a{};
    for (int i = 0; i < 25; ++i) a.in[i] = (const float*)d_in[i];
    a.out = (float*)d_out; a.ws = (unsigned char*)d_ws;
#if MK_N_LAUNCHES == 1
    a.ph_lo = 0; a.ph_hi = N_PHASES;
    hipLaunchKernelGGL(mega_fwd, dim3(grid), dim3(NWAVES * 64), LDS_BYTES, stream, a);
#else
    for (int ph = 0; ph < N_PHASES; ++ph) { a.ph_lo = ph; a.ph_hi = ph + 1; hipLaunchKernelGGL(mega_fwd, dim3(grid), dim3(NWAVES * 64), LDS_BYTES, stream, a); }
#endif
}
```

```cpp
#include <hip/hip_runtime.h>
#include <cstdio>
#include <cstdint>

constexpr int D = 1024, NB = 16, SEQ = 2048, CTXL = 256, DEPTH = 2;
constexpr int ML = NB * SEQ, MC = NB * CTXL, MT = ML + MC;
constexpr int IND = 2560, FF = 4096, NH = 8, HD = 64;
constexpr int MODW = 6 * D;
constexpr float EPS = 1e-6f;
#ifndef MK_N_LAUNCHES
#define MK_N_LAUNCHES 1
#endif

namespace pg8 {
#define PG8_LAS __attribute__((address_space(3)))
typedef unsigned short bf16_t;
typedef short bf16x8 __attribute__((ext_vector_type(8)));
typedef float f32x4 __attribute__((ext_vector_type(4)));
typedef unsigned u32x4 __attribute__((ext_vector_type(4)));
constexpr int BM = 256, BK = 64, HALF = 128, HTB = HALF * BK * 2, STAGE_BYTES = 8 * HTB, NXCD = 8, WGM = 8;

__host__ __device__ __forceinline__ int lds_byte(int r, int c) { const int st = (r >> 4) * 2 + (c >> 5), rr = r & 15, cc = c & 31, ob = rr * 64 + cc * 2; return st * 1024 + (ob ^ (((ob >> 9) & 1) << 5)); }
__host__ __device__ __forceinline__ void stage_rc(int b, int& R, int& C) { const int st = b / 1024, sb = b % 1024, swz = sb ^ (((sb >> 9) & 1) << 5); R = (st >> 1) * 16 + swz / 64; C = (st & 1) * 32 + (swz % 64) / 2; }
__host__ __device__ __forceinline__ int perm32(int rho) { const int n = rho >> 4, i = rho & 15; return 8 * (i >> 2) + 4 * n + (i & 3); }

struct Unit { int pm, pn; };
struct Gemm { const bf16_t* A; const bf16_t* Bt; int M, N, K; };

__host__ __device__ __forceinline__ void map_tile(int wgid, int nM, int nN, Unit& u) {
    const int nwg = nM * nN;
    { const int q = nwg / NXCD, r = nwg % NXCD, xcd = wgid % NXCD, off = wgid / NXCD; wgid = (xcd < r ? xcd * (q + 1) : r * (q + 1) + (xcd - r) * q) + off; }
    const int nig = WGM * nN, gid = wgid / nig, fm = gid * WGM, gsz = (nM - fm) < WGM ? (nM - fm) : WGM;
    u.pm = fm + ((wgid % nig) % gsz); u.pn = (wgid % nig) / gsz;
}
struct Order {
    int nM, nN, nwg, extra, G, c;
    __host__ __device__ void init(int M, int N, int extra_, int G_, int c_) { nM = M / BM; nN = N / BM; nwg = nM * nN; extra = extra_; G = G_; c = c_; }
    __host__ __device__ bool next(int i, Unit& u) const {
        const long L = (long)i * G + c;
        if (L < nwg) { map_tile((int)L, nM, nN, u); return true; }
        if (L < nwg + extra) { const int q = (int)L - nwg; u.pm = nM + q / 5; u.pn = 4 + q % 5; return true; }
        return false;
    }
    __device__ __forceinline__ void a_ready(const Unit&) const {}
    __device__ __forceinline__ void done(const Unit&) const {}
};

__device__ __forceinline__ unsigned cvt_pk_bf16(float lo, float hi) { unsigned r; asm volatile("v_cvt_pk_bf16_f32 %0, %1, %2" : "=v"(r) : "v"(lo), "v"(hi)); return r; }

__device__ __forceinline__ float row_rs(const float* RSSt, unsigned roff, int fq) {
    const f32x4 p0 = *(const f32x4*)(RSSt + (roff + 8u * (unsigned)fq)), p1 = *(const f32x4*)(RSSt + (roff + 8u * (unsigned)fq + 4u));
    float s = ((p0[0] + p0[1]) + (p0[2] + p0[3])) + ((p1[0] + p1[1]) + (p1[2] + p1[3]));
    s += __shfl_xor(s, 16); s += __shfl_xor(s, 32);
    return rsqrtf(s * (1.0f / D) + EPS);
}
template <int ACT, int LDC> struct EpiScale {
    static constexpr bool PERM = true, AFTER_DRAIN = false;
    bf16_t* O; const float* shw; const float* RSS;
    __device__ __forceinline__ void operator()(const f32x4 (&acc)[2][2][4][2], const Unit& u, int wr, int wc, int fr, int fq) const {
        const int brow = u.pm < ML / BM ? (u.pm >> 3) : NB;
        const float* sp = shw + (size_t)brow * LDC + u.pn * BM;
        bf16_t* Ot = O + (size_t)u.pm * BM * LDC + u.pn * BM;
        const float* RSSt = RSS + (size_t)u.pm * BM * 32;
        unsigned cl = (unsigned)(wc * 32 + 8 * fq);
        unsigned rl0 = (unsigned)(wr * 64 + fr);
        asm volatile("" : "+v"(cl), "+v"(rl0));
#pragma unroll
        for (int bj = 0; bj < 2; ++bj) {
            const f32x4 s0 = *(const f32x4*)(sp + (cl + (unsigned)(bj * HALF))), s1 = *(const f32x4*)(sp + (cl + (unsigned)(bj * HALF + 4)));
#pragma unroll
            for (int ai = 0; ai < 2; ++ai)
#pragma unroll
                for (int m = 0; m < 4; ++m) {
                    const float rs = row_rs(RSSt, (rl0 + (unsigned)(ai * HALF + m * 16)) * 32u, fq);
                    f32x4 v0 = acc[ai][bj][m][0] * rs + s0, v1 = acc[ai][bj][m][1] * rs + s1;
                    if (ACT == 1) {
#pragma unroll
                        for (int e = 0; e < 4; ++e) { const float a = fmaxf(v0[e], 0.f), b = fmaxf(v1[e], 0.f); v0[e] = a * a; v1[e] = b * b; }
                    }
                    u32x4 w; w.x = cvt_pk_bf16(v0[0], v0[1]); w.y = cvt_pk_bf16(v0[2], v0[3]); w.z = cvt_pk_bf16(v1[0], v1[1]); w.w = cvt_pk_bf16(v1[2], v1[3]);
                    *(u32x4*)(Ot + ((rl0 + (unsigned)(ai * HALF + m * 16)) * (unsigned)LDC + cl + (unsigned)(bj * HALF))) = w;
                }
        }
    }
};
struct EpiRes {
    static constexpr bool PERM = true, AFTER_DRAIN = false;
    const float* src_lat; const float* src_ctx; float* dst_lat; float* dst_ctx;
    const float* gate;
    const float* gmg; const float* gmsc;
    bf16_t* XA; float* RSS;
    __device__ __forceinline__ void operator()(const f32x4 (&acc)[2][2][4][2], const Unit& u, int wr, int wc, int fr, int fq) const {
        const bool lat = u.pm < ML / BM;
        const int brow = lat ? (u.pm >> 3) : NB;
        const float* src = (lat ? src_lat + (size_t)u.pm * BM * D : src_ctx + (size_t)(u.pm - ML / BM) * BM * D) + u.pn * BM;
        float* dst = (lat ? dst_lat + (size_t)u.pm * BM * D : dst_ctx + (size_t)(u.pm - ML / BM) * BM * D) + u.pn * BM;
        const float* gt = gate + (size_t)brow * MODW + u.pn * BM;
        const float* gg = gmg + u.pn * BM;
        const float* gs = gmsc + (size_t)brow * MODW + u.pn * BM;
        bf16_t* XAt = XA + (size_t)u.pm * BM * D + u.pn * BM;
        float* RSSt = RSS + (size_t)u.pm * BM * 32 + u.pn * 8 + wc;
        unsigned cl = (unsigned)(wc * 32 + 8 * fq);
        unsigned rl0 = (unsigned)(wr * 64 + fr);
        asm volatile("" : "+v"(cl), "+v"(rl0));
        const bool hasxa = XA != nullptr;
#pragma unroll
        for (int bj = 0; bj < 2; ++bj) {
            const unsigned c = cl + (unsigned)(bj * HALF);
            const f32x4 g0 = *(const f32x4*)(gt + c), g1 = *(const f32x4*)(gt + (c + 4u));
            f32x4 m0 = {0.f, 0.f, 0.f, 0.f}, m1 = {0.f, 0.f, 0.f, 0.f};
            if (hasxa) { m0 = *(const f32x4*)(gg + c) * (*(const f32x4*)(gs + c) + 1.0f); m1 = *(const f32x4*)(gg + (c + 4u)) * (*(const f32x4*)(gs + (c + 4u)) + 1.0f); }
#pragma unroll
            for (int ai = 0; ai < 2; ++ai)
#pragma unroll
                for (int m = 0; m < 4; ++m) {
                    const unsigned rl = rl0 + (unsigned)(ai * HALF + m * 16);
                    const unsigned off = rl * (unsigned)D + c;
                    const f32x4 x0 = *(const f32x4*)(src + off), x1 = *(const f32x4*)(src + (off + 4u));
                    const f32x4 y0 = x0 + g0 * acc[ai][bj][m][0], y1 = x1 + g1 * acc[ai][bj][m][1];
                    *(f32x4*)(dst + off) = y0; *(f32x4*)(dst + (off + 4u)) = y1;
                    float ss = ((y0[0] * y0[0] + y0[1] * y0[1]) + (y0[2] * y0[2] + y0[3] * y0[3])) + ((y1[0] * y1[0] + y1[1] * y1[1]) + (y1[2] * y1[2] + y1[3] * y1[3]));
                    ss += __shfl_xor(ss, 16); ss += __shfl_xor(ss, 32);
                    if (fq == 0) RSSt[rl * 32u + (unsigned)(bj * 4)] = ss;
                    if (hasxa) { const f32x4 a0 = y0 * m0, a1 = y1 * m1;
                        u32x4 w; w.x = cvt_pk_bf16(a0[0], a0[1]); w.y = cvt_pk_bf16(a0[2], a0[3]); w.z = cvt_pk_bf16(a1[0], a1[1]); w.w = cvt_pk_bf16(a1[2], a1[3]);
                        *(u32x4*)(XAt + off) = w; }
                    asm volatile("" ::: "memory");
                }
        }
    }
};

template <class Epi, class Sched, bool ALIGN_EPI = false, bool SP2 = false>
__device__ __forceinline__ void gemm_phase(PG8_LAS unsigned char* lds, const Gemm g, const Sched& S, const Epi& E, const int tid) {
    const int wid = __builtin_amdgcn_readfirstlane(tid >> 6), lane = tid & 63, wr = wid >> 2, wc = wid & 3, fr = lane & 15, fq = lane >> 4;
    const int K = g.K, nt = K / BK;
    unsigned voffA[2], voffB[2];
#pragma unroll
    for (int i = 0; i < 2; ++i) { int R, C; stage_rc(tid * 16 + i * 8192, R, C); const int Rb = Epi::PERM ? ((R & ~31) + perm32(R & 31)) : R;
        voffA[i] = (unsigned)(R * K + C) * 2u; voffB[i] = (unsigned)(Rb * K + C) * 2u; }
    const size_t kstep = (size_t)(BK * 2);
    const size_t hstep = (size_t)HALF * K * 2;
    const size_t tstep = 2 * hstep;
    const unsigned ldsw = (unsigned)wid * 1024u;
    const int aoff = lds_byte(wr * 64 + fr, fq * 8), boff = lds_byte(wc * 32 + fr, fq * 8);
#define PG8_SA(b, h) (((b) * 2 + (h)) * HTB)
#define PG8_SB(b, h) ((4 + (b) * 2 + (h)) * HTB)
#define PG8_STAGE(bufoff, gbase, voff) do { _Pragma("unroll") for (int _i = 0; _i < 2; ++_i) \
        __builtin_amdgcn_global_load_lds((const unsigned*)((const char*)(gbase) + (voff)[_i]), (PG8_LAS unsigned*)(lds + (bufoff) + ldsw + _i * 8192), 16, 0, 0); } while (0)
#define PG8_LDA(dst, b, h) do { _Pragma("unroll") for (int m = 0; m < 4; ++m) _Pragma("unroll") for (int k = 0; k < 2; ++k) dst[m][k] = *(const PG8_LAS bf16x8*)(lds + PG8_SA(b, h) + aoff + m * 2048 + k * 1024); } while (0)
#define PG8_LDB(dst, b, h) do { _Pragma("unroll") for (int n = 0; n < 2; ++n) _Pragma("unroll") for (int k = 0; k < 2; ++k) dst[n][k] = *(const PG8_LAS bf16x8*)(lds + PG8_SB(b, h) + boff + n * 2048 + k * 1024); } while (0)
#define PG8_MMA(ai, bj, At, Bt) do { __builtin_amdgcn_s_setprio(1); _Pragma("unroll") for (int m = 0; m < 4; ++m) _Pragma("unroll") for (int n = 0; n < 2; ++n) _Pragma("unroll") for (int k = 0; k < 2; ++k) \
        acc[ai][bj][m][n] = __builtin_amdgcn_mfma_f32_16x16x32_bf16(Bt[n][k], At[m][k], acc[ai][bj][m][n], 0, 0, 0); __builtin_amdgcn_s_setprio(0); } while (0)
#define PG8_WAIT_V(n) asm volatile("s_waitcnt vmcnt(" #n ")" ::: "memory")
#define PG8_WAIT_L(n) asm volatile("s_waitcnt lgkmcnt(" #n ")" ::: "memory")
#define PG8_BAR __builtin_amdgcn_s_barrier()
#define PG8_SCHED __builtin_amdgcn_sched_barrier(0)
    Unit cur, nxt; int ui = 0;
    if (!S.next(0, cur)) return;
    f32x4 acc[2][2][4][2];
#pragma unroll
    for (int a = 0; a < 2; ++a)
#pragma unroll
        for (int b = 0; b < 2; ++b)
#pragma unroll
            for (int m = 0; m < 4; ++m)
#pragma unroll
                for (int n = 0; n < 2; ++n) acc[a][b][m][n] = (f32x4){0.f, 0.f, 0.f, 0.f};
    bf16x8 At[4][2], B0[2][2], B1[2][2];
    const char* cA = (const char*)g.A + (size_t)cur.pm * tstep; const char* cB = (const char*)g.Bt + (size_t)cur.pn * tstep;
    S.a_ready(cur);
    if constexpr (SP2) {
        PG8_STAGE(PG8_SB(0, 0), cB, voffB); PG8_STAGE(PG8_SB(0, 1), cB + hstep, voffB); PG8_STAGE(PG8_SA(0, 0), cA, voffA); PG8_STAGE(PG8_SA(0, 1), cA + hstep, voffA);
        if (wr == 1) PG8_BAR;
        PG8_WAIT_V(2); PG8_BAR;
        PG8_STAGE(PG8_SB(1, 0), cB + kstep, voffB); PG8_STAGE(PG8_SA(1, 0), cA + kstep, voffA); PG8_STAGE(PG8_SB(1, 1), cB + hstep + kstep, voffB);
        PG8_WAIT_V(6); PG8_BAR;
    } else {
        PG8_STAGE(PG8_SB(0, 0), cB, voffB); PG8_STAGE(PG8_SA(0, 0), cA, voffA); PG8_STAGE(PG8_SB(0, 1), cB + hstep, voffB); PG8_STAGE(PG8_SA(0, 1), cA + hstep, voffA);
        if (wr == 1) PG8_BAR;
        PG8_WAIT_V(4); PG8_BAR;
        PG8_STAGE(PG8_SB(1, 0), cB + kstep, voffB); PG8_STAGE(PG8_SA(1, 0), cA + kstep, voffA); PG8_STAGE(PG8_SB(1, 1), cB + hstep + kstep, voffB);
        PG8_WAIT_V(6); PG8_BAR;
    }
    for (;;) {
        const bool has_next = S.next(ui + 1, nxt);
        const char* nA = has_next ? (const char*)g.A + (size_t)nxt.pm * tstep : cA; const char* nB = has_next ? (const char*)g.Bt + (size_t)nxt.pn * tstep : cB;
        for (int t = 0; t < nt; t += 2) {
            const bool last = (t == nt - 2);
            const char* a1 = cA + (size_t)(t + 1) * kstep;
            const char* a2 = last ? nA : cA + (size_t)(t + 2) * kstep; const char* b2 = last ? nB : cB + (size_t)(t + 2) * kstep;
            const char* a3 = a2 + kstep; const char* b3 = b2 + kstep;
            if (last && has_next) S.a_ready(nxt);
            if constexpr (SP2) {
            PG8_LDB(B0, 0, 0); PG8_LDB(B1, 0, 1); PG8_SCHED; PG8_LDA(At, 0, 0); PG8_STAGE(PG8_SA(1, 1), a1 + hstep, voffA);
            PG8_WAIT_V(8); PG8_WAIT_L(0); PG8_BAR; PG8_MMA(0, 0, At, B0); PG8_MMA(0, 1, At, B1); PG8_BAR; PG8_SCHED;
            PG8_LDA(At, 0, 1); PG8_STAGE(PG8_SB(0, 0), b2, voffB); PG8_STAGE(PG8_SB(0, 1), b2 + hstep, voffB); PG8_STAGE(PG8_SA(0, 0), a2, voffA);
            PG8_WAIT_V(8); PG8_WAIT_L(0); PG8_BAR; PG8_MMA(1, 0, At, B0); PG8_MMA(1, 1, At, B1); PG8_BAR; PG8_SCHED;
            PG8_LDB(B0, 1, 0); PG8_LDB(B1, 1, 1); PG8_SCHED; PG8_LDA(At, 1, 0); PG8_STAGE(PG8_SA(0, 1), a2 + hstep, voffA);
            PG8_WAIT_V(8); PG8_WAIT_L(0); PG8_BAR; PG8_MMA(0, 0, At, B0); PG8_MMA(0, 1, At, B1); PG8_BAR; PG8_SCHED;
            PG8_LDA(At, 1, 1); PG8_STAGE(PG8_SB(1, 0), b3, voffB); PG8_STAGE(PG8_SB(1, 1), b3 + hstep, voffB); PG8_STAGE(PG8_SA(1, 0), a3, voffA);
            PG8_WAIT_V(8); PG8_WAIT_L(0); PG8_BAR; PG8_MMA(1, 0, At, B0); PG8_MMA(1, 1, At, B1); PG8_BAR; PG8_SCHED;
            } else {
            PG8_LDB(B0, 0, 0); PG8_SCHED; PG8_LDA(At, 0, 0); PG8_STAGE(PG8_SA(1, 1), a1 + hstep, voffA);
            PG8_WAIT_L(8); PG8_BAR; PG8_WAIT_L(0); PG8_MMA(0, 0, At, B0); PG8_BAR; PG8_SCHED;
            PG8_LDB(B1, 0, 1); PG8_STAGE(PG8_SB(0, 0), b2, voffB);
            PG8_BAR; PG8_WAIT_L(0); PG8_MMA(0, 1, At, B1); PG8_BAR;
            PG8_LDA(At, 0, 1); PG8_STAGE(PG8_SA(0, 0), a2, voffA);
            PG8_BAR; PG8_WAIT_L(0); PG8_MMA(1, 0, At, B0); PG8_BAR; PG8_SCHED;
            PG8_STAGE(PG8_SB(0, 1), b2 + hstep, voffB);
            PG8_WAIT_V(6); PG8_BAR; PG8_MMA(1, 1, At, B1); PG8_BAR;
            PG8_LDB(B0, 1, 0); PG8_SCHED; PG8_LDA(At, 1, 0); PG8_STAGE(PG8_SA(0, 1), a2 + hstep, voffA);
            PG8_WAIT_L(8); PG8_BAR; PG8_WAIT_L(0); PG8_MMA(0, 0, At, B0); PG8_BAR; PG8_SCHED;
            PG8_LDB(B1, 1, 1); PG8_STAGE(PG8_SB(1, 0), b3, voffB);
            PG8_BAR; PG8_WAIT_L(0); PG8_MMA(0, 1, At, B1); PG8_BAR;
            PG8_LDA(At, 1, 1); PG8_STAGE(PG8_SA(1, 0), a3, voffA);
            PG8_BAR; PG8_WAIT_L(0); PG8_MMA(1, 0, At, B0); PG8_BAR; PG8_SCHED;
            PG8_STAGE(PG8_SB(1, 1), b3 + hstep, voffB);
            PG8_WAIT_V(6); PG8_BAR; PG8_MMA(1, 1, At, B1); PG8_BAR;
            }
        }
        if constexpr (ALIGN_EPI) { if (wr == 0) PG8_BAR; }
        if constexpr (!Epi::AFTER_DRAIN) { E(acc, cur, wr, wc, fr, fq); S.done(cur); }
        if (!has_next) break;
#pragma unroll
        for (int a = 0; a < 2; ++a)
#pragma unroll
            for (int b = 0; b < 2; ++b)
#pragma unroll
                for (int m = 0; m < 4; ++m)
#pragma unroll
                    for (int n = 0; n < 2; ++n) acc[a][b][m][n] = (f32x4){0.f, 0.f, 0.f, 0.f};
        cur = nxt; cA = nA; cB = nB; ++ui;
        if constexpr (ALIGN_EPI) { if (wr == 1) PG8_BAR; }
    }
    PG8_WAIT_V(0);
    if constexpr (!ALIGN_EPI) { if (wr == 0) PG8_BAR; }
    PG8_BAR;
    if constexpr (Epi::AFTER_DRAIN) { E.fused(acc, cur, wr, wc, fr, fq, lds, wid, lane); S.done(cur); }
#undef PG8_SA
#undef PG8_SB
#undef PG8_STAGE
#undef PG8_LDA
#undef PG8_LDB
#undef PG8_MMA
#undef PG8_WAIT_V
#undef PG8_WAIT_L
#undef PG8_BAR
#undef PG8_SCHED
}
}

constexpr size_t MiB = 1u << 20;
constexpr size_t WS_CTL = 0, CTL_ZERO_BYTES = 1 * MiB;
constexpr size_t WS_MOD = 1 * MiB;
constexpr size_t WS_SHW1 = 2 * MiB;
constexpr size_t WS_SHW2 = 3 * MiB;
constexpr size_t WS_RSSA = 4 * MiB;
constexpr size_t WS_RSSB = 9 * MiB;
constexpr size_t WS_TOT = 14 * MiB;
constexpr size_t WS_CARRY = 19 * MiB;
constexpr size_t WS_WIN = 22 * MiB;
constexpr size_t WS_WOUT = 32 * MiB;
constexpr size_t WS_W1 = 36 * MiB;
constexpr size_t WS_W2 = 52 * MiB;
constexpr size_t WS_CX = 68 * MiB;
constexpr size_t WS_XA = 84 * MiB;
constexpr size_t WS_HID = 156 * MiB;
constexpr size_t WS_PROJ = WS_HID;
constexpr size_t WS_MIX = WS_HID + 180 * MiB;
constexpr size_t WS_END = 444 * MiB;
static_assert(WS_MIX + (size_t)MT * D * 2 <= WS_END && WS_HID + (size_t)MT * FF * 2 == WS_END, "ws map");
constexpr int CW_BAR = 4096;

constexpr int NWAVES = 8;
constexpr int RING_OFF = 0, RING_BYTES = 131072;
constexpr int LDSCTL_OFF = RING_BYTES, MISC_OFF = LDSCTL_OFF + 320;
constexpr int LDS_BYTES = 147456;

#define GAS __attribute__((address_space(1)))
#define LAS __attribute__((address_space(3)))
typedef unsigned short bf16;
typedef unsigned v4u __attribute__((ext_vector_type(4)));
typedef unsigned v2u __attribute__((ext_vector_type(2)));
typedef float f32x4 __attribute__((ext_vector_type(4)));
typedef float f32x2 __attribute__((ext_vector_type(2)));
typedef GAS unsigned gu32;
#define LDS_WAIT() asm volatile("s_waitcnt lgkmcnt(0)" ::: "memory")
#define VM_WAIT() asm volatile("s_waitcnt vmcnt(0)" ::: "memory")
__device__ __forceinline__ unsigned f2bf(float f) { unsigned u = __builtin_bit_cast(unsigned, f); return (u + 0x7fffu + ((u >> 16) & 1u)) >> 16; }
__device__ __forceinline__ unsigned pk2(float lo, float hi) { return f2bf(lo) | (f2bf(hi) << 16); }
__device__ __forceinline__ float bflo(unsigned w) { return __uint_as_float(w << 16); }
__device__ __forceinline__ float bfhi(unsigned w) { return __uint_as_float(w & 0xffff0000u); }
__device__ __forceinline__ float bf1(bf16 v) { return __uint_as_float((unsigned)v << 16); }
__device__ __forceinline__ float sigmoidf_(float x) { return 1.f / (1.f + __expf(-x)); }
__device__ __forceinline__ float siluf_(float x) { return x * sigmoidf_(x); }
__device__ __forceinline__ float gelu_tanh(float x) { const float u = 0.7978845608028654f * (x + 0.044715f * x * x * x); return x * sigmoidf_(2.f * u); }
__device__ __forceinline__ float wave_sum(float v) {
#pragma unroll
    for (int o = 1; o < 64; o <<= 1) v += __shfl_xor(v, o);
    return v;
}

#define XB_TMO      128
#define XB_XCNT(j)  (256  + 64 * (j))
#define XB_XSUB(j)  (1280 + 64 * (j))
#define XB_XGEN(j)  (2304 + 64 * (j))
#define XB_TOP      3328
#define XB_TOPGEN   3392
#define XCD_BAR_WORDS 3456
#define XB_SPIN_CAP (1u << 18)

__device__ __forceinline__ unsigned xb_ld(unsigned* p)              { return __hip_atomic_load(p, __ATOMIC_RELAXED, __HIP_MEMORY_SCOPE_AGENT); }
__device__ __forceinline__ unsigned xb_add(unsigned* p, unsigned v) { return __hip_atomic_fetch_add(p, v, __ATOMIC_RELAXED, __HIP_MEMORY_SCOPE_AGENT); }
__device__ __forceinline__ unsigned xb_xcc_id() { return (unsigned)__builtin_amdgcn_s_getreg((3 << 11) | 20) & 0xFu; }
#define XB_SPIN(cond, bar) do { unsigned _sp = 0; while (cond) { __builtin_amdgcn_s_sleep(1); \
    if ((++_sp & 255u) == 0u) { if (xb_ld(&(bar)[XB_TMO])) break; if (_sp > XB_SPIN_CAP) { atomicAdd(&(bar)[XB_TMO], 1u); break; } } } } while (0)

struct XcdBarrier {
    unsigned* bar; unsigned x;
    volatile LAS unsigned* st;
};

__device__ __forceinline__ XcdBarrier xcd_barrier_post(unsigned* bar, volatile LAS unsigned* st) {
    XcdBarrier b; b.bar = bar; b.x = xb_xcc_id(); b.st = st;
    if (threadIdx.x == 0) (void)xb_add(&bar[XB_XCNT(b.x)], 1u);
    return b;
}
__device__ __forceinline__ void xcd_barrier_complete(unsigned* bar, unsigned x, unsigned& nloc, unsigned& nx) {
    const unsigned G = gridDim.x * gridDim.y * gridDim.z;
    unsigned sum, cnt, mine, sp = 0u;
    for (;;) {
        sum = 0u; cnt = 0u; mine = 0u;
#pragma unroll
        for (unsigned j = 0; j < 16; ++j) { const unsigned c = xb_ld(&bar[XB_XCNT(j)]); sum += c; cnt += (c > 0u) ? 1u : 0u; mine = (j == x) ? c : mine; }
        if (sum == G) break;
        __builtin_amdgcn_s_sleep(1);
        if ((++sp & 255u) == 0u) { if (xb_ld(&bar[XB_TMO])) break; if (sp > XB_SPIN_CAP) { atomicAdd(&bar[XB_TMO], 1u); break; } }
    }
    nloc = mine > 0u ? mine : 1u; nx = cnt > 0u ? cnt : 1u;
}

__device__ __forceinline__ void xcd_barrier(const XcdBarrier& b) {
    asm volatile("s_waitcnt vmcnt(0)" ::: "memory");
    __syncthreads();
    if (threadIdx.x == 0) {
        unsigned* bar = b.bar;
        __builtin_amdgcn_s_waitcnt(0);
        unsigned nloc = b.st[0], nx = b.st[1];
        if (nloc == 0u) { xcd_barrier_complete(bar, b.x, nloc, nx); b.st[0] = nloc; b.st[1] = nx; }
        const unsigned old = xb_add(&bar[XB_XSUB(b.x)], 1u);
        const unsigned gen = old / nloc;
        if (old + 1u == (gen + 1u) * nloc) {
            __builtin_amdgcn_fence(__ATOMIC_RELEASE, "agent");
            asm volatile("s_waitcnt vmcnt(0)" ::: "memory");
            const unsigned og = xb_add(&bar[XB_TOP], 1u);
            const unsigned tg = og / nx;
            if (og + 1u == (tg + 1u) * nx) xb_add(&bar[XB_TOPGEN], 1u);
            else XB_SPIN(xb_ld(&bar[XB_TOPGEN]) == tg, bar);
            __builtin_amdgcn_fence(__ATOMIC_ACQUIRE, "agent");
            xb_add(&bar[XB_XGEN(b.x)], 1u);
            asm volatile("s_waitcnt vmcnt(0)" ::: "memory");
        } else {
            XB_SPIN(xb_ld(&bar[XB_XGEN(b.x)]) == gen, bar);
            __builtin_amdgcn_fence(__ATOMIC_ACQUIRE, "agent");
            asm volatile("s_waitcnt vmcnt(0)" ::: "memory");
        }
    }
    __syncthreads();
}

struct Frame {
    LAS unsigned char* lds;
    int tid, lane, wave;
    int vcu, G;
    int gw, NGW;
    const float* in[25]; float* out; unsigned char* ws;
};
#define WSP(T, off) ((T*)(F.ws + (off)))

__device__ __forceinline__ void gemv17_item(Frame& F, const LAS float* tab, LAS float* red, const float* W, int ldw, int n0, const float* bias, float* outp, int ldo) {
    float acc[17];
#pragma unroll
    for (int r = 0; r < 17; ++r) acc[r] = 0.f;
    const int k0 = F.wave * 128;
    const float* wp = W + (size_t)k0 * ldw + n0 + F.lane;
#pragma unroll 4
    for (int k = 0; k < 128; ++k) {
        const float wv = wp[(size_t)k * ldw];
#pragma unroll
        for (int r = 0; r < 17; ++r) acc[r] += tab[r * 1024 + k0 + k] * wv;
    }
#pragma unroll
    for (int r = 0; r < 17; ++r) red[(F.wave * 17 + r) * 64 + F.lane] = acc[r];
    __syncthreads();
    for (int i = F.tid; i < 17 * 64; i += NWAVES * 64) {
        const int r = i >> 6, n = i & 63; float s = bias ? bias[n0 + n] : 0.f;
#pragma unroll
        for (int w = 0; w < 8; ++w) s += red[(w * 17 + r) * 64 + n];
        outp[(size_t)r * ldo + n0 + n] = s;
    }
    __syncthreads();
}

__device__ __forceinline__ void p0_transpose_item(const float* W, int K, int N, bf16* WT, LAS float* scr, int item, int lane) {
    const int nblk = N / 32, kb = item / nblk, nb = item % nblk, k0 = 64 * kb, n0 = 32 * nb;
#pragma unroll 8
    for (int i = 0; i < 32; ++i) { const int kk = 2 * i + (lane >> 5); scr[kk * 33 + (lane & 31)] = W[(size_t)(k0 + kk) * N + n0 + (lane & 31)]; }
    LDS_WAIT(); asm volatile("" ::: "memory");
    const int c = lane & 7;
#pragma unroll
    for (int j = 0; j < 4; ++j) { const int n = (lane >> 3) + 8 * j; const LAS float* s = scr + (8 * c) * 33 + n;
        v4u o; o.x = pk2(s[0 * 33], s[1 * 33]); o.y = pk2(s[2 * 33], s[3 * 33]); o.z = pk2(s[4 * 33], s[5 * 33]); o.w = pk2(s[6 * 33], s[7 * 33]);
        *(GAS v4u*)(WT + (size_t)(n0 + n) * K + k0 + 8 * c) = o; }
    LDS_WAIT(); asm volatile("" ::: "memory");
}

__device__ __forceinline__ void phase_p0a(Frame& F) {
    LAS float* tab = (LAS float*)(F.lds);
    LAS float* red = (LAS float*)(F.lds + 17 * 1024 * 4);
    float* MOD = WSP(float, WS_MOD);
    bool filled = false;
    for (int it = F.vcu; it < 2 * 96; it += F.G) {
        if (!filled) {
            for (int i = F.tid; i < 17 * 1024; i += NWAVES * 64) { const int r = i >> 10, k = i & 1023; const float v = (r < 16) ? F.in[1][r * D + k] : F.in[3][k]; tab[i] = siluf_(v); }
            __syncthreads(); filled = true;
        }
        const int l = it / 96, n0 = (it % 96) * 64;
        gemv17_item(F, tab, red, F.in[6] + (size_t)l * D * MODW, MODW, n0, F.in[7] + (size_t)l * MODW, MOD + (size_t)l * 17 * MODW, MODW);
    }
    __syncthreads();
    LAS float* scr = (LAS float*)(F.lds + F.wave * 16384);
    constexpr int I_IN = (D / 64) * (IND / 32), I_OUT = (D / 64) * (D / 32), I_1 = (D / 64) * (FF / 32), I_2 = (FF / 64) * (D / 32), I_L = I_IN + I_OUT + I_1 + I_2;
    for (int it = F.gw; it < 2 * I_L; it += F.NGW) {
        const int l = it / I_L; int r = it % I_L;
        if (r < I_IN) { p0_transpose_item(F.in[8] + (size_t)l * D * IND, D, IND, WSP(bf16, WS_WIN) + (size_t)l * IND * D, scr, r, F.lane); continue; } r -= I_IN;
        if (r < I_OUT) { p0_transpose_item(F.in[9] + (size_t)l * D * D, D, D, WSP(bf16, WS_WOUT) + (size_t)l * D * D, scr, r, F.lane); continue; } r -= I_OUT;
        if (r < I_1) { p0_transpose_item(F.in[22] + (size_t)l * D * FF, D, FF, WSP(bf16, WS_W1) + (size_t)l * FF * D, scr, r, F.lane); continue; } r -= I_1;
        p0_transpose_item(F.in[23] + (size_t)l * FF * D, FF, D, WSP(bf16, WS_W2) + (size_t)l * D * FF, scr, r, F.lane);
    }
}

__device__ __forceinline__ void phase_p0b(Frame& F) {
    LAS float* tab = (LAS float*)(F.lds);
    LAS float* red = (LAS float*)(F.lds + 17 * 1024 * 4);
    const float* MOD = WSP(const float, WS_MOD);
    for (int it = F.vcu; it < 2 * 104; it += F.G) {
        const int l = it / 104, j = it % 104; const bool first = j < 40;
        const int shoff = first ? 0 : 3 * D;
        __syncthreads();
        for (int i = F.tid; i < 17 * 1024; i += NWAVES * 64) { const int r = i >> 10, k = i & 1023; tab[i] = MOD[((size_t)l * 17 + r) * MODW + shoff + k]; }
        __syncthreads();
        if (first) gemv17_item(F, tab, red, F.in[8] + (size_t)l * D * IND, IND, j * 64, nullptr, WSP(float, WS_SHW1) + (size_t)l * 17 * IND, IND);
        else gemv17_item(F, tab, red, F.in[22] + (size_t)l * D * FF, FF, (j - 40) * 64, nullptr, WSP(float, WS_SHW2) + (size_t)l * 17 * FF, FF);
    }
    bf16* XA = WSP(bf16, WS_XA); float* RSSA = WSP(float, WS_RSSA);
    const float* g1 = F.in[4];
    for (int row = F.gw; row < MT; row += F.NGW) {
        const bool lat = row < ML;
        const float* xr = lat ? F.in[0] + (size_t)row * D : F.in[2] + (size_t)(row - ML) * D;
        const int brow = lat ? (row >> 11) : NB;
        const float* sc = MOD + (size_t)brow * MODW + D;
        f32x4 v[4]; float ss = 0.f;
#pragma unroll
        for (int j = 0; j < 4; ++j) { v[j] = *(const f32x4*)(xr + 4 * F.lane + 256 * j); ss += (v[j][0] * v[j][0] + v[j][1] * v[j][1]) + (v[j][2] * v[j][2] + v[j][3] * v[j][3]); }
        ss = wave_sum(ss);
        if (F.lane < 32) RSSA[(size_t)row * 32 + F.lane] = (F.lane == 0) ? ss : 0.f;
#pragma unroll
        for (int j = 0; j < 4; ++j) { const int k = 4 * F.lane + 256 * j;
            const f32x4 gm = *(const f32x4*)(g1 + k) * (*(const f32x4*)(sc + k) + 1.0f), a = v[j] * gm;
            v2u o; o.x = pk2(a[0], a[1]); o.y = pk2(a[2], a[3]); *(v2u*)(XA + (size_t)row * D + k) = o; }
    }
}

__device__ __forceinline__ void conv_row(Frame& F, int l, int row) {
    const bf16* PROJ = WSP(const bf16, WS_PROJ); bf16* MIX = WSP(bf16, WS_MIX);
    const float* cw = F.in[10] + (size_t)l * 31 * 256; const float* cb = F.in[11] + l * 256; const float* lg = F.in[12] + l * 256; const float* lb = F.in[13] + l * 256;
    int lo, hi; if (row < ML) { lo = row & ~(SEQ - 1); hi = lo + SEQ; } else { lo = row & ~(CTXL - 1); hi = lo + CTXL; }
    const int c0 = 4 * F.lane;
    f32x4 acc = *(const f32x4*)(cb + c0);
    for (int k = 0; k < 31; ++k) {
        const int rr = row + k - 15;
        if (rr >= lo && rr < hi) {
            const v2u vv = *(const v2u*)(PROJ + (size_t)rr * IND + c0), gg = *(const v2u*)(PROJ + (size_t)rr * IND + 256 + c0);
            const f32x4 w = *(const f32x4*)(cw + k * 256 + c0);
            acc[0] += w[0] * bflo(vv.x) * sigmoidf_(bflo(gg.x)); acc[1] += w[1] * bfhi(vv.x) * sigmoidf_(bfhi(gg.x));
            acc[2] += w[2] * bflo(vv.y) * sigmoidf_(bflo(gg.y)); acc[3] += w[3] * bfhi(vv.y) * sigmoidf_(bfhi(gg.y));
        }
    }
    const float mu = wave_sum((acc[0] + acc[1]) + (acc[2] + acc[3])) * (1.f / 256.f);
    const f32x4 d = acc - mu;
    const float var = wave_sum((d[0] * d[0] + d[1] * d[1]) + (d[2] * d[2] + d[3] * d[3])) * (1.f / 256.f);
    const f32x4 y = d * rsqrtf(var + EPS) * *(const f32x4*)(lg + c0) + *(const f32x4*)(lb + c0);
    v2u o; o.x = pk2(siluf_(y[0]), siluf_(y[1])); o.y = pk2(siluf_(y[2]), siluf_(y[3]));
    *(v2u*)(MIX + (size_t)row * D + c0) = o;
}

typedef short s16x8 __attribute__((ext_vector_type(8)));
typedef short s16x4 __attribute__((ext_vector_type(4)));
constexpr int NA_VROW = 160;
constexpr int NA_WLDS = 64 * NA_VROW + 2560;
constexpr int NA_ITEMS_LAT = NB * NH * 32 * 4, NA_ITEMS_CTX = NB * NH * 16;
__device__ __forceinline__ void na_item(Frame& F, int l, int it) {
    const bf16* PROJ = WSP(const bf16, WS_PROJ); bf16* MIX = WSP(bf16, WS_MIX);
    LAS unsigned char* wl = F.lds + F.wave * NA_WLDS;
    LAS float* tb = (LAS float*)(wl + 64 * NA_VROW);
    const int lane = F.lane, q16 = lane & 15, g = lane >> 4;
    const bool isctx = it >= NA_ITEMS_LAT;
    int b, h, r = 0, jq = 0, qrow0;
    if (!isctx) { jq = it & 3; r = (it >> 2) & 31; h = (it >> 7) & 7; b = it >> 10; qrow0 = b * SEQ + r * 64 + jq * 16; }
    else { const int j = it - NA_ITEMS_LAT; const int qb = j & 15; h = (j >> 4) & 7; b = j >> 7; qrow0 = ML + b * CTXL + qb * 16; }
    const bf16* Pq = PROJ + 512 + h * HD, * Pk = PROJ + 1024 + h * HD, * Pv = PROJ + 1536 + h * HD;
    s16x8 qf[2];
#pragma unroll
    for (int s = 0; s < 2; ++s) qf[s] = *(const s16x8*)(Pq + (size_t)(qrow0 + q16) * IND + 32 * s + 8 * g);
    int rs = r - 4; rs = rs < 0 ? 0 : (rs > 24 ? 24 : rs);
    const int tlo = jq < 2 ? 0 : jq - 1, thi = jq > 1 ? 3 : jq + 1;
    float madd[4][4];
    int lb;
    {
        const int qc = jq * 16 + q16; int cs = qc - 8; cs = cs < 0 ? 0 : (cs > 48 ? 48 : cs);
#pragma unroll
        for (int t = 0; t < 4; ++t)
#pragma unroll
            for (int e = 0; e < 4; ++e) madd[t][e] = ((unsigned)(16 * t + 4 * g + e - cs) < 16u) ? 0.f : -1.0e30f;
        lb = 64 + 4 * g - qc + 15;
    }
    if (!isctx) {
        const float* rpb = F.in[14] + ((size_t)l * NH + h) * 15 * 31;
        for (int i = lane; i < 640; i += 64) tb[i] = 0.f;
        for (int i = lane; i < 465; i += 64) tb[64 + i] = rpb[i] * 1.4426950408889634f;
    }
    const float c1 = 0.125f * 1.4426950408889634f;
    f32x4 O[4];
#pragma unroll
    for (int dt = 0; dt < 4; ++dt) O[dt] = (f32x4){0.f, 0.f, 0.f, 0.f};
    float m = -1.0e30f, lsum = 0.f;
    const int nch = isctx ? 4 : 12, nloc = isctx ? 0 : 8;
    const unsigned vld_key = (unsigned)(lane >> 3), vld_part = (unsigned)(lane & 7);
    LAS unsigned char* vst = wl + vld_key * NA_VROW + vld_part * 16;
    const LAS unsigned char* vtr = wl + (4 * g + (q16 >> 2)) * NA_VROW + (q16 & 3) * 8;
    auto krow_of = [&](int ch) -> int { return ch < nloc ? b * SEQ + (rs + ch) * 64 : ML + b * CTXL + (ch - nloc) * 64; };
    s16x8 kf[4][2]; v4u vr[8];
    {
        const int k0 = krow_of(0);
#pragma unroll
        for (int t = 0; t < 4; ++t) if (nloc == 0 || (t >= tlo && t <= thi)) {
#pragma unroll
            for (int s = 0; s < 2; ++s) kf[t][s] = *(const s16x8*)(Pk + (size_t)(k0 + 16 * t + q16) * IND + 32 * s + 8 * g); }
#pragma unroll
        for (int i = 0; i < 8; ++i) vr[i] = *(const v4u*)(Pv + (size_t)(k0 + (int)vld_key + 8 * i) * IND + 8 * vld_part);
    }
    for (int ch = 0; ch < nch; ++ch) {
        const bool local = ch < nloc;
#pragma unroll
        for (int i = 0; i < 8; ++i) *(LAS v4u*)(vst + i * 8 * NA_VROW) = vr[i];
        f32x4 S[4];
#pragma unroll
        for (int t = 0; t < 4; ++t) { S[t] = (f32x4){0.f, 0.f, 0.f, 0.f};
            if (!local || (t >= tlo && t <= thi)) {
#pragma unroll
                for (int s = 0; s < 2; ++s) S[t] = __builtin_amdgcn_mfma_f32_16x16x32_bf16(kf[t][s], qf[s], S[t], 0, 0, 0); } }
        if (ch + 1 < nch) {
            const int k1 = krow_of(ch + 1); const bool nlocal = ch + 1 < nloc;
#pragma unroll
            for (int t = 0; t < 4; ++t) if (!nlocal || (t >= tlo && t <= thi)) {
#pragma unroll
                for (int s = 0; s < 2; ++s) kf[t][s] = *(const s16x8*)(Pk + (size_t)(k1 + 16 * t + q16) * IND + 32 * s + 8 * g); }
#pragma unroll
            for (int i = 0; i < 8; ++i) vr[i] = *(const v4u*)(Pv + (size_t)(k1 + (int)vld_key + 8 * i) * IND + 8 * vld_part);
        }
        float cm = -1.0e30f;
        if (local) {
            const LAS float* tr_ = tb + (rs + ch - r + 7) * 31 + lb;
#pragma unroll
            for (int t = 0; t < 4; ++t) if (t >= tlo && t <= thi) {
#pragma unroll
                for (int e = 0; e < 4; ++e) { const float v = S[t][e] * c1 + tr_[16 * t + e] + madd[t][e]; S[t][e] = v; cm = fmaxf(cm, v); } }
        } else {
#pragma unroll
            for (int t = 0; t < 4; ++t)
#pragma unroll
                for (int e = 0; e < 4; ++e) { const float v = S[t][e] * c1; S[t][e] = v; cm = fmaxf(cm, v); }
        }
        cm = fmaxf(cm, __shfl_xor(cm, 16)); cm = fmaxf(cm, __shfl_xor(cm, 32));
        const float mn = fmaxf(m, cm), alpha = __builtin_amdgcn_exp2f(m - mn); m = mn;
        float ps = 0.f;
        unsigned pk[4][2];
#pragma unroll
        for (int t = 0; t < 4; ++t) {
            if (!local || (t >= tlo && t <= thi)) {
                const float p0 = __builtin_amdgcn_exp2f(S[t][0] - mn), p1 = __builtin_amdgcn_exp2f(S[t][1] - mn), p2 = __builtin_amdgcn_exp2f(S[t][2] - mn), p3 = __builtin_amdgcn_exp2f(S[t][3] - mn);
                ps += (p0 + p1) + (p2 + p3);
                pk[t][0] = pg8::cvt_pk_bf16(p0, p1); pk[t][1] = pg8::cvt_pk_bf16(p2, p3);
            } else { pk[t][0] = 0u; pk[t][1] = 0u; }
        }
        lsum = lsum * alpha + ps;
#pragma unroll
        for (int dt = 0; dt < 4; ++dt) O[dt] = O[dt] * alpha;
#pragma unroll
        for (int p = 0; p < 2; ++p) {
            if (!local || (2 * p <= thi && 2 * p + 1 >= tlo)) {
                const v4u bw = {pk[2 * p][0], pk[2 * p][1], pk[2 * p + 1][0], pk[2 * p + 1][1]};
                const s16x8 bfrag = __builtin_bit_cast(s16x8, bw);
#pragma unroll
                for (int dt = 0; dt < 4; ++dt) {
                    const s16x4 a0 = __builtin_amdgcn_ds_read_tr16_b64_v4i16((LAS s16x4*)(vtr + (2 * p) * 16 * NA_VROW + dt * 32));
                    const s16x4 a1 = __builtin_amdgcn_ds_read_tr16_b64_v4i16((LAS s16x4*)(vtr + (2 * p + 1) * 16 * NA_VROW + dt * 32));
                    const s16x8 afrag = __builtin_shufflevector(a0, a1, 0, 1, 2, 3, 4, 5, 6, 7);
                    O[dt] = __builtin_amdgcn_mfma_f32_16x16x32_bf16(afrag, bfrag, O[dt], 0, 0, 0);
                }
            }
        }
    }
    lsum += __shfl_xor(lsum, 16); lsum += __shfl_xor(lsum, 32);
    const float inv = 1.f / lsum;
    bf16* op = MIX + (size_t)(qrow0 + q16) * D + 256 + h * HD + 4 * g;
#pragma unroll
    for (int dt = 0; dt < 4; ++dt) { v2u w; w.x = pg8::cvt_pk_bf16(O[dt][0] * inv, O[dt][1] * inv); w.y = pg8::cvt_pk_bf16(O[dt][2] * inv, O[dt][3] * inv); *(v2u*)(op + 16 * dt) = w; }
}

template <int PASS>
__device__ __forceinline__ void lru_tile(Frame& F, int l, int T) {
    const bf16* PROJ = WSP(const bf16, WS_PROJ);
    LAS unsigned* rxs = (LAS unsigned*)(F.lds);
    LAS float* ucs = (LAS float*)(F.lds + 38 * 128 * 4);
    LAS float* hs = (LAS float*)(F.lds + 38 * 128 * 4 + 65536);
    const int row0 = T * 32;
    int lo, hi; if (row0 < ML) { lo = row0 & ~(SEQ - 1); hi = lo + SEQ; } else { lo = row0 & ~(CTXL - 1); hi = lo + CTXL; }
    __syncthreads();
    for (int i = F.tid; i < 38 * 128; i += NWAVES * 64) { const int rr = i >> 7, cp = i & 127, row = row0 - 3 + rr;
        rxs[i] = (row >= lo && row < hi) ? *(const unsigned*)(PROJ + (size_t)row * IND + 2048 + 2 * cp) : 0u; }
    if (PASS == 1) for (int i = F.tid; i < 32 * 256; i += NWAVES * 64) hs[i] = 0.f;
    __syncthreads();
    const int dir = F.tid >> 8, c = F.tid & 255;
    {
        const float* cw = F.in[15] + ((size_t)(l * 2 + dir) * 4) * 256 + c; const float cbv = F.in[16][(l * 2 + dir) * 256 + c];
        const float w0 = cw[0], w1 = cw[256], w2 = cw[512], w3 = cw[768];
        const LAS bf16* rx = (const LAS bf16*)rxs;
        const int base = dir == 0 ? 0 : 3;
        for (int t = 0; t < 32; ++t) {
            const float u = cbv + w0 * bf1(rx[(t + base + 0) * 256 + c]) + w1 * bf1(rx[(t + base + 1) * 256 + c]) + w2 * bf1(rx[(t + base + 2) * 256 + c]) + w3 * bf1(rx[(t + base + 3) * 256 + c]);
            ucs[(dir * 32 + t) * 256 + c] = u;
        }
    }
    __syncthreads();
    const int kb = c >> 6, ee = c & 63;
    float zx[32], za[32];
    {
        const float bxv = F.in[18][(l * 2 + dir) * 256 + c], bav = F.in[20][(l * 2 + dir) * 256 + c];
#pragma unroll
        for (int tt = 0; tt < 32; ++tt) { zx[tt] = bxv; za[tt] = bav; }
        const float* wx = F.in[17] + (((size_t)(l * 2 + dir) * 4 + kb) * 64) * 64 + ee; const float* wa = F.in[19] + (((size_t)(l * 2 + dir) * 4 + kb) * 64) * 64 + ee;
        const LAS float* ub = ucs + (dir * 32 + (dir == 0 ? 0 : 31)) * 256 + kb * 64;
        const int tstep = dir == 0 ? 256 : -256;
#pragma unroll 2
        for (int d = 0; d < 64; ++d) {
            const float wxv = wx[d * 64], wav = wa[d * 64];
#pragma unroll
            for (int tt = 0; tt < 32; ++tt) { const float u = ub[tt * tstep + d]; zx[tt] += u * wxv; za[tt] += u * wav; }
        }
    }
    const float nl = -F.in[21][(l * 2 + dir) * 256 + c];
    const float sp8 = -8.f * (fmaxf(nl, 0.f) + log1pf(__expf(-fabsf(nl))));
    float h = 0.f, P = 1.f;
    if (PASS == 1) h = WSP(const float, WS_CARRY)[((size_t)dir * 1152 + T) * 256 + c];
    {
        const LAS float* uo = ucs + (dir * 32 + (dir == 0 ? 0 : 31)) * 256 + c;
        LAS float* ho = hs + (dir == 0 ? 0 : 31) * 256 + c;
        const int tstep = dir == 0 ? 256 : -256;
#pragma unroll
        for (int tt = 0; tt < 32; ++tt) {
            const float gx = sigmoidf_(zx[tt]), ga = sigmoidf_(za[tt]);
            const float log_a = sp8 * ga;
            const float a = __expf(log_a);
            const float coef = sqrtf(-expm1f(2.f * log_a));
            h = a * h + coef * gx * uo[tt * tstep];
            if (PASS == 0) P *= a; else __hip_atomic_fetch_add(ho + tt * tstep, h, __ATOMIC_RELAXED, __HIP_MEMORY_SCOPE_WORKGROUP);
        }
    }
    if (PASS == 0) { WSP(f32x2, WS_TOT)[((size_t)dir * 1152 + T) * 256 + c] = (f32x2){P, h}; }
    else {
        __syncthreads();
        bf16* MIX = WSP(bf16, WS_MIX);
        for (int i = F.tid; i < 32 * 128; i += NWAVES * 64) { const int t = i >> 7, cp = i & 127; const size_t row = (size_t)row0 + t;
            const unsigned gw = *(const unsigned*)(PROJ + row * IND + 2304 + 2 * cp);
            *(unsigned*)(MIX + row * D + 768 + 2 * cp) = pk2(gelu_tanh(bflo(gw)) * hs[t * 256 + 2 * cp], gelu_tanh(bfhi(gw)) * hs[t * 256 + 2 * cp + 1]); }
    }
}
__device__ __forceinline__ void lru_carry(Frame& F) {
    const f32x2* TOT = WSP(const f32x2, WS_TOT); float* CARRY = WSP(float, WS_CARRY);
    for (int it = F.gw; it < NB * 2 * 4; it += F.NGW) {
        const int b = it >> 3, dir = (it >> 2) & 1, c = (it & 3) * 64 + F.lane;
        float h = 0.f;
        for (int g = 0; g < 9; ++g) {
            f32x2 ps[8]; int tl[8];
#pragma unroll
            for (int i = 0; i < 8; ++i) { const int s = g * 8 + i;
                int T; if (s < 8) T = 1024 + b * 8 + (dir == 0 ? s : 7 - s); else T = b * 64 + (dir == 0 ? s - 8 : 71 - s);
                tl[i] = T; ps[i] = TOT[((size_t)dir * 1152 + T) * 256 + c]; }
#pragma unroll
            for (int i = 0; i < 8; ++i) { CARRY[((size_t)dir * 1152 + tl[i]) * 256 + c] = h; h = ps[i][0] * h + ps[i][1]; }
        }
    }
}

__device__ __forceinline__ void final_rows(Frame& F) {
    const float* g = F.in[24];
    for (int row = F.gw; row < ML; row += F.NGW) {
        float* xr = F.out + (size_t)row * D;
        f32x4 v[4]; float ss = 0.f;
#pragma unroll
        for (int j = 0; j < 4; ++j) { v[j] = *(const f32x4*)(xr + 4 * F.lane + 256 * j); ss += (v[j][0] * v[j][0] + v[j][1] * v[j][1]) + (v[j][2] * v[j][2] + v[j][3] * v[j][3]); }
        const float rs = rsqrtf(wave_sum(ss) * (1.f / D) + EPS);
#pragma unroll
        for (int j = 0; j < 4; ++j) { const int k = 4 * F.lane + 256 * j; *(f32x4*)(xr + k) = v[j] * rs * *(const f32x4*)(g + k); }
    }
}

constexpr int N_PHASES = 2 + 7 * DEPTH + 1;
struct Args { const float* in[25]; float* out; unsigned char* ws; int ph_lo, ph_hi; };
static_assert(sizeof(Args) == 27 * 8 + 8, "Args has no padding");

__global__ void __launch_bounds__(NWAVES * 64, 2) mega_fwd(Args args) {
    extern __shared__ __attribute__((aligned(16))) unsigned char lds[];
    Frame F;
    F.lds = (LAS unsigned char*)lds;
    F.tid = threadIdx.x; F.lane = F.tid & 63; F.wave = __builtin_amdgcn_readfirstlane(F.tid >> 6);
    F.G = gridDim.x; { const int bx = blockIdx.x; F.vcu = (F.G % 8 == 0) ? (bx % 8) * (F.G / 8) + bx / 8 : bx; }
    F.gw = F.vcu * NWAVES + F.wave; F.NGW = F.G * NWAVES;
#pragma unroll
    for (int i = 0; i < 25; ++i) F.in[i] = args.in[i];
    F.out = args.out; F.ws = args.ws;
    volatile LAS unsigned* MISC = (volatile LAS unsigned*)(F.lds + MISC_OFF);
    for (int u = F.tid; u < (LDS_BYTES - LDSCTL_OFF) / 4; u += NWAVES * 64) ((LAS unsigned*)(F.lds + LDSCTL_OFF))[u] = 0u;
    __syncthreads();
    XcdBarrier bar = xcd_barrier_post((unsigned*)(F.ws + WS_CTL) + CW_BAR, MISC + 8);

    const int lo = args.ph_lo, hi = args.ph_hi;
    for (int ph = lo; ph < hi; ++ph) {
        { int t_ = threadIdx.x; asm volatile("" : "+v"(t_)); F.tid = t_; F.lane = t_ & 63; F.wave = __builtin_amdgcn_readfirstlane(t_ >> 6); F.gw = F.vcu * NWAVES + F.wave; }
        if (ph == 0) {
#ifndef NO_P0
            phase_p0a(F);
#endif
        } else if (ph == 1) {
#ifndef NO_P0
            phase_p0b(F);
#endif
        }
        else if (ph == N_PHASES - 1) final_rows(F);
        else {
            const int l = (ph - 2) / 7, k = (ph - 2) % 7; const bool last = (l == DEPTH - 1);
            const int Mx = last ? ML : MT;
            float* MOD = WSP(float, WS_MOD);
            if (k == 0) {
                pg8::Gemm g{WSP(const bf16, WS_XA), WSP(const bf16, WS_WIN) + (size_t)l * IND * D, MT, IND, D};
                pg8::Order S; if (last) S.init(ML, IND, (MC / 256) * 5, F.G, (int)blockIdx.x); else S.init(MT, IND, 0, F.G, (int)blockIdx.x);
                pg8::EpiScale<0, IND> E{WSP(bf16, WS_PROJ), WSP(const float, WS_SHW1) + (size_t)l * 17 * IND, WSP(const float, WS_RSSA)};

#ifndef NO_G0
                pg8::gemm_phase<pg8::EpiScale<0, IND>, pg8::Order, true, true>(F.lds + RING_OFF, g, S, E, F.tid);
#endif

            } else if (k == 1) {

#ifndef NO_LRU
                for (int T = F.vcu; T < 1152; T += F.G) lru_tile<0>(F, l, T);
#endif

                __syncthreads();
                const int nrows = last ? ML : MT;

#ifndef NO_CONV
                for (int row = F.gw; row < nrows; row += F.NGW) conv_row(F, l, row);
#endif

                const int nna = last ? NA_ITEMS_LAT : NA_ITEMS_LAT + NA_ITEMS_CTX;

#ifndef NO_NA
                for (int it = F.gw; it < nna; it += F.NGW) na_item(F, l, it);
#endif

            } else if (k == 2) {
                lru_carry(F);
            } else if (k == 3) {

#ifndef NO_LRU
                for (int T = F.vcu; T < (last ? 1024 : 1152); T += F.G) lru_tile<1>(F, l, T);
#endif

            } else if (k == 4) {
                pg8::Gemm g{WSP(const bf16, WS_MIX), WSP(const bf16, WS_WOUT) + (size_t)l * D * D, Mx, D, D};
                pg8::Order S; S.init(Mx, D, 0, F.G, (int)blockIdx.x);
                pg8::EpiRes E{l == 0 ? F.in[0] : F.out, l == 0 ? F.in[2] : WSP(const float, WS_CX), F.out, WSP(float, WS_CX),
                              MOD + (size_t)l * 17 * MODW + 2 * D, F.in[5] + l * D, MOD + (size_t)l * 17 * MODW + 4 * D, WSP(bf16, WS_XA), WSP(float, WS_RSSB)};

#ifndef NO_GR
                pg8::gemm_phase<pg8::EpiRes, pg8::Order, true, true>(F.lds + RING_OFF, g, S, E, F.tid);
#endif

            } else if (k == 5) {
                pg8::Gemm g{WSP(const bf16, WS_XA), WSP(const bf16, WS_W1) + (size_t)l * FF * D, Mx, FF, D};
                pg8::Order S; S.init(Mx, FF, 0, F.G, (int)blockIdx.x);
                pg8::EpiScale<1, FF> E{WSP(bf16, WS_HID), WSP(const float, WS_SHW2) + (size_t)l * 17 * FF, WSP(const float, WS_RSSB)};

#ifndef NO_G1
                pg8::gemm_phase<pg8::EpiScale<1, FF>, pg8::Order, true, true>(F.lds + RING_OFF, g, S, E, F.tid);
#endif

            } else {
                pg8::Gemm g{WSP(const bf16, WS_HID), WSP(const bf16, WS_W2) + (size_t)l * D * FF, Mx, D, FF};
                pg8::Order S; S.init(Mx, D, 0, F.G, (int)blockIdx.x);
                const int ln = last ? l : l + 1;
                pg8::EpiRes E{F.out, WSP(const float, WS_CX), F.out, WSP(float, WS_CX),
                              MOD + (size_t)l * 17 * MODW + 5 * D, F.in[4] + ln * D, MOD + (size_t)ln * 17 * MODW + D, last ? (bf16*)nullptr : WSP(bf16, WS_XA), WSP(float, WS_RSSA)};

#ifndef NO_GR
                pg8::gemm_phase<pg8::EpiRes, pg8::Order, true, true>(F.lds + RING_OFF, g, S, E, F.tid);
#endif

            }
        }
        if (ph + 1 < hi) xcd_barrier(bar);
    }
}

extern "C" void kernel_launch(void* const* d_in, const int* in_sizes, int n_in, void* d_out, int out_size, void* d_ws, size_t ws_size, hipStream_t stream) {
    static int grid = 0;
    if (grid == 0) {
        if (n_in != 25 || out_size != ML * D || ws_size < WS_END) { fprintf(stderr, "kernel_launch: unexpected shapes (n_in %d out %d ws %zu)\n", n_in, out_size, ws_size); grid = -1; return; }
        int dev = 0, cus = 0;
        if (hipGetDevice(&dev) != hipSuccess || hipDeviceGetAttribute(&cus, hipDeviceAttributeMultiprocessorCount, dev) != hipSuccess) { grid = -1; return; }
        if (hipFuncSetAttribute((const void*)mega_fwd, hipFuncAttributeMaxDynamicSharedMemorySize, LDS_BYTES) != hipSuccess) { fprintf(stderr, "kernel_launch: hipFuncSetAttribute failed\n"); grid = -1; return; }
        int per_cu = 0;
        if (hipOccupancyMaxActiveBlocksPerMultiprocessor(&per_cu, (const void*)mega_fwd, NWAVES * 64, LDS_BYTES) != hipSuccess || per_cu < 1) fprintf(stderr, "kernel_launch: occupancy query reports %d\n", per_cu);
        (void)hipGetLastError();
        grid = cus;
    }
    if (grid < 0) return;
    if (hipMemsetAsync((char*)d_ws + WS_CTL, 0, CTL_ZERO_BYTES, stream) != hipSuccess) return;
    Args a{};
    for (int i = 0; i < 25; ++i) a.in[i] = (const float*)d_in[i];
    a.out = (float*)d_out; a.ws = (unsigned char*)d_ws;
#if MK_N_LAUNCHES == 1
    a.ph_lo = 0; a.ph_hi = N_PHASES;
    hipLaunchKernelGGL(mega_fwd, dim3(grid), dim3(NWAVES * 64), LDS_BYTES, stream, a);
#else
    for (int ph = 0; ph < N_PHASES; ++ph) { a.ph_lo = ph; a.ph_hi = ph + 1; hipLaunchKernelGGL(mega_fwd, dim3(grid), dim3(NWAVES * 64), LDS_BYTES, stream, a); }
#endif
}
```

```cpp
#include <hip/hip_runtime.h>
#include <cstdio>
#include <cstdint>

constexpr int D = 1024, NB = 16, SEQ = 2048, CTXL = 256, DEPTH = 2;
constexpr int ML = NB * SEQ, MC = NB * CTXL, MT = ML + MC;
constexpr int IND = 2560, FF = 4096, NH = 8, HD = 64;
constexpr int MODW = 6 * D;
constexpr float EPS = 1e-6f;
#ifndef MK_N_LAUNCHES
#define MK_N_LAUNCHES 1
#endif

namespace pg8 {
#define PG8_LAS __attribute__((address_space(3)))
typedef unsigned short bf16_t;
typedef short bf16x8 __attribute__((ext_vector_type(8)));
typedef float f32x4 __attribute__((ext_vector_type(4)));
typedef unsigned u32x4 __attribute__((ext_vector_type(4)));
constexpr int BM = 256, BK = 64, HALF = 128, HTB = HALF * BK * 2, STAGE_BYTES = 8 * HTB, NXCD = 8, WGM = 8;

__host__ __device__ __forceinline__ int lds_byte(int r, int c) { const int st = (r >> 4) * 2 + (c >> 5), rr = r & 15, cc = c & 31, ob = rr * 64 + cc * 2; return st * 1024 + (ob ^ (((ob >> 9) & 1) << 5)); }
__host__ __device__ __forceinline__ void stage_rc(int b, int& R, int& C) { const int st = b / 1024, sb = b % 1024, swz = sb ^ (((sb >> 9) & 1) << 5); R = (st >> 1) * 16 + swz / 64; C = (st & 1) * 32 + (swz % 64) / 2; }
__host__ __device__ __forceinline__ int perm32(int rho) { const int n = rho >> 4, i = rho & 15; return 8 * (i >> 2) + 4 * n + (i & 3); }

struct Unit { int pm, pn; };
struct Gemm { const bf16_t* A; const bf16_t* Bt; int M, N, K; };

__host__ __device__ __forceinline__ void map_tile(int wgid, int nM, int nN, Unit& u) {
    const int nwg = nM * nN;
    { const int q = nwg / NXCD, r = nwg % NXCD, xcd = wgid % NXCD, off = wgid / NXCD; wgid = (xcd < r ? xcd * (q + 1) : r * (q + 1) + (xcd - r) * q) + off; }
    const int nig = WGM * nN, gid = wgid / nig, fm = gid * WGM, gsz = (nM - fm) < WGM ? (nM - fm) : WGM;
    u.pm = fm + ((wgid % nig) % gsz); u.pn = (wgid % nig) / gsz;
}
struct Order {
    int nM, nN, nwg, extra, G, c;
    __host__ __device__ void init(int M, int N, int extra_, int G_, int c_) { nM = M / BM; nN = N / BM; nwg = nM * nN; extra = extra_; G = G_; c = c_; }
    __host__ __device__ bool next(int i, Unit& u) const {
        const long L = (long)i * G + c;
        if (L < nwg) { map_tile((int)L, nM, nN, u); return true; }
        if (L < nwg + extra) { const int q = (int)L - nwg; u.pm = nM + q / 5; u.pn = 4 + q % 5; return true; }
        return false;
    }
    __device__ __forceinline__ void a_ready(const Unit&) const {}
    __device__ __forceinline__ void done(const Unit&) const {}
};

__device__ __forceinline__ unsigned cvt_pk_bf16(float lo, float hi) { unsigned r; asm volatile("v_cvt_pk_bf16_f32 %0, %1, %2" : "=v"(r) : "v"(lo), "v"(hi)); return r; }

__device__ __forceinline__ float row_rs(const float* RSSt, unsigned roff, int fq) {
    const f32x4 p0 = *(const f32x4*)(RSSt + (roff + 8u * (unsigned)fq)), p1 = *(const f32x4*)(RSSt + (roff + 8u * (unsigned)fq + 4u));
    float s = ((p0[0] + p0[1]) + (p0[2] + p0[3])) + ((p1[0] + p1[1]) + (p1[2] + p1[3]));
    s += __shfl_xor(s, 16); s += __shfl_xor(s, 32);
    return rsqrtf(s * (1.0f / D) + EPS);
}
template <int ACT, int LDC> struct EpiScale {
    static constexpr bool PERM = true, AFTER_DRAIN = false;
    bf16_t* O; const float* shw; const float* RSS;
    __device__ __forceinline__ void operator()(const f32x4 (&acc)[2][2][4][2], const Unit& u, int wr, int wc, int fr, int fq) const {
        const int brow = u.pm < ML / BM ? (u.pm >> 3) : NB;
        const float* sp = shw + (size_t)brow * LDC + u.pn * BM;
        bf16_t* Ot = O + (size_t)u.pm * BM * LDC + u.pn * BM;
        const float* RSSt = RSS + (size_t)u.pm * BM * 32;
        unsigned cl = (unsigned)(wc * 32 + 8 * fq);
        unsigned rl0 = (unsigned)(wr * 64 + fr);
        asm volatile("" : "+v"(cl), "+v"(rl0));
#pragma unroll
        for (int bj = 0; bj < 2; ++bj) {
            const f32x4 s0 = *(const f32x4*)(sp + (cl + (unsigned)(bj * HALF))), s1 = *(const f32x4*)(sp + (cl + (unsigned)(bj * HALF + 4)));
#pragma unroll
            for (int ai = 0; ai < 2; ++ai)
#pragma unroll
                for (int m = 0; m < 4; ++m) {
                    const float rs = row_rs(RSSt, (rl0 + (unsigned)(ai * HALF + m * 16)) * 32u, fq);
                    f32x4 v0 = acc[ai][bj][m][0] * rs + s0, v1 = acc[ai][bj][m][1] * rs + s1;
                    if (ACT == 1) {
#pragma unroll
                        for (int e = 0; e < 4; ++e) { const float a = fmaxf(v0[e], 0.f), b = fmaxf(v1[e], 0.f); v0[e] = a * a; v1[e] = b * b; }
                    }
                    u32x4 w; w.x = cvt_pk_bf16(v0[0], v0[1]); w.y = cvt_pk_bf16(v0[2], v0[3]); w.z = cvt_pk_bf16(v1[0], v1[1]); w.w = cvt_pk_bf16(v1[2], v1[3]);
                    *(u32x4*)(Ot + ((rl0 + (unsigned)(ai * HALF + m * 16)) * (unsigned)LDC + cl + (unsigned)(bj * HALF))) = w;
                }
        }
    }
};
struct EpiRes {
    static constexpr bool PERM = true, AFTER_DRAIN = false;
    const float* src_lat; const float* src_ctx; float* dst_lat; float* dst_ctx;
    const float* gate;
    const float* gmg; const float* gmsc;
    bf16_t* XA; float* RSS;
    __device__ __forceinline__ void operator()(const f32x4 (&acc)[2][2][4][2], const Unit& u, int wr, int wc, int fr, int fq) const {
        const bool lat = u.pm < ML / BM;
        const int brow = lat ? (u.pm >> 3) : NB;
        const float* src = (lat ? src_lat + (size_t)u.pm * BM * D : src_ctx + (size_t)(u.pm - ML / BM) * BM * D) + u.pn * BM;
        float* dst = (lat ? dst_lat + (size_t)u.pm * BM * D : dst_ctx + (size_t)(u.pm - ML / BM) * BM * D) + u.pn * BM;
        const float* gt = gate + (size_t)brow * MODW + u.pn * BM;
        const float* gg = gmg + u.pn * BM;
        const float* gs = gmsc + (size_t)brow * MODW + u.pn * BM;
        bf16_t* XAt = XA + (size_t)u.pm * BM * D + u.pn * BM;
        float* RSSt = RSS + (size_t)u.pm * BM * 32 + u.pn * 8 + wc;
        unsigned cl = (unsigned)(wc * 32 + 8 * fq);
        unsigned rl0 = (unsigned)(wr * 64 + fr);
        asm volatile("" : "+v"(cl), "+v"(rl0));
        const bool hasxa = XA != nullptr;
#pragma unroll
        for (int bj = 0; bj < 2; ++bj) {
            const unsigned c = cl + (unsigned)(bj * HALF);
            const f32x4 g0 = *(const f32x4*)(gt + c), g1 = *(const f32x4*)(gt + (c + 4u));
            f32x4 m0 = {0.f, 0.f, 0.f, 0.f}, m1 = {0.f, 0.f, 0.f, 0.f};
            if (hasxa) { m0 = *(const f32x4*)(gg + c) * (*(const f32x4*)(gs + c) + 1.0f); m1 = *(const f32x4*)(gg + (c + 4u)) * (*(const f32x4*)(gs + (c + 4u)) + 1.0f); }
#pragma unroll
            for (int ai = 0; ai < 2; ++ai)
#pragma unroll
                for (int m = 0; m < 4; ++m) {
                    const unsigned rl = rl0 + (unsigned)(ai * HALF + m * 16);
                    const unsigned off = rl * (unsigned)D + c;
                    const f32x4 x0 = *(const f32x4*)(src + off), x1 = *(const f32x4*)(src + (off + 4u));
                    const f32x4 y0 = x0 + g0 * acc[ai][bj][m][0], y1 = x1 + g1 * acc[ai][bj][m][1];
                    *(f32x4*)(dst + off) = y0; *(f32x4*)(dst + (off + 4u)) = y1;
                    float ss = ((y0[0] * y0[0] + y0[1] * y0[1]) + (y0[2] * y0[2] + y0[3] * y0[3])) + ((y1[0] * y1[0] + y1[1] * y1[1]) + (y1[2] * y1[2] + y1[3] * y1[3]));
                    ss += __shfl_xor(ss, 16); ss += __shfl_xor(ss, 32);
                    if (fq == 0) RSSt[rl * 32u + (unsigned)(bj * 4)] = ss;
                    if (hasxa) { const f32x4 a0 = y0 * m0, a1 = y1 * m1;
                        u32x4 w; w.x = cvt_pk_bf16(a0[0], a0[1]); w.y = cvt_pk_bf16(a0[2], a0[3]); w.z = cvt_pk_bf16(a1[0], a1[1]); w.w = cvt_pk_bf16(a1[2], a1[3]);
                        *(u32x4*)(XAt + off) = w; }
                    asm volatile("" ::: "memory");
                }
        }
    }
};

template <class Epi, class Sched, bool ALIGN_EPI = false, bool SP2 = false>
__device__ __forceinline__ void gemm_phase(PG8_LAS unsigned char* lds, const Gemm g, const Sched& S, const Epi& E, const int tid) {
    const int wid = __builtin_amdgcn_readfirstlane(tid >> 6), lane = tid & 63, wr = wid >> 2, wc = wid & 3, fr = lane & 15, fq = lane >> 4;
    const int K = g.K, nt = K / BK;
    unsigned voffA[2], voffB[2];
#pragma unroll
    for (int i = 0; i < 2; ++i) { int R, C; stage_rc(tid * 16 + i * 8192, R, C); const int Rb = Epi::PERM ? ((R & ~31) + perm32(R & 31)) : R;
        voffA[i] = (unsigned)(R * K + C) * 2u; voffB[i] = (unsigned)(Rb * K + C) * 2u; }
    const size_t kstep = (size_t)(BK * 2);
    const size_t hstep = (size_t)HALF * K * 2;
    const size_t tstep = 2 * hstep;
    const unsigned ldsw = (unsigned)wid * 1024u;
    const int aoff = lds_byte(wr * 64 + fr, fq * 8), boff = lds_byte(wc * 32 + fr, fq * 8);
#define PG8_SA(b, h) (((b) * 2 + (h)) * HTB)
#define PG8_SB(b, h) ((4 + (b) * 2 + (h)) * HTB)
#define PG8_STAGE(bufoff, gbase, voff) do { _Pragma("unroll") for (int _i = 0; _i < 2; ++_i) \
        __builtin_amdgcn_global_load_lds((const unsigned*)((const char*)(gbase) + (voff)[_i]), (PG8_LAS unsigned*)(lds + (bufoff) + ldsw + _i * 8192), 16, 0, 0); } while (0)
#define PG8_LDA(dst, b, h) do { _Pragma("unroll") for (int m = 0; m < 4; ++m) _Pragma("unroll") for (int k = 0; k < 2; ++k) dst[m][k] = *(const PG8_LAS bf16x8*)(lds + PG8_SA(b, h) + aoff + m * 2048 + k * 1024); } while (0)
#define PG8_LDB(dst, b, h) do { _Pragma("unroll") for (int n = 0; n < 2; ++n) _Pragma("unroll") for (int k = 0; k < 2; ++k) dst[n][k] = *(const PG8_LAS bf16x8*)(lds + PG8_SB(b, h) + boff + n * 2048 + k * 1024); } while (0)
#define PG8_MMA(ai, bj, At, Bt) do { __builtin_amdgcn_s_setprio(1); _Pragma("unroll") for (int m = 0; m < 4; ++m) _Pragma("unroll") for (int n = 0; n < 2; ++n) _Pragma("unroll") for (int k = 0; k < 2; ++k) \
        acc[ai][bj][m][n] = __builtin_amdgcn_mfma_f32_16x16x32_bf16(Bt[n][k], At[m][k], acc[ai][bj][m][n], 0, 0, 0); __builtin_amdgcn_s_setprio(0); } while (0)
#define PG8_WAIT_V(n) asm volatile("s_waitcnt vmcnt(" #n ")" ::: "memory")
#define PG8_WAIT_L(n) asm volatile("s_waitcnt lgkmcnt(" #n ")" ::: "memory")
#define PG8_BAR __builtin_amdgcn_s_barrier()
#define PG8_SCHED __builtin_amdgcn_sched_barrier(0)
    Unit cur, nxt; int ui = 0;
    if (!S.next(0, cur)) return;
    f32x4 acc[2][2][4][2];
#pragma unroll
    for (int a = 0; a < 2; ++a)
#pragma unroll
        for (int b = 0; b < 2; ++b)
#pragma unroll
            for (int m = 0; m < 4; ++m)
#pragma unroll
                for (int n = 0; n < 2; ++n) acc[a][b][m][n] = (f32x4){0.f, 0.f, 0.f, 0.f};
    bf16x8 At[4][2], B0[2][2], B1[2][2];
    const char* cA = (const char*)g.A + (size_t)cur.pm * tstep; const char* cB = (const char*)g.Bt + (size_t)cur.pn * tstep;
    S.a_ready(cur);
    if constexpr (SP2) {
        PG8_STAGE(PG8_SB(0, 0), cB, voffB); PG8_STAGE(PG8_SB(0, 1), cB + hstep, voffB); PG8_STAGE(PG8_SA(0, 0), cA, voffA); PG8_STAGE(PG8_SA(0, 1), cA + hstep, voffA);
        if (wr == 1) PG8_BAR;
        PG8_WAIT_V(2); PG8_BAR;
        PG8_STAGE(PG8_SB(1, 0), cB + kstep, voffB); PG8_STAGE(PG8_SA(1, 0), cA + kstep, voffA); PG8_STAGE(PG8_SB(1, 1), cB + hstep + kstep, voffB);
        PG8_WAIT_V(6); PG8_BAR;
    } else {
        PG8_STAGE(PG8_SB(0, 0), cB, voffB); PG8_STAGE(PG8_SA(0, 0), cA, voffA); PG8_STAGE(PG8_SB(0, 1), cB + hstep, voffB); PG8_STAGE(PG8_SA(0, 1), cA + hstep, voffA);
        if (wr == 1) PG8_BAR;
        PG8_WAIT_V(4); PG8_BAR;
        PG8_STAGE(PG8_SB(1, 0), cB + kstep, voffB); PG8_STAGE(PG8_SA(1, 0), cA + kstep, voffA); PG8_STAGE(PG8_SB(1, 1), cB + hstep + kstep, voffB);
        PG8_WAIT_V(6); PG8_BAR;
    }
    for (;;) {
        const bool has_next = S.next(ui + 1, nxt);
        const char* nA = has_next ? (const char*)g.A + (size_t)nxt.pm * tstep : cA; const char* nB = has_next ? (const char*)g.Bt + (size_t)nxt.pn * tstep : cB;
        for (int t = 0; t < nt; t += 2) {
            const bool last = (t == nt - 2);
            const char* a1 = cA + (size_t)(t + 1) * kstep;
            const char* a2 = last ? nA : cA + (size_t)(t + 2) * kstep; const char* b2 = last ? nB : cB + (size_t)(t + 2) * kstep;
            const char* a3 = a2 + kstep; const char* b3 = b2 + kstep;
            if (last && has_next) S.a_ready(nxt);
            if constexpr (SP2) {
            PG8_LDB(B0, 0, 0); PG8_LDB(B1, 0, 1); PG8_SCHED; PG8_LDA(At, 0, 0); PG8_STAGE(PG8_SA(1, 1), a1 + hstep, voffA);
            PG8_WAIT_V(8); PG8_WAIT_L(0); PG8_BAR; PG8_MMA(0, 0, At, B0); PG8_MMA(0, 1, At, B1); PG8_BAR; PG8_SCHED;
            PG8_LDA(At, 0, 1); PG8_STAGE(PG8_SB(0, 0), b2, voffB); PG8_STAGE(PG8_SB(0, 1), b2 + hstep, voffB); PG8_STAGE(PG8_SA(0, 0), a2, voffA);
            PG8_WAIT_V(8); PG8_WAIT_L(0); PG8_BAR; PG8_MMA(1, 0, At, B0); PG8_MMA(1, 1, At, B1); PG8_BAR; PG8_SCHED;
            PG8_LDB(B0, 1, 0); PG8_LDB(B1, 1, 1); PG8_SCHED; PG8_LDA(At, 1, 0); PG8_STAGE(PG8_SA(0, 1), a2 + hstep, voffA);
            PG8_WAIT_V(8); PG8_WAIT_L(0); PG8_BAR; PG8_MMA(0, 0, At, B0); PG8_MMA(0, 1, At, B1); PG8_BAR; PG8_SCHED;
            PG8_LDA(At, 1, 1); PG8_STAGE(PG8_SB(1, 0), b3, voffB); PG8_STAGE(PG8_SB(1, 1), b3 + hstep, voffB); PG8_STAGE(PG8_SA(1, 0), a3, voffA);
            PG8_WAIT_V(8); PG8_WAIT_L(0); PG8_BAR; PG8_MMA(1, 0, At, B0); PG8_MMA(1, 1, At, B1); PG8_BAR; PG8_SCHED;
            } else {
            PG8_LDB(B0, 0, 0); PG8_SCHED; PG8_LDA(At, 0, 0); PG8_STAGE(PG8_SA(1, 1), a1 + hstep, voffA);
            PG8_WAIT_L(8); PG8_BAR; PG8_WAIT_L(0); PG8_MMA(0, 0, At, B0); PG8_BAR; PG8_SCHED;
            PG8_LDB(B1, 0, 1); PG8_STAGE(PG8_SB(0, 0), b2, voffB);
            PG8_BAR; PG8_WAIT_L(0); PG8_MMA(0, 1, At, B1); PG8_BAR;
            PG8_LDA(At, 0, 1); PG8_STAGE(PG8_SA(0, 0), a2, voffA);
            PG8_BAR; PG8_WAIT_L(0); PG8_MMA(1, 0, At, B0); PG8_BAR; PG8_SCHED;
            PG8_STAGE(PG8_SB(0, 1), b2 + hstep, voffB);
            PG8_WAIT_V(6); PG8_BAR; PG8_MMA(1, 1, At, B1); PG8_BAR;
            PG8_LDB(B0, 1, 0); PG8_SCHED; PG8_LDA(At, 1, 0); PG8_STAGE(PG8_SA(0, 1), a2 + hstep, voffA);
            PG8_WAIT_L(8); PG8_BAR; PG8_WAIT_L(0); PG8_MMA(0, 0, At, B0); PG8_BAR; PG8_SCHED;
            PG8_LDB(B1, 1, 1); PG8_STAGE(PG8_SB(1, 0), b3, voffB);
            PG8_BAR; PG8_WAIT_L(0); PG8_MMA(0, 1, At, B1); PG8_BAR;
            PG8_LDA(At, 1, 1); PG8_STAGE(PG8_SA(1, 0), a3, voffA);
            PG8_BAR; PG8_WAIT_L(0); PG8_MMA(1, 0, At, B0); PG8_BAR; PG8_SCHED;
            PG8_STAGE(PG8_SB(1, 1), b3 + hstep, voffB);
            PG8_WAIT_V(6); PG8_BAR; PG8_MMA(1, 1, At, B1); PG8_BAR;
            }
        }
        if constexpr (ALIGN_EPI) { if (wr == 0) PG8_BAR; }
        if constexpr (!Epi::AFTER_DRAIN) { E(acc, cur, wr, wc, fr, fq); S.done(cur); }
        if (!has_next) break;
#pragma unroll
        for (int a = 0; a < 2; ++a)
#pragma unroll
            for (int b = 0; b < 2; ++b)
#pragma unroll
                for (int m = 0; m < 4; ++m)
#pragma unroll
                    for (int n = 0; n < 2; ++n) acc[a][b][m][n] = (f32x4){0.f, 0.f, 0.f, 0.f};
        cur = nxt; cA = nA; cB = nB; ++ui;
        if constexpr (ALIGN_EPI) { if (wr == 1) PG8_BAR; }
    }
    PG8_WAIT_V(0);
    if constexpr (!ALIGN_EPI) { if (wr == 0) PG8_BAR; }
    PG8_BAR;
    if constexpr (Epi::AFTER_DRAIN) { E.fused(acc, cur, wr, wc, fr, fq, lds, wid, lane); S.done(cur); }
#undef PG8_SA
#undef PG8_SB
#undef PG8_STAGE
#undef PG8_LDA
#undef PG8_LDB
#undef PG8_MMA
#undef PG8_WAIT_V
#undef PG8_WAIT_L
#undef PG8_BAR
#undef PG8_SCHED
}
}

constexpr size_t MiB = 1u << 20;
constexpr size_t WS_CTL = 0, CTL_ZERO_BYTES = 1 * MiB;
constexpr size_t WS_MOD = 1 * MiB;
constexpr size_t WS_SHW1 = 2 * MiB;
constexpr size_t WS_SHW2 = 3 * MiB;
constexpr size_t WS_RSSA = 4 * MiB;
constexpr size_t WS_RSSB = 9 * MiB;
constexpr size_t WS_TOT = 14 * MiB;
constexpr size_t WS_CARRY = 19 * MiB;
constexpr size_t WS_WLR = 21 * MiB + 512 * 1024;
constexpr size_t WS_WIN = 22 * MiB;
constexpr size_t WS_WOUT = 32 * MiB;
constexpr size_t WS_W1 = 36 * MiB;
constexpr size_t WS_W2 = 52 * MiB;
constexpr size_t WS_CX = 68 * MiB;
constexpr size_t WS_XA = 84 * MiB;
constexpr size_t WS_HID = 156 * MiB;
constexpr size_t WS_PROJ = WS_HID;
constexpr size_t WS_MIX = WS_HID + 180 * MiB;
constexpr size_t WS_END = 444 * MiB;
static_assert(WS_MIX + (size_t)MT * D * 2 <= WS_END && WS_HID + (size_t)MT * FF * 2 == WS_END, "ws map");
constexpr int CW_BAR = 4096;

constexpr int NWAVES = 8;
constexpr int RING_OFF = 0, RING_BYTES = 131072;
constexpr int LDSCTL_OFF = RING_BYTES, MISC_OFF = LDSCTL_OFF + 320;
constexpr int LDS_BYTES = 147456;

#define GAS __attribute__((address_space(1)))
#define LAS __attribute__((address_space(3)))
typedef unsigned short bf16;
typedef unsigned v4u __attribute__((ext_vector_type(4)));
typedef unsigned v2u __attribute__((ext_vector_type(2)));
typedef float f32x4 __attribute__((ext_vector_type(4)));
typedef float f32x2 __attribute__((ext_vector_type(2)));
typedef GAS unsigned gu32;
#define LDS_WAIT() asm volatile("s_waitcnt lgkmcnt(0)" ::: "memory")
#define VM_WAIT() asm volatile("s_waitcnt vmcnt(0)" ::: "memory")
__device__ __forceinline__ unsigned f2bf(float f) { unsigned u = __builtin_bit_cast(unsigned, f); return (u + 0x7fffu + ((u >> 16) & 1u)) >> 16; }
__device__ __forceinline__ unsigned pk2(float lo, float hi) { return f2bf(lo) | (f2bf(hi) << 16); }
__device__ __forceinline__ float bflo(unsigned w) { return __uint_as_float(w << 16); }
__device__ __forceinline__ float bfhi(unsigned w) { return __uint_as_float(w & 0xffff0000u); }
__device__ __forceinline__ float bf1(bf16 v) { return __uint_as_float((unsigned)v << 16); }
__device__ __forceinline__ float sigmoidf_(float x) { return 1.f / (1.f + __expf(-x)); }
__device__ __forceinline__ float siluf_(float x) { return x * sigmoidf_(x); }
__device__ __forceinline__ float gelu_tanh(float x) { const float u = 0.7978845608028654f * (x + 0.044715f * x * x * x); return x * sigmoidf_(2.f * u); }
__device__ __forceinline__ float wave_sum(float v) {
#pragma unroll
    for (int o = 1; o < 64; o <<= 1) v += __shfl_xor(v, o);
    return v;
}

#define XB_TMO      128
#define XB_XCNT(j)  (256  + 64 * (j))
#define XB_XSUB(j)  (1280 + 64 * (j))
#define XB_XGEN(j)  (2304 + 64 * (j))
#define XB_TOP      3328
#define XB_TOPGEN   3392
#define XCD_BAR_WORDS 3456
#define XB_SPIN_CAP (1u << 18)

__device__ __forceinline__ unsigned xb_ld(unsigned* p)              { return __hip_atomic_load(p, __ATOMIC_RELAXED, __HIP_MEMORY_SCOPE_AGENT); }
__device__ __forceinline__ unsigned xb_add(unsigned* p, unsigned v) { return __hip_atomic_fetch_add(p, v, __ATOMIC_RELAXED, __HIP_MEMORY_SCOPE_AGENT); }
__device__ __forceinline__ unsigned xb_xcc_id() { return (unsigned)__builtin_amdgcn_s_getreg((3 << 11) | 20) & 0xFu; }
#define XB_SPIN(cond, bar) do { unsigned _sp = 0; while (cond) { __builtin_amdgcn_s_sleep(1); \
    if ((++_sp & 255u) == 0u) { if (xb_ld(&(bar)[XB_TMO])) break; if (_sp > XB_SPIN_CAP) { atomicAdd(&(bar)[XB_TMO], 1u); break; } } } } while (0)

struct XcdBarrier {
    unsigned* bar; unsigned x;
    volatile LAS unsigned* st;
};

__device__ __forceinline__ XcdBarrier xcd_barrier_post(unsigned* bar, volatile LAS unsigned* st) {
    XcdBarrier b; b.bar = bar; b.x = xb_xcc_id(); b.st = st;
    if (threadIdx.x == 0) (void)xb_add(&bar[XB_XCNT(b.x)], 1u);
    return b;
}
__device__ __forceinline__ void xcd_barrier_complete(unsigned* bar, unsigned x, unsigned& nloc, unsigned& nx) {
    const unsigned G = gridDim.x * gridDim.y * gridDim.z;
    unsigned sum, cnt, mine, sp = 0u;
    for (;;) {
        sum = 0u; cnt = 0u; mine = 0u;
#pragma unroll
        for (unsigned j = 0; j < 16; ++j) { const unsigned c = xb_ld(&bar[XB_XCNT(j)]); sum += c; cnt += (c > 0u) ? 1u : 0u; mine = (j == x) ? c : mine; }
        if (sum == G) break;
        __builtin_amdgcn_s_sleep(1);
        if ((++sp & 255u) == 0u) { if (xb_ld(&bar[XB_TMO])) break; if (sp > XB_SPIN_CAP) { atomicAdd(&bar[XB_TMO], 1u); break; } }
    }
    nloc = mine > 0u ? mine : 1u; nx = cnt > 0u ? cnt : 1u;
}

__device__ __forceinline__ void xcd_barrier(const XcdBarrier& b) {
    asm volatile("s_waitcnt vmcnt(0)" ::: "memory");
    __syncthreads();
    if (threadIdx.x == 0) {
        unsigned* bar = b.bar;
        __builtin_amdgcn_s_waitcnt(0);
        unsigned nloc = b.st[0], nx = b.st[1];
        if (nloc == 0u) { xcd_barrier_complete(bar, b.x, nloc, nx); b.st[0] = nloc; b.st[1] = nx; }
        const unsigned old = xb_add(&bar[XB_XSUB(b.x)], 1u);
        const unsigned gen = old / nloc;
        if (old + 1u == (gen + 1u) * nloc) {
            __builtin_amdgcn_fence(__ATOMIC_RELEASE, "agent");
            asm volatile("s_waitcnt vmcnt(0)" ::: "memory");
            const unsigned og = xb_add(&bar[XB_TOP], 1u);
            const unsigned tg = og / nx;
            if (og + 1u == (tg + 1u) * nx) xb_add(&bar[XB_TOPGEN], 1u);
            else XB_SPIN(xb_ld(&bar[XB_TOPGEN]) == tg, bar);
            __builtin_amdgcn_fence(__ATOMIC_ACQUIRE, "agent");
            xb_add(&bar[XB_XGEN(b.x)], 1u);
            asm volatile("s_waitcnt vmcnt(0)" ::: "memory");
        } else {
            XB_SPIN(xb_ld(&bar[XB_XGEN(b.x)]) == gen, bar);
            __builtin_amdgcn_fence(__ATOMIC_ACQUIRE, "agent");
            asm volatile("s_waitcnt vmcnt(0)" ::: "memory");
        }
    }
    __syncthreads();
}

struct Frame {
    LAS unsigned char* lds;
    int tid, lane, wave;
    int vcu, G;
    int gw, NGW;
    const float* in[25]; float* out; unsigned char* ws;
};
#define WSP(T, off) ((T*)(F.ws + (off)))

__device__ __forceinline__ void gemv17_item(Frame& F, const LAS float* tab, LAS float* red, const float* W, int ldw, int n0, const float* bias, float* outp, int ldo) {
    float acc[17];
#pragma unroll
    for (int r = 0; r < 17; ++r) acc[r] = 0.f;
    const int k0 = F.wave * 128;
    const float* wp = W + (size_t)k0 * ldw + n0 + F.lane;
#pragma unroll 4
    for (int k = 0; k < 128; ++k) {
        const float wv = wp[(size_t)k * ldw];
#pragma unroll
        for (int r = 0; r < 17; ++r) acc[r] += tab[r * 1024 + k0 + k] * wv;
    }
#pragma unroll
    for (int r = 0; r < 17; ++r) red[(F.wave * 17 + r) * 64 + F.lane] = acc[r];
    __syncthreads();
    for (int i = F.tid; i < 17 * 64; i += NWAVES * 64) {
        const int r = i >> 6, n = i & 63; float s = bias ? bias[n0 + n] : 0.f;
#pragma unroll
        for (int w = 0; w < 8; ++w) s += red[(w * 17 + r) * 64 + n];
        outp[(size_t)r * ldo + n0 + n] = s;
    }
    __syncthreads();
}

__device__ __forceinline__ void p0_transpose_item(const float* W, int K, int N, bf16* WT, LAS float* scr, int item, int lane) {
    const int nblk = N / 32, kb = item / nblk, nb = item % nblk, k0 = 64 * kb, n0 = 32 * nb;
#pragma unroll 8
    for (int i = 0; i < 32; ++i) { const int kk = 2 * i + (lane >> 5); scr[kk * 33 + (lane & 31)] = W[(size_t)(k0 + kk) * N + n0 + (lane & 31)]; }
    LDS_WAIT(); asm volatile("" ::: "memory");
    const int c = lane & 7;
#pragma unroll
    for (int j = 0; j < 4; ++j) { const int n = (lane >> 3) + 8 * j; const LAS float* s = scr + (8 * c) * 33 + n;
        v4u o; o.x = pk2(s[0 * 33], s[1 * 33]); o.y = pk2(s[2 * 33], s[3 * 33]); o.z = pk2(s[4 * 33], s[5 * 33]); o.w = pk2(s[6 * 33], s[7 * 33]);
        *(GAS v4u*)(WT + (size_t)(n0 + n) * K + k0 + 8 * c) = o; }
    LDS_WAIT(); asm volatile("" ::: "memory");
}

__device__ __forceinline__ void phase_p0a(Frame& F) {
    LAS float* tab = (LAS float*)(F.lds);
    LAS float* red = (LAS float*)(F.lds + 17 * 1024 * 4);
    float* MOD = WSP(float, WS_MOD);
    bool filled = false;
    for (int it = F.vcu; it < 2 * 96; it += F.G) {
        if (!filled) {
            for (int i = F.tid; i < 17 * 1024; i += NWAVES * 64) { const int r = i >> 10, k = i & 1023; const float v = (r < 16) ? F.in[1][r * D + k] : F.in[3][k]; tab[i] = siluf_(v); }
            __syncthreads(); filled = true;
        }
        const int l = it / 96, n0 = (it % 96) * 64;
        gemv17_item(F, tab, red, F.in[6] + (size_t)l * D * MODW, MODW, n0, F.in[7] + (size_t)l * MODW, MOD + (size_t)l * 17 * MODW, MODW);
    }
    __syncthreads();
    {
        bf16* WLR = WSP(bf16, WS_WLR);
        for (int i = F.gw * 64 + F.lane; i < 2 * 2 * 4 * 2 * 4096; i += F.NGW * 64) { const int d = i & 63, e = (i >> 6) & 63, gt = (i >> 12) & 1, blk = i >> 13;
            const float* src = gt == 0 ? F.in[17] : F.in[19]; WLR[i] = (bf16)f2bf(src[((size_t)blk * 64 + d) * 64 + e]); }
    }
    LAS float* scr = (LAS float*)(F.lds + F.wave * 16384);
    constexpr int I_IN = (D / 64) * (IND / 32), I_OUT = (D / 64) * (D / 32), I_1 = (D / 64) * (FF / 32), I_2 = (FF / 64) * (D / 32), I_L = I_IN + I_OUT + I_1 + I_2;
    for (int it = F.gw; it < 2 * I_L; it += F.NGW) {
        const int l = it / I_L; int r = it % I_L;
        if (r < I_IN) { p0_transpose_item(F.in[8] + (size_t)l * D * IND, D, IND, WSP(bf16, WS_WIN) + (size_t)l * IND * D, scr, r, F.lane); continue; } r -= I_IN;
        if (r < I_OUT) { p0_transpose_item(F.in[9] + (size_t)l * D * D, D, D, WSP(bf16, WS_WOUT) + (size_t)l * D * D, scr, r, F.lane); continue; } r -= I_OUT;
        if (r < I_1) { p0_transpose_item(F.in[22] + (size_t)l * D * FF, D, FF, WSP(bf16, WS_W1) + (size_t)l * FF * D, scr, r, F.lane); continue; } r -= I_1;
        p0_transpose_item(F.in[23] + (size_t)l * FF * D, FF, D, WSP(bf16, WS_W2) + (size_t)l * D * FF, scr, r, F.lane);
    }
}

__device__ __forceinline__ void phase_p0b(Frame& F) {
    LAS float* tab = (LAS float*)(F.lds);
    LAS float* red = (LAS float*)(F.lds + 17 * 1024 * 4);
    const float* MOD = WSP(const float, WS_MOD);
    for (int it = F.vcu; it < 2 * 104; it += F.G) {
        const int l = it / 104, j = it % 104; const bool first = j < 40;
        const int shoff = first ? 0 : 3 * D;
        __syncthreads();
        for (int i = F.tid; i < 17 * 1024; i += NWAVES * 64) { const int r = i >> 10, k = i & 1023; tab[i] = MOD[((size_t)l * 17 + r) * MODW + shoff + k]; }
        __syncthreads();
        if (first) gemv17_item(F, tab, red, F.in[8] + (size_t)l * D * IND, IND, j * 64, nullptr, WSP(float, WS_SHW1) + (size_t)l * 17 * IND, IND);
        else gemv17_item(F, tab, red, F.in[22] + (size_t)l * D * FF, FF, (j - 40) * 64, nullptr, WSP(float, WS_SHW2) + (size_t)l * 17 * FF, FF);
    }
    bf16* XA = WSP(bf16, WS_XA); float* RSSA = WSP(float, WS_RSSA);
    const float* g1 = F.in[4];
    for (int row = F.gw; row < MT; row += F.NGW) {
        const bool lat = row < ML;
        const float* xr = lat ? F.in[0] + (size_t)row * D : F.in[2] + (size_t)(row - ML) * D;
        const int brow = lat ? (row >> 11) : NB;
        const float* sc = MOD + (size_t)brow * MODW + D;
        f32x4 v[4]; float ss = 0.f;
#pragma unroll
        for (int j = 0; j < 4; ++j) { v[j] = *(const f32x4*)(xr + 4 * F.lane + 256 * j); ss += (v[j][0] * v[j][0] + v[j][1] * v[j][1]) + (v[j][2] * v[j][2] + v[j][3] * v[j][3]); }
        ss = wave_sum(ss);
        if (F.lane < 32) RSSA[(size_t)row * 32 + F.lane] = (F.lane == 0) ? ss : 0.f;
#pragma unroll
        for (int j = 0; j < 4; ++j) { const int k = 4 * F.lane + 256 * j;
            const f32x4 gm = *(const f32x4*)(g1 + k) * (*(const f32x4*)(sc + k) + 1.0f), a = v[j] * gm;
            v2u o; o.x = pk2(a[0], a[1]); o.y = pk2(a[2], a[3]); *(v2u*)(XA + (size_t)row * D + k) = o; }
    }
}

__device__ __forceinline__ void conv_row(Frame& F, int l, int row) {
    const bf16* PROJ = WSP(const bf16, WS_PROJ); bf16* MIX = WSP(bf16, WS_MIX);
    const float* cw = F.in[10] + (size_t)l * 31 * 256; const float* cb = F.in[11] + l * 256; const float* lg = F.in[12] + l * 256; const float* lb = F.in[13] + l * 256;
    int lo, hi; if (row < ML) { lo = row & ~(SEQ - 1); hi = lo + SEQ; } else { lo = row & ~(CTXL - 1); hi = lo + CTXL; }
    const int c0 = 4 * F.lane;
    f32x4 acc = *(const f32x4*)(cb + c0);
    for (int k = 0; k < 31; ++k) {
        const int rr = row + k - 15;
        if (rr >= lo && rr < hi) {
            const v2u vv = *(const v2u*)(PROJ + (size_t)rr * IND + c0), gg = *(const v2u*)(PROJ + (size_t)rr * IND + 256 + c0);
            const f32x4 w = *(const f32x4*)(cw + k * 256 + c0);
            acc[0] += w[0] * bflo(vv.x) * sigmoidf_(bflo(gg.x)); acc[1] += w[1] * bfhi(vv.x) * sigmoidf_(bfhi(gg.x));
            acc[2] += w[2] * bflo(vv.y) * sigmoidf_(bflo(gg.y)); acc[3] += w[3] * bfhi(vv.y) * sigmoidf_(bfhi(gg.y));
        }
    }
    const float mu = wave_sum((acc[0] + acc[1]) + (acc[2] + acc[3])) * (1.f / 256.f);
    const f32x4 d = acc - mu;
    const float var = wave_sum((d[0] * d[0] + d[1] * d[1]) + (d[2] * d[2] + d[3] * d[3])) * (1.f / 256.f);
    const f32x4 y = d * rsqrtf(var + EPS) * *(const f32x4*)(lg + c0) + *(const f32x4*)(lb + c0);
    v2u o; o.x = pk2(siluf_(y[0]), siluf_(y[1])); o.y = pk2(siluf_(y[2]), siluf_(y[3]));
    *(v2u*)(MIX + (size_t)row * D + c0) = o;
}

typedef short s16x8 __attribute__((ext_vector_type(8)));
typedef short s16x4 __attribute__((ext_vector_type(4)));
constexpr int NA_VROW = 160;
constexpr int NA_WLDS = 64 * NA_VROW + 2560;
constexpr int NA_ITEMS_LAT = NB * NH * 32 * 4, NA_ITEMS_CTX = NB * NH * 16;
__device__ __forceinline__ void na_item(Frame& F, int l, int it) {
    const bf16* PROJ = WSP(const bf16, WS_PROJ); bf16* MIX = WSP(bf16, WS_MIX);
    LAS unsigned char* wl = F.lds + F.wave * NA_WLDS;
    LAS float* tb = (LAS float*)(wl + 64 * NA_VROW);
    const int lane = F.lane, q16 = lane & 15, g = lane >> 4;
    const bool isctx = it >= NA_ITEMS_LAT;
    int b, h, r = 0, jq = 0, qrow0;
    if (!isctx) { jq = it & 3; r = (it >> 2) & 31; h = (it >> 7) & 7; b = it >> 10; qrow0 = b * SEQ + r * 64 + jq * 16; }
    else { const int j = it - NA_ITEMS_LAT; const int qb = j & 15; h = (j >> 4) & 7; b = j >> 7; qrow0 = ML + b * CTXL + qb * 16; }
    const bf16* Pq = PROJ + 512 + h * HD, * Pk = PROJ + 1024 + h * HD, * Pv = PROJ + 1536 + h * HD;
    s16x8 qf[2];
#pragma unroll
    for (int s = 0; s < 2; ++s) qf[s] = *(const s16x8*)(Pq + (size_t)(qrow0 + q16) * IND + 32 * s + 8 * g);
    int rs = r - 4; rs = rs < 0 ? 0 : (rs > 24 ? 24 : rs);
    const int tlo = jq < 2 ? 0 : jq - 1, thi = jq > 1 ? 3 : jq + 1;
    float madd[4][4];
    int lb;
    {
        const int qc = jq * 16 + q16; int cs = qc - 8; cs = cs < 0 ? 0 : (cs > 48 ? 48 : cs);
#pragma unroll
        for (int t = 0; t < 4; ++t)
#pragma unroll
            for (int e = 0; e < 4; ++e) madd[t][e] = ((unsigned)(16 * t + 4 * g + e - cs) < 16u) ? 0.f : -1.0e30f;
        lb = 64 + 4 * g - qc + 15;
    }
    if (!isctx) {
        const float* rpb = F.in[14] + ((size_t)l * NH + h) * 15 * 31;
        for (int i = lane; i < 640; i += 64) tb[i] = 0.f;
        for (int i = lane; i < 465; i += 64) tb[64 + i] = rpb[i] * 1.4426950408889634f;
    }
    const float c1 = 0.125f * 1.4426950408889634f;
    f32x4 O[4];
#pragma unroll
    for (int dt = 0; dt < 4; ++dt) O[dt] = (f32x4){0.f, 0.f, 0.f, 0.f};
    float m = -1.0e30f, lsum = 0.f;
    const int nch = isctx ? 4 : 12, nloc = isctx ? 0 : 8;
    const unsigned vld_key = (unsigned)(lane >> 3), vld_part = (unsigned)(lane & 7);
    LAS unsigned char* vst = wl + vld_key * NA_VROW + vld_part * 16;
    const LAS unsigned char* vtr = wl + (4 * g + (q16 >> 2)) * NA_VROW + (q16 & 3) * 8;
    auto krow_of = [&](int ch) -> int { return ch < nloc ? b * SEQ + (rs + ch) * 64 : ML + b * CTXL + (ch - nloc) * 64; };
    s16x8 kf[4][2]; v4u vr[8];
    {
        const int k0 = krow_of(0);
#pragma unroll
        for (int t = 0; t < 4; ++t) if (nloc == 0 || (t >= tlo && t <= thi)) {
#pragma unroll
            for (int s = 0; s < 2; ++s) kf[t][s] = *(const s16x8*)(Pk + (size_t)(k0 + 16 * t + q16) * IND + 32 * s + 8 * g); }
#pragma unroll
        for (int i = 0; i < 8; ++i) vr[i] = *(const v4u*)(Pv + (size_t)(k0 + (int)vld_key + 8 * i) * IND + 8 * vld_part);
    }
    for (int ch = 0; ch < nch; ++ch) {
        const bool local = ch < nloc;
#pragma unroll
        for (int i = 0; i < 8; ++i) *(LAS v4u*)(vst + i * 8 * NA_VROW) = vr[i];
        f32x4 S[4];
#pragma unroll
        for (int t = 0; t < 4; ++t) { S[t] = (f32x4){0.f, 0.f, 0.f, 0.f};
            if (!local || (t >= tlo && t <= thi)) {
#pragma unroll
                for (int s = 0; s < 2; ++s) S[t] = __builtin_amdgcn_mfma_f32_16x16x32_bf16(kf[t][s], qf[s], S[t], 0, 0, 0); } }
        if (ch + 1 < nch) {
            const int k1 = krow_of(ch + 1); const bool nlocal = ch + 1 < nloc;
#pragma unroll
            for (int t = 0; t < 4; ++t) if (!nlocal || (t >= tlo && t <= thi)) {
#pragma unroll
                for (int s = 0; s < 2; ++s) kf[t][s] = *(const s16x8*)(Pk + (size_t)(k1 + 16 * t + q16) * IND + 32 * s + 8 * g); }
#pragma unroll
            for (int i = 0; i < 8; ++i) vr[i] = *(const v4u*)(Pv + (size_t)(k1 + (int)vld_key + 8 * i) * IND + 8 * vld_part);
        }
        float cm = -1.0e30f;
        if (local) {
            const LAS float* tr_ = tb + (rs + ch - r + 7) * 31 + lb;
#pragma unroll
            for (int t = 0; t < 4; ++t) if (t >= tlo && t <= thi) {
#pragma unroll
                for (int e = 0; e < 4; ++e) { const float v = S[t][e] * c1 + tr_[16 * t + e] + madd[t][e]; S[t][e] = v; cm = fmaxf(cm, v); } }
        } else {
#pragma unroll
            for (int t = 0; t < 4; ++t)
#pragma unroll
                for (int e = 0; e < 4; ++e) { const float v = S[t][e] * c1; S[t][e] = v; cm = fmaxf(cm, v); }
        }
        cm = fmaxf(cm, __shfl_xor(cm, 16)); cm = fmaxf(cm, __shfl_xor(cm, 32));
        const float mn = fmaxf(m, cm), alpha = __builtin_amdgcn_exp2f(m - mn); m = mn;
        float ps = 0.f;
        unsigned pk[4][2];
#pragma unroll
        for (int t = 0; t < 4; ++t) {
            if (!local || (t >= tlo && t <= thi)) {
                const float p0 = __builtin_amdgcn_exp2f(S[t][0] - mn), p1 = __builtin_amdgcn_exp2f(S[t][1] - mn), p2 = __builtin_amdgcn_exp2f(S[t][2] - mn), p3 = __builtin_amdgcn_exp2f(S[t][3] - mn);
                ps += (p0 + p1) + (p2 + p3);
                pk[t][0] = pg8::cvt_pk_bf16(p0, p1); pk[t][1] = pg8::cvt_pk_bf16(p2, p3);
            } else { pk[t][0] = 0u; pk[t][1] = 0u; }
        }
        lsum = lsum * alpha + ps;
#pragma unroll
        for (int dt = 0; dt < 4; ++dt) O[dt] = O[dt] * alpha;
#pragma unroll
        for (int p = 0; p < 2; ++p) {
            if (!local || (2 * p <= thi && 2 * p + 1 >= tlo)) {
                const v4u bw = {pk[2 * p][0], pk[2 * p][1], pk[2 * p + 1][0], pk[2 * p + 1][1]};
                const s16x8 bfrag = __builtin_bit_cast(s16x8, bw);
#pragma unroll
                for (int dt = 0; dt < 4; ++dt) {
                    const s16x4 a0 = __builtin_amdgcn_ds_read_tr16_b64_v4i16((LAS s16x4*)(vtr + (2 * p) * 16 * NA_VROW + dt * 32));
                    const s16x4 a1 = __builtin_amdgcn_ds_read_tr16_b64_v4i16((LAS s16x4*)(vtr + (2 * p + 1) * 16 * NA_VROW + dt * 32));
                    const s16x8 afrag = __builtin_shufflevector(a0, a1, 0, 1, 2, 3, 4, 5, 6, 7);
                    O[dt] = __builtin_amdgcn_mfma_f32_16x16x32_bf16(afrag, bfrag, O[dt], 0, 0, 0);
                }
            }
        }
    }
    lsum += __shfl_xor(lsum, 16); lsum += __shfl_xor(lsum, 32);
    const float inv = 1.f / lsum;
    bf16* op = MIX + (size_t)(qrow0 + q16) * D + 256 + h * HD + 4 * g;
#pragma unroll
    for (int dt = 0; dt < 4; ++dt) { v2u w; w.x = pg8::cvt_pk_bf16(O[dt][0] * inv, O[dt][1] * inv); w.y = pg8::cvt_pk_bf16(O[dt][2] * inv, O[dt][3] * inv); *(v2u*)(op + 16 * dt) = w; }
}

constexpr int LRU_UCROW = 260;
constexpr int LRU_HSROW = 258;
constexpr int LRU_OFF_UC = 38 * 256 * 2, LRU_OFF_HS = LRU_OFF_UC + 2 * 32 * LRU_UCROW * 4;
static_assert(LRU_OFF_HS + 32 * LRU_HSROW * 4 <= RING_BYTES, "LRU LDS map");
template <int PASS>
__device__ __forceinline__ void lru_phase(Frame& F, int l, int ntiles) {
    const bf16* PROJ = WSP(const bf16, WS_PROJ);
    LAS bf16* rxs = (LAS bf16*)(F.lds);
    LAS float* ucf = (LAS float*)(F.lds + LRU_OFF_UC);
    LAS float* hs = (LAS float*)(F.lds + LRU_OFF_HS);
    const int lane = F.lane, j16 = lane & 15, g = lane >> 4;
    const int dir = F.wave >> 2, kb = F.wave & 3;
    const int ld = l * 2 + dir;
    s16x8 wf[2][4][2];
    {
        const bf16* WLR = WSP(const bf16, WS_WLR) + (size_t)((ld * 4 + kb) * 2) * 4096;
#pragma unroll
        for (int gt = 0; gt < 2; ++gt)
#pragma unroll
            for (int n = 0; n < 4; ++n)
#pragma unroll
                for (int s = 0; s < 2; ++s) wf[gt][n][s] = *(const s16x8*)(WLR + gt * 4096 + (16 * n + j16) * 64 + 32 * s + 8 * g);
    }
    float cbx[4], cba[4], csp[4];
#pragma unroll
    for (int n = 0; n < 4; ++n) {
        const int e = kb * 64 + 16 * n + j16, idx = ld * 256 + e;
        cbx[n] = F.in[18][idx]; cba[n] = F.in[20][idx];
        const float nl = -F.in[21][idx]; csp[n] = -8.f * (fmaxf(nl, 0.f) + log1pf(__expf(-fabsf(nl))));
    }
    const int c = F.tid & 255;
    const float s1w0 = F.in[15][(ld * 4 + 0) * 256 + c], s1w1 = F.in[15][(ld * 4 + 1) * 256 + c], s1w2 = F.in[15][(ld * 4 + 2) * 256 + c], s1w3 = F.in[15][(ld * 4 + 3) * 256 + c], s1cb = F.in[16][ld * 256 + c];
    const int base = dir == 0 ? 0 : 3;
    const bool sec16 = ((g & 1) != 0) != (dir != 0), sec32 = ((g >> 1) != 0) != (dir != 0);
    for (int T = F.vcu; T < ntiles; T += F.G) {
        const int row0 = T * 32;
        int lo, hi; if (row0 < ML) { lo = row0 & ~(SEQ - 1); hi = lo + SEQ; } else { lo = row0 & ~(CTXL - 1); hi = lo + CTXL; }
        __syncthreads();
        for (int i = F.tid; i < 38 * 128; i += NWAVES * 64) { const int rr = i >> 7, cp = i & 127, row = row0 - 3 + rr;
            ((LAS unsigned*)rxs)[i] = (row >= lo && row < hi) ? *(const unsigned*)(PROJ + (size_t)row * IND + 2048 + 2 * cp) : 0u; }
        if (PASS == 1) for (int i = F.tid; i < 32 * LRU_HSROW; i += NWAVES * 64) hs[i] = 0.f;
        __syncthreads();
        {
            float x0 = bf1(rxs[(base + 0) * 256 + c]), x1 = bf1(rxs[(base + 1) * 256 + c]), x2 = bf1(rxs[(base + 2) * 256 + c]);
#pragma unroll 8
            for (int t = 0; t < 32; ++t) {
                const float x3 = bf1(rxs[(t + base + 3) * 256 + c]);
                const float u = s1cb + s1w0 * x0 + s1w1 * x1 + s1w2 * x2 + s1w3 * x3;
                ucf[(dir * 32 + t) * LRU_UCROW + c] = u;
                x0 = x1; x1 = x2; x2 = x3;
            }
        }
        __syncthreads();
        float av[2][4][4], bv[2][4][4];
#pragma unroll
        for (int rt = 0; rt < 2; ++rt) {
            s16x8 af[2];
#pragma unroll
            for (int s = 0; s < 2; ++s) { const LAS float* up = ucf + (dir * 32 + 16 * rt + j16) * LRU_UCROW + kb * 64 + 32 * s + 8 * g;
                const f32x4 u0 = *(const LAS f32x4*)up, u1 = *(const LAS f32x4*)(up + 4);
                const v4u w = {pg8::cvt_pk_bf16(u0[0], u0[1]), pg8::cvt_pk_bf16(u0[2], u0[3]), pg8::cvt_pk_bf16(u1[0], u1[1]), pg8::cvt_pk_bf16(u1[2], u1[3])};
                af[s] = __builtin_bit_cast(s16x8, w); }
#pragma unroll
            for (int n = 0; n < 4; ++n) {
                f32x4 zx = {0.f, 0.f, 0.f, 0.f}, za = {0.f, 0.f, 0.f, 0.f};
#pragma unroll
                for (int s = 0; s < 2; ++s) { zx = __builtin_amdgcn_mfma_f32_16x16x32_bf16(af[s], wf[0][n][s], zx, 0, 0, 0); za = __builtin_amdgcn_mfma_f32_16x16x32_bf16(af[s], wf[1][n][s], za, 0, 0, 0); }
                const int e = kb * 64 + 16 * n + j16;
                const LAS float* uo = ucf + (dir * 32 + 16 * rt + 4 * g) * LRU_UCROW + e;
#pragma unroll
                for (int r = 0; r < 4; ++r) {
                    const float u = uo[r * LRU_UCROW];
                    const float gx = sigmoidf_(zx[r] + cbx[n]), ga = sigmoidf_(za[r] + cba[n]);
                    const float la = csp[n] * ga;
                    av[rt][n][r] = __expf(la);
                    bv[rt][n][r] = sqrtf(-expm1f(2.f * la)) * gx * u;
                }
            }
        }
#pragma unroll
        for (int n = 0; n < 4; ++n) {
            const int e = kb * 64 + 16 * n + j16;
            float EP[2], ES[2], TP[2], TS[2];
#pragma unroll
            for (int rt = 0; rt < 2; ++rt) {
                const float a0 = av[rt][n][0], a1 = av[rt][n][1], a2 = av[rt][n][2], a3 = av[rt][n][3], b0 = bv[rt][n][0], b1 = bv[rt][n][1], b2 = bv[rt][n][2], b3 = bv[rt][n][3];
                const float P = (a0 * a1) * (a2 * a3);
                const float S = dir == 0 ? ((b0 * a1 + b1) * a2 + b2) * a3 + b3 : ((b3 * a2 + b2) * a1 + b1) * a0 + b0;
                const float Pp = __shfl_xor(P, 16), Sp = __shfl_xor(S, 16);
                const float e1P = sec16 ? Pp : 1.f, e1S = sec16 ? Sp : 0.f;
                const float prP = P * Pp, prS = sec16 ? P * Sp + S : Pp * S + Sp;
                const float Pq = __shfl_xor(prP, 32), Sq = __shfl_xor(prS, 32);
                EP[rt] = sec32 ? Pq * e1P : e1P; ES[rt] = sec32 ? e1P * Sq + e1S : e1S;
                TP[rt] = prP * Pq; TS[rt] = sec32 ? prP * Sq + prS : Pq * prS + Sq;
            }
            const float fP = dir == 0 ? TP[0] : TP[1], fS = dir == 0 ? TS[0] : TS[1], sP = dir == 0 ? TP[1] : TP[0], sS = dir == 0 ? TS[1] : TS[0];
            if (PASS == 0) {
                if (g == 0) WSP(f32x2, WS_TOT)[((size_t)dir * 1152 + T) * 256 + e] = (f32x2){fP * sP, sP * fS + sS};
            } else {
                const float hin = WSP(const float, WS_CARRY)[((size_t)dir * 1152 + T) * 256 + e];
                const float hin2 = fP * hin + fS;
                const float h0in = dir == 0 ? hin : hin2, h1in = dir == 0 ? hin2 : hin;
#pragma unroll
                for (int rt = 0; rt < 2; ++rt) {
                    float h = EP[rt] * (rt == 0 ? h0in : h1in) + ES[rt];
                    LAS float* hp = hs + (16 * rt + 4 * g) * LRU_HSROW + e;
                    if (dir == 0) {
#pragma unroll
                        for (int r = 0; r < 4; ++r) { h = av[rt][n][r] * h + bv[rt][n][r]; __hip_atomic_fetch_add(hp + r * LRU_HSROW, h, __ATOMIC_RELAXED, __HIP_MEMORY_SCOPE_WORKGROUP); }
                    } else {
#pragma unroll
                        for (int r = 3; r >= 0; --r) { h = av[rt][n][r] * h + bv[rt][n][r]; __hip_atomic_fetch_add(hp + r * LRU_HSROW, h, __ATOMIC_RELAXED, __HIP_MEMORY_SCOPE_WORKGROUP); }
                    }
                }
            }
        }
        if (PASS == 1) {
            __syncthreads();
            bf16* MIX = WSP(bf16, WS_MIX);
            for (int i = F.tid; i < 32 * 128; i += NWAVES * 64) { const int t = i >> 7, cp = i & 127; const size_t row = (size_t)row0 + t;
                const unsigned gw = *(const unsigned*)(PROJ + row * IND + 2304 + 2 * cp);
                const f32x2 hv = *(const LAS f32x2*)(hs + t * LRU_HSROW + 2 * cp);
                *(unsigned*)(MIX + row * D + 768 + 2 * cp) = pk2(gelu_tanh(bflo(gw)) * hv[0], gelu_tanh(bfhi(gw)) * hv[1]); }
        }
    }
}
__device__ __forceinline__ void lru_carry(Frame& F) {
    const f32x2* TOT = WSP(const f32x2, WS_TOT); float* CARRY = WSP(float, WS_CARRY);
    for (int it = F.gw; it < NB * 2 * 4; it += F.NGW) {
        const int b = it >> 3, dir = (it >> 2) & 1, c = (it & 3) * 64 + F.lane;
        float h = 0.f;
        for (int g = 0; g < 9; ++g) {
            f32x2 ps[8]; int tl[8];
#pragma unroll
            for (int i = 0; i < 8; ++i) { const int s = g * 8 + i;
                int T; if (s < 8) T = 1024 + b * 8 + (dir == 0 ? s : 7 - s); else T = b * 64 + (dir == 0 ? s - 8 : 71 - s);
                tl[i] = T; ps[i] = TOT[((size_t)dir * 1152 + T) * 256 + c]; }
#pragma unroll
            for (int i = 0; i < 8; ++i) { CARRY[((size_t)dir * 1152 + tl[i]) * 256 + c] = h; h = ps[i][0] * h + ps[i][1]; }
        }
    }
}

__device__ __forceinline__ void final_rows(Frame& F) {
    const float* g = F.in[24];
    for (int row = F.gw; row < ML; row += F.NGW) {
        float* xr = F.out + (size_t)row * D;
        f32x4 v[4]; float ss = 0.f;
#pragma unroll
        for (int j = 0; j < 4; ++j) { v[j] = *(const f32x4*)(xr + 4 * F.lane + 256 * j); ss += (v[j][0] * v[j][0] + v[j][1] * v[j][1]) + (v[j][2] * v[j][2] + v[j][3] * v[j][3]); }
        const float rs = rsqrtf(wave_sum(ss) * (1.f / D) + EPS);
#pragma unroll
        for (int j = 0; j < 4; ++j) { const int k = 4 * F.lane + 256 * j; *(f32x4*)(xr + k) = v[j] * rs * *(const f32x4*)(g + k); }
    }
}

constexpr int N_PHASES = 2 + 7 * DEPTH + 1;
struct Args { const float* in[25]; float* out; unsigned char* ws; int ph_lo, ph_hi; };
static_assert(sizeof(Args) == 27 * 8 + 8, "Args has no padding");

__global__ void __launch_bounds__(NWAVES * 64, 2) mega_fwd(Args args) {
    extern __shared__ __attribute__((aligned(16))) unsigned char lds[];
    Frame F;
    F.lds = (LAS unsigned char*)lds;
    F.tid = threadIdx.x; F.lane = F.tid & 63; F.wave = __builtin_amdgcn_readfirstlane(F.tid >> 6);
    F.G = gridDim.x; { const int bx = blockIdx.x; F.vcu = (F.G % 8 == 0) ? (bx % 8) * (F.G / 8) + bx / 8 : bx; }
    F.gw = F.vcu * NWAVES + F.wave; F.NGW = F.G * NWAVES;
#pragma unroll
    for (int i = 0; i < 25; ++i) F.in[i] = args.in[i];
    F.out = args.out; F.ws = args.ws;
    volatile LAS unsigned* MISC = (volatile LAS unsigned*)(F.lds + MISC_OFF);
    for (int u = F.tid; u < (LDS_BYTES - LDSCTL_OFF) / 4; u += NWAVES * 64) ((LAS unsigned*)(F.lds + LDSCTL_OFF))[u] = 0u;
    __syncthreads();
    XcdBarrier bar = xcd_barrier_post((unsigned*)(F.ws + WS_CTL) + CW_BAR, MISC + 8);

    const int lo = args.ph_lo, hi = args.ph_hi;
    for (int ph = lo; ph < hi; ++ph) {
        { int t_ = threadIdx.x; asm volatile("" : "+v"(t_)); F.tid = t_; F.lane = t_ & 63; F.wave = __builtin_amdgcn_readfirstlane(t_ >> 6); F.gw = F.vcu * NWAVES + F.wave; }
        if (ph == 0) {
#ifndef NO_P0
            phase_p0a(F);
#endif
        } else if (ph == 1) {
#ifndef NO_P0
            phase_p0b(F);
#endif
        }
        else if (ph == N_PHASES - 1) final_rows(F);
        else {
            const int l = (ph - 2) / 7, k = (ph - 2) % 7; const bool last = (l == DEPTH - 1);
            const int Mx = last ? ML : MT;
            float* MOD = WSP(float, WS_MOD);
            if (k == 0) {
                pg8::Gemm g{WSP(const bf16, WS_XA), WSP(const bf16, WS_WIN) + (size_t)l * IND * D, MT, IND, D};
                pg8::Order S; if (last) S.init(ML, IND, (MC / 256) * 5, F.G, (int)blockIdx.x); else S.init(MT, IND, 0, F.G, (int)blockIdx.x);
                pg8::EpiScale<0, IND> E{WSP(bf16, WS_PROJ), WSP(const float, WS_SHW1) + (size_t)l * 17 * IND, WSP(const float, WS_RSSA)};

#ifndef NO_G0
                pg8::gemm_phase<pg8::EpiScale<0, IND>, pg8::Order, true, true>(F.lds + RING_OFF, g, S, E, F.tid);
#endif

            } else if (k == 1) {

#ifndef NO_LRU
                lru_phase<0>(F, l, 1152);
#endif

                __syncthreads();
                const int nrows = last ? ML : MT;

#ifndef NO_CONV
                for (int row = F.gw; row < nrows; row += F.NGW) conv_row(F, l, row);
#endif

                const int nna = last ? NA_ITEMS_LAT : NA_ITEMS_LAT + NA_ITEMS_CTX;

#ifndef NO_NA
                for (int it = F.gw; it < nna; it += F.NGW) na_item(F, l, it);
#endif

            } else if (k == 2) {
                lru_carry(F);
            } else if (k == 3) {

#ifndef NO_LRU
                lru_phase<1>(F, l, last ? 1024 : 1152);
#endif

            } else if (k == 4) {
                pg8::Gemm g{WSP(const bf16, WS_MIX), WSP(const bf16, WS_WOUT) + (size_t)l * D * D, Mx, D, D};
                pg8::Order S; S.init(Mx, D, 0, F.G, (int)blockIdx.x);
                pg8::EpiRes E{l == 0 ? F.in[0] : F.out, l == 0 ? F.in[2] : WSP(const float, WS_CX), F.out, WSP(float, WS_CX),
                              MOD + (size_t)l * 17 * MODW + 2 * D, F.in[5] + l * D, MOD + (size_t)l * 17 * MODW + 4 * D, WSP(bf16, WS_XA), WSP(float, WS_RSSB)};

#ifndef NO_GR
                pg8::gemm_phase<pg8::EpiRes, pg8::Order, true, true>(F.lds + RING_OFF, g, S, E, F.tid);
#endif

            } else if (k == 5) {
                pg8::Gemm g{WSP(const bf16, WS_XA), WSP(const bf16, WS_W1) + (size_t)l * FF * D, Mx, FF, D};
                pg8::Order S; S.init(Mx, FF, 0, F.G, (int)blockIdx.x);
                pg8::EpiScale<1, FF> E{WSP(bf16, WS_HID), WSP(const float, WS_SHW2) + (size_t)l * 17 * FF, WSP(const float, WS_RSSB)};

#ifndef NO_G1
                pg8::gemm_phase<pg8::EpiScale<1, FF>, pg8::Order, true, true>(F.lds + RING_OFF, g, S, E, F.tid);
#endif

            } else {
                pg8::Gemm g{WSP(const bf16, WS_HID), WSP(const bf16, WS_W2) + (size_t)l * D * FF, Mx, D, FF};
                pg8::Order S; S.init(Mx, D, 0, F.G, (int)blockIdx.x);
                const int ln = last ? l : l + 1;
                pg8::EpiRes E{F.out, WSP(const float, WS_CX), F.out, WSP(float, WS_CX),
                              MOD + (size_t)l * 17 * MODW + 5 * D, F.in[4] + ln * D, MOD + (size_t)ln * 17 * MODW + D, last ? (bf16*)nullptr : WSP(bf16, WS_XA), WSP(float, WS_RSSA)};

#ifndef NO_GR
                pg8::gemm_phase<pg8::EpiRes, pg8::Order, true, true>(F.lds + RING_OFF, g, S, E, F.tid);
#endif

            }
        }
        if (ph + 1 < hi) xcd_barrier(bar);
    }
}

extern "C" void kernel_launch(void* const* d_in, const int* in_sizes, int n_in, void* d_out, int out_size, void* d_ws, size_t ws_size, hipStream_t stream) {
    static int grid = 0;
    if (grid == 0) {
        if (n_in != 25 || out_size != ML * D || ws_size < WS_END) { fprintf(stderr, "kernel_launch: unexpected shapes (n_in %d out %d ws %zu)\n", n_in, out_size, ws_size); grid = -1; return; }
        int dev = 0, cus = 0;
        if (hipGetDevice(&dev) != hipSuccess || hipDeviceGetAttribute(&cus, hipDeviceAttributeMultiprocessorCount, dev) != hipSuccess) { grid = -1; return; }
        if (hipFuncSetAttribute((const void*)mega_fwd, hipFuncAttributeMaxDynamicSharedMemorySize, LDS_BYTES) != hipSuccess) { fprintf(stderr, "kernel_launch: hipFuncSetAttribute failed\n"); grid = -1; return; }
        int per_cu = 0;
        if (hipOccupancyMaxActiveBlocksPerMultiprocessor(&per_cu, (const void*)mega_fwd, NWAVES * 64, LDS_BYTES) != hipSuccess || per_cu < 1) fprintf(stderr, "kernel_launch: occupancy query reports %d\n", per_cu);
        (void)hipGetLastError();
        grid = cus;
    }
    if (grid < 0) return;
    if (hipMemsetAsync((char*)d_ws + WS_CTL, 0, CTL_ZERO_BYTES, stream) != hipSuccess) return;
    Args a{};
    for (int i = 0; i < 25; ++i) a.in[i] = (const float*)d_in[i];
    a.out = (float*)d_out; a.ws = (unsigned char*)d_ws;
#if MK_N_LAUNCHES == 1
    a.ph_lo = 0; a.ph_hi = N_PHASES;
    hipLaunchKernelGGL(mega_fwd, dim3(grid), dim3(NWAVES * 64), LDS_BYTES, stream, a);
#else
    for (int ph = 0; ph < N_PHASES; ++ph) { a.ph_lo = ph; a.ph_hi = ph + 1; hipLaunchKernelGGL(mega_fwd, dim3(grid), dim3(NWAVES * 64), LDS_BYTES, stream, a); }
#endif
}
```

```cpp
#include <hip/hip_runtime.h>
#include <cstdio>
#include <cstdint>

constexpr int D = 1024, NB = 16, SEQ = 2048, CTXL = 256, DEPTH = 2;
constexpr int ML = NB * SEQ, MC = NB * CTXL, MT = ML + MC;
constexpr int IND = 2560, FF = 4096, NH = 8, HD = 64;
constexpr int MODW = 6 * D;
constexpr float EPS = 1e-6f;
#ifndef MK_N_LAUNCHES
#define MK_N_LAUNCHES 1
#endif

namespace pg8 {
#define PG8_LAS __attribute__((address_space(3)))
typedef unsigned short bf16_t;
typedef short bf16x8 __attribute__((ext_vector_type(8)));
typedef float f32x4 __attribute__((ext_vector_type(4)));
typedef unsigned u32x4 __attribute__((ext_vector_type(4)));
constexpr int BM = 256, BK = 64, HALF = 128, HTB = HALF * BK * 2, STAGE_BYTES = 8 * HTB, NXCD = 8, WGM = 8;

__host__ __device__ __forceinline__ int lds_byte(int r, int c) { const int st = (r >> 4) * 2 + (c >> 5), rr = r & 15, cc = c & 31, ob = rr * 64 + cc * 2; return st * 1024 + (ob ^ (((ob >> 9) & 1) << 5)); }
__host__ __device__ __forceinline__ void stage_rc(int b, int& R, int& C) { const int st = b / 1024, sb = b % 1024, swz = sb ^ (((sb >> 9) & 1) << 5); R = (st >> 1) * 16 + swz / 64; C = (st & 1) * 32 + (swz % 64) / 2; }
__host__ __device__ __forceinline__ int perm32(int rho) { const int n = rho >> 4, i = rho & 15; return 8 * (i >> 2) + 4 * n + (i & 3); }

struct Unit { int pm, pn; };
struct Gemm { const bf16_t* A; const bf16_t* Bt; int M, N, K; };

__host__ __device__ __forceinline__ void map_tile(int wgid, int nM, int nN, Unit& u) {
    const int nwg = nM * nN;
    { const int q = nwg / NXCD, r = nwg % NXCD, xcd = wgid % NXCD, off = wgid / NXCD; wgid = (xcd < r ? xcd * (q + 1) : r * (q + 1) + (xcd - r) * q) + off; }
    const int nig = WGM * nN, gid = wgid / nig, fm = gid * WGM, gsz = (nM - fm) < WGM ? (nM - fm) : WGM;
    u.pm = fm + ((wgid % nig) % gsz); u.pn = (wgid % nig) / gsz;
}
struct Order {
    int nM, nN, nwg, extra, G, c;
    __host__ __device__ void init(int M, int N, int extra_, int G_, int c_) { nM = M / BM; nN = N / BM; nwg = nM * nN; extra = extra_; G = G_; c = c_; }
    __host__ __device__ bool next(int i, Unit& u) const {
        const long L = (long)i * G + c;
        if (L < nwg) { map_tile((int)L, nM, nN, u); return true; }
        if (L < nwg + extra) { const int q = (int)L - nwg; u.pm = nM + q / 5; u.pn = 4 + q % 5; return true; }
        return false;
    }
    __device__ __forceinline__ void a_ready(const Unit&) const {}
    __device__ __forceinline__ void done(const Unit&) const {}
};

__device__ __forceinline__ unsigned cvt_pk_bf16(float lo, float hi) { unsigned r; asm volatile("v_cvt_pk_bf16_f32 %0, %1, %2" : "=v"(r) : "v"(lo), "v"(hi)); return r; }

__device__ __forceinline__ float row_rs(const float* RSSt, unsigned roff, int fq) {
    const f32x4 p0 = *(const f32x4*)(RSSt + (roff + 8u * (unsigned)fq)), p1 = *(const f32x4*)(RSSt + (roff + 8u * (unsigned)fq + 4u));
    float s = ((p0[0] + p0[1]) + (p0[2] + p0[3])) + ((p1[0] + p1[1]) + (p1[2] + p1[3]));
    s += __shfl_xor(s, 16); s += __shfl_xor(s, 32);
    return rsqrtf(s * (1.0f / D) + EPS);
}
template <int ACT, int LDC> struct EpiScale {
    static constexpr bool PERM = true, AFTER_DRAIN = false;
    bf16_t* O; const float* shw; const float* RSS;
    __device__ __forceinline__ void operator()(const f32x4 (&acc)[2][2][4][2], const Unit& u, int wr, int wc, int fr, int fq) const {
        const int brow = u.pm < ML / BM ? (u.pm >> 3) : NB;
        const float* sp = shw + (size_t)brow * LDC + u.pn * BM;
        bf16_t* Ot = O + (size_t)u.pm * BM * LDC + u.pn * BM;
        const float* RSSt = RSS + (size_t)u.pm * BM * 32;
        unsigned cl = (unsigned)(wc * 32 + 8 * fq);
        unsigned rl0 = (unsigned)(wr * 64 + fr);
        asm volatile("" : "+v"(cl), "+v"(rl0));
#pragma unroll
        for (int bj = 0; bj < 2; ++bj) {
            const f32x4 s0 = *(const f32x4*)(sp + (cl + (unsigned)(bj * HALF))), s1 = *(const f32x4*)(sp + (cl + (unsigned)(bj * HALF + 4)));
#pragma unroll
            for (int ai = 0; ai < 2; ++ai)
#pragma unroll
                for (int m = 0; m < 4; ++m) {
                    const float rs = row_rs(RSSt, (rl0 + (unsigned)(ai * HALF + m * 16)) * 32u, fq);
                    f32x4 v0 = acc[ai][bj][m][0] * rs + s0, v1 = acc[ai][bj][m][1] * rs + s1;
                    if (ACT == 1) {
#pragma unroll
                        for (int e = 0; e < 4; ++e) { const float a = fmaxf(v0[e], 0.f), b = fmaxf(v1[e], 0.f); v0[e] = a * a; v1[e] = b * b; }
                    }
                    u32x4 w; w.x = cvt_pk_bf16(v0[0], v0[1]); w.y = cvt_pk_bf16(v0[2], v0[3]); w.z = cvt_pk_bf16(v1[0], v1[1]); w.w = cvt_pk_bf16(v1[2], v1[3]);
                    *(u32x4*)(Ot + ((rl0 + (unsigned)(ai * HALF + m * 16)) * (unsigned)LDC + cl + (unsigned)(bj * HALF))) = w;
                }
        }
    }
};
struct EpiRes {
    static constexpr bool PERM = true, AFTER_DRAIN = false;
    const float* src_lat; const float* src_ctx; float* dst_lat; float* dst_ctx;
    const float* gate;
    const float* gmg; const float* gmsc;
    bf16_t* XA; float* RSS;
    __device__ __forceinline__ void operator()(const f32x4 (&acc)[2][2][4][2], const Unit& u, int wr, int wc, int fr, int fq) const {
        const bool lat = u.pm < ML / BM;
        const int brow = lat ? (u.pm >> 3) : NB;
        const float* src = (lat ? src_lat + (size_t)u.pm * BM * D : src_ctx + (size_t)(u.pm - ML / BM) * BM * D) + u.pn * BM;
        float* dst = (lat ? dst_lat + (size_t)u.pm * BM * D : dst_ctx + (size_t)(u.pm - ML / BM) * BM * D) + u.pn * BM;
        const float* gt = gate + (size_t)brow * MODW + u.pn * BM;
        const float* gg = gmg + u.pn * BM;
        const float* gs = gmsc + (size_t)brow * MODW + u.pn * BM;
        bf16_t* XAt = XA + (size_t)u.pm * BM * D + u.pn * BM;
        float* RSSt = RSS + (size_t)u.pm * BM * 32 + u.pn * 8 + wc;
        unsigned cl = (unsigned)(wc * 32 + 8 * fq);
        unsigned rl0 = (unsigned)(wr * 64 + fr);
        asm volatile("" : "+v"(cl), "+v"(rl0));
        const bool hasxa = XA != nullptr;
#pragma unroll
        for (int bj = 0; bj < 2; ++bj) {
            const unsigned c = cl + (unsigned)(bj * HALF);
            const f32x4 g0 = *(const f32x4*)(gt + c), g1 = *(const f32x4*)(gt + (c + 4u));
            f32x4 m0 = {0.f, 0.f, 0.f, 0.f}, m1 = {0.f, 0.f, 0.f, 0.f};
            if (hasxa) { m0 = *(const f32x4*)(gg + c) * (*(const f32x4*)(gs + c) + 1.0f); m1 = *(const f32x4*)(gg + (c + 4u)) * (*(const f32x4*)(gs + (c + 4u)) + 1.0f); }
#pragma unroll
            for (int ai = 0; ai < 2; ++ai)
#pragma unroll
                for (int m = 0; m < 4; ++m) {
                    const unsigned rl = rl0 + (unsigned)(ai * HALF + m * 16);
                    const unsigned off = rl * (unsigned)D + c;
                    const f32x4 x0 = *(const f32x4*)(src + off), x1 = *(const f32x4*)(src + (off + 4u));
                    const f32x4 y0 = x0 + g0 * acc[ai][bj][m][0], y1 = x1 + g1 * acc[ai][bj][m][1];
                    *(f32x4*)(dst + off) = y0; *(f32x4*)(dst + (off + 4u)) = y1;
                    float ss = ((y0[0] * y0[0] + y0[1] * y0[1]) + (y0[2] * y0[2] + y0[3] * y0[3])) + ((y1[0] * y1[0] + y1[1] * y1[1]) + (y1[2] * y1[2] + y1[3] * y1[3]));
                    ss += __shfl_xor(ss, 16); ss += __shfl_xor(ss, 32);
                    if (fq == 0) RSSt[rl * 32u + (unsigned)(bj * 4)] = ss;
                    if (hasxa) { const f32x4 a0 = y0 * m0, a1 = y1 * m1;
                        u32x4 w; w.x = cvt_pk_bf16(a0[0], a0[1]); w.y = cvt_pk_bf16(a0[2], a0[3]); w.z = cvt_pk_bf16(a1[0], a1[1]); w.w = cvt_pk_bf16(a1[2], a1[3]);
                        *(u32x4*)(XAt + off) = w; }
                    asm volatile("" ::: "memory");
                }
        }
    }
};

template <class Epi, class Sched, bool ALIGN_EPI = false, bool SP2 = false>
__device__ __forceinline__ void gemm_phase(PG8_LAS unsigned char* lds, const Gemm g, const Sched& S, const Epi& E, const int tid) {
    const int wid = __builtin_amdgcn_readfirstlane(tid >> 6), lane = tid & 63, wr = wid >> 2, wc = wid & 3, fr = lane & 15, fq = lane >> 4;
    const int K = g.K, nt = K / BK;
    unsigned voffA[2], voffB[2];
#pragma unroll
    for (int i = 0; i < 2; ++i) { int R, C; stage_rc(tid * 16 + i * 8192, R, C); const int Rb = Epi::PERM ? ((R & ~31) + perm32(R & 31)) : R;
        voffA[i] = (unsigned)(R * K + C) * 2u; voffB[i] = (unsigned)(Rb * K + C) * 2u; }
    const size_t kstep = (size_t)(BK * 2);
    const size_t hstep = (size_t)HALF * K * 2;
    const size_t tstep = 2 * hstep;
    const unsigned ldsw = (unsigned)wid * 1024u;
    const int aoff = lds_byte(wr * 64 + fr, fq * 8), boff = lds_byte(wc * 32 + fr, fq * 8);
#define PG8_SA(b, h) (((b) * 2 + (h)) * HTB)
#define PG8_SB(b, h) ((4 + (b) * 2 + (h)) * HTB)
#define PG8_STAGE(bufoff, gbase, voff) do { _Pragma("unroll") for (int _i = 0; _i < 2; ++_i) \
        __builtin_amdgcn_global_load_lds((const unsigned*)((const char*)(gbase) + (voff)[_i]), (PG8_LAS unsigned*)(lds + (bufoff) + ldsw + _i * 8192), 16, 0, 0); } while (0)
#define PG8_LDA(dst, b, h) do { _Pragma("unroll") for (int m = 0; m < 4; ++m) _Pragma("unroll") for (int k = 0; k < 2; ++k) dst[m][k] = *(const PG8_LAS bf16x8*)(lds + PG8_SA(b, h) + aoff + m * 2048 + k * 1024); } while (0)
#define PG8_LDB(dst, b, h) do { _Pragma("unroll") for (int n = 0; n < 2; ++n) _Pragma("unroll") for (int k = 0; k < 2; ++k) dst[n][k] = *(const PG8_LAS bf16x8*)(lds + PG8_SB(b, h) + boff + n * 2048 + k * 1024); } while (0)
#define PG8_MMA(ai, bj, At, Bt) do { __builtin_amdgcn_s_setprio(1); _Pragma("unroll") for (int m = 0; m < 4; ++m) _Pragma("unroll") for (int n = 0; n < 2; ++n) _Pragma("unroll") for (int k = 0; k < 2; ++k) \
        acc[ai][bj][m][n] = __builtin_amdgcn_mfma_f32_16x16x32_bf16(Bt[n][k], At[m][k], acc[ai][bj][m][n], 0, 0, 0); __builtin_amdgcn_s_setprio(0); } while (0)
#define PG8_WAIT_V(n) asm volatile("s_waitcnt vmcnt(" #n ")" ::: "memory")
#define PG8_WAIT_L(n) asm volatile("s_waitcnt lgkmcnt(" #n ")" ::: "memory")
#define PG8_BAR __builtin_amdgcn_s_barrier()
#define PG8_SCHED __builtin_amdgcn_sched_barrier(0)
    Unit cur, nxt; int ui = 0;
    if (!S.next(0, cur)) return;
    f32x4 acc[2][2][4][2];
#pragma unroll
    for (int a = 0; a < 2; ++a)
#pragma unroll
        for (int b = 0; b < 2; ++b)
#pragma unroll
            for (int m = 0; m < 4; ++m)
#pragma unroll
                for (int n = 0; n < 2; ++n) acc[a][b][m][n] = (f32x4){0.f, 0.f, 0.f, 0.f};
    bf16x8 At[4][2], B0[2][2], B1[2][2];
    const char* cA = (const char*)g.A + (size_t)cur.pm * tstep; const char* cB = (const char*)g.Bt + (size_t)cur.pn * tstep;
    S.a_ready(cur);
    if constexpr (SP2) {
        PG8_STAGE(PG8_SB(0, 0), cB, voffB); PG8_STAGE(PG8_SB(0, 1), cB + hstep, voffB); PG8_STAGE(PG8_SA(0, 0), cA, voffA); PG8_STAGE(PG8_SA(0, 1), cA + hstep, voffA);
        if (wr == 1) PG8_BAR;
        PG8_WAIT_V(2); PG8_BAR;
        PG8_STAGE(PG8_SB(1, 0), cB + kstep, voffB); PG8_STAGE(PG8_SA(1, 0), cA + kstep, voffA); PG8_STAGE(PG8_SB(1, 1), cB + hstep + kstep, voffB);
        PG8_WAIT_V(6); PG8_BAR;
    } else {
        PG8_STAGE(PG8_SB(0, 0), cB, voffB); PG8_STAGE(PG8_SA(0, 0), cA, voffA); PG8_STAGE(PG8_SB(0, 1), cB + hstep, voffB); PG8_STAGE(PG8_SA(0, 1), cA + hstep, voffA);
        if (wr == 1) PG8_BAR;
        PG8_WAIT_V(4); PG8_BAR;
        PG8_STAGE(PG8_SB(1, 0), cB + kstep, voffB); PG8_STAGE(PG8_SA(1, 0), cA + kstep, voffA); PG8_STAGE(PG8_SB(1, 1), cB + hstep + kstep, voffB);
        PG8_WAIT_V(6); PG8_BAR;
    }
    for (;;) {
        const bool has_next = S.next(ui + 1, nxt);
        const char* nA = has_next ? (const char*)g.A + (size_t)nxt.pm * tstep : cA; const char* nB = has_next ? (const char*)g.Bt + (size_t)nxt.pn * tstep : cB;
        for (int t = 0; t < nt; t += 2) {
            const bool last = (t == nt - 2);
            const char* a1 = cA + (size_t)(t + 1) * kstep;
            const char* a2 = last ? nA : cA + (size_t)(t + 2) * kstep; const char* b2 = last ? nB : cB + (size_t)(t + 2) * kstep;
            const char* a3 = a2 + kstep; const char* b3 = b2 + kstep;
            if (last && has_next) S.a_ready(nxt);
            if constexpr (SP2) {
            PG8_LDB(B0, 0, 0); PG8_LDB(B1, 0, 1); PG8_SCHED; PG8_LDA(At, 0, 0); PG8_STAGE(PG8_SA(1, 1), a1 + hstep, voffA);
            PG8_WAIT_V(8); PG8_WAIT_L(0); PG8_BAR; PG8_MMA(0, 0, At, B0); PG8_MMA(0, 1, At, B1); PG8_BAR; PG8_SCHED;
            PG8_LDA(At, 0, 1); PG8_STAGE(PG8_SB(0, 0), b2, voffB); PG8_STAGE(PG8_SB(0, 1), b2 + hstep, voffB); PG8_STAGE(PG8_SA(0, 0), a2, voffA);
            PG8_WAIT_V(8); PG8_WAIT_L(0); PG8_BAR; PG8_MMA(1, 0, At, B0); PG8_MMA(1, 1, At, B1); PG8_BAR; PG8_SCHED;
            PG8_LDB(B0, 1, 0); PG8_LDB(B1, 1, 1); PG8_SCHED; PG8_LDA(At, 1, 0); PG8_STAGE(PG8_SA(0, 1), a2 + hstep, voffA);
            PG8_WAIT_V(8); PG8_WAIT_L(0); PG8_BAR; PG8_MMA(0, 0, At, B0); PG8_MMA(0, 1, At, B1); PG8_BAR; PG8_SCHED;
            PG8_LDA(At, 1, 1); PG8_STAGE(PG8_SB(1, 0), b3, voffB); PG8_STAGE(PG8_SB(1, 1), b3 + hstep, voffB); PG8_STAGE(PG8_SA(1, 0), a3, voffA);
            PG8_WAIT_V(8); PG8_WAIT_L(0); PG8_BAR; PG8_MMA(1, 0, At, B0); PG8_MMA(1, 1, At, B1); PG8_BAR; PG8_SCHED;
            } else {
            PG8_LDB(B0, 0, 0); PG8_SCHED; PG8_LDA(At, 0, 0); PG8_STAGE(PG8_SA(1, 1), a1 + hstep, voffA);
            PG8_WAIT_L(8); PG8_BAR; PG8_WAIT_L(0); PG8_MMA(0, 0, At, B0); PG8_BAR; PG8_SCHED;
            PG8_LDB(B1, 0, 1); PG8_STAGE(PG8_SB(0, 0), b2, voffB);
            PG8_BAR; PG8_WAIT_L(0); PG8_MMA(0, 1, At, B1); PG8_BAR;
            PG8_LDA(At, 0, 1); PG8_STAGE(PG8_SA(0, 0), a2, voffA);
            PG8_BAR; PG8_WAIT_L(0); PG8_MMA(1, 0, At, B0); PG8_BAR; PG8_SCHED;
            PG8_STAGE(PG8_SB(0, 1), b2 + hstep, voffB);
            PG8_WAIT_V(6); PG8_BAR; PG8_MMA(1, 1, At, B1); PG8_BAR;
            PG8_LDB(B0, 1, 0); PG8_SCHED; PG8_LDA(At, 1, 0); PG8_STAGE(PG8_SA(0, 1), a2 + hstep, voffA);
            PG8_WAIT_L(8); PG8_BAR; PG8_WAIT_L(0); PG8_MMA(0, 0, At, B0); PG8_BAR; PG8_SCHED;
            PG8_LDB(B1, 1, 1); PG8_STAGE(PG8_SB(1, 0), b3, voffB);
            PG8_BAR; PG8_WAIT_L(0); PG8_MMA(0, 1, At, B1); PG8_BAR;
            PG8_LDA(At, 1, 1); PG8_STAGE(PG8_SA(1, 0), a3, voffA);
            PG8_BAR; PG8_WAIT_L(0); PG8_MMA(1, 0, At, B0); PG8_BAR; PG8_SCHED;
            PG8_STAGE(PG8_SB(1, 1), b3 + hstep, voffB);
            PG8_WAIT_V(6); PG8_BAR; PG8_MMA(1, 1, At, B1); PG8_BAR;
            }
        }
        if constexpr (ALIGN_EPI) { if (wr == 0) PG8_BAR; }
        if constexpr (!Epi::AFTER_DRAIN) { E(acc, cur, wr, wc, fr, fq); S.done(cur); }
        if (!has_next) break;
#pragma unroll
        for (int a = 0; a < 2; ++a)
#pragma unroll
            for (int b = 0; b < 2; ++b)
#pragma unroll
                for (int m = 0; m < 4; ++m)
#pragma unroll
                    for (int n = 0; n < 2; ++n) acc[a][b][m][n] = (f32x4){0.f, 0.f, 0.f, 0.f};
        cur = nxt; cA = nA; cB = nB; ++ui;
        if constexpr (ALIGN_EPI) { if (wr == 1) PG8_BAR; }
    }
    PG8_WAIT_V(0);
    if constexpr (!ALIGN_EPI) { if (wr == 0) PG8_BAR; }
    PG8_BAR;
    if constexpr (Epi::AFTER_DRAIN) { E.fused(acc, cur, wr, wc, fr, fq, lds, wid, lane); S.done(cur); }
#undef PG8_SA
#undef PG8_SB
#undef PG8_STAGE
#undef PG8_LDA
#undef PG8_LDB
#undef PG8_MMA
#undef PG8_WAIT_V
#undef PG8_WAIT_L
#undef PG8_BAR
#undef PG8_SCHED
}
}

constexpr size_t MiB = 1u << 20;
constexpr size_t WS_CTL = 0, CTL_ZERO_BYTES = 1 * MiB;
constexpr size_t WS_MOD = 1 * MiB;
constexpr size_t WS_SHW1 = 2 * MiB;
constexpr size_t WS_SHW2 = 3 * MiB;
constexpr size_t WS_RSSA = 4 * MiB;
constexpr size_t WS_RSSB = 9 * MiB;
constexpr size_t WS_TOT = 14 * MiB;
constexpr size_t WS_CARRY = 19 * MiB;
constexpr size_t WS_WLR = 21 * MiB + 512 * 1024;
constexpr size_t WS_WIN = 22 * MiB;
constexpr size_t WS_WOUT = 32 * MiB;
constexpr size_t WS_W1 = 36 * MiB;
constexpr size_t WS_W2 = 52 * MiB;
constexpr size_t WS_CX = 68 * MiB;
constexpr size_t WS_XA = 84 * MiB;
constexpr size_t WS_HID = 156 * MiB;
constexpr size_t WS_PROJ = WS_HID;
constexpr size_t WS_MIX = WS_HID + 180 * MiB;
constexpr size_t WS_END = 444 * MiB;
static_assert(WS_MIX + (size_t)MT * D * 2 <= WS_END && WS_HID + (size_t)MT * FF * 2 == WS_END, "ws map");
constexpr int CW_BAR = 4096;

constexpr int NWAVES = 8;
constexpr int RING_OFF = 0, RING_BYTES = 131072;
constexpr int LDSCTL_OFF = RING_BYTES, MISC_OFF = LDSCTL_OFF + 320;
constexpr int LDS_BYTES = 147456;

#define GAS __attribute__((address_space(1)))
#define LAS __attribute__((address_space(3)))
typedef unsigned short bf16;
typedef unsigned v4u __attribute__((ext_vector_type(4)));
typedef unsigned v2u __attribute__((ext_vector_type(2)));
typedef float f32x4 __attribute__((ext_vector_type(4)));
typedef float f32x2 __attribute__((ext_vector_type(2)));
typedef GAS unsigned gu32;
#define LDS_WAIT() asm volatile("s_waitcnt lgkmcnt(0)" ::: "memory")
#define VM_WAIT() asm volatile("s_waitcnt vmcnt(0)" ::: "memory")
__device__ __forceinline__ unsigned f2bf(float f) { unsigned u = __builtin_bit_cast(unsigned, f); return (u + 0x7fffu + ((u >> 16) & 1u)) >> 16; }
__device__ __forceinline__ unsigned pk2(float lo, float hi) { return f2bf(lo) | (f2bf(hi) << 16); }
__device__ __forceinline__ float bflo(unsigned w) { return __uint_as_float(w << 16); }
__device__ __forceinline__ float bfhi(unsigned w) { return __uint_as_float(w & 0xffff0000u); }
__device__ __forceinline__ float bf1(bf16 v) { return __uint_as_float((unsigned)v << 16); }
__device__ __forceinline__ float sigmoidf_(float x) { return __builtin_amdgcn_rcpf(1.f + __builtin_amdgcn_exp2f(-1.4426950408889634f * x)); }
__device__ __forceinline__ float siluf_(float x) { return x * sigmoidf_(x); }
__device__ __forceinline__ float gelu_tanh(float x) { const float u = 0.7978845608028654f * (x + 0.044715f * x * x * x); return x * sigmoidf_(2.f * u); }
__device__ __forceinline__ float wave_sum(float v) {
#pragma unroll
    for (int o = 1; o < 64; o <<= 1) v += __shfl_xor(v, o);
    return v;
}

#define XB_TMO      128
#define XB_XCNT(j)  (256  + 64 * (j))
#define XB_XSUB(j)  (1280 + 64 * (j))
#define XB_XGEN(j)  (2304 + 64 * (j))
#define XB_TOP      3328
#define XB_TOPGEN   3392
#define XCD_BAR_WORDS 3456
#define XB_SPIN_CAP (1u << 18)

__device__ __forceinline__ unsigned xb_ld(unsigned* p)              { return __hip_atomic_load(p, __ATOMIC_RELAXED, __HIP_MEMORY_SCOPE_AGENT); }
__device__ __forceinline__ unsigned xb_add(unsigned* p, unsigned v) { return __hip_atomic_fetch_add(p, v, __ATOMIC_RELAXED, __HIP_MEMORY_SCOPE_AGENT); }
__device__ __forceinline__ unsigned xb_xcc_id() { return (unsigned)__builtin_amdgcn_s_getreg((3 << 11) | 20) & 0xFu; }
#define XB_SPIN(cond, bar) do { unsigned _sp = 0; while (cond) { __builtin_amdgcn_s_sleep(1); \
    if ((++_sp & 255u) == 0u) { if (xb_ld(&(bar)[XB_TMO])) break; if (_sp > XB_SPIN_CAP) { atomicAdd(&(bar)[XB_TMO], 1u); break; } } } } while (0)

struct XcdBarrier {
    unsigned* bar; unsigned x;
    volatile LAS unsigned* st;
};

__device__ __forceinline__ XcdBarrier xcd_barrier_post(unsigned* bar, volatile LAS unsigned* st) {
    XcdBarrier b; b.bar = bar; b.x = xb_xcc_id(); b.st = st;
    if (threadIdx.x == 0) (void)xb_add(&bar[XB_XCNT(b.x)], 1u);
    return b;
}
__device__ __forceinline__ void xcd_barrier_complete(unsigned* bar, unsigned x, unsigned& nloc, unsigned& nx) {
    const unsigned G = gridDim.x * gridDim.y * gridDim.z;
    unsigned sum, cnt, mine, sp = 0u;
    for (;;) {
        sum = 0u; cnt = 0u; mine = 0u;
#pragma unroll
        for (unsigned j = 0; j < 16; ++j) { const unsigned c = xb_ld(&bar[XB_XCNT(j)]); sum += c; cnt += (c > 0u) ? 1u : 0u; mine = (j == x) ? c : mine; }
        if (sum == G) break;
        __builtin_amdgcn_s_sleep(1);
        if ((++sp & 255u) == 0u) { if (xb_ld(&bar[XB_TMO])) break; if (sp > XB_SPIN_CAP) { atomicAdd(&bar[XB_TMO], 1u); break; } }
    }
    nloc = mine > 0u ? mine : 1u; nx = cnt > 0u ? cnt : 1u;
}

__device__ __forceinline__ void xcd_barrier(const XcdBarrier& b) {
    asm volatile("s_waitcnt vmcnt(0)" ::: "memory");
    __syncthreads();
    if (threadIdx.x == 0) {
        unsigned* bar = b.bar;
        __builtin_amdgcn_s_waitcnt(0);
        unsigned nloc = b.st[0], nx = b.st[1];
        if (nloc == 0u) { xcd_barrier_complete(bar, b.x, nloc, nx); b.st[0] = nloc; b.st[1] = nx; }
        const unsigned old = xb_add(&bar[XB_XSUB(b.x)], 1u);
        const unsigned gen = old / nloc;
        if (old + 1u == (gen + 1u) * nloc) {
            __builtin_amdgcn_fence(__ATOMIC_RELEASE, "agent");
            asm volatile("s_waitcnt vmcnt(0)" ::: "memory");
            const unsigned og = xb_add(&bar[XB_TOP], 1u);
            const unsigned tg = og / nx;
            if (og + 1u == (tg + 1u) * nx) xb_add(&bar[XB_TOPGEN], 1u);
            else XB_SPIN(xb_ld(&bar[XB_TOPGEN]) == tg, bar);
            __builtin_amdgcn_fence(__ATOMIC_ACQUIRE, "agent");
            xb_add(&bar[XB_XGEN(b.x)], 1u);
            asm volatile("s_waitcnt vmcnt(0)" ::: "memory");
        } else {
            XB_SPIN(xb_ld(&bar[XB_XGEN(b.x)]) == gen, bar);
            __builtin_amdgcn_fence(__ATOMIC_ACQUIRE, "agent");
            asm volatile("s_waitcnt vmcnt(0)" ::: "memory");
        }
    }
    __syncthreads();
}

struct Frame {
    LAS unsigned char* lds;
    int tid, lane, wave;
    int vcu, G;
    int gw, NGW;
    const float* in[25]; float* out; unsigned char* ws;
};
#define WSP(T, off) ((T*)(F.ws + (off)))

__device__ __forceinline__ void gemv17_item(Frame& F, const LAS float* tab, LAS float* red, const float* W, int ldw, int n0, const float* bias, float* outp, int ldo) {
    float acc[17];
#pragma unroll
    for (int r = 0; r < 17; ++r) acc[r] = 0.f;
    const int k0 = F.wave * 128;
    const float* wp = W + (size_t)k0 * ldw + n0 + F.lane;
#pragma unroll 4
    for (int k = 0; k < 128; ++k) {
        const float wv = wp[(size_t)k * ldw];
#pragma unroll
        for (int r = 0; r < 17; ++r) acc[r] += tab[r * 1024 + k0 + k] * wv;
    }
#pragma unroll
    for (int r = 0; r < 17; ++r) red[(F.wave * 17 + r) * 64 + F.lane] = acc[r];
    __syncthreads();
    for (int i = F.tid; i < 17 * 64; i += NWAVES * 64) {
        const int r = i >> 6, n = i & 63; float s = bias ? bias[n0 + n] : 0.f;
#pragma unroll
        for (int w = 0; w < 8; ++w) s += red[(w * 17 + r) * 64 + n];
        outp[(size_t)r * ldo + n0 + n] = s;
    }
    __syncthreads();
}

__device__ __forceinline__ void p0_transpose_item(const float* W, int K, int N, bf16* WT, LAS float* scr, int item, int lane) {
    const int nblk = N / 32, kb = item / nblk, nb = item % nblk, k0 = 64 * kb, n0 = 32 * nb;
#pragma unroll 8
    for (int i = 0; i < 32; ++i) { const int kk = 2 * i + (lane >> 5); scr[kk * 33 + (lane & 31)] = W[(size_t)(k0 + kk) * N + n0 + (lane & 31)]; }
    LDS_WAIT(); asm volatile("" ::: "memory");
    const int c = lane & 7;
#pragma unroll
    for (int j = 0; j < 4; ++j) { const int n = (lane >> 3) + 8 * j; const LAS float* s = scr + (8 * c) * 33 + n;
        v4u o; o.x = pk2(s[0 * 33], s[1 * 33]); o.y = pk2(s[2 * 33], s[3 * 33]); o.z = pk2(s[4 * 33], s[5 * 33]); o.w = pk2(s[6 * 33], s[7 * 33]);
        *(GAS v4u*)(WT + (size_t)(n0 + n) * K + k0 + 8 * c) = o; }
    LDS_WAIT(); asm volatile("" ::: "memory");
}

__device__ __forceinline__ void phase_p0a(Frame& F) {
    LAS float* tab = (LAS float*)(F.lds);
    LAS float* red = (LAS float*)(F.lds + 17 * 1024 * 4);
    float* MOD = WSP(float, WS_MOD);
    bool filled = false;
    for (int it = F.vcu; it < 2 * 96; it += F.G) {
        if (!filled) {
            for (int i = F.tid; i < 17 * 1024; i += NWAVES * 64) { const int r = i >> 10, k = i & 1023; const float v = (r < 16) ? F.in[1][r * D + k] : F.in[3][k]; tab[i] = siluf_(v); }
            __syncthreads(); filled = true;
        }
        const int l = it / 96, n0 = (it % 96) * 64;
        gemv17_item(F, tab, red, F.in[6] + (size_t)l * D * MODW, MODW, n0, F.in[7] + (size_t)l * MODW, MOD + (size_t)l * 17 * MODW, MODW);
    }
    __syncthreads();
    {
        bf16* WLR = WSP(bf16, WS_WLR);
        for (int i = F.gw * 64 + F.lane; i < 2 * 2 * 4 * 2 * 4096; i += F.NGW * 64) { const int d = i & 63, e = (i >> 6) & 63, gt = (i >> 12) & 1, blk = i >> 13;
            const float* src = gt == 0 ? F.in[17] : F.in[19]; WLR[i] = (bf16)f2bf(src[((size_t)blk * 64 + d) * 64 + e]); }
    }
    LAS float* scr = (LAS float*)(F.lds + F.wave * 16384);
    constexpr int I_IN = (D / 64) * (IND / 32), I_OUT = (D / 64) * (D / 32), I_1 = (D / 64) * (FF / 32), I_2 = (FF / 64) * (D / 32), I_L = I_IN + I_OUT + I_1 + I_2;
    for (int it = F.gw; it < 2 * I_L; it += F.NGW) {
        const int l = it / I_L; int r = it % I_L;
        if (r < I_IN) { p0_transpose_item(F.in[8] + (size_t)l * D * IND, D, IND, WSP(bf16, WS_WIN) + (size_t)l * IND * D, scr, r, F.lane); continue; } r -= I_IN;
        if (r < I_OUT) { p0_transpose_item(F.in[9] + (size_t)l * D * D, D, D, WSP(bf16, WS_WOUT) + (size_t)l * D * D, scr, r, F.lane); continue; } r -= I_OUT;
        if (r < I_1) { p0_transpose_item(F.in[22] + (size_t)l * D * FF, D, FF, WSP(bf16, WS_W1) + (size_t)l * FF * D, scr, r, F.lane); continue; } r -= I_1;
        p0_transpose_item(F.in[23] + (size_t)l * FF * D, FF, D, WSP(bf16, WS_W2) + (size_t)l * D * FF, scr, r, F.lane);
    }
}

__device__ __forceinline__ void phase_p0b(Frame& F) {
    LAS float* tab = (LAS float*)(F.lds);
    LAS float* red = (LAS float*)(F.lds + 17 * 1024 * 4);
    const float* MOD = WSP(const float, WS_MOD);
    for (int it = F.vcu; it < 2 * 104; it += F.G) {
        const int l = it / 104, j = it % 104; const bool first = j < 40;
        const int shoff = first ? 0 : 3 * D;
        __syncthreads();
        for (int i = F.tid; i < 17 * 1024; i += NWAVES * 64) { const int r = i >> 10, k = i & 1023; tab[i] = MOD[((size_t)l * 17 + r) * MODW + shoff + k]; }
        __syncthreads();
        if (first) gemv17_item(F, tab, red, F.in[8] + (size_t)l * D * IND, IND, j * 64, nullptr, WSP(float, WS_SHW1) + (size_t)l * 17 * IND, IND);
        else gemv17_item(F, tab, red, F.in[22] + (size_t)l * D * FF, FF, (j - 40) * 64, nullptr, WSP(float, WS_SHW2) + (size_t)l * 17 * FF, FF);
    }
    bf16* XA = WSP(bf16, WS_XA); float* RSSA = WSP(float, WS_RSSA);
    const float* g1 = F.in[4];
    for (int row = F.gw; row < MT; row += F.NGW) {
        const bool lat = row < ML;
        const float* xr = lat ? F.in[0] + (size_t)row * D : F.in[2] + (size_t)(row - ML) * D;
        const int brow = lat ? (row >> 11) : NB;
        const float* sc = MOD + (size_t)brow * MODW + D;
        f32x4 v[4]; float ss = 0.f;
#pragma unroll
        for (int j = 0; j < 4; ++j) { v[j] = *(const f32x4*)(xr + 4 * F.lane + 256 * j); ss += (v[j][0] * v[j][0] + v[j][1] * v[j][1]) + (v[j][2] * v[j][2] + v[j][3] * v[j][3]); }
        ss = wave_sum(ss);
        if (F.lane < 32) RSSA[(size_t)row * 32 + F.lane] = (F.lane == 0) ? ss : 0.f;
#pragma unroll
        for (int j = 0; j < 4; ++j) { const int k = 4 * F.lane + 256 * j;
            const f32x4 gm = *(const f32x4*)(g1 + k) * (*(const f32x4*)(sc + k) + 1.0f), a = v[j] * gm;
            v2u o; o.x = pk2(a[0], a[1]); o.y = pk2(a[2], a[3]); *(v2u*)(XA + (size_t)row * D + k) = o; }
    }
}

constexpr int CV_OSROW = 260;
__device__ __forceinline__ void conv_phase(Frame& F, int l, int ntiles) {
    const bf16* PROJ = WSP(const bf16, WS_PROJ); bf16* MIX = WSP(bf16, WS_MIX);
    LAS float* us = (LAS float*)(F.lds);
    LAS float* os = (LAS float*)(F.lds + 62 * 256 * 4);
    const int c = F.tid & 255, half = F.tid >> 8;
    float w[31];
#pragma unroll
    for (int k = 0; k < 31; ++k) w[k] = F.in[10][((size_t)l * 31 + k) * 256 + c];
    const float cbias = F.in[11][l * 256 + c];
    const f32x4 lg = *(const f32x4*)(F.in[12] + l * 256 + 4 * F.lane), lb = *(const f32x4*)(F.in[13] + l * 256 + 4 * F.lane);
    for (int T = F.vcu; T < ntiles; T += F.G) {
        const int row0 = T * 32;
        int lo, hi; if (row0 < ML) { lo = row0 & ~(SEQ - 1); hi = lo + SEQ; } else { lo = row0 & ~(CTXL - 1); hi = lo + CTXL; }
        __syncthreads();
        for (int i = F.tid; i < 62 * 128; i += NWAVES * 64) { const int rr = i >> 7, cp = i & 127, row = row0 - 15 + rr;
            f32x2 u = {0.f, 0.f};
            if (row >= lo && row < hi) { const unsigned vv = *(const unsigned*)(PROJ + (size_t)row * IND + 2 * cp), gg = *(const unsigned*)(PROJ + (size_t)row * IND + 256 + 2 * cp);
                u[0] = bflo(vv) * sigmoidf_(bflo(gg)); u[1] = bfhi(vv) * sigmoidf_(bfhi(gg)); }
            *(LAS f32x2*)(us + rr * 256 + 2 * cp) = u; }
        __syncthreads();
        {
            float acc[16];
#pragma unroll
            for (int j = 0; j < 16; ++j) acc[j] = cbias;
            const LAS float* up = us + (16 * half) * 256 + c;
#pragma unroll
            for (int i = 0; i < 46; ++i) { const float x = up[i * 256];
#pragma unroll
                for (int j = 0; j < 16; ++j) if (i - j >= 0 && i - j <= 30) acc[j] += w[i - j] * x; }
#pragma unroll
            for (int j = 0; j < 16; ++j) os[(16 * half + j) * CV_OSROW + c] = acc[j];
        }
        __syncthreads();
#pragma unroll
        for (int q = 0; q < 4; ++q) { const int t = 4 * F.wave + q;
            const f32x4 v = *(const LAS f32x4*)(os + t * CV_OSROW + 4 * F.lane);
            const float mu = wave_sum((v[0] + v[1]) + (v[2] + v[3])) * (1.f / 256.f);
            const f32x4 d = v - mu;
            const float var = wave_sum((d[0] * d[0] + d[1] * d[1]) + (d[2] * d[2] + d[3] * d[3])) * (1.f / 256.f);
            const f32x4 y = d * rsqrtf(var + EPS) * lg + lb;
            v2u o; o.x = pk2(siluf_(y[0]), siluf_(y[1])); o.y = pk2(siluf_(y[2]), siluf_(y[3]));
            *(v2u*)(MIX + (size_t)(row0 + t) * D + 4 * F.lane) = o; }
    }
}

typedef short s16x8 __attribute__((ext_vector_type(8)));
typedef short s16x4 __attribute__((ext_vector_type(4)));
constexpr int NA_VROW = 160;
constexpr int NA_WLDS = 64 * NA_VROW + 2560;
constexpr int NA_ITEMS_LAT = NB * NH * 32 * 4, NA_ITEMS_CTX = NB * NH * 16;
__device__ __forceinline__ void na_item(Frame& F, int l, int it) {
    const bf16* PROJ = WSP(const bf16, WS_PROJ); bf16* MIX = WSP(bf16, WS_MIX);
    LAS unsigned char* wl = F.lds + F.wave * NA_WLDS;
    LAS float* tb = (LAS float*)(wl + 64 * NA_VROW);
    const int lane = F.lane, q16 = lane & 15, g = lane >> 4;
    const bool isctx = it >= NA_ITEMS_LAT;
    int b, h, r = 0, jq = 0, qrow0;
    if (!isctx) { jq = it & 3; r = (it >> 2) & 31; h = (it >> 7) & 7; b = it >> 10; qrow0 = b * SEQ + r * 64 + jq * 16; }
    else { const int j = it - NA_ITEMS_LAT; const int qb = j & 15; h = (j >> 4) & 7; b = j >> 7; qrow0 = ML + b * CTXL + qb * 16; }
    const bf16* Pq = PROJ + 512 + h * HD, * Pk = PROJ + 1024 + h * HD, * Pv = PROJ + 1536 + h * HD;
    s16x8 qf[2];
#pragma unroll
    for (int s = 0; s < 2; ++s) qf[s] = *(const s16x8*)(Pq + (size_t)(qrow0 + q16) * IND + 32 * s + 8 * g);
    int rs = r - 4; rs = rs < 0 ? 0 : (rs > 24 ? 24 : rs);
    const int tlo = jq < 2 ? 0 : jq - 1, thi = jq > 1 ? 3 : jq + 1;
    float madd[4][4];
    int lb;
    {
        const int qc = jq * 16 + q16; int cs = qc - 8; cs = cs < 0 ? 0 : (cs > 48 ? 48 : cs);
#pragma unroll
        for (int t = 0; t < 4; ++t)
#pragma unroll
            for (int e = 0; e < 4; ++e) madd[t][e] = ((unsigned)(16 * t + 4 * g + e - cs) < 16u) ? 0.f : -1.0e30f;
        lb = 64 + 4 * g - qc + 15;
    }
    if (!isctx) {
        const float* rpb = F.in[14] + ((size_t)l * NH + h) * 15 * 31;
        for (int i = lane; i < 640; i += 64) tb[i] = 0.f;
        for (int i = lane; i < 465; i += 64) tb[64 + i] = rpb[i] * 1.4426950408889634f;
    }
    const float c1 = 0.125f * 1.4426950408889634f;
    f32x4 O[4];
#pragma unroll
    for (int dt = 0; dt < 4; ++dt) O[dt] = (f32x4){0.f, 0.f, 0.f, 0.f};
    float m = -1.0e30f, lsum = 0.f;
    const int nch = isctx ? 4 : 12, nloc = isctx ? 0 : 8;
    const unsigned vld_key = (unsigned)(lane >> 3), vld_part = (unsigned)(lane & 7);
    LAS unsigned char* vst = wl + vld_key * NA_VROW + vld_part * 16;
    const LAS unsigned char* vtr = wl + (4 * g + (q16 >> 2)) * NA_VROW + (q16 & 3) * 8;
    auto krow_of = [&](int ch) -> int { return ch < nloc ? b * SEQ + (rs + ch) * 64 : ML + b * CTXL + (ch - nloc) * 64; };
    s16x8 kf[4][2]; v4u vr[8];
    {
        const int k0 = krow_of(0);
#pragma unroll
        for (int t = 0; t < 4; ++t) if (nloc == 0 || (t >= tlo && t <= thi)) {
#pragma unroll
            for (int s = 0; s < 2; ++s) kf[t][s] = *(const s16x8*)(Pk + (size_t)(k0 + 16 * t + q16) * IND + 32 * s + 8 * g); }
#pragma unroll
        for (int i = 0; i < 8; ++i) vr[i] = *(const v4u*)(Pv + (size_t)(k0 + (int)vld_key + 8 * i) * IND + 8 * vld_part);
    }
    for (int ch = 0; ch < nch; ++ch) {
        const bool local = ch < nloc;
#pragma unroll
        for (int i = 0; i < 8; ++i) *(LAS v4u*)(vst + i * 8 * NA_VROW) = vr[i];
        f32x4 S[4];
#pragma unroll
        for (int t = 0; t < 4; ++t) { S[t] = (f32x4){0.f, 0.f, 0.f, 0.f};
            if (!local || (t >= tlo && t <= thi)) {
#pragma unroll
                for (int s = 0; s < 2; ++s) S[t] = __builtin_amdgcn_mfma_f32_16x16x32_bf16(kf[t][s], qf[s], S[t], 0, 0, 0); } }
        if (ch + 1 < nch) {
            const int k1 = krow_of(ch + 1); const bool nlocal = ch + 1 < nloc;
#pragma unroll
            for (int t = 0; t < 4; ++t) if (!nlocal || (t >= tlo && t <= thi)) {
#pragma unroll
                for (int s = 0; s < 2; ++s) kf[t][s] = *(const s16x8*)(Pk + (size_t)(k1 + 16 * t + q16) * IND + 32 * s + 8 * g); }
#pragma unroll
            for (int i = 0; i < 8; ++i) vr[i] = *(const v4u*)(Pv + (size_t)(k1 + (int)vld_key + 8 * i) * IND + 8 * vld_part);
        }
        float cm = -1.0e30f;
        if (local) {
            const LAS float* tr_ = tb + (rs + ch - r + 7) * 31 + lb;
#pragma unroll
            for (int t = 0; t < 4; ++t) if (t >= tlo && t <= thi) {
#pragma unroll
                for (int e = 0; e < 4; ++e) { const float v = S[t][e] * c1 + tr_[16 * t + e] + madd[t][e]; S[t][e] = v; cm = fmaxf(cm, v); } }
        } else {
#pragma unroll
            for (int t = 0; t < 4; ++t)
#pragma unroll
                for (int e = 0; e < 4; ++e) { const float v = S[t][e] * c1; S[t][e] = v; cm = fmaxf(cm, v); }
        }
        cm = fmaxf(cm, __shfl_xor(cm, 16)); cm = fmaxf(cm, __shfl_xor(cm, 32));
        const float mn = fmaxf(m, cm), alpha = __builtin_amdgcn_exp2f(m - mn); m = mn;
        float ps = 0.f;
        unsigned pk[4][2];
#pragma unroll
        for (int t = 0; t < 4; ++t) {
            if (!local || (t >= tlo && t <= thi)) {
                const float p0 = __builtin_amdgcn_exp2f(S[t][0] - mn), p1 = __builtin_amdgcn_exp2f(S[t][1] - mn), p2 = __builtin_amdgcn_exp2f(S[t][2] - mn), p3 = __builtin_amdgcn_exp2f(S[t][3] - mn);
                ps += (p0 + p1) + (p2 + p3);
                pk[t][0] = pg8::cvt_pk_bf16(p0, p1); pk[t][1] = pg8::cvt_pk_bf16(p2, p3);
            } else { pk[t][0] = 0u; pk[t][1] = 0u; }
        }
        lsum = lsum * alpha + ps;
#pragma unroll
        for (int dt = 0; dt < 4; ++dt) O[dt] = O[dt] * alpha;
#pragma unroll
        for (int p = 0; p < 2; ++p) {
            if (!local || (2 * p <= thi && 2 * p + 1 >= tlo)) {
                const v4u bw = {pk[2 * p][0], pk[2 * p][1], pk[2 * p + 1][0], pk[2 * p + 1][1]};
                const s16x8 bfrag = __builtin_bit_cast(s16x8, bw);
#pragma unroll
                for (int dt = 0; dt < 4; ++dt) {
                    const s16x4 a0 = __builtin_amdgcn_ds_read_tr16_b64_v4i16((LAS s16x4*)(vtr + (2 * p) * 16 * NA_VROW + dt * 32));
                    const s16x4 a1 = __builtin_amdgcn_ds_read_tr16_b64_v4i16((LAS s16x4*)(vtr + (2 * p + 1) * 16 * NA_VROW + dt * 32));
                    const s16x8 afrag = __builtin_shufflevector(a0, a1, 0, 1, 2, 3, 4, 5, 6, 7);
                    O[dt] = __builtin_amdgcn_mfma_f32_16x16x32_bf16(afrag, bfrag, O[dt], 0, 0, 0);
                }
            }
        }
    }
    lsum += __shfl_xor(lsum, 16); lsum += __shfl_xor(lsum, 32);
    const float inv = 1.f / lsum;
    bf16* op = MIX + (size_t)(qrow0 + q16) * D + 256 + h * HD + 4 * g;
#pragma unroll
    for (int dt = 0; dt < 4; ++dt) { v2u w; w.x = pg8::cvt_pk_bf16(O[dt][0] * inv, O[dt][1] * inv); w.y = pg8::cvt_pk_bf16(O[dt][2] * inv, O[dt][3] * inv); *(v2u*)(op + 16 * dt) = w; }
}

constexpr int LRU_UCROW = 260;
constexpr int LRU_HSROW = 258;
constexpr int LRU_OFF_UC = 38 * 256 * 2, LRU_OFF_HS = LRU_OFF_UC + 2 * 32 * LRU_UCROW * 4;
static_assert(LRU_OFF_HS + 32 * LRU_HSROW * 4 <= RING_BYTES, "LRU LDS map");
template <int PASS>
__device__ __forceinline__ void lru_phase(Frame& F, int l, int ntiles) {
    const bf16* PROJ = WSP(const bf16, WS_PROJ);
    LAS bf16* rxs = (LAS bf16*)(F.lds);
    LAS float* ucf = (LAS float*)(F.lds + LRU_OFF_UC);
    LAS float* hs = (LAS float*)(F.lds + LRU_OFF_HS);
    const int lane = F.lane, j16 = lane & 15, g = lane >> 4;
    const int dir = F.wave >> 2, kb = F.wave & 3;
    const int ld = l * 2 + dir;
    s16x8 wf[2][4][2];
    {
        const bf16* WLR = WSP(const bf16, WS_WLR) + (size_t)((ld * 4 + kb) * 2) * 4096;
#pragma unroll
        for (int gt = 0; gt < 2; ++gt)
#pragma unroll
            for (int n = 0; n < 4; ++n)
#pragma unroll
                for (int s = 0; s < 2; ++s) wf[gt][n][s] = *(const s16x8*)(WLR + gt * 4096 + (16 * n + j16) * 64 + 32 * s + 8 * g);
    }
    float cbx[4], cba[4], csp[4];
#pragma unroll
    for (int n = 0; n < 4; ++n) {
        const int e = kb * 64 + 16 * n + j16, idx = ld * 256 + e;
        cbx[n] = F.in[18][idx]; cba[n] = F.in[20][idx];
        const float nl = -F.in[21][idx]; csp[n] = -8.f * (fmaxf(nl, 0.f) + log1pf(__expf(-fabsf(nl))));
    }
    const int c = F.tid & 255;
    const float s1w0 = F.in[15][(ld * 4 + 0) * 256 + c], s1w1 = F.in[15][(ld * 4 + 1) * 256 + c], s1w2 = F.in[15][(ld * 4 + 2) * 256 + c], s1w3 = F.in[15][(ld * 4 + 3) * 256 + c], s1cb = F.in[16][ld * 256 + c];
    const int base = dir == 0 ? 0 : 3;
    const bool sec16 = ((g & 1) != 0) != (dir != 0), sec32 = ((g >> 1) != 0) != (dir != 0);
    for (int T = F.vcu; T < ntiles; T += F.G) {
        const int row0 = T * 32;
        int lo, hi; if (row0 < ML) { lo = row0 & ~(SEQ - 1); hi = lo + SEQ; } else { lo = row0 & ~(CTXL - 1); hi = lo + CTXL; }
        __syncthreads();
        for (int i = F.tid; i < 38 * 128; i += NWAVES * 64) { const int rr = i >> 7, cp = i & 127, row = row0 - 3 + rr;
            ((LAS unsigned*)rxs)[i] = (row >= lo && row < hi) ? *(const unsigned*)(PROJ + (size_t)row * IND + 2048 + 2 * cp) : 0u; }
        if (PASS == 1) for (int i = F.tid; i < 32 * LRU_HSROW; i += NWAVES * 64) hs[i] = 0.f;
        __syncthreads();
        {
            float x0 = bf1(rxs[(base + 0) * 256 + c]), x1 = bf1(rxs[(base + 1) * 256 + c]), x2 = bf1(rxs[(base + 2) * 256 + c]);
#pragma unroll 8
            for (int t = 0; t < 32; ++t) {
                const float x3 = bf1(rxs[(t + base + 3) * 256 + c]);
                const float u = s1cb + s1w0 * x0 + s1w1 * x1 + s1w2 * x2 + s1w3 * x3;
                ucf[(dir * 32 + t) * LRU_UCROW + c] = u;
                x0 = x1; x1 = x2; x2 = x3;
            }
        }
        __syncthreads();
        float av[2][4][4], bv[2][4][4];
#pragma unroll
        for (int rt = 0; rt < 2; ++rt) {
            s16x8 af[2];
#pragma unroll
            for (int s = 0; s < 2; ++s) { const LAS float* up = ucf + (dir * 32 + 16 * rt + j16) * LRU_UCROW + kb * 64 + 32 * s + 8 * g;
                const f32x4 u0 = *(const LAS f32x4*)up, u1 = *(const LAS f32x4*)(up + 4);
                const v4u w = {pg8::cvt_pk_bf16(u0[0], u0[1]), pg8::cvt_pk_bf16(u0[2], u0[3]), pg8::cvt_pk_bf16(u1[0], u1[1]), pg8::cvt_pk_bf16(u1[2], u1[3])};
                af[s] = __builtin_bit_cast(s16x8, w); }
#pragma unroll
            for (int n = 0; n < 4; ++n) {
                f32x4 zx = {0.f, 0.f, 0.f, 0.f}, za = {0.f, 0.f, 0.f, 0.f};
#pragma unroll
                for (int s = 0; s < 2; ++s) { zx = __builtin_amdgcn_mfma_f32_16x16x32_bf16(af[s], wf[0][n][s], zx, 0, 0, 0); za = __builtin_amdgcn_mfma_f32_16x16x32_bf16(af[s], wf[1][n][s], za, 0, 0, 0); }
                const int e = kb * 64 + 16 * n + j16;
                const LAS float* uo = ucf + (dir * 32 + 16 * rt + 4 * g) * LRU_UCROW + e;
#pragma unroll
                for (int r = 0; r < 4; ++r) {
                    const float u = uo[r * LRU_UCROW];
                    const float gx = sigmoidf_(zx[r] + cbx[n]), ga = sigmoidf_(za[r] + cba[n]);
                    const float la = csp[n] * ga, a = __builtin_amdgcn_exp2f(1.4426950408889634f * la), y = 2.f * la;
                    const float om = y > -0.02f ? -y * (1.f + y * (0.5f + y * 0.16666667f)) : 1.f - a * a;
                    av[rt][n][r] = a;
                    bv[rt][n][r] = __builtin_amdgcn_sqrtf(om) * gx * u;
                }
            }
        }
#pragma unroll
        for (int n = 0; n < 4; ++n) {
            const int e = kb * 64 + 16 * n + j16;
            float EP[2], ES[2], TP[2], TS[2];
#pragma unroll
            for (int rt = 0; rt < 2; ++rt) {
                const float a0 = av[rt][n][0], a1 = av[rt][n][1], a2 = av[rt][n][2], a3 = av[rt][n][3], b0 = bv[rt][n][0], b1 = bv[rt][n][1], b2 = bv[rt][n][2], b3 = bv[rt][n][3];
                const float P = (a0 * a1) * (a2 * a3);
                const float S = dir == 0 ? ((b0 * a1 + b1) * a2 + b2) * a3 + b3 : ((b3 * a2 + b2) * a1 + b1) * a0 + b0;
                const float Pp = __shfl_xor(P, 16), Sp = __shfl_xor(S, 16);
                const float e1P = sec16 ? Pp : 1.f, e1S = sec16 ? Sp : 0.f;
                const float prP = P * Pp, prS = sec16 ? P * Sp + S : Pp * S + Sp;
                const float Pq = __shfl_xor(prP, 32), Sq = __shfl_xor(prS, 32);
                EP[rt] = sec32 ? Pq * e1P : e1P; ES[rt] = sec32 ? e1P * Sq + e1S : e1S;
                TP[rt] = prP * Pq; TS[rt] = sec32 ? prP * Sq + prS : Pq * prS + Sq;
            }
            const float fP = dir == 0 ? TP[0] : TP[1], fS = dir == 0 ? TS[0] : TS[1], sP = dir == 0 ? TP[1] : TP[0], sS = dir == 0 ? TS[1] : TS[0];
            if (PASS == 0) {
                if (g == 0) WSP(f32x2, WS_TOT)[((size_t)dir * 1152 + T) * 256 + e] = (f32x2){fP * sP, sP * fS + sS};
            } else {
                const float hin = WSP(const float, WS_CARRY)[((size_t)dir * 1152 + T) * 256 + e];
                const float hin2 = fP * hin + fS;
                const float h0in = dir == 0 ? hin : hin2, h1in = dir == 0 ? hin2 : hin;
#pragma unroll
                for (int rt = 0; rt < 2; ++rt) {
                    float h = EP[rt] * (rt == 0 ? h0in : h1in) + ES[rt];
                    LAS float* hp = hs + (16 * rt + 4 * g) * LRU_HSROW + e;
                    if (dir == 0) {
#pragma unroll
                        for (int r = 0; r < 4; ++r) { h = av[rt][n][r] * h + bv[rt][n][r]; __hip_atomic_fetch_add(hp + r * LRU_HSROW, h, __ATOMIC_RELAXED, __HIP_MEMORY_SCOPE_WORKGROUP); }
                    } else {
#pragma unroll
                        for (int r = 3; r >= 0; --r) { h = av[rt][n][r] * h + bv[rt][n][r]; __hip_atomic_fetch_add(hp + r * LRU_HSROW, h, __ATOMIC_RELAXED, __HIP_MEMORY_SCOPE_WORKGROUP); }
                    }
                }
            }
        }
        if (PASS == 1) {
            __syncthreads();
            bf16* MIX = WSP(bf16, WS_MIX);
            for (int i = F.tid; i < 32 * 128; i += NWAVES * 64) { const int t = i >> 7, cp = i & 127; const size_t row = (size_t)row0 + t;
                const unsigned gw = *(const unsigned*)(PROJ + row * IND + 2304 + 2 * cp);
                const f32x2 hv = *(const LAS f32x2*)(hs + t * LRU_HSROW + 2 * cp);
                *(unsigned*)(MIX + row * D + 768 + 2 * cp) = pk2(gelu_tanh(bflo(gw)) * hv[0], gelu_tanh(bfhi(gw)) * hv[1]); }
        }
    }
}
__device__ __forceinline__ void lru_carry(Frame& F) {
    const f32x2* TOT = WSP(const f32x2, WS_TOT); float* CARRY = WSP(float, WS_CARRY);
    for (int it = F.gw; it < NB * 2 * 4; it += F.NGW) {
        const int b = it >> 3, dir = (it >> 2) & 1, c = (it & 3) * 64 + F.lane;
        float h = 0.f;
        for (int g = 0; g < 9; ++g) {
            f32x2 ps[8]; int tl[8];
#pragma unroll
            for (int i = 0; i < 8; ++i) { const int s = g * 8 + i;
                int T; if (s < 8) T = 1024 + b * 8 + (dir == 0 ? s : 7 - s); else T = b * 64 + (dir == 0 ? s - 8 : 71 - s);
                tl[i] = T; ps[i] = TOT[((size_t)dir * 1152 + T) * 256 + c]; }
#pragma unroll
            for (int i = 0; i < 8; ++i) { CARRY[((size_t)dir * 1152 + tl[i]) * 256 + c] = h; h = ps[i][0] * h + ps[i][1]; }
        }
    }
}

__device__ __forceinline__ void final_rows(Frame& F) {
    const float* g = F.in[24];
    for (int row = F.gw; row < ML; row += F.NGW) {
        float* xr = F.out + (size_t)row * D;
        f32x4 v[4]; float ss = 0.f;
#pragma unroll
        for (int j = 0; j < 4; ++j) { v[j] = *(const f32x4*)(xr + 4 * F.lane + 256 * j); ss += (v[j][0] * v[j][0] + v[j][1] * v[j][1]) + (v[j][2] * v[j][2] + v[j][3] * v[j][3]); }
        const float rs = rsqrtf(wave_sum(ss) * (1.f / D) + EPS);
#pragma unroll
        for (int j = 0; j < 4; ++j) { const int k = 4 * F.lane + 256 * j; *(f32x4*)(xr + k) = v[j] * rs * *(const f32x4*)(g + k); }
    }
}

constexpr int N_PHASES = 2 + 7 * DEPTH + 1;
struct Args { const float* in[25]; float* out; unsigned char* ws; int ph_lo, ph_hi; };
static_assert(sizeof(Args) == 27 * 8 + 8, "Args has no padding");

__global__ void __launch_bounds__(NWAVES * 64, 2) mega_fwd(Args args) {
    extern __shared__ __attribute__((aligned(16))) unsigned char lds[];
    Frame F;
    F.lds = (LAS unsigned char*)lds;
    F.tid = threadIdx.x; F.lane = F.tid & 63; F.wave = __builtin_amdgcn_readfirstlane(F.tid >> 6);
    F.G = gridDim.x; { const int bx = blockIdx.x; F.vcu = (F.G % 8 == 0) ? (bx % 8) * (F.G / 8) + bx / 8 : bx; }
    F.gw = F.vcu * NWAVES + F.wave; F.NGW = F.G * NWAVES;
#pragma unroll
    for (int i = 0; i < 25; ++i) F.in[i] = args.in[i];
    F.out = args.out; F.ws = args.ws;
    volatile LAS unsigned* MISC = (volatile LAS unsigned*)(F.lds + MISC_OFF);
    for (int u = F.tid; u < (LDS_BYTES - LDSCTL_OFF) / 4; u += NWAVES * 64) ((LAS unsigned*)(F.lds + LDSCTL_OFF))[u] = 0u;
    __syncthreads();
    XcdBarrier bar = xcd_barrier_post((unsigned*)(F.ws + WS_CTL) + CW_BAR, MISC + 8);

    const int lo = args.ph_lo, hi = args.ph_hi;
#ifdef PROBE_MASK
    bool rep_done = false;
#endif
    for (int ph = lo; ph < hi; ++ph) {
        { int t_ = threadIdx.x; asm volatile("" : "+v"(t_)); F.tid = t_; F.lane = t_ & 63; F.wave = __builtin_amdgcn_readfirstlane(t_ >> 6); F.gw = F.vcu * NWAVES + F.wave; }
        if (ph == 0) {
#ifndef NO_P0
            phase_p0a(F);
#endif
        } else if (ph == 1) {
#ifndef NO_P0
            phase_p0b(F);
#endif
        }
        else if (ph == N_PHASES - 1) final_rows(F);
        else {
            const int l = (ph - 2) / 7, k = (ph - 2) % 7; const bool last = (l == DEPTH - 1);
            const int Mx = last ? ML : MT;
            float* MOD = WSP(float, WS_MOD);
            if (k == 0) {
                pg8::Gemm g{WSP(const bf16, WS_XA), WSP(const bf16, WS_WIN) + (size_t)l * IND * D, MT, IND, D};
                pg8::Order S; if (last) S.init(ML, IND, (MC / 256) * 5, F.G, (int)blockIdx.x); else S.init(MT, IND, 0, F.G, (int)blockIdx.x);
                pg8::EpiScale<0, IND> E{WSP(bf16, WS_PROJ), WSP(const float, WS_SHW1) + (size_t)l * 17 * IND, WSP(const float, WS_RSSA)};

#ifndef NO_G0
                pg8::gemm_phase<pg8::EpiScale<0, IND>, pg8::Order, true, true>(F.lds + RING_OFF, g, S, E, F.tid);
#endif

            } else if (k == 1) {

#ifndef NO_LRU
                lru_phase<0>(F, l, 1152);
#endif

                __syncthreads();
#ifndef NO_CONV
                conv_phase(F, l, last ? 1024 : 1152);
                __syncthreads();
#endif
                const int nna = last ? NA_ITEMS_LAT : NA_ITEMS_LAT + NA_ITEMS_CTX;

#ifndef NO_NA
                for (int it = F.gw; it < nna; it += F.NGW) na_item(F, l, it);
#endif

            } else if (k == 2) {
                lru_carry(F);
            } else if (k == 3) {

#ifndef NO_LRU
                lru_phase<1>(F, l, last ? 1024 : 1152);
#endif

            } else if (k == 4) {
                pg8::Gemm g{WSP(const bf16, WS_MIX), WSP(const bf16, WS_WOUT) + (size_t)l * D * D, Mx, D, D};
                pg8::Order S; S.init(Mx, D, 0, F.G, (int)blockIdx.x);
                pg8::EpiRes E{l == 0 ? F.in[0] : F.out, l == 0 ? F.in[2] : WSP(const float, WS_CX), F.out, WSP(float, WS_CX),
                              MOD + (size_t)l * 17 * MODW + 2 * D, F.in[5] + l * D, MOD + (size_t)l * 17 * MODW + 4 * D, WSP(bf16, WS_XA), WSP(float, WS_RSSB)};

#ifndef NO_GR
                pg8::gemm_phase<pg8::EpiRes, pg8::Order, true, true>(F.lds + RING_OFF, g, S, E, F.tid);
#endif

            } else if (k == 5) {
                pg8::Gemm g{WSP(const bf16, WS_XA), WSP(const bf16, WS_W1) + (size_t)l * FF * D, Mx, FF, D};
                pg8::Order S; S.init(Mx, FF, 0, F.G, (int)blockIdx.x);
                pg8::EpiScale<1, FF> E{WSP(bf16, WS_HID), WSP(const float, WS_SHW2) + (size_t)l * 17 * FF, WSP(const float, WS_RSSB)};

#ifndef NO_G1
                pg8::gemm_phase<pg8::EpiScale<1, FF>, pg8::Order, true, true>(F.lds + RING_OFF, g, S, E, F.tid);
#endif

            } else {
                pg8::Gemm g{WSP(const bf16, WS_HID), WSP(const bf16, WS_W2) + (size_t)l * D * FF, Mx, D, FF};
                pg8::Order S; S.init(Mx, D, 0, F.G, (int)blockIdx.x);
                const int ln = last ? l : l + 1;
                pg8::EpiRes E{F.out, WSP(const float, WS_CX), F.out, WSP(float, WS_CX),
                              MOD + (size_t)l * 17 * MODW + 5 * D, F.in[4] + ln * D, MOD + (size_t)ln * 17 * MODW + D, last ? (bf16*)nullptr : WSP(bf16, WS_XA), WSP(float, WS_RSSA)};

#ifndef NO_GR
                pg8::gemm_phase<pg8::EpiRes, pg8::Order, true, true>(F.lds + RING_OFF, g, S, E, F.tid);
#endif

            }
        }
#ifdef PROBE_MASK
        if (((PROBE_MASK >> ph) & 1) && !rep_done) { rep_done = true; xcd_barrier(bar); --ph; continue; }
        rep_done = false;
#endif
        if (ph + 1 < hi) xcd_barrier(bar);
    }
}

extern "C" void kernel_launch(void* const* d_in, const int* in_sizes, int n_in, void* d_out, int out_size, void* d_ws, size_t ws_size, hipStream_t stream) {
    static int grid = 0;
    if (grid == 0) {
        if (n_in != 25 || out_size != ML * D || ws_size < WS_END) { fprintf(stderr, "kernel_launch: unexpected shapes (n_in %d out %d ws %zu)\n", n_in, out_size, ws_size); grid = -1; return; }
        int dev = 0, cus = 0;
        if (hipGetDevice(&dev) != hipSuccess || hipDeviceGetAttribute(&cus, hipDeviceAttributeMultiprocessorCount, dev) != hipSuccess) { grid = -1; return; }
        if (hipFuncSetAttribute((const void*)mega_fwd, hipFuncAttributeMaxDynamicSharedMemorySize, LDS_BYTES) != hipSuccess) { fprintf(stderr, "kernel_launch: hipFuncSetAttribute failed\n"); grid = -1; return; }
        int per_cu = 0;
        if (hipOccupancyMaxActiveBlocksPerMultiprocessor(&per_cu, (const void*)mega_fwd, NWAVES * 64, LDS_BYTES) != hipSuccess || per_cu < 1) fprintf(stderr, "kernel_launch: occupancy query reports %d\n", per_cu);
        (void)hipGetLastError();
        grid = cus;
    }
    if (grid < 0) return;
    if (hipMemsetAsync((char*)d_ws + WS_CTL, 0, CTL_ZERO_BYTES, stream) != hipSuccess) return;
    Args a{};
    for (int i = 0; i < 25; ++i) a.in[i] = (const float*)d_in[i];
    a.out = (float*)d_out; a.ws = (unsigned char*)d_ws;
#if MK_N_LAUNCHES == 1
    a.ph_lo = 0; a.ph_hi = N_PHASES;
    hipLaunchKernelGGL(mega_fwd, dim3(grid), dim3(NWAVES * 64), LDS_BYTES, stream, a);
#else
    for (int ph = 0; ph < N_PHASES; ++ph) { a.ph_lo = ph; a.ph_hi = ph + 1; hipLaunchKernelGGL(mega_fwd, dim3(grid), dim3(NWAVES * 64), LDS_BYTES, stream, a); }
#endif
}
```

```cpp
#include <hip/hip_runtime.h>
#include <cstdio>
#include <cstdint>

constexpr int D = 1024, NB = 16, SEQ = 2048, CTXL = 256, DEPTH = 2;
constexpr int ML = NB * SEQ, MC = NB * CTXL, MT = ML + MC;
constexpr int IND = 2560, FF = 4096, NH = 8, HD = 64;
constexpr int MODW = 6 * D;
constexpr float EPS = 1e-6f;
#ifndef MK_N_LAUNCHES
#define MK_N_LAUNCHES 1
#endif

namespace pg8 {
#define PG8_LAS __attribute__((address_space(3)))
typedef unsigned short bf16_t;
typedef short bf16x8 __attribute__((ext_vector_type(8)));
typedef float f32x4 __attribute__((ext_vector_type(4)));
typedef unsigned u32x4 __attribute__((ext_vector_type(4)));
constexpr int BM = 256, BK = 64, HALF = 128, HTB = HALF * BK * 2, STAGE_BYTES = 8 * HTB, NXCD = 8, WGM = 8;

__host__ __device__ __forceinline__ int lds_byte(int r, int c) { const int st = (r >> 4) * 2 + (c >> 5), rr = r & 15, cc = c & 31, ob = rr * 64 + cc * 2; return st * 1024 + (ob ^ (((ob >> 9) & 1) << 5)); }
__host__ __device__ __forceinline__ void stage_rc(int b, int& R, int& C) { const int st = b / 1024, sb = b % 1024, swz = sb ^ (((sb >> 9) & 1) << 5); R = (st >> 1) * 16 + swz / 64; C = (st & 1) * 32 + (swz % 64) / 2; }
__host__ __device__ __forceinline__ int perm32(int rho) { const int n = rho >> 4, i = rho & 15; return 8 * (i >> 2) + 4 * n + (i & 3); }

struct Unit { int pm, pn; };
struct Gemm { const bf16_t* A; const bf16_t* Bt; int M, N, K; };

__host__ __device__ __forceinline__ void map_tile(int wgid, int nM, int nN, Unit& u) {
    const int nwg = nM * nN;
    { const int q = nwg / NXCD, r = nwg % NXCD, xcd = wgid % NXCD, off = wgid / NXCD; wgid = (xcd < r ? xcd * (q + 1) : r * (q + 1) + (xcd - r) * q) + off; }
    const int nig = WGM * nN, gid = wgid / nig, fm = gid * WGM, gsz = (nM - fm) < WGM ? (nM - fm) : WGM;
    u.pm = fm + ((wgid % nig) % gsz); u.pn = (wgid % nig) / gsz;
}
struct Order {
    int nM, nN, nwg, extra, G, c;
    __host__ __device__ void init(int M, int N, int extra_, int G_, int c_) { nM = M / BM; nN = N / BM; nwg = nM * nN; extra = extra_; G = G_; c = c_; }
    __host__ __device__ bool next(int i, Unit& u) const {
        const long L = (long)i * G + c;
        if (L < nwg) { map_tile((int)L, nM, nN, u); return true; }
        if (L < nwg + extra) { const int q = (int)L - nwg; u.pm = nM + q / 5; u.pn = 4 + q % 5; return true; }
        return false;
    }
    __device__ __forceinline__ void a_ready(const Unit&) const {}
    __device__ __forceinline__ void done(const Unit&) const {}
};

__device__ __forceinline__ unsigned cvt_pk_bf16(float lo, float hi) { unsigned r; asm volatile("v_cvt_pk_bf16_f32 %0, %1, %2" : "=v"(r) : "v"(lo), "v"(hi)); return r; }

template <int ACT, int LDC> struct EpiScale {
    static constexpr bool PERM = true, AFTER_DRAIN = false;
    bf16_t* O; const float* shw; const float* RSS;
    int probe;
    __device__ __forceinline__ void operator()(const f32x4 (&acc)[2][2][4][2], const Unit& u, int wr, int wc, int fr, int fq) const {
        asm volatile("" : "+s"(wr), "+s"(wc));
        const int brow = u.pm < ML / BM ? (u.pm >> 3) : NB;
        const float* sp = shw + (size_t)brow * LDC + u.pn * BM;
        bf16_t* Ot = O + (size_t)u.pm * BM * LDC + u.pn * BM;
        const float* RSSt = RSS + (size_t)u.pm * BM * 32;
        unsigned cl = (unsigned)(wc * 32 + 8 * fq);
        unsigned rl0 = (unsigned)(wr * 64 + fr);
        asm volatile("" : "+v"(cl), "+v"(rl0));
        f32x4 pa[2][4], pb[2][4], sh[2][2];
#pragma unroll
        for (int ai = 0; ai < 2; ++ai)
#pragma unroll
            for (int m = 0; m < 4; ++m) { const unsigned ro = (rl0 + (unsigned)(ai * HALF + m * 16)) * 32u + 8u * (unsigned)fq;
                if (probe == 2) { pa[ai][m] = acc[ai][0][m][0]; pb[ai][m] = acc[ai][1][m][0]; } else { pa[ai][m] = *(const f32x4*)(RSSt + ro); pb[ai][m] = *(const f32x4*)(RSSt + (ro + 4u)); } }
#pragma unroll
        for (int bj = 0; bj < 2; ++bj) { if (probe == 2) { sh[bj][0] = acc[0][bj][0][1]; sh[bj][1] = acc[1][bj][0][1]; } else { sh[bj][0] = *(const f32x4*)(sp + (cl + (unsigned)(bj * HALF))); sh[bj][1] = *(const f32x4*)(sp + (cl + (unsigned)(bj * HALF + 4))); } }
        float rs[2][4];
#pragma unroll
        for (int ai = 0; ai < 2; ++ai)
#pragma unroll
            for (int m = 0; m < 4; ++m) { const f32x4 p0 = pa[ai][m], p1 = pb[ai][m];
                float s = ((p0[0] + p0[1]) + (p0[2] + p0[3])) + ((p1[0] + p1[1]) + (p1[2] + p1[3]));
                s += __shfl_xor(s, 16); s += __shfl_xor(s, 32);
                rs[ai][m] = rsqrtf(s * (1.0f / D) + EPS); }
#pragma unroll
        for (int bj = 0; bj < 2; ++bj)
#pragma unroll
            for (int ai = 0; ai < 2; ++ai)
#pragma unroll
                for (int m = 0; m < 4; ++m) {
                    f32x4 v0 = acc[ai][bj][m][0] * rs[ai][m] + sh[bj][0], v1 = acc[ai][bj][m][1] * rs[ai][m] + sh[bj][1];
                    if (ACT == 1) {
#pragma unroll
                        for (int e = 0; e < 4; ++e) { const float a = fmaxf(v0[e], 0.f), b = fmaxf(v1[e], 0.f); v0[e] = a * a; v1[e] = b * b; }
                    }
                    u32x4 w; w.x = cvt_pk_bf16(v0[0], v0[1]); w.y = cvt_pk_bf16(v0[2], v0[3]); w.z = cvt_pk_bf16(v1[0], v1[1]); w.w = cvt_pk_bf16(v1[2], v1[3]);
                    if (probe == 0) *(u32x4*)(Ot + ((rl0 + (unsigned)(ai * HALF + m * 16)) * (unsigned)LDC + cl + (unsigned)(bj * HALF))) = w;
                    else asm volatile("" :: "v"(w));
                }
    }
};
struct EpiRes {
    static constexpr bool PERM = true, AFTER_DRAIN = false;
    const float* src_lat; const float* src_ctx; float* dst_lat; float* dst_ctx;
    const float* gate;
    const float* gmg; const float* gmsc;
    bf16_t* XA; float* RSS;
    template <int BJ, int AI0, int NAI, int M0, int NM>
    __device__ __forceinline__ void batch(const f32x4 (&acc)[2][2][4][2], const float* src, float* dst, const float* gt, const float* gg, const float* gs, bf16_t* XAt, float* RSSt, unsigned cl, unsigned rl0, int fq, bool hasxa) const {
        const unsigned c = cl + (unsigned)(BJ * HALF);
        f32x4 x0[NAI][NM], x1[NAI][NM];
#pragma unroll
        for (int a = 0; a < NAI; ++a)
#pragma unroll
            for (int m = 0; m < NM; ++m) { const unsigned off = (rl0 + (unsigned)((AI0 + a) * HALF + (M0 + m) * 16)) * (unsigned)D + c; x0[a][m] = *(const f32x4*)(src + off); x1[a][m] = *(const f32x4*)(src + (off + 4u)); }
        const f32x4 g0 = *(const f32x4*)(gt + c), g1 = *(const f32x4*)(gt + (c + 4u));
        f32x4 m0 = {0.f, 0.f, 0.f, 0.f}, m1 = {0.f, 0.f, 0.f, 0.f};
        if (hasxa) { m0 = *(const f32x4*)(gg + c) * (*(const f32x4*)(gs + c) + 1.0f); m1 = *(const f32x4*)(gg + (c + 4u)) * (*(const f32x4*)(gs + (c + 4u)) + 1.0f); }
        asm volatile("" ::: "memory");
#pragma unroll
        for (int a = 0; a < NAI; ++a)
#pragma unroll
            for (int m = 0; m < NM; ++m) {
                const unsigned rl = rl0 + (unsigned)((AI0 + a) * HALF + (M0 + m) * 16);
                const unsigned off = rl * (unsigned)D + c;
                const f32x4 y0 = x0[a][m] + g0 * acc[AI0 + a][BJ][M0 + m][0], y1 = x1[a][m] + g1 * acc[AI0 + a][BJ][M0 + m][1];
                *(f32x4*)(dst + off) = y0; *(f32x4*)(dst + (off + 4u)) = y1;
                float ss = ((y0[0] * y0[0] + y0[1] * y0[1]) + (y0[2] * y0[2] + y0[3] * y0[3])) + ((y1[0] * y1[0] + y1[1] * y1[1]) + (y1[2] * y1[2] + y1[3] * y1[3]));
                ss += __shfl_xor(ss, 16); ss += __shfl_xor(ss, 32);
                if (fq == 0) RSSt[rl * 32u + (unsigned)(BJ * 4)] = ss;
                if (hasxa) { const f32x4 a0 = y0 * m0, a1 = y1 * m1;
                    u32x4 w; w.x = cvt_pk_bf16(a0[0], a0[1]); w.y = cvt_pk_bf16(a0[2], a0[3]); w.z = cvt_pk_bf16(a1[0], a1[1]); w.w = cvt_pk_bf16(a1[2], a1[3]);
                    *(u32x4*)(XAt + off) = w; }
            }
        asm volatile("" ::: "memory");
    }
    __device__ __forceinline__ void operator()(const f32x4 (&acc)[2][2][4][2], const Unit& u, int wr, int wc, int fr, int fq) const {
        asm volatile("" : "+s"(wr), "+s"(wc));
        const bool lat = u.pm < ML / BM;
        const int brow = lat ? (u.pm >> 3) : NB;
        const float* src = (lat ? src_lat + (size_t)u.pm * BM * D : src_ctx + (size_t)(u.pm - ML / BM) * BM * D) + u.pn * BM;
        float* dst = (lat ? dst_lat + (size_t)u.pm * BM * D : dst_ctx + (size_t)(u.pm - ML / BM) * BM * D) + u.pn * BM;
        const float* gt = gate + (size_t)brow * MODW + u.pn * BM;
        const float* gg = gmg + u.pn * BM;
        const float* gs = gmsc + (size_t)brow * MODW + u.pn * BM;
        bf16_t* XAt = XA + (size_t)u.pm * BM * D + u.pn * BM;
        float* RSSt = RSS + (size_t)u.pm * BM * 32 + u.pn * 8 + wc;
        unsigned cl = (unsigned)(wc * 32 + 8 * fq);
        unsigned rl0 = (unsigned)(wr * 64 + fr);
        asm volatile("" : "+v"(cl), "+v"(rl0));
        const bool hasxa = XA != nullptr;
        batch<0, 0, 1, 0, 2>(acc, src, dst, gt, gg, gs, XAt, RSSt, cl, rl0, fq, hasxa);
        batch<0, 0, 1, 2, 2>(acc, src, dst, gt, gg, gs, XAt, RSSt, cl, rl0, fq, hasxa);
        batch<0, 1, 1, 0, 4>(acc, src, dst, gt, gg, gs, XAt, RSSt, cl, rl0, fq, hasxa);
        batch<1, 0, 2, 0, 4>(acc, src, dst, gt, gg, gs, XAt, RSSt, cl, rl0, fq, hasxa);
    }
};

template <class Epi, class Sched, bool ALIGN_EPI = false, bool SP2 = false>
__device__ __forceinline__ void gemm_phase(PG8_LAS unsigned char* lds, const Gemm g, const Sched& S, const Epi& E, const int tid) {
    const int wid = __builtin_amdgcn_readfirstlane(tid >> 6), lane = tid & 63, wr = wid >> 2, wc = wid & 3, fr = lane & 15, fq = lane >> 4;
    const int K = g.K, nt = K / BK;
    unsigned voffA[2], voffB[2];
#pragma unroll
    for (int i = 0; i < 2; ++i) { int R, C; stage_rc(tid * 16 + i * 8192, R, C); const int Rb = Epi::PERM ? ((R & ~31) + perm32(R & 31)) : R;
        voffA[i] = (unsigned)(R * K + C) * 2u; voffB[i] = (unsigned)(Rb * K + C) * 2u; }
    const size_t kstep = (size_t)(BK * 2);
    const size_t hstep = (size_t)HALF * K * 2;
    const size_t tstep = 2 * hstep;
    const unsigned ldsw = (unsigned)wid * 1024u;
    const int aoff = lds_byte(wr * 64 + fr, fq * 8), boff = lds_byte(wc * 32 + fr, fq * 8);
#define PG8_SA(b, h) (((b) * 2 + (h)) * HTB)
#define PG8_SB(b, h) ((4 + (b) * 2 + (h)) * HTB)
#define PG8_STAGE(bufoff, gbase, voff) do { _Pragma("unroll") for (int _i = 0; _i < 2; ++_i) \
        __builtin_amdgcn_global_load_lds((const unsigned*)((const char*)(gbase) + (voff)[_i]), (PG8_LAS unsigned*)(lds + (bufoff) + ldsw + _i * 8192), 16, 0, 0); } while (0)
#define PG8_LDA(dst, b, h) do { _Pragma("unroll") for (int m = 0; m < 4; ++m) _Pragma("unroll") for (int k = 0; k < 2; ++k) dst[m][k] = *(const PG8_LAS bf16x8*)(lds + PG8_SA(b, h) + aoff + m * 2048 + k * 1024); } while (0)
#define PG8_LDB(dst, b, h) do { _Pragma("unroll") for (int n = 0; n < 2; ++n) _Pragma("unroll") for (int k = 0; k < 2; ++k) dst[n][k] = *(const PG8_LAS bf16x8*)(lds + PG8_SB(b, h) + boff + n * 2048 + k * 1024); } while (0)
#define PG8_MMA(ai, bj, At, Bt) do { __builtin_amdgcn_s_setprio(1); _Pragma("unroll") for (int m = 0; m < 4; ++m) _Pragma("unroll") for (int n = 0; n < 2; ++n) _Pragma("unroll") for (int k = 0; k < 2; ++k) \
        acc[ai][bj][m][n] = __builtin_amdgcn_mfma_f32_16x16x32_bf16(Bt[n][k], At[m][k], acc[ai][bj][m][n], 0, 0, 0); __builtin_amdgcn_s_setprio(0); } while (0)
#define PG8_WAIT_V(n) asm volatile("s_waitcnt vmcnt(" #n ")" ::: "memory")
#define PG8_WAIT_L(n) asm volatile("s_waitcnt lgkmcnt(" #n ")" ::: "memory")
#define PG8_BAR __builtin_amdgcn_s_barrier()
#define PG8_SCHED __builtin_amdgcn_sched_barrier(0)
    Unit cur, nxt; int ui = 0;
    if (!S.next(0, cur)) return;
    f32x4 acc[2][2][4][2];
#pragma unroll
    for (int a = 0; a < 2; ++a)
#pragma unroll
        for (int b = 0; b < 2; ++b)
#pragma unroll
            for (int m = 0; m < 4; ++m)
#pragma unroll
                for (int n = 0; n < 2; ++n) acc[a][b][m][n] = (f32x4){0.f, 0.f, 0.f, 0.f};
    bf16x8 At[4][2], B0[2][2], B1[2][2];
    const char* cA = (const char*)g.A + (size_t)cur.pm * tstep; const char* cB = (const char*)g.Bt + (size_t)cur.pn * tstep;
    S.a_ready(cur);
    if constexpr (SP2) {
        PG8_STAGE(PG8_SB(0, 0), cB, voffB); PG8_STAGE(PG8_SB(0, 1), cB + hstep, voffB); PG8_STAGE(PG8_SA(0, 0), cA, voffA); PG8_STAGE(PG8_SA(0, 1), cA + hstep, voffA);
        if (wr == 1) PG8_BAR;
        PG8_WAIT_V(2); PG8_BAR;
        PG8_STAGE(PG8_SB(1, 0), cB + kstep, voffB); PG8_STAGE(PG8_SA(1, 0), cA + kstep, voffA); PG8_STAGE(PG8_SB(1, 1), cB + hstep + kstep, voffB);
        PG8_WAIT_V(6); PG8_BAR;
    } else {
        PG8_STAGE(PG8_SB(0, 0), cB, voffB); PG8_STAGE(PG8_SA(0, 0), cA, voffA); PG8_STAGE(PG8_SB(0, 1), cB + hstep, voffB); PG8_STAGE(PG8_SA(0, 1), cA + hstep, voffA);
        if (wr == 1) PG8_BAR;
        PG8_WAIT_V(4); PG8_BAR;
        PG8_STAGE(PG8_SB(1, 0), cB + kstep, voffB); PG8_STAGE(PG8_SA(1, 0), cA + kstep, voffA); PG8_STAGE(PG8_SB(1, 1), cB + hstep + kstep, voffB);
        PG8_WAIT_V(6); PG8_BAR;
    }
    for (;;) {
        const bool has_next = S.next(ui + 1, nxt);
        const char* nA = has_next ? (const char*)g.A + (size_t)nxt.pm * tstep : cA; const char* nB = has_next ? (const char*)g.Bt + (size_t)nxt.pn * tstep : cB;
        for (int t = 0; t < nt; t += 2) {
            const bool last = (t == nt - 2);
            const char* a1 = cA + (size_t)(t + 1) * kstep;
            const char* a2 = last ? nA : cA + (size_t)(t + 2) * kstep; const char* b2 = last ? nB : cB + (size_t)(t + 2) * kstep;
            const char* a3 = a2 + kstep; const char* b3 = b2 + kstep;
            if (last && has_next) S.a_ready(nxt);
            if constexpr (SP2) {
            PG8_LDB(B0, 0, 0); PG8_LDB(B1, 0, 1); PG8_SCHED; PG8_LDA(At, 0, 0); PG8_STAGE(PG8_SA(1, 1), a1 + hstep, voffA);
            PG8_WAIT_V(8); PG8_WAIT_L(0); PG8_BAR; PG8_MMA(0, 0, At, B0); PG8_MMA(0, 1, At, B1); PG8_BAR; PG8_SCHED;
            PG8_LDA(At, 0, 1); PG8_STAGE(PG8_SB(0, 0), b2, voffB); PG8_STAGE(PG8_SB(0, 1), b2 + hstep, voffB); PG8_STAGE(PG8_SA(0, 0), a2, voffA);
            PG8_WAIT_V(8); PG8_WAIT_L(0); PG8_BAR; PG8_MMA(1, 0, At, B0); PG8_MMA(1, 1, At, B1); PG8_BAR; PG8_SCHED;
            PG8_LDB(B0, 1, 0); PG8_LDB(B1, 1, 1); PG8_SCHED; PG8_LDA(At, 1, 0); PG8_STAGE(PG8_SA(0, 1), a2 + hstep, voffA);
            PG8_WAIT_V(8); PG8_WAIT_L(0); PG8_BAR; PG8_MMA(0, 0, At, B0); PG8_MMA(0, 1, At, B1); PG8_BAR; PG8_SCHED;
            PG8_LDA(At, 1, 1); PG8_STAGE(PG8_SB(1, 0), b3, voffB); PG8_STAGE(PG8_SB(1, 1), b3 + hstep, voffB); PG8_STAGE(PG8_SA(1, 0), a3, voffA);
            PG8_WAIT_V(8); PG8_WAIT_L(0); PG8_BAR; PG8_MMA(1, 0, At, B0); PG8_MMA(1, 1, At, B1); PG8_BAR; PG8_SCHED;
            } else {
            PG8_LDB(B0, 0, 0); PG8_SCHED; PG8_LDA(At, 0, 0); PG8_STAGE(PG8_SA(1, 1), a1 + hstep, voffA);
            PG8_WAIT_L(8); PG8_BAR; PG8_WAIT_L(0); PG8_MMA(0, 0, At, B0); PG8_BAR; PG8_SCHED;
            PG8_LDB(B1, 0, 1); PG8_STAGE(PG8_SB(0, 0), b2, voffB);
            PG8_BAR; PG8_WAIT_L(0); PG8_MMA(0, 1, At, B1); PG8_BAR;
            PG8_LDA(At, 0, 1); PG8_STAGE(PG8_SA(0, 0), a2, voffA);
            PG8_BAR; PG8_WAIT_L(0); PG8_MMA(1, 0, At, B0); PG8_BAR; PG8_SCHED;
            PG8_STAGE(PG8_SB(0, 1), b2 + hstep, voffB);
            PG8_WAIT_V(6); PG8_BAR; PG8_MMA(1, 1, At, B1); PG8_BAR;
            PG8_LDB(B0, 1, 0); PG8_SCHED; PG8_LDA(At, 1, 0); PG8_STAGE(PG8_SA(0, 1), a2 + hstep, voffA);
            PG8_WAIT_L(8); PG8_BAR; PG8_WAIT_L(0); PG8_MMA(0, 0, At, B0); PG8_BAR; PG8_SCHED;
            PG8_LDB(B1, 1, 1); PG8_STAGE(PG8_SB(1, 0), b3, voffB);
            PG8_BAR; PG8_WAIT_L(0); PG8_MMA(0, 1, At, B1); PG8_BAR;
            PG8_LDA(At, 1, 1); PG8_STAGE(PG8_SA(1, 0), a3, voffA);
            PG8_BAR; PG8_WAIT_L(0); PG8_MMA(1, 0, At, B0); PG8_BAR; PG8_SCHED;
            PG8_STAGE(PG8_SB(1, 1), b3 + hstep, voffB);
            PG8_WAIT_V(6); PG8_BAR; PG8_MMA(1, 1, At, B1); PG8_BAR;
            }
        }
        if constexpr (ALIGN_EPI) { if (wr == 0) PG8_BAR; }
        if constexpr (!Epi::AFTER_DRAIN) { E(acc, cur, wr, wc, fr, fq); S.done(cur); }
        if (!has_next) break;
#pragma unroll
        for (int a = 0; a < 2; ++a)
#pragma unroll
            for (int b = 0; b < 2; ++b)
#pragma unroll
                for (int m = 0; m < 4; ++m)
#pragma unroll
                    for (int n = 0; n < 2; ++n) acc[a][b][m][n] = (f32x4){0.f, 0.f, 0.f, 0.f};
        cur = nxt; cA = nA; cB = nB; ++ui;
        if constexpr (ALIGN_EPI) { if (wr == 1) PG8_BAR; }
    }
    PG8_WAIT_V(0);
    if constexpr (!ALIGN_EPI) { if (wr == 0) PG8_BAR; }
    PG8_BAR;
    if constexpr (Epi::AFTER_DRAIN) { E.fused(acc, cur, wr, wc, fr, fq, lds, wid, lane); S.done(cur); }
#undef PG8_SA
#undef PG8_SB
#undef PG8_STAGE
#undef PG8_LDA
#undef PG8_LDB
#undef PG8_MMA
#undef PG8_WAIT_V
#undef PG8_WAIT_L
#undef PG8_BAR
#undef PG8_SCHED
}
}

constexpr size_t MiB = 1u << 20;
constexpr size_t WS_CTL = 0, CTL_ZERO_BYTES = 1 * MiB;
constexpr size_t WS_MOD = 1 * MiB;
constexpr size_t WS_SHW1 = 2 * MiB;
constexpr size_t WS_SHW2 = 3 * MiB;
constexpr size_t WS_RSSA = 4 * MiB;
constexpr size_t WS_RSSB = 9 * MiB;
constexpr size_t WS_TOT = 14 * MiB;
constexpr size_t WS_CARRY = 19 * MiB;
constexpr size_t WS_WLR = 21 * MiB + 512 * 1024;
constexpr size_t WS_WIN = 22 * MiB;
constexpr size_t WS_WOUT = 32 * MiB;
constexpr size_t WS_W1 = 36 * MiB;
constexpr size_t WS_W2 = 52 * MiB;
constexpr size_t WS_CX = 68 * MiB;
constexpr size_t WS_XA = 84 * MiB;
constexpr size_t WS_HID = 156 * MiB;
constexpr size_t WS_PROJ = WS_HID;
constexpr size_t WS_MIX = WS_HID + 180 * MiB;
constexpr size_t WS_END = 444 * MiB;
static_assert(WS_MIX + (size_t)MT * D * 2 <= WS_END && WS_HID + (size_t)MT * FF * 2 == WS_END, "ws map");
constexpr int CW_BAR = 4096;

constexpr int NWAVES = 8;
constexpr int RING_OFF = 0, RING_BYTES = 131072;
constexpr int LDSCTL_OFF = RING_BYTES, MISC_OFF = LDSCTL_OFF + 320;
constexpr int LDS_BYTES = 147456;

#define GAS __attribute__((address_space(1)))
#define LAS __attribute__((address_space(3)))
typedef unsigned short bf16;
typedef unsigned v4u __attribute__((ext_vector_type(4)));
typedef unsigned v2u __attribute__((ext_vector_type(2)));
typedef float f32x4 __attribute__((ext_vector_type(4)));
typedef float f32x2 __attribute__((ext_vector_type(2)));
typedef GAS unsigned gu32;
#define LDS_WAIT() asm volatile("s_waitcnt lgkmcnt(0)" ::: "memory")
#define VM_WAIT() asm volatile("s_waitcnt vmcnt(0)" ::: "memory")
__device__ __forceinline__ unsigned f2bf(float f) { unsigned u = __builtin_bit_cast(unsigned, f); return (u + 0x7fffu + ((u >> 16) & 1u)) >> 16; }
__device__ __forceinline__ unsigned pk2(float lo, float hi) { return f2bf(lo) | (f2bf(hi) << 16); }
__device__ __forceinline__ float bflo(unsigned w) { return __uint_as_float(w << 16); }
__device__ __forceinline__ float bfhi(unsigned w) { return __uint_as_float(w & 0xffff0000u); }
__device__ __forceinline__ float bf1(bf16 v) { return __uint_as_float((unsigned)v << 16); }
__device__ __forceinline__ float sigmoidf_(float x) { return __builtin_amdgcn_rcpf(1.f + __builtin_amdgcn_exp2f(-1.4426950408889634f * x)); }
__device__ __forceinline__ float siluf_(float x) { return x * sigmoidf_(x); }
__device__ __forceinline__ float gelu_tanh(float x) { const float u = 0.7978845608028654f * (x + 0.044715f * x * x * x); return x * sigmoidf_(2.f * u); }
__device__ __forceinline__ float wave_sum(float v) {
#pragma unroll
    for (int o = 1; o < 64; o <<= 1) v += __shfl_xor(v, o);
    return v;
}

#define XB_TMO      128
#define XB_XCNT(j)  (256  + 64 * (j))
#define XB_XSUB(j)  (1280 + 64 * (j))
#define XB_XGEN(j)  (2304 + 64 * (j))
#define XB_TOP      3328
#define XB_TOPGEN   3392
#define XCD_BAR_WORDS 3456
#define XB_SPIN_CAP (1u << 18)

__device__ __forceinline__ unsigned xb_ld(unsigned* p)              { return __hip_atomic_load(p, __ATOMIC_RELAXED, __HIP_MEMORY_SCOPE_AGENT); }
__device__ __forceinline__ unsigned xb_add(unsigned* p, unsigned v) { return __hip_atomic_fetch_add(p, v, __ATOMIC_RELAXED, __HIP_MEMORY_SCOPE_AGENT); }
__device__ __forceinline__ unsigned xb_xcc_id() { return (unsigned)__builtin_amdgcn_s_getreg((3 << 11) | 20) & 0xFu; }
#define XB_SPIN(cond, bar) do { unsigned _sp = 0; while (cond) { __builtin_amdgcn_s_sleep(1); \
    if ((++_sp & 255u) == 0u) { if (xb_ld(&(bar)[XB_TMO])) break; if (_sp > XB_SPIN_CAP) { atomicAdd(&(bar)[XB_TMO], 1u); break; } } } } while (0)

struct XcdBarrier {
    unsigned* bar; unsigned x;
    volatile LAS unsigned* st;
};

__device__ __forceinline__ XcdBarrier xcd_barrier_post(unsigned* bar, volatile LAS unsigned* st, int tid) {
    XcdBarrier b; b.bar = bar; b.x = xb_xcc_id(); b.st = st;
    if (tid == 0) (void)xb_add(&bar[XB_XCNT(b.x)], 1u);
    return b;
}
__device__ __forceinline__ void xcd_barrier_complete(unsigned* bar, unsigned x, unsigned& nloc, unsigned& nx) {
    const unsigned G = gridDim.x * gridDim.y * gridDim.z;
    unsigned sum, cnt, mine, sp = 0u;
    for (;;) {
        sum = 0u; cnt = 0u; mine = 0u;
#pragma unroll 1
        for (unsigned j = 0; j < 16; ++j) { const unsigned c = xb_ld(&bar[XB_XCNT(j)]); sum += c; cnt += (c > 0u) ? 1u : 0u; mine = (j == x) ? c : mine; }
        if (sum == G) break;
        __builtin_amdgcn_s_sleep(1);
        if ((++sp & 255u) == 0u) { if (xb_ld(&bar[XB_TMO])) break; if (sp > XB_SPIN_CAP) { atomicAdd(&bar[XB_TMO], 1u); break; } }
    }
    nloc = mine > 0u ? mine : 1u; nx = cnt > 0u ? cnt : 1u;
}

__device__ __forceinline__ void xcd_barrier(const XcdBarrier& b, int tid) {
    asm volatile("s_waitcnt vmcnt(0)" ::: "memory");
    __syncthreads();
    if (tid == 0) {
        unsigned* bar = b.bar;
        __builtin_amdgcn_s_waitcnt(0);
        unsigned nloc = b.st[0], nx = b.st[1];
        if (nloc == 0u) { xcd_barrier_complete(bar, b.x, nloc, nx); b.st[0] = nloc; b.st[1] = nx; }
        const unsigned old = xb_add(&bar[XB_XSUB(b.x)], 1u);
        const unsigned gen = old / nloc;
        if (old + 1u == (gen + 1u) * nloc) {
            __builtin_amdgcn_fence(__ATOMIC_RELEASE, "agent");
            asm volatile("s_waitcnt vmcnt(0)" ::: "memory");
            const unsigned og = xb_add(&bar[XB_TOP], 1u);
            const unsigned tg = og / nx;
            if (og + 1u == (tg + 1u) * nx) xb_add(&bar[XB_TOPGEN], 1u);
            else XB_SPIN(xb_ld(&bar[XB_TOPGEN]) == tg, bar);
            __builtin_amdgcn_fence(__ATOMIC_ACQUIRE, "agent");
            xb_add(&bar[XB_XGEN(b.x)], 1u);
            asm volatile("s_waitcnt vmcnt(0)" ::: "memory");
        } else {
            XB_SPIN(xb_ld(&bar[XB_XGEN(b.x)]) == gen, bar);
            __builtin_amdgcn_fence(__ATOMIC_ACQUIRE, "agent");
            asm volatile("s_waitcnt vmcnt(0)" ::: "memory");
        }
    }
    __syncthreads();
}

struct Frame {
    LAS unsigned char* lds;
    int tid, lane, wave;
    int vcu, G;
    int gw, NGW;
    float* out; unsigned char* ws;
};
constexpr int PTR_OFF = LDSCTL_OFF + 512;
__device__ __forceinline__ const float* inp_(LAS unsigned char* lds, int i) {
    const unsigned long long v = *(const LAS unsigned long long*)(lds + PTR_OFF + 8 * i);
    const unsigned lo = __builtin_amdgcn_readfirstlane((unsigned)v), hi = __builtin_amdgcn_readfirstlane((unsigned)(v >> 32));
    return (const float*)(((unsigned long long)hi << 32) | lo);
}
#define INP(i) inp_(F.lds, (i))
#define WSP(T, off) ((T*)(F.ws + (off)))

__device__ __forceinline__ void gemv17_item(Frame& F, const LAS float* tab, LAS float* red, const float* W, int ldw, int n0, const float* bias, float* outp, int ldo) {
    float acc[17];
#pragma unroll
    for (int r = 0; r < 17; ++r) acc[r] = 0.f;
    const int k0 = F.wave * 128;
    const float* wp = W + (size_t)k0 * ldw + n0 + F.lane;
#pragma unroll 4
    for (int k = 0; k < 128; ++k) {
        const float wv = wp[(size_t)k * ldw];
#pragma unroll
        for (int r = 0; r < 17; ++r) acc[r] += tab[r * 1024 + k0 + k] * wv;
    }
#pragma unroll
    for (int r = 0; r < 17; ++r) red[(F.wave * 17 + r) * 64 + F.lane] = acc[r];
    __syncthreads();
    for (int i = F.tid; i < 17 * 64; i += NWAVES * 64) {
        const int r = i >> 6, n = i & 63; float s = bias ? bias[n0 + n] : 0.f;
#pragma unroll
        for (int w = 0; w < 8; ++w) s += red[(w * 17 + r) * 64 + n];
        outp[(size_t)r * ldo + n0 + n] = s;
    }
    __syncthreads();
}

__device__ __forceinline__ void p0_transpose_item(const float* W, int K, int N, bf16* WT, LAS float* scr, int item, int lane) {
    const int nblk = N / 32, kb = item / nblk, nb = item % nblk, k0 = 64 * kb, n0 = 32 * nb;
#pragma unroll 8
    for (int i = 0; i < 32; ++i) { const int kk = 2 * i + (lane >> 5); scr[kk * 33 + (lane & 31)] = W[(size_t)(k0 + kk) * N + n0 + (lane & 31)]; }
    LDS_WAIT(); asm volatile("" ::: "memory");
    const int c = lane & 7;
#pragma unroll
    for (int j = 0; j < 4; ++j) { const int n = (lane >> 3) + 8 * j; const LAS float* s = scr + (8 * c) * 33 + n;
        v4u o; o.x = pk2(s[0 * 33], s[1 * 33]); o.y = pk2(s[2 * 33], s[3 * 33]); o.z = pk2(s[4 * 33], s[5 * 33]); o.w = pk2(s[6 * 33], s[7 * 33]);
        *(GAS v4u*)(WT + (size_t)(n0 + n) * K + k0 + 8 * c) = o; }
    LDS_WAIT(); asm volatile("" ::: "memory");
}

__device__ __forceinline__ void phase_p0a(Frame& F) {
    LAS float* tab = (LAS float*)(F.lds);
    LAS float* red = (LAS float*)(F.lds + 17 * 1024 * 4);
    float* MOD = WSP(float, WS_MOD);
    bool filled = false;
    for (int it = F.vcu; it < 2 * 96; it += F.G) {
        if (!filled) {
            for (int i = F.tid; i < 17 * 1024; i += NWAVES * 64) { const int r = i >> 10, k = i & 1023; const float v = (r < 16) ? INP(1)[r * D + k] : INP(3)[k]; tab[i] = siluf_(v); }
            __syncthreads(); filled = true;
        }
        const int l = it / 96, n0 = (it % 96) * 64;
        gemv17_item(F, tab, red, INP(6) + (size_t)l * D * MODW, MODW, n0, INP(7) + (size_t)l * MODW, MOD + (size_t)l * 17 * MODW, MODW);
    }
    __syncthreads();
    {
        bf16* WLR = WSP(bf16, WS_WLR);
        for (int i = F.gw * 64 + F.lane; i < 2 * 2 * 4 * 2 * 4096; i += F.NGW * 64) { const int d = i & 63, e = (i >> 6) & 63, gt = (i >> 12) & 1, blk = i >> 13;
            const float* src = gt == 0 ? INP(17) : INP(19); WLR[i] = (bf16)f2bf(src[((size_t)blk * 64 + d) * 64 + e]); }
    }
    LAS float* scr = (LAS float*)(F.lds + F.wave * 16384);
    constexpr int I_IN = (D / 64) * (IND / 32), I_OUT = (D / 64) * (D / 32), I_1 = (D / 64) * (FF / 32), I_2 = (FF / 64) * (D / 32), I_L = I_IN + I_OUT + I_1 + I_2;
    for (int it = F.gw; it < 2 * I_L; it += F.NGW) {
        const int l = it / I_L; int r = it % I_L;
        const float* W; bf16* WT; int K = D, N;
        if (r < I_IN) { W = INP(8) + (size_t)l * D * IND; WT = WSP(bf16, WS_WIN) + (size_t)l * IND * D; N = IND; }
        else if (r < I_IN + I_OUT) { r -= I_IN; W = INP(9) + (size_t)l * D * D; WT = WSP(bf16, WS_WOUT) + (size_t)l * D * D; N = D; }
        else if (r < I_IN + I_OUT + I_1) { r -= I_IN + I_OUT; W = INP(22) + (size_t)l * D * FF; WT = WSP(bf16, WS_W1) + (size_t)l * FF * D; N = FF; }
        else { r -= I_IN + I_OUT + I_1; W = INP(23) + (size_t)l * FF * D; WT = WSP(bf16, WS_W2) + (size_t)l * D * FF; K = FF; N = D; }
        p0_transpose_item(W, K, N, WT, scr, r, F.lane);
    }
}

__device__ __forceinline__ void phase_p0b(Frame& F) {
    LAS float* tab = (LAS float*)(F.lds);
    LAS float* red = (LAS float*)(F.lds + 17 * 1024 * 4);
    const float* MOD = WSP(const float, WS_MOD);
    for (int it = F.vcu; it < 2 * 104; it += F.G) {
        const int l = it / 104, j = it % 104; const bool first = j < 40;
        const int shoff = first ? 0 : 3 * D;
        __syncthreads();
        for (int i = F.tid; i < 17 * 1024; i += NWAVES * 64) { const int r = i >> 10, k = i & 1023; tab[i] = MOD[((size_t)l * 17 + r) * MODW + shoff + k]; }
        __syncthreads();
        const int ldw = first ? IND : FF;
        gemv17_item(F, tab, red, first ? INP(8) + (size_t)l * D * IND : INP(22) + (size_t)l * D * FF, ldw, (first ? j : j - 40) * 64, nullptr,
                    first ? WSP(float, WS_SHW1) + (size_t)l * 17 * IND : WSP(float, WS_SHW2) + (size_t)l * 17 * FF, ldw);
    }
    bf16* XA = WSP(bf16, WS_XA); float* RSSA = WSP(float, WS_RSSA);
    const float* g1 = INP(4);
    for (int row = F.gw; row < MT; row += F.NGW) {
        const bool lat = row < ML;
        const float* xr = lat ? INP(0) + (size_t)row * D : INP(2) + (size_t)(row - ML) * D;
        const int brow = lat ? (row >> 11) : NB;
        const float* sc = MOD + (size_t)brow * MODW + D;
        f32x4 v[4]; float ss = 0.f;
#pragma unroll
        for (int j = 0; j < 4; ++j) { v[j] = *(const f32x4*)(xr + 4 * F.lane + 256 * j); ss += (v[j][0] * v[j][0] + v[j][1] * v[j][1]) + (v[j][2] * v[j][2] + v[j][3] * v[j][3]); }
        ss = wave_sum(ss);
        if (F.lane < 32) RSSA[(size_t)row * 32 + F.lane] = (F.lane == 0) ? ss : 0.f;
#pragma unroll
        for (int j = 0; j < 4; ++j) { const int k = 4 * F.lane + 256 * j;
            const f32x4 gm = *(const f32x4*)(g1 + k) * (*(const f32x4*)(sc + k) + 1.0f), a = v[j] * gm;
            v2u o; o.x = pk2(a[0], a[1]); o.y = pk2(a[2], a[3]); *(v2u*)(XA + (size_t)row * D + k) = o; }
    }
}

constexpr int CV_OSROW = 260;
__device__ __forceinline__ void conv_phase(Frame& F, int l, int ntiles) {
    const bf16* PROJ = WSP(const bf16, WS_PROJ); bf16* MIX = WSP(bf16, WS_MIX);
    LAS float* us = (LAS float*)(F.lds);
    LAS float* os = (LAS float*)(F.lds + 62 * 256 * 4);
    const int c = F.tid & 255, half = F.tid >> 8;
    float w[31];
#pragma unroll
    for (int k = 0; k < 31; ++k) w[k] = INP(10)[((size_t)l * 31 + k) * 256 + c];
    const float cbias = INP(11)[l * 256 + c];
    const f32x4 lg = *(const f32x4*)(INP(12) + l * 256 + 4 * F.lane), lb = *(const f32x4*)(INP(13) + l * 256 + 4 * F.lane);
    unsigned pv[16], pg[16];
    auto load_tile = [&](int T) {
        const int row0 = T * 32;
        int lo, hi; if (row0 < ML) { lo = row0 & ~(SEQ - 1); hi = lo + SEQ; } else { lo = row0 & ~(CTXL - 1); hi = lo + CTXL; }
#pragma unroll
        for (int j = 0; j < 16; ++j) { const int i = F.tid + 512 * j, rr = i >> 7, cp = i & 127, row = row0 - 15 + rr;
            const bool ok = (j < 15 || F.tid < 256) && row >= lo && row < hi;
            pv[j] = ok ? *(const unsigned*)(PROJ + (size_t)row * IND + 2 * cp) : 0u; pg[j] = ok ? *(const unsigned*)(PROJ + (size_t)row * IND + 256 + 2 * cp) : 0u; }
    };
    if (F.vcu < ntiles) load_tile(F.vcu);
    for (int T = F.vcu; T < ntiles; T += F.G) {
        const int row0 = T * 32;
        __syncthreads();
#pragma unroll
        for (int j = 0; j < 16; ++j) { const int i = F.tid + 512 * j;
            if (j < 15 || F.tid < 256) { f32x2 u; u[0] = bflo(pv[j]) * sigmoidf_(bflo(pg[j])); u[1] = bfhi(pv[j]) * sigmoidf_(bfhi(pg[j])); *(LAS f32x2*)(us + 2 * i) = u; } }
        if (T + F.G < ntiles) load_tile(T + F.G);
        __syncthreads();
        {
            float acc[16];
#pragma unroll
            for (int j = 0; j < 16; ++j) acc[j] = cbias;
            const LAS float* up = us + (16 * half) * 256 + c;
#pragma unroll
            for (int i = 0; i < 46; ++i) { const float x = up[i * 256];
#pragma unroll
                for (int j = 0; j < 16; ++j) if (i - j >= 0 && i - j <= 30) acc[j] += w[i - j] * x; }
#pragma unroll
            for (int j = 0; j < 16; ++j) os[(16 * half + j) * CV_OSROW + c] = acc[j];
        }
        __syncthreads();
#pragma unroll
        for (int q = 0; q < 4; ++q) { const int t = 4 * F.wave + q;
            const f32x4 v = *(const LAS f32x4*)(os + t * CV_OSROW + 4 * F.lane);
            const float mu = wave_sum((v[0] + v[1]) + (v[2] + v[3])) * (1.f / 256.f);
            const f32x4 d = v - mu;
            const float var = wave_sum((d[0] * d[0] + d[1] * d[1]) + (d[2] * d[2] + d[3] * d[3])) * (1.f / 256.f);
            const f32x4 y = d * rsqrtf(var + EPS) * lg + lb;
            v2u o; o.x = pk2(siluf_(y[0]), siluf_(y[1])); o.y = pk2(siluf_(y[2]), siluf_(y[3]));
            *(v2u*)(MIX + (size_t)(row0 + t) * D + 4 * F.lane) = o; }
    }
}

typedef short s16x8 __attribute__((ext_vector_type(8)));
typedef short s16x4 __attribute__((ext_vector_type(4)));
constexpr int NA_KROW = 144, NA_VROW = 160;
constexpr int NA_STAGE = 64 * NA_KROW + 64 * NA_VROW, NA_OFF_TB = 2 * NA_STAGE;
constexpr int NA_ITEMS_LAT = NB * NH * 16, NA_ITEMS_CTX = NB * NH * 2;
__device__ __forceinline__ void na_phase(Frame& F, int l, int nitems) {
    const bf16* PROJ = WSP(const bf16, WS_PROJ); bf16* MIX = WSP(bf16, WS_MIX);
    LAS float* tb = (LAS float*)(F.lds + NA_OFF_TB);
    const int lane = F.lane, q16 = lane & 15, g = lane >> 4;
    const unsigned skey = (unsigned)(F.tid >> 3), spart = (unsigned)(F.tid & 7);
    const float c1 = 0.125f * 1.4426950408889634f;
    for (int it = F.vcu; it < nitems; it += F.G) {
        const bool isctx = it >= NA_ITEMS_LAT;
        int b, h, r = 0, jq = 0, qrow0, rsA = 0, nloc = 0;
        if (!isctx) { const int rp = it & 15; h = (it >> 4) & 7; b = it >> 7; const int r0 = 2 * rp; r = r0 + (F.wave >> 2); jq = F.wave & 3; qrow0 = b * SEQ + r * 64 + jq * 16;
            rsA = r0 - 4; rsA = rsA < 0 ? 0 : (rsA > 24 ? 24 : rsA); int rsB = r0 - 3; rsB = rsB < 0 ? 0 : (rsB > 24 ? 24 : rsB); nloc = rsB + 8 - rsA; }
        else { const int j = it - NA_ITEMS_LAT; const int hf = j & 1; h = (j >> 1) & 7; b = j >> 4; qrow0 = ML + b * CTXL + hf * 128 + F.wave * 16; }
        const int nch = nloc + 4;
        const bf16* Pq = PROJ + 512 + h * HD, * Pk = PROJ + 1024 + h * HD + 8 * spart, * Pv = PROJ + 1536 + h * HD + 8 * spart;
        auto krow_of = [&](int ch) -> int { return ch < nloc ? b * SEQ + (rsA + ch) * 64 : ML + b * CTXL + (ch - nloc) * 64; };
        s16x8 qf[2];
#pragma unroll
        for (int s = 0; s < 2; ++s) qf[s] = *(const s16x8*)(Pq + (size_t)(qrow0 + q16) * IND + 32 * s + 8 * g);
        int rs = r - 4; rs = rs < 0 ? 0 : (rs > 24 ? 24 : rs);
        const int tlo = jq < 2 ? 0 : jq - 1, thi = jq > 1 ? 3 : jq + 1;
        float madd[4][4]; int lb;
        {
            const int qc = jq * 16 + q16; int cs = qc - 8; cs = cs < 0 ? 0 : (cs > 48 ? 48 : cs);
#pragma unroll
            for (int t = 0; t < 4; ++t)
#pragma unroll
                for (int e = 0; e < 4; ++e) madd[t][e] = ((unsigned)(16 * t + 4 * g + e - cs) < 16u) ? 0.f : -1.0e30f;
            lb = 64 + 4 * g - qc + 15;
        }
        v4u kr_ = *(const v4u*)(Pk + (size_t)(krow_of(0) + (int)skey) * IND), vr_ = *(const v4u*)(Pv + (size_t)(krow_of(0) + (int)skey) * IND);
        __syncthreads();
        if (!isctx) { const float* rpb = INP(14) + ((size_t)l * NH + h) * 15 * 31;
            for (int i = F.tid; i < 640; i += NWAVES * 64) tb[i] = (i >= 64 && i < 64 + 465) ? rpb[i - 64] * 1.4426950408889634f : 0.f; }
        *(LAS v4u*)(F.lds + skey * NA_KROW + spart * 16) = kr_; *(LAS v4u*)(F.lds + 64 * NA_KROW + skey * NA_VROW + spart * 16) = vr_;
        kr_ = *(const v4u*)(Pk + (size_t)(krow_of(1) + (int)skey) * IND); vr_ = *(const v4u*)(Pv + (size_t)(krow_of(1) + (int)skey) * IND);
        f32x4 O[4];
#pragma unroll
        for (int dt = 0; dt < 4; ++dt) O[dt] = (f32x4){0.f, 0.f, 0.f, 0.f};
        float m = -1.0e30f, lsum = 0.f;
        for (int ch = 0; ch < nch; ++ch) {
            __syncthreads();
            LAS unsigned char* cur = F.lds + (ch & 1) * NA_STAGE; LAS unsigned char* nxt = F.lds + ((ch + 1) & 1) * NA_STAGE;
            if (ch + 1 < nch) { *(LAS v4u*)(nxt + skey * NA_KROW + spart * 16) = kr_; *(LAS v4u*)(nxt + 64 * NA_KROW + skey * NA_VROW + spart * 16) = vr_; }
            if (ch + 2 < nch) { const int k2 = krow_of(ch + 2) + (int)skey; kr_ = *(const v4u*)(Pk + (size_t)k2 * IND); vr_ = *(const v4u*)(Pv + (size_t)k2 * IND); }
            const bool local = ch < nloc;
            if (local) { const int kr = rsA + ch; if (kr < rs || kr > rs + 7) continue; }
            const LAS unsigned char* kb_ = cur + q16 * NA_KROW + 16 * g;
            const LAS unsigned char* vtr = cur + 64 * NA_KROW + (4 * g + (q16 >> 2)) * NA_VROW + (q16 & 3) * 8;
            f32x4 S[4];
#pragma unroll
            for (int t = 0; t < 4; ++t) { S[t] = (f32x4){0.f, 0.f, 0.f, 0.f};
                if (!local || (t >= tlo && t <= thi)) {
#pragma unroll
                    for (int s = 0; s < 2; ++s) { const s16x8 kf = *(const LAS s16x8*)(kb_ + t * 16 * NA_KROW + 64 * s); S[t] = __builtin_amdgcn_mfma_f32_16x16x32_bf16(kf, qf[s], S[t], 0, 0, 0); } } }
            float cm = -1.0e30f;
            if (local) {
                const LAS float* tr_ = tb + (rsA + ch - r + 7) * 31 + lb;
#pragma unroll
                for (int t = 0; t < 4; ++t) if (t >= tlo && t <= thi) {
#pragma unroll
                    for (int e = 0; e < 4; ++e) { const float v = S[t][e] * c1 + tr_[16 * t + e] + madd[t][e]; S[t][e] = v; cm = fmaxf(cm, v); } }
            } else {
#pragma unroll
                for (int t = 0; t < 4; ++t)
#pragma unroll
                    for (int e = 0; e < 4; ++e) { const float v = S[t][e] * c1; S[t][e] = v; cm = fmaxf(cm, v); }
            }
            cm = fmaxf(cm, __shfl_xor(cm, 16)); cm = fmaxf(cm, __shfl_xor(cm, 32));
            const float mn = fmaxf(m, cm), alpha = __builtin_amdgcn_exp2f(m - mn); m = mn;
            float ps = 0.f;
            unsigned pk[4][2];
#pragma unroll
            for (int t = 0; t < 4; ++t) {
                if (!local || (t >= tlo && t <= thi)) {
                    const float p0 = __builtin_amdgcn_exp2f(S[t][0] - mn), p1 = __builtin_amdgcn_exp2f(S[t][1] - mn), p2 = __builtin_amdgcn_exp2f(S[t][2] - mn), p3 = __builtin_amdgcn_exp2f(S[t][3] - mn);
                    ps += (p0 + p1) + (p2 + p3);
                    pk[t][0] = pg8::cvt_pk_bf16(p0, p1); pk[t][1] = pg8::cvt_pk_bf16(p2, p3);
                } else { pk[t][0] = 0u; pk[t][1] = 0u; }
            }
            lsum = lsum * alpha + ps;
#pragma unroll
            for (int dt = 0; dt < 4; ++dt) O[dt] = O[dt] * alpha;
#pragma unroll
            for (int p = 0; p < 2; ++p) {
                if (!local || (2 * p <= thi && 2 * p + 1 >= tlo)) {
                    const v4u bw = {pk[2 * p][0], pk[2 * p][1], pk[2 * p + 1][0], pk[2 * p + 1][1]};
                    const s16x8 bfrag = __builtin_bit_cast(s16x8, bw);
#pragma unroll
                    for (int dt = 0; dt < 4; ++dt) {
                        const s16x4 a0 = __builtin_amdgcn_ds_read_tr16_b64_v4i16((LAS s16x4*)(vtr + (2 * p) * 16 * NA_VROW + dt * 32));
                        const s16x4 a1 = __builtin_amdgcn_ds_read_tr16_b64_v4i16((LAS s16x4*)(vtr + (2 * p + 1) * 16 * NA_VROW + dt * 32));
                        const s16x8 afrag = __builtin_shufflevector(a0, a1, 0, 1, 2, 3, 4, 5, 6, 7);
                        O[dt] = __builtin_amdgcn_mfma_f32_16x16x32_bf16(afrag, bfrag, O[dt], 0, 0, 0);
                    }
                }
            }
        }
        lsum += __shfl_xor(lsum, 16); lsum += __shfl_xor(lsum, 32);
        const float inv = __builtin_amdgcn_rcpf(lsum);
        bf16* op = MIX + (size_t)(qrow0 + q16) * D + 256 + h * HD + 4 * g;
#pragma unroll
        for (int dt = 0; dt < 4; ++dt) { v2u w; w.x = pg8::cvt_pk_bf16(O[dt][0] * inv, O[dt][1] * inv); w.y = pg8::cvt_pk_bf16(O[dt][2] * inv, O[dt][3] * inv); *(v2u*)(op + 16 * dt) = w; }
    }
}

constexpr int LRU_UCROW = 260;
constexpr int LRU_HSROW = 258;
constexpr int LRU_OFF_UC = 38 * 256 * 2, LRU_OFF_HS = LRU_OFF_UC + 2 * 32 * LRU_UCROW * 4;
static_assert(LRU_OFF_HS + 32 * LRU_HSROW * 4 <= RING_BYTES, "LRU LDS map");
template <int PASS>
__device__ __forceinline__ void lru_phase(Frame& F, int l, int ntiles) {
    const bf16* PROJ = WSP(const bf16, WS_PROJ);
    LAS bf16* rxs = (LAS bf16*)(F.lds);
    LAS float* ucf = (LAS float*)(F.lds + LRU_OFF_UC);
    LAS float* hs = (LAS float*)(F.lds + LRU_OFF_HS);
    const int lane = F.lane, j16 = lane & 15, g = lane >> 4;
    const int dir = F.wave >> 2, kb = F.wave & 3;
    const int ld = l * 2 + dir;
    s16x8 wf[2][4][2];
    {
        const bf16* WLR = WSP(const bf16, WS_WLR) + (size_t)((ld * 4 + kb) * 2) * 4096;
#pragma unroll
        for (int gt = 0; gt < 2; ++gt)
#pragma unroll
            for (int n = 0; n < 4; ++n)
#pragma unroll
                for (int s = 0; s < 2; ++s) wf[gt][n][s] = *(const s16x8*)(WLR + gt * 4096 + (16 * n + j16) * 64 + 32 * s + 8 * g);
    }
    float cbx[4], cba[4], csp[4];
#pragma unroll
    for (int n = 0; n < 4; ++n) {
        const int e = kb * 64 + 16 * n + j16, idx = ld * 256 + e;
        cbx[n] = INP(18)[idx]; cba[n] = INP(20)[idx];
        const float nl = -INP(21)[idx]; csp[n] = -8.f * (fmaxf(nl, 0.f) + log1pf(__expf(-fabsf(nl))));
    }
    const int c = F.tid & 255;
    const float s1w0 = INP(15)[(ld * 4 + 0) * 256 + c], s1w1 = INP(15)[(ld * 4 + 1) * 256 + c], s1w2 = INP(15)[(ld * 4 + 2) * 256 + c], s1w3 = INP(15)[(ld * 4 + 3) * 256 + c], s1cb = INP(16)[ld * 256 + c];
    const int base = dir == 0 ? 0 : 3;
    const bool sec16 = ((g & 1) != 0) != (dir != 0), sec32 = ((g >> 1) != 0) != (dir != 0);
    unsigned pre[10];
    auto load_tile = [&](int T) {
        const int row0 = T * 32;
        int lo, hi; if (row0 < ML) { lo = row0 & ~(SEQ - 1); hi = lo + SEQ; } else { lo = row0 & ~(CTXL - 1); hi = lo + CTXL; }
#pragma unroll
        for (int j = 0; j < 10; ++j) { const int i = F.tid + 512 * j, rr = i >> 7, cp = i & 127, row = row0 - 3 + rr;
            const bool ok = (j < 9 || F.tid < 256) && row >= lo && row < hi;
            pre[j] = ok ? *(const unsigned*)(PROJ + (size_t)row * IND + 2048 + 2 * cp) : 0u; }
    };
    if (F.vcu < ntiles) load_tile(F.vcu);
    for (int T = F.vcu; T < ntiles; T += F.G) {
        const int row0 = T * 32;
        __syncthreads();
#pragma unroll
        for (int j = 0; j < 10; ++j) { const int i = F.tid + 512 * j; if (j < 9 || F.tid < 256) ((LAS unsigned*)rxs)[i] = pre[j]; }
        if (PASS == 1) for (int i = F.tid; i < 32 * LRU_HSROW; i += NWAVES * 64) hs[i] = 0.f;
        if (T + F.G < ntiles) load_tile(T + F.G);
        float hst[4], Pt[4];
        unsigned gw[8];
#pragma unroll
        for (int n = 0; n < 4; ++n) { Pt[n] = 1.f; hst[n] = PASS == 1 ? WSP(const float, WS_CARRY)[((size_t)dir * 1152 + T) * 256 + kb * 64 + 16 * n + j16] : 0.f; }
        if (PASS == 1) {
#pragma unroll
            for (int j = 0; j < 8; ++j) { const int i = F.tid + 512 * j, t = i >> 7, cp = i & 127; gw[j] = *(const unsigned*)(PROJ + (size_t)(row0 + t) * IND + 2304 + 2 * cp); }
        }
        __syncthreads();
        {
            float x0 = bf1(rxs[(base + 0) * 256 + c]), x1 = bf1(rxs[(base + 1) * 256 + c]), x2 = bf1(rxs[(base + 2) * 256 + c]);
#pragma unroll 8
            for (int t = 0; t < 32; ++t) {
                const float x3 = bf1(rxs[(t + base + 3) * 256 + c]);
                ucf[(dir * 32 + t) * LRU_UCROW + c] = s1cb + s1w0 * x0 + s1w1 * x1 + s1w2 * x2 + s1w3 * x3;
                x0 = x1; x1 = x2; x2 = x3;
            }
        }
        __syncthreads();
#pragma unroll 1
        for (int step = 0; step < 2; ++step) {
            const int rt = dir == 0 ? step : 1 - step;
            s16x8 af[2];
#pragma unroll
            for (int s = 0; s < 2; ++s) { const LAS float* up = ucf + (dir * 32 + 16 * rt + j16) * LRU_UCROW + kb * 64 + 32 * s + 8 * g;
                const f32x4 u0 = *(const LAS f32x4*)up, u1 = *(const LAS f32x4*)(up + 4);
                const v4u w = {pg8::cvt_pk_bf16(u0[0], u0[1]), pg8::cvt_pk_bf16(u0[2], u0[3]), pg8::cvt_pk_bf16(u1[0], u1[1]), pg8::cvt_pk_bf16(u1[2], u1[3])};
                af[s] = __builtin_bit_cast(s16x8, w); }
#pragma unroll
            for (int n = 0; n < 4; ++n) {
                f32x4 zx = {0.f, 0.f, 0.f, 0.f}, za = {0.f, 0.f, 0.f, 0.f};
#pragma unroll
                for (int s = 0; s < 2; ++s) { zx = __builtin_amdgcn_mfma_f32_16x16x32_bf16(af[s], wf[0][n][s], zx, 0, 0, 0); za = __builtin_amdgcn_mfma_f32_16x16x32_bf16(af[s], wf[1][n][s], za, 0, 0, 0); }
                const int e = kb * 64 + 16 * n + j16;
                const LAS float* uo = ucf + (dir * 32 + 16 * rt + 4 * g) * LRU_UCROW + e;
                float a_[4], b_[4];
#pragma unroll
                for (int r = 0; r < 4; ++r) {
                    const float u = uo[r * LRU_UCROW];
                    const float gx = sigmoidf_(zx[r] + cbx[n]), ga = sigmoidf_(za[r] + cba[n]);
                    const float la = csp[n] * ga, a = __builtin_amdgcn_exp2f(1.4426950408889634f * la), y = 2.f * la;
                    const float om = y > -0.02f ? -y * (1.f + y * (0.5f + y * 0.16666667f)) : 1.f - a * a;
                    a_[r] = a; b_[r] = __builtin_amdgcn_sqrtf(om) * gx * u;
                }
                const float P = (a_[0] * a_[1]) * (a_[2] * a_[3]);
                const float S = dir == 0 ? ((b_[0] * a_[1] + b_[1]) * a_[2] + b_[2]) * a_[3] + b_[3] : ((b_[3] * a_[2] + b_[2]) * a_[1] + b_[1]) * a_[0] + b_[0];
                const float Pp = __shfl_xor(P, 16), Sp = __shfl_xor(S, 16);
                const float e1P = sec16 ? Pp : 1.f, e1S = sec16 ? Sp : 0.f;
                const float prP = P * Pp, prS = sec16 ? P * Sp + S : Pp * S + Sp;
                const float Pq = __shfl_xor(prP, 32), Sq = __shfl_xor(prS, 32);
                const float EP = sec32 ? Pq * e1P : e1P, ES = sec32 ? e1P * Sq + e1S : e1S;
                const float TP = prP * Pq, TS = sec32 ? prP * Sq + prS : Pq * prS + Sq;
                if (PASS == 1) {
                    float h = EP * hst[n] + ES;
                    LAS float* hp = hs + (16 * rt + 4 * g) * LRU_HSROW + e;
                    if (dir == 0) {
#pragma unroll
                        for (int r = 0; r < 4; ++r) { h = a_[r] * h + b_[r]; __hip_atomic_fetch_add(hp + r * LRU_HSROW, h, __ATOMIC_RELAXED, __HIP_MEMORY_SCOPE_WORKGROUP); }
                    } else {
#pragma unroll
                        for (int r = 3; r >= 0; --r) { h = a_[r] * h + b_[r]; __hip_atomic_fetch_add(hp + r * LRU_HSROW, h, __ATOMIC_RELAXED, __HIP_MEMORY_SCOPE_WORKGROUP); }
                    }
                } else Pt[n] *= TP;
                hst[n] = TP * hst[n] + TS;
            }
        }
        if (PASS == 0) {
            if (g == 0) {
#pragma unroll
                for (int n = 0; n < 4; ++n) WSP(f32x2, WS_TOT)[((size_t)dir * 1152 + T) * 256 + kb * 64 + 16 * n + j16] = (f32x2){Pt[n], hst[n]};
            }
        } else {
            __syncthreads();
            bf16* MIX = WSP(bf16, WS_MIX);
#pragma unroll
            for (int j = 0; j < 8; ++j) { const int i = F.tid + 512 * j, t = i >> 7, cp = i & 127;
                const f32x2 hv = *(const LAS f32x2*)(hs + t * LRU_HSROW + 2 * cp);
                *(unsigned*)(MIX + (size_t)(row0 + t) * D + 768 + 2 * cp) = pk2(gelu_tanh(bflo(gw[j])) * hv[0], gelu_tanh(bfhi(gw[j])) * hv[1]); }
        }
    }
}
__device__ __forceinline__ void lru_carry(Frame& F) {
    const f32x2* TOT = WSP(const f32x2, WS_TOT); float* CARRY = WSP(float, WS_CARRY);
    for (int it = F.gw; it < NB * 2 * 4; it += F.NGW) {
        const int b = it >> 3, dir = (it >> 2) & 1, c = (it & 3) * 64 + F.lane;
        float h = 0.f;
        for (int g = 0; g < 18; ++g) {
            f32x2 ps[4]; int tl[4];
#pragma unroll
            for (int i = 0; i < 4; ++i) { const int s = g * 4 + i;
                int T; if (s < 8) T = 1024 + b * 8 + (dir == 0 ? s : 7 - s); else T = b * 64 + (dir == 0 ? s - 8 : 71 - s);
                tl[i] = T; ps[i] = TOT[((size_t)dir * 1152 + T) * 256 + c]; }
#pragma unroll
            for (int i = 0; i < 4; ++i) { CARRY[((size_t)dir * 1152 + tl[i]) * 256 + c] = h; h = ps[i][0] * h + ps[i][1]; }
        }
    }
}

__device__ __forceinline__ void final_rows(Frame& F) {
    const float* g = INP(24);
    for (int row = F.gw; row < ML; row += F.NGW) {
        float* xr = F.out + (size_t)row * D;
        f32x4 v[4]; float ss = 0.f;
#pragma unroll
        for (int j = 0; j < 4; ++j) { v[j] = *(const f32x4*)(xr + 4 * F.lane + 256 * j); ss += (v[j][0] * v[j][0] + v[j][1] * v[j][1]) + (v[j][2] * v[j][2] + v[j][3] * v[j][3]); }
        const float rs = rsqrtf(wave_sum(ss) * (1.f / D) + EPS);
#pragma unroll
        for (int j = 0; j < 4; ++j) { const int k = 4 * F.lane + 256 * j; *(f32x4*)(xr + k) = v[j] * rs * *(const f32x4*)(g + k); }
    }
}

constexpr int N_PHASES = 2 + 7 * DEPTH + 1;
struct Args { const float* in[25]; float* out; unsigned char* ws; int ph_lo, ph_hi; };
static_assert(sizeof(Args) == 27 * 8 + 8, "Args has no padding");

__global__ void __launch_bounds__(NWAVES * 64, 2) mega_fwd(Args args) {
    extern __shared__ __attribute__((aligned(16))) unsigned char lds[];
    Frame F;
    F.lds = (LAS unsigned char*)lds;
    const int wave_s = __builtin_amdgcn_readfirstlane((int)threadIdx.x >> 6);
    F.wave = wave_s; F.lane = (int)__builtin_amdgcn_mbcnt_hi(~0u, __builtin_amdgcn_mbcnt_lo(~0u, 0u)); F.tid = wave_s * 64 + F.lane;
    F.G = gridDim.x; { const int bx = blockIdx.x; F.vcu = (F.G % 8 == 0) ? (bx % 8) * (F.G / 8) + bx / 8 : bx; }
    F.gw = F.vcu * NWAVES + F.wave; F.NGW = F.G * NWAVES;
    F.out = args.out; F.ws = args.ws;
    volatile LAS unsigned* MISC = (volatile LAS unsigned*)(F.lds + MISC_OFF);
    for (int u = F.tid; u < (LDS_BYTES - LDSCTL_OFF) / 4; u += NWAVES * 64) ((LAS unsigned*)(F.lds + LDSCTL_OFF))[u] = 0u;
    __syncthreads();
    if (F.tid == 0) {
#pragma unroll
        for (int i = 0; i < 25; ++i) *(LAS unsigned long long*)(F.lds + PTR_OFF + 8 * i) = (unsigned long long)args.in[i];
    }
    __syncthreads();
    XcdBarrier bar = xcd_barrier_post((unsigned*)(F.ws + WS_CTL) + CW_BAR, MISC + 8, F.tid);

    const int lo = args.ph_lo, hi = args.ph_hi;
#ifdef PROBE_MASK
    bool rep_done = false;
#define PROBE_V ((((PROBE_MASK >> ph) & 1) && !rep_done) ? PROBE_VARIANT : 0)
#else
#define PROBE_V 0
#endif
    for (int ph = lo; ph < hi; ++ph) {
        { unsigned ones_ = ~0u; asm volatile("" : "+s"(ones_));
          int t_ = wave_s * 64 + (int)__builtin_amdgcn_mbcnt_hi(ones_, __builtin_amdgcn_mbcnt_lo(ones_, 0u)); asm volatile("" : "+v"(t_)); F.tid = t_; F.lane = t_ & 63; F.wave = __builtin_amdgcn_readfirstlane(t_ >> 6); F.gw = F.vcu * NWAVES + F.wave; }
        if (ph == 0) {
#ifndef NO_P0
            phase_p0a(F);
#endif
        } else if (ph == 1) {
#ifndef NO_P0
            phase_p0b(F);
#endif
        }
        else if (ph == N_PHASES - 1) final_rows(F);
        else {
            const int l = (ph - 2) / 7, k = (ph - 2) % 7; const bool last = (l == DEPTH - 1);
            const int Mx = last ? ML : MT;
            float* MOD = WSP(float, WS_MOD);
            if (k == 0) {
                pg8::Gemm g{WSP(const bf16, WS_XA), WSP(const bf16, WS_WIN) + (size_t)l * IND * D, MT, IND, D};
                pg8::Order S; if (last) S.init(ML, IND, (MC / 256) * 5, F.G, (int)blockIdx.x); else S.init(MT, IND, 0, F.G, (int)blockIdx.x);
                pg8::EpiScale<0, IND> E{WSP(bf16, WS_PROJ), WSP(const float, WS_SHW1) + (size_t)l * 17 * IND, WSP(const float, WS_RSSA), PROBE_V};

#ifndef NO_G0
                pg8::gemm_phase<pg8::EpiScale<0, IND>, pg8::Order, true, true>(F.lds + RING_OFF, g, S, E, F.tid);
#endif

            } else if (k == 1) {

#ifndef NO_LRU
                lru_phase<0>(F, l, 1152);
#ifdef REP_LRU0
                __syncthreads(); lru_phase<0>(F, l, 1152);
#endif
#endif

                __syncthreads();
#ifndef NO_CONV
                conv_phase(F, l, last ? 1024 : 1152);
                __syncthreads();
#ifdef REP_CONV
                conv_phase(F, l, last ? 1024 : 1152);
                __syncthreads();
#endif
#endif
#ifndef NO_NA
                na_phase(F, l, last ? NA_ITEMS_LAT : NA_ITEMS_LAT + NA_ITEMS_CTX);
#ifdef REP_NA
                na_phase(F, l, last ? NA_ITEMS_LAT : NA_ITEMS_LAT + NA_ITEMS_CTX);
#endif
#endif
            } else if (k == 2) {
                lru_carry(F);
            } else if (k == 3) {

#ifndef NO_LRU
                lru_phase<1>(F, l, last ? 1024 : 1152);
#endif

            } else if (k == 4 || k == 6) {
                const bool dn = (k == 6);
                const int ln = (dn && !last) ? l + 1 : l;
                pg8::Gemm g{dn ? WSP(const bf16, WS_HID) : WSP(const bf16, WS_MIX), dn ? WSP(const bf16, WS_W2) + (size_t)l * D * FF : WSP(const bf16, WS_WOUT) + (size_t)l * D * D, Mx, D, dn ? FF : D};
                pg8::Order S; S.init(Mx, D, 0, F.G, (int)blockIdx.x);
                const bool fromin = (!dn && l == 0);
                pg8::EpiRes E{fromin ? INP(0) : F.out, fromin ? INP(2) : WSP(const float, WS_CX), F.out, WSP(float, WS_CX),
                              MOD + (size_t)l * 17 * MODW + (dn ? 5 : 2) * D, (dn ? INP(4) : INP(5)) + ln * D, MOD + (size_t)ln * 17 * MODW + (dn ? 1 : 4) * D,
                              (dn && last) ? (bf16*)nullptr : WSP(bf16, WS_XA), dn ? WSP(float, WS_RSSA) : WSP(float, WS_RSSB)};
#ifndef NO_GR
                pg8::gemm_phase<pg8::EpiRes, pg8::Order, true, true>(F.lds + RING_OFF, g, S, E, F.tid);
#endif
            } else if (k == 5) {
                pg8::Gemm g{WSP(const bf16, WS_XA), WSP(const bf16, WS_W1) + (size_t)l * FF * D, Mx, FF, D};
                pg8::Order S; S.init(Mx, FF, 0, F.G, (int)blockIdx.x);
                pg8::EpiScale<1, FF> E{WSP(bf16, WS_HID), WSP(const float, WS_SHW2) + (size_t)l * 17 * FF, WSP(const float, WS_RSSB), PROBE_V};

#ifndef NO_G1
                pg8::gemm_phase<pg8::EpiScale<1, FF>, pg8::Order, true, true>(F.lds + RING_OFF, g, S, E, F.tid);
#endif

            }
        }
#ifdef PROBE_MASK
        if (((PROBE_MASK >> ph) & 1) && !rep_done) { rep_done = true; xcd_barrier(bar, F.tid); --ph; continue; }
        rep_done = false;
#endif
        if (ph + 1 < hi) xcd_barrier(bar, F.tid);
    }
}

extern "C" void kernel_launch(void* const* d_in, const int* in_sizes, int n_in, void* d_out, int out_size, void* d_ws, size_t ws_size, hipStream_t stream) {
    static int grid = 0;
    if (grid == 0) {
        if (n_in != 25 || out_size != ML * D || ws_size < WS_END) { fprintf(stderr, "kernel_launch: unexpected shapes (n_in %d out %d ws %zu)\n", n_in, out_size, ws_size); grid = -1; return; }
        int dev = 0, cus = 0;
        if (hipGetDevice(&dev) != hipSuccess || hipDeviceGetAttribute(&cus, hipDeviceAttributeMultiprocessorCount, dev) != hipSuccess) { grid = -1; return; }
        if (hipFuncSetAttribute((const void*)mega_fwd, hipFuncAttributeMaxDynamicSharedMemorySize, LDS_BYTES) != hipSuccess) { fprintf(stderr, "kernel_launch: hipFuncSetAttribute failed\n"); grid = -1; return; }
        int per_cu = 0;
        if (hipOccupancyMaxActiveBlocksPerMultiprocessor(&per_cu, (const void*)mega_fwd, NWAVES * 64, LDS_BYTES) != hipSuccess || per_cu < 1) fprintf(stderr, "kernel_launch: occupancy query reports %d\n", per_cu);
        (void)hipGetLastError();
        grid = cus;
    }
    if (grid < 0) return;
    if (hipMemsetAsync((char*)d_ws + WS_CTL, 0, CTL_ZERO_BYTES, stream) != hipSuccess) return;
    Args a{};
    for (int i = 0; i < 25; ++i) a.in[i] = (const float*)d_in[i];
    a.out = (float*)d_out; a.ws = (unsigned char*)d_ws;
#if MK_N_LAUNCHES == 1
    a.ph_lo = 0; a.ph_hi = N_PHASES;
    hipLaunchKernelGGL(mega_fwd, dim3(grid), dim3(NWAVES * 64), LDS_BYTES, stream, a);
#else
    for (int ph = 0; ph < N_PHASES; ++ph) { a.ph_lo = ph; a.ph_hi = ph + 1; hipLaunchKernelGGL(mega_fwd, dim3(grid), dim3(NWAVES * 64), LDS_BYTES, stream, a); }
#endif
}
```

```cpp
#include <hip/hip_runtime.h>
#include <cstdio>
#include <cstdint>

constexpr int D = 1024, NB = 16, SEQ = 2048, CTXL = 256, DEPTH = 2;
constexpr int ML = NB * SEQ, MC = NB * CTXL, MT = ML + MC;
constexpr int IND = 2560, FF = 4096, NH = 8, HD = 64;
constexpr int MODW = 6 * D;
constexpr float EPS = 1e-6f;
#ifndef MK_N_LAUNCHES
#define MK_N_LAUNCHES 1
#endif

namespace pg8 {
#define PG8_LAS __attribute__((address_space(3)))
typedef unsigned short bf16_t;
typedef short bf16x8 __attribute__((ext_vector_type(8)));
typedef float f32x4 __attribute__((ext_vector_type(4)));
typedef unsigned u32x4 __attribute__((ext_vector_type(4)));
constexpr int BM = 256, BK = 64, HALF = 128, HTB = HALF * BK * 2, STAGE_BYTES = 8 * HTB, NXCD = 8, WGM = 8;

__host__ __device__ __forceinline__ int lds_byte(int r, int c) { const int st = (r >> 4) * 2 + (c >> 5), rr = r & 15, cc = c & 31, ob = rr * 64 + cc * 2; return st * 1024 + (ob ^ (((ob >> 9) & 1) << 5)); }
__host__ __device__ __forceinline__ void stage_rc(int b, int& R, int& C) { const int st = b / 1024, sb = b % 1024, swz = sb ^ (((sb >> 9) & 1) << 5); R = (st >> 1) * 16 + swz / 64; C = (st & 1) * 32 + (swz % 64) / 2; }
__host__ __device__ __forceinline__ int perm32(int rho) { const int n = rho >> 4, i = rho & 15; return 8 * (i >> 2) + 4 * n + (i & 3); }

struct Unit { int pm, pn; };
struct Gemm { const bf16_t* A; const bf16_t* Bt; int M, N, K; };

__host__ __device__ __forceinline__ void map_tile(int wgid, int nM, int nN, Unit& u) {
    const int nwg = nM * nN;
    { const int q = nwg / NXCD, r = nwg % NXCD, xcd = wgid % NXCD, off = wgid / NXCD; wgid = (xcd < r ? xcd * (q + 1) : r * (q + 1) + (xcd - r) * q) + off; }
    const int nig = WGM * nN, gid = wgid / nig, fm = gid * WGM, gsz = (nM - fm) < WGM ? (nM - fm) : WGM;
    u.pm = fm + ((wgid % nig) % gsz); u.pn = (wgid % nig) / gsz;
}
struct Order {
    int nM, nN, nwg, extra, G, c;
    __host__ __device__ void init(int M, int N, int extra_, int G_, int c_) { nM = M / BM; nN = N / BM; nwg = nM * nN; extra = extra_; G = G_; c = c_; }
    __host__ __device__ bool next(int i, Unit& u) const {
        const long L = (long)i * G + c;
        if (L < nwg) { map_tile((int)L, nM, nN, u); return true; }
        if (L < nwg + extra) { const int q = (int)L - nwg; u.pm = nM + q / 5; u.pn = 4 + q % 5; return true; }
        return false;
    }
    __device__ __forceinline__ void a_ready(const Unit&) const {}
    __device__ __forceinline__ void done(const Unit&) const {}
};

__device__ __forceinline__ unsigned cvt_pk_bf16(float lo, float hi) { unsigned r; asm volatile("v_cvt_pk_bf16_f32 %0, %1, %2" : "=v"(r) : "v"(lo), "v"(hi)); return r; }

template <int ACT, int LDC> struct EpiScale {
    static constexpr bool PERM = true, AFTER_DRAIN = false;
    bf16_t* O; const float* shw; const float* RSS;
    int probe;
    __device__ __forceinline__ void operator()(const f32x4 (&acc)[2][2][4][2], const Unit& u, int wr, int wc, int fr, int fq) const {
        asm volatile("" : "+s"(wr), "+s"(wc));
        const int brow = u.pm < ML / BM ? (u.pm >> 3) : NB;
        const float* sp = shw + (size_t)brow * LDC + u.pn * BM;
        bf16_t* Ot = O + (size_t)u.pm * BM * LDC + u.pn * BM;
        const float* RSSt = RSS + (size_t)u.pm * BM * 32;
        unsigned cl = (unsigned)(wc * 32 + 8 * fq);
        unsigned rl0 = (unsigned)(wr * 64 + fr);
        asm volatile("" : "+v"(cl), "+v"(rl0));
        f32x4 pa[2][4], pb[2][4], sh[2][2];
#pragma unroll
        for (int ai = 0; ai < 2; ++ai)
#pragma unroll
            for (int m = 0; m < 4; ++m) { const unsigned ro = (rl0 + (unsigned)(ai * HALF + m * 16)) * 32u + 8u * (unsigned)fq;
                if (probe == 2) { pa[ai][m] = acc[ai][0][m][0]; pb[ai][m] = acc[ai][1][m][0]; } else { pa[ai][m] = *(const f32x4*)(RSSt + ro); pb[ai][m] = *(const f32x4*)(RSSt + (ro + 4u)); } }
#pragma unroll
        for (int bj = 0; bj < 2; ++bj) { if (probe == 2) { sh[bj][0] = acc[0][bj][0][1]; sh[bj][1] = acc[1][bj][0][1]; } else { sh[bj][0] = *(const f32x4*)(sp + (cl + (unsigned)(bj * HALF))); sh[bj][1] = *(const f32x4*)(sp + (cl + (unsigned)(bj * HALF + 4))); } }
        float rs[2][4];
#pragma unroll
        for (int ai = 0; ai < 2; ++ai)
#pragma unroll
            for (int m = 0; m < 4; ++m) { const f32x4 p0 = pa[ai][m], p1 = pb[ai][m];
                float s = ((p0[0] + p0[1]) + (p0[2] + p0[3])) + ((p1[0] + p1[1]) + (p1[2] + p1[3]));
                s += __shfl_xor(s, 16); s += __shfl_xor(s, 32);
                rs[ai][m] = rsqrtf(s * (1.0f / D) + EPS); }
#pragma unroll
        for (int bj = 0; bj < 2; ++bj)
#pragma unroll
            for (int ai = 0; ai < 2; ++ai)
#pragma unroll
                for (int m = 0; m < 4; ++m) {
                    f32x4 v0 = acc[ai][bj][m][0] * rs[ai][m] + sh[bj][0], v1 = acc[ai][bj][m][1] * rs[ai][m] + sh[bj][1];
                    if (ACT == 1) {
#pragma unroll
                        for (int e = 0; e < 4; ++e) { const float a = fmaxf(v0[e], 0.f), b = fmaxf(v1[e], 0.f); v0[e] = a * a; v1[e] = b * b; }
                    }
                    u32x4 w; w.x = cvt_pk_bf16(v0[0], v0[1]); w.y = cvt_pk_bf16(v0[2], v0[3]); w.z = cvt_pk_bf16(v1[0], v1[1]); w.w = cvt_pk_bf16(v1[2], v1[3]);
                    if (probe == 0) *(u32x4*)(Ot + ((rl0 + (unsigned)(ai * HALF + m * 16)) * (unsigned)LDC + cl + (unsigned)(bj * HALF))) = w;
                    else asm volatile("" :: "v"(w));
                }
    }
};
struct EpiRes {
    static constexpr bool PERM = true, AFTER_DRAIN = false;
    const float* src_lat; const float* src_ctx; float* dst_lat; float* dst_ctx;
    const float* gate;
    const float* gmg; const float* gmsc;
    bf16_t* XA; float* RSS;
    template <int BJ, int AI0, int NAI, int M0, int NM>
    __device__ __forceinline__ void batch(const f32x4 (&acc)[2][2][4][2], const float* src, float* dst, const float* gt, const float* gg, const float* gs, bf16_t* XAt, float* RSSt, unsigned cl, unsigned rl0, int fq, bool hasxa) const {
        const unsigned c = cl + (unsigned)(BJ * HALF);
        f32x4 x0[NAI][NM], x1[NAI][NM];
#pragma unroll
        for (int a = 0; a < NAI; ++a)
#pragma unroll
            for (int m = 0; m < NM; ++m) { const unsigned off = (rl0 + (unsigned)((AI0 + a) * HALF + (M0 + m) * 16)) * (unsigned)D + c; x0[a][m] = *(const f32x4*)(src + off); x1[a][m] = *(const f32x4*)(src + (off + 4u)); }
        const f32x4 g0 = *(const f32x4*)(gt + c), g1 = *(const f32x4*)(gt + (c + 4u));
        f32x4 m0 = {0.f, 0.f, 0.f, 0.f}, m1 = {0.f, 0.f, 0.f, 0.f};
        if (hasxa) { m0 = *(const f32x4*)(gg + c) * (*(const f32x4*)(gs + c) + 1.0f); m1 = *(const f32x4*)(gg + (c + 4u)) * (*(const f32x4*)(gs + (c + 4u)) + 1.0f); }
        asm volatile("" ::: "memory");
#pragma unroll
        for (int a = 0; a < NAI; ++a)
#pragma unroll
            for (int m = 0; m < NM; ++m) {
                const unsigned rl = rl0 + (unsigned)((AI0 + a) * HALF + (M0 + m) * 16);
                const unsigned off = rl * (unsigned)D + c;
                const f32x4 y0 = x0[a][m] + g0 * acc[AI0 + a][BJ][M0 + m][0], y1 = x1[a][m] + g1 * acc[AI0 + a][BJ][M0 + m][1];
                *(f32x4*)(dst + off) = y0; *(f32x4*)(dst + (off + 4u)) = y1;
                float ss = ((y0[0] * y0[0] + y0[1] * y0[1]) + (y0[2] * y0[2] + y0[3] * y0[3])) + ((y1[0] * y1[0] + y1[1] * y1[1]) + (y1[2] * y1[2] + y1[3] * y1[3]));
                ss += __shfl_xor(ss, 16); ss += __shfl_xor(ss, 32);
                if (fq == 0) RSSt[rl * 32u + (unsigned)(BJ * 4)] = ss;
                if (hasxa) { const f32x4 a0 = y0 * m0, a1 = y1 * m1;
                    u32x4 w; w.x = cvt_pk_bf16(a0[0], a0[1]); w.y = cvt_pk_bf16(a0[2], a0[3]); w.z = cvt_pk_bf16(a1[0], a1[1]); w.w = cvt_pk_bf16(a1[2], a1[3]);
                    *(u32x4*)(XAt + off) = w; }
            }
        asm volatile("" ::: "memory");
    }
    __device__ __forceinline__ void operator()(const f32x4 (&acc)[2][2][4][2], const Unit& u, int wr, int wc, int fr, int fq) const {
        asm volatile("" : "+s"(wr), "+s"(wc));
        const bool lat = u.pm < ML / BM;
        const int brow = lat ? (u.pm >> 3) : NB;
        const float* src = (lat ? src_lat + (size_t)u.pm * BM * D : src_ctx + (size_t)(u.pm - ML / BM) * BM * D) + u.pn * BM;
        float* dst = (lat ? dst_lat + (size_t)u.pm * BM * D : dst_ctx + (size_t)(u.pm - ML / BM) * BM * D) + u.pn * BM;
        const float* gt = gate + (size_t)brow * MODW + u.pn * BM;
        const float* gg = gmg + u.pn * BM;
        const float* gs = gmsc + (size_t)brow * MODW + u.pn * BM;
        bf16_t* XAt = XA + (size_t)u.pm * BM * D + u.pn * BM;
        float* RSSt = RSS + (size_t)u.pm * BM * 32 + u.pn * 8 + wc;
        unsigned cl = (unsigned)(wc * 32 + 8 * fq);
        unsigned rl0 = (unsigned)(wr * 64 + fr);
        asm volatile("" : "+v"(cl), "+v"(rl0));
        const bool hasxa = XA != nullptr;
        batch<0, 0, 1, 0, 2>(acc, src, dst, gt, gg, gs, XAt, RSSt, cl, rl0, fq, hasxa);
        batch<0, 0, 1, 2, 2>(acc, src, dst, gt, gg, gs, XAt, RSSt, cl, rl0, fq, hasxa);
        batch<0, 1, 1, 0, 4>(acc, src, dst, gt, gg, gs, XAt, RSSt, cl, rl0, fq, hasxa);
        batch<1, 0, 2, 0, 4>(acc, src, dst, gt, gg, gs, XAt, RSSt, cl, rl0, fq, hasxa);
    }
};

template <class Epi, class Sched, bool ALIGN_EPI = false, bool SP2 = false>
__device__ __forceinline__ void gemm_phase(PG8_LAS unsigned char* lds, const Gemm g, const Sched& S, const Epi& E, const int tid) {
    const int wid = __builtin_amdgcn_readfirstlane(tid >> 6), lane = tid & 63, wr = wid >> 2, wc = wid & 3, fr = lane & 15, fq = lane >> 4;
    const int K = g.K, nt = K / BK;
    unsigned voffA[2], voffB[2];
#pragma unroll
    for (int i = 0; i < 2; ++i) { int R, C; stage_rc(tid * 16 + i * 8192, R, C); const int Rb = Epi::PERM ? ((R & ~31) + perm32(R & 31)) : R;
        voffA[i] = (unsigned)(R * K + C) * 2u; voffB[i] = (unsigned)(Rb * K + C) * 2u; }
    const size_t kstep = (size_t)(BK * 2);
    const size_t hstep = (size_t)HALF * K * 2;
    const size_t tstep = 2 * hstep;
    const unsigned ldsw = (unsigned)wid * 1024u;
    const int aoff = lds_byte(wr * 64 + fr, fq * 8), boff = lds_byte(wc * 32 + fr, fq * 8);
#define PG8_SA(b, h) (((b) * 2 + (h)) * HTB)
#define PG8_SB(b, h) ((4 + (b) * 2 + (h)) * HTB)
#define PG8_STAGE(bufoff, gbase, voff) do { _Pragma("unroll") for (int _i = 0; _i < 2; ++_i) \
        __builtin_amdgcn_global_load_lds((const unsigned*)((const char*)(gbase) + (voff)[_i]), (PG8_LAS unsigned*)(lds + (bufoff) + ldsw + _i * 8192), 16, 0, 0); } while (0)
#define PG8_LDA(dst, b, h) do { _Pragma("unroll") for (int m = 0; m < 4; ++m) _Pragma("unroll") for (int k = 0; k < 2; ++k) dst[m][k] = *(const PG8_LAS bf16x8*)(lds + PG8_SA(b, h) + aoff + m * 2048 + k * 1024); } while (0)
#define PG8_LDB(dst, b, h) do { _Pragma("unroll") for (int n = 0; n < 2; ++n) _Pragma("unroll") for (int k = 0; k < 2; ++k) dst[n][k] = *(const PG8_LAS bf16x8*)(lds + PG8_SB(b, h) + boff + n * 2048 + k * 1024); } while (0)
#define PG8_MMA(ai, bj, At, Bt) do { __builtin_amdgcn_s_setprio(1); _Pragma("unroll") for (int m = 0; m < 4; ++m) _Pragma("unroll") for (int n = 0; n < 2; ++n) _Pragma("unroll") for (int k = 0; k < 2; ++k) \
        acc[ai][bj][m][n] = __builtin_amdgcn_mfma_f32_16x16x32_bf16(Bt[n][k], At[m][k], acc[ai][bj][m][n], 0, 0, 0); __builtin_amdgcn_s_setprio(0); } while (0)
#define PG8_WAIT_V(n) asm volatile("s_waitcnt vmcnt(" #n ")" ::: "memory")
#define PG8_WAIT_L(n) asm volatile("s_waitcnt lgkmcnt(" #n ")" ::: "memory")
#define PG8_BAR __builtin_amdgcn_s_barrier()
#define PG8_SCHED __builtin_amdgcn_sched_barrier(0)
    Unit cur, nxt; int ui = 0;
    if (!S.next(0, cur)) return;
    f32x4 acc[2][2][4][2];
#pragma unroll
    for (int a = 0; a < 2; ++a)
#pragma unroll
        for (int b = 0; b < 2; ++b)
#pragma unroll
            for (int m = 0; m < 4; ++m)
#pragma unroll
                for (int n = 0; n < 2; ++n) acc[a][b][m][n] = (f32x4){0.f, 0.f, 0.f, 0.f};
    bf16x8 At[4][2], B0[2][2], B1[2][2];
    const char* cA = (const char*)g.A + (size_t)cur.pm * tstep; const char* cB = (const char*)g.Bt + (size_t)cur.pn * tstep;
    S.a_ready(cur);
    if constexpr (SP2) {
        PG8_STAGE(PG8_SB(0, 0), cB, voffB); PG8_STAGE(PG8_SB(0, 1), cB + hstep, voffB); PG8_STAGE(PG8_SA(0, 0), cA, voffA); PG8_STAGE(PG8_SA(0, 1), cA + hstep, voffA);
        if (wr == 1) PG8_BAR;
        PG8_WAIT_V(2); PG8_BAR;
        PG8_STAGE(PG8_SB(1, 0), cB + kstep, voffB); PG8_STAGE(PG8_SA(1, 0), cA + kstep, voffA); PG8_STAGE(PG8_SB(1, 1), cB + hstep + kstep, voffB);
        PG8_WAIT_V(6); PG8_BAR;
    } else {
        PG8_STAGE(PG8_SB(0, 0), cB, voffB); PG8_STAGE(PG8_SA(0, 0), cA, voffA); PG8_STAGE(PG8_SB(0, 1), cB + hstep, voffB); PG8_STAGE(PG8_SA(0, 1), cA + hstep, voffA);
        if (wr == 1) PG8_BAR;
        PG8_WAIT_V(4); PG8_BAR;
        PG8_STAGE(PG8_SB(1, 0), cB + kstep, voffB); PG8_STAGE(PG8_SA(1, 0), cA + kstep, voffA); PG8_STAGE(PG8_SB(1, 1), cB + hstep + kstep, voffB);
        PG8_WAIT_V(6); PG8_BAR;
    }
    for (;;) {
        const bool has_next = S.next(ui + 1, nxt);
        const char* nA = has_next ? (const char*)g.A + (size_t)nxt.pm * tstep : cA; const char* nB = has_next ? (const char*)g.Bt + (size_t)nxt.pn * tstep : cB;
        for (int t = 0; t < nt; t += 2) {
            const bool last = (t == nt - 2);
            const char* a1 = cA + (size_t)(t + 1) * kstep;
            const char* a2 = last ? nA : cA + (size_t)(t + 2) * kstep; const char* b2 = last ? nB : cB + (size_t)(t + 2) * kstep;
            const char* a3 = a2 + kstep; const char* b3 = b2 + kstep;
            if (last && has_next) S.a_ready(nxt);
            if constexpr (SP2) {
            PG8_LDB(B0, 0, 0); PG8_LDB(B1, 0, 1); PG8_SCHED; PG8_LDA(At, 0, 0); PG8_STAGE(PG8_SA(1, 1), a1 + hstep, voffA);
            PG8_WAIT_V(8); PG8_WAIT_L(0); PG8_BAR; PG8_MMA(0, 0, At, B0); PG8_MMA(0, 1, At, B1); PG8_BAR; PG8_SCHED;
            PG8_LDA(At, 0, 1); PG8_STAGE(PG8_SB(0, 0), b2, voffB); PG8_STAGE(PG8_SB(0, 1), b2 + hstep, voffB); PG8_STAGE(PG8_SA(0, 0), a2, voffA);
            PG8_WAIT_V(8); PG8_WAIT_L(0); PG8_BAR; PG8_MMA(1, 0, At, B0); PG8_MMA(1, 1, At, B1); PG8_BAR; PG8_SCHED;
            PG8_LDB(B0, 1, 0); PG8_LDB(B1, 1, 1); PG8_SCHED; PG8_LDA(At, 1, 0); PG8_STAGE(PG8_SA(0, 1), a2 + hstep, voffA);
            PG8_WAIT_V(8); PG8_WAIT_L(0); PG8_BAR; PG8_MMA(0, 0, At, B0); PG8_MMA(0, 1, At, B1); PG8_BAR; PG8_SCHED;
            PG8_LDA(At, 1, 1); PG8_STAGE(PG8_SB(1, 0), b3, voffB); PG8_STAGE(PG8_SB(1, 1), b3 + hstep, voffB); PG8_STAGE(PG8_SA(1, 0), a3, voffA);
            PG8_WAIT_V(8); PG8_WAIT_L(0); PG8_BAR; PG8_MMA(1, 0, At, B0); PG8_MMA(1, 1, At, B1); PG8_BAR; PG8_SCHED;
            } else {
            PG8_LDB(B0, 0, 0); PG8_SCHED; PG8_LDA(At, 0, 0); PG8_STAGE(PG8_SA(1, 1), a1 + hstep, voffA);
            PG8_WAIT_L(8); PG8_BAR; PG8_WAIT_L(0); PG8_MMA(0, 0, At, B0); PG8_BAR; PG8_SCHED;
            PG8_LDB(B1, 0, 1); PG8_STAGE(PG8_SB(0, 0), b2, voffB);
            PG8_BAR; PG8_WAIT_L(0); PG8_MMA(0, 1, At, B1); PG8_BAR;
            PG8_LDA(At, 0, 1); PG8_STAGE(PG8_SA(0, 0), a2, voffA);
            PG8_BAR; PG8_WAIT_L(0); PG8_MMA(1, 0, At, B0); PG8_BAR; PG8_SCHED;
            PG8_STAGE(PG8_SB(0, 1), b2 + hstep, voffB);
            PG8_WAIT_V(6); PG8_BAR; PG8_MMA(1, 1, At, B1); PG8_BAR;
            PG8_LDB(B0, 1, 0); PG8_SCHED; PG8_LDA(At, 1, 0); PG8_STAGE(PG8_SA(0, 1), a2 + hstep, voffA);
            PG8_WAIT_L(8); PG8_BAR; PG8_WAIT_L(0); PG8_MMA(0, 0, At, B0); PG8_BAR; PG8_SCHED;
            PG8_LDB(B1, 1, 1); PG8_STAGE(PG8_SB(1, 0), b3, voffB);
            PG8_BAR; PG8_WAIT_L(0); PG8_MMA(0, 1, At, B1); PG8_BAR;
            PG8_LDA(At, 1, 1); PG8_STAGE(PG8_SA(1, 0), a3, voffA);
            PG8_BAR; PG8_WAIT_L(0); PG8_MMA(1, 0, At, B0); PG8_BAR; PG8_SCHED;
            PG8_STAGE(PG8_SB(1, 1), b3 + hstep, voffB);
            PG8_WAIT_V(6); PG8_BAR; PG8_MMA(1, 1, At, B1); PG8_BAR;
            }
        }
        if constexpr (ALIGN_EPI) { if (wr == 0) PG8_BAR; }
        if constexpr (!Epi::AFTER_DRAIN) { E(acc, cur, wr, wc, fr, fq); S.done(cur); }
        if (!has_next) break;
#pragma unroll
        for (int a = 0; a < 2; ++a)
#pragma unroll
            for (int b = 0; b < 2; ++b)
#pragma unroll
                for (int m = 0; m < 4; ++m)
#pragma unroll
                    for (int n = 0; n < 2; ++n) acc[a][b][m][n] = (f32x4){0.f, 0.f, 0.f, 0.f};
        cur = nxt; cA = nA; cB = nB; ++ui;
        if constexpr (ALIGN_EPI) { if (wr == 1) PG8_BAR; }
    }
    PG8_WAIT_V(0);
    if constexpr (!ALIGN_EPI) { if (wr == 0) PG8_BAR; }
    PG8_BAR;
    if constexpr (Epi::AFTER_DRAIN) { E.fused(acc, cur, wr, wc, fr, fq, lds, wid, lane); S.done(cur); }
#undef PG8_SA
#undef PG8_SB
#undef PG8_STAGE
#undef PG8_LDA
#undef PG8_LDB
#undef PG8_MMA
#undef PG8_WAIT_V
#undef PG8_WAIT_L
#undef PG8_BAR
#undef PG8_SCHED
}
}

constexpr size_t MiB = 1u << 20;
constexpr size_t WS_CTL = 0, CTL_ZERO_BYTES = 1 * MiB;
constexpr size_t WS_MOD = 1 * MiB;
constexpr size_t WS_SHW1 = 2 * MiB;
constexpr size_t WS_SHW2 = 3 * MiB;
constexpr size_t WS_RSSA = 4 * MiB;
constexpr size_t WS_RSSB = 9 * MiB;
constexpr size_t WS_TOT = 14 * MiB;
constexpr size_t WS_CARRY = 19 * MiB;
constexpr size_t WS_WLR = 21 * MiB + 512 * 1024;
constexpr size_t WS_WIN = 22 * MiB;
constexpr size_t WS_WOUT = 32 * MiB;
constexpr size_t WS_W1 = 36 * MiB;
constexpr size_t WS_W2 = 52 * MiB;
constexpr size_t WS_CX = 68 * MiB;
constexpr size_t WS_XA = 84 * MiB;
constexpr size_t WS_HID = 156 * MiB;
constexpr size_t WS_PROJ = WS_HID;
constexpr size_t WS_MIX = WS_HID + 180 * MiB;
constexpr size_t WS_END = 444 * MiB;
static_assert(WS_MIX + (size_t)MT * D * 2 <= WS_END && WS_HID + (size_t)MT * FF * 2 == WS_END, "ws map");
constexpr int CW_BAR = 4096;

constexpr int NWAVES = 8;
constexpr int RING_OFF = 0, RING_BYTES = 131072;
constexpr int LDSCTL_OFF = RING_BYTES, MISC_OFF = LDSCTL_OFF + 320;
constexpr int LDS_BYTES = 147456;

#define GAS __attribute__((address_space(1)))
#define LAS __attribute__((address_space(3)))
typedef unsigned short bf16;
typedef unsigned v4u __attribute__((ext_vector_type(4)));
typedef unsigned v2u __attribute__((ext_vector_type(2)));
typedef float f32x4 __attribute__((ext_vector_type(4)));
typedef float f32x2 __attribute__((ext_vector_type(2)));
typedef GAS unsigned gu32;
#define LDS_WAIT() asm volatile("s_waitcnt lgkmcnt(0)" ::: "memory")
#define VM_WAIT() asm volatile("s_waitcnt vmcnt(0)" ::: "memory")
__device__ __forceinline__ unsigned f2bf(float f) { unsigned u = __builtin_bit_cast(unsigned, f); return (u + 0x7fffu + ((u >> 16) & 1u)) >> 16; }
__device__ __forceinline__ unsigned pk2(float lo, float hi) { return f2bf(lo) | (f2bf(hi) << 16); }
__device__ __forceinline__ float bflo(unsigned w) { return __uint_as_float(w << 16); }
__device__ __forceinline__ float bfhi(unsigned w) { return __uint_as_float(w & 0xffff0000u); }
__device__ __forceinline__ float bf1(bf16 v) { return __uint_as_float((unsigned)v << 16); }
__device__ __forceinline__ float sigmoidf_(float x) { return __builtin_amdgcn_rcpf(1.f + __builtin_amdgcn_exp2f(-1.4426950408889634f * x)); }
__device__ __forceinline__ float siluf_(float x) { return x * sigmoidf_(x); }
__device__ __forceinline__ float gelu_tanh(float x) { const float u = 0.7978845608028654f * (x + 0.044715f * x * x * x); return x * sigmoidf_(2.f * u); }
__device__ __forceinline__ float wave_sum(float v) {
#pragma unroll
    for (int o = 1; o < 64; o <<= 1) v += __shfl_xor(v, o);
    return v;
}

#define XB_TMO      128
#define XB_XCNT(j)  (256  + 64 * (j))
#define XB_XSUB(j)  (1280 + 64 * (j))
#define XB_XGEN(j)  (2304 + 64 * (j))
#define XB_TOP      3328
#define XB_TOPGEN   3392
#define XCD_BAR_WORDS 3456
#define XB_SPIN_CAP (1u << 18)

__device__ __forceinline__ unsigned xb_ld(unsigned* p)              { return __hip_atomic_load(p, __ATOMIC_RELAXED, __HIP_MEMORY_SCOPE_AGENT); }
__device__ __forceinline__ unsigned xb_add(unsigned* p, unsigned v) { return __hip_atomic_fetch_add(p, v, __ATOMIC_RELAXED, __HIP_MEMORY_SCOPE_AGENT); }
__device__ __forceinline__ unsigned xb_xcc_id() { return (unsigned)__builtin_amdgcn_s_getreg((3 << 11) | 20) & 0xFu; }
#define XB_SPIN(cond, bar) do { unsigned _sp = 0; while (cond) { __builtin_amdgcn_s_sleep(1); \
    if ((++_sp & 255u) == 0u) { if (xb_ld(&(bar)[XB_TMO])) break; if (_sp > XB_SPIN_CAP) { atomicAdd(&(bar)[XB_TMO], 1u); break; } } } } while (0)

struct XcdBarrier {
    unsigned* bar; unsigned x;
    volatile LAS unsigned* st;
};

__device__ __forceinline__ XcdBarrier xcd_barrier_post(unsigned* bar, volatile LAS unsigned* st, int tid) {
    XcdBarrier b; b.bar = bar; b.x = xb_xcc_id(); b.st = st;
    if (tid == 0) (void)xb_add(&bar[XB_XCNT(b.x)], 1u);
    return b;
}
__device__ __forceinline__ void xcd_barrier_complete(unsigned* bar, unsigned x, unsigned& nloc, unsigned& nx) {
    const unsigned G = gridDim.x * gridDim.y * gridDim.z;
    unsigned sum, cnt, mine, sp = 0u;
    for (;;) {
        sum = 0u; cnt = 0u; mine = 0u;
#pragma unroll 1
        for (unsigned j = 0; j < 16; ++j) { const unsigned c = xb_ld(&bar[XB_XCNT(j)]); sum += c; cnt += (c > 0u) ? 1u : 0u; mine = (j == x) ? c : mine; }
        if (sum == G) break;
        __builtin_amdgcn_s_sleep(1);
        if ((++sp & 255u) == 0u) { if (xb_ld(&bar[XB_TMO])) break; if (sp > XB_SPIN_CAP) { atomicAdd(&bar[XB_TMO], 1u); break; } }
    }
    nloc = mine > 0u ? mine : 1u; nx = cnt > 0u ? cnt : 1u;
}

__device__ __forceinline__ void xcd_barrier(const XcdBarrier& b, int tid) {
    asm volatile("s_waitcnt vmcnt(0)" ::: "memory");
    __syncthreads();
    if (tid == 0) {
        unsigned* bar = b.bar;
        __builtin_amdgcn_s_waitcnt(0);
        unsigned nloc = b.st[0], nx = b.st[1];
        if (nloc == 0u) { xcd_barrier_complete(bar, b.x, nloc, nx); b.st[0] = nloc; b.st[1] = nx; }
        const unsigned old = xb_add(&bar[XB_XSUB(b.x)], 1u);
        const unsigned gen = old / nloc;
        if (old + 1u == (gen + 1u) * nloc) {
            __builtin_amdgcn_fence(__ATOMIC_RELEASE, "agent");
            asm volatile("s_waitcnt vmcnt(0)" ::: "memory");
            const unsigned og = xb_add(&bar[XB_TOP], 1u);
            const unsigned tg = og / nx;
            if (og + 1u == (tg + 1u) * nx) xb_add(&bar[XB_TOPGEN], 1u);
            else XB_SPIN(xb_ld(&bar[XB_TOPGEN]) == tg, bar);
            __builtin_amdgcn_fence(__ATOMIC_ACQUIRE, "agent");
            xb_add(&bar[XB_XGEN(b.x)], 1u);
            asm volatile("s_waitcnt vmcnt(0)" ::: "memory");
        } else {
            XB_SPIN(xb_ld(&bar[XB_XGEN(b.x)]) == gen, bar);
            __builtin_amdgcn_fence(__ATOMIC_ACQUIRE, "agent");
            asm volatile("s_waitcnt vmcnt(0)" ::: "memory");
        }
    }
    __syncthreads();
}

struct Frame {
    LAS unsigned char* lds;
    int tid, lane, wave;
    int vcu, G;
    int gw, NGW;
    float* out; unsigned char* ws;
};
constexpr int PTR_OFF = LDSCTL_OFF + 512;
__device__ __forceinline__ const float* inp_(LAS unsigned char* lds, int i) {
    const unsigned long long v = *(const LAS unsigned long long*)(lds + PTR_OFF + 8 * i);
    const unsigned lo = __builtin_amdgcn_readfirstlane((unsigned)v), hi = __builtin_amdgcn_readfirstlane((unsigned)(v >> 32));
    return (const float*)(((unsigned long long)hi << 32) | lo);
}
#define INP(i) inp_(F.lds, (i))
#define WSP(T, off) ((T*)(F.ws + (off)))

__device__ __forceinline__ void gemv17_item(Frame& F, const LAS float* tab, LAS float* red, const float* W, int ldw, int n0, const float* bias, float* outp, int ldo) {
    float acc[17];
#pragma unroll
    for (int r = 0; r < 17; ++r) acc[r] = 0.f;
    const int k0 = F.wave * 128;
    const float* wp = W + (size_t)k0 * ldw + n0 + F.lane;
#pragma unroll 4
    for (int k = 0; k < 128; ++k) {
        const float wv = wp[(size_t)k * ldw];
#pragma unroll
        for (int r = 0; r < 17; ++r) acc[r] += tab[r * 1024 + k0 + k] * wv;
    }
#pragma unroll
    for (int r = 0; r < 17; ++r) red[(F.wave * 17 + r) * 64 + F.lane] = acc[r];
    __syncthreads();
    for (int i = F.tid; i < 17 * 64; i += NWAVES * 64) {
        const int r = i >> 6, n = i & 63; float s = bias ? bias[n0 + n] : 0.f;
#pragma unroll
        for (int w = 0; w < 8; ++w) s += red[(w * 17 + r) * 64 + n];
        outp[(size_t)r * ldo + n0 + n] = s;
    }
    __syncthreads();
}

__device__ __forceinline__ void p0_transpose_item(const float* W, int K, int N, bf16* WT, LAS float* scr, int item, int lane) {
    const int nblk = N / 32, kb = item / nblk, nb = item % nblk, k0 = 64 * kb, n0 = 32 * nb;
#pragma unroll 8
    for (int i = 0; i < 32; ++i) { const int kk = 2 * i + (lane >> 5); scr[kk * 33 + (lane & 31)] = W[(size_t)(k0 + kk) * N + n0 + (lane & 31)]; }
    LDS_WAIT(); asm volatile("" ::: "memory");
    const int c = lane & 7;
#pragma unroll
    for (int j = 0; j < 4; ++j) { const int n = (lane >> 3) + 8 * j; const LAS float* s = scr + (8 * c) * 33 + n;
        v4u o; o.x = pk2(s[0 * 33], s[1 * 33]); o.y = pk2(s[2 * 33], s[3 * 33]); o.z = pk2(s[4 * 33], s[5 * 33]); o.w = pk2(s[6 * 33], s[7 * 33]);
        *(GAS v4u*)(WT + (size_t)(n0 + n) * K + k0 + 8 * c) = o; }
    LDS_WAIT(); asm volatile("" ::: "memory");
}

__device__ __forceinline__ void phase_p0a(Frame& F) {
    LAS float* tab = (LAS float*)(F.lds);
    LAS float* red = (LAS float*)(F.lds + 17 * 1024 * 4);
    float* MOD = WSP(float, WS_MOD);
    bool filled = false;
    for (int it = F.vcu; it < 2 * 96; it += F.G) {
        if (!filled) {
            for (int i = F.tid; i < 17 * 1024; i += NWAVES * 64) { const int r = i >> 10, k = i & 1023; const float v = (r < 16) ? INP(1)[r * D + k] : INP(3)[k]; tab[i] = siluf_(v); }
            __syncthreads(); filled = true;
        }
        const int l = it / 96, n0 = (it % 96) * 64;
        gemv17_item(F, tab, red, INP(6) + (size_t)l * D * MODW, MODW, n0, INP(7) + (size_t)l * MODW, MOD + (size_t)l * 17 * MODW, MODW);
    }
    __syncthreads();
    {
        bf16* WLR = WSP(bf16, WS_WLR);
        for (int i = F.gw * 64 + F.lane; i < 2 * 2 * 4 * 2 * 4096; i += F.NGW * 64) { const int d = i & 63, e = (i >> 6) & 63, gt = (i >> 12) & 1, blk = i >> 13;
            const float* src = gt == 0 ? INP(17) : INP(19); WLR[i] = (bf16)f2bf(src[((size_t)blk * 64 + d) * 64 + e]); }
    }
    LAS float* scr = (LAS float*)(F.lds + F.wave * 16384);
    constexpr int I_IN = (D / 64) * (IND / 32), I_OUT = (D / 64) * (D / 32), I_1 = (D / 64) * (FF / 32), I_2 = (FF / 64) * (D / 32), I_L = I_IN + I_OUT + I_1 + I_2;
    for (int it = F.gw; it < 2 * I_L; it += F.NGW) {
        const int l = it / I_L; int r = it % I_L;
        const float* W; bf16* WT; int K = D, N;
        if (r < I_IN) { W = INP(8) + (size_t)l * D * IND; WT = WSP(bf16, WS_WIN) + (size_t)l * IND * D; N = IND; }
        else if (r < I_IN + I_OUT) { r -= I_IN; W = INP(9) + (size_t)l * D * D; WT = WSP(bf16, WS_WOUT) + (size_t)l * D * D; N = D; }
        else if (r < I_IN + I_OUT + I_1) { r -= I_IN + I_OUT; W = INP(22) + (size_t)l * D * FF; WT = WSP(bf16, WS_W1) + (size_t)l * FF * D; N = FF; }
        else { r -= I_IN + I_OUT + I_1; W = INP(23) + (size_t)l * FF * D; WT = WSP(bf16, WS_W2) + (size_t)l * D * FF; K = FF; N = D; }
        p0_transpose_item(W, K, N, WT, scr, r, F.lane);
    }
}

__device__ __forceinline__ void phase_p0b(Frame& F) {
    LAS float* tab = (LAS float*)(F.lds);
    LAS float* red = (LAS float*)(F.lds + 17 * 1024 * 4);
    const float* MOD = WSP(const float, WS_MOD);
    for (int it = F.vcu; it < 2 * 104; it += F.G) {
        const int l = it / 104, j = it % 104; const bool first = j < 40;
        const int shoff = first ? 0 : 3 * D;
        __syncthreads();
        for (int i = F.tid; i < 17 * 1024; i += NWAVES * 64) { const int r = i >> 10, k = i & 1023; tab[i] = MOD[((size_t)l * 17 + r) * MODW + shoff + k]; }
        __syncthreads();
        const int ldw = first ? IND : FF;
        gemv17_item(F, tab, red, first ? INP(8) + (size_t)l * D * IND : INP(22) + (size_t)l * D * FF, ldw, (first ? j : j - 40) * 64, nullptr,
                    first ? WSP(float, WS_SHW1) + (size_t)l * 17 * IND : WSP(float, WS_SHW2) + (size_t)l * 17 * FF, ldw);
    }
    bf16* XA = WSP(bf16, WS_XA); float* RSSA = WSP(float, WS_RSSA);
    const float* g1 = INP(4);
    for (int row = F.gw; row < MT; row += F.NGW) {
        const bool lat = row < ML;
        const float* xr = lat ? INP(0) + (size_t)row * D : INP(2) + (size_t)(row - ML) * D;
        const int brow = lat ? (row >> 11) : NB;
        const float* sc = MOD + (size_t)brow * MODW + D;
        f32x4 v[4]; float ss = 0.f;
#pragma unroll
        for (int j = 0; j < 4; ++j) { v[j] = *(const f32x4*)(xr + 4 * F.lane + 256 * j); ss += (v[j][0] * v[j][0] + v[j][1] * v[j][1]) + (v[j][2] * v[j][2] + v[j][3] * v[j][3]); }
        ss = wave_sum(ss);
        if (F.lane < 32) RSSA[(size_t)row * 32 + F.lane] = (F.lane == 0) ? ss : 0.f;
#pragma unroll
        for (int j = 0; j < 4; ++j) { const int k = 4 * F.lane + 256 * j;
            const f32x4 gm = *(const f32x4*)(g1 + k) * (*(const f32x4*)(sc + k) + 1.0f), a = v[j] * gm;
            v2u o; o.x = pk2(a[0], a[1]); o.y = pk2(a[2], a[3]); *(v2u*)(XA + (size_t)row * D + k) = o; }
    }
}

constexpr int CV_OSROW = 260;
__device__ __forceinline__ void conv_phase(Frame& F, int l, int ntiles) {
    const bf16* PROJ = WSP(const bf16, WS_PROJ); bf16* MIX = WSP(bf16, WS_MIX);
    LAS float* us = (LAS float*)(F.lds);
    LAS float* os = (LAS float*)(F.lds + 62 * 256 * 4);
    const int c = F.tid & 255, half = F.tid >> 8;
    float w[31];
#pragma unroll
    for (int k = 0; k < 31; ++k) w[k] = INP(10)[((size_t)l * 31 + k) * 256 + c];
    const float cbias = INP(11)[l * 256 + c];
    const f32x4 lg = *(const f32x4*)(INP(12) + l * 256 + 4 * F.lane), lb = *(const f32x4*)(INP(13) + l * 256 + 4 * F.lane);
    unsigned pv[16], pg[16];
    auto load_tile = [&](int T) {
        const int row0 = T * 32;
        int lo, hi; if (row0 < ML) { lo = row0 & ~(SEQ - 1); hi = lo + SEQ; } else { lo = row0 & ~(CTXL - 1); hi = lo + CTXL; }
#pragma unroll
        for (int j = 0; j < 16; ++j) { const int i = F.tid + 512 * j, rr = i >> 7, cp = i & 127, row = row0 - 15 + rr;
            const bool ok = (j < 15 || F.tid < 256) && row >= lo && row < hi;
            pv[j] = ok ? *(const unsigned*)(PROJ + (size_t)row * IND + 2 * cp) : 0u; pg[j] = ok ? *(const unsigned*)(PROJ + (size_t)row * IND + 256 + 2 * cp) : 0u; }
    };
    if (F.vcu < ntiles) load_tile(F.vcu);
    for (int T = F.vcu; T < ntiles; T += F.G) {
        const int row0 = T * 32;
        __syncthreads();
#pragma unroll
        for (int j = 0; j < 16; ++j) { const int i = F.tid + 512 * j;
            if (j < 15 || F.tid < 256) { f32x2 u; u[0] = bflo(pv[j]) * sigmoidf_(bflo(pg[j])); u[1] = bfhi(pv[j]) * sigmoidf_(bfhi(pg[j])); *(LAS f32x2*)(us + 2 * i) = u; } }
        if (T + F.G < ntiles) load_tile(T + F.G);
        __syncthreads();
        {
            float acc[16];
#pragma unroll
            for (int j = 0; j < 16; ++j) acc[j] = cbias;
            const LAS float* up = us + (16 * half) * 256 + c;
#pragma unroll
            for (int i = 0; i < 46; ++i) { const float x = up[i * 256];
#pragma unroll
                for (int j = 0; j < 16; ++j) if (i - j >= 0 && i - j <= 30) acc[j] += w[i - j] * x; }
#pragma unroll
            for (int j = 0; j < 16; ++j) os[(16 * half + j) * CV_OSROW + c] = acc[j];
        }
        __syncthreads();
#pragma unroll
        for (int q = 0; q < 4; ++q) { const int t = 4 * F.wave + q;
            const f32x4 v = *(const LAS f32x4*)(os + t * CV_OSROW + 4 * F.lane);
            const float mu = wave_sum((v[0] + v[1]) + (v[2] + v[3])) * (1.f / 256.f);
            const f32x4 d = v - mu;
            const float var = wave_sum((d[0] * d[0] + d[1] * d[1]) + (d[2] * d[2] + d[3] * d[3])) * (1.f / 256.f);
            const f32x4 y = d * rsqrtf(var + EPS) * lg + lb;
            v2u o; o.x = pk2(siluf_(y[0]), siluf_(y[1])); o.y = pk2(siluf_(y[2]), siluf_(y[3]));
            *(v2u*)(MIX + (size_t)(row0 + t) * D + 4 * F.lane) = o; }
    }
}

typedef short s16x8 __attribute__((ext_vector_type(8)));
typedef short s16x4 __attribute__((ext_vector_type(4)));
constexpr int NA_KROW = 144, NA_VROW = 160;
constexpr int NA_STAGE = 64 * NA_KROW + 64 * NA_VROW, NA_OFF_TB = 2 * NA_STAGE;
constexpr int NA_ITEMS_LAT = NB * NH * 16, NA_ITEMS_CTX = NB * NH * 2;
__device__ __forceinline__ void na_phase(Frame& F, int l, int nitems) {
    const bf16* PROJ = WSP(const bf16, WS_PROJ); bf16* MIX = WSP(bf16, WS_MIX);
    LAS float* tb = (LAS float*)(F.lds + NA_OFF_TB);
    const int lane = F.lane, q16 = lane & 15, g = lane >> 4;
    const unsigned skey = (unsigned)(F.tid >> 3), spart = (unsigned)(F.tid & 7);
    const float c1 = 0.125f * 1.4426950408889634f;
    for (int it = F.vcu; it < nitems; it += F.G) {
        const bool isctx = it >= NA_ITEMS_LAT;
        int b, h, r = 0, jq = 0, qrow0, rsA = 0, nloc = 0;
        if (!isctx) { const int rp = it & 15; h = (it >> 4) & 7; b = it >> 7; const int r0 = 2 * rp; r = r0 + (F.wave >> 2); jq = F.wave & 3; qrow0 = b * SEQ + r * 64 + jq * 16;
            rsA = r0 - 4; rsA = rsA < 0 ? 0 : (rsA > 24 ? 24 : rsA); int rsB = r0 - 3; rsB = rsB < 0 ? 0 : (rsB > 24 ? 24 : rsB); nloc = rsB + 8 - rsA; }
        else { const int j = it - NA_ITEMS_LAT; const int hf = j & 1; h = (j >> 1) & 7; b = j >> 4; qrow0 = ML + b * CTXL + hf * 128 + F.wave * 16; }
        const int nch = nloc + 4;
        const bf16* Pq = PROJ + 512 + h * HD, * Pk = PROJ + 1024 + h * HD + 8 * spart, * Pv = PROJ + 1536 + h * HD + 8 * spart;
        auto krow_of = [&](int ch) -> int { return ch < nloc ? b * SEQ + (rsA + ch) * 64 : ML + b * CTXL + (ch - nloc) * 64; };
        s16x8 qf[2];
#pragma unroll
        for (int s = 0; s < 2; ++s) qf[s] = *(const s16x8*)(Pq + (size_t)(qrow0 + q16) * IND + 32 * s + 8 * g);
        int rs = r - 4; rs = rs < 0 ? 0 : (rs > 24 ? 24 : rs);
        const int tlo = jq < 2 ? 0 : jq - 1, thi = jq > 1 ? 3 : jq + 1;
        float madd[4][4]; int lb;
        {
            const int qc = jq * 16 + q16; int cs = qc - 8; cs = cs < 0 ? 0 : (cs > 48 ? 48 : cs);
#pragma unroll
            for (int t = 0; t < 4; ++t)
#pragma unroll
                for (int e = 0; e < 4; ++e) madd[t][e] = ((unsigned)(16 * t + 4 * g + e - cs) < 16u) ? 0.f : -1.0e30f;
            lb = 64 + 4 * g - qc + 15;
        }
        v4u kr_ = *(const v4u*)(Pk + (size_t)(krow_of(0) + (int)skey) * IND), vr_ = *(const v4u*)(Pv + (size_t)(krow_of(0) + (int)skey) * IND);
        __syncthreads();
        if (!isctx) { const float* rpb = INP(14) + ((size_t)l * NH + h) * 15 * 31;
            for (int i = F.tid; i < 640; i += NWAVES * 64) tb[i] = (i >= 64 && i < 64 + 465) ? rpb[i - 64] * 1.4426950408889634f : 0.f; }
        *(LAS v4u*)(F.lds + skey * NA_KROW + spart * 16) = kr_; *(LAS v4u*)(F.lds + 64 * NA_KROW + skey * NA_VROW + spart * 16) = vr_;
        kr_ = *(const v4u*)(Pk + (size_t)(krow_of(1) + (int)skey) * IND); vr_ = *(const v4u*)(Pv + (size_t)(krow_of(1) + (int)skey) * IND);
        f32x4 O[4];
#pragma unroll
        for (int dt = 0; dt < 4; ++dt) O[dt] = (f32x4){0.f, 0.f, 0.f, 0.f};
        float m = -1.0e30f, lsum = 0.f;
        for (int ch = 0; ch < nch; ++ch) {
            __syncthreads();
            LAS unsigned char* cur = F.lds + (ch & 1) * NA_STAGE; LAS unsigned char* nxt = F.lds + ((ch + 1) & 1) * NA_STAGE;
            if (ch + 1 < nch) { *(LAS v4u*)(nxt + skey * NA_KROW + spart * 16) = kr_; *(LAS v4u*)(nxt + 64 * NA_KROW + skey * NA_VROW + spart * 16) = vr_; }
            if (ch + 2 < nch) { const int k2 = krow_of(ch + 2) + (int)skey; kr_ = *(const v4u*)(Pk + (size_t)k2 * IND); vr_ = *(const v4u*)(Pv + (size_t)k2 * IND); }
            const bool local = ch < nloc;
            if (local) { const int kr = rsA + ch; if (kr < rs || kr > rs + 7) continue; }
            const LAS unsigned char* kb_ = cur + q16 * NA_KROW + 16 * g;
            const LAS unsigned char* vtr = cur + 64 * NA_KROW + (4 * g + (q16 >> 2)) * NA_VROW + (q16 & 3) * 8;
            f32x4 S[4];
#pragma unroll
            for (int t = 0; t < 4; ++t) { S[t] = (f32x4){0.f, 0.f, 0.f, 0.f};
                if (!local || (t >= tlo && t <= thi)) {
#pragma unroll
                    for (int s = 0; s < 2; ++s) { const s16x8 kf = *(const LAS s16x8*)(kb_ + t * 16 * NA_KROW + 64 * s); S[t] = __builtin_amdgcn_mfma_f32_16x16x32_bf16(kf, qf[s], S[t], 0, 0, 0); } } }
            float cm = -1.0e30f;
            if (local) {
                const LAS float* tr_ = tb + (rsA + ch - r + 7) * 31 + lb;
#pragma unroll
                for (int t = 0; t < 4; ++t) if (t >= tlo && t <= thi) {
#pragma unroll
                    for (int e = 0; e < 4; ++e) { const float v = S[t][e] * c1 + tr_[16 * t + e] + madd[t][e]; S[t][e] = v; cm = fmaxf(cm, v); } }
            } else {
#pragma unroll
                for (int t = 0; t < 4; ++t)
#pragma unroll
                    for (int e = 0; e < 4; ++e) { const float v = S[t][e] * c1; S[t][e] = v; cm = fmaxf(cm, v); }
            }
            cm = fmaxf(cm, __shfl_xor(cm, 16)); cm = fmaxf(cm, __shfl_xor(cm, 32));
            const float mn = fmaxf(m, cm), alpha = __builtin_amdgcn_exp2f(m - mn); m = mn;
            float ps = 0.f;
            unsigned pk[4][2];
#pragma unroll
            for (int t = 0; t < 4; ++t) {
                if (!local || (t >= tlo && t <= thi)) {
                    const float p0 = __builtin_amdgcn_exp2f(S[t][0] - mn), p1 = __builtin_amdgcn_exp2f(S[t][1] - mn), p2 = __builtin_amdgcn_exp2f(S[t][2] - mn), p3 = __builtin_amdgcn_exp2f(S[t][3] - mn);
                    ps += (p0 + p1) + (p2 + p3);
                    pk[t][0] = pg8::cvt_pk_bf16(p0, p1); pk[t][1] = pg8::cvt_pk_bf16(p2, p3);
                } else { pk[t][0] = 0u; pk[t][1] = 0u; }
            }
            lsum = lsum * alpha + ps;
#pragma unroll
            for (int dt = 0; dt < 4; ++dt) O[dt] = O[dt] * alpha;
#pragma unroll
            for (int p = 0; p < 2; ++p) {
                if (!local || (2 * p <= thi && 2 * p + 1 >= tlo)) {
                    const v4u bw = {pk[2 * p][0], pk[2 * p][1], pk[2 * p + 1][0], pk[2 * p + 1][1]};
                    const s16x8 bfrag = __builtin_bit_cast(s16x8, bw);
#pragma unroll
                    for (int dt = 0; dt < 4; ++dt) {
                        const s16x4 a0 = __builtin_amdgcn_ds_read_tr16_b64_v4i16((LAS s16x4*)(vtr + (2 * p) * 16 * NA_VROW + dt * 32));
                        const s16x4 a1 = __builtin_amdgcn_ds_read_tr16_b64_v4i16((LAS s16x4*)(vtr + (2 * p + 1) * 16 * NA_VROW + dt * 32));
                        const s16x8 afrag = __builtin_shufflevector(a0, a1, 0, 1, 2, 3, 4, 5, 6, 7);
                        O[dt] = __builtin_amdgcn_mfma_f32_16x16x32_bf16(afrag, bfrag, O[dt], 0, 0, 0);
                    }
                }
            }
        }
        lsum += __shfl_xor(lsum, 16); lsum += __shfl_xor(lsum, 32);
        const float inv = __builtin_amdgcn_rcpf(lsum);
        bf16* op = MIX + (size_t)(qrow0 + q16) * D + 256 + h * HD + 4 * g;
#pragma unroll
        for (int dt = 0; dt < 4; ++dt) { v2u w; w.x = pg8::cvt_pk_bf16(O[dt][0] * inv, O[dt][1] * inv); w.y = pg8::cvt_pk_bf16(O[dt][2] * inv, O[dt][3] * inv); *(v2u*)(op + 16 * dt) = w; }
    }
}

constexpr int LRU_UCROW = 260;
constexpr int LRU_OFF_UC = 38 * 256 * 2, LRU_OFF_GT = LRU_OFF_UC + 2 * 32 * LRU_UCROW * 4;
static_assert(LRU_OFF_GT + 32 * 256 * 2 <= RING_BYTES, "LRU LDS map");
template <int PASS>
__device__ __forceinline__ void lru_phase(Frame& F, int l, int ntiles) {
    const bf16* PROJ = WSP(const bf16, WS_PROJ);
    LAS bf16* rxs = (LAS bf16*)(F.lds);
    LAS float* ucf = (LAS float*)(F.lds + LRU_OFF_UC);
    LAS bf16* gts = (LAS bf16*)(F.lds + LRU_OFF_GT);
    const int lane = F.lane, j16 = lane & 15, g = lane >> 4;
    const int kb = F.wave & 3, nh = F.wave >> 2;
    s16x8 wf[2][2][2][2];
    float cbx[2][2], cba[2][2], csp[2][2];
#pragma unroll
    for (int dir = 0; dir < 2; ++dir) {
        const int ld = l * 2 + dir;
        const bf16* WLR = WSP(const bf16, WS_WLR) + (size_t)((ld * 4 + kb) * 2) * 4096;
#pragma unroll
        for (int gt = 0; gt < 2; ++gt)
#pragma unroll
            for (int n2 = 0; n2 < 2; ++n2)
#pragma unroll
                for (int s_ = 0; s_ < 2; ++s_) wf[dir][gt][n2][s_] = *(const s16x8*)(WLR + gt * 4096 + (16 * (2 * nh + n2) + j16) * 64 + 32 * s_ + 8 * g);
#pragma unroll
        for (int n2 = 0; n2 < 2; ++n2) {
            const int e = kb * 64 + 16 * (2 * nh + n2) + j16, idx = ld * 256 + e;
            cbx[dir][n2] = INP(18)[idx]; cba[dir][n2] = INP(20)[idx];
            const float nl = -INP(21)[idx]; csp[dir][n2] = -8.f * (fmaxf(nl, 0.f) + log1pf(__expf(-fabsf(nl))));
        }
    }
    const int c = F.tid & 255, sdir = F.tid >> 8;
    const int sld = l * 2 + sdir;
    const float s1w0 = INP(15)[(sld * 4 + 0) * 256 + c], s1w1 = INP(15)[(sld * 4 + 1) * 256 + c], s1w2 = INP(15)[(sld * 4 + 2) * 256 + c], s1w3 = INP(15)[(sld * 4 + 3) * 256 + c], s1cb = INP(16)[sld * 256 + c];
    const int base = sdir == 0 ? 0 : 3;
    unsigned pre[10], pgw[8];
    auto load_tile = [&](int T) {
        const int row0 = T * 32;
        int lo, hi; if (row0 < ML) { lo = row0 & ~(SEQ - 1); hi = lo + SEQ; } else { lo = row0 & ~(CTXL - 1); hi = lo + CTXL; }
#pragma unroll
        for (int j = 0; j < 10; ++j) { const int i = F.tid + 512 * j, rr = i >> 7, cp = i & 127, row = row0 - 3 + rr;
            const bool ok = (j < 9 || F.tid < 256) && row >= lo && row < hi;
            pre[j] = ok ? *(const unsigned*)(PROJ + (size_t)row * IND + 2048 + 2 * cp) : 0u; }
        if (PASS == 1) {
#pragma unroll
            for (int j = 0; j < 8; ++j) { const int i = F.tid + 512 * j, t = i >> 7, cp = i & 127; pgw[j] = *(const unsigned*)(PROJ + (size_t)(row0 + t) * IND + 2304 + 2 * cp); }
        }
    };
    if (F.vcu < ntiles) load_tile(F.vcu);
    for (int T = F.vcu; T < ntiles; T += F.G) {
        const int row0 = T * 32;
        __syncthreads();
#pragma unroll
        for (int j = 0; j < 10; ++j) { const int i = F.tid + 512 * j; if (j < 9 || F.tid < 256) ((LAS unsigned*)rxs)[i] = pre[j]; }
        if (PASS == 1) {
#pragma unroll
            for (int j = 0; j < 8; ++j) ((LAS unsigned*)gts)[F.tid + 512 * j] = pgw[j];
        }
        if (T + F.G < ntiles) load_tile(T + F.G);
        float hst[2][2];
#pragma unroll
        for (int dir = 0; dir < 2; ++dir)
#pragma unroll
            for (int n2 = 0; n2 < 2; ++n2) hst[dir][n2] = PASS == 1 ? WSP(const float, WS_CARRY)[((size_t)dir * 1152 + T) * 256 + kb * 64 + 16 * (2 * nh + n2) + j16] : 0.f;
        __syncthreads();
        {
            float x0 = bf1(rxs[(base + 0) * 256 + c]), x1 = bf1(rxs[(base + 1) * 256 + c]), x2 = bf1(rxs[(base + 2) * 256 + c]);
#pragma unroll 8
            for (int t = 0; t < 32; ++t) {
                const float x3 = bf1(rxs[(t + base + 3) * 256 + c]);
                ucf[(sdir * 32 + t) * LRU_UCROW + c] = s1cb + s1w0 * x0 + s1w1 * x1 + s1w2 * x2 + s1w3 * x3;
                x0 = x1; x1 = x2; x2 = x3;
            }
        }
        __syncthreads();
        float hf[2][2][4];
        float Pt[2][2] = {{1.f, 1.f}, {1.f, 1.f}};
#pragma unroll
        for (int dir = 0; dir < 2; ++dir) {
            const bool sec16 = ((g & 1) != 0) != (dir != 0), sec32 = ((g >> 1) != 0) != (dir != 0);
#pragma unroll
            for (int step = 0; step < 2; ++step) {
                const int rt = dir == 0 ? step : 1 - step;
                s16x8 af[2];
#pragma unroll
                for (int s_ = 0; s_ < 2; ++s_) { const LAS float* up = ucf + (dir * 32 + 16 * rt + j16) * LRU_UCROW + kb * 64 + 32 * s_ + 8 * g;
                    const f32x4 u0 = *(const LAS f32x4*)up, u1 = *(const LAS f32x4*)(up + 4);
                    const v4u w = {pg8::cvt_pk_bf16(u0[0], u0[1]), pg8::cvt_pk_bf16(u0[2], u0[3]), pg8::cvt_pk_bf16(u1[0], u1[1]), pg8::cvt_pk_bf16(u1[2], u1[3])};
                    af[s_] = __builtin_bit_cast(s16x8, w); }
#pragma unroll
                for (int n2 = 0; n2 < 2; ++n2) {
                    f32x4 zx = {0.f, 0.f, 0.f, 0.f}, za = {0.f, 0.f, 0.f, 0.f};
#pragma unroll
                    for (int s_ = 0; s_ < 2; ++s_) { zx = __builtin_amdgcn_mfma_f32_16x16x32_bf16(af[s_], wf[dir][0][n2][s_], zx, 0, 0, 0); za = __builtin_amdgcn_mfma_f32_16x16x32_bf16(af[s_], wf[dir][1][n2][s_], za, 0, 0, 0); }
                    const int e = kb * 64 + 16 * (2 * nh + n2) + j16;
                    const LAS float* uo = ucf + (dir * 32 + 16 * rt + 4 * g) * LRU_UCROW + e;
                    float a_[4], b_[4];
#pragma unroll
                    for (int r = 0; r < 4; ++r) {
                        const float u = uo[r * LRU_UCROW];
                        const float gx = sigmoidf_(zx[r] + cbx[dir][n2]), ga = sigmoidf_(za[r] + cba[dir][n2]);
                        const float la = csp[dir][n2] * ga, a = __builtin_amdgcn_exp2f(1.4426950408889634f * la), y = 2.f * la;
                        const float om = y > -0.02f ? -y * (1.f + y * (0.5f + y * 0.16666667f)) : 1.f - a * a;
                        a_[r] = a; b_[r] = __builtin_amdgcn_sqrtf(om) * gx * u;
                    }
                    const float P = (a_[0] * a_[1]) * (a_[2] * a_[3]);
                    const float S = dir == 0 ? ((b_[0] * a_[1] + b_[1]) * a_[2] + b_[2]) * a_[3] + b_[3] : ((b_[3] * a_[2] + b_[2]) * a_[1] + b_[1]) * a_[0] + b_[0];
                    const float Pp = __shfl_xor(P, 16), Sp = __shfl_xor(S, 16);
                    const float e1P = sec16 ? Pp : 1.f, e1S = sec16 ? Sp : 0.f;
                    const float prP = P * Pp, prS = sec16 ? P * Sp + S : Pp * S + Sp;
                    const float Pq = __shfl_xor(prP, 32), Sq = __shfl_xor(prS, 32);
                    const float EP = sec32 ? Pq * e1P : e1P, ES = sec32 ? e1P * Sq + e1S : e1S;
                    const float TP = prP * Pq, TS = sec32 ? prP * Sq + prS : Pq * prS + Sq;
                    if (PASS == 1) {
                        float h = EP * hst[dir][n2] + ES;
                        if (dir == 0) {
#pragma unroll
                            for (int r = 0; r < 4; ++r) { h = a_[r] * h + b_[r]; hf[rt][n2][r] = h; }
                        } else {
                            float hb[4];
#pragma unroll
                            for (int r = 3; r >= 0; --r) { h = a_[r] * h + b_[r]; hb[r] = h; }
                            bf16* mp = WSP(bf16, WS_MIX) + (size_t)(row0 + 16 * rt + 4 * g) * D + 768 + e;
                            const LAS bf16* gp = gts + (16 * rt + 4 * g) * 256 + e;
#pragma unroll
                            for (int r = 0; r < 4; ++r) mp[(size_t)r * D] = (bf16)f2bf(gelu_tanh(bf1(gp[r * 256])) * (hf[rt][n2][r] + hb[r]));
                        }
                    } else Pt[dir][n2] *= TP;
                    hst[dir][n2] = TP * hst[dir][n2] + TS;
                }
            }
        }
        if (PASS == 0 && g == 0) {
#pragma unroll
            for (int dir = 0; dir < 2; ++dir)
#pragma unroll
                for (int n2 = 0; n2 < 2; ++n2) WSP(f32x2, WS_TOT)[((size_t)dir * 1152 + T) * 256 + kb * 64 + 16 * (2 * nh + n2) + j16] = (f32x2){Pt[dir][n2], hst[dir][n2]};
        }
    }
}
__device__ __forceinline__ void lru_carry(Frame& F) {
    const f32x2* TOT = WSP(const f32x2, WS_TOT); float* CARRY = WSP(float, WS_CARRY);
    for (int it = F.gw; it < NB * 2 * 4; it += F.NGW) {
        const int b = it >> 3, dir = (it >> 2) & 1, c = (it & 3) * 64 + F.lane;
        float h = 0.f;
        for (int g = 0; g < 18; ++g) {
            f32x2 ps[4]; int tl[4];
#pragma unroll
            for (int i = 0; i < 4; ++i) { const int s = g * 4 + i;
                int T; if (s < 8) T = 1024 + b * 8 + (dir == 0 ? s : 7 - s); else T = b * 64 + (dir == 0 ? s - 8 : 71 - s);
                tl[i] = T; ps[i] = TOT[((size_t)dir * 1152 + T) * 256 + c]; }
#pragma unroll
            for (int i = 0; i < 4; ++i) { CARRY[((size_t)dir * 1152 + tl[i]) * 256 + c] = h; h = ps[i][0] * h + ps[i][1]; }
        }
    }
}

__device__ __forceinline__ void final_rows(Frame& F) {
    const float* g = INP(24);
    for (int row = F.gw; row < ML; row += F.NGW) {
        float* xr = F.out + (size_t)row * D;
        f32x4 v[4]; float ss = 0.f;
#pragma unroll
        for (int j = 0; j < 4; ++j) { v[j] = *(const f32x4*)(xr + 4 * F.lane + 256 * j); ss += (v[j][0] * v[j][0] + v[j][1] * v[j][1]) + (v[j][2] * v[j][2] + v[j][3] * v[j][3]); }
        const float rs = rsqrtf(wave_sum(ss) * (1.f / D) + EPS);
#pragma unroll
        for (int j = 0; j < 4; ++j) { const int k = 4 * F.lane + 256 * j; *(f32x4*)(xr + k) = v[j] * rs * *(const f32x4*)(g + k); }
    }
}

constexpr int N_PHASES = 2 + 7 * DEPTH + 1;
struct Args { const float* in[25]; float* out; unsigned char* ws; int ph_lo, ph_hi; };
static_assert(sizeof(Args) == 27 * 8 + 8, "Args has no padding");

__global__ void __launch_bounds__(NWAVES * 64, 2) mega_fwd(Args args) {
    extern __shared__ __attribute__((aligned(16))) unsigned char lds[];
    Frame F;
    F.lds = (LAS unsigned char*)lds;
    const int wave_s = __builtin_amdgcn_readfirstlane((int)threadIdx.x >> 6);
    F.wave = wave_s; F.lane = (int)__builtin_amdgcn_mbcnt_hi(~0u, __builtin_amdgcn_mbcnt_lo(~0u, 0u)); F.tid = wave_s * 64 + F.lane;
    F.G = gridDim.x; { const int bx = blockIdx.x; F.vcu = (F.G % 8 == 0) ? (bx % 8) * (F.G / 8) + bx / 8 : bx; }
    F.gw = F.vcu * NWAVES + F.wave; F.NGW = F.G * NWAVES;
    F.out = args.out; F.ws = args.ws;
    volatile LAS unsigned* MISC = (volatile LAS unsigned*)(F.lds + MISC_OFF);
    for (int u = F.tid; u < (LDS_BYTES - LDSCTL_OFF) / 4; u += NWAVES * 64) ((LAS unsigned*)(F.lds + LDSCTL_OFF))[u] = 0u;
    __syncthreads();
    if (F.tid == 0) {
#pragma unroll
        for (int i = 0; i < 25; ++i) *(LAS unsigned long long*)(F.lds + PTR_OFF + 8 * i) = (unsigned long long)args.in[i];
    }
    __syncthreads();
    XcdBarrier bar = xcd_barrier_post((unsigned*)(F.ws + WS_CTL) + CW_BAR, MISC + 8, F.tid);

    const int lo = args.ph_lo, hi = args.ph_hi;
#ifdef PROBE_MASK
    bool rep_done = false;
#define PROBE_V ((((PROBE_MASK >> ph) & 1) && !rep_done) ? PROBE_VARIANT : 0)
#else
#define PROBE_V 0
#endif
    for (int ph = lo; ph < hi; ++ph) {
        { unsigned ones_ = ~0u; asm volatile("" : "+s"(ones_));
          int t_ = wave_s * 64 + (int)__builtin_amdgcn_mbcnt_hi(ones_, __builtin_amdgcn_mbcnt_lo(ones_, 0u)); asm volatile("" : "+v"(t_)); F.tid = t_; F.lane = t_ & 63; F.wave = __builtin_amdgcn_readfirstlane(t_ >> 6); F.gw = F.vcu * NWAVES + F.wave; }
        if (ph == 0) {
#ifndef NO_P0
            phase_p0a(F);
#endif
        } else if (ph == 1) {
#ifndef NO_P0
            phase_p0b(F);
#endif
        }
        else if (ph == N_PHASES - 1) final_rows(F);
        else {
            const int l = (ph - 2) / 7, k = (ph - 2) % 7; const bool last = (l == DEPTH - 1);
            const int Mx = last ? ML : MT;
            float* MOD = WSP(float, WS_MOD);
            if (k == 0) {
                pg8::Gemm g{WSP(const bf16, WS_XA), WSP(const bf16, WS_WIN) + (size_t)l * IND * D, MT, IND, D};
                pg8::Order S; if (last) S.init(ML, IND, (MC / 256) * 5, F.G, (int)blockIdx.x); else S.init(MT, IND, 0, F.G, (int)blockIdx.x);
                pg8::EpiScale<0, IND> E{WSP(bf16, WS_PROJ), WSP(const float, WS_SHW1) + (size_t)l * 17 * IND, WSP(const float, WS_RSSA), PROBE_V};

#ifndef NO_G0
                pg8::gemm_phase<pg8::EpiScale<0, IND>, pg8::Order, true, true>(F.lds + RING_OFF, g, S, E, F.tid);
#endif

            } else if (k == 1) {

#ifndef NO_LRU
                lru_phase<0>(F, l, 1152);
#ifdef REP_LRU0
                __syncthreads(); lru_phase<0>(F, l, 1152);
#endif
#endif

                __syncthreads();
#ifndef NO_CONV
                conv_phase(F, l, last ? 1024 : 1152);
                __syncthreads();
#ifdef REP_CONV
                conv_phase(F, l, last ? 1024 : 1152);
                __syncthreads();
#endif
#endif
#ifndef NO_NA
                na_phase(F, l, last ? NA_ITEMS_LAT : NA_ITEMS_LAT + NA_ITEMS_CTX);
#ifdef REP_NA
                na_phase(F, l, last ? NA_ITEMS_LAT : NA_ITEMS_LAT + NA_ITEMS_CTX);
#endif
#endif
            } else if (k == 2) {
                lru_carry(F);
            } else if (k == 3) {

#ifndef NO_LRU
                lru_phase<1>(F, l, last ? 1024 : 1152);
#endif

            } else if (k == 4 || k == 6) {
                const bool dn = (k == 6);
                const int ln = (dn && !last) ? l + 1 : l;
                pg8::Gemm g{dn ? WSP(const bf16, WS_HID) : WSP(const bf16, WS_MIX), dn ? WSP(const bf16, WS_W2) + (size_t)l * D * FF : WSP(const bf16, WS_WOUT) + (size_t)l * D * D, Mx, D, dn ? FF : D};
                pg8::Order S; S.init(Mx, D, 0, F.G, (int)blockIdx.x);
                const bool fromin = (!dn && l == 0);
                pg8::EpiRes E{fromin ? INP(0) : F.out, fromin ? INP(2) : WSP(const float, WS_CX), F.out, WSP(float, WS_CX),
                              MOD + (size_t)l * 17 * MODW + (dn ? 5 : 2) * D, (dn ? INP(4) : INP(5)) + ln * D, MOD + (size_t)ln * 17 * MODW + (dn ? 1 : 4) * D,
                              (dn && last) ? (bf16*)nullptr : WSP(bf16, WS_XA), dn ? WSP(float, WS_RSSA) : WSP(float, WS_RSSB)};
#ifndef NO_GR
                pg8::gemm_phase<pg8::EpiRes, pg8::Order, true, true>(F.lds + RING_OFF, g, S, E, F.tid);
#endif
            } else if (k == 5) {
                pg8::Gemm g{WSP(const bf16, WS_XA), WSP(const bf16, WS_W1) + (size_t)l * FF * D, Mx, FF, D};
                pg8::Order S; S.init(Mx, FF, 0, F.G, (int)blockIdx.x);
                pg8::EpiScale<1, FF> E{WSP(bf16, WS_HID), WSP(const float, WS_SHW2) + (size_t)l * 17 * FF, WSP(const float, WS_RSSB), PROBE_V};

#ifndef NO_G1
                pg8::gemm_phase<pg8::EpiScale<1, FF>, pg8::Order, true, true>(F.lds + RING_OFF, g, S, E, F.tid);
#endif

            }
        }
#ifdef PROBE_MASK
        if (((PROBE_MASK >> ph) & 1) && !rep_done) { rep_done = true; xcd_barrier(bar, F.tid); --ph; continue; }
        rep_done = false;
#endif
        if (ph + 1 < hi) xcd_barrier(bar, F.tid);
    }
}

extern "C" void kernel_launch(void* const* d_in, const int* in_sizes, int n_in, void* d_out, int out_size, void* d_ws, size_t ws_size, hipStream_t stream) {
    static int grid = 0;
    if (grid == 0) {
        if (n_in != 25 || out_size != ML * D || ws_size < WS_END) { fprintf(stderr, "kernel_launch: unexpected shapes (n_in %d out %d ws %zu)\n", n_in, out_size, ws_size); grid = -1; return; }
        int dev = 0, cus = 0;
        if (hipGetDevice(&dev) != hipSuccess || hipDeviceGetAttribute(&cus, hipDeviceAttributeMultiprocessorCount, dev) != hipSuccess) { grid = -1; return; }
        if (hipFuncSetAttribute((const void*)mega_fwd, hipFuncAttributeMaxDynamicSharedMemorySize, LDS_BYTES) != hipSuccess) { fprintf(stderr, "kernel_launch: hipFuncSetAttribute failed\n"); grid = -1; return; }
        int per_cu = 0;
        if (hipOccupancyMaxActiveBlocksPerMultiprocessor(&per_cu, (const void*)mega_fwd, NWAVES * 64, LDS_BYTES) != hipSuccess || per_cu < 1) fprintf(stderr, "kernel_launch: occupancy query reports %d\n", per_cu);
        (void)hipGetLastError();
        grid = cus;
    }
    if (grid < 0) return;
    if (hipMemsetAsync((char*)d_ws + WS_CTL, 0, CTL_ZERO_BYTES, stream) != hipSuccess) return;
    Args a{};
    for (int i = 0; i < 25; ++i) a.in[i] = (const float*)d_in[i];
    a.out = (float*)d_out; a.ws = (unsigned char*)d_ws;
#if MK_N_LAUNCHES == 1
    a.ph_lo = 0; a.ph_hi = N_PHASES;
    hipLaunchKernelGGL(mega_fwd, dim3(grid), dim3(NWAVES * 64), LDS_BYTES, stream, a);
#else
    for (int ph = 0; ph < N_PHASES; ++ph) { a.ph_lo = ph; a.ph_hi = ph + 1; hipLaunchKernelGGL(mega_fwd, dim3(grid), dim3(NWAVES * 64), LDS_BYTES, stream, a); }
#endif
}
```

```cpp
#include <hip/hip_runtime.h>
#include <cstdio>
#include <cstdint>

constexpr int D = 1024, NB = 16, SEQ = 2048, CTXL = 256, DEPTH = 2;
constexpr int ML = NB * SEQ, MC = NB * CTXL, MT = ML + MC;
constexpr int IND = 2560, FF = 4096, NH = 8, HD = 64;
constexpr int MODW = 6 * D;
constexpr float EPS = 1e-6f;
#ifndef MK_N_LAUNCHES
#define MK_N_LAUNCHES 1
#endif

namespace pg8 {
#define PG8_LAS __attribute__((address_space(3)))
typedef unsigned short bf16_t;
typedef short bf16x8 __attribute__((ext_vector_type(8)));
typedef float f32x4 __attribute__((ext_vector_type(4)));
typedef unsigned u32x4 __attribute__((ext_vector_type(4)));
constexpr int BM = 256, BK = 64, HALF = 128, HTB = HALF * BK * 2, STAGE_BYTES = 8 * HTB, NXCD = 8, WGM = 8;

__host__ __device__ __forceinline__ int lds_byte(int r, int c) { const int st = (r >> 4) * 2 + (c >> 5), rr = r & 15, cc = c & 31, ob = rr * 64 + cc * 2; return st * 1024 + (ob ^ (((ob >> 9) & 1) << 5)); }
__host__ __device__ __forceinline__ void stage_rc(int b, int& R, int& C) { const int st = b / 1024, sb = b % 1024, swz = sb ^ (((sb >> 9) & 1) << 5); R = (st >> 1) * 16 + swz / 64; C = (st & 1) * 32 + (swz % 64) / 2; }
__host__ __device__ __forceinline__ int perm32(int rho) { const int n = rho >> 4, i = rho & 15; return 8 * (i >> 2) + 4 * n + (i & 3); }

struct Unit { int pm, pn; };
struct Gemm { const bf16_t* A; const bf16_t* Bt; int M, N, K; };

__host__ __device__ __forceinline__ void map_tile(int wgid, int nM, int nN, Unit& u) {
    const int nwg = nM * nN;
    { const int q = nwg / NXCD, r = nwg % NXCD, xcd = wgid % NXCD, off = wgid / NXCD; wgid = (xcd < r ? xcd * (q + 1) : r * (q + 1) + (xcd - r) * q) + off; }
    const int nig = WGM * nN, gid = wgid / nig, fm = gid * WGM, gsz = (nM - fm) < WGM ? (nM - fm) : WGM;
    u.pm = fm + ((wgid % nig) % gsz); u.pn = (wgid % nig) / gsz;
}
struct Order {
    int nM, nN, nwg, extra, G, c;
    __host__ __device__ void init(int M, int N, int extra_, int G_, int c_) { nM = M / BM; nN = N / BM; nwg = nM * nN; extra = extra_; G = G_; c = c_; }
    __host__ __device__ bool next(int i, Unit& u) const {
        const long L = (long)i * G + c;
        if (L < nwg) { map_tile((int)L, nM, nN, u); return true; }
        if (L < nwg + extra) { const int q = (int)L - nwg; u.pm = nM + q / 5; u.pn = 4 + q % 5; return true; }
        return false;
    }
    __device__ __forceinline__ void a_ready(const Unit&) const {}
    __device__ __forceinline__ void done(const Unit&) const {}
};

__device__ __forceinline__ unsigned cvt_pk_bf16(float lo, float hi) { unsigned r; asm volatile("v_cvt_pk_bf16_f32 %0, %1, %2" : "=v"(r) : "v"(lo), "v"(hi)); return r; }

template <int ACT, int LDC> struct EpiScale {
    static constexpr bool PERM = true, AFTER_DRAIN = false;
    bf16_t* O; const float* shw; const float* RSS;
    int probe;
    __device__ __forceinline__ void operator()(const f32x4 (&acc)[2][2][4][2], const Unit& u, int wr, int wc, int fr, int fq) const {
        asm volatile("" : "+s"(wr), "+s"(wc));
        const int brow = u.pm < ML / BM ? (u.pm >> 3) : NB;
        const float* sp = shw + (size_t)brow * LDC + u.pn * BM;
        bf16_t* Ot = O + (size_t)u.pm * BM * LDC + u.pn * BM;
        const float* RSSt = RSS + (size_t)u.pm * BM * 32;
        unsigned cl = (unsigned)(wc * 32 + 8 * fq);
        unsigned rl0 = (unsigned)(wr * 64 + fr);
        asm volatile("" : "+v"(cl), "+v"(rl0));
        f32x4 pa[2][4], pb[2][4], sh[2][2];
#pragma unroll
        for (int ai = 0; ai < 2; ++ai)
#pragma unroll
            for (int m = 0; m < 4; ++m) { const unsigned ro = (rl0 + (unsigned)(ai * HALF + m * 16)) * 32u + 8u * (unsigned)fq;
                if (probe == 2) { pa[ai][m] = acc[ai][0][m][0]; pb[ai][m] = acc[ai][1][m][0]; } else { pa[ai][m] = *(const f32x4*)(RSSt + ro); pb[ai][m] = *(const f32x4*)(RSSt + (ro + 4u)); } }
#pragma unroll
        for (int bj = 0; bj < 2; ++bj) { if (probe == 2) { sh[bj][0] = acc[0][bj][0][1]; sh[bj][1] = acc[1][bj][0][1]; } else { sh[bj][0] = *(const f32x4*)(sp + (cl + (unsigned)(bj * HALF))); sh[bj][1] = *(const f32x4*)(sp + (cl + (unsigned)(bj * HALF + 4))); } }
        float rs[2][4];
#pragma unroll
        for (int ai = 0; ai < 2; ++ai)
#pragma unroll
            for (int m = 0; m < 4; ++m) { const f32x4 p0 = pa[ai][m], p1 = pb[ai][m];
                float s = ((p0[0] + p0[1]) + (p0[2] + p0[3])) + ((p1[0] + p1[1]) + (p1[2] + p1[3]));
                s += __shfl_xor(s, 16); s += __shfl_xor(s, 32);
                rs[ai][m] = rsqrtf(s * (1.0f / D) + EPS); }
#pragma unroll
        for (int bj = 0; bj < 2; ++bj)
#pragma unroll
            for (int ai = 0; ai < 2; ++ai)
#pragma unroll
                for (int m = 0; m < 4; ++m) {
                    f32x4 v0 = acc[ai][bj][m][0] * rs[ai][m] + sh[bj][0], v1 = acc[ai][bj][m][1] * rs[ai][m] + sh[bj][1];
                    if (ACT == 1) {
#pragma unroll
                        for (int e = 0; e < 4; ++e) { const float a = fmaxf(v0[e], 0.f), b = fmaxf(v1[e], 0.f); v0[e] = a * a; v1[e] = b * b; }
                    }
                    u32x4 w; w.x = cvt_pk_bf16(v0[0], v0[1]); w.y = cvt_pk_bf16(v0[2], v0[3]); w.z = cvt_pk_bf16(v1[0], v1[1]); w.w = cvt_pk_bf16(v1[2], v1[3]);
                    if (probe == 0) *(u32x4*)(Ot + ((rl0 + (unsigned)(ai * HALF + m * 16)) * (unsigned)LDC + cl + (unsigned)(bj * HALF))) = w;
                    else asm volatile("" :: "v"(w));
                }
    }
};
struct EpiRes {
    static constexpr bool PERM = true, AFTER_DRAIN = false;
    const float* src_lat; const float* src_ctx;
    float* dst_lat;
    const float* gate;
    const float* gmg; const float* gmsc;
    const float* gmg_o; const float* gmsc_o;
    bf16_t* XA; float* RSS; int hasxa;
    template <int BJ, int AI0, int NAI, int M0, int NM>
    __device__ __forceinline__ void batch(const f32x4 (&acc)[2][2][4][2], const float* src, float* dst, const float* gt, const float* gg, const float* gs, const float* go, const float* gso, bf16_t* XAt, float* RSSt, unsigned cl, unsigned rl0, int fq) const {
        const unsigned c = cl + (unsigned)(BJ * HALF);
        f32x4 x0[NAI][NM], x1[NAI][NM];
        const bool srcf = src != nullptr;
        if (srcf) {
#pragma unroll
            for (int a = 0; a < NAI; ++a)
#pragma unroll
                for (int m = 0; m < NM; ++m) { const unsigned off = (rl0 + (unsigned)((AI0 + a) * HALF + (M0 + m) * 16)) * (unsigned)D + c; x0[a][m] = *(const f32x4*)(src + off); x1[a][m] = *(const f32x4*)(src + (off + 4u)); }
        } else {
            u32x4 xb[NAI][NM];
#pragma unroll
            for (int a = 0; a < NAI; ++a)
#pragma unroll
                for (int m = 0; m < NM; ++m) { const unsigned off = (rl0 + (unsigned)((AI0 + a) * HALF + (M0 + m) * 16)) * (unsigned)D + c; xb[a][m] = *(const u32x4*)(XAt + off); }
            const f32x4 i0 = *(const f32x4*)(go + c) * (*(const f32x4*)(gso + c) + 1.0f), i1 = *(const f32x4*)(go + (c + 4u)) * (*(const f32x4*)(gso + (c + 4u)) + 1.0f);
            f32x4 r0, r1;
#pragma unroll
            for (int e = 0; e < 4; ++e) { r0[e] = __builtin_amdgcn_rcpf(i0[e]); r1[e] = __builtin_amdgcn_rcpf(i1[e]); }
#pragma unroll
            for (int a = 0; a < NAI; ++a)
#pragma unroll
                for (int m = 0; m < NM; ++m) { const u32x4 w = xb[a][m];
                    x0[a][m] = (f32x4){__uint_as_float(w.x << 16), __uint_as_float(w.x & 0xffff0000u), __uint_as_float(w.y << 16), __uint_as_float(w.y & 0xffff0000u)} * r0;
                    x1[a][m] = (f32x4){__uint_as_float(w.z << 16), __uint_as_float(w.z & 0xffff0000u), __uint_as_float(w.w << 16), __uint_as_float(w.w & 0xffff0000u)} * r1; }
        }
        const f32x4 g0 = *(const f32x4*)(gt + c), g1 = *(const f32x4*)(gt + (c + 4u));
        f32x4 m0 = {0.f, 0.f, 0.f, 0.f}, m1 = {0.f, 0.f, 0.f, 0.f};
        if (hasxa) { m0 = *(const f32x4*)(gg + c) * (*(const f32x4*)(gs + c) + 1.0f); m1 = *(const f32x4*)(gg + (c + 4u)) * (*(const f32x4*)(gs + (c + 4u)) + 1.0f); }
        asm volatile("" ::: "memory");
#pragma unroll
        for (int a = 0; a < NAI; ++a)
#pragma unroll
            for (int m = 0; m < NM; ++m) {
                const unsigned rl = rl0 + (unsigned)((AI0 + a) * HALF + (M0 + m) * 16);
                const unsigned off = rl * (unsigned)D + c;
                const f32x4 y0 = x0[a][m] + g0 * acc[AI0 + a][BJ][M0 + m][0], y1 = x1[a][m] + g1 * acc[AI0 + a][BJ][M0 + m][1];
                if (dst) { *(f32x4*)(dst + off) = y0; *(f32x4*)(dst + (off + 4u)) = y1; }
                float ss = ((y0[0] * y0[0] + y0[1] * y0[1]) + (y0[2] * y0[2] + y0[3] * y0[3])) + ((y1[0] * y1[0] + y1[1] * y1[1]) + (y1[2] * y1[2] + y1[3] * y1[3]));
                ss += __shfl_xor(ss, 16); ss += __shfl_xor(ss, 32);
                if (fq == 0) RSSt[rl * 32u + (unsigned)(BJ * 4)] = ss;
                if (hasxa) { const f32x4 a0 = y0 * m0, a1 = y1 * m1;
                    u32x4 w; w.x = cvt_pk_bf16(a0[0], a0[1]); w.y = cvt_pk_bf16(a0[2], a0[3]); w.z = cvt_pk_bf16(a1[0], a1[1]); w.w = cvt_pk_bf16(a1[2], a1[3]);
                    *(u32x4*)(XAt + off) = w; }
            }
        asm volatile("" ::: "memory");
    }
    __device__ __forceinline__ void operator()(const f32x4 (&acc)[2][2][4][2], const Unit& u, int wr, int wc, int fr, int fq) const {
        asm volatile("" : "+s"(wr), "+s"(wc));
        const bool lat = u.pm < ML / BM;
        const int brow = lat ? (u.pm >> 3) : NB;
        const float* src = src_lat ? (lat ? src_lat + (size_t)u.pm * BM * D : src_ctx + (size_t)(u.pm - ML / BM) * BM * D) + u.pn * BM : nullptr;
        float* dst = (dst_lat && lat) ? dst_lat + (size_t)u.pm * BM * D + u.pn * BM : nullptr;
        const float* gt = gate + (size_t)brow * MODW + u.pn * BM;
        const float* gg = gmg + u.pn * BM;
        const float* gs = gmsc + (size_t)brow * MODW + u.pn * BM;
        const float* go = gmg_o + u.pn * BM;
        const float* gso = gmsc_o + (size_t)brow * MODW + u.pn * BM;
        bf16_t* XAt = XA + (size_t)u.pm * BM * D + u.pn * BM;
        float* RSSt = RSS + (size_t)u.pm * BM * 32 + u.pn * 8 + wc;
        unsigned cl = (unsigned)(wc * 32 + 8 * fq);
        unsigned rl0 = (unsigned)(wr * 64 + fr);
        asm volatile("" : "+v"(cl), "+v"(rl0));
        batch<0, 0, 1, 0, 2>(acc, src, dst, gt, gg, gs, go, gso, XAt, RSSt, cl, rl0, fq);
        batch<0, 0, 1, 2, 2>(acc, src, dst, gt, gg, gs, go, gso, XAt, RSSt, cl, rl0, fq);
        batch<0, 1, 1, 0, 4>(acc, src, dst, gt, gg, gs, go, gso, XAt, RSSt, cl, rl0, fq);
        batch<1, 0, 2, 0, 4>(acc, src, dst, gt, gg, gs, go, gso, XAt, RSSt, cl, rl0, fq);
    }
};

template <class Epi, class Sched, bool ALIGN_EPI = false, bool SP2 = false>
__device__ __forceinline__ void gemm_phase(PG8_LAS unsigned char* lds, const Gemm g, const Sched& S, const Epi& E, const int tid) {
    const int wid = __builtin_amdgcn_readfirstlane(tid >> 6), lane = tid & 63, wr = wid >> 2, wc = wid & 3, fr = lane & 15, fq = lane >> 4;
    const int K = g.K, nt = K / BK;
    unsigned voffA[2], voffB[2];
#pragma unroll
    for (int i = 0; i < 2; ++i) { int R, C; stage_rc(tid * 16 + i * 8192, R, C); const int Rb = Epi::PERM ? ((R & ~31) + perm32(R & 31)) : R;
        voffA[i] = (unsigned)(R * K + C) * 2u; voffB[i] = (unsigned)(Rb * K + C) * 2u; }
    const size_t kstep = (size_t)(BK * 2);
    const size_t hstep = (size_t)HALF * K * 2;
    const size_t tstep = 2 * hstep;
    const unsigned ldsw = (unsigned)wid * 1024u;
    const int aoff = lds_byte(wr * 64 + fr, fq * 8), boff = lds_byte(wc * 32 + fr, fq * 8);
#define PG8_SA(b, h) (((b) * 2 + (h)) * HTB)
#define PG8_SB(b, h) ((4 + (b) * 2 + (h)) * HTB)
#define PG8_STAGE(bufoff, gbase, voff) do { _Pragma("unroll") for (int _i = 0; _i < 2; ++_i) \
        __builtin_amdgcn_global_load_lds((const unsigned*)((const char*)(gbase) + (voff)[_i]), (PG8_LAS unsigned*)(lds + (bufoff) + ldsw + _i * 8192), 16, 0, 0); } while (0)
#define PG8_LDA(dst, b, h) do { _Pragma("unroll") for (int m = 0; m < 4; ++m) _Pragma("unroll") for (int k = 0; k < 2; ++k) dst[m][k] = *(const PG8_LAS bf16x8*)(lds + PG8_SA(b, h) + aoff + m * 2048 + k * 1024); } while (0)
#define PG8_LDB(dst, b, h) do { _Pragma("unroll") for (int n = 0; n < 2; ++n) _Pragma("unroll") for (int k = 0; k < 2; ++k) dst[n][k] = *(const PG8_LAS bf16x8*)(lds + PG8_SB(b, h) + boff + n * 2048 + k * 1024); } while (0)
#define PG8_MMA(ai, bj, At, Bt) do { __builtin_amdgcn_s_setprio(1); _Pragma("unroll") for (int m = 0; m < 4; ++m) _Pragma("unroll") for (int n = 0; n < 2; ++n) _Pragma("unroll") for (int k = 0; k < 2; ++k) \
        acc[ai][bj][m][n] = __builtin_amdgcn_mfma_f32_16x16x32_bf16(Bt[n][k], At[m][k], acc[ai][bj][m][n], 0, 0, 0); __builtin_amdgcn_s_setprio(0); } while (0)
#define PG8_WAIT_V(n) asm volatile("s_waitcnt vmcnt(" #n ")" ::: "memory")
#define PG8_WAIT_L(n) asm volatile("s_waitcnt lgkmcnt(" #n ")" ::: "memory")
#define PG8_BAR __builtin_amdgcn_s_barrier()
#define PG8_SCHED __builtin_amdgcn_sched_barrier(0)
    Unit cur, nxt; int ui = 0;
    if (!S.next(0, cur)) return;
    f32x4 acc[2][2][4][2];
#pragma unroll
    for (int a = 0; a < 2; ++a)
#pragma unroll
        for (int b = 0; b < 2; ++b)
#pragma unroll
            for (int m = 0; m < 4; ++m)
#pragma unroll
                for (int n = 0; n < 2; ++n) acc[a][b][m][n] = (f32x4){0.f, 0.f, 0.f, 0.f};
    bf16x8 At[4][2], B0[2][2], B1[2][2];
    const char* cA = (const char*)g.A + (size_t)cur.pm * tstep; const char* cB = (const char*)g.Bt + (size_t)cur.pn * tstep;
    S.a_ready(cur);
    if constexpr (SP2) {
        PG8_STAGE(PG8_SB(0, 0), cB, voffB); PG8_STAGE(PG8_SB(0, 1), cB + hstep, voffB); PG8_STAGE(PG8_SA(0, 0), cA, voffA); PG8_STAGE(PG8_SA(0, 1), cA + hstep, voffA);
        if (wr == 1) PG8_BAR;
        PG8_WAIT_V(2); PG8_BAR;
        PG8_STAGE(PG8_SB(1, 0), cB + kstep, voffB); PG8_STAGE(PG8_SA(1, 0), cA + kstep, voffA); PG8_STAGE(PG8_SB(1, 1), cB + hstep + kstep, voffB);
        PG8_WAIT_V(6); PG8_BAR;
    } else {
        PG8_STAGE(PG8_SB(0, 0), cB, voffB); PG8_STAGE(PG8_SA(0, 0), cA, voffA); PG8_STAGE(PG8_SB(0, 1), cB + hstep, voffB); PG8_STAGE(PG8_SA(0, 1), cA + hstep, voffA);
        if (wr == 1) PG8_BAR;
        PG8_WAIT_V(4); PG8_BAR;
        PG8_STAGE(PG8_SB(1, 0), cB + kstep, voffB); PG8_STAGE(PG8_SA(1, 0), cA + kstep, voffA); PG8_STAGE(PG8_SB(1, 1), cB + hstep + kstep, voffB);
        PG8_WAIT_V(6); PG8_BAR;
    }
    for (;;) {
        const bool has_next = S.next(ui + 1, nxt);
        const char* nA = has_next ? (const char*)g.A + (size_t)nxt.pm * tstep : cA; const char* nB = has_next ? (const char*)g.Bt + (size_t)nxt.pn * tstep : cB;
        for (int t = 0; t < nt; t += 2) {
            const bool last = (t == nt - 2);
            const char* a1 = cA + (size_t)(t + 1) * kstep;
            const char* a2 = last ? nA : cA + (size_t)(t + 2) * kstep; const char* b2 = last ? nB : cB + (size_t)(t + 2) * kstep;
            const char* a3 = a2 + kstep; const char* b3 = b2 + kstep;
            if (last && has_next) S.a_ready(nxt);
            if constexpr (SP2) {
            PG8_LDB(B0, 0, 0); PG8_LDB(B1, 0, 1); PG8_SCHED; PG8_LDA(At, 0, 0); PG8_STAGE(PG8_SA(1, 1), a1 + hstep, voffA);
            PG8_WAIT_V(8); PG8_WAIT_L(0); PG8_BAR; PG8_MMA(0, 0, At, B0); PG8_MMA(0, 1, At, B1); PG8_BAR; PG8_SCHED;
            PG8_LDA(At, 0, 1); PG8_STAGE(PG8_SB(0, 0), b2, voffB); PG8_STAGE(PG8_SB(0, 1), b2 + hstep, voffB); PG8_STAGE(PG8_SA(0, 0), a2, voffA);
            PG8_WAIT_V(8); PG8_WAIT_L(0); PG8_BAR; PG8_MMA(1, 0, At, B0); PG8_MMA(1, 1, At, B1); PG8_BAR; PG8_SCHED;
            PG8_LDB(B0, 1, 0); PG8_LDB(B1, 1, 1); PG8_SCHED; PG8_LDA(At, 1, 0); PG8_STAGE(PG8_SA(0, 1), a2 + hstep, voffA);
            PG8_WAIT_V(8); PG8_WAIT_L(0); PG8_BAR; PG8_MMA(0, 0, At, B0); PG8_MMA(0, 1, At, B1); PG8_BAR; PG8_SCHED;
            PG8_LDA(At, 1, 1); PG8_STAGE(PG8_SB(1, 0), b3, voffB); PG8_STAGE(PG8_SB(1, 1), b3 + hstep, voffB); PG8_STAGE(PG8_SA(1, 0), a3, voffA);
            PG8_WAIT_V(8); PG8_WAIT_L(0); PG8_BAR; PG8_MMA(1, 0, At, B0); PG8_MMA(1, 1, At, B1); PG8_BAR; PG8_SCHED;
            } else {
            PG8_LDB(B0, 0, 0); PG8_SCHED; PG8_LDA(At, 0, 0); PG8_STAGE(PG8_SA(1, 1), a1 + hstep, voffA);
            PG8_WAIT_L(8); PG8_BAR; PG8_WAIT_L(0); PG8_MMA(0, 0, At, B0); PG8_BAR; PG8_SCHED;
            PG8_LDB(B1, 0, 1); PG8_STAGE(PG8_SB(0, 0), b2, voffB);
            PG8_BAR; PG8_WAIT_L(0); PG8_MMA(0, 1, At, B1); PG8_BAR;
            PG8_LDA(At, 0, 1); PG8_STAGE(PG8_SA(0, 0), a2, voffA);
            PG8_BAR; PG8_WAIT_L(0); PG8_MMA(1, 0, At, B0); PG8_BAR; PG8_SCHED;
            PG8_STAGE(PG8_SB(0, 1), b2 + hstep, voffB);
            PG8_WAIT_V(6); PG8_BAR; PG8_MMA(1, 1, At, B1); PG8_BAR;
            PG8_LDB(B0, 1, 0); PG8_SCHED; PG8_LDA(At, 1, 0); PG8_STAGE(PG8_SA(0, 1), a2 + hstep, voffA);
            PG8_WAIT_L(8); PG8_BAR; PG8_WAIT_L(0); PG8_MMA(0, 0, At, B0); PG8_BAR; PG8_SCHED;
            PG8_LDB(B1, 1, 1); PG8_STAGE(PG8_SB(1, 0), b3, voffB);
            PG8_BAR; PG8_WAIT_L(0); PG8_MMA(0, 1, At, B1); PG8_BAR;
            PG8_LDA(At, 1, 1); PG8_STAGE(PG8_SA(1, 0), a3, voffA);
            PG8_BAR; PG8_WAIT_L(0); PG8_MMA(1, 0, At, B0); PG8_BAR; PG8_SCHED;
            PG8_STAGE(PG8_SB(1, 1), b3 + hstep, voffB);
            PG8_WAIT_V(6); PG8_BAR; PG8_MMA(1, 1, At, B1); PG8_BAR;
            }
        }
        if constexpr (ALIGN_EPI) { if (wr == 0) PG8_BAR; }
        if constexpr (!Epi::AFTER_DRAIN) { E(acc, cur, wr, wc, fr, fq); S.done(cur); }
        if (!has_next) break;
#pragma unroll
        for (int a = 0; a < 2; ++a)
#pragma unroll
            for (int b = 0; b < 2; ++b)
#pragma unroll
                for (int m = 0; m < 4; ++m)
#pragma unroll
                    for (int n = 0; n < 2; ++n) acc[a][b][m][n] = (f32x4){0.f, 0.f, 0.f, 0.f};
        cur = nxt; cA = nA; cB = nB; ++ui;
        if constexpr (ALIGN_EPI) { if (wr == 1) PG8_BAR; }
    }
    PG8_WAIT_V(0);
    if constexpr (!ALIGN_EPI) { if (wr == 0) PG8_BAR; }
    PG8_BAR;
    if constexpr (Epi::AFTER_DRAIN) { E.fused(acc, cur, wr, wc, fr, fq, lds, wid, lane); S.done(cur); }
#undef PG8_SA
#undef PG8_SB
#undef PG8_STAGE
#undef PG8_LDA
#undef PG8_LDB
#undef PG8_MMA
#undef PG8_WAIT_V
#undef PG8_WAIT_L
#undef PG8_BAR
#undef PG8_SCHED
}
}

constexpr size_t MiB = 1u << 20;
constexpr size_t WS_CTL = 0, CTL_ZERO_BYTES = 1 * MiB;
constexpr size_t WS_MOD = 1 * MiB;
constexpr size_t WS_SHW1 = 2 * MiB;
constexpr size_t WS_SHW2 = 3 * MiB;
constexpr size_t WS_RSSA = 4 * MiB;
constexpr size_t WS_RSSB = 9 * MiB;
constexpr size_t WS_TOT = 14 * MiB;
constexpr size_t WS_CARRY = 19 * MiB;
constexpr size_t WS_WLR = 21 * MiB + 512 * 1024;
constexpr size_t WS_WIN = 22 * MiB;
constexpr size_t WS_WOUT = 32 * MiB;
constexpr size_t WS_W1 = 36 * MiB;
constexpr size_t WS_W2 = 52 * MiB;
constexpr size_t WS_CX = 68 * MiB;
constexpr size_t WS_XA = 84 * MiB;
constexpr size_t WS_HID = 156 * MiB;
constexpr size_t WS_PROJ = WS_HID;
constexpr size_t WS_MIX = WS_HID + 180 * MiB;
constexpr size_t WS_END = 444 * MiB;
static_assert(WS_MIX + (size_t)MT * D * 2 <= WS_END && WS_HID + (size_t)MT * FF * 2 == WS_END, "ws map");
constexpr int CW_BAR = 4096;

constexpr int NWAVES = 8;
constexpr int RING_OFF = 0, RING_BYTES = 131072;
constexpr int LDSCTL_OFF = RING_BYTES, MISC_OFF = LDSCTL_OFF + 320;
constexpr int LDS_BYTES = 147456;

#define GAS __attribute__((address_space(1)))
#define LAS __attribute__((address_space(3)))
typedef unsigned short bf16;
typedef unsigned v4u __attribute__((ext_vector_type(4)));
typedef unsigned v2u __attribute__((ext_vector_type(2)));
typedef float f32x4 __attribute__((ext_vector_type(4)));
typedef float f32x2 __attribute__((ext_vector_type(2)));
typedef GAS unsigned gu32;
#define LDS_WAIT() asm volatile("s_waitcnt lgkmcnt(0)" ::: "memory")
#define VM_WAIT() asm volatile("s_waitcnt vmcnt(0)" ::: "memory")
__device__ __forceinline__ unsigned f2bf(float f) { unsigned u = __builtin_bit_cast(unsigned, f); return (u + 0x7fffu + ((u >> 16) & 1u)) >> 16; }
__device__ __forceinline__ unsigned pk2(float lo, float hi) { return f2bf(lo) | (f2bf(hi) << 16); }
__device__ __forceinline__ float bflo(unsigned w) { return __uint_as_float(w << 16); }
__device__ __forceinline__ float bfhi(unsigned w) { return __uint_as_float(w & 0xffff0000u); }
__device__ __forceinline__ float bf1(bf16 v) { return __uint_as_float((unsigned)v << 16); }
__device__ __forceinline__ float sigmoidf_(float x) { return __builtin_amdgcn_rcpf(1.f + __builtin_amdgcn_exp2f(-1.4426950408889634f * x)); }
__device__ __forceinline__ float siluf_(float x) { return x * sigmoidf_(x); }
__device__ __forceinline__ float gelu_tanh(float x) { const float u = 0.7978845608028654f * (x + 0.044715f * x * x * x); return x * sigmoidf_(2.f * u); }
__device__ __forceinline__ float wave_sum(float v) {
#pragma unroll
    for (int o = 1; o < 64; o <<= 1) v += __shfl_xor(v, o);
    return v;
}

#define XB_TMO      128
#define XB_XCNT(j)  (256  + 64 * (j))
#define XB_XSUB(j)  (1280 + 64 * (j))
#define XB_XGEN(j)  (2304 + 64 * (j))
#define XB_TOP      3328
#define XB_TOPGEN   3392
#define XCD_BAR_WORDS 3456
#define XB_SPIN_CAP (1u << 18)

__device__ __forceinline__ unsigned xb_ld(unsigned* p)              { return __hip_atomic_load(p, __ATOMIC_RELAXED, __HIP_MEMORY_SCOPE_AGENT); }
__device__ __forceinline__ unsigned xb_add(unsigned* p, unsigned v) { return __hip_atomic_fetch_add(p, v, __ATOMIC_RELAXED, __HIP_MEMORY_SCOPE_AGENT); }
__device__ __forceinline__ unsigned xb_xcc_id() { return (unsigned)__builtin_amdgcn_s_getreg((3 << 11) | 20) & 0xFu; }
#define XB_SPIN(cond, bar) do { unsigned _sp = 0; while (cond) { __builtin_amdgcn_s_sleep(1); \
    if ((++_sp & 255u) == 0u) { if (xb_ld(&(bar)[XB_TMO])) break; if (_sp > XB_SPIN_CAP) { atomicAdd(&(bar)[XB_TMO], 1u); break; } } } } while (0)

struct XcdBarrier {
    unsigned* bar; unsigned x;
    volatile LAS unsigned* st;
};

__device__ __forceinline__ XcdBarrier xcd_barrier_post(unsigned* bar, volatile LAS unsigned* st, int tid) {
    XcdBarrier b; b.bar = bar; b.x = xb_xcc_id(); b.st = st;
    if (tid == 0) (void)xb_add(&bar[XB_XCNT(b.x)], 1u);
    return b;
}
__device__ __forceinline__ void xcd_barrier_complete(unsigned* bar, unsigned x, unsigned& nloc, unsigned& nx) {
    const unsigned G = gridDim.x * gridDim.y * gridDim.z;
    unsigned sum, cnt, mine, sp = 0u;
    for (;;) {
        sum = 0u; cnt = 0u; mine = 0u;
#pragma unroll 1
        for (unsigned j = 0; j < 16; ++j) { const unsigned c = xb_ld(&bar[XB_XCNT(j)]); sum += c; cnt += (c > 0u) ? 1u : 0u; mine = (j == x) ? c : mine; }
        if (sum == G) break;
        __builtin_amdgcn_s_sleep(1);
        if ((++sp & 255u) == 0u) { if (xb_ld(&bar[XB_TMO])) break; if (sp > XB_SPIN_CAP) { atomicAdd(&bar[XB_TMO], 1u); break; } }
    }
    nloc = mine > 0u ? mine : 1u; nx = cnt > 0u ? cnt : 1u;
}

__device__ __forceinline__ void xcd_barrier(const XcdBarrier& b, int tid) {
    asm volatile("s_waitcnt vmcnt(0)" ::: "memory");
    __syncthreads();
    if (tid == 0) {
        unsigned* bar = b.bar;
        __builtin_amdgcn_s_waitcnt(0);
        unsigned nloc = b.st[0], nx = b.st[1];
        if (nloc == 0u) { xcd_barrier_complete(bar, b.x, nloc, nx); b.st[0] = nloc; b.st[1] = nx; }
        const unsigned old = xb_add(&bar[XB_XSUB(b.x)], 1u);
        const unsigned gen = old / nloc;
        if (old + 1u == (gen + 1u) * nloc) {
            __builtin_amdgcn_fence(__ATOMIC_RELEASE, "agent");
            asm volatile("s_waitcnt vmcnt(0)" ::: "memory");
            const unsigned og = xb_add(&bar[XB_TOP], 1u);
            const unsigned tg = og / nx;
            if (og + 1u == (tg + 1u) * nx) xb_add(&bar[XB_TOPGEN], 1u);
            else XB_SPIN(xb_ld(&bar[XB_TOPGEN]) == tg, bar);
            __builtin_amdgcn_fence(__ATOMIC_ACQUIRE, "agent");
            xb_add(&bar[XB_XGEN(b.x)], 1u);
            asm volatile("s_waitcnt vmcnt(0)" ::: "memory");
        } else {
            XB_SPIN(xb_ld(&bar[XB_XGEN(b.x)]) == gen, bar);
            __builtin_amdgcn_fence(__ATOMIC_ACQUIRE, "agent");
            asm volatile("s_waitcnt vmcnt(0)" ::: "memory");
        }
    }
    __syncthreads();
}

struct Frame {
    LAS unsigned char* lds;
    int tid, lane, wave;
    int vcu, G;
    int gw, NGW;
    float* out; unsigned char* ws;
};
constexpr int PTR_OFF = LDSCTL_OFF + 512;
__device__ __forceinline__ const float* inp_(LAS unsigned char* lds, int i) {
    const unsigned long long v = *(const LAS unsigned long long*)(lds + PTR_OFF + 8 * i);
    const unsigned lo = __builtin_amdgcn_readfirstlane((unsigned)v), hi = __builtin_amdgcn_readfirstlane((unsigned)(v >> 32));
    return (const float*)(((unsigned long long)hi << 32) | lo);
}
#define INP(i) inp_(F.lds, (i))
#define WSP(T, off) ((T*)(F.ws + (off)))

__device__ __forceinline__ void gemv17_item(Frame& F, const LAS float* tab, LAS float* red, const float* W, int ldw, int n0, const float* bias, float* outp, int ldo) {
    float acc[17];
#pragma unroll
    for (int r = 0; r < 17; ++r) acc[r] = 0.f;
    const int k0 = F.wave * 128;
    const float* wp = W + (size_t)k0 * ldw + n0 + F.lane;
#pragma unroll 4
    for (int k = 0; k < 128; ++k) {
        const float wv = wp[(size_t)k * ldw];
#pragma unroll
        for (int r = 0; r < 17; ++r) acc[r] += tab[r * 1024 + k0 + k] * wv;
    }
#pragma unroll
    for (int r = 0; r < 17; ++r) red[(F.wave * 17 + r) * 64 + F.lane] = acc[r];
    __syncthreads();
    for (int i = F.tid; i < 17 * 64; i += NWAVES * 64) {
        const int r = i >> 6, n = i & 63; float s = bias ? bias[n0 + n] : 0.f;
#pragma unroll
        for (int w = 0; w < 8; ++w) s += red[(w * 17 + r) * 64 + n];
        outp[(size_t)r * ldo + n0 + n] = s;
    }
    __syncthreads();
}

__device__ __forceinline__ void p0_transpose_item(const float* W, int K, int N, bf16* WT, LAS float* scr, int item, int lane) {
    const int nblk = N / 32, kb = item / nblk, nb = item % nblk, k0 = 64 * kb, n0 = 32 * nb;
#pragma unroll 8
    for (int i = 0; i < 32; ++i) { const int kk = 2 * i + (lane >> 5); scr[kk * 33 + (lane & 31)] = W[(size_t)(k0 + kk) * N + n0 + (lane & 31)]; }
    LDS_WAIT(); asm volatile("" ::: "memory");
    const int c = lane & 7;
#pragma unroll
    for (int j = 0; j < 4; ++j) { const int n = (lane >> 3) + 8 * j; const LAS float* s = scr + (8 * c) * 33 + n;
        v4u o; o.x = pk2(s[0 * 33], s[1 * 33]); o.y = pk2(s[2 * 33], s[3 * 33]); o.z = pk2(s[4 * 33], s[5 * 33]); o.w = pk2(s[6 * 33], s[7 * 33]);
        *(GAS v4u*)(WT + (size_t)(n0 + n) * K + k0 + 8 * c) = o; }
    LDS_WAIT(); asm volatile("" ::: "memory");
}

__device__ __forceinline__ void phase_p0a(Frame& F) {
    LAS float* tab = (LAS float*)(F.lds);
    LAS float* red = (LAS float*)(F.lds + 17 * 1024 * 4);
    float* MOD = WSP(float, WS_MOD);
    bool filled = false;
    for (int it = F.vcu; it < 2 * 96; it += F.G) {
        if (!filled) {
            for (int i = F.tid; i < 17 * 1024; i += NWAVES * 64) { const int r = i >> 10, k = i & 1023; const float v = (r < 16) ? INP(1)[r * D + k] : INP(3)[k]; tab[i] = siluf_(v); }
            __syncthreads(); filled = true;
        }
        const int l = it / 96, n0 = (it % 96) * 64;
        gemv17_item(F, tab, red, INP(6) + (size_t)l * D * MODW, MODW, n0, INP(7) + (size_t)l * MODW, MOD + (size_t)l * 17 * MODW, MODW);
    }
    __syncthreads();
    {
        bf16* WLR = WSP(bf16, WS_WLR);
        for (int i = F.gw * 64 + F.lane; i < 2 * 2 * 4 * 2 * 4096; i += F.NGW * 64) { const int d = i & 63, e = (i >> 6) & 63, gt = (i >> 12) & 1, blk = i >> 13;
            const float* src = gt == 0 ? INP(17) : INP(19); WLR[i] = (bf16)f2bf(src[((size_t)blk * 64 + d) * 64 + e]); }
    }
    LAS float* scr = (LAS float*)(F.lds + F.wave * 16384);
    constexpr int I_IN = (D / 64) * (IND / 32), I_OUT = (D / 64) * (D / 32), I_1 = (D / 64) * (FF / 32), I_2 = (FF / 64) * (D / 32), I_L = I_IN + I_OUT + I_1 + I_2;
    for (int it = F.gw; it < 2 * I_L; it += F.NGW) {
        const int l = it / I_L; int r = it % I_L;
        const float* W; bf16* WT; int K = D, N;
        if (r < I_IN) { W = INP(8) + (size_t)l * D * IND; WT = WSP(bf16, WS_WIN) + (size_t)l * IND * D; N = IND; }
        else if (r < I_IN + I_OUT) { r -= I_IN; W = INP(9) + (size_t)l * D * D; WT = WSP(bf16, WS_WOUT) + (size_t)l * D * D; N = D; }
        else if (r < I_IN + I_OUT + I_1) { r -= I_IN + I_OUT; W = INP(22) + (size_t)l * D * FF; WT = WSP(bf16, WS_W1) + (size_t)l * FF * D; N = FF; }
        else { r -= I_IN + I_OUT + I_1; W = INP(23) + (size_t)l * FF * D; WT = WSP(bf16, WS_W2) + (size_t)l * D * FF; K = FF; N = D; }
        p0_transpose_item(W, K, N, WT, scr, r, F.lane);
    }
}

__device__ __forceinline__ void phase_p0b(Frame& F) {
    LAS float* tab = (LAS float*)(F.lds);
    LAS float* red = (LAS float*)(F.lds + 17 * 1024 * 4);
    const float* MOD = WSP(const float, WS_MOD);
    for (int it = F.vcu; it < 2 * 104; it += F.G) {
        const int l = it / 104, j = it % 104; const bool first = j < 40;
        const int shoff = first ? 0 : 3 * D;
        __syncthreads();
        for (int i = F.tid; i < 17 * 1024; i += NWAVES * 64) { const int r = i >> 10, k = i & 1023; tab[i] = MOD[((size_t)l * 17 + r) * MODW + shoff + k]; }
        __syncthreads();
        const int ldw = first ? IND : FF;
        gemv17_item(F, tab, red, first ? INP(8) + (size_t)l * D * IND : INP(22) + (size_t)l * D * FF, ldw, (first ? j : j - 40) * 64, nullptr,
                    first ? WSP(float, WS_SHW1) + (size_t)l * 17 * IND : WSP(float, WS_SHW2) + (size_t)l * 17 * FF, ldw);
    }
    bf16* XA = WSP(bf16, WS_XA); float* RSSA = WSP(float, WS_RSSA);
    const float* g1 = INP(4);
    for (int row = F.gw; row < MT; row += F.NGW) {
        const bool lat = row < ML;
        const float* xr = lat ? INP(0) + (size_t)row * D : INP(2) + (size_t)(row - ML) * D;
        const int brow = lat ? (row >> 11) : NB;
        const float* sc = MOD + (size_t)brow * MODW + D;
        f32x4 v[4]; float ss = 0.f;
#pragma unroll
        for (int j = 0; j < 4; ++j) { v[j] = *(const f32x4*)(xr + 4 * F.lane + 256 * j); ss += (v[j][0] * v[j][0] + v[j][1] * v[j][1]) + (v[j][2] * v[j][2] + v[j][3] * v[j][3]); }
        ss = wave_sum(ss);
        if (F.lane < 32) RSSA[(size_t)row * 32 + F.lane] = (F.lane == 0) ? ss : 0.f;
#pragma unroll
        for (int j = 0; j < 4; ++j) { const int k = 4 * F.lane + 256 * j;
            const f32x4 gm = *(const f32x4*)(g1 + k) * (*(const f32x4*)(sc + k) + 1.0f), a = v[j] * gm;
            v2u o; o.x = pk2(a[0], a[1]); o.y = pk2(a[2], a[3]); *(v2u*)(XA + (size_t)row * D + k) = o; }
    }
}

constexpr int CV_OSROW = 260;
__device__ __forceinline__ void conv_phase(Frame& F, int l, int ntiles) {
    const bf16* PROJ = WSP(const bf16, WS_PROJ); bf16* MIX = WSP(bf16, WS_MIX);
    LAS float* us = (LAS float*)(F.lds);
    LAS float* os = (LAS float*)(F.lds + 62 * 256 * 4);
    const int c = F.tid & 255, half = F.tid >> 8;
    float w[31];
#pragma unroll
    for (int k = 0; k < 31; ++k) w[k] = INP(10)[((size_t)l * 31 + k) * 256 + c];
    const float cbias = INP(11)[l * 256 + c];
    const f32x4 lg = *(const f32x4*)(INP(12) + l * 256 + 4 * F.lane), lb = *(const f32x4*)(INP(13) + l * 256 + 4 * F.lane);
    unsigned pv[16], pg[16];
    auto load_tile = [&](int T) {
        const int row0 = T * 32;
        int lo, hi; if (row0 < ML) { lo = row0 & ~(SEQ - 1); hi = lo + SEQ; } else { lo = row0 & ~(CTXL - 1); hi = lo + CTXL; }
#pragma unroll
        for (int j = 0; j < 16; ++j) { const int i = F.tid + 512 * j, rr = i >> 7, cp = i & 127, row = row0 - 15 + rr;
            const bool ok = (j < 15 || F.tid < 256) && row >= lo && row < hi;
            pv[j] = ok ? *(const unsigned*)(PROJ + (size_t)row * IND + 2 * cp) : 0u; pg[j] = ok ? *(const unsigned*)(PROJ + (size_t)row * IND + 256 + 2 * cp) : 0u; }
    };
    if (F.vcu < ntiles) load_tile(F.vcu);
    for (int T = F.vcu; T < ntiles; T += F.G) {
        const int row0 = T * 32;
        __syncthreads();
#pragma unroll
        for (int j = 0; j < 16; ++j) { const int i = F.tid + 512 * j;
            if (j < 15 || F.tid < 256) { f32x2 u; u[0] = bflo(pv[j]) * sigmoidf_(bflo(pg[j])); u[1] = bfhi(pv[j]) * sigmoidf_(bfhi(pg[j])); *(LAS f32x2*)(us + 2 * i) = u; } }
        if (T + F.G < ntiles) load_tile(T + F.G);
        __syncthreads();
        {
            float acc[16];
#pragma unroll
            for (int j = 0; j < 16; ++j) acc[j] = cbias;
            const LAS float* up = us + (16 * half) * 256 + c;
#pragma unroll
            for (int i = 0; i < 46; ++i) { const float x = up[i * 256];
#pragma unroll
                for (int j = 0; j < 16; ++j) if (i - j >= 0 && i - j <= 30) acc[j] += w[i - j] * x; }
#pragma unroll
            for (int j = 0; j < 16; ++j) os[(16 * half + j) * CV_OSROW + c] = acc[j];
        }
        __syncthreads();
#pragma unroll
        for (int q = 0; q < 4; ++q) { const int t = 4 * F.wave + q;
            const f32x4 v = *(const LAS f32x4*)(os + t * CV_OSROW + 4 * F.lane);
            const float mu = wave_sum((v[0] + v[1]) + (v[2] + v[3])) * (1.f / 256.f);
            const f32x4 d = v - mu;
            const float var = wave_sum((d[0] * d[0] + d[1] * d[1]) + (d[2] * d[2] + d[3] * d[3])) * (1.f / 256.f);
            const f32x4 y = d * rsqrtf(var + EPS) * lg + lb;
            v2u o; o.x = pk2(siluf_(y[0]), siluf_(y[1])); o.y = pk2(siluf_(y[2]), siluf_(y[3]));
            *(v2u*)(MIX + (size_t)(row0 + t) * D + 4 * F.lane) = o; }
    }
}

typedef short s16x8 __attribute__((ext_vector_type(8)));
typedef short s16x4 __attribute__((ext_vector_type(4)));
constexpr int NA_KROW = 144, NA_VROW = 160;
constexpr int NA_STAGE = 64 * NA_KROW + 64 * NA_VROW, NA_OFF_TB = 2 * NA_STAGE;
constexpr int NA_ITEMS_LAT = NB * NH * 16, NA_ITEMS_CTX = NB * NH * 2;
__device__ __forceinline__ void na_phase(Frame& F, int l, int nitems) {
    const bf16* PROJ = WSP(const bf16, WS_PROJ); bf16* MIX = WSP(bf16, WS_MIX);
    LAS float* tb = (LAS float*)(F.lds + NA_OFF_TB);
    const int lane = F.lane, q16 = lane & 15, g = lane >> 4;
    const unsigned skey = (unsigned)(F.tid >> 3), spart = (unsigned)(F.tid & 7);
    const float c1 = 0.125f * 1.4426950408889634f;
    for (int it = F.vcu; it < nitems; it += F.G) {
        const bool isctx = it >= NA_ITEMS_LAT;
        int b, h, r = 0, jq = 0, qrow0, rsA = 0, nloc = 0;
        if (!isctx) { const int rp = it & 15; h = (it >> 4) & 7; b = it >> 7; const int r0 = 2 * rp; r = r0 + (F.wave >> 2); jq = F.wave & 3; qrow0 = b * SEQ + r * 64 + jq * 16;
            rsA = r0 - 4; rsA = rsA < 0 ? 0 : (rsA > 24 ? 24 : rsA); int rsB = r0 - 3; rsB = rsB < 0 ? 0 : (rsB > 24 ? 24 : rsB); nloc = rsB + 8 - rsA; }
        else { const int j = it - NA_ITEMS_LAT; const int hf = j & 1; h = (j >> 1) & 7; b = j >> 4; qrow0 = ML + b * CTXL + hf * 128 + F.wave * 16; }
        const int nch = nloc + 4;
        const bf16* Pq = PROJ + 512 + h * HD, * Pk = PROJ + 1024 + h * HD + 8 * spart, * Pv = PROJ + 1536 + h * HD + 8 * spart;
        auto krow_of = [&](int ch) -> int { return ch < nloc ? b * SEQ + (rsA + ch) * 64 : ML + b * CTXL + (ch - nloc) * 64; };
        s16x8 qf[2];
#pragma unroll
        for (int s = 0; s < 2; ++s) qf[s] = *(const s16x8*)(Pq + (size_t)(qrow0 + q16) * IND + 32 * s + 8 * g);
        int rs = r - 4; rs = rs < 0 ? 0 : (rs > 24 ? 24 : rs);
        const int tlo = jq < 2 ? 0 : jq - 1, thi = jq > 1 ? 3 : jq + 1;
        float madd[4][4]; int lb;
        {
            const int qc = jq * 16 + q16; int cs = qc - 8; cs = cs < 0 ? 0 : (cs > 48 ? 48 : cs);
#pragma unroll
            for (int t = 0; t < 4; ++t)
#pragma unroll
                for (int e = 0; e < 4; ++e) madd[t][e] = ((unsigned)(16 * t + 4 * g + e - cs) < 16u) ? 0.f : -1.0e30f;
            lb = 64 + 4 * g - qc + 15;
        }
        v4u kr_ = *(const v4u*)(Pk + (size_t)(krow_of(0) + (int)skey) * IND), vr_ = *(const v4u*)(Pv + (size_t)(krow_of(0) + (int)skey) * IND);
        __syncthreads();
        if (!isctx) { const float* rpb = INP(14) + ((size_t)l * NH + h) * 15 * 31;
            for (int i = F.tid; i < 640; i += NWAVES * 64) tb[i] = (i >= 64 && i < 64 + 465) ? rpb[i - 64] * 1.4426950408889634f : 0.f; }
        *(LAS v4u*)(F.lds + skey * NA_KROW + spart * 16) = kr_; *(LAS v4u*)(F.lds + 64 * NA_KROW + skey * NA_VROW + spart * 16) = vr_;
        kr_ = *(const v4u*)(Pk + (size_t)(krow_of(1) + (int)skey) * IND); vr_ = *(const v4u*)(Pv + (size_t)(krow_of(1) + (int)skey) * IND);
        f32x4 O[4];
#pragma unroll
        for (int dt = 0; dt < 4; ++dt) O[dt] = (f32x4){0.f, 0.f, 0.f, 0.f};
        float m = -1.0e30f, lsum = 0.f;
        for (int ch = 0; ch < nch; ++ch) {
            __syncthreads();
            LAS unsigned char* cur = F.lds + (ch & 1) * NA_STAGE; LAS unsigned char* nxt = F.lds + ((ch + 1) & 1) * NA_STAGE;
            if (ch + 1 < nch) { *(LAS v4u*)(nxt + skey * NA_KROW + spart * 16) = kr_; *(LAS v4u*)(nxt + 64 * NA_KROW + skey * NA_VROW + spart * 16) = vr_; }
            if (ch + 2 < nch) { const int k2 = krow_of(ch + 2) + (int)skey; kr_ = *(const v4u*)(Pk + (size_t)k2 * IND); vr_ = *(const v4u*)(Pv + (size_t)k2 * IND); }
            const bool local = ch < nloc;
            if (local) { const int kr = rsA + ch; if (kr < rs || kr > rs + 7) continue; }
            const LAS unsigned char* kb_ = cur + q16 * NA_KROW + 16 * g;
            const LAS unsigned char* vtr = cur + 64 * NA_KROW + (4 * g + (q16 >> 2)) * NA_VROW + (q16 & 3) * 8;
            f32x4 S[4];
#pragma unroll
            for (int t = 0; t < 4; ++t) { S[t] = (f32x4){0.f, 0.f, 0.f, 0.f};
                if (!local || (t >= tlo && t <= thi)) {
#pragma unroll
                    for (int s = 0; s < 2; ++s) { const s16x8 kf = *(const LAS s16x8*)(kb_ + t * 16 * NA_KROW + 64 * s); S[t] = __builtin_amdgcn_mfma_f32_16x16x32_bf16(kf, qf[s], S[t], 0, 0, 0); } } }
            float cm = -1.0e30f;
            if (local) {
                const LAS float* tr_ = tb + (rsA + ch - r + 7) * 31 + lb;
#pragma unroll
                for (int t = 0; t < 4; ++t) if (t >= tlo && t <= thi) {
#pragma unroll
                    for (int e = 0; e < 4; ++e) { const float v = S[t][e] * c1 + tr_[16 * t + e] + madd[t][e]; S[t][e] = v; cm = fmaxf(cm, v); } }
            } else {
#pragma unroll
                for (int t = 0; t < 4; ++t)
#pragma unroll
                    for (int e = 0; e < 4; ++e) { const float v = S[t][e] * c1; S[t][e] = v; cm = fmaxf(cm, v); }
            }
            cm = fmaxf(cm, __shfl_xor(cm, 16)); cm = fmaxf(cm, __shfl_xor(cm, 32));
            const float mn = fmaxf(m, cm), alpha = __builtin_amdgcn_exp2f(m - mn); m = mn;
            float ps = 0.f;
            unsigned pk[4][2];
#pragma unroll
            for (int t = 0; t < 4; ++t) {
                if (!local || (t >= tlo && t <= thi)) {
                    const float p0 = __builtin_amdgcn_exp2f(S[t][0] - mn), p1 = __builtin_amdgcn_exp2f(S[t][1] - mn), p2 = __builtin_amdgcn_exp2f(S[t][2] - mn), p3 = __builtin_amdgcn_exp2f(S[t][3] - mn);
                    ps += (p0 + p1) + (p2 + p3);
                    pk[t][0] = pg8::cvt_pk_bf16(p0, p1); pk[t][1] = pg8::cvt_pk_bf16(p2, p3);
                } else { pk[t][0] = 0u; pk[t][1] = 0u; }
            }
            lsum = lsum * alpha + ps;
#pragma unroll
            for (int dt = 0; dt < 4; ++dt) O[dt] = O[dt] * alpha;
#pragma unroll
            for (int p = 0; p < 2; ++p) {
                if (!local || (2 * p <= thi && 2 * p + 1 >= tlo)) {
                    const v4u bw = {pk[2 * p][0], pk[2 * p][1], pk[2 * p + 1][0], pk[2 * p + 1][1]};
                    const s16x8 bfrag = __builtin_bit_cast(s16x8, bw);
#pragma unroll
                    for (int dt = 0; dt < 4; ++dt) {
                        const s16x4 a0 = __builtin_amdgcn_ds_read_tr16_b64_v4i16((LAS s16x4*)(vtr + (2 * p) * 16 * NA_VROW + dt * 32));
                        const s16x4 a1 = __builtin_amdgcn_ds_read_tr16_b64_v4i16((LAS s16x4*)(vtr + (2 * p + 1) * 16 * NA_VROW + dt * 32));
                        const s16x8 afrag = __builtin_shufflevector(a0, a1, 0, 1, 2, 3, 4, 5, 6, 7);
                        O[dt] = __builtin_amdgcn_mfma_f32_16x16x32_bf16(afrag, bfrag, O[dt], 0, 0, 0);
                    }
                }
            }
        }
        lsum += __shfl_xor(lsum, 16); lsum += __shfl_xor(lsum, 32);
        const float inv = __builtin_amdgcn_rcpf(lsum);
        bf16* op = MIX + (size_t)(qrow0 + q16) * D + 256 + h * HD + 4 * g;
#pragma unroll
        for (int dt = 0; dt < 4; ++dt) { v2u w; w.x = pg8::cvt_pk_bf16(O[dt][0] * inv, O[dt][1] * inv); w.y = pg8::cvt_pk_bf16(O[dt][2] * inv, O[dt][3] * inv); *(v2u*)(op + 16 * dt) = w; }
    }
}

constexpr int LRU_UCROW = 260;
constexpr int LRU_OFF_UC = 38 * 256 * 2, LRU_OFF_GT = LRU_OFF_UC + 2 * 32 * LRU_UCROW * 4;
static_assert(LRU_OFF_GT + 32 * 256 * 2 <= RING_BYTES, "LRU LDS map");
template <int PASS>
__device__ __forceinline__ void lru_phase(Frame& F, int l, int ntiles) {
    const bf16* PROJ = WSP(const bf16, WS_PROJ);
    LAS bf16* rxs = (LAS bf16*)(F.lds);
    LAS float* ucf = (LAS float*)(F.lds + LRU_OFF_UC);
    LAS bf16* gts = (LAS bf16*)(F.lds + LRU_OFF_GT);
    const int lane = F.lane, j16 = lane & 15, g = lane >> 4;
    const int kb = F.wave & 3, nh = F.wave >> 2;
    s16x8 wf[2][2][2][2];
    float cbx[2][2], cba[2][2], csp[2][2];
#pragma unroll
    for (int dir = 0; dir < 2; ++dir) {
        const int ld = l * 2 + dir;
        const bf16* WLR = WSP(const bf16, WS_WLR) + (size_t)((ld * 4 + kb) * 2) * 4096;
#pragma unroll
        for (int gt = 0; gt < 2; ++gt)
#pragma unroll
            for (int n2 = 0; n2 < 2; ++n2)
#pragma unroll
                for (int s_ = 0; s_ < 2; ++s_) wf[dir][gt][n2][s_] = *(const s16x8*)(WLR + gt * 4096 + (16 * (2 * nh + n2) + j16) * 64 + 32 * s_ + 8 * g);
#pragma unroll
        for (int n2 = 0; n2 < 2; ++n2) {
            const int e = kb * 64 + 16 * (2 * nh + n2) + j16, idx = ld * 256 + e;
            cbx[dir][n2] = INP(18)[idx]; cba[dir][n2] = INP(20)[idx];
            const float nl = -INP(21)[idx]; csp[dir][n2] = -8.f * (fmaxf(nl, 0.f) + log1pf(__expf(-fabsf(nl))));
        }
    }
    const int c = F.tid & 255, sdir = F.tid >> 8;
    const int sld = l * 2 + sdir;
    const float s1w0 = INP(15)[(sld * 4 + 0) * 256 + c], s1w1 = INP(15)[(sld * 4 + 1) * 256 + c], s1w2 = INP(15)[(sld * 4 + 2) * 256 + c], s1w3 = INP(15)[(sld * 4 + 3) * 256 + c], s1cb = INP(16)[sld * 256 + c];
    const int base = sdir == 0 ? 0 : 3;
    unsigned pre[10], pgw[8];
    auto load_tile = [&](int T) {
        const int row0 = T * 32;
        int lo, hi; if (row0 < ML) { lo = row0 & ~(SEQ - 1); hi = lo + SEQ; } else { lo = row0 & ~(CTXL - 1); hi = lo + CTXL; }
#pragma unroll
        for (int j = 0; j < 10; ++j) { const int i = F.tid + 512 * j, rr = i >> 7, cp = i & 127, row = row0 - 3 + rr;
            const bool ok = (j < 9 || F.tid < 256) && row >= lo && row < hi;
            pre[j] = ok ? *(const unsigned*)(PROJ + (size_t)row * IND + 2048 + 2 * cp) : 0u; }
        if (PASS == 1) {
#pragma unroll
            for (int j = 0; j < 8; ++j) { const int i = F.tid + 512 * j, t = i >> 7, cp = i & 127; pgw[j] = *(const unsigned*)(PROJ + (size_t)(row0 + t) * IND + 2304 + 2 * cp); }
        }
    };
    if (F.vcu < ntiles) load_tile(F.vcu);
    for (int T = F.vcu; T < ntiles; T += F.G) {
        const int row0 = T * 32;
        __syncthreads();
#pragma unroll
        for (int j = 0; j < 10; ++j) { const int i = F.tid + 512 * j; if (j < 9 || F.tid < 256) ((LAS unsigned*)rxs)[i] = pre[j]; }
        if (PASS == 1) {
#pragma unroll
            for (int j = 0; j < 8; ++j) ((LAS unsigned*)gts)[F.tid + 512 * j] = pgw[j];
        }
        if (T + F.G < ntiles) load_tile(T + F.G);
        float hst[2][2];
#pragma unroll
        for (int dir = 0; dir < 2; ++dir)
#pragma unroll
            for (int n2 = 0; n2 < 2; ++n2) hst[dir][n2] = PASS == 1 ? WSP(const float, WS_CARRY)[((size_t)dir * 1152 + T) * 256 + kb * 64 + 16 * (2 * nh + n2) + j16] : 0.f;
        __syncthreads();
        {
            float x0 = bf1(rxs[(base + 0) * 256 + c]), x1 = bf1(rxs[(base + 1) * 256 + c]), x2 = bf1(rxs[(base + 2) * 256 + c]);
#pragma unroll 8
            for (int t = 0; t < 32; ++t) {
                const float x3 = bf1(rxs[(t + base + 3) * 256 + c]);
                ucf[(sdir * 32 + t) * LRU_UCROW + c] = s1cb + s1w0 * x0 + s1w1 * x1 + s1w2 * x2 + s1w3 * x3;
                x0 = x1; x1 = x2; x2 = x3;
            }
        }
        __syncthreads();
        float hf[2][2][4];
        float Pt[2][2] = {{1.f, 1.f}, {1.f, 1.f}};
#pragma unroll
        for (int dir = 0; dir < 2; ++dir) {
            const bool sec16 = ((g & 1) != 0) != (dir != 0), sec32 = ((g >> 1) != 0) != (dir != 0);
#pragma unroll
            for (int step = 0; step < 2; ++step) {
                const int rt = dir == 0 ? step : 1 - step;
                s16x8 af[2];
#pragma unroll
                for (int s_ = 0; s_ < 2; ++s_) { const LAS float* up = ucf + (dir * 32 + 16 * rt + j16) * LRU_UCROW + kb * 64 + 32 * s_ + 8 * g;
                    const f32x4 u0 = *(const LAS f32x4*)up, u1 = *(const LAS f32x4*)(up + 4);
                    const v4u w = {pg8::cvt_pk_bf16(u0[0], u0[1]), pg8::cvt_pk_bf16(u0[2], u0[3]), pg8::cvt_pk_bf16(u1[0], u1[1]), pg8::cvt_pk_bf16(u1[2], u1[3])};
                    af[s_] = __builtin_bit_cast(s16x8, w); }
#pragma unroll
                for (int n2 = 0; n2 < 2; ++n2) {
                    f32x4 zx = {0.f, 0.f, 0.f, 0.f}, za = {0.f, 0.f, 0.f, 0.f};
#pragma unroll
                    for (int s_ = 0; s_ < 2; ++s_) { zx = __builtin_amdgcn_mfma_f32_16x16x32_bf16(af[s_], wf[dir][0][n2][s_], zx, 0, 0, 0); za = __builtin_amdgcn_mfma_f32_16x16x32_bf16(af[s_], wf[dir][1][n2][s_], za, 0, 0, 0); }
                    const int e = kb * 64 + 16 * (2 * nh + n2) + j16;
                    const LAS float* uo = ucf + (dir * 32 + 16 * rt + 4 * g) * LRU_UCROW + e;
                    float a_[4], b_[4];
#pragma unroll
                    for (int r = 0; r < 4; ++r) {
                        const float u = uo[r * LRU_UCROW];
                        const float gx = sigmoidf_(zx[r] + cbx[dir][n2]), ga = sigmoidf_(za[r] + cba[dir][n2]);
                        const float la = csp[dir][n2] * ga, a = __builtin_amdgcn_exp2f(1.4426950408889634f * la), y = 2.f * la;
                        const float om = y > -0.02f ? -y * (1.f + y * (0.5f + y * 0.16666667f)) : 1.f - a * a;
                        a_[r] = a; b_[r] = __builtin_amdgcn_sqrtf(om) * gx * u;
                    }
                    const float P = (a_[0] * a_[1]) * (a_[2] * a_[3]);
                    const float S = dir == 0 ? ((b_[0] * a_[1] + b_[1]) * a_[2] + b_[2]) * a_[3] + b_[3] : ((b_[3] * a_[2] + b_[2]) * a_[1] + b_[1]) * a_[0] + b_[0];
                    const float Pp = __shfl_xor(P, 16), Sp = __shfl_xor(S, 16);
                    const float e1P = sec16 ? Pp : 1.f, e1S = sec16 ? Sp : 0.f;
                    const float prP = P * Pp, prS = sec16 ? P * Sp + S : Pp * S + Sp;
                    const float Pq = __shfl_xor(prP, 32), Sq = __shfl_xor(prS, 32);
                    const float EP = sec32 ? Pq * e1P : e1P, ES = sec32 ? e1P * Sq + e1S : e1S;
                    const float TP = prP * Pq, TS = sec32 ? prP * Sq + prS : Pq * prS + Sq;
                    if (PASS == 1) {
                        float h = EP * hst[dir][n2] + ES;
                        if (dir == 0) {
#pragma unroll
                            for (int r = 0; r < 4; ++r) { h = a_[r] * h + b_[r]; hf[rt][n2][r] = h; }
                        } else {
                            float hb[4];
#pragma unroll
                            for (int r = 3; r >= 0; --r) { h = a_[r] * h + b_[r]; hb[r] = h; }
                            bf16* mp = WSP(bf16, WS_MIX) + (size_t)(row0 + 16 * rt + 4 * g) * D + 768 + e;
                            const LAS bf16* gp = gts + (16 * rt + 4 * g) * 256 + e;
#pragma unroll
                            for (int r = 0; r < 4; ++r) mp[(size_t)r * D] = (bf16)f2bf(gelu_tanh(bf1(gp[r * 256])) * (hf[rt][n2][r] + hb[r]));
                        }
                    } else Pt[dir][n2] *= TP;
                    hst[dir][n2] = TP * hst[dir][n2] + TS;
                }
            }
        }
        if (PASS == 0 && g == 0) {
#pragma unroll
            for (int dir = 0; dir < 2; ++dir)
#pragma unroll
                for (int n2 = 0; n2 < 2; ++n2) WSP(f32x2, WS_TOT)[((size_t)dir * 1152 + T) * 256 + kb * 64 + 16 * (2 * nh + n2) + j16] = (f32x2){Pt[dir][n2], hst[dir][n2]};
        }
    }
}
__device__ __forceinline__ void lru_carry(Frame& F) {
    const f32x2* TOT = WSP(const f32x2, WS_TOT); float* CARRY = WSP(float, WS_CARRY);
    for (int it = F.gw; it < NB * 2 * 4; it += F.NGW) {
        const int b = it >> 3, dir = (it >> 2) & 1, c = (it & 3) * 64 + F.lane;
        float h = 0.f;
        for (int g = 0; g < 18; ++g) {
            f32x2 ps[4]; int tl[4];
#pragma unroll
            for (int i = 0; i < 4; ++i) { const int s = g * 4 + i;
                int T; if (s < 8) T = 1024 + b * 8 + (dir == 0 ? s : 7 - s); else T = b * 64 + (dir == 0 ? s - 8 : 71 - s);
                tl[i] = T; ps[i] = TOT[((size_t)dir * 1152 + T) * 256 + c]; }
#pragma unroll
            for (int i = 0; i < 4; ++i) { CARRY[((size_t)dir * 1152 + tl[i]) * 256 + c] = h; h = ps[i][0] * h + ps[i][1]; }
        }
    }
}

__device__ __forceinline__ void final_rows(Frame& F) {
    const float* g = INP(24);
    for (int row = F.gw; row < ML; row += F.NGW) {
        float* xr = F.out + (size_t)row * D;
        f32x4 v[4]; float ss = 0.f;
#pragma unroll
        for (int j = 0; j < 4; ++j) { v[j] = *(const f32x4*)(xr + 4 * F.lane + 256 * j); ss += (v[j][0] * v[j][0] + v[j][1] * v[j][1]) + (v[j][2] * v[j][2] + v[j][3] * v[j][3]); }
        const float rs = rsqrtf(wave_sum(ss) * (1.f / D) + EPS);
#pragma unroll
        for (int j = 0; j < 4; ++j) { const int k = 4 * F.lane + 256 * j; *(f32x4*)(xr + k) = v[j] * rs * *(const f32x4*)(g + k); }
    }
}

constexpr int N_PHASES = 2 + 7 * DEPTH + 1;
struct Args { const float* in[25]; float* out; unsigned char* ws; int ph_lo, ph_hi; };
static_assert(sizeof(Args) == 27 * 8 + 8, "Args has no padding");

__global__ void __launch_bounds__(NWAVES * 64, 2) mega_fwd(Args args) {
    extern __shared__ __attribute__((aligned(16))) unsigned char lds[];
    Frame F;
    F.lds = (LAS unsigned char*)lds;
    const int wave_s = __builtin_amdgcn_readfirstlane((int)threadIdx.x >> 6);
    F.wave = wave_s; F.lane = (int)__builtin_amdgcn_mbcnt_hi(~0u, __builtin_amdgcn_mbcnt_lo(~0u, 0u)); F.tid = wave_s * 64 + F.lane;
    F.G = gridDim.x; { const int bx = blockIdx.x; F.vcu = (F.G % 8 == 0) ? (bx % 8) * (F.G / 8) + bx / 8 : bx; }
    F.gw = F.vcu * NWAVES + F.wave; F.NGW = F.G * NWAVES;
    F.out = args.out; F.ws = args.ws;
    volatile LAS unsigned* MISC = (volatile LAS unsigned*)(F.lds + MISC_OFF);
    for (int u = F.tid; u < (LDS_BYTES - LDSCTL_OFF) / 4; u += NWAVES * 64) ((LAS unsigned*)(F.lds + LDSCTL_OFF))[u] = 0u;
    __syncthreads();
    if (F.tid == 0) {
#pragma unroll
        for (int i = 0; i < 25; ++i) *(LAS unsigned long long*)(F.lds + PTR_OFF + 8 * i) = (unsigned long long)args.in[i];
    }
    __syncthreads();
    XcdBarrier bar = xcd_barrier_post((unsigned*)(F.ws + WS_CTL) + CW_BAR, MISC + 8, F.tid);

    const int lo = args.ph_lo, hi = args.ph_hi;
#ifdef PROBE_MASK
    bool rep_done = false;
#define PROBE_V ((((PROBE_MASK >> ph) & 1) && !rep_done) ? PROBE_VARIANT : 0)
#else
#define PROBE_V 0
#endif
    for (int ph = lo; ph < hi; ++ph) {
        { unsigned ones_ = ~0u; asm volatile("" : "+s"(ones_));
          int t_ = wave_s * 64 + (int)__builtin_amdgcn_mbcnt_hi(ones_, __builtin_amdgcn_mbcnt_lo(ones_, 0u)); asm volatile("" : "+v"(t_)); F.tid = t_; F.lane = t_ & 63; F.wave = __builtin_amdgcn_readfirstlane(t_ >> 6); F.gw = F.vcu * NWAVES + F.wave; }
        if (ph == 0) {
#ifndef NO_P0
            phase_p0a(F);
#endif
        } else if (ph == 1) {
#ifndef NO_P0
            phase_p0b(F);
#endif
        }
        else if (ph == N_PHASES - 1) final_rows(F);
        else {
            const int l = (ph - 2) / 7, k = (ph - 2) % 7; const bool last = (l == DEPTH - 1);
            const int Mx = last ? ML : MT;
            float* MOD = WSP(float, WS_MOD);
            if (k == 0) {
                pg8::Gemm g{WSP(const bf16, WS_XA), WSP(const bf16, WS_WIN) + (size_t)l * IND * D, MT, IND, D};
                pg8::Order S; if (last) S.init(ML, IND, (MC / 256) * 5, F.G, (int)blockIdx.x); else S.init(MT, IND, 0, F.G, (int)blockIdx.x);
                pg8::EpiScale<0, IND> E{WSP(bf16, WS_PROJ), WSP(const float, WS_SHW1) + (size_t)l * 17 * IND, WSP(const float, WS_RSSA), PROBE_V};

#ifndef NO_G0
                pg8::gemm_phase<pg8::EpiScale<0, IND>, pg8::Order, true, true>(F.lds + RING_OFF, g, S, E, F.tid);
#endif

            } else if (k == 1) {

#ifndef NO_LRU
                lru_phase<0>(F, l, 1152);
#ifdef REP_LRU0
                __syncthreads(); lru_phase<0>(F, l, 1152);
#endif
#endif

                __syncthreads();
#ifndef NO_CONV
                conv_phase(F, l, last ? 1024 : 1152);
                __syncthreads();
#ifdef REP_CONV
                conv_phase(F, l, last ? 1024 : 1152);
                __syncthreads();
#endif
#endif
#ifndef NO_NA
                na_phase(F, l, last ? NA_ITEMS_LAT : NA_ITEMS_LAT + NA_ITEMS_CTX);
#ifdef REP_NA
                na_phase(F, l, last ? NA_ITEMS_LAT : NA_ITEMS_LAT + NA_ITEMS_CTX);
#endif
#endif
            } else if (k == 2) {
                lru_carry(F);
            } else if (k == 3) {

#ifndef NO_LRU
                lru_phase<1>(F, l, last ? 1024 : 1152);
#endif

            } else if (k == 4 || k == 6) {
                const bool dn = (k == 6);
                const int ln = (dn && !last) ? l + 1 : l;
                pg8::Gemm g{dn ? WSP(const bf16, WS_HID) : WSP(const bf16, WS_MIX), dn ? WSP(const bf16, WS_W2) + (size_t)l * D * FF : WSP(const bf16, WS_WOUT) + (size_t)l * D * D, Mx, D, dn ? FF : D};
                pg8::Order S; S.init(Mx, D, 0, F.G, (int)blockIdx.x);
                const bool fromin = (!dn && l == 0);
                const float* go_g = dn ? INP(5) + l * D : INP(4) + l * D;
                const float* go_s = MOD + (size_t)l * 17 * MODW + (dn ? 4 : 1) * D;
                pg8::EpiRes E{fromin ? INP(0) : (const float*)nullptr, fromin ? INP(2) : (const float*)nullptr, (dn && last) ? F.out : (float*)nullptr,
                              MOD + (size_t)l * 17 * MODW + (dn ? 5 : 2) * D, (dn ? INP(4) : INP(5)) + ln * D, MOD + (size_t)ln * 17 * MODW + (dn ? 1 : 4) * D,
                              go_g, go_s, WSP(bf16, WS_XA), dn ? WSP(float, WS_RSSA) : WSP(float, WS_RSSB), (dn && last) ? 0 : 1};
#ifndef NO_GR
                pg8::gemm_phase<pg8::EpiRes, pg8::Order, true, true>(F.lds + RING_OFF, g, S, E, F.tid);
#endif
            } else if (k == 5) {
                pg8::Gemm g{WSP(const bf16, WS_XA), WSP(const bf16, WS_W1) + (size_t)l * FF * D, Mx, FF, D};
                pg8::Order S; S.init(Mx, FF, 0, F.G, (int)blockIdx.x);
                pg8::EpiScale<1, FF> E{WSP(bf16, WS_HID), WSP(const float, WS_SHW2) + (size_t)l * 17 * FF, WSP(const float, WS_RSSB), PROBE_V};

#ifndef NO_G1
                pg8::gemm_phase<pg8::EpiScale<1, FF>, pg8::Order, true, true>(F.lds + RING_OFF, g, S, E, F.tid);
#endif

            }
        }
#ifdef PROBE_MASK
        if (((PROBE_MASK >> ph) & 1) && !rep_done) { rep_done = true; xcd_barrier(bar, F.tid); --ph; continue; }
        rep_done = false;
#endif
        if (ph + 1 < hi) xcd_barrier(bar, F.tid);
    }
}

extern "C" void kernel_launch(void* const* d_in, const int* in_sizes, int n_in, void* d_out, int out_size, void* d_ws, size_t ws_size, hipStream_t stream) {
    static int grid = 0;
    if (grid == 0) {
        if (n_in != 25 || out_size != ML * D || ws_size < WS_END) { fprintf(stderr, "kernel_launch: unexpected shapes (n_in %d out %d ws %zu)\n", n_in, out_size, ws_size); grid = -1; return; }
        int dev = 0, cus = 0;
        if (hipGetDevice(&dev) != hipSuccess || hipDeviceGetAttribute(&cus, hipDeviceAttributeMultiprocessorCount, dev) != hipSuccess) { grid = -1; return; }
        if (hipFuncSetAttribute((const void*)mega_fwd, hipFuncAttributeMaxDynamicSharedMemorySize, LDS_BYTES) != hipSuccess) { fprintf(stderr, "kernel_launch: hipFuncSetAttribute failed\n"); grid = -1; return; }
        int per_cu = 0;
        if (hipOccupancyMaxActiveBlocksPerMultiprocessor(&per_cu, (const void*)mega_fwd, NWAVES * 64, LDS_BYTES) != hipSuccess || per_cu < 1) fprintf(stderr, "kernel_launch: occupancy query reports %d\n", per_cu);
        (void)hipGetLastError();
        grid = cus;
    }
    if (grid < 0) return;
    if (hipMemsetAsync((char*)d_ws + WS_CTL, 0, CTL_ZERO_BYTES, stream) != hipSuccess) return;
    Args a{};
    for (int i = 0; i < 25; ++i) a.in[i] = (const float*)d_in[i];
    a.out = (float*)d_out; a.ws = (unsigned char*)d_ws;
#if MK_N_LAUNCHES == 1
    a.ph_lo = 0; a.ph_hi = N_PHASES;
    hipLaunchKernelGGL(mega_fwd, dim3(grid), dim3(NWAVES * 64), LDS_BYTES, stream, a);
#else
    for (int ph = 0; ph < N_PHASES; ++ph) { a.ph_lo = ph; a.ph_hi = ph + 1; hipLaunchKernelGGL(mega_fwd, dim3(grid), dim3(NWAVES * 64), LDS_BYTES, stream, a); }
#endif
}
```

```cpp
#include <hip/hip_runtime.h>
#include <cstdio>
#include <cstdint>

constexpr int D = 1024, NB = 16, SEQ = 2048, CTXL = 256, DEPTH = 2;
constexpr int ML = NB * SEQ, MC = NB * CTXL, MT = ML + MC;
constexpr int IND = 2560, FF = 4096, NH = 8, HD = 64;
constexpr int MODW = 6 * D;
constexpr float EPS = 1e-6f;
#ifndef MK_N_LAUNCHES
#define MK_N_LAUNCHES 1
#endif

namespace pg8 {
#define PG8_LAS __attribute__((address_space(3)))
typedef unsigned short bf16_t;
typedef short bf16x8 __attribute__((ext_vector_type(8)));
typedef float f32x4 __attribute__((ext_vector_type(4)));
typedef unsigned u32x4 __attribute__((ext_vector_type(4)));
constexpr int BM = 256, BK = 64, HALF = 128, HTB = HALF * BK * 2, STAGE_BYTES = 8 * HTB, NXCD = 8, WGM = 8;

__host__ __device__ __forceinline__ int lds_byte(int r, int c) { const int st = (r >> 4) * 2 + (c >> 5), rr = r & 15, cc = c & 31, ob = rr * 64 + cc * 2; return st * 1024 + (ob ^ (((ob >> 9) & 1) << 5)); }
__host__ __device__ __forceinline__ void stage_rc(int b, int& R, int& C) { const int st = b / 1024, sb = b % 1024, swz = sb ^ (((sb >> 9) & 1) << 5); R = (st >> 1) * 16 + swz / 64; C = (st & 1) * 32 + (swz % 64) / 2; }
__host__ __device__ __forceinline__ int perm32(int rho) { const int n = rho >> 4, i = rho & 15; return 8 * (i >> 2) + 4 * n + (i & 3); }

struct Unit { int pm, pn; };
struct Gemm { const bf16_t* A; const bf16_t* Bt; int M, N, K; };

__host__ __device__ __forceinline__ void map_tile(int wgid, int nM, int nN, Unit& u) {
    const int nwg = nM * nN;
    { const int q = nwg / NXCD, r = nwg % NXCD, xcd = wgid % NXCD, off = wgid / NXCD; wgid = (xcd < r ? xcd * (q + 1) : r * (q + 1) + (xcd - r) * q) + off; }
    const int nig = WGM * nN, gid = wgid / nig, fm = gid * WGM, gsz = (nM - fm) < WGM ? (nM - fm) : WGM;
    u.pm = fm + ((wgid % nig) % gsz); u.pn = (wgid % nig) / gsz;
}
struct Order {
    int nM, nN, nwg, extra, G, c;
    __host__ __device__ void init(int M, int N, int extra_, int G_, int c_) { nM = M / BM; nN = N / BM; nwg = nM * nN; extra = extra_; G = G_; c = c_; }
    __host__ __device__ bool next(int i, Unit& u) const {
        const long L = (long)i * G + c;
        if (L < nwg) { map_tile((int)L, nM, nN, u); return true; }
        if (L < nwg + extra) { const int q = (int)L - nwg; u.pm = nM + q / 5; u.pn = 4 + q % 5; return true; }
        return false;
    }
    __device__ __forceinline__ void a_ready(const Unit&) const {}
    __device__ __forceinline__ void done(const Unit&) const {}
};

__device__ __forceinline__ unsigned cvt_pk_bf16(float lo, float hi) { unsigned r; asm volatile("v_cvt_pk_bf16_f32 %0, %1, %2" : "=v"(r) : "v"(lo), "v"(hi)); return r; }

template <int ACT, int LDC> struct EpiScale {
    static constexpr bool PERM = true, AFTER_DRAIN = false;
    bf16_t* O; const float* shw; const float* RSS;
    int probe;
    __device__ __forceinline__ void operator()(const f32x4 (&acc)[2][2][4][2], const Unit& u, int wr, int wc, int fr, int fq) const {
        asm volatile("" : "+s"(wr), "+s"(wc));
        const int brow = u.pm < ML / BM ? (u.pm >> 3) : NB;
        const float* sp = shw + (size_t)brow * LDC + u.pn * BM;
        bf16_t* Ot = O + (size_t)u.pm * BM * LDC + u.pn * BM;
        const float* RSSt = RSS + (size_t)u.pm * BM * 32;
        unsigned cl = (unsigned)(wc * 32 + 8 * fq);
        unsigned rl0 = (unsigned)(wr * 64 + fr);
        asm volatile("" : "+v"(cl), "+v"(rl0));
        f32x4 pa[2][4], pb[2][4], sh[2][2];
#pragma unroll
        for (int ai = 0; ai < 2; ++ai)
#pragma unroll
            for (int m = 0; m < 4; ++m) { const unsigned ro = (rl0 + (unsigned)(ai * HALF + m * 16)) * 32u + 8u * (unsigned)fq;
                if (probe == 2) { pa[ai][m] = acc[ai][0][m][0]; pb[ai][m] = acc[ai][1][m][0]; } else { pa[ai][m] = *(const f32x4*)(RSSt + ro); pb[ai][m] = *(const f32x4*)(RSSt + (ro + 4u)); } }
#pragma unroll
        for (int bj = 0; bj < 2; ++bj) { if (probe == 2) { sh[bj][0] = acc[0][bj][0][1]; sh[bj][1] = acc[1][bj][0][1]; } else { sh[bj][0] = *(const f32x4*)(sp + (cl + (unsigned)(bj * HALF))); sh[bj][1] = *(const f32x4*)(sp + (cl + (unsigned)(bj * HALF + 4))); } }
        float rs[2][4];
#pragma unroll
        for (int ai = 0; ai < 2; ++ai)
#pragma unroll
            for (int m = 0; m < 4; ++m) { const f32x4 p0 = pa[ai][m], p1 = pb[ai][m];
                float s = ((p0[0] + p0[1]) + (p0[2] + p0[3])) + ((p1[0] + p1[1]) + (p1[2] + p1[3]));
                s += __shfl_xor(s, 16); s += __shfl_xor(s, 32);
                rs[ai][m] = rsqrtf(s * (1.0f / D) + EPS); }
#pragma unroll
        for (int bj = 0; bj < 2; ++bj)
#pragma unroll
            for (int ai = 0; ai < 2; ++ai)
#pragma unroll
                for (int m = 0; m < 4; ++m) {
                    f32x4 v0 = acc[ai][bj][m][0] * rs[ai][m] + sh[bj][0], v1 = acc[ai][bj][m][1] * rs[ai][m] + sh[bj][1];
                    if (ACT == 1) {
#pragma unroll
                        for (int e = 0; e < 4; ++e) { const float a = fmaxf(v0[e], 0.f), b = fmaxf(v1[e], 0.f); v0[e] = a * a; v1[e] = b * b; }
                    }
                    u32x4 w; w.x = cvt_pk_bf16(v0[0], v0[1]); w.y = cvt_pk_bf16(v0[2], v0[3]); w.z = cvt_pk_bf16(v1[0], v1[1]); w.w = cvt_pk_bf16(v1[2], v1[3]);
                    if (probe == 0) *(u32x4*)(Ot + ((rl0 + (unsigned)(ai * HALF + m * 16)) * (unsigned)LDC + cl + (unsigned)(bj * HALF))) = w;
                    else asm volatile("" :: "v"(w));
                }
    }
};
struct EpiRes {
    static constexpr bool PERM = true, AFTER_DRAIN = false;
    const float* src_lat; const float* src_ctx;
    float* dst_lat;
    const float* gate;
    const float* gmg; const float* gmsc;
    const float* gmg_o; const float* gmsc_o;
    bf16_t* XA; float* RSS; int hasxa;
    template <int BJ, int AI0, int NAI, int M0, int NM>
    __device__ __forceinline__ void batch(const f32x4 (&acc)[2][2][4][2], const float* src, float* dst, const float* gt, const float* gg, const float* gs, const float* go, const float* gso, bf16_t* XAt, float* RSSt, unsigned cl, unsigned rl0, int fq) const {
        const unsigned c = cl + (unsigned)(BJ * HALF);
        f32x4 x0[NAI][NM], x1[NAI][NM];
        const bool srcf = src != nullptr;
        if (srcf) {
#pragma unroll
            for (int a = 0; a < NAI; ++a)
#pragma unroll
                for (int m = 0; m < NM; ++m) { const unsigned off = (rl0 + (unsigned)((AI0 + a) * HALF + (M0 + m) * 16)) * (unsigned)D + c; x0[a][m] = *(const f32x4*)(src + off); x1[a][m] = *(const f32x4*)(src + (off + 4u)); }
        } else {
            u32x4 xb[NAI][NM];
#pragma unroll
            for (int a = 0; a < NAI; ++a)
#pragma unroll
                for (int m = 0; m < NM; ++m) { const unsigned off = (rl0 + (unsigned)((AI0 + a) * HALF + (M0 + m) * 16)) * (unsigned)D + c; xb[a][m] = *(const u32x4*)(XAt + off); }
            const f32x4 i0 = *(const f32x4*)(go + c) * (*(const f32x4*)(gso + c) + 1.0f), i1 = *(const f32x4*)(go + (c + 4u)) * (*(const f32x4*)(gso + (c + 4u)) + 1.0f);
            f32x4 r0, r1;
#pragma unroll
            for (int e = 0; e < 4; ++e) { r0[e] = __builtin_amdgcn_rcpf(i0[e]); r1[e] = __builtin_amdgcn_rcpf(i1[e]); }
#pragma unroll
            for (int a = 0; a < NAI; ++a)
#pragma unroll
                for (int m = 0; m < NM; ++m) { const u32x4 w = xb[a][m];
                    x0[a][m] = (f32x4){__uint_as_float(w.x << 16), __uint_as_float(w.x & 0xffff0000u), __uint_as_float(w.y << 16), __uint_as_float(w.y & 0xffff0000u)} * r0;
                    x1[a][m] = (f32x4){__uint_as_float(w.z << 16), __uint_as_float(w.z & 0xffff0000u), __uint_as_float(w.w << 16), __uint_as_float(w.w & 0xffff0000u)} * r1; }
        }
        const f32x4 g0 = *(const f32x4*)(gt + c), g1 = *(const f32x4*)(gt + (c + 4u));
        f32x4 m0 = {0.f, 0.f, 0.f, 0.f}, m1 = {0.f, 0.f, 0.f, 0.f};
        if (hasxa) { m0 = *(const f32x4*)(gg + c) * (*(const f32x4*)(gs + c) + 1.0f); m1 = *(const f32x4*)(gg + (c + 4u)) * (*(const f32x4*)(gs + (c + 4u)) + 1.0f); }
        asm volatile("" ::: "memory");
#pragma unroll
        for (int a = 0; a < NAI; ++a)
#pragma unroll
            for (int m = 0; m < NM; ++m) {
                const unsigned rl = rl0 + (unsigned)((AI0 + a) * HALF + (M0 + m) * 16);
                const unsigned off = rl * (unsigned)D + c;
                const f32x4 y0 = x0[a][m] + g0 * acc[AI0 + a][BJ][M0 + m][0], y1 = x1[a][m] + g1 * acc[AI0 + a][BJ][M0 + m][1];
                if (dst) { *(f32x4*)(dst + off) = y0; *(f32x4*)(dst + (off + 4u)) = y1; }
                float ss = ((y0[0] * y0[0] + y0[1] * y0[1]) + (y0[2] * y0[2] + y0[3] * y0[3])) + ((y1[0] * y1[0] + y1[1] * y1[1]) + (y1[2] * y1[2] + y1[3] * y1[3]));
                ss += __shfl_xor(ss, 16); ss += __shfl_xor(ss, 32);
                if (fq == 0) RSSt[rl * 32u + (unsigned)(BJ * 4)] = ss;
                if (hasxa) { const f32x4 a0 = y0 * m0, a1 = y1 * m1;
                    u32x4 w; w.x = cvt_pk_bf16(a0[0], a0[1]); w.y = cvt_pk_bf16(a0[2], a0[3]); w.z = cvt_pk_bf16(a1[0], a1[1]); w.w = cvt_pk_bf16(a1[2], a1[3]);
                    *(u32x4*)(XAt + off) = w; }
            }
        asm volatile("" ::: "memory");
    }
    __device__ __forceinline__ void operator()(const f32x4 (&acc)[2][2][4][2], const Unit& u, int wr, int wc, int fr, int fq) const {
        asm volatile("" : "+s"(wr), "+s"(wc));
        const bool lat = u.pm < ML / BM;
        const int brow = lat ? (u.pm >> 3) : NB;
        const float* src = src_lat ? (lat ? src_lat + (size_t)u.pm * BM * D : src_ctx + (size_t)(u.pm - ML / BM) * BM * D) + u.pn * BM : nullptr;
        float* dst = (dst_lat && lat) ? dst_lat + (size_t)u.pm * BM * D + u.pn * BM : nullptr;
        const float* gt = gate + (size_t)brow * MODW + u.pn * BM;
        const float* gg = gmg + u.pn * BM;
        const float* gs = gmsc + (size_t)brow * MODW + u.pn * BM;
        const float* go = gmg_o + u.pn * BM;
        const float* gso = gmsc_o + (size_t)brow * MODW + u.pn * BM;
        bf16_t* XAt = XA + (size_t)u.pm * BM * D + u.pn * BM;
        float* RSSt = RSS + (size_t)u.pm * BM * 32 + u.pn * 8 + wc;
        unsigned cl = (unsigned)(wc * 32 + 8 * fq);
        unsigned rl0 = (unsigned)(wr * 64 + fr);
        asm volatile("" : "+v"(cl), "+v"(rl0));
        batch<0, 0, 1, 0, 2>(acc, src, dst, gt, gg, gs, go, gso, XAt, RSSt, cl, rl0, fq);
        batch<0, 0, 1, 2, 2>(acc, src, dst, gt, gg, gs, go, gso, XAt, RSSt, cl, rl0, fq);
        batch<0, 1, 1, 0, 4>(acc, src, dst, gt, gg, gs, go, gso, XAt, RSSt, cl, rl0, fq);
        batch<1, 0, 2, 0, 4>(acc, src, dst, gt, gg, gs, go, gso, XAt, RSSt, cl, rl0, fq);
    }
};

template <class Epi, class Sched, bool ALIGN_EPI = false, bool SP2 = false>
__device__ __forceinline__ void gemm_phase(PG8_LAS unsigned char* lds, const Gemm g, const Sched& S, const Epi& E, const int tid) {
    const int wid = __builtin_amdgcn_readfirstlane(tid >> 6), lane = tid & 63, wr = wid >> 2, wc = wid & 3, fr = lane & 15, fq = lane >> 4;
    const int K = g.K, nt = K / BK;
    unsigned voffA[2], voffB[2];
#pragma unroll
    for (int i = 0; i < 2; ++i) { int R, C; stage_rc(tid * 16 + i * 8192, R, C); const int Rb = Epi::PERM ? ((R & ~31) + perm32(R & 31)) : R;
        voffA[i] = (unsigned)(R * K + C) * 2u; voffB[i] = (unsigned)(Rb * K + C) * 2u; }
    const size_t kstep = (size_t)(BK * 2);
    const size_t hstep = (size_t)HALF * K * 2;
    const size_t tstep = 2 * hstep;
    const unsigned ldsw = (unsigned)wid * 1024u;
    const int aoff = lds_byte(wr * 64 + fr, fq * 8), boff = lds_byte(wc * 32 + fr, fq * 8);
#define PG8_SA(b, h) (((b) * 2 + (h)) * HTB)
#define PG8_SB(b, h) ((4 + (b) * 2 + (h)) * HTB)
#define PG8_STAGE(bufoff, gbase, voff) do { _Pragma("unroll") for (int _i = 0; _i < 2; ++_i) \
        __builtin_amdgcn_global_load_lds((const unsigned*)((const char*)(gbase) + (voff)[_i]), (PG8_LAS unsigned*)(lds + (bufoff) + ldsw + _i * 8192), 16, 0, 0); } while (0)
#define PG8_LDA(dst, b, h) do { _Pragma("unroll") for (int m = 0; m < 4; ++m) _Pragma("unroll") for (int k = 0; k < 2; ++k) dst[m][k] = *(const PG8_LAS bf16x8*)(lds + PG8_SA(b, h) + aoff + m * 2048 + k * 1024); } while (0)
#define PG8_LDB(dst, b, h) do { _Pragma("unroll") for (int n = 0; n < 2; ++n) _Pragma("unroll") for (int k = 0; k < 2; ++k) dst[n][k] = *(const PG8_LAS bf16x8*)(lds + PG8_SB(b, h) + boff + n * 2048 + k * 1024); } while (0)
#define PG8_MMA(ai, bj, At, Bt) do { __builtin_amdgcn_s_setprio(1); _Pragma("unroll") for (int m = 0; m < 4; ++m) _Pragma("unroll") for (int n = 0; n < 2; ++n) _Pragma("unroll") for (int k = 0; k < 2; ++k) \
        acc[ai][bj][m][n] = __builtin_amdgcn_mfma_f32_16x16x32_bf16(Bt[n][k], At[m][k], acc[ai][bj][m][n], 0, 0, 0); __builtin_amdgcn_s_setprio(0); } while (0)
#define PG8_WAIT_V(n) asm volatile("s_waitcnt vmcnt(" #n ")" ::: "memory")
#define PG8_WAIT_L(n) asm volatile("s_waitcnt lgkmcnt(" #n ")" ::: "memory")
#define PG8_BAR __builtin_amdgcn_s_barrier()
#define PG8_SCHED __builtin_amdgcn_sched_barrier(0)
    Unit cur, nxt; int ui = 0;
    if (!S.next(0, cur)) return;
    f32x4 acc[2][2][4][2];
#pragma unroll
    for (int a = 0; a < 2; ++a)
#pragma unroll
        for (int b = 0; b < 2; ++b)
#pragma unroll
            for (int m = 0; m < 4; ++m)
#pragma unroll
                for (int n = 0; n < 2; ++n) acc[a][b][m][n] = (f32x4){0.f, 0.f, 0.f, 0.f};
    bf16x8 At[4][2], B0[2][2], B1[2][2];
    const char* cA = (const char*)g.A + (size_t)cur.pm * tstep; const char* cB = (const char*)g.Bt + (size_t)cur.pn * tstep;
    S.a_ready(cur);
    if constexpr (SP2) {
        PG8_STAGE(PG8_SB(0, 0), cB, voffB); PG8_STAGE(PG8_SB(0, 1), cB + hstep, voffB); PG8_STAGE(PG8_SA(0, 0), cA, voffA); PG8_STAGE(PG8_SA(0, 1), cA + hstep, voffA);
        if (wr == 1) PG8_BAR;
        PG8_WAIT_V(2); PG8_BAR;
        PG8_STAGE(PG8_SB(1, 0), cB + kstep, voffB); PG8_STAGE(PG8_SA(1, 0), cA + kstep, voffA); PG8_STAGE(PG8_SB(1, 1), cB + hstep + kstep, voffB);
        PG8_WAIT_V(6); PG8_BAR;
    } else {
        PG8_STAGE(PG8_SB(0, 0), cB, voffB); PG8_STAGE(PG8_SA(0, 0), cA, voffA); PG8_STAGE(PG8_SB(0, 1), cB + hstep, voffB); PG8_STAGE(PG8_SA(0, 1), cA + hstep, voffA);
        if (wr == 1) PG8_BAR;
        PG8_WAIT_V(4); PG8_BAR;
        PG8_STAGE(PG8_SB(1, 0), cB + kstep, voffB); PG8_STAGE(PG8_SA(1, 0), cA + kstep, voffA); PG8_STAGE(PG8_SB(1, 1), cB + hstep + kstep, voffB);
        PG8_WAIT_V(6); PG8_BAR;
    }
    for (;;) {
        const bool has_next = S.next(ui + 1, nxt);
        const char* nA = has_next ? (const char*)g.A + (size_t)nxt.pm * tstep : cA; const char* nB = has_next ? (const char*)g.Bt + (size_t)nxt.pn * tstep : cB;
        for (int t = 0; t < nt; t += 2) {
            const bool last = (t == nt - 2);
            const char* a1 = cA + (size_t)(t + 1) * kstep;
            const char* a2 = last ? nA : cA + (size_t)(t + 2) * kstep; const char* b2 = last ? nB : cB + (size_t)(t + 2) * kstep;
            const char* a3 = a2 + kstep; const char* b3 = b2 + kstep;
            if (last && has_next) S.a_ready(nxt);
            if constexpr (SP2) {
            PG8_LDB(B0, 0, 0); PG8_LDB(B1, 0, 1); PG8_SCHED; PG8_LDA(At, 0, 0); PG8_STAGE(PG8_SA(1, 1), a1 + hstep, voffA);
            PG8_WAIT_V(8); PG8_WAIT_L(0); PG8_BAR; PG8_MMA(0, 0, At, B0); PG8_MMA(0, 1, At, B1); PG8_BAR; PG8_SCHED;
            PG8_LDA(At, 0, 1); PG8_STAGE(PG8_SB(0, 0), b2, voffB); PG8_STAGE(PG8_SB(0, 1), b2 + hstep, voffB); PG8_STAGE(PG8_SA(0, 0), a2, voffA);
            PG8_WAIT_V(8); PG8_WAIT_L(0); PG8_BAR; PG8_MMA(1, 0, At, B0); PG8_MMA(1, 1, At, B1); PG8_BAR; PG8_SCHED;
            PG8_LDB(B0, 1, 0); PG8_LDB(B1, 1, 1); PG8_SCHED; PG8_LDA(At, 1, 0); PG8_STAGE(PG8_SA(0, 1), a2 + hstep, voffA);
            PG8_WAIT_V(8); PG8_WAIT_L(0); PG8_BAR; PG8_MMA(0, 0, At, B0); PG8_MMA(0, 1, At, B1); PG8_BAR; PG8_SCHED;
            PG8_LDA(At, 1, 1); PG8_STAGE(PG8_SB(1, 0), b3, voffB); PG8_STAGE(PG8_SB(1, 1), b3 + hstep, voffB); PG8_STAGE(PG8_SA(1, 0), a3, voffA);
            PG8_WAIT_V(8); PG8_WAIT_L(0); PG8_BAR; PG8_MMA(1, 0, At, B0); PG8_MMA(1, 1, At, B1); PG8_BAR; PG8_SCHED;
            } else {
            PG8_LDB(B0, 0, 0); PG8_SCHED; PG8_LDA(At, 0, 0); PG8_STAGE(PG8_SA(1, 1), a1 + hstep, voffA);
            PG8_WAIT_L(8); PG8_BAR; PG8_WAIT_L(0); PG8_MMA(0, 0, At, B0); PG8_BAR; PG8_SCHED;
            PG8_LDB(B1, 0, 1); PG8_STAGE(PG8_SB(0, 0), b2, voffB);
            PG8_BAR; PG8_WAIT_L(0); PG8_MMA(0, 1, At, B1); PG8_BAR;
            PG8_LDA(At, 0, 1); PG8_STAGE(PG8_SA(0, 0), a2, voffA);
            PG8_BAR; PG8_WAIT_L(0); PG8_MMA(1, 0, At, B0); PG8_BAR; PG8_SCHED;
            PG8_STAGE(PG8_SB(0, 1), b2 + hstep, voffB);
            PG8_WAIT_V(6); PG8_BAR; PG8_MMA(1, 1, At, B1); PG8_BAR;
            PG8_LDB(B0, 1, 0); PG8_SCHED; PG8_LDA(At, 1, 0); PG8_STAGE(PG8_SA(0, 1), a2 + hstep, voffA);
            PG8_WAIT_L(8); PG8_BAR; PG8_WAIT_L(0); PG8_MMA(0, 0, At, B0); PG8_BAR; PG8_SCHED;
            PG8_LDB(B1, 1, 1); PG8_STAGE(PG8_SB(1, 0), b3, voffB);
            PG8_BAR; PG8_WAIT_L(0); PG8_MMA(0, 1, At, B1); PG8_BAR;
            PG8_LDA(At, 1, 1); PG8_STAGE(PG8_SA(1, 0), a3, voffA);
            PG8_BAR; PG8_WAIT_L(0); PG8_MMA(1, 0, At, B0); PG8_BAR; PG8_SCHED;
            PG8_STAGE(PG8_SB(1, 1), b3 + hstep, voffB);
            PG8_WAIT_V(6); PG8_BAR; PG8_MMA(1, 1, At, B1); PG8_BAR;
            }
        }
        if constexpr (ALIGN_EPI) { if (wr == 0) PG8_BAR; }
        if constexpr (!Epi::AFTER_DRAIN) { E(acc, cur, wr, wc, fr, fq); S.done(cur); }
        if (!has_next) break;
#pragma unroll
        for (int a = 0; a < 2; ++a)
#pragma unroll
            for (int b = 0; b < 2; ++b)
#pragma unroll
                for (int m = 0; m < 4; ++m)
#pragma unroll
                    for (int n = 0; n < 2; ++n) acc[a][b][m][n] = (f32x4){0.f, 0.f, 0.f, 0.f};
        cur = nxt; cA = nA; cB = nB; ++ui;
        if constexpr (ALIGN_EPI) { if (wr == 1) PG8_BAR; }
    }
    PG8_WAIT_V(0);
    if constexpr (!ALIGN_EPI) { if (wr == 0) PG8_BAR; }
    PG8_BAR;
    if constexpr (Epi::AFTER_DRAIN) { E.fused(acc, cur, wr, wc, fr, fq, lds, wid, lane); S.done(cur); }
#undef PG8_SA
#undef PG8_SB
#undef PG8_STAGE
#undef PG8_LDA
#undef PG8_LDB
#undef PG8_MMA
#undef PG8_WAIT_V
#undef PG8_WAIT_L
#undef PG8_BAR
#undef PG8_SCHED
}
}

constexpr size_t MiB = 1u << 20;
constexpr size_t WS_CTL = 0, CTL_ZERO_BYTES = 1 * MiB;
constexpr size_t WS_MOD = 1 * MiB;
constexpr size_t WS_SHW1 = 2 * MiB;
constexpr size_t WS_SHW2 = 3 * MiB;
constexpr size_t WS_RSSA = 4 * MiB;
constexpr size_t WS_RSSB = 9 * MiB;
constexpr size_t WS_TOT = 14 * MiB;
constexpr size_t WS_CARRY = 19 * MiB;
constexpr size_t WS_WLR = 21 * MiB + 512 * 1024;
constexpr size_t WS_WIN = 22 * MiB;
constexpr size_t WS_WOUT = 32 * MiB;
constexpr size_t WS_W1 = 36 * MiB;
constexpr size_t WS_W2 = 52 * MiB;
constexpr size_t WS_CX = 68 * MiB;
constexpr size_t WS_XA = 84 * MiB;
constexpr size_t WS_HID = 156 * MiB;
constexpr size_t WS_PROJ = WS_HID;
constexpr size_t WS_MIX = WS_HID + 180 * MiB;
constexpr size_t WS_END = 444 * MiB;
static_assert(WS_MIX + (size_t)MT * D * 2 <= WS_END && WS_HID + (size_t)MT * FF * 2 == WS_END, "ws map");
constexpr size_t WS_ZERO = WS_CTL + 512 * 1024;
constexpr int CW_BAR = 4096;

constexpr int NWAVES = 8;
constexpr int RING_OFF = 0, RING_BYTES = 131072;
constexpr int LDSCTL_OFF = RING_BYTES, MISC_OFF = LDSCTL_OFF + 320;
constexpr int LDS_BYTES = 147456;

#define GAS __attribute__((address_space(1)))
#define LAS __attribute__((address_space(3)))
typedef unsigned short bf16;
typedef unsigned v4u __attribute__((ext_vector_type(4)));
typedef unsigned v2u __attribute__((ext_vector_type(2)));
typedef float f32x4 __attribute__((ext_vector_type(4)));
typedef float f32x2 __attribute__((ext_vector_type(2)));
typedef GAS unsigned gu32;
#define LDS_WAIT() asm volatile("s_waitcnt lgkmcnt(0)" ::: "memory")
#define VM_WAIT() asm volatile("s_waitcnt vmcnt(0)" ::: "memory")
__device__ __forceinline__ unsigned f2bf(float f) { unsigned u = __builtin_bit_cast(unsigned, f); return (u + 0x7fffu + ((u >> 16) & 1u)) >> 16; }
__device__ __forceinline__ unsigned pk2(float lo, float hi) { return f2bf(lo) | (f2bf(hi) << 16); }
__device__ __forceinline__ float bflo(unsigned w) { return __uint_as_float(w << 16); }
__device__ __forceinline__ float bfhi(unsigned w) { return __uint_as_float(w & 0xffff0000u); }
__device__ __forceinline__ float bf1(bf16 v) { return __uint_as_float((unsigned)v << 16); }
__device__ __forceinline__ float sigmoidf_(float x) { return __builtin_amdgcn_rcpf(1.f + __builtin_amdgcn_exp2f(-1.4426950408889634f * x)); }
__device__ __forceinline__ float siluf_(float x) { return x * sigmoidf_(x); }
__device__ __forceinline__ float gelu_tanh(float x) { const float u = 0.7978845608028654f * (x + 0.044715f * x * x * x); return x * sigmoidf_(2.f * u); }
__device__ __forceinline__ float wave_sum(float v) {
#pragma unroll
    for (int o = 1; o < 64; o <<= 1) v += __shfl_xor(v, o);
    return v;
}

#define XB_TMO      128
#define XB_XCNT(j)  (256  + 64 * (j))
#define XB_XSUB(j)  (1280 + 64 * (j))
#define XB_XGEN(j)  (2304 + 64 * (j))
#define XB_TOP      3328
#define XB_TOPGEN   3392
#define XCD_BAR_WORDS 3456
#define XB_SPIN_CAP (1u << 18)

__device__ __forceinline__ unsigned xb_ld(unsigned* p)              { return __hip_atomic_load(p, __ATOMIC_RELAXED, __HIP_MEMORY_SCOPE_AGENT); }
__device__ __forceinline__ unsigned xb_add(unsigned* p, unsigned v) { return __hip_atomic_fetch_add(p, v, __ATOMIC_RELAXED, __HIP_MEMORY_SCOPE_AGENT); }
__device__ __forceinline__ unsigned xb_xcc_id() { return (unsigned)__builtin_amdgcn_s_getreg((3 << 11) | 20) & 0xFu; }
#define XB_SPIN(cond, bar) do { unsigned _sp = 0; while (cond) { __builtin_amdgcn_s_sleep(1); \
    if ((++_sp & 255u) == 0u) { if (xb_ld(&(bar)[XB_TMO])) break; if (_sp > XB_SPIN_CAP) { atomicAdd(&(bar)[XB_TMO], 1u); break; } } } } while (0)

struct XcdBarrier {
    unsigned* bar; unsigned x;
    volatile LAS unsigned* st;
};

__device__ __forceinline__ XcdBarrier xcd_barrier_post(unsigned* bar, volatile LAS unsigned* st, int tid) {
    XcdBarrier b; b.bar = bar; b.x = xb_xcc_id(); b.st = st;
    if (tid == 0) (void)xb_add(&bar[XB_XCNT(b.x)], 1u);
    return b;
}
__device__ __forceinline__ void xcd_barrier_complete(unsigned* bar, unsigned x, unsigned& nloc, unsigned& nx) {
    const unsigned G = gridDim.x * gridDim.y * gridDim.z;
    unsigned sum, cnt, mine, sp = 0u;
    for (;;) {
        sum = 0u; cnt = 0u; mine = 0u;
#pragma unroll 1
        for (unsigned j = 0; j < 16; ++j) { const unsigned c = xb_ld(&bar[XB_XCNT(j)]); sum += c; cnt += (c > 0u) ? 1u : 0u; mine = (j == x) ? c : mine; }
        if (sum == G) break;
        __builtin_amdgcn_s_sleep(1);
        if ((++sp & 255u) == 0u) { if (xb_ld(&bar[XB_TMO])) break; if (sp > XB_SPIN_CAP) { atomicAdd(&bar[XB_TMO], 1u); break; } }
    }
    nloc = mine > 0u ? mine : 1u; nx = cnt > 0u ? cnt : 1u;
}

__device__ __forceinline__ void xcd_barrier(const XcdBarrier& b, int tid) {
    asm volatile("s_waitcnt vmcnt(0)" ::: "memory");
    __syncthreads();
    if (tid == 0) {
        unsigned* bar = b.bar;
        __builtin_amdgcn_s_waitcnt(0);
        unsigned nloc = b.st[0], nx = b.st[1];
        if (nloc == 0u) { xcd_barrier_complete(bar, b.x, nloc, nx); b.st[0] = nloc; b.st[1] = nx; }
        const unsigned old = xb_add(&bar[XB_XSUB(b.x)], 1u);
        const unsigned gen = old / nloc;
        if (old + 1u == (gen + 1u) * nloc) {
            __builtin_amdgcn_fence(__ATOMIC_RELEASE, "agent");
            asm volatile("s_waitcnt vmcnt(0)" ::: "memory");
            const unsigned og = xb_add(&bar[XB_TOP], 1u);
            const unsigned tg = og / nx;
            if (og + 1u == (tg + 1u) * nx) xb_add(&bar[XB_TOPGEN], 1u);
            else XB_SPIN(xb_ld(&bar[XB_TOPGEN]) == tg, bar);
            __builtin_amdgcn_fence(__ATOMIC_ACQUIRE, "agent");
            xb_add(&bar[XB_XGEN(b.x)], 1u);
            asm volatile("s_waitcnt vmcnt(0)" ::: "memory");
        } else {
            XB_SPIN(xb_ld(&bar[XB_XGEN(b.x)]) == gen, bar);
            __builtin_amdgcn_fence(__ATOMIC_ACQUIRE, "agent");
            asm volatile("s_waitcnt vmcnt(0)" ::: "memory");
        }
    }
    __syncthreads();
}

struct Frame {
    LAS unsigned char* lds;
    int tid, lane, wave;
    int vcu, G;
    int gw, NGW;
    float* out; unsigned char* ws;
};
constexpr int PTR_OFF = LDSCTL_OFF + 512;
__device__ __forceinline__ const float* inp_(LAS unsigned char* lds, int i) {
    const unsigned long long v = *(const LAS unsigned long long*)(lds + PTR_OFF + 8 * i);
    const unsigned lo = __builtin_amdgcn_readfirstlane((unsigned)v), hi = __builtin_amdgcn_readfirstlane((unsigned)(v >> 32));
    return (const float*)(((unsigned long long)hi << 32) | lo);
}
#define INP(i) inp_(F.lds, (i))
#define WSP(T, off) ((T*)(F.ws + (off)))

__device__ __forceinline__ void gemv17_item(Frame& F, const LAS float* tab, LAS float* red, const float* W, int ldw, int n0, const float* bias, float* outp, int ldo) {
    float acc[17];
#pragma unroll
    for (int r = 0; r < 17; ++r) acc[r] = 0.f;
    const int k0 = F.wave * 128;
    const float* wp = W + (size_t)k0 * ldw + n0 + F.lane;
#pragma unroll 4
    for (int k = 0; k < 128; ++k) {
        const float wv = wp[(size_t)k * ldw];
#pragma unroll
        for (int r = 0; r < 17; ++r) acc[r] += tab[r * 1024 + k0 + k] * wv;
    }
#pragma unroll
    for (int r = 0; r < 17; ++r) red[(F.wave * 17 + r) * 64 + F.lane] = acc[r];
    __syncthreads();
    for (int i = F.tid; i < 17 * 64; i += NWAVES * 64) {
        const int r = i >> 6, n = i & 63; float s = bias ? bias[n0 + n] : 0.f;
#pragma unroll
        for (int w = 0; w < 8; ++w) s += red[(w * 17 + r) * 64 + n];
        outp[(size_t)r * ldo + n0 + n] = s;
    }
    __syncthreads();
}

__device__ __forceinline__ void p0_transpose_item(const float* W, int K, int N, bf16* WT, LAS float* scr, int item, int lane) {
    const int nblk = N / 32, kb = item / nblk, nb = item % nblk, k0 = 64 * kb, n0 = 32 * nb;
#pragma unroll 8
    for (int i = 0; i < 32; ++i) { const int kk = 2 * i + (lane >> 5); scr[kk * 33 + (lane & 31)] = W[(size_t)(k0 + kk) * N + n0 + (lane & 31)]; }
    LDS_WAIT(); asm volatile("" ::: "memory");
    const int c = lane & 7;
#pragma unroll
    for (int j = 0; j < 4; ++j) { const int n = (lane >> 3) + 8 * j; const LAS float* s = scr + (8 * c) * 33 + n;
        v4u o; o.x = pk2(s[0 * 33], s[1 * 33]); o.y = pk2(s[2 * 33], s[3 * 33]); o.z = pk2(s[4 * 33], s[5 * 33]); o.w = pk2(s[6 * 33], s[7 * 33]);
        *(GAS v4u*)(WT + (size_t)(n0 + n) * K + k0 + 8 * c) = o; }
    LDS_WAIT(); asm volatile("" ::: "memory");
}

__device__ __forceinline__ void phase_p0a(Frame& F) {
    LAS float* tab = (LAS float*)(F.lds);
    LAS float* red = (LAS float*)(F.lds + 17 * 1024 * 4);
    float* MOD = WSP(float, WS_MOD);
    bool filled = false;
    for (int it = F.vcu; it < 2 * 96; it += F.G) {
        if (!filled) {
            for (int i = F.tid; i < 17 * 1024; i += NWAVES * 64) { const int r = i >> 10, k = i & 1023; const float v = (r < 16) ? INP(1)[r * D + k] : INP(3)[k]; tab[i] = siluf_(v); }
            __syncthreads(); filled = true;
        }
        const int l = it / 96, n0 = (it % 96) * 64;
        gemv17_item(F, tab, red, INP(6) + (size_t)l * D * MODW, MODW, n0, INP(7) + (size_t)l * MODW, MOD + (size_t)l * 17 * MODW, MODW);
    }
    __syncthreads();
    {
        bf16* WLR = WSP(bf16, WS_WLR);
        for (int i = F.gw * 64 + F.lane; i < 2 * 2 * 4 * 2 * 4096; i += F.NGW * 64) { const int d = i & 63, e = (i >> 6) & 63, gt = (i >> 12) & 1, blk = i >> 13;
            const float* src = gt == 0 ? INP(17) : INP(19); WLR[i] = (bf16)f2bf(src[((size_t)blk * 64 + d) * 64 + e]); }
    }
    LAS float* scr = (LAS float*)(F.lds + F.wave * 16384);
    constexpr int I_IN = (D / 64) * (IND / 32), I_OUT = (D / 64) * (D / 32), I_1 = (D / 64) * (FF / 32), I_2 = (FF / 64) * (D / 32), I_L = I_IN + I_OUT + I_1 + I_2;
    for (int it = F.gw; it < 2 * I_L; it += F.NGW) {
        const int l = it / I_L; int r = it % I_L;
        const float* W; bf16* WT; int K = D, N;
        if (r < I_IN) { W = INP(8) + (size_t)l * D * IND; WT = WSP(bf16, WS_WIN) + (size_t)l * IND * D; N = IND; }
        else if (r < I_IN + I_OUT) { r -= I_IN; W = INP(9) + (size_t)l * D * D; WT = WSP(bf16, WS_WOUT) + (size_t)l * D * D; N = D; }
        else if (r < I_IN + I_OUT + I_1) { r -= I_IN + I_OUT; W = INP(22) + (size_t)l * D * FF; WT = WSP(bf16, WS_W1) + (size_t)l * FF * D; N = FF; }
        else { r -= I_IN + I_OUT + I_1; W = INP(23) + (size_t)l * FF * D; WT = WSP(bf16, WS_W2) + (size_t)l * D * FF; K = FF; N = D; }
        p0_transpose_item(W, K, N, WT, scr, r, F.lane);
    }
}

__device__ __forceinline__ void phase_p0b(Frame& F) {
    LAS float* tab = (LAS float*)(F.lds);
    LAS float* red = (LAS float*)(F.lds + 17 * 1024 * 4);
    const float* MOD = WSP(const float, WS_MOD);
    for (int it = F.vcu; it < 2 * 104; it += F.G) {
        const int l = it / 104, j = it % 104; const bool first = j < 40;
        const int shoff = first ? 0 : 3 * D;
        __syncthreads();
        for (int i = F.tid; i < 17 * 1024; i += NWAVES * 64) { const int r = i >> 10, k = i & 1023; tab[i] = MOD[((size_t)l * 17 + r) * MODW + shoff + k]; }
        __syncthreads();
        const int ldw = first ? IND : FF;
        gemv17_item(F, tab, red, first ? INP(8) + (size_t)l * D * IND : INP(22) + (size_t)l * D * FF, ldw, (first ? j : j - 40) * 64, nullptr,
                    first ? WSP(float, WS_SHW1) + (size_t)l * 17 * IND : WSP(float, WS_SHW2) + (size_t)l * 17 * FF, ldw);
    }
    bf16* XA = WSP(bf16, WS_XA); float* RSSA = WSP(float, WS_RSSA);
    const float* g1 = INP(4);
    for (int row = F.gw; row < MT; row += F.NGW) {
        const bool lat = row < ML;
        const float* xr = lat ? INP(0) + (size_t)row * D : INP(2) + (size_t)(row - ML) * D;
        const int brow = lat ? (row >> 11) : NB;
        const float* sc = MOD + (size_t)brow * MODW + D;
        f32x4 v[4]; float ss = 0.f;
#pragma unroll
        for (int j = 0; j < 4; ++j) { v[j] = *(const f32x4*)(xr + 4 * F.lane + 256 * j); ss += (v[j][0] * v[j][0] + v[j][1] * v[j][1]) + (v[j][2] * v[j][2] + v[j][3] * v[j][3]); }
        ss = wave_sum(ss);
        if (F.lane < 32) RSSA[(size_t)row * 32 + F.lane] = (F.lane == 0) ? ss : 0.f;
#pragma unroll
        for (int j = 0; j < 4; ++j) { const int k = 4 * F.lane + 256 * j;
            const f32x4 gm = *(const f32x4*)(g1 + k) * (*(const f32x4*)(sc + k) + 1.0f), a = v[j] * gm;
            v2u o; o.x = pk2(a[0], a[1]); o.y = pk2(a[2], a[3]); *(v2u*)(XA + (size_t)row * D + k) = o; }
    }
}

constexpr int CV_OSROW = 260;
__device__ __forceinline__ void conv_phase(Frame& F, int l, int ntiles) {
    const bf16* PROJ = WSP(const bf16, WS_PROJ); bf16* MIX = WSP(bf16, WS_MIX);
    LAS float* us = (LAS float*)(F.lds);
    LAS float* os = (LAS float*)(F.lds + 62 * 256 * 4);
    const int c = F.tid & 255, half = F.tid >> 8;
    float w[31];
#pragma unroll
    for (int k = 0; k < 31; ++k) w[k] = INP(10)[((size_t)l * 31 + k) * 256 + c];
    const float cbias = INP(11)[l * 256 + c];
    const f32x4 lg = *(const f32x4*)(INP(12) + l * 256 + 4 * F.lane), lb = *(const f32x4*)(INP(13) + l * 256 + 4 * F.lane);
    unsigned pv[16], pg[16];
    auto load_tile = [&](int T) {
        const int row0 = T * 32;
        int lo, hi; if (row0 < ML) { lo = row0 & ~(SEQ - 1); hi = lo + SEQ; } else { lo = row0 & ~(CTXL - 1); hi = lo + CTXL; }
#pragma unroll
        for (int j = 0; j < 16; ++j) { const int i = F.tid + 512 * j, rr = i >> 7, cp = i & 127, row = row0 - 15 + rr;
            const bool ok = (j < 15 || F.tid < 256) && row >= lo && row < hi;
            pv[j] = ok ? *(const unsigned*)(PROJ + (size_t)row * IND + 2 * cp) : 0u; pg[j] = ok ? *(const unsigned*)(PROJ + (size_t)row * IND + 256 + 2 * cp) : 0u; }
    };
    if (F.vcu < ntiles) load_tile(F.vcu);
    for (int T = F.vcu; T < ntiles; T += F.G) {
        const int row0 = T * 32;
        __syncthreads();
#pragma unroll
        for (int j = 0; j < 16; ++j) { const int i = F.tid + 512 * j;
            if (j < 15 || F.tid < 256) { f32x2 u; u[0] = bflo(pv[j]) * sigmoidf_(bflo(pg[j])); u[1] = bfhi(pv[j]) * sigmoidf_(bfhi(pg[j])); *(LAS f32x2*)(us + 2 * i) = u; } }
        if (T + F.G < ntiles) load_tile(T + F.G);
        __syncthreads();
        {
            float acc[16];
#pragma unroll
            for (int j = 0; j < 16; ++j) acc[j] = cbias;
            const LAS float* up = us + (16 * half) * 256 + c;
#pragma unroll
            for (int i = 0; i < 46; ++i) { const float x = up[i * 256];
#pragma unroll
                for (int j = 0; j < 16; ++j) if (i - j >= 0 && i - j <= 30) acc[j] += w[i - j] * x; }
#pragma unroll
            for (int j = 0; j < 16; ++j) os[(16 * half + j) * CV_OSROW + c] = acc[j];
        }
        __syncthreads();
#pragma unroll
        for (int q = 0; q < 4; ++q) { const int t = 4 * F.wave + q;
            const f32x4 v = *(const LAS f32x4*)(os + t * CV_OSROW + 4 * F.lane);
            const float mu = wave_sum((v[0] + v[1]) + (v[2] + v[3])) * (1.f / 256.f);
            const f32x4 d = v - mu;
            const float var = wave_sum((d[0] * d[0] + d[1] * d[1]) + (d[2] * d[2] + d[3] * d[3])) * (1.f / 256.f);
            const f32x4 y = d * rsqrtf(var + EPS) * lg + lb;
            v2u o; o.x = pk2(siluf_(y[0]), siluf_(y[1])); o.y = pk2(siluf_(y[2]), siluf_(y[3]));
            *(v2u*)(MIX + (size_t)(row0 + t) * D + 4 * F.lane) = o; }
    }
}

typedef short s16x8 __attribute__((ext_vector_type(8)));
typedef short s16x4 __attribute__((ext_vector_type(4)));
constexpr int NA_KROW = 144, NA_VROW = 160;
constexpr int NA_STAGE = 64 * NA_KROW + 64 * NA_VROW, NA_OFF_TB = 2 * NA_STAGE;
constexpr int NA_ITEMS_LAT = NB * NH * 8, NA_ITEMS_CTX = NB * NH * 2;
struct NaBlk { f32x4 O[4]; float m, lsum; };
__device__ __forceinline__ int na_rs(int r) { int v = r - 4; return v < 0 ? 0 : (v > 24 ? 24 : v); }
__device__ __forceinline__ void na_phase(Frame& F, int l, int nitems) {
    const bf16* PROJ = WSP(const bf16, WS_PROJ); bf16* MIX = WSP(bf16, WS_MIX);
    LAS float* tb = (LAS float*)(F.lds + NA_OFF_TB);
    const int lane = F.lane, q16 = lane & 15, g = lane >> 4;
    const unsigned skey = (unsigned)(F.tid >> 3), spart = (unsigned)(F.tid & 7);
    const float c1 = 0.125f * 1.4426950408889634f;
    for (int it = F.vcu; it < nitems; it += F.G) {
        const bool isctx = it >= NA_ITEMS_LAT;
        int b, h, ra = 0, jq = 0, qrow0, rsI = 0, nloc = 0;
        if (!isctx) { const int r4 = it & 7; h = (it >> 3) & 7; b = it >> 6; const int r0 = 4 * r4; ra = r0 + 2 * (F.wave >> 2); jq = F.wave & 3; qrow0 = b * SEQ + ra * 64 + jq * 16;
            rsI = na_rs(r0); nloc = na_rs(r0 + 3) + 8 - rsI; }
        else { const int j = it - NA_ITEMS_LAT; const int hf = j & 1; h = (j >> 1) & 7; b = j >> 4; qrow0 = ML + b * CTXL + hf * 128 + F.wave * 16; }
        const int nch = nloc + 4;
        const bf16* Pq = PROJ + 512 + h * HD, * Pk = PROJ + 1024 + h * HD + 8 * spart, * Pv = PROJ + 1536 + h * HD + 8 * spart;
        auto krow_of = [&](int ch) -> int { return ch < nloc ? b * SEQ + (rsI + ch) * 64 : ML + b * CTXL + (ch - nloc) * 64; };
        s16x8 qfA[2], qfB[2];
#pragma unroll
        for (int s_ = 0; s_ < 2; ++s_) { qfA[s_] = *(const s16x8*)(Pq + (size_t)(qrow0 + q16) * IND + 32 * s_ + 8 * g); qfB[s_] = isctx ? qfA[s_] : *(const s16x8*)(Pq + (size_t)(qrow0 + 64 + q16) * IND + 32 * s_ + 8 * g); }
        const int rsA = na_rs(ra), rsB = na_rs(ra + 1);
        const int tlo = jq < 2 ? 0 : jq - 1, thi = jq > 1 ? 3 : jq + 1;
        float madd[4][4]; int lb;
        {
            const int qc = jq * 16 + q16; int cs = qc - 8; cs = cs < 0 ? 0 : (cs > 48 ? 48 : cs);
#pragma unroll
            for (int t = 0; t < 4; ++t)
#pragma unroll
                for (int e = 0; e < 4; ++e) madd[t][e] = ((unsigned)(16 * t + 4 * g + e - cs) < 16u) ? 0.f : -1.0e30f;
            lb = 64 + 4 * g - qc + 15;
        }
        v4u kr_ = *(const v4u*)(Pk + (size_t)(krow_of(0) + (int)skey) * IND), vr_ = *(const v4u*)(Pv + (size_t)(krow_of(0) + (int)skey) * IND);
        __syncthreads();
        if (!isctx) { const float* rpb = INP(14) + ((size_t)l * NH + h) * 15 * 31;
            for (int i = F.tid; i < 640; i += NWAVES * 64) tb[i] = (i >= 64 && i < 64 + 465) ? rpb[i - 64] * 1.4426950408889634f : 0.f; }
        *(LAS v4u*)(F.lds + skey * NA_KROW + spart * 16) = kr_; *(LAS v4u*)(F.lds + 64 * NA_KROW + skey * NA_VROW + spart * 16) = vr_;
        kr_ = *(const v4u*)(Pk + (size_t)(krow_of(1) + (int)skey) * IND); vr_ = *(const v4u*)(Pv + (size_t)(krow_of(1) + (int)skey) * IND);
        NaBlk A, B;
#pragma unroll
        for (int dt = 0; dt < 4; ++dt) { A.O[dt] = (f32x4){0.f, 0.f, 0.f, 0.f}; B.O[dt] = (f32x4){0.f, 0.f, 0.f, 0.f}; }
        A.m = -1.0e30f; A.lsum = 0.f; B.m = -1.0e30f; B.lsum = 0.f;
        for (int ch = 0; ch < nch; ++ch) {
            __syncthreads();
            LAS unsigned char* cur = F.lds + (ch & 1) * NA_STAGE; LAS unsigned char* nxt = F.lds + ((ch + 1) & 1) * NA_STAGE;
            if (ch + 1 < nch) { *(LAS v4u*)(nxt + skey * NA_KROW + spart * 16) = kr_; *(LAS v4u*)(nxt + 64 * NA_KROW + skey * NA_VROW + spart * 16) = vr_; }
            if (ch + 2 < nch) { const int k2 = krow_of(ch + 2) + (int)skey; kr_ = *(const v4u*)(Pk + (size_t)k2 * IND); vr_ = *(const v4u*)(Pv + (size_t)k2 * IND); }
            const bool local = ch < nloc;
            const int kr = rsI + ch;
            const bool actA = !local || (kr >= rsA && kr <= rsA + 7), actB = !isctx && (!local || (kr >= rsB && kr <= rsB + 7));
            if (!actA && !actB) continue;
            const LAS unsigned char* kb_ = cur + q16 * NA_KROW + 16 * g;
            const LAS unsigned char* vtr = cur + 64 * NA_KROW + (4 * g + (q16 >> 2)) * NA_VROW + (q16 & 3) * 8;
            f32x4 SA[4], SB[4];
#pragma unroll
            for (int t = 0; t < 4; ++t) { SA[t] = (f32x4){0.f, 0.f, 0.f, 0.f}; SB[t] = (f32x4){0.f, 0.f, 0.f, 0.f};
                if (!local || (t >= tlo && t <= thi)) {
#pragma unroll
                    for (int s_ = 0; s_ < 2; ++s_) { const s16x8 kf = *(const LAS s16x8*)(kb_ + t * 16 * NA_KROW + 64 * s_);
                        if (actA) SA[t] = __builtin_amdgcn_mfma_f32_16x16x32_bf16(kf, qfA[s_], SA[t], 0, 0, 0);
                        if (actB) SB[t] = __builtin_amdgcn_mfma_f32_16x16x32_bf16(kf, qfB[s_], SB[t], 0, 0, 0); } } }
            unsigned pkA[4][2], pkB[4][2];
            auto soft = [&](f32x4 (&S)[4], NaBlk& X, unsigned (&pk)[4][2], int rq) {
                float cm = -1.0e30f;
                if (local) {
                    const LAS float* tr_ = tb + (kr - rq + 7) * 31 + lb;
#pragma unroll
                    for (int t = 0; t < 4; ++t) if (t >= tlo && t <= thi) {
#pragma unroll
                        for (int e = 0; e < 4; ++e) { const float v = S[t][e] * c1 + tr_[16 * t + e] + madd[t][e]; S[t][e] = v; cm = fmaxf(cm, v); } }
                } else {
#pragma unroll
                    for (int t = 0; t < 4; ++t)
#pragma unroll
                        for (int e = 0; e < 4; ++e) { const float v = S[t][e] * c1; S[t][e] = v; cm = fmaxf(cm, v); }
                }
                if (!__all(cm <= X.m + 8.f)) {
                    cm = fmaxf(cm, __shfl_xor(cm, 16)); cm = fmaxf(cm, __shfl_xor(cm, 32));
                    const float mn = fmaxf(X.m, cm), alpha = __builtin_amdgcn_exp2f(X.m - mn); X.m = mn;
                    X.lsum *= alpha;
#pragma unroll
                    for (int dt = 0; dt < 4; ++dt) X.O[dt] = X.O[dt] * alpha;
                }
                const float mm = X.m;
                float ps = 0.f;
#pragma unroll
                for (int t = 0; t < 4; ++t) {
                    if (!local || (t >= tlo && t <= thi)) {
                        const float p0 = __builtin_amdgcn_exp2f(S[t][0] - mm), p1 = __builtin_amdgcn_exp2f(S[t][1] - mm), p2 = __builtin_amdgcn_exp2f(S[t][2] - mm), p3 = __builtin_amdgcn_exp2f(S[t][3] - mm);
                        ps += (p0 + p1) + (p2 + p3);
                        pk[t][0] = pg8::cvt_pk_bf16(p0, p1); pk[t][1] = pg8::cvt_pk_bf16(p2, p3);
                    } else { pk[t][0] = 0u; pk[t][1] = 0u; }
                }
                X.lsum += ps;
            };
            if (actA) soft(SA, A, pkA, ra);
            if (actB) soft(SB, B, pkB, ra + 1);
#pragma unroll
            for (int p = 0; p < 2; ++p) {
                if (!local || (2 * p <= thi && 2 * p + 1 >= tlo)) {
                    const v4u bwA = {pkA[2 * p][0], pkA[2 * p][1], pkA[2 * p + 1][0], pkA[2 * p + 1][1]}, bwB = {pkB[2 * p][0], pkB[2 * p][1], pkB[2 * p + 1][0], pkB[2 * p + 1][1]};
                    const s16x8 bfA = __builtin_bit_cast(s16x8, bwA), bfB = __builtin_bit_cast(s16x8, bwB);
#pragma unroll
                    for (int dt = 0; dt < 4; ++dt) {
                        const s16x4 a0 = __builtin_amdgcn_ds_read_tr16_b64_v4i16((LAS s16x4*)(vtr + (2 * p) * 16 * NA_VROW + dt * 32));
                        const s16x4 a1 = __builtin_amdgcn_ds_read_tr16_b64_v4i16((LAS s16x4*)(vtr + (2 * p + 1) * 16 * NA_VROW + dt * 32));
                        const s16x8 afrag = __builtin_shufflevector(a0, a1, 0, 1, 2, 3, 4, 5, 6, 7);
                        if (actA) A.O[dt] = __builtin_amdgcn_mfma_f32_16x16x32_bf16(afrag, bfA, A.O[dt], 0, 0, 0);
                        if (actB) B.O[dt] = __builtin_amdgcn_mfma_f32_16x16x32_bf16(afrag, bfB, B.O[dt], 0, 0, 0);
                    }
                }
            }
        }
        {
            float ls = A.lsum; ls += __shfl_xor(ls, 16); ls += __shfl_xor(ls, 32);
            const float inv = __builtin_amdgcn_rcpf(ls);
            bf16* op = MIX + (size_t)(qrow0 + q16) * D + 256 + h * HD + 4 * g;
#pragma unroll
            for (int dt = 0; dt < 4; ++dt) { v2u w; w.x = pg8::cvt_pk_bf16(A.O[dt][0] * inv, A.O[dt][1] * inv); w.y = pg8::cvt_pk_bf16(A.O[dt][2] * inv, A.O[dt][3] * inv); *(v2u*)(op + 16 * dt) = w; }
        }
        if (!isctx) {
            float ls = B.lsum; ls += __shfl_xor(ls, 16); ls += __shfl_xor(ls, 32);
            const float inv = __builtin_amdgcn_rcpf(ls);
            bf16* op = MIX + (size_t)(qrow0 + 64 + q16) * D + 256 + h * HD + 4 * g;
#pragma unroll
            for (int dt = 0; dt < 4; ++dt) { v2u w; w.x = pg8::cvt_pk_bf16(B.O[dt][0] * inv, B.O[dt][1] * inv); w.y = pg8::cvt_pk_bf16(B.O[dt][2] * inv, B.O[dt][3] * inv); *(v2u*)(op + 16 * dt) = w; }
        }
    }
}

constexpr int LRU_UCROW = 260;
constexpr int LRU_OFF_UC = 38 * 256 * 2, LRU_OFF_GT = LRU_OFF_UC + 2 * 32 * LRU_UCROW * 4;
static_assert(LRU_OFF_GT + 32 * 256 * 2 <= RING_BYTES, "LRU LDS map");
template <int PASS>
__device__ __forceinline__ void lru_phase(Frame& F, int l, int ntiles) {
    const bf16* PROJ = WSP(const bf16, WS_PROJ);
    LAS bf16* rxs = (LAS bf16*)(F.lds);
    LAS float* ucf = (LAS float*)(F.lds + LRU_OFF_UC);
    LAS bf16* gts = (LAS bf16*)(F.lds + LRU_OFF_GT);
    const int lane = F.lane, j16 = lane & 15, g = lane >> 4;
    const int kb = F.wave & 3, nh = F.wave >> 2;
    s16x8 wf[2][2][2][2];
    float cbx[2][2], cba[2][2], csp[2][2];
#pragma unroll
    for (int dir = 0; dir < 2; ++dir) {
        const int ld = l * 2 + dir;
        const bf16* WLR = WSP(const bf16, WS_WLR) + (size_t)((ld * 4 + kb) * 2) * 4096;
#pragma unroll
        for (int gt = 0; gt < 2; ++gt)
#pragma unroll
            for (int n2 = 0; n2 < 2; ++n2)
#pragma unroll
                for (int s_ = 0; s_ < 2; ++s_) wf[dir][gt][n2][s_] = *(const s16x8*)(WLR + gt * 4096 + (16 * (2 * nh + n2) + j16) * 64 + 32 * s_ + 8 * g);
#pragma unroll
        for (int n2 = 0; n2 < 2; ++n2) {
            const int e = kb * 64 + 16 * (2 * nh + n2) + j16, idx = ld * 256 + e;
            cbx[dir][n2] = INP(18)[idx]; cba[dir][n2] = INP(20)[idx];
            const float nl = -INP(21)[idx]; csp[dir][n2] = -8.f * (fmaxf(nl, 0.f) + log1pf(__expf(-fabsf(nl))));
        }
    }
    const int c = F.tid & 255, sdir = F.tid >> 8;
    const int sld = l * 2 + sdir;
    const float s1w0 = INP(15)[(sld * 4 + 0) * 256 + c], s1w1 = INP(15)[(sld * 4 + 1) * 256 + c], s1w2 = INP(15)[(sld * 4 + 2) * 256 + c], s1w3 = INP(15)[(sld * 4 + 3) * 256 + c], s1cb = INP(16)[sld * 256 + c];
    const int base = sdir == 0 ? 0 : 3;
    unsigned pre[10], pgw[8];
    auto load_tile = [&](int T) {
        const int row0 = T * 32;
        int lo, hi; if (row0 < ML) { lo = row0 & ~(SEQ - 1); hi = lo + SEQ; } else { lo = row0 & ~(CTXL - 1); hi = lo + CTXL; }
#pragma unroll
        for (int j = 0; j < 10; ++j) { const int i = F.tid + 512 * j, rr = i >> 7, cp = i & 127, row = row0 - 3 + rr;
            const bool ok = (j < 9 || F.tid < 256) && row >= lo && row < hi;
            pre[j] = ok ? *(const unsigned*)(PROJ + (size_t)row * IND + 2048 + 2 * cp) : 0u; }
        if (PASS == 1) {
#pragma unroll
            for (int j = 0; j < 8; ++j) { const int i = F.tid + 512 * j, t = i >> 7, cp = i & 127; pgw[j] = *(const unsigned*)(PROJ + (size_t)(row0 + t) * IND + 2304 + 2 * cp); }
        }
    };
    if (F.vcu < ntiles) load_tile(F.vcu);
    for (int T = F.vcu; T < ntiles; T += F.G) {
        const int row0 = T * 32;
        __syncthreads();
#pragma unroll
        for (int j = 0; j < 10; ++j) { const int i = F.tid + 512 * j; if (j < 9 || F.tid < 256) ((LAS unsigned*)rxs)[i] = pre[j]; }
        if (PASS == 1) {
#pragma unroll
            for (int j = 0; j < 8; ++j) ((LAS unsigned*)gts)[F.tid + 512 * j] = pgw[j];
        }
        if (T + F.G < ntiles) load_tile(T + F.G);
        float hst[2][2];
#pragma unroll
        for (int dir = 0; dir < 2; ++dir)
#pragma unroll
            for (int n2 = 0; n2 < 2; ++n2) hst[dir][n2] = PASS == 1 ? WSP(const float, WS_CARRY)[((size_t)dir * 1152 + T) * 256 + kb * 64 + 16 * (2 * nh + n2) + j16] : 0.f;
        __syncthreads();
        {
            float x0 = bf1(rxs[(base + 0) * 256 + c]), x1 = bf1(rxs[(base + 1) * 256 + c]), x2 = bf1(rxs[(base + 2) * 256 + c]);
#pragma unroll 8
            for (int t = 0; t < 32; ++t) {
                const float x3 = bf1(rxs[(t + base + 3) * 256 + c]);
                ucf[(sdir * 32 + t) * LRU_UCROW + c] = s1cb + s1w0 * x0 + s1w1 * x1 + s1w2 * x2 + s1w3 * x3;
                x0 = x1; x1 = x2; x2 = x3;
            }
        }
        __syncthreads();
        float hf[2][2][4];
        float Pt[2][2] = {{1.f, 1.f}, {1.f, 1.f}};
#pragma unroll
        for (int dir = 0; dir < 2; ++dir) {
            const bool sec16 = ((g & 1) != 0) != (dir != 0), sec32 = ((g >> 1) != 0) != (dir != 0);
#pragma unroll
            for (int step = 0; step < 2; ++step) {
                const int rt = dir == 0 ? step : 1 - step;
                s16x8 af[2];
#pragma unroll
                for (int s_ = 0; s_ < 2; ++s_) { const LAS float* up = ucf + (dir * 32 + 16 * rt + j16) * LRU_UCROW + kb * 64 + 32 * s_ + 8 * g;
                    const f32x4 u0 = *(const LAS f32x4*)up, u1 = *(const LAS f32x4*)(up + 4);
                    const v4u w = {pg8::cvt_pk_bf16(u0[0], u0[1]), pg8::cvt_pk_bf16(u0[2], u0[3]), pg8::cvt_pk_bf16(u1[0], u1[1]), pg8::cvt_pk_bf16(u1[2], u1[3])};
                    af[s_] = __builtin_bit_cast(s16x8, w); }
#pragma unroll
                for (int n2 = 0; n2 < 2; ++n2) {
                    f32x4 zx = {0.f, 0.f, 0.f, 0.f}, za = {0.f, 0.f, 0.f, 0.f};
#pragma unroll
                    for (int s_ = 0; s_ < 2; ++s_) { zx = __builtin_amdgcn_mfma_f32_16x16x32_bf16(af[s_], wf[dir][0][n2][s_], zx, 0, 0, 0); za = __builtin_amdgcn_mfma_f32_16x16x32_bf16(af[s_], wf[dir][1][n2][s_], za, 0, 0, 0); }
                    const int e = kb * 64 + 16 * (2 * nh + n2) + j16;
                    const LAS float* uo = ucf + (dir * 32 + 16 * rt + 4 * g) * LRU_UCROW + e;
                    float a_[4], b_[4];
#pragma unroll
                    for (int r = 0; r < 4; ++r) {
                        const float u = uo[r * LRU_UCROW];
                        const float gx = sigmoidf_(zx[r] + cbx[dir][n2]), ga = sigmoidf_(za[r] + cba[dir][n2]);
                        const float la = csp[dir][n2] * ga, a = __builtin_amdgcn_exp2f(1.4426950408889634f * la), y = 2.f * la;
                        const float om = y > -0.02f ? -y * (1.f + y * (0.5f + y * 0.16666667f)) : 1.f - a * a;
                        a_[r] = a; b_[r] = __builtin_amdgcn_sqrtf(om) * gx * u;
                    }
                    const float P = (a_[0] * a_[1]) * (a_[2] * a_[3]);
                    const float S = dir == 0 ? ((b_[0] * a_[1] + b_[1]) * a_[2] + b_[2]) * a_[3] + b_[3] : ((b_[3] * a_[2] + b_[2]) * a_[1] + b_[1]) * a_[0] + b_[0];
                    const float Pp = __shfl_xor(P, 16), Sp = __shfl_xor(S, 16);
                    const float e1P = sec16 ? Pp : 1.f, e1S = sec16 ? Sp : 0.f;
                    const float prP = P * Pp, prS = sec16 ? P * Sp + S : Pp * S + Sp;
                    const float Pq = __shfl_xor(prP, 32), Sq = __shfl_xor(prS, 32);
                    const float EP = sec32 ? Pq * e1P : e1P, ES = sec32 ? e1P * Sq + e1S : e1S;
                    const float TP = prP * Pq, TS = sec32 ? prP * Sq + prS : Pq * prS + Sq;
                    if (PASS == 1) {
                        float h = EP * hst[dir][n2] + ES;
                        if (dir == 0) {
#pragma unroll
                            for (int r = 0; r < 4; ++r) { h = a_[r] * h + b_[r]; hf[rt][n2][r] = h; }
                        } else {
                            float hb[4];
#pragma unroll
                            for (int r = 3; r >= 0; --r) { h = a_[r] * h + b_[r]; hb[r] = h; }
                            bf16* mp = WSP(bf16, WS_MIX) + (size_t)(row0 + 16 * rt + 4 * g) * D + 768 + e;
                            const LAS bf16* gp = gts + (16 * rt + 4 * g) * 256 + e;
#pragma unroll
                            for (int r = 0; r < 4; ++r) mp[(size_t)r * D] = (bf16)f2bf(gelu_tanh(bf1(gp[r * 256])) * (hf[rt][n2][r] + hb[r]));
                        }
                    } else Pt[dir][n2] *= TP;
                    hst[dir][n2] = TP * hst[dir][n2] + TS;
                }
            }
        }
        if (PASS == 0 && g == 0) {
#pragma unroll
            for (int dir = 0; dir < 2; ++dir)
#pragma unroll
                for (int n2 = 0; n2 < 2; ++n2) WSP(f32x2, WS_TOT)[((size_t)dir * 1152 + T) * 256 + kb * 64 + 16 * (2 * nh + n2) + j16] = (f32x2){Pt[dir][n2], hst[dir][n2]};
        }
    }
}
__device__ __forceinline__ void lru_carry(Frame& F) {
    const f32x2* TOT = WSP(const f32x2, WS_TOT); float* CARRY = WSP(float, WS_CARRY);
    for (int it = F.gw; it < NB * 2 * 4; it += F.NGW) {
        const int b = it >> 3, dir = (it >> 2) & 1, c = (it & 3) * 64 + F.lane;
        float h = 0.f;
        for (int g = 0; g < 18; ++g) {
            f32x2 ps[4]; int tl[4];
#pragma unroll
            for (int i = 0; i < 4; ++i) { const int s = g * 4 + i;
                int T; if (s < 8) T = 1024 + b * 8 + (dir == 0 ? s : 7 - s); else T = b * 64 + (dir == 0 ? s - 8 : 71 - s);
                tl[i] = T; ps[i] = TOT[((size_t)dir * 1152 + T) * 256 + c]; }
#pragma unroll
            for (int i = 0; i < 4; ++i) { CARRY[((size_t)dir * 1152 + tl[i]) * 256 + c] = h; h = ps[i][0] * h + ps[i][1]; }
        }
    }
}

__device__ __forceinline__ void final_rows(Frame& F) {
    const bf16* XA = WSP(const bf16, WS_XA); const float* RSS = WSP(const float, WS_RSSA);
    for (int row = F.gw; row < ML; row += 2 * F.NGW) {
        const int row2 = row + F.NGW; const bool two = row2 < ML;
        const v4u a0 = *(const v4u*)(XA + (size_t)row * D + 8 * F.lane), a1 = *(const v4u*)(XA + (size_t)row * D + 512 + 8 * F.lane);
        const float p0 = F.lane < 32 ? RSS[(size_t)row * 32 + F.lane] : 0.f;
        v4u b0 = a0, b1 = a1; float p1 = 0.f;
        if (two) { b0 = *(const v4u*)(XA + (size_t)row2 * D + 8 * F.lane); b1 = *(const v4u*)(XA + (size_t)row2 * D + 512 + 8 * F.lane); p1 = F.lane < 32 ? RSS[(size_t)row2 * 32 + F.lane] : 0.f; }
        const float rs0 = rsqrtf(wave_sum(p0) * (1.f / D) + EPS), rs1 = rsqrtf(wave_sum(p1) * (1.f / D) + EPS);
        float* o = F.out + (size_t)row * D + 8 * F.lane;
        *(f32x4*)(o) = (f32x4){bflo(a0.x), bfhi(a0.x), bflo(a0.y), bfhi(a0.y)} * rs0; *(f32x4*)(o + 4) = (f32x4){bflo(a0.z), bfhi(a0.z), bflo(a0.w), bfhi(a0.w)} * rs0;
        *(f32x4*)(o + 512) = (f32x4){bflo(a1.x), bfhi(a1.x), bflo(a1.y), bfhi(a1.y)} * rs0; *(f32x4*)(o + 516) = (f32x4){bflo(a1.z), bfhi(a1.z), bflo(a1.w), bfhi(a1.w)} * rs0;
        if (two) { float* o2 = F.out + (size_t)row2 * D + 8 * F.lane;
            *(f32x4*)(o2) = (f32x4){bflo(b0.x), bfhi(b0.x), bflo(b0.y), bfhi(b0.y)} * rs1; *(f32x4*)(o2 + 4) = (f32x4){bflo(b0.z), bfhi(b0.z), bflo(b0.w), bfhi(b0.w)} * rs1;
            *(f32x4*)(o2 + 512) = (f32x4){bflo(b1.x), bfhi(b1.x), bflo(b1.y), bfhi(b1.y)} * rs1; *(f32x4*)(o2 + 516) = (f32x4){bflo(b1.z), bfhi(b1.z), bflo(b1.w), bfhi(b1.w)} * rs1; }
    }
}

constexpr int N_PHASES = 2 + 7 * DEPTH + 1;
struct Args { const float* in[25]; float* out; unsigned char* ws; int ph_lo, ph_hi; };
static_assert(sizeof(Args) == 27 * 8 + 8, "Args has no padding");

__global__ void __launch_bounds__(NWAVES * 64, 2) mega_fwd(Args args) {
    extern __shared__ __attribute__((aligned(16))) unsigned char lds[];
    Frame F;
    F.lds = (LAS unsigned char*)lds;
    const int wave_s = __builtin_amdgcn_readfirstlane((int)threadIdx.x >> 6);
    F.wave = wave_s; F.lane = (int)__builtin_amdgcn_mbcnt_hi(~0u, __builtin_amdgcn_mbcnt_lo(~0u, 0u)); F.tid = wave_s * 64 + F.lane;
    F.G = gridDim.x; { const int bx = blockIdx.x; F.vcu = (F.G % 8 == 0) ? (bx % 8) * (F.G / 8) + bx / 8 : bx; }
    F.gw = F.vcu * NWAVES + F.wave; F.NGW = F.G * NWAVES;
    F.out = args.out; F.ws = args.ws;
    volatile LAS unsigned* MISC = (volatile LAS unsigned*)(F.lds + MISC_OFF);
    for (int u = F.tid; u < (LDS_BYTES - LDSCTL_OFF) / 4; u += NWAVES * 64) ((LAS unsigned*)(F.lds + LDSCTL_OFF))[u] = 0u;
    __syncthreads();
    if (F.tid == 0) {
#pragma unroll
        for (int i = 0; i < 25; ++i) *(LAS unsigned long long*)(F.lds + PTR_OFF + 8 * i) = (unsigned long long)args.in[i];
    }
    __syncthreads();
    XcdBarrier bar = xcd_barrier_post((unsigned*)(F.ws + WS_CTL) + CW_BAR, MISC + 8, F.tid);

    const int lo = args.ph_lo, hi = args.ph_hi;
#ifdef PROBE_MASK
    bool rep_done = false;
#define PROBE_V ((((PROBE_MASK >> ph) & 1) && !rep_done) ? PROBE_VARIANT : 0)
#else
#define PROBE_V 0
#endif
    for (int ph = lo; ph < hi; ++ph) {
        { unsigned ones_ = ~0u; asm volatile("" : "+s"(ones_));
          int t_ = wave_s * 64 + (int)__builtin_amdgcn_mbcnt_hi(ones_, __builtin_amdgcn_mbcnt_lo(ones_, 0u)); asm volatile("" : "+v"(t_)); F.tid = t_; F.lane = t_ & 63; F.wave = __builtin_amdgcn_readfirstlane(t_ >> 6); F.gw = F.vcu * NWAVES + F.wave; }
        if (ph == 0) {
#ifndef NO_P0
            phase_p0a(F);
#endif
        } else if (ph == 1) {
#ifndef NO_P0
            phase_p0b(F);
#endif
        }
        else if (ph == N_PHASES - 1) final_rows(F);
        else {
            const int l = (ph - 2) / 7, k = (ph - 2) % 7; const bool last = (l == DEPTH - 1);
            const int Mx = last ? ML : MT;
            float* MOD = WSP(float, WS_MOD);
            if (k == 0) {
                pg8::Gemm g{WSP(const bf16, WS_XA), WSP(const bf16, WS_WIN) + (size_t)l * IND * D, MT, IND, D};
                pg8::Order S; if (last) S.init(ML, IND, (MC / 256) * 5, F.G, (int)blockIdx.x); else S.init(MT, IND, 0, F.G, (int)blockIdx.x);
                pg8::EpiScale<0, IND> E{WSP(bf16, WS_PROJ), WSP(const float, WS_SHW1) + (size_t)l * 17 * IND, WSP(const float, WS_RSSA), PROBE_V};

#ifndef NO_G0
                pg8::gemm_phase<pg8::EpiScale<0, IND>, pg8::Order, true, true>(F.lds + RING_OFF, g, S, E, F.tid);
#endif

            } else if (k == 1) {

#ifndef NO_LRU
                lru_phase<0>(F, l, 1152);
#ifdef REP_LRU0
                __syncthreads(); lru_phase<0>(F, l, 1152);
#endif
#endif

                __syncthreads();
#ifndef NO_CONV
                conv_phase(F, l, last ? 1024 : 1152);
                __syncthreads();
#ifdef REP_CONV
                conv_phase(F, l, last ? 1024 : 1152);
                __syncthreads();
#endif
#endif
#ifndef NO_NA
                na_phase(F, l, last ? NA_ITEMS_LAT : NA_ITEMS_LAT + NA_ITEMS_CTX);
#ifdef REP_NA
                na_phase(F, l, last ? NA_ITEMS_LAT : NA_ITEMS_LAT + NA_ITEMS_CTX);
#endif
#endif
            } else if (k == 2) {
                lru_carry(F);
            } else if (k == 3) {

#ifndef NO_LRU
                lru_phase<1>(F, l, last ? 1024 : 1152);
#endif

            } else if (k == 4 || k == 6) {
                const bool dn = (k == 6);
                const int ln = (dn && !last) ? l + 1 : l;
                pg8::Gemm g{dn ? WSP(const bf16, WS_HID) : WSP(const bf16, WS_MIX), dn ? WSP(const bf16, WS_W2) + (size_t)l * D * FF : WSP(const bf16, WS_WOUT) + (size_t)l * D * D, Mx, D, dn ? FF : D};
                pg8::Order S; S.init(Mx, D, 0, F.G, (int)blockIdx.x);
                const bool fromin = (!dn && l == 0);
                const float* go_g = dn ? INP(5) + l * D : INP(4) + l * D;
                const float* go_s = MOD + (size_t)l * 17 * MODW + (dn ? 4 : 1) * D;
                const bool fin = dn && last;
                pg8::EpiRes E{fromin ? INP(0) : (const float*)nullptr, fromin ? INP(2) : (const float*)nullptr, (float*)nullptr,
                              MOD + (size_t)l * 17 * MODW + (dn ? 5 : 2) * D, fin ? INP(24) : (dn ? INP(4) : INP(5)) + ln * D, fin ? WSP(const float, WS_ZERO) : MOD + (size_t)ln * 17 * MODW + (dn ? 1 : 4) * D,
                              go_g, go_s, WSP(bf16, WS_XA), dn ? WSP(float, WS_RSSA) : WSP(float, WS_RSSB), 1};
#ifndef NO_GR
                pg8::gemm_phase<pg8::EpiRes, pg8::Order, true, true>(F.lds + RING_OFF, g, S, E, F.tid);
#endif
            } else if (k == 5) {
                pg8::Gemm g{WSP(const bf16, WS_XA), WSP(const bf16, WS_W1) + (size_t)l * FF * D, Mx, FF, D};
                pg8::Order S; S.init(Mx, FF, 0, F.G, (int)blockIdx.x);
                pg8::EpiScale<1, FF> E{WSP(bf16, WS_HID), WSP(const float, WS_SHW2) + (size_t)l * 17 * FF, WSP(const float, WS_RSSB), PROBE_V};

#ifndef NO_G1
                pg8::gemm_phase<pg8::EpiScale<1, FF>, pg8::Order, true, true>(F.lds + RING_OFF, g, S, E, F.tid);
#endif

            }
        }
#ifdef PROBE_MASK
        if (((PROBE_MASK >> ph) & 1) && !rep_done) { rep_done = true; xcd_barrier(bar, F.tid); --ph; continue; }
        rep_done = false;
#endif
        if (ph + 1 < hi) xcd_barrier(bar, F.tid);
    }
}

extern "C" void kernel_launch(void* const* d_in, const int* in_sizes, int n_in, void* d_out, int out_size, void* d_ws, size_t ws_size, hipStream_t stream) {
    static int grid = 0;
    if (grid == 0) {
        if (n_in != 25 || out_size != ML * D || ws_size < WS_END) { fprintf(stderr, "kernel_launch: unexpected shapes (n_in %d out %d ws %zu)\n", n_in, out_size, ws_size); grid = -1; return; }
        int dev = 0, cus = 0;
        if (hipGetDevice(&dev) != hipSuccess || hipDeviceGetAttribute(&cus, hipDeviceAttributeMultiprocessorCount, dev) != hipSuccess) { grid = -1; return; }
        if (hipFuncSetAttribute((const void*)mega_fwd, hipFuncAttributeMaxDynamicSharedMemorySize, LDS_BYTES) != hipSuccess) { fprintf(stderr, "kernel_launch: hipFuncSetAttribute failed\n"); grid = -1; return; }
        int per_cu = 0;
        if (hipOccupancyMaxActiveBlocksPerMultiprocessor(&per_cu, (const void*)mega_fwd, NWAVES * 64, LDS_BYTES) != hipSuccess || per_cu < 1) fprintf(stderr, "kernel_launch: occupancy query reports %d\n", per_cu);
        (void)hipGetLastError();
        grid = cus;
    }
    if (grid < 0) return;
    if (hipMemsetAsync((char*)d_ws + WS_CTL, 0, CTL_ZERO_BYTES, stream) != hipSuccess) return;
    Args a{};
    for (int i = 0; i < 25; ++i) a.in[i] = (const float*)d_in[i];
    a.out = (float*)d_out; a.ws = (unsigned char*)d_ws;
#if MK_N_LAUNCHES == 1
    a.ph_lo = 0; a.ph_hi = N_PHASES;
    hipLaunchKernelGGL(mega_fwd, dim3(grid), dim3(NWAVES * 64), LDS_BYTES, stream, a);
#else
    for (int ph = 0; ph < N_PHASES; ++ph) { a.ph_lo = ph; a.ph_hi = ph + 1; hipLaunchKernelGGL(mega_fwd, dim3(grid), dim3(NWAVES * 64), LDS_BYTES, stream, a); }
#endif
}
```

```cpp
#include <hip/hip_runtime.h>
#include <cstdio>
#include <cstdint>

constexpr int D = 1024, NB = 16, SEQ = 2048, CTXL = 256, DEPTH = 2;
constexpr int ML = NB * SEQ, MC = NB * CTXL, MT = ML + MC;
constexpr int IND = 2560, FF = 4096, NH = 8, HD = 64;
constexpr int MODW = 6 * D;
constexpr float EPS = 1e-6f;
#ifndef MK_N_LAUNCHES
#define MK_N_LAUNCHES 1
#endif

namespace pg8 {
#define PG8_LAS __attribute__((address_space(3)))
typedef unsigned short bf16_t;
typedef short bf16x8 __attribute__((ext_vector_type(8)));
typedef float f32x4 __attribute__((ext_vector_type(4)));
typedef unsigned u32x4 __attribute__((ext_vector_type(4)));
constexpr int BM = 256, BK = 64, HALF = 128, HTB = HALF * BK * 2, STAGE_BYTES = 8 * HTB, NXCD = 8, WGM = 8;

__host__ __device__ __forceinline__ int lds_byte(int r, int c) { const int st = (r >> 4) * 2 + (c >> 5), rr = r & 15, cc = c & 31, ob = rr * 64 + cc * 2; return st * 1024 + (ob ^ (((ob >> 9) & 1) << 5)); }
__host__ __device__ __forceinline__ void stage_rc(int b, int& R, int& C) { const int st = b / 1024, sb = b % 1024, swz = sb ^ (((sb >> 9) & 1) << 5); R = (st >> 1) * 16 + swz / 64; C = (st & 1) * 32 + (swz % 64) / 2; }
__host__ __device__ __forceinline__ int perm32(int rho) { const int n = rho >> 4, i = rho & 15; return 8 * (i >> 2) + 4 * n + (i & 3); }

struct Unit { int pm, pn; };
struct Gemm { const bf16_t* A; const bf16_t* Bt; int M, N, K; };

__host__ __device__ __forceinline__ void map_tile(int wgid, int nM, int nN, Unit& u) {
    const int nwg = nM * nN;
    { const int q = nwg / NXCD, r = nwg % NXCD, xcd = wgid % NXCD, off = wgid / NXCD; wgid = (xcd < r ? xcd * (q + 1) : r * (q + 1) + (xcd - r) * q) + off; }
    const int nig = WGM * nN, gid = wgid / nig, fm = gid * WGM, gsz = (nM - fm) < WGM ? (nM - fm) : WGM;
    u.pm = fm + ((wgid % nig) % gsz); u.pn = (wgid % nig) / gsz;
}
struct Order {
    int nM, nN, nwg, extra, mode, ntf, G, c;
    __host__ __device__ void init(int M, int N, int K, int extra_, int mode_, int G_, int c_) { nM = M / BM; nN = N / BM; nwg = nM * nN; extra = extra_; mode = mode_; ntf = K / BK; G = G_; c = c_; }
    __host__ __device__ bool next(int i, Unit& u) const {
        const long L = (long)i * G + c;
        if (L < nwg) { map_tile((int)L, nM, nN, u); return true; }
        if (L < nwg + extra) { const int q = (int)L - nwg;
            if (mode == 1) { u.pm = nM + q / 5; u.pn = 4 + q % 5; }
            else { u.pm = nM + (q >> 4); u.pn = 4 + 4 * (q & 3) + ((q >> 2) & 3); }
            return true; }
        return false;
    }
    __device__ __forceinline__ void a_ready(const Unit&) const {}
    __device__ __forceinline__ void done(const Unit&) const {}
};

__device__ __forceinline__ unsigned cvt_pk_bf16(float lo, float hi) { unsigned r; asm volatile("v_cvt_pk_bf16_f32 %0, %1, %2" : "=v"(r) : "v"(lo), "v"(hi)); return r; }

template <int ACT, int LDC> struct EpiScale {
    static constexpr bool PERM = true, AFTER_DRAIN = false;
    bf16_t* O; const float* shw; const float* RSS;
    int probe;
    __device__ __forceinline__ void operator()(const f32x4 (&acc)[2][2][4][2], const Unit& u, int wr, int wc, int fr, int fq) const {
        asm volatile("" : "+s"(wr), "+s"(wc));
        const int brow = u.pm < ML / BM ? (u.pm >> 3) : NB;
        const float* sp = shw + (size_t)brow * LDC + u.pn * BM;
        bf16_t* Ot = O + (size_t)u.pm * BM * LDC + u.pn * BM;
        const float* RSSt = RSS + (size_t)u.pm * BM * 32;
        unsigned cl = (unsigned)(wc * 32 + 8 * fq);
        unsigned rl0 = (unsigned)(wr * 64 + fr);
        asm volatile("" : "+v"(cl), "+v"(rl0));
        f32x4 pa[2][4], pb[2][4], sh[2][2];
#pragma unroll
        for (int ai = 0; ai < 2; ++ai)
#pragma unroll
            for (int m = 0; m < 4; ++m) { const unsigned ro = (rl0 + (unsigned)(ai * HALF + m * 16)) * 32u + 8u * (unsigned)fq;
                if (probe == 2) { pa[ai][m] = acc[ai][0][m][0]; pb[ai][m] = acc[ai][1][m][0]; } else { pa[ai][m] = *(const f32x4*)(RSSt + ro); pb[ai][m] = *(const f32x4*)(RSSt + (ro + 4u)); } }
#pragma unroll
        for (int bj = 0; bj < 2; ++bj) { if (probe == 2) { sh[bj][0] = acc[0][bj][0][1]; sh[bj][1] = acc[1][bj][0][1]; } else { sh[bj][0] = *(const f32x4*)(sp + (cl + (unsigned)(bj * HALF))); sh[bj][1] = *(const f32x4*)(sp + (cl + (unsigned)(bj * HALF + 4))); } }
        float rs[2][4];
#pragma unroll
        for (int ai = 0; ai < 2; ++ai)
#pragma unroll
            for (int m = 0; m < 4; ++m) { const f32x4 p0 = pa[ai][m], p1 = pb[ai][m];
                float s = ((p0[0] + p0[1]) + (p0[2] + p0[3])) + ((p1[0] + p1[1]) + (p1[2] + p1[3]));
                s += __shfl_xor(s, 16); s += __shfl_xor(s, 32);
                rs[ai][m] = rsqrtf(s * (1.0f / D) + EPS); }
#pragma unroll
        for (int bj = 0; bj < 2; ++bj)
#pragma unroll
            for (int ai = 0; ai < 2; ++ai)
#pragma unroll
                for (int m = 0; m < 4; ++m) {
                    f32x4 v0 = acc[ai][bj][m][0] * rs[ai][m] + sh[bj][0], v1 = acc[ai][bj][m][1] * rs[ai][m] + sh[bj][1];
                    if (ACT == 1) {
#pragma unroll
                        for (int e = 0; e < 4; ++e) { const float a = fmaxf(v0[e], 0.f), b = fmaxf(v1[e], 0.f); v0[e] = a * a; v1[e] = b * b; }
                    }
                    u32x4 w; w.x = cvt_pk_bf16(v0[0], v0[1]); w.y = cvt_pk_bf16(v0[2], v0[3]); w.z = cvt_pk_bf16(v1[0], v1[1]); w.w = cvt_pk_bf16(v1[2], v1[3]);
                    if (probe == 0) *(u32x4*)(Ot + ((rl0 + (unsigned)(ai * HALF + m * 16)) * (unsigned)LDC + cl + (unsigned)(bj * HALF))) = w;
                    else asm volatile("" :: "v"(w));
                }
    }
};
struct EpiRes {
    static constexpr bool PERM = true, AFTER_DRAIN = false;
    const float* src_lat; const float* src_ctx;
    float* dst_lat;
    const float* gate;
    const float* gmg; const float* gmsc;
    const float* gmg_o; const float* gmsc_o;
    bf16_t* XA; float* RSS; int hasxa;
    template <int BJ, int AI0, int NAI, int M0, int NM>
    __device__ __forceinline__ void batch(const f32x4 (&acc)[2][2][4][2], const float* src, float* dst, const float* gt, const float* gg, const float* gs, const float* go, const float* gso, bf16_t* XAt, float* RSSt, unsigned cl, unsigned rl0, int fq) const {
        const unsigned c = cl + (unsigned)(BJ * HALF);
        f32x4 x0[NAI][NM], x1[NAI][NM];
        const bool srcf = src != nullptr;
        if (srcf) {
#pragma unroll
            for (int a = 0; a < NAI; ++a)
#pragma unroll
                for (int m = 0; m < NM; ++m) { const unsigned off = (rl0 + (unsigned)((AI0 + a) * HALF + (M0 + m) * 16)) * (unsigned)D + c; x0[a][m] = *(const f32x4*)(src + off); x1[a][m] = *(const f32x4*)(src + (off + 4u)); }
        } else {
            u32x4 xb[NAI][NM];
#pragma unroll
            for (int a = 0; a < NAI; ++a)
#pragma unroll
                for (int m = 0; m < NM; ++m) { const unsigned off = (rl0 + (unsigned)((AI0 + a) * HALF + (M0 + m) * 16)) * (unsigned)D + c; xb[a][m] = *(const u32x4*)(XAt + off); }
            const f32x4 i0 = *(const f32x4*)(go + c) * (*(const f32x4*)(gso + c) + 1.0f), i1 = *(const f32x4*)(go + (c + 4u)) * (*(const f32x4*)(gso + (c + 4u)) + 1.0f);
            f32x4 r0, r1;
#pragma unroll
            for (int e = 0; e < 4; ++e) { r0[e] = __builtin_amdgcn_rcpf(i0[e]); r1[e] = __builtin_amdgcn_rcpf(i1[e]); }
#pragma unroll
            for (int a = 0; a < NAI; ++a)
#pragma unroll
                for (int m = 0; m < NM; ++m) { const u32x4 w = xb[a][m];
                    x0[a][m] = (f32x4){__uint_as_float(w.x << 16), __uint_as_float(w.x & 0xffff0000u), __uint_as_float(w.y << 16), __uint_as_float(w.y & 0xffff0000u)} * r0;
                    x1[a][m] = (f32x4){__uint_as_float(w.z << 16), __uint_as_float(w.z & 0xffff0000u), __uint_as_float(w.w << 16), __uint_as_float(w.w & 0xffff0000u)} * r1; }
        }
        const f32x4 g0 = *(const f32x4*)(gt + c), g1 = *(const f32x4*)(gt + (c + 4u));
        f32x4 m0 = {0.f, 0.f, 0.f, 0.f}, m1 = {0.f, 0.f, 0.f, 0.f};
        if (hasxa) { m0 = *(const f32x4*)(gg + c) * (*(const f32x4*)(gs + c) + 1.0f); m1 = *(const f32x4*)(gg + (c + 4u)) * (*(const f32x4*)(gs + (c + 4u)) + 1.0f); }
        asm volatile("" ::: "memory");
#pragma unroll
        for (int a = 0; a < NAI; ++a)
#pragma unroll
            for (int m = 0; m < NM; ++m) {
                const unsigned rl = rl0 + (unsigned)((AI0 + a) * HALF + (M0 + m) * 16);
                const unsigned off = rl * (unsigned)D + c;
                const f32x4 y0 = x0[a][m] + g0 * acc[AI0 + a][BJ][M0 + m][0], y1 = x1[a][m] + g1 * acc[AI0 + a][BJ][M0 + m][1];
                if (dst) { *(f32x4*)(dst + off) = y0; *(f32x4*)(dst + (off + 4u)) = y1; }
                float ss = ((y0[0] * y0[0] + y0[1] * y0[1]) + (y0[2] * y0[2] + y0[3] * y0[3])) + ((y1[0] * y1[0] + y1[1] * y1[1]) + (y1[2] * y1[2] + y1[3] * y1[3]));
                ss += __shfl_xor(ss, 16); ss += __shfl_xor(ss, 32);
                if (fq == 0) RSSt[rl * 32u + (unsigned)(BJ * 4)] = ss;
                if (hasxa) { const f32x4 a0 = y0 * m0, a1 = y1 * m1;
                    u32x4 w; w.x = cvt_pk_bf16(a0[0], a0[1]); w.y = cvt_pk_bf16(a0[2], a0[3]); w.z = cvt_pk_bf16(a1[0], a1[1]); w.w = cvt_pk_bf16(a1[2], a1[3]);
                    *(u32x4*)(XAt + off) = w; }
            }
        asm volatile("" ::: "memory");
    }
    __device__ __forceinline__ void operator()(const f32x4 (&acc)[2][2][4][2], const Unit& u, int wr, int wc, int fr, int fq) const {
        asm volatile("" : "+s"(wr), "+s"(wc));
        const bool lat = u.pm < ML / BM;
        const int brow = lat ? (u.pm >> 3) : NB;
        const float* src = src_lat ? (lat ? src_lat + (size_t)u.pm * BM * D : src_ctx + (size_t)(u.pm - ML / BM) * BM * D) + u.pn * BM : nullptr;
        float* dst = (dst_lat && lat) ? dst_lat + (size_t)u.pm * BM * D + u.pn * BM : nullptr;
        const float* gt = gate + (size_t)brow * MODW + u.pn * BM;
        const float* gg = gmg + u.pn * BM;
        const float* gs = gmsc + (size_t)brow * MODW + u.pn * BM;
        const float* go = gmg_o + u.pn * BM;
        const float* gso = gmsc_o + (size_t)brow * MODW + u.pn * BM;
        bf16_t* XAt = XA + (size_t)u.pm * BM * D + u.pn * BM;
        float* RSSt = RSS + (size_t)u.pm * BM * 32 + u.pn * 8 + wc;
        unsigned cl = (unsigned)(wc * 32 + 8 * fq);
        unsigned rl0 = (unsigned)(wr * 64 + fr);
        asm volatile("" : "+v"(cl), "+v"(rl0));
        batch<0, 0, 1, 0, 2>(acc, src, dst, gt, gg, gs, go, gso, XAt, RSSt, cl, rl0, fq);
        batch<0, 0, 1, 2, 2>(acc, src, dst, gt, gg, gs, go, gso, XAt, RSSt, cl, rl0, fq);
        batch<0, 1, 1, 0, 4>(acc, src, dst, gt, gg, gs, go, gso, XAt, RSSt, cl, rl0, fq);
        batch<1, 0, 2, 0, 4>(acc, src, dst, gt, gg, gs, go, gso, XAt, RSSt, cl, rl0, fq);
    }
};

struct EpiSlab {
    static constexpr bool PERM = true, AFTER_DRAIN = false;
    float* P; const float* gate;
    __device__ __forceinline__ void operator()(const f32x4 (&acc)[2][2][4][2], const Unit& u, int wr, int wc, int fr, int fq) const {
        asm volatile("" : "+s"(wr), "+s"(wc));
        const int ks = (u.pn - 4) >> 2, pn = u.pn & 3;
        float* At = P + ((size_t)ks * MC + (size_t)(u.pm - ML / BM) * BM) * D + pn * BM;
        const float* gtq = gate + pn * BM;
        unsigned cl = (unsigned)(wc * 32 + 8 * fq), rl0 = (unsigned)(wr * 64 + fr);
        asm volatile("" : "+v"(cl), "+v"(rl0));
#pragma unroll
        for (int bj = 0; bj < 2; ++bj) { const unsigned c = cl + (unsigned)(bj * HALF);
            const f32x4 g0 = *(const f32x4*)(gtq + c), g1 = *(const f32x4*)(gtq + (c + 4u));
#pragma unroll
            for (int ai = 0; ai < 2; ++ai)
#pragma unroll
                for (int m = 0; m < 4; ++m) { const unsigned off = (rl0 + (unsigned)(ai * HALF + m * 16)) * (unsigned)D + c;
                    *(f32x4*)(At + off) = g0 * acc[ai][bj][m][0]; *(f32x4*)(At + (off + 4u)) = g1 * acc[ai][bj][m][1]; } }
    }
};

template <class Epi, class Sched, bool ALIGN_EPI = false, bool SP2 = false, bool VARK = false>
__device__ __forceinline__ void gemm_phase(PG8_LAS unsigned char* lds, const Gemm g, const Sched& S, const Epi& E, const int tid) {
    const int wid = __builtin_amdgcn_readfirstlane(tid >> 6), lane = tid & 63, wr = wid >> 2, wc = wid & 3, fr = lane & 15, fq = lane >> 4;
    const int K = g.K;
    unsigned voffA[2], voffB[2];
#pragma unroll
    for (int i = 0; i < 2; ++i) { int R, C; stage_rc(tid * 16 + i * 8192, R, C); const int Rb = Epi::PERM ? ((R & ~31) + perm32(R & 31)) : R;
        voffA[i] = (unsigned)(R * K + C) * 2u; voffB[i] = (unsigned)(Rb * K + C) * 2u; }
    const size_t kstep = (size_t)(BK * 2);
    const size_t hstep = (size_t)HALF * K * 2;
    const size_t tstep = 2 * hstep;
    const unsigned ldsw = (unsigned)wid * 1024u;
    const int aoff = lds_byte(wr * 64 + fr, fq * 8), boff = lds_byte(wc * 32 + fr, fq * 8);
#define PG8_SA(b, h) (((b) * 2 + (h)) * HTB)
#define PG8_SB(b, h) ((4 + (b) * 2 + (h)) * HTB)
#define PG8_STAGE(bufoff, gbase, voff) do { _Pragma("unroll") for (int _i = 0; _i < 2; ++_i) \
        __builtin_amdgcn_global_load_lds((const unsigned*)((const char*)(gbase) + (voff)[_i]), (PG8_LAS unsigned*)(lds + (bufoff) + ldsw + _i * 8192), 16, 0, 0); } while (0)
#define PG8_LDA(dst, b, h) do { _Pragma("unroll") for (int m = 0; m < 4; ++m) _Pragma("unroll") for (int k = 0; k < 2; ++k) dst[m][k] = *(const PG8_LAS bf16x8*)(lds + PG8_SA(b, h) + aoff + m * 2048 + k * 1024); } while (0)
#define PG8_LDB(dst, b, h) do { _Pragma("unroll") for (int n = 0; n < 2; ++n) _Pragma("unroll") for (int k = 0; k < 2; ++k) dst[n][k] = *(const PG8_LAS bf16x8*)(lds + PG8_SB(b, h) + boff + n * 2048 + k * 1024); } while (0)
#define PG8_MMA(ai, bj, At, Bt) do { __builtin_amdgcn_s_setprio(1); _Pragma("unroll") for (int m = 0; m < 4; ++m) _Pragma("unroll") for (int n = 0; n < 2; ++n) _Pragma("unroll") for (int k = 0; k < 2; ++k) \
        acc[ai][bj][m][n] = __builtin_amdgcn_mfma_f32_16x16x32_bf16(Bt[n][k], At[m][k], acc[ai][bj][m][n], 0, 0, 0); __builtin_amdgcn_s_setprio(0); } while (0)
#define PG8_WAIT_V(n) asm volatile("s_waitcnt vmcnt(" #n ")" ::: "memory")
#define PG8_WAIT_L(n) asm volatile("s_waitcnt lgkmcnt(" #n ")" ::: "memory")
#define PG8_BAR __builtin_amdgcn_s_barrier()
#define PG8_SCHED __builtin_amdgcn_sched_barrier(0)
    Unit cur, nxt; int ui = 0;
    if (!S.next(0, cur)) return;
    cur.pm = __builtin_amdgcn_readfirstlane(cur.pm); cur.pn = __builtin_amdgcn_readfirstlane(cur.pn);
    f32x4 acc[2][2][4][2];
#pragma unroll
    for (int a = 0; a < 2; ++a)
#pragma unroll
        for (int b = 0; b < 2; ++b)
#pragma unroll
            for (int m = 0; m < 4; ++m)
#pragma unroll
                for (int n = 0; n < 2; ++n) acc[a][b][m][n] = (f32x4){0.f, 0.f, 0.f, 0.f};
    bf16x8 At[4][2], B0[2][2], B1[2][2];
#define PG8_KOFF(u) ((VARK && (u).pn >= 4) ? (size_t)(((u).pn - 4) >> 2) * (size_t)(K / 4) * 2 : (size_t)0)
#define PG8_PN(u) ((VARK && (u).pn >= 4) ? ((u).pn & 3) : (u).pn)
    const char* cA = (const char*)g.A + (size_t)cur.pm * tstep + PG8_KOFF(cur); const char* cB = (const char*)g.Bt + (size_t)PG8_PN(cur) * tstep + PG8_KOFF(cur);
    S.a_ready(cur);
    if constexpr (SP2) {
        PG8_STAGE(PG8_SB(0, 0), cB, voffB); PG8_STAGE(PG8_SB(0, 1), cB + hstep, voffB); PG8_STAGE(PG8_SA(0, 0), cA, voffA); PG8_STAGE(PG8_SA(0, 1), cA + hstep, voffA);
        if (wr == 1) PG8_BAR;
        PG8_WAIT_V(2); PG8_BAR;
        PG8_STAGE(PG8_SB(1, 0), cB + kstep, voffB); PG8_STAGE(PG8_SA(1, 0), cA + kstep, voffA); PG8_STAGE(PG8_SB(1, 1), cB + hstep + kstep, voffB);
        PG8_WAIT_V(6); PG8_BAR;
    } else {
        PG8_STAGE(PG8_SB(0, 0), cB, voffB); PG8_STAGE(PG8_SA(0, 0), cA, voffA); PG8_STAGE(PG8_SB(0, 1), cB + hstep, voffB); PG8_STAGE(PG8_SA(0, 1), cA + hstep, voffA);
        if (wr == 1) PG8_BAR;
        PG8_WAIT_V(4); PG8_BAR;
        PG8_STAGE(PG8_SB(1, 0), cB + kstep, voffB); PG8_STAGE(PG8_SA(1, 0), cA + kstep, voffA); PG8_STAGE(PG8_SB(1, 1), cB + hstep + kstep, voffB);
        PG8_WAIT_V(6); PG8_BAR;
    }
    for (;;) {
        const bool has_next = S.next(ui + 1, nxt);
        nxt.pm = __builtin_amdgcn_readfirstlane(nxt.pm); nxt.pn = __builtin_amdgcn_readfirstlane(nxt.pn);
        const char* nA = has_next ? (const char*)g.A + (size_t)nxt.pm * tstep + PG8_KOFF(nxt) : cA; const char* nB = has_next ? (const char*)g.Bt + (size_t)PG8_PN(nxt) * tstep + PG8_KOFF(nxt) : cB;
        const int nt = (VARK && cur.pn >= 4) ? K / BK / 4 : K / BK;
        for (int t = 0; t < nt; t += 2) {
            const bool last = (t == nt - 2);
            const char* a1 = cA + (size_t)(t + 1) * kstep;
            const char* a2 = last ? nA : cA + (size_t)(t + 2) * kstep; const char* b2 = last ? nB : cB + (size_t)(t + 2) * kstep;
            const char* a3 = a2 + kstep; const char* b3 = b2 + kstep;
            if (last && has_next) S.a_ready(nxt);
            if constexpr (SP2) {
            PG8_LDB(B0, 0, 0); PG8_LDB(B1, 0, 1); PG8_SCHED; PG8_LDA(At, 0, 0); PG8_STAGE(PG8_SA(1, 1), a1 + hstep, voffA);
            PG8_WAIT_V(8); PG8_WAIT_L(0); PG8_BAR; PG8_MMA(0, 0, At, B0); PG8_MMA(0, 1, At, B1); PG8_BAR; PG8_SCHED;
            PG8_LDA(At, 0, 1); PG8_STAGE(PG8_SB(0, 0), b2, voffB); PG8_STAGE(PG8_SB(0, 1), b2 + hstep, voffB); PG8_STAGE(PG8_SA(0, 0), a2, voffA);
            PG8_WAIT_V(8); PG8_WAIT_L(0); PG8_BAR; PG8_MMA(1, 0, At, B0); PG8_MMA(1, 1, At, B1); PG8_BAR; PG8_SCHED;
            PG8_LDB(B0, 1, 0); PG8_LDB(B1, 1, 1); PG8_SCHED; PG8_LDA(At, 1, 0); PG8_STAGE(PG8_SA(0, 1), a2 + hstep, voffA);
            PG8_WAIT_V(8); PG8_WAIT_L(0); PG8_BAR; PG8_MMA(0, 0, At, B0); PG8_MMA(0, 1, At, B1); PG8_BAR; PG8_SCHED;
            PG8_LDA(At, 1, 1); PG8_STAGE(PG8_SB(1, 0), b3, voffB); PG8_STAGE(PG8_SB(1, 1), b3 + hstep, voffB); PG8_STAGE(PG8_SA(1, 0), a3, voffA);
            PG8_WAIT_V(8); PG8_WAIT_L(0); PG8_BAR; PG8_MMA(1, 0, At, B0); PG8_MMA(1, 1, At, B1); PG8_BAR; PG8_SCHED;
            } else {
            PG8_LDB(B0, 0, 0); PG8_SCHED; PG8_LDA(At, 0, 0); PG8_STAGE(PG8_SA(1, 1), a1 + hstep, voffA);
            PG8_WAIT_L(8); PG8_BAR; PG8_WAIT_L(0); PG8_MMA(0, 0, At, B0); PG8_BAR; PG8_SCHED;
            PG8_LDB(B1, 0, 1); PG8_STAGE(PG8_SB(0, 0), b2, voffB);
            PG8_BAR; PG8_WAIT_L(0); PG8_MMA(0, 1, At, B1); PG8_BAR;
            PG8_LDA(At, 0, 1); PG8_STAGE(PG8_SA(0, 0), a2, voffA);
            PG8_BAR; PG8_WAIT_L(0); PG8_MMA(1, 0, At, B0); PG8_BAR; PG8_SCHED;
            PG8_STAGE(PG8_SB(0, 1), b2 + hstep, voffB);
            PG8_WAIT_V(6); PG8_BAR; PG8_MMA(1, 1, At, B1); PG8_BAR;
            PG8_LDB(B0, 1, 0); PG8_SCHED; PG8_LDA(At, 1, 0); PG8_STAGE(PG8_SA(0, 1), a2 + hstep, voffA);
            PG8_WAIT_L(8); PG8_BAR; PG8_WAIT_L(0); PG8_MMA(0, 0, At, B0); PG8_BAR; PG8_SCHED;
            PG8_LDB(B1, 1, 1); PG8_STAGE(PG8_SB(1, 0), b3, voffB);
            PG8_BAR; PG8_WAIT_L(0); PG8_MMA(0, 1, At, B1); PG8_BAR;
            PG8_LDA(At, 1, 1); PG8_STAGE(PG8_SA(1, 0), a3, voffA);
            PG8_BAR; PG8_WAIT_L(0); PG8_MMA(1, 0, At, B0); PG8_BAR; PG8_SCHED;
            PG8_STAGE(PG8_SB(1, 1), b3 + hstep, voffB);
            PG8_WAIT_V(6); PG8_BAR; PG8_MMA(1, 1, At, B1); PG8_BAR;
            }
        }
        if constexpr (ALIGN_EPI) { if (wr == 0) PG8_BAR; }
        if constexpr (!Epi::AFTER_DRAIN) { E(acc, cur, wr, wc, fr, fq); S.done(cur); }
        if (!has_next) break;
#pragma unroll
        for (int a = 0; a < 2; ++a)
#pragma unroll
            for (int b = 0; b < 2; ++b)
#pragma unroll
                for (int m = 0; m < 4; ++m)
#pragma unroll
                    for (int n = 0; n < 2; ++n) acc[a][b][m][n] = (f32x4){0.f, 0.f, 0.f, 0.f};
        cur = nxt; cA = nA; cB = nB; ++ui;
        if constexpr (ALIGN_EPI) { if (wr == 1) PG8_BAR; }
    }
    PG8_WAIT_V(0);
    if constexpr (!ALIGN_EPI) { if (wr == 0) PG8_BAR; }
    PG8_BAR;
    if constexpr (Epi::AFTER_DRAIN) { E.fused(acc, cur, wr, wc, fr, fq, lds, wid, lane); S.done(cur); }
#undef PG8_KOFF
#undef PG8_PN
#undef PG8_SA
#undef PG8_SB
#undef PG8_STAGE
#undef PG8_LDA
#undef PG8_LDB
#undef PG8_MMA
#undef PG8_WAIT_V
#undef PG8_WAIT_L
#undef PG8_BAR
#undef PG8_SCHED
}
}

constexpr size_t MiB = 1u << 20;
constexpr size_t WS_CTL = 0, CTL_ZERO_BYTES = 1 * MiB;
constexpr size_t WS_MOD = 1 * MiB;
constexpr size_t WS_SHW1 = 2 * MiB;
constexpr size_t WS_SHW2 = 3 * MiB;
constexpr size_t WS_RSSA = 4 * MiB;
constexpr size_t WS_RSSB = 9 * MiB;
constexpr size_t WS_TOT = 14 * MiB;
constexpr size_t WS_CARRY = 19 * MiB;
constexpr size_t WS_WLR = 21 * MiB + 512 * 1024;
constexpr size_t WS_WIN = 22 * MiB;
constexpr size_t WS_WOUT = 32 * MiB;
constexpr size_t WS_W1 = 36 * MiB;
constexpr size_t WS_W2 = 52 * MiB;
constexpr size_t WS_CX = 68 * MiB;
constexpr size_t WS_XA = 84 * MiB;
constexpr size_t WS_HID = 156 * MiB;
constexpr size_t WS_PROJ = WS_HID;
constexpr size_t WS_MIX = WS_HID + 180 * MiB;
constexpr size_t WS_PART = 444 * MiB;
constexpr size_t WS_END = 508 * MiB;
static_assert(WS_MIX + (size_t)MT * D * 2 <= WS_PART && WS_HID + (size_t)MT * FF * 2 == WS_PART && WS_PART + (size_t)4 * MC * D * 4 == WS_END, "ws map");
constexpr size_t WS_ZERO = WS_CTL + 512 * 1024;
constexpr int CW_BAR = 4096;

constexpr int NWAVES = 8;
constexpr int RING_OFF = 0, RING_BYTES = 131072;
constexpr int LDSCTL_OFF = RING_BYTES, MISC_OFF = LDSCTL_OFF + 320;
constexpr int LDS_BYTES = 147456;

#define GAS __attribute__((address_space(1)))
#define LAS __attribute__((address_space(3)))
typedef unsigned short bf16;
typedef unsigned v4u __attribute__((ext_vector_type(4)));
typedef unsigned v2u __attribute__((ext_vector_type(2)));
typedef float f32x4 __attribute__((ext_vector_type(4)));
typedef float f32x2 __attribute__((ext_vector_type(2)));
typedef GAS unsigned gu32;
#define LDS_WAIT() asm volatile("s_waitcnt lgkmcnt(0)" ::: "memory")
#define VM_WAIT() asm volatile("s_waitcnt vmcnt(0)" ::: "memory")
__device__ __forceinline__ unsigned f2bf(float f) { unsigned u = __builtin_bit_cast(unsigned, f); return (u + 0x7fffu + ((u >> 16) & 1u)) >> 16; }
__device__ __forceinline__ unsigned pk2(float lo, float hi) { return f2bf(lo) | (f2bf(hi) << 16); }
__device__ __forceinline__ float bflo(unsigned w) { return __uint_as_float(w << 16); }
__device__ __forceinline__ float bfhi(unsigned w) { return __uint_as_float(w & 0xffff0000u); }
__device__ __forceinline__ float bf1(bf16 v) { return __uint_as_float((unsigned)v << 16); }
__device__ __forceinline__ float sigmoidf_(float x) { return __builtin_amdgcn_rcpf(1.f + __builtin_amdgcn_exp2f(-1.4426950408889634f * x)); }
__device__ __forceinline__ float siluf_(float x) { return x * sigmoidf_(x); }
__device__ __forceinline__ float gelu_tanh(float x) { const float u = 0.7978845608028654f * (x + 0.044715f * x * x * x); return x * sigmoidf_(2.f * u); }
__device__ __forceinline__ float wave_sum(float v) {
#pragma unroll
    for (int o = 1; o < 64; o <<= 1) v += __shfl_xor(v, o);
    return v;
}

#define XB_TMO      128
#define XB_XCNT(j)  (256  + 64 * (j))
#define XB_XSUB(j)  (1280 + 64 * (j))
#define XB_XGEN(j)  (2304 + 64 * (j))
#define XB_TOP      3328
#define XB_TOPGEN   3392
#define XCD_BAR_WORDS 3456
#define XB_SPIN_CAP (1u << 18)

__device__ __forceinline__ unsigned xb_ld(unsigned* p)              { return __hip_atomic_load(p, __ATOMIC_RELAXED, __HIP_MEMORY_SCOPE_AGENT); }
__device__ __forceinline__ unsigned xb_add(unsigned* p, unsigned v) { return __hip_atomic_fetch_add(p, v, __ATOMIC_RELAXED, __HIP_MEMORY_SCOPE_AGENT); }
__device__ __forceinline__ unsigned xb_xcc_id() { return (unsigned)__builtin_amdgcn_s_getreg((3 << 11) | 20) & 0xFu; }
#define XB_SPIN(cond, bar) do { unsigned _sp = 0; while (cond) { __builtin_amdgcn_s_sleep(1); \
    if ((++_sp & 255u) == 0u) { if (xb_ld(&(bar)[XB_TMO])) break; if (_sp > XB_SPIN_CAP) { atomicAdd(&(bar)[XB_TMO], 1u); break; } } } } while (0)

struct XcdBarrier {
    unsigned* bar; unsigned x;
    volatile LAS unsigned* st;
};

__device__ __forceinline__ XcdBarrier xcd_barrier_post(unsigned* bar, volatile LAS unsigned* st, int tid) {
    XcdBarrier b; b.bar = bar; b.x = xb_xcc_id(); b.st = st;
    if (tid == 0) (void)xb_add(&bar[XB_XCNT(b.x)], 1u);
    return b;
}
__device__ __forceinline__ void xcd_barrier_complete(unsigned* bar, unsigned x, unsigned& nloc, unsigned& nx) {
    const unsigned G = gridDim.x * gridDim.y * gridDim.z;
    unsigned sum, cnt, mine, sp = 0u;
    for (;;) {
        sum = 0u; cnt = 0u; mine = 0u;
#pragma unroll 1
        for (unsigned j = 0; j < 16; ++j) { const unsigned c = xb_ld(&bar[XB_XCNT(j)]); sum += c; cnt += (c > 0u) ? 1u : 0u; mine = (j == x) ? c : mine; }
        if (sum == G) break;
        __builtin_amdgcn_s_sleep(1);
        if ((++sp & 255u) == 0u) { if (xb_ld(&bar[XB_TMO])) break; if (sp > XB_SPIN_CAP) { atomicAdd(&bar[XB_TMO], 1u); break; } }
    }
    nloc = mine > 0u ? mine : 1u; nx = cnt > 0u ? cnt : 1u;
}

__device__ __forceinline__ void xcd_barrier(const XcdBarrier& b, int tid) {
    asm volatile("s_waitcnt vmcnt(0)" ::: "memory");
    __syncthreads();
    if (tid == 0) {
        unsigned* bar = b.bar;
        __builtin_amdgcn_s_waitcnt(0);
        unsigned nloc = b.st[0], nx = b.st[1];
        if (nloc == 0u) { xcd_barrier_complete(bar, b.x, nloc, nx); b.st[0] = nloc; b.st[1] = nx; }
        const unsigned old = xb_add(&bar[XB_XSUB(b.x)], 1u);
        const unsigned gen = old / nloc;
        if (old + 1u == (gen + 1u) * nloc) {
            __builtin_amdgcn_fence(__ATOMIC_RELEASE, "agent");
            asm volatile("s_waitcnt vmcnt(0)" ::: "memory");
            const unsigned og = xb_add(&bar[XB_TOP], 1u);
            const unsigned tg = og / nx;
            if (og + 1u == (tg + 1u) * nx) xb_add(&bar[XB_TOPGEN], 1u);
            else XB_SPIN(xb_ld(&bar[XB_TOPGEN]) == tg, bar);
            __builtin_amdgcn_fence(__ATOMIC_ACQUIRE, "agent");
            xb_add(&bar[XB_XGEN(b.x)], 1u);
            asm volatile("s_waitcnt vmcnt(0)" ::: "memory");
        } else {
            XB_SPIN(xb_ld(&bar[XB_XGEN(b.x)]) == gen, bar);
            __builtin_amdgcn_fence(__ATOMIC_ACQUIRE, "agent");
            asm volatile("s_waitcnt vmcnt(0)" ::: "memory");
        }
    }
    __syncthreads();
}

struct Frame {
    LAS unsigned char* lds;
    int tid, lane, wave;
    int vcu, G;
    int gw, NGW;
    float* out; unsigned char* ws;
};
constexpr int PTR_OFF = LDSCTL_OFF + 512;
__device__ __forceinline__ const float* inp_(LAS unsigned char* lds, int i) {
    const unsigned long long v = *(const LAS unsigned long long*)(lds + PTR_OFF + 8 * i);
    const unsigned lo = __builtin_amdgcn_readfirstlane((unsigned)v), hi = __builtin_amdgcn_readfirstlane((unsigned)(v >> 32));
    return (const float*)(((unsigned long long)hi << 32) | lo);
}
#define INP(i) inp_(F.lds, (i))
#define WSP(T, off) ((T*)(F.ws + (off)))

__device__ __forceinline__ void gemv17_item(Frame& F, const LAS float* tab, LAS float* red, const float* W, int ldw, int n0, const float* bias, float* outp, int ldo) {
    float acc[17];
#pragma unroll
    for (int r = 0; r < 17; ++r) acc[r] = 0.f;
    const int k0 = F.wave * 128;
    const float* wp = W + (size_t)k0 * ldw + n0 + F.lane;
#pragma unroll 1
    for (int kk = 0; kk < 128; kk += 32) {
        float wv[32];
#pragma unroll
        for (int k = 0; k < 32; ++k) wv[k] = wp[(size_t)(kk + k) * ldw];
#pragma unroll
        for (int k = 0; k < 32; ++k) {
#pragma unroll
            for (int r = 0; r < 17; ++r) acc[r] += tab[r * 1024 + k0 + kk + k] * wv[k];
        }
    }
#pragma unroll
    for (int r = 0; r < 17; ++r) red[(F.wave * 17 + r) * 64 + F.lane] = acc[r];
    __syncthreads();
    for (int i = F.tid; i < 17 * 64; i += NWAVES * 64) {
        const int r = i >> 6, n = i & 63; float s = bias ? bias[n0 + n] : 0.f;
#pragma unroll
        for (int w = 0; w < 8; ++w) s += red[(w * 17 + r) * 64 + n];
        outp[(size_t)r * ldo + n0 + n] = s;
    }
    __syncthreads();
}

__device__ __forceinline__ void p0_transpose_item(const float* W, int K, int N, bf16* WT, LAS float* scr, int item, int lane) {
    const int nblk = N / 32, kb = item / nblk, nb = item % nblk, k0 = 64 * kb, n0 = 32 * nb;
    float tv[32];
#pragma unroll
    for (int i = 0; i < 32; ++i) { const int kk = 2 * i + (lane >> 5); tv[i] = W[(size_t)(k0 + kk) * N + n0 + (lane & 31)]; }
#pragma unroll
    for (int i = 0; i < 32; ++i) { const int kk = 2 * i + (lane >> 5); scr[kk * 33 + (lane & 31)] = tv[i]; }
    LDS_WAIT(); asm volatile("" ::: "memory");
    const int c = lane & 7;
#pragma unroll
    for (int j = 0; j < 4; ++j) { const int n = (lane >> 3) + 8 * j; const LAS float* s = scr + (8 * c) * 33 + n;
        v4u o; o.x = pk2(s[0 * 33], s[1 * 33]); o.y = pk2(s[2 * 33], s[3 * 33]); o.z = pk2(s[4 * 33], s[5 * 33]); o.w = pk2(s[6 * 33], s[7 * 33]);
        *(GAS v4u*)(WT + (size_t)(n0 + n) * K + k0 + 8 * c) = o; }
    LDS_WAIT(); asm volatile("" ::: "memory");
}

__device__ __forceinline__ void phase_p0a(Frame& F) {
    LAS float* tab = (LAS float*)(F.lds);
    LAS float* red = (LAS float*)(F.lds + 17 * 1024 * 4);
    float* MOD = WSP(float, WS_MOD);
    bool filled = false;
    for (int it = F.vcu; it < 2 * 96; it += F.G) {
        if (!filled) {
            for (int i = F.tid; i < 17 * 1024; i += NWAVES * 64) { const int r = i >> 10, k = i & 1023; const float v = (r < 16) ? INP(1)[r * D + k] : INP(3)[k]; tab[i] = siluf_(v); }
            __syncthreads(); filled = true;
        }
        const int l = it / 96, n0 = (it % 96) * 64;
        gemv17_item(F, tab, red, INP(6) + (size_t)l * D * MODW, MODW, n0, INP(7) + (size_t)l * MODW, MOD + (size_t)l * 17 * MODW, MODW);
    }
    __syncthreads();
    {
        bf16* WLR = WSP(bf16, WS_WLR);
        for (int i = F.gw * 64 + F.lane; i < 2 * 2 * 4 * 2 * 4096; i += F.NGW * 64) { const int d = i & 63, e = (i >> 6) & 63, gt = (i >> 12) & 1, blk = i >> 13;
            const float* src = gt == 0 ? INP(17) : INP(19); WLR[i] = (bf16)f2bf(src[((size_t)blk * 64 + d) * 64 + e]); }
    }
    LAS float* scr = (LAS float*)(F.lds + F.wave * 16384);
    constexpr int I_IN = (D / 64) * (IND / 32), I_OUT = (D / 64) * (D / 32), I_1 = (D / 64) * (FF / 32), I_2 = (FF / 64) * (D / 32), I_L = I_IN + I_OUT + I_1 + I_2;
    for (int it = F.gw; it < 2 * I_L; it += F.NGW) {
        const int l = it / I_L; int r = it % I_L;
        const float* W; bf16* WT; int K = D, N;
        if (r < I_IN) { W = INP(8) + (size_t)l * D * IND; WT = WSP(bf16, WS_WIN) + (size_t)l * IND * D; N = IND; }
        else if (r < I_IN + I_OUT) { r -= I_IN; W = INP(9) + (size_t)l * D * D; WT = WSP(bf16, WS_WOUT) + (size_t)l * D * D; N = D; }
        else if (r < I_IN + I_OUT + I_1) { r -= I_IN + I_OUT; W = INP(22) + (size_t)l * D * FF; WT = WSP(bf16, WS_W1) + (size_t)l * FF * D; N = FF; }
        else { r -= I_IN + I_OUT + I_1; W = INP(23) + (size_t)l * FF * D; WT = WSP(bf16, WS_W2) + (size_t)l * D * FF; K = FF; N = D; }
        p0_transpose_item(W, K, N, WT, scr, r, F.lane);
    }
}

__device__ __forceinline__ void phase_p0b(Frame& F) {
    LAS float* tab = (LAS float*)(F.lds);
    LAS float* red = (LAS float*)(F.lds + 17 * 1024 * 4);
    const float* MOD = WSP(const float, WS_MOD);
    for (int it = F.vcu; it < 2 * 104; it += F.G) {
        const int l = it / 104, j = it % 104; const bool first = j < 40;
        const int shoff = first ? 0 : 3 * D;
        __syncthreads();
        for (int i = F.tid; i < 17 * 1024; i += NWAVES * 64) { const int r = i >> 10, k = i & 1023; tab[i] = MOD[((size_t)l * 17 + r) * MODW + shoff + k]; }
        __syncthreads();
        const int ldw = first ? IND : FF;
        gemv17_item(F, tab, red, first ? INP(8) + (size_t)l * D * IND : INP(22) + (size_t)l * D * FF, ldw, (first ? j : j - 40) * 64, nullptr,
                    first ? WSP(float, WS_SHW1) + (size_t)l * 17 * IND : WSP(float, WS_SHW2) + (size_t)l * 17 * FF, ldw);
    }
    bf16* XA = WSP(bf16, WS_XA); float* RSSA = WSP(float, WS_RSSA);
    const float* g1 = INP(4);
    for (int row = F.gw; row < MT; row += 2 * F.NGW) {
        f32x4 v[2][4]; float ss[2]; int rw[2]; const float* scp[2];
#pragma unroll
        for (int q = 0; q < 2; ++q) { int r_ = row + q * F.NGW; if (r_ >= MT) r_ = row; rw[q] = r_;
            const bool lat = r_ < ML;
            const float* xr = lat ? INP(0) + (size_t)r_ * D : INP(2) + (size_t)(r_ - ML) * D;
            scp[q] = MOD + (size_t)(lat ? (r_ >> 11) : NB) * MODW + D;
#pragma unroll
            for (int j = 0; j < 4; ++j) v[q][j] = *(const f32x4*)(xr + 4 * F.lane + 256 * j); }
#pragma unroll
        for (int q = 0; q < 2; ++q) { float s_ = 0.f;
#pragma unroll
            for (int j = 0; j < 4; ++j) s_ += (v[q][j][0] * v[q][j][0] + v[q][j][1] * v[q][j][1]) + (v[q][j][2] * v[q][j][2] + v[q][j][3] * v[q][j][3]);
            ss[q] = wave_sum(s_); }
#pragma unroll
        for (int q = 0; q < 2; ++q) { if (q == 1 && rw[1] == row) break;
            if (F.lane < 32) RSSA[(size_t)rw[q] * 32 + F.lane] = (F.lane == 0) ? ss[q] : 0.f;
#pragma unroll
            for (int j = 0; j < 4; ++j) { const int k = 4 * F.lane + 256 * j;
                const f32x4 gm = *(const f32x4*)(g1 + k) * (*(const f32x4*)(scp[q] + k) + 1.0f), a = v[q][j] * gm;
                v2u o; o.x = pk2(a[0], a[1]); o.y = pk2(a[2], a[3]); *(v2u*)(XA + (size_t)rw[q] * D + k) = o; } }
    }
}

constexpr int CV_OSROW = 260;
__device__ __forceinline__ void conv_phase(Frame& F, int l, int ntiles) {
    const bf16* PROJ = WSP(const bf16, WS_PROJ); bf16* MIX = WSP(bf16, WS_MIX);
    LAS float* us = (LAS float*)(F.lds);
    LAS float* os = (LAS float*)(F.lds + 62 * 256 * 4);
    const int c = F.tid & 255, half = F.tid >> 8;
    float w[31];
#pragma unroll
    for (int k = 0; k < 31; ++k) w[k] = INP(10)[((size_t)l * 31 + k) * 256 + c];
    const float cbias = INP(11)[l * 256 + c];
    const f32x4 lg = *(const f32x4*)(INP(12) + l * 256 + 4 * F.lane), lb = *(const f32x4*)(INP(13) + l * 256 + 4 * F.lane);
    unsigned pv[16], pg[16];
    auto load_tile = [&](int T) {
        const int row0 = T * 32;
        int lo, hi; if (row0 < ML) { lo = row0 & ~(SEQ - 1); hi = lo + SEQ; } else { lo = row0 & ~(CTXL - 1); hi = lo + CTXL; }
#pragma unroll
        for (int j = 0; j < 16; ++j) { const int i = F.tid + 512 * j, rr = i >> 7, cp = i & 127, row = row0 - 15 + rr;
            const bool ok = (j < 15 || F.tid < 256) && row >= lo && row < hi;
            pv[j] = ok ? *(const unsigned*)(PROJ + (size_t)row * IND + 2 * cp) : 0u; pg[j] = ok ? *(const unsigned*)(PROJ + (size_t)row * IND + 256 + 2 * cp) : 0u; }
    };
    if (F.vcu < ntiles) load_tile(F.vcu);
    for (int T = F.vcu; T < ntiles; T += F.G) {
        const int row0 = T * 32;
        __syncthreads();
#pragma unroll
        for (int j = 0; j < 16; ++j) { const int i = F.tid + 512 * j;
            if (j < 15 || F.tid < 256) { f32x2 u; u[0] = bflo(pv[j]) * sigmoidf_(bflo(pg[j])); u[1] = bfhi(pv[j]) * sigmoidf_(bfhi(pg[j])); *(LAS f32x2*)(us + 2 * i) = u; } }
        if (T + F.G < ntiles) load_tile(T + F.G);
        __syncthreads();
        {
            float acc[16];
#pragma unroll
            for (int j = 0; j < 16; ++j) acc[j] = cbias;
            const LAS float* up = us + (16 * half) * 256 + c;
#pragma unroll
            for (int i = 0; i < 46; ++i) { const float x = up[i * 256];
#pragma unroll
                for (int j = 0; j < 16; ++j) if (i - j >= 0 && i - j <= 30) acc[j] += w[i - j] * x; }
#pragma unroll
            for (int j = 0; j < 16; ++j) os[(16 * half + j) * CV_OSROW + c] = acc[j];
        }
        __syncthreads();
#pragma unroll
        for (int q = 0; q < 4; ++q) { const int t = 4 * F.wave + q;
            const f32x4 v = *(const LAS f32x4*)(os + t * CV_OSROW + 4 * F.lane);
            const float mu = wave_sum((v[0] + v[1]) + (v[2] + v[3])) * (1.f / 256.f);
            const f32x4 d = v - mu;
            const float var = wave_sum((d[0] * d[0] + d[1] * d[1]) + (d[2] * d[2] + d[3] * d[3])) * (1.f / 256.f);
            const f32x4 y = d * rsqrtf(var + EPS) * lg + lb;
            v2u o; o.x = pk2(siluf_(y[0]), siluf_(y[1])); o.y = pk2(siluf_(y[2]), siluf_(y[3]));
            *(v2u*)(MIX + (size_t)(row0 + t) * D + 4 * F.lane) = o; }
    }
}

typedef short s16x8 __attribute__((ext_vector_type(8)));
typedef short s16x4 __attribute__((ext_vector_type(4)));
constexpr int NA_KROW = 144, NA_VROW = 160;
constexpr int NA_STAGE = 64 * NA_KROW + 64 * NA_VROW, NA_OFF_TB = 2 * NA_STAGE;
constexpr int NA_ITEMS_LAT = NB * NH * 8, NA_ITEMS_CTX = NB * NH * 2;
struct NaBlk { f32x4 O[4]; float m, lsum; };
__device__ __forceinline__ int na_rs(int r) { int v = r - 4; return v < 0 ? 0 : (v > 24 ? 24 : v); }
__device__ __forceinline__ void na_phase(Frame& F, int l, int nitems, int nav = 0) {
    const bf16* PROJ = WSP(const bf16, WS_PROJ); bf16* MIX = WSP(bf16, WS_MIX);
    LAS float* tb = (LAS float*)(F.lds + NA_OFF_TB);
    const int lane = F.lane, q16 = lane & 15, g = lane >> 4;
    const unsigned skey = (unsigned)(F.tid >> 3), spart = (unsigned)(F.tid & 7);
    const float c1 = 0.125f * 1.4426950408889634f;
    for (int it = F.vcu; it < nitems; it += F.G) {
        const bool isctx = it >= NA_ITEMS_LAT;
        int b, h, ra = 0, jq = 0, qrow0, rsI = 0, nloc = 0;
        if (!isctx) { const int r4 = it & 7; h = (it >> 3) & 7; b = it >> 6; const int r0 = 4 * r4; ra = r0 + 2 * (F.wave >> 2); jq = F.wave & 3; qrow0 = b * SEQ + ra * 64 + jq * 16;
            rsI = na_rs(r0); nloc = na_rs(r0 + 3) + 8 - rsI; }
        else { const int j = it - NA_ITEMS_LAT; const int hf = j & 1; h = (j >> 1) & 7; b = j >> 4; qrow0 = ML + b * CTXL + hf * 128 + F.wave * 16; }
        const int nch = nloc + 4;
        const bf16* Pq = PROJ + 512 + h * HD, * Pk = PROJ + 1024 + h * HD + 8 * spart, * Pv = PROJ + 1536 + h * HD + 8 * spart;
        auto krow_of = [&](int ch) -> int { return ch < nloc ? b * SEQ + (rsI + ch) * 64 : ML + b * CTXL + (ch - nloc) * 64; };
        s16x8 qfA[2], qfB[2];
#pragma unroll
        for (int s_ = 0; s_ < 2; ++s_) { qfA[s_] = *(const s16x8*)(Pq + (size_t)(qrow0 + q16) * IND + 32 * s_ + 8 * g); qfB[s_] = isctx ? qfA[s_] : *(const s16x8*)(Pq + (size_t)(qrow0 + 64 + q16) * IND + 32 * s_ + 8 * g); }
        const int rsA = na_rs(ra), rsB = na_rs(ra + 1);
        const int tlo = jq < 2 ? 0 : jq - 1, thi = jq > 1 ? 3 : jq + 1;
        float madd[4][4]; int lb;
        {
            const int qc = jq * 16 + q16; int cs = qc - 8; cs = cs < 0 ? 0 : (cs > 48 ? 48 : cs);
#pragma unroll
            for (int t = 0; t < 4; ++t)
#pragma unroll
                for (int e = 0; e < 4; ++e) madd[t][e] = ((unsigned)(16 * t + 4 * g + e - cs) < 16u) ? 0.f : -1.0e30f;
            lb = 64 + 4 * g - qc + 15;
        }
        v4u kr_ = *(const v4u*)(Pk + (size_t)(krow_of(0) + (int)skey) * IND), vr_ = *(const v4u*)(Pv + (size_t)(krow_of(0) + (int)skey) * IND);
        __syncthreads();
        if (!isctx) { const float* rpb = INP(14) + ((size_t)l * NH + h) * 15 * 31;
            for (int i = F.tid; i < 640; i += NWAVES * 64) tb[i] = (i >= 64 && i < 64 + 465) ? rpb[i - 64] * 1.4426950408889634f : 0.f; }
        *(LAS v4u*)(F.lds + skey * NA_KROW + spart * 16) = kr_; *(LAS v4u*)(F.lds + 64 * NA_KROW + skey * NA_VROW + spart * 16) = vr_;
        kr_ = *(const v4u*)(Pk + (size_t)(krow_of(1) + (int)skey) * IND); vr_ = *(const v4u*)(Pv + (size_t)(krow_of(1) + (int)skey) * IND);
        NaBlk A, B;
#pragma unroll
        for (int dt = 0; dt < 4; ++dt) { A.O[dt] = (f32x4){0.f, 0.f, 0.f, 0.f}; B.O[dt] = (f32x4){0.f, 0.f, 0.f, 0.f}; }
        A.m = -1.0e30f; A.lsum = 0.f; B.m = -1.0e30f; B.lsum = 0.f;
        for (int ch = 0; ch < nch; ++ch) {
            __syncthreads();
            LAS unsigned char* cur = F.lds + (ch & 1) * NA_STAGE; LAS unsigned char* nxt = F.lds + ((ch + 1) & 1) * NA_STAGE;
            if (ch + 1 < nch) { *(LAS v4u*)(nxt + skey * NA_KROW + spart * 16) = kr_; *(LAS v4u*)(nxt + 64 * NA_KROW + skey * NA_VROW + spart * 16) = vr_; }
            if (ch + 2 < nch) { const int k2 = krow_of(ch + 2) + (int)skey; kr_ = *(const v4u*)(Pk + (size_t)k2 * IND); vr_ = *(const v4u*)(Pv + (size_t)k2 * IND); }
            const bool local = ch < nloc;
            const int kr = rsI + ch;
            const bool actA = !local || (kr >= rsA && kr <= rsA + 7), actB = !isctx && (!local || (kr >= rsB && kr <= rsB + 7));
            if ((!actA && !actB) || nav == 1) continue;
            const LAS unsigned char* kb_ = cur + q16 * NA_KROW + 16 * g;
            const LAS unsigned char* vtr = cur + 64 * NA_KROW + (4 * g + (q16 >> 2)) * NA_VROW + (q16 & 3) * 8;
            f32x4 SA[4], SB[4];
#pragma unroll
            for (int t = 0; t < 4; ++t) { SA[t] = (f32x4){0.f, 0.f, 0.f, 0.f}; SB[t] = (f32x4){0.f, 0.f, 0.f, 0.f};
                if (!local || (t >= tlo && t <= thi)) {
#pragma unroll
                    for (int s_ = 0; s_ < 2; ++s_) { const s16x8 kf = *(const LAS s16x8*)(kb_ + t * 16 * NA_KROW + 64 * s_);
                        if (actA) SA[t] = __builtin_amdgcn_mfma_f32_16x16x32_bf16(kf, qfA[s_], SA[t], 0, 0, 0);
                        if (actB) SB[t] = __builtin_amdgcn_mfma_f32_16x16x32_bf16(kf, qfB[s_], SB[t], 0, 0, 0); } } }
            unsigned pkA[4][2], pkB[4][2];
            auto soft = [&](f32x4 (&S)[4], NaBlk& X, unsigned (&pk)[4][2], int rq) {
                float cm = -1.0e30f;
                if (local) {
                    const LAS float* tr_ = tb + (kr - rq + 7) * 31 + lb;
#pragma unroll
                    for (int t = 0; t < 4; ++t) if (t >= tlo && t <= thi) {
#pragma unroll
                        for (int e = 0; e < 4; ++e) { const float v = S[t][e] * c1 + tr_[16 * t + e] + madd[t][e]; S[t][e] = v; cm = fmaxf(cm, v); } }
                } else {
#pragma unroll
                    for (int t = 0; t < 4; ++t)
#pragma unroll
                        for (int e = 0; e < 4; ++e) { const float v = S[t][e] * c1; S[t][e] = v; cm = fmaxf(cm, v); }
                }
                if (!__all(cm <= X.m + 8.f)) {
                    cm = fmaxf(cm, __shfl_xor(cm, 16)); cm = fmaxf(cm, __shfl_xor(cm, 32));
                    const float mn = fmaxf(X.m, cm), alpha = __builtin_amdgcn_exp2f(X.m - mn); X.m = mn;
                    X.lsum *= alpha;
#pragma unroll
                    for (int dt = 0; dt < 4; ++dt) X.O[dt] = X.O[dt] * alpha;
                }
                const float mm = X.m;
                float ps = 0.f;
#pragma unroll
                for (int t = 0; t < 4; ++t) {
                    if (!local || (t >= tlo && t <= thi)) {
                        const float p0 = __builtin_amdgcn_exp2f(S[t][0] - mm), p1 = __builtin_amdgcn_exp2f(S[t][1] - mm), p2 = __builtin_amdgcn_exp2f(S[t][2] - mm), p3 = __builtin_amdgcn_exp2f(S[t][3] - mm);
                        ps += (p0 + p1) + (p2 + p3);
                        pk[t][0] = pg8::cvt_pk_bf16(p0, p1); pk[t][1] = pg8::cvt_pk_bf16(p2, p3);
                    } else { pk[t][0] = 0u; pk[t][1] = 0u; }
                }
                X.lsum += ps;
            };
            if (nav == 2) { asm volatile("" :: "v"(SA[0]), "v"(SA[1]), "v"(SA[2]), "v"(SA[3]), "v"(SB[0]), "v"(SB[1]), "v"(SB[2]), "v"(SB[3])); continue; }
            if (actA) soft(SA, A, pkA, ra);
            if (actB) soft(SB, B, pkB, ra + 1);
            if (nav == 3) { asm volatile("" :: "v"(pkA[0][0]), "v"(pkA[1][1]), "v"(pkA[2][0]), "v"(pkA[3][1]), "v"(pkB[0][0]), "v"(pkB[1][1]), "v"(pkB[2][0]), "v"(pkB[3][1])); continue; }
#pragma unroll
            for (int p = 0; p < 2; ++p) {
                if (!local || (2 * p <= thi && 2 * p + 1 >= tlo)) {
                    const v4u bwA = {pkA[2 * p][0], pkA[2 * p][1], pkA[2 * p + 1][0], pkA[2 * p + 1][1]}, bwB = {pkB[2 * p][0], pkB[2 * p][1], pkB[2 * p + 1][0], pkB[2 * p + 1][1]};
                    const s16x8 bfA = __builtin_bit_cast(s16x8, bwA), bfB = __builtin_bit_cast(s16x8, bwB);
#pragma unroll
                    for (int dt = 0; dt < 4; ++dt) {
                        const s16x4 a0 = __builtin_amdgcn_ds_read_tr16_b64_v4i16((LAS s16x4*)(vtr + (2 * p) * 16 * NA_VROW + dt * 32));
                        const s16x4 a1 = __builtin_amdgcn_ds_read_tr16_b64_v4i16((LAS s16x4*)(vtr + (2 * p + 1) * 16 * NA_VROW + dt * 32));
                        const s16x8 afrag = __builtin_shufflevector(a0, a1, 0, 1, 2, 3, 4, 5, 6, 7);
                        if (actA) A.O[dt] = __builtin_amdgcn_mfma_f32_16x16x32_bf16(afrag, bfA, A.O[dt], 0, 0, 0);
                        if (actB) B.O[dt] = __builtin_amdgcn_mfma_f32_16x16x32_bf16(afrag, bfB, B.O[dt], 0, 0, 0);
                    }
                }
            }
        }
        {
            float ls = A.lsum; ls += __shfl_xor(ls, 16); ls += __shfl_xor(ls, 32);
            const float inv = __builtin_amdgcn_rcpf(ls);
            bf16* op = MIX + (size_t)(qrow0 + q16) * D + 256 + h * HD + 4 * g;
#pragma unroll
            for (int dt = 0; dt < 4; ++dt) { v2u w; w.x = pg8::cvt_pk_bf16(A.O[dt][0] * inv, A.O[dt][1] * inv); w.y = pg8::cvt_pk_bf16(A.O[dt][2] * inv, A.O[dt][3] * inv); *(v2u*)(op + 16 * dt) = w; }
        }
        if (!isctx) {
            float ls = B.lsum; ls += __shfl_xor(ls, 16); ls += __shfl_xor(ls, 32);
            const float inv = __builtin_amdgcn_rcpf(ls);
            bf16* op = MIX + (size_t)(qrow0 + 64 + q16) * D + 256 + h * HD + 4 * g;
#pragma unroll
            for (int dt = 0; dt < 4; ++dt) { v2u w; w.x = pg8::cvt_pk_bf16(B.O[dt][0] * inv, B.O[dt][1] * inv); w.y = pg8::cvt_pk_bf16(B.O[dt][2] * inv, B.O[dt][3] * inv); *(v2u*)(op + 16 * dt) = w; }
        }
    }
}

constexpr int LRU_UCROW = 260;
constexpr int LRU_OFF_UC = 38 * 256 * 2, LRU_OFF_GT = LRU_OFF_UC + 2 * 32 * LRU_UCROW * 4;
static_assert(LRU_OFF_GT + 32 * 256 * 2 <= RING_BYTES, "LRU LDS map");
template <int PASS>
__device__ __forceinline__ void lru_phase(Frame& F, int l, int ntiles) {
    const bf16* PROJ = WSP(const bf16, WS_PROJ);
    LAS bf16* rxs = (LAS bf16*)(F.lds);
    LAS float* ucf = (LAS float*)(F.lds + LRU_OFF_UC);
    LAS bf16* gts = (LAS bf16*)(F.lds + LRU_OFF_GT);
    const int lane = F.lane, j16 = lane & 15, g = lane >> 4;
    const int kb = F.wave & 3, nh = F.wave >> 2;
    s16x8 wf[2][2][2][2];
    float cbx[2][2], cba[2][2], csp[2][2];
#pragma unroll
    for (int dir = 0; dir < 2; ++dir) {
        const int ld = l * 2 + dir;
        const bf16* WLR = WSP(const bf16, WS_WLR) + (size_t)((ld * 4 + kb) * 2) * 4096;
#pragma unroll
        for (int gt = 0; gt < 2; ++gt)
#pragma unroll
            for (int n2 = 0; n2 < 2; ++n2)
#pragma unroll
                for (int s_ = 0; s_ < 2; ++s_) wf[dir][gt][n2][s_] = *(const s16x8*)(WLR + gt * 4096 + (16 * (2 * nh + n2) + j16) * 64 + 32 * s_ + 8 * g);
#pragma unroll
        for (int n2 = 0; n2 < 2; ++n2) {
            const int e = kb * 64 + 16 * (2 * nh + n2) + j16, idx = ld * 256 + e;
            cbx[dir][n2] = INP(18)[idx]; cba[dir][n2] = INP(20)[idx];
            const float nl = -INP(21)[idx]; csp[dir][n2] = -8.f * (fmaxf(nl, 0.f) + log1pf(__expf(-fabsf(nl))));
        }
    }
    const int c = F.tid & 255, sdir = F.tid >> 8;
    const int sld = l * 2 + sdir;
    const float s1w0 = INP(15)[(sld * 4 + 0) * 256 + c], s1w1 = INP(15)[(sld * 4 + 1) * 256 + c], s1w2 = INP(15)[(sld * 4 + 2) * 256 + c], s1w3 = INP(15)[(sld * 4 + 3) * 256 + c], s1cb = INP(16)[sld * 256 + c];
    const int base = sdir == 0 ? 0 : 3;
    unsigned pre[10], pgw[8];
    auto load_tile = [&](int T) {
        const int row0 = T * 32;
        int lo, hi; if (row0 < ML) { lo = row0 & ~(SEQ - 1); hi = lo + SEQ; } else { lo = row0 & ~(CTXL - 1); hi = lo + CTXL; }
#pragma unroll
        for (int j = 0; j < 10; ++j) { const int i = F.tid + 512 * j, rr = i >> 7, cp = i & 127, row = row0 - 3 + rr;
            const bool ok = (j < 9 || F.tid < 256) && row >= lo && row < hi;
            pre[j] = ok ? *(const unsigned*)(PROJ + (size_t)row * IND + 2048 + 2 * cp) : 0u; }
        if (PASS == 1) {
#pragma unroll
            for (int j = 0; j < 8; ++j) { const int i = F.tid + 512 * j, t = i >> 7, cp = i & 127; pgw[j] = *(const unsigned*)(PROJ + (size_t)(row0 + t) * IND + 2304 + 2 * cp); }
        }
    };
    if (F.vcu < ntiles) load_tile(F.vcu);
    for (int T = F.vcu; T < ntiles; T += F.G) {
        const int row0 = T * 32;
        __syncthreads();
#pragma unroll
        for (int j = 0; j < 10; ++j) { const int i = F.tid + 512 * j; if (j < 9 || F.tid < 256) ((LAS unsigned*)rxs)[i] = pre[j]; }
        if (PASS == 1) {
#pragma unroll
            for (int j = 0; j < 8; ++j) ((LAS unsigned*)gts)[F.tid + 512 * j] = pgw[j];
        }
        if (T + F.G < ntiles) load_tile(T + F.G);
        float hst[2][2];
#pragma unroll
        for (int dir = 0; dir < 2; ++dir)
#pragma unroll
            for (int n2 = 0; n2 < 2; ++n2) hst[dir][n2] = PASS == 1 ? WSP(const float, WS_CARRY)[((size_t)dir * 1152 + T) * 256 + kb * 64 + 16 * (2 * nh + n2) + j16] : 0.f;
        __syncthreads();
        {
            float x0 = bf1(rxs[(base + 0) * 256 + c]), x1 = bf1(rxs[(base + 1) * 256 + c]), x2 = bf1(rxs[(base + 2) * 256 + c]);
#pragma unroll 8
            for (int t = 0; t < 32; ++t) {
                const float x3 = bf1(rxs[(t + base + 3) * 256 + c]);
                ucf[(sdir * 32 + t) * LRU_UCROW + c] = s1cb + s1w0 * x0 + s1w1 * x1 + s1w2 * x2 + s1w3 * x3;
                x0 = x1; x1 = x2; x2 = x3;
            }
        }
        __syncthreads();
        float hf[2][2][4];
        float Pt[2][2] = {{1.f, 1.f}, {1.f, 1.f}};
#pragma unroll
        for (int dir = 0; dir < 2; ++dir) {
            const bool sec16 = ((g & 1) != 0) != (dir != 0), sec32 = ((g >> 1) != 0) != (dir != 0);
#pragma unroll
            for (int step = 0; step < 2; ++step) {
                const int rt = dir == 0 ? step : 1 - step;
                s16x8 af[2];
#pragma unroll
                for (int s_ = 0; s_ < 2; ++s_) { const LAS float* up = ucf + (dir * 32 + 16 * rt + j16) * LRU_UCROW + kb * 64 + 32 * s_ + 8 * g;
                    const f32x4 u0 = *(const LAS f32x4*)up, u1 = *(const LAS f32x4*)(up + 4);
                    const v4u w = {pg8::cvt_pk_bf16(u0[0], u0[1]), pg8::cvt_pk_bf16(u0[2], u0[3]), pg8::cvt_pk_bf16(u1[0], u1[1]), pg8::cvt_pk_bf16(u1[2], u1[3])};
                    af[s_] = __builtin_bit_cast(s16x8, w); }
#pragma unroll
                for (int n2 = 0; n2 < 2; ++n2) {
                    f32x4 zx = {0.f, 0.f, 0.f, 0.f}, za = {0.f, 0.f, 0.f, 0.f};
#pragma unroll
                    for (int s_ = 0; s_ < 2; ++s_) { zx = __builtin_amdgcn_mfma_f32_16x16x32_bf16(af[s_], wf[dir][0][n2][s_], zx, 0, 0, 0); za = __builtin_amdgcn_mfma_f32_16x16x32_bf16(af[s_], wf[dir][1][n2][s_], za, 0, 0, 0); }
                    const int e = kb * 64 + 16 * (2 * nh + n2) + j16;
                    const LAS float* uo = ucf + (dir * 32 + 16 * rt + 4 * g) * LRU_UCROW + e;
                    float a_[4], b_[4];
#pragma unroll
                    for (int r = 0; r < 4; ++r) {
                        const float u = uo[r * LRU_UCROW];
                        const float gx = sigmoidf_(zx[r] + cbx[dir][n2]), ga = sigmoidf_(za[r] + cba[dir][n2]);
                        const float la = csp[dir][n2] * ga, a = __builtin_amdgcn_exp2f(1.4426950408889634f * la), y = 2.f * la;
                        const float om = y > -0.02f ? -y * (1.f + y * (0.5f + y * 0.16666667f)) : 1.f - a * a;
                        a_[r] = a; b_[r] = __builtin_amdgcn_sqrtf(om) * gx * u;
                    }
                    const float P = (a_[0] * a_[1]) * (a_[2] * a_[3]);
                    const float S = dir == 0 ? ((b_[0] * a_[1] + b_[1]) * a_[2] + b_[2]) * a_[3] + b_[3] : ((b_[3] * a_[2] + b_[2]) * a_[1] + b_[1]) * a_[0] + b_[0];
                    const float Pp = __shfl_xor(P, 16), Sp = __shfl_xor(S, 16);
                    const float e1P = sec16 ? Pp : 1.f, e1S = sec16 ? Sp : 0.f;
                    const float prP = P * Pp, prS = sec16 ? P * Sp + S : Pp * S + Sp;
                    const float Pq = __shfl_xor(prP, 32), Sq = __shfl_xor(prS, 32);
                    const float EP = sec32 ? Pq * e1P : e1P, ES = sec32 ? e1P * Sq + e1S : e1S;
                    const float TP = prP * Pq, TS = sec32 ? prP * Sq + prS : Pq * prS + Sq;
                    if (PASS == 1) {
                        float h = EP * hst[dir][n2] + ES;
                        if (dir == 0) {
#pragma unroll
                            for (int r = 0; r < 4; ++r) { h = a_[r] * h + b_[r]; hf[rt][n2][r] = h; }
                        } else {
                            float hb[4];
#pragma unroll
                            for (int r = 3; r >= 0; --r) { h = a_[r] * h + b_[r]; hb[r] = h; }
                            bf16* mp = WSP(bf16, WS_MIX) + (size_t)(row0 + 16 * rt + 4 * g) * D + 768 + e;
                            const LAS bf16* gp = gts + (16 * rt + 4 * g) * 256 + e;
#pragma unroll
                            for (int r = 0; r < 4; ++r) mp[(size_t)r * D] = (bf16)f2bf(gelu_tanh(bf1(gp[r * 256])) * (hf[rt][n2][r] + hb[r]));
                        }
                    } else Pt[dir][n2] *= TP;
                    hst[dir][n2] = TP * hst[dir][n2] + TS;
                }
            }
        }
        if (PASS == 0 && g == 0) {
#pragma unroll
            for (int dir = 0; dir < 2; ++dir)
#pragma unroll
                for (int n2 = 0; n2 < 2; ++n2) WSP(f32x2, WS_TOT)[((size_t)dir * 1152 + T) * 256 + kb * 64 + 16 * (2 * nh + n2) + j16] = (f32x2){Pt[dir][n2], hst[dir][n2]};
        }
    }
}
__device__ __forceinline__ void lru_carry(Frame& F) {
    const f32x2* TOT = WSP(const f32x2, WS_TOT); float* CARRY = WSP(float, WS_CARRY);
    for (int it = F.gw; it < NB * 2 * 4; it += F.NGW) {
        const int b = it >> 3, dir = (it >> 2) & 1, c = (it & 3) * 64 + F.lane;
        float h = 0.f;
        for (int g = 0; g < 18; ++g) {
            f32x2 ps[4]; int tl[4];
#pragma unroll
            for (int i = 0; i < 4; ++i) { const int s = g * 4 + i;
                int T; if (s < 8) T = 1024 + b * 8 + (dir == 0 ? s : 7 - s); else T = b * 64 + (dir == 0 ? s - 8 : 71 - s);
                tl[i] = T; ps[i] = TOT[((size_t)dir * 1152 + T) * 256 + c]; }
#pragma unroll
            for (int i = 0; i < 4; ++i) { CARRY[((size_t)dir * 1152 + tl[i]) * 256 + c] = h; h = ps[i][0] * h + ps[i][1]; }
        }
    }
}

__device__ __forceinline__ void ctx_finalize(Frame& F, int l) {
    bf16* XA = WSP(bf16, WS_XA); float* RSSA = WSP(float, WS_RSSA); const float* ACC = WSP(const float, WS_PART); const float* MOD = WSP(const float, WS_MOD);
    const float* go = INP(5) + (l - 1) * D; const float* gso = MOD + ((size_t)(l - 1) * 17 + NB) * MODW + 4 * D;
    const float* gn = INP(4) + l * D; const float* gsn = MOD + ((size_t)l * 17 + NB) * MODW + D;
    for (int r = F.gw; r < MC; r += F.NGW) {
        const size_t row = (size_t)ML + r;
        float ss = 0.f; f32x4 y[4];
#pragma unroll
        for (int j = 0; j < 4; ++j) { const int k = 4 * F.lane + 256 * j;
            const v2u w = *(const v2u*)(XA + row * D + k);
            const f32x4 im = *(const f32x4*)(go + k) * (*(const f32x4*)(gso + k) + 1.0f);
            const f32x4 xo = (f32x4){bflo(w.x) * __builtin_amdgcn_rcpf(im[0]), bfhi(w.x) * __builtin_amdgcn_rcpf(im[1]), bflo(w.y) * __builtin_amdgcn_rcpf(im[2]), bfhi(w.y) * __builtin_amdgcn_rcpf(im[3])};
            const float* ap = ACC + (size_t)r * D + k;
            y[j] = xo + ((*(const f32x4*)ap + *(const f32x4*)(ap + (size_t)MC * D)) + (*(const f32x4*)(ap + (size_t)2 * MC * D) + *(const f32x4*)(ap + (size_t)3 * MC * D)));
            ss += (y[j][0] * y[j][0] + y[j][1] * y[j][1]) + (y[j][2] * y[j][2] + y[j][3] * y[j][3]); }
        ss = wave_sum(ss);
        if (F.lane < 32) RSSA[row * 32 + F.lane] = (F.lane == 0) ? ss : 0.f;
#pragma unroll
        for (int j = 0; j < 4; ++j) { const int k = 4 * F.lane + 256 * j;
            const f32x4 a = y[j] * (*(const f32x4*)(gn + k) * (*(const f32x4*)(gsn + k) + 1.0f));
            v2u o; o.x = pk2(a[0], a[1]); o.y = pk2(a[2], a[3]); *(v2u*)(XA + row * D + k) = o; }
    }
}

__device__ __forceinline__ void final_rows(Frame& F) {
    const bf16* XA = WSP(const bf16, WS_XA); const float* RSS = WSP(const float, WS_RSSA);
    for (int row = F.gw; row < ML; row += 2 * F.NGW) {
        const int row2 = row + F.NGW; const bool two = row2 < ML;
        const v4u a0 = *(const v4u*)(XA + (size_t)row * D + 8 * F.lane), a1 = *(const v4u*)(XA + (size_t)row * D + 512 + 8 * F.lane);
        const float p0 = F.lane < 32 ? RSS[(size_t)row * 32 + F.lane] : 0.f;
        v4u b0 = a0, b1 = a1; float p1 = 0.f;
        if (two) { b0 = *(const v4u*)(XA + (size_t)row2 * D + 8 * F.lane); b1 = *(const v4u*)(XA + (size_t)row2 * D + 512 + 8 * F.lane); p1 = F.lane < 32 ? RSS[(size_t)row2 * 32 + F.lane] : 0.f; }
        const float rs0 = rsqrtf(wave_sum(p0) * (1.f / D) + EPS), rs1 = rsqrtf(wave_sum(p1) * (1.f / D) + EPS);
        float* o = F.out + (size_t)row * D + 8 * F.lane;
        *(f32x4*)(o) = (f32x4){bflo(a0.x), bfhi(a0.x), bflo(a0.y), bfhi(a0.y)} * rs0; *(f32x4*)(o + 4) = (f32x4){bflo(a0.z), bfhi(a0.z), bflo(a0.w), bfhi(a0.w)} * rs0;
        *(f32x4*)(o + 512) = (f32x4){bflo(a1.x), bfhi(a1.x), bflo(a1.y), bfhi(a1.y)} * rs0; *(f32x4*)(o + 516) = (f32x4){bflo(a1.z), bfhi(a1.z), bflo(a1.w), bfhi(a1.w)} * rs0;
        if (two) { float* o2 = F.out + (size_t)row2 * D + 8 * F.lane;
            *(f32x4*)(o2) = (f32x4){bflo(b0.x), bfhi(b0.x), bflo(b0.y), bfhi(b0.y)} * rs1; *(f32x4*)(o2 + 4) = (f32x4){bflo(b0.z), bfhi(b0.z), bflo(b0.w), bfhi(b0.w)} * rs1;
            *(f32x4*)(o2 + 512) = (f32x4){bflo(b1.x), bfhi(b1.x), bflo(b1.y), bfhi(b1.y)} * rs1; *(f32x4*)(o2 + 516) = (f32x4){bflo(b1.z), bfhi(b1.z), bflo(b1.w), bfhi(b1.w)} * rs1; }
    }
}

constexpr int N_PHASES = 2 + 7 * DEPTH + 1;
struct Args { const float* in[25]; float* out; unsigned char* ws; int ph_lo, ph_hi; };
static_assert(sizeof(Args) == 27 * 8 + 8, "Args has no padding");

__global__ void __launch_bounds__(NWAVES * 64, 2) mega_fwd(Args args) {
    extern __shared__ __attribute__((aligned(16))) unsigned char lds[];
    Frame F;
    F.lds = (LAS unsigned char*)lds;
    const int wave_s = __builtin_amdgcn_readfirstlane((int)threadIdx.x >> 6);
    F.wave = wave_s; F.lane = (int)__builtin_amdgcn_mbcnt_hi(~0u, __builtin_amdgcn_mbcnt_lo(~0u, 0u)); F.tid = wave_s * 64 + F.lane;
    F.G = gridDim.x; { const int bx = blockIdx.x; F.vcu = (F.G % 8 == 0) ? (bx % 8) * (F.G / 8) + bx / 8 : bx; }
    F.gw = F.vcu * NWAVES + F.wave; F.NGW = F.G * NWAVES;
    F.out = args.out; F.ws = args.ws;
    volatile LAS unsigned* MISC = (volatile LAS unsigned*)(F.lds + MISC_OFF);
    for (int u = F.tid; u < (LDS_BYTES - LDSCTL_OFF) / 4; u += NWAVES * 64) ((LAS unsigned*)(F.lds + LDSCTL_OFF))[u] = 0u;
    __syncthreads();
    if (F.tid == 0) {
#pragma unroll
        for (int i = 0; i < 25; ++i) *(LAS unsigned long long*)(F.lds + PTR_OFF + 8 * i) = (unsigned long long)args.in[i];
    }
    __syncthreads();
    XcdBarrier bar = xcd_barrier_post((unsigned*)(F.ws + WS_CTL) + CW_BAR, MISC + 8, F.tid);

    const int lo = args.ph_lo, hi = args.ph_hi;
#ifdef PROBE_MASK
    bool rep_done = false;
#define PROBE_V ((((PROBE_MASK >> ph) & 1) && !rep_done) ? PROBE_VARIANT : 0)
#else
#define PROBE_V 0
#endif
    for (int ph = lo; ph < hi; ++ph) {
        { unsigned ones_ = ~0u; asm volatile("" : "+s"(ones_));
          int t_ = wave_s * 64 + (int)__builtin_amdgcn_mbcnt_hi(ones_, __builtin_amdgcn_mbcnt_lo(ones_, 0u)); asm volatile("" : "+v"(t_)); F.tid = t_; F.lane = t_ & 63; F.wave = __builtin_amdgcn_readfirstlane(t_ >> 6); F.gw = F.vcu * NWAVES + F.wave; }
        if (ph == 0) {
#ifndef NO_P0
            phase_p0a(F);
#endif
        } else if (ph == 1) {
#ifndef NO_P0
            phase_p0b(F);
#endif
        }
        else if (ph == N_PHASES - 1) final_rows(F);
        else {
            const int l = (ph - 2) / 7, k = (ph - 2) % 7; const bool last = (l == DEPTH - 1);
            const int Mx = last ? ML : MT;
            float* MOD = WSP(float, WS_MOD);
            if (k == 0) {
                if (l > 0) { ctx_finalize(F, l); xcd_barrier(bar, F.tid); }
                pg8::Gemm g{WSP(const bf16, WS_XA), WSP(const bf16, WS_WIN) + (size_t)l * IND * D, MT, IND, D};
                pg8::Order S; if (last) S.init(ML, IND, D, (MC / 256) * 5, 1, F.G, (int)blockIdx.x); else S.init(MT, IND, D, 0, 0, F.G, (int)blockIdx.x);
                pg8::EpiScale<0, IND> E{WSP(bf16, WS_PROJ), WSP(const float, WS_SHW1) + (size_t)l * 17 * IND, WSP(const float, WS_RSSA), PROBE_V};

#ifndef NO_G0
                pg8::gemm_phase<pg8::EpiScale<0, IND>, pg8::Order, true, true>(F.lds + RING_OFF, g, S, E, F.tid);
#endif

            } else if (k == 1) {

#ifndef NO_LRU
                lru_phase<0>(F, l, 1152);
#ifdef REP_LRU0
                __syncthreads(); lru_phase<0>(F, l, 1152);
#endif
#endif

                __syncthreads();
#ifndef NO_CONV
                conv_phase(F, l, last ? 1024 : 1152);
                __syncthreads();
#ifdef REP_CONV
                conv_phase(F, l, last ? 1024 : 1152);
                __syncthreads();
#endif
#endif
#ifndef NO_NA
#ifdef REP_NA
                na_phase(F, l, last ? NA_ITEMS_LAT : NA_ITEMS_LAT + NA_ITEMS_CTX, REP_NA);
#else
                na_phase(F, l, last ? NA_ITEMS_LAT : NA_ITEMS_LAT + NA_ITEMS_CTX);
#endif
#ifdef REP_NA
                __syncthreads(); na_phase(F, l, last ? NA_ITEMS_LAT : NA_ITEMS_LAT + NA_ITEMS_CTX, 0);
#endif
#endif
            } else if (k == 2) {
                lru_carry(F);
            } else if (k == 3) {

#ifndef NO_LRU
                lru_phase<1>(F, l, last ? 1024 : 1152);
#endif

            } else if (k == 4 || k == 6) {
                const bool dn = (k == 6);
                const int ln = (dn && !last) ? l + 1 : l;
                pg8::Gemm g{dn ? WSP(const bf16, WS_HID) : WSP(const bf16, WS_MIX), dn ? WSP(const bf16, WS_W2) + (size_t)l * D * FF : WSP(const bf16, WS_WOUT) + (size_t)l * D * D, Mx, D, dn ? FF : D};
                const bool splitk = dn && !last;
                pg8::Order S; S.init(splitk ? ML : Mx, D, dn ? FF : D, 0, 0, F.G, (int)blockIdx.x);
                const bool fromin = (!dn && l == 0);
                const float* go_g = dn ? INP(5) + l * D : INP(4) + l * D;
                const float* go_s = MOD + (size_t)l * 17 * MODW + (dn ? 4 : 1) * D;
                const bool fin = dn && last;
                pg8::EpiRes E{fromin ? INP(0) : (const float*)nullptr, fromin ? INP(2) : (const float*)nullptr, (float*)nullptr,
                              MOD + (size_t)l * 17 * MODW + (dn ? 5 : 2) * D, fin ? INP(24) : (dn ? INP(4) : INP(5)) + ln * D, fin ? WSP(const float, WS_ZERO) : MOD + (size_t)ln * 17 * MODW + (dn ? 1 : 4) * D,
                              go_g, go_s, WSP(bf16, WS_XA), dn ? WSP(float, WS_RSSA) : WSP(float, WS_RSSB), 1};
#ifndef NO_GR
                pg8::gemm_phase<pg8::EpiRes, pg8::Order, true, true>(F.lds + RING_OFF, g, S, E, F.tid);
                if (splitk) {
                    pg8::Order S2; S2.init(ML, 0, FF, (MC / 256) * 16, 2, F.G, (int)blockIdx.x);
                    pg8::EpiSlab E2{WSP(float, WS_PART), MOD + ((size_t)l * 17 + NB) * MODW + 5 * D};
                    pg8::gemm_phase<pg8::EpiSlab, pg8::Order, true, true, true>(F.lds + RING_OFF, g, S2, E2, F.tid);
                }
#endif
            } else if (k == 5) {
                pg8::Gemm g{WSP(const bf16, WS_XA), WSP(const bf16, WS_W1) + (size_t)l * FF * D, Mx, FF, D};
                pg8::Order S; S.init(Mx, FF, D, 0, 0, F.G, (int)blockIdx.x);
                pg8::EpiScale<1, FF> E{WSP(bf16, WS_HID), WSP(const float, WS_SHW2) + (size_t)l * 17 * FF, WSP(const float, WS_RSSB), PROBE_V};

#ifndef NO_G1
                pg8::gemm_phase<pg8::EpiScale<1, FF>, pg8::Order, true, true>(F.lds + RING_OFF, g, S, E, F.tid);
#endif

            }
        }
#ifdef PROBE_MASK
        if (((PROBE_MASK >> ph) & 1) && !rep_done) { rep_done = true; xcd_barrier(bar, F.tid); --ph; continue; }
        rep_done = false;
#endif
        if (ph + 1 < hi) xcd_barrier(bar, F.tid);
    }
}

extern "C" void kernel_launch(void* const* d_in, const int* in_sizes, int n_in, void* d_out, int out_size, void* d_ws, size_t ws_size, hipStream_t stream) {
    static int grid = 0;
    if (grid == 0) {
        if (n_in != 25 || out_size != ML * D || ws_size < WS_END) { fprintf(stderr, "kernel_launch: unexpected shapes (n_in %d out %d ws %zu)\n", n_in, out_size, ws_size); grid = -1; return; }
        int dev = 0, cus = 0;
        if (hipGetDevice(&dev) != hipSuccess || hipDeviceGetAttribute(&cus, hipDeviceAttributeMultiprocessorCount, dev) != hipSuccess) { grid = -1; return; }
        if (hipFuncSetAttribute((const void*)mega_fwd, hipFuncAttributeMaxDynamicSharedMemorySize, LDS_BYTES) != hipSuccess) { fprintf(stderr, "kernel_launch: hipFuncSetAttribute failed\n"); grid = -1; return; }
        int per_cu = 0;
        if (hipOccupancyMaxActiveBlocksPerMultiprocessor(&per_cu, (const void*)mega_fwd, NWAVES * 64, LDS_BYTES) != hipSuccess || per_cu < 1) fprintf(stderr, "kernel_launch: occupancy query reports %d\n", per_cu);
        (void)hipGetLastError();
        grid = cus;
    }
    if (grid < 0) return;
    if (hipMemsetAsync((char*)d_ws + WS_CTL, 0, CTL_ZERO_BYTES, stream) != hipSuccess) return;
    Args a{};
    for (int i = 0; i < 25; ++i) a.in[i] = (const float*)d_in[i];
    a.out = (float*)d_out; a.ws = (unsigned char*)d_ws;
#if MK_N_LAUNCHES == 1
    a.ph_lo = 0; a.ph_hi = N_PHASES;
    hipLaunchKernelGGL(mega_fwd, dim3(grid), dim3(NWAVES * 64), LDS_BYTES, stream, a);
#else
    for (int ph = 0; ph < N_PHASES; ++ph) { a.ph_lo = ph; a.ph_hi = ph + 1; hipLaunchKernelGGL(mega_fwd, dim3(grid), dim3(NWAVES * 64), LDS_BYTES, stream, a); }
#endif
}
```

```cpp
#include <hip/hip_runtime.h>
#include <cstdio>
#include <cstdint>

constexpr int D = 1024, NB = 16, SEQ = 2048, CTXL = 256, DEPTH = 2;
constexpr int ML = NB * SEQ, MC = NB * CTXL, MT = ML + MC;
constexpr int IND = 2560, FF = 4096, NH = 8, HD = 64;
constexpr int MODW = 6 * D;
constexpr float EPS = 1e-6f;
#ifndef MK_N_LAUNCHES
#define MK_N_LAUNCHES 1
#endif

namespace pg8 {
#define PG8_LAS __attribute__((address_space(3)))
typedef unsigned short bf16_t;
typedef short bf16x8 __attribute__((ext_vector_type(8)));
typedef float f32x4 __attribute__((ext_vector_type(4)));
typedef unsigned u32x4 __attribute__((ext_vector_type(4)));
constexpr int BM = 256, BK = 64, HALF = 128, HTB = HALF * BK * 2, STAGE_BYTES = 8 * HTB, NXCD = 8, WGM = 8;

__host__ __device__ __forceinline__ int lds_byte(int r, int c) { const int st = (r >> 4) * 2 + (c >> 5), rr = r & 15, cc = c & 31, ob = rr * 64 + cc * 2; return st * 1024 + (ob ^ (((ob >> 9) & 1) << 5)); }
__host__ __device__ __forceinline__ void stage_rc(int b, int& R, int& C) { const int st = b / 1024, sb = b % 1024, swz = sb ^ (((sb >> 9) & 1) << 5); R = (st >> 1) * 16 + swz / 64; C = (st & 1) * 32 + (swz % 64) / 2; }
__host__ __device__ __forceinline__ int perm32(int rho) { const int n = rho >> 4, i = rho & 15; return 8 * (i >> 2) + 4 * n + (i & 3); }

struct Unit { int pm, pn; };
struct Gemm { const bf16_t* A; const bf16_t* Bt; int M, N, K; };

__host__ __device__ __forceinline__ void map_tile(int wgid, int nM, int nN, Unit& u) {
    const int nwg = nM * nN;
    { const int q = nwg / NXCD, r = nwg % NXCD, xcd = wgid % NXCD, off = wgid / NXCD; wgid = (xcd < r ? xcd * (q + 1) : r * (q + 1) + (xcd - r) * q) + off; }
    const int nig = WGM * nN, gid = wgid / nig, fm = gid * WGM, gsz = (nM - fm) < WGM ? (nM - fm) : WGM;
    u.pm = fm + ((wgid % nig) % gsz); u.pn = (wgid % nig) / gsz;
}
struct Order {
    int nM, nN, nwg, extra, mode, ntf, G, c;
    __host__ __device__ void init(int M, int N, int K, int extra_, int mode_, int G_, int c_) { nM = M / BM; nN = N / BM; nwg = nM * nN; extra = extra_; mode = mode_; ntf = K / BK; G = G_; c = c_; }
    __host__ __device__ bool next(int i, Unit& u) const {
        const long L = (long)i * G + c;
        if (L < nwg) { map_tile((int)L, nM, nN, u); return true; }
        if (L < nwg + extra) { const int q = (int)L - nwg;
            if (mode == 1) { u.pm = nM + q / 5; u.pn = 4 + q % 5; }
            else { u.pm = nM + (q >> 4); u.pn = 4 + 4 * (q & 3) + ((q >> 2) & 3); }
            return true; }
        return false;
    }
    __device__ __forceinline__ void a_ready(const Unit&) const {}
    __device__ __forceinline__ void done(const Unit&) const {}
};

__device__ __forceinline__ unsigned cvt_pk_bf16(float lo, float hi) { unsigned r; asm volatile("v_cvt_pk_bf16_f32 %0, %1, %2" : "=v"(r) : "v"(lo), "v"(hi)); return r; }

template <int ACT, int LDC> struct EpiScale {
    static constexpr bool PERM = true, AFTER_DRAIN = false;
    bf16_t* O; const float* shw; const float* RSS;
    int probe;
    __device__ __forceinline__ void operator()(const f32x4 (&acc)[2][2][4][2], const Unit& u, int wr, int wc, int fr, int fq) const {
        asm volatile("" : "+s"(wr), "+s"(wc));
        const int brow = u.pm < ML / BM ? (u.pm >> 3) : NB;
        const float* sp = shw + (size_t)brow * LDC + u.pn * BM;
        bf16_t* Ot = O + (size_t)u.pm * BM * LDC + u.pn * BM;
        const float* RSSt = RSS + (size_t)u.pm * BM * 32;
        unsigned cl = (unsigned)(wc * 32 + 8 * fq);
        unsigned rl0 = (unsigned)(wr * 64 + fr);
        asm volatile("" : "+v"(cl), "+v"(rl0));
        f32x4 pa[2][4], pb[2][4], sh[2][2];
#pragma unroll
        for (int ai = 0; ai < 2; ++ai)
#pragma unroll
            for (int m = 0; m < 4; ++m) { const unsigned ro = (rl0 + (unsigned)(ai * HALF + m * 16)) * 32u + 8u * (unsigned)fq;
                if (probe == 2) { pa[ai][m] = acc[ai][0][m][0]; pb[ai][m] = acc[ai][1][m][0]; } else { pa[ai][m] = *(const f32x4*)(RSSt + ro); pb[ai][m] = *(const f32x4*)(RSSt + (ro + 4u)); } }
#pragma unroll
        for (int bj = 0; bj < 2; ++bj) { if (probe == 2) { sh[bj][0] = acc[0][bj][0][1]; sh[bj][1] = acc[1][bj][0][1]; } else { sh[bj][0] = *(const f32x4*)(sp + (cl + (unsigned)(bj * HALF))); sh[bj][1] = *(const f32x4*)(sp + (cl + (unsigned)(bj * HALF + 4))); } }
        float rs[2][4];
#pragma unroll
        for (int ai = 0; ai < 2; ++ai)
#pragma unroll
            for (int m = 0; m < 4; ++m) { const f32x4 p0 = pa[ai][m], p1 = pb[ai][m];
                float s = ((p0[0] + p0[1]) + (p0[2] + p0[3])) + ((p1[0] + p1[1]) + (p1[2] + p1[3]));
                s += __shfl_xor(s, 16); s += __shfl_xor(s, 32);
                rs[ai][m] = rsqrtf(s * (1.0f / D) + EPS); }
#pragma unroll
        for (int bj = 0; bj < 2; ++bj)
#pragma unroll
            for (int ai = 0; ai < 2; ++ai)
#pragma unroll
                for (int m = 0; m < 4; ++m) {
                    f32x4 v0 = acc[ai][bj][m][0] * rs[ai][m] + sh[bj][0], v1 = acc[ai][bj][m][1] * rs[ai][m] + sh[bj][1];
                    if (ACT == 1) {
#pragma unroll
                        for (int e = 0; e < 4; ++e) { const float a = fmaxf(v0[e], 0.f), b = fmaxf(v1[e], 0.f); v0[e] = a * a; v1[e] = b * b; }
                    }
                    u32x4 w; w.x = cvt_pk_bf16(v0[0], v0[1]); w.y = cvt_pk_bf16(v0[2], v0[3]); w.z = cvt_pk_bf16(v1[0], v1[1]); w.w = cvt_pk_bf16(v1[2], v1[3]);
                    if (probe == 0) *(u32x4*)(Ot + ((rl0 + (unsigned)(ai * HALF + m * 16)) * (unsigned)LDC + cl + (unsigned)(bj * HALF))) = w;
                    else asm volatile("" :: "v"(w));
                }
    }
};
struct EpiRes {
    static constexpr bool PERM = true, AFTER_DRAIN = false;
    const float* src_lat; const float* src_ctx;
    float* dst_lat;
    const float* gate;
    const float* gmg; const float* gmsc;
    const float* gmg_o; const float* gmsc_o;
    bf16_t* XA; float* RSS; int hasxa;
    template <int BJ, int AI0, int NAI, int M0, int NM>
    __device__ __forceinline__ void batch(const f32x4 (&acc)[2][2][4][2], const float* src, float* dst, const float* gt, const float* gg, const float* gs, const float* go, const float* gso, bf16_t* XAt, float* RSSt, unsigned cl, unsigned rl0, int fq) const {
        const unsigned c = cl + (unsigned)(BJ * HALF);
        f32x4 x0[NAI][NM], x1[NAI][NM];
        const bool srcf = src != nullptr;
        if (srcf) {
#pragma unroll
            for (int a = 0; a < NAI; ++a)
#pragma unroll
                for (int m = 0; m < NM; ++m) { const unsigned off = (rl0 + (unsigned)((AI0 + a) * HALF + (M0 + m) * 16)) * (unsigned)D + c; x0[a][m] = *(const f32x4*)(src + off); x1[a][m] = *(const f32x4*)(src + (off + 4u)); }
        } else {
            u32x4 xb[NAI][NM];
#pragma unroll
            for (int a = 0; a < NAI; ++a)
#pragma unroll
                for (int m = 0; m < NM; ++m) { const unsigned off = (rl0 + (unsigned)((AI0 + a) * HALF + (M0 + m) * 16)) * (unsigned)D + c; xb[a][m] = *(const u32x4*)(XAt + off); }
            const f32x4 i0 = *(const f32x4*)(go + c) * (*(const f32x4*)(gso + c) + 1.0f), i1 = *(const f32x4*)(go + (c + 4u)) * (*(const f32x4*)(gso + (c + 4u)) + 1.0f);
            f32x4 r0, r1;
#pragma unroll
            for (int e = 0; e < 4; ++e) { r0[e] = __builtin_amdgcn_rcpf(i0[e]); r1[e] = __builtin_amdgcn_rcpf(i1[e]); }
#pragma unroll
            for (int a = 0; a < NAI; ++a)
#pragma unroll
                for (int m = 0; m < NM; ++m) { const u32x4 w = xb[a][m];
                    x0[a][m] = (f32x4){__uint_as_float(w.x << 16), __uint_as_float(w.x & 0xffff0000u), __uint_as_float(w.y << 16), __uint_as_float(w.y & 0xffff0000u)} * r0;
                    x1[a][m] = (f32x4){__uint_as_float(w.z << 16), __uint_as_float(w.z & 0xffff0000u), __uint_as_float(w.w << 16), __uint_as_float(w.w & 0xffff0000u)} * r1; }
        }
        const f32x4 g0 = *(const f32x4*)(gt + c), g1 = *(const f32x4*)(gt + (c + 4u));
        f32x4 m0 = {0.f, 0.f, 0.f, 0.f}, m1 = {0.f, 0.f, 0.f, 0.f};
        if (hasxa) { m0 = *(const f32x4*)(gg + c) * (*(const f32x4*)(gs + c) + 1.0f); m1 = *(const f32x4*)(gg + (c + 4u)) * (*(const f32x4*)(gs + (c + 4u)) + 1.0f); }
        asm volatile("" ::: "memory");
#pragma unroll
        for (int a = 0; a < NAI; ++a)
#pragma unroll
            for (int m = 0; m < NM; ++m) {
                const unsigned rl = rl0 + (unsigned)((AI0 + a) * HALF + (M0 + m) * 16);
                const unsigned off = rl * (unsigned)D + c;
                const f32x4 y0 = x0[a][m] + g0 * acc[AI0 + a][BJ][M0 + m][0], y1 = x1[a][m] + g1 * acc[AI0 + a][BJ][M0 + m][1];
                if (dst) { *(f32x4*)(dst + off) = y0; *(f32x4*)(dst + (off + 4u)) = y1; }
                float ss = ((y0[0] * y0[0] + y0[1] * y0[1]) + (y0[2] * y0[2] + y0[3] * y0[3])) + ((y1[0] * y1[0] + y1[1] * y1[1]) + (y1[2] * y1[2] + y1[3] * y1[3]));
                ss += __shfl_xor(ss, 16); ss += __shfl_xor(ss, 32);
                if (fq == 0) RSSt[rl * 32u + (unsigned)(BJ * 4)] = ss;
                if (hasxa) { const f32x4 a0 = y0 * m0, a1 = y1 * m1;
                    u32x4 w; w.x = cvt_pk_bf16(a0[0], a0[1]); w.y = cvt_pk_bf16(a0[2], a0[3]); w.z = cvt_pk_bf16(a1[0], a1[1]); w.w = cvt_pk_bf16(a1[2], a1[3]);
                    *(u32x4*)(XAt + off) = w; }
            }
        asm volatile("" ::: "memory");
    }
    __device__ __forceinline__ void operator()(const f32x4 (&acc)[2][2][4][2], const Unit& u, int wr, int wc, int fr, int fq) const {
        asm volatile("" : "+s"(wr), "+s"(wc));
        const bool lat = u.pm < ML / BM;
        const int brow = lat ? (u.pm >> 3) : NB;
        const float* src = src_lat ? (lat ? src_lat + (size_t)u.pm * BM * D : src_ctx + (size_t)(u.pm - ML / BM) * BM * D) + u.pn * BM : nullptr;
        float* dst = (dst_lat && lat) ? dst_lat + (size_t)u.pm * BM * D + u.pn * BM : nullptr;
        const float* gt = gate + (size_t)brow * MODW + u.pn * BM;
        const float* gg = gmg + u.pn * BM;
        const float* gs = gmsc + (size_t)brow * MODW + u.pn * BM;
        const float* go = gmg_o + u.pn * BM;
        const float* gso = gmsc_o + (size_t)brow * MODW + u.pn * BM;
        bf16_t* XAt = XA + (size_t)u.pm * BM * D + u.pn * BM;
        float* RSSt = RSS + (size_t)u.pm * BM * 32 + u.pn * 8 + wc;
        unsigned cl = (unsigned)(wc * 32 + 8 * fq);
        unsigned rl0 = (unsigned)(wr * 64 + fr);
        asm volatile("" : "+v"(cl), "+v"(rl0));
        batch<0, 0, 1, 0, 2>(acc, src, dst, gt, gg, gs, go, gso, XAt, RSSt, cl, rl0, fq);
        batch<0, 0, 1, 2, 2>(acc, src, dst, gt, gg, gs, go, gso, XAt, RSSt, cl, rl0, fq);
        batch<0, 1, 1, 0, 4>(acc, src, dst, gt, gg, gs, go, gso, XAt, RSSt, cl, rl0, fq);
        batch<1, 0, 2, 0, 4>(acc, src, dst, gt, gg, gs, go, gso, XAt, RSSt, cl, rl0, fq);
    }
};

struct EpiSlab {
    static constexpr bool PERM = true, AFTER_DRAIN = false;
    float* P; const float* gate;
    __device__ __forceinline__ void operator()(const f32x4 (&acc)[2][2][4][2], const Unit& u, int wr, int wc, int fr, int fq) const {
        asm volatile("" : "+s"(wr), "+s"(wc));
        const int ks = (u.pn - 4) >> 2, pn = u.pn & 3;
        float* At = P + ((size_t)ks * MC + (size_t)(u.pm - ML / BM) * BM) * D + pn * BM;
        const float* gtq = gate + pn * BM;
        unsigned cl = (unsigned)(wc * 32 + 8 * fq), rl0 = (unsigned)(wr * 64 + fr);
        asm volatile("" : "+v"(cl), "+v"(rl0));
#pragma unroll
        for (int bj = 0; bj < 2; ++bj) { const unsigned c = cl + (unsigned)(bj * HALF);
            const f32x4 g0 = *(const f32x4*)(gtq + c), g1 = *(const f32x4*)(gtq + (c + 4u));
#pragma unroll
            for (int ai = 0; ai < 2; ++ai)
#pragma unroll
                for (int m = 0; m < 4; ++m) { const unsigned off = (rl0 + (unsigned)(ai * HALF + m * 16)) * (unsigned)D + c;
                    *(f32x4*)(At + off) = g0 * acc[ai][bj][m][0]; *(f32x4*)(At + (off + 4u)) = g1 * acc[ai][bj][m][1]; } }
    }
};

template <class Epi, class Sched, bool ALIGN_EPI = false, bool SP2 = false, bool VARK = false>
__device__ __forceinline__ void gemm_phase(PG8_LAS unsigned char* lds, const Gemm g, const Sched& S, const Epi& E, const int tid) {
    const int wid = __builtin_amdgcn_readfirstlane(tid >> 6), lane = tid & 63, wr = wid >> 2, wc = wid & 3, fr = lane & 15, fq = lane >> 4;
    const int K = g.K;
    unsigned voffA[2], voffB[2];
#pragma unroll
    for (int i = 0; i < 2; ++i) { int R, C; stage_rc(tid * 16 + i * 8192, R, C); const int Rb = Epi::PERM ? ((R & ~31) + perm32(R & 31)) : R;
        voffA[i] = (unsigned)(R * K + C) * 2u; voffB[i] = (unsigned)(Rb * K + C) * 2u; }
    const size_t kstep = (size_t)(BK * 2);
    const size_t hstep = (size_t)HALF * K * 2;
    const size_t tstep = 2 * hstep;
    const unsigned ldsw = (unsigned)wid * 1024u;
    const int aoff = lds_byte(wr * 64 + fr, fq * 8), boff = lds_byte(wc * 32 + fr, fq * 8);
#define PG8_SA(b, h) (((b) * 2 + (h)) * HTB)
#define PG8_SB(b, h) ((4 + (b) * 2 + (h)) * HTB)
#define PG8_STAGE(bufoff, gbase, voff) do { _Pragma("unroll") for (int _i = 0; _i < 2; ++_i) \
        __builtin_amdgcn_global_load_lds((const unsigned*)((const char*)(gbase) + (voff)[_i]), (PG8_LAS unsigned*)(lds + (bufoff) + ldsw + _i * 8192), 16, 0, 0); } while (0)
#define PG8_LDA(dst, b, h) do { _Pragma("unroll") for (int m = 0; m < 4; ++m) _Pragma("unroll") for (int k = 0; k < 2; ++k) dst[m][k] = *(const PG8_LAS bf16x8*)(lds + PG8_SA(b, h) + aoff + m * 2048 + k * 1024); } while (0)
#define PG8_LDB(dst, b, h) do { _Pragma("unroll") for (int n = 0; n < 2; ++n) _Pragma("unroll") for (int k = 0; k < 2; ++k) dst[n][k] = *(const PG8_LAS bf16x8*)(lds + PG8_SB(b, h) + boff + n * 2048 + k * 1024); } while (0)
#define PG8_MMA(ai, bj, At, Bt) do { __builtin_amdgcn_s_setprio(1); _Pragma("unroll") for (int m = 0; m < 4; ++m) _Pragma("unroll") for (int n = 0; n < 2; ++n) _Pragma("unroll") for (int k = 0; k < 2; ++k) \
        acc[ai][bj][m][n] = __builtin_amdgcn_mfma_f32_16x16x32_bf16(Bt[n][k], At[m][k], acc[ai][bj][m][n], 0, 0, 0); __builtin_amdgcn_s_setprio(0); } while (0)
#define PG8_WAIT_V(n) asm volatile("s_waitcnt vmcnt(" #n ")" ::: "memory")
#define PG8_WAIT_L(n) asm volatile("s_waitcnt lgkmcnt(" #n ")" ::: "memory")
#define PG8_BAR __builtin_amdgcn_s_barrier()
#define PG8_SCHED __builtin_amdgcn_sched_barrier(0)
    Unit cur, nxt; int ui = 0;
    if (!S.next(0, cur)) return;
    cur.pm = __builtin_amdgcn_readfirstlane(cur.pm); cur.pn = __builtin_amdgcn_readfirstlane(cur.pn);
    f32x4 acc[2][2][4][2];
#pragma unroll
    for (int a = 0; a < 2; ++a)
#pragma unroll
        for (int b = 0; b < 2; ++b)
#pragma unroll
            for (int m = 0; m < 4; ++m)
#pragma unroll
                for (int n = 0; n < 2; ++n) acc[a][b][m][n] = (f32x4){0.f, 0.f, 0.f, 0.f};
    bf16x8 At[4][2], B0[2][2], B1[2][2];
#define PG8_KOFF(u) ((VARK && (u).pn >= 4) ? (size_t)(((u).pn - 4) >> 2) * (size_t)(K / 4) * 2 : (size_t)0)
#define PG8_PN(u) ((VARK && (u).pn >= 4) ? ((u).pn & 3) : (u).pn)
    const char* cA = (const char*)g.A + (size_t)cur.pm * tstep + PG8_KOFF(cur); const char* cB = (const char*)g.Bt + (size_t)PG8_PN(cur) * tstep + PG8_KOFF(cur);
    S.a_ready(cur);
    if constexpr (SP2) {
        PG8_STAGE(PG8_SB(0, 0), cB, voffB); PG8_STAGE(PG8_SB(0, 1), cB + hstep, voffB); PG8_STAGE(PG8_SA(0, 0), cA, voffA); PG8_STAGE(PG8_SA(0, 1), cA + hstep, voffA);
        if (wr == 1) PG8_BAR;
        PG8_WAIT_V(2); PG8_BAR;
        PG8_STAGE(PG8_SB(1, 0), cB + kstep, voffB); PG8_STAGE(PG8_SA(1, 0), cA + kstep, voffA); PG8_STAGE(PG8_SB(1, 1), cB + hstep + kstep, voffB);
        PG8_WAIT_V(6); PG8_BAR;
    } else {
        PG8_STAGE(PG8_SB(0, 0), cB, voffB); PG8_STAGE(PG8_SA(0, 0), cA, voffA); PG8_STAGE(PG8_SB(0, 1), cB + hstep, voffB); PG8_STAGE(PG8_SA(0, 1), cA + hstep, voffA);
        if (wr == 1) PG8_BAR;
        PG8_WAIT_V(4); PG8_BAR;
        PG8_STAGE(PG8_SB(1, 0), cB + kstep, voffB); PG8_STAGE(PG8_SA(1, 0), cA + kstep, voffA); PG8_STAGE(PG8_SB(1, 1), cB + hstep + kstep, voffB);
        PG8_WAIT_V(6); PG8_BAR;
    }
    for (;;) {
        const bool has_next = S.next(ui + 1, nxt);
        nxt.pm = __builtin_amdgcn_readfirstlane(nxt.pm); nxt.pn = __builtin_amdgcn_readfirstlane(nxt.pn);
        const char* nA = has_next ? (const char*)g.A + (size_t)nxt.pm * tstep + PG8_KOFF(nxt) : cA; const char* nB = has_next ? (const char*)g.Bt + (size_t)PG8_PN(nxt) * tstep + PG8_KOFF(nxt) : cB;
        const int nt = (VARK && cur.pn >= 4) ? K / BK / 4 : K / BK;
        for (int t = 0; t < nt; t += 2) {
            const bool last = (t == nt - 2);
            const char* a1 = cA + (size_t)(t + 1) * kstep;
            const char* a2 = last ? nA : cA + (size_t)(t + 2) * kstep; const char* b2 = last ? nB : cB + (size_t)(t + 2) * kstep;
            const char* a3 = a2 + kstep; const char* b3 = b2 + kstep;
            if (last && has_next) S.a_ready(nxt);
            if constexpr (SP2) {
            PG8_LDB(B0, 0, 0); PG8_LDB(B1, 0, 1); PG8_SCHED; PG8_LDA(At, 0, 0); PG8_STAGE(PG8_SA(1, 1), a1 + hstep, voffA);
            PG8_WAIT_V(8); PG8_WAIT_L(0); PG8_BAR; PG8_MMA(0, 0, At, B0); PG8_MMA(0, 1, At, B1); PG8_BAR; PG8_SCHED;
            PG8_LDA(At, 0, 1); PG8_STAGE(PG8_SB(0, 0), b2, voffB); PG8_STAGE(PG8_SB(0, 1), b2 + hstep, voffB); PG8_STAGE(PG8_SA(0, 0), a2, voffA);
            PG8_WAIT_V(8); PG8_WAIT_L(0); PG8_BAR; PG8_MMA(1, 0, At, B0); PG8_MMA(1, 1, At, B1); PG8_BAR; PG8_SCHED;
            PG8_LDB(B0, 1, 0); PG8_LDB(B1, 1, 1); PG8_SCHED; PG8_LDA(At, 1, 0); PG8_STAGE(PG8_SA(0, 1), a2 + hstep, voffA);
            PG8_WAIT_V(8); PG8_WAIT_L(0); PG8_BAR; PG8_MMA(0, 0, At, B0); PG8_MMA(0, 1, At, B1); PG8_BAR; PG8_SCHED;
            PG8_LDA(At, 1, 1); PG8_STAGE(PG8_SB(1, 0), b3, voffB); PG8_STAGE(PG8_SB(1, 1), b3 + hstep, voffB); PG8_STAGE(PG8_SA(1, 0), a3, voffA);
            PG8_WAIT_V(8); PG8_WAIT_L(0); PG8_BAR; PG8_MMA(1, 0, At, B0); PG8_MMA(1, 1, At, B1); PG8_BAR; PG8_SCHED;
            } else {
            PG8_LDB(B0, 0, 0); PG8_SCHED; PG8_LDA(At, 0, 0); PG8_STAGE(PG8_SA(1, 1), a1 + hstep, voffA);
            PG8_WAIT_L(8); PG8_BAR; PG8_WAIT_L(0); PG8_MMA(0, 0, At, B0); PG8_BAR; PG8_SCHED;
            PG8_LDB(B1, 0, 1); PG8_STAGE(PG8_SB(0, 0), b2, voffB);
            PG8_BAR; PG8_WAIT_L(0); PG8_MMA(0, 1, At, B1); PG8_BAR;
            PG8_LDA(At, 0, 1); PG8_STAGE(PG8_SA(0, 0), a2, voffA);
            PG8_BAR; PG8_WAIT_L(0); PG8_MMA(1, 0, At, B0); PG8_BAR; PG8_SCHED;
            PG8_STAGE(PG8_SB(0, 1), b2 + hstep, voffB);
            PG8_WAIT_V(6); PG8_BAR; PG8_MMA(1, 1, At, B1); PG8_BAR;
            PG8_LDB(B0, 1, 0); PG8_SCHED; PG8_LDA(At, 1, 0); PG8_STAGE(PG8_SA(0, 1), a2 + hstep, voffA);
            PG8_WAIT_L(8); PG8_BAR; PG8_WAIT_L(0); PG8_MMA(0, 0, At, B0); PG8_BAR; PG8_SCHED;
            PG8_LDB(B1, 1, 1); PG8_STAGE(PG8_SB(1, 0), b3, voffB);
            PG8_BAR; PG8_WAIT_L(0); PG8_MMA(0, 1, At, B1); PG8_BAR;
            PG8_LDA(At, 1, 1); PG8_STAGE(PG8_SA(1, 0), a3, voffA);
            PG8_BAR; PG8_WAIT_L(0); PG8_MMA(1, 0, At, B0); PG8_BAR; PG8_SCHED;
            PG8_STAGE(PG8_SB(1, 1), b3 + hstep, voffB);
            PG8_WAIT_V(6); PG8_BAR; PG8_MMA(1, 1, At, B1); PG8_BAR;
            }
        }
        if constexpr (ALIGN_EPI) { if (wr == 0) PG8_BAR; }
        if constexpr (!Epi::AFTER_DRAIN) { E(acc, cur, wr, wc, fr, fq); S.done(cur); }
        if (!has_next) break;
#pragma unroll
        for (int a = 0; a < 2; ++a)
#pragma unroll
            for (int b = 0; b < 2; ++b)
#pragma unroll
                for (int m = 0; m < 4; ++m)
#pragma unroll
                    for (int n = 0; n < 2; ++n) acc[a][b][m][n] = (f32x4){0.f, 0.f, 0.f, 0.f};
        cur = nxt; cA = nA; cB = nB; ++ui;
        if constexpr (ALIGN_EPI) { if (wr == 1) PG8_BAR; }
    }
    PG8_WAIT_V(0);
    if constexpr (!ALIGN_EPI) { if (wr == 0) PG8_BAR; }
    PG8_BAR;
    if constexpr (Epi::AFTER_DRAIN) { E.fused(acc, cur, wr, wc, fr, fq, lds, wid, lane); S.done(cur); }
#undef PG8_KOFF
#undef PG8_PN
#undef PG8_SA
#undef PG8_SB
#undef PG8_STAGE
#undef PG8_LDA
#undef PG8_LDB
#undef PG8_MMA
#undef PG8_WAIT_V
#undef PG8_WAIT_L
#undef PG8_BAR
#undef PG8_SCHED
}
}

constexpr size_t MiB = 1u << 20;
constexpr size_t WS_CTL = 0, CTL_ZERO_BYTES = 1 * MiB;
constexpr size_t WS_MOD = 1 * MiB;
constexpr size_t WS_SHW1 = 2 * MiB;
constexpr size_t WS_SHW2 = 3 * MiB;
constexpr size_t WS_RSSA = 4 * MiB;
constexpr size_t WS_RSSB = 9 * MiB;
constexpr size_t WS_TOT = 14 * MiB;
constexpr size_t WS_CARRY = 19 * MiB;
constexpr size_t WS_WLR = 21 * MiB + 512 * 1024;
constexpr size_t WS_WIN = 22 * MiB;
constexpr size_t WS_WOUT = 32 * MiB;
constexpr size_t WS_W1 = 36 * MiB;
constexpr size_t WS_W2 = 52 * MiB;
constexpr size_t WS_CX = 68 * MiB;
constexpr size_t WS_XA = 84 * MiB;
constexpr size_t WS_HID = 156 * MiB;
constexpr size_t WS_PROJ = WS_HID;
constexpr size_t WS_MIX = WS_HID + 180 * MiB;
constexpr size_t WS_PART = 444 * MiB;
constexpr size_t WS_END = 508 * MiB;
static_assert(WS_MIX + (size_t)MT * D * 2 <= WS_PART && WS_HID + (size_t)MT * FF * 2 == WS_PART && WS_PART + (size_t)4 * MC * D * 4 == WS_END, "ws map");
constexpr size_t WS_ZERO = WS_CTL + 512 * 1024;
constexpr int CW_BAR = 4096;

constexpr int NWAVES = 8;
constexpr int RING_OFF = 0, RING_BYTES = 131072;
constexpr int LDSCTL_OFF = RING_BYTES, MISC_OFF = LDSCTL_OFF + 320;
constexpr int LDS_BYTES = 147456;

#define GAS __attribute__((address_space(1)))
#define LAS __attribute__((address_space(3)))
typedef unsigned short bf16;
typedef unsigned v4u __attribute__((ext_vector_type(4)));
typedef unsigned v2u __attribute__((ext_vector_type(2)));
typedef float f32x4 __attribute__((ext_vector_type(4)));
typedef float f32x2 __attribute__((ext_vector_type(2)));
typedef GAS unsigned gu32;
#define LDS_WAIT() asm volatile("s_waitcnt lgkmcnt(0)" ::: "memory")
#define VM_WAIT() asm volatile("s_waitcnt vmcnt(0)" ::: "memory")
__device__ __forceinline__ unsigned f2bf(float f) { unsigned u = __builtin_bit_cast(unsigned, f); return (u + 0x7fffu + ((u >> 16) & 1u)) >> 16; }
__device__ __forceinline__ unsigned pk2(float lo, float hi) { return f2bf(lo) | (f2bf(hi) << 16); }
__device__ __forceinline__ float bflo(unsigned w) { return __uint_as_float(w << 16); }
__device__ __forceinline__ float bfhi(unsigned w) { return __uint_as_float(w & 0xffff0000u); }
__device__ __forceinline__ float bf1(bf16 v) { return __uint_as_float((unsigned)v << 16); }
__device__ __forceinline__ float sigmoidf_(float x) { return __builtin_amdgcn_rcpf(1.f + __builtin_amdgcn_exp2f(-1.4426950408889634f * x)); }
__device__ __forceinline__ float siluf_(float x) { return x * sigmoidf_(x); }
__device__ __forceinline__ float gelu_tanh(float x) { const float u = 0.7978845608028654f * (x + 0.044715f * x * x * x); return x * sigmoidf_(2.f * u); }
__device__ __forceinline__ float wave_sum(float v) {
#pragma unroll
    for (int o = 1; o < 64; o <<= 1) v += __shfl_xor(v, o);
    return v;
}

#define XB_TMO      128
#define XB_XCNT(j)  (256  + 64 * (j))
#define XB_XSUB(j)  (1280 + 64 * (j))
#define XB_XGEN(j)  (2304 + 64 * (j))
#define XB_TOP      3328
#define XB_TOPGEN   3392
#define XCD_BAR_WORDS 3456
#define XB_SPIN_CAP (1u << 18)

__device__ __forceinline__ unsigned xb_ld(unsigned* p)              { return __hip_atomic_load(p, __ATOMIC_RELAXED, __HIP_MEMORY_SCOPE_AGENT); }
__device__ __forceinline__ unsigned xb_add(unsigned* p, unsigned v) { return __hip_atomic_fetch_add(p, v, __ATOMIC_RELAXED, __HIP_MEMORY_SCOPE_AGENT); }
__device__ __forceinline__ unsigned xb_xcc_id() { return (unsigned)__builtin_amdgcn_s_getreg((3 << 11) | 20) & 0xFu; }
#define XB_SPIN(cond, bar) do { unsigned _sp = 0; while (cond) { __builtin_amdgcn_s_sleep(1); \
    if ((++_sp & 255u) == 0u) { if (xb_ld(&(bar)[XB_TMO])) break; if (_sp > XB_SPIN_CAP) { atomicAdd(&(bar)[XB_TMO], 1u); break; } } } } while (0)

struct XcdBarrier {
    unsigned* bar; unsigned x;
    volatile LAS unsigned* st;
};

__device__ __forceinline__ XcdBarrier xcd_barrier_post(unsigned* bar, volatile LAS unsigned* st, int tid) {
    XcdBarrier b; b.bar = bar; b.x = xb_xcc_id(); b.st = st;
    if (tid == 0) (void)xb_add(&bar[XB_XCNT(b.x)], 1u);
    return b;
}
__device__ __forceinline__ void xcd_barrier_complete(unsigned* bar, unsigned x, unsigned& nloc, unsigned& nx) {
    const unsigned G = gridDim.x * gridDim.y * gridDim.z;
    unsigned sum, cnt, mine, sp = 0u;
    for (;;) {
        sum = 0u; cnt = 0u; mine = 0u;
#pragma unroll 1
        for (unsigned j = 0; j < 16; ++j) { const unsigned c = xb_ld(&bar[XB_XCNT(j)]); sum += c; cnt += (c > 0u) ? 1u : 0u; mine = (j == x) ? c : mine; }
        if (sum == G) break;
        __builtin_amdgcn_s_sleep(1);
        if ((++sp & 255u) == 0u) { if (xb_ld(&bar[XB_TMO])) break; if (sp > XB_SPIN_CAP) { atomicAdd(&bar[XB_TMO], 1u); break; } }
    }
    nloc = mine > 0u ? mine : 1u; nx = cnt > 0u ? cnt : 1u;
}

__device__ __forceinline__ void xcd_barrier(const XcdBarrier& b, int tid) {
    asm volatile("s_waitcnt vmcnt(0)" ::: "memory");
    __syncthreads();
    if (tid == 0) {
        unsigned* bar = b.bar;
        __builtin_amdgcn_s_waitcnt(0);
        unsigned nloc = b.st[0], nx = b.st[1];
        if (nloc == 0u) { xcd_barrier_complete(bar, b.x, nloc, nx); b.st[0] = nloc; b.st[1] = nx; }
        const unsigned old = xb_add(&bar[XB_XSUB(b.x)], 1u);
        const unsigned gen = old / nloc;
        if (old + 1u == (gen + 1u) * nloc) {
            __builtin_amdgcn_fence(__ATOMIC_RELEASE, "agent");
            asm volatile("s_waitcnt vmcnt(0)" ::: "memory");
            const unsigned og = xb_add(&bar[XB_TOP], 1u);
            const unsigned tg = og / nx;
            if (og + 1u == (tg + 1u) * nx) xb_add(&bar[XB_TOPGEN], 1u);
            else XB_SPIN(xb_ld(&bar[XB_TOPGEN]) == tg, bar);
            __builtin_amdgcn_fence(__ATOMIC_ACQUIRE, "agent");
            xb_add(&bar[XB_XGEN(b.x)], 1u);
            asm volatile("s_waitcnt vmcnt(0)" ::: "memory");
        } else {
            XB_SPIN(xb_ld(&bar[XB_XGEN(b.x)]) == gen, bar);
            __builtin_amdgcn_fence(__ATOMIC_ACQUIRE, "agent");
            asm volatile("s_waitcnt vmcnt(0)" ::: "memory");
        }
    }
    __syncthreads();
}

struct Frame {
    LAS unsigned char* lds;
    int tid, lane, wave;
    int vcu, G;
    int gw, NGW;
    float* out; unsigned char* ws;
};
constexpr int PTR_OFF = LDSCTL_OFF + 512;
__device__ __forceinline__ const float* inp_(LAS unsigned char* lds, int i) {
    const unsigned long long v = *(const LAS unsigned long long*)(lds + PTR_OFF + 8 * i);
    const unsigned lo = __builtin_amdgcn_readfirstlane((unsigned)v), hi = __builtin_amdgcn_readfirstlane((unsigned)(v >> 32));
    return (const float*)(((unsigned long long)hi << 32) | lo);
}
#define INP(i) inp_(F.lds, (i))
#define WSP(T, off) ((T*)(F.ws + (off)))

__device__ __forceinline__ void gemv17_item(Frame& F, const LAS float* tab, LAS float* red, const float* W, int ldw, int n0, const float* bias, float* outp, int ldo) {
    float acc[17];
#pragma unroll
    for (int r = 0; r < 17; ++r) acc[r] = 0.f;
    const int k0 = F.wave * 128;
    const float* wp = W + (size_t)k0 * ldw + n0 + F.lane;
#pragma unroll 1
    for (int kk = 0; kk < 128; kk += 32) {
        float wv[32];
#pragma unroll
        for (int k = 0; k < 32; ++k) wv[k] = wp[(size_t)(kk + k) * ldw];
#pragma unroll
        for (int k = 0; k < 32; ++k) {
#pragma unroll
            for (int r = 0; r < 17; ++r) acc[r] += tab[r * 1024 + k0 + kk + k] * wv[k];
        }
    }
#pragma unroll
    for (int r = 0; r < 17; ++r) red[(F.wave * 17 + r) * 64 + F.lane] = acc[r];
    __syncthreads();
    for (int i = F.tid; i < 17 * 64; i += NWAVES * 64) {
        const int r = i >> 6, n = i & 63; float s = bias ? bias[n0 + n] : 0.f;
#pragma unroll
        for (int w = 0; w < 8; ++w) s += red[(w * 17 + r) * 64 + n];
        outp[(size_t)r * ldo + n0 + n] = s;
    }
    __syncthreads();
}

__device__ __forceinline__ void p0_transpose_item(const float* W, int K, int N, bf16* WT, LAS float* scr, int item, int lane) {
    const int nblk = N / 32, kb = item / nblk, nb = item % nblk, k0 = 64 * kb, n0 = 32 * nb;
    float tv[32];
#pragma unroll
    for (int i = 0; i < 32; ++i) { const int kk = 2 * i + (lane >> 5); tv[i] = W[(size_t)(k0 + kk) * N + n0 + (lane & 31)]; }
#pragma unroll
    for (int i = 0; i < 32; ++i) { const int kk = 2 * i + (lane >> 5); scr[kk * 33 + (lane & 31)] = tv[i]; }
    LDS_WAIT(); asm volatile("" ::: "memory");
    const int c = lane & 7;
#pragma unroll
    for (int j = 0; j < 4; ++j) { const int n = (lane >> 3) + 8 * j; const LAS float* s = scr + (8 * c) * 33 + n;
        v4u o; o.x = pk2(s[0 * 33], s[1 * 33]); o.y = pk2(s[2 * 33], s[3 * 33]); o.z = pk2(s[4 * 33], s[5 * 33]); o.w = pk2(s[6 * 33], s[7 * 33]);
        *(GAS v4u*)(WT + (size_t)(n0 + n) * K + k0 + 8 * c) = o; }
    LDS_WAIT(); asm volatile("" ::: "memory");
}

__device__ __forceinline__ void phase_p0a(Frame& F) {
    LAS float* tab = (LAS float*)(F.lds);
    LAS float* red = (LAS float*)(F.lds + 17 * 1024 * 4);
    float* MOD = WSP(float, WS_MOD);
    bool filled = false;
    for (int it = F.vcu; it < 2 * 96; it += F.G) {
        if (!filled) {
            for (int i = F.tid; i < 17 * 1024; i += NWAVES * 64) { const int r = i >> 10, k = i & 1023; const float v = (r < 16) ? INP(1)[r * D + k] : INP(3)[k]; tab[i] = siluf_(v); }
            __syncthreads(); filled = true;
        }
        const int l = it / 96, n0 = (it % 96) * 64;
        gemv17_item(F, tab, red, INP(6) + (size_t)l * D * MODW, MODW, n0, INP(7) + (size_t)l * MODW, MOD + (size_t)l * 17 * MODW, MODW);
    }
    __syncthreads();
    {
        bf16* WLR = WSP(bf16, WS_WLR);
        for (int i = F.gw * 64 + F.lane; i < 2 * 2 * 4 * 2 * 4096; i += F.NGW * 64) { const int d = i & 63, e = (i >> 6) & 63, gt = (i >> 12) & 1, blk = i >> 13;
            const float* src = gt == 0 ? INP(17) : INP(19); WLR[i] = (bf16)f2bf(src[((size_t)blk * 64 + d) * 64 + e]); }
    }
    LAS float* scr = (LAS float*)(F.lds + F.wave * 16384);
    constexpr int I_IN = (D / 64) * (IND / 32), I_OUT = (D / 64) * (D / 32), I_1 = (D / 64) * (FF / 32), I_2 = (FF / 64) * (D / 32), I_L = I_IN + I_OUT + I_1 + I_2;
    for (int it = F.gw; it < 2 * I_L; it += F.NGW) {
        const int l = it / I_L; int r = it % I_L;
        const float* W; bf16* WT; int K = D, N;
        if (r < I_IN) { W = INP(8) + (size_t)l * D * IND; WT = WSP(bf16, WS_WIN) + (size_t)l * IND * D; N = IND; }
        else if (r < I_IN + I_OUT) { r -= I_IN; W = INP(9) + (size_t)l * D * D; WT = WSP(bf16, WS_WOUT) + (size_t)l * D * D; N = D; }
        else if (r < I_IN + I_OUT + I_1) { r -= I_IN + I_OUT; W = INP(22) + (size_t)l * D * FF; WT = WSP(bf16, WS_W1) + (size_t)l * FF * D; N = FF; }
        else { r -= I_IN + I_OUT + I_1; W = INP(23) + (size_t)l * FF * D; WT = WSP(bf16, WS_W2) + (size_t)l * D * FF; K = FF; N = D; }
        p0_transpose_item(W, K, N, WT, scr, r, F.lane);
    }
}

__device__ __forceinline__ void phase_p0b(Frame& F) {
    LAS float* tab = (LAS float*)(F.lds);
    LAS float* red = (LAS float*)(F.lds + 17 * 1024 * 4);
    const float* MOD = WSP(const float, WS_MOD);
    for (int it = F.vcu; it < 2 * 104; it += F.G) {
        const int l = it / 104, j = it % 104; const bool first = j < 40;
        const int shoff = first ? 0 : 3 * D;
        __syncthreads();
        for (int i = F.tid; i < 17 * 1024; i += NWAVES * 64) { const int r = i >> 10, k = i & 1023; tab[i] = MOD[((size_t)l * 17 + r) * MODW + shoff + k]; }
        __syncthreads();
        const int ldw = first ? IND : FF;
        gemv17_item(F, tab, red, first ? INP(8) + (size_t)l * D * IND : INP(22) + (size_t)l * D * FF, ldw, (first ? j : j - 40) * 64, nullptr,
                    first ? WSP(float, WS_SHW1) + (size_t)l * 17 * IND : WSP(float, WS_SHW2) + (size_t)l * 17 * FF, ldw);
    }
    bf16* XA = WSP(bf16, WS_XA); float* RSSA = WSP(float, WS_RSSA);
    const float* g1 = INP(4);
    for (int row = F.gw; row < MT; row += 2 * F.NGW) {
        f32x4 v[2][4]; float ss[2]; int rw[2]; const float* scp[2];
#pragma unroll
        for (int q = 0; q < 2; ++q) { int r_ = row + q * F.NGW; if (r_ >= MT) r_ = row; rw[q] = r_;
            const bool lat = r_ < ML;
            const float* xr = lat ? INP(0) + (size_t)r_ * D : INP(2) + (size_t)(r_ - ML) * D;
            scp[q] = MOD + (size_t)(lat ? (r_ >> 11) : NB) * MODW + D;
#pragma unroll
            for (int j = 0; j < 4; ++j) v[q][j] = *(const f32x4*)(xr + 4 * F.lane + 256 * j); }
#pragma unroll
        for (int q = 0; q < 2; ++q) { float s_ = 0.f;
#pragma unroll
            for (int j = 0; j < 4; ++j) s_ += (v[q][j][0] * v[q][j][0] + v[q][j][1] * v[q][j][1]) + (v[q][j][2] * v[q][j][2] + v[q][j][3] * v[q][j][3]);
            ss[q] = wave_sum(s_); }
#pragma unroll
        for (int q = 0; q < 2; ++q) { if (q == 1 && rw[1] == row) break;
            if (F.lane < 32) RSSA[(size_t)rw[q] * 32 + F.lane] = (F.lane == 0) ? ss[q] : 0.f;
#pragma unroll
            for (int j = 0; j < 4; ++j) { const int k = 4 * F.lane + 256 * j;
                const f32x4 gm = *(const f32x4*)(g1 + k) * (*(const f32x4*)(scp[q] + k) + 1.0f), a = v[q][j] * gm;
                v2u o; o.x = pk2(a[0], a[1]); o.y = pk2(a[2], a[3]); *(v2u*)(XA + (size_t)rw[q] * D + k) = o; } }
    }
}

constexpr int CV_OSROW = 260;
__device__ __forceinline__ void conv_phase(Frame& F, int l, int ntiles) {
    const bf16* PROJ = WSP(const bf16, WS_PROJ); bf16* MIX = WSP(bf16, WS_MIX);
    LAS float* us = (LAS float*)(F.lds);
    LAS float* os = (LAS float*)(F.lds + 62 * 256 * 4);
    const int c = F.tid & 255, half = F.tid >> 8;
    float w[31];
#pragma unroll
    for (int k = 0; k < 31; ++k) w[k] = INP(10)[((size_t)l * 31 + k) * 256 + c];
    const float cbias = INP(11)[l * 256 + c];
    const f32x4 lg = *(const f32x4*)(INP(12) + l * 256 + 4 * F.lane), lb = *(const f32x4*)(INP(13) + l * 256 + 4 * F.lane);
    unsigned pv[16], pg[16];
    auto load_tile = [&](int T) {
        const int row0 = T * 32;
        int lo, hi; if (row0 < ML) { lo = row0 & ~(SEQ - 1); hi = lo + SEQ; } else { lo = row0 & ~(CTXL - 1); hi = lo + CTXL; }
#pragma unroll
        for (int j = 0; j < 16; ++j) { const int i = F.tid + 512 * j, rr = i >> 7, cp = i & 127, row = row0 - 15 + rr;
            const bool ok = (j < 15 || F.tid < 256) && row >= lo && row < hi;
            pv[j] = ok ? *(const unsigned*)(PROJ + (size_t)row * IND + 2 * cp) : 0u; pg[j] = ok ? *(const unsigned*)(PROJ + (size_t)row * IND + 256 + 2 * cp) : 0u; }
    };
    if (F.vcu < ntiles) load_tile(F.vcu);
    for (int T = F.vcu; T < ntiles; T += F.G) {
        const int row0 = T * 32;
        __syncthreads();
#pragma unroll
        for (int j = 0; j < 16; ++j) { const int i = F.tid + 512 * j;
            if (j < 15 || F.tid < 256) { f32x2 u; u[0] = bflo(pv[j]) * sigmoidf_(bflo(pg[j])); u[1] = bfhi(pv[j]) * sigmoidf_(bfhi(pg[j])); *(LAS f32x2*)(us + 2 * i) = u; } }
        if (T + F.G < ntiles) load_tile(T + F.G);
        __syncthreads();
        {
            float acc[16];
#pragma unroll
            for (int j = 0; j < 16; ++j) acc[j] = cbias;
            const LAS float* up = us + (16 * half) * 256 + c;
#pragma unroll
            for (int i = 0; i < 46; ++i) { const float x = up[i * 256];
#pragma unroll
                for (int j = 0; j < 16; ++j) if (i - j >= 0 && i - j <= 30) acc[j] += w[i - j] * x; }
#pragma unroll
            for (int j = 0; j < 16; ++j) os[(16 * half + j) * CV_OSROW + c] = acc[j];
        }
        __syncthreads();
#pragma unroll
        for (int q = 0; q < 4; ++q) { const int t = 4 * F.wave + q;
            const f32x4 v = *(const LAS f32x4*)(os + t * CV_OSROW + 4 * F.lane);
            const float mu = wave_sum((v[0] + v[1]) + (v[2] + v[3])) * (1.f / 256.f);
            const f32x4 d = v - mu;
            const float var = wave_sum((d[0] * d[0] + d[1] * d[1]) + (d[2] * d[2] + d[3] * d[3])) * (1.f / 256.f);
            const f32x4 y = d * rsqrtf(var + EPS) * lg + lb;
            v2u o; o.x = pk2(siluf_(y[0]), siluf_(y[1])); o.y = pk2(siluf_(y[2]), siluf_(y[3]));
            *(v2u*)(MIX + (size_t)(row0 + t) * D + 4 * F.lane) = o; }
    }
}

typedef short s16x8 __attribute__((ext_vector_type(8)));
typedef short s16x4 __attribute__((ext_vector_type(4)));
constexpr int NA_KROW = 144, NA_VROW = 160;
constexpr int NA_STAGE = 64 * NA_KROW + 64 * NA_VROW, NA_OFF_TB = 2 * NA_STAGE;
constexpr int NA_ITEMS_LAT = NB * NH * 8, NA_ITEMS_CTX = NB * NH * 2;
struct NaBlk { f32x4 O[4]; float m, lsum; int first; };
__device__ __forceinline__ int na_rs(int r) { int v = r - 4; return v < 0 ? 0 : (v > 24 ? 24 : v); }
__device__ __forceinline__ s16x8 na_scale_q(v4u w, float c) {
    v4u o; o.x = pg8::cvt_pk_bf16(bflo(w.x) * c, bfhi(w.x) * c); o.y = pg8::cvt_pk_bf16(bflo(w.y) * c, bfhi(w.y) * c); o.z = pg8::cvt_pk_bf16(bflo(w.z) * c, bfhi(w.z) * c); o.w = pg8::cvt_pk_bf16(bflo(w.w) * c, bfhi(w.w) * c);
    return __builtin_bit_cast(s16x8, o);
}
__device__ __forceinline__ void na_phase(Frame& F, int l, int nitems, int nav = 0) {
    const bf16* PROJ = WSP(const bf16, WS_PROJ); bf16* MIX = WSP(bf16, WS_MIX);
    LAS float* tb = (LAS float*)(F.lds + NA_OFF_TB);
    const int lane = F.lane, q16 = lane & 15, g = lane >> 4;
    const unsigned skey = (unsigned)(F.tid >> 3), spart = (unsigned)(F.tid & 7);
    const float c1 = 0.125f * 1.4426950408889634f;
    for (int it = F.vcu; it < nitems; it += F.G) {
        const bool isctx = it >= NA_ITEMS_LAT;
        int b, h, ra = 0, jq = 0, qrow0, rsI = 0, nloc = 0;
        if (!isctx) { const int r4 = it & 7; h = (it >> 3) & 7; b = it >> 6; const int r0 = 4 * r4; ra = r0 + 2 * (F.wave >> 2); jq = F.wave & 3; qrow0 = b * SEQ + ra * 64 + jq * 16;
            rsI = na_rs(r0); nloc = na_rs(r0 + 3) + 8 - rsI; }
        else { const int j = it - NA_ITEMS_LAT; const int hf = j & 1; h = (j >> 1) & 7; b = j >> 4; qrow0 = ML + b * CTXL + hf * 128 + F.wave * 16; }
        const int nch = nloc + 4;
        const bf16* Pq = PROJ + 512 + h * HD, * Pk = PROJ + 1024 + h * HD + 8 * spart, * Pv = PROJ + 1536 + h * HD + 8 * spart;
        auto krow_of = [&](int ch) -> int { return ch < nloc ? b * SEQ + (rsI + ch) * 64 : ML + b * CTXL + (ch - nloc) * 64; };
        s16x8 qfA[2], qfB[2];
#pragma unroll
        for (int s_ = 0; s_ < 2; ++s_) { qfA[s_] = na_scale_q(*(const v4u*)(Pq + (size_t)(qrow0 + q16) * IND + 32 * s_ + 8 * g), c1);
            qfB[s_] = isctx ? qfA[s_] : na_scale_q(*(const v4u*)(Pq + (size_t)(qrow0 + 64 + q16) * IND + 32 * s_ + 8 * g), c1); }
        const int rsA = na_rs(ra), rsB = na_rs(ra + 1);
        const int o0 = jq == 0 ? 0 : 16 * jq - 8, o1 = jq == 0 ? 16 : (jq == 3 ? 48 : 16 * jq + 8);
        float madd[2][4]; int lb[2];
        {
            const int qc = jq * 16 + q16; int cs = qc - 8; cs = cs < 0 ? 0 : (cs > 48 ? 48 : cs);
#pragma unroll
            for (int e = 0; e < 4; ++e) { const int k0 = o0 + 4 * g + e, k1 = o1 + 4 * g + e;
                madd[0][e] = ((unsigned)(k0 - cs) < 16u) ? 0.f : -1.0e30f;
                madd[1][e] = (((unsigned)(k1 - cs) < 16u) && !(jq == 3 && k1 < 56)) ? 0.f : -1.0e30f; }
            lb[0] = 64 + o0 + 4 * g - qc + 15; lb[1] = 64 + o1 + 4 * g - qc + 15;
        }
        v4u kr_ = *(const v4u*)(Pk + (size_t)(krow_of(0) + (int)skey) * IND), vr_ = *(const v4u*)(Pv + (size_t)(krow_of(0) + (int)skey) * IND);
        __syncthreads();
        if (!isctx) { const float* rpb = INP(14) + ((size_t)l * NH + h) * 15 * 31;
            for (int i = F.tid; i < 640; i += NWAVES * 64) tb[i] = (i >= 64 && i < 64 + 465) ? rpb[i - 64] * 1.4426950408889634f : 0.f; }
        *(LAS v4u*)(F.lds + skey * NA_KROW + spart * 16) = kr_; *(LAS v4u*)(F.lds + 64 * NA_KROW + skey * NA_VROW + spart * 16) = vr_;
        kr_ = *(const v4u*)(Pk + (size_t)(krow_of(1) + (int)skey) * IND); vr_ = *(const v4u*)(Pv + (size_t)(krow_of(1) + (int)skey) * IND);
        NaBlk A, B;
#pragma unroll
        for (int dt = 0; dt < 4; ++dt) { A.O[dt] = (f32x4){0.f, 0.f, 0.f, 0.f}; B.O[dt] = (f32x4){0.f, 0.f, 0.f, 0.f}; }
        A.m = 0.f; A.lsum = 0.f; A.first = 1; B.m = 0.f; B.lsum = 0.f; B.first = 1;
        for (int ch = 0; ch < nch; ++ch) {
            __syncthreads();
            LAS unsigned char* cur = F.lds + (ch & 1) * NA_STAGE; LAS unsigned char* nxt = F.lds + ((ch + 1) & 1) * NA_STAGE;
            if (ch + 1 < nch) { *(LAS v4u*)(nxt + skey * NA_KROW + spart * 16) = kr_; *(LAS v4u*)(nxt + 64 * NA_KROW + skey * NA_VROW + spart * 16) = vr_; }
            if (ch + 2 < nch) { const int k2 = krow_of(ch + 2) + (int)skey; kr_ = *(const v4u*)(Pk + (size_t)k2 * IND); vr_ = *(const v4u*)(Pv + (size_t)k2 * IND); }
            const bool local = ch < nloc;
            const int kr = rsI + ch;
            const bool actA = !local || (kr >= rsA && kr <= rsA + 7), actB = !isctx && (!local || (kr >= rsB && kr <= rsB + 7));
            if ((!actA && !actB) || nav == 1) continue;
            auto finish = [&](f32x4* S, int nt_, NaBlk& X, unsigned (*pk)[2], float cm) {
                if (X.first || !__all(cm <= 8.f)) {
                    cm = fmaxf(cm, __shfl_xor(cm, 16)); cm = fmaxf(cm, __shfl_xor(cm, 32));
                    const float d = X.first ? cm : fmaxf(cm, 0.f);
                    if (!X.first) { const float alpha = __builtin_amdgcn_exp2f(-d); X.lsum *= alpha;
#pragma unroll
                        for (int dt = 0; dt < 4; ++dt) X.O[dt] = X.O[dt] * alpha; }
                    X.m += d; X.first = 0;
#pragma unroll
                    for (int t = 0; t < 4; ++t) if (t < nt_) S[t] = S[t] - d;
                }
                float ps = 0.f;
#pragma unroll
                for (int t = 0; t < 4; ++t) if (t < nt_) {
                    const float p0 = __builtin_amdgcn_exp2f(S[t][0]), p1 = __builtin_amdgcn_exp2f(S[t][1]), p2 = __builtin_amdgcn_exp2f(S[t][2]), p3 = __builtin_amdgcn_exp2f(S[t][3]);
                    ps += (p0 + p1) + (p2 + p3);
                    pk[t][0] = pg8::cvt_pk_bf16(p0, p1); pk[t][1] = pg8::cvt_pk_bf16(p2, p3); }
                X.lsum += ps;
            };
            unsigned pkA[4][2], pkB[4][2];
            if (local) {
                const LAS unsigned char* kb_ = cur + q16 * NA_KROW + 16 * g;
                f32x4 SA[2], SB[2];
#pragma unroll
                for (int t = 0; t < 2; ++t) { const float ma = -A.m, mb = -B.m; SA[t] = (f32x4){ma, ma, ma, ma}; SB[t] = (f32x4){mb, mb, mb, mb};
                    const int o = t == 0 ? o0 : o1;
#pragma unroll
                    for (int s_ = 0; s_ < 2; ++s_) { const s16x8 kf = *(const LAS s16x8*)(kb_ + o * NA_KROW + 64 * s_);
                        if (actA) SA[t] = __builtin_amdgcn_mfma_f32_16x16x32_bf16(kf, qfA[s_], SA[t], 0, 0, 0);
                        if (actB) SB[t] = __builtin_amdgcn_mfma_f32_16x16x32_bf16(kf, qfB[s_], SB[t], 0, 0, 0); } }
                if (nav == 2) { asm volatile("" :: "v"(SA[0]), "v"(SA[1]), "v"(SB[0]), "v"(SB[1])); continue; }
                auto soft_local = [&](f32x4 (&S)[2], NaBlk& X, unsigned (&pk)[4][2], int rq) {
                    float cm = -1.0e30f;
#pragma unroll
                    for (int t = 0; t < 2; ++t) { const LAS float* tr_ = tb + (kr - rq + 7) * 31 + lb[t];
#pragma unroll
                        for (int e = 0; e < 4; ++e) { const float v = (S[t][e] + tr_[e]) + madd[t][e]; S[t][e] = v; cm = fmaxf(cm, v); } }
                    finish(S, 2, X, pk, cm);
                };
                if (actA) soft_local(SA, A, pkA, ra);
                if (actB) soft_local(SB, B, pkB, ra + 1);
                if (nav == 3) { asm volatile("" :: "v"(pkA[0][0]), "v"(pkA[1][1]), "v"(pkB[0][0]), "v"(pkB[1][1])); continue; }
                const LAS unsigned char* vtr = cur + 64 * NA_KROW + (4 * g + (q16 >> 2)) * NA_VROW + (q16 & 3) * 8;
                const v4u bwA = {pkA[0][0], pkA[0][1], pkA[1][0], pkA[1][1]}, bwB = {pkB[0][0], pkB[0][1], pkB[1][0], pkB[1][1]};
                const s16x8 bfA = __builtin_bit_cast(s16x8, bwA), bfB = __builtin_bit_cast(s16x8, bwB);
#pragma unroll
                for (int dt = 0; dt < 4; ++dt) {
                    const s16x4 a0 = __builtin_amdgcn_ds_read_tr16_b64_v4i16((LAS s16x4*)(vtr + o0 * NA_VROW + dt * 32));
                    const s16x4 a1 = __builtin_amdgcn_ds_read_tr16_b64_v4i16((LAS s16x4*)(vtr + o1 * NA_VROW + dt * 32));
                    const s16x8 afrag = __builtin_shufflevector(a0, a1, 0, 1, 2, 3, 4, 5, 6, 7);
                    if (actA) A.O[dt] = __builtin_amdgcn_mfma_f32_16x16x32_bf16(afrag, bfA, A.O[dt], 0, 0, 0);
                    if (actB) B.O[dt] = __builtin_amdgcn_mfma_f32_16x16x32_bf16(afrag, bfB, B.O[dt], 0, 0, 0);
                }
            } else {
                const LAS unsigned char* kb_ = cur + q16 * NA_KROW + 16 * g;
                f32x4 SA[4], SB[4];
#pragma unroll
                for (int t = 0; t < 4; ++t) { const float ma = -A.m, mb = -B.m; SA[t] = (f32x4){ma, ma, ma, ma}; SB[t] = (f32x4){mb, mb, mb, mb};
#pragma unroll
                    for (int s_ = 0; s_ < 2; ++s_) { const s16x8 kf = *(const LAS s16x8*)(kb_ + t * 16 * NA_KROW + 64 * s_);
                        SA[t] = __builtin_amdgcn_mfma_f32_16x16x32_bf16(kf, qfA[s_], SA[t], 0, 0, 0);
                        if (actB) SB[t] = __builtin_amdgcn_mfma_f32_16x16x32_bf16(kf, qfB[s_], SB[t], 0, 0, 0); } }
                if (nav == 2) { asm volatile("" :: "v"(SA[0]), "v"(SA[1]), "v"(SA[2]), "v"(SA[3]), "v"(SB[0]), "v"(SB[1]), "v"(SB[2]), "v"(SB[3])); continue; }
                auto soft_ctx = [&](f32x4 (&S)[4], NaBlk& X, unsigned (&pk)[4][2]) {
                    float cm = -1.0e30f;
#pragma unroll
                    for (int t = 0; t < 4; ++t)
#pragma unroll
                        for (int e = 0; e < 4; ++e) cm = fmaxf(cm, S[t][e]);
                    finish(S, 4, X, pk, cm);
                };
                soft_ctx(SA, A, pkA);
                if (actB) soft_ctx(SB, B, pkB);
                if (nav == 3) { asm volatile("" :: "v"(pkA[0][0]), "v"(pkA[1][1]), "v"(pkA[2][0]), "v"(pkA[3][1]), "v"(pkB[0][0]), "v"(pkB[1][1]), "v"(pkB[2][0]), "v"(pkB[3][1])); continue; }
                const LAS unsigned char* vtr = cur + 64 * NA_KROW + (4 * g + (q16 >> 2)) * NA_VROW + (q16 & 3) * 8;
#pragma unroll
                for (int p = 0; p < 2; ++p) {
                    const v4u bwA = {pkA[2 * p][0], pkA[2 * p][1], pkA[2 * p + 1][0], pkA[2 * p + 1][1]}, bwB = {pkB[2 * p][0], pkB[2 * p][1], pkB[2 * p + 1][0], pkB[2 * p + 1][1]};
                    const s16x8 bfA = __builtin_bit_cast(s16x8, bwA), bfB = __builtin_bit_cast(s16x8, bwB);
#pragma unroll
                    for (int dt = 0; dt < 4; ++dt) {
                        const s16x4 a0 = __builtin_amdgcn_ds_read_tr16_b64_v4i16((LAS s16x4*)(vtr + (2 * p) * 16 * NA_VROW + dt * 32));
                        const s16x4 a1 = __builtin_amdgcn_ds_read_tr16_b64_v4i16((LAS s16x4*)(vtr + (2 * p + 1) * 16 * NA_VROW + dt * 32));
                        const s16x8 afrag = __builtin_shufflevector(a0, a1, 0, 1, 2, 3, 4, 5, 6, 7);
                        A.O[dt] = __builtin_amdgcn_mfma_f32_16x16x32_bf16(afrag, bfA, A.O[dt], 0, 0, 0);
                        if (actB) B.O[dt] = __builtin_amdgcn_mfma_f32_16x16x32_bf16(afrag, bfB, B.O[dt], 0, 0, 0);
                    }
                }
            }
        }
        {
            float ls = A.lsum; ls += __shfl_xor(ls, 16); ls += __shfl_xor(ls, 32);
            const float inv = __builtin_amdgcn_rcpf(ls);
            bf16* op = MIX + (size_t)(qrow0 + q16) * D + 256 + h * HD + 4 * g;
#pragma unroll
            for (int dt = 0; dt < 4; ++dt) { v2u w; w.x = pg8::cvt_pk_bf16(A.O[dt][0] * inv, A.O[dt][1] * inv); w.y = pg8::cvt_pk_bf16(A.O[dt][2] * inv, A.O[dt][3] * inv); *(v2u*)(op + 16 * dt) = w; }
        }
        if (!isctx) {
            float ls = B.lsum; ls += __shfl_xor(ls, 16); ls += __shfl_xor(ls, 32);
            const float inv = __builtin_amdgcn_rcpf(ls);
            bf16* op = MIX + (size_t)(qrow0 + 64 + q16) * D + 256 + h * HD + 4 * g;
#pragma unroll
            for (int dt = 0; dt < 4; ++dt) { v2u w; w.x = pg8::cvt_pk_bf16(B.O[dt][0] * inv, B.O[dt][1] * inv); w.y = pg8::cvt_pk_bf16(B.O[dt][2] * inv, B.O[dt][3] * inv); *(v2u*)(op + 16 * dt) = w; }
        }
    }
}

constexpr int LRU_UCROW = 260;
constexpr int LRU_OFF_UC = 38 * 256 * 2, LRU_OFF_GT = LRU_OFF_UC + 2 * 32 * LRU_UCROW * 4;
static_assert(LRU_OFF_GT + 32 * 256 * 2 <= RING_BYTES, "LRU LDS map");
template <int PASS>
__device__ __forceinline__ void lru_phase(Frame& F, int l, int ntiles) {
    const bf16* PROJ = WSP(const bf16, WS_PROJ);
    LAS bf16* rxs = (LAS bf16*)(F.lds);
    LAS float* ucf = (LAS float*)(F.lds + LRU_OFF_UC);
    LAS bf16* gts = (LAS bf16*)(F.lds + LRU_OFF_GT);
    const int lane = F.lane, j16 = lane & 15, g = lane >> 4;
    const int kb = F.wave & 3, nh = F.wave >> 2;
    s16x8 wf[2][2][2][2];
    float cbx[2][2], cba[2][2], csp[2][2];
#pragma unroll
    for (int dir = 0; dir < 2; ++dir) {
        const int ld = l * 2 + dir;
        const bf16* WLR = WSP(const bf16, WS_WLR) + (size_t)((ld * 4 + kb) * 2) * 4096;
#pragma unroll
        for (int gt = 0; gt < 2; ++gt)
#pragma unroll
            for (int n2 = 0; n2 < 2; ++n2)
#pragma unroll
                for (int s_ = 0; s_ < 2; ++s_) wf[dir][gt][n2][s_] = *(const s16x8*)(WLR + gt * 4096 + (16 * (2 * nh + n2) + j16) * 64 + 32 * s_ + 8 * g);
#pragma unroll
        for (int n2 = 0; n2 < 2; ++n2) {
            const int e = kb * 64 + 16 * (2 * nh + n2) + j16, idx = ld * 256 + e;
            cbx[dir][n2] = INP(18)[idx]; cba[dir][n2] = INP(20)[idx];
            const float nl = -INP(21)[idx]; csp[dir][n2] = -8.f * (fmaxf(nl, 0.f) + log1pf(__expf(-fabsf(nl))));
        }
    }
    const int c = F.tid & 255, sdir = F.tid >> 8;
    const int sld = l * 2 + sdir;
    const float s1w0 = INP(15)[(sld * 4 + 0) * 256 + c], s1w1 = INP(15)[(sld * 4 + 1) * 256 + c], s1w2 = INP(15)[(sld * 4 + 2) * 256 + c], s1w3 = INP(15)[(sld * 4 + 3) * 256 + c], s1cb = INP(16)[sld * 256 + c];
    const int base = sdir == 0 ? 0 : 3;
    unsigned pre[10], pgw[8];
    auto load_tile = [&](int T) {
        const int row0 = T * 32;
        int lo, hi; if (row0 < ML) { lo = row0 & ~(SEQ - 1); hi = lo + SEQ; } else { lo = row0 & ~(CTXL - 1); hi = lo + CTXL; }
#pragma unroll
        for (int j = 0; j < 10; ++j) { const int i = F.tid + 512 * j, rr = i >> 7, cp = i & 127, row = row0 - 3 + rr;
            const bool ok = (j < 9 || F.tid < 256) && row >= lo && row < hi;
            pre[j] = ok ? *(const unsigned*)(PROJ + (size_t)row * IND + 2048 + 2 * cp) : 0u; }
        if (PASS == 1) {
#pragma unroll
            for (int j = 0; j < 8; ++j) { const int i = F.tid + 512 * j, t = i >> 7, cp = i & 127; pgw[j] = *(const unsigned*)(PROJ + (size_t)(row0 + t) * IND + 2304 + 2 * cp); }
        }
    };
    if (F.vcu < ntiles) load_tile(F.vcu);
    for (int T = F.vcu; T < ntiles; T += F.G) {
        const int row0 = T * 32;
        __syncthreads();
#pragma unroll
        for (int j = 0; j < 10; ++j) { const int i = F.tid + 512 * j; if (j < 9 || F.tid < 256) ((LAS unsigned*)rxs)[i] = pre[j]; }
        if (PASS == 1) {
#pragma unroll
            for (int j = 0; j < 8; ++j) ((LAS unsigned*)gts)[F.tid + 512 * j] = pgw[j];
        }
        if (T + F.G < ntiles) load_tile(T + F.G);
        float hst[2][2];
#pragma unroll
        for (int dir = 0; dir < 2; ++dir)
#pragma unroll
            for (int n2 = 0; n2 < 2; ++n2) hst[dir][n2] = PASS == 1 ? WSP(const float, WS_CARRY)[((size_t)dir * 1152 + T) * 256 + kb * 64 + 16 * (2 * nh + n2) + j16] : 0.f;
        __syncthreads();
        {
            float x0 = bf1(rxs[(base + 0) * 256 + c]), x1 = bf1(rxs[(base + 1) * 256 + c]), x2 = bf1(rxs[(base + 2) * 256 + c]);
#pragma unroll 8
            for (int t = 0; t < 32; ++t) {
                const float x3 = bf1(rxs[(t + base + 3) * 256 + c]);
                ucf[(sdir * 32 + t) * LRU_UCROW + c] = s1cb + s1w0 * x0 + s1w1 * x1 + s1w2 * x2 + s1w3 * x3;
                x0 = x1; x1 = x2; x2 = x3;
            }
        }
        __syncthreads();
        float hf[2][2][4];
        float Pt[2][2] = {{1.f, 1.f}, {1.f, 1.f}};
#pragma unroll
        for (int dir = 0; dir < 2; ++dir) {
            const bool sec16 = ((g & 1) != 0) != (dir != 0), sec32 = ((g >> 1) != 0) != (dir != 0);
#pragma unroll
            for (int step = 0; step < 2; ++step) {
                const int rt = dir == 0 ? step : 1 - step;
                s16x8 af[2];
#pragma unroll
                for (int s_ = 0; s_ < 2; ++s_) { const LAS float* up = ucf + (dir * 32 + 16 * rt + j16) * LRU_UCROW + kb * 64 + 32 * s_ + 8 * g;
                    const f32x4 u0 = *(const LAS f32x4*)up, u1 = *(const LAS f32x4*)(up + 4);
                    const v4u w = {pg8::cvt_pk_bf16(u0[0], u0[1]), pg8::cvt_pk_bf16(u0[2], u0[3]), pg8::cvt_pk_bf16(u1[0], u1[1]), pg8::cvt_pk_bf16(u1[2], u1[3])};
                    af[s_] = __builtin_bit_cast(s16x8, w); }
#pragma unroll
                for (int n2 = 0; n2 < 2; ++n2) {
                    f32x4 zx = {0.f, 0.f, 0.f, 0.f}, za = {0.f, 0.f, 0.f, 0.f};
#pragma unroll
                    for (int s_ = 0; s_ < 2; ++s_) { zx = __builtin_amdgcn_mfma_f32_16x16x32_bf16(af[s_], wf[dir][0][n2][s_], zx, 0, 0, 0); za = __builtin_amdgcn_mfma_f32_16x16x32_bf16(af[s_], wf[dir][1][n2][s_], za, 0, 0, 0); }
                    const int e = kb * 64 + 16 * (2 * nh + n2) + j16;
                    const LAS float* uo = ucf + (dir * 32 + 16 * rt + 4 * g) * LRU_UCROW + e;
                    float a_[4], b_[4];
#pragma unroll
                    for (int r = 0; r < 4; ++r) {
                        const float u = uo[r * LRU_UCROW];
                        const float gx = sigmoidf_(zx[r] + cbx[dir][n2]), ga = sigmoidf_(za[r] + cba[dir][n2]);
                        const float la = csp[dir][n2] * ga, a = __builtin_amdgcn_exp2f(1.4426950408889634f * la), y = 2.f * la;
                        const float om = y > -0.02f ? -y * (1.f + y * (0.5f + y * 0.16666667f)) : 1.f - a * a;
                        a_[r] = a; b_[r] = __builtin_amdgcn_sqrtf(om) * gx * u;
                    }
                    const float P = (a_[0] * a_[1]) * (a_[2] * a_[3]);
                    const float S = dir == 0 ? ((b_[0] * a_[1] + b_[1]) * a_[2] + b_[2]) * a_[3] + b_[3] : ((b_[3] * a_[2] + b_[2]) * a_[1] + b_[1]) * a_[0] + b_[0];
                    const float Pp = __shfl_xor(P, 16), Sp = __shfl_xor(S, 16);
                    const float e1P = sec16 ? Pp : 1.f, e1S = sec16 ? Sp : 0.f;
                    const float prP = P * Pp, prS = sec16 ? P * Sp + S : Pp * S + Sp;
                    const float Pq = __shfl_xor(prP, 32), Sq = __shfl_xor(prS, 32);
                    const float EP = sec32 ? Pq * e1P : e1P, ES = sec32 ? e1P * Sq + e1S : e1S;
                    const float TP = prP * Pq, TS = sec32 ? prP * Sq + prS : Pq * prS + Sq;
                    if (PASS == 1) {
                        float h = EP * hst[dir][n2] + ES;
                        if (dir == 0) {
#pragma unroll
                            for (int r = 0; r < 4; ++r) { h = a_[r] * h + b_[r]; hf[rt][n2][r] = h; }
                        } else {
                            float hb[4];
#pragma unroll
                            for (int r = 3; r >= 0; --r) { h = a_[r] * h + b_[r]; hb[r] = h; }
                            bf16* mp = WSP(bf16, WS_MIX) + (size_t)(row0 + 16 * rt + 4 * g) * D + 768 + e;
                            const LAS bf16* gp = gts + (16 * rt + 4 * g) * 256 + e;
#pragma unroll
                            for (int r = 0; r < 4; ++r) mp[(size_t)r * D] = (bf16)f2bf(gelu_tanh(bf1(gp[r * 256])) * (hf[rt][n2][r] + hb[r]));
                        }
                    } else Pt[dir][n2] *= TP;
                    hst[dir][n2] = TP * hst[dir][n2] + TS;
                }
            }
        }
        if (PASS == 0 && g == 0) {
#pragma unroll
            for (int dir = 0; dir < 2; ++dir)
#pragma unroll
                for (int n2 = 0; n2 < 2; ++n2) WSP(f32x2, WS_TOT)[((size_t)dir * 1152 + T) * 256 + kb * 64 + 16 * (2 * nh + n2) + j16] = (f32x2){Pt[dir][n2], hst[dir][n2]};
        }
    }
}
__device__ __forceinline__ void lru_carry(Frame& F) {
    const f32x2* TOT = WSP(const f32x2, WS_TOT); float* CARRY = WSP(float, WS_CARRY);
    for (int it = F.gw; it < NB * 2 * 4; it += F.NGW) {
        const int b = it >> 3, dir = (it >> 2) & 1, c = (it & 3) * 64 + F.lane;
        float h = 0.f;
        for (int g = 0; g < 18; ++g) {
            f32x2 ps[4]; int tl[4];
#pragma unroll
            for (int i = 0; i < 4; ++i) { const int s = g * 4 + i;
                int T; if (s < 8) T = 1024 + b * 8 + (dir == 0 ? s : 7 - s); else T = b * 64 + (dir == 0 ? s - 8 : 71 - s);
                tl[i] = T; ps[i] = TOT[((size_t)dir * 1152 + T) * 256 + c]; }
#pragma unroll
            for (int i = 0; i < 4; ++i) { CARRY[((size_t)dir * 1152 + tl[i]) * 256 + c] = h; h = ps[i][0] * h + ps[i][1]; }
        }
    }
}

__device__ __forceinline__ void ctx_finalize(Frame& F, int l) {
    bf16* XA = WSP(bf16, WS_XA); float* RSSA = WSP(float, WS_RSSA); const float* ACC = WSP(const float, WS_PART); const float* MOD = WSP(const float, WS_MOD);
    const float* go = INP(5) + (l - 1) * D; const float* gso = MOD + ((size_t)(l - 1) * 17 + NB) * MODW + 4 * D;
    const float* gn = INP(4) + l * D; const float* gsn = MOD + ((size_t)l * 17 + NB) * MODW + D;
    for (int r = F.gw; r < MC; r += F.NGW) {
        const size_t row = (size_t)ML + r;
        float ss = 0.f; f32x4 y[4];
#pragma unroll
        for (int j = 0; j < 4; ++j) { const int k = 4 * F.lane + 256 * j;
            const v2u w = *(const v2u*)(XA + row * D + k);
            const f32x4 im = *(const f32x4*)(go + k) * (*(const f32x4*)(gso + k) + 1.0f);
            const f32x4 xo = (f32x4){bflo(w.x) * __builtin_amdgcn_rcpf(im[0]), bfhi(w.x) * __builtin_amdgcn_rcpf(im[1]), bflo(w.y) * __builtin_amdgcn_rcpf(im[2]), bfhi(w.y) * __builtin_amdgcn_rcpf(im[3])};
            const float* ap = ACC + (size_t)r * D + k;
            y[j] = xo + ((*(const f32x4*)ap + *(const f32x4*)(ap + (size_t)MC * D)) + (*(const f32x4*)(ap + (size_t)2 * MC * D) + *(const f32x4*)(ap + (size_t)3 * MC * D)));
            ss += (y[j][0] * y[j][0] + y[j][1] * y[j][1]) + (y[j][2] * y[j][2] + y[j][3] * y[j][3]); }
        ss = wave_sum(ss);
        if (F.lane < 32) RSSA[row * 32 + F.lane] = (F.lane == 0) ? ss : 0.f;
#pragma unroll
        for (int j = 0; j < 4; ++j) { const int k = 4 * F.lane + 256 * j;
            const f32x4 a = y[j] * (*(const f32x4*)(gn + k) * (*(const f32x4*)(gsn + k) + 1.0f));
            v2u o; o.x = pk2(a[0], a[1]); o.y = pk2(a[2], a[3]); *(v2u*)(XA + row * D + k) = o; }
    }
}

__device__ __forceinline__ void final_rows(Frame& F) {
    const bf16* XA = WSP(const bf16, WS_XA); const float* RSS = WSP(const float, WS_RSSA);
    for (int row = F.gw; row < ML; row += 2 * F.NGW) {
        const int row2 = row + F.NGW; const bool two = row2 < ML;
        const v4u a0 = *(const v4u*)(XA + (size_t)row * D + 8 * F.lane), a1 = *(const v4u*)(XA + (size_t)row * D + 512 + 8 * F.lane);
        const float p0 = F.lane < 32 ? RSS[(size_t)row * 32 + F.lane] : 0.f;
        v4u b0 = a0, b1 = a1; float p1 = 0.f;
        if (two) { b0 = *(const v4u*)(XA + (size_t)row2 * D + 8 * F.lane); b1 = *(const v4u*)(XA + (size_t)row2 * D + 512 + 8 * F.lane); p1 = F.lane < 32 ? RSS[(size_t)row2 * 32 + F.lane] : 0.f; }
        const float rs0 = rsqrtf(wave_sum(p0) * (1.f / D) + EPS), rs1 = rsqrtf(wave_sum(p1) * (1.f / D) + EPS);
        float* o = F.out + (size_t)row * D + 8 * F.lane;
        *(f32x4*)(o) = (f32x4){bflo(a0.x), bfhi(a0.x), bflo(a0.y), bfhi(a0.y)} * rs0; *(f32x4*)(o + 4) = (f32x4){bflo(a0.z), bfhi(a0.z), bflo(a0.w), bfhi(a0.w)} * rs0;
        *(f32x4*)(o + 512) = (f32x4){bflo(a1.x), bfhi(a1.x), bflo(a1.y), bfhi(a1.y)} * rs0; *(f32x4*)(o + 516) = (f32x4){bflo(a1.z), bfhi(a1.z), bflo(a1.w), bfhi(a1.w)} * rs0;
        if (two) { float* o2 = F.out + (size_t)row2 * D + 8 * F.lane;
            *(f32x4*)(o2) = (f32x4){bflo(b0.x), bfhi(b0.x), bflo(b0.y), bfhi(b0.y)} * rs1; *(f32x4*)(o2 + 4) = (f32x4){bflo(b0.z), bfhi(b0.z), bflo(b0.w), bfhi(b0.w)} * rs1;
            *(f32x4*)(o2 + 512) = (f32x4){bflo(b1.x), bfhi(b1.x), bflo(b1.y), bfhi(b1.y)} * rs1; *(f32x4*)(o2 + 516) = (f32x4){bflo(b1.z), bfhi(b1.z), bflo(b1.w), bfhi(b1.w)} * rs1; }
    }
}

constexpr int N_PHASES = 2 + 7 * DEPTH + 1;
struct Args { const float* in[25]; float* out; unsigned char* ws; int ph_lo, ph_hi; };
static_assert(sizeof(Args) == 27 * 8 + 8, "Args has no padding");

__global__ void __launch_bounds__(NWAVES * 64, 2) mega_fwd(Args args) {
    extern __shared__ __attribute__((aligned(16))) unsigned char lds[];
    Frame F;
    F.lds = (LAS unsigned char*)lds;
    const int wave_s = __builtin_amdgcn_readfirstlane((int)threadIdx.x >> 6);
    F.wave = wave_s; F.lane = (int)__builtin_amdgcn_mbcnt_hi(~0u, __builtin_amdgcn_mbcnt_lo(~0u, 0u)); F.tid = wave_s * 64 + F.lane;
    F.G = gridDim.x; { const int bx = blockIdx.x; F.vcu = (F.G % 8 == 0) ? (bx % 8) * (F.G / 8) + bx / 8 : bx; }
    F.gw = F.vcu * NWAVES + F.wave; F.NGW = F.G * NWAVES;
    F.out = args.out; F.ws = args.ws;
    volatile LAS unsigned* MISC = (volatile LAS unsigned*)(F.lds + MISC_OFF);
    for (int u = F.tid; u < (LDS_BYTES - LDSCTL_OFF) / 4; u += NWAVES * 64) ((LAS unsigned*)(F.lds + LDSCTL_OFF))[u] = 0u;
    __syncthreads();
    if (F.tid == 0) {
#pragma unroll
        for (int i = 0; i < 25; ++i) *(LAS unsigned long long*)(F.lds + PTR_OFF + 8 * i) = (unsigned long long)args.in[i];
    }
    __syncthreads();
    XcdBarrier bar = xcd_barrier_post((unsigned*)(F.ws + WS_CTL) + CW_BAR, MISC + 8, F.tid);

    const int lo = args.ph_lo, hi = args.ph_hi;
#ifdef PROBE_MASK
    bool rep_done = false;
#define PROBE_V ((((PROBE_MASK >> ph) & 1) && !rep_done) ? PROBE_VARIANT : 0)
#else
#define PROBE_V 0
#endif
    for (int ph = lo; ph < hi; ++ph) {
        { unsigned ones_ = ~0u; asm volatile("" : "+s"(ones_));
          int t_ = wave_s * 64 + (int)__builtin_amdgcn_mbcnt_hi(ones_, __builtin_amdgcn_mbcnt_lo(ones_, 0u)); asm volatile("" : "+v"(t_)); F.tid = t_; F.lane = t_ & 63; F.wave = __builtin_amdgcn_readfirstlane(t_ >> 6); F.gw = F.vcu * NWAVES + F.wave; }
        if (ph == 0) {
#ifndef NO_P0
            phase_p0a(F);
#endif
        } else if (ph == 1) {
#ifndef NO_P0
            phase_p0b(F);
#endif
        }
        else if (ph == N_PHASES - 1) final_rows(F);
        else {
            const int l = (ph - 2) / 7, k = (ph - 2) % 7; const bool last = (l == DEPTH - 1);
            const int Mx = last ? ML : MT;
            float* MOD = WSP(float, WS_MOD);
            if (k == 0) {
                if (l > 0) { ctx_finalize(F, l); xcd_barrier(bar, F.tid); }
                pg8::Gemm g{WSP(const bf16, WS_XA), WSP(const bf16, WS_WIN) + (size_t)l * IND * D, MT, IND, D};
                pg8::Order S; if (last) S.init(ML, IND, D, (MC / 256) * 5, 1, F.G, (int)blockIdx.x); else S.init(MT, IND, D, 0, 0, F.G, (int)blockIdx.x);
                pg8::EpiScale<0, IND> E{WSP(bf16, WS_PROJ), WSP(const float, WS_SHW1) + (size_t)l * 17 * IND, WSP(const float, WS_RSSA), PROBE_V};

#ifndef NO_G0
                pg8::gemm_phase<pg8::EpiScale<0, IND>, pg8::Order, true, true>(F.lds + RING_OFF, g, S, E, F.tid);
#endif

            } else if (k == 1) {

#ifndef NO_LRU
                lru_phase<0>(F, l, 1152);
#ifdef REP_LRU0
                __syncthreads(); lru_phase<0>(F, l, 1152);
#endif
#endif

                __syncthreads();
#ifndef NO_CONV
                conv_phase(F, l, last ? 1024 : 1152);
                __syncthreads();
#ifdef REP_CONV
                conv_phase(F, l, last ? 1024 : 1152);
                __syncthreads();
#endif
#endif
#ifndef NO_NA
#ifdef REP_NA
                na_phase(F, l, last ? NA_ITEMS_LAT : NA_ITEMS_LAT + NA_ITEMS_CTX, REP_NA);
#else
                na_phase(F, l, last ? NA_ITEMS_LAT : NA_ITEMS_LAT + NA_ITEMS_CTX);
#endif
#ifdef REP_NA
                __syncthreads(); na_phase(F, l, last ? NA_ITEMS_LAT : NA_ITEMS_LAT + NA_ITEMS_CTX, 0);
#endif
#endif
            } else if (k == 2) {
                lru_carry(F);
            } else if (k == 3) {

#ifndef NO_LRU
                lru_phase<1>(F, l, last ? 1024 : 1152);
#endif

            } else if (k == 4 || k == 6) {
                const bool dn = (k == 6);
                const int ln = (dn && !last) ? l + 1 : l;
                pg8::Gemm g{dn ? WSP(const bf16, WS_HID) : WSP(const bf16, WS_MIX), dn ? WSP(const bf16, WS_W2) + (size_t)l * D * FF : WSP(const bf16, WS_WOUT) + (size_t)l * D * D, Mx, D, dn ? FF : D};
                const bool splitk = dn && !last;
                pg8::Order S; S.init(splitk ? ML : Mx, D, dn ? FF : D, 0, 0, F.G, (int)blockIdx.x);
                const bool fromin = (!dn && l == 0);
                const float* go_g = dn ? INP(5) + l * D : INP(4) + l * D;
                const float* go_s = MOD + (size_t)l * 17 * MODW + (dn ? 4 : 1) * D;
                const bool fin = dn && last;
                pg8::EpiRes E{fromin ? INP(0) : (const float*)nullptr, fromin ? INP(2) : (const float*)nullptr, (float*)nullptr,
                              MOD + (size_t)l * 17 * MODW + (dn ? 5 : 2) * D, fin ? INP(24) : (dn ? INP(4) : INP(5)) + ln * D, fin ? WSP(const float, WS_ZERO) : MOD + (size_t)ln * 17 * MODW + (dn ? 1 : 4) * D,
                              go_g, go_s, WSP(bf16, WS_XA), dn ? WSP(float, WS_RSSA) : WSP(float, WS_RSSB), 1};
#ifndef NO_GR
                pg8::gemm_phase<pg8::EpiRes, pg8::Order, true, true>(F.lds + RING_OFF, g, S, E, F.tid);
                if (splitk) {
                    pg8::Order S2; S2.init(ML, 0, FF, (MC / 256) * 16, 2, F.G, (int)blockIdx.x);
                    pg8::EpiSlab E2{WSP(float, WS_PART), MOD + ((size_t)l * 17 + NB) * MODW + 5 * D};
                    pg8::gemm_phase<pg8::EpiSlab, pg8::Order, true, true, true>(F.lds + RING_OFF, g, S2, E2, F.tid);
                }
#endif
            } else if (k == 5) {
                pg8::Gemm g{WSP(const bf16, WS_XA), WSP(const bf16, WS_W1) + (size_t)l * FF * D, Mx, FF, D};
                pg8::Order S; S.init(Mx, FF, D, 0, 0, F.G, (int)blockIdx.x);
                pg8::EpiScale<1, FF> E{WSP(bf16, WS_HID), WSP(const float, WS_SHW2) + (size_t)l * 17 * FF, WSP(const float, WS_RSSB), PROBE_V};

#ifndef NO_G1
                pg8::gemm_phase<pg8::EpiScale<1, FF>, pg8::Order, true, true>(F.lds + RING_OFF, g, S, E, F.tid);
#endif

            }
        }
#ifdef PROBE_MASK
        if (((PROBE_MASK >> ph) & 1) && !rep_done) { rep_done = true; xcd_barrier(bar, F.tid); --ph; continue; }
        rep_done = false;
#endif
        if (ph + 1 < hi) xcd_barrier(bar, F.tid);
    }
}

extern "C" void kernel_launch(void* const* d_in, const int* in_sizes, int n_in, void* d_out, int out_size, void* d_ws, size_t ws_size, hipStream_t stream) {
    static int grid = 0;
    if (grid == 0) {
        if (n_in != 25 || out_size != ML * D || ws_size < WS_END) { fprintf(stderr, "kernel_launch: unexpected shapes (n_in %d out %d ws %zu)\n", n_in, out_size, ws_size); grid = -1; return; }
        int dev = 0, cus = 0;
        if (hipGetDevice(&dev) != hipSuccess || hipDeviceGetAttribute(&cus, hipDeviceAttributeMultiprocessorCount, dev) != hipSuccess) { grid = -1; return; }
        if (hipFuncSetAttribute((const void*)mega_fwd, hipFuncAttributeMaxDynamicSharedMemorySize, LDS_BYTES) != hipSuccess) { fprintf(stderr, "kernel_launch: hipFuncSetAttribute failed\n"); grid = -1; return; }
        int per_cu = 0;
        if (hipOccupancyMaxActiveBlocksPerMultiprocessor(&per_cu, (const void*)mega_fwd, NWAVES * 64, LDS_BYTES) != hipSuccess || per_cu < 1) fprintf(stderr, "kernel_launch: occupancy query reports %d\n", per_cu);
        (void)hipGetLastError();
        grid = cus;
    }
    if (grid < 0) return;
    if (hipMemsetAsync((char*)d_ws + WS_CTL, 0, CTL_ZERO_BYTES, stream) != hipSuccess) return;
    Args a{};
    for (int i = 0; i < 25; ++i) a.in[i] = (const float*)d_in[i];
    a.out = (float*)d_out; a.ws = (unsigned char*)d_ws;
#if MK_N_LAUNCHES == 1
    a.ph_lo = 0; a.ph_hi = N_PHASES;
    hipLaunchKernelGGL(mega_fwd, dim3(grid), dim3(NWAVES * 64), LDS_BYTES, stream, a);
#else
    for (int ph = 0; ph < N_PHASES; ++ph) { a.ph_lo = ph; a.ph_hi = ph + 1; hipLaunchKernelGGL(mega_fwd, dim3(grid), dim3(NWAVES * 64), LDS_BYTES, stream, a); }
#endif
}
```

```cpp
#include <hip/hip_runtime.h>
#include <cstdio>
#include <cstdint>

constexpr int D = 1024, NB = 16, SEQ = 2048, CTXL = 256, DEPTH = 2;
constexpr int ML = NB * SEQ, MC = NB * CTXL, MT = ML + MC;
constexpr int IND = 2560, FF = 4096, NH = 8, HD = 64;
constexpr int MODW = 6 * D;
constexpr float EPS = 1e-6f;
#ifndef MK_N_LAUNCHES
#define MK_N_LAUNCHES 1
#endif

namespace pg8 {
#define PG8_LAS __attribute__((address_space(3)))
typedef unsigned short bf16_t;
typedef short bf16x8 __attribute__((ext_vector_type(8)));
typedef float f32x4 __attribute__((ext_vector_type(4)));
typedef unsigned u32x4 __attribute__((ext_vector_type(4)));
constexpr int BM = 256, BK = 64, HALF = 128, HTB = HALF * BK * 2, STAGE_BYTES = 8 * HTB, NXCD = 8;

__host__ __device__ __forceinline__ int lds_byte(int r, int c) { const int st = (r >> 4) * 2 + (c >> 5), rr = r & 15, cc = c & 31, ob = rr * 64 + cc * 2; return st * 1024 + (ob ^ (((ob >> 9) & 1) << 5)); }
__host__ __device__ __forceinline__ void stage_rc(int b, int& R, int& C) { const int st = b / 1024, sb = b % 1024, swz = sb ^ (((sb >> 9) & 1) << 5); R = (st >> 1) * 16 + swz / 64; C = (st & 1) * 32 + (swz % 64) / 2; }
__host__ __device__ __forceinline__ int perm32(int rho) { const int n = rho >> 4, i = rho & 15; return 8 * (i >> 2) + 4 * n + (i & 3); }

struct Unit { int pm, pn; };
struct Gemm { const bf16_t* A; const bf16_t* Bt; int M, N, K; };

__host__ __device__ __forceinline__ void map_tile(int wgid, int nM, int nN, int WGM, Unit& u) {
    const int nwg = nM * nN;
    { const int q = nwg / NXCD, r = nwg % NXCD, xcd = wgid % NXCD, off = wgid / NXCD; wgid = (xcd < r ? xcd * (q + 1) : r * (q + 1) + (xcd - r) * q) + off; }
    const int nig = WGM * nN, gid = wgid / nig, fm = gid * WGM, gsz = (nM - fm) < WGM ? (nM - fm) : WGM;
    u.pm = fm + ((wgid % nig) % gsz); u.pn = (wgid % nig) / gsz;
}
struct Order {
    int nM, nN, nwg, extra, mode, wgm, G, c;
    __host__ __device__ void init(int M, int N, int wgm_, int extra_, int mode_, int G_, int c_) { nM = M / BM; nN = N / BM; nwg = nM * nN; extra = extra_; mode = mode_; wgm = wgm_; G = G_; c = c_; }
    __host__ __device__ bool next(int i, Unit& u) const {
        const long L = (long)i * G + c;
        if (L < nwg) { map_tile((int)L, nM, nN, wgm, u); return true; }
        if (L < nwg + extra) { const int q = (int)L - nwg;
            if (mode == 1) { u.pm = nM + q / 5; u.pn = 4 + q % 5; }
            else { u.pm = nM + (q >> 4); u.pn = 4 + 4 * (q & 3) + ((q >> 2) & 3); }
            return true; }
        return false;
    }
    __device__ __forceinline__ void a_ready(const Unit&) const {}
    __device__ __forceinline__ void done(const Unit&) const {}
};

__device__ __forceinline__ unsigned cvt_pk_bf16(float lo, float hi) { unsigned r; asm volatile("v_cvt_pk_bf16_f32 %0, %1, %2" : "=v"(r) : "v"(lo), "v"(hi)); return r; }

template <int ACT, int LDC> struct EpiScale {
    static constexpr bool PERM = true, AFTER_DRAIN = false;
    bf16_t* O; const float* shw; const float* RSS;
    int probe;
    __device__ __forceinline__ void operator()(const f32x4 (&acc)[2][2][4][2], const Unit& u, int wr, int wc, int fr, int fq) const {
        asm volatile("" : "+s"(wr), "+s"(wc));
        const int brow = u.pm < ML / BM ? (u.pm >> 3) : NB;
        const float* sp = shw + (size_t)brow * LDC + u.pn * BM;
        bf16_t* Ot = O + (size_t)u.pm * BM * LDC + u.pn * BM;
        const float* RSSt = RSS + (size_t)u.pm * BM * 32;
        unsigned cl = (unsigned)(wc * 32 + 8 * fq);
        unsigned rl0 = (unsigned)(wr * 64 + fr);
        asm volatile("" : "+v"(cl), "+v"(rl0));
        f32x4 pa[2][4], pb[2][4], sh[2][2];
#pragma unroll
        for (int ai = 0; ai < 2; ++ai)
#pragma unroll
            for (int m = 0; m < 4; ++m) { const unsigned ro = (rl0 + (unsigned)(ai * HALF + m * 16)) * 32u + 8u * (unsigned)fq;
                if (probe == 2) { pa[ai][m] = acc[ai][0][m][0]; pb[ai][m] = acc[ai][1][m][0]; } else { pa[ai][m] = *(const f32x4*)(RSSt + ro); pb[ai][m] = *(const f32x4*)(RSSt + (ro + 4u)); } }
#pragma unroll
        for (int bj = 0; bj < 2; ++bj) { if (probe == 2) { sh[bj][0] = acc[0][bj][0][1]; sh[bj][1] = acc[1][bj][0][1]; } else { sh[bj][0] = *(const f32x4*)(sp + (cl + (unsigned)(bj * HALF))); sh[bj][1] = *(const f32x4*)(sp + (cl + (unsigned)(bj * HALF + 4))); } }
        float rs[2][4];
#pragma unroll
        for (int ai = 0; ai < 2; ++ai)
#pragma unroll
            for (int m = 0; m < 4; ++m) { const f32x4 p0 = pa[ai][m], p1 = pb[ai][m];
                float s = ((p0[0] + p0[1]) + (p0[2] + p0[3])) + ((p1[0] + p1[1]) + (p1[2] + p1[3]));
                s += __shfl_xor(s, 16); s += __shfl_xor(s, 32);
                rs[ai][m] = rsqrtf(s * (1.0f / D) + EPS); }
#pragma unroll
        for (int bj = 0; bj < 2; ++bj)
#pragma unroll
            for (int ai = 0; ai < 2; ++ai)
#pragma unroll
                for (int m = 0; m < 4; ++m) {
                    f32x4 v0 = acc[ai][bj][m][0] * rs[ai][m] + sh[bj][0], v1 = acc[ai][bj][m][1] * rs[ai][m] + sh[bj][1];
                    if (ACT == 1) {
#pragma unroll
                        for (int e = 0; e < 4; ++e) { const float a = fmaxf(v0[e], 0.f), b = fmaxf(v1[e], 0.f); v0[e] = a * a; v1[e] = b * b; }
                    }
                    u32x4 w; w.x = cvt_pk_bf16(v0[0], v0[1]); w.y = cvt_pk_bf16(v0[2], v0[3]); w.z = cvt_pk_bf16(v1[0], v1[1]); w.w = cvt_pk_bf16(v1[2], v1[3]);
                    if (probe == 0) *(u32x4*)(Ot + ((rl0 + (unsigned)(ai * HALF + m * 16)) * (unsigned)LDC + cl + (unsigned)(bj * HALF))) = w;
                    else asm volatile("" :: "v"(w));
                }
    }
};
struct EpiRes {
    static constexpr bool PERM = true, AFTER_DRAIN = false;
    const float* src_lat; const float* src_ctx;
    float* dst_lat;
    const float* gate;
    const float* gmg; const float* gmsc;
    const float* gmg_o; const float* gmsc_o;
    bf16_t* XA; float* RSS; int hasxa;
    template <int BJ, int AI0, int NAI, int M0, int NM>
    __device__ __forceinline__ void batch(const f32x4 (&acc)[2][2][4][2], const float* src, float* dst, const float* gt, const float* gg, const float* gs, const float* go, const float* gso, bf16_t* XAt, float* RSSt, unsigned cl, unsigned rl0, int fq) const {
        const unsigned c = cl + (unsigned)(BJ * HALF);
        f32x4 x0[NAI][NM], x1[NAI][NM];
        const bool srcf = src != nullptr;
        if (srcf) {
#pragma unroll
            for (int a = 0; a < NAI; ++a)
#pragma unroll
                for (int m = 0; m < NM; ++m) { const unsigned off = (rl0 + (unsigned)((AI0 + a) * HALF + (M0 + m) * 16)) * (unsigned)D + c; x0[a][m] = *(const f32x4*)(src + off); x1[a][m] = *(const f32x4*)(src + (off + 4u)); }
        } else {
            u32x4 xb[NAI][NM];
#pragma unroll
            for (int a = 0; a < NAI; ++a)
#pragma unroll
                for (int m = 0; m < NM; ++m) { const unsigned off = (rl0 + (unsigned)((AI0 + a) * HALF + (M0 + m) * 16)) * (unsigned)D + c; xb[a][m] = *(const u32x4*)(XAt + off); }
            const f32x4 i0 = *(const f32x4*)(go + c) * (*(const f32x4*)(gso + c) + 1.0f), i1 = *(const f32x4*)(go + (c + 4u)) * (*(const f32x4*)(gso + (c + 4u)) + 1.0f);
            f32x4 r0, r1;
#pragma unroll
            for (int e = 0; e < 4; ++e) { r0[e] = __builtin_amdgcn_rcpf(i0[e]); r1[e] = __builtin_amdgcn_rcpf(i1[e]); }
#pragma unroll
            for (int a = 0; a < NAI; ++a)
#pragma unroll
                for (int m = 0; m < NM; ++m) { const u32x4 w = xb[a][m];
                    x0[a][m] = (f32x4){__uint_as_float(w.x << 16), __uint_as_float(w.x & 0xffff0000u), __uint_as_float(w.y << 16), __uint_as_float(w.y & 0xffff0000u)} * r0;
                    x1[a][m] = (f32x4){__uint_as_float(w.z << 16), __uint_as_float(w.z & 0xffff0000u), __uint_as_float(w.w << 16), __uint_as_float(w.w & 0xffff0000u)} * r1; }
        }
        const f32x4 g0 = *(const f32x4*)(gt + c), g1 = *(const f32x4*)(gt + (c + 4u));
        f32x4 m0 = {0.f, 0.f, 0.f, 0.f}, m1 = {0.f, 0.f, 0.f, 0.f};
        if (hasxa) { m0 = *(const f32x4*)(gg + c) * (*(const f32x4*)(gs + c) + 1.0f); m1 = *(const f32x4*)(gg + (c + 4u)) * (*(const f32x4*)(gs + (c + 4u)) + 1.0f); }
        asm volatile("" ::: "memory");
#pragma unroll
        for (int a = 0; a < NAI; ++a)
#pragma unroll
            for (int m = 0; m < NM; ++m) {
                const unsigned rl = rl0 + (unsigned)((AI0 + a) * HALF + (M0 + m) * 16);
                const unsigned off = rl * (unsigned)D + c;
                const f32x4 y0 = x0[a][m] + g0 * acc[AI0 + a][BJ][M0 + m][0], y1 = x1[a][m] + g1 * acc[AI0 + a][BJ][M0 + m][1];
                if (dst) { *(f32x4*)(dst + off) = y0; *(f32x4*)(dst + (off + 4u)) = y1; }
                float ss = ((y0[0] * y0[0] + y0[1] * y0[1]) + (y0[2] * y0[2] + y0[3] * y0[3])) + ((y1[0] * y1[0] + y1[1] * y1[1]) + (y1[2] * y1[2] + y1[3] * y1[3]));
                ss += __shfl_xor(ss, 16); ss += __shfl_xor(ss, 32);
                if (fq == 0) RSSt[rl * 32u + (unsigned)(BJ * 4)] = ss;
                if (hasxa) { const f32x4 a0 = y0 * m0, a1 = y1 * m1;
                    u32x4 w; w.x = cvt_pk_bf16(a0[0], a0[1]); w.y = cvt_pk_bf16(a0[2], a0[3]); w.z = cvt_pk_bf16(a1[0], a1[1]); w.w = cvt_pk_bf16(a1[2], a1[3]);
                    *(u32x4*)(XAt + off) = w; }
            }
        asm volatile("" ::: "memory");
    }
    __device__ __forceinline__ void operator()(const f32x4 (&acc)[2][2][4][2], const Unit& u, int wr, int wc, int fr, int fq) const {
        asm volatile("" : "+s"(wr), "+s"(wc));
        const bool lat = u.pm < ML / BM;
        const int brow = lat ? (u.pm >> 3) : NB;
        const float* src = src_lat ? (lat ? src_lat + (size_t)u.pm * BM * D : src_ctx + (size_t)(u.pm - ML / BM) * BM * D) + u.pn * BM : nullptr;
        float* dst = (dst_lat && lat) ? dst_lat + (size_t)u.pm * BM * D + u.pn * BM : nullptr;
        const float* gt = gate + (size_t)brow * MODW + u.pn * BM;
        const float* gg = gmg + u.pn * BM;
        const float* gs = gmsc + (size_t)brow * MODW + u.pn * BM;
        const float* go = gmg_o + u.pn * BM;
        const float* gso = gmsc_o + (size_t)brow * MODW + u.pn * BM;
        bf16_t* XAt = XA + (size_t)u.pm * BM * D + u.pn * BM;
        float* RSSt = RSS + (size_t)u.pm * BM * 32 + u.pn * 8 + wc;
        unsigned cl = (unsigned)(wc * 32 + 8 * fq);
        unsigned rl0 = (unsigned)(wr * 64 + fr);
        asm volatile("" : "+v"(cl), "+v"(rl0));
        batch<0, 0, 1, 0, 2>(acc, src, dst, gt, gg, gs, go, gso, XAt, RSSt, cl, rl0, fq);
        batch<0, 0, 1, 2, 2>(acc, src, dst, gt, gg, gs, go, gso, XAt, RSSt, cl, rl0, fq);
        batch<0, 1, 1, 0, 4>(acc, src, dst, gt, gg, gs, go, gso, XAt, RSSt, cl, rl0, fq);
        batch<1, 0, 2, 0, 4>(acc, src, dst, gt, gg, gs, go, gso, XAt, RSSt, cl, rl0, fq);
    }
};

struct EpiSlab {
    static constexpr bool PERM = true, AFTER_DRAIN = false;
    float* P; const float* gate;
    __device__ __forceinline__ void operator()(const f32x4 (&acc)[2][2][4][2], const Unit& u, int wr, int wc, int fr, int fq) const {
        asm volatile("" : "+s"(wr), "+s"(wc));
        const int ks = (u.pn - 4) >> 2, pn = u.pn & 3;
        float* At = P + ((size_t)ks * MC + (size_t)(u.pm - ML / BM) * BM) * D + pn * BM;
        const float* gtq = gate + pn * BM;
        unsigned cl = (unsigned)(wc * 32 + 8 * fq), rl0 = (unsigned)(wr * 64 + fr);
        asm volatile("" : "+v"(cl), "+v"(rl0));
#pragma unroll
        for (int bj = 0; bj < 2; ++bj) { const unsigned c = cl + (unsigned)(bj * HALF);
            const f32x4 g0 = *(const f32x4*)(gtq + c), g1 = *(const f32x4*)(gtq + (c + 4u));
#pragma unroll
            for (int ai = 0; ai < 2; ++ai)
#pragma unroll
                for (int m = 0; m < 4; ++m) { const unsigned off = (rl0 + (unsigned)(ai * HALF + m * 16)) * (unsigned)D + c;
                    *(f32x4*)(At + off) = g0 * acc[ai][bj][m][0]; *(f32x4*)(At + (off + 4u)) = g1 * acc[ai][bj][m][1]; } }
    }
};

template <class Epi, class Sched, bool ALIGN_EPI = false, bool SP2 = false, bool VARK = false>
__device__ __forceinline__ void gemm_phase(PG8_LAS unsigned char* lds, const Gemm g, const Sched& S, const Epi& E, const int tid) {
    const int wid = __builtin_amdgcn_readfirstlane(tid >> 6), lane = tid & 63, wr = wid >> 2, wc = wid & 3, fr = lane & 15, fq = lane >> 4;
    const int K = g.K;
    unsigned voffA[2], voffB[2];
#pragma unroll
    for (int i = 0; i < 2; ++i) { int R, C; stage_rc(tid * 16 + i * 8192, R, C); const int Rb = Epi::PERM ? ((R & ~31) + perm32(R & 31)) : R;
        voffA[i] = (unsigned)(R * K + C) * 2u; voffB[i] = (unsigned)(Rb * K + C) * 2u; }
    const size_t kstep = (size_t)(BK * 2);
    const size_t hstep = (size_t)HALF * K * 2;
    const size_t tstep = 2 * hstep;
    const unsigned ldsw = (unsigned)wid * 1024u;
    const int aoff = lds_byte(wr * 64 + fr, fq * 8), boff = lds_byte(wc * 32 + fr, fq * 8);
#define PG8_SA(b, h) (((b) * 2 + (h)) * HTB)
#define PG8_SB(b, h) ((4 + (b) * 2 + (h)) * HTB)
#define PG8_STAGE(bufoff, gbase, voff) do { _Pragma("unroll") for (int _i = 0; _i < 2; ++_i) \
        __builtin_amdgcn_global_load_lds((const unsigned*)((const char*)(gbase) + (voff)[_i]), (PG8_LAS unsigned*)(lds + (bufoff) + ldsw + _i * 8192), 16, 0, 0); } while (0)
#define PG8_LDA(dst, b, h) do { _Pragma("unroll") for (int m = 0; m < 4; ++m) _Pragma("unroll") for (int k = 0; k < 2; ++k) dst[m][k] = *(const PG8_LAS bf16x8*)(lds + PG8_SA(b, h) + aoff + m * 2048 + k * 1024); } while (0)
#define PG8_LDB(dst, b, h) do { _Pragma("unroll") for (int n = 0; n < 2; ++n) _Pragma("unroll") for (int k = 0; k < 2; ++k) dst[n][k] = *(const PG8_LAS bf16x8*)(lds + PG8_SB(b, h) + boff + n * 2048 + k * 1024); } while (0)
#define PG8_MMA(ai, bj, At, Bt) do { __builtin_amdgcn_s_setprio(1); _Pragma("unroll") for (int m = 0; m < 4; ++m) _Pragma("unroll") for (int n = 0; n < 2; ++n) _Pragma("unroll") for (int k = 0; k < 2; ++k) \
        acc[ai][bj][m][n] = __builtin_amdgcn_mfma_f32_16x16x32_bf16(Bt[n][k], At[m][k], acc[ai][bj][m][n], 0, 0, 0); __builtin_amdgcn_s_setprio(0); } while (0)
#define PG8_WAIT_V(n) asm volatile("s_waitcnt vmcnt(" #n ")" ::: "memory")
#define PG8_WAIT_L(n) asm volatile("s_waitcnt lgkmcnt(" #n ")" ::: "memory")
#define PG8_BAR __builtin_amdgcn_s_barrier()
#define PG8_SCHED __builtin_amdgcn_sched_barrier(0)
    Unit cur, nxt; int ui = 0;
    if (!S.next(0, cur)) return;
    cur.pm = __builtin_amdgcn_readfirstlane(cur.pm); cur.pn = __builtin_amdgcn_readfirstlane(cur.pn);
    f32x4 acc[2][2][4][2];
#pragma unroll
    for (int a = 0; a < 2; ++a)
#pragma unroll
        for (int b = 0; b < 2; ++b)
#pragma unroll
            for (int m = 0; m < 4; ++m)
#pragma unroll
                for (int n = 0; n < 2; ++n) acc[a][b][m][n] = (f32x4){0.f, 0.f, 0.f, 0.f};
    bf16x8 At[4][2], B0[2][2], B1[2][2];
#define PG8_KOFF(u) ((VARK && (u).pn >= 4) ? (size_t)(((u).pn - 4) >> 2) * (size_t)(K / 4) * 2 : (size_t)0)
#define PG8_PN(u) ((VARK && (u).pn >= 4) ? ((u).pn & 3) : (u).pn)
    const char* cA = (const char*)g.A + (size_t)cur.pm * tstep + PG8_KOFF(cur); const char* cB = (const char*)g.Bt + (size_t)PG8_PN(cur) * tstep + PG8_KOFF(cur);
    S.a_ready(cur);
    if constexpr (SP2) {
        PG8_STAGE(PG8_SB(0, 0), cB, voffB); PG8_STAGE(PG8_SB(0, 1), cB + hstep, voffB); PG8_STAGE(PG8_SA(0, 0), cA, voffA); PG8_STAGE(PG8_SA(0, 1), cA + hstep, voffA);
        if (wr == 1) PG8_BAR;
        PG8_WAIT_V(2); PG8_BAR;
        PG8_STAGE(PG8_SB(1, 0), cB + kstep, voffB); PG8_STAGE(PG8_SA(1, 0), cA + kstep, voffA); PG8_STAGE(PG8_SB(1, 1), cB + hstep + kstep, voffB);
        PG8_WAIT_V(6); PG8_BAR;
    } else {
        PG8_STAGE(PG8_SB(0, 0), cB, voffB); PG8_STAGE(PG8_SA(0, 0), cA, voffA); PG8_STAGE(PG8_SB(0, 1), cB + hstep, voffB); PG8_STAGE(PG8_SA(0, 1), cA + hstep, voffA);
        if (wr == 1) PG8_BAR;
        PG8_WAIT_V(4); PG8_BAR;
        PG8_STAGE(PG8_SB(1, 0), cB + kstep, voffB); PG8_STAGE(PG8_SA(1, 0), cA + kstep, voffA); PG8_STAGE(PG8_SB(1, 1), cB + hstep + kstep, voffB);
        PG8_WAIT_V(6); PG8_BAR;
    }
    for (;;) {
        const bool has_next = S.next(ui + 1, nxt);
        nxt.pm = __builtin_amdgcn_readfirstlane(nxt.pm); nxt.pn = __builtin_amdgcn_readfirstlane(nxt.pn);
        const char* nA = has_next ? (const char*)g.A + (size_t)nxt.pm * tstep + PG8_KOFF(nxt) : cA; const char* nB = has_next ? (const char*)g.Bt + (size_t)PG8_PN(nxt) * tstep + PG8_KOFF(nxt) : cB;
        const int nt = (VARK && cur.pn >= 4) ? K / BK / 4 : K / BK;
        for (int t = 0; t < nt; t += 2) {
            const bool last = (t == nt - 2);
            const char* a1 = cA + (size_t)(t + 1) * kstep;
            const char* a2 = last ? nA : cA + (size_t)(t + 2) * kstep; const char* b2 = last ? nB : cB + (size_t)(t + 2) * kstep;
            const char* a3 = a2 + kstep; const char* b3 = b2 + kstep;
            if (last && has_next) S.a_ready(nxt);
            if constexpr (SP2) {
            PG8_LDB(B0, 0, 0); PG8_LDB(B1, 0, 1); PG8_SCHED; PG8_LDA(At, 0, 0); PG8_STAGE(PG8_SA(1, 1), a1 + hstep, voffA);
            PG8_WAIT_V(8); PG8_WAIT_L(0); PG8_BAR; PG8_MMA(0, 0, At, B0); PG8_MMA(0, 1, At, B1); PG8_BAR; PG8_SCHED;
            PG8_LDA(At, 0, 1); PG8_STAGE(PG8_SB(0, 0), b2, voffB); PG8_STAGE(PG8_SB(0, 1), b2 + hstep, voffB); PG8_STAGE(PG8_SA(0, 0), a2, voffA);
            PG8_WAIT_V(8); PG8_WAIT_L(0); PG8_BAR; PG8_MMA(1, 0, At, B0); PG8_MMA(1, 1, At, B1); PG8_BAR; PG8_SCHED;
            PG8_LDB(B0, 1, 0); PG8_LDB(B1, 1, 1); PG8_SCHED; PG8_LDA(At, 1, 0); PG8_STAGE(PG8_SA(0, 1), a2 + hstep, voffA);
            PG8_WAIT_V(8); PG8_WAIT_L(0); PG8_BAR; PG8_MMA(0, 0, At, B0); PG8_MMA(0, 1, At, B1); PG8_BAR; PG8_SCHED;
            PG8_LDA(At, 1, 1); PG8_STAGE(PG8_SB(1, 0), b3, voffB); PG8_STAGE(PG8_SB(1, 1), b3 + hstep, voffB); PG8_STAGE(PG8_SA(1, 0), a3, voffA);
            PG8_WAIT_V(8); PG8_WAIT_L(0); PG8_BAR; PG8_MMA(1, 0, At, B0); PG8_MMA(1, 1, At, B1); PG8_BAR; PG8_SCHED;
            } else {
            PG8_LDB(B0, 0, 0); PG8_SCHED; PG8_LDA(At, 0, 0); PG8_STAGE(PG8_SA(1, 1), a1 + hstep, voffA);
            PG8_WAIT_L(8); PG8_BAR; PG8_WAIT_L(0); PG8_MMA(0, 0, At, B0); PG8_BAR; PG8_SCHED;
            PG8_LDB(B1, 0, 1); PG8_STAGE(PG8_SB(0, 0), b2, voffB);
            PG8_BAR; PG8_WAIT_L(0); PG8_MMA(0, 1, At, B1); PG8_BAR;
            PG8_LDA(At, 0, 1); PG8_STAGE(PG8_SA(0, 0), a2, voffA);
            PG8_BAR; PG8_WAIT_L(0); PG8_MMA(1, 0, At, B0); PG8_BAR; PG8_SCHED;
            PG8_STAGE(PG8_SB(0, 1), b2 + hstep, voffB);
            PG8_WAIT_V(6); PG8_BAR; PG8_MMA(1, 1, At, B1); PG8_BAR;
            PG8_LDB(B0, 1, 0); PG8_SCHED; PG8_LDA(At, 1, 0); PG8_STAGE(PG8_SA(0, 1), a2 + hstep, voffA);
            PG8_WAIT_L(8); PG8_BAR; PG8_WAIT_L(0); PG8_MMA(0, 0, At, B0); PG8_BAR; PG8_SCHED;
            PG8_LDB(B1, 1, 1); PG8_STAGE(PG8_SB(1, 0), b3, voffB);
            PG8_BAR; PG8_WAIT_L(0); PG8_MMA(0, 1, At, B1); PG8_BAR;
            PG8_LDA(At, 1, 1); PG8_STAGE(PG8_SA(1, 0), a3, voffA);
            PG8_BAR; PG8_WAIT_L(0); PG8_MMA(1, 0, At, B0); PG8_BAR; PG8_SCHED;
            PG8_STAGE(PG8_SB(1, 1), b3 + hstep, voffB);
            PG8_WAIT_V(6); PG8_BAR; PG8_MMA(1, 1, At, B1); PG8_BAR;
            }
        }
        if constexpr (ALIGN_EPI) { if (wr == 0) PG8_BAR; }
        if constexpr (!Epi::AFTER_DRAIN) { E(acc, cur, wr, wc, fr, fq); S.done(cur); }
        if (!has_next) break;
#pragma unroll
        for (int a = 0; a < 2; ++a)
#pragma unroll
            for (int b = 0; b < 2; ++b)
#pragma unroll
                for (int m = 0; m < 4; ++m)
#pragma unroll
                    for (int n = 0; n < 2; ++n) acc[a][b][m][n] = (f32x4){0.f, 0.f, 0.f, 0.f};
        cur = nxt; cA = nA; cB = nB; ++ui;
        if constexpr (ALIGN_EPI) { if (wr == 1) PG8_BAR; }
    }
    PG8_WAIT_V(0);
    if constexpr (!ALIGN_EPI) { if (wr == 0) PG8_BAR; }
    PG8_BAR;
    if constexpr (Epi::AFTER_DRAIN) { E.fused(acc, cur, wr, wc, fr, fq, lds, wid, lane); S.done(cur); }
#undef PG8_KOFF
#undef PG8_PN
#undef PG8_SA
#undef PG8_SB
#undef PG8_STAGE
#undef PG8_LDA
#undef PG8_LDB
#undef PG8_MMA
#undef PG8_WAIT_V
#undef PG8_WAIT_L
#undef PG8_BAR
#undef PG8_SCHED
}
}

constexpr size_t MiB = 1u << 20;
constexpr size_t WS_CTL = 0, CTL_ZERO_BYTES = 1 * MiB;
constexpr size_t WS_MOD = 1 * MiB;
constexpr size_t WS_SHW1 = 2 * MiB;
constexpr size_t WS_SHW2 = 3 * MiB;
constexpr size_t WS_RSSA = 4 * MiB;
constexpr size_t WS_RSSB = 9 * MiB;
constexpr size_t WS_TOT = 14 * MiB;
constexpr size_t WS_CARRY = 19 * MiB;
constexpr size_t WS_WLR = 21 * MiB + 512 * 1024;
constexpr size_t WS_WIN = 22 * MiB;
constexpr size_t WS_WOUT = 32 * MiB;
constexpr size_t WS_W1 = 36 * MiB;
constexpr size_t WS_W2 = 52 * MiB;
constexpr size_t WS_CX = 68 * MiB;
constexpr size_t WS_XA = 84 * MiB;
constexpr size_t WS_HID = 156 * MiB;
constexpr size_t WS_PROJ = WS_HID;
constexpr size_t WS_MIX = WS_HID + 180 * MiB;
constexpr size_t WS_PART = 444 * MiB;
constexpr size_t WS_END = 508 * MiB;
static_assert(WS_MIX + (size_t)MT * D * 2 <= WS_PART && WS_HID + (size_t)MT * FF * 2 == WS_PART && WS_PART + (size_t)4 * MC * D * 4 == WS_END, "ws map");
constexpr size_t WS_ZERO = WS_CTL + 512 * 1024;
constexpr int CW_BAR = 4096;

#ifndef WGM_IN
#define WGM_IN 4
#endif
#ifndef WGM_OUT
#define WGM_OUT 4
#endif
#ifndef WGM_UP
#define WGM_UP 4
#endif
#ifndef WGM_DN
#define WGM_DN 4
#endif
constexpr int NWAVES = 8;
constexpr int RING_OFF = 0, RING_BYTES = 131072;
constexpr int LDSCTL_OFF = RING_BYTES, MISC_OFF = LDSCTL_OFF + 320;
constexpr int LDS_BYTES = 147456;

#define GAS __attribute__((address_space(1)))
#define LAS __attribute__((address_space(3)))
typedef unsigned short bf16;
typedef unsigned v4u __attribute__((ext_vector_type(4)));
typedef unsigned v2u __attribute__((ext_vector_type(2)));
typedef float f32x4 __attribute__((ext_vector_type(4)));
typedef float f32x2 __attribute__((ext_vector_type(2)));
typedef GAS unsigned gu32;
#define LDS_WAIT() asm volatile("s_waitcnt lgkmcnt(0)" ::: "memory")
#define VM_WAIT() asm volatile("s_waitcnt vmcnt(0)" ::: "memory")
__device__ __forceinline__ unsigned f2bf(float f) { unsigned u = __builtin_bit_cast(unsigned, f); return (u + 0x7fffu + ((u >> 16) & 1u)) >> 16; }
__device__ __forceinline__ unsigned pk2(float lo, float hi) { return f2bf(lo) | (f2bf(hi) << 16); }
__device__ __forceinline__ float bflo(unsigned w) { return __uint_as_float(w << 16); }
__device__ __forceinline__ float bfhi(unsigned w) { return __uint_as_float(w & 0xffff0000u); }
__device__ __forceinline__ float bf1(bf16 v) { return __uint_as_float((unsigned)v << 16); }
__device__ __forceinline__ float sigmoidf_(float x) { return __builtin_amdgcn_rcpf(1.f + __builtin_amdgcn_exp2f(-1.4426950408889634f * x)); }
__device__ __forceinline__ float siluf_(float x) { return x * sigmoidf_(x); }
__device__ __forceinline__ float gelu_tanh(float x) { const float u = 0.7978845608028654f * (x + 0.044715f * x * x * x); return x * sigmoidf_(2.f * u); }
__device__ __forceinline__ float wave_sum(float v) {
#pragma unroll
    for (int o = 1; o < 64; o <<= 1) v += __shfl_xor(v, o);
    return v;
}

#define XB_TMO      128
#define XB_XCNT(j)  (256  + 64 * (j))
#define XB_XSUB(j)  (1280 + 64 * (j))
#define XB_XGEN(j)  (2304 + 64 * (j))
#define XB_TOP      3328
#define XB_TOPGEN   3392
#define XCD_BAR_WORDS 3456
#define XB_SPIN_CAP (1u << 18)

__device__ __forceinline__ unsigned xb_ld(unsigned* p)              { return __hip_atomic_load(p, __ATOMIC_RELAXED, __HIP_MEMORY_SCOPE_AGENT); }
__device__ __forceinline__ unsigned xb_add(unsigned* p, unsigned v) { return __hip_atomic_fetch_add(p, v, __ATOMIC_RELAXED, __HIP_MEMORY_SCOPE_AGENT); }
__device__ __forceinline__ unsigned xb_xcc_id() { return (unsigned)__builtin_amdgcn_s_getreg((3 << 11) | 20) & 0xFu; }
#define XB_SPIN(cond, bar) do { unsigned _sp = 0; while (cond) { __builtin_amdgcn_s_sleep(1); \
    if ((++_sp & 255u) == 0u) { if (xb_ld(&(bar)[XB_TMO])) break; if (_sp > XB_SPIN_CAP) { atomicAdd(&(bar)[XB_TMO], 1u); break; } } } } while (0)

struct XcdBarrier {
    unsigned* bar; unsigned x;
    volatile LAS unsigned* st;
};

__device__ __forceinline__ XcdBarrier xcd_barrier_post(unsigned* bar, volatile LAS unsigned* st, int tid) {
    XcdBarrier b; b.bar = bar; b.x = xb_xcc_id(); b.st = st;
    if (tid == 0) (void)xb_add(&bar[XB_XCNT(b.x)], 1u);
    return b;
}
__device__ __forceinline__ void xcd_barrier_complete(unsigned* bar, unsigned x, unsigned& nloc, unsigned& nx) {
    const unsigned G = gridDim.x * gridDim.y * gridDim.z;
    unsigned sum, cnt, mine, sp = 0u;
    for (;;) {
        sum = 0u; cnt = 0u; mine = 0u;
#pragma unroll 1
        for (unsigned j = 0; j < 16; ++j) { const unsigned c = xb_ld(&bar[XB_XCNT(j)]); sum += c; cnt += (c > 0u) ? 1u : 0u; mine = (j == x) ? c : mine; }
        if (sum == G) break;
        __builtin_amdgcn_s_sleep(1);
        if ((++sp & 255u) == 0u) { if (xb_ld(&bar[XB_TMO])) break; if (sp > XB_SPIN_CAP) { atomicAdd(&bar[XB_TMO], 1u); break; } }
    }
    nloc = mine > 0u ? mine : 1u; nx = cnt > 0u ? cnt : 1u;
}

__device__ __forceinline__ void xcd_barrier(const XcdBarrier& b, int tid) {
    asm volatile("s_waitcnt vmcnt(0)" ::: "memory");
    __syncthreads();
    if (tid == 0) {
        unsigned* bar = b.bar;
        __builtin_amdgcn_s_waitcnt(0);
        unsigned nloc = b.st[0], nx = b.st[1];
        if (nloc == 0u) { xcd_barrier_complete(bar, b.x, nloc, nx); b.st[0] = nloc; b.st[1] = nx; }
        const unsigned old = xb_add(&bar[XB_XSUB(b.x)], 1u);
        const unsigned gen = old / nloc;
        if (old + 1u == (gen + 1u) * nloc) {
            __builtin_amdgcn_fence(__ATOMIC_RELEASE, "agent");
            asm volatile("s_waitcnt vmcnt(0)" ::: "memory");
            const unsigned og = xb_add(&bar[XB_TOP], 1u);
            const unsigned tg = og / nx;
            if (og + 1u == (tg + 1u) * nx) xb_add(&bar[XB_TOPGEN], 1u);
            else XB_SPIN(xb_ld(&bar[XB_TOPGEN]) == tg, bar);
            __builtin_amdgcn_fence(__ATOMIC_ACQUIRE, "agent");
            xb_add(&bar[XB_XGEN(b.x)], 1u);
            asm volatile("s_waitcnt vmcnt(0)" ::: "memory");
        } else {
            XB_SPIN(xb_ld(&bar[XB_XGEN(b.x)]) == gen, bar);
            __builtin_amdgcn_fence(__ATOMIC_ACQUIRE, "agent");
            asm volatile("s_waitcnt vmcnt(0)" ::: "memory");
        }
    }
    __syncthreads();
}

struct Frame {
    LAS unsigned char* lds;
    int tid, lane, wave;
    int vcu, G;
    int gw, NGW;
    float* out; unsigned char* ws;
};
constexpr int PTR_OFF = LDSCTL_OFF + 512;
__device__ __forceinline__ const float* inp_(LAS unsigned char* lds, int i) {
    const unsigned long long v = *(const LAS unsigned long long*)(lds + PTR_OFF + 8 * i);
    const unsigned lo = __builtin_amdgcn_readfirstlane((unsigned)v), hi = __builtin_amdgcn_readfirstlane((unsigned)(v >> 32));
    return (const float*)(((unsigned long long)hi << 32) | lo);
}
#define INP(i) inp_(F.lds, (i))
#define WSP(T, off) ((T*)(F.ws + (off)))

__device__ __forceinline__ void gemv17_item(Frame& F, const LAS float* tab, LAS float* red, const float* W, int ldw, int n0, const float* bias, float* outp, int ldo) {
    float acc[17];
#pragma unroll
    for (int r = 0; r < 17; ++r) acc[r] = 0.f;
    const int k0 = F.wave * 128;
    const float* wp = W + (size_t)k0 * ldw + n0 + F.lane;
#pragma unroll 1
    for (int kk = 0; kk < 128; kk += 32) {
        float wv[32];
#pragma unroll
        for (int k = 0; k < 32; ++k) wv[k] = wp[(size_t)(kk + k) * ldw];
#pragma unroll
        for (int k = 0; k < 32; ++k) {
#pragma unroll
            for (int r = 0; r < 17; ++r) acc[r] += tab[r * 1024 + k0 + kk + k] * wv[k];
        }
    }
#pragma unroll
    for (int r = 0; r < 17; ++r) red[(F.wave * 17 + r) * 64 + F.lane] = acc[r];
    __syncthreads();
    for (int i = F.tid; i < 17 * 64; i += NWAVES * 64) {
        const int r = i >> 6, n = i & 63; float s = bias ? bias[n0 + n] : 0.f;
#pragma unroll
        for (int w = 0; w < 8; ++w) s += red[(w * 17 + r) * 64 + n];
        outp[(size_t)r * ldo + n0 + n] = s;
    }
    __syncthreads();
}

__device__ __forceinline__ void p0_transpose_item(const float* W, int K, int N, bf16* WT, LAS float* scr, int item, int lane) {
    const int nblk = N / 32, kb = item / nblk, nb = item % nblk, k0 = 64 * kb, n0 = 32 * nb;
    float tv[32];
#pragma unroll
    for (int i = 0; i < 32; ++i) { const int kk = 2 * i + (lane >> 5); tv[i] = W[(size_t)(k0 + kk) * N + n0 + (lane & 31)]; }
#pragma unroll
    for (int i = 0; i < 32; ++i) { const int kk = 2 * i + (lane >> 5); scr[kk * 33 + (lane & 31)] = tv[i]; }
    LDS_WAIT(); asm volatile("" ::: "memory");
    const int c = lane & 7;
#pragma unroll
    for (int j = 0; j < 4; ++j) { const int n = (lane >> 3) + 8 * j; const LAS float* s = scr + (8 * c) * 33 + n;
        v4u o; o.x = pk2(s[0 * 33], s[1 * 33]); o.y = pk2(s[2 * 33], s[3 * 33]); o.z = pk2(s[4 * 33], s[5 * 33]); o.w = pk2(s[6 * 33], s[7 * 33]);
        *(GAS v4u*)(WT + (size_t)(n0 + n) * K + k0 + 8 * c) = o; }
    LDS_WAIT(); asm volatile("" ::: "memory");
}

__device__ __forceinline__ void phase_p0a(Frame& F) {
    LAS float* tab = (LAS float*)(F.lds);
    LAS float* red = (LAS float*)(F.lds + 17 * 1024 * 4);
    float* MOD = WSP(float, WS_MOD);
    bool filled = false;
    for (int it = F.vcu; it < 2 * 96; it += F.G) {
        if (!filled) {
            for (int i = F.tid; i < 17 * 1024; i += NWAVES * 64) { const int r = i >> 10, k = i & 1023; const float v = (r < 16) ? INP(1)[r * D + k] : INP(3)[k]; tab[i] = siluf_(v); }
            __syncthreads(); filled = true;
        }
        const int l = it / 96, n0 = (it % 96) * 64;
        gemv17_item(F, tab, red, INP(6) + (size_t)l * D * MODW, MODW, n0, INP(7) + (size_t)l * MODW, MOD + (size_t)l * 17 * MODW, MODW);
    }
}

__device__ __forceinline__ void phase_p0b(Frame& F) {
    LAS float* tab = (LAS float*)(F.lds);
    LAS float* red = (LAS float*)(F.lds + 17 * 1024 * 4);
    const float* MOD = WSP(const float, WS_MOD);
    for (int it = F.vcu; it < 2 * 104; it += F.G) {
        const int l = it / 104, j = it % 104; const bool first = j < 40;
        const int shoff = first ? 0 : 3 * D;
        __syncthreads();
        for (int i = F.tid; i < 17 * 1024; i += NWAVES * 64) { const int r = i >> 10, k = i & 1023; tab[i] = MOD[((size_t)l * 17 + r) * MODW + shoff + k]; }
        __syncthreads();
        const int ldw = first ? IND : FF;
        gemv17_item(F, tab, red, first ? INP(8) + (size_t)l * D * IND : INP(22) + (size_t)l * D * FF, ldw, (first ? j : j - 40) * 64, nullptr,
                    first ? WSP(float, WS_SHW1) + (size_t)l * 17 * IND : WSP(float, WS_SHW2) + (size_t)l * 17 * FF, ldw);
    }
    bf16* XA = WSP(bf16, WS_XA); float* RSSA = WSP(float, WS_RSSA);
    const float* g1 = INP(4);
    for (int row = F.gw; row < MT; row += 2 * F.NGW) {
        f32x4 v[2][4]; float ss[2]; int rw[2]; const float* scp[2];
#pragma unroll
        for (int q = 0; q < 2; ++q) { int r_ = row + q * F.NGW; if (r_ >= MT) r_ = row; rw[q] = r_;
            const bool lat = r_ < ML;
            const float* xr = lat ? INP(0) + (size_t)r_ * D : INP(2) + (size_t)(r_ - ML) * D;
            scp[q] = MOD + (size_t)(lat ? (r_ >> 11) : NB) * MODW + D;
#pragma unroll
            for (int j = 0; j < 4; ++j) v[q][j] = *(const f32x4*)(xr + 4 * F.lane + 256 * j); }
#pragma unroll
        for (int q = 0; q < 2; ++q) { float s_ = 0.f;
#pragma unroll
            for (int j = 0; j < 4; ++j) s_ += (v[q][j][0] * v[q][j][0] + v[q][j][1] * v[q][j][1]) + (v[q][j][2] * v[q][j][2] + v[q][j][3] * v[q][j][3]);
            ss[q] = wave_sum(s_); }
#pragma unroll
        for (int q = 0; q < 2; ++q) { if (q == 1 && rw[1] == row) break;
            if (F.lane < 32) RSSA[(size_t)rw[q] * 32 + F.lane] = (F.lane == 0) ? ss[q] : 0.f;
#pragma unroll
            for (int j = 0; j < 4; ++j) { const int k = 4 * F.lane + 256 * j;
                const f32x4 gm = *(const f32x4*)(g1 + k) * (*(const f32x4*)(scp[q] + k) + 1.0f), a = v[q][j] * gm;
                v2u o; o.x = pk2(a[0], a[1]); o.y = pk2(a[2], a[3]); *(v2u*)(XA + (size_t)rw[q] * D + k) = o; } }
    }
    __syncthreads();
    {
        bf16* WLR = WSP(bf16, WS_WLR);
        for (int i = F.gw * 64 + F.lane; i < 2 * 2 * 4 * 2 * 4096; i += F.NGW * 64) { const int d = i & 63, e = (i >> 6) & 63, gt = (i >> 12) & 1, blk = i >> 13;
            const float* src = gt == 0 ? INP(17) : INP(19); WLR[i] = (bf16)f2bf(src[((size_t)blk * 64 + d) * 64 + e]); }
    }
    LAS float* scr = (LAS float*)(F.lds + F.wave * 16384);
    constexpr int I_IN = (D / 64) * (IND / 32), I_OUT = (D / 64) * (D / 32), I_1 = (D / 64) * (FF / 32), I_2 = (FF / 64) * (D / 32), I_L = I_IN + I_OUT + I_1 + I_2;
    for (int it = F.gw; it < 2 * I_L; it += F.NGW) {
        const int l = it / I_L; int r = it % I_L;
        const float* W; bf16* WT; int K = D, N;
        if (r < I_IN) { W = INP(8) + (size_t)l * D * IND; WT = WSP(bf16, WS_WIN) + (size_t)l * IND * D; N = IND; }
        else if (r < I_IN + I_OUT) { r -= I_IN; W = INP(9) + (size_t)l * D * D; WT = WSP(bf16, WS_WOUT) + (size_t)l * D * D; N = D; }
        else if (r < I_IN + I_OUT + I_1) { r -= I_IN + I_OUT; W = INP(22) + (size_t)l * D * FF; WT = WSP(bf16, WS_W1) + (size_t)l * FF * D; N = FF; }
        else { r -= I_IN + I_OUT + I_1; W = INP(23) + (size_t)l * FF * D; WT = WSP(bf16, WS_W2) + (size_t)l * D * FF; K = FF; N = D; }
        p0_transpose_item(W, K, N, WT, scr, r, F.lane);
    }
}


constexpr int CV_OSROW = 260;
__device__ __forceinline__ void conv_phase(Frame& F, int l, int ntiles) {
    const bf16* PROJ = WSP(const bf16, WS_PROJ); bf16* MIX = WSP(bf16, WS_MIX);
    LAS float* us = (LAS float*)(F.lds);
    LAS float* os = (LAS float*)(F.lds + 62 * 256 * 4);
    const int c = F.tid & 255, half = F.tid >> 8;
    float w[31];
#pragma unroll
    for (int k = 0; k < 31; ++k) w[k] = INP(10)[((size_t)l * 31 + k) * 256 + c];
    const float cbias = INP(11)[l * 256 + c];
    const f32x4 lg = *(const f32x4*)(INP(12) + l * 256 + 4 * F.lane), lb = *(const f32x4*)(INP(13) + l * 256 + 4 * F.lane);
    unsigned pv[16], pg[16];
    auto load_tile = [&](int T) {
        const int row0 = T * 32;
        int lo, hi; if (row0 < ML) { lo = row0 & ~(SEQ - 1); hi = lo + SEQ; } else { lo = row0 & ~(CTXL - 1); hi = lo + CTXL; }
#pragma unroll
        for (int j = 0; j < 16; ++j) { const int i = F.tid + 512 * j, rr = i >> 7, cp = i & 127, row = row0 - 15 + rr;
            const bool ok = (j < 15 || F.tid < 256) && row >= lo && row < hi;
            pv[j] = ok ? *(const unsigned*)(PROJ + (size_t)row * IND + 2 * cp) : 0u; pg[j] = ok ? *(const unsigned*)(PROJ + (size_t)row * IND + 256 + 2 * cp) : 0u; }
    };
    const int T0 = F.G - 1 - F.vcu;
    if (T0 < ntiles) load_tile(T0);
    for (int T = T0; T < ntiles; T += F.G) {
        const int row0 = T * 32;
        __syncthreads();
#pragma unroll
        for (int j = 0; j < 16; ++j) { const int i = F.tid + 512 * j;
            if (j < 15 || F.tid < 256) { f32x2 u; u[0] = bflo(pv[j]) * sigmoidf_(bflo(pg[j])); u[1] = bfhi(pv[j]) * sigmoidf_(bfhi(pg[j])); *(LAS f32x2*)(us + 2 * i) = u; } }
        if (T + F.G < ntiles) load_tile(T + F.G);
        __syncthreads();
        {
            float acc[16];
#pragma unroll
            for (int j = 0; j < 16; ++j) acc[j] = cbias;
            const LAS float* up = us + (16 * half) * 256 + c;
#pragma unroll
            for (int i = 0; i < 46; ++i) { const float x = up[i * 256];
#pragma unroll
                for (int j = 0; j < 16; ++j) if (i - j >= 0 && i - j <= 30) acc[j] += w[i - j] * x; }
#pragma unroll
            for (int j = 0; j < 16; ++j) os[(16 * half + j) * CV_OSROW + c] = acc[j];
        }
        __syncthreads();
#pragma unroll
        for (int q = 0; q < 4; ++q) { const int t = 4 * F.wave + q;
            const f32x4 v = *(const LAS f32x4*)(os + t * CV_OSROW + 4 * F.lane);
            const float mu = wave_sum((v[0] + v[1]) + (v[2] + v[3])) * (1.f / 256.f);
            const f32x4 d = v - mu;
            const float var = wave_sum((d[0] * d[0] + d[1] * d[1]) + (d[2] * d[2] + d[3] * d[3])) * (1.f / 256.f);
            const f32x4 y = d * rsqrtf(var + EPS) * lg + lb;
            v2u o; o.x = pk2(siluf_(y[0]), siluf_(y[1])); o.y = pk2(siluf_(y[2]), siluf_(y[3]));
            *(v2u*)(MIX + (size_t)(row0 + t) * D + 4 * F.lane) = o; }
    }
}

typedef short s16x8 __attribute__((ext_vector_type(8)));
typedef short s16x4 __attribute__((ext_vector_type(4)));
constexpr int NA_KROW = 144, NA_VROW = 160;
constexpr int NA_STAGE = 64 * NA_KROW + 64 * NA_VROW, NA_OFF_TB = 2 * NA_STAGE;
constexpr int NA_ITEMS_LAT = NB * NH * 8, NA_ITEMS_CTX = NB * NH * 2;
struct NaBlk { f32x4 O[4]; float m, lsum; int first; };
__device__ __forceinline__ int na_rs(int r) { int v = r - 4; return v < 0 ? 0 : (v > 24 ? 24 : v); }
__device__ __forceinline__ s16x8 na_scale_q(v4u w, float c) {
    v4u o; o.x = pg8::cvt_pk_bf16(bflo(w.x) * c, bfhi(w.x) * c); o.y = pg8::cvt_pk_bf16(bflo(w.y) * c, bfhi(w.y) * c); o.z = pg8::cvt_pk_bf16(bflo(w.z) * c, bfhi(w.z) * c); o.w = pg8::cvt_pk_bf16(bflo(w.w) * c, bfhi(w.w) * c);
    return __builtin_bit_cast(s16x8, o);
}
__device__ __forceinline__ void na_phase(Frame& F, int l, int nitems, int nav = 0) {
    const bf16* PROJ = WSP(const bf16, WS_PROJ); bf16* MIX = WSP(bf16, WS_MIX);
    LAS float* tb = (LAS float*)(F.lds + NA_OFF_TB);
    const int lane = F.lane, q16 = lane & 15, g = lane >> 4;
    const unsigned skey = (unsigned)(F.tid >> 3), spart = (unsigned)(F.tid & 7);
    const float c1 = 0.125f * 1.4426950408889634f;
    for (int it = F.vcu; it < nitems; it += F.G) {
        const bool isctx = it >= NA_ITEMS_LAT;
        int b, h, ra = 0, jq = 0, qrow0, rsI = 0, nloc = 0;
        if (!isctx) { const int r4 = it & 7; h = (it >> 3) & 7; b = it >> 6; const int r0 = 4 * r4; ra = r0 + 2 * (F.wave >> 2); jq = F.wave & 3; qrow0 = b * SEQ + ra * 64 + jq * 16;
            rsI = na_rs(r0); nloc = na_rs(r0 + 3) + 8 - rsI; }
        else { const int j = it - NA_ITEMS_LAT; const int hf = j & 1; h = (j >> 1) & 7; b = j >> 4; qrow0 = ML + b * CTXL + hf * 128 + F.wave * 16; }
        const int nch = nloc + 4;
        const bf16* Pq = PROJ + 512 + h * HD, * Pk = PROJ + 1024 + h * HD + 8 * spart, * Pv = PROJ + 1536 + h * HD + 8 * spart;
        auto krow_of = [&](int ch) -> int { return ch < nloc ? b * SEQ + (rsI + ch) * 64 : ML + b * CTXL + (ch - nloc) * 64; };
        s16x8 qfA[2], qfB[2];
#pragma unroll
        for (int s_ = 0; s_ < 2; ++s_) { qfA[s_] = na_scale_q(*(const v4u*)(Pq + (size_t)(qrow0 + q16) * IND + 32 * s_ + 8 * g), c1);
            qfB[s_] = isctx ? qfA[s_] : na_scale_q(*(const v4u*)(Pq + (size_t)(qrow0 + 64 + q16) * IND + 32 * s_ + 8 * g), c1); }
        const int rsA = na_rs(ra), rsB = na_rs(ra + 1);
        const int o0 = jq == 0 ? 0 : 16 * jq - 8, o1 = jq == 0 ? 16 : (jq == 3 ? 48 : 16 * jq + 8);
        float madd[2][4]; int lb[2];
        {
            const int qc = jq * 16 + q16; int cs = qc - 8; cs = cs < 0 ? 0 : (cs > 48 ? 48 : cs);
#pragma unroll
            for (int e = 0; e < 4; ++e) { const int k0 = o0 + 4 * g + e, k1 = o1 + 4 * g + e;
                madd[0][e] = ((unsigned)(k0 - cs) < 16u) ? 0.f : -1.0e30f;
                madd[1][e] = (((unsigned)(k1 - cs) < 16u) && !(jq == 3 && k1 < 56)) ? 0.f : -1.0e30f; }
            lb[0] = 64 + o0 + 4 * g - qc + 15; lb[1] = 64 + o1 + 4 * g - qc + 15;
        }
        v4u kr_ = *(const v4u*)(Pk + (size_t)(krow_of(0) + (int)skey) * IND), vr_ = *(const v4u*)(Pv + (size_t)(krow_of(0) + (int)skey) * IND);
        __syncthreads();
        if (!isctx) { const float* rpb = INP(14) + ((size_t)l * NH + h) * 15 * 31;
            for (int i = F.tid; i < 640; i += NWAVES * 64) tb[i] = (i >= 64 && i < 64 + 465) ? rpb[i - 64] * 1.4426950408889634f : 0.f; }
        *(LAS v4u*)(F.lds + skey * NA_KROW + spart * 16) = kr_; *(LAS v4u*)(F.lds + 64 * NA_KROW + skey * NA_VROW + spart * 16) = vr_;
        kr_ = *(const v4u*)(Pk + (size_t)(krow_of(1) + (int)skey) * IND); vr_ = *(const v4u*)(Pv + (size_t)(krow_of(1) + (int)skey) * IND);
        NaBlk A, B;
#pragma unroll
        for (int dt = 0; dt < 4; ++dt) { A.O[dt] = (f32x4){0.f, 0.f, 0.f, 0.f}; B.O[dt] = (f32x4){0.f, 0.f, 0.f, 0.f}; }
        A.m = 0.f; A.lsum = 0.f; A.first = 1; B.m = 0.f; B.lsum = 0.f; B.first = 1;
        for (int ch = 0; ch < nch; ++ch) {
            __syncthreads();
            LAS unsigned char* cur = F.lds + (ch & 1) * NA_STAGE; LAS unsigned char* nxt = F.lds + ((ch + 1) & 1) * NA_STAGE;
            if (ch + 1 < nch) { *(LAS v4u*)(nxt + skey * NA_KROW + spart * 16) = kr_; *(LAS v4u*)(nxt + 64 * NA_KROW + skey * NA_VROW + spart * 16) = vr_; }
            if (ch + 2 < nch) { const int k2 = krow_of(ch + 2) + (int)skey; kr_ = *(const v4u*)(Pk + (size_t)k2 * IND); vr_ = *(const v4u*)(Pv + (size_t)k2 * IND); }
            const bool local = ch < nloc;
            const int kr = rsI + ch;
            const bool actA = !local || (kr >= rsA && kr <= rsA + 7), actB = !isctx && (!local || (kr >= rsB && kr <= rsB + 7));
            if ((!actA && !actB) || nav == 1) continue;
            auto finish = [&](f32x4* S, int nt_, NaBlk& X, unsigned (*pk)[2], float cm) {
                if (X.first || !__all(cm <= 8.f)) {
                    cm = fmaxf(cm, __shfl_xor(cm, 16)); cm = fmaxf(cm, __shfl_xor(cm, 32));
                    const float d = X.first ? cm : fmaxf(cm, 0.f);
                    if (!X.first) { const float alpha = __builtin_amdgcn_exp2f(-d); X.lsum *= alpha;
#pragma unroll
                        for (int dt = 0; dt < 4; ++dt) X.O[dt] = X.O[dt] * alpha; }
                    X.m += d; X.first = 0;
#pragma unroll
                    for (int t = 0; t < 4; ++t) if (t < nt_) S[t] = S[t] - d;
                }
                float ps = 0.f;
#pragma unroll
                for (int t = 0; t < 4; ++t) if (t < nt_) {
                    const float p0 = __builtin_amdgcn_exp2f(S[t][0]), p1 = __builtin_amdgcn_exp2f(S[t][1]), p2 = __builtin_amdgcn_exp2f(S[t][2]), p3 = __builtin_amdgcn_exp2f(S[t][3]);
                    ps += (p0 + p1) + (p2 + p3);
                    pk[t][0] = pg8::cvt_pk_bf16(p0, p1); pk[t][1] = pg8::cvt_pk_bf16(p2, p3); }
                X.lsum += ps;
            };
            unsigned pkA[4][2], pkB[4][2];
            if (local) {
                const LAS unsigned char* kb_ = cur + q16 * NA_KROW + 16 * g;
                f32x4 SA[2], SB[2];
#pragma unroll
                for (int t = 0; t < 2; ++t) { const float ma = -A.m, mb = -B.m; SA[t] = (f32x4){ma, ma, ma, ma}; SB[t] = (f32x4){mb, mb, mb, mb};
                    const int o = t == 0 ? o0 : o1;
#pragma unroll
                    for (int s_ = 0; s_ < 2; ++s_) { const s16x8 kf = *(const LAS s16x8*)(kb_ + o * NA_KROW + 64 * s_);
                        if (actA) SA[t] = __builtin_amdgcn_mfma_f32_16x16x32_bf16(kf, qfA[s_], SA[t], 0, 0, 0);
                        if (actB) SB[t] = __builtin_amdgcn_mfma_f32_16x16x32_bf16(kf, qfB[s_], SB[t], 0, 0, 0); } }
                if (nav == 2) { asm volatile("" :: "v"(SA[0]), "v"(SA[1]), "v"(SB[0]), "v"(SB[1])); continue; }
                auto soft_local = [&](f32x4 (&S)[2], NaBlk& X, unsigned (&pk)[4][2], int rq) {
                    float cm = -1.0e30f;
#pragma unroll
                    for (int t = 0; t < 2; ++t) { const LAS float* tr_ = tb + (kr - rq + 7) * 31 + lb[t];
#pragma unroll
                        for (int e = 0; e < 4; ++e) { const float v = (S[t][e] + tr_[e]) + madd[t][e]; S[t][e] = v; cm = fmaxf(cm, v); } }
                    finish(S, 2, X, pk, cm);
                };
                if (actA) soft_local(SA, A, pkA, ra);
                if (actB) soft_local(SB, B, pkB, ra + 1);
                if (nav == 3) { asm volatile("" :: "v"(pkA[0][0]), "v"(pkA[1][1]), "v"(pkB[0][0]), "v"(pkB[1][1])); continue; }
                const LAS unsigned char* vtr = cur + 64 * NA_KROW + (4 * g + (q16 >> 2)) * NA_VROW + (q16 & 3) * 8;
                const v4u bwA = {pkA[0][0], pkA[0][1], pkA[1][0], pkA[1][1]}, bwB = {pkB[0][0], pkB[0][1], pkB[1][0], pkB[1][1]};
                const s16x8 bfA = __builtin_bit_cast(s16x8, bwA), bfB = __builtin_bit_cast(s16x8, bwB);
#pragma unroll
                for (int dt = 0; dt < 4; ++dt) {
                    const s16x4 a0 = __builtin_amdgcn_ds_read_tr16_b64_v4i16((LAS s16x4*)(vtr + o0 * NA_VROW + dt * 32));
                    const s16x4 a1 = __builtin_amdgcn_ds_read_tr16_b64_v4i16((LAS s16x4*)(vtr + o1 * NA_VROW + dt * 32));
                    const s16x8 afrag = __builtin_shufflevector(a0, a1, 0, 1, 2, 3, 4, 5, 6, 7);
                    if (actA) A.O[dt] = __builtin_amdgcn_mfma_f32_16x16x32_bf16(afrag, bfA, A.O[dt], 0, 0, 0);
                    if (actB) B.O[dt] = __builtin_amdgcn_mfma_f32_16x16x32_bf16(afrag, bfB, B.O[dt], 0, 0, 0);
                }
            } else {
                const LAS unsigned char* kb_ = cur + q16 * NA_KROW + 16 * g;
                f32x4 SA[4], SB[4];
#pragma unroll
                for (int t = 0; t < 4; ++t) { const float ma = -A.m, mb = -B.m; SA[t] = (f32x4){ma, ma, ma, ma}; SB[t] = (f32x4){mb, mb, mb, mb};
#pragma unroll
                    for (int s_ = 0; s_ < 2; ++s_) { const s16x8 kf = *(const LAS s16x8*)(kb_ + t * 16 * NA_KROW + 64 * s_);
                        SA[t] = __builtin_amdgcn_mfma_f32_16x16x32_bf16(kf, qfA[s_], SA[t], 0, 0, 0);
                        if (actB) SB[t] = __builtin_amdgcn_mfma_f32_16x16x32_bf16(kf, qfB[s_], SB[t], 0, 0, 0); } }
                if (nav == 2) { asm volatile("" :: "v"(SA[0]), "v"(SA[1]), "v"(SA[2]), "v"(SA[3]), "v"(SB[0]), "v"(SB[1]), "v"(SB[2]), "v"(SB[3])); continue; }
                auto soft_ctx = [&](f32x4 (&S)[4], NaBlk& X, unsigned (&pk)[4][2]) {
                    float cm = -1.0e30f;
#pragma unroll
                    for (int t = 0; t < 4; ++t)
#pragma unroll
                        for (int e = 0; e < 4; ++e) cm = fmaxf(cm, S[t][e]);
                    finish(S, 4, X, pk, cm);
                };
                soft_ctx(SA, A, pkA);
                if (actB) soft_ctx(SB, B, pkB);
                if (nav == 3) { asm volatile("" :: "v"(pkA[0][0]), "v"(pkA[1][1]), "v"(pkA[2][0]), "v"(pkA[3][1]), "v"(pkB[0][0]), "v"(pkB[1][1]), "v"(pkB[2][0]), "v"(pkB[3][1])); continue; }
                const LAS unsigned char* vtr = cur + 64 * NA_KROW + (4 * g + (q16 >> 2)) * NA_VROW + (q16 & 3) * 8;
#pragma unroll
                for (int p = 0; p < 2; ++p) {
                    const v4u bwA = {pkA[2 * p][0], pkA[2 * p][1], pkA[2 * p + 1][0], pkA[2 * p + 1][1]}, bwB = {pkB[2 * p][0], pkB[2 * p][1], pkB[2 * p + 1][0], pkB[2 * p + 1][1]};
                    const s16x8 bfA = __builtin_bit_cast(s16x8, bwA), bfB = __builtin_bit_cast(s16x8, bwB);
#pragma unroll
                    for (int dt = 0; dt < 4; ++dt) {
                        const s16x4 a0 = __builtin_amdgcn_ds_read_tr16_b64_v4i16((LAS s16x4*)(vtr + (2 * p) * 16 * NA_VROW + dt * 32));
                        const s16x4 a1 = __builtin_amdgcn_ds_read_tr16_b64_v4i16((LAS s16x4*)(vtr + (2 * p + 1) * 16 * NA_VROW + dt * 32));
                        const s16x8 afrag = __builtin_shufflevector(a0, a1, 0, 1, 2, 3, 4, 5, 6, 7);
                        A.O[dt] = __builtin_amdgcn_mfma_f32_16x16x32_bf16(afrag, bfA, A.O[dt], 0, 0, 0);
                        if (actB) B.O[dt] = __builtin_amdgcn_mfma_f32_16x16x32_bf16(afrag, bfB, B.O[dt], 0, 0, 0);
                    }
                }
            }
        }
        {
            float ls = A.lsum; ls += __shfl_xor(ls, 16); ls += __shfl_xor(ls, 32);
            const float inv = __builtin_amdgcn_rcpf(ls);
            bf16* op = MIX + (size_t)(qrow0 + q16) * D + 256 + h * HD + 4 * g;
#pragma unroll
            for (int dt = 0; dt < 4; ++dt) { v2u w; w.x = pg8::cvt_pk_bf16(A.O[dt][0] * inv, A.O[dt][1] * inv); w.y = pg8::cvt_pk_bf16(A.O[dt][2] * inv, A.O[dt][3] * inv); *(v2u*)(op + 16 * dt) = w; }
        }
        if (!isctx) {
            float ls = B.lsum; ls += __shfl_xor(ls, 16); ls += __shfl_xor(ls, 32);
            const float inv = __builtin_amdgcn_rcpf(ls);
            bf16* op = MIX + (size_t)(qrow0 + 64 + q16) * D + 256 + h * HD + 4 * g;
#pragma unroll
            for (int dt = 0; dt < 4; ++dt) { v2u w; w.x = pg8::cvt_pk_bf16(B.O[dt][0] * inv, B.O[dt][1] * inv); w.y = pg8::cvt_pk_bf16(B.O[dt][2] * inv, B.O[dt][3] * inv); *(v2u*)(op + 16 * dt) = w; }
        }
    }
}

constexpr int LRU_UCROW = 260;
constexpr int LRU_OFF_UC = 38 * 256 * 2, LRU_OFF_GT = LRU_OFF_UC + 2 * 32 * LRU_UCROW * 4;
static_assert(LRU_OFF_GT + 32 * 256 * 2 <= RING_BYTES, "LRU LDS map");
template <int PASS>
__device__ __forceinline__ void lru_phase(Frame& F, int l, int ntiles) {
    const bf16* PROJ = WSP(const bf16, WS_PROJ);
    LAS bf16* rxs = (LAS bf16*)(F.lds);
    LAS float* ucf = (LAS float*)(F.lds + LRU_OFF_UC);
    LAS bf16* gts = (LAS bf16*)(F.lds + LRU_OFF_GT);
    const int lane = F.lane, j16 = lane & 15, g = lane >> 4;
    const int kb = F.wave & 3, nh = F.wave >> 2;
    s16x8 wf[2][2][2][2];
    float cbx[2][2], cba[2][2], csp[2][2];
#pragma unroll
    for (int dir = 0; dir < 2; ++dir) {
        const int ld = l * 2 + dir;
        const bf16* WLR = WSP(const bf16, WS_WLR) + (size_t)((ld * 4 + kb) * 2) * 4096;
#pragma unroll
        for (int gt = 0; gt < 2; ++gt)
#pragma unroll
            for (int n2 = 0; n2 < 2; ++n2)
#pragma unroll
                for (int s_ = 0; s_ < 2; ++s_) wf[dir][gt][n2][s_] = *(const s16x8*)(WLR + gt * 4096 + (16 * (2 * nh + n2) + j16) * 64 + 32 * s_ + 8 * g);
#pragma unroll
        for (int n2 = 0; n2 < 2; ++n2) {
            const int e = kb * 64 + 16 * (2 * nh + n2) + j16, idx = ld * 256 + e;
            cbx[dir][n2] = INP(18)[idx]; cba[dir][n2] = INP(20)[idx];
            const float nl = -INP(21)[idx]; csp[dir][n2] = -8.f * (fmaxf(nl, 0.f) + log1pf(__expf(-fabsf(nl))));
        }
    }
    const int c = F.tid & 255, sdir = F.tid >> 8;
    const int sld = l * 2 + sdir;
    const float s1w0 = INP(15)[(sld * 4 + 0) * 256 + c], s1w1 = INP(15)[(sld * 4 + 1) * 256 + c], s1w2 = INP(15)[(sld * 4 + 2) * 256 + c], s1w3 = INP(15)[(sld * 4 + 3) * 256 + c], s1cb = INP(16)[sld * 256 + c];
    const int base = sdir == 0 ? 0 : 3;
    unsigned pre[10], pgw[8];
    auto load_tile = [&](int T) {
        const int row0 = T * 32;
        int lo, hi; if (row0 < ML) { lo = row0 & ~(SEQ - 1); hi = lo + SEQ; } else { lo = row0 & ~(CTXL - 1); hi = lo + CTXL; }
#pragma unroll
        for (int j = 0; j < 10; ++j) { const int i = F.tid + 512 * j, rr = i >> 7, cp = i & 127, row = row0 - 3 + rr;
            const bool ok = (j < 9 || F.tid < 256) && row >= lo && row < hi;
            pre[j] = ok ? *(const unsigned*)(PROJ + (size_t)row * IND + 2048 + 2 * cp) : 0u; }
        if (PASS == 1) {
#pragma unroll
            for (int j = 0; j < 8; ++j) { const int i = F.tid + 512 * j, t = i >> 7, cp = i & 127; pgw[j] = *(const unsigned*)(PROJ + (size_t)(row0 + t) * IND + 2304 + 2 * cp); }
        }
    };
    if (F.vcu < ntiles) load_tile(F.vcu);
    for (int T = F.vcu; T < ntiles; T += F.G) {
        const int row0 = T * 32;
        __syncthreads();
#pragma unroll
        for (int j = 0; j < 10; ++j) { const int i = F.tid + 512 * j; if (j < 9 || F.tid < 256) ((LAS unsigned*)rxs)[i] = pre[j]; }
        if (PASS == 1) {
#pragma unroll
            for (int j = 0; j < 8; ++j) ((LAS unsigned*)gts)[F.tid + 512 * j] = pgw[j];
        }
        if (T + F.G < ntiles) load_tile(T + F.G);
        float hst[2][2];
#pragma unroll
        for (int dir = 0; dir < 2; ++dir)
#pragma unroll
            for (int n2 = 0; n2 < 2; ++n2) hst[dir][n2] = PASS == 1 ? WSP(const float, WS_CARRY)[((size_t)dir * 1152 + T) * 256 + kb * 64 + 16 * (2 * nh + n2) + j16] : 0.f;
        __syncthreads();
        {
            float x0 = bf1(rxs[(base + 0) * 256 + c]), x1 = bf1(rxs[(base + 1) * 256 + c]), x2 = bf1(rxs[(base + 2) * 256 + c]);
#pragma unroll 8
            for (int t = 0; t < 32; ++t) {
                const float x3 = bf1(rxs[(t + base + 3) * 256 + c]);
                ucf[(sdir * 32 + t) * LRU_UCROW + c] = s1cb + s1w0 * x0 + s1w1 * x1 + s1w2 * x2 + s1w3 * x3;
                x0 = x1; x1 = x2; x2 = x3;
            }
        }
        __syncthreads();
        float hf[2][2][4];
        float Pt[2][2] = {{1.f, 1.f}, {1.f, 1.f}};
#pragma unroll
        for (int dir = 0; dir < 2; ++dir) {
            const bool sec16 = ((g & 1) != 0) != (dir != 0), sec32 = ((g >> 1) != 0) != (dir != 0);
#pragma unroll
            for (int step = 0; step < 2; ++step) {
                const int rt = dir == 0 ? step : 1 - step;
                s16x8 af[2];
#pragma unroll
                for (int s_ = 0; s_ < 2; ++s_) { const LAS float* up = ucf + (dir * 32 + 16 * rt + j16) * LRU_UCROW + kb * 64 + 32 * s_ + 8 * g;
                    const f32x4 u0 = *(const LAS f32x4*)up, u1 = *(const LAS f32x4*)(up + 4);
                    const v4u w = {pg8::cvt_pk_bf16(u0[0], u0[1]), pg8::cvt_pk_bf16(u0[2], u0[3]), pg8::cvt_pk_bf16(u1[0], u1[1]), pg8::cvt_pk_bf16(u1[2], u1[3])};
                    af[s_] = __builtin_bit_cast(s16x8, w); }
#pragma unroll
                for (int n2 = 0; n2 < 2; ++n2) {
                    f32x4 zx = {0.f, 0.f, 0.f, 0.f}, za = {0.f, 0.f, 0.f, 0.f};
#pragma unroll
                    for (int s_ = 0; s_ < 2; ++s_) { zx = __builtin_amdgcn_mfma_f32_16x16x32_bf16(af[s_], wf[dir][0][n2][s_], zx, 0, 0, 0); za = __builtin_amdgcn_mfma_f32_16x16x32_bf16(af[s_], wf[dir][1][n2][s_], za, 0, 0, 0); }
                    const int e = kb * 64 + 16 * (2 * nh + n2) + j16;
                    const LAS float* uo = ucf + (dir * 32 + 16 * rt + 4 * g) * LRU_UCROW + e;
                    float a_[4], b_[4];
#pragma unroll
                    for (int r = 0; r < 4; ++r) {
                        const float u = uo[r * LRU_UCROW];
                        const float gx = sigmoidf_(zx[r] + cbx[dir][n2]), ga = sigmoidf_(za[r] + cba[dir][n2]);
                        const float la = csp[dir][n2] * ga, a = __builtin_amdgcn_exp2f(1.4426950408889634f * la), y = 2.f * la;
                        const float om = y > -0.02f ? -y * (1.f + y * (0.5f + y * 0.16666667f)) : 1.f - a * a;
                        a_[r] = a; b_[r] = __builtin_amdgcn_sqrtf(om) * gx * u;
                    }
                    const float P = (a_[0] * a_[1]) * (a_[2] * a_[3]);
                    const float S = dir == 0 ? ((b_[0] * a_[1] + b_[1]) * a_[2] + b_[2]) * a_[3] + b_[3] : ((b_[3] * a_[2] + b_[2]) * a_[1] + b_[1]) * a_[0] + b_[0];
                    const float Pp = __shfl_xor(P, 16), Sp = __shfl_xor(S, 16);
                    const float e1P = sec16 ? Pp : 1.f, e1S = sec16 ? Sp : 0.f;
                    const float prP = P * Pp, prS = sec16 ? P * Sp + S : Pp * S + Sp;
                    const float Pq = __shfl_xor(prP, 32), Sq = __shfl_xor(prS, 32);
                    const float EP = sec32 ? Pq * e1P : e1P, ES = sec32 ? e1P * Sq + e1S : e1S;
                    const float TP = prP * Pq, TS = sec32 ? prP * Sq + prS : Pq * prS + Sq;
                    if (PASS == 1) {
                        float h = EP * hst[dir][n2] + ES;
                        if (dir == 0) {
#pragma unroll
                            for (int r = 0; r < 4; ++r) { h = a_[r] * h + b_[r]; hf[rt][n2][r] = h; }
                        } else {
                            float hb[4];
#pragma unroll
                            for (int r = 3; r >= 0; --r) { h = a_[r] * h + b_[r]; hb[r] = h; }
                            bf16* mp = WSP(bf16, WS_MIX) + (size_t)(row0 + 16 * rt + 4 * g) * D + 768 + e;
                            const LAS bf16* gp = gts + (16 * rt + 4 * g) * 256 + e;
#pragma unroll
                            for (int r = 0; r < 4; ++r) mp[(size_t)r * D] = (bf16)f2bf(gelu_tanh(bf1(gp[r * 256])) * (hf[rt][n2][r] + hb[r]));
                        }
                    } else Pt[dir][n2] *= TP;
                    hst[dir][n2] = TP * hst[dir][n2] + TS;
                }
            }
        }
        if (PASS == 0 && g == 0) {
#pragma unroll
            for (int dir = 0; dir < 2; ++dir)
#pragma unroll
                for (int n2 = 0; n2 < 2; ++n2) WSP(f32x2, WS_TOT)[((size_t)dir * 1152 + T) * 256 + kb * 64 + 16 * (2 * nh + n2) + j16] = (f32x2){Pt[dir][n2], hst[dir][n2]};
        }
    }
}
__device__ __forceinline__ void lru_carry(Frame& F) {
    const f32x2* TOT = WSP(const f32x2, WS_TOT); float* CARRY = WSP(float, WS_CARRY);
    for (int it = F.gw; it < NB * 2 * 4; it += F.NGW) {
        const int b = it >> 3, dir = (it >> 2) & 1, c = (it & 3) * 64 + F.lane;
        float h = 0.f;
        for (int g = 0; g < 18; ++g) {
            f32x2 ps[4]; int tl[4];
#pragma unroll
            for (int i = 0; i < 4; ++i) { const int s = g * 4 + i;
                int T; if (s < 8) T = 1024 + b * 8 + (dir == 0 ? s : 7 - s); else T = b * 64 + (dir == 0 ? s - 8 : 71 - s);
                tl[i] = T; ps[i] = TOT[((size_t)dir * 1152 + T) * 256 + c]; }
#pragma unroll
            for (int i = 0; i < 4; ++i) { CARRY[((size_t)dir * 1152 + tl[i]) * 256 + c] = h; h = ps[i][0] * h + ps[i][1]; }
        }
    }
}

__device__ __forceinline__ void ctx_finalize(Frame& F, int l) {
    bf16* XA = WSP(bf16, WS_XA); float* RSSA = WSP(float, WS_RSSA); const float* ACC = WSP(const float, WS_PART); const float* MOD = WSP(const float, WS_MOD);
    const float* go = INP(5) + (l - 1) * D; const float* gso = MOD + ((size_t)(l - 1) * 17 + NB) * MODW + 4 * D;
    const float* gn = INP(4) + l * D; const float* gsn = MOD + ((size_t)l * 17 + NB) * MODW + D;
    for (int r = F.gw; r < MC; r += F.NGW) {
        const size_t row = (size_t)ML + r;
        float ss = 0.f; f32x4 y[4];
#pragma unroll
        for (int j = 0; j < 4; ++j) { const int k = 4 * F.lane + 256 * j;
            const v2u w = *(const v2u*)(XA + row * D + k);
            const f32x4 im = *(const f32x4*)(go + k) * (*(const f32x4*)(gso + k) + 1.0f);
            const f32x4 xo = (f32x4){bflo(w.x) * __builtin_amdgcn_rcpf(im[0]), bfhi(w.x) * __builtin_amdgcn_rcpf(im[1]), bflo(w.y) * __builtin_amdgcn_rcpf(im[2]), bfhi(w.y) * __builtin_amdgcn_rcpf(im[3])};
            const float* ap = ACC + (size_t)r * D + k;
            y[j] = xo + ((*(const f32x4*)ap + *(const f32x4*)(ap + (size_t)MC * D)) + (*(const f32x4*)(ap + (size_t)2 * MC * D) + *(const f32x4*)(ap + (size_t)3 * MC * D)));
            ss += (y[j][0] * y[j][0] + y[j][1] * y[j][1]) + (y[j][2] * y[j][2] + y[j][3] * y[j][3]); }
        ss = wave_sum(ss);
        if (F.lane < 32) RSSA[row * 32 + F.lane] = (F.lane == 0) ? ss : 0.f;
#pragma unroll
        for (int j = 0; j < 4; ++j) { const int k = 4 * F.lane + 256 * j;
            const f32x4 a = y[j] * (*(const f32x4*)(gn + k) * (*(const f32x4*)(gsn + k) + 1.0f));
            v2u o; o.x = pk2(a[0], a[1]); o.y = pk2(a[2], a[3]); *(v2u*)(XA + row * D + k) = o; }
    }
}

__device__ __forceinline__ void final_rows(Frame& F) {
    const bf16* XA = WSP(const bf16, WS_XA); const float* RSS = WSP(const float, WS_RSSA);
    for (int row = F.gw; row < ML; row += 2 * F.NGW) {
        const int row2 = row + F.NGW; const bool two = row2 < ML;
        const v4u a0 = *(const v4u*)(XA + (size_t)row * D + 8 * F.lane), a1 = *(const v4u*)(XA + (size_t)row * D + 512 + 8 * F.lane);
        const float p0 = F.lane < 32 ? RSS[(size_t)row * 32 + F.lane] : 0.f;
        v4u b0 = a0, b1 = a1; float p1 = 0.f;
        if (two) { b0 = *(const v4u*)(XA + (size_t)row2 * D + 8 * F.lane); b1 = *(const v4u*)(XA + (size_t)row2 * D + 512 + 8 * F.lane); p1 = F.lane < 32 ? RSS[(size_t)row2 * 32 + F.lane] : 0.f; }
        const float rs0 = rsqrtf(wave_sum(p0) * (1.f / D) + EPS), rs1 = rsqrtf(wave_sum(p1) * (1.f / D) + EPS);
        float* o = F.out + (size_t)row * D + 8 * F.lane;
        *(f32x4*)(o) = (f32x4){bflo(a0.x), bfhi(a0.x), bflo(a0.y), bfhi(a0.y)} * rs0; *(f32x4*)(o + 4) = (f32x4){bflo(a0.z), bfhi(a0.z), bflo(a0.w), bfhi(a0.w)} * rs0;
        *(f32x4*)(o + 512) = (f32x4){bflo(a1.x), bfhi(a1.x), bflo(a1.y), bfhi(a1.y)} * rs0; *(f32x4*)(o + 516) = (f32x4){bflo(a1.z), bfhi(a1.z), bflo(a1.w), bfhi(a1.w)} * rs0;
        if (two) { float* o2 = F.out + (size_t)row2 * D + 8 * F.lane;
            *(f32x4*)(o2) = (f32x4){bflo(b0.x), bfhi(b0.x), bflo(b0.y), bfhi(b0.y)} * rs1; *(f32x4*)(o2 + 4) = (f32x4){bflo(b0.z), bfhi(b0.z), bflo(b0.w), bfhi(b0.w)} * rs1;
            *(f32x4*)(o2 + 512) = (f32x4){bflo(b1.x), bfhi(b1.x), bflo(b1.y), bfhi(b1.y)} * rs1; *(f32x4*)(o2 + 516) = (f32x4){bflo(b1.z), bfhi(b1.z), bflo(b1.w), bfhi(b1.w)} * rs1; }
    }
}

constexpr int N_PHASES = 2 + 7 * DEPTH + 1;
struct Args { const float* in[25]; float* out; unsigned char* ws; int ph_lo, ph_hi; };
static_assert(sizeof(Args) == 27 * 8 + 8, "Args has no padding");

__global__ void __launch_bounds__(NWAVES * 64, 2) mega_fwd(Args args) {
    extern __shared__ __attribute__((aligned(16))) unsigned char lds[];
    Frame F;
    F.lds = (LAS unsigned char*)lds;
    const int wave_s = __builtin_amdgcn_readfirstlane((int)threadIdx.x >> 6);
    F.wave = wave_s; F.lane = (int)__builtin_amdgcn_mbcnt_hi(~0u, __builtin_amdgcn_mbcnt_lo(~0u, 0u)); F.tid = wave_s * 64 + F.lane;
    F.G = gridDim.x; { const int bx = blockIdx.x; F.vcu = (F.G % 8 == 0) ? (bx % 8) * (F.G / 8) + bx / 8 : bx; }
    F.gw = F.vcu * NWAVES + F.wave; F.NGW = F.G * NWAVES;
    F.out = args.out; F.ws = args.ws;
    volatile LAS unsigned* MISC = (volatile LAS unsigned*)(F.lds + MISC_OFF);
    for (int u = F.tid; u < (LDS_BYTES - LDSCTL_OFF) / 4; u += NWAVES * 64) ((LAS unsigned*)(F.lds + LDSCTL_OFF))[u] = 0u;
    __syncthreads();
    if (F.tid == 0) {
#pragma unroll
        for (int i = 0; i < 25; ++i) *(LAS unsigned long long*)(F.lds + PTR_OFF + 8 * i) = (unsigned long long)args.in[i];
    }
    __syncthreads();
    XcdBarrier bar = xcd_barrier_post((unsigned*)(F.ws + WS_CTL) + CW_BAR, MISC + 8, F.tid);

    const int lo = args.ph_lo, hi = args.ph_hi;
#ifdef PROBE_MASK
    bool rep_done = false;
#define PROBE_V ((((PROBE_MASK >> ph) & 1) && !rep_done) ? PROBE_VARIANT : 0)
#else
#define PROBE_V 0
#endif
    for (int ph = lo; ph < hi; ++ph) {
        { unsigned ones_ = ~0u; asm volatile("" : "+s"(ones_));
          int t_ = wave_s * 64 + (int)__builtin_amdgcn_mbcnt_hi(ones_, __builtin_amdgcn_mbcnt_lo(ones_, 0u)); asm volatile("" : "+v"(t_)); F.tid = t_; F.lane = t_ & 63; F.wave = __builtin_amdgcn_readfirstlane(t_ >> 6); F.gw = F.vcu * NWAVES + F.wave; }
        if (ph == 0) {
#ifndef NO_P0
            phase_p0a(F);
#endif
        } else if (ph == 1) {
#ifndef NO_P0
            phase_p0b(F);
#endif
        }
        else if (ph == N_PHASES - 1) final_rows(F);
        else {
            const int l = (ph - 2) / 7, k = (ph - 2) % 7; const bool last = (l == DEPTH - 1);
            const int Mx = last ? ML : MT;
            float* MOD = WSP(float, WS_MOD);
            if (k == 0) {
                if (l > 0) { ctx_finalize(F, l); xcd_barrier(bar, F.tid); }
                pg8::Gemm g{WSP(const bf16, WS_XA), WSP(const bf16, WS_WIN) + (size_t)l * IND * D, MT, IND, D};
                pg8::Order S; if (last) S.init(ML, IND, WGM_IN, (MC / 256) * 5, 1, F.G, (int)blockIdx.x); else S.init(MT, IND, WGM_IN, 0, 0, F.G, (int)blockIdx.x);
                pg8::EpiScale<0, IND> E{WSP(bf16, WS_PROJ), WSP(const float, WS_SHW1) + (size_t)l * 17 * IND, WSP(const float, WS_RSSA), PROBE_V};

#ifndef NO_G0
                pg8::gemm_phase<pg8::EpiScale<0, IND>, pg8::Order, true, true>(F.lds + RING_OFF, g, S, E, F.tid);
#endif

            } else if (k == 1) {

#ifndef NO_LRU
                lru_phase<0>(F, l, 1152);
#ifdef REP_LRU0
                __syncthreads(); lru_phase<0>(F, l, 1152);
#endif
#endif

                __syncthreads();
#ifndef NO_CONV
                conv_phase(F, l, last ? 1024 : 1152);
                __syncthreads();
#ifdef REP_CONV
                conv_phase(F, l, last ? 1024 : 1152);
                __syncthreads();
#endif
#endif
#ifndef NO_NA
#ifdef REP_NA
                na_phase(F, l, last ? NA_ITEMS_LAT : NA_ITEMS_LAT + NA_ITEMS_CTX, REP_NA);
#else
                na_phase(F, l, last ? NA_ITEMS_LAT : NA_ITEMS_LAT + NA_ITEMS_CTX);
#endif
#ifdef REP_NA
                __syncthreads(); na_phase(F, l, last ? NA_ITEMS_LAT : NA_ITEMS_LAT + NA_ITEMS_CTX, 0);
#endif
#endif
            } else if (k == 2) {
                lru_carry(F);
            } else if (k == 3) {

#ifndef NO_LRU
                lru_phase<1>(F, l, last ? 1024 : 1152);
#endif

            } else if (k == 4 || k == 6) {
                const bool dn = (k == 6);
                const int ln = (dn && !last) ? l + 1 : l;
                pg8::Gemm g{dn ? WSP(const bf16, WS_HID) : WSP(const bf16, WS_MIX), dn ? WSP(const bf16, WS_W2) + (size_t)l * D * FF : WSP(const bf16, WS_WOUT) + (size_t)l * D * D, Mx, D, dn ? FF : D};
                const bool splitk = dn && !last;
                pg8::Order S; S.init(splitk ? ML : Mx, D, dn ? WGM_DN : WGM_OUT, 0, 0, F.G, (int)blockIdx.x);
                const bool fromin = (!dn && l == 0);
                const float* go_g = dn ? INP(5) + l * D : INP(4) + l * D;
                const float* go_s = MOD + (size_t)l * 17 * MODW + (dn ? 4 : 1) * D;
                const bool fin = dn && last;
                pg8::EpiRes E{fromin ? INP(0) : (const float*)nullptr, fromin ? INP(2) : (const float*)nullptr, (float*)nullptr,
                              MOD + (size_t)l * 17 * MODW + (dn ? 5 : 2) * D, fin ? INP(24) : (dn ? INP(4) : INP(5)) + ln * D, fin ? WSP(const float, WS_ZERO) : MOD + (size_t)ln * 17 * MODW + (dn ? 1 : 4) * D,
                              go_g, go_s, WSP(bf16, WS_XA), dn ? WSP(float, WS_RSSA) : WSP(float, WS_RSSB), 1};
#ifndef NO_GR
                pg8::gemm_phase<pg8::EpiRes, pg8::Order, true, true>(F.lds + RING_OFF, g, S, E, F.tid);
                if (splitk) {
                    pg8::Order S2; S2.init(ML, 0, 4, (MC / 256) * 16, 2, F.G, (int)blockIdx.x);
                    pg8::EpiSlab E2{WSP(float, WS_PART), MOD + ((size_t)l * 17 + NB) * MODW + 5 * D};
                    pg8::gemm_phase<pg8::EpiSlab, pg8::Order, true, true, true>(F.lds + RING_OFF, g, S2, E2, F.tid);
                }
#endif
            } else if (k == 5) {
                pg8::Gemm g{WSP(const bf16, WS_XA), WSP(const bf16, WS_W1) + (size_t)l * FF * D, Mx, FF, D};
                pg8::Order S; S.init(Mx, FF, WGM_UP, 0, 0, F.G, (int)blockIdx.x);
                pg8::EpiScale<1, FF> E{WSP(bf16, WS_HID), WSP(const float, WS_SHW2) + (size_t)l * 17 * FF, WSP(const float, WS_RSSB), PROBE_V};

#ifndef NO_G1
                pg8::gemm_phase<pg8::EpiScale<1, FF>, pg8::Order, true, true>(F.lds + RING_OFF, g, S, E, F.tid);
#endif

            }
        }
#ifdef PROBE_MASK
        if (((PROBE_MASK >> ph) & 1) && !rep_done) { rep_done = true; xcd_barrier(bar, F.tid); --ph; continue; }
        rep_done = false;
#endif
        if (ph + 1 < hi) xcd_barrier(bar, F.tid);
#ifdef PROBE_BAR2
        if (ph + 1 < hi) xcd_barrier(bar, F.tid);
#endif
    }
}

extern "C" void kernel_launch(void* const* d_in, const int* in_sizes, int n_in, void* d_out, int out_size, void* d_ws, size_t ws_size, hipStream_t stream) {
    static int grid = 0;
    if (grid == 0) {
        if (n_in != 25 || out_size != ML * D || ws_size < WS_END) { fprintf(stderr, "kernel_launch: unexpected shapes (n_in %d out %d ws %zu)\n", n_in, out_size, ws_size); grid = -1; return; }
        int dev = 0, cus = 0;
        if (hipGetDevice(&dev) != hipSuccess || hipDeviceGetAttribute(&cus, hipDeviceAttributeMultiprocessorCount, dev) != hipSuccess) { grid = -1; return; }
        if (hipFuncSetAttribute((const void*)mega_fwd, hipFuncAttributeMaxDynamicSharedMemorySize, LDS_BYTES) != hipSuccess) { fprintf(stderr, "kernel_launch: hipFuncSetAttribute failed\n"); grid = -1; return; }
        int per_cu = 0;
        if (hipOccupancyMaxActiveBlocksPerMultiprocessor(&per_cu, (const void*)mega_fwd, NWAVES * 64, LDS_BYTES) != hipSuccess || per_cu < 1) fprintf(stderr, "kernel_launch: occupancy query reports %d\n", per_cu);
        (void)hipGetLastError();
        grid = cus;
    }
    if (grid < 0) return;
    if (hipMemsetAsync((char*)d_ws + WS_CTL, 0, CTL_ZERO_BYTES, stream) != hipSuccess) return;
    Args a{};
    for (int i = 0; i < 25; ++i) a.in[i] = (const float*)d_in[i];
    a.out = (float*)d_out; a.ws = (unsigned char*)d_ws;
#if MK_N_LAUNCHES == 1
    a.ph_lo = 0; a.ph_hi = N_PHASES;
    hipLaunchKernelGGL(mega_fwd, dim3(grid), dim3(NWAVES * 64), LDS_BYTES, stream, a);
#else
    for (int ph = 0; ph < N_PHASES; ++ph) { a.ph_lo = ph; a.ph_hi = ph + 1; hipLaunchKernelGGL(mega_fwd, dim3(grid), dim3(NWAVES * 64), LDS_BYTES, stream, a); }
#endif
}
```

```cpp
#include <hip/hip_runtime.h>
#include <cstdio>
#include <cstdint>

constexpr int D = 1024, NB = 16, SEQ = 2048, CTXL = 256, DEPTH = 2;
constexpr int ML = NB * SEQ, MC = NB * CTXL, MT = ML + MC;
constexpr int IND = 2560, FF = 4096, NH = 8, HD = 64;
constexpr int MODW = 6 * D;
constexpr float EPS = 1e-6f;
#ifndef MK_N_LAUNCHES
#define MK_N_LAUNCHES 1
#endif

namespace pg8 {
#define PG8_LAS __attribute__((address_space(3)))
typedef unsigned short bf16_t;
typedef short bf16x8 __attribute__((ext_vector_type(8)));
typedef float f32x4 __attribute__((ext_vector_type(4)));
typedef unsigned u32x4 __attribute__((ext_vector_type(4)));
constexpr int BM = 256, BK = 64, HALF = 128, HTB = HALF * BK * 2, STAGE_BYTES = 8 * HTB, NXCD = 8;

__host__ __device__ __forceinline__ int lds_byte(int r, int c) { const int st = (r >> 4) * 2 + (c >> 5), rr = r & 15, cc = c & 31, ob = rr * 64 + cc * 2; return st * 1024 + (ob ^ (((ob >> 9) & 1) << 5)); }
__host__ __device__ __forceinline__ void stage_rc(int b, int& R, int& C) { const int st = b / 1024, sb = b % 1024, swz = sb ^ (((sb >> 9) & 1) << 5); R = (st >> 1) * 16 + swz / 64; C = (st & 1) * 32 + (swz % 64) / 2; }
__host__ __device__ __forceinline__ int perm32(int rho) { const int n = rho >> 4, i = rho & 15; return 8 * (i >> 2) + 4 * n + (i & 3); }

struct Unit { int pm, pn; };
struct Gemm { const bf16_t* A; const bf16_t* Bt; int M, N, K; };

__host__ __device__ __forceinline__ void map_tile(int wgid, int nM, int nN, int WGM, Unit& u) {
    const int nwg = nM * nN;
    { const int q = nwg / NXCD, r = nwg % NXCD, xcd = wgid % NXCD, off = wgid / NXCD; wgid = (xcd < r ? xcd * (q + 1) : r * (q + 1) + (xcd - r) * q) + off; }
    const int nig = WGM * nN, gid = wgid / nig, fm = gid * WGM, gsz = (nM - fm) < WGM ? (nM - fm) : WGM;
    u.pm = fm + ((wgid % nig) % gsz); u.pn = (wgid % nig) / gsz;
}
struct Order {
    int nM, nN, nwg, extra, mode, wgm, G, c;
    __host__ __device__ void init(int M, int N, int wgm_, int extra_, int mode_, int G_, int c_) { nM = M / BM; nN = N / BM; nwg = nM * nN; extra = extra_; mode = mode_; wgm = wgm_; G = G_; c = c_; }
    __host__ __device__ bool next(int i, Unit& u) const {
        const long L = (long)i * G + c;
        if (L < nwg) { map_tile((int)L, nM, nN, wgm, u); return true; }
        if (L < nwg + extra) { const int q = (int)L - nwg;
            if (mode == 1) { u.pm = nM + q / 5; u.pn = 4 + q % 5; }
            else { u.pm = nM + (q >> 4); u.pn = 4 + 4 * (q & 3) + ((q >> 2) & 3); }
            return true; }
        return false;
    }
    __device__ __forceinline__ void a_ready(const Unit&) const {}
    __device__ __forceinline__ void done(const Unit&) const {}
};

__device__ __forceinline__ unsigned cvt_pk_bf16(float lo, float hi) { unsigned r; asm volatile("v_cvt_pk_bf16_f32 %0, %1, %2" : "=v"(r) : "v"(lo), "v"(hi)); return r; }

template <int ACT, int LDC> struct EpiScale {
    static constexpr bool PERM = true, AFTER_DRAIN = false;
    bf16_t* O; const float* shw; const float* RSS;
    int probe;
    __device__ __forceinline__ void operator()(const f32x4 (&acc)[2][2][4][2], const Unit& u, int wr, int wc, int fr, int fq) const {
        asm volatile("" : "+s"(wr), "+s"(wc));
        const int brow = u.pm < ML / BM ? (u.pm >> 3) : NB;
        const float* sp = shw + (size_t)brow * LDC + u.pn * BM;
        bf16_t* Ot = O + (size_t)u.pm * BM * LDC + u.pn * BM;
        const float* RSSt = RSS + (size_t)u.pm * BM * 32;
        unsigned cl = (unsigned)(wc * 32 + 8 * fq);
        unsigned rl0 = (unsigned)(wr * 64 + fr);
        asm volatile("" : "+v"(cl), "+v"(rl0));
        f32x4 pa[2][4], pb[2][4], sh[2][2];
#pragma unroll
        for (int ai = 0; ai < 2; ++ai)
#pragma unroll
            for (int m = 0; m < 4; ++m) { const unsigned ro = (rl0 + (unsigned)(ai * HALF + m * 16)) * 32u + 8u * (unsigned)fq;
                if (probe == 2) { pa[ai][m] = acc[ai][0][m][0]; pb[ai][m] = acc[ai][1][m][0]; } else { pa[ai][m] = *(const f32x4*)(RSSt + ro); pb[ai][m] = *(const f32x4*)(RSSt + (ro + 4u)); } }
#pragma unroll
        for (int bj = 0; bj < 2; ++bj) { if (probe == 2) { sh[bj][0] = acc[0][bj][0][1]; sh[bj][1] = acc[1][bj][0][1]; } else { sh[bj][0] = *(const f32x4*)(sp + (cl + (unsigned)(bj * HALF))); sh[bj][1] = *(const f32x4*)(sp + (cl + (unsigned)(bj * HALF + 4))); } }
        float rs[2][4];
#pragma unroll
        for (int ai = 0; ai < 2; ++ai)
#pragma unroll
            for (int m = 0; m < 4; ++m) { const f32x4 p0 = pa[ai][m], p1 = pb[ai][m];
                float s = ((p0[0] + p0[1]) + (p0[2] + p0[3])) + ((p1[0] + p1[1]) + (p1[2] + p1[3]));
                s += __shfl_xor(s, 16); s += __shfl_xor(s, 32);
                rs[ai][m] = rsqrtf(s * (1.0f / D) + EPS); }
#pragma unroll
        for (int bj = 0; bj < 2; ++bj)
#pragma unroll
            for (int ai = 0; ai < 2; ++ai)
#pragma unroll
                for (int m = 0; m < 4; ++m) {
                    f32x4 v0 = acc[ai][bj][m][0] * rs[ai][m] + sh[bj][0], v1 = acc[ai][bj][m][1] * rs[ai][m] + sh[bj][1];
                    if (ACT == 1) {
#pragma unroll
                        for (int e = 0; e < 4; ++e) { const float a = fmaxf(v0[e], 0.f), b = fmaxf(v1[e], 0.f); v0[e] = a * a; v1[e] = b * b; }
                    }
                    u32x4 w; w.x = cvt_pk_bf16(v0[0], v0[1]); w.y = cvt_pk_bf16(v0[2], v0[3]); w.z = cvt_pk_bf16(v1[0], v1[1]); w.w = cvt_pk_bf16(v1[2], v1[3]);
                    if (probe == 0) *(u32x4*)(Ot + ((rl0 + (unsigned)(ai * HALF + m * 16)) * (unsigned)LDC + cl + (unsigned)(bj * HALF))) = w;
                    else asm volatile("" :: "v"(w));
                }
    }
};
struct EpiRes {
    static constexpr bool PERM = true, AFTER_DRAIN = false;
    const float* src_lat; const float* src_ctx;
    float* dst_lat;
    const float* gate;
    const float* gmg; const float* gmsc;
    const float* gmg_o; const float* gmsc_o;
    bf16_t* XA; float* RSS; int hasxa;
    template <int BJ, int AI0, int NAI, int M0, int NM>
    __device__ __forceinline__ void batch(const f32x4 (&acc)[2][2][4][2], const float* src, float* dst, const float* gt, const float* gg, const float* gs, const float* go, const float* gso, bf16_t* XAt, float* RSSt, unsigned cl, unsigned rl0, int fq) const {
        const unsigned c = cl + (unsigned)(BJ * HALF);
        f32x4 x0[NAI][NM], x1[NAI][NM];
        const bool srcf = src != nullptr;
        if (srcf) {
#pragma unroll
            for (int a = 0; a < NAI; ++a)
#pragma unroll
                for (int m = 0; m < NM; ++m) { const unsigned off = (rl0 + (unsigned)((AI0 + a) * HALF + (M0 + m) * 16)) * (unsigned)D + c; x0[a][m] = *(const f32x4*)(src + off); x1[a][m] = *(const f32x4*)(src + (off + 4u)); }
        } else {
            u32x4 xb[NAI][NM];
#pragma unroll
            for (int a = 0; a < NAI; ++a)
#pragma unroll
                for (int m = 0; m < NM; ++m) { const unsigned off = (rl0 + (unsigned)((AI0 + a) * HALF + (M0 + m) * 16)) * (unsigned)D + c; xb[a][m] = *(const u32x4*)(XAt + off); }
            const f32x4 i0 = *(const f32x4*)(go + c) * (*(const f32x4*)(gso + c) + 1.0f), i1 = *(const f32x4*)(go + (c + 4u)) * (*(const f32x4*)(gso + (c + 4u)) + 1.0f);
            f32x4 r0, r1;
#pragma unroll
            for (int e = 0; e < 4; ++e) { r0[e] = __builtin_amdgcn_rcpf(i0[e]); r1[e] = __builtin_amdgcn_rcpf(i1[e]); }
#pragma unroll
            for (int a = 0; a < NAI; ++a)
#pragma unroll
                for (int m = 0; m < NM; ++m) { const u32x4 w = xb[a][m];
                    x0[a][m] = (f32x4){__uint_as_float(w.x << 16), __uint_as_float(w.x & 0xffff0000u), __uint_as_float(w.y << 16), __uint_as_float(w.y & 0xffff0000u)} * r0;
                    x1[a][m] = (f32x4){__uint_as_float(w.z << 16), __uint_as_float(w.z & 0xffff0000u), __uint_as_float(w.w << 16), __uint_as_float(w.w & 0xffff0000u)} * r1; }
        }
        const f32x4 g0 = *(const f32x4*)(gt + c), g1 = *(const f32x4*)(gt + (c + 4u));
        f32x4 m0 = {0.f, 0.f, 0.f, 0.f}, m1 = {0.f, 0.f, 0.f, 0.f};
        if (hasxa) { m0 = *(const f32x4*)(gg + c) * (*(const f32x4*)(gs + c) + 1.0f); m1 = *(const f32x4*)(gg + (c + 4u)) * (*(const f32x4*)(gs + (c + 4u)) + 1.0f); }
        asm volatile("" ::: "memory");
#pragma unroll
        for (int a = 0; a < NAI; ++a)
#pragma unroll
            for (int m = 0; m < NM; ++m) {
                const unsigned rl = rl0 + (unsigned)((AI0 + a) * HALF + (M0 + m) * 16);
                const unsigned off = rl * (unsigned)D + c;
                const f32x4 y0 = x0[a][m] + g0 * acc[AI0 + a][BJ][M0 + m][0], y1 = x1[a][m] + g1 * acc[AI0 + a][BJ][M0 + m][1];
                if (dst) { *(f32x4*)(dst + off) = y0; *(f32x4*)(dst + (off + 4u)) = y1; }
                float ss = ((y0[0] * y0[0] + y0[1] * y0[1]) + (y0[2] * y0[2] + y0[3] * y0[3])) + ((y1[0] * y1[0] + y1[1] * y1[1]) + (y1[2] * y1[2] + y1[3] * y1[3]));
                ss += __shfl_xor(ss, 16); ss += __shfl_xor(ss, 32);
                if (fq == 0) RSSt[rl * 32u + (unsigned)(BJ * 4)] = ss;
                if (hasxa) { const f32x4 a0 = y0 * m0, a1 = y1 * m1;
                    u32x4 w; w.x = cvt_pk_bf16(a0[0], a0[1]); w.y = cvt_pk_bf16(a0[2], a0[3]); w.z = cvt_pk_bf16(a1[0], a1[1]); w.w = cvt_pk_bf16(a1[2], a1[3]);
                    *(u32x4*)(XAt + off) = w; }
            }
        asm volatile("" ::: "memory");
    }
    __device__ __forceinline__ void operator()(const f32x4 (&acc)[2][2][4][2], const Unit& u, int wr, int wc, int fr, int fq) const {
        asm volatile("" : "+s"(wr), "+s"(wc));
        const bool lat = u.pm < ML / BM;
        const int brow = lat ? (u.pm >> 3) : NB;
        const float* src = src_lat ? (lat ? src_lat + (size_t)u.pm * BM * D : src_ctx + (size_t)(u.pm - ML / BM) * BM * D) + u.pn * BM : nullptr;
        float* dst = (dst_lat && lat) ? dst_lat + (size_t)u.pm * BM * D + u.pn * BM : nullptr;
        const float* gt = gate + (size_t)brow * MODW + u.pn * BM;
        const float* gg = gmg + u.pn * BM;
        const float* gs = gmsc + (size_t)brow * MODW + u.pn * BM;
        const float* go = gmg_o + u.pn * BM;
        const float* gso = gmsc_o + (size_t)brow * MODW + u.pn * BM;
        bf16_t* XAt = XA + (size_t)u.pm * BM * D + u.pn * BM;
        float* RSSt = RSS + (size_t)u.pm * BM * 32 + u.pn * 8 + wc;
        unsigned cl = (unsigned)(wc * 32 + 8 * fq);
        unsigned rl0 = (unsigned)(wr * 64 + fr);
        asm volatile("" : "+v"(cl), "+v"(rl0));
        batch<0, 0, 1, 0, 2>(acc, src, dst, gt, gg, gs, go, gso, XAt, RSSt, cl, rl0, fq);
        batch<0, 0, 1, 2, 2>(acc, src, dst, gt, gg, gs, go, gso, XAt, RSSt, cl, rl0, fq);
        batch<0, 1, 1, 0, 4>(acc, src, dst, gt, gg, gs, go, gso, XAt, RSSt, cl, rl0, fq);
        batch<1, 0, 2, 0, 4>(acc, src, dst, gt, gg, gs, go, gso, XAt, RSSt, cl, rl0, fq);
    }
};

struct EpiSlab {
    static constexpr bool PERM = true, AFTER_DRAIN = false;
    float* P; const float* gate;
    __device__ __forceinline__ void operator()(const f32x4 (&acc)[2][2][4][2], const Unit& u, int wr, int wc, int fr, int fq) const {
        asm volatile("" : "+s"(wr), "+s"(wc));
        const int ks = (u.pn - 4) >> 2, pn = u.pn & 3;
        float* At = P + ((size_t)ks * MC + (size_t)(u.pm - ML / BM) * BM) * D + pn * BM;
        const float* gtq = gate + pn * BM;
        unsigned cl = (unsigned)(wc * 32 + 8 * fq), rl0 = (unsigned)(wr * 64 + fr);
        asm volatile("" : "+v"(cl), "+v"(rl0));
#pragma unroll
        for (int bj = 0; bj < 2; ++bj) { const unsigned c = cl + (unsigned)(bj * HALF);
            const f32x4 g0 = *(const f32x4*)(gtq + c), g1 = *(const f32x4*)(gtq + (c + 4u));
#pragma unroll
            for (int ai = 0; ai < 2; ++ai)
#pragma unroll
                for (int m = 0; m < 4; ++m) { const unsigned off = (rl0 + (unsigned)(ai * HALF + m * 16)) * (unsigned)D + c;
                    *(f32x4*)(At + off) = g0 * acc[ai][bj][m][0]; *(f32x4*)(At + (off + 4u)) = g1 * acc[ai][bj][m][1]; } }
    }
};

template <class Epi, class Sched, bool ALIGN_EPI = false, bool SP2 = false, bool VARK = false>
__device__ __forceinline__ void gemm_phase(PG8_LAS unsigned char* lds, const Gemm g, const Sched& S, const Epi& E, const int tid) {
    const int wid = __builtin_amdgcn_readfirstlane(tid >> 6), lane = tid & 63, wr = wid >> 2, wc = wid & 3, fr = lane & 15, fq = lane >> 4;
    const int K = g.K;
    unsigned voffA[2], voffB[2];
#pragma unroll
    for (int i = 0; i < 2; ++i) { int R, C; stage_rc(tid * 16 + i * 8192, R, C); const int Rb = Epi::PERM ? ((R & ~31) + perm32(R & 31)) : R;
        voffA[i] = (unsigned)(R * K + C) * 2u; voffB[i] = (unsigned)(Rb * K + C) * 2u; }
    const size_t kstep = (size_t)(BK * 2);
    const size_t hstep = (size_t)HALF * K * 2;
    const size_t tstep = 2 * hstep;
    const unsigned ldsw = (unsigned)wid * 1024u;
    const int aoff = lds_byte(wr * 64 + fr, fq * 8), boff = lds_byte(wc * 32 + fr, fq * 8);
#define PG8_SA(b, h) (((b) * 2 + (h)) * HTB)
#define PG8_SB(b, h) ((4 + (b) * 2 + (h)) * HTB)
#define PG8_STAGE(bufoff, gbase, voff) do { _Pragma("unroll") for (int _i = 0; _i < 2; ++_i) \
        __builtin_amdgcn_global_load_lds((const unsigned*)((const char*)(gbase) + (voff)[_i]), (PG8_LAS unsigned*)(lds + (bufoff) + ldsw + _i * 8192), 16, 0, 0); } while (0)
#define PG8_LDA(dst, b, h) do { _Pragma("unroll") for (int m = 0; m < 4; ++m) _Pragma("unroll") for (int k = 0; k < 2; ++k) dst[m][k] = *(const PG8_LAS bf16x8*)(lds + PG8_SA(b, h) + aoff + m * 2048 + k * 1024); } while (0)
#define PG8_LDB(dst, b, h) do { _Pragma("unroll") for (int n = 0; n < 2; ++n) _Pragma("unroll") for (int k = 0; k < 2; ++k) dst[n][k] = *(const PG8_LAS bf16x8*)(lds + PG8_SB(b, h) + boff + n * 2048 + k * 1024); } while (0)
#define PG8_MMA(ai, bj, At, Bt) do { __builtin_amdgcn_s_setprio(1); _Pragma("unroll") for (int m = 0; m < 4; ++m) _Pragma("unroll") for (int n = 0; n < 2; ++n) _Pragma("unroll") for (int k = 0; k < 2; ++k) \
        acc[ai][bj][m][n] = __builtin_amdgcn_mfma_f32_16x16x32_bf16(Bt[n][k], At[m][k], acc[ai][bj][m][n], 0, 0, 0); __builtin_amdgcn_s_setprio(0); } while (0)
#define PG8_WAIT_V(n) asm volatile("s_waitcnt vmcnt(" #n ")" ::: "memory")
#define PG8_WAIT_L(n) asm volatile("s_waitcnt lgkmcnt(" #n ")" ::: "memory")
#define PG8_BAR __builtin_amdgcn_s_barrier()
#define PG8_SCHED __builtin_amdgcn_sched_barrier(0)
    Unit cur, nxt; int ui = 0;
    if (!S.next(0, cur)) return;
    cur.pm = __builtin_amdgcn_readfirstlane(cur.pm); cur.pn = __builtin_amdgcn_readfirstlane(cur.pn);
    f32x4 acc[2][2][4][2];
#pragma unroll
    for (int a = 0; a < 2; ++a)
#pragma unroll
        for (int b = 0; b < 2; ++b)
#pragma unroll
            for (int m = 0; m < 4; ++m)
#pragma unroll
                for (int n = 0; n < 2; ++n) acc[a][b][m][n] = (f32x4){0.f, 0.f, 0.f, 0.f};
    bf16x8 At[4][2], B0[2][2], B1[2][2];
#define PG8_KOFF(u) ((VARK && (u).pn >= 4) ? (size_t)(((u).pn - 4) >> 2) * (size_t)(K / 4) * 2 : (size_t)0)
#define PG8_PN(u) ((VARK && (u).pn >= 4) ? ((u).pn & 3) : (u).pn)
    const char* cA = (const char*)g.A + (size_t)cur.pm * tstep + PG8_KOFF(cur); const char* cB = (const char*)g.Bt + (size_t)PG8_PN(cur) * tstep + PG8_KOFF(cur);
    S.a_ready(cur);
    if constexpr (SP2) {
        PG8_STAGE(PG8_SB(0, 0), cB, voffB); PG8_STAGE(PG8_SB(0, 1), cB + hstep, voffB); PG8_STAGE(PG8_SA(0, 0), cA, voffA); PG8_STAGE(PG8_SA(0, 1), cA + hstep, voffA);
        if (wr == 1) PG8_BAR;
        PG8_WAIT_V(2); PG8_BAR;
        PG8_STAGE(PG8_SB(1, 0), cB + kstep, voffB); PG8_STAGE(PG8_SA(1, 0), cA + kstep, voffA); PG8_STAGE(PG8_SB(1, 1), cB + hstep + kstep, voffB);
        PG8_WAIT_V(6); PG8_BAR;
    } else {
        PG8_STAGE(PG8_SB(0, 0), cB, voffB); PG8_STAGE(PG8_SA(0, 0), cA, voffA); PG8_STAGE(PG8_SB(0, 1), cB + hstep, voffB); PG8_STAGE(PG8_SA(0, 1), cA + hstep, voffA);
        if (wr == 1) PG8_BAR;
        PG8_WAIT_V(4); PG8_BAR;
        PG8_STAGE(PG8_SB(1, 0), cB + kstep, voffB); PG8_STAGE(PG8_SA(1, 0), cA + kstep, voffA); PG8_STAGE(PG8_SB(1, 1), cB + hstep + kstep, voffB);
        PG8_WAIT_V(6); PG8_BAR;
    }
    for (;;) {
        const bool has_next = S.next(ui + 1, nxt);
        nxt.pm = __builtin_amdgcn_readfirstlane(nxt.pm); nxt.pn = __builtin_amdgcn_readfirstlane(nxt.pn);
        const char* nA = has_next ? (const char*)g.A + (size_t)nxt.pm * tstep + PG8_KOFF(nxt) : cA; const char* nB = has_next ? (const char*)g.Bt + (size_t)PG8_PN(nxt) * tstep + PG8_KOFF(nxt) : cB;
        const int nt = (VARK && cur.pn >= 4) ? K / BK / 4 : K / BK;
        for (int t = 0; t < nt; t += 2) {
            const bool last = (t == nt - 2);
            const char* a1 = cA + (size_t)(t + 1) * kstep;
            const char* a2 = last ? nA : cA + (size_t)(t + 2) * kstep; const char* b2 = last ? nB : cB + (size_t)(t + 2) * kstep;
            const char* a3 = a2 + kstep; const char* b3 = b2 + kstep;
            if (last && has_next) S.a_ready(nxt);
            if constexpr (SP2) {
            PG8_LDB(B0, 0, 0); PG8_LDB(B1, 0, 1); PG8_SCHED; PG8_LDA(At, 0, 0); PG8_STAGE(PG8_SA(1, 1), a1 + hstep, voffA);
            PG8_WAIT_V(8); PG8_WAIT_L(0); PG8_BAR; PG8_MMA(0, 0, At, B0); PG8_MMA(0, 1, At, B1); PG8_BAR; PG8_SCHED;
            PG8_LDA(At, 0, 1); PG8_STAGE(PG8_SB(0, 0), b2, voffB); PG8_STAGE(PG8_SB(0, 1), b2 + hstep, voffB); PG8_STAGE(PG8_SA(0, 0), a2, voffA);
            PG8_WAIT_V(8); PG8_WAIT_L(0); PG8_BAR; PG8_MMA(1, 0, At, B0); PG8_MMA(1, 1, At, B1); PG8_BAR; PG8_SCHED;
            PG8_LDB(B0, 1, 0); PG8_LDB(B1, 1, 1); PG8_SCHED; PG8_LDA(At, 1, 0); PG8_STAGE(PG8_SA(0, 1), a2 + hstep, voffA);
            PG8_WAIT_V(8); PG8_WAIT_L(0); PG8_BAR; PG8_MMA(0, 0, At, B0); PG8_MMA(0, 1, At, B1); PG8_BAR; PG8_SCHED;
            PG8_LDA(At, 1, 1); PG8_STAGE(PG8_SB(1, 0), b3, voffB); PG8_STAGE(PG8_SB(1, 1), b3 + hstep, voffB); PG8_STAGE(PG8_SA(1, 0), a3, voffA);
            PG8_WAIT_V(8); PG8_WAIT_L(0); PG8_BAR; PG8_MMA(1, 0, At, B0); PG8_MMA(1, 1, At, B1); PG8_BAR; PG8_SCHED;
            } else {
            PG8_LDB(B0, 0, 0); PG8_SCHED; PG8_LDA(At, 0, 0); PG8_STAGE(PG8_SA(1, 1), a1 + hstep, voffA);
            PG8_WAIT_L(8); PG8_BAR; PG8_WAIT_L(0); PG8_MMA(0, 0, At, B0); PG8_BAR; PG8_SCHED;
            PG8_LDB(B1, 0, 1); PG8_STAGE(PG8_SB(0, 0), b2, voffB);
            PG8_BAR; PG8_WAIT_L(0); PG8_MMA(0, 1, At, B1); PG8_BAR;
            PG8_LDA(At, 0, 1); PG8_STAGE(PG8_SA(0, 0), a2, voffA);
            PG8_BAR; PG8_WAIT_L(0); PG8_MMA(1, 0, At, B0); PG8_BAR; PG8_SCHED;
            PG8_STAGE(PG8_SB(0, 1), b2 + hstep, voffB);
            PG8_WAIT_V(6); PG8_BAR; PG8_MMA(1, 1, At, B1); PG8_BAR;
            PG8_LDB(B0, 1, 0); PG8_SCHED; PG8_LDA(At, 1, 0); PG8_STAGE(PG8_SA(0, 1), a2 + hstep, voffA);
            PG8_WAIT_L(8); PG8_BAR; PG8_WAIT_L(0); PG8_MMA(0, 0, At, B0); PG8_BAR; PG8_SCHED;
            PG8_LDB(B1, 1, 1); PG8_STAGE(PG8_SB(1, 0), b3, voffB);
            PG8_BAR; PG8_WAIT_L(0); PG8_MMA(0, 1, At, B1); PG8_BAR;
            PG8_LDA(At, 1, 1); PG8_STAGE(PG8_SA(1, 0), a3, voffA);
            PG8_BAR; PG8_WAIT_L(0); PG8_MMA(1, 0, At, B0); PG8_BAR; PG8_SCHED;
            PG8_STAGE(PG8_SB(1, 1), b3 + hstep, voffB);
            PG8_WAIT_V(6); PG8_BAR; PG8_MMA(1, 1, At, B1); PG8_BAR;
            }
        }
        if constexpr (ALIGN_EPI) { if (wr == 0) PG8_BAR; }
        if constexpr (!Epi::AFTER_DRAIN) { E(acc, cur, wr, wc, fr, fq); S.done(cur); }
        if (!has_next) break;
#pragma unroll
        for (int a = 0; a < 2; ++a)
#pragma unroll
            for (int b = 0; b < 2; ++b)
#pragma unroll
                for (int m = 0; m < 4; ++m)
#pragma unroll
                    for (int n = 0; n < 2; ++n) acc[a][b][m][n] = (f32x4){0.f, 0.f, 0.f, 0.f};
        cur = nxt; cA = nA; cB = nB; ++ui;
        if constexpr (ALIGN_EPI) { if (wr == 1) PG8_BAR; }
    }
    PG8_WAIT_V(0);
    if constexpr (!ALIGN_EPI) { if (wr == 0) PG8_BAR; }
    PG8_BAR;
    if constexpr (Epi::AFTER_DRAIN) { E.fused(acc, cur, wr, wc, fr, fq, lds, wid, lane); S.done(cur); }
#undef PG8_KOFF
#undef PG8_PN
#undef PG8_SA
#undef PG8_SB
#undef PG8_STAGE
#undef PG8_LDA
#undef PG8_LDB
#undef PG8_MMA
#undef PG8_WAIT_V
#undef PG8_WAIT_L
#undef PG8_BAR
#undef PG8_SCHED
}
}

constexpr size_t MiB = 1u << 20;
constexpr size_t WS_CTL = 0, CTL_ZERO_BYTES = 1 * MiB;
constexpr size_t WS_MOD = 1 * MiB;
constexpr size_t WS_SHW1 = 2 * MiB;
constexpr size_t WS_SHW2 = 3 * MiB;
constexpr size_t WS_RSSA = 4 * MiB;
constexpr size_t WS_RSSB = 9 * MiB;
constexpr size_t WS_TOT = 14 * MiB;
constexpr size_t WS_CARRY = 19 * MiB;
constexpr size_t WS_WLR = 21 * MiB + 512 * 1024;
constexpr size_t WS_WIN = 22 * MiB;
constexpr size_t WS_WOUT = 32 * MiB;
constexpr size_t WS_W1 = 36 * MiB;
constexpr size_t WS_W2 = 52 * MiB;
constexpr size_t WS_CX = 68 * MiB;
constexpr size_t WS_XA = 84 * MiB;
constexpr size_t WS_HID = 156 * MiB;
constexpr size_t WS_PROJ = WS_HID;
constexpr size_t WS_MIX = WS_HID + 180 * MiB;
constexpr size_t WS_PART = 444 * MiB;
constexpr size_t WS_AB = 436 * MiB;
constexpr size_t WS_END = 508 * MiB;
static_assert(WS_MIX + (size_t)MT * D * 2 <= WS_PART && WS_HID + (size_t)MT * FF * 2 == WS_PART && WS_PART + (size_t)4 * MC * D * 4 == WS_END && WS_AB >= WS_MIX + (size_t)MT * D * 2 && WS_AB + (size_t)1152 * 2 * 2 * 8 * 2 * 64 * 16 == WS_END, "ws map");
constexpr size_t WS_ZERO = WS_CTL + 512 * 1024;
constexpr int CW_BAR = 4096;

#ifndef WGM_IN
#define WGM_IN 4
#endif
#ifndef WGM_OUT
#define WGM_OUT 4
#endif
#ifndef WGM_UP
#define WGM_UP 4
#endif
#ifndef WGM_DN
#define WGM_DN 4
#endif
constexpr int NWAVES = 8;
constexpr int RING_OFF = 0, RING_BYTES = 131072;
constexpr int LDSCTL_OFF = RING_BYTES, MISC_OFF = LDSCTL_OFF + 320;
constexpr int LDS_BYTES = 147456;

#define GAS __attribute__((address_space(1)))
#define LAS __attribute__((address_space(3)))
typedef unsigned short bf16;
typedef unsigned v4u __attribute__((ext_vector_type(4)));
typedef unsigned v2u __attribute__((ext_vector_type(2)));
typedef float f32x4 __attribute__((ext_vector_type(4)));
typedef float f32x2 __attribute__((ext_vector_type(2)));
typedef GAS unsigned gu32;
#define LDS_WAIT() asm volatile("s_waitcnt lgkmcnt(0)" ::: "memory")
#define VM_WAIT() asm volatile("s_waitcnt vmcnt(0)" ::: "memory")
__device__ __forceinline__ unsigned f2bf(float f) { unsigned u = __builtin_bit_cast(unsigned, f); return (u + 0x7fffu + ((u >> 16) & 1u)) >> 16; }
__device__ __forceinline__ unsigned pk2(float lo, float hi) { return f2bf(lo) | (f2bf(hi) << 16); }
__device__ __forceinline__ float bflo(unsigned w) { return __uint_as_float(w << 16); }
__device__ __forceinline__ float bfhi(unsigned w) { return __uint_as_float(w & 0xffff0000u); }
__device__ __forceinline__ float bf1(bf16 v) { return __uint_as_float((unsigned)v << 16); }
__device__ __forceinline__ float sigmoidf_(float x) { return __builtin_amdgcn_rcpf(1.f + __builtin_amdgcn_exp2f(-1.4426950408889634f * x)); }
__device__ __forceinline__ float siluf_(float x) { return x * sigmoidf_(x); }
__device__ __forceinline__ float gelu_tanh(float x) { const float u = 0.7978845608028654f * (x + 0.044715f * x * x * x); return x * sigmoidf_(2.f * u); }
__device__ __forceinline__ float wave_sum(float v) {
#pragma unroll
    for (int o = 1; o < 64; o <<= 1) v += __shfl_xor(v, o);
    return v;
}

#define XB_TMO      128
#define XB_XCNT(j)  (256  + 64 * (j))
#define XB_XSUB(j)  (1280 + 64 * (j))
#define XB_XGEN(j)  (2304 + 64 * (j))
#define XB_TOP      3328
#define XB_TOPGEN   3392
#define XCD_BAR_WORDS 3456
#define XB_SPIN_CAP (1u << 18)

__device__ __forceinline__ unsigned xb_ld(unsigned* p)              { return __hip_atomic_load(p, __ATOMIC_RELAXED, __HIP_MEMORY_SCOPE_AGENT); }
__device__ __forceinline__ unsigned xb_add(unsigned* p, unsigned v) { return __hip_atomic_fetch_add(p, v, __ATOMIC_RELAXED, __HIP_MEMORY_SCOPE_AGENT); }
__device__ __forceinline__ unsigned xb_xcc_id() { return (unsigned)__builtin_amdgcn_s_getreg((3 << 11) | 20) & 0xFu; }
#define XB_SPIN(cond, bar) do { unsigned _sp = 0; while (cond) { __builtin_amdgcn_s_sleep(1); \
    if ((++_sp & 255u) == 0u) { if (xb_ld(&(bar)[XB_TMO])) break; if (_sp > XB_SPIN_CAP) { atomicAdd(&(bar)[XB_TMO], 1u); break; } } } } while (0)

struct XcdBarrier {
    unsigned* bar; unsigned x;
    volatile LAS unsigned* st;
};

__device__ __forceinline__ XcdBarrier xcd_barrier_post(unsigned* bar, volatile LAS unsigned* st, int tid) {
    XcdBarrier b; b.bar = bar; b.x = xb_xcc_id(); b.st = st;
    if (tid == 0) (void)xb_add(&bar[XB_XCNT(b.x)], 1u);
    return b;
}
__device__ __forceinline__ void xcd_barrier_complete(unsigned* bar, unsigned x, unsigned& nloc, unsigned& nx) {
    const unsigned G = gridDim.x * gridDim.y * gridDim.z;
    unsigned sum, cnt, mine, sp = 0u;
    for (;;) {
        sum = 0u; cnt = 0u; mine = 0u;
#pragma unroll 1
        for (unsigned j = 0; j < 16; ++j) { const unsigned c = xb_ld(&bar[XB_XCNT(j)]); sum += c; cnt += (c > 0u) ? 1u : 0u; mine = (j == x) ? c : mine; }
        if (sum == G) break;
        __builtin_amdgcn_s_sleep(1);
        if ((++sp & 255u) == 0u) { if (xb_ld(&bar[XB_TMO])) break; if (sp > XB_SPIN_CAP) { atomicAdd(&bar[XB_TMO], 1u); break; } }
    }
    nloc = mine > 0u ? mine : 1u; nx = cnt > 0u ? cnt : 1u;
}

__device__ __forceinline__ void xcd_barrier(const XcdBarrier& b, int tid) {
    asm volatile("s_waitcnt vmcnt(0)" ::: "memory");
    __syncthreads();
    if (tid == 0) {
        unsigned* bar = b.bar;
        __builtin_amdgcn_s_waitcnt(0);
        unsigned nloc = b.st[0], nx = b.st[1];
        if (nloc == 0u) { xcd_barrier_complete(bar, b.x, nloc, nx); b.st[0] = nloc; b.st[1] = nx; }
        const unsigned old = xb_add(&bar[XB_XSUB(b.x)], 1u);
        const unsigned gen = old / nloc;
        if (old + 1u == (gen + 1u) * nloc) {
            __builtin_amdgcn_fence(__ATOMIC_RELEASE, "agent");
            asm volatile("s_waitcnt vmcnt(0)" ::: "memory");
            const unsigned og = xb_add(&bar[XB_TOP], 1u);
            const unsigned tg = og / nx;
            if (og + 1u == (tg + 1u) * nx) xb_add(&bar[XB_TOPGEN], 1u);
            else XB_SPIN(xb_ld(&bar[XB_TOPGEN]) == tg, bar);
            __builtin_amdgcn_fence(__ATOMIC_ACQUIRE, "agent");
            xb_add(&bar[XB_XGEN(b.x)], 1u);
            asm volatile("s_waitcnt vmcnt(0)" ::: "memory");
        } else {
            XB_SPIN(xb_ld(&bar[XB_XGEN(b.x)]) == gen, bar);
            __builtin_amdgcn_fence(__ATOMIC_ACQUIRE, "agent");
            asm volatile("s_waitcnt vmcnt(0)" ::: "memory");
        }
    }
    __syncthreads();
}

struct Frame {
    LAS unsigned char* lds;
    int tid, lane, wave;
    int vcu, G;
    int gw, NGW;
    float* out; unsigned char* ws;
};
constexpr int PTR_OFF = LDSCTL_OFF + 512;
__device__ __forceinline__ const float* inp_(LAS unsigned char* lds, int i) {
    const unsigned long long v = *(const LAS unsigned long long*)(lds + PTR_OFF + 8 * i);
    const unsigned lo = __builtin_amdgcn_readfirstlane((unsigned)v), hi = __builtin_amdgcn_readfirstlane((unsigned)(v >> 32));
    return (const float*)(((unsigned long long)hi << 32) | lo);
}
#define INP(i) inp_(F.lds, (i))
#define WSP(T, off) ((T*)(F.ws + (off)))

__device__ __forceinline__ void gemv17_item(Frame& F, const LAS float* tab, LAS float* red, const float* W, int ldw, int n0, const float* bias, float* outp, int ldo) {
    float acc[17];
#pragma unroll
    for (int r = 0; r < 17; ++r) acc[r] = 0.f;
    const int k0 = F.wave * 128;
    const float* wp = W + (size_t)k0 * ldw + n0 + F.lane;
#pragma unroll 1
    for (int kk = 0; kk < 128; kk += 32) {
        float wv[32];
#pragma unroll
        for (int k = 0; k < 32; ++k) wv[k] = wp[(size_t)(kk + k) * ldw];
#pragma unroll
        for (int k = 0; k < 32; ++k) {
#pragma unroll
            for (int r = 0; r < 17; ++r) acc[r] += tab[r * 1024 + k0 + kk + k] * wv[k];
        }
    }
#pragma unroll
    for (int r = 0; r < 17; ++r) red[(F.wave * 17 + r) * 64 + F.lane] = acc[r];
    __syncthreads();
    for (int i = F.tid; i < 17 * 64; i += NWAVES * 64) {
        const int r = i >> 6, n = i & 63; float s = bias ? bias[n0 + n] : 0.f;
#pragma unroll
        for (int w = 0; w < 8; ++w) s += red[(w * 17 + r) * 64 + n];
        outp[(size_t)r * ldo + n0 + n] = s;
    }
    __syncthreads();
}

__device__ __forceinline__ void p0_transpose_item(const float* W, int K, int N, bf16* WT, LAS float* scr, int item, int lane) {
    const int nblk = N / 32, kb = item / nblk, nb = item % nblk, k0 = 64 * kb, n0 = 32 * nb;
    float tv[32];
#pragma unroll
    for (int i = 0; i < 32; ++i) { const int kk = 2 * i + (lane >> 5); tv[i] = W[(size_t)(k0 + kk) * N + n0 + (lane & 31)]; }
#pragma unroll
    for (int i = 0; i < 32; ++i) { const int kk = 2 * i + (lane >> 5); scr[kk * 33 + (lane & 31)] = tv[i]; }
    LDS_WAIT(); asm volatile("" ::: "memory");
    const int c = lane & 7;
#pragma unroll
    for (int j = 0; j < 4; ++j) { const int n = (lane >> 3) + 8 * j; const LAS float* s = scr + (8 * c) * 33 + n;
        v4u o; o.x = pk2(s[0 * 33], s[1 * 33]); o.y = pk2(s[2 * 33], s[3 * 33]); o.z = pk2(s[4 * 33], s[5 * 33]); o.w = pk2(s[6 * 33], s[7 * 33]);
        *(GAS v4u*)(WT + (size_t)(n0 + n) * K + k0 + 8 * c) = o; }
    LDS_WAIT(); asm volatile("" ::: "memory");
}

__device__ __forceinline__ void phase_p0a(Frame& F) {
    LAS float* tab = (LAS float*)(F.lds);
    LAS float* red = (LAS float*)(F.lds + 17 * 1024 * 4);
    float* MOD = WSP(float, WS_MOD);
    bool filled = false;
    for (int it = F.vcu; it < 2 * 96; it += F.G) {
        if (!filled) {
            for (int i = F.tid; i < 17 * 1024; i += NWAVES * 64) { const int r = i >> 10, k = i & 1023; const float v = (r < 16) ? INP(1)[r * D + k] : INP(3)[k]; tab[i] = siluf_(v); }
            __syncthreads(); filled = true;
        }
        const int l = it / 96, n0 = (it % 96) * 64;
        gemv17_item(F, tab, red, INP(6) + (size_t)l * D * MODW, MODW, n0, INP(7) + (size_t)l * MODW, MOD + (size_t)l * 17 * MODW, MODW);
    }
}

__device__ __forceinline__ void phase_p0b(Frame& F) {
    LAS float* tab = (LAS float*)(F.lds);
    LAS float* red = (LAS float*)(F.lds + 17 * 1024 * 4);
    const float* MOD = WSP(const float, WS_MOD);
    for (int it = F.vcu; it < 2 * 104; it += F.G) {
        const int l = it / 104, j = it % 104; const bool first = j < 40;
        const int shoff = first ? 0 : 3 * D;
        __syncthreads();
        for (int i = F.tid; i < 17 * 1024; i += NWAVES * 64) { const int r = i >> 10, k = i & 1023; tab[i] = MOD[((size_t)l * 17 + r) * MODW + shoff + k]; }
        __syncthreads();
        const int ldw = first ? IND : FF;
        gemv17_item(F, tab, red, first ? INP(8) + (size_t)l * D * IND : INP(22) + (size_t)l * D * FF, ldw, (first ? j : j - 40) * 64, nullptr,
                    first ? WSP(float, WS_SHW1) + (size_t)l * 17 * IND : WSP(float, WS_SHW2) + (size_t)l * 17 * FF, ldw);
    }
    bf16* XA = WSP(bf16, WS_XA); float* RSSA = WSP(float, WS_RSSA);
    const float* g1 = INP(4);
    for (int row = F.gw; row < MT; row += 2 * F.NGW) {
        f32x4 v[2][4]; float ss[2]; int rw[2]; const float* scp[2];
#pragma unroll
        for (int q = 0; q < 2; ++q) { int r_ = row + q * F.NGW; if (r_ >= MT) r_ = row; rw[q] = r_;
            const bool lat = r_ < ML;
            const float* xr = lat ? INP(0) + (size_t)r_ * D : INP(2) + (size_t)(r_ - ML) * D;
            scp[q] = MOD + (size_t)(lat ? (r_ >> 11) : NB) * MODW + D;
#pragma unroll
            for (int j = 0; j < 4; ++j) v[q][j] = *(const f32x4*)(xr + 4 * F.lane + 256 * j); }
#pragma unroll
        for (int q = 0; q < 2; ++q) { float s_ = 0.f;
#pragma unroll
            for (int j = 0; j < 4; ++j) s_ += (v[q][j][0] * v[q][j][0] + v[q][j][1] * v[q][j][1]) + (v[q][j][2] * v[q][j][2] + v[q][j][3] * v[q][j][3]);
            ss[q] = wave_sum(s_); }
#pragma unroll
        for (int q = 0; q < 2; ++q) { if (q == 1 && rw[1] == row) break;
            if (F.lane < 32) RSSA[(size_t)rw[q] * 32 + F.lane] = (F.lane == 0) ? ss[q] : 0.f;
#pragma unroll
            for (int j = 0; j < 4; ++j) { const int k = 4 * F.lane + 256 * j;
                const f32x4 gm = *(const f32x4*)(g1 + k) * (*(const f32x4*)(scp[q] + k) + 1.0f), a = v[q][j] * gm;
                v2u o; o.x = pk2(a[0], a[1]); o.y = pk2(a[2], a[3]); *(v2u*)(XA + (size_t)rw[q] * D + k) = o; } }
    }
    __syncthreads();
    {
        bf16* WLR = WSP(bf16, WS_WLR);
        for (int i = F.gw * 64 + F.lane; i < 2 * 2 * 4 * 2 * 4096; i += F.NGW * 64) { const int d = i & 63, e = (i >> 6) & 63, gt = (i >> 12) & 1, blk = i >> 13;
            const float* src = gt == 0 ? INP(17) : INP(19); WLR[i] = (bf16)f2bf(src[((size_t)blk * 64 + d) * 64 + e]); }
    }
    LAS float* scr = (LAS float*)(F.lds + F.wave * 16384);
    constexpr int I_IN = (D / 64) * (IND / 32), I_OUT = (D / 64) * (D / 32), I_1 = (D / 64) * (FF / 32), I_2 = (FF / 64) * (D / 32), I_L = I_IN + I_OUT + I_1 + I_2;
    for (int it = F.gw; it < 2 * I_L; it += F.NGW) {
        const int l = it / I_L; int r = it % I_L;
        const float* W; bf16* WT; int K = D, N;
        if (r < I_IN) { W = INP(8) + (size_t)l * D * IND; WT = WSP(bf16, WS_WIN) + (size_t)l * IND * D; N = IND; }
        else if (r < I_IN + I_OUT) { r -= I_IN; W = INP(9) + (size_t)l * D * D; WT = WSP(bf16, WS_WOUT) + (size_t)l * D * D; N = D; }
        else if (r < I_IN + I_OUT + I_1) { r -= I_IN + I_OUT; W = INP(22) + (size_t)l * D * FF; WT = WSP(bf16, WS_W1) + (size_t)l * FF * D; N = FF; }
        else { r -= I_IN + I_OUT + I_1; W = INP(23) + (size_t)l * FF * D; WT = WSP(bf16, WS_W2) + (size_t)l * D * FF; K = FF; N = D; }
        p0_transpose_item(W, K, N, WT, scr, r, F.lane);
    }
}


constexpr int CV_OSROW = 260;
__device__ __forceinline__ void conv_phase(Frame& F, int l, int ntiles) {
    const bf16* PROJ = WSP(const bf16, WS_PROJ); bf16* MIX = WSP(bf16, WS_MIX);
    LAS float* us = (LAS float*)(F.lds);
    LAS float* os = (LAS float*)(F.lds + 62 * 256 * 4);
    const int c = F.tid & 255, half = F.tid >> 8;
    float w[31];
#pragma unroll
    for (int k = 0; k < 31; ++k) w[k] = INP(10)[((size_t)l * 31 + k) * 256 + c];
    const float cbias = INP(11)[l * 256 + c];
    const f32x4 lg = *(const f32x4*)(INP(12) + l * 256 + 4 * F.lane), lb = *(const f32x4*)(INP(13) + l * 256 + 4 * F.lane);
    unsigned pv[16], pg[16];
    auto load_tile = [&](int T) {
        const int row0 = T * 32;
        int lo, hi; if (row0 < ML) { lo = row0 & ~(SEQ - 1); hi = lo + SEQ; } else { lo = row0 & ~(CTXL - 1); hi = lo + CTXL; }
#pragma unroll
        for (int j = 0; j < 16; ++j) { const int i = F.tid + 512 * j, rr = i >> 7, cp = i & 127, row = row0 - 15 + rr;
            const bool ok = (j < 15 || F.tid < 256) && row >= lo && row < hi;
            pv[j] = ok ? *(const unsigned*)(PROJ + (size_t)row * IND + 2 * cp) : 0u; pg[j] = ok ? *(const unsigned*)(PROJ + (size_t)row * IND + 256 + 2 * cp) : 0u; }
    };
    const int T0 = F.G - 1 - F.vcu;
    if (T0 < ntiles) load_tile(T0);
    for (int T = T0; T < ntiles; T += F.G) {
        const int row0 = T * 32;
        __syncthreads();
#pragma unroll
        for (int j = 0; j < 16; ++j) { const int i = F.tid + 512 * j;
            if (j < 15 || F.tid < 256) { f32x2 u; u[0] = bflo(pv[j]) * sigmoidf_(bflo(pg[j])); u[1] = bfhi(pv[j]) * sigmoidf_(bfhi(pg[j])); *(LAS f32x2*)(us + 2 * i) = u; } }
        if (T + F.G < ntiles) load_tile(T + F.G);
        __syncthreads();
        {
            float acc[16];
#pragma unroll
            for (int j = 0; j < 16; ++j) acc[j] = cbias;
            const LAS float* up = us + (16 * half) * 256 + c;
#pragma unroll
            for (int i = 0; i < 46; ++i) { const float x = up[i * 256];
#pragma unroll
                for (int j = 0; j < 16; ++j) if (i - j >= 0 && i - j <= 30) acc[j] += w[i - j] * x; }
#pragma unroll
            for (int j = 0; j < 16; ++j) os[(16 * half + j) * CV_OSROW + c] = acc[j];
        }
        __syncthreads();
#pragma unroll
        for (int q = 0; q < 4; ++q) { const int t = 4 * F.wave + q;
            const f32x4 v = *(const LAS f32x4*)(os + t * CV_OSROW + 4 * F.lane);
            const float mu = wave_sum((v[0] + v[1]) + (v[2] + v[3])) * (1.f / 256.f);
            const f32x4 d = v - mu;
            const float var = wave_sum((d[0] * d[0] + d[1] * d[1]) + (d[2] * d[2] + d[3] * d[3])) * (1.f / 256.f);
            const f32x4 y = d * rsqrtf(var + EPS) * lg + lb;
            v2u o; o.x = pk2(siluf_(y[0]), siluf_(y[1])); o.y = pk2(siluf_(y[2]), siluf_(y[3]));
            *(v2u*)(MIX + (size_t)(row0 + t) * D + 4 * F.lane) = o; }
    }
}

typedef short s16x8 __attribute__((ext_vector_type(8)));
typedef short s16x4 __attribute__((ext_vector_type(4)));
constexpr int NA_KROW = 144, NA_VROW = 160;
constexpr int NA_STAGE = 64 * NA_KROW + 64 * NA_VROW, NA_OFF_TB = 2 * NA_STAGE;
constexpr int NA_ITEMS_LAT = NB * NH * 8, NA_ITEMS_CTX = NB * NH * 2;
struct NaBlk { f32x4 O[4]; float m, lsum; int first; };
__device__ __forceinline__ int na_rs(int r) { int v = r - 4; return v < 0 ? 0 : (v > 24 ? 24 : v); }
__device__ __forceinline__ s16x8 na_scale_q(v4u w, float c) {
    v4u o; o.x = pg8::cvt_pk_bf16(bflo(w.x) * c, bfhi(w.x) * c); o.y = pg8::cvt_pk_bf16(bflo(w.y) * c, bfhi(w.y) * c); o.z = pg8::cvt_pk_bf16(bflo(w.z) * c, bfhi(w.z) * c); o.w = pg8::cvt_pk_bf16(bflo(w.w) * c, bfhi(w.w) * c);
    return __builtin_bit_cast(s16x8, o);
}
__device__ __forceinline__ void na_phase(Frame& F, int l, int nitems, int nav = 0) {
    const bf16* PROJ = WSP(const bf16, WS_PROJ); bf16* MIX = WSP(bf16, WS_MIX);
    LAS float* tb = (LAS float*)(F.lds + NA_OFF_TB);
    const int lane = F.lane, q16 = lane & 15, g = lane >> 4;
    const unsigned skey = (unsigned)(F.tid >> 3), spart = (unsigned)(F.tid & 7);
    const float c1 = 0.125f * 1.4426950408889634f;
    for (int it = F.vcu; it < nitems; it += F.G) {
        const bool isctx = it >= NA_ITEMS_LAT;
        int b, h, ra = 0, jq = 0, qrow0, rsI = 0, nloc = 0;
        if (!isctx) { const int r4 = it & 7; h = (it >> 3) & 7; b = it >> 6; const int r0 = 4 * r4; ra = r0 + 2 * (F.wave >> 2); jq = F.wave & 3; qrow0 = b * SEQ + ra * 64 + jq * 16;
            rsI = na_rs(r0); nloc = na_rs(r0 + 3) + 8 - rsI; }
        else { const int j = it - NA_ITEMS_LAT; const int hf = j & 1; h = (j >> 1) & 7; b = j >> 4; qrow0 = ML + b * CTXL + hf * 128 + F.wave * 16; }
        const int nch = nloc + 4;
        const bf16* Pq = PROJ + 512 + h * HD, * Pk = PROJ + 1024 + h * HD + 8 * spart, * Pv = PROJ + 1536 + h * HD + 8 * spart;
        auto krow_of = [&](int ch) -> int { return ch < nloc ? b * SEQ + (rsI + ch) * 64 : ML + b * CTXL + (ch - nloc) * 64; };
        s16x8 qfA[2], qfB[2];
#pragma unroll
        for (int s_ = 0; s_ < 2; ++s_) { qfA[s_] = na_scale_q(*(const v4u*)(Pq + (size_t)(qrow0 + q16) * IND + 32 * s_ + 8 * g), c1);
            qfB[s_] = isctx ? qfA[s_] : na_scale_q(*(const v4u*)(Pq + (size_t)(qrow0 + 64 + q16) * IND + 32 * s_ + 8 * g), c1); }
        const int rsA = na_rs(ra), rsB = na_rs(ra + 1);
        const int o0 = jq == 0 ? 0 : 16 * jq - 8, o1 = jq == 0 ? 16 : (jq == 3 ? 48 : 16 * jq + 8);
        float madd[2][4]; int lb[2];
        {
            const int qc = jq * 16 + q16; int cs = qc - 8; cs = cs < 0 ? 0 : (cs > 48 ? 48 : cs);
#pragma unroll
            for (int e = 0; e < 4; ++e) { const int k0 = o0 + 4 * g + e, k1 = o1 + 4 * g + e;
                madd[0][e] = ((unsigned)(k0 - cs) < 16u) ? 0.f : -1.0e30f;
                madd[1][e] = (((unsigned)(k1 - cs) < 16u) && !(jq == 3 && k1 < 56)) ? 0.f : -1.0e30f; }
            lb[0] = 64 + o0 + 4 * g - qc + 15; lb[1] = 64 + o1 + 4 * g - qc + 15;
        }
        v4u kr_ = *(const v4u*)(Pk + (size_t)(krow_of(0) + (int)skey) * IND), vr_ = *(const v4u*)(Pv + (size_t)(krow_of(0) + (int)skey) * IND);
        __syncthreads();
        if (!isctx) { const float* rpb = INP(14) + ((size_t)l * NH + h) * 15 * 31;
            for (int i = F.tid; i < 640; i += NWAVES * 64) tb[i] = (i >= 64 && i < 64 + 465) ? rpb[i - 64] * 1.4426950408889634f : 0.f; }
        *(LAS v4u*)(F.lds + skey * NA_KROW + spart * 16) = kr_; *(LAS v4u*)(F.lds + 64 * NA_KROW + skey * NA_VROW + spart * 16) = vr_;
        kr_ = *(const v4u*)(Pk + (size_t)(krow_of(1) + (int)skey) * IND); vr_ = *(const v4u*)(Pv + (size_t)(krow_of(1) + (int)skey) * IND);
        NaBlk A, B;
#pragma unroll
        for (int dt = 0; dt < 4; ++dt) { A.O[dt] = (f32x4){0.f, 0.f, 0.f, 0.f}; B.O[dt] = (f32x4){0.f, 0.f, 0.f, 0.f}; }
        A.m = 0.f; A.lsum = 0.f; A.first = 1; B.m = 0.f; B.lsum = 0.f; B.first = 1;
        for (int ch = 0; ch < nch; ++ch) {
            __syncthreads();
            LAS unsigned char* cur = F.lds + (ch & 1) * NA_STAGE; LAS unsigned char* nxt = F.lds + ((ch + 1) & 1) * NA_STAGE;
            if (ch + 1 < nch) { *(LAS v4u*)(nxt + skey * NA_KROW + spart * 16) = kr_; *(LAS v4u*)(nxt + 64 * NA_KROW + skey * NA_VROW + spart * 16) = vr_; }
            if (ch + 2 < nch) { const int k2 = krow_of(ch + 2) + (int)skey; kr_ = *(const v4u*)(Pk + (size_t)k2 * IND); vr_ = *(const v4u*)(Pv + (size_t)k2 * IND); }
            const bool local = ch < nloc;
            const int kr = rsI + ch;
            const bool actA = !local || (kr >= rsA && kr <= rsA + 7), actB = !isctx && (!local || (kr >= rsB && kr <= rsB + 7));
            if ((!actA && !actB) || nav == 1) continue;
            auto finish = [&](f32x4* S, int nt_, NaBlk& X, unsigned (*pk)[2], float cm) {
                if (X.first || !__all(cm <= 8.f)) {
                    cm = fmaxf(cm, __shfl_xor(cm, 16)); cm = fmaxf(cm, __shfl_xor(cm, 32));
                    const float d = X.first ? cm : fmaxf(cm, 0.f);
                    if (!X.first) { const float alpha = __builtin_amdgcn_exp2f(-d); X.lsum *= alpha;
#pragma unroll
                        for (int dt = 0; dt < 4; ++dt) X.O[dt] = X.O[dt] * alpha; }
                    X.m += d; X.first = 0;
#pragma unroll
                    for (int t = 0; t < 4; ++t) if (t < nt_) S[t] = S[t] - d;
                }
                float ps = 0.f;
#pragma unroll
                for (int t = 0; t < 4; ++t) if (t < nt_) {
                    const float p0 = __builtin_amdgcn_exp2f(S[t][0]), p1 = __builtin_amdgcn_exp2f(S[t][1]), p2 = __builtin_amdgcn_exp2f(S[t][2]), p3 = __builtin_amdgcn_exp2f(S[t][3]);
                    ps += (p0 + p1) + (p2 + p3);
                    pk[t][0] = pg8::cvt_pk_bf16(p0, p1); pk[t][1] = pg8::cvt_pk_bf16(p2, p3); }
                X.lsum += ps;
            };
            unsigned pkA[4][2], pkB[4][2];
            if (local) {
                const LAS unsigned char* kb_ = cur + q16 * NA_KROW + 16 * g;
                f32x4 SA[2], SB[2];
#pragma unroll
                for (int t = 0; t < 2; ++t) { const float ma = -A.m, mb = -B.m; SA[t] = (f32x4){ma, ma, ma, ma}; SB[t] = (f32x4){mb, mb, mb, mb};
                    const int o = t == 0 ? o0 : o1;
#pragma unroll
                    for (int s_ = 0; s_ < 2; ++s_) { const s16x8 kf = *(const LAS s16x8*)(kb_ + o * NA_KROW + 64 * s_);
                        if (actA) SA[t] = __builtin_amdgcn_mfma_f32_16x16x32_bf16(kf, qfA[s_], SA[t], 0, 0, 0);
                        if (actB) SB[t] = __builtin_amdgcn_mfma_f32_16x16x32_bf16(kf, qfB[s_], SB[t], 0, 0, 0); } }
                if (nav == 2) { asm volatile("" :: "v"(SA[0]), "v"(SA[1]), "v"(SB[0]), "v"(SB[1])); continue; }
                auto soft_local = [&](f32x4 (&S)[2], NaBlk& X, unsigned (&pk)[4][2], int rq) {
                    float cm = -1.0e30f;
#pragma unroll
                    for (int t = 0; t < 2; ++t) { const LAS float* tr_ = tb + (kr - rq + 7) * 31 + lb[t];
#pragma unroll
                        for (int e = 0; e < 4; ++e) { const float v = (S[t][e] + tr_[e]) + madd[t][e]; S[t][e] = v; cm = fmaxf(cm, v); } }
                    finish(S, 2, X, pk, cm);
                };
                if (actA) soft_local(SA, A, pkA, ra);
                if (actB) soft_local(SB, B, pkB, ra + 1);
                if (nav == 3) { asm volatile("" :: "v"(pkA[0][0]), "v"(pkA[1][1]), "v"(pkB[0][0]), "v"(pkB[1][1])); continue; }
                const LAS unsigned char* vtr = cur + 64 * NA_KROW + (4 * g + (q16 >> 2)) * NA_VROW + (q16 & 3) * 8;
                const v4u bwA = {pkA[0][0], pkA[0][1], pkA[1][0], pkA[1][1]}, bwB = {pkB[0][0], pkB[0][1], pkB[1][0], pkB[1][1]};
                const s16x8 bfA = __builtin_bit_cast(s16x8, bwA), bfB = __builtin_bit_cast(s16x8, bwB);
#pragma unroll
                for (int dt = 0; dt < 4; ++dt) {
                    const s16x4 a0 = __builtin_amdgcn_ds_read_tr16_b64_v4i16((LAS s16x4*)(vtr + o0 * NA_VROW + dt * 32));
                    const s16x4 a1 = __builtin_amdgcn_ds_read_tr16_b64_v4i16((LAS s16x4*)(vtr + o1 * NA_VROW + dt * 32));
                    const s16x8 afrag = __builtin_shufflevector(a0, a1, 0, 1, 2, 3, 4, 5, 6, 7);
                    if (actA) A.O[dt] = __builtin_amdgcn_mfma_f32_16x16x32_bf16(afrag, bfA, A.O[dt], 0, 0, 0);
                    if (actB) B.O[dt] = __builtin_amdgcn_mfma_f32_16x16x32_bf16(afrag, bfB, B.O[dt], 0, 0, 0);
                }
            } else {
                const LAS unsigned char* kb_ = cur + q16 * NA_KROW + 16 * g;
                f32x4 SA[4], SB[4];
#pragma unroll
                for (int t = 0; t < 4; ++t) { const float ma = -A.m, mb = -B.m; SA[t] = (f32x4){ma, ma, ma, ma}; SB[t] = (f32x4){mb, mb, mb, mb};
#pragma unroll
                    for (int s_ = 0; s_ < 2; ++s_) { const s16x8 kf = *(const LAS s16x8*)(kb_ + t * 16 * NA_KROW + 64 * s_);
                        SA[t] = __builtin_amdgcn_mfma_f32_16x16x32_bf16(kf, qfA[s_], SA[t], 0, 0, 0);
                        if (actB) SB[t] = __builtin_amdgcn_mfma_f32_16x16x32_bf16(kf, qfB[s_], SB[t], 0, 0, 0); } }
                if (nav == 2) { asm volatile("" :: "v"(SA[0]), "v"(SA[1]), "v"(SA[2]), "v"(SA[3]), "v"(SB[0]), "v"(SB[1]), "v"(SB[2]), "v"(SB[3])); continue; }
                auto soft_ctx = [&](f32x4 (&S)[4], NaBlk& X, unsigned (&pk)[4][2]) {
                    float cm = -1.0e30f;
#pragma unroll
                    for (int t = 0; t < 4; ++t)
#pragma unroll
                        for (int e = 0; e < 4; ++e) cm = fmaxf(cm, S[t][e]);
                    finish(S, 4, X, pk, cm);
                };
                soft_ctx(SA, A, pkA);
                if (actB) soft_ctx(SB, B, pkB);
                if (nav == 3) { asm volatile("" :: "v"(pkA[0][0]), "v"(pkA[1][1]), "v"(pkA[2][0]), "v"(pkA[3][1]), "v"(pkB[0][0]), "v"(pkB[1][1]), "v"(pkB[2][0]), "v"(pkB[3][1])); continue; }
                const LAS unsigned char* vtr = cur + 64 * NA_KROW + (4 * g + (q16 >> 2)) * NA_VROW + (q16 & 3) * 8;
#pragma unroll
                for (int p = 0; p < 2; ++p) {
                    const v4u bwA = {pkA[2 * p][0], pkA[2 * p][1], pkA[2 * p + 1][0], pkA[2 * p + 1][1]}, bwB = {pkB[2 * p][0], pkB[2 * p][1], pkB[2 * p + 1][0], pkB[2 * p + 1][1]};
                    const s16x8 bfA = __builtin_bit_cast(s16x8, bwA), bfB = __builtin_bit_cast(s16x8, bwB);
#pragma unroll
                    for (int dt = 0; dt < 4; ++dt) {
                        const s16x4 a0 = __builtin_amdgcn_ds_read_tr16_b64_v4i16((LAS s16x4*)(vtr + (2 * p) * 16 * NA_VROW + dt * 32));
                        const s16x4 a1 = __builtin_amdgcn_ds_read_tr16_b64_v4i16((LAS s16x4*)(vtr + (2 * p + 1) * 16 * NA_VROW + dt * 32));
                        const s16x8 afrag = __builtin_shufflevector(a0, a1, 0, 1, 2, 3, 4, 5, 6, 7);
                        A.O[dt] = __builtin_amdgcn_mfma_f32_16x16x32_bf16(afrag, bfA, A.O[dt], 0, 0, 0);
                        if (actB) B.O[dt] = __builtin_amdgcn_mfma_f32_16x16x32_bf16(afrag, bfB, B.O[dt], 0, 0, 0);
                    }
                }
            }
        }
        {
            float ls = A.lsum; ls += __shfl_xor(ls, 16); ls += __shfl_xor(ls, 32);
            const float inv = __builtin_amdgcn_rcpf(ls);
            bf16* op = MIX + (size_t)(qrow0 + q16) * D + 256 + h * HD + 4 * g;
#pragma unroll
            for (int dt = 0; dt < 4; ++dt) { v2u w; w.x = pg8::cvt_pk_bf16(A.O[dt][0] * inv, A.O[dt][1] * inv); w.y = pg8::cvt_pk_bf16(A.O[dt][2] * inv, A.O[dt][3] * inv); *(v2u*)(op + 16 * dt) = w; }
        }
        if (!isctx) {
            float ls = B.lsum; ls += __shfl_xor(ls, 16); ls += __shfl_xor(ls, 32);
            const float inv = __builtin_amdgcn_rcpf(ls);
            bf16* op = MIX + (size_t)(qrow0 + 64 + q16) * D + 256 + h * HD + 4 * g;
#pragma unroll
            for (int dt = 0; dt < 4; ++dt) { v2u w; w.x = pg8::cvt_pk_bf16(B.O[dt][0] * inv, B.O[dt][1] * inv); w.y = pg8::cvt_pk_bf16(B.O[dt][2] * inv, B.O[dt][3] * inv); *(v2u*)(op + 16 * dt) = w; }
        }
    }
}

constexpr int LRU_UCROW = 260;
constexpr int LRU_OFF_UC = 38 * 256 * 2, LRU_OFF_GT = LRU_OFF_UC + 2 * 32 * LRU_UCROW * 4;
static_assert(LRU_OFF_GT + 32 * 256 * 2 <= RING_BYTES, "LRU LDS map");
template <int PASS>
__device__ __forceinline__ void lru_phase(Frame& F, int l, int ntiles) {
    const bf16* PROJ = WSP(const bf16, WS_PROJ);
    LAS bf16* rxs = (LAS bf16*)(F.lds);
    LAS float* ucf = (LAS float*)(F.lds + LRU_OFF_UC);
    LAS bf16* gts = (LAS bf16*)(F.lds + LRU_OFF_GT);
    const int lane = F.lane, j16 = lane & 15, g = lane >> 4;
    const int kb = F.wave & 3, nh = F.wave >> 2;
    s16x8 wf[2][2][2][2];
    float cbx[2][2], cba[2][2], csp[2][2];
#pragma unroll
    for (int dir = 0; dir < 2; ++dir) {
        const int ld = l * 2 + dir;
        const bf16* WLR = WSP(const bf16, WS_WLR) + (size_t)((ld * 4 + kb) * 2) * 4096;
#pragma unroll
        for (int gt = 0; gt < 2; ++gt)
#pragma unroll
            for (int n2 = 0; n2 < 2; ++n2)
#pragma unroll
                for (int s_ = 0; s_ < 2; ++s_) wf[dir][gt][n2][s_] = *(const s16x8*)(WLR + gt * 4096 + (16 * (2 * nh + n2) + j16) * 64 + 32 * s_ + 8 * g);
#pragma unroll
        for (int n2 = 0; n2 < 2; ++n2) {
            const int e = kb * 64 + 16 * (2 * nh + n2) + j16, idx = ld * 256 + e;
            cbx[dir][n2] = INP(18)[idx]; cba[dir][n2] = INP(20)[idx];
            const float nl = -INP(21)[idx]; csp[dir][n2] = -8.f * (fmaxf(nl, 0.f) + log1pf(__expf(-fabsf(nl))));
        }
    }
    const int c = F.tid & 255, sdir = F.tid >> 8;
    const int sld = l * 2 + sdir;
    const float s1w0 = INP(15)[(sld * 4 + 0) * 256 + c], s1w1 = INP(15)[(sld * 4 + 1) * 256 + c], s1w2 = INP(15)[(sld * 4 + 2) * 256 + c], s1w3 = INP(15)[(sld * 4 + 3) * 256 + c], s1cb = INP(16)[sld * 256 + c];
    const int base = sdir == 0 ? 0 : 3;
    unsigned pre[10], pgw[8];
    auto load_tile = [&](int T) {
        const int row0 = T * 32;
        int lo, hi; if (row0 < ML) { lo = row0 & ~(SEQ - 1); hi = lo + SEQ; } else { lo = row0 & ~(CTXL - 1); hi = lo + CTXL; }
#pragma unroll
        for (int j = 0; j < 10; ++j) { const int i = F.tid + 512 * j, rr = i >> 7, cp = i & 127, row = row0 - 3 + rr;
            const bool ok = (j < 9 || F.tid < 256) && row >= lo && row < hi;
            pre[j] = ok ? *(const unsigned*)(PROJ + (size_t)row * IND + 2048 + 2 * cp) : 0u; }
        if (PASS == 1) {
#pragma unroll
            for (int j = 0; j < 8; ++j) { const int i = F.tid + 512 * j, t = i >> 7, cp = i & 127; pgw[j] = *(const unsigned*)(PROJ + (size_t)(row0 + t) * IND + 2304 + 2 * cp); }
        }
    };
    if (F.vcu < ntiles) load_tile(F.vcu);
    for (int T = F.vcu; T < ntiles; T += F.G) {
        const int row0 = T * 32;
        __syncthreads();
#pragma unroll
        for (int j = 0; j < 10; ++j) { const int i = F.tid + 512 * j; if (j < 9 || F.tid < 256) ((LAS unsigned*)rxs)[i] = pre[j]; }
        if (PASS == 1) {
#pragma unroll
            for (int j = 0; j < 8; ++j) ((LAS unsigned*)gts)[F.tid + 512 * j] = pgw[j];
        }
        if (T + F.G < ntiles) load_tile(T + F.G);
        float hst[2][2];
#pragma unroll
        for (int dir = 0; dir < 2; ++dir)
#pragma unroll
            for (int n2 = 0; n2 < 2; ++n2) hst[dir][n2] = PASS == 1 ? WSP(const float, WS_CARRY)[((size_t)dir * 1152 + T) * 256 + kb * 64 + 16 * (2 * nh + n2) + j16] : 0.f;
        __syncthreads();
        {
            float x0 = bf1(rxs[(base + 0) * 256 + c]), x1 = bf1(rxs[(base + 1) * 256 + c]), x2 = bf1(rxs[(base + 2) * 256 + c]);
#pragma unroll 8
            for (int t = 0; t < 32; ++t) {
                const float x3 = bf1(rxs[(t + base + 3) * 256 + c]);
                ucf[(sdir * 32 + t) * LRU_UCROW + c] = s1cb + s1w0 * x0 + s1w1 * x1 + s1w2 * x2 + s1w3 * x3;
                x0 = x1; x1 = x2; x2 = x3;
            }
        }
        __syncthreads();
        float hf[2][2][4];
        float Pt[2][2] = {{1.f, 1.f}, {1.f, 1.f}};
#pragma unroll
        for (int dir = 0; dir < 2; ++dir) {
            const bool sec16 = ((g & 1) != 0) != (dir != 0), sec32 = ((g >> 1) != 0) != (dir != 0);
#pragma unroll
            for (int step = 0; step < 2; ++step) {
                const int rt = dir == 0 ? step : 1 - step;
                s16x8 af[2];
#pragma unroll
                for (int s_ = 0; s_ < 2; ++s_) { const LAS float* up = ucf + (dir * 32 + 16 * rt + j16) * LRU_UCROW + kb * 64 + 32 * s_ + 8 * g;
                    const f32x4 u0 = *(const LAS f32x4*)up, u1 = *(const LAS f32x4*)(up + 4);
                    const v4u w = {pg8::cvt_pk_bf16(u0[0], u0[1]), pg8::cvt_pk_bf16(u0[2], u0[3]), pg8::cvt_pk_bf16(u1[0], u1[1]), pg8::cvt_pk_bf16(u1[2], u1[3])};
                    af[s_] = __builtin_bit_cast(s16x8, w); }
#pragma unroll
                for (int n2 = 0; n2 < 2; ++n2) {
                    f32x4 zx = {0.f, 0.f, 0.f, 0.f}, za = {0.f, 0.f, 0.f, 0.f};
#pragma unroll
                    for (int s_ = 0; s_ < 2; ++s_) { zx = __builtin_amdgcn_mfma_f32_16x16x32_bf16(af[s_], wf[dir][0][n2][s_], zx, 0, 0, 0); za = __builtin_amdgcn_mfma_f32_16x16x32_bf16(af[s_], wf[dir][1][n2][s_], za, 0, 0, 0); }
                    const int e = kb * 64 + 16 * (2 * nh + n2) + j16;
                    const LAS float* uo = ucf + (dir * 32 + 16 * rt + 4 * g) * LRU_UCROW + e;
                    float a_[4], b_[4]; unsigned abw[4];
#pragma unroll
                    for (int r = 0; r < 4; ++r) {
                        const float u = uo[r * LRU_UCROW];
                        const float gx = sigmoidf_(zx[r] + cbx[dir][n2]), ga = sigmoidf_(za[r] + cba[dir][n2]);
                        const float la = csp[dir][n2] * ga, a = __builtin_amdgcn_exp2f(1.4426950408889634f * la), y = 2.f * la;
                        const float om = y > -0.02f ? -y * (1.f + y * (0.5f + y * 0.16666667f)) : 1.f - a * a;
                        a_[r] = a; b_[r] = __builtin_amdgcn_sqrtf(om) * gx * u;
                        if (PASS == 0) {
                            const float oma = la > -0.02f ? -la * (1.f + la * (0.5f + la * 0.16666667f)) : 1.f - a;
                            abw[r] = pg8::cvt_pk_bf16(oma, b_[r]); a_[r] = 1.f - bflo(abw[r]); b_[r] = bfhi(abw[r]);
                        }
                    }
                    if (PASS == 0) WSP(v4u, WS_AB)[(((((size_t)T * 2 + dir) * 2 + rt) * 8 + F.wave) * 2 + n2) * 64 + lane] = (v4u){abw[0], abw[1], abw[2], abw[3]};
                    const float P = (a_[0] * a_[1]) * (a_[2] * a_[3]);
                    const float S = dir == 0 ? ((b_[0] * a_[1] + b_[1]) * a_[2] + b_[2]) * a_[3] + b_[3] : ((b_[3] * a_[2] + b_[2]) * a_[1] + b_[1]) * a_[0] + b_[0];
                    const float Pp = __shfl_xor(P, 16), Sp = __shfl_xor(S, 16);
                    const float e1P = sec16 ? Pp : 1.f, e1S = sec16 ? Sp : 0.f;
                    const float prP = P * Pp, prS = sec16 ? P * Sp + S : Pp * S + Sp;
                    const float Pq = __shfl_xor(prP, 32), Sq = __shfl_xor(prS, 32);
                    const float EP = sec32 ? Pq * e1P : e1P, ES = sec32 ? e1P * Sq + e1S : e1S;
                    const float TP = prP * Pq, TS = sec32 ? prP * Sq + prS : Pq * prS + Sq;
                    if (PASS == 1) {
                        float h = EP * hst[dir][n2] + ES;
                        if (dir == 0) {
#pragma unroll
                            for (int r = 0; r < 4; ++r) { h = a_[r] * h + b_[r]; hf[rt][n2][r] = h; }
                        } else {
                            float hb[4];
#pragma unroll
                            for (int r = 3; r >= 0; --r) { h = a_[r] * h + b_[r]; hb[r] = h; }
                            bf16* mp = WSP(bf16, WS_MIX) + (size_t)(row0 + 16 * rt + 4 * g) * D + 768 + e;
                            const LAS bf16* gp = gts + (16 * rt + 4 * g) * 256 + e;
#pragma unroll
                            for (int r = 0; r < 4; ++r) mp[(size_t)r * D] = (bf16)f2bf(gelu_tanh(bf1(gp[r * 256])) * (hf[rt][n2][r] + hb[r]));
                        }
                    } else Pt[dir][n2] *= TP;
                    hst[dir][n2] = TP * hst[dir][n2] + TS;
                }
            }
        }
        if (PASS == 0 && g == 0) {
#pragma unroll
            for (int dir = 0; dir < 2; ++dir)
#pragma unroll
                for (int n2 = 0; n2 < 2; ++n2) WSP(f32x2, WS_TOT)[((size_t)dir * 1152 + T) * 256 + kb * 64 + 16 * (2 * nh + n2) + j16] = (f32x2){Pt[dir][n2], hst[dir][n2]};
        }
    }
}
__device__ __forceinline__ void lru_scan_phase(Frame& F, int l, int ntiles) {
    const bf16* PROJ = WSP(const bf16, WS_PROJ);
    LAS bf16* gts = (LAS bf16*)(F.lds);
    const int lane = F.lane, j16 = lane & 15, g = lane >> 4;
    const int kb = F.wave & 3, nh = F.wave >> 2;
    const v4u* AB = WSP(const v4u, WS_AB);
    v4u pab[2][2][2]; unsigned pgw[8];
    auto load_tile = [&](int T) {
#pragma unroll
        for (int dir = 0; dir < 2; ++dir)
#pragma unroll
            for (int rt = 0; rt < 2; ++rt)
#pragma unroll
                for (int n2 = 0; n2 < 2; ++n2) pab[dir][rt][n2] = AB[(((((size_t)T * 2 + dir) * 2 + rt) * 8 + F.wave) * 2 + n2) * 64 + lane];
#pragma unroll
        for (int j = 0; j < 8; ++j) { const int i = F.tid + 512 * j, t = i >> 7, cp = i & 127; pgw[j] = *(const unsigned*)(PROJ + (size_t)(T * 32 + t) * IND + 2304 + 2 * cp); }
    };
    if (F.vcu < ntiles) load_tile(F.vcu);
    for (int T = F.vcu; T < ntiles; T += F.G) {
        const int row0 = T * 32;
        __syncthreads();
#pragma unroll
        for (int j = 0; j < 8; ++j) ((LAS unsigned*)gts)[F.tid + 512 * j] = pgw[j];
        v4u cur[2][2][2];
#pragma unroll
        for (int dir = 0; dir < 2; ++dir)
#pragma unroll
            for (int rt = 0; rt < 2; ++rt)
#pragma unroll
                for (int n2 = 0; n2 < 2; ++n2) cur[dir][rt][n2] = pab[dir][rt][n2];
        float hst[2][2];
#pragma unroll
        for (int dir = 0; dir < 2; ++dir)
#pragma unroll
            for (int n2 = 0; n2 < 2; ++n2) hst[dir][n2] = WSP(const float, WS_CARRY)[((size_t)dir * 1152 + T) * 256 + kb * 64 + 16 * (2 * nh + n2) + j16];
        if (T + F.G < ntiles) load_tile(T + F.G);
        __syncthreads();
        float hf[2][2][4];
#pragma unroll
        for (int dir = 0; dir < 2; ++dir) {
            const bool sec16 = ((g & 1) != 0) != (dir != 0), sec32 = ((g >> 1) != 0) != (dir != 0);
#pragma unroll
            for (int step = 0; step < 2; ++step) {
                const int rt = dir == 0 ? step : 1 - step;
#pragma unroll
                for (int n2 = 0; n2 < 2; ++n2) {
                    const int e = kb * 64 + 16 * (2 * nh + n2) + j16;
                    const v4u w = cur[dir][rt][n2];
                    const float a_[4] = {1.f - bflo(w.x), 1.f - bflo(w.y), 1.f - bflo(w.z), 1.f - bflo(w.w)}, b_[4] = {bfhi(w.x), bfhi(w.y), bfhi(w.z), bfhi(w.w)};
                    const float P = (a_[0] * a_[1]) * (a_[2] * a_[3]);
                    const float S = dir == 0 ? ((b_[0] * a_[1] + b_[1]) * a_[2] + b_[2]) * a_[3] + b_[3] : ((b_[3] * a_[2] + b_[2]) * a_[1] + b_[1]) * a_[0] + b_[0];
                    const float Pp = __shfl_xor(P, 16), Sp = __shfl_xor(S, 16);
                    const float e1P = sec16 ? Pp : 1.f, e1S = sec16 ? Sp : 0.f;
                    const float prP = P * Pp, prS = sec16 ? P * Sp + S : Pp * S + Sp;
                    const float Pq = __shfl_xor(prP, 32), Sq = __shfl_xor(prS, 32);
                    const float EP = sec32 ? Pq * e1P : e1P, ES = sec32 ? e1P * Sq + e1S : e1S;
                    const float TP = prP * Pq, TS = sec32 ? prP * Sq + prS : Pq * prS + Sq;
                    float h = EP * hst[dir][n2] + ES;
                    if (dir == 0) {
#pragma unroll
                        for (int r = 0; r < 4; ++r) { h = a_[r] * h + b_[r]; hf[rt][n2][r] = h; }
                    } else {
                        float hb[4];
#pragma unroll
                        for (int r = 3; r >= 0; --r) { h = a_[r] * h + b_[r]; hb[r] = h; }
                        bf16* mp = WSP(bf16, WS_MIX) + (size_t)(row0 + 16 * rt + 4 * g) * D + 768 + e;
                        const LAS bf16* gp = gts + (16 * rt + 4 * g) * 256 + e;
#pragma unroll
                        for (int r = 0; r < 4; ++r) mp[(size_t)r * D] = (bf16)f2bf(gelu_tanh(bf1(gp[r * 256])) * (hf[rt][n2][r] + hb[r]));
                    }
                    hst[dir][n2] = TP * hst[dir][n2] + TS;
                }
            }
        }
    }
}

__device__ __forceinline__ void lru_carry(Frame& F) {
    const f32x2* TOT = WSP(const f32x2, WS_TOT); float* CARRY = WSP(float, WS_CARRY);
    for (int it = F.gw; it < NB * 2 * 4; it += F.NGW) {
        const int b = it >> 3, dir = (it >> 2) & 1, c = (it & 3) * 64 + F.lane;
        float h = 0.f;
        for (int g = 0; g < 18; ++g) {
            f32x2 ps[4]; int tl[4];
#pragma unroll
            for (int i = 0; i < 4; ++i) { const int s = g * 4 + i;
                int T; if (s < 8) T = 1024 + b * 8 + (dir == 0 ? s : 7 - s); else T = b * 64 + (dir == 0 ? s - 8 : 71 - s);
                tl[i] = T; ps[i] = TOT[((size_t)dir * 1152 + T) * 256 + c]; }
#pragma unroll
            for (int i = 0; i < 4; ++i) { CARRY[((size_t)dir * 1152 + tl[i]) * 256 + c] = h; h = ps[i][0] * h + ps[i][1]; }
        }
    }
}

__device__ __forceinline__ void ctx_finalize(Frame& F, int l) {
    bf16* XA = WSP(bf16, WS_XA); float* RSSA = WSP(float, WS_RSSA); const float* ACC = WSP(const float, WS_PART); const float* MOD = WSP(const float, WS_MOD);
    const float* go = INP(5) + (l - 1) * D; const float* gso = MOD + ((size_t)(l - 1) * 17 + NB) * MODW + 4 * D;
    const float* gn = INP(4) + l * D; const float* gsn = MOD + ((size_t)l * 17 + NB) * MODW + D;
    for (int r = F.gw; r < MC; r += F.NGW) {
        const size_t row = (size_t)ML + r;
        float ss = 0.f; f32x4 y[4];
#pragma unroll
        for (int j = 0; j < 4; ++j) { const int k = 4 * F.lane + 256 * j;
            const v2u w = *(const v2u*)(XA + row * D + k);
            const f32x4 im = *(const f32x4*)(go + k) * (*(const f32x4*)(gso + k) + 1.0f);
            const f32x4 xo = (f32x4){bflo(w.x) * __builtin_amdgcn_rcpf(im[0]), bfhi(w.x) * __builtin_amdgcn_rcpf(im[1]), bflo(w.y) * __builtin_amdgcn_rcpf(im[2]), bfhi(w.y) * __builtin_amdgcn_rcpf(im[3])};
            const float* ap = ACC + (size_t)r * D + k;
            y[j] = xo + ((*(const f32x4*)ap + *(const f32x4*)(ap + (size_t)MC * D)) + (*(const f32x4*)(ap + (size_t)2 * MC * D) + *(const f32x4*)(ap + (size_t)3 * MC * D)));
            ss += (y[j][0] * y[j][0] + y[j][1] * y[j][1]) + (y[j][2] * y[j][2] + y[j][3] * y[j][3]); }
        ss = wave_sum(ss);
        if (F.lane < 32) RSSA[row * 32 + F.lane] = (F.lane == 0) ? ss : 0.f;
#pragma unroll
        for (int j = 0; j < 4; ++j) { const int k = 4 * F.lane + 256 * j;
            const f32x4 a = y[j] * (*(const f32x4*)(gn + k) * (*(const f32x4*)(gsn + k) + 1.0f));
            v2u o; o.x = pk2(a[0], a[1]); o.y = pk2(a[2], a[3]); *(v2u*)(XA + row * D + k) = o; }
    }
}

__device__ __forceinline__ void final_rows(Frame& F) {
    const bf16* XA = WSP(const bf16, WS_XA); const float* RSS = WSP(const float, WS_RSSA);
    for (int row = F.gw; row < ML; row += 2 * F.NGW) {
        const int row2 = row + F.NGW; const bool two = row2 < ML;
        const v4u a0 = *(const v4u*)(XA + (size_t)row * D + 8 * F.lane), a1 = *(const v4u*)(XA + (size_t)row * D + 512 + 8 * F.lane);
        const float p0 = F.lane < 32 ? RSS[(size_t)row * 32 + F.lane] : 0.f;
        v4u b0 = a0, b1 = a1; float p1 = 0.f;
        if (two) { b0 = *(const v4u*)(XA + (size_t)row2 * D + 8 * F.lane); b1 = *(const v4u*)(XA + (size_t)row2 * D + 512 + 8 * F.lane); p1 = F.lane < 32 ? RSS[(size_t)row2 * 32 + F.lane] : 0.f; }
        const float rs0 = rsqrtf(wave_sum(p0) * (1.f / D) + EPS), rs1 = rsqrtf(wave_sum(p1) * (1.f / D) + EPS);
        float* o = F.out + (size_t)row * D + 8 * F.lane;
        *(f32x4*)(o) = (f32x4){bflo(a0.x), bfhi(a0.x), bflo(a0.y), bfhi(a0.y)} * rs0; *(f32x4*)(o + 4) = (f32x4){bflo(a0.z), bfhi(a0.z), bflo(a0.w), bfhi(a0.w)} * rs0;
        *(f32x4*)(o + 512) = (f32x4){bflo(a1.x), bfhi(a1.x), bflo(a1.y), bfhi(a1.y)} * rs0; *(f32x4*)(o + 516) = (f32x4){bflo(a1.z), bfhi(a1.z), bflo(a1.w), bfhi(a1.w)} * rs0;
        if (two) { float* o2 = F.out + (size_t)row2 * D + 8 * F.lane;
            *(f32x4*)(o2) = (f32x4){bflo(b0.x), bfhi(b0.x), bflo(b0.y), bfhi(b0.y)} * rs1; *(f32x4*)(o2 + 4) = (f32x4){bflo(b0.z), bfhi(b0.z), bflo(b0.w), bfhi(b0.w)} * rs1;
            *(f32x4*)(o2 + 512) = (f32x4){bflo(b1.x), bfhi(b1.x), bflo(b1.y), bfhi(b1.y)} * rs1; *(f32x4*)(o2 + 516) = (f32x4){bflo(b1.z), bfhi(b1.z), bflo(b1.w), bfhi(b1.w)} * rs1; }
    }
}

constexpr int N_PHASES = 2 + 7 * DEPTH + 1;
struct Args { const float* in[25]; float* out; unsigned char* ws; int ph_lo, ph_hi; };
static_assert(sizeof(Args) == 27 * 8 + 8, "Args has no padding");

__global__ void __launch_bounds__(NWAVES * 64, 2) mega_fwd(Args args) {
    extern __shared__ __attribute__((aligned(16))) unsigned char lds[];
    Frame F;
    F.lds = (LAS unsigned char*)lds;
    const int wave_s = __builtin_amdgcn_readfirstlane((int)threadIdx.x >> 6);
    F.wave = wave_s; F.lane = (int)__builtin_amdgcn_mbcnt_hi(~0u, __builtin_amdgcn_mbcnt_lo(~0u, 0u)); F.tid = wave_s * 64 + F.lane;
    F.G = gridDim.x; { const int bx = blockIdx.x; F.vcu = (F.G % 8 == 0) ? (bx % 8) * (F.G / 8) + bx / 8 : bx; }
    F.gw = F.vcu * NWAVES + F.wave; F.NGW = F.G * NWAVES;
    F.out = args.out; F.ws = args.ws;
    volatile LAS unsigned* MISC = (volatile LAS unsigned*)(F.lds + MISC_OFF);
    for (int u = F.tid; u < (LDS_BYTES - LDSCTL_OFF) / 4; u += NWAVES * 64) ((LAS unsigned*)(F.lds + LDSCTL_OFF))[u] = 0u;
    __syncthreads();
    if (F.tid == 0) {
#pragma unroll
        for (int i = 0; i < 25; ++i) *(LAS unsigned long long*)(F.lds + PTR_OFF + 8 * i) = (unsigned long long)args.in[i];
    }
    __syncthreads();
    XcdBarrier bar = xcd_barrier_post((unsigned*)(F.ws + WS_CTL) + CW_BAR, MISC + 8, F.tid);

    const int lo = args.ph_lo, hi = args.ph_hi;
#ifdef PROBE_MASK
    bool rep_done = false;
#define PROBE_V ((((PROBE_MASK >> ph) & 1) && !rep_done) ? PROBE_VARIANT : 0)
#else
#define PROBE_V 0
#endif
    for (int ph = lo; ph < hi; ++ph) {
        { unsigned ones_ = ~0u; asm volatile("" : "+s"(ones_));
          int t_ = wave_s * 64 + (int)__builtin_amdgcn_mbcnt_hi(ones_, __builtin_amdgcn_mbcnt_lo(ones_, 0u)); asm volatile("" : "+v"(t_)); F.tid = t_; F.lane = t_ & 63; F.wave = __builtin_amdgcn_readfirstlane(t_ >> 6); F.gw = F.vcu * NWAVES + F.wave; }
        if (ph == 0) {
#ifndef NO_P0
            phase_p0a(F);
#endif
        } else if (ph == 1) {
#ifndef NO_P0
            phase_p0b(F);
#endif
        }
        else if (ph == N_PHASES - 1) final_rows(F);
        else {
            const int l = (ph - 2) / 7, k = (ph - 2) % 7; const bool last = (l == DEPTH - 1);
            const int Mx = last ? ML : MT;
            float* MOD = WSP(float, WS_MOD);
            if (k == 0) {
                if (l > 0) { ctx_finalize(F, l); xcd_barrier(bar, F.tid); }
                pg8::Gemm g{WSP(const bf16, WS_XA), WSP(const bf16, WS_WIN) + (size_t)l * IND * D, MT, IND, D};
                pg8::Order S; if (last) S.init(ML, IND, WGM_IN, (MC / 256) * 5, 1, F.G, (int)blockIdx.x); else S.init(MT, IND, WGM_IN, 0, 0, F.G, (int)blockIdx.x);
                pg8::EpiScale<0, IND> E{WSP(bf16, WS_PROJ), WSP(const float, WS_SHW1) + (size_t)l * 17 * IND, WSP(const float, WS_RSSA), PROBE_V};

#ifndef NO_G0
                pg8::gemm_phase<pg8::EpiScale<0, IND>, pg8::Order, true, true>(F.lds + RING_OFF, g, S, E, F.tid);
#endif

            } else if (k == 1) {

#ifndef NO_LRU
                lru_phase<0>(F, l, 1152);
#ifdef REP_LRU0
                __syncthreads(); lru_phase<0>(F, l, 1152);
#endif
#endif

                __syncthreads();
#ifndef NO_CONV
                conv_phase(F, l, last ? 1024 : 1152);
                __syncthreads();
#ifdef REP_CONV
                conv_phase(F, l, last ? 1024 : 1152);
                __syncthreads();
#endif
#endif
#ifndef NO_NA
#ifdef REP_NA
                na_phase(F, l, last ? NA_ITEMS_LAT : NA_ITEMS_LAT + NA_ITEMS_CTX, REP_NA);
#else
                na_phase(F, l, last ? NA_ITEMS_LAT : NA_ITEMS_LAT + NA_ITEMS_CTX);
#endif
#ifdef REP_NA
                __syncthreads(); na_phase(F, l, last ? NA_ITEMS_LAT : NA_ITEMS_LAT + NA_ITEMS_CTX, 0);
#endif
#endif
            } else if (k == 2) {
                lru_carry(F);
            } else if (k == 3) {

#ifndef NO_LRU
                lru_scan_phase(F, l, last ? 1024 : 1152);
#endif

            } else if (k == 4 || k == 6) {
                const bool dn = (k == 6);
                const int ln = (dn && !last) ? l + 1 : l;
                pg8::Gemm g{dn ? WSP(const bf16, WS_HID) : WSP(const bf16, WS_MIX), dn ? WSP(const bf16, WS_W2) + (size_t)l * D * FF : WSP(const bf16, WS_WOUT) + (size_t)l * D * D, Mx, D, dn ? FF : D};
                const bool splitk = dn && !last;
                pg8::Order S; S.init(splitk ? ML : Mx, D, dn ? WGM_DN : WGM_OUT, 0, 0, F.G, (int)blockIdx.x);
                const bool fromin = (!dn && l == 0);
                const float* go_g = dn ? INP(5) + l * D : INP(4) + l * D;
                const float* go_s = MOD + (size_t)l * 17 * MODW + (dn ? 4 : 1) * D;
                const bool fin = dn && last;
                pg8::EpiRes E{fromin ? INP(0) : (const float*)nullptr, fromin ? INP(2) : (const float*)nullptr, (float*)nullptr,
                              MOD + (size_t)l * 17 * MODW + (dn ? 5 : 2) * D, fin ? INP(24) : (dn ? INP(4) : INP(5)) + ln * D, fin ? WSP(const float, WS_ZERO) : MOD + (size_t)ln * 17 * MODW + (dn ? 1 : 4) * D,
                              go_g, go_s, WSP(bf16, WS_XA), dn ? WSP(float, WS_RSSA) : WSP(float, WS_RSSB), 1};
#ifndef NO_GR
                pg8::gemm_phase<pg8::EpiRes, pg8::Order, true, true>(F.lds + RING_OFF, g, S, E, F.tid);
                if (splitk) {
                    pg8::Order S2; S2.init(ML, 0, 4, (MC / 256) * 16, 2, F.G, (int)blockIdx.x);
                    pg8::EpiSlab E2{WSP(float, WS_PART), MOD + ((size_t)l * 17 + NB) * MODW + 5 * D};
                    pg8::gemm_phase<pg8::EpiSlab, pg8::Order, true, true, true>(F.lds + RING_OFF, g, S2, E2, F.tid);
                }
#endif
            } else if (k == 5) {
                pg8::Gemm g{WSP(const bf16, WS_XA), WSP(const bf16, WS_W1) + (size_t)l * FF * D, Mx, FF, D};
                pg8::Order S; S.init(Mx, FF, WGM_UP, 0, 0, F.G, (int)blockIdx.x);
                pg8::EpiScale<1, FF> E{WSP(bf16, WS_HID), WSP(const float, WS_SHW2) + (size_t)l * 17 * FF, WSP(const float, WS_RSSB), PROBE_V};

#ifndef NO_G1
                pg8::gemm_phase<pg8::EpiScale<1, FF>, pg8::Order, true, true>(F.lds + RING_OFF, g, S, E, F.tid);
#endif

            }
        }
#ifdef PROBE_MASK
        if (((PROBE_MASK >> ph) & 1) && !rep_done) { rep_done = true; xcd_barrier(bar, F.tid); --ph; continue; }
        rep_done = false;
#endif
        if (ph + 1 < hi) xcd_barrier(bar, F.tid);
#ifdef PROBE_BAR2
        if (ph + 1 < hi) xcd_barrier(bar, F.tid);
#endif
    }
}

extern "C" void kernel_launch(void* const* d_in, const int* in_sizes, int n_in, void* d_out, int out_size, void* d_ws, size_t ws_size, hipStream_t stream) {
    static int grid = 0;
    if (grid == 0) {
        if (n_in != 25 || out_size != ML * D || ws_size < WS_END) { fprintf(stderr, "kernel_launch: unexpected shapes (n_in %d out %d ws %zu)\n", n_in, out_size, ws_size); grid = -1; return; }
        int dev = 0, cus = 0;
        if (hipGetDevice(&dev) != hipSuccess || hipDeviceGetAttribute(&cus, hipDeviceAttributeMultiprocessorCount, dev) != hipSuccess) { grid = -1; return; }
        if (hipFuncSetAttribute((const void*)mega_fwd, hipFuncAttributeMaxDynamicSharedMemorySize, LDS_BYTES) != hipSuccess) { fprintf(stderr, "kernel_launch: hipFuncSetAttribute failed\n"); grid = -1; return; }
        int per_cu = 0;
        if (hipOccupancyMaxActiveBlocksPerMultiprocessor(&per_cu, (const void*)mega_fwd, NWAVES * 64, LDS_BYTES) != hipSuccess || per_cu < 1) fprintf(stderr, "kernel_launch: occupancy query reports %d\n", per_cu);
        (void)hipGetLastError();
        grid = cus;
    }
    if (grid < 0) return;
    if (hipMemsetAsync((char*)d_ws + WS_CTL, 0, CTL_ZERO_BYTES, stream) != hipSuccess) return;
    Args a{};
    for (int i = 0; i < 25; ++i) a.in[i] = (const float*)d_in[i];
    a.out = (float*)d_out; a.ws = (unsigned char*)d_ws;
#if MK_N_LAUNCHES == 1
    a.ph_lo = 0; a.ph_hi = N_PHASES;
    hipLaunchKernelGGL(mega_fwd, dim3(grid), dim3(NWAVES * 64), LDS_BYTES, stream, a);
#else
    for (int ph = 0; ph < N_PHASES; ++ph) { a.ph_lo = ph; a.ph_hi = ph + 1; hipLaunchKernelGGL(mega_fwd, dim3(grid), dim3(NWAVES * 64), LDS_BYTES, stream, a); }
#endif
}
```

```cpp
#include <hip/hip_runtime.h>
#include <cstdio>
#include <cstdint>

constexpr int D = 1024, NB = 16, SEQ = 2048, CTXL = 256, DEPTH = 2;
constexpr int ML = NB * SEQ, MC = NB * CTXL, MT = ML + MC;
constexpr int IND = 2560, FF = 4096, NH = 8, HD = 64;
constexpr int MODW = 6 * D;
constexpr float EPS = 1e-6f;
#ifndef MK_N_LAUNCHES
#define MK_N_LAUNCHES 1
#endif

namespace pg8 {
#define PG8_LAS __attribute__((address_space(3)))
typedef unsigned short bf16_t;
typedef short bf16x8 __attribute__((ext_vector_type(8)));
typedef float f32x4 __attribute__((ext_vector_type(4)));
typedef unsigned u32x4 __attribute__((ext_vector_type(4)));
constexpr int BM = 256, BK = 64, HALF = 128, HTB = HALF * BK * 2, STAGE_BYTES = 8 * HTB, NXCD = 8;

__host__ __device__ __forceinline__ int lds_byte(int r, int c) { const int st = (r >> 4) * 2 + (c >> 5), rr = r & 15, cc = c & 31, ob = rr * 64 + cc * 2; return st * 1024 + (ob ^ (((ob >> 9) & 1) << 5)); }
__host__ __device__ __forceinline__ void stage_rc(int b, int& R, int& C) { const int st = b / 1024, sb = b % 1024, swz = sb ^ (((sb >> 9) & 1) << 5); R = (st >> 1) * 16 + swz / 64; C = (st & 1) * 32 + (swz % 64) / 2; }
__host__ __device__ __forceinline__ int perm32(int rho) { const int n = rho >> 4, i = rho & 15; return 8 * (i >> 2) + 4 * n + (i & 3); }

struct Unit { int pm, pn; };
struct Gemm { const bf16_t* A; const bf16_t* Bt; int M, N, K; };

__host__ __device__ __forceinline__ void map_tile(int wgid, int nM, int nN, int WGM, Unit& u) {
    const int nwg = nM * nN;
    { const int q = nwg / NXCD, r = nwg % NXCD, xcd = wgid % NXCD, off = wgid / NXCD; wgid = (xcd < r ? xcd * (q + 1) : r * (q + 1) + (xcd - r) * q) + off; }
    const int nig = WGM * nN, gid = wgid / nig, fm = gid * WGM, gsz = (nM - fm) < WGM ? (nM - fm) : WGM;
    u.pm = fm + ((wgid % nig) % gsz); u.pn = (wgid % nig) / gsz;
}
struct Order {
    int nM, nN, nwg, extra, mode, wgm, G, c;
    __host__ __device__ void init(int M, int N, int wgm_, int extra_, int mode_, int G_, int c_) { nM = M / BM; nN = N / BM; nwg = nM * nN; extra = extra_; mode = mode_; wgm = wgm_; G = G_; c = c_; }
    __host__ __device__ bool next(int i, Unit& u) const {
        const long L = (long)i * G + c;
        if (L < nwg) { map_tile((int)L, nM, nN, wgm, u); return true; }
        if (L < nwg + extra) { const int q = (int)L - nwg;
            if (mode == 1) { u.pm = nM + q / 5; u.pn = 4 + q % 5; }
            else { u.pm = nM + (q >> 4); u.pn = 4 + 4 * (q & 3) + ((q >> 2) & 3); }
            return true; }
        return false;
    }
    __device__ __forceinline__ void a_ready(const Unit&) const {}
    __device__ __forceinline__ void done(const Unit&) const {}
};

__device__ __forceinline__ unsigned cvt_pk_bf16(float lo, float hi) { unsigned r; asm volatile("v_cvt_pk_bf16_f32 %0, %1, %2" : "=v"(r) : "v"(lo), "v"(hi)); return r; }

template <int ACT, int LDC, bool GLU = false> struct EpiScale {
    static constexpr bool PERM = true, AFTER_DRAIN = false;
    bf16_t* O; const float* shw; const float* RSS;
    int probe;
    __device__ __forceinline__ void operator()(const f32x4 (&acc)[2][2][4][2], const Unit& u, int wr, int wc, int fr, int fq) const {
        asm volatile("" : "+s"(wr), "+s"(wc));
        const int brow = u.pm < ML / BM ? (u.pm >> 3) : NB;
        const float* sp = shw + (size_t)brow * LDC + u.pn * BM;
        bf16_t* Ot = O + (size_t)u.pm * BM * LDC + u.pn * BM;
        const float* RSSt = RSS + (size_t)u.pm * BM * 32;
        unsigned cl = (unsigned)(wc * 32 + 8 * fq);
        unsigned rl0 = (unsigned)(wr * 64 + fr);
        asm volatile("" : "+v"(cl), "+v"(rl0));
        f32x4 pa[2][4], pb[2][4], sh[2][2];
#pragma unroll
        for (int ai = 0; ai < 2; ++ai)
#pragma unroll
            for (int m = 0; m < 4; ++m) { const unsigned ro = (rl0 + (unsigned)(ai * HALF + m * 16)) * 32u + 8u * (unsigned)fq;
                if (probe == 2) { pa[ai][m] = acc[ai][0][m][0]; pb[ai][m] = acc[ai][1][m][0]; } else { pa[ai][m] = *(const f32x4*)(RSSt + ro); pb[ai][m] = *(const f32x4*)(RSSt + (ro + 4u)); } }
#pragma unroll
        for (int bj = 0; bj < 2; ++bj) { if (probe == 2) { sh[bj][0] = acc[0][bj][0][1]; sh[bj][1] = acc[1][bj][0][1]; } else { sh[bj][0] = *(const f32x4*)(sp + (cl + (unsigned)(bj * HALF))); sh[bj][1] = *(const f32x4*)(sp + (cl + (unsigned)(bj * HALF + 4))); } }
        float rs[2][4];
#pragma unroll
        for (int ai = 0; ai < 2; ++ai)
#pragma unroll
            for (int m = 0; m < 4; ++m) { const f32x4 p0 = pa[ai][m], p1 = pb[ai][m];
                float s = ((p0[0] + p0[1]) + (p0[2] + p0[3])) + ((p1[0] + p1[1]) + (p1[2] + p1[3]));
                s += __shfl_xor(s, 16); s += __shfl_xor(s, 32);
                rs[ai][m] = rsqrtf(s * (1.0f / D) + EPS); }
        if (GLU && u.pn < 2) {
#pragma unroll
            for (int ai = 0; ai < 2; ++ai)
#pragma unroll
                for (int m = 0; m < 4; ++m) {
                    const f32x4 a0 = acc[ai][0][m][0] * rs[ai][m] + sh[0][0], a1 = acc[ai][0][m][1] * rs[ai][m] + sh[0][1];
                    const f32x4 g0 = acc[ai][1][m][0] * rs[ai][m] + sh[1][0], g1 = acc[ai][1][m][1] * rs[ai][m] + sh[1][1];
                    f32x4 v0, v1;
#pragma unroll
                    for (int e = 0; e < 4; ++e) { v0[e] = a0[e] * __builtin_amdgcn_rcpf(1.f + __builtin_amdgcn_exp2f(-1.4426950408889634f * g0[e])); v1[e] = a1[e] * __builtin_amdgcn_rcpf(1.f + __builtin_amdgcn_exp2f(-1.4426950408889634f * g1[e])); }
                    u32x4 w; w.x = cvt_pk_bf16(v0[0], v0[1]); w.y = cvt_pk_bf16(v0[2], v0[3]); w.z = cvt_pk_bf16(v1[0], v1[1]); w.w = cvt_pk_bf16(v1[2], v1[3]);
                    *(u32x4*)(O + (size_t)u.pm * BM * LDC + u.pn * HALF + ((rl0 + (unsigned)(ai * HALF + m * 16)) * (unsigned)LDC + cl)) = w;
                }
            return;
        }
#pragma unroll
        for (int bj = 0; bj < 2; ++bj)
#pragma unroll
            for (int ai = 0; ai < 2; ++ai)
#pragma unroll
                for (int m = 0; m < 4; ++m) {
                    f32x4 v0 = acc[ai][bj][m][0] * rs[ai][m] + sh[bj][0], v1 = acc[ai][bj][m][1] * rs[ai][m] + sh[bj][1];
                    if (ACT == 1) {
#pragma unroll
                        for (int e = 0; e < 4; ++e) { const float a = fmaxf(v0[e], 0.f), b = fmaxf(v1[e], 0.f); v0[e] = a * a; v1[e] = b * b; }
                    }
                    u32x4 w; w.x = cvt_pk_bf16(v0[0], v0[1]); w.y = cvt_pk_bf16(v0[2], v0[3]); w.z = cvt_pk_bf16(v1[0], v1[1]); w.w = cvt_pk_bf16(v1[2], v1[3]);
                    if (probe == 0) *(u32x4*)(Ot + ((rl0 + (unsigned)(ai * HALF + m * 16)) * (unsigned)LDC + cl + (unsigned)(bj * HALF))) = w;
                    else asm volatile("" :: "v"(w));
                }
    }
};
struct EpiRes {
    static constexpr bool PERM = true, AFTER_DRAIN = false;
    const float* src_lat; const float* src_ctx;
    float* dst_lat;
    const float* gate;
    const float* gmg; const float* gmsc;
    const float* gmg_o; const float* gmsc_o;
    bf16_t* XA; float* RSS; int hasxa;
    template <int BJ, int AI0, int NAI, int M0, int NM>
    __device__ __forceinline__ void batch(const f32x4 (&acc)[2][2][4][2], const float* src, float* dst, const float* gt, const float* gg, const float* gs, const float* go, const float* gso, bf16_t* XAt, float* RSSt, unsigned cl, unsigned rl0, int fq) const {
        const unsigned c = cl + (unsigned)(BJ * HALF);
        f32x4 x0[NAI][NM], x1[NAI][NM];
        const bool srcf = src != nullptr;
        if (srcf) {
#pragma unroll
            for (int a = 0; a < NAI; ++a)
#pragma unroll
                for (int m = 0; m < NM; ++m) { const unsigned off = (rl0 + (unsigned)((AI0 + a) * HALF + (M0 + m) * 16)) * (unsigned)D + c; x0[a][m] = *(const f32x4*)(src + off); x1[a][m] = *(const f32x4*)(src + (off + 4u)); }
        } else {
            u32x4 xb[NAI][NM];
#pragma unroll
            for (int a = 0; a < NAI; ++a)
#pragma unroll
                for (int m = 0; m < NM; ++m) { const unsigned off = (rl0 + (unsigned)((AI0 + a) * HALF + (M0 + m) * 16)) * (unsigned)D + c; xb[a][m] = *(const u32x4*)(XAt + off); }
            const f32x4 i0 = *(const f32x4*)(go + c) * (*(const f32x4*)(gso + c) + 1.0f), i1 = *(const f32x4*)(go + (c + 4u)) * (*(const f32x4*)(gso + (c + 4u)) + 1.0f);
            f32x4 r0, r1;
#pragma unroll
            for (int e = 0; e < 4; ++e) { r0[e] = __builtin_amdgcn_rcpf(i0[e]); r1[e] = __builtin_amdgcn_rcpf(i1[e]); }
#pragma unroll
            for (int a = 0; a < NAI; ++a)
#pragma unroll
                for (int m = 0; m < NM; ++m) { const u32x4 w = xb[a][m];
                    x0[a][m] = (f32x4){__uint_as_float(w.x << 16), __uint_as_float(w.x & 0xffff0000u), __uint_as_float(w.y << 16), __uint_as_float(w.y & 0xffff0000u)} * r0;
                    x1[a][m] = (f32x4){__uint_as_float(w.z << 16), __uint_as_float(w.z & 0xffff0000u), __uint_as_float(w.w << 16), __uint_as_float(w.w & 0xffff0000u)} * r1; }
        }
        const f32x4 g0 = *(const f32x4*)(gt + c), g1 = *(const f32x4*)(gt + (c + 4u));
        f32x4 m0 = {0.f, 0.f, 0.f, 0.f}, m1 = {0.f, 0.f, 0.f, 0.f};
        if (hasxa) { m0 = *(const f32x4*)(gg + c) * (*(const f32x4*)(gs + c) + 1.0f); m1 = *(const f32x4*)(gg + (c + 4u)) * (*(const f32x4*)(gs + (c + 4u)) + 1.0f); }
        asm volatile("" ::: "memory");
#pragma unroll
        for (int a = 0; a < NAI; ++a)
#pragma unroll
            for (int m = 0; m < NM; ++m) {
                const unsigned rl = rl0 + (unsigned)((AI0 + a) * HALF + (M0 + m) * 16);
                const unsigned off = rl * (unsigned)D + c;
                const f32x4 y0 = x0[a][m] + g0 * acc[AI0 + a][BJ][M0 + m][0], y1 = x1[a][m] + g1 * acc[AI0 + a][BJ][M0 + m][1];
                if (dst) { *(f32x4*)(dst + off) = y0; *(f32x4*)(dst + (off + 4u)) = y1; }
                float ss = ((y0[0] * y0[0] + y0[1] * y0[1]) + (y0[2] * y0[2] + y0[3] * y0[3])) + ((y1[0] * y1[0] + y1[1] * y1[1]) + (y1[2] * y1[2] + y1[3] * y1[3]));
                ss += __shfl_xor(ss, 16); ss += __shfl_xor(ss, 32);
                if (fq == 0) RSSt[rl * 32u + (unsigned)(BJ * 4)] = ss;
                if (hasxa) { const f32x4 a0 = y0 * m0, a1 = y1 * m1;
                    u32x4 w; w.x = cvt_pk_bf16(a0[0], a0[1]); w.y = cvt_pk_bf16(a0[2], a0[3]); w.z = cvt_pk_bf16(a1[0], a1[1]); w.w = cvt_pk_bf16(a1[2], a1[3]);
                    *(u32x4*)(XAt + off) = w; }
            }
        asm volatile("" ::: "memory");
    }
    __device__ __forceinline__ void operator()(const f32x4 (&acc)[2][2][4][2], const Unit& u, int wr, int wc, int fr, int fq) const {
        asm volatile("" : "+s"(wr), "+s"(wc));
        const bool lat = u.pm < ML / BM;
        const int brow = lat ? (u.pm >> 3) : NB;
        const float* src = src_lat ? (lat ? src_lat + (size_t)u.pm * BM * D : src_ctx + (size_t)(u.pm - ML / BM) * BM * D) + u.pn * BM : nullptr;
        float* dst = (dst_lat && lat) ? dst_lat + (size_t)u.pm * BM * D + u.pn * BM : nullptr;
        const float* gt = gate + (size_t)brow * MODW + u.pn * BM;
        const float* gg = gmg + u.pn * BM;
        const float* gs = gmsc + (size_t)brow * MODW + u.pn * BM;
        const float* go = gmg_o + u.pn * BM;
        const float* gso = gmsc_o + (size_t)brow * MODW + u.pn * BM;
        bf16_t* XAt = XA + (size_t)u.pm * BM * D + u.pn * BM;
        float* RSSt = RSS + (size_t)u.pm * BM * 32 + u.pn * 8 + wc;
        unsigned cl = (unsigned)(wc * 32 + 8 * fq);
        unsigned rl0 = (unsigned)(wr * 64 + fr);
        asm volatile("" : "+v"(cl), "+v"(rl0));
        batch<0, 0, 1, 0, 2>(acc, src, dst, gt, gg, gs, go, gso, XAt, RSSt, cl, rl0, fq);
        batch<0, 0, 1, 2, 2>(acc, src, dst, gt, gg, gs, go, gso, XAt, RSSt, cl, rl0, fq);
        batch<0, 1, 1, 0, 4>(acc, src, dst, gt, gg, gs, go, gso, XAt, RSSt, cl, rl0, fq);
        batch<1, 0, 2, 0, 4>(acc, src, dst, gt, gg, gs, go, gso, XAt, RSSt, cl, rl0, fq);
    }
};

struct EpiSlab {
    static constexpr bool PERM = true, AFTER_DRAIN = false;
    float* P; const float* gate;
    __device__ __forceinline__ void operator()(const f32x4 (&acc)[2][2][4][2], const Unit& u, int wr, int wc, int fr, int fq) const {
        asm volatile("" : "+s"(wr), "+s"(wc));
        const int ks = (u.pn - 4) >> 2, pn = u.pn & 3;
        float* At = P + ((size_t)ks * MC + (size_t)(u.pm - ML / BM) * BM) * D + pn * BM;
        const float* gtq = gate + pn * BM;
        unsigned cl = (unsigned)(wc * 32 + 8 * fq), rl0 = (unsigned)(wr * 64 + fr);
        asm volatile("" : "+v"(cl), "+v"(rl0));
#pragma unroll
        for (int bj = 0; bj < 2; ++bj) { const unsigned c = cl + (unsigned)(bj * HALF);
            const f32x4 g0 = *(const f32x4*)(gtq + c), g1 = *(const f32x4*)(gtq + (c + 4u));
#pragma unroll
            for (int ai = 0; ai < 2; ++ai)
#pragma unroll
                for (int m = 0; m < 4; ++m) { const unsigned off = (rl0 + (unsigned)(ai * HALF + m * 16)) * (unsigned)D + c;
                    *(f32x4*)(At + off) = g0 * acc[ai][bj][m][0]; *(f32x4*)(At + (off + 4u)) = g1 * acc[ai][bj][m][1]; } }
    }
};

template <class Epi, class Sched, bool ALIGN_EPI = false, bool SP2 = false, bool VARK = false>
__device__ __forceinline__ void gemm_phase(PG8_LAS unsigned char* lds, const Gemm g, const Sched& S, const Epi& E, const int tid) {
    const int wid = __builtin_amdgcn_readfirstlane(tid >> 6), lane = tid & 63, wr = wid >> 2, wc = wid & 3, fr = lane & 15, fq = lane >> 4;
    const int K = g.K;
    unsigned voffA[2], voffB[2];
#pragma unroll
    for (int i = 0; i < 2; ++i) { int R, C; stage_rc(tid * 16 + i * 8192, R, C); const int Rb = Epi::PERM ? ((R & ~31) + perm32(R & 31)) : R;
        voffA[i] = (unsigned)(R * K + C) * 2u; voffB[i] = (unsigned)(Rb * K + C) * 2u; }
    const size_t kstep = (size_t)(BK * 2);
    const size_t hstep = (size_t)HALF * K * 2;
    const size_t tstep = 2 * hstep;
    const unsigned ldsw = (unsigned)wid * 1024u;
    const int aoff = lds_byte(wr * 64 + fr, fq * 8), boff = lds_byte(wc * 32 + fr, fq * 8);
#define PG8_SA(b, h) (((b) * 2 + (h)) * HTB)
#define PG8_SB(b, h) ((4 + (b) * 2 + (h)) * HTB)
#define PG8_STAGE(bufoff, gbase, voff) do { _Pragma("unroll") for (int _i = 0; _i < 2; ++_i) \
        __builtin_amdgcn_global_load_lds((const unsigned*)((const char*)(gbase) + (voff)[_i]), (PG8_LAS unsigned*)(lds + (bufoff) + ldsw + _i * 8192), 16, 0, 0); } while (0)
#define PG8_LDA(dst, b, h) do { _Pragma("unroll") for (int m = 0; m < 4; ++m) _Pragma("unroll") for (int k = 0; k < 2; ++k) dst[m][k] = *(const PG8_LAS bf16x8*)(lds + PG8_SA(b, h) + aoff + m * 2048 + k * 1024); } while (0)
#define PG8_LDB(dst, b, h) do { _Pragma("unroll") for (int n = 0; n < 2; ++n) _Pragma("unroll") for (int k = 0; k < 2; ++k) dst[n][k] = *(const PG8_LAS bf16x8*)(lds + PG8_SB(b, h) + boff + n * 2048 + k * 1024); } while (0)
#define PG8_MMA(ai, bj, At, Bt) do { __builtin_amdgcn_s_setprio(1); _Pragma("unroll") for (int m = 0; m < 4; ++m) _Pragma("unroll") for (int n = 0; n < 2; ++n) _Pragma("unroll") for (int k = 0; k < 2; ++k) \
        acc[ai][bj][m][n] = __builtin_amdgcn_mfma_f32_16x16x32_bf16(Bt[n][k], At[m][k], acc[ai][bj][m][n], 0, 0, 0); __builtin_amdgcn_s_setprio(0); } while (0)
#define PG8_WAIT_V(n) asm volatile("s_waitcnt vmcnt(" #n ")" ::: "memory")
#define PG8_WAIT_L(n) asm volatile("s_waitcnt lgkmcnt(" #n ")" ::: "memory")
#define PG8_BAR __builtin_amdgcn_s_barrier()
#define PG8_SCHED __builtin_amdgcn_sched_barrier(0)
    Unit cur, nxt; int ui = 0;
    if (!S.next(0, cur)) return;
    cur.pm = __builtin_amdgcn_readfirstlane(cur.pm); cur.pn = __builtin_amdgcn_readfirstlane(cur.pn);
    f32x4 acc[2][2][4][2];
#pragma unroll
    for (int a = 0; a < 2; ++a)
#pragma unroll
        for (int b = 0; b < 2; ++b)
#pragma unroll
            for (int m = 0; m < 4; ++m)
#pragma unroll
                for (int n = 0; n < 2; ++n) acc[a][b][m][n] = (f32x4){0.f, 0.f, 0.f, 0.f};
    bf16x8 At[4][2], B0[2][2], B1[2][2];
#define PG8_KOFF(u) ((VARK && (u).pn >= 4) ? (size_t)(((u).pn - 4) >> 2) * (size_t)(K / 4) * 2 : (size_t)0)
#define PG8_PN(u) ((VARK && (u).pn >= 4) ? ((u).pn & 3) : (u).pn)
    const char* cA = (const char*)g.A + (size_t)cur.pm * tstep + PG8_KOFF(cur); const char* cB = (const char*)g.Bt + (size_t)PG8_PN(cur) * tstep + PG8_KOFF(cur);
    S.a_ready(cur);
    if constexpr (SP2) {
        PG8_STAGE(PG8_SB(0, 0), cB, voffB); PG8_STAGE(PG8_SB(0, 1), cB + hstep, voffB); PG8_STAGE(PG8_SA(0, 0), cA, voffA); PG8_STAGE(PG8_SA(0, 1), cA + hstep, voffA);
        if (wr == 1) PG8_BAR;
        PG8_WAIT_V(2); PG8_BAR;
        PG8_STAGE(PG8_SB(1, 0), cB + kstep, voffB); PG8_STAGE(PG8_SA(1, 0), cA + kstep, voffA); PG8_STAGE(PG8_SB(1, 1), cB + hstep + kstep, voffB);
        PG8_WAIT_V(6); PG8_BAR;
    } else {
        PG8_STAGE(PG8_SB(0, 0), cB, voffB); PG8_STAGE(PG8_SA(0, 0), cA, voffA); PG8_STAGE(PG8_SB(0, 1), cB + hstep, voffB); PG8_STAGE(PG8_SA(0, 1), cA + hstep, voffA);
        if (wr == 1) PG8_BAR;
        PG8_WAIT_V(4); PG8_BAR;
        PG8_STAGE(PG8_SB(1, 0), cB + kstep, voffB); PG8_STAGE(PG8_SA(1, 0), cA + kstep, voffA); PG8_STAGE(PG8_SB(1, 1), cB + hstep + kstep, voffB);
        PG8_WAIT_V(6); PG8_BAR;
    }
    for (;;) {
        const bool has_next = S.next(ui + 1, nxt);
        nxt.pm = __builtin_amdgcn_readfirstlane(nxt.pm); nxt.pn = __builtin_amdgcn_readfirstlane(nxt.pn);
        const char* nA = has_next ? (const char*)g.A + (size_t)nxt.pm * tstep + PG8_KOFF(nxt) : cA; const char* nB = has_next ? (const char*)g.Bt + (size_t)PG8_PN(nxt) * tstep + PG8_KOFF(nxt) : cB;
        const int nt = (VARK && cur.pn >= 4) ? K / BK / 4 : K / BK;
        for (int t = 0; t < nt; t += 2) {
            const bool last = (t == nt - 2);
            const char* a1 = cA + (size_t)(t + 1) * kstep;
            const char* a2 = last ? nA : cA + (size_t)(t + 2) * kstep; const char* b2 = last ? nB : cB + (size_t)(t + 2) * kstep;
            const char* a3 = a2 + kstep; const char* b3 = b2 + kstep;
            if (last && has_next) S.a_ready(nxt);
            if constexpr (SP2) {
            int fresh = __builtin_amdgcn_readfirstlane(((t == 0) && (ui > 0)) ? 1 : 0); asm volatile("" : "+s"(fresh));
            PG8_LDB(B0, 0, 0); PG8_LDB(B1, 0, 1); PG8_SCHED; PG8_LDA(At, 0, 0); PG8_STAGE(PG8_SA(1, 1), a1 + hstep, voffA);
            if (!fresh) PG8_WAIT_V(8); PG8_WAIT_L(0); PG8_BAR; PG8_MMA(0, 0, At, B0); PG8_MMA(0, 1, At, B1); PG8_BAR; PG8_SCHED;
            PG8_LDA(At, 0, 1); PG8_STAGE(PG8_SB(0, 0), b2, voffB); PG8_STAGE(PG8_SB(0, 1), b2 + hstep, voffB); PG8_STAGE(PG8_SA(0, 0), a2, voffA);
            if (!fresh) PG8_WAIT_V(8); PG8_WAIT_L(0); PG8_BAR; PG8_MMA(1, 0, At, B0); PG8_MMA(1, 1, At, B1); PG8_BAR; PG8_SCHED;
            PG8_LDB(B0, 1, 0); PG8_LDB(B1, 1, 1); PG8_SCHED; PG8_LDA(At, 1, 0); PG8_STAGE(PG8_SA(0, 1), a2 + hstep, voffA);
            PG8_WAIT_V(8); PG8_WAIT_L(0); PG8_BAR; PG8_MMA(0, 0, At, B0); PG8_MMA(0, 1, At, B1); PG8_BAR; PG8_SCHED;
            PG8_LDA(At, 1, 1); PG8_STAGE(PG8_SB(1, 0), b3, voffB); PG8_STAGE(PG8_SB(1, 1), b3 + hstep, voffB); PG8_STAGE(PG8_SA(1, 0), a3, voffA);
            PG8_WAIT_V(8); PG8_WAIT_L(0); PG8_BAR; PG8_MMA(1, 0, At, B0); PG8_MMA(1, 1, At, B1); PG8_BAR; PG8_SCHED;
            } else {
            PG8_LDB(B0, 0, 0); PG8_SCHED; PG8_LDA(At, 0, 0); PG8_STAGE(PG8_SA(1, 1), a1 + hstep, voffA);
            PG8_WAIT_L(8); PG8_BAR; PG8_WAIT_L(0); PG8_MMA(0, 0, At, B0); PG8_BAR; PG8_SCHED;
            PG8_LDB(B1, 0, 1); PG8_STAGE(PG8_SB(0, 0), b2, voffB);
            PG8_BAR; PG8_WAIT_L(0); PG8_MMA(0, 1, At, B1); PG8_BAR;
            PG8_LDA(At, 0, 1); PG8_STAGE(PG8_SA(0, 0), a2, voffA);
            PG8_BAR; PG8_WAIT_L(0); PG8_MMA(1, 0, At, B0); PG8_BAR; PG8_SCHED;
            PG8_STAGE(PG8_SB(0, 1), b2 + hstep, voffB);
            PG8_WAIT_V(6); PG8_BAR; PG8_MMA(1, 1, At, B1); PG8_BAR;
            PG8_LDB(B0, 1, 0); PG8_SCHED; PG8_LDA(At, 1, 0); PG8_STAGE(PG8_SA(0, 1), a2 + hstep, voffA);
            PG8_WAIT_L(8); PG8_BAR; PG8_WAIT_L(0); PG8_MMA(0, 0, At, B0); PG8_BAR; PG8_SCHED;
            PG8_LDB(B1, 1, 1); PG8_STAGE(PG8_SB(1, 0), b3, voffB);
            PG8_BAR; PG8_WAIT_L(0); PG8_MMA(0, 1, At, B1); PG8_BAR;
            PG8_LDA(At, 1, 1); PG8_STAGE(PG8_SA(1, 0), a3, voffA);
            PG8_BAR; PG8_WAIT_L(0); PG8_MMA(1, 0, At, B0); PG8_BAR; PG8_SCHED;
            PG8_STAGE(PG8_SB(1, 1), b3 + hstep, voffB);
            PG8_WAIT_V(6); PG8_BAR; PG8_MMA(1, 1, At, B1); PG8_BAR;
            }
        }
        if constexpr (ALIGN_EPI) { if (wr == 0) PG8_BAR; }
        if constexpr (!Epi::AFTER_DRAIN) { E(acc, cur, wr, wc, fr, fq); S.done(cur); }
        if (!has_next) break;
#pragma unroll
        for (int a = 0; a < 2; ++a)
#pragma unroll
            for (int b = 0; b < 2; ++b)
#pragma unroll
                for (int m = 0; m < 4; ++m)
#pragma unroll
                    for (int n = 0; n < 2; ++n) acc[a][b][m][n] = (f32x4){0.f, 0.f, 0.f, 0.f};
        cur = nxt; cA = nA; cB = nB; ++ui;
        if constexpr (ALIGN_EPI) { if (wr == 1) PG8_BAR; }
    }
    PG8_WAIT_V(0);
    if constexpr (!ALIGN_EPI) { if (wr == 0) PG8_BAR; }
    PG8_BAR;
    if constexpr (Epi::AFTER_DRAIN) { E.fused(acc, cur, wr, wc, fr, fq, lds, wid, lane); S.done(cur); }
#undef PG8_KOFF
#undef PG8_PN
#undef PG8_SA
#undef PG8_SB
#undef PG8_STAGE
#undef PG8_LDA
#undef PG8_LDB
#undef PG8_MMA
#undef PG8_WAIT_V
#undef PG8_WAIT_L
#undef PG8_BAR
#undef PG8_SCHED
}
}

constexpr size_t MiB = 1u << 20;
constexpr size_t WS_CTL = 0, CTL_ZERO_BYTES = 1 * MiB;
constexpr size_t WS_MOD = 1 * MiB;
constexpr size_t WS_SHW1 = 2 * MiB;
constexpr size_t WS_SHW2 = 3 * MiB;
constexpr size_t WS_RSSA = 4 * MiB;
constexpr size_t WS_RSSB = 9 * MiB;
constexpr size_t WS_TOT = 14 * MiB;
constexpr size_t WS_CARRY = 19 * MiB;
constexpr size_t WS_WLR = 21 * MiB + 512 * 1024;
constexpr size_t WS_WIN = 22 * MiB;
constexpr size_t WS_WOUT = 32 * MiB;
constexpr size_t WS_W1 = 36 * MiB;
constexpr size_t WS_W2 = 52 * MiB;
constexpr size_t WS_CX = 68 * MiB;
constexpr size_t WS_XA = 84 * MiB;
constexpr size_t WS_HID = 156 * MiB;
constexpr size_t WS_PROJ = WS_HID;
constexpr size_t WS_MIX = WS_HID + 180 * MiB;
constexpr size_t WS_PART = 444 * MiB;
constexpr size_t WS_AB = 436 * MiB;
constexpr size_t WS_END = 508 * MiB;
static_assert(WS_MIX + (size_t)MT * D * 2 <= WS_PART && WS_HID + (size_t)MT * FF * 2 == WS_PART && WS_PART + (size_t)4 * MC * D * 4 == WS_END && WS_AB >= WS_MIX + (size_t)MT * D * 2 && WS_AB + (size_t)1152 * 2 * 2 * 8 * 2 * 64 * 16 == WS_END, "ws map");
constexpr size_t WS_ZERO = WS_CTL + 512 * 1024;
constexpr int CW_BAR = 4096;

#ifndef WGM_IN
#define WGM_IN 4
#endif
#ifndef WGM_OUT
#define WGM_OUT 4
#endif
#ifndef WGM_UP
#define WGM_UP 4
#endif
#ifndef WGM_DN
#define WGM_DN 4
#endif
constexpr int NWAVES = 8;
constexpr int RING_OFF = 0, RING_BYTES = 131072;
constexpr int LDSCTL_OFF = RING_BYTES, MISC_OFF = LDSCTL_OFF + 320;
constexpr int LDS_BYTES = 147456;

#define GAS __attribute__((address_space(1)))
#define LAS __attribute__((address_space(3)))
typedef unsigned short bf16;
typedef unsigned v4u __attribute__((ext_vector_type(4)));
typedef unsigned v2u __attribute__((ext_vector_type(2)));
typedef float f32x4 __attribute__((ext_vector_type(4)));
typedef float f32x2 __attribute__((ext_vector_type(2)));
typedef GAS unsigned gu32;
#define LDS_WAIT() asm volatile("s_waitcnt lgkmcnt(0)" ::: "memory")
#define VM_WAIT() asm volatile("s_waitcnt vmcnt(0)" ::: "memory")
__device__ __forceinline__ unsigned f2bf(float f) { unsigned u = __builtin_bit_cast(unsigned, f); return (u + 0x7fffu + ((u >> 16) & 1u)) >> 16; }
__device__ __forceinline__ unsigned pk2(float lo, float hi) { return f2bf(lo) | (f2bf(hi) << 16); }
__device__ __forceinline__ float bflo(unsigned w) { return __uint_as_float(w << 16); }
__device__ __forceinline__ float bfhi(unsigned w) { return __uint_as_float(w & 0xffff0000u); }
__device__ __forceinline__ float bf1(bf16 v) { return __uint_as_float((unsigned)v << 16); }
__device__ __forceinline__ float sigmoidf_(float x) { return __builtin_amdgcn_rcpf(1.f + __builtin_amdgcn_exp2f(-1.4426950408889634f * x)); }
__device__ __forceinline__ float siluf_(float x) { return x * sigmoidf_(x); }
__device__ __forceinline__ float gelu_tanh(float x) { const float u = 0.7978845608028654f * (x + 0.044715f * x * x * x); return x * sigmoidf_(2.f * u); }
__device__ __forceinline__ float wave_sum(float v) {
#pragma unroll
    for (int o = 1; o < 64; o <<= 1) v += __shfl_xor(v, o);
    return v;
}

#define XB_TMO      128
#define XB_XCNT(j)  (256  + 64 * (j))
#define XB_XSUB(j)  (1280 + 64 * (j))
#define XB_XGEN(j)  (2304 + 64 * (j))
#define XB_TOP      3328
#define XB_TOPGEN   3392
#define XCD_BAR_WORDS 3456
#define XB_SPIN_CAP (1u << 18)

__device__ __forceinline__ unsigned xb_ld(unsigned* p)              { return __hip_atomic_load(p, __ATOMIC_RELAXED, __HIP_MEMORY_SCOPE_AGENT); }
__device__ __forceinline__ unsigned xb_add(unsigned* p, unsigned v) { return __hip_atomic_fetch_add(p, v, __ATOMIC_RELAXED, __HIP_MEMORY_SCOPE_AGENT); }
__device__ __forceinline__ unsigned xb_xcc_id() { return (unsigned)__builtin_amdgcn_s_getreg((3 << 11) | 20) & 0xFu; }
#define XB_SPIN(cond, bar) do { unsigned _sp = 0; while (cond) { __builtin_amdgcn_s_sleep(1); \
    if ((++_sp & 255u) == 0u) { if (xb_ld(&(bar)[XB_TMO])) break; if (_sp > XB_SPIN_CAP) { atomicAdd(&(bar)[XB_TMO], 1u); break; } } } } while (0)

struct XcdBarrier {
    unsigned* bar; unsigned x;
    volatile LAS unsigned* st;
};

__device__ __forceinline__ XcdBarrier xcd_barrier_post(unsigned* bar, volatile LAS unsigned* st, int tid) {
    XcdBarrier b; b.bar = bar; b.x = xb_xcc_id(); b.st = st;
    if (tid == 0) (void)xb_add(&bar[XB_XCNT(b.x)], 1u);
    return b;
}
__device__ __forceinline__ void xcd_barrier_complete(unsigned* bar, unsigned x, unsigned& nloc, unsigned& nx) {
    const unsigned G = gridDim.x * gridDim.y * gridDim.z;
    unsigned sum, cnt, mine, sp = 0u;
    for (;;) {
        sum = 0u; cnt = 0u; mine = 0u;
#pragma unroll 1
        for (unsigned j = 0; j < 16; ++j) { const unsigned c = xb_ld(&bar[XB_XCNT(j)]); sum += c; cnt += (c > 0u) ? 1u : 0u; mine = (j == x) ? c : mine; }
        if (sum == G) break;
        __builtin_amdgcn_s_sleep(1);
        if ((++sp & 255u) == 0u) { if (xb_ld(&bar[XB_TMO])) break; if (sp > XB_SPIN_CAP) { atomicAdd(&bar[XB_TMO], 1u); break; } }
    }
    nloc = mine > 0u ? mine : 1u; nx = cnt > 0u ? cnt : 1u;
}

__device__ __forceinline__ void xcd_barrier(const XcdBarrier& b, int tid) {
    asm volatile("s_waitcnt vmcnt(0)" ::: "memory");
    __syncthreads();
    if (tid == 0) {
        unsigned* bar = b.bar;
        __builtin_amdgcn_s_waitcnt(0);
        unsigned nloc = b.st[0], nx = b.st[1];
        if (nloc == 0u) { xcd_barrier_complete(bar, b.x, nloc, nx); b.st[0] = nloc; b.st[1] = nx; }
        const unsigned old = xb_add(&bar[XB_XSUB(b.x)], 1u);
        const unsigned gen = old / nloc;
        if (old + 1u == (gen + 1u) * nloc) {
            __builtin_amdgcn_fence(__ATOMIC_RELEASE, "agent");
            asm volatile("s_waitcnt vmcnt(0)" ::: "memory");
            const unsigned og = xb_add(&bar[XB_TOP], 1u);
            const unsigned tg = og / nx;
            if (og + 1u == (tg + 1u) * nx) xb_add(&bar[XB_TOPGEN], 1u);
            else XB_SPIN(xb_ld(&bar[XB_TOPGEN]) == tg, bar);
            __builtin_amdgcn_fence(__ATOMIC_ACQUIRE, "agent");
            xb_add(&bar[XB_XGEN(b.x)], 1u);
            asm volatile("s_waitcnt vmcnt(0)" ::: "memory");
        } else {
            XB_SPIN(xb_ld(&bar[XB_XGEN(b.x)]) == gen, bar);
            __builtin_amdgcn_fence(__ATOMIC_ACQUIRE, "agent");
            asm volatile("s_waitcnt vmcnt(0)" ::: "memory");
        }
    }
    __syncthreads();
}

struct Frame {
    LAS unsigned char* lds;
    int tid, lane, wave;
    int vcu, G;
    int gw, NGW;
    float* out; unsigned char* ws;
};
constexpr int PTR_OFF = LDSCTL_OFF + 512;
__device__ __forceinline__ const float* inp_(LAS unsigned char* lds, int i) {
    const unsigned long long v = *(const LAS unsigned long long*)(lds + PTR_OFF + 8 * i);
    const unsigned lo = __builtin_amdgcn_readfirstlane((unsigned)v), hi = __builtin_amdgcn_readfirstlane((unsigned)(v >> 32));
    return (const float*)(((unsigned long long)hi << 32) | lo);
}
#define INP(i) inp_(F.lds, (i))
#define WSP(T, off) ((T*)(F.ws + (off)))

__device__ __forceinline__ void gemv17_item(Frame& F, const LAS float* tab, LAS float* red, const float* W, int ldw, int n0, const float* bias, float* outp, int ldo, int n0out) {
    float acc[17];
#pragma unroll
    for (int r = 0; r < 17; ++r) acc[r] = 0.f;
    const int k0 = F.wave * 128;
    const float* wp = W + (size_t)k0 * ldw + n0 + F.lane;
#pragma unroll 1
    for (int kk = 0; kk < 128; kk += 32) {
        float wv[32];
#pragma unroll
        for (int k = 0; k < 32; ++k) wv[k] = wp[(size_t)(kk + k) * ldw];
#pragma unroll
        for (int k = 0; k < 32; ++k) {
#pragma unroll
            for (int r = 0; r < 17; ++r) acc[r] += tab[r * 1024 + k0 + kk + k] * wv[k];
        }
    }
#pragma unroll
    for (int r = 0; r < 17; ++r) red[(F.wave * 17 + r) * 64 + F.lane] = acc[r];
    __syncthreads();
    for (int i = F.tid; i < 17 * 64; i += NWAVES * 64) {
        const int r = i >> 6, n = i & 63; float s = bias ? bias[n0 + n] : 0.f;
#pragma unroll
        for (int w = 0; w < 8; ++w) s += red[(w * 17 + r) * 64 + n];
        outp[(size_t)r * ldo + n0out + n] = s;
    }
    __syncthreads();
}

__host__ __device__ __forceinline__ int glu_col(int o) { return o >= 512 ? o : ((o >> 7) & 1) * 256 + (o >> 8) * 128 + (o & 127); }
__device__ __forceinline__ void p0_transpose_item(const float* W, int K, int N, bf16* WT, LAS float* scr, int item, int lane, bool glu) {
    const int nblk = N / 32, kb = item / nblk, nb = item % nblk, k0 = 64 * kb, n0 = 32 * nb;
    const int n0o = glu ? glu_col(n0) : n0;
    float tv[32];
#pragma unroll
    for (int i = 0; i < 32; ++i) { const int kk = 2 * i + (lane >> 5); tv[i] = W[(size_t)(k0 + kk) * N + n0 + (lane & 31)]; }
#pragma unroll
    for (int i = 0; i < 32; ++i) { const int kk = 2 * i + (lane >> 5); scr[kk * 33 + (lane & 31)] = tv[i]; }
    LDS_WAIT(); asm volatile("" ::: "memory");
    const int c = lane & 7;
#pragma unroll
    for (int j = 0; j < 4; ++j) { const int n = (lane >> 3) + 8 * j; const LAS float* s = scr + (8 * c) * 33 + n;
        v4u o; o.x = pk2(s[0 * 33], s[1 * 33]); o.y = pk2(s[2 * 33], s[3 * 33]); o.z = pk2(s[4 * 33], s[5 * 33]); o.w = pk2(s[6 * 33], s[7 * 33]);
        *(GAS v4u*)(WT + (size_t)(n0o + n) * K + k0 + 8 * c) = o; }
    LDS_WAIT(); asm volatile("" ::: "memory");
}

__device__ __forceinline__ void weight_items(Frame& F, int first, int last, int widx, int nw) {
    LAS float* scr = (LAS float*)(F.lds + F.wave * 16384);
    constexpr int I_IN = (D / 64) * (IND / 32), I_OUT = (D / 64) * (D / 32), I_1 = (D / 64) * (FF / 32), I_2 = (FF / 64) * (D / 32), I_L = I_IN + I_OUT + I_1 + I_2;
    for (int it = first + widx; it < last; it += nw) {
        const int l = it / I_L; int r = it % I_L;
        const float* W; bf16* WT; int K = D, N; const bool glu = r < I_IN;
        if (r < I_IN) { W = INP(8) + (size_t)l * D * IND; WT = WSP(bf16, WS_WIN) + (size_t)l * IND * D; N = IND; }
        else if (r < I_IN + I_OUT) { r -= I_IN; W = INP(9) + (size_t)l * D * D; WT = WSP(bf16, WS_WOUT) + (size_t)l * D * D; N = D; }
        else if (r < I_IN + I_OUT + I_1) { r -= I_IN + I_OUT; W = INP(22) + (size_t)l * D * FF; WT = WSP(bf16, WS_W1) + (size_t)l * FF * D; N = FF; }
        else { r -= I_IN + I_OUT + I_1; W = INP(23) + (size_t)l * FF * D; WT = WSP(bf16, WS_W2) + (size_t)l * D * FF; K = FF; N = D; }
        p0_transpose_item(W, K, N, WT, scr, r, F.lane, glu);
    }
}
constexpr int W_ITEMS = 2 * ((D / 64) * (IND / 32) + (D / 64) * (D / 32) + (D / 64) * (FF / 32) + (FF / 64) * (D / 32));
constexpr int W_EARLY = 64 * NWAVES * 3;

__device__ __forceinline__ void phase_p0a(Frame& F) {
    LAS float* tab = (LAS float*)(F.lds);
    LAS float* red = (LAS float*)(F.lds + 17 * 1024 * 4);
    float* MOD = WSP(float, WS_MOD);
    bool filled = false;
    for (int it = F.vcu; it < 2 * 96; it += F.G) {
        if (!filled) {
            for (int i = F.tid; i < 17 * 1024; i += NWAVES * 64) { const int r = i >> 10, k = i & 1023; const float v = (r < 16) ? INP(1)[r * D + k] : INP(3)[k]; tab[i] = siluf_(v); }
            __syncthreads(); filled = true;
        }
        const int l = it / 96, n0 = (it % 96) * 64;
        gemv17_item(F, tab, red, INP(6) + (size_t)l * D * MODW, MODW, n0, INP(7) + (size_t)l * MODW, MOD + (size_t)l * 17 * MODW, MODW, n0);
    }
    if (F.G == 256 && F.vcu >= 192) weight_items(F, 0, W_EARLY, (F.vcu - 192) * NWAVES + F.wave, 64 * NWAVES);
}

__device__ __forceinline__ void phase_p0b(Frame& F) {
    LAS float* tab = (LAS float*)(F.lds);
    LAS float* red = (LAS float*)(F.lds + 17 * 1024 * 4);
    const float* MOD = WSP(const float, WS_MOD);
    for (int it = F.vcu; it < 2 * 104; it += F.G) {
        const int l = it / 104, j = it % 104; const bool first = j < 40;
        const int shoff = first ? 0 : 3 * D;
        __syncthreads();
        for (int i = F.tid; i < 17 * 1024; i += NWAVES * 64) { const int r = i >> 10, k = i & 1023; tab[i] = MOD[((size_t)l * 17 + r) * MODW + shoff + k]; }
        __syncthreads();
        const int ldw = first ? IND : FF;
        gemv17_item(F, tab, red, first ? INP(8) + (size_t)l * D * IND : INP(22) + (size_t)l * D * FF, ldw, (first ? j : j - 40) * 64, nullptr,
                    first ? WSP(float, WS_SHW1) + (size_t)l * 17 * IND : WSP(float, WS_SHW2) + (size_t)l * 17 * FF, ldw, first ? glu_col(j * 64) : (j - 40) * 64);
    }
    bf16* XA = WSP(bf16, WS_XA); float* RSSA = WSP(float, WS_RSSA);
    const float* g1 = INP(4);
    for (int row = F.gw; row < MT; row += 2 * F.NGW) {
        f32x4 v[2][4]; float ss[2]; int rw[2]; const float* scp[2];
#pragma unroll
        for (int q = 0; q < 2; ++q) { int r_ = row + q * F.NGW; if (r_ >= MT) r_ = row; rw[q] = r_;
            const bool lat = r_ < ML;
            const float* xr = lat ? INP(0) + (size_t)r_ * D : INP(2) + (size_t)(r_ - ML) * D;
            scp[q] = MOD + (size_t)(lat ? (r_ >> 11) : NB) * MODW + D;
#pragma unroll
            for (int j = 0; j < 4; ++j) v[q][j] = *(const f32x4*)(xr + 4 * F.lane + 256 * j); }
#pragma unroll
        for (int q = 0; q < 2; ++q) { float s_ = 0.f;
#pragma unroll
            for (int j = 0; j < 4; ++j) s_ += (v[q][j][0] * v[q][j][0] + v[q][j][1] * v[q][j][1]) + (v[q][j][2] * v[q][j][2] + v[q][j][3] * v[q][j][3]);
            ss[q] = wave_sum(s_); }
#pragma unroll
        for (int q = 0; q < 2; ++q) { if (q == 1 && rw[1] == row) break;
            if (F.lane < 32) RSSA[(size_t)rw[q] * 32 + F.lane] = (F.lane == 0) ? ss[q] : 0.f;
#pragma unroll
            for (int j = 0; j < 4; ++j) { const int k = 4 * F.lane + 256 * j;
                const f32x4 gm = *(const f32x4*)(g1 + k) * (*(const f32x4*)(scp[q] + k) + 1.0f), a = v[q][j] * gm;
                v2u o; o.x = pk2(a[0], a[1]); o.y = pk2(a[2], a[3]); *(v2u*)(XA + (size_t)rw[q] * D + k) = o; } }
    }
    __syncthreads();
    {
        bf16* WLR = WSP(bf16, WS_WLR);
        for (int i = F.gw * 64 + F.lane; i < 2 * 2 * 4 * 2 * 4096; i += F.NGW * 64) { const int d = i & 63, e = (i >> 6) & 63, gt = (i >> 12) & 1, blk = i >> 13;
            const float* src = gt == 0 ? INP(17) : INP(19); WLR[i] = (bf16)f2bf(src[((size_t)blk * 64 + d) * 64 + e]); }
    }
    weight_items(F, (F.G == 256) ? W_EARLY : 0, W_ITEMS, F.gw, F.NGW);
}

constexpr int CV_OSROW = 260;
__device__ __forceinline__ void conv_phase(Frame& F, int l, int ntiles) {
    const bf16* PROJ = WSP(const bf16, WS_PROJ); bf16* MIX = WSP(bf16, WS_MIX);
    LAS float* us = (LAS float*)(F.lds);
    LAS float* os = (LAS float*)(F.lds + 62 * 256 * 4);
    const int c = F.tid & 255, half = F.tid >> 8;
    float w[31];
#pragma unroll
    for (int k = 0; k < 31; ++k) w[k] = INP(10)[((size_t)l * 31 + k) * 256 + c];
    const float cbias = INP(11)[l * 256 + c];
    const f32x4 lg = *(const f32x4*)(INP(12) + l * 256 + 4 * F.lane), lb = *(const f32x4*)(INP(13) + l * 256 + 4 * F.lane);
    unsigned pv[16];
    auto load_tile = [&](int T) {
        const int row0 = T * 32;
        int lo, hi; if (row0 < ML) { lo = row0 & ~(SEQ - 1); hi = lo + SEQ; } else { lo = row0 & ~(CTXL - 1); hi = lo + CTXL; }
#pragma unroll
        for (int j = 0; j < 16; ++j) { const int i = F.tid + 512 * j, rr = i >> 7, cp = i & 127, row = row0 - 15 + rr;
            const bool ok = (j < 15 || F.tid < 256) && row >= lo && row < hi;
            pv[j] = ok ? *(const unsigned*)(PROJ + (size_t)row * IND + 2 * cp) : 0u; }
    };
    const int T0 = F.G - 1 - F.vcu;
    if (T0 < ntiles) load_tile(T0);
    for (int T = T0; T < ntiles; T += F.G) {
        const int row0 = T * 32;
        __syncthreads();
#pragma unroll
        for (int j = 0; j < 16; ++j) { const int i = F.tid + 512 * j;
            if (j < 15 || F.tid < 256) { f32x2 u; u[0] = bflo(pv[j]); u[1] = bfhi(pv[j]); *(LAS f32x2*)(us + 2 * i) = u; } }
        if (T + F.G < ntiles) load_tile(T + F.G);
        __syncthreads();
        {
            float acc[16];
#pragma unroll
            for (int j = 0; j < 16; ++j) acc[j] = cbias;
            const LAS float* up = us + (16 * half) * 256 + c;
#pragma unroll
            for (int i = 0; i < 46; ++i) { const float x = up[i * 256];
#pragma unroll
                for (int j = 0; j < 16; ++j) if (i - j >= 0 && i - j <= 30) acc[j] += w[i - j] * x; }
#pragma unroll
            for (int j = 0; j < 16; ++j) os[(16 * half + j) * CV_OSROW + c] = acc[j];
        }
        __syncthreads();
#pragma unroll
        for (int q = 0; q < 4; ++q) { const int t = 4 * F.wave + q;
            const f32x4 v = *(const LAS f32x4*)(os + t * CV_OSROW + 4 * F.lane);
            const float mu = wave_sum((v[0] + v[1]) + (v[2] + v[3])) * (1.f / 256.f);
            const f32x4 d = v - mu;
            const float var = wave_sum((d[0] * d[0] + d[1] * d[1]) + (d[2] * d[2] + d[3] * d[3])) * (1.f / 256.f);
            const f32x4 y = d * rsqrtf(var + EPS) * lg + lb;
            v2u o; o.x = pk2(siluf_(y[0]), siluf_(y[1])); o.y = pk2(siluf_(y[2]), siluf_(y[3]));
            *(v2u*)(MIX + (size_t)(row0 + t) * D + 4 * F.lane) = o; }
    }
}

typedef short s16x8 __attribute__((ext_vector_type(8)));
typedef short s16x4 __attribute__((ext_vector_type(4)));
constexpr int NA_KROW = 144, NA_VROW = 160;
constexpr int NA_STAGE = 64 * NA_KROW + 64 * NA_VROW, NA_SLOT = 2 * NA_STAGE, NA_OFF_TB = 2 * NA_SLOT;
static_assert(NA_OFF_TB + 2560 <= RING_BYTES, "NA LDS map");
constexpr int NA_ITEMS_LAT = NB * NH * 8, NA_ITEMS_CTX = NB * NH * 2;
struct NaBlk { f32x4 O[4]; float m, lsum; int first; };
__device__ __forceinline__ int na_rs(int r) { int v = r - 4; return v < 0 ? 0 : (v > 24 ? 24 : v); }
__device__ __forceinline__ s16x8 na_scale_q(v4u w, float c) {
    v4u o; o.x = pg8::cvt_pk_bf16(bflo(w.x) * c, bfhi(w.x) * c); o.y = pg8::cvt_pk_bf16(bflo(w.y) * c, bfhi(w.y) * c); o.z = pg8::cvt_pk_bf16(bflo(w.z) * c, bfhi(w.z) * c); o.w = pg8::cvt_pk_bf16(bflo(w.w) * c, bfhi(w.w) * c);
    return __builtin_bit_cast(s16x8, o);
}
__device__ __forceinline__ void na_phase(Frame& F, int l, int nitems, int nav = 0) {
    const bf16* PROJ = WSP(const bf16, WS_PROJ); bf16* MIX = WSP(bf16, WS_MIX);
    LAS float* tb = (LAS float*)(F.lds + NA_OFF_TB);
    const int lane = F.lane, q16 = lane & 15, g = lane >> 4;
    const unsigned skey = (unsigned)(F.tid >> 3), spart = (unsigned)(F.tid & 7);
    const float c1 = 0.125f * 1.4426950408889634f;
    for (int it = F.vcu; it < nitems; it += F.G) {
        const bool isctx = it >= NA_ITEMS_LAT;
        int b, h, ra = 0, jq = 0, qrow0, rsI = 0, nloc = 0;
        if (!isctx) { const int r4 = it & 7; h = (it >> 3) & 7; b = it >> 6; const int r0 = 4 * r4; ra = r0 + 2 * (F.wave >> 2); jq = F.wave & 3; qrow0 = b * SEQ + ra * 64 + jq * 16;
            rsI = na_rs(r0); nloc = na_rs(r0 + 3) + 8 - rsI; }
        else { const int j = it - NA_ITEMS_LAT; const int hf = j & 1; h = (j >> 1) & 7; b = j >> 4; qrow0 = ML + b * CTXL + hf * 128 + F.wave * 16; }
        const int nch = nloc + 4;
        const bf16* Pq = PROJ + 512 + h * HD, * Pk = PROJ + 1024 + h * HD + 8 * spart, * Pv = PROJ + 1536 + h * HD + 8 * spart;
        auto krow_of = [&](int ch) -> int { if (ch > nch - 1) ch = nch - 1; return ch < nloc ? b * SEQ + (rsI + ch) * 64 : ML + b * CTXL + (ch - nloc) * 64; };
        s16x8 qfA[2], qfB[2];
#pragma unroll
        for (int s_ = 0; s_ < 2; ++s_) { qfA[s_] = na_scale_q(*(const v4u*)(Pq + (size_t)(qrow0 + q16) * IND + 32 * s_ + 8 * g), c1);
            qfB[s_] = isctx ? qfA[s_] : na_scale_q(*(const v4u*)(Pq + (size_t)(qrow0 + 64 + q16) * IND + 32 * s_ + 8 * g), c1); }
        const int rsA = na_rs(ra), rsB = na_rs(ra + 1);
        const int o0 = jq == 0 ? 0 : 16 * jq - 8, o1 = jq == 0 ? 16 : (jq == 3 ? 48 : 16 * jq + 8);
        float madd[2][4]; int lb[2];
        {
            const int qc = jq * 16 + q16; int cs = qc - 8; cs = cs < 0 ? 0 : (cs > 48 ? 48 : cs);
#pragma unroll
            for (int e = 0; e < 4; ++e) { const int k0 = o0 + 4 * g + e, k1 = o1 + 4 * g + e;
                madd[0][e] = ((unsigned)(k0 - cs) < 16u) ? 0.f : -1.0e30f;
                madd[1][e] = (((unsigned)(k1 - cs) < 16u) && !(jq == 3 && k1 < 56)) ? 0.f : -1.0e30f; }
            lb[0] = 64 + o0 + 4 * g - qc + 15; lb[1] = 64 + o1 + 4 * g - qc + 15;
        }
        const int npair = (nch + 1) >> 1;
        v4u kr0 = *(const v4u*)(Pk + (size_t)(krow_of(0) + (int)skey) * IND), vr0 = *(const v4u*)(Pv + (size_t)(krow_of(0) + (int)skey) * IND);
        v4u kr1 = *(const v4u*)(Pk + (size_t)(krow_of(1) + (int)skey) * IND), vr1 = *(const v4u*)(Pv + (size_t)(krow_of(1) + (int)skey) * IND);
        __syncthreads();
        if (!isctx) { const float* rpb = INP(14) + ((size_t)l * NH + h) * 15 * 31;
            for (int i = F.tid; i < 640; i += NWAVES * 64) tb[i] = (i >= 64 && i < 64 + 465) ? rpb[i - 64] * 1.4426950408889634f : 0.f; }
        {
            LAS unsigned char* s0 = F.lds;
            *(LAS v4u*)(s0 + skey * NA_KROW + spart * 16) = kr0; *(LAS v4u*)(s0 + 64 * NA_KROW + skey * NA_VROW + spart * 16) = vr0;
            *(LAS v4u*)(s0 + NA_STAGE + skey * NA_KROW + spart * 16) = kr1; *(LAS v4u*)(s0 + NA_STAGE + 64 * NA_KROW + skey * NA_VROW + spart * 16) = vr1;
        }
        kr0 = *(const v4u*)(Pk + (size_t)(krow_of(2) + (int)skey) * IND); vr0 = *(const v4u*)(Pv + (size_t)(krow_of(2) + (int)skey) * IND);
        kr1 = *(const v4u*)(Pk + (size_t)(krow_of(3) + (int)skey) * IND); vr1 = *(const v4u*)(Pv + (size_t)(krow_of(3) + (int)skey) * IND);
        NaBlk A, B;
#pragma unroll
        for (int dt = 0; dt < 4; ++dt) { A.O[dt] = (f32x4){0.f, 0.f, 0.f, 0.f}; B.O[dt] = (f32x4){0.f, 0.f, 0.f, 0.f}; }
        A.m = 0.f; A.lsum = 0.f; A.first = 1; B.m = 0.f; B.lsum = 0.f; B.first = 1;
        for (int cp = 0; cp < npair; ++cp) {
            __syncthreads();
            if (cp + 1 < npair) { LAS unsigned char* nx = F.lds + ((cp + 1) & 1) * NA_SLOT;
                *(LAS v4u*)(nx + skey * NA_KROW + spart * 16) = kr0; *(LAS v4u*)(nx + 64 * NA_KROW + skey * NA_VROW + spart * 16) = vr0;
                *(LAS v4u*)(nx + NA_STAGE + skey * NA_KROW + spart * 16) = kr1; *(LAS v4u*)(nx + NA_STAGE + 64 * NA_KROW + skey * NA_VROW + spart * 16) = vr1; }
            if (cp + 2 < npair) { const int k2 = krow_of(2 * cp + 4) + (int)skey, k3 = krow_of(2 * cp + 5) + (int)skey;
                kr0 = *(const v4u*)(Pk + (size_t)k2 * IND); vr0 = *(const v4u*)(Pv + (size_t)k2 * IND); kr1 = *(const v4u*)(Pk + (size_t)k3 * IND); vr1 = *(const v4u*)(Pv + (size_t)k3 * IND); }
          for (int sub = 0; sub < 2; ++sub) {
            const int ch = 2 * cp + sub;
            if (ch >= nch) break;
            LAS unsigned char* cur = F.lds + (cp & 1) * NA_SLOT + sub * NA_STAGE;
            const bool local = ch < nloc;
            const int kr = rsI + ch;
            const bool actA = !local || (kr >= rsA && kr <= rsA + 7), actB = !isctx && (!local || (kr >= rsB && kr <= rsB + 7));
            if ((!actA && !actB) || nav == 1) continue;
            auto finish = [&](f32x4* S, int nt_, NaBlk& X, unsigned (*pk)[2], float cm) {
                if (X.first || !__all(cm <= 8.f)) {
                    cm = fmaxf(cm, __shfl_xor(cm, 16)); cm = fmaxf(cm, __shfl_xor(cm, 32));
                    const float d = X.first ? cm : fmaxf(cm, 0.f);
                    if (!X.first) { const float alpha = __builtin_amdgcn_exp2f(-d); X.lsum *= alpha;
#pragma unroll
                        for (int dt = 0; dt < 4; ++dt) X.O[dt] = X.O[dt] * alpha; }
                    X.m += d; X.first = 0;
#pragma unroll
                    for (int t = 0; t < 4; ++t) if (t < nt_) S[t] = S[t] - d;
                }
                float ps = 0.f;
#pragma unroll
                for (int t = 0; t < 4; ++t) if (t < nt_) {
                    const float p0 = __builtin_amdgcn_exp2f(S[t][0]), p1 = __builtin_amdgcn_exp2f(S[t][1]), p2 = __builtin_amdgcn_exp2f(S[t][2]), p3 = __builtin_amdgcn_exp2f(S[t][3]);
                    ps += (p0 + p1) + (p2 + p3);
                    pk[t][0] = pg8::cvt_pk_bf16(p0, p1); pk[t][1] = pg8::cvt_pk_bf16(p2, p3); }
                X.lsum += ps;
            };
            unsigned pkA[4][2], pkB[4][2];
            if (local) {
                const LAS unsigned char* kb_ = cur + q16 * NA_KROW + 16 * g;
                f32x4 SA[2], SB[2];
#pragma unroll
                for (int t = 0; t < 2; ++t) { const float ma = -A.m, mb = -B.m; SA[t] = (f32x4){ma, ma, ma, ma}; SB[t] = (f32x4){mb, mb, mb, mb};
                    const int o = t == 0 ? o0 : o1;
#pragma unroll
                    for (int s_ = 0; s_ < 2; ++s_) { const s16x8 kf = *(const LAS s16x8*)(kb_ + o * NA_KROW + 64 * s_);
                        if (actA) SA[t] = __builtin_amdgcn_mfma_f32_16x16x32_bf16(kf, qfA[s_], SA[t], 0, 0, 0);
                        if (actB) SB[t] = __builtin_amdgcn_mfma_f32_16x16x32_bf16(kf, qfB[s_], SB[t], 0, 0, 0); } }
                if (nav == 2) { asm volatile("" :: "v"(SA[0]), "v"(SA[1]), "v"(SB[0]), "v"(SB[1])); continue; }
                auto soft_local = [&](f32x4 (&S)[2], NaBlk& X, unsigned (&pk)[4][2], int rq) {
                    float cm = -1.0e30f;
#pragma unroll
                    for (int t = 0; t < 2; ++t) { const LAS float* tr_ = tb + (kr - rq + 7) * 31 + lb[t];
#pragma unroll
                        for (int e = 0; e < 4; ++e) { const float v = (S[t][e] + tr_[e]) + madd[t][e]; S[t][e] = v; cm = fmaxf(cm, v); } }
                    finish(S, 2, X, pk, cm);
                };
                if (actA) soft_local(SA, A, pkA, ra);
                if (actB) soft_local(SB, B, pkB, ra + 1);
                if (nav == 3) { asm volatile("" :: "v"(pkA[0][0]), "v"(pkA[1][1]), "v"(pkB[0][0]), "v"(pkB[1][1])); continue; }
                const LAS unsigned char* vtr = cur + 64 * NA_KROW + (4 * g + (q16 >> 2)) * NA_VROW + (q16 & 3) * 8;
                const v4u bwA = {pkA[0][0], pkA[0][1], pkA[1][0], pkA[1][1]}, bwB = {pkB[0][0], pkB[0][1], pkB[1][0], pkB[1][1]};
                const s16x8 bfA = __builtin_bit_cast(s16x8, bwA), bfB = __builtin_bit_cast(s16x8, bwB);
#pragma unroll
                for (int dt = 0; dt < 4; ++dt) {
                    const s16x4 a0 = __builtin_amdgcn_ds_read_tr16_b64_v4i16((LAS s16x4*)(vtr + o0 * NA_VROW + dt * 32));
                    const s16x4 a1 = __builtin_amdgcn_ds_read_tr16_b64_v4i16((LAS s16x4*)(vtr + o1 * NA_VROW + dt * 32));
                    const s16x8 afrag = __builtin_shufflevector(a0, a1, 0, 1, 2, 3, 4, 5, 6, 7);
                    if (actA) A.O[dt] = __builtin_amdgcn_mfma_f32_16x16x32_bf16(afrag, bfA, A.O[dt], 0, 0, 0);
                    if (actB) B.O[dt] = __builtin_amdgcn_mfma_f32_16x16x32_bf16(afrag, bfB, B.O[dt], 0, 0, 0);
                }
            } else {
                const LAS unsigned char* kb_ = cur + q16 * NA_KROW + 16 * g;
                f32x4 SA[4], SB[4];
#pragma unroll
                for (int t = 0; t < 4; ++t) { const float ma = -A.m, mb = -B.m; SA[t] = (f32x4){ma, ma, ma, ma}; SB[t] = (f32x4){mb, mb, mb, mb};
#pragma unroll
                    for (int s_ = 0; s_ < 2; ++s_) { const s16x8 kf = *(const LAS s16x8*)(kb_ + t * 16 * NA_KROW + 64 * s_);
                        SA[t] = __builtin_amdgcn_mfma_f32_16x16x32_bf16(kf, qfA[s_], SA[t], 0, 0, 0);
                        if (actB) SB[t] = __builtin_amdgcn_mfma_f32_16x16x32_bf16(kf, qfB[s_], SB[t], 0, 0, 0); } }
                if (nav == 2) { asm volatile("" :: "v"(SA[0]), "v"(SA[1]), "v"(SA[2]), "v"(SA[3]), "v"(SB[0]), "v"(SB[1]), "v"(SB[2]), "v"(SB[3])); continue; }
                auto soft_ctx = [&](f32x4 (&S)[4], NaBlk& X, unsigned (&pk)[4][2]) {
                    float cm = -1.0e30f;
#pragma unroll
                    for (int t = 0; t < 4; ++t)
#pragma unroll
                        for (int e = 0; e < 4; ++e) cm = fmaxf(cm, S[t][e]);
                    finish(S, 4, X, pk, cm);
                };
                soft_ctx(SA, A, pkA);
                if (actB) soft_ctx(SB, B, pkB);
                if (nav == 3) { asm volatile("" :: "v"(pkA[0][0]), "v"(pkA[1][1]), "v"(pkA[2][0]), "v"(pkA[3][1]), "v"(pkB[0][0]), "v"(pkB[1][1]), "v"(pkB[2][0]), "v"(pkB[3][1])); continue; }
                const LAS unsigned char* vtr = cur + 64 * NA_KROW + (4 * g + (q16 >> 2)) * NA_VROW + (q16 & 3) * 8;
#pragma unroll
                for (int p = 0; p < 2; ++p) {
                    const v4u bwA = {pkA[2 * p][0], pkA[2 * p][1], pkA[2 * p + 1][0], pkA[2 * p + 1][1]}, bwB = {pkB[2 * p][0], pkB[2 * p][1], pkB[2 * p + 1][0], pkB[2 * p + 1][1]};
                    const s16x8 bfA = __builtin_bit_cast(s16x8, bwA), bfB = __builtin_bit_cast(s16x8, bwB);
#pragma unroll
                    for (int dt = 0; dt < 4; ++dt) {
                        const s16x4 a0 = __builtin_amdgcn_ds_read_tr16_b64_v4i16((LAS s16x4*)(vtr + (2 * p) * 16 * NA_VROW + dt * 32));
                        const s16x4 a1 = __builtin_amdgcn_ds_read_tr16_b64_v4i16((LAS s16x4*)(vtr + (2 * p + 1) * 16 * NA_VROW + dt * 32));
                        const s16x8 afrag = __builtin_shufflevector(a0, a1, 0, 1, 2, 3, 4, 5, 6, 7);
                        A.O[dt] = __builtin_amdgcn_mfma_f32_16x16x32_bf16(afrag, bfA, A.O[dt], 0, 0, 0);
                        if (actB) B.O[dt] = __builtin_amdgcn_mfma_f32_16x16x32_bf16(afrag, bfB, B.O[dt], 0, 0, 0);
                    }
                }
            }
          }
        }
        {
            float ls = A.lsum; ls += __shfl_xor(ls, 16); ls += __shfl_xor(ls, 32);
            const float inv = __builtin_amdgcn_rcpf(ls);
            bf16* op = MIX + (size_t)(qrow0 + q16) * D + 256 + h * HD + 4 * g;
#pragma unroll
            for (int dt = 0; dt < 4; ++dt) { v2u w; w.x = pg8::cvt_pk_bf16(A.O[dt][0] * inv, A.O[dt][1] * inv); w.y = pg8::cvt_pk_bf16(A.O[dt][2] * inv, A.O[dt][3] * inv); *(v2u*)(op + 16 * dt) = w; }
        }
        if (!isctx) {
            float ls = B.lsum; ls += __shfl_xor(ls, 16); ls += __shfl_xor(ls, 32);
            const float inv = __builtin_amdgcn_rcpf(ls);
            bf16* op = MIX + (size_t)(qrow0 + 64 + q16) * D + 256 + h * HD + 4 * g;
#pragma unroll
            for (int dt = 0; dt < 4; ++dt) { v2u w; w.x = pg8::cvt_pk_bf16(B.O[dt][0] * inv, B.O[dt][1] * inv); w.y = pg8::cvt_pk_bf16(B.O[dt][2] * inv, B.O[dt][3] * inv); *(v2u*)(op + 16 * dt) = w; }
        }
    }
}

constexpr int LRU_UCROW = 260;
constexpr int LRU_OFF_UC = 38 * 256 * 2, LRU_OFF_GT = LRU_OFF_UC + 2 * 32 * LRU_UCROW * 4;
static_assert(LRU_OFF_GT + 32 * 256 * 2 <= RING_BYTES, "LRU LDS map");
template <int PASS>
__device__ __forceinline__ void lru_phase(Frame& F, int l, int ntiles) {
    const bf16* PROJ = WSP(const bf16, WS_PROJ);
    LAS bf16* rxs = (LAS bf16*)(F.lds);
    LAS float* ucf = (LAS float*)(F.lds + LRU_OFF_UC);
    LAS bf16* gts = (LAS bf16*)(F.lds + LRU_OFF_GT);
    const int lane = F.lane, j16 = lane & 15, g = lane >> 4;
    const int kb = F.wave & 3, nh = F.wave >> 2;
    s16x8 wf[2][2][2][2];
    float cbx[2][2], cba[2][2], csp[2][2];
#pragma unroll
    for (int dir = 0; dir < 2; ++dir) {
        const int ld = l * 2 + dir;
        const bf16* WLR = WSP(const bf16, WS_WLR) + (size_t)((ld * 4 + kb) * 2) * 4096;
#pragma unroll
        for (int gt = 0; gt < 2; ++gt)
#pragma unroll
            for (int n2 = 0; n2 < 2; ++n2)
#pragma unroll
                for (int s_ = 0; s_ < 2; ++s_) wf[dir][gt][n2][s_] = *(const s16x8*)(WLR + gt * 4096 + (16 * (2 * nh + n2) + j16) * 64 + 32 * s_ + 8 * g);
#pragma unroll
        for (int n2 = 0; n2 < 2; ++n2) {
            const int e = kb * 64 + 16 * (2 * nh + n2) + j16, idx = ld * 256 + e;
            cbx[dir][n2] = INP(18)[idx]; cba[dir][n2] = INP(20)[idx];
            const float nl = -INP(21)[idx]; csp[dir][n2] = -8.f * (fmaxf(nl, 0.f) + log1pf(__expf(-fabsf(nl))));
        }
    }
    const int c = F.tid & 255, sdir = F.tid >> 8;
    const int sld = l * 2 + sdir;
    const float s1w0 = INP(15)[(sld * 4 + 0) * 256 + c], s1w1 = INP(15)[(sld * 4 + 1) * 256 + c], s1w2 = INP(15)[(sld * 4 + 2) * 256 + c], s1w3 = INP(15)[(sld * 4 + 3) * 256 + c], s1cb = INP(16)[sld * 256 + c];
    const int base = sdir == 0 ? 0 : 3;
    unsigned pre[10], pgw[8];
    auto load_tile = [&](int T) {
        const int row0 = T * 32;
        int lo, hi; if (row0 < ML) { lo = row0 & ~(SEQ - 1); hi = lo + SEQ; } else { lo = row0 & ~(CTXL - 1); hi = lo + CTXL; }
#pragma unroll
        for (int j = 0; j < 10; ++j) { const int i = F.tid + 512 * j, rr = i >> 7, cp = i & 127, row = row0 - 3 + rr;
            const bool ok = (j < 9 || F.tid < 256) && row >= lo && row < hi;
            pre[j] = ok ? *(const unsigned*)(PROJ + (size_t)row * IND + 2048 + 2 * cp) : 0u; }
        if (PASS == 1) {
#pragma unroll
            for (int j = 0; j < 8; ++j) { const int i = F.tid + 512 * j, t = i >> 7, cp = i & 127; pgw[j] = *(const unsigned*)(PROJ + (size_t)(row0 + t) * IND + 2304 + 2 * cp); }
        }
    };
    if (F.vcu < ntiles) load_tile(F.vcu);
    for (int T = F.vcu; T < ntiles; T += F.G) {
        const int row0 = T * 32;
        __syncthreads();
#pragma unroll
        for (int j = 0; j < 10; ++j) { const int i = F.tid + 512 * j; if (j < 9 || F.tid < 256) ((LAS unsigned*)rxs)[i] = pre[j]; }
        if (PASS == 1) {
#pragma unroll
            for (int j = 0; j < 8; ++j) ((LAS unsigned*)gts)[F.tid + 512 * j] = pgw[j];
        }
        if (T + F.G < ntiles) load_tile(T + F.G);
        float hst[2][2];
#pragma unroll
        for (int dir = 0; dir < 2; ++dir)
#pragma unroll
            for (int n2 = 0; n2 < 2; ++n2) hst[dir][n2] = PASS == 1 ? WSP(const float, WS_CARRY)[((size_t)dir * 1152 + T) * 256 + kb * 64 + 16 * (2 * nh + n2) + j16] : 0.f;
        __syncthreads();
        {
            float x0 = bf1(rxs[(base + 0) * 256 + c]), x1 = bf1(rxs[(base + 1) * 256 + c]), x2 = bf1(rxs[(base + 2) * 256 + c]);
#pragma unroll 8
            for (int t = 0; t < 32; ++t) {
                const float x3 = bf1(rxs[(t + base + 3) * 256 + c]);
                ucf[(sdir * 32 + t) * LRU_UCROW + c] = s1cb + s1w0 * x0 + s1w1 * x1 + s1w2 * x2 + s1w3 * x3;
                x0 = x1; x1 = x2; x2 = x3;
            }
        }
        __syncthreads();
        float hf[2][2][4];
        float Pt[2][2] = {{1.f, 1.f}, {1.f, 1.f}};
#pragma unroll
        for (int dir = 0; dir < 2; ++dir) {
            const bool sec16 = ((g & 1) != 0) != (dir != 0), sec32 = ((g >> 1) != 0) != (dir != 0);
#pragma unroll
            for (int step = 0; step < 2; ++step) {
                const int rt = dir == 0 ? step : 1 - step;
                s16x8 af[2];
#pragma unroll
                for (int s_ = 0; s_ < 2; ++s_) { const LAS float* up = ucf + (dir * 32 + 16 * rt + j16) * LRU_UCROW + kb * 64 + 32 * s_ + 8 * g;
                    const f32x4 u0 = *(const LAS f32x4*)up, u1 = *(const LAS f32x4*)(up + 4);
                    const v4u w = {pg8::cvt_pk_bf16(u0[0], u0[1]), pg8::cvt_pk_bf16(u0[2], u0[3]), pg8::cvt_pk_bf16(u1[0], u1[1]), pg8::cvt_pk_bf16(u1[2], u1[3])};
                    af[s_] = __builtin_bit_cast(s16x8, w); }
#pragma unroll
                for (int n2 = 0; n2 < 2; ++n2) {
                    f32x4 zx = {0.f, 0.f, 0.f, 0.f}, za = {0.f, 0.f, 0.f, 0.f};
#pragma unroll
                    for (int s_ = 0; s_ < 2; ++s_) { zx = __builtin_amdgcn_mfma_f32_16x16x32_bf16(af[s_], wf[dir][0][n2][s_], zx, 0, 0, 0); za = __builtin_amdgcn_mfma_f32_16x16x32_bf16(af[s_], wf[dir][1][n2][s_], za, 0, 0, 0); }
                    const int e = kb * 64 + 16 * (2 * nh + n2) + j16;
                    const LAS float* uo = ucf + (dir * 32 + 16 * rt + 4 * g) * LRU_UCROW + e;
                    float a_[4], b_[4]; unsigned abw[4];
#pragma unroll
                    for (int r = 0; r < 4; ++r) {
                        const float u = uo[r * LRU_UCROW];
                        const float gx = sigmoidf_(zx[r] + cbx[dir][n2]), ga = sigmoidf_(za[r] + cba[dir][n2]);
                        const float la = csp[dir][n2] * ga, a = __builtin_amdgcn_exp2f(1.4426950408889634f * la), y = 2.f * la;
                        const float om = y > -0.02f ? -y * (1.f + y * (0.5f + y * 0.16666667f)) : 1.f - a * a;
                        a_[r] = a; b_[r] = __builtin_amdgcn_sqrtf(om) * gx * u;
                        if (PASS == 0) {
                            const float oma = la > -0.02f ? -la * (1.f + la * (0.5f + la * 0.16666667f)) : 1.f - a;
                            abw[r] = pg8::cvt_pk_bf16(oma, b_[r]); a_[r] = 1.f - bflo(abw[r]); b_[r] = bfhi(abw[r]);
                        }
                    }
                    if (PASS == 0) WSP(v4u, WS_AB)[(((((size_t)T * 2 + dir) * 2 + rt) * 8 + F.wave) * 2 + n2) * 64 + lane] = (v4u){abw[0], abw[1], abw[2], abw[3]};
                    const float P = (a_[0] * a_[1]) * (a_[2] * a_[3]);
                    const float S = dir == 0 ? ((b_[0] * a_[1] + b_[1]) * a_[2] + b_[2]) * a_[3] + b_[3] : ((b_[3] * a_[2] + b_[2]) * a_[1] + b_[1]) * a_[0] + b_[0];
                    const float Pp = __shfl_xor(P, 16), Sp = __shfl_xor(S, 16);
                    const float e1P = sec16 ? Pp : 1.f, e1S = sec16 ? Sp : 0.f;
                    const float prP = P * Pp, prS = sec16 ? P * Sp + S : Pp * S + Sp;
                    const float Pq = __shfl_xor(prP, 32), Sq = __shfl_xor(prS, 32);
                    const float EP = sec32 ? Pq * e1P : e1P, ES = sec32 ? e1P * Sq + e1S : e1S;
                    const float TP = prP * Pq, TS = sec32 ? prP * Sq + prS : Pq * prS + Sq;
                    if (PASS == 1) {
                        float h = EP * hst[dir][n2] + ES;
                        if (dir == 0) {
#pragma unroll
                            for (int r = 0; r < 4; ++r) { h = a_[r] * h + b_[r]; hf[rt][n2][r] = h; }
                        } else {
                            float hb[4];
#pragma unroll
                            for (int r = 3; r >= 0; --r) { h = a_[r] * h + b_[r]; hb[r] = h; }
                            bf16* mp = WSP(bf16, WS_MIX) + (size_t)(row0 + 16 * rt + 4 * g) * D + 768 + e;
                            const LAS bf16* gp = gts + (16 * rt + 4 * g) * 256 + e;
#pragma unroll
                            for (int r = 0; r < 4; ++r) mp[(size_t)r * D] = (bf16)f2bf(gelu_tanh(bf1(gp[r * 256])) * (hf[rt][n2][r] + hb[r]));
                        }
                    } else Pt[dir][n2] *= TP;
                    hst[dir][n2] = TP * hst[dir][n2] + TS;
                }
            }
        }
        if (PASS == 0 && g == 0) {
#pragma unroll
            for (int dir = 0; dir < 2; ++dir)
#pragma unroll
                for (int n2 = 0; n2 < 2; ++n2) WSP(f32x2, WS_TOT)[((size_t)dir * 1152 + T) * 256 + kb * 64 + 16 * (2 * nh + n2) + j16] = (f32x2){Pt[dir][n2], hst[dir][n2]};
        }
    }
}
__device__ __forceinline__ void lru_scan_phase(Frame& F, int l, int ntiles) {
    const bf16* PROJ = WSP(const bf16, WS_PROJ);
    LAS bf16* gts = (LAS bf16*)(F.lds);
    const int lane = F.lane, j16 = lane & 15, g = lane >> 4;
    const int kb = F.wave & 3, nh = F.wave >> 2;
    const v4u* AB = WSP(const v4u, WS_AB);
    v4u pab[2][2][2]; unsigned pgw[8];
    auto load_tile = [&](int T) {
#pragma unroll
        for (int dir = 0; dir < 2; ++dir)
#pragma unroll
            for (int rt = 0; rt < 2; ++rt)
#pragma unroll
                for (int n2 = 0; n2 < 2; ++n2) pab[dir][rt][n2] = AB[(((((size_t)T * 2 + dir) * 2 + rt) * 8 + F.wave) * 2 + n2) * 64 + lane];
#pragma unroll
        for (int j = 0; j < 8; ++j) { const int i = F.tid + 512 * j, t = i >> 7, cp = i & 127; pgw[j] = *(const unsigned*)(PROJ + (size_t)(T * 32 + t) * IND + 2304 + 2 * cp); }
    };
    if (F.vcu < ntiles) load_tile(F.vcu);
    for (int T = F.vcu; T < ntiles; T += F.G) {
        const int row0 = T * 32;
        __syncthreads();
#pragma unroll
        for (int j = 0; j < 8; ++j) ((LAS unsigned*)gts)[F.tid + 512 * j] = pgw[j];
        v4u cur[2][2][2];
#pragma unroll
        for (int dir = 0; dir < 2; ++dir)
#pragma unroll
            for (int rt = 0; rt < 2; ++rt)
#pragma unroll
                for (int n2 = 0; n2 < 2; ++n2) cur[dir][rt][n2] = pab[dir][rt][n2];
        float hst[2][2];
#pragma unroll
        for (int dir = 0; dir < 2; ++dir)
#pragma unroll
            for (int n2 = 0; n2 < 2; ++n2) hst[dir][n2] = WSP(const float, WS_CARRY)[((size_t)dir * 1152 + T) * 256 + kb * 64 + 16 * (2 * nh + n2) + j16];
        if (T + F.G < ntiles) load_tile(T + F.G);
        __syncthreads();
        float hf[2][2][4];
#pragma unroll
        for (int dir = 0; dir < 2; ++dir) {
            const bool sec16 = ((g & 1) != 0) != (dir != 0), sec32 = ((g >> 1) != 0) != (dir != 0);
#pragma unroll
            for (int step = 0; step < 2; ++step) {
                const int rt = dir == 0 ? step : 1 - step;
#pragma unroll
                for (int n2 = 0; n2 < 2; ++n2) {
                    const int e = kb * 64 + 16 * (2 * nh + n2) + j16;
                    const v4u w = cur[dir][rt][n2];
                    const float a_[4] = {1.f - bflo(w.x), 1.f - bflo(w.y), 1.f - bflo(w.z), 1.f - bflo(w.w)}, b_[4] = {bfhi(w.x), bfhi(w.y), bfhi(w.z), bfhi(w.w)};
                    const float P = (a_[0] * a_[1]) * (a_[2] * a_[3]);
                    const float S = dir == 0 ? ((b_[0] * a_[1] + b_[1]) * a_[2] + b_[2]) * a_[3] + b_[3] : ((b_[3] * a_[2] + b_[2]) * a_[1] + b_[1]) * a_[0] + b_[0];
                    const float Pp = __shfl_xor(P, 16), Sp = __shfl_xor(S, 16);
                    const float e1P = sec16 ? Pp : 1.f, e1S = sec16 ? Sp : 0.f;
                    const float prP = P * Pp, prS = sec16 ? P * Sp + S : Pp * S + Sp;
                    const float Pq = __shfl_xor(prP, 32), Sq = __shfl_xor(prS, 32);
                    const float EP = sec32 ? Pq * e1P : e1P, ES = sec32 ? e1P * Sq + e1S : e1S;
                    const float TP = prP * Pq, TS = sec32 ? prP * Sq + prS : Pq * prS + Sq;
                    float h = EP * hst[dir][n2] + ES;
                    if (dir == 0) {
#pragma unroll
                        for (int r = 0; r < 4; ++r) { h = a_[r] * h + b_[r]; hf[rt][n2][r] = h; }
                    } else {
                        float hb[4];
#pragma unroll
                        for (int r = 3; r >= 0; --r) { h = a_[r] * h + b_[r]; hb[r] = h; }
                        bf16* mp = WSP(bf16, WS_MIX) + (size_t)(row0 + 16 * rt + 4 * g) * D + 768 + e;
                        const LAS bf16* gp = gts + (16 * rt + 4 * g) * 256 + e;
#pragma unroll
                        for (int r = 0; r < 4; ++r) mp[(size_t)r * D] = (bf16)f2bf(gelu_tanh(bf1(gp[r * 256])) * (hf[rt][n2][r] + hb[r]));
                    }
                    hst[dir][n2] = TP * hst[dir][n2] + TS;
                }
            }
        }
    }
}

__device__ __forceinline__ void lru_carry(Frame& F) {
    const f32x2* TOT = WSP(const f32x2, WS_TOT); float* CARRY = WSP(float, WS_CARRY);
    for (int it = F.gw; it < NB * 2 * 4; it += F.NGW) {
        const int b = it >> 3, dir = (it >> 2) & 1, c = (it & 3) * 64 + F.lane;
        float h = 0.f;
        for (int g = 0; g < 18; ++g) {
            f32x2 ps[4]; int tl[4];
#pragma unroll
            for (int i = 0; i < 4; ++i) { const int s = g * 4 + i;
                int T; if (s < 8) T = 1024 + b * 8 + (dir == 0 ? s : 7 - s); else T = b * 64 + (dir == 0 ? s - 8 : 71 - s);
                tl[i] = T; ps[i] = TOT[((size_t)dir * 1152 + T) * 256 + c]; }
#pragma unroll
            for (int i = 0; i < 4; ++i) { CARRY[((size_t)dir * 1152 + tl[i]) * 256 + c] = h; h = ps[i][0] * h + ps[i][1]; }
        }
    }
}

__device__ __forceinline__ void ctx_finalize(Frame& F, int l) {
    bf16* XA = WSP(bf16, WS_XA); float* RSSA = WSP(float, WS_RSSA); const float* ACC = WSP(const float, WS_PART); const float* MOD = WSP(const float, WS_MOD);
    const float* go = INP(5) + (l - 1) * D; const float* gso = MOD + ((size_t)(l - 1) * 17 + NB) * MODW + 4 * D;
    const float* gn = INP(4) + l * D; const float* gsn = MOD + ((size_t)l * 17 + NB) * MODW + D;
    for (int r = F.gw; r < MC; r += F.NGW) {
        const size_t row = (size_t)ML + r;
        float ss = 0.f; f32x4 y[4];
#pragma unroll
        for (int j = 0; j < 4; ++j) { const int k = 4 * F.lane + 256 * j;
            const v2u w = *(const v2u*)(XA + row * D + k);
            const f32x4 im = *(const f32x4*)(go + k) * (*(const f32x4*)(gso + k) + 1.0f);
            const f32x4 xo = (f32x4){bflo(w.x) * __builtin_amdgcn_rcpf(im[0]), bfhi(w.x) * __builtin_amdgcn_rcpf(im[1]), bflo(w.y) * __builtin_amdgcn_rcpf(im[2]), bfhi(w.y) * __builtin_amdgcn_rcpf(im[3])};
            const float* ap = ACC + (size_t)r * D + k;
            y[j] = xo + ((*(const f32x4*)ap + *(const f32x4*)(ap + (size_t)MC * D)) + (*(const f32x4*)(ap + (size_t)2 * MC * D) + *(const f32x4*)(ap + (size_t)3 * MC * D)));
            ss += (y[j][0] * y[j][0] + y[j][1] * y[j][1]) + (y[j][2] * y[j][2] + y[j][3] * y[j][3]); }
        ss = wave_sum(ss);
        if (F.lane < 32) RSSA[row * 32 + F.lane] = (F.lane == 0) ? ss : 0.f;
#pragma unroll
        for (int j = 0; j < 4; ++j) { const int k = 4 * F.lane + 256 * j;
            const f32x4 a = y[j] * (*(const f32x4*)(gn + k) * (*(const f32x4*)(gsn + k) + 1.0f));
            v2u o; o.x = pk2(a[0], a[1]); o.y = pk2(a[2], a[3]); *(v2u*)(XA + row * D + k) = o; }
    }
}

__device__ __forceinline__ void final_rows(Frame& F) {
    const bf16* XA = WSP(const bf16, WS_XA); const float* RSS = WSP(const float, WS_RSSA);
    for (int row = F.gw; row < ML; row += 2 * F.NGW) {
        const int row2 = row + F.NGW; const bool two = row2 < ML;
        const v4u a0 = *(const v4u*)(XA + (size_t)row * D + 8 * F.lane), a1 = *(const v4u*)(XA + (size_t)row * D + 512 + 8 * F.lane);
        const float p0 = F.lane < 32 ? RSS[(size_t)row * 32 + F.lane] : 0.f;
        v4u b0 = a0, b1 = a1; float p1 = 0.f;
        if (two) { b0 = *(const v4u*)(XA + (size_t)row2 * D + 8 * F.lane); b1 = *(const v4u*)(XA + (size_t)row2 * D + 512 + 8 * F.lane); p1 = F.lane < 32 ? RSS[(size_t)row2 * 32 + F.lane] : 0.f; }
        const float rs0 = rsqrtf(wave_sum(p0) * (1.f / D) + EPS), rs1 = rsqrtf(wave_sum(p1) * (1.f / D) + EPS);
        float* o = F.out + (size_t)row * D + 8 * F.lane;
        *(f32x4*)(o) = (f32x4){bflo(a0.x), bfhi(a0.x), bflo(a0.y), bfhi(a0.y)} * rs0; *(f32x4*)(o + 4) = (f32x4){bflo(a0.z), bfhi(a0.z), bflo(a0.w), bfhi(a0.w)} * rs0;
        *(f32x4*)(o + 512) = (f32x4){bflo(a1.x), bfhi(a1.x), bflo(a1.y), bfhi(a1.y)} * rs0; *(f32x4*)(o + 516) = (f32x4){bflo(a1.z), bfhi(a1.z), bflo(a1.w), bfhi(a1.w)} * rs0;
        if (two) { float* o2 = F.out + (size_t)row2 * D + 8 * F.lane;
            *(f32x4*)(o2) = (f32x4){bflo(b0.x), bfhi(b0.x), bflo(b0.y), bfhi(b0.y)} * rs1; *(f32x4*)(o2 + 4) = (f32x4){bflo(b0.z), bfhi(b0.z), bflo(b0.w), bfhi(b0.w)} * rs1;
            *(f32x4*)(o2 + 512) = (f32x4){bflo(b1.x), bfhi(b1.x), bflo(b1.y), bfhi(b1.y)} * rs1; *(f32x4*)(o2 + 516) = (f32x4){bflo(b1.z), bfhi(b1.z), bflo(b1.w), bfhi(b1.w)} * rs1; }
    }
}

constexpr int N_PHASES = 2 + 7 * DEPTH + 1;
struct Args { const float* in[25]; float* out; unsigned char* ws; int ph_lo, ph_hi; };
static_assert(sizeof(Args) == 27 * 8 + 8, "Args has no padding");

__global__ void __launch_bounds__(NWAVES * 64, 2) mega_fwd(Args args) {
    extern __shared__ __attribute__((aligned(16))) unsigned char lds[];
    Frame F;
    F.lds = (LAS unsigned char*)lds;
    const int wave_s = __builtin_amdgcn_readfirstlane((int)threadIdx.x >> 6);
    F.wave = wave_s; F.lane = (int)__builtin_amdgcn_mbcnt_hi(~0u, __builtin_amdgcn_mbcnt_lo(~0u, 0u)); F.tid = wave_s * 64 + F.lane;
    F.G = gridDim.x; { const int bx = blockIdx.x; F.vcu = (F.G % 8 == 0) ? (bx % 8) * (F.G / 8) + bx / 8 : bx; }
    F.gw = F.vcu * NWAVES + F.wave; F.NGW = F.G * NWAVES;
    F.out = args.out; F.ws = args.ws;
    volatile LAS unsigned* MISC = (volatile LAS unsigned*)(F.lds + MISC_OFF);
    for (int u = F.tid; u < (LDS_BYTES - LDSCTL_OFF) / 4; u += NWAVES * 64) ((LAS unsigned*)(F.lds + LDSCTL_OFF))[u] = 0u;
    __syncthreads();
    if (F.tid == 0) {
#pragma unroll
        for (int i = 0; i < 25; ++i) *(LAS unsigned long long*)(F.lds + PTR_OFF + 8 * i) = (unsigned long long)args.in[i];
    }
    __syncthreads();
    XcdBarrier bar = xcd_barrier_post((unsigned*)(F.ws + WS_CTL) + CW_BAR, MISC + 8, F.tid);

    const int lo = args.ph_lo, hi = args.ph_hi;
#ifdef PROBE_MASK
    bool rep_done = false;
#define PROBE_V ((((PROBE_MASK >> ph) & 1) && !rep_done) ? PROBE_VARIANT : 0)
#else
#define PROBE_V 0
#endif
    for (int ph = lo; ph < hi; ++ph) {
        { unsigned ones_ = ~0u; asm volatile("" : "+s"(ones_));
          int t_ = wave_s * 64 + (int)__builtin_amdgcn_mbcnt_hi(ones_, __builtin_amdgcn_mbcnt_lo(ones_, 0u)); asm volatile("" : "+v"(t_)); F.tid = t_; F.lane = t_ & 63; F.wave = __builtin_amdgcn_readfirstlane(t_ >> 6); F.gw = F.vcu * NWAVES + F.wave; }
        if (ph == 0) {
#ifndef NO_P0
            phase_p0a(F);
#endif
        } else if (ph == 1) {
#ifndef NO_P0
            phase_p0b(F);
#endif
        }
        else if (ph == N_PHASES - 1) final_rows(F);
        else {
            const int l = (ph - 2) / 7, k = (ph - 2) % 7; const bool last = (l == DEPTH - 1);
            const int Mx = last ? ML : MT;
            float* MOD = WSP(float, WS_MOD);
            if (k == 0) {
                if (l > 0) { ctx_finalize(F, l); xcd_barrier(bar, F.tid); }
                pg8::Gemm g{WSP(const bf16, WS_XA), WSP(const bf16, WS_WIN) + (size_t)l * IND * D, MT, IND, D};
                pg8::Order S; if (last) S.init(ML, IND, WGM_IN, (MC / 256) * 5, 1, F.G, (int)blockIdx.x); else S.init(MT, IND, WGM_IN, 0, 0, F.G, (int)blockIdx.x);
                pg8::EpiScale<0, IND, true> E{WSP(bf16, WS_PROJ), WSP(const float, WS_SHW1) + (size_t)l * 17 * IND, WSP(const float, WS_RSSA), PROBE_V};

#ifndef NO_G0
                pg8::gemm_phase<pg8::EpiScale<0, IND, true>, pg8::Order, true, true>(F.lds + RING_OFF, g, S, E, F.tid);
#endif

            } else if (k == 1) {

#ifndef NO_LRU
                lru_phase<0>(F, l, 1152);
#ifdef REP_LRU0
                __syncthreads(); lru_phase<0>(F, l, 1152);
#endif
#endif

                __syncthreads();
#ifndef NO_CONV
                conv_phase(F, l, last ? 1024 : 1152);
                __syncthreads();
#ifdef REP_CONV
                conv_phase(F, l, last ? 1024 : 1152);
                __syncthreads();
#endif
#endif
#ifndef NO_NA
#ifdef REP_NA
                na_phase(F, l, last ? NA_ITEMS_LAT : NA_ITEMS_LAT + NA_ITEMS_CTX, REP_NA);
#else
                na_phase(F, l, last ? NA_ITEMS_LAT : NA_ITEMS_LAT + NA_ITEMS_CTX);
#endif
#ifdef REP_NA
                __syncthreads(); na_phase(F, l, last ? NA_ITEMS_LAT : NA_ITEMS_LAT + NA_ITEMS_CTX, 0);
#endif
#endif
            } else if (k == 2) {
                lru_carry(F);
            } else if (k == 3) {

#ifndef NO_LRU
                lru_scan_phase(F, l, last ? 1024 : 1152);
#endif

            } else if (k == 4 || k == 6) {
                const bool dn = (k == 6);
                const int ln = (dn && !last) ? l + 1 : l;
                pg8::Gemm g{dn ? WSP(const bf16, WS_HID) : WSP(const bf16, WS_MIX), dn ? WSP(const bf16, WS_W2) + (size_t)l * D * FF : WSP(const bf16, WS_WOUT) + (size_t)l * D * D, Mx, D, dn ? FF : D};
                const bool splitk = dn && !last;
                pg8::Order S; S.init(splitk ? ML : Mx, D, dn ? WGM_DN : WGM_OUT, 0, 0, F.G, (int)blockIdx.x);
                const bool fromin = (!dn && l == 0);
                const float* go_g = dn ? INP(5) + l * D : INP(4) + l * D;
                const float* go_s = MOD + (size_t)l * 17 * MODW + (dn ? 4 : 1) * D;
                const bool fin = dn && last;
                pg8::EpiRes E{fromin ? INP(0) : (const float*)nullptr, fromin ? INP(2) : (const float*)nullptr, (float*)nullptr,
                              MOD + (size_t)l * 17 * MODW + (dn ? 5 : 2) * D, fin ? INP(24) : (dn ? INP(4) : INP(5)) + ln * D, fin ? WSP(const float, WS_ZERO) : MOD + (size_t)ln * 17 * MODW + (dn ? 1 : 4) * D,
                              go_g, go_s, WSP(bf16, WS_XA), dn ? WSP(float, WS_RSSA) : WSP(float, WS_RSSB), 1};
#ifndef NO_GR
                pg8::gemm_phase<pg8::EpiRes, pg8::Order, true, true>(F.lds + RING_OFF, g, S, E, F.tid);
                if (splitk) {
                    pg8::Order S2; S2.init(ML, 0, 4, (MC / 256) * 16, 2, F.G, (int)blockIdx.x);
                    pg8::EpiSlab E2{WSP(float, WS_PART), MOD + ((size_t)l * 17 + NB) * MODW + 5 * D};
                    pg8::gemm_phase<pg8::EpiSlab, pg8::Order, true, true, true>(F.lds + RING_OFF, g, S2, E2, F.tid);
                }
#endif
            } else if (k == 5) {
                pg8::Gemm g{WSP(const bf16, WS_XA), WSP(const bf16, WS_W1) + (size_t)l * FF * D, Mx, FF, D};
                pg8::Order S; S.init(Mx, FF, WGM_UP, 0, 0, F.G, (int)blockIdx.x);
                pg8::EpiScale<1, FF> E{WSP(bf16, WS_HID), WSP(const float, WS_SHW2) + (size_t)l * 17 * FF, WSP(const float, WS_RSSB), PROBE_V};

#ifndef NO_G1
                pg8::gemm_phase<pg8::EpiScale<1, FF>, pg8::Order, true, true>(F.lds + RING_OFF, g, S, E, F.tid);
#endif

            }
        }
#ifdef PROBE_MASK
        if (((PROBE_MASK >> ph) & 1) && !rep_done) { rep_done = true; xcd_barrier(bar, F.tid); --ph; continue; }
        rep_done = false;
#endif
        if (ph + 1 < hi) xcd_barrier(bar, F.tid);
#ifdef PROBE_BAR2
        if (ph + 1 < hi) xcd_barrier(bar, F.tid);
#endif
    }
}

extern "C" void kernel_launch(void* const* d_in, const int* in_sizes, int n_in, void* d_out, int out_size, void* d_ws, size_t ws_size, hipStream_t stream) {
    static int grid = 0;
    if (grid == 0) {
        if (n_in != 25 || out_size != ML * D || ws_size < WS_END) { fprintf(stderr, "kernel_launch: unexpected shapes (n_in %d out %d ws %zu)\n", n_in, out_size, ws_size); grid = -1; return; }
        int dev = 0, cus = 0;
        if (hipGetDevice(&dev) != hipSuccess || hipDeviceGetAttribute(&cus, hipDeviceAttributeMultiprocessorCount, dev) != hipSuccess) { grid = -1; return; }
        if (hipFuncSetAttribute((const void*)mega_fwd, hipFuncAttributeMaxDynamicSharedMemorySize, LDS_BYTES) != hipSuccess) { fprintf(stderr, "kernel_launch: hipFuncSetAttribute failed\n"); grid = -1; return; }
        int per_cu = 0;
        if (hipOccupancyMaxActiveBlocksPerMultiprocessor(&per_cu, (const void*)mega_fwd, NWAVES * 64, LDS_BYTES) != hipSuccess || per_cu < 1) fprintf(stderr, "kernel_launch: occupancy query reports %d\n", per_cu);
        (void)hipGetLastError();
        grid = cus;
    }
    if (grid < 0) return;
    if (hipMemsetAsync((char*)d_ws + WS_CTL, 0, CTL_ZERO_BYTES, stream) != hipSuccess) return;
    Args a{};
    for (int i = 0; i < 25; ++i) a.in[i] = (const float*)d_in[i];
    a.out = (float*)d_out; a.ws = (unsigned char*)d_ws;
#if MK_N_LAUNCHES == 1
    a.ph_lo = 0; a.ph_hi = N_PHASES;
    hipLaunchKernelGGL(mega_fwd, dim3(grid), dim3(NWAVES * 64), LDS_BYTES, stream, a);
#else
    for (int ph = 0; ph < N_PHASES; ++ph) { a.ph_lo = ph; a.ph_hi = ph + 1; hipLaunchKernelGGL(mega_fwd, dim3(grid), dim3(NWAVES * 64), LDS_BYTES, stream, a); }
#endif
}
```

```cpp
#include <hip/hip_runtime.h>
#include <cstdio>
#include <cstdint>

constexpr int D = 1024, NB = 16, SEQ = 2048, CTXL = 256, DEPTH = 2;
constexpr int ML = NB * SEQ, MC = NB * CTXL, MT = ML + MC;
constexpr int IND = 2560, FF = 4096, NH = 8, HD = 64;
constexpr int MODW = 6 * D;
constexpr float EPS = 1e-6f;
#ifndef MK_N_LAUNCHES
#define MK_N_LAUNCHES 1
#endif

namespace pg8 {
#define PG8_LAS __attribute__((address_space(3)))
typedef unsigned short bf16_t;
typedef short bf16x8 __attribute__((ext_vector_type(8)));
typedef float f32x4 __attribute__((ext_vector_type(4)));
typedef unsigned u32x4 __attribute__((ext_vector_type(4)));
constexpr int BM = 256, BK = 64, HALF = 128, HTB = HALF * BK * 2, STAGE_BYTES = 8 * HTB, NXCD = 8;
constexpr int TBL_UNITS = 9;

__host__ __device__ __forceinline__ int lds_byte(int r, int c) { const int st = (r >> 4) * 2 + (c >> 5), rr = r & 15, cc = c & 31, ob = rr * 64 + cc * 2; return st * 1024 + (ob ^ (((ob >> 9) & 1) << 5)); }
__host__ __device__ __forceinline__ void stage_rc(int b, int& R, int& C) { const int st = b / 1024, sb = b % 1024, swz = sb ^ (((sb >> 9) & 1) << 5); R = (st >> 1) * 16 + swz / 64; C = (st & 1) * 32 + (swz % 64) / 2; }
__host__ __device__ __forceinline__ int perm32(int rho) { const int n = rho >> 4, i = rho & 15; return 8 * (i >> 2) + 4 * n + (i & 3); }

struct Unit { int pm, pn; };
struct Gemm { const bf16_t* A; const bf16_t* Bt; int M, N, K; };

__host__ __device__ __forceinline__ void map_tile(int wgid, int nM, int nN, int WGM, Unit& u) {
    const int nwg = nM * nN;
    { const int q = nwg / NXCD, r = nwg % NXCD, xcd = wgid % NXCD, off = wgid / NXCD; wgid = (xcd < r ? xcd * (q + 1) : r * (q + 1) + (xcd - r) * q) + off; }
    const int nig = WGM * nN, gid = wgid / nig, fm = gid * WGM, gsz = (nM - fm) < WGM ? (nM - fm) : WGM;
    u.pm = fm + ((wgid % nig) % gsz); u.pn = (wgid % nig) / gsz;
}
struct Order {
    int nM, nN, nwg, extra, mode, wgm, G, c;
    __host__ __device__ void init(int M, int N, int wgm_, int extra_, int mode_, int G_, int c_) { nM = M / BM; nN = N / BM; nwg = nM * nN; extra = extra_; mode = mode_; wgm = wgm_; G = G_; c = c_; }
    __host__ __device__ bool next(int i, Unit& u) const {
        const long L = (long)i * G + c;
        if (L < nwg) { map_tile((int)L, nM, nN, wgm, u); return true; }
        if (L < nwg + extra) { const int q = (int)L - nwg;
            if (mode == 1) { u.pm = nM + q / 5; u.pn = 4 + q % 5; }
            else { u.pm = nM + (q >> 4); u.pn = 4 + 4 * (q & 3) + ((q >> 2) & 3); }
            return true; }
        return false;
    }
    __device__ __forceinline__ void a_ready(const Unit&) const {}
    __device__ __forceinline__ void done(const Unit&) const {}
};

__device__ __forceinline__ unsigned cvt_pk_bf16(float lo, float hi) { unsigned r; asm volatile("v_cvt_pk_bf16_f32 %0, %1, %2" : "=v"(r) : "v"(lo), "v"(hi)); return r; }

template <int ACT, int LDC, bool GLU = false> struct EpiScale {
    static constexpr bool PERM = true, AFTER_DRAIN = false;
    bf16_t* O;
    const PG8_LAS float* tbl;
    int probe;
    __device__ __forceinline__ void operator()(const f32x4 (&acc)[2][2][4][2], const Unit& u, int wr, int wc, int fr, int fq, int ui) const {
        asm volatile("" : "+s"(wr), "+s"(wc));
        bf16_t* Ot = O + (size_t)u.pm * BM * LDC + u.pn * BM;
        unsigned cl = (unsigned)(wc * 32 + 8 * fq);
        unsigned rl0 = (unsigned)(wr * 64 + fr);
        asm volatile("" : "+v"(cl), "+v"(rl0));
        const PG8_LAS float* rst = tbl + ui * 256, * sht = tbl + TBL_UNITS * 256 + ui * 256;
        f32x4 sh[2][2]; float rs[2][4];
#pragma unroll
        for (int ai = 0; ai < 2; ++ai)
#pragma unroll
            for (int m = 0; m < 4; ++m) rs[ai][m] = rst[rl0 + (unsigned)(ai * HALF + m * 16)];
#pragma unroll
        for (int bj = 0; bj < 2; ++bj) { sh[bj][0] = *(const PG8_LAS f32x4*)(sht + (cl + (unsigned)(bj * HALF))); sh[bj][1] = *(const PG8_LAS f32x4*)(sht + (cl + (unsigned)(bj * HALF + 4))); }
        if (GLU && u.pn < 2) {
#pragma unroll
            for (int ai = 0; ai < 2; ++ai)
#pragma unroll
                for (int m = 0; m < 4; ++m) {
                    const f32x4 a0 = acc[ai][0][m][0] * rs[ai][m] + sh[0][0], a1 = acc[ai][0][m][1] * rs[ai][m] + sh[0][1];
                    const f32x4 g0 = acc[ai][1][m][0] * rs[ai][m] + sh[1][0], g1 = acc[ai][1][m][1] * rs[ai][m] + sh[1][1];
                    f32x4 v0, v1;
#pragma unroll
                    for (int e = 0; e < 4; ++e) { v0[e] = a0[e] * __builtin_amdgcn_rcpf(1.f + __builtin_amdgcn_exp2f(-1.4426950408889634f * g0[e])); v1[e] = a1[e] * __builtin_amdgcn_rcpf(1.f + __builtin_amdgcn_exp2f(-1.4426950408889634f * g1[e])); }
                    u32x4 w; w.x = cvt_pk_bf16(v0[0], v0[1]); w.y = cvt_pk_bf16(v0[2], v0[3]); w.z = cvt_pk_bf16(v1[0], v1[1]); w.w = cvt_pk_bf16(v1[2], v1[3]);
                    *(u32x4*)(O + (size_t)u.pm * BM * LDC + u.pn * HALF + ((rl0 + (unsigned)(ai * HALF + m * 16)) * (unsigned)LDC + cl)) = w;
                }
            return;
        }
#pragma unroll
        for (int bj = 0; bj < 2; ++bj)
#pragma unroll
            for (int ai = 0; ai < 2; ++ai)
#pragma unroll
                for (int m = 0; m < 4; ++m) {
                    f32x4 v0 = acc[ai][bj][m][0] * rs[ai][m] + sh[bj][0], v1 = acc[ai][bj][m][1] * rs[ai][m] + sh[bj][1];
                    if (ACT == 1) {
#pragma unroll
                        for (int e = 0; e < 4; ++e) { const float a = fmaxf(v0[e], 0.f), b = fmaxf(v1[e], 0.f); v0[e] = a * a; v1[e] = b * b; }
                    }
                    u32x4 w; w.x = cvt_pk_bf16(v0[0], v0[1]); w.y = cvt_pk_bf16(v0[2], v0[3]); w.z = cvt_pk_bf16(v1[0], v1[1]); w.w = cvt_pk_bf16(v1[2], v1[3]);
                    if (probe == 0) *(u32x4*)(Ot + ((rl0 + (unsigned)(ai * HALF + m * 16)) * (unsigned)LDC + cl + (unsigned)(bj * HALF))) = w;
                    else asm volatile("" :: "v"(w));
                }
    }
};
struct EpiRes {
    static constexpr bool PERM = true, AFTER_DRAIN = false;
    const float* src_lat; const float* src_ctx;
    float* dst_lat;
    const float* gate;
    const float* gmg; const float* gmsc;
    const float* gmg_o; const float* gmsc_o;
    bf16_t* XA; float* RSS; int hasxa;
    template <int BJ, int AI0, int NAI, int M0, int NM>
    __device__ __forceinline__ void batch(const f32x4 (&acc)[2][2][4][2], const float* src, float* dst, const float* gt, const float* gg, const float* gs, const float* go, const float* gso, bf16_t* XAt, float* RSSt, unsigned cl, unsigned rl0, int fq) const {
        const unsigned c = cl + (unsigned)(BJ * HALF);
        f32x4 x0[NAI][NM], x1[NAI][NM];
        const bool srcf = src != nullptr;
        if (srcf) {
#pragma unroll
            for (int a = 0; a < NAI; ++a)
#pragma unroll
                for (int m = 0; m < NM; ++m) { const unsigned off = (rl0 + (unsigned)((AI0 + a) * HALF + (M0 + m) * 16)) * (unsigned)D + c; x0[a][m] = *(const f32x4*)(src + off); x1[a][m] = *(const f32x4*)(src + (off + 4u)); }
        } else {
            u32x4 xb[NAI][NM];
#pragma unroll
            for (int a = 0; a < NAI; ++a)
#pragma unroll
                for (int m = 0; m < NM; ++m) { const unsigned off = (rl0 + (unsigned)((AI0 + a) * HALF + (M0 + m) * 16)) * (unsigned)D + c; xb[a][m] = *(const u32x4*)(XAt + off); }
            const f32x4 i0 = *(const f32x4*)(go + c) * (*(const f32x4*)(gso + c) + 1.0f), i1 = *(const f32x4*)(go + (c + 4u)) * (*(const f32x4*)(gso + (c + 4u)) + 1.0f);
            f32x4 r0, r1;
#pragma unroll
            for (int e = 0; e < 4; ++e) { r0[e] = __builtin_amdgcn_rcpf(i0[e]); r1[e] = __builtin_amdgcn_rcpf(i1[e]); }
#pragma unroll
            for (int a = 0; a < NAI; ++a)
#pragma unroll
                for (int m = 0; m < NM; ++m) { const u32x4 w = xb[a][m];
                    x0[a][m] = (f32x4){__uint_as_float(w.x << 16), __uint_as_float(w.x & 0xffff0000u), __uint_as_float(w.y << 16), __uint_as_float(w.y & 0xffff0000u)} * r0;
                    x1[a][m] = (f32x4){__uint_as_float(w.z << 16), __uint_as_float(w.z & 0xffff0000u), __uint_as_float(w.w << 16), __uint_as_float(w.w & 0xffff0000u)} * r1; }
        }
        const f32x4 g0 = *(const f32x4*)(gt + c), g1 = *(const f32x4*)(gt + (c + 4u));
        f32x4 m0 = {0.f, 0.f, 0.f, 0.f}, m1 = {0.f, 0.f, 0.f, 0.f};
        if (hasxa) { m0 = *(const f32x4*)(gg + c) * (*(const f32x4*)(gs + c) + 1.0f); m1 = *(const f32x4*)(gg + (c + 4u)) * (*(const f32x4*)(gs + (c + 4u)) + 1.0f); }
        asm volatile("" ::: "memory");
#pragma unroll
        for (int a = 0; a < NAI; ++a)
#pragma unroll
            for (int m = 0; m < NM; ++m) {
                const unsigned rl = rl0 + (unsigned)((AI0 + a) * HALF + (M0 + m) * 16);
                const unsigned off = rl * (unsigned)D + c;
                const f32x4 y0 = x0[a][m] + g0 * acc[AI0 + a][BJ][M0 + m][0], y1 = x1[a][m] + g1 * acc[AI0 + a][BJ][M0 + m][1];
                if (dst) { *(f32x4*)(dst + off) = y0; *(f32x4*)(dst + (off + 4u)) = y1; }
                float ss = ((y0[0] * y0[0] + y0[1] * y0[1]) + (y0[2] * y0[2] + y0[3] * y0[3])) + ((y1[0] * y1[0] + y1[1] * y1[1]) + (y1[2] * y1[2] + y1[3] * y1[3]));
                ss += __shfl_xor(ss, 16); ss += __shfl_xor(ss, 32);
                if (fq == 0) RSSt[rl * 32u + (unsigned)(BJ * 4)] = ss;
                if (hasxa) { const f32x4 a0 = y0 * m0, a1 = y1 * m1;
                    u32x4 w; w.x = cvt_pk_bf16(a0[0], a0[1]); w.y = cvt_pk_bf16(a0[2], a0[3]); w.z = cvt_pk_bf16(a1[0], a1[1]); w.w = cvt_pk_bf16(a1[2], a1[3]);
                    *(u32x4*)(XAt + off) = w; }
            }
        asm volatile("" ::: "memory");
    }
    __device__ __forceinline__ void operator()(const f32x4 (&acc)[2][2][4][2], const Unit& u, int wr, int wc, int fr, int fq, int) const {
        asm volatile("" : "+s"(wr), "+s"(wc));
        const bool lat = u.pm < ML / BM;
        const int brow = lat ? (u.pm >> 3) : NB;
        const float* src = src_lat ? (lat ? src_lat + (size_t)u.pm * BM * D : src_ctx + (size_t)(u.pm - ML / BM) * BM * D) + u.pn * BM : nullptr;
        float* dst = (dst_lat && lat) ? dst_lat + (size_t)u.pm * BM * D + u.pn * BM : nullptr;
        const float* gt = gate + (size_t)brow * MODW + u.pn * BM;
        const float* gg = gmg + u.pn * BM;
        const float* gs = gmsc + (size_t)brow * MODW + u.pn * BM;
        const float* go = gmg_o + u.pn * BM;
        const float* gso = gmsc_o + (size_t)brow * MODW + u.pn * BM;
        bf16_t* XAt = XA + (size_t)u.pm * BM * D + u.pn * BM;
        float* RSSt = RSS + (size_t)u.pm * BM * 32 + u.pn * 8 + wc;
        unsigned cl = (unsigned)(wc * 32 + 8 * fq);
        unsigned rl0 = (unsigned)(wr * 64 + fr);
        asm volatile("" : "+v"(cl), "+v"(rl0));
        batch<0, 0, 1, 0, 2>(acc, src, dst, gt, gg, gs, go, gso, XAt, RSSt, cl, rl0, fq);
        batch<0, 0, 1, 2, 2>(acc, src, dst, gt, gg, gs, go, gso, XAt, RSSt, cl, rl0, fq);
        batch<0, 1, 1, 0, 4>(acc, src, dst, gt, gg, gs, go, gso, XAt, RSSt, cl, rl0, fq);
        batch<1, 0, 2, 0, 4>(acc, src, dst, gt, gg, gs, go, gso, XAt, RSSt, cl, rl0, fq);
    }
};

struct EpiSlab {
    static constexpr bool PERM = true, AFTER_DRAIN = false;
    float* P; const float* gate;
    __device__ __forceinline__ void operator()(const f32x4 (&acc)[2][2][4][2], const Unit& u, int wr, int wc, int fr, int fq, int) const {
        asm volatile("" : "+s"(wr), "+s"(wc));
        const int ks = (u.pn - 4) >> 2, pn = u.pn & 3;
        float* At = P + ((size_t)ks * MC + (size_t)(u.pm - ML / BM) * BM) * D + pn * BM;
        const float* gtq = gate + pn * BM;
        unsigned cl = (unsigned)(wc * 32 + 8 * fq), rl0 = (unsigned)(wr * 64 + fr);
        asm volatile("" : "+v"(cl), "+v"(rl0));
#pragma unroll
        for (int bj = 0; bj < 2; ++bj) { const unsigned c = cl + (unsigned)(bj * HALF);
            const f32x4 g0 = *(const f32x4*)(gtq + c), g1 = *(const f32x4*)(gtq + (c + 4u));
#pragma unroll
            for (int ai = 0; ai < 2; ++ai)
#pragma unroll
                for (int m = 0; m < 4; ++m) { const unsigned off = (rl0 + (unsigned)(ai * HALF + m * 16)) * (unsigned)D + c;
                    *(f32x4*)(At + off) = g0 * acc[ai][bj][m][0]; *(f32x4*)(At + (off + 4u)) = g1 * acc[ai][bj][m][1]; } }
    }
};

template <class Epi, class Sched, bool ALIGN_EPI = false, bool SP2 = false, bool VARK = false>
__device__ __forceinline__ void gemm_phase(PG8_LAS unsigned char* lds, const Gemm g, const Sched& S, const Epi& E, const int tid) {
    const int wid = __builtin_amdgcn_readfirstlane(tid >> 6), lane = tid & 63, wr = wid >> 2, wc = wid & 3, fr = lane & 15, fq = lane >> 4;
    const int K = g.K;
    unsigned voffA[2], voffB[2];
#pragma unroll
    for (int i = 0; i < 2; ++i) { int R, C; stage_rc(tid * 16 + i * 8192, R, C); const int Rb = Epi::PERM ? ((R & ~31) + perm32(R & 31)) : R;
        voffA[i] = (unsigned)(R * K + C) * 2u; voffB[i] = (unsigned)(Rb * K + C) * 2u; }
    const size_t kstep = (size_t)(BK * 2);
    const size_t hstep = (size_t)HALF * K * 2;
    const size_t tstep = 2 * hstep;
    const unsigned ldsw = (unsigned)wid * 1024u;
    const int aoff = lds_byte(wr * 64 + fr, fq * 8), boff = lds_byte(wc * 32 + fr, fq * 8);
#define PG8_SA(b, h) (((b) * 2 + (h)) * HTB)
#define PG8_SB(b, h) ((4 + (b) * 2 + (h)) * HTB)
#define PG8_STAGE(bufoff, gbase, voff) do { _Pragma("unroll") for (int _i = 0; _i < 2; ++_i) \
        __builtin_amdgcn_global_load_lds((const unsigned*)((const char*)(gbase) + (voff)[_i]), (PG8_LAS unsigned*)(lds + (bufoff) + ldsw + _i * 8192), 16, 0, 0); } while (0)
#define PG8_LDA(dst, b, h) do { _Pragma("unroll") for (int m = 0; m < 4; ++m) _Pragma("unroll") for (int k = 0; k < 2; ++k) dst[m][k] = *(const PG8_LAS bf16x8*)(lds + PG8_SA(b, h) + aoff + m * 2048 + k * 1024); } while (0)
#define PG8_LDB(dst, b, h) do { _Pragma("unroll") for (int n = 0; n < 2; ++n) _Pragma("unroll") for (int k = 0; k < 2; ++k) dst[n][k] = *(const PG8_LAS bf16x8*)(lds + PG8_SB(b, h) + boff + n * 2048 + k * 1024); } while (0)
#define PG8_MMA(ai, bj, At, Bt) do { __builtin_amdgcn_s_setprio(1); _Pragma("unroll") for (int m = 0; m < 4; ++m) _Pragma("unroll") for (int n = 0; n < 2; ++n) _Pragma("unroll") for (int k = 0; k < 2; ++k) \
        acc[ai][bj][m][n] = __builtin_amdgcn_mfma_f32_16x16x32_bf16(Bt[n][k], At[m][k], acc[ai][bj][m][n], 0, 0, 0); __builtin_amdgcn_s_setprio(0); } while (0)
#define PG8_WAIT_V(n) asm volatile("s_waitcnt vmcnt(" #n ")" ::: "memory")
#define PG8_WAIT_L(n) asm volatile("s_waitcnt lgkmcnt(" #n ")" ::: "memory")
#define PG8_BAR __builtin_amdgcn_s_barrier()
#define PG8_SCHED __builtin_amdgcn_sched_barrier(0)
    Unit cur, nxt; int ui = 0;
    if (!S.next(0, cur)) return;
    cur.pm = __builtin_amdgcn_readfirstlane(cur.pm); cur.pn = __builtin_amdgcn_readfirstlane(cur.pn);
    f32x4 acc[2][2][4][2];
#pragma unroll
    for (int a = 0; a < 2; ++a)
#pragma unroll
        for (int b = 0; b < 2; ++b)
#pragma unroll
            for (int m = 0; m < 4; ++m)
#pragma unroll
                for (int n = 0; n < 2; ++n) acc[a][b][m][n] = (f32x4){0.f, 0.f, 0.f, 0.f};
    bf16x8 At[4][2], B0[2][2], B1[2][2];
#define PG8_KOFF(u) ((VARK && (u).pn >= 4) ? (size_t)(((u).pn - 4) >> 2) * (size_t)(K / 4) * 2 : (size_t)0)
#define PG8_PN(u) ((VARK && (u).pn >= 4) ? ((u).pn & 3) : (u).pn)
    const char* cA = (const char*)g.A + (size_t)cur.pm * tstep + PG8_KOFF(cur); const char* cB = (const char*)g.Bt + (size_t)PG8_PN(cur) * tstep + PG8_KOFF(cur);
    S.a_ready(cur);
    if constexpr (SP2) {
        PG8_STAGE(PG8_SB(0, 0), cB, voffB); PG8_STAGE(PG8_SB(0, 1), cB + hstep, voffB); PG8_STAGE(PG8_SA(0, 0), cA, voffA); PG8_STAGE(PG8_SA(0, 1), cA + hstep, voffA);
        if (wr == 1) PG8_BAR;
        PG8_WAIT_V(2); PG8_BAR;
        PG8_STAGE(PG8_SB(1, 0), cB + kstep, voffB); PG8_STAGE(PG8_SA(1, 0), cA + kstep, voffA); PG8_STAGE(PG8_SB(1, 1), cB + hstep + kstep, voffB);
        PG8_WAIT_V(6); PG8_BAR;
    } else {
        PG8_STAGE(PG8_SB(0, 0), cB, voffB); PG8_STAGE(PG8_SA(0, 0), cA, voffA); PG8_STAGE(PG8_SB(0, 1), cB + hstep, voffB); PG8_STAGE(PG8_SA(0, 1), cA + hstep, voffA);
        if (wr == 1) PG8_BAR;
        PG8_WAIT_V(4); PG8_BAR;
        PG8_STAGE(PG8_SB(1, 0), cB + kstep, voffB); PG8_STAGE(PG8_SA(1, 0), cA + kstep, voffA); PG8_STAGE(PG8_SB(1, 1), cB + hstep + kstep, voffB);
        PG8_WAIT_V(6); PG8_BAR;
    }
    for (;;) {
        const bool has_next = S.next(ui + 1, nxt);
        nxt.pm = __builtin_amdgcn_readfirstlane(nxt.pm); nxt.pn = __builtin_amdgcn_readfirstlane(nxt.pn);
        const char* nA = has_next ? (const char*)g.A + (size_t)nxt.pm * tstep + PG8_KOFF(nxt) : cA; const char* nB = has_next ? (const char*)g.Bt + (size_t)PG8_PN(nxt) * tstep + PG8_KOFF(nxt) : cB;
        const int nt = (VARK && cur.pn >= 4) ? K / BK / 4 : K / BK;
        for (int t = 0; t < nt; t += 2) {
            const bool last = (t == nt - 2);
            const char* a1 = cA + (size_t)(t + 1) * kstep;
            const char* a2 = last ? nA : cA + (size_t)(t + 2) * kstep; const char* b2 = last ? nB : cB + (size_t)(t + 2) * kstep;
            const char* a3 = a2 + kstep; const char* b3 = b2 + kstep;
            if (last && has_next) S.a_ready(nxt);
            if constexpr (SP2) {
            PG8_LDB(B0, 0, 0); PG8_LDB(B1, 0, 1); PG8_SCHED; PG8_LDA(At, 0, 0); PG8_STAGE(PG8_SA(1, 1), a1 + hstep, voffA);
            PG8_WAIT_V(8); PG8_WAIT_L(0); PG8_BAR; PG8_MMA(0, 0, At, B0); PG8_MMA(0, 1, At, B1); PG8_BAR; PG8_SCHED;
            PG8_LDA(At, 0, 1); PG8_STAGE(PG8_SB(0, 0), b2, voffB); PG8_STAGE(PG8_SB(0, 1), b2 + hstep, voffB); PG8_STAGE(PG8_SA(0, 0), a2, voffA);
            PG8_WAIT_V(8); PG8_WAIT_L(0); PG8_BAR; PG8_MMA(1, 0, At, B0); PG8_MMA(1, 1, At, B1); PG8_BAR; PG8_SCHED;
            PG8_LDB(B0, 1, 0); PG8_LDB(B1, 1, 1); PG8_SCHED; PG8_LDA(At, 1, 0); PG8_STAGE(PG8_SA(0, 1), a2 + hstep, voffA);
            PG8_WAIT_V(8); PG8_WAIT_L(0); PG8_BAR; PG8_MMA(0, 0, At, B0); PG8_MMA(0, 1, At, B1); PG8_BAR; PG8_SCHED;
            PG8_LDA(At, 1, 1); PG8_STAGE(PG8_SB(1, 0), b3, voffB); PG8_STAGE(PG8_SB(1, 1), b3 + hstep, voffB); PG8_STAGE(PG8_SA(1, 0), a3, voffA);
            PG8_WAIT_V(8); PG8_WAIT_L(0); PG8_BAR; PG8_MMA(1, 0, At, B0); PG8_MMA(1, 1, At, B1); PG8_BAR; PG8_SCHED;
            } else {
            PG8_LDB(B0, 0, 0); PG8_SCHED; PG8_LDA(At, 0, 0); PG8_STAGE(PG8_SA(1, 1), a1 + hstep, voffA);
            PG8_WAIT_L(8); PG8_BAR; PG8_WAIT_L(0); PG8_MMA(0, 0, At, B0); PG8_BAR; PG8_SCHED;
            PG8_LDB(B1, 0, 1); PG8_STAGE(PG8_SB(0, 0), b2, voffB);
            PG8_BAR; PG8_WAIT_L(0); PG8_MMA(0, 1, At, B1); PG8_BAR;
            PG8_LDA(At, 0, 1); PG8_STAGE(PG8_SA(0, 0), a2, voffA);
            PG8_BAR; PG8_WAIT_L(0); PG8_MMA(1, 0, At, B0); PG8_BAR; PG8_SCHED;
            PG8_STAGE(PG8_SB(0, 1), b2 + hstep, voffB);
            PG8_WAIT_V(6); PG8_BAR; PG8_MMA(1, 1, At, B1); PG8_BAR;
            PG8_LDB(B0, 1, 0); PG8_SCHED; PG8_LDA(At, 1, 0); PG8_STAGE(PG8_SA(0, 1), a2 + hstep, voffA);
            PG8_WAIT_L(8); PG8_BAR; PG8_WAIT_L(0); PG8_MMA(0, 0, At, B0); PG8_BAR; PG8_SCHED;
            PG8_LDB(B1, 1, 1); PG8_STAGE(PG8_SB(1, 0), b3, voffB);
            PG8_BAR; PG8_WAIT_L(0); PG8_MMA(0, 1, At, B1); PG8_BAR;
            PG8_LDA(At, 1, 1); PG8_STAGE(PG8_SA(1, 0), a3, voffA);
            PG8_BAR; PG8_WAIT_L(0); PG8_MMA(1, 0, At, B0); PG8_BAR; PG8_SCHED;
            PG8_STAGE(PG8_SB(1, 1), b3 + hstep, voffB);
            PG8_WAIT_V(6); PG8_BAR; PG8_MMA(1, 1, At, B1); PG8_BAR;
            }
        }
        if constexpr (ALIGN_EPI) { if (wr == 0) PG8_BAR; }
        if constexpr (!Epi::AFTER_DRAIN) { E(acc, cur, wr, wc, fr, fq, ui); S.done(cur); }
        if (!has_next) break;
#pragma unroll
        for (int a = 0; a < 2; ++a)
#pragma unroll
            for (int b = 0; b < 2; ++b)
#pragma unroll
                for (int m = 0; m < 4; ++m)
#pragma unroll
                    for (int n = 0; n < 2; ++n) acc[a][b][m][n] = (f32x4){0.f, 0.f, 0.f, 0.f};
        cur = nxt; cA = nA; cB = nB; ++ui;
        if constexpr (ALIGN_EPI) { if (wr == 1) PG8_BAR; }
    }
    PG8_WAIT_V(0);
    if constexpr (!ALIGN_EPI) { if (wr == 0) PG8_BAR; }
    PG8_BAR;
    if constexpr (Epi::AFTER_DRAIN) { E.fused(acc, cur, wr, wc, fr, fq, lds, wid, lane); S.done(cur); }
#undef PG8_KOFF
#undef PG8_PN
#undef PG8_SA
#undef PG8_SB
#undef PG8_STAGE
#undef PG8_LDA
#undef PG8_LDB
#undef PG8_MMA
#undef PG8_WAIT_V
#undef PG8_WAIT_L
#undef PG8_BAR
#undef PG8_SCHED
}
}

constexpr size_t MiB = 1u << 20;
constexpr size_t WS_CTL = 0, CTL_ZERO_BYTES = 1 * MiB;
constexpr size_t WS_MOD = 1 * MiB;
constexpr size_t WS_SHW1 = 2 * MiB;
constexpr size_t WS_SHW2 = 3 * MiB;
constexpr size_t WS_RSSA = 4 * MiB;
constexpr size_t WS_RSSB = 9 * MiB;
constexpr size_t WS_TOT = 14 * MiB;
constexpr size_t WS_CARRY = 19 * MiB;
constexpr size_t WS_WLR = 21 * MiB + 512 * 1024;
constexpr size_t WS_WIN = 22 * MiB;
constexpr size_t WS_WOUT = 32 * MiB;
constexpr size_t WS_W1 = 36 * MiB;
constexpr size_t WS_W2 = 52 * MiB;
constexpr size_t WS_CX = 68 * MiB;
constexpr size_t WS_XA = 84 * MiB;
constexpr size_t WS_HID = 156 * MiB;
constexpr size_t WS_PROJ = WS_HID;
constexpr size_t WS_MIX = WS_HID + 180 * MiB;
constexpr size_t WS_PART = 444 * MiB;
constexpr size_t WS_AB = 436 * MiB;
constexpr size_t WS_END = 508 * MiB;
static_assert(WS_MIX + (size_t)MT * D * 2 <= WS_PART && WS_HID + (size_t)MT * FF * 2 == WS_PART && WS_PART + (size_t)4 * MC * D * 4 == WS_END && WS_AB >= WS_MIX + (size_t)MT * D * 2 && WS_AB + (size_t)1152 * 2 * 2 * 8 * 2 * 64 * 16 == WS_END, "ws map");
constexpr size_t WS_ZERO = WS_CTL + 512 * 1024;
constexpr int CW_BAR = 4096;

#ifndef WGM_IN
#define WGM_IN 4
#endif
#ifndef WGM_OUT
#define WGM_OUT 4
#endif
#ifndef WGM_UP
#define WGM_UP 4
#endif
#ifndef WGM_DN
#define WGM_DN 4
#endif
constexpr int NWAVES = 8;
constexpr int RING_OFF = 0, RING_BYTES = 131072;
constexpr int LDSCTL_OFF = RING_BYTES, MISC_OFF = LDSCTL_OFF + 320;
constexpr int TBL_OFF = LDSCTL_OFF + 1024;
static_assert(TBL_OFF + 2 * pg8::TBL_UNITS * 256 * 4 <= 163840, "LDS map");
constexpr int LDS_BYTES = 163840;

#define GAS __attribute__((address_space(1)))
#define LAS __attribute__((address_space(3)))
typedef unsigned short bf16;
typedef unsigned v4u __attribute__((ext_vector_type(4)));
typedef unsigned v2u __attribute__((ext_vector_type(2)));
typedef float f32x4 __attribute__((ext_vector_type(4)));
typedef float f32x2 __attribute__((ext_vector_type(2)));
typedef GAS unsigned gu32;
#define LDS_WAIT() asm volatile("s_waitcnt lgkmcnt(0)" ::: "memory")
#define VM_WAIT() asm volatile("s_waitcnt vmcnt(0)" ::: "memory")
__device__ __forceinline__ unsigned f2bf(float f) { unsigned u = __builtin_bit_cast(unsigned, f); return (u + 0x7fffu + ((u >> 16) & 1u)) >> 16; }
__device__ __forceinline__ unsigned pk2(float lo, float hi) { return f2bf(lo) | (f2bf(hi) << 16); }
__device__ __forceinline__ float bflo(unsigned w) { return __uint_as_float(w << 16); }
__device__ __forceinline__ float bfhi(unsigned w) { return __uint_as_float(w & 0xffff0000u); }
__device__ __forceinline__ float bf1(bf16 v) { return __uint_as_float((unsigned)v << 16); }
__device__ __forceinline__ float sigmoidf_(float x) { return __builtin_amdgcn_rcpf(1.f + __builtin_amdgcn_exp2f(-1.4426950408889634f * x)); }
__device__ __forceinline__ float siluf_(float x) { return x * sigmoidf_(x); }
__device__ __forceinline__ float gelu_tanh(float x) { const float u = 0.7978845608028654f * (x + 0.044715f * x * x * x); return x * sigmoidf_(2.f * u); }
__device__ __forceinline__ float wave_sum(float v) {
#pragma unroll
    for (int o = 1; o < 64; o <<= 1) v += __shfl_xor(v, o);
    return v;
}

#define XB_TMO      128
#define XB_XCNT(j)  (256  + 64 * (j))
#define XB_XSUB(j)  (1280 + 64 * (j))
#define XB_XGEN(j)  (2304 + 64 * (j))
#define XB_TOP      3328
#define XB_TOPGEN   3392
#define XCD_BAR_WORDS 3456
#define XB_SPIN_CAP (1u << 18)

__device__ __forceinline__ unsigned xb_ld(unsigned* p)              { return __hip_atomic_load(p, __ATOMIC_RELAXED, __HIP_MEMORY_SCOPE_AGENT); }
__device__ __forceinline__ unsigned xb_add(unsigned* p, unsigned v) { return __hip_atomic_fetch_add(p, v, __ATOMIC_RELAXED, __HIP_MEMORY_SCOPE_AGENT); }
__device__ __forceinline__ unsigned xb_xcc_id() { return (unsigned)__builtin_amdgcn_s_getreg((3 << 11) | 20) & 0xFu; }
#define XB_SPIN(cond, bar) do { unsigned _sp = 0; while (cond) { __builtin_amdgcn_s_sleep(1); \
    if ((++_sp & 255u) == 0u) { if (xb_ld(&(bar)[XB_TMO])) break; if (_sp > XB_SPIN_CAP) { atomicAdd(&(bar)[XB_TMO], 1u); break; } } } } while (0)

struct XcdBarrier {
    unsigned* bar; unsigned x;
    volatile LAS unsigned* st;
};

__device__ __forceinline__ XcdBarrier xcd_barrier_post(unsigned* bar, volatile LAS unsigned* st, int tid) {
    XcdBarrier b; b.bar = bar; b.x = xb_xcc_id(); b.st = st;
    if (tid == 0) (void)xb_add(&bar[XB_XCNT(b.x)], 1u);
    return b;
}
__device__ __forceinline__ void xcd_barrier_complete(unsigned* bar, unsigned x, unsigned& nloc, unsigned& nx) {
    const unsigned G = gridDim.x * gridDim.y * gridDim.z;
    unsigned sum, cnt, mine, sp = 0u;
    for (;;) {
        sum = 0u; cnt = 0u; mine = 0u;
#pragma unroll 1
        for (unsigned j = 0; j < 16; ++j) { const unsigned c = xb_ld(&bar[XB_XCNT(j)]); sum += c; cnt += (c > 0u) ? 1u : 0u; mine = (j == x) ? c : mine; }
        if (sum == G) break;
        __builtin_amdgcn_s_sleep(1);
        if ((++sp & 255u) == 0u) { if (xb_ld(&bar[XB_TMO])) break; if (sp > XB_SPIN_CAP) { atomicAdd(&bar[XB_TMO], 1u); break; } }
    }
    nloc = mine > 0u ? mine : 1u; nx = cnt > 0u ? cnt : 1u;
}

__device__ __forceinline__ void xcd_barrier(const XcdBarrier& b, int tid) {
    asm volatile("s_waitcnt vmcnt(0)" ::: "memory");
    __syncthreads();
    if (tid == 0) {
        unsigned* bar = b.bar;
        __builtin_amdgcn_s_waitcnt(0);
        unsigned nloc = b.st[0], nx = b.st[1];
        if (nloc == 0u) { xcd_barrier_complete(bar, b.x, nloc, nx); b.st[0] = nloc; b.st[1] = nx; }
        const unsigned old = xb_add(&bar[XB_XSUB(b.x)], 1u);
        const unsigned gen = old / nloc;
        if (old + 1u == (gen + 1u) * nloc) {
            __builtin_amdgcn_fence(__ATOMIC_RELEASE, "agent");
            asm volatile("s_waitcnt vmcnt(0)" ::: "memory");
            const unsigned og = xb_add(&bar[XB_TOP], 1u);
            const unsigned tg = og / nx;
            if (og + 1u == (tg + 1u) * nx) xb_add(&bar[XB_TOPGEN], 1u);
            else XB_SPIN(xb_ld(&bar[XB_TOPGEN]) == tg, bar);
            __builtin_amdgcn_fence(__ATOMIC_ACQUIRE, "agent");
            xb_add(&bar[XB_XGEN(b.x)], 1u);
            asm volatile("s_waitcnt vmcnt(0)" ::: "memory");
        } else {
            XB_SPIN(xb_ld(&bar[XB_XGEN(b.x)]) == gen, bar);
            __builtin_amdgcn_fence(__ATOMIC_ACQUIRE, "agent");
            asm volatile("s_waitcnt vmcnt(0)" ::: "memory");
        }
    }
    __syncthreads();
}

struct Frame {
    LAS unsigned char* lds;
    int tid, lane, wave;
    int vcu, G;
    int gw, NGW;
    float* out; unsigned char* ws;
};
constexpr int PTR_OFF = LDSCTL_OFF + 512;
__device__ __forceinline__ const float* inp_(LAS unsigned char* lds, int i) {
    const unsigned long long v = *(const LAS unsigned long long*)(lds + PTR_OFF + 8 * i);
    const unsigned lo = __builtin_amdgcn_readfirstlane((unsigned)v), hi = __builtin_amdgcn_readfirstlane((unsigned)(v >> 32));
    return (const float*)(((unsigned long long)hi << 32) | lo);
}
#define INP(i) inp_(F.lds, (i))
#define WSP(T, off) ((T*)(F.ws + (off)))

__device__ __forceinline__ void gemv17_item(Frame& F, const LAS float* tab, LAS float* red, const float* W, int ldw, int n0, const float* bias, float* outp, int ldo, int n0out) {
    float acc[17];
#pragma unroll
    for (int r = 0; r < 17; ++r) acc[r] = 0.f;
    const int k0 = F.wave * 128;
    const float* wp = W + (size_t)k0 * ldw + n0 + F.lane;
#pragma unroll 1
    for (int kk = 0; kk < 128; kk += 32) {
        float wv[32];
#pragma unroll
        for (int k = 0; k < 32; ++k) wv[k] = wp[(size_t)(kk + k) * ldw];
#pragma unroll
        for (int k = 0; k < 32; ++k) {
#pragma unroll
            for (int r = 0; r < 17; ++r) acc[r] += tab[r * 1024 + k0 + kk + k] * wv[k];
        }
    }
#pragma unroll
    for (int r = 0; r < 17; ++r) red[(F.wave * 17 + r) * 64 + F.lane] = acc[r];
    __syncthreads();
    for (int i = F.tid; i < 17 * 64; i += NWAVES * 64) {
        const int r = i >> 6, n = i & 63; float s = bias ? bias[n0 + n] : 0.f;
#pragma unroll
        for (int w = 0; w < 8; ++w) s += red[(w * 17 + r) * 64 + n];
        outp[(size_t)r * ldo + n0out + n] = s;
    }
    __syncthreads();
}

__host__ __device__ __forceinline__ int glu_col(int o) { return o >= 512 ? o : ((o >> 7) & 1) * 256 + (o >> 8) * 128 + (o & 127); }
__device__ __forceinline__ void p0_transpose_item(const float* W, int K, int N, bf16* WT, LAS float* scr, int item, int lane, bool glu) {
    const int nblk = N / 32, kb = item / nblk, nb = item % nblk, k0 = 64 * kb, n0 = 32 * nb;
    const int n0o = glu ? glu_col(n0) : n0;
    float tv[32];
#pragma unroll
    for (int i = 0; i < 32; ++i) { const int kk = 2 * i + (lane >> 5); tv[i] = W[(size_t)(k0 + kk) * N + n0 + (lane & 31)]; }
#pragma unroll
    for (int i = 0; i < 32; ++i) { const int kk = 2 * i + (lane >> 5); scr[kk * 33 + (lane & 31)] = tv[i]; }
    LDS_WAIT(); asm volatile("" ::: "memory");
    const int c = lane & 7;
#pragma unroll
    for (int j = 0; j < 4; ++j) { const int n = (lane >> 3) + 8 * j; const LAS float* s = scr + (8 * c) * 33 + n;
        v4u o; o.x = pk2(s[0 * 33], s[1 * 33]); o.y = pk2(s[2 * 33], s[3 * 33]); o.z = pk2(s[4 * 33], s[5 * 33]); o.w = pk2(s[6 * 33], s[7 * 33]);
        *(GAS v4u*)(WT + (size_t)(n0o + n) * K + k0 + 8 * c) = o; }
    LDS_WAIT(); asm volatile("" ::: "memory");
}

__device__ __forceinline__ void weight_items(Frame& F, int first, int last, int widx, int nw) {
    LAS float* scr = (LAS float*)(F.lds + F.wave * 16384);
    constexpr int I_IN = (D / 64) * (IND / 32), I_OUT = (D / 64) * (D / 32), I_1 = (D / 64) * (FF / 32), I_2 = (FF / 64) * (D / 32), I_L = I_IN + I_OUT + I_1 + I_2;
    for (int it = first + widx; it < last; it += nw) {
        const int l = it / I_L; int r = it % I_L;
        const float* W; bf16* WT; int K = D, N; const bool glu = r < I_IN;
        if (r < I_IN) { W = INP(8) + (size_t)l * D * IND; WT = WSP(bf16, WS_WIN) + (size_t)l * IND * D; N = IND; }
        else if (r < I_IN + I_OUT) { r -= I_IN; W = INP(9) + (size_t)l * D * D; WT = WSP(bf16, WS_WOUT) + (size_t)l * D * D; N = D; }
        else if (r < I_IN + I_OUT + I_1) { r -= I_IN + I_OUT; W = INP(22) + (size_t)l * D * FF; WT = WSP(bf16, WS_W1) + (size_t)l * FF * D; N = FF; }
        else { r -= I_IN + I_OUT + I_1; W = INP(23) + (size_t)l * FF * D; WT = WSP(bf16, WS_W2) + (size_t)l * D * FF; K = FF; N = D; }
        p0_transpose_item(W, K, N, WT, scr, r, F.lane, glu);
    }
}
constexpr int W_ITEMS = 2 * ((D / 64) * (IND / 32) + (D / 64) * (D / 32) + (D / 64) * (FF / 32) + (FF / 64) * (D / 32));
constexpr int W_EARLY = 64 * NWAVES * 3;

__device__ __forceinline__ void phase_p0a(Frame& F) {
    LAS float* tab = (LAS float*)(F.lds);
    LAS float* red = (LAS float*)(F.lds + 17 * 1024 * 4);
    float* MOD = WSP(float, WS_MOD);
    bool filled = false;
    for (int it = F.vcu; it < 2 * 96; it += F.G) {
        if (!filled) {
            for (int i = F.tid; i < 17 * 1024; i += NWAVES * 64) { const int r = i >> 10, k = i & 1023; const float v = (r < 16) ? INP(1)[r * D + k] : INP(3)[k]; tab[i] = siluf_(v); }
            __syncthreads(); filled = true;
        }
        const int l = it / 96, n0 = (it % 96) * 64;
        gemv17_item(F, tab, red, INP(6) + (size_t)l * D * MODW, MODW, n0, INP(7) + (size_t)l * MODW, MOD + (size_t)l * 17 * MODW, MODW, n0);
    }
    if (F.G == 256 && F.vcu >= 192) weight_items(F, 0, W_EARLY, (F.vcu - 192) * NWAVES + F.wave, 64 * NWAVES);
}

__device__ __forceinline__ void phase_p0b(Frame& F) {
    LAS float* tab = (LAS float*)(F.lds);
    LAS float* red = (LAS float*)(F.lds + 17 * 1024 * 4);
    const float* MOD = WSP(const float, WS_MOD);
    for (int it = F.vcu; it < 2 * 104; it += F.G) {
        const int l = it / 104, j = it % 104; const bool first = j < 40;
        const int shoff = first ? 0 : 3 * D;
        __syncthreads();
        for (int i = F.tid; i < 17 * 1024; i += NWAVES * 64) { const int r = i >> 10, k = i & 1023; tab[i] = MOD[((size_t)l * 17 + r) * MODW + shoff + k]; }
        __syncthreads();
        const int ldw = first ? IND : FF;
        gemv17_item(F, tab, red, first ? INP(8) + (size_t)l * D * IND : INP(22) + (size_t)l * D * FF, ldw, (first ? j : j - 40) * 64, nullptr,
                    first ? WSP(float, WS_SHW1) + (size_t)l * 17 * IND : WSP(float, WS_SHW2) + (size_t)l * 17 * FF, ldw, first ? glu_col(j * 64) : (j - 40) * 64);
    }
    bf16* XA = WSP(bf16, WS_XA); float* RSSA = WSP(float, WS_RSSA);
    const float* g1 = INP(4);
    for (int row = F.gw; row < MT; row += 2 * F.NGW) {
        f32x4 v[2][4]; float ss[2]; int rw[2]; const float* scp[2];
#pragma unroll
        for (int q = 0; q < 2; ++q) { int r_ = row + q * F.NGW; if (r_ >= MT) r_ = row; rw[q] = r_;
            const bool lat = r_ < ML;
            const float* xr = lat ? INP(0) + (size_t)r_ * D : INP(2) + (size_t)(r_ - ML) * D;
            scp[q] = MOD + (size_t)(lat ? (r_ >> 11) : NB) * MODW + D;
#pragma unroll
            for (int j = 0; j < 4; ++j) v[q][j] = *(const f32x4*)(xr + 4 * F.lane + 256 * j); }
#pragma unroll
        for (int q = 0; q < 2; ++q) { float s_ = 0.f;
#pragma unroll
            for (int j = 0; j < 4; ++j) s_ += (v[q][j][0] * v[q][j][0] + v[q][j][1] * v[q][j][1]) + (v[q][j][2] * v[q][j][2] + v[q][j][3] * v[q][j][3]);
            ss[q] = wave_sum(s_); }
#pragma unroll
        for (int q = 0; q < 2; ++q) { if (q == 1 && rw[1] == row) break;
            if (F.lane < 32) RSSA[(size_t)rw[q] * 32 + F.lane] = (F.lane == 0) ? ss[q] : 0.f;
#pragma unroll
            for (int j = 0; j < 4; ++j) { const int k = 4 * F.lane + 256 * j;
                const f32x4 gm = *(const f32x4*)(g1 + k) * (*(const f32x4*)(scp[q] + k) + 1.0f), a = v[q][j] * gm;
                v2u o; o.x = pk2(a[0], a[1]); o.y = pk2(a[2], a[3]); *(v2u*)(XA + (size_t)rw[q] * D + k) = o; } }
    }
    __syncthreads();
    {
        bf16* WLR = WSP(bf16, WS_WLR);
        for (int i = F.gw * 64 + F.lane; i < 2 * 2 * 4 * 2 * 4096; i += F.NGW * 64) { const int d = i & 63, e = (i >> 6) & 63, gt = (i >> 12) & 1, blk = i >> 13;
            const float* src = gt == 0 ? INP(17) : INP(19); WLR[i] = (bf16)f2bf(src[((size_t)blk * 64 + d) * 64 + e]); }
    }
    weight_items(F, (F.G == 256) ? W_EARLY : 0, W_ITEMS, F.gw, F.NGW);
}

constexpr int CV_OSROW = 260;
__device__ __forceinline__ void conv_phase(Frame& F, int l, int ntiles) {
    const bf16* PROJ = WSP(const bf16, WS_PROJ); bf16* MIX = WSP(bf16, WS_MIX);
    LAS float* us = (LAS float*)(F.lds);
    LAS float* os = (LAS float*)(F.lds + 62 * 256 * 4);
    const int c = F.tid & 255, half = F.tid >> 8;
    float w[31];
#pragma unroll
    for (int k = 0; k < 31; ++k) w[k] = INP(10)[((size_t)l * 31 + k) * 256 + c];
    const float cbias = INP(11)[l * 256 + c];
    const f32x4 lg = *(const f32x4*)(INP(12) + l * 256 + 4 * F.lane), lb = *(const f32x4*)(INP(13) + l * 256 + 4 * F.lane);
    unsigned pv[16];
    auto load_tile = [&](int T) {
        const int row0 = T * 32;
        int lo, hi; if (row0 < ML) { lo = row0 & ~(SEQ - 1); hi = lo + SEQ; } else { lo = row0 & ~(CTXL - 1); hi = lo + CTXL; }
#pragma unroll
        for (int j = 0; j < 16; ++j) { const int i = F.tid + 512 * j, rr = i >> 7, cp = i & 127, row = row0 - 15 + rr;
            const bool ok = (j < 15 || F.tid < 256) && row >= lo && row < hi;
            pv[j] = ok ? *(const unsigned*)(PROJ + (size_t)row * IND + 2 * cp) : 0u; }
    };
    const int T0 = F.G - 1 - F.vcu;
    if (T0 < ntiles) load_tile(T0);
    for (int T = T0; T < ntiles; T += F.G) {
        const int row0 = T * 32;
        __syncthreads();
#pragma unroll
        for (int j = 0; j < 16; ++j) { const int i = F.tid + 512 * j;
            if (j < 15 || F.tid < 256) { f32x2 u; u[0] = bflo(pv[j]); u[1] = bfhi(pv[j]); *(LAS f32x2*)(us + 2 * i) = u; } }
        if (T + F.G < ntiles) load_tile(T + F.G);
        __syncthreads();
        {
            float acc[16];
#pragma unroll
            for (int j = 0; j < 16; ++j) acc[j] = cbias;
            const LAS float* up = us + (16 * half) * 256 + c;
#pragma unroll
            for (int i = 0; i < 46; ++i) { const float x = up[i * 256];
#pragma unroll
                for (int j = 0; j < 16; ++j) if (i - j >= 0 && i - j <= 30) acc[j] += w[i - j] * x; }
#pragma unroll
            for (int j = 0; j < 16; ++j) os[(16 * half + j) * CV_OSROW + c] = acc[j];
        }
        __syncthreads();
#pragma unroll
        for (int q = 0; q < 4; ++q) { const int t = 4 * F.wave + q;
            const f32x4 v = *(const LAS f32x4*)(os + t * CV_OSROW + 4 * F.lane);
            const float mu = wave_sum((v[0] + v[1]) + (v[2] + v[3])) * (1.f / 256.f);
            const f32x4 d = v - mu;
            const float var = wave_sum((d[0] * d[0] + d[1] * d[1]) + (d[2] * d[2] + d[3] * d[3])) * (1.f / 256.f);
            const f32x4 y = d * rsqrtf(var + EPS) * lg + lb;
            v2u o; o.x = pk2(siluf_(y[0]), siluf_(y[1])); o.y = pk2(siluf_(y[2]), siluf_(y[3]));
            *(v2u*)(MIX + (size_t)(row0 + t) * D + 4 * F.lane) = o; }
    }
}

typedef short s16x8 __attribute__((ext_vector_type(8)));
typedef short s16x4 __attribute__((ext_vector_type(4)));
constexpr int NA_KROW = 144, NA_VROW = 160;
constexpr int NA_STAGE = 64 * NA_KROW + 64 * NA_VROW, NA_SLOT = 2 * NA_STAGE, NA_OFF_TB = 2 * NA_SLOT;
static_assert(NA_OFF_TB + 2560 <= RING_BYTES, "NA LDS map");
constexpr int NA_ITEMS_LAT = NB * NH * 8, NA_ITEMS_CTX = NB * NH * 2;
struct NaBlk { f32x4 O[4]; float m, lsum; int first; };
__device__ __forceinline__ int na_rs(int r) { int v = r - 4; return v < 0 ? 0 : (v > 24 ? 24 : v); }
__device__ __forceinline__ s16x8 na_scale_q(v4u w, float c) {
    v4u o; o.x = pg8::cvt_pk_bf16(bflo(w.x) * c, bfhi(w.x) * c); o.y = pg8::cvt_pk_bf16(bflo(w.y) * c, bfhi(w.y) * c); o.z = pg8::cvt_pk_bf16(bflo(w.z) * c, bfhi(w.z) * c); o.w = pg8::cvt_pk_bf16(bflo(w.w) * c, bfhi(w.w) * c);
    return __builtin_bit_cast(s16x8, o);
}
__device__ __forceinline__ void na_phase(Frame& F, int l, int nitems, int nav = 0) {
    const bf16* PROJ = WSP(const bf16, WS_PROJ); bf16* MIX = WSP(bf16, WS_MIX);
    LAS float* tb = (LAS float*)(F.lds + NA_OFF_TB);
    const int lane = F.lane, q16 = lane & 15, g = lane >> 4;
    const unsigned skey = (unsigned)(F.tid >> 3), spart = (unsigned)(F.tid & 7);
    const float c1 = 0.125f * 1.4426950408889634f;
    for (int it = F.vcu; it < nitems; it += F.G) {
        const bool isctx = it >= NA_ITEMS_LAT;
        int b, h, ra = 0, jq = 0, qrow0, rsI = 0, nloc = 0;
        if (!isctx) { const int r4 = it & 7; h = (it >> 3) & 7; b = it >> 6; const int r0 = 4 * r4; ra = r0 + 2 * (F.wave >> 2); jq = F.wave & 3; qrow0 = b * SEQ + ra * 64 + jq * 16;
            rsI = na_rs(r0); nloc = na_rs(r0 + 3) + 8 - rsI; }
        else { const int j = it - NA_ITEMS_LAT; const int hf = j & 1; h = (j >> 1) & 7; b = j >> 4; qrow0 = ML + b * CTXL + hf * 128 + F.wave * 16; }
        const int nch = nloc + 4;
        const bf16* Pq = PROJ + 512 + h * HD, * Pk = PROJ + 1024 + h * HD + 8 * spart, * Pv = PROJ + 1536 + h * HD + 8 * spart;
        auto krow_of = [&](int ch) -> int { if (ch > nch - 1) ch = nch - 1; return ch < nloc ? b * SEQ + (rsI + ch) * 64 : ML + b * CTXL + (ch - nloc) * 64; };
        s16x8 qfA[2], qfB[2];
#pragma unroll
        for (int s_ = 0; s_ < 2; ++s_) { qfA[s_] = na_scale_q(*(const v4u*)(Pq + (size_t)(qrow0 + q16) * IND + 32 * s_ + 8 * g), c1);
            qfB[s_] = isctx ? qfA[s_] : na_scale_q(*(const v4u*)(Pq + (size_t)(qrow0 + 64 + q16) * IND + 32 * s_ + 8 * g), c1); }
        const int rsA = na_rs(ra), rsB = na_rs(ra + 1);
        const int o0 = jq == 0 ? 0 : 16 * jq - 8, o1 = jq == 0 ? 16 : (jq == 3 ? 48 : 16 * jq + 8);
        float madd[2][4]; int lb[2];
        {
            const int qc = jq * 16 + q16; int cs = qc - 8; cs = cs < 0 ? 0 : (cs > 48 ? 48 : cs);
#pragma unroll
            for (int e = 0; e < 4; ++e) { const int k0 = o0 + 4 * g + e, k1 = o1 + 4 * g + e;
                madd[0][e] = ((unsigned)(k0 - cs) < 16u) ? 0.f : -1.0e30f;
                madd[1][e] = (((unsigned)(k1 - cs) < 16u) && !(jq == 3 && k1 < 56)) ? 0.f : -1.0e30f; }
            lb[0] = 64 + o0 + 4 * g - qc + 15; lb[1] = 64 + o1 + 4 * g - qc + 15;
        }
        const int npair = (nch + 1) >> 1;
        v4u kr0 = *(const v4u*)(Pk + (size_t)(krow_of(0) + (int)skey) * IND), vr0 = *(const v4u*)(Pv + (size_t)(krow_of(0) + (int)skey) * IND);
        v4u kr1 = *(const v4u*)(Pk + (size_t)(krow_of(1) + (int)skey) * IND), vr1 = *(const v4u*)(Pv + (size_t)(krow_of(1) + (int)skey) * IND);
        __syncthreads();
        if (!isctx) { const float* rpb = INP(14) + ((size_t)l * NH + h) * 15 * 31;
            for (int i = F.tid; i < 640; i += NWAVES * 64) tb[i] = (i >= 64 && i < 64 + 465) ? rpb[i - 64] * 1.4426950408889634f : 0.f; }
        {
            LAS unsigned char* s0 = F.lds;
            *(LAS v4u*)(s0 + skey * NA_KROW + spart * 16) = kr0; *(LAS v4u*)(s0 + 64 * NA_KROW + skey * NA_VROW + spart * 16) = vr0;
            *(LAS v4u*)(s0 + NA_STAGE + skey * NA_KROW + spart * 16) = kr1; *(LAS v4u*)(s0 + NA_STAGE + 64 * NA_KROW + skey * NA_VROW + spart * 16) = vr1;
        }
        kr0 = *(const v4u*)(Pk + (size_t)(krow_of(2) + (int)skey) * IND); vr0 = *(const v4u*)(Pv + (size_t)(krow_of(2) + (int)skey) * IND);
        kr1 = *(const v4u*)(Pk + (size_t)(krow_of(3) + (int)skey) * IND); vr1 = *(const v4u*)(Pv + (size_t)(krow_of(3) + (int)skey) * IND);
        NaBlk A, B;
#pragma unroll
        for (int dt = 0; dt < 4; ++dt) { A.O[dt] = (f32x4){0.f, 0.f, 0.f, 0.f}; B.O[dt] = (f32x4){0.f, 0.f, 0.f, 0.f}; }
        A.m = 0.f; A.lsum = 0.f; A.first = 1; B.m = 0.f; B.lsum = 0.f; B.first = 1;
        for (int cp = 0; cp < npair; ++cp) {
            __syncthreads();
            if (cp + 1 < npair) { LAS unsigned char* nx = F.lds + ((cp + 1) & 1) * NA_SLOT;
                *(LAS v4u*)(nx + skey * NA_KROW + spart * 16) = kr0; *(LAS v4u*)(nx + 64 * NA_KROW + skey * NA_VROW + spart * 16) = vr0;
                *(LAS v4u*)(nx + NA_STAGE + skey * NA_KROW + spart * 16) = kr1; *(LAS v4u*)(nx + NA_STAGE + 64 * NA_KROW + skey * NA_VROW + spart * 16) = vr1; }
            if (cp + 2 < npair) { const int k2 = krow_of(2 * cp + 4) + (int)skey, k3 = krow_of(2 * cp + 5) + (int)skey;
                kr0 = *(const v4u*)(Pk + (size_t)k2 * IND); vr0 = *(const v4u*)(Pv + (size_t)k2 * IND); kr1 = *(const v4u*)(Pk + (size_t)k3 * IND); vr1 = *(const v4u*)(Pv + (size_t)k3 * IND); }
          for (int sub = 0; sub < 2; ++sub) {
            const int ch = 2 * cp + sub;
            if (ch >= nch) break;
            LAS unsigned char* cur = F.lds + (cp & 1) * NA_SLOT + sub * NA_STAGE;
            const bool local = ch < nloc;
            const int kr = rsI + ch;
            const bool actA = !local || (kr >= rsA && kr <= rsA + 7), actB = !isctx && (!local || (kr >= rsB && kr <= rsB + 7));
            if ((!actA && !actB) || nav == 1) continue;
            auto finish = [&](f32x4* S, int nt_, NaBlk& X, unsigned (*pk)[2], float cm) {
                if (X.first || !__all(cm <= 8.f)) {
                    cm = fmaxf(cm, __shfl_xor(cm, 16)); cm = fmaxf(cm, __shfl_xor(cm, 32));
                    const float d = X.first ? cm : fmaxf(cm, 0.f);
                    if (!X.first) { const float alpha = __builtin_amdgcn_exp2f(-d); X.lsum *= alpha;
#pragma unroll
                        for (int dt = 0; dt < 4; ++dt) X.O[dt] = X.O[dt] * alpha; }
                    X.m += d; X.first = 0;
#pragma unroll
                    for (int t = 0; t < 4; ++t) if (t < nt_) S[t] = S[t] - d;
                }
                float ps = 0.f;
#pragma unroll
                for (int t = 0; t < 4; ++t) if (t < nt_) {
                    const float p0 = __builtin_amdgcn_exp2f(S[t][0]), p1 = __builtin_amdgcn_exp2f(S[t][1]), p2 = __builtin_amdgcn_exp2f(S[t][2]), p3 = __builtin_amdgcn_exp2f(S[t][3]);
                    ps += (p0 + p1) + (p2 + p3);
                    pk[t][0] = pg8::cvt_pk_bf16(p0, p1); pk[t][1] = pg8::cvt_pk_bf16(p2, p3); }
                X.lsum += ps;
            };
            unsigned pkA[4][2], pkB[4][2];
            if (local) {
                const LAS unsigned char* kb_ = cur + q16 * NA_KROW + 16 * g;
                f32x4 SA[2], SB[2];
#pragma unroll
                for (int t = 0; t < 2; ++t) { const float ma = -A.m, mb = -B.m; SA[t] = (f32x4){ma, ma, ma, ma}; SB[t] = (f32x4){mb, mb, mb, mb};
                    const int o = t == 0 ? o0 : o1;
#pragma unroll
                    for (int s_ = 0; s_ < 2; ++s_) { const s16x8 kf = *(const LAS s16x8*)(kb_ + o * NA_KROW + 64 * s_);
                        if (actA) SA[t] = __builtin_amdgcn_mfma_f32_16x16x32_bf16(kf, qfA[s_], SA[t], 0, 0, 0);
                        if (actB) SB[t] = __builtin_amdgcn_mfma_f32_16x16x32_bf16(kf, qfB[s_], SB[t], 0, 0, 0); } }
                if (nav == 2) { asm volatile("" :: "v"(SA[0]), "v"(SA[1]), "v"(SB[0]), "v"(SB[1])); continue; }
                auto soft_local = [&](f32x4 (&S)[2], NaBlk& X, unsigned (&pk)[4][2], int rq) {
                    float cm = -1.0e30f;
#pragma unroll
                    for (int t = 0; t < 2; ++t) { const LAS float* tr_ = tb + (kr - rq + 7) * 31 + lb[t];
#pragma unroll
                        for (int e = 0; e < 4; ++e) { const float v = (S[t][e] + tr_[e]) + madd[t][e]; S[t][e] = v; cm = fmaxf(cm, v); } }
                    finish(S, 2, X, pk, cm);
                };
                if (actA) soft_local(SA, A, pkA, ra);
                if (actB) soft_local(SB, B, pkB, ra + 1);
                if (nav == 3) { asm volatile("" :: "v"(pkA[0][0]), "v"(pkA[1][1]), "v"(pkB[0][0]), "v"(pkB[1][1])); continue; }
                const LAS unsigned char* vtr = cur + 64 * NA_KROW + (4 * g + (q16 >> 2)) * NA_VROW + (q16 & 3) * 8;
                const v4u bwA = {pkA[0][0], pkA[0][1], pkA[1][0], pkA[1][1]}, bwB = {pkB[0][0], pkB[0][1], pkB[1][0], pkB[1][1]};
                const s16x8 bfA = __builtin_bit_cast(s16x8, bwA), bfB = __builtin_bit_cast(s16x8, bwB);
#pragma unroll
                for (int dt = 0; dt < 4; ++dt) {
                    const s16x4 a0 = __builtin_amdgcn_ds_read_tr16_b64_v4i16((LAS s16x4*)(vtr + o0 * NA_VROW + dt * 32));
                    const s16x4 a1 = __builtin_amdgcn_ds_read_tr16_b64_v4i16((LAS s16x4*)(vtr + o1 * NA_VROW + dt * 32));
                    const s16x8 afrag = __builtin_shufflevector(a0, a1, 0, 1, 2, 3, 4, 5, 6, 7);
                    if (actA) A.O[dt] = __builtin_amdgcn_mfma_f32_16x16x32_bf16(afrag, bfA, A.O[dt], 0, 0, 0);
                    if (actB) B.O[dt] = __builtin_amdgcn_mfma_f32_16x16x32_bf16(afrag, bfB, B.O[dt], 0, 0, 0);
                }
            } else {
                const LAS unsigned char* kb_ = cur + q16 * NA_KROW + 16 * g;
                f32x4 SA[4], SB[4];
#pragma unroll
                for (int t = 0; t < 4; ++t) { const float ma = -A.m, mb = -B.m; SA[t] = (f32x4){ma, ma, ma, ma}; SB[t] = (f32x4){mb, mb, mb, mb};
#pragma unroll
                    for (int s_ = 0; s_ < 2; ++s_) { const s16x8 kf = *(const LAS s16x8*)(kb_ + t * 16 * NA_KROW + 64 * s_);
                        SA[t] = __builtin_amdgcn_mfma_f32_16x16x32_bf16(kf, qfA[s_], SA[t], 0, 0, 0);
                        if (actB) SB[t] = __builtin_amdgcn_mfma_f32_16x16x32_bf16(kf, qfB[s_], SB[t], 0, 0, 0); } }
                if (nav == 2) { asm volatile("" :: "v"(SA[0]), "v"(SA[1]), "v"(SA[2]), "v"(SA[3]), "v"(SB[0]), "v"(SB[1]), "v"(SB[2]), "v"(SB[3])); continue; }
                auto soft_ctx = [&](f32x4 (&S)[4], NaBlk& X, unsigned (&pk)[4][2]) {
                    float cm = -1.0e30f;
#pragma unroll
                    for (int t = 0; t < 4; ++t)
#pragma unroll
                        for (int e = 0; e < 4; ++e) cm = fmaxf(cm, S[t][e]);
                    finish(S, 4, X, pk, cm);
                };
                soft_ctx(SA, A, pkA);
                if (actB) soft_ctx(SB, B, pkB);
                if (nav == 3) { asm volatile("" :: "v"(pkA[0][0]), "v"(pkA[1][1]), "v"(pkA[2][0]), "v"(pkA[3][1]), "v"(pkB[0][0]), "v"(pkB[1][1]), "v"(pkB[2][0]), "v"(pkB[3][1])); continue; }
                const LAS unsigned char* vtr = cur + 64 * NA_KROW + (4 * g + (q16 >> 2)) * NA_VROW + (q16 & 3) * 8;
#pragma unroll
                for (int p = 0; p < 2; ++p) {
                    const v4u bwA = {pkA[2 * p][0], pkA[2 * p][1], pkA[2 * p + 1][0], pkA[2 * p + 1][1]}, bwB = {pkB[2 * p][0], pkB[2 * p][1], pkB[2 * p + 1][0], pkB[2 * p + 1][1]};
                    const s16x8 bfA = __builtin_bit_cast(s16x8, bwA), bfB = __builtin_bit_cast(s16x8, bwB);
#pragma unroll
                    for (int dt = 0; dt < 4; ++dt) {
                        const s16x4 a0 = __builtin_amdgcn_ds_read_tr16_b64_v4i16((LAS s16x4*)(vtr + (2 * p) * 16 * NA_VROW + dt * 32));
                        const s16x4 a1 = __builtin_amdgcn_ds_read_tr16_b64_v4i16((LAS s16x4*)(vtr + (2 * p + 1) * 16 * NA_VROW + dt * 32));
                        const s16x8 afrag = __builtin_shufflevector(a0, a1, 0, 1, 2, 3, 4, 5, 6, 7);
                        A.O[dt] = __builtin_amdgcn_mfma_f32_16x16x32_bf16(afrag, bfA, A.O[dt], 0, 0, 0);
                        if (actB) B.O[dt] = __builtin_amdgcn_mfma_f32_16x16x32_bf16(afrag, bfB, B.O[dt], 0, 0, 0);
                    }
                }
            }
          }
        }
        {
            float ls = A.lsum; ls += __shfl_xor(ls, 16); ls += __shfl_xor(ls, 32);
            const float inv = __builtin_amdgcn_rcpf(ls);
            bf16* op = MIX + (size_t)(qrow0 + q16) * D + 256 + h * HD + 4 * g;
#pragma unroll
            for (int dt = 0; dt < 4; ++dt) { v2u w; w.x = pg8::cvt_pk_bf16(A.O[dt][0] * inv, A.O[dt][1] * inv); w.y = pg8::cvt_pk_bf16(A.O[dt][2] * inv, A.O[dt][3] * inv); *(v2u*)(op + 16 * dt) = w; }
        }
        if (!isctx) {
            float ls = B.lsum; ls += __shfl_xor(ls, 16); ls += __shfl_xor(ls, 32);
            const float inv = __builtin_amdgcn_rcpf(ls);
            bf16* op = MIX + (size_t)(qrow0 + 64 + q16) * D + 256 + h * HD + 4 * g;
#pragma unroll
            for (int dt = 0; dt < 4; ++dt) { v2u w; w.x = pg8::cvt_pk_bf16(B.O[dt][0] * inv, B.O[dt][1] * inv); w.y = pg8::cvt_pk_bf16(B.O[dt][2] * inv, B.O[dt][3] * inv); *(v2u*)(op + 16 * dt) = w; }
        }
    }
}

constexpr int LRU_UCROW = 260;
constexpr int LRU_OFF_UC = 38 * 256 * 2, LRU_OFF_GT = LRU_OFF_UC + 2 * 32 * LRU_UCROW * 4;
static_assert(LRU_OFF_GT + 32 * 256 * 2 <= RING_BYTES, "LRU LDS map");
template <int PASS>
__device__ __forceinline__ void lru_phase(Frame& F, int l, int ntiles) {
    const bf16* PROJ = WSP(const bf16, WS_PROJ);
    LAS bf16* rxs = (LAS bf16*)(F.lds);
    LAS float* ucf = (LAS float*)(F.lds + LRU_OFF_UC);
    LAS bf16* gts = (LAS bf16*)(F.lds + LRU_OFF_GT);
    const int lane = F.lane, j16 = lane & 15, g = lane >> 4;
    const int kb = F.wave & 3, nh = F.wave >> 2;
    s16x8 wf[2][2][2][2];
    float cbx[2][2], cba[2][2], csp[2][2];
#pragma unroll
    for (int dir = 0; dir < 2; ++dir) {
        const int ld = l * 2 + dir;
        const bf16* WLR = WSP(const bf16, WS_WLR) + (size_t)((ld * 4 + kb) * 2) * 4096;
#pragma unroll
        for (int gt = 0; gt < 2; ++gt)
#pragma unroll
            for (int n2 = 0; n2 < 2; ++n2)
#pragma unroll
                for (int s_ = 0; s_ < 2; ++s_) wf[dir][gt][n2][s_] = *(const s16x8*)(WLR + gt * 4096 + (16 * (2 * nh + n2) + j16) * 64 + 32 * s_ + 8 * g);
#pragma unroll
        for (int n2 = 0; n2 < 2; ++n2) {
            const int e = kb * 64 + 16 * (2 * nh + n2) + j16, idx = ld * 256 + e;
            cbx[dir][n2] = INP(18)[idx]; cba[dir][n2] = INP(20)[idx];
            const float nl = -INP(21)[idx]; csp[dir][n2] = -8.f * (fmaxf(nl, 0.f) + log1pf(__expf(-fabsf(nl))));
        }
    }
    const int c = F.tid & 255, sdir = F.tid >> 8;
    const int sld = l * 2 + sdir;
    const float s1w0 = INP(15)[(sld * 4 + 0) * 256 + c], s1w1 = INP(15)[(sld * 4 + 1) * 256 + c], s1w2 = INP(15)[(sld * 4 + 2) * 256 + c], s1w3 = INP(15)[(sld * 4 + 3) * 256 + c], s1cb = INP(16)[sld * 256 + c];
    const int base = sdir == 0 ? 0 : 3;
    unsigned pre[10], pgw[8];
    auto load_tile = [&](int T) {
        const int row0 = T * 32;
        int lo, hi; if (row0 < ML) { lo = row0 & ~(SEQ - 1); hi = lo + SEQ; } else { lo = row0 & ~(CTXL - 1); hi = lo + CTXL; }
#pragma unroll
        for (int j = 0; j < 10; ++j) { const int i = F.tid + 512 * j, rr = i >> 7, cp = i & 127, row = row0 - 3 + rr;
            const bool ok = (j < 9 || F.tid < 256) && row >= lo && row < hi;
            pre[j] = ok ? *(const unsigned*)(PROJ + (size_t)row * IND + 2048 + 2 * cp) : 0u; }
        if (PASS == 1) {
#pragma unroll
            for (int j = 0; j < 8; ++j) { const int i = F.tid + 512 * j, t = i >> 7, cp = i & 127; pgw[j] = *(const unsigned*)(PROJ + (size_t)(row0 + t) * IND + 2304 + 2 * cp); }
        }
    };
    if (F.vcu < ntiles) load_tile(F.vcu);
    for (int T = F.vcu; T < ntiles; T += F.G) {
        const int row0 = T * 32;
        __syncthreads();
#pragma unroll
        for (int j = 0; j < 10; ++j) { const int i = F.tid + 512 * j; if (j < 9 || F.tid < 256) ((LAS unsigned*)rxs)[i] = pre[j]; }
        if (PASS == 1) {
#pragma unroll
            for (int j = 0; j < 8; ++j) ((LAS unsigned*)gts)[F.tid + 512 * j] = pgw[j];
        }
        if (T + F.G < ntiles) load_tile(T + F.G);
        float hst[2][2];
#pragma unroll
        for (int dir = 0; dir < 2; ++dir)
#pragma unroll
            for (int n2 = 0; n2 < 2; ++n2) hst[dir][n2] = PASS == 1 ? WSP(const float, WS_CARRY)[((size_t)dir * 1152 + T) * 256 + kb * 64 + 16 * (2 * nh + n2) + j16] : 0.f;
        __syncthreads();
        {
            float x0 = bf1(rxs[(base + 0) * 256 + c]), x1 = bf1(rxs[(base + 1) * 256 + c]), x2 = bf1(rxs[(base + 2) * 256 + c]);
#pragma unroll 8
            for (int t = 0; t < 32; ++t) {
                const float x3 = bf1(rxs[(t + base + 3) * 256 + c]);
                ucf[(sdir * 32 + t) * LRU_UCROW + c] = s1cb + s1w0 * x0 + s1w1 * x1 + s1w2 * x2 + s1w3 * x3;
                x0 = x1; x1 = x2; x2 = x3;
            }
        }
        __syncthreads();
        float hf[2][2][4];
        float Pt[2][2] = {{1.f, 1.f}, {1.f, 1.f}};
#pragma unroll
        for (int dir = 0; dir < 2; ++dir) {
            const bool sec16 = ((g & 1) != 0) != (dir != 0), sec32 = ((g >> 1) != 0) != (dir != 0);
#pragma unroll
            for (int step = 0; step < 2; ++step) {
                const int rt = dir == 0 ? step : 1 - step;
                s16x8 af[2];
#pragma unroll
                for (int s_ = 0; s_ < 2; ++s_) { const LAS float* up = ucf + (dir * 32 + 16 * rt + j16) * LRU_UCROW + kb * 64 + 32 * s_ + 8 * g;
                    const f32x4 u0 = *(const LAS f32x4*)up, u1 = *(const LAS f32x4*)(up + 4);
                    const v4u w = {pg8::cvt_pk_bf16(u0[0], u0[1]), pg8::cvt_pk_bf16(u0[2], u0[3]), pg8::cvt_pk_bf16(u1[0], u1[1]), pg8::cvt_pk_bf16(u1[2], u1[3])};
                    af[s_] = __builtin_bit_cast(s16x8, w); }
#pragma unroll
                for (int n2 = 0; n2 < 2; ++n2) {
                    f32x4 zx = {0.f, 0.f, 0.f, 0.f}, za = {0.f, 0.f, 0.f, 0.f};
#pragma unroll
                    for (int s_ = 0; s_ < 2; ++s_) { zx = __builtin_amdgcn_mfma_f32_16x16x32_bf16(af[s_], wf[dir][0][n2][s_], zx, 0, 0, 0); za = __builtin_amdgcn_mfma_f32_16x16x32_bf16(af[s_], wf[dir][1][n2][s_], za, 0, 0, 0); }
                    const int e = kb * 64 + 16 * (2 * nh + n2) + j16;
                    const LAS float* uo = ucf + (dir * 32 + 16 * rt + 4 * g) * LRU_UCROW + e;
                    float a_[4], b_[4]; unsigned abw[4];
#pragma unroll
                    for (int r = 0; r < 4; ++r) {
                        const float u = uo[r * LRU_UCROW];
                        const float gx = sigmoidf_(zx[r] + cbx[dir][n2]), ga = sigmoidf_(za[r] + cba[dir][n2]);
                        const float la = csp[dir][n2] * ga, a = __builtin_amdgcn_exp2f(1.4426950408889634f * la), y = 2.f * la;
                        const float om = y > -0.02f ? -y * (1.f + y * (0.5f + y * 0.16666667f)) : 1.f - a * a;
                        a_[r] = a; b_[r] = __builtin_amdgcn_sqrtf(om) * gx * u;
                        if (PASS == 0) {
                            const float oma = la > -0.02f ? -la * (1.f + la * (0.5f + la * 0.16666667f)) : 1.f - a;
                            abw[r] = pg8::cvt_pk_bf16(oma, b_[r]); a_[r] = 1.f - bflo(abw[r]); b_[r] = bfhi(abw[r]);
                        }
                    }
                    if (PASS == 0) WSP(v4u, WS_AB)[(((((size_t)T * 2 + dir) * 2 + rt) * 8 + F.wave) * 2 + n2) * 64 + lane] = (v4u){abw[0], abw[1], abw[2], abw[3]};
                    const float P = (a_[0] * a_[1]) * (a_[2] * a_[3]);
                    const float S = dir == 0 ? ((b_[0] * a_[1] + b_[1]) * a_[2] + b_[2]) * a_[3] + b_[3] : ((b_[3] * a_[2] + b_[2]) * a_[1] + b_[1]) * a_[0] + b_[0];
                    const float Pp = __shfl_xor(P, 16), Sp = __shfl_xor(S, 16);
                    const float e1P = sec16 ? Pp : 1.f, e1S = sec16 ? Sp : 0.f;
                    const float prP = P * Pp, prS = sec16 ? P * Sp + S : Pp * S + Sp;
                    const float Pq = __shfl_xor(prP, 32), Sq = __shfl_xor(prS, 32);
                    const float EP = sec32 ? Pq * e1P : e1P, ES = sec32 ? e1P * Sq + e1S : e1S;
                    const float TP = prP * Pq, TS = sec32 ? prP * Sq + prS : Pq * prS + Sq;
                    if (PASS == 1) {
                        float h = EP * hst[dir][n2] + ES;
                        if (dir == 0) {
#pragma unroll
                            for (int r = 0; r < 4; ++r) { h = a_[r] * h + b_[r]; hf[rt][n2][r] = h; }
                        } else {
                            float hb[4];
#pragma unroll
                            for (int r = 3; r >= 0; --r) { h = a_[r] * h + b_[r]; hb[r] = h; }
                            bf16* mp = WSP(bf16, WS_MIX) + (size_t)(row0 + 16 * rt + 4 * g) * D + 768 + e;
                            const LAS bf16* gp = gts + (16 * rt + 4 * g) * 256 + e;
#pragma unroll
                            for (int r = 0; r < 4; ++r) mp[(size_t)r * D] = (bf16)f2bf(gelu_tanh(bf1(gp[r * 256])) * (hf[rt][n2][r] + hb[r]));
                        }
                    } else Pt[dir][n2] *= TP;
                    hst[dir][n2] = TP * hst[dir][n2] + TS;
                }
            }
        }
        if (PASS == 0 && g == 0) {
#pragma unroll
            for (int dir = 0; dir < 2; ++dir)
#pragma unroll
                for (int n2 = 0; n2 < 2; ++n2) WSP(f32x2, WS_TOT)[((size_t)dir * 1152 + T) * 256 + kb * 64 + 16 * (2 * nh + n2) + j16] = (f32x2){Pt[dir][n2], hst[dir][n2]};
        }
    }
}
__device__ __forceinline__ void lru_scan_phase(Frame& F, int l, int ntiles) {
    const bf16* PROJ = WSP(const bf16, WS_PROJ);
    LAS bf16* gts = (LAS bf16*)(F.lds);
    const int lane = F.lane, j16 = lane & 15, g = lane >> 4;
    const int kb = F.wave & 3, nh = F.wave >> 2;
    const v4u* AB = WSP(const v4u, WS_AB);
    v4u pab[2][2][2]; unsigned pgw[8];
    auto load_tile = [&](int T) {
#pragma unroll
        for (int dir = 0; dir < 2; ++dir)
#pragma unroll
            for (int rt = 0; rt < 2; ++rt)
#pragma unroll
                for (int n2 = 0; n2 < 2; ++n2) pab[dir][rt][n2] = AB[(((((size_t)T * 2 + dir) * 2 + rt) * 8 + F.wave) * 2 + n2) * 64 + lane];
#pragma unroll
        for (int j = 0; j < 8; ++j) { const int i = F.tid + 512 * j, t = i >> 7, cp = i & 127; pgw[j] = *(const unsigned*)(PROJ + (size_t)(T * 32 + t) * IND + 2304 + 2 * cp); }
    };
    if (F.vcu < ntiles) load_tile(F.vcu);
    for (int T = F.vcu; T < ntiles; T += F.G) {
        const int row0 = T * 32;
        __syncthreads();
#pragma unroll
        for (int j = 0; j < 8; ++j) ((LAS unsigned*)gts)[F.tid + 512 * j] = pgw[j];
        v4u cur[2][2][2];
#pragma unroll
        for (int dir = 0; dir < 2; ++dir)
#pragma unroll
            for (int rt = 0; rt < 2; ++rt)
#pragma unroll
                for (int n2 = 0; n2 < 2; ++n2) cur[dir][rt][n2] = pab[dir][rt][n2];
        float hst[2][2];
#pragma unroll
        for (int dir = 0; dir < 2; ++dir)
#pragma unroll
            for (int n2 = 0; n2 < 2; ++n2) hst[dir][n2] = WSP(const float, WS_CARRY)[((size_t)dir * 1152 + T) * 256 + kb * 64 + 16 * (2 * nh + n2) + j16];
        if (T + F.G < ntiles) load_tile(T + F.G);
        __syncthreads();
        float hf[2][2][4];
#pragma unroll
        for (int dir = 0; dir < 2; ++dir) {
            const bool sec16 = ((g & 1) != 0) != (dir != 0), sec32 = ((g >> 1) != 0) != (dir != 0);
#pragma unroll
            for (int step = 0; step < 2; ++step) {
                const int rt = dir == 0 ? step : 1 - step;
#pragma unroll
                for (int n2 = 0; n2 < 2; ++n2) {
                    const int e = kb * 64 + 16 * (2 * nh + n2) + j16;
                    const v4u w = cur[dir][rt][n2];
                    const float a_[4] = {1.f - bflo(w.x), 1.f - bflo(w.y), 1.f - bflo(w.z), 1.f - bflo(w.w)}, b_[4] = {bfhi(w.x), bfhi(w.y), bfhi(w.z), bfhi(w.w)};
                    const float P = (a_[0] * a_[1]) * (a_[2] * a_[3]);
                    const float S = dir == 0 ? ((b_[0] * a_[1] + b_[1]) * a_[2] + b_[2]) * a_[3] + b_[3] : ((b_[3] * a_[2] + b_[2]) * a_[1] + b_[1]) * a_[0] + b_[0];
                    const float Pp = __shfl_xor(P, 16), Sp = __shfl_xor(S, 16);
                    const float e1P = sec16 ? Pp : 1.f, e1S = sec16 ? Sp : 0.f;
                    const float prP = P * Pp, prS = sec16 ? P * Sp + S : Pp * S + Sp;
                    const float Pq = __shfl_xor(prP, 32), Sq = __shfl_xor(prS, 32);
                    const float EP = sec32 ? Pq * e1P : e1P, ES = sec32 ? e1P * Sq + e1S : e1S;
                    const float TP = prP * Pq, TS = sec32 ? prP * Sq + prS : Pq * prS + Sq;
                    float h = EP * hst[dir][n2] + ES;
                    if (dir == 0) {
#pragma unroll
                        for (int r = 0; r < 4; ++r) { h = a_[r] * h + b_[r]; hf[rt][n2][r] = h; }
                    } else {
                        float hb[4];
#pragma unroll
                        for (int r = 3; r >= 0; --r) { h = a_[r] * h + b_[r]; hb[r] = h; }
                        bf16* mp = WSP(bf16, WS_MIX) + (size_t)(row0 + 16 * rt + 4 * g) * D + 768 + e;
                        const LAS bf16* gp = gts + (16 * rt + 4 * g) * 256 + e;
#pragma unroll
                        for (int r = 0; r < 4; ++r) mp[(size_t)r * D] = (bf16)f2bf(gelu_tanh(bf1(gp[r * 256])) * (hf[rt][n2][r] + hb[r]));
                    }
                    hst[dir][n2] = TP * hst[dir][n2] + TS;
                }
            }
        }
    }
}

__device__ __forceinline__ void lru_carry(Frame& F) {
    const f32x2* TOT = WSP(const f32x2, WS_TOT); float* CARRY = WSP(float, WS_CARRY);
    for (int it = F.gw; it < NB * 2 * 4; it += F.NGW) {
        const int b = it >> 3, dir = (it >> 2) & 1, c = (it & 3) * 64 + F.lane;
        float h = 0.f;
        for (int g = 0; g < 18; ++g) {
            f32x2 ps[4]; int tl[4];
#pragma unroll
            for (int i = 0; i < 4; ++i) { const int s = g * 4 + i;
                int T; if (s < 8) T = 1024 + b * 8 + (dir == 0 ? s : 7 - s); else T = b * 64 + (dir == 0 ? s - 8 : 71 - s);
                tl[i] = T; ps[i] = TOT[((size_t)dir * 1152 + T) * 256 + c]; }
#pragma unroll
            for (int i = 0; i < 4; ++i) { CARRY[((size_t)dir * 1152 + tl[i]) * 256 + c] = h; h = ps[i][0] * h + ps[i][1]; }
        }
    }
}

__device__ __forceinline__ void ctx_finalize(Frame& F, int l) {
    bf16* XA = WSP(bf16, WS_XA); float* RSSA = WSP(float, WS_RSSA); const float* ACC = WSP(const float, WS_PART); const float* MOD = WSP(const float, WS_MOD);
    const float* go = INP(5) + (l - 1) * D; const float* gso = MOD + ((size_t)(l - 1) * 17 + NB) * MODW + 4 * D;
    const float* gn = INP(4) + l * D; const float* gsn = MOD + ((size_t)l * 17 + NB) * MODW + D;
    for (int r = F.gw; r < MC; r += F.NGW) {
        const size_t row = (size_t)ML + r;
        float ss = 0.f; f32x4 y[4];
#pragma unroll
        for (int j = 0; j < 4; ++j) { const int k = 4 * F.lane + 256 * j;
            const v2u w = *(const v2u*)(XA + row * D + k);
            const f32x4 im = *(const f32x4*)(go + k) * (*(const f32x4*)(gso + k) + 1.0f);
            const f32x4 xo = (f32x4){bflo(w.x) * __builtin_amdgcn_rcpf(im[0]), bfhi(w.x) * __builtin_amdgcn_rcpf(im[1]), bflo(w.y) * __builtin_amdgcn_rcpf(im[2]), bfhi(w.y) * __builtin_amdgcn_rcpf(im[3])};
            const float* ap = ACC + (size_t)r * D + k;
            y[j] = xo + ((*(const f32x4*)ap + *(const f32x4*)(ap + (size_t)MC * D)) + (*(const f32x4*)(ap + (size_t)2 * MC * D) + *(const f32x4*)(ap + (size_t)3 * MC * D)));
            ss += (y[j][0] * y[j][0] + y[j][1] * y[j][1]) + (y[j][2] * y[j][2] + y[j][3] * y[j][3]); }
        ss = wave_sum(ss);
        if (F.lane < 32) RSSA[row * 32 + F.lane] = (F.lane == 0) ? ss : 0.f;
#pragma unroll
        for (int j = 0; j < 4; ++j) { const int k = 4 * F.lane + 256 * j;
            const f32x4 a = y[j] * (*(const f32x4*)(gn + k) * (*(const f32x4*)(gsn + k) + 1.0f));
            v2u o; o.x = pk2(a[0], a[1]); o.y = pk2(a[2], a[3]); *(v2u*)(XA + row * D + k) = o; }
    }
}

__device__ __forceinline__ void final_rows(Frame& F) {
    const bf16* XA = WSP(const bf16, WS_XA); const float* RSS = WSP(const float, WS_RSSA);
    for (int row = F.gw; row < ML; row += 2 * F.NGW) {
        const int row2 = row + F.NGW; const bool two = row2 < ML;
        const v4u a0 = *(const v4u*)(XA + (size_t)row * D + 8 * F.lane), a1 = *(const v4u*)(XA + (size_t)row * D + 512 + 8 * F.lane);
        const float p0 = F.lane < 32 ? RSS[(size_t)row * 32 + F.lane] : 0.f;
        v4u b0 = a0, b1 = a1; float p1 = 0.f;
        if (two) { b0 = *(const v4u*)(XA + (size_t)row2 * D + 8 * F.lane); b1 = *(const v4u*)(XA + (size_t)row2 * D + 512 + 8 * F.lane); p1 = F.lane < 32 ? RSS[(size_t)row2 * 32 + F.lane] : 0.f; }
        const float rs0 = rsqrtf(wave_sum(p0) * (1.f / D) + EPS), rs1 = rsqrtf(wave_sum(p1) * (1.f / D) + EPS);
        float* o = F.out + (size_t)row * D + 8 * F.lane;
        *(f32x4*)(o) = (f32x4){bflo(a0.x), bfhi(a0.x), bflo(a0.y), bfhi(a0.y)} * rs0; *(f32x4*)(o + 4) = (f32x4){bflo(a0.z), bfhi(a0.z), bflo(a0.w), bfhi(a0.w)} * rs0;
        *(f32x4*)(o + 512) = (f32x4){bflo(a1.x), bfhi(a1.x), bflo(a1.y), bfhi(a1.y)} * rs0; *(f32x4*)(o + 516) = (f32x4){bflo(a1.z), bfhi(a1.z), bflo(a1.w), bfhi(a1.w)} * rs0;
        if (two) { float* o2 = F.out + (size_t)row2 * D + 8 * F.lane;
            *(f32x4*)(o2) = (f32x4){bflo(b0.x), bfhi(b0.x), bflo(b0.y), bfhi(b0.y)} * rs1; *(f32x4*)(o2 + 4) = (f32x4){bflo(b0.z), bfhi(b0.z), bflo(b0.w), bfhi(b0.w)} * rs1;
            *(f32x4*)(o2 + 512) = (f32x4){bflo(b1.x), bfhi(b1.x), bflo(b1.y), bfhi(b1.y)} * rs1; *(f32x4*)(o2 + 516) = (f32x4){bflo(b1.z), bfhi(b1.z), bflo(b1.w), bfhi(b1.w)} * rs1; }
    }
}

template <int LDC>
__device__ __forceinline__ void fill_scale_tables(Frame& F, const pg8::Order& S, const float* RSS, const float* shw) {
    LAS float* RS_T = (LAS float*)(F.lds + TBL_OFF); LAS float* SH_T = RS_T + pg8::TBL_UNITS * 256;
    const int row = F.tid >> 1, half = F.tid & 1;
#pragma unroll 1
    for (int i0 = 0; i0 < pg8::TBL_UNITS; i0 += 3) {
        f32x4 p[3][4], sv[3]; bool ok[3];
#pragma unroll
        for (int j = 0; j < 3; ++j) { pg8::Unit u; ok[j] = S.next(i0 + j, u);
            if (ok[j]) { const float* b = RSS + ((size_t)u.pm * 256 + row) * 32 + 16 * half;
#pragma unroll
                for (int q = 0; q < 4; ++q) p[j][q] = *(const f32x4*)(b + 4 * q);
                if (F.tid < 64) sv[j] = *(const f32x4*)(shw + (size_t)(u.pm < ML / 256 ? (u.pm >> 3) : NB) * LDC + u.pn * 256 + 4 * F.tid); } }
#pragma unroll
        for (int j = 0; j < 3; ++j) if (ok[j]) {
            float s = 0.f;
#pragma unroll
            for (int q = 0; q < 4; ++q) s += (p[j][q][0] + p[j][q][1]) + (p[j][q][2] + p[j][q][3]);
            s += __shfl_xor(s, 1);
            if (half == 0) RS_T[(i0 + j) * 256 + row] = rsqrtf(s * (1.0f / D) + EPS);
            if (F.tid < 64) *(LAS f32x4*)(SH_T + (i0 + j) * 256 + 4 * F.tid) = sv[j]; }
    }
    __syncthreads();
}

constexpr int N_PHASES = 2 + 7 * DEPTH + 1;
struct Args { const float* in[25]; float* out; unsigned char* ws; int ph_lo, ph_hi; };
static_assert(sizeof(Args) == 27 * 8 + 8, "Args has no padding");

__global__ void __launch_bounds__(NWAVES * 64, 2) mega_fwd(Args args) {
    extern __shared__ __attribute__((aligned(16))) unsigned char lds[];
    Frame F;
    F.lds = (LAS unsigned char*)lds;
    const int wave_s = __builtin_amdgcn_readfirstlane((int)threadIdx.x >> 6);
    F.wave = wave_s; F.lane = (int)__builtin_amdgcn_mbcnt_hi(~0u, __builtin_amdgcn_mbcnt_lo(~0u, 0u)); F.tid = wave_s * 64 + F.lane;
    F.G = gridDim.x; { const int bx = blockIdx.x; F.vcu = (F.G % 8 == 0) ? (bx % 8) * (F.G / 8) + bx / 8 : bx; }
    F.gw = F.vcu * NWAVES + F.wave; F.NGW = F.G * NWAVES;
    F.out = args.out; F.ws = args.ws;
    volatile LAS unsigned* MISC = (volatile LAS unsigned*)(F.lds + MISC_OFF);
    for (int u = F.tid; u < (LDS_BYTES - LDSCTL_OFF) / 4; u += NWAVES * 64) ((LAS unsigned*)(F.lds + LDSCTL_OFF))[u] = 0u;
    __syncthreads();
    if (F.tid == 0) {
#pragma unroll
        for (int i = 0; i < 25; ++i) *(LAS unsigned long long*)(F.lds + PTR_OFF + 8 * i) = (unsigned long long)args.in[i];
    }
    __syncthreads();
    XcdBarrier bar = xcd_barrier_post((unsigned*)(F.ws + WS_CTL) + CW_BAR, MISC + 8, F.tid);

    const int lo = args.ph_lo, hi = args.ph_hi;
#ifdef PROBE_MASK
    bool rep_done = false;
#define PROBE_V ((((PROBE_MASK >> ph) & 1) && !rep_done) ? PROBE_VARIANT : 0)
#else
#define PROBE_V 0
#endif
    for (int ph = lo; ph < hi; ++ph) {
        { unsigned ones_ = ~0u; asm volatile("" : "+s"(ones_));
          int t_ = wave_s * 64 + (int)__builtin_amdgcn_mbcnt_hi(ones_, __builtin_amdgcn_mbcnt_lo(ones_, 0u)); asm volatile("" : "+v"(t_)); F.tid = t_; F.lane = t_ & 63; F.wave = __builtin_amdgcn_readfirstlane(t_ >> 6); F.gw = F.vcu * NWAVES + F.wave; }
        if (ph == 0) {
#ifndef NO_P0
            phase_p0a(F);
#endif
        } else if (ph == 1) {
#ifndef NO_P0
            phase_p0b(F);
#endif
        }
        else if (ph == N_PHASES - 1) final_rows(F);
        else {
            const int l = (ph - 2) / 7, k = (ph - 2) % 7; const bool last = (l == DEPTH - 1);
            const int Mx = last ? ML : MT;
            float* MOD = WSP(float, WS_MOD);
            if (k == 0) {
                if (l > 0) { ctx_finalize(F, l); xcd_barrier(bar, F.tid); }
                pg8::Gemm g{WSP(const bf16, WS_XA), WSP(const bf16, WS_WIN) + (size_t)l * IND * D, MT, IND, D};
                pg8::Order S; if (last) S.init(ML, IND, WGM_IN, (MC / 256) * 5, 1, F.G, (int)blockIdx.x); else S.init(MT, IND, WGM_IN, 0, 0, F.G, (int)blockIdx.x);
                fill_scale_tables<IND>(F, S, WSP(const float, WS_RSSA), WSP(const float, WS_SHW1) + (size_t)l * 17 * IND);
                pg8::EpiScale<0, IND, true> E{WSP(bf16, WS_PROJ), (const LAS float*)(F.lds + TBL_OFF), PROBE_V};

#ifndef NO_G0
                pg8::gemm_phase<pg8::EpiScale<0, IND, true>, pg8::Order, true, true>(F.lds + RING_OFF, g, S, E, F.tid);
#endif

            } else if (k == 1) {

#ifndef NO_LRU
                lru_phase<0>(F, l, 1152);
#ifdef REP_LRU0
                __syncthreads(); lru_phase<0>(F, l, 1152);
#endif
#endif

                __syncthreads();
#ifndef NO_CONV
                conv_phase(F, l, last ? 1024 : 1152);
                __syncthreads();
#ifdef REP_CONV
                conv_phase(F, l, last ? 1024 : 1152);
                __syncthreads();
#endif
#endif
#ifndef NO_NA
#ifdef REP_NA
                na_phase(F, l, last ? NA_ITEMS_LAT : NA_ITEMS_LAT + NA_ITEMS_CTX, REP_NA);
#else
                na_phase(F, l, last ? NA_ITEMS_LAT : NA_ITEMS_LAT + NA_ITEMS_CTX);
#endif
#ifdef REP_NA
                __syncthreads(); na_phase(F, l, last ? NA_ITEMS_LAT : NA_ITEMS_LAT + NA_ITEMS_CTX, 0);
#endif
#endif
            } else if (k == 2) {
                lru_carry(F);
            } else if (k == 3) {

#ifndef NO_LRU
                lru_scan_phase(F, l, last ? 1024 : 1152);
#endif

            } else if (k == 4 || k == 6) {
                const bool dn = (k == 6);
                const int ln = (dn && !last) ? l + 1 : l;
                pg8::Gemm g{dn ? WSP(const bf16, WS_HID) : WSP(const bf16, WS_MIX), dn ? WSP(const bf16, WS_W2) + (size_t)l * D * FF : WSP(const bf16, WS_WOUT) + (size_t)l * D * D, Mx, D, dn ? FF : D};
                const bool splitk = dn && !last;
                pg8::Order S; S.init(splitk ? ML : Mx, D, dn ? WGM_DN : WGM_OUT, 0, 0, F.G, (int)blockIdx.x);
                const bool fromin = (!dn && l == 0);
                const float* go_g = dn ? INP(5) + l * D : INP(4) + l * D;
                const float* go_s = MOD + (size_t)l * 17 * MODW + (dn ? 4 : 1) * D;
                const bool fin = dn && last;
                pg8::EpiRes E{fromin ? INP(0) : (const float*)nullptr, fromin ? INP(2) : (const float*)nullptr, (float*)nullptr,
                              MOD + (size_t)l * 17 * MODW + (dn ? 5 : 2) * D, fin ? INP(24) : (dn ? INP(4) : INP(5)) + ln * D, fin ? WSP(const float, WS_ZERO) : MOD + (size_t)ln * 17 * MODW + (dn ? 1 : 4) * D,
                              go_g, go_s, WSP(bf16, WS_XA), dn ? WSP(float, WS_RSSA) : WSP(float, WS_RSSB), 1};
#ifndef NO_GR
                pg8::gemm_phase<pg8::EpiRes, pg8::Order, true, true>(F.lds + RING_OFF, g, S, E, F.tid);
                if (splitk) {
                    pg8::Order S2; S2.init(ML, 0, 4, (MC / 256) * 16, 2, F.G, (int)blockIdx.x);
                    pg8::EpiSlab E2{WSP(float, WS_PART), MOD + ((size_t)l * 17 + NB) * MODW + 5 * D};
                    pg8::gemm_phase<pg8::EpiSlab, pg8::Order, true, true, true>(F.lds + RING_OFF, g, S2, E2, F.tid);
                }
#endif
            } else if (k == 5) {
                pg8::Gemm g{WSP(const bf16, WS_XA), WSP(const bf16, WS_W1) + (size_t)l * FF * D, Mx, FF, D};
                pg8::Order S; S.init(Mx, FF, WGM_UP, 0, 0, F.G, (int)blockIdx.x);
                fill_scale_tables<FF>(F, S, WSP(const float, WS_RSSB), WSP(const float, WS_SHW2) + (size_t)l * 17 * FF);
                pg8::EpiScale<1, FF> E{WSP(bf16, WS_HID), (const LAS float*)(F.lds + TBL_OFF), PROBE_V};

#ifndef NO_G1
                pg8::gemm_phase<pg8::EpiScale<1, FF>, pg8::Order, true, true>(F.lds + RING_OFF, g, S, E, F.tid);
#endif

            }
        }
#ifdef PROBE_MASK
        if (((PROBE_MASK >> ph) & 1) && !rep_done) { rep_done = true; xcd_barrier(bar, F.tid); --ph; continue; }
        rep_done = false;
#endif
        if (ph + 1 < hi) xcd_barrier(bar, F.tid);
#ifdef PROBE_BAR2
        if (ph + 1 < hi) xcd_barrier(bar, F.tid);
#endif
    }
}

extern "C" void kernel_launch(void* const* d_in, const int* in_sizes, int n_in, void* d_out, int out_size, void* d_ws, size_t ws_size, hipStream_t stream) {
    static int grid = 0;
    if (grid == 0) {
        if (n_in != 25 || out_size != ML * D || ws_size < WS_END) { fprintf(stderr, "kernel_launch: unexpected shapes (n_in %d out %d ws %zu)\n", n_in, out_size, ws_size); grid = -1; return; }
        int dev = 0, cus = 0;
        if (hipGetDevice(&dev) != hipSuccess || hipDeviceGetAttribute(&cus, hipDeviceAttributeMultiprocessorCount, dev) != hipSuccess) { grid = -1; return; }
        if (hipFuncSetAttribute((const void*)mega_fwd, hipFuncAttributeMaxDynamicSharedMemorySize, LDS_BYTES) != hipSuccess) { fprintf(stderr, "kernel_launch: hipFuncSetAttribute failed\n"); grid = -1; return; }
        int per_cu = 0;
        if (hipOccupancyMaxActiveBlocksPerMultiprocessor(&per_cu, (const void*)mega_fwd, NWAVES * 64, LDS_BYTES) != hipSuccess || per_cu < 1) fprintf(stderr, "kernel_launch: occupancy query reports %d\n", per_cu);
        (void)hipGetLastError();
        grid = cus;
    }
    if (grid < 0) return;
    if (hipMemsetAsync((char*)d_ws + WS_CTL, 0, CTL_ZERO_BYTES, stream) != hipSuccess) return;
    Args a{};
    for (int i = 0; i < 25; ++i) a.in[i] = (const float*)d_in[i];
    a.out = (float*)d_out; a.ws = (unsigned char*)d_ws;
#if MK_N_LAUNCHES == 1
    a.ph_lo = 0; a.ph_hi = N_PHASES;
    hipLaunchKernelGGL(mega_fwd, dim3(grid), dim3(NWAVES * 64), LDS_BYTES, stream, a);
#else
    for (int ph = 0; ph < N_PHASES; ++ph) { a.ph_lo = ph; a.ph_hi = ph + 1; hipLaunchKernelGGL(mega_fwd, dim3(grid), dim3(NWAVES * 64), LDS_BYTES, stream, a); }
#endif
}
```

```cpp
#include <hip/hip_runtime.h>
#include <cstdio>
#include <cstdint>

constexpr int D = 1024, NB = 16, SEQ = 2048, CTXL = 256, DEPTH = 2;
constexpr int ML = NB * SEQ, MC = NB * CTXL, MT = ML + MC;
constexpr int IND = 2560, FF = 4096, NH = 8, HD = 64;
constexpr int MODW = 6 * D;
constexpr float EPS = 1e-6f;
#ifndef MK_N_LAUNCHES
#define MK_N_LAUNCHES 1
#endif

namespace pg8 {
#define PG8_LAS __attribute__((address_space(3)))
typedef unsigned short bf16_t;
typedef short bf16x8 __attribute__((ext_vector_type(8)));
typedef float f32x4 __attribute__((ext_vector_type(4)));
typedef unsigned u32x4 __attribute__((ext_vector_type(4)));
constexpr int BM = 256, BK = 64, HALF = 128, HTB = HALF * BK * 2, STAGE_BYTES = 8 * HTB, NXCD = 8;
constexpr int TBL_UNITS = 9;

__host__ __device__ __forceinline__ int lds_byte(int r, int c) { const int st = (r >> 4) * 2 + (c >> 5), rr = r & 15, cc = c & 31, ob = rr * 64 + cc * 2; return st * 1024 + (ob ^ (((ob >> 9) & 1) << 5)); }
__host__ __device__ __forceinline__ void stage_rc(int b, int& R, int& C) { const int st = b / 1024, sb = b % 1024, swz = sb ^ (((sb >> 9) & 1) << 5); R = (st >> 1) * 16 + swz / 64; C = (st & 1) * 32 + (swz % 64) / 2; }
__host__ __device__ __forceinline__ int perm32(int rho) { const int n = rho >> 4, i = rho & 15; return 8 * (i >> 2) + 4 * n + (i & 3); }

struct Unit { int pm, pn; };
struct Gemm { const bf16_t* A; const bf16_t* Bt; int M, N, K; };

__host__ __device__ __forceinline__ void map_tile(int wgid, int nM, int nN, int WGM, Unit& u) {
    const int nwg = nM * nN;
    { const int q = nwg / NXCD, r = nwg % NXCD, xcd = wgid % NXCD, off = wgid / NXCD; wgid = (xcd < r ? xcd * (q + 1) : r * (q + 1) + (xcd - r) * q) + off; }
    const int nig = WGM * nN, gid = wgid / nig, fm = gid * WGM, gsz = (nM - fm) < WGM ? (nM - fm) : WGM;
    u.pm = fm + ((wgid % nig) % gsz); u.pn = (wgid % nig) / gsz;
}
struct Order {
    int nM, nN, nwg, extra, mode, wgm, G, c;
    __host__ __device__ void init(int M, int N, int wgm_, int extra_, int mode_, int G_, int c_) { nM = M / BM; nN = N / BM; nwg = nM * nN; extra = extra_; mode = mode_; wgm = wgm_; G = G_; c = c_; }
    __host__ __device__ bool next(int i, Unit& u) const {
        const long L = (long)i * G + c;
        if (L < nwg) { map_tile((int)L, nM, nN, wgm, u); return true; }
        if (L < nwg + extra) { const int q = (int)L - nwg;
            if (mode == 1) { u.pm = nM + q / 5; u.pn = 4 + q % 5; }
            else { u.pm = nM + (q >> 4); u.pn = 4 + 4 * (q & 3) + ((q >> 2) & 3); }
            return true; }
        return false;
    }
    __device__ __forceinline__ void a_ready(const Unit&) const {}
    __device__ __forceinline__ void done(const Unit&) const {}
};

__device__ __forceinline__ unsigned cvt_pk_bf16(float lo, float hi) { unsigned r; asm volatile("v_cvt_pk_bf16_f32 %0, %1, %2" : "=v"(r) : "v"(lo), "v"(hi)); return r; }

template <int ACT, int LDC, bool GLU = false> struct EpiScale {
    static constexpr bool PERM = true, AFTER_DRAIN = false;
    bf16_t* O;
    const PG8_LAS float* tbl;
    int probe;
    __device__ __forceinline__ void operator()(const f32x4 (&acc)[2][2][4][2], const Unit& u, int wr, int wc, int fr, int fq, int ui) const {
        asm volatile("" : "+s"(wr), "+s"(wc));
        bf16_t* Ot = O + (size_t)u.pm * BM * LDC + u.pn * BM;
        unsigned cl = (unsigned)(wc * 32 + 8 * fq);
        unsigned rl0 = (unsigned)(wr * 64 + fr);
        asm volatile("" : "+v"(cl), "+v"(rl0));
        const PG8_LAS float* rst = tbl + ui * 256, * sht = tbl + TBL_UNITS * 256 + ui * 256;
        f32x4 sh[2][2]; float rs[2][4];
#pragma unroll
        for (int ai = 0; ai < 2; ++ai)
#pragma unroll
            for (int m = 0; m < 4; ++m) rs[ai][m] = rst[rl0 + (unsigned)(ai * HALF + m * 16)];
#pragma unroll
        for (int bj = 0; bj < 2; ++bj) { sh[bj][0] = *(const PG8_LAS f32x4*)(sht + (cl + (unsigned)(bj * HALF))); sh[bj][1] = *(const PG8_LAS f32x4*)(sht + (cl + (unsigned)(bj * HALF + 4))); }
        if (GLU && u.pn < 2) {
#pragma unroll
            for (int ai = 0; ai < 2; ++ai)
#pragma unroll
                for (int m = 0; m < 4; ++m) {
                    const f32x4 a0 = acc[ai][0][m][0] * rs[ai][m] + sh[0][0], a1 = acc[ai][0][m][1] * rs[ai][m] + sh[0][1];
                    const f32x4 g0 = acc[ai][1][m][0] * rs[ai][m] + sh[1][0], g1 = acc[ai][1][m][1] * rs[ai][m] + sh[1][1];
                    f32x4 v0, v1;
#pragma unroll
                    for (int e = 0; e < 4; ++e) { v0[e] = a0[e] * __builtin_amdgcn_rcpf(1.f + __builtin_amdgcn_exp2f(-1.4426950408889634f * g0[e])); v1[e] = a1[e] * __builtin_amdgcn_rcpf(1.f + __builtin_amdgcn_exp2f(-1.4426950408889634f * g1[e])); }
                    u32x4 w; w.x = cvt_pk_bf16(v0[0], v0[1]); w.y = cvt_pk_bf16(v0[2], v0[3]); w.z = cvt_pk_bf16(v1[0], v1[1]); w.w = cvt_pk_bf16(v1[2], v1[3]);
                    *(u32x4*)(O + (size_t)u.pm * BM * LDC + u.pn * HALF + ((rl0 + (unsigned)(ai * HALF + m * 16)) * (unsigned)LDC + cl)) = w;
                }
            return;
        }
#pragma unroll
        for (int bj = 0; bj < 2; ++bj)
#pragma unroll
            for (int ai = 0; ai < 2; ++ai)
#pragma unroll
                for (int m = 0; m < 4; ++m) {
                    f32x4 v0 = acc[ai][bj][m][0] * rs[ai][m] + sh[bj][0], v1 = acc[ai][bj][m][1] * rs[ai][m] + sh[bj][1];
                    if (ACT == 1) {
#pragma unroll
                        for (int e = 0; e < 4; ++e) { const float a = fmaxf(v0[e], 0.f), b = fmaxf(v1[e], 0.f); v0[e] = a * a; v1[e] = b * b; }
                    }
                    u32x4 w; w.x = cvt_pk_bf16(v0[0], v0[1]); w.y = cvt_pk_bf16(v0[2], v0[3]); w.z = cvt_pk_bf16(v1[0], v1[1]); w.w = cvt_pk_bf16(v1[2], v1[3]);
                    if (probe == 0) *(u32x4*)(Ot + ((rl0 + (unsigned)(ai * HALF + m * 16)) * (unsigned)LDC + cl + (unsigned)(bj * HALF))) = w;
                    else asm volatile("" :: "v"(w));
                }
    }
};
template <int NB_> struct EpiRes {
    static constexpr bool PERM = true, AFTER_DRAIN = false;
    const PG8_LAS float* tbl;
    bf16_t* XA; float* RSS;
    __device__ __forceinline__ void operator()(const f32x4 (&acc)[2][2][4][2], const Unit& u, int wr, int wc, int fr, int fq, int ui) const {
        asm volatile("" : "+s"(wr), "+s"(wc));
        bf16_t* XAt = XA + (size_t)u.pm * BM * D + u.pn * BM;
        float* RSSt = RSS + (size_t)u.pm * BM * 32 + u.pn * 8 + wc;
        unsigned cl = (unsigned)(wc * 32 + 8 * fq);
        unsigned rl0 = (unsigned)(wr * 64 + fr);
        asm volatile("" : "+v"(cl), "+v"(rl0));
        const PG8_LAS float* gT = tbl + ui * 256, * mT = tbl + (TBL_UNITS + ui) * 256, * iT = tbl + (2 * TBL_UNITS + ui) * 256;
        constexpr int BJB = 2 / NB_;
#pragma unroll
        for (int b0 = 0; b0 < 2; b0 += BJB) {
            u32x4 xb[BJB][2][4];
#pragma unroll
            for (int bb = 0; bb < BJB; ++bb)
#pragma unroll
                for (int ai = 0; ai < 2; ++ai)
#pragma unroll
                    for (int m = 0; m < 4; ++m) xb[bb][ai][m] = *(const u32x4*)(XAt + ((rl0 + (unsigned)(ai * HALF + m * 16)) * (unsigned)D + cl + (unsigned)((b0 + bb) * HALF)));
            asm volatile("" ::: "memory");
#pragma unroll
            for (int bb = 0; bb < BJB; ++bb) {
                const int bj = b0 + bb;
                const unsigned c = cl + (unsigned)(bj * HALF);
                const f32x4 g0 = *(const PG8_LAS f32x4*)(gT + c), g1 = *(const PG8_LAS f32x4*)(gT + (c + 4u)), m0 = *(const PG8_LAS f32x4*)(mT + c), m1 = *(const PG8_LAS f32x4*)(mT + (c + 4u)),
                            r0 = *(const PG8_LAS f32x4*)(iT + c), r1 = *(const PG8_LAS f32x4*)(iT + (c + 4u));
#pragma unroll
                for (int ai = 0; ai < 2; ++ai)
#pragma unroll
                    for (int m = 0; m < 4; ++m) {
                        const unsigned rl = rl0 + (unsigned)(ai * HALF + m * 16);
                        const u32x4 w = xb[bb][ai][m];
                        const f32x4 x0 = (f32x4){__uint_as_float(w.x << 16), __uint_as_float(w.x & 0xffff0000u), __uint_as_float(w.y << 16), __uint_as_float(w.y & 0xffff0000u)} * r0;
                        const f32x4 x1 = (f32x4){__uint_as_float(w.z << 16), __uint_as_float(w.z & 0xffff0000u), __uint_as_float(w.w << 16), __uint_as_float(w.w & 0xffff0000u)} * r1;
                        const f32x4 y0 = x0 + g0 * acc[ai][bj][m][0], y1 = x1 + g1 * acc[ai][bj][m][1];
                        float ss = ((y0[0] * y0[0] + y0[1] * y0[1]) + (y0[2] * y0[2] + y0[3] * y0[3])) + ((y1[0] * y1[0] + y1[1] * y1[1]) + (y1[2] * y1[2] + y1[3] * y1[3]));
                        ss += __shfl_xor(ss, 16); ss += __shfl_xor(ss, 32);
                        if (fq == 0) RSSt[rl * 32u + (unsigned)(bj * 4)] = ss;
                        const f32x4 a0 = y0 * m0, a1 = y1 * m1;
                        u32x4 o; o.x = cvt_pk_bf16(a0[0], a0[1]); o.y = cvt_pk_bf16(a0[2], a0[3]); o.z = cvt_pk_bf16(a1[0], a1[1]); o.w = cvt_pk_bf16(a1[2], a1[3]);
                        *(u32x4*)(XAt + (rl * (unsigned)D + c)) = o;
                    }
            }
            asm volatile("" ::: "memory");
        }
    }
};

struct EpiSlab {
    static constexpr bool PERM = true, AFTER_DRAIN = false;
    float* P; const float* gate;
    __device__ __forceinline__ void operator()(const f32x4 (&acc)[2][2][4][2], const Unit& u, int wr, int wc, int fr, int fq, int) const {
        asm volatile("" : "+s"(wr), "+s"(wc));
        const int ks = (u.pn - 4) >> 2, pn = u.pn & 3;
        float* At = P + ((size_t)ks * MC + (size_t)(u.pm - ML / BM) * BM) * D + pn * BM;
        const float* gtq = gate + pn * BM;
        unsigned cl = (unsigned)(wc * 32 + 8 * fq), rl0 = (unsigned)(wr * 64 + fr);
        asm volatile("" : "+v"(cl), "+v"(rl0));
        f32x4 gv[2][2];
#pragma unroll
        for (int bj = 0; bj < 2; ++bj) { gv[bj][0] = *(const f32x4*)(gtq + (cl + (unsigned)(bj * HALF))); gv[bj][1] = *(const f32x4*)(gtq + (cl + (unsigned)(bj * HALF + 4))); }
#pragma unroll
        for (int bj = 0; bj < 2; ++bj) { const unsigned c = cl + (unsigned)(bj * HALF);
#pragma unroll
            for (int ai = 0; ai < 2; ++ai)
#pragma unroll
                for (int m = 0; m < 4; ++m) { const unsigned off = (rl0 + (unsigned)(ai * HALF + m * 16)) * (unsigned)D + c;
                    *(f32x4*)(At + off) = gv[bj][0] * acc[ai][bj][m][0]; *(f32x4*)(At + (off + 4u)) = gv[bj][1] * acc[ai][bj][m][1]; } }
    }
};

template <class Epi, class Sched, bool ALIGN_EPI = false, bool SP2 = false, bool VARK = false>
__device__ __forceinline__ void gemm_phase(PG8_LAS unsigned char* lds, const Gemm g, const Sched& S, const Epi& E, const int tid) {
    const int wid = __builtin_amdgcn_readfirstlane(tid >> 6), lane = tid & 63, wr = wid >> 2, wc = wid & 3, fr = lane & 15, fq = lane >> 4;
    const int K = g.K;
    unsigned voffA[2], voffB[2];
#pragma unroll
    for (int i = 0; i < 2; ++i) { int R, C; stage_rc(tid * 16 + i * 8192, R, C); const int Rb = Epi::PERM ? ((R & ~31) + perm32(R & 31)) : R;
        voffA[i] = (unsigned)(R * K + C) * 2u; voffB[i] = (unsigned)(Rb * K + C) * 2u; }
    const size_t kstep = (size_t)(BK * 2);
    const size_t hstep = (size_t)HALF * K * 2;
    const size_t tstep = 2 * hstep;
    const unsigned ldsw = (unsigned)wid * 1024u;
    const int aoff = lds_byte(wr * 64 + fr, fq * 8), boff = lds_byte(wc * 32 + fr, fq * 8);
#define PG8_SA(b, h) (((b) * 2 + (h)) * HTB)
#define PG8_SB(b, h) ((4 + (b) * 2 + (h)) * HTB)
#define PG8_STAGE(bufoff, gbase, voff) do { _Pragma("unroll") for (int _i = 0; _i < 2; ++_i) \
        __builtin_amdgcn_global_load_lds((const unsigned*)((const char*)(gbase) + (voff)[_i]), (PG8_LAS unsigned*)(lds + (bufoff) + ldsw + _i * 8192), 16, 0, 0); } while (0)
#define PG8_LDA(dst, b, h) do { _Pragma("unroll") for (int m = 0; m < 4; ++m) _Pragma("unroll") for (int k = 0; k < 2; ++k) dst[m][k] = *(const PG8_LAS bf16x8*)(lds + PG8_SA(b, h) + aoff + m * 2048 + k * 1024); } while (0)
#define PG8_LDB(dst, b, h) do { _Pragma("unroll") for (int n = 0; n < 2; ++n) _Pragma("unroll") for (int k = 0; k < 2; ++k) dst[n][k] = *(const PG8_LAS bf16x8*)(lds + PG8_SB(b, h) + boff + n * 2048 + k * 1024); } while (0)
#define PG8_MMA(ai, bj, At, Bt) do { __builtin_amdgcn_s_setprio(1); _Pragma("unroll") for (int m = 0; m < 4; ++m) _Pragma("unroll") for (int n = 0; n < 2; ++n) _Pragma("unroll") for (int k = 0; k < 2; ++k) \
        acc[ai][bj][m][n] = __builtin_amdgcn_mfma_f32_16x16x32_bf16(Bt[n][k], At[m][k], acc[ai][bj][m][n], 0, 0, 0); __builtin_amdgcn_s_setprio(0); } while (0)
#define PG8_WAIT_V(n) asm volatile("s_waitcnt vmcnt(" #n ")" ::: "memory")
#define PG8_WAIT_L(n) asm volatile("s_waitcnt lgkmcnt(" #n ")" ::: "memory")
#define PG8_BAR __builtin_amdgcn_s_barrier()
#define PG8_SCHED __builtin_amdgcn_sched_barrier(0)
    Unit cur, nxt; int ui = 0;
    if (!S.next(0, cur)) return;
    cur.pm = __builtin_amdgcn_readfirstlane(cur.pm); cur.pn = __builtin_amdgcn_readfirstlane(cur.pn);
    f32x4 acc[2][2][4][2];
#pragma unroll
    for (int a = 0; a < 2; ++a)
#pragma unroll
        for (int b = 0; b < 2; ++b)
#pragma unroll
            for (int m = 0; m < 4; ++m)
#pragma unroll
                for (int n = 0; n < 2; ++n) acc[a][b][m][n] = (f32x4){0.f, 0.f, 0.f, 0.f};
    bf16x8 At[4][2], B0[2][2], B1[2][2];
#define PG8_KOFF(u) ((VARK && (u).pn >= 4) ? (size_t)(((u).pn - 4) >> 2) * (size_t)(K / 4) * 2 : (size_t)0)
#define PG8_PN(u) ((VARK && (u).pn >= 4) ? ((u).pn & 3) : (u).pn)
    const char* cA = (const char*)g.A + (size_t)cur.pm * tstep + PG8_KOFF(cur); const char* cB = (const char*)g.Bt + (size_t)PG8_PN(cur) * tstep + PG8_KOFF(cur);
    S.a_ready(cur);
    if constexpr (SP2) {
        PG8_STAGE(PG8_SB(0, 0), cB, voffB); PG8_STAGE(PG8_SB(0, 1), cB + hstep, voffB); PG8_STAGE(PG8_SA(0, 0), cA, voffA); PG8_STAGE(PG8_SA(0, 1), cA + hstep, voffA);
        if (wr == 1) PG8_BAR;
        PG8_WAIT_V(2); PG8_BAR;
        PG8_STAGE(PG8_SB(1, 0), cB + kstep, voffB); PG8_STAGE(PG8_SA(1, 0), cA + kstep, voffA); PG8_STAGE(PG8_SB(1, 1), cB + hstep + kstep, voffB);
        PG8_WAIT_V(6); PG8_BAR;
    } else {
        PG8_STAGE(PG8_SB(0, 0), cB, voffB); PG8_STAGE(PG8_SA(0, 0), cA, voffA); PG8_STAGE(PG8_SB(0, 1), cB + hstep, voffB); PG8_STAGE(PG8_SA(0, 1), cA + hstep, voffA);
        if (wr == 1) PG8_BAR;
        PG8_WAIT_V(4); PG8_BAR;
        PG8_STAGE(PG8_SB(1, 0), cB + kstep, voffB); PG8_STAGE(PG8_SA(1, 0), cA + kstep, voffA); PG8_STAGE(PG8_SB(1, 1), cB + hstep + kstep, voffB);
        PG8_WAIT_V(6); PG8_BAR;
    }
    for (;;) {
        const bool has_next = S.next(ui + 1, nxt);
        nxt.pm = __builtin_amdgcn_readfirstlane(nxt.pm); nxt.pn = __builtin_amdgcn_readfirstlane(nxt.pn);
        const char* nA = has_next ? (const char*)g.A + (size_t)nxt.pm * tstep + PG8_KOFF(nxt) : cA; const char* nB = has_next ? (const char*)g.Bt + (size_t)PG8_PN(nxt) * tstep + PG8_KOFF(nxt) : cB;
        const int nt = (VARK && cur.pn >= 4) ? K / BK / 4 : K / BK;
        for (int t = 0; t < nt; t += 2) {
            const bool last = (t == nt - 2);
            const char* a1 = cA + (size_t)(t + 1) * kstep;
            const char* a2 = last ? nA : cA + (size_t)(t + 2) * kstep; const char* b2 = last ? nB : cB + (size_t)(t + 2) * kstep;
            const char* a3 = a2 + kstep; const char* b3 = b2 + kstep;
            if (last && has_next) S.a_ready(nxt);
            if constexpr (SP2) {
            PG8_LDB(B0, 0, 0); PG8_LDB(B1, 0, 1); PG8_SCHED; PG8_LDA(At, 0, 0); PG8_STAGE(PG8_SA(1, 1), a1 + hstep, voffA);
            PG8_WAIT_V(8); PG8_WAIT_L(0); PG8_BAR; PG8_MMA(0, 0, At, B0); PG8_MMA(0, 1, At, B1); PG8_BAR; PG8_SCHED;
            PG8_LDA(At, 0, 1); PG8_STAGE(PG8_SB(0, 0), b2, voffB); PG8_STAGE(PG8_SB(0, 1), b2 + hstep, voffB); PG8_STAGE(PG8_SA(0, 0), a2, voffA);
            PG8_WAIT_V(8); PG8_WAIT_L(0); PG8_BAR; PG8_MMA(1, 0, At, B0); PG8_MMA(1, 1, At, B1); PG8_BAR; PG8_SCHED;
            PG8_LDB(B0, 1, 0); PG8_LDB(B1, 1, 1); PG8_SCHED; PG8_LDA(At, 1, 0); PG8_STAGE(PG8_SA(0, 1), a2 + hstep, voffA);
            PG8_WAIT_V(8); PG8_WAIT_L(0); PG8_BAR; PG8_MMA(0, 0, At, B0); PG8_MMA(0, 1, At, B1); PG8_BAR; PG8_SCHED;
            PG8_LDA(At, 1, 1); PG8_STAGE(PG8_SB(1, 0), b3, voffB); PG8_STAGE(PG8_SB(1, 1), b3 + hstep, voffB); PG8_STAGE(PG8_SA(1, 0), a3, voffA);
            PG8_WAIT_V(8); PG8_WAIT_L(0); PG8_BAR; PG8_MMA(1, 0, At, B0); PG8_MMA(1, 1, At, B1); PG8_BAR; PG8_SCHED;
            } else {
            PG8_LDB(B0, 0, 0); PG8_SCHED; PG8_LDA(At, 0, 0); PG8_STAGE(PG8_SA(1, 1), a1 + hstep, voffA);
            PG8_WAIT_L(8); PG8_BAR; PG8_WAIT_L(0); PG8_MMA(0, 0, At, B0); PG8_BAR; PG8_SCHED;
            PG8_LDB(B1, 0, 1); PG8_STAGE(PG8_SB(0, 0), b2, voffB);
            PG8_BAR; PG8_WAIT_L(0); PG8_MMA(0, 1, At, B1); PG8_BAR;
            PG8_LDA(At, 0, 1); PG8_STAGE(PG8_SA(0, 0), a2, voffA);
            PG8_BAR; PG8_WAIT_L(0); PG8_MMA(1, 0, At, B0); PG8_BAR; PG8_SCHED;
            PG8_STAGE(PG8_SB(0, 1), b2 + hstep, voffB);
            PG8_WAIT_V(6); PG8_BAR; PG8_MMA(1, 1, At, B1); PG8_BAR;
            PG8_LDB(B0, 1, 0); PG8_SCHED; PG8_LDA(At, 1, 0); PG8_STAGE(PG8_SA(0, 1), a2 + hstep, voffA);
            PG8_WAIT_L(8); PG8_BAR; PG8_WAIT_L(0); PG8_MMA(0, 0, At, B0); PG8_BAR; PG8_SCHED;
            PG8_LDB(B1, 1, 1); PG8_STAGE(PG8_SB(1, 0), b3, voffB);
            PG8_BAR; PG8_WAIT_L(0); PG8_MMA(0, 1, At, B1); PG8_BAR;
            PG8_LDA(At, 1, 1); PG8_STAGE(PG8_SA(1, 0), a3, voffA);
            PG8_BAR; PG8_WAIT_L(0); PG8_MMA(1, 0, At, B0); PG8_BAR; PG8_SCHED;
            PG8_STAGE(PG8_SB(1, 1), b3 + hstep, voffB);
            PG8_WAIT_V(6); PG8_BAR; PG8_MMA(1, 1, At, B1); PG8_BAR;
            }
        }
        if constexpr (ALIGN_EPI) { if (wr == 0) PG8_BAR; }
        if constexpr (!Epi::AFTER_DRAIN) { E(acc, cur, wr, wc, fr, fq, ui); S.done(cur); }
        if (!has_next) break;
#pragma unroll
        for (int a = 0; a < 2; ++a)
#pragma unroll
            for (int b = 0; b < 2; ++b)
#pragma unroll
                for (int m = 0; m < 4; ++m)
#pragma unroll
                    for (int n = 0; n < 2; ++n) acc[a][b][m][n] = (f32x4){0.f, 0.f, 0.f, 0.f};
        cur = nxt; cA = nA; cB = nB; ++ui;
        if constexpr (ALIGN_EPI) { if (wr == 1) PG8_BAR; }
    }
    PG8_WAIT_V(0);
    if constexpr (!ALIGN_EPI) { if (wr == 0) PG8_BAR; }
    PG8_BAR;
    if constexpr (Epi::AFTER_DRAIN) { E.fused(acc, cur, wr, wc, fr, fq, lds, wid, lane); S.done(cur); }
#undef PG8_KOFF
#undef PG8_PN
#undef PG8_SA
#undef PG8_SB
#undef PG8_STAGE
#undef PG8_LDA
#undef PG8_LDB
#undef PG8_MMA
#undef PG8_WAIT_V
#undef PG8_WAIT_L
#undef PG8_BAR
#undef PG8_SCHED
}
}

constexpr size_t MiB = 1u << 20;
constexpr size_t WS_CTL = 0, CTL_ZERO_BYTES = 1 * MiB;
constexpr size_t WS_MOD = 1 * MiB;
constexpr size_t WS_SHW1 = 2 * MiB;
constexpr size_t WS_SHW2 = 3 * MiB;
constexpr size_t WS_RSSA = 4 * MiB;
constexpr size_t WS_RSSB = 9 * MiB;
constexpr size_t WS_TOT = 14 * MiB;
constexpr size_t WS_CARRY = 19 * MiB;
constexpr size_t WS_WLR = 21 * MiB + 512 * 1024;
constexpr size_t WS_WIN = 22 * MiB;
constexpr size_t WS_WOUT = 32 * MiB;
constexpr size_t WS_W1 = 36 * MiB;
constexpr size_t WS_W2 = 52 * MiB;
constexpr size_t WS_CX = 68 * MiB;
constexpr size_t WS_XA = 84 * MiB;
constexpr size_t WS_HID = 156 * MiB;
constexpr size_t WS_PROJ = WS_HID;
constexpr size_t WS_MIX = WS_HID + 180 * MiB;
constexpr size_t WS_PART = 444 * MiB;
constexpr size_t WS_AB = 436 * MiB;
constexpr size_t WS_END = 508 * MiB;
static_assert(WS_MIX + (size_t)MT * D * 2 <= WS_PART && WS_HID + (size_t)MT * FF * 2 == WS_PART && WS_PART + (size_t)4 * MC * D * 4 == WS_END && WS_AB >= WS_MIX + (size_t)MT * D * 2 && WS_AB + (size_t)1152 * 2 * 2 * 8 * 2 * 64 * 16 == WS_END, "ws map");
constexpr size_t WS_ZERO = WS_CTL + 512 * 1024;
constexpr int CW_BAR = 4096;

#ifndef WGM_IN
#define WGM_IN 4
#endif
#ifndef WGM_OUT
#define WGM_OUT 4
#endif
#ifndef WGM_UP
#define WGM_UP 4
#endif
#ifndef WGM_DN
#define WGM_DN 4
#endif
#ifndef RES_NB
#define RES_NB 2
#endif
constexpr int NWAVES = 8;
constexpr int RING_OFF = 0, RING_BYTES = 131072;
constexpr int LDSCTL_OFF = RING_BYTES, MISC_OFF = LDSCTL_OFF + 320;
constexpr int TBL_OFF = LDSCTL_OFF + 1024;
static_assert(TBL_OFF + 3 * pg8::TBL_UNITS * 256 * 4 <= 163840, "LDS map");
constexpr int LDS_BYTES = 163840;

#define GAS __attribute__((address_space(1)))
#define LAS __attribute__((address_space(3)))
typedef unsigned short bf16;
typedef unsigned v4u __attribute__((ext_vector_type(4)));
typedef unsigned v2u __attribute__((ext_vector_type(2)));
typedef float f32x4 __attribute__((ext_vector_type(4)));
typedef float f32x2 __attribute__((ext_vector_type(2)));
typedef GAS unsigned gu32;
#define LDS_WAIT() asm volatile("s_waitcnt lgkmcnt(0)" ::: "memory")
#define VM_WAIT() asm volatile("s_waitcnt vmcnt(0)" ::: "memory")
__device__ __forceinline__ unsigned f2bf(float f) { unsigned u = __builtin_bit_cast(unsigned, f); return (u + 0x7fffu + ((u >> 16) & 1u)) >> 16; }
__device__ __forceinline__ unsigned pk2(float lo, float hi) { return f2bf(lo) | (f2bf(hi) << 16); }
__device__ __forceinline__ float bflo(unsigned w) { return __uint_as_float(w << 16); }
__device__ __forceinline__ float bfhi(unsigned w) { return __uint_as_float(w & 0xffff0000u); }
__device__ __forceinline__ float bf1(bf16 v) { return __uint_as_float((unsigned)v << 16); }
__device__ __forceinline__ float sigmoidf_(float x) { return __builtin_amdgcn_rcpf(1.f + __builtin_amdgcn_exp2f(-1.4426950408889634f * x)); }
__device__ __forceinline__ float siluf_(float x) { return x * sigmoidf_(x); }
__device__ __forceinline__ float gelu_tanh(float x) { const float u = 0.7978845608028654f * (x + 0.044715f * x * x * x); return x * sigmoidf_(2.f * u); }
__device__ __forceinline__ float wave_sum(float v) {
#pragma unroll
    for (int o = 1; o < 64; o <<= 1) v += __shfl_xor(v, o);
    return v;
}

#define XB_TMO      128
#define XB_XCNT(j)  (256  + 64 * (j))
#define XB_XSUB(j)  (1280 + 64 * (j))
#define XB_XGEN(j)  (2304 + 64 * (j))
#define XB_TOP      3328
#define XB_TOPGEN   3392
#define XCD_BAR_WORDS 3456
#define XB_SPIN_CAP (1u << 18)

__device__ __forceinline__ unsigned xb_ld(unsigned* p)              { return __hip_atomic_load(p, __ATOMIC_RELAXED, __HIP_MEMORY_SCOPE_AGENT); }
__device__ __forceinline__ unsigned xb_add(unsigned* p, unsigned v) { return __hip_atomic_fetch_add(p, v, __ATOMIC_RELAXED, __HIP_MEMORY_SCOPE_AGENT); }
__device__ __forceinline__ unsigned xb_xcc_id() { return (unsigned)__builtin_amdgcn_s_getreg((3 << 11) | 20) & 0xFu; }
#define XB_SPIN(cond, bar) do { unsigned _sp = 0; while (cond) { __builtin_amdgcn_s_sleep(1); \
    if ((++_sp & 255u) == 0u) { if (xb_ld(&(bar)[XB_TMO])) break; if (_sp > XB_SPIN_CAP) { atomicAdd(&(bar)[XB_TMO], 1u); break; } } } } while (0)

struct XcdBarrier {
    unsigned* bar; unsigned x;
    volatile LAS unsigned* st;
};

__device__ __forceinline__ XcdBarrier xcd_barrier_post(unsigned* bar, volatile LAS unsigned* st, int tid) {
    XcdBarrier b; b.bar = bar; b.x = xb_xcc_id(); b.st = st;
    if (tid == 0) (void)xb_add(&bar[XB_XCNT(b.x)], 1u);
    return b;
}
__device__ __forceinline__ void xcd_barrier_complete(unsigned* bar, unsigned x, unsigned& nloc, unsigned& nx) {
    const unsigned G = gridDim.x * gridDim.y * gridDim.z;
    unsigned sum, cnt, mine, sp = 0u;
    for (;;) {
        sum = 0u; cnt = 0u; mine = 0u;
#pragma unroll 1
        for (unsigned j = 0; j < 16; ++j) { const unsigned c = xb_ld(&bar[XB_XCNT(j)]); sum += c; cnt += (c > 0u) ? 1u : 0u; mine = (j == x) ? c : mine; }
        if (sum == G) break;
        __builtin_amdgcn_s_sleep(1);
        if ((++sp & 255u) == 0u) { if (xb_ld(&bar[XB_TMO])) break; if (sp > XB_SPIN_CAP) { atomicAdd(&bar[XB_TMO], 1u); break; } }
    }
    nloc = mine > 0u ? mine : 1u; nx = cnt > 0u ? cnt : 1u;
}

__device__ __forceinline__ void xcd_barrier(const XcdBarrier& b, int tid) {
    asm volatile("s_waitcnt vmcnt(0)" ::: "memory");
    __syncthreads();
    if (tid == 0) {
        unsigned* bar = b.bar;
        __builtin_amdgcn_s_waitcnt(0);
        unsigned nloc = b.st[0], nx = b.st[1];
        if (nloc == 0u) { xcd_barrier_complete(bar, b.x, nloc, nx); b.st[0] = nloc; b.st[1] = nx; }
        const unsigned old = xb_add(&bar[XB_XSUB(b.x)], 1u);
        const unsigned gen = old / nloc;
        if (old + 1u == (gen + 1u) * nloc) {
            __builtin_amdgcn_fence(__ATOMIC_RELEASE, "agent");
            asm volatile("s_waitcnt vmcnt(0)" ::: "memory");
            const unsigned og = xb_add(&bar[XB_TOP], 1u);
            const unsigned tg = og / nx;
            if (og + 1u == (tg + 1u) * nx) xb_add(&bar[XB_TOPGEN], 1u);
            else XB_SPIN(xb_ld(&bar[XB_TOPGEN]) == tg, bar);
            __builtin_amdgcn_fence(__ATOMIC_ACQUIRE, "agent");
            xb_add(&bar[XB_XGEN(b.x)], 1u);
            asm volatile("s_waitcnt vmcnt(0)" ::: "memory");
        } else {
            XB_SPIN(xb_ld(&bar[XB_XGEN(b.x)]) == gen, bar);
            __builtin_amdgcn_fence(__ATOMIC_ACQUIRE, "agent");
            asm volatile("s_waitcnt vmcnt(0)" ::: "memory");
        }
    }
    __syncthreads();
}

struct Frame {
    LAS unsigned char* lds;
    int tid, lane, wave;
    int vcu, G;
    int gw, NGW;
    float* out; unsigned char* ws;
};
constexpr int PTR_OFF = LDSCTL_OFF + 512;
__device__ __forceinline__ const float* inp_(LAS unsigned char* lds, int i) {
    const unsigned long long v = *(const LAS unsigned long long*)(lds + PTR_OFF + 8 * i);
    const unsigned lo = __builtin_amdgcn_readfirstlane((unsigned)v), hi = __builtin_amdgcn_readfirstlane((unsigned)(v >> 32));
    return (const float*)(((unsigned long long)hi << 32) | lo);
}
#define INP(i) inp_(F.lds, (i))
#define WSP(T, off) ((T*)(F.ws + (off)))

__device__ __forceinline__ void gemv17_item(Frame& F, const LAS float* tab, LAS float* red, const float* W, int ldw, int n0, const float* bias, float* outp, int ldo, int n0out) {
    float acc[17];
#pragma unroll
    for (int r = 0; r < 17; ++r) acc[r] = 0.f;
    const int k0 = F.wave * 128;
    const float* wp = W + (size_t)k0 * ldw + n0 + F.lane;
#pragma unroll 1
    for (int kk = 0; kk < 128; kk += 32) {
        float wv[32];
#pragma unroll
        for (int k = 0; k < 32; ++k) wv[k] = wp[(size_t)(kk + k) * ldw];
#pragma unroll
        for (int k = 0; k < 32; ++k) {
#pragma unroll
            for (int r = 0; r < 17; ++r) acc[r] += tab[r * 1024 + k0 + kk + k] * wv[k];
        }
    }
#pragma unroll
    for (int r = 0; r < 17; ++r) red[(F.wave * 17 + r) * 64 + F.lane] = acc[r];
    __syncthreads();
    for (int i = F.tid; i < 17 * 64; i += NWAVES * 64) {
        const int r = i >> 6, n = i & 63; float s = bias ? bias[n0 + n] : 0.f;
#pragma unroll
        for (int w = 0; w < 8; ++w) s += red[(w * 17 + r) * 64 + n];
        outp[(size_t)r * ldo + n0out + n] = s;
    }
    __syncthreads();
}

__host__ __device__ __forceinline__ int glu_col(int o) { return o >= 512 ? o : ((o >> 7) & 1) * 256 + (o >> 8) * 128 + (o & 127); }
__device__ __forceinline__ void p0_transpose_item(const float* W, int K, int N, bf16* WT, LAS float* scr, int item, int lane, bool glu) {
    const int nblk = N / 32, kb = item / nblk, nb = item % nblk, k0 = 64 * kb, n0 = 32 * nb;
    const int n0o = glu ? glu_col(n0) : n0;
    float tv[32];
#pragma unroll
    for (int i = 0; i < 32; ++i) { const int kk = 2 * i + (lane >> 5); tv[i] = W[(size_t)(k0 + kk) * N + n0 + (lane & 31)]; }
#pragma unroll
    for (int i = 0; i < 32; ++i) { const int kk = 2 * i + (lane >> 5); scr[kk * 33 + (lane & 31)] = tv[i]; }
    LDS_WAIT(); asm volatile("" ::: "memory");
    const int c = lane & 7;
#pragma unroll
    for (int j = 0; j < 4; ++j) { const int n = (lane >> 3) + 8 * j; const LAS float* s = scr + (8 * c) * 33 + n;
        v4u o; o.x = pk2(s[0 * 33], s[1 * 33]); o.y = pk2(s[2 * 33], s[3 * 33]); o.z = pk2(s[4 * 33], s[5 * 33]); o.w = pk2(s[6 * 33], s[7 * 33]);
        *(GAS v4u*)(WT + (size_t)(n0o + n) * K + k0 + 8 * c) = o; }
    LDS_WAIT(); asm volatile("" ::: "memory");
}

__device__ __forceinline__ void weight_items(Frame& F, int first, int last, int widx, int nw) {
    LAS float* scr = (LAS float*)(F.lds + F.wave * 16384);
    constexpr int I_IN = (D / 64) * (IND / 32), I_OUT = (D / 64) * (D / 32), I_1 = (D / 64) * (FF / 32), I_2 = (FF / 64) * (D / 32), I_L = I_IN + I_OUT + I_1 + I_2;
    for (int it = first + widx; it < last; it += nw) {
        const int l = it / I_L; int r = it % I_L;
        const float* W; bf16* WT; int K = D, N; const bool glu = r < I_IN;
        if (r < I_IN) { W = INP(8) + (size_t)l * D * IND; WT = WSP(bf16, WS_WIN) + (size_t)l * IND * D; N = IND; }
        else if (r < I_IN + I_OUT) { r -= I_IN; W = INP(9) + (size_t)l * D * D; WT = WSP(bf16, WS_WOUT) + (size_t)l * D * D; N = D; }
        else if (r < I_IN + I_OUT + I_1) { r -= I_IN + I_OUT; W = INP(22) + (size_t)l * D * FF; WT = WSP(bf16, WS_W1) + (size_t)l * FF * D; N = FF; }
        else { r -= I_IN + I_OUT + I_1; W = INP(23) + (size_t)l * FF * D; WT = WSP(bf16, WS_W2) + (size_t)l * D * FF; K = FF; N = D; }
        p0_transpose_item(W, K, N, WT, scr, r, F.lane, glu);
    }
}
constexpr int W_ITEMS = 2 * ((D / 64) * (IND / 32) + (D / 64) * (D / 32) + (D / 64) * (FF / 32) + (FF / 64) * (D / 32));
constexpr int W_EARLY = 64 * NWAVES * 3;

__device__ __forceinline__ void phase_p0a(Frame& F) {
    LAS float* tab = (LAS float*)(F.lds);
    LAS float* red = (LAS float*)(F.lds + 17 * 1024 * 4);
    float* MOD = WSP(float, WS_MOD);
    bool filled = false;
    for (int it = F.vcu; it < 2 * 96; it += F.G) {
        if (!filled) {
            for (int i = F.tid; i < 17 * 1024; i += NWAVES * 64) { const int r = i >> 10, k = i & 1023; const float v = (r < 16) ? INP(1)[r * D + k] : INP(3)[k]; tab[i] = siluf_(v); }
            __syncthreads(); filled = true;
        }
        const int l = it / 96, n0 = (it % 96) * 64;
        gemv17_item(F, tab, red, INP(6) + (size_t)l * D * MODW, MODW, n0, INP(7) + (size_t)l * MODW, MOD + (size_t)l * 17 * MODW, MODW, n0);
    }
    if (F.G == 256 && F.vcu >= 192) weight_items(F, 0, W_EARLY, (F.vcu - 192) * NWAVES + F.wave, 64 * NWAVES);
}

__device__ __forceinline__ void phase_p0b(Frame& F) {
    LAS float* tab = (LAS float*)(F.lds);
    LAS float* red = (LAS float*)(F.lds + 17 * 1024 * 4);
    const float* MOD = WSP(const float, WS_MOD);
    for (int it = F.vcu; it < 2 * 104; it += F.G) {
        const int l = it / 104, j = it % 104; const bool first = j < 40;
        const int shoff = first ? 0 : 3 * D;
        __syncthreads();
        for (int i = F.tid; i < 17 * 1024; i += NWAVES * 64) { const int r = i >> 10, k = i & 1023; tab[i] = MOD[((size_t)l * 17 + r) * MODW + shoff + k]; }
        __syncthreads();
        const int ldw = first ? IND : FF;
        gemv17_item(F, tab, red, first ? INP(8) + (size_t)l * D * IND : INP(22) + (size_t)l * D * FF, ldw, (first ? j : j - 40) * 64, nullptr,
                    first ? WSP(float, WS_SHW1) + (size_t)l * 17 * IND : WSP(float, WS_SHW2) + (size_t)l * 17 * FF, ldw, first ? glu_col(j * 64) : (j - 40) * 64);
    }
    bf16* XA = WSP(bf16, WS_XA); float* RSSA = WSP(float, WS_RSSA);
    const float* g1 = INP(4);
    for (int row = F.gw; row < MT; row += 2 * F.NGW) {
        f32x4 v[2][4]; float ss[2]; int rw[2]; const float* scp[2];
#pragma unroll
        for (int q = 0; q < 2; ++q) { int r_ = row + q * F.NGW; if (r_ >= MT) r_ = row; rw[q] = r_;
            const bool lat = r_ < ML;
            const float* xr = lat ? INP(0) + (size_t)r_ * D : INP(2) + (size_t)(r_ - ML) * D;
            scp[q] = MOD + (size_t)(lat ? (r_ >> 11) : NB) * MODW + D;
#pragma unroll
            for (int j = 0; j < 4; ++j) v[q][j] = *(const f32x4*)(xr + 4 * F.lane + 256 * j); }
#pragma unroll
        for (int q = 0; q < 2; ++q) { float s_ = 0.f;
#pragma unroll
            for (int j = 0; j < 4; ++j) s_ += (v[q][j][0] * v[q][j][0] + v[q][j][1] * v[q][j][1]) + (v[q][j][2] * v[q][j][2] + v[q][j][3] * v[q][j][3]);
            ss[q] = wave_sum(s_); }
#pragma unroll
        for (int q = 0; q < 2; ++q) { if (q == 1 && rw[1] == row) break;
            if (F.lane < 32) RSSA[(size_t)rw[q] * 32 + F.lane] = (F.lane == 0) ? ss[q] : 0.f;
#pragma unroll
            for (int j = 0; j < 4; ++j) { const int k = 4 * F.lane + 256 * j;
                const f32x4 gm = *(const f32x4*)(g1 + k) * (*(const f32x4*)(scp[q] + k) + 1.0f), a = v[q][j] * gm;
                v2u o; o.x = pk2(a[0], a[1]); o.y = pk2(a[2], a[3]); *(v2u*)(XA + (size_t)rw[q] * D + k) = o; } }
    }
    __syncthreads();
    {
        bf16* WLR = WSP(bf16, WS_WLR);
        for (int i = F.gw * 64 + F.lane; i < 2 * 2 * 4 * 2 * 4096; i += F.NGW * 64) { const int d = i & 63, e = (i >> 6) & 63, gt = (i >> 12) & 1, blk = i >> 13;
            const float* src = gt == 0 ? INP(17) : INP(19); WLR[i] = (bf16)f2bf(src[((size_t)blk * 64 + d) * 64 + e]); }
    }
    weight_items(F, (F.G == 256) ? W_EARLY : 0, W_ITEMS, F.gw, F.NGW);
}

constexpr int CV_OSROW = 260;
__device__ __forceinline__ void conv_phase(Frame& F, int l, int ntiles) {
    const bf16* PROJ = WSP(const bf16, WS_PROJ); bf16* MIX = WSP(bf16, WS_MIX);
    LAS float* us = (LAS float*)(F.lds);
    LAS float* os = (LAS float*)(F.lds + 62 * 256 * 4);
    const int c = F.tid & 255, half = F.tid >> 8;
    float w[31];
#pragma unroll
    for (int k = 0; k < 31; ++k) w[k] = INP(10)[((size_t)l * 31 + k) * 256 + c];
    const float cbias = INP(11)[l * 256 + c];
    const f32x4 lg = *(const f32x4*)(INP(12) + l * 256 + 4 * F.lane), lb = *(const f32x4*)(INP(13) + l * 256 + 4 * F.lane);
    unsigned pv[16];
    auto load_tile = [&](int T) {
        const int row0 = T * 32;
        int lo, hi; if (row0 < ML) { lo = row0 & ~(SEQ - 1); hi = lo + SEQ; } else { lo = row0 & ~(CTXL - 1); hi = lo + CTXL; }
#pragma unroll
        for (int j = 0; j < 16; ++j) { const int i = F.tid + 512 * j, rr = i >> 7, cp = i & 127, row = row0 - 15 + rr;
            const bool ok = (j < 15 || F.tid < 256) && row >= lo && row < hi;
            pv[j] = ok ? *(const unsigned*)(PROJ + (size_t)row * IND + 2 * cp) : 0u; }
    };
    const int T0 = F.G - 1 - F.vcu;
    if (T0 < ntiles) load_tile(T0);
    for (int T = T0; T < ntiles; T += F.G) {
        const int row0 = T * 32;
        __syncthreads();
#pragma unroll
        for (int j = 0; j < 16; ++j) { const int i = F.tid + 512 * j;
            if (j < 15 || F.tid < 256) { f32x2 u; u[0] = bflo(pv[j]); u[1] = bfhi(pv[j]); *(LAS f32x2*)(us + 2 * i) = u; } }
        if (T + F.G < ntiles) load_tile(T + F.G);
        __syncthreads();
        {
            float acc[16];
#pragma unroll
            for (int j = 0; j < 16; ++j) acc[j] = cbias;
            const LAS float* up = us + (16 * half) * 256 + c;
#pragma unroll
            for (int i = 0; i < 46; ++i) { const float x = up[i * 256];
#pragma unroll
                for (int j = 0; j < 16; ++j) if (i - j >= 0 && i - j <= 30) acc[j] += w[i - j] * x; }
#pragma unroll
            for (int j = 0; j < 16; ++j) os[(16 * half + j) * CV_OSROW + c] = acc[j];
        }
        __syncthreads();
#pragma unroll
        for (int q = 0; q < 4; ++q) { const int t = 4 * F.wave + q;
            const f32x4 v = *(const LAS f32x4*)(os + t * CV_OSROW + 4 * F.lane);
            const float mu = wave_sum((v[0] + v[1]) + (v[2] + v[3])) * (1.f / 256.f);
            const f32x4 d = v - mu;
            const float var = wave_sum((d[0] * d[0] + d[1] * d[1]) + (d[2] * d[2] + d[3] * d[3])) * (1.f / 256.f);
            const f32x4 y = d * rsqrtf(var + EPS) * lg + lb;
            v2u o; o.x = pk2(siluf_(y[0]), siluf_(y[1])); o.y = pk2(siluf_(y[2]), siluf_(y[3]));
            *(v2u*)(MIX + (size_t)(row0 + t) * D + 4 * F.lane) = o; }
    }
}

typedef short s16x8 __attribute__((ext_vector_type(8)));
typedef short s16x4 __attribute__((ext_vector_type(4)));
constexpr int NA_KROW = 144, NA_VROW = 160;
constexpr int NA_STAGE = 64 * NA_KROW + 64 * NA_VROW, NA_SLOT = 2 * NA_STAGE, NA_OFF_TB = 2 * NA_SLOT;
static_assert(NA_OFF_TB + 2560 <= RING_BYTES, "NA LDS map");
constexpr int NA_ITEMS_LAT = NB * NH * 8, NA_ITEMS_CTX = NB * NH * 2;
struct NaBlk { f32x4 O[4]; float m, lsum; int first; };
__device__ __forceinline__ int na_rs(int r) { int v = r - 4; return v < 0 ? 0 : (v > 24 ? 24 : v); }
__device__ __forceinline__ s16x8 na_scale_q(v4u w, float c) {
    v4u o; o.x = pg8::cvt_pk_bf16(bflo(w.x) * c, bfhi(w.x) * c); o.y = pg8::cvt_pk_bf16(bflo(w.y) * c, bfhi(w.y) * c); o.z = pg8::cvt_pk_bf16(bflo(w.z) * c, bfhi(w.z) * c); o.w = pg8::cvt_pk_bf16(bflo(w.w) * c, bfhi(w.w) * c);
    return __builtin_bit_cast(s16x8, o);
}
__device__ __forceinline__ void na_phase(Frame& F, int l, int nitems, int nav = 0) {
    const bf16* PROJ = WSP(const bf16, WS_PROJ); bf16* MIX = WSP(bf16, WS_MIX);
    LAS float* tb = (LAS float*)(F.lds + NA_OFF_TB);
    const int lane = F.lane, q16 = lane & 15, g = lane >> 4;
    const unsigned skey = (unsigned)(F.tid >> 3), spart = (unsigned)(F.tid & 7);
    const float c1 = 0.125f * 1.4426950408889634f;
    for (int it = F.vcu; it < nitems; it += F.G) {
        const bool isctx = it >= NA_ITEMS_LAT;
        int b, h, ra = 0, jq = 0, qrow0, rsI = 0, nloc = 0;
        if (!isctx) { const int r4 = it & 7; h = (it >> 3) & 7; b = it >> 6; const int r0 = 4 * r4; ra = r0 + 2 * (F.wave >> 2); jq = F.wave & 3; qrow0 = b * SEQ + ra * 64 + jq * 16;
            rsI = na_rs(r0); nloc = na_rs(r0 + 3) + 8 - rsI; }
        else { const int j = it - NA_ITEMS_LAT; const int hf = j & 1; h = (j >> 1) & 7; b = j >> 4; qrow0 = ML + b * CTXL + hf * 128 + F.wave * 16; }
        const int nch = nloc + 4;
        const bf16* Pq = PROJ + 512 + h * HD, * Pk = PROJ + 1024 + h * HD + 8 * spart, * Pv = PROJ + 1536 + h * HD + 8 * spart;
        auto krow_of = [&](int ch) -> int { if (ch > nch - 1) ch = nch - 1; return ch < nloc ? b * SEQ + (rsI + ch) * 64 : ML + b * CTXL + (ch - nloc) * 64; };
        s16x8 qfA[2], qfB[2];
#pragma unroll
        for (int s_ = 0; s_ < 2; ++s_) { qfA[s_] = na_scale_q(*(const v4u*)(Pq + (size_t)(qrow0 + q16) * IND + 32 * s_ + 8 * g), c1);
            qfB[s_] = isctx ? qfA[s_] : na_scale_q(*(const v4u*)(Pq + (size_t)(qrow0 + 64 + q16) * IND + 32 * s_ + 8 * g), c1); }
        const int rsA = na_rs(ra), rsB = na_rs(ra + 1);
        const int o0 = jq == 0 ? 0 : 16 * jq - 8, o1 = jq == 0 ? 16 : (jq == 3 ? 48 : 16 * jq + 8);
        float madd[2][4]; int lb[2];
        {
            const int qc = jq * 16 + q16; int cs = qc - 8; cs = cs < 0 ? 0 : (cs > 48 ? 48 : cs);
#pragma unroll
            for (int e = 0; e < 4; ++e) { const int k0 = o0 + 4 * g + e, k1 = o1 + 4 * g + e;
                madd[0][e] = ((unsigned)(k0 - cs) < 16u) ? 0.f : -1.0e30f;
                madd[1][e] = (((unsigned)(k1 - cs) < 16u) && !(jq == 3 && k1 < 56)) ? 0.f : -1.0e30f; }
            lb[0] = 64 + o0 + 4 * g - qc + 15; lb[1] = 64 + o1 + 4 * g - qc + 15;
        }
        const int npair = (nch + 1) >> 1;
        v4u kr0 = *(const v4u*)(Pk + (size_t)(krow_of(0) + (int)skey) * IND), vr0 = *(const v4u*)(Pv + (size_t)(krow_of(0) + (int)skey) * IND);
        v4u kr1 = *(const v4u*)(Pk + (size_t)(krow_of(1) + (int)skey) * IND), vr1 = *(const v4u*)(Pv + (size_t)(krow_of(1) + (int)skey) * IND);
        __syncthreads();
        if (!isctx) { const float* rpb = INP(14) + ((size_t)l * NH + h) * 15 * 31;
            for (int i = F.tid; i < 640; i += NWAVES * 64) tb[i] = (i >= 64 && i < 64 + 465) ? rpb[i - 64] * 1.4426950408889634f : 0.f; }
        {
            LAS unsigned char* s0 = F.lds;
            *(LAS v4u*)(s0 + skey * NA_KROW + spart * 16) = kr0; *(LAS v4u*)(s0 + 64 * NA_KROW + skey * NA_VROW + spart * 16) = vr0;
            *(LAS v4u*)(s0 + NA_STAGE + skey * NA_KROW + spart * 16) = kr1; *(LAS v4u*)(s0 + NA_STAGE + 64 * NA_KROW + skey * NA_VROW + spart * 16) = vr1;
        }
        kr0 = *(const v4u*)(Pk + (size_t)(krow_of(2) + (int)skey) * IND); vr0 = *(const v4u*)(Pv + (size_t)(krow_of(2) + (int)skey) * IND);
        kr1 = *(const v4u*)(Pk + (size_t)(krow_of(3) + (int)skey) * IND); vr1 = *(const v4u*)(Pv + (size_t)(krow_of(3) + (int)skey) * IND);
        NaBlk A, B;
#pragma unroll
        for (int dt = 0; dt < 4; ++dt) { A.O[dt] = (f32x4){0.f, 0.f, 0.f, 0.f}; B.O[dt] = (f32x4){0.f, 0.f, 0.f, 0.f}; }
        A.m = 0.f; A.lsum = 0.f; A.first = 1; B.m = 0.f; B.lsum = 0.f; B.first = 1;
        for (int cp = 0; cp < npair; ++cp) {
            __syncthreads();
            if (cp + 1 < npair) { LAS unsigned char* nx = F.lds + ((cp + 1) & 1) * NA_SLOT;
                *(LAS v4u*)(nx + skey * NA_KROW + spart * 16) = kr0; *(LAS v4u*)(nx + 64 * NA_KROW + skey * NA_VROW + spart * 16) = vr0;
                *(LAS v4u*)(nx + NA_STAGE + skey * NA_KROW + spart * 16) = kr1; *(LAS v4u*)(nx + NA_STAGE + 64 * NA_KROW + skey * NA_VROW + spart * 16) = vr1; }
            if (cp + 2 < npair) { const int k2 = krow_of(2 * cp + 4) + (int)skey, k3 = krow_of(2 * cp + 5) + (int)skey;
                kr0 = *(const v4u*)(Pk + (size_t)k2 * IND); vr0 = *(const v4u*)(Pv + (size_t)k2 * IND); kr1 = *(const v4u*)(Pk + (size_t)k3 * IND); vr1 = *(const v4u*)(Pv + (size_t)k3 * IND); }
          for (int sub = 0; sub < 2; ++sub) {
            const int ch = 2 * cp + sub;
            if (ch >= nch) break;
            LAS unsigned char* cur = F.lds + (cp & 1) * NA_SLOT + sub * NA_STAGE;
            const bool local = ch < nloc;
            const int kr = rsI + ch;
            const bool actA = !local || (kr >= rsA && kr <= rsA + 7), actB = !isctx && (!local || (kr >= rsB && kr <= rsB + 7));
            if ((!actA && !actB) || nav == 1) continue;
            auto finish = [&](f32x4* S, int nt_, NaBlk& X, unsigned (*pk)[2], float cm) {
                if (X.first || !__all(cm <= 8.f)) {
                    cm = fmaxf(cm, __shfl_xor(cm, 16)); cm = fmaxf(cm, __shfl_xor(cm, 32));
                    const float d = X.first ? cm : fmaxf(cm, 0.f);
                    if (!X.first) { const float alpha = __builtin_amdgcn_exp2f(-d); X.lsum *= alpha;
#pragma unroll
                        for (int dt = 0; dt < 4; ++dt) X.O[dt] = X.O[dt] * alpha; }
                    X.m += d; X.first = 0;
#pragma unroll
                    for (int t = 0; t < 4; ++t) if (t < nt_) S[t] = S[t] - d;
                }
                float ps = 0.f;
#pragma unroll
                for (int t = 0; t < 4; ++t) if (t < nt_) {
                    const float p0 = __builtin_amdgcn_exp2f(S[t][0]), p1 = __builtin_amdgcn_exp2f(S[t][1]), p2 = __builtin_amdgcn_exp2f(S[t][2]), p3 = __builtin_amdgcn_exp2f(S[t][3]);
                    ps += (p0 + p1) + (p2 + p3);
                    pk[t][0] = pg8::cvt_pk_bf16(p0, p1); pk[t][1] = pg8::cvt_pk_bf16(p2, p3); }
                X.lsum += ps;
            };
            unsigned pkA[4][2], pkB[4][2];
            if (local) {
                const LAS unsigned char* kb_ = cur + q16 * NA_KROW + 16 * g;
                f32x4 SA[2], SB[2];
#pragma unroll
                for (int t = 0; t < 2; ++t) { const float ma = -A.m, mb = -B.m; SA[t] = (f32x4){ma, ma, ma, ma}; SB[t] = (f32x4){mb, mb, mb, mb};
                    const int o = t == 0 ? o0 : o1;
#pragma unroll
                    for (int s_ = 0; s_ < 2; ++s_) { const s16x8 kf = *(const LAS s16x8*)(kb_ + o * NA_KROW + 64 * s_);
                        if (actA) SA[t] = __builtin_amdgcn_mfma_f32_16x16x32_bf16(kf, qfA[s_], SA[t], 0, 0, 0);
                        if (actB) SB[t] = __builtin_amdgcn_mfma_f32_16x16x32_bf16(kf, qfB[s_], SB[t], 0, 0, 0); } }
                if (nav == 2) { asm volatile("" :: "v"(SA[0]), "v"(SA[1]), "v"(SB[0]), "v"(SB[1])); continue; }
                auto soft_local = [&](f32x4 (&S)[2], NaBlk& X, unsigned (&pk)[4][2], int rq) {
                    float cm = -1.0e30f;
#pragma unroll
                    for (int t = 0; t < 2; ++t) { const LAS float* tr_ = tb + (kr - rq + 7) * 31 + lb[t];
#pragma unroll
                        for (int e = 0; e < 4; ++e) { const float v = (S[t][e] + tr_[e]) + madd[t][e]; S[t][e] = v; cm = fmaxf(cm, v); } }
                    finish(S, 2, X, pk, cm);
                };
                if (actA) soft_local(SA, A, pkA, ra);
                if (actB) soft_local(SB, B, pkB, ra + 1);
                if (nav == 3) { asm volatile("" :: "v"(pkA[0][0]), "v"(pkA[1][1]), "v"(pkB[0][0]), "v"(pkB[1][1])); continue; }
                const LAS unsigned char* vtr = cur + 64 * NA_KROW + (4 * g + (q16 >> 2)) * NA_VROW + (q16 & 3) * 8;
                const v4u bwA = {pkA[0][0], pkA[0][1], pkA[1][0], pkA[1][1]}, bwB = {pkB[0][0], pkB[0][1], pkB[1][0], pkB[1][1]};
                const s16x8 bfA = __builtin_bit_cast(s16x8, bwA), bfB = __builtin_bit_cast(s16x8, bwB);
#pragma unroll
                for (int dt = 0; dt < 4; ++dt) {
                    const s16x4 a0 = __builtin_amdgcn_ds_read_tr16_b64_v4i16((LAS s16x4*)(vtr + o0 * NA_VROW + dt * 32));
                    const s16x4 a1 = __builtin_amdgcn_ds_read_tr16_b64_v4i16((LAS s16x4*)(vtr + o1 * NA_VROW + dt * 32));
                    const s16x8 afrag = __builtin_shufflevector(a0, a1, 0, 1, 2, 3, 4, 5, 6, 7);
                    if (actA) A.O[dt] = __builtin_amdgcn_mfma_f32_16x16x32_bf16(afrag, bfA, A.O[dt], 0, 0, 0);
                    if (actB) B.O[dt] = __builtin_amdgcn_mfma_f32_16x16x32_bf16(afrag, bfB, B.O[dt], 0, 0, 0);
                }
            } else {
                const LAS unsigned char* kb_ = cur + q16 * NA_KROW + 16 * g;
                f32x4 SA[4], SB[4];
#pragma unroll
                for (int t = 0; t < 4; ++t) { const float ma = -A.m, mb = -B.m; SA[t] = (f32x4){ma, ma, ma, ma}; SB[t] = (f32x4){mb, mb, mb, mb};
#pragma unroll
                    for (int s_ = 0; s_ < 2; ++s_) { const s16x8 kf = *(const LAS s16x8*)(kb_ + t * 16 * NA_KROW + 64 * s_);
                        SA[t] = __builtin_amdgcn_mfma_f32_16x16x32_bf16(kf, qfA[s_], SA[t], 0, 0, 0);
                        if (actB) SB[t] = __builtin_amdgcn_mfma_f32_16x16x32_bf16(kf, qfB[s_], SB[t], 0, 0, 0); } }
                if (nav == 2) { asm volatile("" :: "v"(SA[0]), "v"(SA[1]), "v"(SA[2]), "v"(SA[3]), "v"(SB[0]), "v"(SB[1]), "v"(SB[2]), "v"(SB[3])); continue; }
                auto soft_ctx = [&](f32x4 (&S)[4], NaBlk& X, unsigned (&pk)[4][2]) {
                    float cm = -1.0e30f;
#pragma unroll
                    for (int t = 0; t < 4; ++t)
#pragma unroll
                        for (int e = 0; e < 4; ++e) cm = fmaxf(cm, S[t][e]);
                    finish(S, 4, X, pk, cm);
                };
                soft_ctx(SA, A, pkA);
                if (actB) soft_ctx(SB, B, pkB);
                if (nav == 3) { asm volatile("" :: "v"(pkA[0][0]), "v"(pkA[1][1]), "v"(pkA[2][0]), "v"(pkA[3][1]), "v"(pkB[0][0]), "v"(pkB[1][1]), "v"(pkB[2][0]), "v"(pkB[3][1])); continue; }
                const LAS unsigned char* vtr = cur + 64 * NA_KROW + (4 * g + (q16 >> 2)) * NA_VROW + (q16 & 3) * 8;
#pragma unroll
                for (int p = 0; p < 2; ++p) {
                    const v4u bwA = {pkA[2 * p][0], pkA[2 * p][1], pkA[2 * p + 1][0], pkA[2 * p + 1][1]}, bwB = {pkB[2 * p][0], pkB[2 * p][1], pkB[2 * p + 1][0], pkB[2 * p + 1][1]};
                    const s16x8 bfA = __builtin_bit_cast(s16x8, bwA), bfB = __builtin_bit_cast(s16x8, bwB);
#pragma unroll
                    for (int dt = 0; dt < 4; ++dt) {
                        const s16x4 a0 = __builtin_amdgcn_ds_read_tr16_b64_v4i16((LAS s16x4*)(vtr + (2 * p) * 16 * NA_VROW + dt * 32));
                        const s16x4 a1 = __builtin_amdgcn_ds_read_tr16_b64_v4i16((LAS s16x4*)(vtr + (2 * p + 1) * 16 * NA_VROW + dt * 32));
                        const s16x8 afrag = __builtin_shufflevector(a0, a1, 0, 1, 2, 3, 4, 5, 6, 7);
                        A.O[dt] = __builtin_amdgcn_mfma_f32_16x16x32_bf16(afrag, bfA, A.O[dt], 0, 0, 0);
                        if (actB) B.O[dt] = __builtin_amdgcn_mfma_f32_16x16x32_bf16(afrag, bfB, B.O[dt], 0, 0, 0);
                    }
                }
            }
          }
        }
        {
            float ls = A.lsum; ls += __shfl_xor(ls, 16); ls += __shfl_xor(ls, 32);
            const float inv = __builtin_amdgcn_rcpf(ls);
            bf16* op = MIX + (size_t)(qrow0 + q16) * D + 256 + h * HD + 4 * g;
#pragma unroll
            for (int dt = 0; dt < 4; ++dt) { v2u w; w.x = pg8::cvt_pk_bf16(A.O[dt][0] * inv, A.O[dt][1] * inv); w.y = pg8::cvt_pk_bf16(A.O[dt][2] * inv, A.O[dt][3] * inv); *(v2u*)(op + 16 * dt) = w; }
        }
        if (!isctx) {
            float ls = B.lsum; ls += __shfl_xor(ls, 16); ls += __shfl_xor(ls, 32);
            const float inv = __builtin_amdgcn_rcpf(ls);
            bf16* op = MIX + (size_t)(qrow0 + 64 + q16) * D + 256 + h * HD + 4 * g;
#pragma unroll
            for (int dt = 0; dt < 4; ++dt) { v2u w; w.x = pg8::cvt_pk_bf16(B.O[dt][0] * inv, B.O[dt][1] * inv); w.y = pg8::cvt_pk_bf16(B.O[dt][2] * inv, B.O[dt][3] * inv); *(v2u*)(op + 16 * dt) = w; }
        }
    }
}

constexpr int LRU_UCROW = 260;
constexpr int LRU_OFF_UC = 38 * 256 * 2, LRU_OFF_GT = LRU_OFF_UC + 2 * 32 * LRU_UCROW * 4;
static_assert(LRU_OFF_GT + 32 * 256 * 2 <= RING_BYTES, "LRU LDS map");
template <int PASS>
__device__ __forceinline__ void lru_phase(Frame& F, int l, int ntiles) {
    const bf16* PROJ = WSP(const bf16, WS_PROJ);
    LAS bf16* rxs = (LAS bf16*)(F.lds);
    LAS float* ucf = (LAS float*)(F.lds + LRU_OFF_UC);
    LAS bf16* gts = (LAS bf16*)(F.lds + LRU_OFF_GT);
    const int lane = F.lane, j16 = lane & 15, g = lane >> 4;
    const int kb = F.wave & 3, nh = F.wave >> 2;
    s16x8 wf[2][2][2][2];
    float cbx[2][2], cba[2][2], csp[2][2];
#pragma unroll
    for (int dir = 0; dir < 2; ++dir) {
        const int ld = l * 2 + dir;
        const bf16* WLR = WSP(const bf16, WS_WLR) + (size_t)((ld * 4 + kb) * 2) * 4096;
#pragma unroll
        for (int gt = 0; gt < 2; ++gt)
#pragma unroll
            for (int n2 = 0; n2 < 2; ++n2)
#pragma unroll
                for (int s_ = 0; s_ < 2; ++s_) wf[dir][gt][n2][s_] = *(const s16x8*)(WLR + gt * 4096 + (16 * (2 * nh + n2) + j16) * 64 + 32 * s_ + 8 * g);
#pragma unroll
        for (int n2 = 0; n2 < 2; ++n2) {
            const int e = kb * 64 + 16 * (2 * nh + n2) + j16, idx = ld * 256 + e;
            cbx[dir][n2] = INP(18)[idx]; cba[dir][n2] = INP(20)[idx];
            const float nl = -INP(21)[idx]; csp[dir][n2] = -8.f * (fmaxf(nl, 0.f) + log1pf(__expf(-fabsf(nl))));
        }
    }
    const int c = F.tid & 255, sdir = F.tid >> 8;
    const int sld = l * 2 + sdir;
    const float s1w0 = INP(15)[(sld * 4 + 0) * 256 + c], s1w1 = INP(15)[(sld * 4 + 1) * 256 + c], s1w2 = INP(15)[(sld * 4 + 2) * 256 + c], s1w3 = INP(15)[(sld * 4 + 3) * 256 + c], s1cb = INP(16)[sld * 256 + c];
    const int base = sdir == 0 ? 0 : 3;
    unsigned pre[10], pgw[8];
    auto load_tile = [&](int T) {
        const int row0 = T * 32;
        int lo, hi; if (row0 < ML) { lo = row0 & ~(SEQ - 1); hi = lo + SEQ; } else { lo = row0 & ~(CTXL - 1); hi = lo + CTXL; }
#pragma unroll
        for (int j = 0; j < 10; ++j) { const int i = F.tid + 512 * j, rr = i >> 7, cp = i & 127, row = row0 - 3 + rr;
            const bool ok = (j < 9 || F.tid < 256) && row >= lo && row < hi;
            pre[j] = ok ? *(const unsigned*)(PROJ + (size_t)row * IND + 2048 + 2 * cp) : 0u; }
        if (PASS == 1) {
#pragma unroll
            for (int j = 0; j < 8; ++j) { const int i = F.tid + 512 * j, t = i >> 7, cp = i & 127; pgw[j] = *(const unsigned*)(PROJ + (size_t)(row0 + t) * IND + 2304 + 2 * cp); }
        }
    };
    if (F.vcu < ntiles) load_tile(F.vcu);
    for (int T = F.vcu; T < ntiles; T += F.G) {
        const int row0 = T * 32;
        __syncthreads();
#pragma unroll
        for (int j = 0; j < 10; ++j) { const int i = F.tid + 512 * j; if (j < 9 || F.tid < 256) ((LAS unsigned*)rxs)[i] = pre[j]; }
        if (PASS == 1) {
#pragma unroll
            for (int j = 0; j < 8; ++j) ((LAS unsigned*)gts)[F.tid + 512 * j] = pgw[j];
        }
        if (T + F.G < ntiles) load_tile(T + F.G);
        float hst[2][2];
#pragma unroll
        for (int dir = 0; dir < 2; ++dir)
#pragma unroll
            for (int n2 = 0; n2 < 2; ++n2) hst[dir][n2] = PASS == 1 ? WSP(const float, WS_CARRY)[((size_t)dir * 1152 + T) * 256 + kb * 64 + 16 * (2 * nh + n2) + j16] : 0.f;
        __syncthreads();
        {
            float x0 = bf1(rxs[(base + 0) * 256 + c]), x1 = bf1(rxs[(base + 1) * 256 + c]), x2 = bf1(rxs[(base + 2) * 256 + c]);
#pragma unroll 8
            for (int t = 0; t < 32; ++t) {
                const float x3 = bf1(rxs[(t + base + 3) * 256 + c]);
                ucf[(sdir * 32 + t) * LRU_UCROW + c] = s1cb + s1w0 * x0 + s1w1 * x1 + s1w2 * x2 + s1w3 * x3;
                x0 = x1; x1 = x2; x2 = x3;
            }
        }
        __syncthreads();
        float hf[2][2][4];
        float Pt[2][2] = {{1.f, 1.f}, {1.f, 1.f}};
#pragma unroll
        for (int dir = 0; dir < 2; ++dir) {
            const bool sec16 = ((g & 1) != 0) != (dir != 0), sec32 = ((g >> 1) != 0) != (dir != 0);
#pragma unroll
            for (int step = 0; step < 2; ++step) {
                const int rt = dir == 0 ? step : 1 - step;
                s16x8 af[2];
#pragma unroll
                for (int s_ = 0; s_ < 2; ++s_) { const LAS float* up = ucf + (dir * 32 + 16 * rt + j16) * LRU_UCROW + kb * 64 + 32 * s_ + 8 * g;
                    const f32x4 u0 = *(const LAS f32x4*)up, u1 = *(const LAS f32x4*)(up + 4);
                    const v4u w = {pg8::cvt_pk_bf16(u0[0], u0[1]), pg8::cvt_pk_bf16(u0[2], u0[3]), pg8::cvt_pk_bf16(u1[0], u1[1]), pg8::cvt_pk_bf16(u1[2], u1[3])};
                    af[s_] = __builtin_bit_cast(s16x8, w); }
#pragma unroll
                for (int n2 = 0; n2 < 2; ++n2) {
                    f32x4 zx = {0.f, 0.f, 0.f, 0.f}, za = {0.f, 0.f, 0.f, 0.f};
#pragma unroll
                    for (int s_ = 0; s_ < 2; ++s_) { zx = __builtin_amdgcn_mfma_f32_16x16x32_bf16(af[s_], wf[dir][0][n2][s_], zx, 0, 0, 0); za = __builtin_amdgcn_mfma_f32_16x16x32_bf16(af[s_], wf[dir][1][n2][s_], za, 0, 0, 0); }
                    const int e = kb * 64 + 16 * (2 * nh + n2) + j16;
                    const LAS float* uo = ucf + (dir * 32 + 16 * rt + 4 * g) * LRU_UCROW + e;
                    float a_[4], b_[4]; unsigned abw[4];
#pragma unroll
                    for (int r = 0; r < 4; ++r) {
                        const float u = uo[r * LRU_UCROW];
                        const float gx = sigmoidf_(zx[r] + cbx[dir][n2]), ga = sigmoidf_(za[r] + cba[dir][n2]);
                        const float la = csp[dir][n2] * ga, a = __builtin_amdgcn_exp2f(1.4426950408889634f * la), y = 2.f * la;
                        const float om = y > -0.02f ? -y * (1.f + y * (0.5f + y * 0.16666667f)) : 1.f - a * a;
                        a_[r] = a; b_[r] = __builtin_amdgcn_sqrtf(om) * gx * u;
                        if (PASS == 0) {
                            const float oma = la > -0.02f ? -la * (1.f + la * (0.5f + la * 0.16666667f)) : 1.f - a;
                            abw[r] = pg8::cvt_pk_bf16(oma, b_[r]); a_[r] = 1.f - bflo(abw[r]); b_[r] = bfhi(abw[r]);
                        }
                    }
                    if (PASS == 0) WSP(v4u, WS_AB)[(((((size_t)T * 2 + dir) * 2 + rt) * 8 + F.wave) * 2 + n2) * 64 + lane] = (v4u){abw[0], abw[1], abw[2], abw[3]};
                    const float P = (a_[0] * a_[1]) * (a_[2] * a_[3]);
                    const float S = dir == 0 ? ((b_[0] * a_[1] + b_[1]) * a_[2] + b_[2]) * a_[3] + b_[3] : ((b_[3] * a_[2] + b_[2]) * a_[1] + b_[1]) * a_[0] + b_[0];
                    const float Pp = __shfl_xor(P, 16), Sp = __shfl_xor(S, 16);
                    const float e1P = sec16 ? Pp : 1.f, e1S = sec16 ? Sp : 0.f;
                    const float prP = P * Pp, prS = sec16 ? P * Sp + S : Pp * S + Sp;
                    const float Pq = __shfl_xor(prP, 32), Sq = __shfl_xor(prS, 32);
                    const float EP = sec32 ? Pq * e1P : e1P, ES = sec32 ? e1P * Sq + e1S : e1S;
                    const float TP = prP * Pq, TS = sec32 ? prP * Sq + prS : Pq * prS + Sq;
                    if (PASS == 1) {
                        float h = EP * hst[dir][n2] + ES;
                        if (dir == 0) {
#pragma unroll
                            for (int r = 0; r < 4; ++r) { h = a_[r] * h + b_[r]; hf[rt][n2][r] = h; }
                        } else {
                            float hb[4];
#pragma unroll
                            for (int r = 3; r >= 0; --r) { h = a_[r] * h + b_[r]; hb[r] = h; }
                            bf16* mp = WSP(bf16, WS_MIX) + (size_t)(row0 + 16 * rt + 4 * g) * D + 768 + e;
                            const LAS bf16* gp = gts + (16 * rt + 4 * g) * 256 + e;
#pragma unroll
                            for (int r = 0; r < 4; ++r) mp[(size_t)r * D] = (bf16)f2bf(gelu_tanh(bf1(gp[r * 256])) * (hf[rt][n2][r] + hb[r]));
                        }
                    } else Pt[dir][n2] *= TP;
                    hst[dir][n2] = TP * hst[dir][n2] + TS;
                }
            }
        }
        if (PASS == 0 && g == 0) {
#pragma unroll
            for (int dir = 0; dir < 2; ++dir)
#pragma unroll
                for (int n2 = 0; n2 < 2; ++n2) WSP(f32x2, WS_TOT)[((size_t)dir * 1152 + T) * 256 + kb * 64 + 16 * (2 * nh + n2) + j16] = (f32x2){Pt[dir][n2], hst[dir][n2]};
        }
    }
}
__device__ __forceinline__ void lru_scan_phase(Frame& F, int l, int ntiles) {
    const bf16* PROJ = WSP(const bf16, WS_PROJ);
    LAS bf16* gts = (LAS bf16*)(F.lds);
    const int lane = F.lane, j16 = lane & 15, g = lane >> 4;
    const int kb = F.wave & 3, nh = F.wave >> 2;
    const v4u* AB = WSP(const v4u, WS_AB);
    v4u pab[2][2][2]; unsigned pgw[8];
    auto load_tile = [&](int T) {
#pragma unroll
        for (int dir = 0; dir < 2; ++dir)
#pragma unroll
            for (int rt = 0; rt < 2; ++rt)
#pragma unroll
                for (int n2 = 0; n2 < 2; ++n2) pab[dir][rt][n2] = AB[(((((size_t)T * 2 + dir) * 2 + rt) * 8 + F.wave) * 2 + n2) * 64 + lane];
#pragma unroll
        for (int j = 0; j < 8; ++j) { const int i = F.tid + 512 * j, t = i >> 7, cp = i & 127; pgw[j] = *(const unsigned*)(PROJ + (size_t)(T * 32 + t) * IND + 2304 + 2 * cp); }
    };
    if (F.vcu < ntiles) load_tile(F.vcu);
    for (int T = F.vcu; T < ntiles; T += F.G) {
        const int row0 = T * 32;
        __syncthreads();
#pragma unroll
        for (int j = 0; j < 8; ++j) ((LAS unsigned*)gts)[F.tid + 512 * j] = pgw[j];
        v4u cur[2][2][2];
#pragma unroll
        for (int dir = 0; dir < 2; ++dir)
#pragma unroll
            for (int rt = 0; rt < 2; ++rt)
#pragma unroll
                for (int n2 = 0; n2 < 2; ++n2) cur[dir][rt][n2] = pab[dir][rt][n2];
        float hst[2][2];
#pragma unroll
        for (int dir = 0; dir < 2; ++dir)
#pragma unroll
            for (int n2 = 0; n2 < 2; ++n2) hst[dir][n2] = WSP(const float, WS_CARRY)[((size_t)dir * 1152 + T) * 256 + kb * 64 + 16 * (2 * nh + n2) + j16];
        if (T + F.G < ntiles) load_tile(T + F.G);
        __syncthreads();
        float hf[2][2][4];
#pragma unroll
        for (int dir = 0; dir < 2; ++dir) {
            const bool sec16 = ((g & 1) != 0) != (dir != 0), sec32 = ((g >> 1) != 0) != (dir != 0);
#pragma unroll
            for (int step = 0; step < 2; ++step) {
                const int rt = dir == 0 ? step : 1 - step;
#pragma unroll
                for (int n2 = 0; n2 < 2; ++n2) {
                    const int e = kb * 64 + 16 * (2 * nh + n2) + j16;
                    const v4u w = cur[dir][rt][n2];
                    const float a_[4] = {1.f - bflo(w.x), 1.f - bflo(w.y), 1.f - bflo(w.z), 1.f - bflo(w.w)}, b_[4] = {bfhi(w.x), bfhi(w.y), bfhi(w.z), bfhi(w.w)};
                    const float P = (a_[0] * a_[1]) * (a_[2] * a_[3]);
                    const float S = dir == 0 ? ((b_[0] * a_[1] + b_[1]) * a_[2] + b_[2]) * a_[3] + b_[3] : ((b_[3] * a_[2] + b_[2]) * a_[1] + b_[1]) * a_[0] + b_[0];
                    const float Pp = __shfl_xor(P, 16), Sp = __shfl_xor(S, 16);
                    const float e1P = sec16 ? Pp : 1.f, e1S = sec16 ? Sp : 0.f;
                    const float prP = P * Pp, prS = sec16 ? P * Sp + S : Pp * S + Sp;
                    const float Pq = __shfl_xor(prP, 32), Sq = __shfl_xor(prS, 32);
                    const float EP = sec32 ? Pq * e1P : e1P, ES = sec32 ? e1P * Sq + e1S : e1S;
                    const float TP = prP * Pq, TS = sec32 ? prP * Sq + prS : Pq * prS + Sq;
                    float h = EP * hst[dir][n2] + ES;
                    if (dir == 0) {
#pragma unroll
                        for (int r = 0; r < 4; ++r) { h = a_[r] * h + b_[r]; hf[rt][n2][r] = h; }
                    } else {
                        float hb[4];
#pragma unroll
                        for (int r = 3; r >= 0; --r) { h = a_[r] * h + b_[r]; hb[r] = h; }
                        bf16* mp = WSP(bf16, WS_MIX) + (size_t)(row0 + 16 * rt + 4 * g) * D + 768 + e;
                        const LAS bf16* gp = gts + (16 * rt + 4 * g) * 256 + e;
#pragma unroll
                        for (int r = 0; r < 4; ++r) mp[(size_t)r * D] = (bf16)f2bf(gelu_tanh(bf1(gp[r * 256])) * (hf[rt][n2][r] + hb[r]));
                    }
                    hst[dir][n2] = TP * hst[dir][n2] + TS;
                }
            }
        }
    }
}

__device__ __forceinline__ void lru_carry(Frame& F) {
    const f32x2* TOT = WSP(const f32x2, WS_TOT); float* CARRY = WSP(float, WS_CARRY);
    for (int it = F.gw; it < NB * 2 * 4; it += F.NGW) {
        const int b = it >> 3, dir = (it >> 2) & 1, c = (it & 3) * 64 + F.lane;
        float h = 0.f;
        for (int g = 0; g < 18; ++g) {
            f32x2 ps[4]; int tl[4];
#pragma unroll
            for (int i = 0; i < 4; ++i) { const int s = g * 4 + i;
                int T; if (s < 8) T = 1024 + b * 8 + (dir == 0 ? s : 7 - s); else T = b * 64 + (dir == 0 ? s - 8 : 71 - s);
                tl[i] = T; ps[i] = TOT[((size_t)dir * 1152 + T) * 256 + c]; }
#pragma unroll
            for (int i = 0; i < 4; ++i) { CARRY[((size_t)dir * 1152 + tl[i]) * 256 + c] = h; h = ps[i][0] * h + ps[i][1]; }
        }
    }
}

__device__ __forceinline__ void ctx_finalize(Frame& F, int l) {
    bf16* XA = WSP(bf16, WS_XA); float* RSSA = WSP(float, WS_RSSA); const float* ACC = WSP(const float, WS_PART); const float* MOD = WSP(const float, WS_MOD);
    const float* go = INP(5) + (l - 1) * D; const float* gso = MOD + ((size_t)(l - 1) * 17 + NB) * MODW + 4 * D;
    const float* gn = INP(4) + l * D; const float* gsn = MOD + ((size_t)l * 17 + NB) * MODW + D;
    for (int r = F.gw; r < MC; r += F.NGW) {
        const size_t row = (size_t)ML + r;
        float ss = 0.f; f32x4 y[4];
#pragma unroll
        for (int j = 0; j < 4; ++j) { const int k = 4 * F.lane + 256 * j;
            const v2u w = *(const v2u*)(XA + row * D + k);
            const f32x4 im = *(const f32x4*)(go + k) * (*(const f32x4*)(gso + k) + 1.0f);
            const f32x4 xo = (f32x4){bflo(w.x) * __builtin_amdgcn_rcpf(im[0]), bfhi(w.x) * __builtin_amdgcn_rcpf(im[1]), bflo(w.y) * __builtin_amdgcn_rcpf(im[2]), bfhi(w.y) * __builtin_amdgcn_rcpf(im[3])};
            const float* ap = ACC + (size_t)r * D + k;
            y[j] = xo + ((*(const f32x4*)ap + *(const f32x4*)(ap + (size_t)MC * D)) + (*(const f32x4*)(ap + (size_t)2 * MC * D) + *(const f32x4*)(ap + (size_t)3 * MC * D)));
            ss += (y[j][0] * y[j][0] + y[j][1] * y[j][1]) + (y[j][2] * y[j][2] + y[j][3] * y[j][3]); }
        ss = wave_sum(ss);
        if (F.lane < 32) RSSA[row * 32 + F.lane] = (F.lane == 0) ? ss : 0.f;
#pragma unroll
        for (int j = 0; j < 4; ++j) { const int k = 4 * F.lane + 256 * j;
            const f32x4 a = y[j] * (*(const f32x4*)(gn + k) * (*(const f32x4*)(gsn + k) + 1.0f));
            v2u o; o.x = pk2(a[0], a[1]); o.y = pk2(a[2], a[3]); *(v2u*)(XA + row * D + k) = o; }
    }
}

__device__ __forceinline__ void final_rows(Frame& F) {
    const bf16* XA = WSP(const bf16, WS_XA); const float* RSS = WSP(const float, WS_RSSA);
    for (int row = F.gw; row < ML; row += 2 * F.NGW) {
        const int row2 = row + F.NGW; const bool two = row2 < ML;
        const v4u a0 = *(const v4u*)(XA + (size_t)row * D + 8 * F.lane), a1 = *(const v4u*)(XA + (size_t)row * D + 512 + 8 * F.lane);
        const float p0 = F.lane < 32 ? RSS[(size_t)row * 32 + F.lane] : 0.f;
        v4u b0 = a0, b1 = a1; float p1 = 0.f;
        if (two) { b0 = *(const v4u*)(XA + (size_t)row2 * D + 8 * F.lane); b1 = *(const v4u*)(XA + (size_t)row2 * D + 512 + 8 * F.lane); p1 = F.lane < 32 ? RSS[(size_t)row2 * 32 + F.lane] : 0.f; }
        const float rs0 = rsqrtf(wave_sum(p0) * (1.f / D) + EPS), rs1 = rsqrtf(wave_sum(p1) * (1.f / D) + EPS);
        float* o = F.out + (size_t)row * D + 8 * F.lane;
        *(f32x4*)(o) = (f32x4){bflo(a0.x), bfhi(a0.x), bflo(a0.y), bfhi(a0.y)} * rs0; *(f32x4*)(o + 4) = (f32x4){bflo(a0.z), bfhi(a0.z), bflo(a0.w), bfhi(a0.w)} * rs0;
        *(f32x4*)(o + 512) = (f32x4){bflo(a1.x), bfhi(a1.x), bflo(a1.y), bfhi(a1.y)} * rs0; *(f32x4*)(o + 516) = (f32x4){bflo(a1.z), bfhi(a1.z), bflo(a1.w), bfhi(a1.w)} * rs0;
        if (two) { float* o2 = F.out + (size_t)row2 * D + 8 * F.lane;
            *(f32x4*)(o2) = (f32x4){bflo(b0.x), bfhi(b0.x), bflo(b0.y), bfhi(b0.y)} * rs1; *(f32x4*)(o2 + 4) = (f32x4){bflo(b0.z), bfhi(b0.z), bflo(b0.w), bfhi(b0.w)} * rs1;
            *(f32x4*)(o2 + 512) = (f32x4){bflo(b1.x), bfhi(b1.x), bflo(b1.y), bfhi(b1.y)} * rs1; *(f32x4*)(o2 + 516) = (f32x4){bflo(b1.z), bfhi(b1.z), bflo(b1.w), bfhi(b1.w)} * rs1; }
    }
}

__device__ __forceinline__ void fill_res_tables(Frame& F, const pg8::Order& S, const float* gate, const float* gmg, const float* gmsc, const float* go, const float* gso) {
    LAS float* T = (LAS float*)(F.lds + TBL_OFF);
    if (F.tid < 256) {
#pragma unroll 1
        for (int i = 0; i < pg8::TBL_UNITS; ++i) { pg8::Unit u; if (!S.next(i, u)) break;
            const int brow = u.pm < ML / 256 ? (u.pm >> 3) : NB, col = u.pn * 256 + F.tid;
            T[i * 256 + F.tid] = gate[(size_t)brow * MODW + col];
            T[(pg8::TBL_UNITS + i) * 256 + F.tid] = gmg[col] * (1.f + gmsc[(size_t)brow * MODW + col]);
            T[(2 * pg8::TBL_UNITS + i) * 256 + F.tid] = __builtin_amdgcn_rcpf(go[col] * (1.f + gso[(size_t)brow * MODW + col])); }
    }
    __syncthreads();
}

template <int LDC>
__device__ __forceinline__ void fill_scale_tables(Frame& F, const pg8::Order& S, const float* RSS, const float* shw) {
    LAS float* RS_T = (LAS float*)(F.lds + TBL_OFF); LAS float* SH_T = RS_T + pg8::TBL_UNITS * 256;
    const int row = F.tid >> 1, half = F.tid & 1;
#pragma unroll 1
    for (int i0 = 0; i0 < pg8::TBL_UNITS; i0 += 3) {
        f32x4 p[3][4], sv[3]; bool ok[3];
#pragma unroll
        for (int j = 0; j < 3; ++j) { pg8::Unit u; ok[j] = S.next(i0 + j, u);
            if (ok[j]) { const float* b = RSS + ((size_t)u.pm * 256 + row) * 32 + 16 * half;
#pragma unroll
                for (int q = 0; q < 4; ++q) p[j][q] = *(const f32x4*)(b + 4 * q);
                if (F.tid < 64) sv[j] = *(const f32x4*)(shw + (size_t)(u.pm < ML / 256 ? (u.pm >> 3) : NB) * LDC + u.pn * 256 + 4 * F.tid); } }
#pragma unroll
        for (int j = 0; j < 3; ++j) if (ok[j]) {
            float s = 0.f;
#pragma unroll
            for (int q = 0; q < 4; ++q) s += (p[j][q][0] + p[j][q][1]) + (p[j][q][2] + p[j][q][3]);
            s += __shfl_xor(s, 1);
            if (half == 0) RS_T[(i0 + j) * 256 + row] = rsqrtf(s * (1.0f / D) + EPS);
            if (F.tid < 64) *(LAS f32x4*)(SH_T + (i0 + j) * 256 + 4 * F.tid) = sv[j]; }
    }
    __syncthreads();
}

constexpr int N_PHASES = 2 + 7 * DEPTH + 1;
struct Args { const float* in[25]; float* out; unsigned char* ws; int ph_lo, ph_hi; };
static_assert(sizeof(Args) == 27 * 8 + 8, "Args has no padding");

__global__ void __launch_bounds__(NWAVES * 64, 2) mega_fwd(Args args) {
    extern __shared__ __attribute__((aligned(16))) unsigned char lds[];
    Frame F;
    F.lds = (LAS unsigned char*)lds;
    const int wave_s = __builtin_amdgcn_readfirstlane((int)threadIdx.x >> 6);
    F.wave = wave_s; F.lane = (int)__builtin_amdgcn_mbcnt_hi(~0u, __builtin_amdgcn_mbcnt_lo(~0u, 0u)); F.tid = wave_s * 64 + F.lane;
    F.G = gridDim.x; { const int bx = blockIdx.x; F.vcu = (F.G % 8 == 0) ? (bx % 8) * (F.G / 8) + bx / 8 : bx; }
    F.gw = F.vcu * NWAVES + F.wave; F.NGW = F.G * NWAVES;
    F.out = args.out; F.ws = args.ws;
    volatile LAS unsigned* MISC = (volatile LAS unsigned*)(F.lds + MISC_OFF);
    for (int u = F.tid; u < (LDS_BYTES - LDSCTL_OFF) / 4; u += NWAVES * 64) ((LAS unsigned*)(F.lds + LDSCTL_OFF))[u] = 0u;
    __syncthreads();
    if (F.tid == 0) {
#pragma unroll
        for (int i = 0; i < 25; ++i) *(LAS unsigned long long*)(F.lds + PTR_OFF + 8 * i) = (unsigned long long)args.in[i];
    }
    __syncthreads();
    XcdBarrier bar = xcd_barrier_post((unsigned*)(F.ws + WS_CTL) + CW_BAR, MISC + 8, F.tid);

    const int lo = args.ph_lo, hi = args.ph_hi;
#ifdef PROBE_MASK
    bool rep_done = false;
#define PROBE_V ((((PROBE_MASK >> ph) & 1) && !rep_done) ? PROBE_VARIANT : 0)
#else
#define PROBE_V 0
#endif
    for (int ph = lo; ph < hi; ++ph) {
        { unsigned ones_ = ~0u; asm volatile("" : "+s"(ones_));
          int t_ = wave_s * 64 + (int)__builtin_amdgcn_mbcnt_hi(ones_, __builtin_amdgcn_mbcnt_lo(ones_, 0u)); asm volatile("" : "+v"(t_)); F.tid = t_; F.lane = t_ & 63; F.wave = __builtin_amdgcn_readfirstlane(t_ >> 6); F.gw = F.vcu * NWAVES + F.wave; }
        if (ph == 0) {
#ifndef NO_P0
            phase_p0a(F);
#endif
        } else if (ph == 1) {
#ifndef NO_P0
            phase_p0b(F);
#endif
        }
        else if (ph == N_PHASES - 1) final_rows(F);
        else {
            const int l = (ph - 2) / 7, k = (ph - 2) % 7; const bool last = (l == DEPTH - 1);
            const int Mx = last ? ML : MT;
            float* MOD = WSP(float, WS_MOD);
            if (k == 0) {
                if (l > 0) { ctx_finalize(F, l); xcd_barrier(bar, F.tid); }
                pg8::Gemm g{WSP(const bf16, WS_XA), WSP(const bf16, WS_WIN) + (size_t)l * IND * D, MT, IND, D};
                pg8::Order S; if (last) S.init(ML, IND, WGM_IN, (MC / 256) * 5, 1, F.G, (int)blockIdx.x); else S.init(MT, IND, WGM_IN, 0, 0, F.G, (int)blockIdx.x);
                fill_scale_tables<IND>(F, S, WSP(const float, WS_RSSA), WSP(const float, WS_SHW1) + (size_t)l * 17 * IND);
                pg8::EpiScale<0, IND, true> E{WSP(bf16, WS_PROJ), (const LAS float*)(F.lds + TBL_OFF), PROBE_V};

#ifndef NO_G0
                pg8::gemm_phase<pg8::EpiScale<0, IND, true>, pg8::Order, true, true>(F.lds + RING_OFF, g, S, E, F.tid);
#endif

            } else if (k == 1) {

#ifndef NO_LRU
                lru_phase<0>(F, l, 1152);
#ifdef REP_LRU0
                __syncthreads(); lru_phase<0>(F, l, 1152);
#endif
#endif

                __syncthreads();
#ifndef NO_CONV
                conv_phase(F, l, last ? 1024 : 1152);
                __syncthreads();
#ifdef REP_CONV
                conv_phase(F, l, last ? 1024 : 1152);
                __syncthreads();
#endif
#endif
#ifndef NO_NA
#ifdef REP_NA
                na_phase(F, l, last ? NA_ITEMS_LAT : NA_ITEMS_LAT + NA_ITEMS_CTX, REP_NA);
#else
                na_phase(F, l, last ? NA_ITEMS_LAT : NA_ITEMS_LAT + NA_ITEMS_CTX);
#endif
#ifdef REP_NA
                __syncthreads(); na_phase(F, l, last ? NA_ITEMS_LAT : NA_ITEMS_LAT + NA_ITEMS_CTX, 0);
#endif
#endif
            } else if (k == 2) {
                lru_carry(F);
            } else if (k == 3) {

#ifndef NO_LRU
                lru_scan_phase(F, l, last ? 1024 : 1152);
#endif

            } else if (k == 4 || k == 6) {
                const bool dn = (k == 6);
                const int ln = (dn && !last) ? l + 1 : l;
                pg8::Gemm g{dn ? WSP(const bf16, WS_HID) : WSP(const bf16, WS_MIX), dn ? WSP(const bf16, WS_W2) + (size_t)l * D * FF : WSP(const bf16, WS_WOUT) + (size_t)l * D * D, Mx, D, dn ? FF : D};
                const bool splitk = dn && !last;
                pg8::Order S; S.init(splitk ? ML : Mx, D, dn ? WGM_DN : WGM_OUT, 0, 0, F.G, (int)blockIdx.x);
                const float* go_g = dn ? INP(5) + l * D : INP(4) + l * D;
                const float* go_s = MOD + (size_t)l * 17 * MODW + (dn ? 4 : 1) * D;
                const bool fin = dn && last;
                fill_res_tables(F, S, MOD + (size_t)l * 17 * MODW + (dn ? 5 : 2) * D, fin ? INP(24) : (dn ? INP(4) : INP(5)) + ln * D, fin ? WSP(const float, WS_ZERO) : MOD + (size_t)ln * 17 * MODW + (dn ? 1 : 4) * D, go_g, go_s);
                pg8::EpiRes<RES_NB> E{(const LAS float*)(F.lds + TBL_OFF), WSP(bf16, WS_XA), dn ? WSP(float, WS_RSSA) : WSP(float, WS_RSSB)};
#ifndef NO_GR
                pg8::gemm_phase<pg8::EpiRes<RES_NB>, pg8::Order, true, true>(F.lds + RING_OFF, g, S, E, F.tid);
                if (splitk) {
                    pg8::Order S2; S2.init(ML, 0, 4, (MC / 256) * 16, 2, F.G, (int)blockIdx.x);
                    pg8::EpiSlab E2{WSP(float, WS_PART), MOD + ((size_t)l * 17 + NB) * MODW + 5 * D};
                    pg8::gemm_phase<pg8::EpiSlab, pg8::Order, true, true, true>(F.lds + RING_OFF, g, S2, E2, F.tid);
                }
#endif
            } else if (k == 5) {
                pg8::Gemm g{WSP(const bf16, WS_XA), WSP(const bf16, WS_W1) + (size_t)l * FF * D, Mx, FF, D};
                pg8::Order S; S.init(Mx, FF, WGM_UP, 0, 0, F.G, (int)blockIdx.x);
                fill_scale_tables<FF>(F, S, WSP(const float, WS_RSSB), WSP(const float, WS_SHW2) + (size_t)l * 17 * FF);
                pg8::EpiScale<1, FF> E{WSP(bf16, WS_HID), (const LAS float*)(F.lds + TBL_OFF), PROBE_V};

#ifndef NO_G1
                pg8::gemm_phase<pg8::EpiScale<1, FF>, pg8::Order, true, true>(F.lds + RING_OFF, g, S, E, F.tid);
#endif

            }
        }
#ifdef PROBE_MASK
        if (((PROBE_MASK >> ph) & 1) && !rep_done) { rep_done = true; xcd_barrier(bar, F.tid); --ph; continue; }
        rep_done = false;
#endif
        if (ph + 1 < hi) xcd_barrier(bar, F.tid);
#ifdef PROBE_BAR2
        if (ph + 1 < hi) xcd_barrier(bar, F.tid);
#endif
    }
}

extern "C" void kernel_launch(void* const* d_in, const int* in_sizes, int n_in, void* d_out, int out_size, void* d_ws, size_t ws_size, hipStream_t stream) {
    static int grid = 0;
    if (grid == 0) {
        if (n_in != 25 || out_size != ML * D || ws_size < WS_END) { fprintf(stderr, "kernel_launch: unexpected shapes (n_in %d out %d ws %zu)\n", n_in, out_size, ws_size); grid = -1; return; }
        int dev = 0, cus = 0;
        if (hipGetDevice(&dev) != hipSuccess || hipDeviceGetAttribute(&cus, hipDeviceAttributeMultiprocessorCount, dev) != hipSuccess) { grid = -1; return; }
        if (hipFuncSetAttribute((const void*)mega_fwd, hipFuncAttributeMaxDynamicSharedMemorySize, LDS_BYTES) != hipSuccess) { fprintf(stderr, "kernel_launch: hipFuncSetAttribute failed\n"); grid = -1; return; }
        int per_cu = 0;
        if (hipOccupancyMaxActiveBlocksPerMultiprocessor(&per_cu, (const void*)mega_fwd, NWAVES * 64, LDS_BYTES) != hipSuccess || per_cu < 1) fprintf(stderr, "kernel_launch: occupancy query reports %d\n", per_cu);
        (void)hipGetLastError();
        grid = cus;
    }
    if (grid < 0) return;
    if (hipMemsetAsync((char*)d_ws + WS_CTL, 0, CTL_ZERO_BYTES, stream) != hipSuccess) return;
    Args a{};
    for (int i = 0; i < 25; ++i) a.in[i] = (const float*)d_in[i];
    a.out = (float*)d_out; a.ws = (unsigned char*)d_ws;
#if MK_N_LAUNCHES == 1
    a.ph_lo = 0; a.ph_hi = N_PHASES;
    hipLaunchKernelGGL(mega_fwd, dim3(grid), dim3(NWAVES * 64), LDS_BYTES, stream, a);
#else
    for (int ph = 0; ph < N_PHASES; ++ph) { a.ph_lo = ph; a.ph_hi = ph + 1; hipLaunchKernelGGL(mega_fwd, dim3(grid), dim3(NWAVES * 64), LDS_BYTES, stream, a); }
#endif
}
```

```cpp
#include <hip/hip_runtime.h>
#include <cstdio>
#include <cstdint>

constexpr int D = 1024, NB = 16, SEQ = 2048, CTXL = 256, DEPTH = 2;
constexpr int ML = NB * SEQ, MC = NB * CTXL, MT = ML + MC;
constexpr int IND = 2560, FF = 4096, NH = 8, HD = 64;
constexpr int MODW = 6 * D;
constexpr float EPS = 1e-6f;
#ifndef MK_N_LAUNCHES
#define MK_N_LAUNCHES 1
#endif

namespace pg8 {
#define PG8_LAS __attribute__((address_space(3)))
typedef unsigned short bf16_t;
typedef short bf16x8 __attribute__((ext_vector_type(8)));
typedef float f32x4 __attribute__((ext_vector_type(4)));
typedef unsigned u32x4 __attribute__((ext_vector_type(4)));
constexpr int BM = 256, BK = 64, HALF = 128, HTB = HALF * BK * 2, STAGE_BYTES = 8 * HTB, NXCD = 8;
constexpr int TBL_UNITS = 9;

__host__ __device__ __forceinline__ int lds_byte(int r, int c) { const int st = (r >> 4) * 2 + (c >> 5), rr = r & 15, cc = c & 31, ob = rr * 64 + cc * 2; return st * 1024 + (ob ^ (((ob >> 9) & 1) << 5)); }
__host__ __device__ __forceinline__ void stage_rc(int b, int& R, int& C) { const int st = b / 1024, sb = b % 1024, swz = sb ^ (((sb >> 9) & 1) << 5); R = (st >> 1) * 16 + swz / 64; C = (st & 1) * 32 + (swz % 64) / 2; }
__host__ __device__ __forceinline__ int perm32(int rho) { const int n = rho >> 4, i = rho & 15; return 8 * (i >> 2) + 4 * n + (i & 3); }

struct Unit { int pm, pn; };
struct Gemm { const bf16_t* A; const bf16_t* Bt; int M, N, K; };

__host__ __device__ __forceinline__ void map_tile(int wgid, int nM, int nN, int WGM, Unit& u) {
    const int nwg = nM * nN;
    { const int q = nwg / NXCD, r = nwg % NXCD, xcd = wgid % NXCD, off = wgid / NXCD; wgid = (xcd < r ? xcd * (q + 1) : r * (q + 1) + (xcd - r) * q) + off; }
    const int nig = WGM * nN, gid = wgid / nig, fm = gid * WGM, gsz = (nM - fm) < WGM ? (nM - fm) : WGM;
    u.pm = fm + ((wgid % nig) % gsz); u.pn = (wgid % nig) / gsz;
}
struct Order {
    int nM, nN, nwg, extra, mode, wgm, G, c;
    __host__ __device__ void init(int M, int N, int wgm_, int extra_, int mode_, int G_, int c_) { nM = M / BM; nN = N / BM; nwg = nM * nN; extra = extra_; mode = mode_; wgm = wgm_; G = G_; c = c_; }
    __host__ __device__ bool next(int i, Unit& u) const {
        const long L = (long)i * G + c;
        if (L < nwg) { map_tile((int)L, nM, nN, wgm, u); return true; }
        if (L < nwg + extra) { const int q = (int)L - nwg;
            if (mode == 1) { u.pm = nM + q / 5; u.pn = 4 + q % 5; }
            else { u.pm = nM + (q >> 4); u.pn = 4 + 4 * (q & 3) + ((q >> 2) & 3); }
            return true; }
        return false;
    }
    __device__ __forceinline__ void a_ready(const Unit&) const {}
    __device__ __forceinline__ void done(const Unit&) const {}
};

__device__ __forceinline__ unsigned cvt_pk_bf16(float lo, float hi) { unsigned r; asm volatile("v_cvt_pk_bf16_f32 %0, %1, %2" : "=v"(r) : "v"(lo), "v"(hi)); return r; }

template <int ACT, int LDC, bool GLU = false> struct EpiScale {
    static constexpr bool PERM = true, AFTER_DRAIN = false;
    bf16_t* O;
    const PG8_LAS float* tbl;
    int probe;
    __device__ __forceinline__ void operator()(const f32x4 (&acc)[2][2][4][2], const Unit& u, int wr, int wc, int fr, int fq, int ui) const {
        asm volatile("" : "+s"(wr), "+s"(wc));
        bf16_t* Ot = O + (size_t)u.pm * BM * LDC + u.pn * BM;
        unsigned cl = (unsigned)(wc * 32 + 8 * fq);
        unsigned rl0 = (unsigned)(wr * 64 + fr);
        asm volatile("" : "+v"(cl), "+v"(rl0));
        const PG8_LAS float* rst = tbl + ui * 256, * sht = tbl + TBL_UNITS * 256 + ui * 256;
        f32x4 sh[2][2]; float rs[2][4];
#pragma unroll
        for (int ai = 0; ai < 2; ++ai)
#pragma unroll
            for (int m = 0; m < 4; ++m) rs[ai][m] = rst[rl0 + (unsigned)(ai * HALF + m * 16)];
#pragma unroll
        for (int bj = 0; bj < 2; ++bj) { sh[bj][0] = *(const PG8_LAS f32x4*)(sht + (cl + (unsigned)(bj * HALF))); sh[bj][1] = *(const PG8_LAS f32x4*)(sht + (cl + (unsigned)(bj * HALF + 4))); }
        if (GLU && u.pn < 2) {
#pragma unroll
            for (int ai = 0; ai < 2; ++ai)
#pragma unroll
                for (int m = 0; m < 4; ++m) {
                    const f32x4 a0 = acc[ai][0][m][0] * rs[ai][m] + sh[0][0], a1 = acc[ai][0][m][1] * rs[ai][m] + sh[0][1];
                    const f32x4 g0 = acc[ai][1][m][0] * rs[ai][m] + sh[1][0], g1 = acc[ai][1][m][1] * rs[ai][m] + sh[1][1];
                    f32x4 v0, v1;
#pragma unroll
                    for (int e = 0; e < 4; ++e) { v0[e] = a0[e] * __builtin_amdgcn_rcpf(1.f + __builtin_amdgcn_exp2f(-1.4426950408889634f * g0[e])); v1[e] = a1[e] * __builtin_amdgcn_rcpf(1.f + __builtin_amdgcn_exp2f(-1.4426950408889634f * g1[e])); }
                    u32x4 w; w.x = cvt_pk_bf16(v0[0], v0[1]); w.y = cvt_pk_bf16(v0[2], v0[3]); w.z = cvt_pk_bf16(v1[0], v1[1]); w.w = cvt_pk_bf16(v1[2], v1[3]);
                    *(u32x4*)(O + (size_t)u.pm * BM * LDC + u.pn * HALF + ((rl0 + (unsigned)(ai * HALF + m * 16)) * (unsigned)LDC + cl)) = w;
                }
            return;
        }
#pragma unroll
        for (int bj = 0; bj < 2; ++bj)
#pragma unroll
            for (int ai = 0; ai < 2; ++ai)
#pragma unroll
                for (int m = 0; m < 4; ++m) {
                    f32x4 v0 = acc[ai][bj][m][0] * rs[ai][m] + sh[bj][0], v1 = acc[ai][bj][m][1] * rs[ai][m] + sh[bj][1];
                    if (ACT == 1) {
#pragma unroll
                        for (int e = 0; e < 4; ++e) { const float a = fmaxf(v0[e], 0.f), b = fmaxf(v1[e], 0.f); v0[e] = a * a; v1[e] = b * b; }
                    }
                    u32x4 w; w.x = cvt_pk_bf16(v0[0], v0[1]); w.y = cvt_pk_bf16(v0[2], v0[3]); w.z = cvt_pk_bf16(v1[0], v1[1]); w.w = cvt_pk_bf16(v1[2], v1[3]);
                    if (probe == 0) *(u32x4*)(Ot + ((rl0 + (unsigned)(ai * HALF + m * 16)) * (unsigned)LDC + cl + (unsigned)(bj * HALF))) = w;
                    else asm volatile("" :: "v"(w));
                }
    }
};
template <int NB_> struct EpiRes {
    static constexpr bool PERM = true, AFTER_DRAIN = false;
    const PG8_LAS float* tbl;
    bf16_t* XA; float* RSS;
    __device__ __forceinline__ void operator()(const f32x4 (&acc)[2][2][4][2], const Unit& u, int wr, int wc, int fr, int fq, int ui) const {
        asm volatile("" : "+s"(wr), "+s"(wc));
        bf16_t* XAt = XA + (size_t)u.pm * BM * D + u.pn * BM;
        float* RSSt = RSS + (size_t)u.pm * BM * 32 + u.pn * 8 + wc;
        unsigned cl = (unsigned)(wc * 32 + 8 * fq);
        unsigned rl0 = (unsigned)(wr * 64 + fr);
        asm volatile("" : "+v"(cl), "+v"(rl0));
        const PG8_LAS float* gT = tbl + ui * 256, * mT = tbl + (TBL_UNITS + ui) * 256, * iT = tbl + (2 * TBL_UNITS + ui) * 256;
        constexpr int BJB = 2 / NB_;
#pragma unroll
        for (int b0 = 0; b0 < 2; b0 += BJB) {
            u32x4 xb[BJB][2][4];
#pragma unroll
            for (int bb = 0; bb < BJB; ++bb)
#pragma unroll
                for (int ai = 0; ai < 2; ++ai)
#pragma unroll
                    for (int m = 0; m < 4; ++m) xb[bb][ai][m] = *(const u32x4*)(XAt + ((rl0 + (unsigned)(ai * HALF + m * 16)) * (unsigned)D + cl + (unsigned)((b0 + bb) * HALF)));
            asm volatile("" ::: "memory");
#pragma unroll
            for (int bb = 0; bb < BJB; ++bb) {
                const int bj = b0 + bb;
                const unsigned c = cl + (unsigned)(bj * HALF);
                const f32x4 g0 = *(const PG8_LAS f32x4*)(gT + c), g1 = *(const PG8_LAS f32x4*)(gT + (c + 4u)), m0 = *(const PG8_LAS f32x4*)(mT + c), m1 = *(const PG8_LAS f32x4*)(mT + (c + 4u)),
                            r0 = *(const PG8_LAS f32x4*)(iT + c), r1 = *(const PG8_LAS f32x4*)(iT + (c + 4u));
#pragma unroll
                for (int ai = 0; ai < 2; ++ai)
#pragma unroll
                    for (int m = 0; m < 4; ++m) {
                        const unsigned rl = rl0 + (unsigned)(ai * HALF + m * 16);
                        const u32x4 w = xb[bb][ai][m];
                        const f32x4 x0 = (f32x4){__uint_as_float(w.x << 16), __uint_as_float(w.x & 0xffff0000u), __uint_as_float(w.y << 16), __uint_as_float(w.y & 0xffff0000u)} * r0;
                        const f32x4 x1 = (f32x4){__uint_as_float(w.z << 16), __uint_as_float(w.z & 0xffff0000u), __uint_as_float(w.w << 16), __uint_as_float(w.w & 0xffff0000u)} * r1;
                        const f32x4 y0 = x0 + g0 * acc[ai][bj][m][0], y1 = x1 + g1 * acc[ai][bj][m][1];
                        float ss = ((y0[0] * y0[0] + y0[1] * y0[1]) + (y0[2] * y0[2] + y0[3] * y0[3])) + ((y1[0] * y1[0] + y1[1] * y1[1]) + (y1[2] * y1[2] + y1[3] * y1[3]));
                        ss += __shfl_xor(ss, 16); ss += __shfl_xor(ss, 32);
                        if (fq == 0) RSSt[rl * 32u + (unsigned)(bj * 4)] = ss;
                        const f32x4 a0 = y0 * m0, a1 = y1 * m1;
                        u32x4 o; o.x = cvt_pk_bf16(a0[0], a0[1]); o.y = cvt_pk_bf16(a0[2], a0[3]); o.z = cvt_pk_bf16(a1[0], a1[1]); o.w = cvt_pk_bf16(a1[2], a1[3]);
                        *(u32x4*)(XAt + (rl * (unsigned)D + c)) = o;
                    }
            }
            asm volatile("" ::: "memory");
        }
    }
};

struct EpiSlab {
    static constexpr bool PERM = true, AFTER_DRAIN = false;
    float* P; const float* gate;
    __device__ __forceinline__ void operator()(const f32x4 (&acc)[2][2][4][2], const Unit& u, int wr, int wc, int fr, int fq, int) const {
        asm volatile("" : "+s"(wr), "+s"(wc));
        const int ks = (u.pn - 4) >> 2, pn = u.pn & 3;
        float* At = P + ((size_t)ks * MC + (size_t)(u.pm - ML / BM) * BM) * D + pn * BM;
        const float* gtq = gate + pn * BM;
        unsigned cl = (unsigned)(wc * 32 + 8 * fq), rl0 = (unsigned)(wr * 64 + fr);
        asm volatile("" : "+v"(cl), "+v"(rl0));
        f32x4 gv[2][2];
#pragma unroll
        for (int bj = 0; bj < 2; ++bj) { gv[bj][0] = *(const f32x4*)(gtq + (cl + (unsigned)(bj * HALF))); gv[bj][1] = *(const f32x4*)(gtq + (cl + (unsigned)(bj * HALF + 4))); }
#pragma unroll
        for (int bj = 0; bj < 2; ++bj) { const unsigned c = cl + (unsigned)(bj * HALF);
#pragma unroll
            for (int ai = 0; ai < 2; ++ai)
#pragma unroll
                for (int m = 0; m < 4; ++m) { const unsigned off = (rl0 + (unsigned)(ai * HALF + m * 16)) * (unsigned)D + c;
                    *(f32x4*)(At + off) = gv[bj][0] * acc[ai][bj][m][0]; *(f32x4*)(At + (off + 4u)) = gv[bj][1] * acc[ai][bj][m][1]; } }
    }
};

template <class Epi, class Sched, bool ALIGN_EPI = false, bool SP2 = false, bool VARK = false>
__device__ __forceinline__ void gemm_phase(PG8_LAS unsigned char* lds, const Gemm g, const Sched& S, const Epi& E, const int tid) {
    const int wid = __builtin_amdgcn_readfirstlane(tid >> 6), lane = tid & 63, wr = wid >> 2, wc = wid & 3, fr = lane & 15, fq = lane >> 4;
    const int K = g.K;
    unsigned voffA[2], voffB[2];
#pragma unroll
    for (int i = 0; i < 2; ++i) { int R, C; stage_rc(tid * 16 + i * 8192, R, C); const int Rb = Epi::PERM ? ((R & ~31) + perm32(R & 31)) : R;
        voffA[i] = (unsigned)(R * K + C) * 2u; voffB[i] = (unsigned)(Rb * K + C) * 2u; }
    const size_t kstep = (size_t)(BK * 2);
    const size_t hstep = (size_t)HALF * K * 2;
    const size_t tstep = 2 * hstep;
    const unsigned ldsw = (unsigned)wid * 1024u;
    const int aoff = lds_byte(wr * 64 + fr, fq * 8), boff = lds_byte(wc * 32 + fr, fq * 8);
#define PG8_SA(b, h) (((b) * 2 + (h)) * HTB)
#define PG8_SB(b, h) ((4 + (b) * 2 + (h)) * HTB)
#define PG8_STAGE(bufoff, gbase, voff) do { _Pragma("unroll") for (int _i = 0; _i < 2; ++_i) \
        __builtin_amdgcn_global_load_lds((const unsigned*)((const char*)(gbase) + (voff)[_i]), (PG8_LAS unsigned*)(lds + (bufoff) + ldsw + _i * 8192), 16, 0, 0); } while (0)
#define PG8_LDA(dst, b, h) do { _Pragma("unroll") for (int m = 0; m < 4; ++m) _Pragma("unroll") for (int k = 0; k < 2; ++k) dst[m][k] = *(const PG8_LAS bf16x8*)(lds + PG8_SA(b, h) + aoff + m * 2048 + k * 1024); } while (0)
#define PG8_LDB(dst, b, h) do { _Pragma("unroll") for (int n = 0; n < 2; ++n) _Pragma("unroll") for (int k = 0; k < 2; ++k) dst[n][k] = *(const PG8_LAS bf16x8*)(lds + PG8_SB(b, h) + boff + n * 2048 + k * 1024); } while (0)
#define PG8_MMA(ai, bj, At, Bt) do { __builtin_amdgcn_s_setprio(1); _Pragma("unroll") for (int m = 0; m < 4; ++m) _Pragma("unroll") for (int n = 0; n < 2; ++n) _Pragma("unroll") for (int k = 0; k < 2; ++k) \
        acc[ai][bj][m][n] = __builtin_amdgcn_mfma_f32_16x16x32_bf16(Bt[n][k], At[m][k], acc[ai][bj][m][n], 0, 0, 0); __builtin_amdgcn_s_setprio(0); } while (0)
#define PG8_WAIT_V(n) asm volatile("s_waitcnt vmcnt(" #n ")" ::: "memory")
#define PG8_WAIT_L(n) asm volatile("s_waitcnt lgkmcnt(" #n ")" ::: "memory")
#define PG8_BAR __builtin_amdgcn_s_barrier()
#define PG8_SCHED __builtin_amdgcn_sched_barrier(0)
    Unit cur, nxt; int ui = 0;
    if (!S.next(0, cur)) return;
    cur.pm = __builtin_amdgcn_readfirstlane(cur.pm); cur.pn = __builtin_amdgcn_readfirstlane(cur.pn);
    f32x4 acc[2][2][4][2];
#pragma unroll
    for (int a = 0; a < 2; ++a)
#pragma unroll
        for (int b = 0; b < 2; ++b)
#pragma unroll
            for (int m = 0; m < 4; ++m)
#pragma unroll
                for (int n = 0; n < 2; ++n) acc[a][b][m][n] = (f32x4){0.f, 0.f, 0.f, 0.f};
    bf16x8 At[4][2], B0[2][2], B1[2][2];
#define PG8_KOFF(u) ((VARK && (u).pn >= 4) ? (size_t)(((u).pn - 4) >> 2) * (size_t)(K / 4) * 2 : (size_t)0)
#define PG8_PN(u) ((VARK && (u).pn >= 4) ? ((u).pn & 3) : (u).pn)
    const char* cA = (const char*)g.A + (size_t)cur.pm * tstep + PG8_KOFF(cur); const char* cB = (const char*)g.Bt + (size_t)PG8_PN(cur) * tstep + PG8_KOFF(cur);
    S.a_ready(cur);
    if constexpr (SP2) {
        PG8_STAGE(PG8_SB(0, 0), cB, voffB); PG8_STAGE(PG8_SB(0, 1), cB + hstep, voffB); PG8_STAGE(PG8_SA(0, 0), cA, voffA); PG8_STAGE(PG8_SA(0, 1), cA + hstep, voffA);
        if (wr == 1) PG8_BAR;
        PG8_WAIT_V(2); PG8_BAR;
        PG8_STAGE(PG8_SB(1, 0), cB + kstep, voffB); PG8_STAGE(PG8_SA(1, 0), cA + kstep, voffA); PG8_STAGE(PG8_SB(1, 1), cB + hstep + kstep, voffB);
        PG8_WAIT_V(6); PG8_BAR;
    } else {
        PG8_STAGE(PG8_SB(0, 0), cB, voffB); PG8_STAGE(PG8_SA(0, 0), cA, voffA); PG8_STAGE(PG8_SB(0, 1), cB + hstep, voffB); PG8_STAGE(PG8_SA(0, 1), cA + hstep, voffA);
        if (wr == 1) PG8_BAR;
        PG8_WAIT_V(4); PG8_BAR;
        PG8_STAGE(PG8_SB(1, 0), cB + kstep, voffB); PG8_STAGE(PG8_SA(1, 0), cA + kstep, voffA); PG8_STAGE(PG8_SB(1, 1), cB + hstep + kstep, voffB);
        PG8_WAIT_V(6); PG8_BAR;
    }
    for (;;) {
        const bool has_next = S.next(ui + 1, nxt);
        nxt.pm = __builtin_amdgcn_readfirstlane(nxt.pm); nxt.pn = __builtin_amdgcn_readfirstlane(nxt.pn);
        const char* nA = has_next ? (const char*)g.A + (size_t)nxt.pm * tstep + PG8_KOFF(nxt) : cA; const char* nB = has_next ? (const char*)g.Bt + (size_t)PG8_PN(nxt) * tstep + PG8_KOFF(nxt) : cB;
        const int nt = (VARK && cur.pn >= 4) ? K / BK / 4 : K / BK;
        for (int t = 0; t < nt; t += 2) {
            const bool last = (t == nt - 2);
            const char* a1 = cA + (size_t)(t + 1) * kstep;
            const char* a2 = last ? nA : cA + (size_t)(t + 2) * kstep; const char* b2 = last ? nB : cB + (size_t)(t + 2) * kstep;
            const char* a3 = a2 + kstep; const char* b3 = b2 + kstep;
            if (last && has_next) S.a_ready(nxt);
            if constexpr (SP2) {
            PG8_LDB(B0, 0, 0); PG8_LDB(B1, 0, 1); PG8_SCHED; PG8_LDA(At, 0, 0); PG8_STAGE(PG8_SA(1, 1), a1 + hstep, voffA);
            PG8_WAIT_V(8); PG8_WAIT_L(0); PG8_BAR; PG8_MMA(0, 0, At, B0); PG8_MMA(0, 1, At, B1); PG8_BAR; PG8_SCHED;
            PG8_LDA(At, 0, 1); PG8_STAGE(PG8_SB(0, 0), b2, voffB); PG8_STAGE(PG8_SB(0, 1), b2 + hstep, voffB); PG8_STAGE(PG8_SA(0, 0), a2, voffA);
            PG8_WAIT_V(8); PG8_WAIT_L(0); PG8_BAR; PG8_MMA(1, 0, At, B0); PG8_MMA(1, 1, At, B1); PG8_BAR; PG8_SCHED;
            PG8_LDB(B0, 1, 0); PG8_LDB(B1, 1, 1); PG8_SCHED; PG8_LDA(At, 1, 0); PG8_STAGE(PG8_SA(0, 1), a2 + hstep, voffA);
            PG8_WAIT_V(8); PG8_WAIT_L(0); PG8_BAR; PG8_MMA(0, 0, At, B0); PG8_MMA(0, 1, At, B1); PG8_BAR; PG8_SCHED;
            PG8_LDA(At, 1, 1); PG8_STAGE(PG8_SB(1, 0), b3, voffB); PG8_STAGE(PG8_SB(1, 1), b3 + hstep, voffB); PG8_STAGE(PG8_SA(1, 0), a3, voffA);
            PG8_WAIT_V(8); PG8_WAIT_L(0); PG8_BAR; PG8_MMA(1, 0, At, B0); PG8_MMA(1, 1, At, B1); PG8_BAR; PG8_SCHED;
            } else {
            PG8_LDB(B0, 0, 0); PG8_SCHED; PG8_LDA(At, 0, 0); PG8_STAGE(PG8_SA(1, 1), a1 + hstep, voffA);
            PG8_WAIT_L(8); PG8_BAR; PG8_WAIT_L(0); PG8_MMA(0, 0, At, B0); PG8_BAR; PG8_SCHED;
            PG8_LDB(B1, 0, 1); PG8_STAGE(PG8_SB(0, 0), b2, voffB);
            PG8_BAR; PG8_WAIT_L(0); PG8_MMA(0, 1, At, B1); PG8_BAR;
            PG8_LDA(At, 0, 1); PG8_STAGE(PG8_SA(0, 0), a2, voffA);
            PG8_BAR; PG8_WAIT_L(0); PG8_MMA(1, 0, At, B0); PG8_BAR; PG8_SCHED;
            PG8_STAGE(PG8_SB(0, 1), b2 + hstep, voffB);
            PG8_WAIT_V(6); PG8_BAR; PG8_MMA(1, 1, At, B1); PG8_BAR;
            PG8_LDB(B0, 1, 0); PG8_SCHED; PG8_LDA(At, 1, 0); PG8_STAGE(PG8_SA(0, 1), a2 + hstep, voffA);
            PG8_WAIT_L(8); PG8_BAR; PG8_WAIT_L(0); PG8_MMA(0, 0, At, B0); PG8_BAR; PG8_SCHED;
            PG8_LDB(B1, 1, 1); PG8_STAGE(PG8_SB(1, 0), b3, voffB);
            PG8_BAR; PG8_WAIT_L(0); PG8_MMA(0, 1, At, B1); PG8_BAR;
            PG8_LDA(At, 1, 1); PG8_STAGE(PG8_SA(1, 0), a3, voffA);
            PG8_BAR; PG8_WAIT_L(0); PG8_MMA(1, 0, At, B0); PG8_BAR; PG8_SCHED;
            PG8_STAGE(PG8_SB(1, 1), b3 + hstep, voffB);
            PG8_WAIT_V(6); PG8_BAR; PG8_MMA(1, 1, At, B1); PG8_BAR;
            }
        }
        if constexpr (ALIGN_EPI) { if (wr == 0) PG8_BAR; }
        if constexpr (!Epi::AFTER_DRAIN) { E(acc, cur, wr, wc, fr, fq, ui); S.done(cur); }
        if (!has_next) break;
#pragma unroll
        for (int a = 0; a < 2; ++a)
#pragma unroll
            for (int b = 0; b < 2; ++b)
#pragma unroll
                for (int m = 0; m < 4; ++m)
#pragma unroll
                    for (int n = 0; n < 2; ++n) acc[a][b][m][n] = (f32x4){0.f, 0.f, 0.f, 0.f};
        cur = nxt; cA = nA; cB = nB; ++ui;
        if constexpr (ALIGN_EPI) { if (wr == 1) PG8_BAR; }
    }
    PG8_WAIT_V(0);
    if constexpr (!ALIGN_EPI) { if (wr == 0) PG8_BAR; }
    PG8_BAR;
    if constexpr (Epi::AFTER_DRAIN) { E.fused(acc, cur, wr, wc, fr, fq, lds, wid, lane); S.done(cur); }
#undef PG8_KOFF
#undef PG8_PN
#undef PG8_SA
#undef PG8_SB
#undef PG8_STAGE
#undef PG8_LDA
#undef PG8_LDB
#undef PG8_MMA
#undef PG8_WAIT_V
#undef PG8_WAIT_L
#undef PG8_BAR
#undef PG8_SCHED
}
}

constexpr size_t MiB = 1u << 20;
constexpr size_t WS_CTL = 0, CTL_ZERO_BYTES = 1 * MiB;
constexpr size_t WS_MOD = 1 * MiB;
constexpr size_t WS_SHW1 = 2 * MiB;
constexpr size_t WS_SHW2 = 3 * MiB;
constexpr size_t WS_RSSA = 4 * MiB;
constexpr size_t WS_RSSB = 9 * MiB;
constexpr size_t WS_TOT = 14 * MiB;
constexpr size_t WS_CARRY = 19 * MiB;
constexpr size_t WS_WLR = 21 * MiB + 512 * 1024;
constexpr size_t WS_WIN = 22 * MiB;
constexpr size_t WS_WOUT = 32 * MiB;
constexpr size_t WS_W1 = 36 * MiB;
constexpr size_t WS_W2 = 52 * MiB;
constexpr size_t WS_CX = 68 * MiB;
constexpr size_t WS_XA = 84 * MiB;
constexpr size_t WS_HID = 156 * MiB;
constexpr size_t WS_PROJ = WS_HID;
constexpr size_t WS_MIX = WS_HID + 180 * MiB;
constexpr size_t WS_PART = 444 * MiB;
constexpr size_t WS_AB = 436 * MiB;
constexpr size_t WS_END = 508 * MiB;
static_assert(WS_MIX + (size_t)MT * D * 2 <= WS_PART && WS_HID + (size_t)MT * FF * 2 == WS_PART && WS_PART + (size_t)4 * MC * D * 4 == WS_END && WS_AB >= WS_MIX + (size_t)MT * D * 2 && WS_AB + (size_t)1152 * 2 * 2 * 8 * 2 * 64 * 16 == WS_END, "ws map");
constexpr size_t WS_ZERO = WS_CTL + 512 * 1024;
constexpr int CW_BAR = 4096;

#ifndef WGM_IN
#define WGM_IN 4
#endif
#ifndef WGM_OUT
#define WGM_OUT 4
#endif
#ifndef WGM_UP
#define WGM_UP 4
#endif
#ifndef WGM_DN
#define WGM_DN 4
#endif
#ifndef RES_NB
#define RES_NB 2
#endif
constexpr int NWAVES = 8;
constexpr int RING_OFF = 0, RING_BYTES = 131072;
constexpr int LDSCTL_OFF = RING_BYTES, MISC_OFF = LDSCTL_OFF + 320;
constexpr int TBL_OFF = LDSCTL_OFF + 1024;
static_assert(TBL_OFF + 3 * pg8::TBL_UNITS * 256 * 4 <= 163840, "LDS map");
constexpr int LDS_BYTES = 163840;

#define GAS __attribute__((address_space(1)))
#define LAS __attribute__((address_space(3)))
typedef unsigned short bf16;
typedef unsigned v4u __attribute__((ext_vector_type(4)));
typedef unsigned v2u __attribute__((ext_vector_type(2)));
typedef float f32x4 __attribute__((ext_vector_type(4)));
typedef float f32x2 __attribute__((ext_vector_type(2)));
typedef GAS unsigned gu32;
#define LDS_WAIT() asm volatile("s_waitcnt lgkmcnt(0)" ::: "memory")
#define VM_WAIT() asm volatile("s_waitcnt vmcnt(0)" ::: "memory")
__device__ __forceinline__ unsigned f2bf(float f) { unsigned u = __builtin_bit_cast(unsigned, f); return (u + 0x7fffu + ((u >> 16) & 1u)) >> 16; }
__device__ __forceinline__ unsigned pk2(float lo, float hi) { return f2bf(lo) | (f2bf(hi) << 16); }
__device__ __forceinline__ float bflo(unsigned w) { return __uint_as_float(w << 16); }
__device__ __forceinline__ float bfhi(unsigned w) { return __uint_as_float(w & 0xffff0000u); }
__device__ __forceinline__ float bf1(bf16 v) { return __uint_as_float((unsigned)v << 16); }
__device__ __forceinline__ float sigmoidf_(float x) { return __builtin_amdgcn_rcpf(1.f + __builtin_amdgcn_exp2f(-1.4426950408889634f * x)); }
__device__ __forceinline__ float siluf_(float x) { return x * sigmoidf_(x); }
__device__ __forceinline__ float gelu_tanh(float x) { const float u = 0.7978845608028654f * (x + 0.044715f * x * x * x); return x * sigmoidf_(2.f * u); }
__device__ __forceinline__ float wave_sum(float v) {
#pragma unroll
    for (int o = 1; o < 64; o <<= 1) v += __shfl_xor(v, o);
    return v;
}

#define XB_TMO      128
#define XB_XCNT(j)  (256  + 64 * (j))
#define XB_XSUB(j)  (1280 + 64 * (j))
#define XB_XGEN(j)  (2304 + 64 * (j))
#define XB_TOP      3328
#define XB_TOPGEN   3392
#define XCD_BAR_WORDS 3456
#define XB_SPIN_CAP (1u << 18)

__device__ __forceinline__ unsigned xb_ld(unsigned* p)              { return __hip_atomic_load(p, __ATOMIC_RELAXED, __HIP_MEMORY_SCOPE_AGENT); }
__device__ __forceinline__ unsigned xb_add(unsigned* p, unsigned v) { return __hip_atomic_fetch_add(p, v, __ATOMIC_RELAXED, __HIP_MEMORY_SCOPE_AGENT); }
__device__ __forceinline__ unsigned xb_xcc_id() { return (unsigned)__builtin_amdgcn_s_getreg((3 << 11) | 20) & 0xFu; }
#define XB_SPIN(cond, bar) do { unsigned _sp = 0; while (cond) { __builtin_amdgcn_s_sleep(1); \
    if ((++_sp & 255u) == 0u) { if (xb_ld(&(bar)[XB_TMO])) break; if (_sp > XB_SPIN_CAP) { atomicAdd(&(bar)[XB_TMO], 1u); break; } } } } while (0)

struct XcdBarrier {
    unsigned* bar; unsigned x;
    volatile LAS unsigned* st;
};

__device__ __forceinline__ XcdBarrier xcd_barrier_post(unsigned* bar, volatile LAS unsigned* st, int tid) {
    XcdBarrier b; b.bar = bar; b.x = xb_xcc_id(); b.st = st;
    if (tid == 0) (void)xb_add(&bar[XB_XCNT(b.x)], 1u);
    return b;
}
__device__ __forceinline__ void xcd_barrier_complete(unsigned* bar, unsigned x, unsigned& nloc, unsigned& nx) {
    const unsigned G = gridDim.x * gridDim.y * gridDim.z;
    unsigned sum, cnt, mine, sp = 0u;
    for (;;) {
        sum = 0u; cnt = 0u; mine = 0u;
#pragma unroll 1
        for (unsigned j = 0; j < 16; ++j) { const unsigned c = xb_ld(&bar[XB_XCNT(j)]); sum += c; cnt += (c > 0u) ? 1u : 0u; mine = (j == x) ? c : mine; }
        if (sum == G) break;
        __builtin_amdgcn_s_sleep(1);
        if ((++sp & 255u) == 0u) { if (xb_ld(&bar[XB_TMO])) break; if (sp > XB_SPIN_CAP) { atomicAdd(&bar[XB_TMO], 1u); break; } }
    }
    nloc = mine > 0u ? mine : 1u; nx = cnt > 0u ? cnt : 1u;
}

__device__ __forceinline__ void xcd_barrier(const XcdBarrier& b, int tid) {
    asm volatile("s_waitcnt vmcnt(0)" ::: "memory");
    __syncthreads();
    if (tid == 0) {
        unsigned* bar = b.bar;
        __builtin_amdgcn_s_waitcnt(0);
        unsigned nloc = b.st[0], nx = b.st[1];
        if (nloc == 0u) { xcd_barrier_complete(bar, b.x, nloc, nx); b.st[0] = nloc; b.st[1] = nx; }
        const unsigned old = xb_add(&bar[XB_XSUB(b.x)], 1u);
        const unsigned gen = old / nloc;
        if (old + 1u == (gen + 1u) * nloc) {
            __builtin_amdgcn_fence(__ATOMIC_RELEASE, "agent");
            asm volatile("s_waitcnt vmcnt(0)" ::: "memory");
            const unsigned og = xb_add(&bar[XB_TOP], 1u);
            const unsigned tg = og / nx;
            if (og + 1u == (tg + 1u) * nx) xb_add(&bar[XB_TOPGEN], 1u);
            else XB_SPIN(xb_ld(&bar[XB_TOPGEN]) == tg, bar);
            __builtin_amdgcn_fence(__ATOMIC_ACQUIRE, "agent");
            xb_add(&bar[XB_XGEN(b.x)], 1u);
            asm volatile("s_waitcnt vmcnt(0)" ::: "memory");
        } else {
            XB_SPIN(xb_ld(&bar[XB_XGEN(b.x)]) == gen, bar);
            __builtin_amdgcn_fence(__ATOMIC_ACQUIRE, "agent");
            asm volatile("s_waitcnt vmcnt(0)" ::: "memory");
        }
    }
    __syncthreads();
}

struct Frame {
    LAS unsigned char* lds;
    int tid, lane, wave;
    int vcu, G;
    int gw, NGW;
    float* out; unsigned char* ws;
};
constexpr int PTR_OFF = LDSCTL_OFF + 512;
__device__ __forceinline__ const float* inp_(LAS unsigned char* lds, int i) {
    const unsigned long long v = *(const LAS unsigned long long*)(lds + PTR_OFF + 8 * i);
    const unsigned lo = __builtin_amdgcn_readfirstlane((unsigned)v), hi = __builtin_amdgcn_readfirstlane((unsigned)(v >> 32));
    return (const float*)(((unsigned long long)hi << 32) | lo);
}
#define INP(i) inp_(F.lds, (i))
#define WSP(T, off) ((T*)(F.ws + (off)))

__device__ __forceinline__ void gemv17_item(Frame& F, const LAS float* tab, LAS float* red, const float* W, int ldw, int n0, const float* bias, float* outp, int ldo, int n0out) {
    float acc[17];
#pragma unroll
    for (int r = 0; r < 17; ++r) acc[r] = 0.f;
    const int k0 = F.wave * 128;
    const float* wp = W + (size_t)k0 * ldw + n0 + F.lane;
#pragma unroll 1
    for (int kk = 0; kk < 128; kk += 32) {
        float wv[32];
#pragma unroll
        for (int k = 0; k < 32; ++k) wv[k] = wp[(size_t)(kk + k) * ldw];
#pragma unroll
        for (int k = 0; k < 32; ++k) {
#pragma unroll
            for (int r = 0; r < 17; ++r) acc[r] += tab[r * 1024 + k0 + kk + k] * wv[k];
        }
    }
#pragma unroll
    for (int r = 0; r < 17; ++r) red[(F.wave * 17 + r) * 64 + F.lane] = acc[r];
    __syncthreads();
    for (int i = F.tid; i < 17 * 64; i += NWAVES * 64) {
        const int r = i >> 6, n = i & 63; float s = bias ? bias[n0 + n] : 0.f;
#pragma unroll
        for (int w = 0; w < 8; ++w) s += red[(w * 17 + r) * 64 + n];
        outp[(size_t)r * ldo + n0out + n] = s;
    }
    __syncthreads();
}

__host__ __device__ __forceinline__ int glu_col(int o) { return o >= 512 ? o : ((o >> 7) & 1) * 256 + (o >> 8) * 128 + (o & 127); }
__device__ __forceinline__ void p0_transpose_item(const float* W, int K, int N, bf16* WT, LAS float* scr, int item, int lane, bool glu) {
    const int nblk = N / 32, kb = item / nblk, nb = item % nblk, k0 = 64 * kb, n0 = 32 * nb;
    const int n0o = glu ? glu_col(n0) : n0;
    float tv[32];
#pragma unroll
    for (int i = 0; i < 32; ++i) { const int kk = 2 * i + (lane >> 5); tv[i] = W[(size_t)(k0 + kk) * N + n0 + (lane & 31)]; }
#pragma unroll
    for (int i = 0; i < 32; ++i) { const int kk = 2 * i + (lane >> 5); scr[kk * 33 + (lane & 31)] = tv[i]; }
    LDS_WAIT(); asm volatile("" ::: "memory");
    const int c = lane & 7;
#pragma unroll
    for (int j = 0; j < 4; ++j) { const int n = (lane >> 3) + 8 * j; const LAS float* s = scr + (8 * c) * 33 + n;
        v4u o; o.x = pk2(s[0 * 33], s[1 * 33]); o.y = pk2(s[2 * 33], s[3 * 33]); o.z = pk2(s[4 * 33], s[5 * 33]); o.w = pk2(s[6 * 33], s[7 * 33]);
        *(GAS v4u*)(WT + (size_t)(n0o + n) * K + k0 + 8 * c) = o; }
    LDS_WAIT(); asm volatile("" ::: "memory");
}

__device__ __forceinline__ void weight_items(Frame& F, int first, int last, int widx, int nw) {
    LAS float* scr = (LAS float*)(F.lds + F.wave * 16384);
    constexpr int I_IN = (D / 64) * (IND / 32), I_OUT = (D / 64) * (D / 32), I_1 = (D / 64) * (FF / 32), I_2 = (FF / 64) * (D / 32), I_L = I_IN + I_OUT + I_1 + I_2;
    for (int it = first + widx; it < last; it += nw) {
        const int l = it / I_L; int r = it % I_L;
        const float* W; bf16* WT; int K = D, N; const bool glu = r < I_IN;
        if (r < I_IN) { W = INP(8) + (size_t)l * D * IND; WT = WSP(bf16, WS_WIN) + (size_t)l * IND * D; N = IND; }
        else if (r < I_IN + I_OUT) { r -= I_IN; W = INP(9) + (size_t)l * D * D; WT = WSP(bf16, WS_WOUT) + (size_t)l * D * D; N = D; }
        else if (r < I_IN + I_OUT + I_1) { r -= I_IN + I_OUT; W = INP(22) + (size_t)l * D * FF; WT = WSP(bf16, WS_W1) + (size_t)l * FF * D; N = FF; }
        else { r -= I_IN + I_OUT + I_1; W = INP(23) + (size_t)l * FF * D; WT = WSP(bf16, WS_W2) + (size_t)l * D * FF; K = FF; N = D; }
        p0_transpose_item(W, K, N, WT, scr, r, F.lane, glu);
    }
}
constexpr int W_ITEMS = 2 * ((D / 64) * (IND / 32) + (D / 64) * (D / 32) + (D / 64) * (FF / 32) + (FF / 64) * (D / 32));
constexpr int W_EARLY = 64 * NWAVES * 3;

__device__ __forceinline__ void phase_p0a(Frame& F) {
    LAS float* tab = (LAS float*)(F.lds);
    LAS float* red = (LAS float*)(F.lds + 17 * 1024 * 4);
    float* MOD = WSP(float, WS_MOD);
    bool filled = false;
    for (int it = F.vcu; it < 2 * 96; it += F.G) {
        if (!filled) {
            for (int i = F.tid; i < 17 * 1024; i += NWAVES * 64) { const int r = i >> 10, k = i & 1023; const float v = (r < 16) ? INP(1)[r * D + k] : INP(3)[k]; tab[i] = siluf_(v); }
            __syncthreads(); filled = true;
        }
        const int l = it / 96, n0 = (it % 96) * 64;
        gemv17_item(F, tab, red, INP(6) + (size_t)l * D * MODW, MODW, n0, INP(7) + (size_t)l * MODW, MOD + (size_t)l * 17 * MODW, MODW, n0);
    }
    if (F.G == 256 && F.vcu >= 192) weight_items(F, 0, W_EARLY, (F.vcu - 192) * NWAVES + F.wave, 64 * NWAVES);
}

__device__ __forceinline__ void phase_p0b(Frame& F) {
    LAS float* tab = (LAS float*)(F.lds);
    LAS float* red = (LAS float*)(F.lds + 17 * 1024 * 4);
    const float* MOD = WSP(const float, WS_MOD);
    for (int it = F.vcu; it < 2 * 104; it += F.G) {
        const int l = it / 104, j = it % 104; const bool first = j < 40;
        const int shoff = first ? 0 : 3 * D;
        __syncthreads();
        for (int i = F.tid; i < 17 * 1024; i += NWAVES * 64) { const int r = i >> 10, k = i & 1023; tab[i] = MOD[((size_t)l * 17 + r) * MODW + shoff + k]; }
        __syncthreads();
        const int ldw = first ? IND : FF;
        gemv17_item(F, tab, red, first ? INP(8) + (size_t)l * D * IND : INP(22) + (size_t)l * D * FF, ldw, (first ? j : j - 40) * 64, nullptr,
                    first ? WSP(float, WS_SHW1) + (size_t)l * 17 * IND : WSP(float, WS_SHW2) + (size_t)l * 17 * FF, ldw, first ? glu_col(j * 64) : (j - 40) * 64);
    }
    bf16* XA = WSP(bf16, WS_XA); float* RSSA = WSP(float, WS_RSSA);
    const float* g1 = INP(4);
    for (int row = F.gw; row < MT; row += 2 * F.NGW) {
        f32x4 v[2][4]; float ss[2]; int rw[2]; const float* scp[2];
#pragma unroll
        for (int q = 0; q < 2; ++q) { int r_ = row + q * F.NGW; if (r_ >= MT) r_ = row; rw[q] = r_;
            const bool lat = r_ < ML;
            const float* xr = lat ? INP(0) + (size_t)r_ * D : INP(2) + (size_t)(r_ - ML) * D;
            scp[q] = MOD + (size_t)(lat ? (r_ >> 11) : NB) * MODW + D;
#pragma unroll
            for (int j = 0; j < 4; ++j) v[q][j] = *(const f32x4*)(xr + 4 * F.lane + 256 * j); }
#pragma unroll
        for (int q = 0; q < 2; ++q) { float s_ = 0.f;
#pragma unroll
            for (int j = 0; j < 4; ++j) s_ += (v[q][j][0] * v[q][j][0] + v[q][j][1] * v[q][j][1]) + (v[q][j][2] * v[q][j][2] + v[q][j][3] * v[q][j][3]);
            ss[q] = wave_sum(s_); }
#pragma unroll
        for (int q = 0; q < 2; ++q) { if (q == 1 && rw[1] == row) break;
            if (F.lane < 32) RSSA[(size_t)rw[q] * 32 + F.lane] = (F.lane == 0) ? ss[q] : 0.f;
#pragma unroll
            for (int j = 0; j < 4; ++j) { const int k = 4 * F.lane + 256 * j;
                const f32x4 gm = *(const f32x4*)(g1 + k) * (*(const f32x4*)(scp[q] + k) + 1.0f), a = v[q][j] * gm;
                v2u o; o.x = pk2(a[0], a[1]); o.y = pk2(a[2], a[3]); *(v2u*)(XA + (size_t)rw[q] * D + k) = o; } }
    }
    __syncthreads();
    {
        bf16* WLR = WSP(bf16, WS_WLR);
        for (int i = F.gw * 64 + F.lane; i < 2 * 2 * 4 * 2 * 4096; i += F.NGW * 64) { const int d = i & 63, e = (i >> 6) & 63, gt = (i >> 12) & 1, blk = i >> 13;
            const float* src = gt == 0 ? INP(17) : INP(19); WLR[i] = (bf16)f2bf(src[((size_t)blk * 64 + d) * 64 + e]); }
    }
    weight_items(F, (F.G == 256) ? W_EARLY : 0, W_ITEMS, F.gw, F.NGW);
}

constexpr int CV_OSROW = 260;
__device__ __forceinline__ void conv_phase(Frame& F, int l, int ntiles) {
    const bf16* PROJ = WSP(const bf16, WS_PROJ); bf16* MIX = WSP(bf16, WS_MIX);
    LAS float* us = (LAS float*)(F.lds);
    LAS float* os = (LAS float*)(F.lds + 62 * 256 * 4);
    const int c = F.tid & 255, half = F.tid >> 8;
    float w[31];
#pragma unroll
    for (int k = 0; k < 31; ++k) w[k] = INP(10)[((size_t)l * 31 + k) * 256 + c];
    const float cbias = INP(11)[l * 256 + c];
    const f32x4 lg = *(const f32x4*)(INP(12) + l * 256 + 4 * F.lane), lb = *(const f32x4*)(INP(13) + l * 256 + 4 * F.lane);
    unsigned pv[16];
    auto load_tile = [&](int T) {
        const int row0 = T * 32;
        int lo, hi; if (row0 < ML) { lo = row0 & ~(SEQ - 1); hi = lo + SEQ; } else { lo = row0 & ~(CTXL - 1); hi = lo + CTXL; }
#pragma unroll
        for (int j = 0; j < 16; ++j) { const int i = F.tid + 512 * j, rr = i >> 7, cp = i & 127, row = row0 - 15 + rr;
            const bool ok = (j < 15 || F.tid < 256) && row >= lo && row < hi;
            pv[j] = ok ? *(const unsigned*)(PROJ + (size_t)row * IND + 2 * cp) : 0u; }
    };
    const int T0 = F.G - 1 - F.vcu;
    if (T0 < ntiles) load_tile(T0);
    for (int T = T0; T < ntiles; T += F.G) {
        const int row0 = T * 32;
        __syncthreads();
#pragma unroll
        for (int j = 0; j < 16; ++j) { const int i = F.tid + 512 * j;
            if (j < 15 || F.tid < 256) { f32x2 u; u[0] = bflo(pv[j]); u[1] = bfhi(pv[j]); *(LAS f32x2*)(us + 2 * i) = u; } }
        if (T + F.G < ntiles) load_tile(T + F.G);
        __syncthreads();
        {
            float acc[16];
#pragma unroll
            for (int j = 0; j < 16; ++j) acc[j] = cbias;
            const LAS float* up = us + (16 * half) * 256 + c;
#pragma unroll
            for (int i = 0; i < 46; ++i) { const float x = up[i * 256];
#pragma unroll
                for (int j = 0; j < 16; ++j) if (i - j >= 0 && i - j <= 30) acc[j] += w[i - j] * x; }
#pragma unroll
            for (int j = 0; j < 16; ++j) os[(16 * half + j) * CV_OSROW + c] = acc[j];
        }
        __syncthreads();
#pragma unroll
        for (int q = 0; q < 4; ++q) { const int t = 4 * F.wave + q;
            const f32x4 v = *(const LAS f32x4*)(os + t * CV_OSROW + 4 * F.lane);
            const float mu = wave_sum((v[0] + v[1]) + (v[2] + v[3])) * (1.f / 256.f);
            const f32x4 d = v - mu;
            const float var = wave_sum((d[0] * d[0] + d[1] * d[1]) + (d[2] * d[2] + d[3] * d[3])) * (1.f / 256.f);
            const f32x4 y = d * rsqrtf(var + EPS) * lg + lb;
            v2u o; o.x = pk2(siluf_(y[0]), siluf_(y[1])); o.y = pk2(siluf_(y[2]), siluf_(y[3]));
            *(v2u*)(MIX + (size_t)(row0 + t) * D + 4 * F.lane) = o; }
    }
}

typedef short s16x8 __attribute__((ext_vector_type(8)));
typedef short s16x4 __attribute__((ext_vector_type(4)));
constexpr int NA_KROW = 144, NA_VROW = 160;
constexpr int NA_STAGE = 64 * NA_KROW + 64 * NA_VROW, NA_SLOT = 2 * NA_STAGE, NA_OFF_TB = 2 * NA_SLOT;
static_assert(NA_OFF_TB + 2560 <= RING_BYTES, "NA LDS map");
constexpr int NA_ITEMS_LAT = NB * NH * 8, NA_ITEMS_CTX = NB * NH * 2;
struct NaBlk { f32x4 O[4]; float m, lsum; int first; };
__device__ __forceinline__ int na_rs(int r) { int v = r - 4; return v < 0 ? 0 : (v > 24 ? 24 : v); }
__device__ __forceinline__ s16x8 na_scale_q(v4u w, float c) {
    v4u o; o.x = pg8::cvt_pk_bf16(bflo(w.x) * c, bfhi(w.x) * c); o.y = pg8::cvt_pk_bf16(bflo(w.y) * c, bfhi(w.y) * c); o.z = pg8::cvt_pk_bf16(bflo(w.z) * c, bfhi(w.z) * c); o.w = pg8::cvt_pk_bf16(bflo(w.w) * c, bfhi(w.w) * c);
    return __builtin_bit_cast(s16x8, o);
}
__device__ __forceinline__ void na_phase(Frame& F, int l, int nitems, int nav = 0) {
    const bf16* PROJ = WSP(const bf16, WS_PROJ); bf16* MIX = WSP(bf16, WS_MIX);
    LAS float* tb = (LAS float*)(F.lds + NA_OFF_TB);
    const int lane = F.lane, q16 = lane & 15, g = lane >> 4;
    const unsigned skey = (unsigned)(F.tid >> 3), spart = (unsigned)(F.tid & 7);
    const float c1 = 0.125f * 1.4426950408889634f;
    struct NaItem { int b, h, ra, qrow0, rsI, nloc, nch, npair, isctx; };
    auto decode = [&](int it, NaItem& I) {
        I.isctx = it >= NA_ITEMS_LAT ? 1 : 0; I.ra = 0; I.rsI = 0; I.nloc = 0;
        if (!I.isctx) { const int r4 = it & 7; I.h = (it >> 3) & 7; I.b = it >> 6; const int r0 = 4 * r4; I.ra = r0 + 2 * (F.wave >> 2); I.qrow0 = I.b * SEQ + I.ra * 64 + (F.wave & 3) * 16;
            I.rsI = na_rs(r0); I.nloc = na_rs(r0 + 3) + 8 - I.rsI; }
        else { const int j = it - NA_ITEMS_LAT; const int hf = j & 1; I.h = (j >> 1) & 7; I.b = j >> 4; I.qrow0 = ML + I.b * CTXL + hf * 128 + F.wave * 16; }
        I.nch = I.nloc + 4; I.npair = (I.nch + 1) >> 1;
    };
    auto krow_of = [&](const NaItem& I, int ch) -> int { if (ch > I.nch - 1) ch = I.nch - 1; return ch < I.nloc ? I.b * SEQ + (I.rsI + ch) * 64 : ML + I.b * CTXL + (ch - I.nloc) * 64; };
    const int jq = F.wave & 3;
    const int o0 = jq == 0 ? 0 : 16 * jq - 8, o1 = jq == 0 ? 16 : (jq == 3 ? 48 : 16 * jq + 8);
    float madd[2][4]; int lb[2];
    {
        const int qc = jq * 16 + q16; int cs = qc - 8; cs = cs < 0 ? 0 : (cs > 48 ? 48 : cs);
#pragma unroll
        for (int e = 0; e < 4; ++e) { const int k0 = o0 + 4 * g + e, k1 = o1 + 4 * g + e;
            madd[0][e] = ((unsigned)(k0 - cs) < 16u) ? 0.f : -1.0e30f;
            madd[1][e] = (((unsigned)(k1 - cs) < 16u) && !(jq == 3 && k1 < 56)) ? 0.f : -1.0e30f; }
        lb[0] = 64 + o0 + 4 * g - qc + 15; lb[1] = 64 + o1 + 4 * g - qc + 15;
    }
    v4u kr0, vr0, kr1, vr1, qrA[2], qrB[2];
    auto issue_first = [&](const NaItem& I) {
        const bf16* Pk = PROJ + 1024 + I.h * HD + 8 * spart, * Pv = PROJ + 1536 + I.h * HD + 8 * spart, * Pq = PROJ + 512 + I.h * HD;
        kr0 = *(const v4u*)(Pk + (size_t)(krow_of(I, 0) + (int)skey) * IND); vr0 = *(const v4u*)(Pv + (size_t)(krow_of(I, 0) + (int)skey) * IND);
        kr1 = *(const v4u*)(Pk + (size_t)(krow_of(I, 1) + (int)skey) * IND); vr1 = *(const v4u*)(Pv + (size_t)(krow_of(I, 1) + (int)skey) * IND);
#pragma unroll
        for (int s_ = 0; s_ < 2; ++s_) { qrA[s_] = *(const v4u*)(Pq + (size_t)(I.qrow0 + q16) * IND + 32 * s_ + 8 * g);
            qrB[s_] = I.isctx ? qrA[s_] : *(const v4u*)(Pq + (size_t)(I.qrow0 + 64 + q16) * IND + 32 * s_ + 8 * g); }
    };
    NaItem I; int it = F.vcu; bool have = it < nitems; int tb_h = -1;
    if (have) { decode(it, I); issue_first(I); }
    while (have) {
        const bool isctx = I.isctx != 0;
        const int ra = I.ra, rsI = I.rsI, nloc = I.nloc, nch = I.nch, npair = I.npair, qrow0 = I.qrow0, h = I.h;
        const bf16* Pk = PROJ + 1024 + h * HD + 8 * spart, * Pv = PROJ + 1536 + h * HD + 8 * spart;
        s16x8 qfA[2], qfB[2];
#pragma unroll
        for (int s_ = 0; s_ < 2; ++s_) { qfA[s_] = na_scale_q(qrA[s_], c1); qfB[s_] = na_scale_q(qrB[s_], c1); }
        const int rsA = na_rs(ra), rsB = na_rs(ra + 1);
        NaItem N; const int itn = it + F.G; const bool haven = itn < nitems; if (haven) decode(itn, N); else N = I;
        __syncthreads();
        if (!isctx && h != tb_h) { const float* rpb = INP(14) + ((size_t)l * NH + h) * 15 * 31; tb_h = h;
            for (int i = F.tid; i < 640; i += NWAVES * 64) tb[i] = (i >= 64 && i < 64 + 465) ? rpb[i - 64] * 1.4426950408889634f : 0.f; }
        {
            LAS unsigned char* s0 = F.lds;
            *(LAS v4u*)(s0 + skey * NA_KROW + spart * 16) = kr0; *(LAS v4u*)(s0 + 64 * NA_KROW + skey * NA_VROW + spart * 16) = vr0;
            *(LAS v4u*)(s0 + NA_STAGE + skey * NA_KROW + spart * 16) = kr1; *(LAS v4u*)(s0 + NA_STAGE + 64 * NA_KROW + skey * NA_VROW + spart * 16) = vr1;
        }
        if (npair > 2) {
            kr0 = *(const v4u*)(Pk + (size_t)(krow_of(I, 2) + (int)skey) * IND); vr0 = *(const v4u*)(Pv + (size_t)(krow_of(I, 2) + (int)skey) * IND);
            kr1 = *(const v4u*)(Pk + (size_t)(krow_of(I, 3) + (int)skey) * IND); vr1 = *(const v4u*)(Pv + (size_t)(krow_of(I, 3) + (int)skey) * IND);
        } else {
            kr0 = *(const v4u*)(Pk + (size_t)(krow_of(I, 2) + (int)skey) * IND); vr0 = *(const v4u*)(Pv + (size_t)(krow_of(I, 2) + (int)skey) * IND);
            kr1 = *(const v4u*)(Pk + (size_t)(krow_of(I, 3) + (int)skey) * IND); vr1 = *(const v4u*)(Pv + (size_t)(krow_of(I, 3) + (int)skey) * IND);
        }
        NaBlk A, B;
#pragma unroll
        for (int dt = 0; dt < 4; ++dt) { A.O[dt] = (f32x4){0.f, 0.f, 0.f, 0.f}; B.O[dt] = (f32x4){0.f, 0.f, 0.f, 0.f}; }
        A.m = 0.f; A.lsum = 0.f; A.first = 1; B.m = 0.f; B.lsum = 0.f; B.first = 1;
        for (int cp = 0; cp < npair; ++cp) {
            __syncthreads();
            if (cp + 1 < npair) { LAS unsigned char* nx = F.lds + ((cp + 1) & 1) * NA_SLOT;
                *(LAS v4u*)(nx + skey * NA_KROW + spart * 16) = kr0; *(LAS v4u*)(nx + 64 * NA_KROW + skey * NA_VROW + spart * 16) = vr0;
                *(LAS v4u*)(nx + NA_STAGE + skey * NA_KROW + spart * 16) = kr1; *(LAS v4u*)(nx + NA_STAGE + 64 * NA_KROW + skey * NA_VROW + spart * 16) = vr1; }
            if (cp + 2 < npair) { const int k2 = krow_of(I, 2 * cp + 4) + (int)skey, k3 = krow_of(I, 2 * cp + 5) + (int)skey;
                kr0 = *(const v4u*)(Pk + (size_t)k2 * IND); vr0 = *(const v4u*)(Pv + (size_t)k2 * IND); kr1 = *(const v4u*)(Pk + (size_t)k3 * IND); vr1 = *(const v4u*)(Pv + (size_t)k3 * IND); }
            else if (cp + 2 == npair && haven) issue_first(N);
          for (int sub = 0; sub < 2; ++sub) {
            const int ch = 2 * cp + sub;
            if (ch >= nch) break;
            LAS unsigned char* cur = F.lds + (cp & 1) * NA_SLOT + sub * NA_STAGE;
            const bool local = ch < nloc;
            const int kr = rsI + ch;
            const bool actA = !local || (kr >= rsA && kr <= rsA + 7), actB = !isctx && (!local || (kr >= rsB && kr <= rsB + 7));
            if ((!actA && !actB) || nav == 1) continue;
            auto finish = [&](f32x4* S, int nt_, NaBlk& X, unsigned (*pk)[2], float cm) {
                if (X.first || !__all(cm <= 8.f)) {
                    cm = fmaxf(cm, __shfl_xor(cm, 16)); cm = fmaxf(cm, __shfl_xor(cm, 32));
                    const float d = X.first ? cm : fmaxf(cm, 0.f);
                    if (!X.first) { const float alpha = __builtin_amdgcn_exp2f(-d); X.lsum *= alpha;
#pragma unroll
                        for (int dt = 0; dt < 4; ++dt) X.O[dt] = X.O[dt] * alpha; }
                    X.m += d; X.first = 0;
#pragma unroll
                    for (int t = 0; t < 4; ++t) if (t < nt_) S[t] = S[t] - d;
                }
                float ps = 0.f;
#pragma unroll
                for (int t = 0; t < 4; ++t) if (t < nt_) {
                    const float p0 = __builtin_amdgcn_exp2f(S[t][0]), p1 = __builtin_amdgcn_exp2f(S[t][1]), p2 = __builtin_amdgcn_exp2f(S[t][2]), p3 = __builtin_amdgcn_exp2f(S[t][3]);
                    ps += (p0 + p1) + (p2 + p3);
                    pk[t][0] = pg8::cvt_pk_bf16(p0, p1); pk[t][1] = pg8::cvt_pk_bf16(p2, p3); }
                X.lsum += ps;
            };
            unsigned pkA[4][2], pkB[4][2];
            if (local) {
                const LAS unsigned char* kb_ = cur + q16 * NA_KROW + 16 * g;
                f32x4 SA[2], SB[2];
#pragma unroll
                for (int t = 0; t < 2; ++t) { const float ma = -A.m, mb = -B.m; SA[t] = (f32x4){ma, ma, ma, ma}; SB[t] = (f32x4){mb, mb, mb, mb};
                    const int o = t == 0 ? o0 : o1;
#pragma unroll
                    for (int s_ = 0; s_ < 2; ++s_) { const s16x8 kf = *(const LAS s16x8*)(kb_ + o * NA_KROW + 64 * s_);
                        if (actA) SA[t] = __builtin_amdgcn_mfma_f32_16x16x32_bf16(kf, qfA[s_], SA[t], 0, 0, 0);
                        if (actB) SB[t] = __builtin_amdgcn_mfma_f32_16x16x32_bf16(kf, qfB[s_], SB[t], 0, 0, 0); } }
                if (nav == 2) { asm volatile("" :: "v"(SA[0]), "v"(SA[1]), "v"(SB[0]), "v"(SB[1])); continue; }
                auto soft_local = [&](f32x4 (&S)[2], NaBlk& X, unsigned (&pk)[4][2], int rq) {
                    float cm = -1.0e30f;
#pragma unroll
                    for (int t = 0; t < 2; ++t) { const LAS float* tr_ = tb + (kr - rq + 7) * 31 + lb[t];
#pragma unroll
                        for (int e = 0; e < 4; ++e) { const float v = (S[t][e] + tr_[e]) + madd[t][e]; S[t][e] = v; cm = fmaxf(cm, v); } }
                    finish(S, 2, X, pk, cm);
                };
                if (actA) soft_local(SA, A, pkA, ra);
                if (actB) soft_local(SB, B, pkB, ra + 1);
                if (nav == 3) { asm volatile("" :: "v"(pkA[0][0]), "v"(pkA[1][1]), "v"(pkB[0][0]), "v"(pkB[1][1])); continue; }
                const LAS unsigned char* vtr = cur + 64 * NA_KROW + (4 * g + (q16 >> 2)) * NA_VROW + (q16 & 3) * 8;
                const v4u bwA = {pkA[0][0], pkA[0][1], pkA[1][0], pkA[1][1]}, bwB = {pkB[0][0], pkB[0][1], pkB[1][0], pkB[1][1]};
                const s16x8 bfA = __builtin_bit_cast(s16x8, bwA), bfB = __builtin_bit_cast(s16x8, bwB);
#pragma unroll
                for (int dt = 0; dt < 4; ++dt) {
                    const s16x4 a0 = __builtin_amdgcn_ds_read_tr16_b64_v4i16((LAS s16x4*)(vtr + o0 * NA_VROW + dt * 32));
                    const s16x4 a1 = __builtin_amdgcn_ds_read_tr16_b64_v4i16((LAS s16x4*)(vtr + o1 * NA_VROW + dt * 32));
                    const s16x8 afrag = __builtin_shufflevector(a0, a1, 0, 1, 2, 3, 4, 5, 6, 7);
                    if (actA) A.O[dt] = __builtin_amdgcn_mfma_f32_16x16x32_bf16(afrag, bfA, A.O[dt], 0, 0, 0);
                    if (actB) B.O[dt] = __builtin_amdgcn_mfma_f32_16x16x32_bf16(afrag, bfB, B.O[dt], 0, 0, 0);
                }
            } else {
                const LAS unsigned char* kb_ = cur + q16 * NA_KROW + 16 * g;
                f32x4 SA[4], SB[4];
#pragma unroll
                for (int t = 0; t < 4; ++t) { const float ma = -A.m, mb = -B.m; SA[t] = (f32x4){ma, ma, ma, ma}; SB[t] = (f32x4){mb, mb, mb, mb};
#pragma unroll
                    for (int s_ = 0; s_ < 2; ++s_) { const s16x8 kf = *(const LAS s16x8*)(kb_ + t * 16 * NA_KROW + 64 * s_);
                        SA[t] = __builtin_amdgcn_mfma_f32_16x16x32_bf16(kf, qfA[s_], SA[t], 0, 0, 0);
                        if (actB) SB[t] = __builtin_amdgcn_mfma_f32_16x16x32_bf16(kf, qfB[s_], SB[t], 0, 0, 0); } }
                if (nav == 2) { asm volatile("" :: "v"(SA[0]), "v"(SA[1]), "v"(SA[2]), "v"(SA[3]), "v"(SB[0]), "v"(SB[1]), "v"(SB[2]), "v"(SB[3])); continue; }
                auto soft_ctx = [&](f32x4 (&S)[4], NaBlk& X, unsigned (&pk)[4][2]) {
                    float cm = -1.0e30f;
#pragma unroll
                    for (int t = 0; t < 4; ++t)
#pragma unroll
                        for (int e = 0; e < 4; ++e) cm = fmaxf(cm, S[t][e]);
                    finish(S, 4, X, pk, cm);
                };
                soft_ctx(SA, A, pkA);
                if (actB) soft_ctx(SB, B, pkB);
                if (nav == 3) { asm volatile("" :: "v"(pkA[0][0]), "v"(pkA[1][1]), "v"(pkA[2][0]), "v"(pkA[3][1]), "v"(pkB[0][0]), "v"(pkB[1][1]), "v"(pkB[2][0]), "v"(pkB[3][1])); continue; }
                const LAS unsigned char* vtr = cur + 64 * NA_KROW + (4 * g + (q16 >> 2)) * NA_VROW + (q16 & 3) * 8;
#pragma unroll
                for (int p = 0; p < 2; ++p) {
                    const v4u bwA = {pkA[2 * p][0], pkA[2 * p][1], pkA[2 * p + 1][0], pkA[2 * p + 1][1]}, bwB = {pkB[2 * p][0], pkB[2 * p][1], pkB[2 * p + 1][0], pkB[2 * p + 1][1]};
                    const s16x8 bfA = __builtin_bit_cast(s16x8, bwA), bfB = __builtin_bit_cast(s16x8, bwB);
#pragma unroll
                    for (int dt = 0; dt < 4; ++dt) {
                        const s16x4 a0 = __builtin_amdgcn_ds_read_tr16_b64_v4i16((LAS s16x4*)(vtr + (2 * p) * 16 * NA_VROW + dt * 32));
                        const s16x4 a1 = __builtin_amdgcn_ds_read_tr16_b64_v4i16((LAS s16x4*)(vtr + (2 * p + 1) * 16 * NA_VROW + dt * 32));
                        const s16x8 afrag = __builtin_shufflevector(a0, a1, 0, 1, 2, 3, 4, 5, 6, 7);
                        A.O[dt] = __builtin_amdgcn_mfma_f32_16x16x32_bf16(afrag, bfA, A.O[dt], 0, 0, 0);
                        if (actB) B.O[dt] = __builtin_amdgcn_mfma_f32_16x16x32_bf16(afrag, bfB, B.O[dt], 0, 0, 0);
                    }
                }
            }
          }
        }
        {
            float ls = A.lsum; ls += __shfl_xor(ls, 16); ls += __shfl_xor(ls, 32);
            const float inv = __builtin_amdgcn_rcpf(ls);
            bf16* op = MIX + (size_t)(qrow0 + q16) * D + 256 + h * HD + 4 * g;
#pragma unroll
            for (int dt = 0; dt < 4; ++dt) { v2u w; w.x = pg8::cvt_pk_bf16(A.O[dt][0] * inv, A.O[dt][1] * inv); w.y = pg8::cvt_pk_bf16(A.O[dt][2] * inv, A.O[dt][3] * inv); *(v2u*)(op + 16 * dt) = w; }
        }
        if (!isctx) {
            float ls = B.lsum; ls += __shfl_xor(ls, 16); ls += __shfl_xor(ls, 32);
            const float inv = __builtin_amdgcn_rcpf(ls);
            bf16* op = MIX + (size_t)(qrow0 + 64 + q16) * D + 256 + h * HD + 4 * g;
#pragma unroll
            for (int dt = 0; dt < 4; ++dt) { v2u w; w.x = pg8::cvt_pk_bf16(B.O[dt][0] * inv, B.O[dt][1] * inv); w.y = pg8::cvt_pk_bf16(B.O[dt][2] * inv, B.O[dt][3] * inv); *(v2u*)(op + 16 * dt) = w; }
        }
        it = itn; have = haven; I = N;
    }
}

constexpr int LRU_UCROW = 260;
constexpr int LRU_OFF_UC = 38 * 256 * 2, LRU_OFF_GT = LRU_OFF_UC + 2 * 32 * LRU_UCROW * 4;
static_assert(LRU_OFF_GT + 32 * 256 * 2 <= RING_BYTES, "LRU LDS map");
template <int PASS>
__device__ __forceinline__ void lru_phase(Frame& F, int l, int ntiles) {
    const bf16* PROJ = WSP(const bf16, WS_PROJ);
    LAS bf16* rxs = (LAS bf16*)(F.lds);
    LAS float* ucf = (LAS float*)(F.lds + LRU_OFF_UC);
    LAS bf16* gts = (LAS bf16*)(F.lds + LRU_OFF_GT);
    const int lane = F.lane, j16 = lane & 15, g = lane >> 4;
    const int kb = F.wave & 3, nh = F.wave >> 2;
    s16x8 wf[2][2][2][2];
    float cbx[2][2], cba[2][2], csp[2][2];
#pragma unroll
    for (int dir = 0; dir < 2; ++dir) {
        const int ld = l * 2 + dir;
        const bf16* WLR = WSP(const bf16, WS_WLR) + (size_t)((ld * 4 + kb) * 2) * 4096;
#pragma unroll
        for (int gt = 0; gt < 2; ++gt)
#pragma unroll
            for (int n2 = 0; n2 < 2; ++n2)
#pragma unroll
                for (int s_ = 0; s_ < 2; ++s_) wf[dir][gt][n2][s_] = *(const s16x8*)(WLR + gt * 4096 + (16 * (2 * nh + n2) + j16) * 64 + 32 * s_ + 8 * g);
#pragma unroll
        for (int n2 = 0; n2 < 2; ++n2) {
            const int e = kb * 64 + 16 * (2 * nh + n2) + j16, idx = ld * 256 + e;
            cbx[dir][n2] = INP(18)[idx]; cba[dir][n2] = INP(20)[idx];
            const float nl = -INP(21)[idx]; csp[dir][n2] = -8.f * (fmaxf(nl, 0.f) + log1pf(__expf(-fabsf(nl))));
        }
    }
    const int c = F.tid & 255, sdir = F.tid >> 8;
    const int sld = l * 2 + sdir;
    const float s1w0 = INP(15)[(sld * 4 + 0) * 256 + c], s1w1 = INP(15)[(sld * 4 + 1) * 256 + c], s1w2 = INP(15)[(sld * 4 + 2) * 256 + c], s1w3 = INP(15)[(sld * 4 + 3) * 256 + c], s1cb = INP(16)[sld * 256 + c];
    const int base = sdir == 0 ? 0 : 3;
    unsigned pre[10], pgw[8];
    auto load_tile = [&](int T) {
        const int row0 = T * 32;
        int lo, hi; if (row0 < ML) { lo = row0 & ~(SEQ - 1); hi = lo + SEQ; } else { lo = row0 & ~(CTXL - 1); hi = lo + CTXL; }
#pragma unroll
        for (int j = 0; j < 10; ++j) { const int i = F.tid + 512 * j, rr = i >> 7, cp = i & 127, row = row0 - 3 + rr;
            const bool ok = (j < 9 || F.tid < 256) && row >= lo && row < hi;
            pre[j] = ok ? *(const unsigned*)(PROJ + (size_t)row * IND + 2048 + 2 * cp) : 0u; }
        if (PASS == 1) {
#pragma unroll
            for (int j = 0; j < 8; ++j) { const int i = F.tid + 512 * j, t = i >> 7, cp = i & 127; pgw[j] = *(const unsigned*)(PROJ + (size_t)(row0 + t) * IND + 2304 + 2 * cp); }
        }
    };
    if (F.vcu < ntiles) load_tile(F.vcu);
    for (int T = F.vcu; T < ntiles; T += F.G) {
        const int row0 = T * 32;
        __syncthreads();
#pragma unroll
        for (int j = 0; j < 10; ++j) { const int i = F.tid + 512 * j; if (j < 9 || F.tid < 256) ((LAS unsigned*)rxs)[i] = pre[j]; }
        if (PASS == 1) {
#pragma unroll
            for (int j = 0; j < 8; ++j) ((LAS unsigned*)gts)[F.tid + 512 * j] = pgw[j];
        }
        if (T + F.G < ntiles) load_tile(T + F.G);
        float hst[2][2];
#pragma unroll
        for (int dir = 0; dir < 2; ++dir)
#pragma unroll
            for (int n2 = 0; n2 < 2; ++n2) hst[dir][n2] = PASS == 1 ? WSP(const float, WS_CARRY)[((size_t)dir * 1152 + T) * 256 + kb * 64 + 16 * (2 * nh + n2) + j16] : 0.f;
        __syncthreads();
        {
            float x0 = bf1(rxs[(base + 0) * 256 + c]), x1 = bf1(rxs[(base + 1) * 256 + c]), x2 = bf1(rxs[(base + 2) * 256 + c]);
#pragma unroll 8
            for (int t = 0; t < 32; ++t) {
                const float x3 = bf1(rxs[(t + base + 3) * 256 + c]);
                ucf[(sdir * 32 + t) * LRU_UCROW + c] = s1cb + s1w0 * x0 + s1w1 * x1 + s1w2 * x2 + s1w3 * x3;
                x0 = x1; x1 = x2; x2 = x3;
            }
        }
        __syncthreads();
        float hf[2][2][4];
        float Pt[2][2] = {{1.f, 1.f}, {1.f, 1.f}};
#pragma unroll
        for (int dir = 0; dir < 2; ++dir) {
            const bool sec16 = ((g & 1) != 0) != (dir != 0), sec32 = ((g >> 1) != 0) != (dir != 0);
#pragma unroll
            for (int step = 0; step < 2; ++step) {
                const int rt = dir == 0 ? step : 1 - step;
                s16x8 af[2];
#pragma unroll
                for (int s_ = 0; s_ < 2; ++s_) { const LAS float* up = ucf + (dir * 32 + 16 * rt + j16) * LRU_UCROW + kb * 64 + 32 * s_ + 8 * g;
                    const f32x4 u0 = *(const LAS f32x4*)up, u1 = *(const LAS f32x4*)(up + 4);
                    const v4u w = {pg8::cvt_pk_bf16(u0[0], u0[1]), pg8::cvt_pk_bf16(u0[2], u0[3]), pg8::cvt_pk_bf16(u1[0], u1[1]), pg8::cvt_pk_bf16(u1[2], u1[3])};
                    af[s_] = __builtin_bit_cast(s16x8, w); }
#pragma unroll
                for (int n2 = 0; n2 < 2; ++n2) {
                    f32x4 zx = {0.f, 0.f, 0.f, 0.f}, za = {0.f, 0.f, 0.f, 0.f};
#pragma unroll
                    for (int s_ = 0; s_ < 2; ++s_) { zx = __builtin_amdgcn_mfma_f32_16x16x32_bf16(af[s_], wf[dir][0][n2][s_], zx, 0, 0, 0); za = __builtin_amdgcn_mfma_f32_16x16x32_bf16(af[s_], wf[dir][1][n2][s_], za, 0, 0, 0); }
                    const int e = kb * 64 + 16 * (2 * nh + n2) + j16;
                    const LAS float* uo = ucf + (dir * 32 + 16 * rt + 4 * g) * LRU_UCROW + e;
                    float a_[4], b_[4]; unsigned abw[4];
#pragma unroll
                    for (int r = 0; r < 4; ++r) {
                        const float u = uo[r * LRU_UCROW];
                        const float gx = sigmoidf_(zx[r] + cbx[dir][n2]), ga = sigmoidf_(za[r] + cba[dir][n2]);
                        const float la = csp[dir][n2] * ga, a = __builtin_amdgcn_exp2f(1.4426950408889634f * la), y = 2.f * la;
                        const float om = y > -0.02f ? -y * (1.f + y * (0.5f + y * 0.16666667f)) : 1.f - a * a;
                        a_[r] = a; b_[r] = __builtin_amdgcn_sqrtf(om) * gx * u;
                        if (PASS == 0) {
                            const float oma = la > -0.02f ? -la * (1.f + la * (0.5f + la * 0.16666667f)) : 1.f - a;
                            abw[r] = pg8::cvt_pk_bf16(oma, b_[r]); a_[r] = 1.f - bflo(abw[r]); b_[r] = bfhi(abw[r]);
                        }
                    }
                    if (PASS == 0) WSP(v4u, WS_AB)[(((((size_t)T * 2 + dir) * 2 + rt) * 8 + F.wave) * 2 + n2) * 64 + lane] = (v4u){abw[0], abw[1], abw[2], abw[3]};
                    const float P = (a_[0] * a_[1]) * (a_[2] * a_[3]);
                    const float S = dir == 0 ? ((b_[0] * a_[1] + b_[1]) * a_[2] + b_[2]) * a_[3] + b_[3] : ((b_[3] * a_[2] + b_[2]) * a_[1] + b_[1]) * a_[0] + b_[0];
                    const float Pp = __shfl_xor(P, 16), Sp = __shfl_xor(S, 16);
                    const float e1P = sec16 ? Pp : 1.f, e1S = sec16 ? Sp : 0.f;
                    const float prP = P * Pp, prS = sec16 ? P * Sp + S : Pp * S + Sp;
                    const float Pq = __shfl_xor(prP, 32), Sq = __shfl_xor(prS, 32);
                    const float EP = sec32 ? Pq * e1P : e1P, ES = sec32 ? e1P * Sq + e1S : e1S;
                    const float TP = prP * Pq, TS = sec32 ? prP * Sq + prS : Pq * prS + Sq;
                    if (PASS == 1) {
                        float h = EP * hst[dir][n2] + ES;
                        if (dir == 0) {
#pragma unroll
                            for (int r = 0; r < 4; ++r) { h = a_[r] * h + b_[r]; hf[rt][n2][r] = h; }
                        } else {
                            float hb[4];
#pragma unroll
                            for (int r = 3; r >= 0; --r) { h = a_[r] * h + b_[r]; hb[r] = h; }
                            bf16* mp = WSP(bf16, WS_MIX) + (size_t)(row0 + 16 * rt + 4 * g) * D + 768 + e;
                            const LAS bf16* gp = gts + (16 * rt + 4 * g) * 256 + e;
#pragma unroll
                            for (int r = 0; r < 4; ++r) mp[(size_t)r * D] = (bf16)f2bf(gelu_tanh(bf1(gp[r * 256])) * (hf[rt][n2][r] + hb[r]));
                        }
                    } else Pt[dir][n2] *= TP;
                    hst[dir][n2] = TP * hst[dir][n2] + TS;
                }
            }
        }
        if (PASS == 0 && g == 0) {
#pragma unroll
            for (int dir = 0; dir < 2; ++dir)
#pragma unroll
                for (int n2 = 0; n2 < 2; ++n2) WSP(f32x2, WS_TOT)[((size_t)dir * 1152 + T) * 256 + kb * 64 + 16 * (2 * nh + n2) + j16] = (f32x2){Pt[dir][n2], hst[dir][n2]};
        }
    }
}
__device__ __forceinline__ void lru_scan_phase(Frame& F, int l, int ntiles) {
    const bf16* PROJ = WSP(const bf16, WS_PROJ);
    LAS bf16* gts = (LAS bf16*)(F.lds);
    const int lane = F.lane, j16 = lane & 15, g = lane >> 4;
    const int kb = F.wave & 3, nh = F.wave >> 2;
    const v4u* AB = WSP(const v4u, WS_AB);
    v4u pab[2][2][2]; unsigned pgw[8];
    auto load_tile = [&](int T) {
#pragma unroll
        for (int dir = 0; dir < 2; ++dir)
#pragma unroll
            for (int rt = 0; rt < 2; ++rt)
#pragma unroll
                for (int n2 = 0; n2 < 2; ++n2) pab[dir][rt][n2] = AB[(((((size_t)T * 2 + dir) * 2 + rt) * 8 + F.wave) * 2 + n2) * 64 + lane];
#pragma unroll
        for (int j = 0; j < 8; ++j) { const int i = F.tid + 512 * j, t = i >> 7, cp = i & 127; pgw[j] = *(const unsigned*)(PROJ + (size_t)(T * 32 + t) * IND + 2304 + 2 * cp); }
    };
    if (F.vcu < ntiles) load_tile(F.vcu);
    for (int T = F.vcu; T < ntiles; T += F.G) {
        const int row0 = T * 32;
        __syncthreads();
#pragma unroll
        for (int j = 0; j < 8; ++j) ((LAS unsigned*)gts)[F.tid + 512 * j] = pgw[j];
        v4u cur[2][2][2];
#pragma unroll
        for (int dir = 0; dir < 2; ++dir)
#pragma unroll
            for (int rt = 0; rt < 2; ++rt)
#pragma unroll
                for (int n2 = 0; n2 < 2; ++n2) cur[dir][rt][n2] = pab[dir][rt][n2];
        float hst[2][2];
#pragma unroll
        for (int dir = 0; dir < 2; ++dir)
#pragma unroll
            for (int n2 = 0; n2 < 2; ++n2) hst[dir][n2] = WSP(const float, WS_CARRY)[((size_t)dir * 1152 + T) * 256 + kb * 64 + 16 * (2 * nh + n2) + j16];
        if (T + F.G < ntiles) load_tile(T + F.G);
        __syncthreads();
        float hf[2][2][4];
#pragma unroll
        for (int dir = 0; dir < 2; ++dir) {
            const bool sec16 = ((g & 1) != 0) != (dir != 0), sec32 = ((g >> 1) != 0) != (dir != 0);
#pragma unroll
            for (int step = 0; step < 2; ++step) {
                const int rt = dir == 0 ? step : 1 - step;
#pragma unroll
                for (int n2 = 0; n2 < 2; ++n2) {
                    const int e = kb * 64 + 16 * (2 * nh + n2) + j16;
                    const v4u w = cur[dir][rt][n2];
                    const float a_[4] = {1.f - bflo(w.x), 1.f - bflo(w.y), 1.f - bflo(w.z), 1.f - bflo(w.w)}, b_[4] = {bfhi(w.x), bfhi(w.y), bfhi(w.z), bfhi(w.w)};
                    const float P = (a_[0] * a_[1]) * (a_[2] * a_[3]);
                    const float S = dir == 0 ? ((b_[0] * a_[1] + b_[1]) * a_[2] + b_[2]) * a_[3] + b_[3] : ((b_[3] * a_[2] + b_[2]) * a_[1] + b_[1]) * a_[0] + b_[0];
                    const float Pp = __shfl_xor(P, 16), Sp = __shfl_xor(S, 16);
                    const float e1P = sec16 ? Pp : 1.f, e1S = sec16 ? Sp : 0.f;
                    const float prP = P * Pp, prS = sec16 ? P * Sp + S : Pp * S + Sp;
                    const float Pq = __shfl_xor(prP, 32), Sq = __shfl_xor(prS, 32);
                    const float EP = sec32 ? Pq * e1P : e1P, ES = sec32 ? e1P * Sq + e1S : e1S;
                    const float TP = prP * Pq, TS = sec32 ? prP * Sq + prS : Pq * prS + Sq;
                    float h = EP * hst[dir][n2] + ES;
                    if (dir == 0) {
#pragma unroll
                        for (int r = 0; r < 4; ++r) { h = a_[r] * h + b_[r]; hf[rt][n2][r] = h; }
                    } else {
                        float hb[4];
#pragma unroll
                        for (int r = 3; r >= 0; --r) { h = a_[r] * h + b_[r]; hb[r] = h; }
                        bf16* mp = WSP(bf16, WS_MIX) + (size_t)(row0 + 16 * rt + 4 * g) * D + 768 + e;
                        const LAS bf16* gp = gts + (16 * rt + 4 * g) * 256 + e;
#pragma unroll
                        for (int r = 0; r < 4; ++r) mp[(size_t)r * D] = (bf16)f2bf(gelu_tanh(bf1(gp[r * 256])) * (hf[rt][n2][r] + hb[r]));
                    }
                    hst[dir][n2] = TP * hst[dir][n2] + TS;
                }
            }
        }
    }
}

__device__ __forceinline__ void lru_carry(Frame& F) {
    const f32x2* TOT = WSP(const f32x2, WS_TOT); float* CARRY = WSP(float, WS_CARRY);
    for (int it = F.gw; it < NB * 2 * 4; it += F.NGW) {
        const int b = it >> 3, dir = (it >> 2) & 1, c = (it & 3) * 64 + F.lane;
        float h = 0.f;
        for (int g = 0; g < 18; ++g) {
            f32x2 ps[4]; int tl[4];
#pragma unroll
            for (int i = 0; i < 4; ++i) { const int s = g * 4 + i;
                int T; if (s < 8) T = 1024 + b * 8 + (dir == 0 ? s : 7 - s); else T = b * 64 + (dir == 0 ? s - 8 : 71 - s);
                tl[i] = T; ps[i] = TOT[((size_t)dir * 1152 + T) * 256 + c]; }
#pragma unroll
            for (int i = 0; i < 4; ++i) { CARRY[((size_t)dir * 1152 + tl[i]) * 256 + c] = h; h = ps[i][0] * h + ps[i][1]; }
        }
    }
}

__device__ __forceinline__ void ctx_finalize(Frame& F, int l) {
    bf16* XA = WSP(bf16, WS_XA); float* RSSA = WSP(float, WS_RSSA); const float* ACC = WSP(const float, WS_PART); const float* MOD = WSP(const float, WS_MOD);
    const float* go = INP(5) + (l - 1) * D; const float* gso = MOD + ((size_t)(l - 1) * 17 + NB) * MODW + 4 * D;
    const float* gn = INP(4) + l * D; const float* gsn = MOD + ((size_t)l * 17 + NB) * MODW + D;
    for (int r = F.gw; r < MC; r += F.NGW) {
        const size_t row = (size_t)ML + r;
        float ss = 0.f; f32x4 y[4];
#pragma unroll
        for (int j = 0; j < 4; ++j) { const int k = 4 * F.lane + 256 * j;
            const v2u w = *(const v2u*)(XA + row * D + k);
            const f32x4 im = *(const f32x4*)(go + k) * (*(const f32x4*)(gso + k) + 1.0f);
            const f32x4 xo = (f32x4){bflo(w.x) * __builtin_amdgcn_rcpf(im[0]), bfhi(w.x) * __builtin_amdgcn_rcpf(im[1]), bflo(w.y) * __builtin_amdgcn_rcpf(im[2]), bfhi(w.y) * __builtin_amdgcn_rcpf(im[3])};
            const float* ap = ACC + (size_t)r * D + k;
            y[j] = xo + ((*(const f32x4*)ap + *(const f32x4*)(ap + (size_t)MC * D)) + (*(const f32x4*)(ap + (size_t)2 * MC * D) + *(const f32x4*)(ap + (size_t)3 * MC * D)));
            ss += (y[j][0] * y[j][0] + y[j][1] * y[j][1]) + (y[j][2] * y[j][2] + y[j][3] * y[j][3]); }
        ss = wave_sum(ss);
        if (F.lane < 32) RSSA[row * 32 + F.lane] = (F.lane == 0) ? ss : 0.f;
#pragma unroll
        for (int j = 0; j < 4; ++j) { const int k = 4 * F.lane + 256 * j;
            const f32x4 a = y[j] * (*(const f32x4*)(gn + k) * (*(const f32x4*)(gsn + k) + 1.0f));
            v2u o; o.x = pk2(a[0], a[1]); o.y = pk2(a[2], a[3]); *(v2u*)(XA + row * D + k) = o; }
    }
}

__device__ __forceinline__ void final_rows(Frame& F) {
    const bf16* XA = WSP(const bf16, WS_XA); const float* RSS = WSP(const float, WS_RSSA);
    for (int row = F.gw; row < ML; row += 2 * F.NGW) {
        const int row2 = row + F.NGW; const bool two = row2 < ML;
        const v4u a0 = *(const v4u*)(XA + (size_t)row * D + 8 * F.lane), a1 = *(const v4u*)(XA + (size_t)row * D + 512 + 8 * F.lane);
        const float p0 = F.lane < 32 ? RSS[(size_t)row * 32 + F.lane] : 0.f;
        v4u b0 = a0, b1 = a1; float p1 = 0.f;
        if (two) { b0 = *(const v4u*)(XA + (size_t)row2 * D + 8 * F.lane); b1 = *(const v4u*)(XA + (size_t)row2 * D + 512 + 8 * F.lane); p1 = F.lane < 32 ? RSS[(size_t)row2 * 32 + F.lane] : 0.f; }
        const float rs0 = rsqrtf(wave_sum(p0) * (1.f / D) + EPS), rs1 = rsqrtf(wave_sum(p1) * (1.f / D) + EPS);
        float* o = F.out + (size_t)row * D + 8 * F.lane;
        *(f32x4*)(o) = (f32x4){bflo(a0.x), bfhi(a0.x), bflo(a0.y), bfhi(a0.y)} * rs0; *(f32x4*)(o + 4) = (f32x4){bflo(a0.z), bfhi(a0.z), bflo(a0.w), bfhi(a0.w)} * rs0;
        *(f32x4*)(o + 512) = (f32x4){bflo(a1.x), bfhi(a1.x), bflo(a1.y), bfhi(a1.y)} * rs0; *(f32x4*)(o + 516) = (f32x4){bflo(a1.z), bfhi(a1.z), bflo(a1.w), bfhi(a1.w)} * rs0;
        if (two) { float* o2 = F.out + (size_t)row2 * D + 8 * F.lane;
            *(f32x4*)(o2) = (f32x4){bflo(b0.x), bfhi(b0.x), bflo(b0.y), bfhi(b0.y)} * rs1; *(f32x4*)(o2 + 4) = (f32x4){bflo(b0.z), bfhi(b0.z), bflo(b0.w), bfhi(b0.w)} * rs1;
            *(f32x4*)(o2 + 512) = (f32x4){bflo(b1.x), bfhi(b1.x), bflo(b1.y), bfhi(b1.y)} * rs1; *(f32x4*)(o2 + 516) = (f32x4){bflo(b1.z), bfhi(b1.z), bflo(b1.w), bfhi(b1.w)} * rs1; }
    }
}

__device__ __forceinline__ void fill_res_tables(Frame& F, const pg8::Order& S, const float* gate, const float* gmg, const float* gmsc, const float* go, const float* gso) {
    LAS float* T = (LAS float*)(F.lds + TBL_OFF);
    if (F.tid < 256) {
#pragma unroll 1
        for (int i = 0; i < pg8::TBL_UNITS; ++i) { pg8::Unit u; if (!S.next(i, u)) break;
            const int brow = u.pm < ML / 256 ? (u.pm >> 3) : NB, col = u.pn * 256 + F.tid;
            T[i * 256 + F.tid] = gate[(size_t)brow * MODW + col];
            T[(pg8::TBL_UNITS + i) * 256 + F.tid] = gmg[col] * (1.f + gmsc[(size_t)brow * MODW + col]);
            T[(2 * pg8::TBL_UNITS + i) * 256 + F.tid] = __builtin_amdgcn_rcpf(go[col] * (1.f + gso[(size_t)brow * MODW + col])); }
    }
    __syncthreads();
}

template <int LDC>
__device__ __forceinline__ void fill_scale_tables(Frame& F, const pg8::Order& S, const float* RSS, const float* shw) {
    LAS float* RS_T = (LAS float*)(F.lds + TBL_OFF); LAS float* SH_T = RS_T + pg8::TBL_UNITS * 256;
    const int row = F.tid >> 1, half = F.tid & 1;
#pragma unroll 1
    for (int i0 = 0; i0 < pg8::TBL_UNITS; i0 += 3) {
        f32x4 p[3][4], sv[3]; bool ok[3];
#pragma unroll
        for (int j = 0; j < 3; ++j) { pg8::Unit u; ok[j] = S.next(i0 + j, u);
            if (ok[j]) { const float* b = RSS + ((size_t)u.pm * 256 + row) * 32 + 16 * half;
#pragma unroll
                for (int q = 0; q < 4; ++q) p[j][q] = *(const f32x4*)(b + 4 * q);
                if (F.tid < 64) sv[j] = *(const f32x4*)(shw + (size_t)(u.pm < ML / 256 ? (u.pm >> 3) : NB) * LDC + u.pn * 256 + 4 * F.tid); } }
#pragma unroll
        for (int j = 0; j < 3; ++j) if (ok[j]) {
            float s = 0.f;
#pragma unroll
            for (int q = 0; q < 4; ++q) s += (p[j][q][0] + p[j][q][1]) + (p[j][q][2] + p[j][q][3]);
            s += __shfl_xor(s, 1);
            if (half == 0) RS_T[(i0 + j) * 256 + row] = rsqrtf(s * (1.0f / D) + EPS);
            if (F.tid < 64) *(LAS f32x4*)(SH_T + (i0 + j) * 256 + 4 * F.tid) = sv[j]; }
    }
    __syncthreads();
}

constexpr int N_PHASES = 2 + 7 * DEPTH + 1;
struct Args { const float* in[25]; float* out; unsigned char* ws; int ph_lo, ph_hi; };
static_assert(sizeof(Args) == 27 * 8 + 8, "Args has no padding");

__global__ void __launch_bounds__(NWAVES * 64, 2) mega_fwd(Args args) {
    extern __shared__ __attribute__((aligned(16))) unsigned char lds[];
    Frame F;
    F.lds = (LAS unsigned char*)lds;
    const int wave_s = __builtin_amdgcn_readfirstlane((int)threadIdx.x >> 6);
    F.wave = wave_s; F.lane = (int)__builtin_amdgcn_mbcnt_hi(~0u, __builtin_amdgcn_mbcnt_lo(~0u, 0u)); F.tid = wave_s * 64 + F.lane;
    F.G = gridDim.x; { const int bx = blockIdx.x; F.vcu = (F.G % 8 == 0) ? (bx % 8) * (F.G / 8) + bx / 8 : bx; }
    F.gw = F.vcu * NWAVES + F.wave; F.NGW = F.G * NWAVES;
    F.out = args.out; F.ws = args.ws;
    volatile LAS unsigned* MISC = (volatile LAS unsigned*)(F.lds + MISC_OFF);
    for (int u = F.tid; u < (LDS_BYTES - LDSCTL_OFF) / 4; u += NWAVES * 64) ((LAS unsigned*)(F.lds + LDSCTL_OFF))[u] = 0u;
    __syncthreads();
    if (F.tid == 0) {
#pragma unroll
        for (int i = 0; i < 25; ++i) *(LAS unsigned long long*)(F.lds + PTR_OFF + 8 * i) = (unsigned long long)args.in[i];
    }
    __syncthreads();
    XcdBarrier bar = xcd_barrier_post((unsigned*)(F.ws + WS_CTL) + CW_BAR, MISC + 8, F.tid);

    const int lo = args.ph_lo, hi = args.ph_hi;
#ifdef PROBE_MASK
    bool rep_done = false;
#define PROBE_V ((((PROBE_MASK >> ph) & 1) && !rep_done) ? PROBE_VARIANT : 0)
#else
#define PROBE_V 0
#endif
    for (int ph = lo; ph < hi; ++ph) {
        { unsigned ones_ = ~0u; asm volatile("" : "+s"(ones_));
          int t_ = wave_s * 64 + (int)__builtin_amdgcn_mbcnt_hi(ones_, __builtin_amdgcn_mbcnt_lo(ones_, 0u)); asm volatile("" : "+v"(t_)); F.tid = t_; F.lane = t_ & 63; F.wave = __builtin_amdgcn_readfirstlane(t_ >> 6); F.gw = F.vcu * NWAVES + F.wave; }
        if (ph == 0) {
#ifndef NO_P0
            phase_p0a(F);
#endif
        } else if (ph == 1) {
#ifndef NO_P0
            phase_p0b(F);
#endif
        }
        else if (ph == N_PHASES - 1) final_rows(F);
        else {
            const int l = (ph - 2) / 7, k = (ph - 2) % 7; const bool last = (l == DEPTH - 1);
            const int Mx = last ? ML : MT;
            float* MOD = WSP(float, WS_MOD);
            if (k == 0) {
                if (l > 0) { ctx_finalize(F, l); xcd_barrier(bar, F.tid); }
                pg8::Gemm g{WSP(const bf16, WS_XA), WSP(const bf16, WS_WIN) + (size_t)l * IND * D, MT, IND, D};
                pg8::Order S; if (last) S.init(ML, IND, WGM_IN, (MC / 256) * 5, 1, F.G, (int)blockIdx.x); else S.init(MT, IND, WGM_IN, 0, 0, F.G, (int)blockIdx.x);
                fill_scale_tables<IND>(F, S, WSP(const float, WS_RSSA), WSP(const float, WS_SHW1) + (size_t)l * 17 * IND);
                pg8::EpiScale<0, IND, true> E{WSP(bf16, WS_PROJ), (const LAS float*)(F.lds + TBL_OFF), PROBE_V};

#ifndef NO_G0
                pg8::gemm_phase<pg8::EpiScale<0, IND, true>, pg8::Order, true, true>(F.lds + RING_OFF, g, S, E, F.tid);
#endif

            } else if (k == 1) {

#ifndef NO_LRU
                lru_phase<0>(F, l, 1152);
#ifdef REP_LRU0
                __syncthreads(); lru_phase<0>(F, l, 1152);
#endif
#endif

                __syncthreads();
#ifndef NO_CONV
                conv_phase(F, l, last ? 1024 : 1152);
                __syncthreads();
#ifdef REP_CONV
                conv_phase(F, l, last ? 1024 : 1152);
                __syncthreads();
#endif
#endif
#ifndef NO_NA
#ifdef REP_NA
                na_phase(F, l, last ? NA_ITEMS_LAT : NA_ITEMS_LAT + NA_ITEMS_CTX, REP_NA);
#else
                na_phase(F, l, last ? NA_ITEMS_LAT : NA_ITEMS_LAT + NA_ITEMS_CTX);
#endif
#ifdef REP_NA
                __syncthreads(); na_phase(F, l, last ? NA_ITEMS_LAT : NA_ITEMS_LAT + NA_ITEMS_CTX, 0);
#endif
#endif
            } else if (k == 2) {
                lru_carry(F);
            } else if (k == 3) {

#ifndef NO_LRU
                lru_scan_phase(F, l, last ? 1024 : 1152);
#endif

            } else if (k == 4 || k == 6) {
                const bool dn = (k == 6);
                const int ln = (dn && !last) ? l + 1 : l;
                pg8::Gemm g{dn ? WSP(const bf16, WS_HID) : WSP(const bf16, WS_MIX), dn ? WSP(const bf16, WS_W2) + (size_t)l * D * FF : WSP(const bf16, WS_WOUT) + (size_t)l * D * D, Mx, D, dn ? FF : D};
                const bool splitk = dn && !last;
                pg8::Order S; S.init(splitk ? ML : Mx, D, dn ? WGM_DN : WGM_OUT, 0, 0, F.G, (int)blockIdx.x);
                const float* go_g = dn ? INP(5) + l * D : INP(4) + l * D;
                const float* go_s = MOD + (size_t)l * 17 * MODW + (dn ? 4 : 1) * D;
                const bool fin = dn && last;
                fill_res_tables(F, S, MOD + (size_t)l * 17 * MODW + (dn ? 5 : 2) * D, fin ? INP(24) : (dn ? INP(4) : INP(5)) + ln * D, fin ? WSP(const float, WS_ZERO) : MOD + (size_t)ln * 17 * MODW + (dn ? 1 : 4) * D, go_g, go_s);
                pg8::EpiRes<RES_NB> E{(const LAS float*)(F.lds + TBL_OFF), WSP(bf16, WS_XA), dn ? WSP(float, WS_RSSA) : WSP(float, WS_RSSB)};
#ifndef NO_GR
                pg8::gemm_phase<pg8::EpiRes<RES_NB>, pg8::Order, true, true>(F.lds + RING_OFF, g, S, E, F.tid);
                if (splitk) {
                    pg8::Order S2; S2.init(ML, 0, 4, (MC / 256) * 16, 2, F.G, (int)blockIdx.x);
                    pg8::EpiSlab E2{WSP(float, WS_PART), MOD + ((size_t)l * 17 + NB) * MODW + 5 * D};
                    pg8::gemm_phase<pg8::EpiSlab, pg8::Order, true, true, true>(F.lds + RING_OFF, g, S2, E2, F.tid);
                }
#endif
            } else if (k == 5) {
                pg8::Gemm g{WSP(const bf16, WS_XA), WSP(const bf16, WS_W1) + (size_t)l * FF * D, Mx, FF, D};
                pg8::Order S; S.init(Mx, FF, WGM_UP, 0, 0, F.G, (int)blockIdx.x);
                fill_scale_tables<FF>(F, S, WSP(const float, WS_RSSB), WSP(const float, WS_SHW2) + (size_t)l * 17 * FF);
                pg8::EpiScale<1, FF> E{WSP(bf16, WS_HID), (const LAS float*)(F.lds + TBL_OFF), PROBE_V};

#ifndef NO_G1
                pg8::gemm_phase<pg8::EpiScale<1, FF>, pg8::Order, true, true>(F.lds + RING_OFF, g, S, E, F.tid);
#endif

            }
        }
#ifdef PROBE_MASK
        if (((PROBE_MASK >> ph) & 1) && !rep_done) { rep_done = true; xcd_barrier(bar, F.tid); --ph; continue; }
        rep_done = false;
#endif
        if (ph + 1 < hi) xcd_barrier(bar, F.tid);
#ifdef PROBE_BAR2
        if (ph + 1 < hi) xcd_barrier(bar, F.tid);
#endif
    }
}

extern "C" void kernel_launch(void* const* d_in, const int* in_sizes, int n_in, void* d_out, int out_size, void* d_ws, size_t ws_size, hipStream_t stream) {
    static int grid = 0;
    if (grid == 0) {
        if (n_in != 25 || out_size != ML * D || ws_size < WS_END) { fprintf(stderr, "kernel_launch: unexpected shapes (n_in %d out %d ws %zu)\n", n_in, out_size, ws_size); grid = -1; return; }
        int dev = 0, cus = 0;
        if (hipGetDevice(&dev) != hipSuccess || hipDeviceGetAttribute(&cus, hipDeviceAttributeMultiprocessorCount, dev) != hipSuccess) { grid = -1; return; }
        if (hipFuncSetAttribute((const void*)mega_fwd, hipFuncAttributeMaxDynamicSharedMemorySize, LDS_BYTES) != hipSuccess) { fprintf(stderr, "kernel_launch: hipFuncSetAttribute failed\n"); grid = -1; return; }
        int per_cu = 0;
        if (hipOccupancyMaxActiveBlocksPerMultiprocessor(&per_cu, (const void*)mega_fwd, NWAVES * 64, LDS_BYTES) != hipSuccess || per_cu < 1) fprintf(stderr, "kernel_launch: occupancy query reports %d\n", per_cu);
        (void)hipGetLastError();
        grid = cus;
    }
    if (grid < 0) return;
    if (hipMemsetAsync((char*)d_ws + WS_CTL, 0, CTL_ZERO_BYTES, stream) != hipSuccess) return;
    Args a{};
    for (int i = 0; i < 25; ++i) a.in[i] = (const float*)d_in[i];
    a.out = (float*)d_out; a.ws = (unsigned char*)d_ws;
#if MK_N_LAUNCHES == 1
    a.ph_lo = 0; a.ph_hi = N_PHASES;
    hipLaunchKernelGGL(mega_fwd, dim3(grid), dim3(NWAVES * 64), LDS_BYTES, stream, a);
#else
    for (int ph = 0; ph < N_PHASES; ++ph) { a.ph_lo = ph; a.ph_hi = ph + 1; hipLaunchKernelGGL(mega_fwd, dim3(grid), dim3(NWAVES * 64), LDS_BYTES, stream, a); }
#endif
}
```

```cpp
#include <hip/hip_runtime.h>
#include <cstdio>
#include <cstdint>

constexpr int D = 1024, NB = 16, SEQ = 2048, CTXL = 256, DEPTH = 2;
constexpr int ML = NB * SEQ, MC = NB * CTXL, MT = ML + MC;
constexpr int IND = 2560, FF = 4096, NH = 8, HD = 64;
constexpr int MODW = 6 * D;
constexpr float EPS = 1e-6f;
#ifndef MK_N_LAUNCHES
#define MK_N_LAUNCHES 1
#endif

namespace pg8 {
#define PG8_LAS __attribute__((address_space(3)))
typedef unsigned short bf16_t;
typedef short bf16x8 __attribute__((ext_vector_type(8)));
typedef float f32x4 __attribute__((ext_vector_type(4)));
typedef unsigned u32x4 __attribute__((ext_vector_type(4)));
constexpr int BM = 256, BK = 64, HALF = 128, HTB = HALF * BK * 2, STAGE_BYTES = 8 * HTB, NXCD = 8;
constexpr int TBL_UNITS = 9;

__host__ __device__ __forceinline__ int lds_byte(int r, int c) { const int st = (r >> 4) * 2 + (c >> 5), rr = r & 15, cc = c & 31, ob = rr * 64 + cc * 2; return st * 1024 + (ob ^ (((ob >> 9) & 1) << 5)); }
__host__ __device__ __forceinline__ void stage_rc(int b, int& R, int& C) { const int st = b / 1024, sb = b % 1024, swz = sb ^ (((sb >> 9) & 1) << 5); R = (st >> 1) * 16 + swz / 64; C = (st & 1) * 32 + (swz % 64) / 2; }
__host__ __device__ __forceinline__ int perm32(int rho) { const int n = rho >> 4, i = rho & 15; return 8 * (i >> 2) + 4 * n + (i & 3); }

struct Unit { int pm, pn; };
struct Gemm { const bf16_t* A; const bf16_t* Bt; int M, N, K; };

__host__ __device__ __forceinline__ void map_tile(int wgid, int nM, int nN, int WGM, Unit& u) {
    const int nwg = nM * nN;
    { const int q = nwg / NXCD, r = nwg % NXCD, xcd = wgid % NXCD, off = wgid / NXCD; wgid = (xcd < r ? xcd * (q + 1) : r * (q + 1) + (xcd - r) * q) + off; }
    const int nig = WGM * nN, gid = wgid / nig, fm = gid * WGM, gsz = (nM - fm) < WGM ? (nM - fm) : WGM;
    u.pm = fm + ((wgid % nig) % gsz); u.pn = (wgid % nig) / gsz;
}
struct Order {
    int nM, nN, nwg, extra, mode, wgm, G, c;
    __host__ __device__ void init(int M, int N, int wgm_, int extra_, int mode_, int G_, int c_) { nM = M / BM; nN = N / BM; nwg = nM * nN; extra = extra_; mode = mode_; wgm = wgm_; G = G_; c = c_; }
    __host__ __device__ bool next(int i, Unit& u) const {
        const long L = (long)i * G + c;
        if (L < nwg) { map_tile((int)L, nM, nN, wgm, u); return true; }
        if (L < nwg + extra) { const int q = (int)L - nwg;
            if (mode == 1) { u.pm = nM + q / 5; u.pn = 4 + q % 5; }
            else { u.pm = nM + (q >> 4); u.pn = 4 + 4 * (q & 3) + ((q >> 2) & 3); }
            return true; }
        return false;
    }
    __device__ __forceinline__ void a_ready(const Unit&) const {}
    __device__ __forceinline__ void done(const Unit&) const {}
};

__device__ __forceinline__ unsigned cvt_pk_bf16(float lo, float hi) { unsigned r; asm volatile("v_cvt_pk_bf16_f32 %0, %1, %2" : "=v"(r) : "v"(lo), "v"(hi)); return r; }

template <int ACT, int LDC, bool GLU = false> struct EpiScale {
    static constexpr bool PERM = true, AFTER_DRAIN = false;
    bf16_t* O;
    const PG8_LAS float* tbl;
    int probe;
    __device__ __forceinline__ void operator()(const f32x4 (&acc)[2][2][4][2], const Unit& u, int wr, int wc, int fr, int fq, int ui) const {
        asm volatile("" : "+s"(wr), "+s"(wc));
        bf16_t* Ot = O + (size_t)u.pm * BM * LDC + u.pn * BM;
        unsigned cl = (unsigned)(wc * 32 + 8 * fq);
        unsigned rl0 = (unsigned)(wr * 64 + fr);
        asm volatile("" : "+v"(cl), "+v"(rl0));
        const PG8_LAS float* rst = tbl + ui * 256, * sht = tbl + TBL_UNITS * 256 + ui * 256;
        f32x4 sh[2][2]; float rs[2][4];
#pragma unroll
        for (int ai = 0; ai < 2; ++ai)
#pragma unroll
            for (int m = 0; m < 4; ++m) rs[ai][m] = rst[rl0 + (unsigned)(ai * HALF + m * 16)];
#pragma unroll
        for (int bj = 0; bj < 2; ++bj) { sh[bj][0] = *(const PG8_LAS f32x4*)(sht + (cl + (unsigned)(bj * HALF))); sh[bj][1] = *(const PG8_LAS f32x4*)(sht + (cl + (unsigned)(bj * HALF + 4))); }
        if (GLU && u.pn < 2) {
#pragma unroll
            for (int ai = 0; ai < 2; ++ai)
#pragma unroll
                for (int m = 0; m < 4; ++m) {
                    const f32x4 a0 = acc[ai][0][m][0] * rs[ai][m] + sh[0][0], a1 = acc[ai][0][m][1] * rs[ai][m] + sh[0][1];
                    const f32x4 g0 = acc[ai][1][m][0] * rs[ai][m] + sh[1][0], g1 = acc[ai][1][m][1] * rs[ai][m] + sh[1][1];
                    f32x4 v0, v1;
#pragma unroll
                    for (int e = 0; e < 4; ++e) { v0[e] = a0[e] * __builtin_amdgcn_rcpf(1.f + __builtin_amdgcn_exp2f(-1.4426950408889634f * g0[e])); v1[e] = a1[e] * __builtin_amdgcn_rcpf(1.f + __builtin_amdgcn_exp2f(-1.4426950408889634f * g1[e])); }
                    u32x4 w; w.x = cvt_pk_bf16(v0[0], v0[1]); w.y = cvt_pk_bf16(v0[2], v0[3]); w.z = cvt_pk_bf16(v1[0], v1[1]); w.w = cvt_pk_bf16(v1[2], v1[3]);
                    *(u32x4*)(O + (size_t)u.pm * BM * LDC + u.pn * HALF + ((rl0 + (unsigned)(ai * HALF + m * 16)) * (unsigned)LDC + cl)) = w;
                }
            return;
        }
#pragma unroll
        for (int bj = 0; bj < 2; ++bj)
#pragma unroll
            for (int ai = 0; ai < 2; ++ai)
#pragma unroll
                for (int m = 0; m < 4; ++m) {
                    f32x4 v0 = acc[ai][bj][m][0] * rs[ai][m] + sh[bj][0], v1 = acc[ai][bj][m][1] * rs[ai][m] + sh[bj][1];
                    if (ACT == 1) {
#pragma unroll
                        for (int e = 0; e < 4; ++e) { const float a = fmaxf(v0[e], 0.f), b = fmaxf(v1[e], 0.f); v0[e] = a * a; v1[e] = b * b; }
                    }
                    u32x4 w; w.x = cvt_pk_bf16(v0[0], v0[1]); w.y = cvt_pk_bf16(v0[2], v0[3]); w.z = cvt_pk_bf16(v1[0], v1[1]); w.w = cvt_pk_bf16(v1[2], v1[3]);
                    if (probe == 0) *(u32x4*)(Ot + ((rl0 + (unsigned)(ai * HALF + m * 16)) * (unsigned)LDC + cl + (unsigned)(bj * HALF))) = w;
                    else asm volatile("" :: "v"(w));
                }
    }
};
template <int NB_> struct EpiRes {
    static constexpr bool PERM = true, AFTER_DRAIN = false;
    const PG8_LAS float* tbl;
    bf16_t* XA; float* RSS;
    __device__ __forceinline__ void operator()(const f32x4 (&acc)[2][2][4][2], const Unit& u, int wr, int wc, int fr, int fq, int ui) const {
        asm volatile("" : "+s"(wr), "+s"(wc));
        bf16_t* XAt = XA + (size_t)u.pm * BM * D + u.pn * BM;
        float* RSSt = RSS + (size_t)u.pm * BM * 32 + u.pn * 8 + wc;
        unsigned cl = (unsigned)(wc * 32 + 8 * fq);
        unsigned rl0 = (unsigned)(wr * 64 + fr);
        asm volatile("" : "+v"(cl), "+v"(rl0));
        const PG8_LAS float* gT = tbl + ui * 256, * mT = tbl + (TBL_UNITS + ui) * 256, * iT = tbl + (2 * TBL_UNITS + ui) * 256;
        constexpr int BJB = 2 / NB_;
#pragma unroll
        for (int b0 = 0; b0 < 2; b0 += BJB) {
            u32x4 xb[BJB][2][4];
#pragma unroll
            for (int bb = 0; bb < BJB; ++bb)
#pragma unroll
                for (int ai = 0; ai < 2; ++ai)
#pragma unroll
                    for (int m = 0; m < 4; ++m) xb[bb][ai][m] = *(const u32x4*)(XAt + ((rl0 + (unsigned)(ai * HALF + m * 16)) * (unsigned)D + cl + (unsigned)((b0 + bb) * HALF)));
            asm volatile("" ::: "memory");
#pragma unroll
            for (int bb = 0; bb < BJB; ++bb) {
                const int bj = b0 + bb;
                const unsigned c = cl + (unsigned)(bj * HALF);
                const f32x4 g0 = *(const PG8_LAS f32x4*)(gT + c), g1 = *(const PG8_LAS f32x4*)(gT + (c + 4u)), m0 = *(const PG8_LAS f32x4*)(mT + c), m1 = *(const PG8_LAS f32x4*)(mT + (c + 4u)),
                            r0 = *(const PG8_LAS f32x4*)(iT + c), r1 = *(const PG8_LAS f32x4*)(iT + (c + 4u));
#pragma unroll
                for (int ai = 0; ai < 2; ++ai)
#pragma unroll
                    for (int m = 0; m < 4; ++m) {
                        const unsigned rl = rl0 + (unsigned)(ai * HALF + m * 16);
                        const u32x4 w = xb[bb][ai][m];
                        const f32x4 x0 = (f32x4){__uint_as_float(w.x << 16), __uint_as_float(w.x & 0xffff0000u), __uint_as_float(w.y << 16), __uint_as_float(w.y & 0xffff0000u)} * r0;
                        const f32x4 x1 = (f32x4){__uint_as_float(w.z << 16), __uint_as_float(w.z & 0xffff0000u), __uint_as_float(w.w << 16), __uint_as_float(w.w & 0xffff0000u)} * r1;
                        const f32x4 y0 = x0 + g0 * acc[ai][bj][m][0], y1 = x1 + g1 * acc[ai][bj][m][1];
                        float ss = ((y0[0] * y0[0] + y0[1] * y0[1]) + (y0[2] * y0[2] + y0[3] * y0[3])) + ((y1[0] * y1[0] + y1[1] * y1[1]) + (y1[2] * y1[2] + y1[3] * y1[3]));
                        ss += __shfl_xor(ss, 16); ss += __shfl_xor(ss, 32);
                        if (fq == 0) RSSt[rl * 32u + (unsigned)(bj * 4)] = ss;
                        const f32x4 a0 = y0 * m0, a1 = y1 * m1;
                        u32x4 o; o.x = cvt_pk_bf16(a0[0], a0[1]); o.y = cvt_pk_bf16(a0[2], a0[3]); o.z = cvt_pk_bf16(a1[0], a1[1]); o.w = cvt_pk_bf16(a1[2], a1[3]);
                        *(u32x4*)(XAt + (rl * (unsigned)D + c)) = o;
                    }
            }
            asm volatile("" ::: "memory");
        }
    }
};

struct EpiSlab {
    static constexpr bool PERM = true, AFTER_DRAIN = false;
    float* P; const float* gate;
    __device__ __forceinline__ void operator()(const f32x4 (&acc)[2][2][4][2], const Unit& u, int wr, int wc, int fr, int fq, int) const {
        asm volatile("" : "+s"(wr), "+s"(wc));
        const int ks = (u.pn - 4) >> 2, pn = u.pn & 3;
        float* At = P + ((size_t)ks * MC + (size_t)(u.pm - ML / BM) * BM) * D + pn * BM;
        const float* gtq = gate + pn * BM;
        unsigned cl = (unsigned)(wc * 32 + 8 * fq), rl0 = (unsigned)(wr * 64 + fr);
        asm volatile("" : "+v"(cl), "+v"(rl0));
        f32x4 gv[2][2];
#pragma unroll
        for (int bj = 0; bj < 2; ++bj) { gv[bj][0] = *(const f32x4*)(gtq + (cl + (unsigned)(bj * HALF))); gv[bj][1] = *(const f32x4*)(gtq + (cl + (unsigned)(bj * HALF + 4))); }
#pragma unroll
        for (int bj = 0; bj < 2; ++bj) { const unsigned c = cl + (unsigned)(bj * HALF);
#pragma unroll
            for (int ai = 0; ai < 2; ++ai)
#pragma unroll
                for (int m = 0; m < 4; ++m) { const unsigned off = (rl0 + (unsigned)(ai * HALF + m * 16)) * (unsigned)D + c;
                    *(f32x4*)(At + off) = gv[bj][0] * acc[ai][bj][m][0]; *(f32x4*)(At + (off + 4u)) = gv[bj][1] * acc[ai][bj][m][1]; } }
    }
};

template <class Epi, class Sched, bool ALIGN_EPI = false, bool SP2 = false, bool VARK = false>
__device__ __forceinline__ void gemm_phase(PG8_LAS unsigned char* lds, const Gemm g, const Sched& S, const Epi& E, const int tid) {
    const int wid = __builtin_amdgcn_readfirstlane(tid >> 6), lane = tid & 63, wr = wid >> 2, wc = wid & 3, fr = lane & 15, fq = lane >> 4;
    const int K = g.K;
    unsigned voffA[2], voffB[2];
#pragma unroll
    for (int i = 0; i < 2; ++i) { int R, C; stage_rc(tid * 16 + i * 8192, R, C); const int Rb = Epi::PERM ? ((R & ~31) + perm32(R & 31)) : R;
        voffA[i] = (unsigned)(R * K + C) * 2u; voffB[i] = (unsigned)(Rb * K + C) * 2u; }
    const size_t kstep = (size_t)(BK * 2);
    const size_t hstep = (size_t)HALF * K * 2;
    const size_t tstep = 2 * hstep;
    const unsigned ldsw = (unsigned)wid * 1024u;
    const int aoff = lds_byte(wr * 64 + fr, fq * 8), boff = lds_byte(wc * 32 + fr, fq * 8);
#define PG8_SA(b, h) (((b) * 2 + (h)) * HTB)
#define PG8_SB(b, h) ((4 + (b) * 2 + (h)) * HTB)
#define PG8_STAGE(bufoff, gbase, voff) do { _Pragma("unroll") for (int _i = 0; _i < 2; ++_i) \
        __builtin_amdgcn_global_load_lds((const unsigned*)((const char*)(gbase) + (voff)[_i]), (PG8_LAS unsigned*)(lds + (bufoff) + ldsw + _i * 8192), 16, 0, 0); } while (0)
#define PG8_LDA(dst, b, h) do { _Pragma("unroll") for (int m = 0; m < 4; ++m) _Pragma("unroll") for (int k = 0; k < 2; ++k) dst[m][k] = *(const PG8_LAS bf16x8*)(lds + PG8_SA(b, h) + aoff + m * 2048 + k * 1024); } while (0)
#define PG8_LDB(dst, b, h) do { _Pragma("unroll") for (int n = 0; n < 2; ++n) _Pragma("unroll") for (int k = 0; k < 2; ++k) dst[n][k] = *(const PG8_LAS bf16x8*)(lds + PG8_SB(b, h) + boff + n * 2048 + k * 1024); } while (0)
#define PG8_MMA(ai, bj, At, Bt) do { __builtin_amdgcn_s_setprio(1); _Pragma("unroll") for (int m = 0; m < 4; ++m) _Pragma("unroll") for (int n = 0; n < 2; ++n) _Pragma("unroll") for (int k = 0; k < 2; ++k) \
        acc[ai][bj][m][n] = __builtin_amdgcn_mfma_f32_16x16x32_bf16(Bt[n][k], At[m][k], acc[ai][bj][m][n], 0, 0, 0); __builtin_amdgcn_s_setprio(0); } while (0)
#define PG8_WAIT_V(n) asm volatile("s_waitcnt vmcnt(" #n ")" ::: "memory")
#define PG8_WAIT_L(n) asm volatile("s_waitcnt lgkmcnt(" #n ")" ::: "memory")
#define PG8_BAR __builtin_amdgcn_s_barrier()
#define PG8_SCHED __builtin_amdgcn_sched_barrier(0)
    Unit cur, nxt; int ui = 0;
    if (!S.next(0, cur)) return;
    cur.pm = __builtin_amdgcn_readfirstlane(cur.pm); cur.pn = __builtin_amdgcn_readfirstlane(cur.pn);
    f32x4 acc[2][2][4][2];
#pragma unroll
    for (int a = 0; a < 2; ++a)
#pragma unroll
        for (int b = 0; b < 2; ++b)
#pragma unroll
            for (int m = 0; m < 4; ++m)
#pragma unroll
                for (int n = 0; n < 2; ++n) acc[a][b][m][n] = (f32x4){0.f, 0.f, 0.f, 0.f};
    bf16x8 At[4][2], B0[2][2], B1[2][2];
#define PG8_KOFF(u) ((VARK && (u).pn >= 4) ? (size_t)(((u).pn - 4) >> 2) * (size_t)(K / 4) * 2 : (size_t)0)
#define PG8_PN(u) ((VARK && (u).pn >= 4) ? ((u).pn & 3) : (u).pn)
    const char* cA = (const char*)g.A + (size_t)cur.pm * tstep + PG8_KOFF(cur); const char* cB = (const char*)g.Bt + (size_t)PG8_PN(cur) * tstep + PG8_KOFF(cur);
    S.a_ready(cur);
    if constexpr (SP2) {
        PG8_STAGE(PG8_SB(0, 0), cB, voffB); PG8_STAGE(PG8_SB(0, 1), cB + hstep, voffB); PG8_STAGE(PG8_SA(0, 0), cA, voffA); PG8_STAGE(PG8_SA(0, 1), cA + hstep, voffA);
        if (wr == 1) PG8_BAR;
        PG8_WAIT_V(2); PG8_BAR;
        PG8_STAGE(PG8_SB(1, 0), cB + kstep, voffB); PG8_STAGE(PG8_SA(1, 0), cA + kstep, voffA); PG8_STAGE(PG8_SB(1, 1), cB + hstep + kstep, voffB);
        PG8_WAIT_V(6); PG8_BAR;
    } else {
        PG8_STAGE(PG8_SB(0, 0), cB, voffB); PG8_STAGE(PG8_SA(0, 0), cA, voffA); PG8_STAGE(PG8_SB(0, 1), cB + hstep, voffB); PG8_STAGE(PG8_SA(0, 1), cA + hstep, voffA);
        if (wr == 1) PG8_BAR;
        PG8_WAIT_V(4); PG8_BAR;
        PG8_STAGE(PG8_SB(1, 0), cB + kstep, voffB); PG8_STAGE(PG8_SA(1, 0), cA + kstep, voffA); PG8_STAGE(PG8_SB(1, 1), cB + hstep + kstep, voffB);
        PG8_WAIT_V(6); PG8_BAR;
    }
    for (;;) {
        const bool has_next = S.next(ui + 1, nxt);
        nxt.pm = __builtin_amdgcn_readfirstlane(nxt.pm); nxt.pn = __builtin_amdgcn_readfirstlane(nxt.pn);
        const char* nA = has_next ? (const char*)g.A + (size_t)nxt.pm * tstep + PG8_KOFF(nxt) : cA; const char* nB = has_next ? (const char*)g.Bt + (size_t)PG8_PN(nxt) * tstep + PG8_KOFF(nxt) : cB;
        const int nt = (VARK && cur.pn >= 4) ? K / BK / 4 : K / BK;
        for (int t = 0; t < nt; t += 2) {
            const bool last = (t == nt - 2);
            const char* a1 = cA + (size_t)(t + 1) * kstep;
            const char* a2 = last ? nA : cA + (size_t)(t + 2) * kstep; const char* b2 = last ? nB : cB + (size_t)(t + 2) * kstep;
            const char* a3 = a2 + kstep; const char* b3 = b2 + kstep;
            if (last && has_next) S.a_ready(nxt);
            if constexpr (SP2) {
            PG8_LDB(B0, 0, 0); PG8_LDB(B1, 0, 1); PG8_SCHED; PG8_LDA(At, 0, 0); PG8_STAGE(PG8_SA(1, 1), a1 + hstep, voffA);
            PG8_WAIT_V(8); PG8_WAIT_L(0); PG8_BAR; PG8_MMA(0, 0, At, B0); PG8_MMA(0, 1, At, B1); PG8_BAR; PG8_SCHED;
            PG8_LDA(At, 0, 1); PG8_STAGE(PG8_SB(0, 0), b2, voffB); PG8_STAGE(PG8_SB(0, 1), b2 + hstep, voffB); PG8_STAGE(PG8_SA(0, 0), a2, voffA);
            PG8_WAIT_V(8); PG8_WAIT_L(0); PG8_BAR; PG8_MMA(1, 0, At, B0); PG8_MMA(1, 1, At, B1); PG8_BAR; PG8_SCHED;
            PG8_LDB(B0, 1, 0); PG8_LDB(B1, 1, 1); PG8_SCHED; PG8_LDA(At, 1, 0); PG8_STAGE(PG8_SA(0, 1), a2 + hstep, voffA);
            PG8_WAIT_V(8); PG8_WAIT_L(0); PG8_BAR; PG8_MMA(0, 0, At, B0); PG8_MMA(0, 1, At, B1); PG8_BAR; PG8_SCHED;
            PG8_LDA(At, 1, 1); PG8_STAGE(PG8_SB(1, 0), b3, voffB); PG8_STAGE(PG8_SB(1, 1), b3 + hstep, voffB); PG8_STAGE(PG8_SA(1, 0), a3, voffA);
            PG8_WAIT_V(8); PG8_WAIT_L(0); PG8_BAR; PG8_MMA(1, 0, At, B0); PG8_MMA(1, 1, At, B1); PG8_BAR; PG8_SCHED;
            } else {
            PG8_LDB(B0, 0, 0); PG8_SCHED; PG8_LDA(At, 0, 0); PG8_STAGE(PG8_SA(1, 1), a1 + hstep, voffA);
            PG8_WAIT_L(8); PG8_BAR; PG8_WAIT_L(0); PG8_MMA(0, 0, At, B0); PG8_BAR; PG8_SCHED;
            PG8_LDB(B1, 0, 1); PG8_STAGE(PG8_SB(0, 0), b2, voffB);
            PG8_BAR; PG8_WAIT_L(0); PG8_MMA(0, 1, At, B1); PG8_BAR;
            PG8_LDA(At, 0, 1); PG8_STAGE(PG8_SA(0, 0), a2, voffA);
            PG8_BAR; PG8_WAIT_L(0); PG8_MMA(1, 0, At, B0); PG8_BAR; PG8_SCHED;
            PG8_STAGE(PG8_SB(0, 1), b2 + hstep, voffB);
            PG8_WAIT_V(6); PG8_BAR; PG8_MMA(1, 1, At, B1); PG8_BAR;
            PG8_LDB(B0, 1, 0); PG8_SCHED; PG8_LDA(At, 1, 0); PG8_STAGE(PG8_SA(0, 1), a2 + hstep, voffA);
            PG8_WAIT_L(8); PG8_BAR; PG8_WAIT_L(0); PG8_MMA(0, 0, At, B0); PG8_BAR; PG8_SCHED;
            PG8_LDB(B1, 1, 1); PG8_STAGE(PG8_SB(1, 0), b3, voffB);
            PG8_BAR; PG8_WAIT_L(0); PG8_MMA(0, 1, At, B1); PG8_BAR;
            PG8_LDA(At, 1, 1); PG8_STAGE(PG8_SA(1, 0), a3, voffA);
            PG8_BAR; PG8_WAIT_L(0); PG8_MMA(1, 0, At, B0); PG8_BAR; PG8_SCHED;
            PG8_STAGE(PG8_SB(1, 1), b3 + hstep, voffB);
            PG8_WAIT_V(6); PG8_BAR; PG8_MMA(1, 1, At, B1); PG8_BAR;
            }
        }
        if constexpr (ALIGN_EPI) { if (wr == 0) PG8_BAR; }
        if constexpr (!Epi::AFTER_DRAIN) { E(acc, cur, wr, wc, fr, fq, ui); S.done(cur); }
        if (!has_next) break;
#pragma unroll
        for (int a = 0; a < 2; ++a)
#pragma unroll
            for (int b = 0; b < 2; ++b)
#pragma unroll
                for (int m = 0; m < 4; ++m)
#pragma unroll
                    for (int n = 0; n < 2; ++n) acc[a][b][m][n] = (f32x4){0.f, 0.f, 0.f, 0.f};
        cur = nxt; cA = nA; cB = nB; ++ui;
        if constexpr (ALIGN_EPI) { if (wr == 1) PG8_BAR; }
    }
    PG8_WAIT_V(0);
    if constexpr (!ALIGN_EPI) { if (wr == 0) PG8_BAR; }
    PG8_BAR;
    if constexpr (Epi::AFTER_DRAIN) { E.fused(acc, cur, wr, wc, fr, fq, lds, wid, lane); S.done(cur); }
#undef PG8_KOFF
#undef PG8_PN
#undef PG8_SA
#undef PG8_SB
#undef PG8_STAGE
#undef PG8_LDA
#undef PG8_LDB
#undef PG8_MMA
#undef PG8_WAIT_V
#undef PG8_WAIT_L
#undef PG8_BAR
#undef PG8_SCHED
}
}

constexpr size_t MiB = 1u << 20;
constexpr size_t WS_CTL = 0, CTL_ZERO_BYTES = 1 * MiB;
constexpr size_t WS_MOD = 1 * MiB;
constexpr size_t WS_SHW1 = 2 * MiB;
constexpr size_t WS_SHW2 = 3 * MiB;
constexpr size_t WS_RSSA = 4 * MiB;
constexpr size_t WS_RSSB = 9 * MiB;
constexpr size_t WS_TOT = 14 * MiB;
constexpr size_t WS_CARRY = 19 * MiB;
constexpr size_t WS_WLR = 21 * MiB + 512 * 1024;
constexpr size_t WS_WIN = 22 * MiB;
constexpr size_t WS_WOUT = 32 * MiB;
constexpr size_t WS_W1 = 36 * MiB;
constexpr size_t WS_W2 = 52 * MiB;
constexpr size_t WS_CX = 68 * MiB;
constexpr size_t WS_XA = 84 * MiB;
constexpr size_t WS_HID = 156 * MiB;
constexpr size_t WS_PROJ = WS_HID;
constexpr size_t WS_MIX = WS_HID + 180 * MiB;
constexpr size_t WS_PART = 444 * MiB;
constexpr size_t WS_AB = 436 * MiB;
constexpr size_t WS_END = 508 * MiB;
static_assert(WS_MIX + (size_t)MT * D * 2 <= WS_PART && WS_HID + (size_t)MT * FF * 2 == WS_PART && WS_PART + (size_t)4 * MC * D * 4 == WS_END && WS_AB >= WS_MIX + (size_t)MT * D * 2 && WS_AB + (size_t)1152 * 2 * 2 * 8 * 2 * 64 * 16 == WS_END, "ws map");
constexpr size_t WS_ZERO = WS_CTL + 512 * 1024;
constexpr int CW_BAR = 4096;

#ifndef WGM_IN
#define WGM_IN 4
#endif
#ifndef WGM_OUT
#define WGM_OUT 4
#endif
#ifndef WGM_UP
#define WGM_UP 4
#endif
#ifndef WGM_DN
#define WGM_DN 4
#endif
#ifndef RES_NB
#define RES_NB 2
#endif
constexpr int NWAVES = 8;
constexpr int RING_OFF = 0, RING_BYTES = 131072;
constexpr int LDSCTL_OFF = RING_BYTES, MISC_OFF = LDSCTL_OFF + 320;
constexpr int TBL_OFF = LDSCTL_OFF + 1024;
static_assert(TBL_OFF + 3 * pg8::TBL_UNITS * 256 * 4 <= 163840, "LDS map");
constexpr int LDS_BYTES = 163840;

#define GAS __attribute__((address_space(1)))
#define LAS __attribute__((address_space(3)))
typedef unsigned short bf16;
typedef unsigned v4u __attribute__((ext_vector_type(4)));
typedef unsigned v2u __attribute__((ext_vector_type(2)));
typedef float f32x4 __attribute__((ext_vector_type(4)));
typedef float f32x2 __attribute__((ext_vector_type(2)));
typedef GAS unsigned gu32;
#define LDS_WAIT() asm volatile("s_waitcnt lgkmcnt(0)" ::: "memory")
#define VM_WAIT() asm volatile("s_waitcnt vmcnt(0)" ::: "memory")
__device__ __forceinline__ unsigned f2bf(float f) { unsigned u = __builtin_bit_cast(unsigned, f); return (u + 0x7fffu + ((u >> 16) & 1u)) >> 16; }
__device__ __forceinline__ unsigned pk2(float lo, float hi) { return f2bf(lo) | (f2bf(hi) << 16); }
__device__ __forceinline__ float bflo(unsigned w) { return __uint_as_float(w << 16); }
__device__ __forceinline__ float bfhi(unsigned w) { return __uint_as_float(w & 0xffff0000u); }
__device__ __forceinline__ float bf1(bf16 v) { return __uint_as_float((unsigned)v << 16); }
__device__ __forceinline__ float sigmoidf_(float x) { return __builtin_amdgcn_rcpf(1.f + __builtin_amdgcn_exp2f(-1.4426950408889634f * x)); }
__device__ __forceinline__ float siluf_(float x) { return x * sigmoidf_(x); }
__device__ __forceinline__ float gelu_tanh(float x) { const float u = 0.7978845608028654f * (x + 0.044715f * x * x * x); return x * sigmoidf_(2.f * u); }
__device__ __forceinline__ float wave_sum(float v) {
#pragma unroll
    for (int o = 1; o < 64; o <<= 1) v += __shfl_xor(v, o);
    return v;
}

#define XB_TMO      128
#define XB_XCNT(j)  (256  + 64 * (j))
#define XB_XSUB(j)  (1280 + 64 * (j))
#define XB_XGEN(j)  (2304 + 64 * (j))
#define XB_TOP      3328
#define XB_TOPGEN   3392
#define XCD_BAR_WORDS 3456
#define XB_SPIN_CAP (1u << 18)

__device__ __forceinline__ unsigned xb_ld(unsigned* p)              { return __hip_atomic_load(p, __ATOMIC_RELAXED, __HIP_MEMORY_SCOPE_AGENT); }
__device__ __forceinline__ unsigned xb_add(unsigned* p, unsigned v) { return __hip_atomic_fetch_add(p, v, __ATOMIC_RELAXED, __HIP_MEMORY_SCOPE_AGENT); }
__device__ __forceinline__ unsigned xb_xcc_id() { return (unsigned)__builtin_amdgcn_s_getreg((3 << 11) | 20) & 0xFu; }
#define XB_SPIN(cond, bar) do { unsigned _sp = 0; while (cond) { __builtin_amdgcn_s_sleep(1); \
    if ((++_sp & 255u) == 0u) { if (xb_ld(&(bar)[XB_TMO])) break; if (_sp > XB_SPIN_CAP) { atomicAdd(&(bar)[XB_TMO], 1u); break; } } } } while (0)

struct XcdBarrier {
    unsigned* bar; unsigned x;
    volatile LAS unsigned* st;
};

__device__ __forceinline__ XcdBarrier xcd_barrier_post(unsigned* bar, volatile LAS unsigned* st, int tid) {
    XcdBarrier b; b.bar = bar; b.x = xb_xcc_id(); b.st = st;
    if (tid == 0) (void)xb_add(&bar[XB_XCNT(b.x)], 1u);
    return b;
}
__device__ __forceinline__ void xcd_barrier_complete(unsigned* bar, unsigned x, unsigned& nloc, unsigned& nx) {
    const unsigned G = gridDim.x * gridDim.y * gridDim.z;
    unsigned sum, cnt, mine, sp = 0u;
    for (;;) {
        sum = 0u; cnt = 0u; mine = 0u;
#pragma unroll 1
        for (unsigned j = 0; j < 16; ++j) { const unsigned c = xb_ld(&bar[XB_XCNT(j)]); sum += c; cnt += (c > 0u) ? 1u : 0u; mine = (j == x) ? c : mine; }
        if (sum == G) break;
        __builtin_amdgcn_s_sleep(1);
        if ((++sp & 255u) == 0u) { if (xb_ld(&bar[XB_TMO])) break; if (sp > XB_SPIN_CAP) { atomicAdd(&bar[XB_TMO], 1u); break; } }
    }
    nloc = mine > 0u ? mine : 1u; nx = cnt > 0u ? cnt : 1u;
}

__device__ __forceinline__ void xcd_barrier(const XcdBarrier& b, int tid) {
    asm volatile("s_waitcnt vmcnt(0)" ::: "memory");
    __syncthreads();
    if (tid == 0) {
        unsigned* bar = b.bar;
        __builtin_amdgcn_s_waitcnt(0);
        unsigned nloc = b.st[0], nx = b.st[1];
        if (nloc == 0u) { xcd_barrier_complete(bar, b.x, nloc, nx); b.st[0] = nloc; b.st[1] = nx; }
        const unsigned old = xb_add(&bar[XB_XSUB(b.x)], 1u);
        const unsigned gen = old / nloc;
        if (old + 1u == (gen + 1u) * nloc) {
            __builtin_amdgcn_fence(__ATOMIC_RELEASE, "agent");
            asm volatile("s_waitcnt vmcnt(0)" ::: "memory");
            const unsigned og = xb_add(&bar[XB_TOP], 1u);
            const unsigned tg = og / nx;
            if (og + 1u == (tg + 1u) * nx) xb_add(&bar[XB_TOPGEN], 1u);
            else XB_SPIN(xb_ld(&bar[XB_TOPGEN]) == tg, bar);
            __builtin_amdgcn_fence(__ATOMIC_ACQUIRE, "agent");
            xb_add(&bar[XB_XGEN(b.x)], 1u);
            asm volatile("s_waitcnt vmcnt(0)" ::: "memory");
        } else {
            XB_SPIN(xb_ld(&bar[XB_XGEN(b.x)]) == gen, bar);
            __builtin_amdgcn_fence(__ATOMIC_ACQUIRE, "agent");
            asm volatile("s_waitcnt vmcnt(0)" ::: "memory");
        }
    }
    __syncthreads();
}

struct Frame {
    LAS unsigned char* lds;
    int tid, lane, wave;
    int vcu, G;
    int gw, NGW;
    float* out; unsigned char* ws;
};
constexpr int PTR_OFF = LDSCTL_OFF + 512;
__device__ __forceinline__ const float* inp_(LAS unsigned char* lds, int i) {
    const unsigned long long v = *(const LAS unsigned long long*)(lds + PTR_OFF + 8 * i);
    const unsigned lo = __builtin_amdgcn_readfirstlane((unsigned)v), hi = __builtin_amdgcn_readfirstlane((unsigned)(v >> 32));
    return (const float*)(((unsigned long long)hi << 32) | lo);
}
#define INP(i) inp_(F.lds, (i))
#define WSP(T, off) ((T*)(F.ws + (off)))

__device__ __forceinline__ void gemv17_item(Frame& F, const LAS float* tab, LAS float* red, const float* W, int ldw, int n0, const float* bias, float* outp, int ldo, int n0out) {
    float acc[17];
#pragma unroll
    for (int r = 0; r < 17; ++r) acc[r] = 0.f;
    const int k0 = F.wave * 128;
    const float* wp = W + (size_t)k0 * ldw + n0 + F.lane;
#pragma unroll 1
    for (int kk = 0; kk < 128; kk += 32) {
        float wv[32];
#pragma unroll
        for (int k = 0; k < 32; ++k) wv[k] = wp[(size_t)(kk + k) * ldw];
#pragma unroll
        for (int k = 0; k < 32; ++k) {
#pragma unroll
            for (int r = 0; r < 17; ++r) acc[r] += tab[r * 1024 + k0 + kk + k] * wv[k];
        }
    }
#pragma unroll
    for (int r = 0; r < 17; ++r) red[(F.wave * 17 + r) * 64 + F.lane] = acc[r];
    __syncthreads();
    for (int i = F.tid; i < 17 * 64; i += NWAVES * 64) {
        const int r = i >> 6, n = i & 63; float s = bias ? bias[n0 + n] : 0.f;
#pragma unroll
        for (int w = 0; w < 8; ++w) s += red[(w * 17 + r) * 64 + n];
        outp[(size_t)r * ldo + n0out + n] = s;
    }
    __syncthreads();
}

__host__ __device__ __forceinline__ int glu_col(int o) { return o >= 512 ? o : ((o >> 7) & 1) * 256 + (o >> 8) * 128 + (o & 127); }
__device__ __forceinline__ void p0_transpose_item(const float* W, int K, int N, bf16* WT, LAS float* scr, int item, int lane, bool glu) {
    const int nblk = N / 32, kb = item / nblk, nb = item % nblk, k0 = 64 * kb, n0 = 32 * nb;
    const int n0o = glu ? glu_col(n0) : n0;
    float tv[32];
#pragma unroll
    for (int i = 0; i < 32; ++i) { const int kk = 2 * i + (lane >> 5); tv[i] = W[(size_t)(k0 + kk) * N + n0 + (lane & 31)]; }
#pragma unroll
    for (int i = 0; i < 32; ++i) { const int kk = 2 * i + (lane >> 5); scr[kk * 33 + (lane & 31)] = tv[i]; }
    LDS_WAIT(); asm volatile("" ::: "memory");
    const int c = lane & 7;
#pragma unroll
    for (int j = 0; j < 4; ++j) { const int n = (lane >> 3) + 8 * j; const LAS float* s = scr + (8 * c) * 33 + n;
        v4u o; o.x = pk2(s[0 * 33], s[1 * 33]); o.y = pk2(s[2 * 33], s[3 * 33]); o.z = pk2(s[4 * 33], s[5 * 33]); o.w = pk2(s[6 * 33], s[7 * 33]);
        *(GAS v4u*)(WT + (size_t)(n0o + n) * K + k0 + 8 * c) = o; }
    LDS_WAIT(); asm volatile("" ::: "memory");
}

__device__ __forceinline__ void weight_items(Frame& F, int first, int last, int widx, int nw) {
    LAS float* scr = (LAS float*)(F.lds + F.wave * 16384);
    constexpr int I_IN = (D / 64) * (IND / 32), I_OUT = (D / 64) * (D / 32), I_1 = (D / 64) * (FF / 32), I_2 = (FF / 64) * (D / 32), I_L = I_IN + I_OUT + I_1 + I_2;
    for (int it = first + widx; it < last; it += nw) {
        const int l = it / I_L; int r = it % I_L;
        const float* W; bf16* WT; int K = D, N; const bool glu = r < I_IN;
        if (r < I_IN) { W = INP(8) + (size_t)l * D * IND; WT = WSP(bf16, WS_WIN) + (size_t)l * IND * D; N = IND; }
        else if (r < I_IN + I_OUT) { r -= I_IN; W = INP(9) + (size_t)l * D * D; WT = WSP(bf16, WS_WOUT) + (size_t)l * D * D; N = D; }
        else if (r < I_IN + I_OUT + I_1) { r -= I_IN + I_OUT; W = INP(22) + (size_t)l * D * FF; WT = WSP(bf16, WS_W1) + (size_t)l * FF * D; N = FF; }
        else { r -= I_IN + I_OUT + I_1; W = INP(23) + (size_t)l * FF * D; WT = WSP(bf16, WS_W2) + (size_t)l * D * FF; K = FF; N = D; }
        p0_transpose_item(W, K, N, WT, scr, r, F.lane, glu);
    }
}
constexpr int W_ITEMS = 2 * ((D / 64) * (IND / 32) + (D / 64) * (D / 32) + (D / 64) * (FF / 32) + (FF / 64) * (D / 32));
constexpr int W_EARLY = 64 * NWAVES * 3;

__device__ __forceinline__ void phase_p0a(Frame& F) {
    LAS float* tab = (LAS float*)(F.lds);
    LAS float* red = (LAS float*)(F.lds + 17 * 1024 * 4);
    float* MOD = WSP(float, WS_MOD);
    bool filled = false;
    for (int it = F.vcu; it < 2 * 96; it += F.G) {
        if (!filled) {
            for (int i = F.tid; i < 17 * 1024; i += NWAVES * 64) { const int r = i >> 10, k = i & 1023; const float v = (r < 16) ? INP(1)[r * D + k] : INP(3)[k]; tab[i] = siluf_(v); }
            __syncthreads(); filled = true;
        }
        const int l = it / 96, n0 = (it % 96) * 64;
        gemv17_item(F, tab, red, INP(6) + (size_t)l * D * MODW, MODW, n0, INP(7) + (size_t)l * MODW, MOD + (size_t)l * 17 * MODW, MODW, n0);
    }
    if (F.G == 256 && F.vcu >= 192) weight_items(F, 0, W_EARLY, (F.vcu - 192) * NWAVES + F.wave, 64 * NWAVES);
}

__device__ __forceinline__ void phase_p0b(Frame& F) {
    LAS float* tab = (LAS float*)(F.lds);
    LAS float* red = (LAS float*)(F.lds + 17 * 1024 * 4);
    const float* MOD = WSP(const float, WS_MOD);
    for (int it = F.vcu; it < 2 * 104; it += F.G) {
        const int l = it / 104, j = it % 104; const bool first = j < 40;
        const int shoff = first ? 0 : 3 * D;
        __syncthreads();
        for (int i = F.tid; i < 17 * 1024; i += NWAVES * 64) { const int r = i >> 10, k = i & 1023; tab[i] = MOD[((size_t)l * 17 + r) * MODW + shoff + k]; }
        __syncthreads();
        const int ldw = first ? IND : FF;
        gemv17_item(F, tab, red, first ? INP(8) + (size_t)l * D * IND : INP(22) + (size_t)l * D * FF, ldw, (first ? j : j - 40) * 64, nullptr,
                    first ? WSP(float, WS_SHW1) + (size_t)l * 17 * IND : WSP(float, WS_SHW2) + (size_t)l * 17 * FF, ldw, first ? glu_col(j * 64) : (j - 40) * 64);
    }
    bf16* XA = WSP(bf16, WS_XA); float* RSSA = WSP(float, WS_RSSA);
    const float* g1 = INP(4);
    for (int row = F.gw; row < MT; row += 2 * F.NGW) {
        f32x4 v[2][4]; float ss[2]; int rw[2]; const float* scp[2];
#pragma unroll
        for (int q = 0; q < 2; ++q) { int r_ = row + q * F.NGW; if (r_ >= MT) r_ = row; rw[q] = r_;
            const bool lat = r_ < ML;
            const float* xr = lat ? INP(0) + (size_t)r_ * D : INP(2) + (size_t)(r_ - ML) * D;
            scp[q] = MOD + (size_t)(lat ? (r_ >> 11) : NB) * MODW + D;
#pragma unroll
            for (int j = 0; j < 4; ++j) v[q][j] = *(const f32x4*)(xr + 4 * F.lane + 256 * j); }
#pragma unroll
        for (int q = 0; q < 2; ++q) { float s_ = 0.f;
#pragma unroll
            for (int j = 0; j < 4; ++j) s_ += (v[q][j][0] * v[q][j][0] + v[q][j][1] * v[q][j][1]) + (v[q][j][2] * v[q][j][2] + v[q][j][3] * v[q][j][3]);
            ss[q] = wave_sum(s_); }
#pragma unroll
        for (int q = 0; q < 2; ++q) { if (q == 1 && rw[1] == row) break;
            if (F.lane < 32) RSSA[(size_t)rw[q] * 32 + F.lane] = (F.lane == 0) ? ss[q] : 0.f;
#pragma unroll
            for (int j = 0; j < 4; ++j) { const int k = 4 * F.lane + 256 * j;
                const f32x4 gm = *(const f32x4*)(g1 + k) * (*(const f32x4*)(scp[q] + k) + 1.0f), a = v[q][j] * gm;
                v2u o; o.x = pk2(a[0], a[1]); o.y = pk2(a[2], a[3]); *(v2u*)(XA + (size_t)rw[q] * D + k) = o; } }
    }
    __syncthreads();
    {
        bf16* WLR = WSP(bf16, WS_WLR);
        for (int i = F.gw * 64 + F.lane; i < 2 * 2 * 4 * 2 * 4096; i += F.NGW * 64) { const int d = i & 63, e = (i >> 6) & 63, gt = (i >> 12) & 1, blk = i >> 13;
            const float* src = gt == 0 ? INP(17) : INP(19); WLR[i] = (bf16)f2bf(src[((size_t)blk * 64 + d) * 64 + e]); }
    }
    weight_items(F, (F.G == 256) ? W_EARLY : 0, W_ITEMS, F.gw, F.NGW);
}

constexpr int CV_OSROW = 260;
__device__ __forceinline__ void conv_phase(Frame& F, int l, int ntiles) {
    const bf16* PROJ = WSP(const bf16, WS_PROJ); bf16* MIX = WSP(bf16, WS_MIX);
    LAS float* us = (LAS float*)(F.lds);
    LAS float* os = (LAS float*)(F.lds + 62 * 256 * 4);
    const int c = F.tid & 255, half = F.tid >> 8;
    float w[31];
#pragma unroll
    for (int k = 0; k < 31; ++k) w[k] = INP(10)[((size_t)l * 31 + k) * 256 + c];
    const float cbias = INP(11)[l * 256 + c];
    const f32x4 lg = *(const f32x4*)(INP(12) + l * 256 + 4 * F.lane), lb = *(const f32x4*)(INP(13) + l * 256 + 4 * F.lane);
    unsigned pv[16];
    auto load_tile = [&](int T) {
        const int row0 = T * 32;
        int lo, hi; if (row0 < ML) { lo = row0 & ~(SEQ - 1); hi = lo + SEQ; } else { lo = row0 & ~(CTXL - 1); hi = lo + CTXL; }
#pragma unroll
        for (int j = 0; j < 16; ++j) { const int i = F.tid + 512 * j, rr = i >> 7, cp = i & 127, row = row0 - 15 + rr;
            const bool ok = (j < 15 || F.tid < 256) && row >= lo && row < hi;
            pv[j] = ok ? *(const unsigned*)(PROJ + (size_t)row * IND + 2 * cp) : 0u; }
    };
    const int T0 = F.G - 1 - F.vcu;
    if (T0 < ntiles) load_tile(T0);
    for (int T = T0; T < ntiles; T += F.G) {
        const int row0 = T * 32;
        __syncthreads();
#pragma unroll
        for (int j = 0; j < 16; ++j) { const int i = F.tid + 512 * j;
            if (j < 15 || F.tid < 256) { f32x2 u; u[0] = bflo(pv[j]); u[1] = bfhi(pv[j]); *(LAS f32x2*)(us + 2 * i) = u; } }
        if (T + F.G < ntiles) load_tile(T + F.G);
        __syncthreads();
        {
            float acc[16];
#pragma unroll
            for (int j = 0; j < 16; ++j) acc[j] = cbias;
            const LAS float* up = us + (16 * half) * 256 + c;
#pragma unroll
            for (int i = 0; i < 46; ++i) { const float x = up[i * 256];
#pragma unroll
                for (int j = 0; j < 16; ++j) if (i - j >= 0 && i - j <= 30) acc[j] += w[i - j] * x; }
#pragma unroll
            for (int j = 0; j < 16; ++j) os[(16 * half + j) * CV_OSROW + c] = acc[j];
        }
        __syncthreads();
#pragma unroll
        for (int q = 0; q < 4; ++q) { const int t = 4 * F.wave + q;
            const f32x4 v = *(const LAS f32x4*)(os + t * CV_OSROW + 4 * F.lane);
            const float mu = wave_sum((v[0] + v[1]) + (v[2] + v[3])) * (1.f / 256.f);
            const f32x4 d = v - mu;
            const float var = wave_sum((d[0] * d[0] + d[1] * d[1]) + (d[2] * d[2] + d[3] * d[3])) * (1.f / 256.f);
            const f32x4 y = d * rsqrtf(var + EPS) * lg + lb;
            v2u o; o.x = pk2(siluf_(y[0]), siluf_(y[1])); o.y = pk2(siluf_(y[2]), siluf_(y[3]));
            *(v2u*)(MIX + (size_t)(row0 + t) * D + 4 * F.lane) = o; }
    }
}

typedef short s16x8 __attribute__((ext_vector_type(8)));
typedef short s16x4 __attribute__((ext_vector_type(4)));
constexpr int NA_KROW = 144, NA_VROW = 160;
constexpr int NA_STAGE = 64 * NA_KROW + 64 * NA_VROW, NA_SLOT = 2 * NA_STAGE, NA_OFF_TB = 2 * NA_SLOT;
static_assert(NA_OFF_TB + 2560 <= RING_BYTES, "NA LDS map");
constexpr int NA_ITEMS_LAT = NB * NH * 8, NA_ITEMS_CTX = NB * NH * 2;
struct NaBlk { f32x4 O[4]; float m, lsum; int first; };
__device__ __forceinline__ int na_rs(int r) { int v = r - 4; return v < 0 ? 0 : (v > 24 ? 24 : v); }
__device__ __forceinline__ s16x8 na_scale_q(v4u w, float c) {
    v4u o; o.x = pg8::cvt_pk_bf16(bflo(w.x) * c, bfhi(w.x) * c); o.y = pg8::cvt_pk_bf16(bflo(w.y) * c, bfhi(w.y) * c); o.z = pg8::cvt_pk_bf16(bflo(w.z) * c, bfhi(w.z) * c); o.w = pg8::cvt_pk_bf16(bflo(w.w) * c, bfhi(w.w) * c);
    return __builtin_bit_cast(s16x8, o);
}
__device__ __forceinline__ void na_phase(Frame& F, int l, int nitems, int nav = 0) {
    const bf16* PROJ = WSP(const bf16, WS_PROJ); bf16* MIX = WSP(bf16, WS_MIX);
    LAS float* tb = (LAS float*)(F.lds + NA_OFF_TB);
    const int lane = F.lane, q16 = lane & 15, g = lane >> 4;
    const unsigned skey = (unsigned)(F.tid >> 3), spart = (unsigned)(F.tid & 7);
    const float c1 = 0.125f * 1.4426950408889634f;
    struct NaItem { int b, h, ra, qrow0, rsI, nloc, nch, npair, isctx; };
    auto decode = [&](int it, NaItem& I) {
        I.isctx = it >= NA_ITEMS_LAT ? 1 : 0; I.ra = 0; I.rsI = 0; I.nloc = 0;
        if (!I.isctx) { const int r4 = it & 7; I.h = (it >> 3) & 7; I.b = it >> 6; const int r0 = 4 * r4; I.ra = r0 + 2 * (F.wave >> 2); I.qrow0 = I.b * SEQ + I.ra * 64 + (F.wave & 3) * 16;
            I.rsI = na_rs(r0); I.nloc = na_rs(r0 + 3) + 8 - I.rsI; }
        else { const int j = it - NA_ITEMS_LAT; const int hf = j & 1; I.h = (j >> 1) & 7; I.b = j >> 4; I.qrow0 = ML + I.b * CTXL + hf * 128 + F.wave * 16; }
        I.nch = I.nloc + 4; I.npair = (I.nch + 1) >> 1;
    };
    auto krow_of = [&](const NaItem& I, int ch) -> int { if (ch > I.nch - 1) ch = I.nch - 1; return ch < I.nloc ? I.b * SEQ + (I.rsI + ch) * 64 : ML + I.b * CTXL + (ch - I.nloc) * 64; };
    const int jq = F.wave & 3;
    const int o0 = jq == 0 ? 0 : 16 * jq - 8, o1 = jq == 0 ? 16 : (jq == 3 ? 48 : 16 * jq + 8);
    float madd[2][4]; int lb[2];
    {
        const int qc = jq * 16 + q16; int cs = qc - 8; cs = cs < 0 ? 0 : (cs > 48 ? 48 : cs);
#pragma unroll
        for (int e = 0; e < 4; ++e) { const int k0 = o0 + 4 * g + e, k1 = o1 + 4 * g + e;
            madd[0][e] = ((unsigned)(k0 - cs) < 16u) ? 0.f : -1.0e30f;
            madd[1][e] = (((unsigned)(k1 - cs) < 16u) && !(jq == 3 && k1 < 56)) ? 0.f : -1.0e30f; }
        lb[0] = 64 + o0 + 4 * g - qc + 15; lb[1] = 64 + o1 + 4 * g - qc + 15;
    }
    v4u kr0, vr0, kr1, vr1, qrA[2], qrB[2];
    auto issue_first = [&](const NaItem& I) {
        const bf16* Pk = PROJ + 1024 + I.h * HD + 8 * spart, * Pv = PROJ + 1536 + I.h * HD + 8 * spart, * Pq = PROJ + 512 + I.h * HD;
        kr0 = *(const v4u*)(Pk + (size_t)(krow_of(I, 0) + (int)skey) * IND); vr0 = *(const v4u*)(Pv + (size_t)(krow_of(I, 0) + (int)skey) * IND);
        kr1 = *(const v4u*)(Pk + (size_t)(krow_of(I, 1) + (int)skey) * IND); vr1 = *(const v4u*)(Pv + (size_t)(krow_of(I, 1) + (int)skey) * IND);
#pragma unroll
        for (int s_ = 0; s_ < 2; ++s_) { qrA[s_] = *(const v4u*)(Pq + (size_t)(I.qrow0 + q16) * IND + 32 * s_ + 8 * g);
            qrB[s_] = I.isctx ? qrA[s_] : *(const v4u*)(Pq + (size_t)(I.qrow0 + 64 + q16) * IND + 32 * s_ + 8 * g); }
    };
    NaItem I; int it = F.vcu; bool have = it < nitems; int tb_h = -1;
    if (have) { decode(it, I); issue_first(I); }
    while (have) {
        const bool isctx = I.isctx != 0;
        const int ra = I.ra, rsI = I.rsI, nloc = I.nloc, nch = I.nch, npair = I.npair, qrow0 = I.qrow0, h = I.h;
        const bf16* Pk = PROJ + 1024 + h * HD + 8 * spart, * Pv = PROJ + 1536 + h * HD + 8 * spart;
        s16x8 qfA[2], qfB[2];
#pragma unroll
        for (int s_ = 0; s_ < 2; ++s_) { qfA[s_] = na_scale_q(qrA[s_], c1); qfB[s_] = na_scale_q(qrB[s_], c1); }
        const int rsA = na_rs(ra), rsB = na_rs(ra + 1);
        NaItem N; const int itn = it + F.G; const bool haven = itn < nitems; if (haven) decode(itn, N); else N = I;
        __syncthreads();
        if (!isctx && h != tb_h) { const float* rpb = INP(14) + ((size_t)l * NH + h) * 15 * 31; tb_h = h;
            for (int i = F.tid; i < 640; i += NWAVES * 64) tb[i] = (i >= 64 && i < 64 + 465) ? rpb[i - 64] * 1.4426950408889634f : 0.f; }
        {
            LAS unsigned char* s0 = F.lds;
            *(LAS v4u*)(s0 + skey * NA_KROW + spart * 16) = kr0; *(LAS v4u*)(s0 + 64 * NA_KROW + skey * NA_VROW + spart * 16) = vr0;
            *(LAS v4u*)(s0 + NA_STAGE + skey * NA_KROW + spart * 16) = kr1; *(LAS v4u*)(s0 + NA_STAGE + 64 * NA_KROW + skey * NA_VROW + spart * 16) = vr1;
        }
        if (npair > 2) {
            kr0 = *(const v4u*)(Pk + (size_t)(krow_of(I, 2) + (int)skey) * IND); vr0 = *(const v4u*)(Pv + (size_t)(krow_of(I, 2) + (int)skey) * IND);
            kr1 = *(const v4u*)(Pk + (size_t)(krow_of(I, 3) + (int)skey) * IND); vr1 = *(const v4u*)(Pv + (size_t)(krow_of(I, 3) + (int)skey) * IND);
        } else {
            kr0 = *(const v4u*)(Pk + (size_t)(krow_of(I, 2) + (int)skey) * IND); vr0 = *(const v4u*)(Pv + (size_t)(krow_of(I, 2) + (int)skey) * IND);
            kr1 = *(const v4u*)(Pk + (size_t)(krow_of(I, 3) + (int)skey) * IND); vr1 = *(const v4u*)(Pv + (size_t)(krow_of(I, 3) + (int)skey) * IND);
        }
        NaBlk A, B;
#pragma unroll
        for (int dt = 0; dt < 4; ++dt) { A.O[dt] = (f32x4){0.f, 0.f, 0.f, 0.f}; B.O[dt] = (f32x4){0.f, 0.f, 0.f, 0.f}; }
        A.m = 0.f; A.lsum = 0.f; A.first = 1; B.m = 0.f; B.lsum = 0.f; B.first = 1;
        for (int cp = 0; cp < npair; ++cp) {
            __syncthreads();
            if (cp + 1 < npair) { LAS unsigned char* nx = F.lds + ((cp + 1) & 1) * NA_SLOT;
                *(LAS v4u*)(nx + skey * NA_KROW + spart * 16) = kr0; *(LAS v4u*)(nx + 64 * NA_KROW + skey * NA_VROW + spart * 16) = vr0;
                *(LAS v4u*)(nx + NA_STAGE + skey * NA_KROW + spart * 16) = kr1; *(LAS v4u*)(nx + NA_STAGE + 64 * NA_KROW + skey * NA_VROW + spart * 16) = vr1; }
            if (cp + 2 < npair) { const int k2 = krow_of(I, 2 * cp + 4) + (int)skey, k3 = krow_of(I, 2 * cp + 5) + (int)skey;
                kr0 = *(const v4u*)(Pk + (size_t)k2 * IND); vr0 = *(const v4u*)(Pv + (size_t)k2 * IND); kr1 = *(const v4u*)(Pk + (size_t)k3 * IND); vr1 = *(const v4u*)(Pv + (size_t)k3 * IND); }
            else if (cp + 2 == npair && haven) issue_first(N);
          for (int sub = 0; sub < 2; ++sub) {
            const int ch = 2 * cp + sub;
            if (ch >= nch) break;
            LAS unsigned char* cur = F.lds + (cp & 1) * NA_SLOT + sub * NA_STAGE;
            const bool local = ch < nloc;
            const int kr = rsI + ch;
            const bool actA = !local || (kr >= rsA && kr <= rsA + 7), actB = !isctx && (!local || (kr >= rsB && kr <= rsB + 7));
            if ((!actA && !actB) || nav == 1) continue;
            auto finish = [&](f32x4* S, int nt_, NaBlk& X, unsigned (*pk)[2], float cm) {
                if (X.first || !__all(cm <= 8.f)) {
                    cm = fmaxf(cm, __shfl_xor(cm, 16)); cm = fmaxf(cm, __shfl_xor(cm, 32));
                    const float d = X.first ? cm : fmaxf(cm, 0.f);
                    if (!X.first) { const float alpha = __builtin_amdgcn_exp2f(-d); X.lsum *= alpha;
#pragma unroll
                        for (int dt = 0; dt < 4; ++dt) X.O[dt] = X.O[dt] * alpha; }
                    X.m += d; X.first = 0;
#pragma unroll
                    for (int t = 0; t < 4; ++t) if (t < nt_) S[t] = S[t] - d;
                }
                float ps = 0.f;
#pragma unroll
                for (int t = 0; t < 4; ++t) if (t < nt_) {
                    const float p0 = __builtin_amdgcn_exp2f(S[t][0]), p1 = __builtin_amdgcn_exp2f(S[t][1]), p2 = __builtin_amdgcn_exp2f(S[t][2]), p3 = __builtin_amdgcn_exp2f(S[t][3]);
                    ps += (p0 + p1) + (p2 + p3);
                    pk[t][0] = pg8::cvt_pk_bf16(p0, p1); pk[t][1] = pg8::cvt_pk_bf16(p2, p3); }
                X.lsum += ps;
            };
            unsigned pkA[4][2], pkB[4][2];
            if (local) {
                const LAS unsigned char* kb_ = cur + q16 * NA_KROW + 16 * g;
                f32x4 SA[2], SB[2];
#pragma unroll
                for (int t = 0; t < 2; ++t) { const float ma = -A.m, mb = -B.m; SA[t] = (f32x4){ma, ma, ma, ma}; SB[t] = (f32x4){mb, mb, mb, mb};
                    const int o = t == 0 ? o0 : o1;
#pragma unroll
                    for (int s_ = 0; s_ < 2; ++s_) { const s16x8 kf = *(const LAS s16x8*)(kb_ + o * NA_KROW + 64 * s_);
                        if (actA) SA[t] = __builtin_amdgcn_mfma_f32_16x16x32_bf16(kf, qfA[s_], SA[t], 0, 0, 0);
                        if (actB) SB[t] = __builtin_amdgcn_mfma_f32_16x16x32_bf16(kf, qfB[s_], SB[t], 0, 0, 0); } }
                if (nav == 2) { asm volatile("" :: "v"(SA[0]), "v"(SA[1]), "v"(SB[0]), "v"(SB[1])); continue; }
                auto soft_local = [&](f32x4 (&S)[2], NaBlk& X, unsigned (&pk)[4][2], int rq) {
                    float cm = -1.0e30f;
#pragma unroll
                    for (int t = 0; t < 2; ++t) { const LAS float* tr_ = tb + (kr - rq + 7) * 31 + lb[t];
#pragma unroll
                        for (int e = 0; e < 4; ++e) { const float v = (S[t][e] + tr_[e]) + madd[t][e]; S[t][e] = v; cm = fmaxf(cm, v); } }
                    finish(S, 2, X, pk, cm);
                };
                if (actA) soft_local(SA, A, pkA, ra);
                if (actB) soft_local(SB, B, pkB, ra + 1);
                if (nav == 3) { asm volatile("" :: "v"(pkA[0][0]), "v"(pkA[1][1]), "v"(pkB[0][0]), "v"(pkB[1][1])); continue; }
                const LAS unsigned char* vtr = cur + 64 * NA_KROW + (4 * g + (q16 >> 2)) * NA_VROW + (q16 & 3) * 8;
                const v4u bwA = {pkA[0][0], pkA[0][1], pkA[1][0], pkA[1][1]}, bwB = {pkB[0][0], pkB[0][1], pkB[1][0], pkB[1][1]};
                const s16x8 bfA = __builtin_bit_cast(s16x8, bwA), bfB = __builtin_bit_cast(s16x8, bwB);
#pragma unroll
                for (int dt = 0; dt < 4; ++dt) {
                    const s16x4 a0 = __builtin_amdgcn_ds_read_tr16_b64_v4i16((LAS s16x4*)(vtr + o0 * NA_VROW + dt * 32));
                    const s16x4 a1 = __builtin_amdgcn_ds_read_tr16_b64_v4i16((LAS s16x4*)(vtr + o1 * NA_VROW + dt * 32));
                    const s16x8 afrag = __builtin_shufflevector(a0, a1, 0, 1, 2, 3, 4, 5, 6, 7);
                    if (actA) A.O[dt] = __builtin_amdgcn_mfma_f32_16x16x32_bf16(afrag, bfA, A.O[dt], 0, 0, 0);
                    if (actB) B.O[dt] = __builtin_amdgcn_mfma_f32_16x16x32_bf16(afrag, bfB, B.O[dt], 0, 0, 0);
                }
            } else {
                const LAS unsigned char* kb_ = cur + q16 * NA_KROW + 16 * g;
                f32x4 SA[4], SB[4];
#pragma unroll
                for (int t = 0; t < 4; ++t) { const float ma = -A.m, mb = -B.m; SA[t] = (f32x4){ma, ma, ma, ma}; SB[t] = (f32x4){mb, mb, mb, mb};
#pragma unroll
                    for (int s_ = 0; s_ < 2; ++s_) { const s16x8 kf = *(const LAS s16x8*)(kb_ + t * 16 * NA_KROW + 64 * s_);
                        SA[t] = __builtin_amdgcn_mfma_f32_16x16x32_bf16(kf, qfA[s_], SA[t], 0, 0, 0);
                        if (actB) SB[t] = __builtin_amdgcn_mfma_f32_16x16x32_bf16(kf, qfB[s_], SB[t], 0, 0, 0); } }
                if (nav == 2) { asm volatile("" :: "v"(SA[0]), "v"(SA[1]), "v"(SA[2]), "v"(SA[3]), "v"(SB[0]), "v"(SB[1]), "v"(SB[2]), "v"(SB[3])); continue; }
                auto soft_ctx = [&](f32x4 (&S)[4], NaBlk& X, unsigned (&pk)[4][2]) {
                    float cm = -1.0e30f;
#pragma unroll
                    for (int t = 0; t < 4; ++t)
#pragma unroll
                        for (int e = 0; e < 4; ++e) cm = fmaxf(cm, S[t][e]);
                    finish(S, 4, X, pk, cm);
                };
                soft_ctx(SA, A, pkA);
                if (actB) soft_ctx(SB, B, pkB);
                if (nav == 3) { asm volatile("" :: "v"(pkA[0][0]), "v"(pkA[1][1]), "v"(pkA[2][0]), "v"(pkA[3][1]), "v"(pkB[0][0]), "v"(pkB[1][1]), "v"(pkB[2][0]), "v"(pkB[3][1])); continue; }
                const LAS unsigned char* vtr = cur + 64 * NA_KROW + (4 * g + (q16 >> 2)) * NA_VROW + (q16 & 3) * 8;
#pragma unroll
                for (int p = 0; p < 2; ++p) {
                    const v4u bwA = {pkA[2 * p][0], pkA[2 * p][1], pkA[2 * p + 1][0], pkA[2 * p + 1][1]}, bwB = {pkB[2 * p][0], pkB[2 * p][1], pkB[2 * p + 1][0], pkB[2 * p + 1][1]};
                    const s16x8 bfA = __builtin_bit_cast(s16x8, bwA), bfB = __builtin_bit_cast(s16x8, bwB);
#pragma unroll
                    for (int dt = 0; dt < 4; ++dt) {
                        const s16x4 a0 = __builtin_amdgcn_ds_read_tr16_b64_v4i16((LAS s16x4*)(vtr + (2 * p) * 16 * NA_VROW + dt * 32));
                        const s16x4 a1 = __builtin_amdgcn_ds_read_tr16_b64_v4i16((LAS s16x4*)(vtr + (2 * p + 1) * 16 * NA_VROW + dt * 32));
                        const s16x8 afrag = __builtin_shufflevector(a0, a1, 0, 1, 2, 3, 4, 5, 6, 7);
                        A.O[dt] = __builtin_amdgcn_mfma_f32_16x16x32_bf16(afrag, bfA, A.O[dt], 0, 0, 0);
                        if (actB) B.O[dt] = __builtin_amdgcn_mfma_f32_16x16x32_bf16(afrag, bfB, B.O[dt], 0, 0, 0);
                    }
                }
            }
          }
        }
        {
            float ls = A.lsum; ls += __shfl_xor(ls, 16); ls += __shfl_xor(ls, 32);
            const float inv = __builtin_amdgcn_rcpf(ls);
            bf16* op = MIX + (size_t)(qrow0 + q16) * D + 256 + h * HD + 4 * g;
#pragma unroll
            for (int dt = 0; dt < 4; ++dt) { v2u w; w.x = pg8::cvt_pk_bf16(A.O[dt][0] * inv, A.O[dt][1] * inv); w.y = pg8::cvt_pk_bf16(A.O[dt][2] * inv, A.O[dt][3] * inv); *(v2u*)(op + 16 * dt) = w; }
        }
        if (!isctx) {
            float ls = B.lsum; ls += __shfl_xor(ls, 16); ls += __shfl_xor(ls, 32);
            const float inv = __builtin_amdgcn_rcpf(ls);
            bf16* op = MIX + (size_t)(qrow0 + 64 + q16) * D + 256 + h * HD + 4 * g;
#pragma unroll
            for (int dt = 0; dt < 4; ++dt) { v2u w; w.x = pg8::cvt_pk_bf16(B.O[dt][0] * inv, B.O[dt][1] * inv); w.y = pg8::cvt_pk_bf16(B.O[dt][2] * inv, B.O[dt][3] * inv); *(v2u*)(op + 16 * dt) = w; }
        }
        it = itn; have = haven; I = N;
    }
}

constexpr int LRU_UCROW = 260;
constexpr int LRU_OFF_UC = 38 * 256 * 2, LRU_OFF_GT = LRU_OFF_UC + 2 * 32 * LRU_UCROW * 4;
static_assert(LRU_OFF_GT + 32 * 256 * 2 <= RING_BYTES, "LRU LDS map");
template <int PASS>
__device__ __forceinline__ void lru_phase(Frame& F, int l, int ntiles) {
    const bf16* PROJ = WSP(const bf16, WS_PROJ);
    LAS bf16* rxs = (LAS bf16*)(F.lds);
    LAS float* ucf = (LAS float*)(F.lds + LRU_OFF_UC);
    LAS bf16* gts = (LAS bf16*)(F.lds + LRU_OFF_GT);
    const int lane = F.lane, j16 = lane & 15, g = lane >> 4;
    const int kb = F.wave & 3, nh = F.wave >> 2;
    s16x8 wf[2][2][2][2];
    float cbx[2][2], cba[2][2], csp[2][2];
#pragma unroll
    for (int dir = 0; dir < 2; ++dir) {
        const int ld = l * 2 + dir;
        const bf16* WLR = WSP(const bf16, WS_WLR) + (size_t)((ld * 4 + kb) * 2) * 4096;
#pragma unroll
        for (int gt = 0; gt < 2; ++gt)
#pragma unroll
            for (int n2 = 0; n2 < 2; ++n2)
#pragma unroll
                for (int s_ = 0; s_ < 2; ++s_) wf[dir][gt][n2][s_] = *(const s16x8*)(WLR + gt * 4096 + (16 * (2 * nh + n2) + j16) * 64 + 32 * s_ + 8 * g);
#pragma unroll
        for (int n2 = 0; n2 < 2; ++n2) {
            const int e = kb * 64 + 16 * (2 * nh + n2) + j16, idx = ld * 256 + e;
            cbx[dir][n2] = INP(18)[idx]; cba[dir][n2] = INP(20)[idx];
            const float nl = -INP(21)[idx]; csp[dir][n2] = -8.f * (fmaxf(nl, 0.f) + log1pf(__expf(-fabsf(nl))));
        }
    }
    const int c = F.tid & 255, sdir = F.tid >> 8;
    const int sld = l * 2 + sdir;
    const float s1w0 = INP(15)[(sld * 4 + 0) * 256 + c], s1w1 = INP(15)[(sld * 4 + 1) * 256 + c], s1w2 = INP(15)[(sld * 4 + 2) * 256 + c], s1w3 = INP(15)[(sld * 4 + 3) * 256 + c], s1cb = INP(16)[sld * 256 + c];
    const int base = sdir == 0 ? 0 : 3;
    unsigned pre[10], pgw[8];
    auto load_tile = [&](int T) {
        const int row0 = T * 32;
        int lo, hi; if (row0 < ML) { lo = row0 & ~(SEQ - 1); hi = lo + SEQ; } else { lo = row0 & ~(CTXL - 1); hi = lo + CTXL; }
#pragma unroll
        for (int j = 0; j < 10; ++j) { const int i = F.tid + 512 * j, rr = i >> 7, cp = i & 127, row = row0 - 3 + rr;
            const bool ok = (j < 9 || F.tid < 256) && row >= lo && row < hi;
            pre[j] = ok ? *(const unsigned*)(PROJ + (size_t)row * IND + 2048 + 2 * cp) : 0u; }
        if (PASS == 1) {
#pragma unroll
            for (int j = 0; j < 8; ++j) { const int i = F.tid + 512 * j, t = i >> 7, cp = i & 127; pgw[j] = *(const unsigned*)(PROJ + (size_t)(row0 + t) * IND + 2304 + 2 * cp); }
        }
    };
    if (F.vcu < ntiles) load_tile(F.vcu);
    for (int T = F.vcu; T < ntiles; T += F.G) {
        const int row0 = T * 32;
        __syncthreads();
#pragma unroll
        for (int j = 0; j < 10; ++j) { const int i = F.tid + 512 * j; if (j < 9 || F.tid < 256) ((LAS unsigned*)rxs)[i] = pre[j]; }
        if (PASS == 1) {
#pragma unroll
            for (int j = 0; j < 8; ++j) ((LAS unsigned*)gts)[F.tid + 512 * j] = pgw[j];
        }
        if (T + F.G < ntiles) load_tile(T + F.G);
        float hst[2][2];
#pragma unroll
        for (int dir = 0; dir < 2; ++dir)
#pragma unroll
            for (int n2 = 0; n2 < 2; ++n2) hst[dir][n2] = PASS == 1 ? WSP(const float, WS_CARRY)[((size_t)dir * 1152 + T) * 256 + kb * 64 + 16 * (2 * nh + n2) + j16] : 0.f;
        __syncthreads();
        {
            float x0 = bf1(rxs[(base + 0) * 256 + c]), x1 = bf1(rxs[(base + 1) * 256 + c]), x2 = bf1(rxs[(base + 2) * 256 + c]);
#pragma unroll 8
            for (int t = 0; t < 32; ++t) {
                const float x3 = bf1(rxs[(t + base + 3) * 256 + c]);
                ucf[(sdir * 32 + t) * LRU_UCROW + c] = s1cb + s1w0 * x0 + s1w1 * x1 + s1w2 * x2 + s1w3 * x3;
                x0 = x1; x1 = x2; x2 = x3;
            }
        }
        __syncthreads();
        float hf[2][2][4];
        float Pt[2][2] = {{1.f, 1.f}, {1.f, 1.f}};
#pragma unroll
        for (int dir = 0; dir < 2; ++dir) {
            const bool sec16 = ((g & 1) != 0) != (dir != 0), sec32 = ((g >> 1) != 0) != (dir != 0);
#pragma unroll
            for (int step = 0; step < 2; ++step) {
                const int rt = dir == 0 ? step : 1 - step;
                s16x8 af[2];
#pragma unroll
                for (int s_ = 0; s_ < 2; ++s_) { const LAS float* up = ucf + (dir * 32 + 16 * rt + j16) * LRU_UCROW + kb * 64 + 32 * s_ + 8 * g;
                    const f32x4 u0 = *(const LAS f32x4*)up, u1 = *(const LAS f32x4*)(up + 4);
                    const v4u w = {pg8::cvt_pk_bf16(u0[0], u0[1]), pg8::cvt_pk_bf16(u0[2], u0[3]), pg8::cvt_pk_bf16(u1[0], u1[1]), pg8::cvt_pk_bf16(u1[2], u1[3])};
                    af[s_] = __builtin_bit_cast(s16x8, w); }
#pragma unroll
                for (int n2 = 0; n2 < 2; ++n2) {
                    f32x4 zx = {0.f, 0.f, 0.f, 0.f}, za = {0.f, 0.f, 0.f, 0.f};
#pragma unroll
                    for (int s_ = 0; s_ < 2; ++s_) { zx = __builtin_amdgcn_mfma_f32_16x16x32_bf16(af[s_], wf[dir][0][n2][s_], zx, 0, 0, 0); za = __builtin_amdgcn_mfma_f32_16x16x32_bf16(af[s_], wf[dir][1][n2][s_], za, 0, 0, 0); }
                    const int e = kb * 64 + 16 * (2 * nh + n2) + j16;
                    const LAS float* uo = ucf + (dir * 32 + 16 * rt + 4 * g) * LRU_UCROW + e;
                    float a_[4], b_[4]; unsigned abw[4];
#pragma unroll
                    for (int r = 0; r < 4; ++r) {
                        const float u = uo[r * LRU_UCROW];
                        const float gx = sigmoidf_(zx[r] + cbx[dir][n2]), ga = sigmoidf_(za[r] + cba[dir][n2]);
                        const float la = csp[dir][n2] * ga, a = __builtin_amdgcn_exp2f(1.4426950408889634f * la), y = 2.f * la;
                        const float om = y > -0.02f ? -y * (1.f + y * (0.5f + y * 0.16666667f)) : 1.f - a * a;
                        a_[r] = a; b_[r] = __builtin_amdgcn_sqrtf(om) * gx * u;
                        if (PASS == 0) {
                            const float oma = la > -0.02f ? -la * (1.f + la * (0.5f + la * 0.16666667f)) : 1.f - a;
                            abw[r] = pg8::cvt_pk_bf16(oma, b_[r]); a_[r] = 1.f - bflo(abw[r]); b_[r] = bfhi(abw[r]);
                        }
                    }
                    if (PASS == 0) WSP(v4u, WS_AB)[(((((size_t)T * 2 + dir) * 2 + rt) * 8 + F.wave) * 2 + n2) * 64 + lane] = (v4u){abw[0], abw[1], abw[2], abw[3]};
                    const float P = (a_[0] * a_[1]) * (a_[2] * a_[3]);
                    const float S = dir == 0 ? ((b_[0] * a_[1] + b_[1]) * a_[2] + b_[2]) * a_[3] + b_[3] : ((b_[3] * a_[2] + b_[2]) * a_[1] + b_[1]) * a_[0] + b_[0];
                    const float Pp = __shfl_xor(P, 16), Sp = __shfl_xor(S, 16);
                    const float e1P = sec16 ? Pp : 1.f, e1S = sec16 ? Sp : 0.f;
                    const float prP = P * Pp, prS = sec16 ? P * Sp + S : Pp * S + Sp;
                    const float Pq = __shfl_xor(prP, 32), Sq = __shfl_xor(prS, 32);
                    const float EP = sec32 ? Pq * e1P : e1P, ES = sec32 ? e1P * Sq + e1S : e1S;
                    const float TP = prP * Pq, TS = sec32 ? prP * Sq + prS : Pq * prS + Sq;
                    if (PASS == 1) {
                        float h = EP * hst[dir][n2] + ES;
                        if (dir == 0) {
#pragma unroll
                            for (int r = 0; r < 4; ++r) { h = a_[r] * h + b_[r]; hf[rt][n2][r] = h; }
                        } else {
                            float hb[4];
#pragma unroll
                            for (int r = 3; r >= 0; --r) { h = a_[r] * h + b_[r]; hb[r] = h; }
                            bf16* mp = WSP(bf16, WS_MIX) + (size_t)(row0 + 16 * rt + 4 * g) * D + 768 + e;
                            const LAS bf16* gp = gts + (16 * rt + 4 * g) * 256 + e;
#pragma unroll
                            for (int r = 0; r < 4; ++r) mp[(size_t)r * D] = (bf16)f2bf(gelu_tanh(bf1(gp[r * 256])) * (hf[rt][n2][r] + hb[r]));
                        }
                    } else Pt[dir][n2] *= TP;
                    hst[dir][n2] = TP * hst[dir][n2] + TS;
                }
            }
        }
        if (PASS == 0 && g == 0) {
#pragma unroll
            for (int dir = 0; dir < 2; ++dir)
#pragma unroll
                for (int n2 = 0; n2 < 2; ++n2) WSP(f32x2, WS_TOT)[((size_t)dir * 1152 + T) * 256 + kb * 64 + 16 * (2 * nh + n2) + j16] = (f32x2){Pt[dir][n2], hst[dir][n2]};
        }
    }
}
__device__ __forceinline__ void lru_scan_phase(Frame& F, int l, int ntiles) {
    const bf16* PROJ = WSP(const bf16, WS_PROJ);
    LAS bf16* gts = (LAS bf16*)(F.lds);
    const int lane = F.lane, j16 = lane & 15, g = lane >> 4;
    const int kb = F.wave & 3, nh = F.wave >> 2;
    const v4u* AB = WSP(const v4u, WS_AB);
    v4u pab[2][2][2]; unsigned pgw[8];
    auto load_tile = [&](int T) {
#pragma unroll
        for (int dir = 0; dir < 2; ++dir)
#pragma unroll
            for (int rt = 0; rt < 2; ++rt)
#pragma unroll
                for (int n2 = 0; n2 < 2; ++n2) pab[dir][rt][n2] = AB[(((((size_t)T * 2 + dir) * 2 + rt) * 8 + F.wave) * 2 + n2) * 64 + lane];
#pragma unroll
        for (int j = 0; j < 8; ++j) { const int i = F.tid + 512 * j, t = i >> 7, cp = i & 127; pgw[j] = *(const unsigned*)(PROJ + (size_t)(T * 32 + t) * IND + 2304 + 2 * cp); }
    };
    if (F.vcu < ntiles) load_tile(F.vcu);
    for (int T = F.vcu; T < ntiles; T += F.G) {
        const int row0 = T * 32;
        __syncthreads();
#pragma unroll
        for (int j = 0; j < 8; ++j) ((LAS unsigned*)gts)[F.tid + 512 * j] = pgw[j];
        v4u cur[2][2][2];
#pragma unroll
        for (int dir = 0; dir < 2; ++dir)
#pragma unroll
            for (int rt = 0; rt < 2; ++rt)
#pragma unroll
                for (int n2 = 0; n2 < 2; ++n2) cur[dir][rt][n2] = pab[dir][rt][n2];
        float hst[2][2];
#pragma unroll
        for (int dir = 0; dir < 2; ++dir)
#pragma unroll
            for (int n2 = 0; n2 < 2; ++n2) hst[dir][n2] = WSP(const float, WS_CARRY)[((size_t)dir * 1152 + T) * 256 + kb * 64 + 16 * (2 * nh + n2) + j16];
        if (T + F.G < ntiles) load_tile(T + F.G);
        __syncthreads();
        float hf[2][2][4];
#pragma unroll
        for (int dir = 0; dir < 2; ++dir) {
            const bool sec16 = ((g & 1) != 0) != (dir != 0), sec32 = ((g >> 1) != 0) != (dir != 0);
#pragma unroll
            for (int step = 0; step < 2; ++step) {
                const int rt = dir == 0 ? step : 1 - step;
#pragma unroll
                for (int n2 = 0; n2 < 2; ++n2) {
                    const int e = kb * 64 + 16 * (2 * nh + n2) + j16;
                    const v4u w = cur[dir][rt][n2];
                    const float a_[4] = {1.f - bflo(w.x), 1.f - bflo(w.y), 1.f - bflo(w.z), 1.f - bflo(w.w)}, b_[4] = {bfhi(w.x), bfhi(w.y), bfhi(w.z), bfhi(w.w)};
                    const float P = (a_[0] * a_[1]) * (a_[2] * a_[3]);
                    const float S = dir == 0 ? ((b_[0] * a_[1] + b_[1]) * a_[2] + b_[2]) * a_[3] + b_[3] : ((b_[3] * a_[2] + b_[2]) * a_[1] + b_[1]) * a_[0] + b_[0];
                    const float Pp = __shfl_xor(P, 16), Sp = __shfl_xor(S, 16);
                    const float e1P = sec16 ? Pp : 1.f, e1S = sec16 ? Sp : 0.f;
                    const float prP = P * Pp, prS = sec16 ? P * Sp + S : Pp * S + Sp;
                    const float Pq = __shfl_xor(prP, 32), Sq = __shfl_xor(prS, 32);
                    const float EP = sec32 ? Pq * e1P : e1P, ES = sec32 ? e1P * Sq + e1S : e1S;
                    const float TP = prP * Pq, TS = sec32 ? prP * Sq + prS : Pq * prS + Sq;
                    float h = EP * hst[dir][n2] + ES;
                    if (dir == 0) {
#pragma unroll
                        for (int r = 0; r < 4; ++r) { h = a_[r] * h + b_[r]; hf[rt][n2][r] = h; }
                    } else {
                        float hb[4];
#pragma unroll
                        for (int r = 3; r >= 0; --r) { h = a_[r] * h + b_[r]; hb[r] = h; }
                        bf16* mp = WSP(bf16, WS_MIX) + (size_t)(row0 + 16 * rt + 4 * g) * D + 768 + e;
                        const LAS bf16* gp = gts + (16 * rt + 4 * g) * 256 + e;
#pragma unroll
                        for (int r = 0; r < 4; ++r) mp[(size_t)r * D] = (bf16)f2bf(gelu_tanh(bf1(gp[r * 256])) * (hf[rt][n2][r] + hb[r]));
                    }
                    hst[dir][n2] = TP * hst[dir][n2] + TS;
                }
            }
        }
    }
}

constexpr int LQ_WVB = 35 * 128 + 32 * 144;
constexpr int LQ_WV = 72 * 1024;
constexpr int LQ_CH = TBL_OFF;
constexpr int LQ_FL = LQ_CH + 72 * 2 * 16 * 4;
constexpr int LQ_WV2 = LQ_FL + 2 * 72 * 4;
static_assert(LQ_WV + 6 * LQ_WVB <= RING_BYTES && LQ_WV2 + 2 * LQ_WVB <= LDS_BYTES && LQ_WV2 % 16 == 0, "LRU LDS map");
__device__ __forceinline__ void lru_seq_phase(Frame& F, int l, bool last) {
    const bf16* PROJ = WSP(const bf16, WS_PROJ);
    const int lane = F.lane, j16 = lane & 15, g = lane >> 4, cpn = lane & 31, hh = lane >> 5;
    LAS unsigned char* wreg = F.lds + (F.wave < 6 ? LQ_WV + F.wave * LQ_WVB : LQ_WV2 + (F.wave - 6) * LQ_WVB);
    LAS unsigned* rx32 = (LAS unsigned*)wreg;
    LAS unsigned char* ucb = wreg + 35 * 128;
    volatile LAS unsigned* cflag = (volatile LAS unsigned*)(F.lds + LQ_FL);
    volatile LAS unsigned* hflag = cflag + 72;
    LAS float* chain = (LAS float*)(F.lds + LQ_CH);
    for (int item = F.vcu; item < NB * 16; item += F.G) {
        const int b = item >> 4, cg = item & 15, kb = cg >> 2, nn = cg & 3;
        __syncthreads();
        if (F.tid < 144) cflag[F.tid] = 0u;
        __syncthreads();
        s16x8 wf[2][2][2]; float cbx[2], cba[2], csp[2]; f32x2 cw[2][4], cb[2];
#pragma unroll
        for (int dir = 0; dir < 2; ++dir) {
            const int ld = l * 2 + dir;
            const bf16* WLR = WSP(const bf16, WS_WLR) + (size_t)((ld * 4 + kb) * 2) * 4096;
#pragma unroll
            for (int gt = 0; gt < 2; ++gt)
#pragma unroll
                for (int s_ = 0; s_ < 2; ++s_) wf[dir][gt][s_] = *(const s16x8*)(WLR + gt * 4096 + (16 * nn + j16) * 64 + 32 * s_ + 8 * g);
            const int idx = ld * 256 + kb * 64 + 16 * nn + j16;
            cbx[dir] = INP(18)[idx]; cba[dir] = INP(20)[idx];
            const float nl = -INP(21)[idx]; csp[dir] = -8.f * (fmaxf(nl, 0.f) + log1pf(__expf(-fabsf(nl))));
            const int c0 = kb * 64 + 2 * cpn;
#pragma unroll
            for (int k = 0; k < 4; ++k) cw[dir][k] = (f32x2){INP(15)[(ld * 4 + k) * 256 + c0], INP(15)[(ld * 4 + k) * 256 + c0 + 1]};
            cb[dir] = (f32x2){INP(16)[ld * 256 + c0], INP(16)[ld * 256 + c0 + 1]};
        }
        auto tile_row0 = [&](int s, int dir) -> int { return s < 8 ? ML + b * CTXL + 32 * (dir == 0 ? s : 7 - s) : b * SEQ + 32 * (dir == 0 ? s - 8 : 71 - s); };
        v4u pre[5];
        auto load_rows = [&](int s, int dir) {
            const int lo = s < 8 ? ML + b * CTXL : b * SEQ, hi = lo + (s < 8 ? CTXL : SEQ);
            const int r0 = tile_row0(s, dir) - (dir == 0 ? 3 : 0);
#pragma unroll
            for (int j = 0; j < 5; ++j) { const int rr = (lane >> 3) + 8 * j, row = r0 + rr;
                const bool ok = rr < 35 && row >= lo && row < hi;
                pre[j] = ok ? *(const v4u*)(PROJ + (size_t)row * IND + 2048 + kb * 64 + 8 * (lane & 7)) : (v4u){0u, 0u, 0u, 0u}; }
        };
        load_rows(F.wave, 0);
        for (int s = F.wave; s < 72; s += 8) {
            const bool ctxs = s < 8, comb = ctxs ? s >= 4 : s >= 40, outp = !(last && ctxs);
            float A_[2][2][4], B_[2][2][4], EP[2][2], ES[2][2], TP[2][2], TS[2][2];
#pragma unroll
            for (int dir = 0; dir < 2; ++dir) {
#pragma unroll
                for (int j = 0; j < 5; ++j) { const int rr = (lane >> 3) + 8 * j; if (rr < 35) *(LAS v4u*)(wreg + rr * 128 + 16 * (lane & 7)) = pre[j]; }
                if (dir == 0) load_rows(s, 1); else if (s + 8 < 72) load_rows(s + 8, 0);
                {
                    auto up2 = [](unsigned w) -> f32x2 { return (f32x2){bflo(w), bfhi(w)}; };
                    f32x2 x0 = up2(rx32[(16 * hh + 0) * 32 + cpn]), x1 = up2(rx32[(16 * hh + 1) * 32 + cpn]), x2 = up2(rx32[(16 * hh + 2) * 32 + cpn]);
#pragma unroll
                    for (int t = 0; t < 16; ++t) {
                        const f32x2 x3 = up2(rx32[(16 * hh + t + 3) * 32 + cpn]);
                        const f32x2 acc = cb[dir] + cw[dir][0] * x0 + cw[dir][1] * x1 + cw[dir][2] * x2 + cw[dir][3] * x3;
                        *(LAS unsigned*)(ucb + (16 * hh + t) * 144 + 4 * cpn) = pg8::cvt_pk_bf16(acc[0], acc[1]);
                        x0 = x1; x1 = x2; x2 = x3;
                    }
                }
                const bool sec16 = ((g & 1) != 0) != (dir != 0), sec32 = ((g >> 1) != 0) != (dir != 0);
#pragma unroll
                for (int rt = 0; rt < 2; ++rt) {
                    f32x4 zx = {0.f, 0.f, 0.f, 0.f}, za = {0.f, 0.f, 0.f, 0.f};
#pragma unroll
                    for (int s_ = 0; s_ < 2; ++s_) { const s16x8 af = *(const LAS s16x8*)(ucb + (16 * rt + j16) * 144 + 64 * s_ + 16 * g);
                        zx = __builtin_amdgcn_mfma_f32_16x16x32_bf16(af, wf[dir][0][s_], zx, 0, 0, 0); za = __builtin_amdgcn_mfma_f32_16x16x32_bf16(af, wf[dir][1][s_], za, 0, 0, 0); }
                    float a_[4], b_[4];
#pragma unroll
                    for (int r = 0; r < 4; ++r) {
                        const float u = bf1(*(const LAS bf16*)(ucb + (16 * rt + 4 * g + r) * 144 + 2 * (16 * nn + j16)));
                        const float gx = sigmoidf_(zx[r] + cbx[dir]), ga = sigmoidf_(za[r] + cba[dir]);
                        const float la = csp[dir] * ga, a = __builtin_amdgcn_exp2f(1.4426950408889634f * la), y = 2.f * la;
                        const float om = y > -0.02f ? -y * (1.f + y * (0.5f + y * 0.16666667f)) : 1.f - a * a;
                        a_[r] = a; b_[r] = __builtin_amdgcn_sqrtf(om) * gx * u;
                        A_[dir][rt][r] = a_[r]; B_[dir][rt][r] = b_[r];
                    }
                    const float P = (a_[0] * a_[1]) * (a_[2] * a_[3]);
                    const float S = dir == 0 ? ((b_[0] * a_[1] + b_[1]) * a_[2] + b_[2]) * a_[3] + b_[3] : ((b_[3] * a_[2] + b_[2]) * a_[1] + b_[1]) * a_[0] + b_[0];
                    const float Pp = __shfl_xor(P, 16), Sp = __shfl_xor(S, 16);
                    const float e1P = sec16 ? Pp : 1.f, e1S = sec16 ? Sp : 0.f;
                    const float prP = P * Pp, prS = sec16 ? P * Sp + S : Pp * S + Sp;
                    const float Pq = __shfl_xor(prP, 32), Sq = __shfl_xor(prS, 32);
                    EP[dir][rt] = sec32 ? Pq * e1P : e1P; ES[dir][rt] = sec32 ? e1P * Sq + e1S : e1S;
                    TP[dir][rt] = prP * Pq; TS[dir][rt] = sec32 ? prP * Sq + prS : Pq * prS + Sq;
                }
            }
            bf16 gr[2][2][4];
            if (comb && outp) {
#pragma unroll
                for (int dir = 0; dir < 2; ++dir) { const bf16* gp = PROJ + (size_t)(tile_row0(s, dir) + 4 * g) * IND + 2304 + 16 * cg + j16;
#pragma unroll
                    for (int rt = 0; rt < 2; ++rt)
#pragma unroll
                        for (int r = 0; r < 4; ++r) gr[dir][rt][r] = gp[(size_t)(16 * rt + r) * IND]; }
            }
            float hin[2] = {0.f, 0.f};
            if (s > 0) {
                while (__builtin_amdgcn_readfirstlane(cflag[s - 1]) == 0u) __builtin_amdgcn_s_sleep(1);
                asm volatile("" ::: "memory");
                hin[0] = chain[((s - 1) * 2 + 0) * 16 + j16]; hin[1] = chain[((s - 1) * 2 + 1) * 16 + j16];
            }
#pragma unroll
            for (int dir = 0; dir < 2; ++dir) { const int rf = dir == 0 ? 0 : 1, rs_ = 1 - rf;
                const float hout = (TP[dir][rf] * TP[dir][rs_]) * hin[dir] + (TP[dir][rs_] * TS[dir][rf] + TS[dir][rs_]);
                if (g == 0) chain[(s * 2 + dir) * 16 + j16] = hout; }
            asm volatile("" ::: "memory");
            cflag[s] = 1u;
            asm volatile("" ::: "memory");
#pragma unroll
            for (int dir = 0; dir < 2; ++dir) { const int rf = dir == 0 ? 0 : 1, rs_ = 1 - rf;
                float hv[2][4];
                { float h = EP[dir][rf] * hin[dir] + ES[dir][rf];
                  if (dir == 0) {
#pragma unroll
                      for (int r = 0; r < 4; ++r) { h = A_[dir][rf][r] * h + B_[dir][rf][r]; hv[rf][r] = h; }
                  } else {
#pragma unroll
                      for (int r = 3; r >= 0; --r) { h = A_[dir][rf][r] * h + B_[dir][rf][r]; hv[rf][r] = h; }
                  } }
                { const float hm = TP[dir][rf] * hin[dir] + TS[dir][rf]; float h = EP[dir][rs_] * hm + ES[dir][rs_];
                  if (dir == 0) {
#pragma unroll
                      for (int r = 0; r < 4; ++r) { h = A_[dir][rs_][r] * h + B_[dir][rs_][r]; hv[rs_][r] = h; }
                  } else {
#pragma unroll
                      for (int r = 3; r >= 0; --r) { h = A_[dir][rs_][r] * h + B_[dir][rs_][r]; hv[rs_][r] = h; }
                  } }
                if (outp) {
                    const int id = s < 8 ? (dir == 0 ? s : 7 - s) : (dir == 0 ? s : 79 - s);
                    LAS v4u* hb = (LAS v4u*)(F.lds + id * 1024 + lane * 16);
                    if (!comb) {
                        *hb = (v4u){pg8::cvt_pk_bf16(hv[0][0], hv[0][1]), pg8::cvt_pk_bf16(hv[0][2], hv[0][3]), pg8::cvt_pk_bf16(hv[1][0], hv[1][1]), pg8::cvt_pk_bf16(hv[1][2], hv[1][3])};
                        asm volatile("" ::: "memory");
                        hflag[id] = 1u;
                        asm volatile("" ::: "memory");
                    } else {
                        while (__builtin_amdgcn_readfirstlane(hflag[id]) == 0u) __builtin_amdgcn_s_sleep(1);
                        asm volatile("" ::: "memory");
                        const v4u o = *hb;
                        const float ot[2][4] = {{bflo(o.x), bfhi(o.x), bflo(o.y), bfhi(o.y)}, {bflo(o.z), bfhi(o.z), bflo(o.w), bfhi(o.w)}};
                        bf16* mp = WSP(bf16, WS_MIX) + (size_t)(tile_row0(s, dir) + 4 * g) * D + 768 + 16 * cg + j16;
#pragma unroll
                        for (int rt = 0; rt < 2; ++rt)
#pragma unroll
                            for (int r = 0; r < 4; ++r) mp[(size_t)(16 * rt + r) * D] = (bf16)f2bf(gelu_tanh(bf1(gr[dir][rt][r])) * (hv[rt][r] + ot[rt][r]));
                    }
                }
            }
        }
    }
}

__device__ __forceinline__ void lru_carry(Frame& F) {
    const f32x2* TOT = WSP(const f32x2, WS_TOT); float* CARRY = WSP(float, WS_CARRY);
    for (int it = F.gw; it < NB * 2 * 4; it += F.NGW) {
        const int b = it >> 3, dir = (it >> 2) & 1, c = (it & 3) * 64 + F.lane;
        float h = 0.f;
        for (int g = 0; g < 18; ++g) {
            f32x2 ps[4]; int tl[4];
#pragma unroll
            for (int i = 0; i < 4; ++i) { const int s = g * 4 + i;
                int T; if (s < 8) T = 1024 + b * 8 + (dir == 0 ? s : 7 - s); else T = b * 64 + (dir == 0 ? s - 8 : 71 - s);
                tl[i] = T; ps[i] = TOT[((size_t)dir * 1152 + T) * 256 + c]; }
#pragma unroll
            for (int i = 0; i < 4; ++i) { CARRY[((size_t)dir * 1152 + tl[i]) * 256 + c] = h; h = ps[i][0] * h + ps[i][1]; }
        }
    }
}

__device__ __forceinline__ void ctx_finalize(Frame& F, int l) {
    bf16* XA = WSP(bf16, WS_XA); float* RSSA = WSP(float, WS_RSSA); const float* ACC = WSP(const float, WS_PART); const float* MOD = WSP(const float, WS_MOD);
    const float* go = INP(5) + (l - 1) * D; const float* gso = MOD + ((size_t)(l - 1) * 17 + NB) * MODW + 4 * D;
    const float* gn = INP(4) + l * D; const float* gsn = MOD + ((size_t)l * 17 + NB) * MODW + D;
    for (int r = F.gw; r < MC; r += F.NGW) {
        const size_t row = (size_t)ML + r;
        float ss = 0.f; f32x4 y[4];
#pragma unroll
        for (int j = 0; j < 4; ++j) { const int k = 4 * F.lane + 256 * j;
            const v2u w = *(const v2u*)(XA + row * D + k);
            const f32x4 im = *(const f32x4*)(go + k) * (*(const f32x4*)(gso + k) + 1.0f);
            const f32x4 xo = (f32x4){bflo(w.x) * __builtin_amdgcn_rcpf(im[0]), bfhi(w.x) * __builtin_amdgcn_rcpf(im[1]), bflo(w.y) * __builtin_amdgcn_rcpf(im[2]), bfhi(w.y) * __builtin_amdgcn_rcpf(im[3])};
            const float* ap = ACC + (size_t)r * D + k;
            y[j] = xo + ((*(const f32x4*)ap + *(const f32x4*)(ap + (size_t)MC * D)) + (*(const f32x4*)(ap + (size_t)2 * MC * D) + *(const f32x4*)(ap + (size_t)3 * MC * D)));
            ss += (y[j][0] * y[j][0] + y[j][1] * y[j][1]) + (y[j][2] * y[j][2] + y[j][3] * y[j][3]); }
        ss = wave_sum(ss);
        if (F.lane < 32) RSSA[row * 32 + F.lane] = (F.lane == 0) ? ss : 0.f;
#pragma unroll
        for (int j = 0; j < 4; ++j) { const int k = 4 * F.lane + 256 * j;
            const f32x4 a = y[j] * (*(const f32x4*)(gn + k) * (*(const f32x4*)(gsn + k) + 1.0f));
            v2u o; o.x = pk2(a[0], a[1]); o.y = pk2(a[2], a[3]); *(v2u*)(XA + row * D + k) = o; }
    }
}

__device__ __forceinline__ void final_rows(Frame& F) {
    const bf16* XA = WSP(const bf16, WS_XA); const float* RSS = WSP(const float, WS_RSSA);
    for (int row = F.gw; row < ML; row += 2 * F.NGW) {
        const int row2 = row + F.NGW; const bool two = row2 < ML;
        const v4u a0 = *(const v4u*)(XA + (size_t)row * D + 8 * F.lane), a1 = *(const v4u*)(XA + (size_t)row * D + 512 + 8 * F.lane);
        const float p0 = F.lane < 32 ? RSS[(size_t)row * 32 + F.lane] : 0.f;
        v4u b0 = a0, b1 = a1; float p1 = 0.f;
        if (two) { b0 = *(const v4u*)(XA + (size_t)row2 * D + 8 * F.lane); b1 = *(const v4u*)(XA + (size_t)row2 * D + 512 + 8 * F.lane); p1 = F.lane < 32 ? RSS[(size_t)row2 * 32 + F.lane] : 0.f; }
        const float rs0 = rsqrtf(wave_sum(p0) * (1.f / D) + EPS), rs1 = rsqrtf(wave_sum(p1) * (1.f / D) + EPS);
        float* o = F.out + (size_t)row * D + 8 * F.lane;
        *(f32x4*)(o) = (f32x4){bflo(a0.x), bfhi(a0.x), bflo(a0.y), bfhi(a0.y)} * rs0; *(f32x4*)(o + 4) = (f32x4){bflo(a0.z), bfhi(a0.z), bflo(a0.w), bfhi(a0.w)} * rs0;
        *(f32x4*)(o + 512) = (f32x4){bflo(a1.x), bfhi(a1.x), bflo(a1.y), bfhi(a1.y)} * rs0; *(f32x4*)(o + 516) = (f32x4){bflo(a1.z), bfhi(a1.z), bflo(a1.w), bfhi(a1.w)} * rs0;
        if (two) { float* o2 = F.out + (size_t)row2 * D + 8 * F.lane;
            *(f32x4*)(o2) = (f32x4){bflo(b0.x), bfhi(b0.x), bflo(b0.y), bfhi(b0.y)} * rs1; *(f32x4*)(o2 + 4) = (f32x4){bflo(b0.z), bfhi(b0.z), bflo(b0.w), bfhi(b0.w)} * rs1;
            *(f32x4*)(o2 + 512) = (f32x4){bflo(b1.x), bfhi(b1.x), bflo(b1.y), bfhi(b1.y)} * rs1; *(f32x4*)(o2 + 516) = (f32x4){bflo(b1.z), bfhi(b1.z), bflo(b1.w), bfhi(b1.w)} * rs1; }
    }
}

__device__ __forceinline__ void fill_res_tables(Frame& F, const pg8::Order& S, const float* gate, const float* gmg, const float* gmsc, const float* go, const float* gso) {
    LAS float* T = (LAS float*)(F.lds + TBL_OFF);
    if (F.tid < 256) {
#pragma unroll 1
        for (int i = 0; i < pg8::TBL_UNITS; ++i) { pg8::Unit u; if (!S.next(i, u)) break;
            const int brow = u.pm < ML / 256 ? (u.pm >> 3) : NB, col = u.pn * 256 + F.tid;
            T[i * 256 + F.tid] = gate[(size_t)brow * MODW + col];
            T[(pg8::TBL_UNITS + i) * 256 + F.tid] = gmg[col] * (1.f + gmsc[(size_t)brow * MODW + col]);
            T[(2 * pg8::TBL_UNITS + i) * 256 + F.tid] = __builtin_amdgcn_rcpf(go[col] * (1.f + gso[(size_t)brow * MODW + col])); }
    }
    __syncthreads();
}

template <int LDC>
__device__ __forceinline__ void fill_scale_tables(Frame& F, const pg8::Order& S, const float* RSS, const float* shw) {
    LAS float* RS_T = (LAS float*)(F.lds + TBL_OFF); LAS float* SH_T = RS_T + pg8::TBL_UNITS * 256;
    const int row = F.tid >> 1, half = F.tid & 1;
#pragma unroll 1
    for (int i0 = 0; i0 < pg8::TBL_UNITS; i0 += 3) {
        f32x4 p[3][4], sv[3]; bool ok[3];
#pragma unroll
        for (int j = 0; j < 3; ++j) { pg8::Unit u; ok[j] = S.next(i0 + j, u);
            if (ok[j]) { const float* b = RSS + ((size_t)u.pm * 256 + row) * 32 + 16 * half;
#pragma unroll
                for (int q = 0; q < 4; ++q) p[j][q] = *(const f32x4*)(b + 4 * q);
                if (F.tid < 64) sv[j] = *(const f32x4*)(shw + (size_t)(u.pm < ML / 256 ? (u.pm >> 3) : NB) * LDC + u.pn * 256 + 4 * F.tid); } }
#pragma unroll
        for (int j = 0; j < 3; ++j) if (ok[j]) {
            float s = 0.f;
#pragma unroll
            for (int q = 0; q < 4; ++q) s += (p[j][q][0] + p[j][q][1]) + (p[j][q][2] + p[j][q][3]);
            s += __shfl_xor(s, 1);
            if (half == 0) RS_T[(i0 + j) * 256 + row] = rsqrtf(s * (1.0f / D) + EPS);
            if (F.tid < 64) *(LAS f32x4*)(SH_T + (i0 + j) * 256 + 4 * F.tid) = sv[j]; }
    }
    __syncthreads();
}

constexpr int N_PHASES = 2 + 5 * DEPTH + 1;
struct Args { const float* in[25]; float* out; unsigned char* ws; int ph_lo, ph_hi; };
static_assert(sizeof(Args) == 27 * 8 + 8, "Args has no padding");

__global__ void __launch_bounds__(NWAVES * 64, 2) mega_fwd(Args args) {
    extern __shared__ __attribute__((aligned(16))) unsigned char lds[];
    Frame F;
    F.lds = (LAS unsigned char*)lds;
    const int wave_s = __builtin_amdgcn_readfirstlane((int)threadIdx.x >> 6);
    F.wave = wave_s; F.lane = (int)__builtin_amdgcn_mbcnt_hi(~0u, __builtin_amdgcn_mbcnt_lo(~0u, 0u)); F.tid = wave_s * 64 + F.lane;
    F.G = gridDim.x; { const int bx = blockIdx.x; F.vcu = (F.G % 8 == 0) ? (bx % 8) * (F.G / 8) + bx / 8 : bx; }
    F.gw = F.vcu * NWAVES + F.wave; F.NGW = F.G * NWAVES;
    F.out = args.out; F.ws = args.ws;
    volatile LAS unsigned* MISC = (volatile LAS unsigned*)(F.lds + MISC_OFF);
    for (int u = F.tid; u < (LDS_BYTES - LDSCTL_OFF) / 4; u += NWAVES * 64) ((LAS unsigned*)(F.lds + LDSCTL_OFF))[u] = 0u;
    __syncthreads();
    if (F.tid == 0) {
#pragma unroll
        for (int i = 0; i < 25; ++i) *(LAS unsigned long long*)(F.lds + PTR_OFF + 8 * i) = (unsigned long long)args.in[i];
    }
    __syncthreads();
    XcdBarrier bar = xcd_barrier_post((unsigned*)(F.ws + WS_CTL) + CW_BAR, MISC + 8, F.tid);

    const int lo = args.ph_lo, hi = args.ph_hi;
#ifdef PROBE_MASK
    bool rep_done = false;
#define PROBE_V ((((PROBE_MASK >> ph) & 1) && !rep_done) ? PROBE_VARIANT : 0)
#else
#define PROBE_V 0
#endif
    for (int ph = lo; ph < hi; ++ph) {
        { unsigned ones_ = ~0u; asm volatile("" : "+s"(ones_));
          int t_ = wave_s * 64 + (int)__builtin_amdgcn_mbcnt_hi(ones_, __builtin_amdgcn_mbcnt_lo(ones_, 0u)); asm volatile("" : "+v"(t_)); F.tid = t_; F.lane = t_ & 63; F.wave = __builtin_amdgcn_readfirstlane(t_ >> 6); F.gw = F.vcu * NWAVES + F.wave; }
        if (ph == 0) {
#ifndef NO_P0
            phase_p0a(F);
#endif
        } else if (ph == 1) {
#ifndef NO_P0
            phase_p0b(F);
#endif
        }
        else if (ph == N_PHASES - 1) final_rows(F);
        else {
            const int l = (ph - 2) / 5, k5 = (ph - 2) % 5, k = k5 < 2 ? k5 : k5 + 2; const bool last = (l == DEPTH - 1);
            const int Mx = last ? ML : MT;
            float* MOD = WSP(float, WS_MOD);
            if (k == 0) {
                if (l > 0) { ctx_finalize(F, l); xcd_barrier(bar, F.tid); }
                pg8::Gemm g{WSP(const bf16, WS_XA), WSP(const bf16, WS_WIN) + (size_t)l * IND * D, MT, IND, D};
                pg8::Order S; if (last) S.init(ML, IND, WGM_IN, (MC / 256) * 5, 1, F.G, (int)blockIdx.x); else S.init(MT, IND, WGM_IN, 0, 0, F.G, (int)blockIdx.x);
                fill_scale_tables<IND>(F, S, WSP(const float, WS_RSSA), WSP(const float, WS_SHW1) + (size_t)l * 17 * IND);
                pg8::EpiScale<0, IND, true> E{WSP(bf16, WS_PROJ), (const LAS float*)(F.lds + TBL_OFF), PROBE_V};

#ifndef NO_G0
                pg8::gemm_phase<pg8::EpiScale<0, IND, true>, pg8::Order, true, true>(F.lds + RING_OFF, g, S, E, F.tid);
#endif

            } else if (k == 1) {

#ifndef NO_LRU
                lru_seq_phase(F, l, last);
#ifdef REP_LRU0
                __syncthreads(); lru_seq_phase(F, l, last);
#endif
#endif

                __syncthreads();
#ifndef NO_CONV
                conv_phase(F, l, last ? 1024 : 1152);
                __syncthreads();
#ifdef REP_CONV
                conv_phase(F, l, last ? 1024 : 1152);
                __syncthreads();
#endif
#endif
#ifndef NO_NA
#ifdef REP_NA
                na_phase(F, l, last ? NA_ITEMS_LAT : NA_ITEMS_LAT + NA_ITEMS_CTX, REP_NA);
#else
                na_phase(F, l, last ? NA_ITEMS_LAT : NA_ITEMS_LAT + NA_ITEMS_CTX);
#endif
#ifdef REP_NA
                __syncthreads(); na_phase(F, l, last ? NA_ITEMS_LAT : NA_ITEMS_LAT + NA_ITEMS_CTX, 0);
#endif
#endif
            } else if (k == 4 || k == 6) {
                const bool dn = (k == 6);
                const int ln = (dn && !last) ? l + 1 : l;
                pg8::Gemm g{dn ? WSP(const bf16, WS_HID) : WSP(const bf16, WS_MIX), dn ? WSP(const bf16, WS_W2) + (size_t)l * D * FF : WSP(const bf16, WS_WOUT) + (size_t)l * D * D, Mx, D, dn ? FF : D};
                const bool splitk = dn && !last;
                pg8::Order S; S.init(splitk ? ML : Mx, D, dn ? WGM_DN : WGM_OUT, 0, 0, F.G, (int)blockIdx.x);
                const float* go_g = dn ? INP(5) + l * D : INP(4) + l * D;
                const float* go_s = MOD + (size_t)l * 17 * MODW + (dn ? 4 : 1) * D;
                const bool fin = dn && last;
                fill_res_tables(F, S, MOD + (size_t)l * 17 * MODW + (dn ? 5 : 2) * D, fin ? INP(24) : (dn ? INP(4) : INP(5)) + ln * D, fin ? WSP(const float, WS_ZERO) : MOD + (size_t)ln * 17 * MODW + (dn ? 1 : 4) * D, go_g, go_s);
                pg8::EpiRes<RES_NB> E{(const LAS float*)(F.lds + TBL_OFF), WSP(bf16, WS_XA), dn ? WSP(float, WS_RSSA) : WSP(float, WS_RSSB)};
#ifndef NO_GR
                pg8::gemm_phase<pg8::EpiRes<RES_NB>, pg8::Order, true, true>(F.lds + RING_OFF, g, S, E, F.tid);
                if (splitk) {
                    pg8::Order S2; S2.init(ML, 0, 4, (MC / 256) * 16, 2, F.G, (int)blockIdx.x);
                    pg8::EpiSlab E2{WSP(float, WS_PART), MOD + ((size_t)l * 17 + NB) * MODW + 5 * D};
                    pg8::gemm_phase<pg8::EpiSlab, pg8::Order, true, true, true>(F.lds + RING_OFF, g, S2, E2, F.tid);
                }
#endif
            } else if (k == 5) {
                pg8::Gemm g{WSP(const bf16, WS_XA), WSP(const bf16, WS_W1) + (size_t)l * FF * D, Mx, FF, D};
                pg8::Order S; S.init(Mx, FF, WGM_UP, 0, 0, F.G, (int)blockIdx.x);
                fill_scale_tables<FF>(F, S, WSP(const float, WS_RSSB), WSP(const float, WS_SHW2) + (size_t)l * 17 * FF);
                pg8::EpiScale<1, FF> E{WSP(bf16, WS_HID), (const LAS float*)(F.lds + TBL_OFF), PROBE_V};

#ifndef NO_G1
                pg8::gemm_phase<pg8::EpiScale<1, FF>, pg8::Order, true, true>(F.lds + RING_OFF, g, S, E, F.tid);
#endif

            }
        }
#ifdef PROBE_MASK
        if (((PROBE_MASK >> ph) & 1) && !rep_done) { rep_done = true; xcd_barrier(bar, F.tid); --ph; continue; }
        rep_done = false;
#endif
        if (ph + 1 < hi) xcd_barrier(bar, F.tid);
#ifdef PROBE_BAR2
        if (ph + 1 < hi) xcd_barrier(bar, F.tid);
#endif
    }
}

extern "C" void kernel_launch(void* const* d_in, const int* in_sizes, int n_in, void* d_out, int out_size, void* d_ws, size_t ws_size, hipStream_t stream) {
    static int grid = 0;
    if (grid == 0) {
        if (n_in != 25 || out_size != ML * D || ws_size < WS_END) { fprintf(stderr, "kernel_launch: unexpected shapes (n_in %d out %d ws %zu)\n", n_in, out_size, ws_size); grid = -1; return; }
        int dev = 0, cus = 0;
        if (hipGetDevice(&dev) != hipSuccess || hipDeviceGetAttribute(&cus, hipDeviceAttributeMultiprocessorCount, dev) != hipSuccess) { grid = -1; return; }
        if (hipFuncSetAttribute((const void*)mega_fwd, hipFuncAttributeMaxDynamicSharedMemorySize, LDS_BYTES) != hipSuccess) { fprintf(stderr, "kernel_launch: hipFuncSetAttribute failed\n"); grid = -1; return; }
        int per_cu = 0;
        if (hipOccupancyMaxActiveBlocksPerMultiprocessor(&per_cu, (const void*)mega_fwd, NWAVES * 64, LDS_BYTES) != hipSuccess || per_cu < 1) fprintf(stderr, "kernel_launch: occupancy query reports %d\n", per_cu);
        (void)hipGetLastError();
        grid = cus;
    }
    if (grid < 0) return;
    if (hipMemsetAsync((char*)d_ws + WS_CTL, 0, CTL_ZERO_BYTES, stream) != hipSuccess) return;
    Args a{};
    for (int i = 0; i < 25; ++i) a.in[i] = (const float*)d_in[i];
    a.out = (float*)d_out; a.ws = (unsigned char*)d_ws;
#if MK_N_LAUNCHES == 1
    a.ph_lo = 0; a.ph_hi = N_PHASES;
    hipLaunchKernelGGL(mega_fwd, dim3(grid), dim3(NWAVES * 64), LDS_BYTES, stream, a);
#else
    for (int ph = 0; ph < N_PHASES; ++ph) { a.ph_lo = ph; a.ph_hi = ph + 1; hipLaunchKernelGGL(mega_fwd, dim3(grid), dim3(NWAVES * 64), LDS_BYTES, stream, a); }
#endif
}
```

```cpp
#include <hip/hip_runtime.h>
#include <cstdio>
#include <cstdint>

constexpr int D = 1024, NB = 16, SEQ = 2048, CTXL = 256, DEPTH = 2;
constexpr int ML = NB * SEQ, MC = NB * CTXL, MT = ML + MC;
constexpr int IND = 2560, FF = 4096, NH = 8, HD = 64;
constexpr int MODW = 6 * D;
constexpr float EPS = 1e-6f;
#ifndef MK_N_LAUNCHES
#define MK_N_LAUNCHES 1
#endif

namespace pg8 {
#define PG8_LAS __attribute__((address_space(3)))
typedef unsigned short bf16_t;
typedef short bf16x8 __attribute__((ext_vector_type(8)));
typedef float f32x4 __attribute__((ext_vector_type(4)));
typedef unsigned u32x4 __attribute__((ext_vector_type(4)));
constexpr int BM = 256, BK = 64, HALF = 128, HTB = HALF * BK * 2, STAGE_BYTES = 8 * HTB, NXCD = 8;
constexpr int TBL_UNITS = 9;

__host__ __device__ __forceinline__ int lds_byte(int r, int c) { const int st = (r >> 4) * 2 + (c >> 5), rr = r & 15, cc = c & 31, ob = rr * 64 + cc * 2; return st * 1024 + (ob ^ (((ob >> 9) & 1) << 5)); }
__host__ __device__ __forceinline__ void stage_rc(int b, int& R, int& C) { const int st = b / 1024, sb = b % 1024, swz = sb ^ (((sb >> 9) & 1) << 5); R = (st >> 1) * 16 + swz / 64; C = (st & 1) * 32 + (swz % 64) / 2; }
__host__ __device__ __forceinline__ int perm32(int rho) { const int n = rho >> 4, i = rho & 15; return 8 * (i >> 2) + 4 * n + (i & 3); }

struct Unit { int pm, pn; };
struct Gemm { const bf16_t* A; const bf16_t* Bt; int M, N, K; };

__host__ __device__ __forceinline__ void map_tile(int wgid, int nM, int nN, int WGM, Unit& u) {
    const int nwg = nM * nN;
    { const int q = nwg / NXCD, r = nwg % NXCD, xcd = wgid % NXCD, off = wgid / NXCD; wgid = (xcd < r ? xcd * (q + 1) : r * (q + 1) + (xcd - r) * q) + off; }
    const int nig = WGM * nN, gid = wgid / nig, fm = gid * WGM, gsz = (nM - fm) < WGM ? (nM - fm) : WGM;
    u.pm = fm + ((wgid % nig) % gsz); u.pn = (wgid % nig) / gsz;
}
struct Order {
    int nM, nN, nwg, extra, mode, wgm, G, c;
    __host__ __device__ void init(int M, int N, int wgm_, int extra_, int mode_, int G_, int c_) { nM = M / BM; nN = N / BM; nwg = nM * nN; extra = extra_; mode = mode_; wgm = wgm_; G = G_; c = c_; }
    __host__ __device__ bool next(int i, Unit& u) const {
        const long L = (long)i * G + c;
        if (L < nwg) { map_tile((int)L, nM, nN, wgm, u); return true; }
        if (L < nwg + extra) { const int q = (int)L - nwg;
            if (mode == 1) { u.pm = nM + q / 5; u.pn = 4 + q % 5; }
            else { u.pm = nM + (q >> 4); u.pn = 4 + 4 * (q & 3) + ((q >> 2) & 3); }
            return true; }
        return false;
    }
    __device__ __forceinline__ void a_ready(const Unit&) const {}
    __device__ __forceinline__ void done(const Unit&) const {}
};

__device__ __forceinline__ unsigned cvt_pk_bf16(float lo, float hi) { unsigned r; asm volatile("v_cvt_pk_bf16_f32 %0, %1, %2" : "=v"(r) : "v"(lo), "v"(hi)); return r; }

template <int ACT, int LDC, bool GLU = false> struct EpiScale {
    static constexpr bool PERM = true, AFTER_DRAIN = false;
    bf16_t* O;
    const PG8_LAS float* tbl;
    int probe;
    __device__ __forceinline__ void operator()(const f32x4 (&acc)[2][2][4][2], const Unit& u, int wr, int wc, int fr, int fq, int ui) const {
        asm volatile("" : "+s"(wr), "+s"(wc));
        bf16_t* Ot = O + (size_t)u.pm * BM * LDC + u.pn * BM;
        unsigned cl = (unsigned)(wc * 32 + 8 * fq);
        unsigned rl0 = (unsigned)(wr * 64 + fr);
        asm volatile("" : "+v"(cl), "+v"(rl0));
        const PG8_LAS float* rst = tbl + ui * 256, * sht = tbl + TBL_UNITS * 256 + ui * 256;
        f32x4 sh[2][2]; float rs[2][4];
#pragma unroll
        for (int ai = 0; ai < 2; ++ai)
#pragma unroll
            for (int m = 0; m < 4; ++m) rs[ai][m] = rst[rl0 + (unsigned)(ai * HALF + m * 16)];
#pragma unroll
        for (int bj = 0; bj < 2; ++bj) { sh[bj][0] = *(const PG8_LAS f32x4*)(sht + (cl + (unsigned)(bj * HALF))); sh[bj][1] = *(const PG8_LAS f32x4*)(sht + (cl + (unsigned)(bj * HALF + 4))); }
        if (GLU && u.pn < 2) {
#pragma unroll
            for (int ai = 0; ai < 2; ++ai)
#pragma unroll
                for (int m = 0; m < 4; ++m) {
                    const f32x4 a0 = acc[ai][0][m][0] * rs[ai][m] + sh[0][0], a1 = acc[ai][0][m][1] * rs[ai][m] + sh[0][1];
                    const f32x4 g0 = acc[ai][1][m][0] * rs[ai][m] + sh[1][0], g1 = acc[ai][1][m][1] * rs[ai][m] + sh[1][1];
                    f32x4 v0, v1;
#pragma unroll
                    for (int e = 0; e < 4; ++e) { v0[e] = a0[e] * __builtin_amdgcn_rcpf(1.f + __builtin_amdgcn_exp2f(-1.4426950408889634f * g0[e])); v1[e] = a1[e] * __builtin_amdgcn_rcpf(1.f + __builtin_amdgcn_exp2f(-1.4426950408889634f * g1[e])); }
                    u32x4 w; w.x = cvt_pk_bf16(v0[0], v0[1]); w.y = cvt_pk_bf16(v0[2], v0[3]); w.z = cvt_pk_bf16(v1[0], v1[1]); w.w = cvt_pk_bf16(v1[2], v1[3]);
                    *(u32x4*)(O + (size_t)u.pm * BM * LDC + u.pn * HALF + ((rl0 + (unsigned)(ai * HALF + m * 16)) * (unsigned)LDC + cl)) = w;
                }
            return;
        }
#pragma unroll
        for (int bj = 0; bj < 2; ++bj)
#pragma unroll
            for (int ai = 0; ai < 2; ++ai)
#pragma unroll
                for (int m = 0; m < 4; ++m) {
                    f32x4 v0 = acc[ai][bj][m][0] * rs[ai][m] + sh[bj][0], v1 = acc[ai][bj][m][1] * rs[ai][m] + sh[bj][1];
                    if (ACT == 1) {
#pragma unroll
                        for (int e = 0; e < 4; ++e) { const float a = fmaxf(v0[e], 0.f), b = fmaxf(v1[e], 0.f); v0[e] = a * a; v1[e] = b * b; }
                    }
                    u32x4 w; w.x = cvt_pk_bf16(v0[0], v0[1]); w.y = cvt_pk_bf16(v0[2], v0[3]); w.z = cvt_pk_bf16(v1[0], v1[1]); w.w = cvt_pk_bf16(v1[2], v1[3]);
                    if (probe == 0) *(u32x4*)(Ot + ((rl0 + (unsigned)(ai * HALF + m * 16)) * (unsigned)LDC + cl + (unsigned)(bj * HALF))) = w;
                    else asm volatile("" :: "v"(w));
                }
    }
};
template <int NB_> struct EpiRes {
    static constexpr bool PERM = true, AFTER_DRAIN = false;
    const PG8_LAS float* tbl;
    bf16_t* XA; float* RSS;
    __device__ __forceinline__ void operator()(const f32x4 (&acc)[2][2][4][2], const Unit& u, int wr, int wc, int fr, int fq, int ui) const {
        asm volatile("" : "+s"(wr), "+s"(wc));
        bf16_t* XAt = XA + (size_t)u.pm * BM * D + u.pn * BM;
        float* RSSt = RSS + (size_t)u.pm * BM * 32 + u.pn * 8 + wc;
        unsigned cl = (unsigned)(wc * 32 + 8 * fq);
        unsigned rl0 = (unsigned)(wr * 64 + fr);
        asm volatile("" : "+v"(cl), "+v"(rl0));
        const PG8_LAS float* gT = tbl + ui * 256, * mT = tbl + (TBL_UNITS + ui) * 256, * iT = tbl + (2 * TBL_UNITS + ui) * 256;
        constexpr int BJB = 2 / NB_;
#pragma unroll
        for (int b0 = 0; b0 < 2; b0 += BJB) {
            u32x4 xb[BJB][2][4];
#pragma unroll
            for (int bb = 0; bb < BJB; ++bb)
#pragma unroll
                for (int ai = 0; ai < 2; ++ai)
#pragma unroll
                    for (int m = 0; m < 4; ++m) xb[bb][ai][m] = *(const u32x4*)(XAt + ((rl0 + (unsigned)(ai * HALF + m * 16)) * (unsigned)D + cl + (unsigned)((b0 + bb) * HALF)));
            asm volatile("" ::: "memory");
#pragma unroll
            for (int bb = 0; bb < BJB; ++bb) {
                const int bj = b0 + bb;
                const unsigned c = cl + (unsigned)(bj * HALF);
                const f32x4 g0 = *(const PG8_LAS f32x4*)(gT + c), g1 = *(const PG8_LAS f32x4*)(gT + (c + 4u)), m0 = *(const PG8_LAS f32x4*)(mT + c), m1 = *(const PG8_LAS f32x4*)(mT + (c + 4u)),
                            r0 = *(const PG8_LAS f32x4*)(iT + c), r1 = *(const PG8_LAS f32x4*)(iT + (c + 4u));
#pragma unroll
                for (int ai = 0; ai < 2; ++ai)
#pragma unroll
                    for (int m = 0; m < 4; ++m) {
                        const unsigned rl = rl0 + (unsigned)(ai * HALF + m * 16);
                        const u32x4 w = xb[bb][ai][m];
                        const f32x4 x0 = (f32x4){__uint_as_float(w.x << 16), __uint_as_float(w.x & 0xffff0000u), __uint_as_float(w.y << 16), __uint_as_float(w.y & 0xffff0000u)} * r0;
                        const f32x4 x1 = (f32x4){__uint_as_float(w.z << 16), __uint_as_float(w.z & 0xffff0000u), __uint_as_float(w.w << 16), __uint_as_float(w.w & 0xffff0000u)} * r1;
                        const f32x4 y0 = x0 + g0 * acc[ai][bj][m][0], y1 = x1 + g1 * acc[ai][bj][m][1];
                        float ss = ((y0[0] * y0[0] + y0[1] * y0[1]) + (y0[2] * y0[2] + y0[3] * y0[3])) + ((y1[0] * y1[0] + y1[1] * y1[1]) + (y1[2] * y1[2] + y1[3] * y1[3]));
                        ss += __shfl_xor(ss, 16); ss += __shfl_xor(ss, 32);
                        if (fq == 0) RSSt[rl * 32u + (unsigned)(bj * 4)] = ss;
                        const f32x4 a0 = y0 * m0, a1 = y1 * m1;
                        u32x4 o; o.x = cvt_pk_bf16(a0[0], a0[1]); o.y = cvt_pk_bf16(a0[2], a0[3]); o.z = cvt_pk_bf16(a1[0], a1[1]); o.w = cvt_pk_bf16(a1[2], a1[3]);
                        *(u32x4*)(XAt + (rl * (unsigned)D + c)) = o;
                    }
            }
            asm volatile("" ::: "memory");
        }
    }
};

struct EpiSlab {
    static constexpr bool PERM = true, AFTER_DRAIN = false;
    float* P; const float* gate;
    __device__ __forceinline__ void operator()(const f32x4 (&acc)[2][2][4][2], const Unit& u, int wr, int wc, int fr, int fq, int) const {
        asm volatile("" : "+s"(wr), "+s"(wc));
        const int ks = (u.pn - 4) >> 2, pn = u.pn & 3;
        float* At = P + ((size_t)ks * MC + (size_t)(u.pm - ML / BM) * BM) * D + pn * BM;
        const float* gtq = gate + pn * BM;
        unsigned cl = (unsigned)(wc * 32 + 8 * fq), rl0 = (unsigned)(wr * 64 + fr);
        asm volatile("" : "+v"(cl), "+v"(rl0));
        f32x4 gv[2][2];
#pragma unroll
        for (int bj = 0; bj < 2; ++bj) { gv[bj][0] = *(const f32x4*)(gtq + (cl + (unsigned)(bj * HALF))); gv[bj][1] = *(const f32x4*)(gtq + (cl + (unsigned)(bj * HALF + 4))); }
#pragma unroll
        for (int bj = 0; bj < 2; ++bj) { const unsigned c = cl + (unsigned)(bj * HALF);
#pragma unroll
            for (int ai = 0; ai < 2; ++ai)
#pragma unroll
                for (int m = 0; m < 4; ++m) { const unsigned off = (rl0 + (unsigned)(ai * HALF + m * 16)) * (unsigned)D + c;
                    *(f32x4*)(At + off) = gv[bj][0] * acc[ai][bj][m][0]; *(f32x4*)(At + (off + 4u)) = gv[bj][1] * acc[ai][bj][m][1]; } }
    }
};

template <class Epi, class Sched, bool ALIGN_EPI = false, bool SP2 = false, bool VARK = false>
__device__ __forceinline__ void gemm_phase(PG8_LAS unsigned char* lds, const Gemm g, const Sched& S, const Epi& E, const int tid) {
    const int wid = __builtin_amdgcn_readfirstlane(tid >> 6), lane = tid & 63, wr = wid >> 2, wc = wid & 3, fr = lane & 15, fq = lane >> 4;
    const int K = g.K;
    unsigned voffA[2], voffB[2];
#pragma unroll
    for (int i = 0; i < 2; ++i) { int R, C; stage_rc(tid * 16 + i * 8192, R, C); const int Rb = Epi::PERM ? ((R & ~31) + perm32(R & 31)) : R;
        voffA[i] = (unsigned)(R * K + C) * 2u; voffB[i] = (unsigned)(Rb * K + C) * 2u; }
    const size_t kstep = (size_t)(BK * 2);
    const size_t hstep = (size_t)HALF * K * 2;
    const size_t tstep = 2 * hstep;
    const unsigned ldsw = (unsigned)wid * 1024u;
    const int aoff = lds_byte(wr * 64 + fr, fq * 8), boff = lds_byte(wc * 32 + fr, fq * 8);
#define PG8_SA(b, h) (((b) * 2 + (h)) * HTB)
#define PG8_SB(b, h) ((4 + (b) * 2 + (h)) * HTB)
#define PG8_STAGE(bufoff, gbase, voff) do { _Pragma("unroll") for (int _i = 0; _i < 2; ++_i) \
        __builtin_amdgcn_global_load_lds((const unsigned*)((const char*)(gbase) + (voff)[_i]), (PG8_LAS unsigned*)(lds + (bufoff) + ldsw + _i * 8192), 16, 0, 0); } while (0)
#define PG8_LDA(dst, b, h) do { _Pragma("unroll") for (int m = 0; m < 4; ++m) _Pragma("unroll") for (int k = 0; k < 2; ++k) dst[m][k] = *(const PG8_LAS bf16x8*)(lds + PG8_SA(b, h) + aoff + m * 2048 + k * 1024); } while (0)
#define PG8_LDB(dst, b, h) do { _Pragma("unroll") for (int n = 0; n < 2; ++n) _Pragma("unroll") for (int k = 0; k < 2; ++k) dst[n][k] = *(const PG8_LAS bf16x8*)(lds + PG8_SB(b, h) + boff + n * 2048 + k * 1024); } while (0)
#define PG8_MMA(ai, bj, At, Bt) do { __builtin_amdgcn_s_setprio(1); _Pragma("unroll") for (int m = 0; m < 4; ++m) _Pragma("unroll") for (int n = 0; n < 2; ++n) _Pragma("unroll") for (int k = 0; k < 2; ++k) \
        acc[ai][bj][m][n] = __builtin_amdgcn_mfma_f32_16x16x32_bf16(Bt[n][k], At[m][k], acc[ai][bj][m][n], 0, 0, 0); __builtin_amdgcn_s_setprio(0); } while (0)
#define PG8_WAIT_V(n) asm volatile("s_waitcnt vmcnt(" #n ")" ::: "memory")
#define PG8_WAIT_L(n) asm volatile("s_waitcnt lgkmcnt(" #n ")" ::: "memory")
#define PG8_BAR __builtin_amdgcn_s_barrier()
#define PG8_SCHED __builtin_amdgcn_sched_barrier(0)
    Unit cur, nxt; int ui = 0;
    if (!S.next(0, cur)) return;
    cur.pm = __builtin_amdgcn_readfirstlane(cur.pm); cur.pn = __builtin_amdgcn_readfirstlane(cur.pn);
    f32x4 acc[2][2][4][2];
#pragma unroll
    for (int a = 0; a < 2; ++a)
#pragma unroll
        for (int b = 0; b < 2; ++b)
#pragma unroll
            for (int m = 0; m < 4; ++m)
#pragma unroll
                for (int n = 0; n < 2; ++n) acc[a][b][m][n] = (f32x4){0.f, 0.f, 0.f, 0.f};
    bf16x8 At[4][2], B0[2][2], B1[2][2];
#define PG8_KOFF(u) ((VARK && (u).pn >= 4) ? (size_t)(((u).pn - 4) >> 2) * (size_t)(K / 4) * 2 : (size_t)0)
#define PG8_PN(u) ((VARK && (u).pn >= 4) ? ((u).pn & 3) : (u).pn)
    const char* cA = (const char*)g.A + (size_t)cur.pm * tstep + PG8_KOFF(cur); const char* cB = (const char*)g.Bt + (size_t)PG8_PN(cur) * tstep + PG8_KOFF(cur);
    S.a_ready(cur);
    if constexpr (SP2) {
        PG8_STAGE(PG8_SB(0, 0), cB, voffB); PG8_STAGE(PG8_SB(0, 1), cB + hstep, voffB); PG8_STAGE(PG8_SA(0, 0), cA, voffA); PG8_STAGE(PG8_SA(0, 1), cA + hstep, voffA);
        if (wr == 1) PG8_BAR;
        PG8_WAIT_V(2); PG8_BAR;
        PG8_STAGE(PG8_SB(1, 0), cB + kstep, voffB); PG8_STAGE(PG8_SA(1, 0), cA + kstep, voffA); PG8_STAGE(PG8_SB(1, 1), cB + hstep + kstep, voffB);
        PG8_WAIT_V(6); PG8_BAR;
    } else {
        PG8_STAGE(PG8_SB(0, 0), cB, voffB); PG8_STAGE(PG8_SA(0, 0), cA, voffA); PG8_STAGE(PG8_SB(0, 1), cB + hstep, voffB); PG8_STAGE(PG8_SA(0, 1), cA + hstep, voffA);
        if (wr == 1) PG8_BAR;
        PG8_WAIT_V(4); PG8_BAR;
        PG8_STAGE(PG8_SB(1, 0), cB + kstep, voffB); PG8_STAGE(PG8_SA(1, 0), cA + kstep, voffA); PG8_STAGE(PG8_SB(1, 1), cB + hstep + kstep, voffB);
        PG8_WAIT_V(6); PG8_BAR;
    }
    for (;;) {
        const bool has_next = S.next(ui + 1, nxt);
        nxt.pm = __builtin_amdgcn_readfirstlane(nxt.pm); nxt.pn = __builtin_amdgcn_readfirstlane(nxt.pn);
        const char* nA = has_next ? (const char*)g.A + (size_t)nxt.pm * tstep + PG8_KOFF(nxt) : cA; const char* nB = has_next ? (const char*)g.Bt + (size_t)PG8_PN(nxt) * tstep + PG8_KOFF(nxt) : cB;
        const int nt = (VARK && cur.pn >= 4) ? K / BK / 4 : K / BK;
        for (int t = 0; t < nt; t += 2) {
            const bool last = (t == nt - 2);
            const char* a1 = cA + (size_t)(t + 1) * kstep;
            const char* a2 = last ? nA : cA + (size_t)(t + 2) * kstep; const char* b2 = last ? nB : cB + (size_t)(t + 2) * kstep;
            const char* a3 = a2 + kstep; const char* b3 = b2 + kstep;
            if (last && has_next) S.a_ready(nxt);
            if constexpr (SP2) {
            PG8_LDB(B0, 0, 0); PG8_LDB(B1, 0, 1); PG8_SCHED; PG8_LDA(At, 0, 0); PG8_STAGE(PG8_SA(1, 1), a1 + hstep, voffA);
            PG8_WAIT_V(8); PG8_WAIT_L(0); PG8_BAR; PG8_MMA(0, 0, At, B0); PG8_MMA(0, 1, At, B1); PG8_BAR; PG8_SCHED;
            PG8_LDA(At, 0, 1); PG8_STAGE(PG8_SB(0, 0), b2, voffB); PG8_STAGE(PG8_SB(0, 1), b2 + hstep, voffB); PG8_STAGE(PG8_SA(0, 0), a2, voffA);
            PG8_WAIT_V(8); PG8_WAIT_L(0); PG8_BAR; PG8_MMA(1, 0, At, B0); PG8_MMA(1, 1, At, B1); PG8_BAR; PG8_SCHED;
            PG8_LDB(B0, 1, 0); PG8_LDB(B1, 1, 1); PG8_SCHED; PG8_LDA(At, 1, 0); PG8_STAGE(PG8_SA(0, 1), a2 + hstep, voffA);
            PG8_WAIT_V(8); PG8_WAIT_L(0); PG8_BAR; PG8_MMA(0, 0, At, B0); PG8_MMA(0, 1, At, B1); PG8_BAR; PG8_SCHED;
            PG8_LDA(At, 1, 1); PG8_STAGE(PG8_SB(1, 0), b3, voffB); PG8_STAGE(PG8_SB(1, 1), b3 + hstep, voffB); PG8_STAGE(PG8_SA(1, 0), a3, voffA);
            PG8_WAIT_V(8); PG8_WAIT_L(0); PG8_BAR; PG8_MMA(1, 0, At, B0); PG8_MMA(1, 1, At, B1); PG8_BAR; PG8_SCHED;
            } else {
            PG8_LDB(B0, 0, 0); PG8_SCHED; PG8_LDA(At, 0, 0); PG8_STAGE(PG8_SA(1, 1), a1 + hstep, voffA);
            PG8_WAIT_L(8); PG8_BAR; PG8_WAIT_L(0); PG8_MMA(0, 0, At, B0); PG8_BAR; PG8_SCHED;
            PG8_LDB(B1, 0, 1); PG8_STAGE(PG8_SB(0, 0), b2, voffB);
            PG8_BAR; PG8_WAIT_L(0); PG8_MMA(0, 1, At, B1); PG8_BAR;
            PG8_LDA(At, 0, 1); PG8_STAGE(PG8_SA(0, 0), a2, voffA);
            PG8_BAR; PG8_WAIT_L(0); PG8_MMA(1, 0, At, B0); PG8_BAR; PG8_SCHED;
            PG8_STAGE(PG8_SB(0, 1), b2 + hstep, voffB);
            PG8_WAIT_V(6); PG8_BAR; PG8_MMA(1, 1, At, B1); PG8_BAR;
            PG8_LDB(B0, 1, 0); PG8_SCHED; PG8_LDA(At, 1, 0); PG8_STAGE(PG8_SA(0, 1), a2 + hstep, voffA);
            PG8_WAIT_L(8); PG8_BAR; PG8_WAIT_L(0); PG8_MMA(0, 0, At, B0); PG8_BAR; PG8_SCHED;
            PG8_LDB(B1, 1, 1); PG8_STAGE(PG8_SB(1, 0), b3, voffB);
            PG8_BAR; PG8_WAIT_L(0); PG8_MMA(0, 1, At, B1); PG8_BAR;
            PG8_LDA(At, 1, 1); PG8_STAGE(PG8_SA(1, 0), a3, voffA);
            PG8_BAR; PG8_WAIT_L(0); PG8_MMA(1, 0, At, B0); PG8_BAR; PG8_SCHED;
            PG8_STAGE(PG8_SB(1, 1), b3 + hstep, voffB);
            PG8_WAIT_V(6); PG8_BAR; PG8_MMA(1, 1, At, B1); PG8_BAR;
            }
        }
        if constexpr (ALIGN_EPI) { if (wr == 0) PG8_BAR; }
        if constexpr (!Epi::AFTER_DRAIN) { E(acc, cur, wr, wc, fr, fq, ui); S.done(cur); }
        if (!has_next) break;
#pragma unroll
        for (int a = 0; a < 2; ++a)
#pragma unroll
            for (int b = 0; b < 2; ++b)
#pragma unroll
                for (int m = 0; m < 4; ++m)
#pragma unroll
                    for (int n = 0; n < 2; ++n) acc[a][b][m][n] = (f32x4){0.f, 0.f, 0.f, 0.f};
        cur = nxt; cA = nA; cB = nB; ++ui;
        if constexpr (ALIGN_EPI) { if (wr == 1) PG8_BAR; }
    }
    PG8_WAIT_V(0);
    if constexpr (!ALIGN_EPI) { if (wr == 0) PG8_BAR; }
    PG8_BAR;
    if constexpr (Epi::AFTER_DRAIN) { E.fused(acc, cur, wr, wc, fr, fq, lds, wid, lane); S.done(cur); }
#undef PG8_KOFF
#undef PG8_PN
#undef PG8_SA
#undef PG8_SB
#undef PG8_STAGE
#undef PG8_LDA
#undef PG8_LDB
#undef PG8_MMA
#undef PG8_WAIT_V
#undef PG8_WAIT_L
#undef PG8_BAR
#undef PG8_SCHED
}
}

constexpr size_t MiB = 1u << 20;
constexpr size_t WS_CTL = 0, CTL_ZERO_BYTES = 1 * MiB;
constexpr size_t WS_MOD = 1 * MiB;
constexpr size_t WS_SHW1 = 2 * MiB;
constexpr size_t WS_SHW2 = 3 * MiB;
constexpr size_t WS_RSSA = 4 * MiB;
constexpr size_t WS_RSSB = 9 * MiB;
constexpr size_t WS_TOT = 14 * MiB;
constexpr size_t WS_CARRY = 19 * MiB;
constexpr size_t WS_WLR = 21 * MiB + 512 * 1024;
constexpr size_t WS_WIN = 22 * MiB;
constexpr size_t WS_WOUT = 32 * MiB;
constexpr size_t WS_W1 = 36 * MiB;
constexpr size_t WS_W2 = 52 * MiB;
constexpr size_t WS_CX = 68 * MiB;
constexpr size_t WS_XA = 84 * MiB;
constexpr size_t WS_HID = 156 * MiB;
constexpr size_t WS_PROJ = WS_HID;
constexpr size_t WS_MIX = WS_HID + 180 * MiB;
constexpr size_t WS_PART = 444 * MiB;
constexpr size_t WS_AB = 436 * MiB;
constexpr size_t WS_END = 508 * MiB;
static_assert(WS_MIX + (size_t)MT * D * 2 <= WS_PART && WS_HID + (size_t)MT * FF * 2 == WS_PART && WS_PART + (size_t)4 * MC * D * 4 == WS_END && WS_AB >= WS_MIX + (size_t)MT * D * 2 && WS_AB + (size_t)1152 * 2 * 2 * 8 * 2 * 64 * 16 == WS_END, "ws map");
constexpr size_t WS_ZERO = WS_CTL + 512 * 1024;
constexpr int CW_BAR = 4096;

#ifndef WGM_IN
#define WGM_IN 4
#endif
#ifndef WGM_OUT
#define WGM_OUT 4
#endif
#ifndef WGM_UP
#define WGM_UP 4
#endif
#ifndef WGM_DN
#define WGM_DN 4
#endif
#ifndef RES_NB
#define RES_NB 2
#endif
constexpr int NWAVES = 8;
constexpr int RING_OFF = 0, RING_BYTES = 131072;
constexpr int LDSCTL_OFF = RING_BYTES, MISC_OFF = LDSCTL_OFF + 320;
constexpr int TBL_OFF = LDSCTL_OFF + 1024;
static_assert(TBL_OFF + 3 * pg8::TBL_UNITS * 256 * 4 <= 163840, "LDS map");
constexpr int LDS_BYTES = 163840;

#define GAS __attribute__((address_space(1)))
#define LAS __attribute__((address_space(3)))
typedef unsigned short bf16;
typedef unsigned v4u __attribute__((ext_vector_type(4)));
typedef unsigned v2u __attribute__((ext_vector_type(2)));
typedef float f32x4 __attribute__((ext_vector_type(4)));
typedef float f32x2 __attribute__((ext_vector_type(2)));
typedef GAS unsigned gu32;
#define LDS_WAIT() asm volatile("s_waitcnt lgkmcnt(0)" ::: "memory")
#define VM_WAIT() asm volatile("s_waitcnt vmcnt(0)" ::: "memory")
__device__ __forceinline__ unsigned f2bf(float f) { unsigned u = __builtin_bit_cast(unsigned, f); return (u + 0x7fffu + ((u >> 16) & 1u)) >> 16; }
__device__ __forceinline__ unsigned pk2(float lo, float hi) { return f2bf(lo) | (f2bf(hi) << 16); }
__device__ __forceinline__ float bflo(unsigned w) { return __uint_as_float(w << 16); }
__device__ __forceinline__ float bfhi(unsigned w) { return __uint_as_float(w & 0xffff0000u); }
__device__ __forceinline__ float bf1(bf16 v) { return __uint_as_float((unsigned)v << 16); }
__device__ __forceinline__ float sigmoidf_(float x) { return __builtin_amdgcn_rcpf(1.f + __builtin_amdgcn_exp2f(-1.4426950408889634f * x)); }
__device__ __forceinline__ float siluf_(float x) { return x * sigmoidf_(x); }
__device__ __forceinline__ float gelu_tanh(float x) { const float u = 0.7978845608028654f * (x + 0.044715f * x * x * x); return x * sigmoidf_(2.f * u); }
__device__ __forceinline__ float wave_sum(float v) {
#pragma unroll
    for (int o = 1; o < 64; o <<= 1) v += __shfl_xor(v, o);
    return v;
}

#define XB_TMO      128
#define XB_XCNT(j)  (256  + 64 * (j))
#define XB_XSUB(j)  (1280 + 64 * (j))
#define XB_XGEN(j)  (2304 + 64 * (j))
#define XB_TOP      3328
#define XB_TOPGEN   3392
#define XCD_BAR_WORDS 3456
#define XB_SPIN_CAP (1u << 18)

__device__ __forceinline__ unsigned xb_ld(unsigned* p)              { return __hip_atomic_load(p, __ATOMIC_RELAXED, __HIP_MEMORY_SCOPE_AGENT); }
__device__ __forceinline__ unsigned xb_add(unsigned* p, unsigned v) { return __hip_atomic_fetch_add(p, v, __ATOMIC_RELAXED, __HIP_MEMORY_SCOPE_AGENT); }
__device__ __forceinline__ unsigned xb_xcc_id() { return (unsigned)__builtin_amdgcn_s_getreg((3 << 11) | 20) & 0xFu; }
#define XB_SPIN(cond, bar) do { unsigned _sp = 0; while (cond) { __builtin_amdgcn_s_sleep(1); \
    if ((++_sp & 255u) == 0u) { if (xb_ld(&(bar)[XB_TMO])) break; if (_sp > XB_SPIN_CAP) { atomicAdd(&(bar)[XB_TMO], 1u); break; } } } } while (0)

struct XcdBarrier {
    unsigned* bar; unsigned x;
    volatile LAS unsigned* st;
};

__device__ __forceinline__ XcdBarrier xcd_barrier_post(unsigned* bar, volatile LAS unsigned* st, int tid) {
    XcdBarrier b; b.bar = bar; b.x = xb_xcc_id(); b.st = st;
    if (tid == 0) (void)xb_add(&bar[XB_XCNT(b.x)], 1u);
    return b;
}
__device__ __forceinline__ void xcd_barrier_complete(unsigned* bar, unsigned x, unsigned& nloc, unsigned& nx) {
    const unsigned G = gridDim.x * gridDim.y * gridDim.z;
    unsigned sum, cnt, mine, sp = 0u;
    for (;;) {
        sum = 0u; cnt = 0u; mine = 0u;
#pragma unroll 1
        for (unsigned j = 0; j < 16; ++j) { const unsigned c = xb_ld(&bar[XB_XCNT(j)]); sum += c; cnt += (c > 0u) ? 1u : 0u; mine = (j == x) ? c : mine; }
        if (sum == G) break;
        __builtin_amdgcn_s_sleep(1);
        if ((++sp & 255u) == 0u) { if (xb_ld(&bar[XB_TMO])) break; if (sp > XB_SPIN_CAP) { atomicAdd(&bar[XB_TMO], 1u); break; } }
    }
    nloc = mine > 0u ? mine : 1u; nx = cnt > 0u ? cnt : 1u;
}

__device__ __forceinline__ void xcd_barrier(const XcdBarrier& b, int tid) {
    asm volatile("s_waitcnt vmcnt(0)" ::: "memory");
    __syncthreads();
    if (tid == 0) {
        unsigned* bar = b.bar;
        __builtin_amdgcn_s_waitcnt(0);
        unsigned nloc = b.st[0], nx = b.st[1];
        if (nloc == 0u) { xcd_barrier_complete(bar, b.x, nloc, nx); b.st[0] = nloc; b.st[1] = nx; }
        const unsigned old = xb_add(&bar[XB_XSUB(b.x)], 1u);
        const unsigned gen = old / nloc;
        if (old + 1u == (gen + 1u) * nloc) {
            __builtin_amdgcn_fence(__ATOMIC_RELEASE, "agent");
            asm volatile("s_waitcnt vmcnt(0)" ::: "memory");
            const unsigned og = xb_add(&bar[XB_TOP], 1u);
            const unsigned tg = og / nx;
            if (og + 1u == (tg + 1u) * nx) xb_add(&bar[XB_TOPGEN], 1u);
            else XB_SPIN(xb_ld(&bar[XB_TOPGEN]) == tg, bar);
            __builtin_amdgcn_fence(__ATOMIC_ACQUIRE, "agent");
            xb_add(&bar[XB_XGEN(b.x)], 1u);
            asm volatile("s_waitcnt vmcnt(0)" ::: "memory");
        } else {
            XB_SPIN(xb_ld(&bar[XB_XGEN(b.x)]) == gen, bar);
            __builtin_amdgcn_fence(__ATOMIC_ACQUIRE, "agent");
            asm volatile("s_waitcnt vmcnt(0)" ::: "memory");
        }
    }
    __syncthreads();
}

struct Frame {
    LAS unsigned char* lds;
    int tid, lane, wave;
    int vcu, G;
    int gw, NGW;
    float* out; unsigned char* ws;
};
constexpr int PTR_OFF = LDSCTL_OFF + 512;
__device__ __forceinline__ const float* inp_(LAS unsigned char* lds, int i) {
    const unsigned long long v = *(const LAS unsigned long long*)(lds + PTR_OFF + 8 * i);
    const unsigned lo = __builtin_amdgcn_readfirstlane((unsigned)v), hi = __builtin_amdgcn_readfirstlane((unsigned)(v >> 32));
    return (const float*)(((unsigned long long)hi << 32) | lo);
}
#define INP(i) inp_(F.lds, (i))
#define WSP(T, off) ((T*)(F.ws + (off)))

__device__ __forceinline__ void gemv17_item(Frame& F, const LAS float* tab, LAS float* red, const float* W, int ldw, int n0, const float* bias, float* outp, int ldo, int n0out) {
    float acc[17];
#pragma unroll
    for (int r = 0; r < 17; ++r) acc[r] = 0.f;
    const int k0 = F.wave * 128;
    const float* wp = W + (size_t)k0 * ldw + n0 + F.lane;
#pragma unroll 1
    for (int kk = 0; kk < 128; kk += 32) {
        float wv[32];
#pragma unroll
        for (int k = 0; k < 32; ++k) wv[k] = wp[(size_t)(kk + k) * ldw];
#pragma unroll
        for (int k = 0; k < 32; ++k) {
#pragma unroll
            for (int r = 0; r < 17; ++r) acc[r] += tab[r * 1024 + k0 + kk + k] * wv[k];
        }
    }
#pragma unroll
    for (int r = 0; r < 17; ++r) red[(F.wave * 17 + r) * 64 + F.lane] = acc[r];
    __syncthreads();
    for (int i = F.tid; i < 17 * 64; i += NWAVES * 64) {
        const int r = i >> 6, n = i & 63; float s = bias ? bias[n0 + n] : 0.f;
#pragma unroll
        for (int w = 0; w < 8; ++w) s += red[(w * 17 + r) * 64 + n];
        outp[(size_t)r * ldo + n0out + n] = s;
    }
    __syncthreads();
}

__host__ __device__ __forceinline__ int glu_col(int o) { return o >= 512 ? o : ((o >> 7) & 1) * 256 + (o >> 8) * 128 + (o & 127); }
__device__ __forceinline__ void p0_transpose_item(const float* W, int K, int N, bf16* WT, LAS float* scr, int item, int lane, bool glu) {
    const int nblk = N / 32, kb = item / nblk, nb = item % nblk, k0 = 64 * kb, n0 = 32 * nb;
    const int n0o = glu ? glu_col(n0) : n0;
    float tv[32];
#pragma unroll
    for (int i = 0; i < 32; ++i) { const int kk = 2 * i + (lane >> 5); tv[i] = W[(size_t)(k0 + kk) * N + n0 + (lane & 31)]; }
#pragma unroll
    for (int i = 0; i < 32; ++i) { const int kk = 2 * i + (lane >> 5); scr[kk * 33 + (lane & 31)] = tv[i]; }
    LDS_WAIT(); asm volatile("" ::: "memory");
    const int c = lane & 7;
#pragma unroll
    for (int j = 0; j < 4; ++j) { const int n = (lane >> 3) + 8 * j; const LAS float* s = scr + (8 * c) * 33 + n;
        v4u o; o.x = pk2(s[0 * 33], s[1 * 33]); o.y = pk2(s[2 * 33], s[3 * 33]); o.z = pk2(s[4 * 33], s[5 * 33]); o.w = pk2(s[6 * 33], s[7 * 33]);
        *(GAS v4u*)(WT + (size_t)(n0o + n) * K + k0 + 8 * c) = o; }
    LDS_WAIT(); asm volatile("" ::: "memory");
}

__device__ __forceinline__ void weight_items(Frame& F, int first, int last, int widx, int nw) {
    LAS float* scr = (LAS float*)(F.lds + F.wave * 16384);
    constexpr int I_IN = (D / 64) * (IND / 32), I_OUT = (D / 64) * (D / 32), I_1 = (D / 64) * (FF / 32), I_2 = (FF / 64) * (D / 32), I_L = I_IN + I_OUT + I_1 + I_2;
    for (int it = first + widx; it < last; it += nw) {
        const int l = it / I_L; int r = it % I_L;
        const float* W; bf16* WT; int K = D, N; const bool glu = r < I_IN;
        if (r < I_IN) { W = INP(8) + (size_t)l * D * IND; WT = WSP(bf16, WS_WIN) + (size_t)l * IND * D; N = IND; }
        else if (r < I_IN + I_OUT) { r -= I_IN; W = INP(9) + (size_t)l * D * D; WT = WSP(bf16, WS_WOUT) + (size_t)l * D * D; N = D; }
        else if (r < I_IN + I_OUT + I_1) { r -= I_IN + I_OUT; W = INP(22) + (size_t)l * D * FF; WT = WSP(bf16, WS_W1) + (size_t)l * FF * D; N = FF; }
        else { r -= I_IN + I_OUT + I_1; W = INP(23) + (size_t)l * FF * D; WT = WSP(bf16, WS_W2) + (size_t)l * D * FF; K = FF; N = D; }
        p0_transpose_item(W, K, N, WT, scr, r, F.lane, glu);
    }
}
constexpr int W_ITEMS = 2 * ((D / 64) * (IND / 32) + (D / 64) * (D / 32) + (D / 64) * (FF / 32) + (FF / 64) * (D / 32));
constexpr int W_EARLY = 64 * NWAVES * 3;

__device__ __forceinline__ void phase_p0a(Frame& F) {
    LAS float* tab = (LAS float*)(F.lds);
    LAS float* red = (LAS float*)(F.lds + 17 * 1024 * 4);
    float* MOD = WSP(float, WS_MOD);
    bool filled = false;
    for (int it = F.vcu; it < 2 * 96; it += F.G) {
        if (!filled) {
            for (int i = F.tid; i < 17 * 1024; i += NWAVES * 64) { const int r = i >> 10, k = i & 1023; const float v = (r < 16) ? INP(1)[r * D + k] : INP(3)[k]; tab[i] = siluf_(v); }
            __syncthreads(); filled = true;
        }
        const int l = it / 96, n0 = (it % 96) * 64;
        gemv17_item(F, tab, red, INP(6) + (size_t)l * D * MODW, MODW, n0, INP(7) + (size_t)l * MODW, MOD + (size_t)l * 17 * MODW, MODW, n0);
    }
    if (F.G == 256 && F.vcu >= 192) weight_items(F, 0, W_EARLY, (F.vcu - 192) * NWAVES + F.wave, 64 * NWAVES);
}

__device__ __forceinline__ void phase_p0b(Frame& F) {
    LAS float* tab = (LAS float*)(F.lds);
    LAS float* red = (LAS float*)(F.lds + 17 * 1024 * 4);
    const float* MOD = WSP(const float, WS_MOD);
    for (int it = F.vcu; it < 2 * 104; it += F.G) {
        const int l = it / 104, j = it % 104; const bool first = j < 40;
        const int shoff = first ? 0 : 3 * D;
        __syncthreads();
        for (int i = F.tid; i < 17 * 1024; i += NWAVES * 64) { const int r = i >> 10, k = i & 1023; tab[i] = MOD[((size_t)l * 17 + r) * MODW + shoff + k]; }
        __syncthreads();
        const int ldw = first ? IND : FF;
        gemv17_item(F, tab, red, first ? INP(8) + (size_t)l * D * IND : INP(22) + (size_t)l * D * FF, ldw, (first ? j : j - 40) * 64, nullptr,
                    first ? WSP(float, WS_SHW1) + (size_t)l * 17 * IND : WSP(float, WS_SHW2) + (size_t)l * 17 * FF, ldw, first ? glu_col(j * 64) : (j - 40) * 64);
    }
    bf16* XA = WSP(bf16, WS_XA); float* RSSA = WSP(float, WS_RSSA);
    const float* g1 = INP(4);
    for (int row = F.gw; row < MT; row += 2 * F.NGW) {
        f32x4 v[2][4]; float ss[2]; int rw[2]; const float* scp[2];
#pragma unroll
        for (int q = 0; q < 2; ++q) { int r_ = row + q * F.NGW; if (r_ >= MT) r_ = row; rw[q] = r_;
            const bool lat = r_ < ML;
            const float* xr = lat ? INP(0) + (size_t)r_ * D : INP(2) + (size_t)(r_ - ML) * D;
            scp[q] = MOD + (size_t)(lat ? (r_ >> 11) : NB) * MODW + D;
#pragma unroll
            for (int j = 0; j < 4; ++j) v[q][j] = *(const f32x4*)(xr + 4 * F.lane + 256 * j); }
#pragma unroll
        for (int q = 0; q < 2; ++q) { float s_ = 0.f;
#pragma unroll
            for (int j = 0; j < 4; ++j) s_ += (v[q][j][0] * v[q][j][0] + v[q][j][1] * v[q][j][1]) + (v[q][j][2] * v[q][j][2] + v[q][j][3] * v[q][j][3]);
            ss[q] = wave_sum(s_); }
#pragma unroll
        for (int q = 0; q < 2; ++q) { if (q == 1 && rw[1] == row) break;
            if (F.lane < 32) RSSA[(size_t)rw[q] * 32 + F.lane] = (F.lane == 0) ? ss[q] : 0.f;
#pragma unroll
            for (int j = 0; j < 4; ++j) { const int k = 4 * F.lane + 256 * j;
                const f32x4 gm = *(const f32x4*)(g1 + k) * (*(const f32x4*)(scp[q] + k) + 1.0f), a = v[q][j] * gm;
                v2u o; o.x = pk2(a[0], a[1]); o.y = pk2(a[2], a[3]); *(v2u*)(XA + (size_t)rw[q] * D + k) = o; } }
    }
    __syncthreads();
    {
        bf16* WLR = WSP(bf16, WS_WLR);
        for (int i = F.gw * 64 + F.lane; i < 2 * 2 * 4 * 2 * 4096; i += F.NGW * 64) { const int d = i & 63, e = (i >> 6) & 63, gt = (i >> 12) & 1, blk = i >> 13;
            const float* src = gt == 0 ? INP(17) : INP(19); WLR[i] = (bf16)f2bf(src[((size_t)blk * 64 + d) * 64 + e]); }
    }
    weight_items(F, (F.G == 256) ? W_EARLY : 0, W_ITEMS, F.gw, F.NGW);
}

constexpr int CV_OSROW = 260;
__device__ __forceinline__ void conv_phase(Frame& F, int l, int ntiles) {
    const bf16* PROJ = WSP(const bf16, WS_PROJ); bf16* MIX = WSP(bf16, WS_MIX);
    LAS float* us = (LAS float*)(F.lds);
    LAS float* os = (LAS float*)(F.lds + 62 * 256 * 4);
    const int c = F.tid & 255, half = F.tid >> 8;
    float w[31];
#pragma unroll
    for (int k = 0; k < 31; ++k) w[k] = INP(10)[((size_t)l * 31 + k) * 256 + c];
    const float cbias = INP(11)[l * 256 + c];
    const int lt = F.tid >> 4, lseg = F.tid & 15;
    f32x4 lg[4], lb[4];
#pragma unroll
    for (int q = 0; q < 4; ++q) { lg[q] = *(const f32x4*)(INP(12) + l * 256 + 16 * lseg + 4 * q); lb[q] = *(const f32x4*)(INP(13) + l * 256 + 16 * lseg + 4 * q); }
    auto row16_sum = [](float v) -> float {
        v += __builtin_bit_cast(float, __builtin_amdgcn_update_dpp(0, __builtin_bit_cast(int, v), 0xB1, 0xf, 0xf, true));
        v += __builtin_bit_cast(float, __builtin_amdgcn_update_dpp(0, __builtin_bit_cast(int, v), 0x4E, 0xf, 0xf, true));
        v += __builtin_bit_cast(float, __builtin_amdgcn_update_dpp(0, __builtin_bit_cast(int, v), 0x141, 0xf, 0xf, true));
        v += __builtin_bit_cast(float, __builtin_amdgcn_update_dpp(0, __builtin_bit_cast(int, v), 0x140, 0xf, 0xf, true));
        return v; };
    unsigned pv[16];
    auto load_tile = [&](int T) {
        const int row0 = T * 32;
        int lo, hi; if (row0 < ML) { lo = row0 & ~(SEQ - 1); hi = lo + SEQ; } else { lo = row0 & ~(CTXL - 1); hi = lo + CTXL; }
#pragma unroll
        for (int j = 0; j < 16; ++j) { const int i = F.tid + 512 * j, rr = i >> 7, cp = i & 127, row = row0 - 15 + rr;
            const bool ok = (j < 15 || F.tid < 256) && row >= lo && row < hi;
            pv[j] = ok ? *(const unsigned*)(PROJ + (size_t)row * IND + 2 * cp) : 0u; }
    };
    const int T0 = F.G - 1 - F.vcu;
    if (T0 < ntiles) load_tile(T0);
    for (int T = T0; T < ntiles; T += F.G) {
        const int row0 = T * 32;
        __syncthreads();
#pragma unroll
        for (int j = 0; j < 16; ++j) { const int i = F.tid + 512 * j;
            if (j < 15 || F.tid < 256) { f32x2 u; u[0] = bflo(pv[j]); u[1] = bfhi(pv[j]); *(LAS f32x2*)(us + 2 * i) = u; } }
        if (T + F.G < ntiles) load_tile(T + F.G);
        __syncthreads();
        {
            float acc[16];
#pragma unroll
            for (int j = 0; j < 16; ++j) acc[j] = cbias;
            const LAS float* up = us + (16 * half) * 256 + c;
#pragma unroll
            for (int i = 0; i < 46; ++i) { const float x = up[i * 256];
#pragma unroll
                for (int j = 0; j < 16; ++j) if (i - j >= 0 && i - j <= 30) acc[j] += w[i - j] * x; }
#pragma unroll
            for (int j = 0; j < 16; ++j) os[(16 * half + j) * CV_OSROW + c] = acc[j];
        }
        __syncthreads();
        {
            f32x4 v[4];
#pragma unroll
            for (int q = 0; q < 4; ++q) v[q] = *(const LAS f32x4*)(os + lt * CV_OSROW + 16 * lseg + 4 * q);
            float s1 = 0.f;
#pragma unroll
            for (int q = 0; q < 4; ++q) s1 += (v[q][0] + v[q][1]) + (v[q][2] + v[q][3]);
            const float mu = row16_sum(s1) * (1.f / 256.f);
            float s2 = 0.f;
#pragma unroll
            for (int q = 0; q < 4; ++q) { v[q] = v[q] - mu; s2 += (v[q][0] * v[q][0] + v[q][1] * v[q][1]) + (v[q][2] * v[q][2] + v[q][3] * v[q][3]); }
            const float rstd = rsqrtf(row16_sum(s2) * (1.f / 256.f) + EPS);
            unsigned ow[8];
#pragma unroll
            for (int q = 0; q < 4; ++q) { const f32x4 y = v[q] * rstd * lg[q] + lb[q];
                ow[2 * q] = pg8::cvt_pk_bf16(siluf_(y[0]), siluf_(y[1])); ow[2 * q + 1] = pg8::cvt_pk_bf16(siluf_(y[2]), siluf_(y[3])); }
            bf16* op = MIX + (size_t)(row0 + lt) * D + 16 * lseg;
            *(v4u*)op = (v4u){ow[0], ow[1], ow[2], ow[3]}; *(v4u*)(op + 8) = (v4u){ow[4], ow[5], ow[6], ow[7]};
        }
    }
}

typedef short s16x8 __attribute__((ext_vector_type(8)));
typedef short s16x4 __attribute__((ext_vector_type(4)));
constexpr int NA_KROW = 144, NA_VROW = 160;
constexpr int NA_STAGE = 64 * NA_KROW + 64 * NA_VROW, NA_SLOT = 2 * NA_STAGE, NA_OFF_TB = 2 * NA_SLOT;
static_assert(NA_OFF_TB + 2560 <= RING_BYTES, "NA LDS map");
constexpr int NA_ITEMS_LAT = NB * NH * 8, NA_ITEMS_CTX = NB * NH * 2;
struct NaBlk { f32x4 O[4]; float m, lsum; int first; };
__device__ __forceinline__ int na_rs(int r) { int v = r - 4; return v < 0 ? 0 : (v > 24 ? 24 : v); }
__device__ __forceinline__ s16x8 na_scale_q(v4u w, float c) {
    v4u o; o.x = pg8::cvt_pk_bf16(bflo(w.x) * c, bfhi(w.x) * c); o.y = pg8::cvt_pk_bf16(bflo(w.y) * c, bfhi(w.y) * c); o.z = pg8::cvt_pk_bf16(bflo(w.z) * c, bfhi(w.z) * c); o.w = pg8::cvt_pk_bf16(bflo(w.w) * c, bfhi(w.w) * c);
    return __builtin_bit_cast(s16x8, o);
}
__device__ __forceinline__ void na_phase(Frame& F, int l, int nitems, int nav = 0) {
    const bf16* PROJ = WSP(const bf16, WS_PROJ); bf16* MIX = WSP(bf16, WS_MIX);
    LAS float* tb = (LAS float*)(F.lds + NA_OFF_TB);
    const int lane = F.lane, q16 = lane & 15, g = lane >> 4;
    const unsigned skey = (unsigned)(F.tid >> 3), spart = (unsigned)(F.tid & 7);
    const float c1 = 0.125f * 1.4426950408889634f;
    struct NaItem { int b, h, ra, qrow0, rsI, nloc, nch, npair, isctx; };
    auto decode = [&](int it, NaItem& I) {
        I.isctx = it >= NA_ITEMS_LAT ? 1 : 0; I.ra = 0; I.rsI = 0; I.nloc = 0;
        if (!I.isctx) { const int r4 = it & 7; I.h = (it >> 3) & 7; I.b = it >> 6; const int r0 = 4 * r4; I.ra = r0 + 2 * (F.wave >> 2); I.qrow0 = I.b * SEQ + I.ra * 64 + (F.wave & 3) * 16;
            I.rsI = na_rs(r0); I.nloc = na_rs(r0 + 3) + 8 - I.rsI; }
        else { const int j = it - NA_ITEMS_LAT; const int hf = j & 1; I.h = (j >> 1) & 7; I.b = j >> 4; I.qrow0 = ML + I.b * CTXL + hf * 128 + F.wave * 16; }
        I.nch = I.nloc + 4; I.npair = (I.nch + 1) >> 1;
    };
    auto krow_of = [&](const NaItem& I, int ch) -> int { if (ch > I.nch - 1) ch = I.nch - 1; return ch < I.nloc ? I.b * SEQ + (I.rsI + ch) * 64 : ML + I.b * CTXL + (ch - I.nloc) * 64; };
    const int jq = F.wave & 3;
    const int o0 = jq == 0 ? 0 : 16 * jq - 8, o1 = jq == 0 ? 16 : (jq == 3 ? 48 : 16 * jq + 8);
    float madd[2][4]; int lb[2];
    {
        const int qc = jq * 16 + q16; int cs = qc - 8; cs = cs < 0 ? 0 : (cs > 48 ? 48 : cs);
#pragma unroll
        for (int e = 0; e < 4; ++e) { const int k0 = o0 + 4 * g + e, k1 = o1 + 4 * g + e;
            madd[0][e] = ((unsigned)(k0 - cs) < 16u) ? 0.f : -1.0e30f;
            madd[1][e] = (((unsigned)(k1 - cs) < 16u) && !(jq == 3 && k1 < 56)) ? 0.f : -1.0e30f; }
        lb[0] = 64 + o0 + 4 * g - qc + 15; lb[1] = 64 + o1 + 4 * g - qc + 15;
    }
    v4u kr0, vr0, kr1, vr1, qrA[2], qrB[2];
    auto issue_first = [&](const NaItem& I) {
        const bf16* Pk = PROJ + 1024 + I.h * HD + 8 * spart, * Pv = PROJ + 1536 + I.h * HD + 8 * spart, * Pq = PROJ + 512 + I.h * HD;
        kr0 = *(const v4u*)(Pk + (size_t)(krow_of(I, 0) + (int)skey) * IND); vr0 = *(const v4u*)(Pv + (size_t)(krow_of(I, 0) + (int)skey) * IND);
        kr1 = *(const v4u*)(Pk + (size_t)(krow_of(I, 1) + (int)skey) * IND); vr1 = *(const v4u*)(Pv + (size_t)(krow_of(I, 1) + (int)skey) * IND);
#pragma unroll
        for (int s_ = 0; s_ < 2; ++s_) { qrA[s_] = *(const v4u*)(Pq + (size_t)(I.qrow0 + q16) * IND + 32 * s_ + 8 * g);
            qrB[s_] = I.isctx ? qrA[s_] : *(const v4u*)(Pq + (size_t)(I.qrow0 + 64 + q16) * IND + 32 * s_ + 8 * g); }
    };
    NaItem I; int it = F.vcu; bool have = it < nitems; int tb_h = -1;
    if (have) { decode(it, I); issue_first(I); }
    while (have) {
        const bool isctx = I.isctx != 0;
        const int ra = I.ra, rsI = I.rsI, nloc = I.nloc, nch = I.nch, npair = I.npair, qrow0 = I.qrow0, h = I.h;
        const bf16* Pk = PROJ + 1024 + h * HD + 8 * spart, * Pv = PROJ + 1536 + h * HD + 8 * spart;
        s16x8 qfA[2], qfB[2];
#pragma unroll
        for (int s_ = 0; s_ < 2; ++s_) { qfA[s_] = na_scale_q(qrA[s_], c1); qfB[s_] = na_scale_q(qrB[s_], c1); }
        const int rsA = na_rs(ra), rsB = na_rs(ra + 1);
        NaItem N; const int itn = it + F.G; const bool haven = itn < nitems; if (haven) decode(itn, N); else N = I;
        __syncthreads();
        if (!isctx && h != tb_h) { const float* rpb = INP(14) + ((size_t)l * NH + h) * 15 * 31; tb_h = h;
            for (int i = F.tid; i < 640; i += NWAVES * 64) tb[i] = (i >= 64 && i < 64 + 465) ? rpb[i - 64] * 1.4426950408889634f : 0.f; }
        {
            LAS unsigned char* s0 = F.lds;
            *(LAS v4u*)(s0 + skey * NA_KROW + spart * 16) = kr0; *(LAS v4u*)(s0 + 64 * NA_KROW + skey * NA_VROW + spart * 16) = vr0;
            *(LAS v4u*)(s0 + NA_STAGE + skey * NA_KROW + spart * 16) = kr1; *(LAS v4u*)(s0 + NA_STAGE + 64 * NA_KROW + skey * NA_VROW + spart * 16) = vr1;
        }
        if (npair > 2) {
            kr0 = *(const v4u*)(Pk + (size_t)(krow_of(I, 2) + (int)skey) * IND); vr0 = *(const v4u*)(Pv + (size_t)(krow_of(I, 2) + (int)skey) * IND);
            kr1 = *(const v4u*)(Pk + (size_t)(krow_of(I, 3) + (int)skey) * IND); vr1 = *(const v4u*)(Pv + (size_t)(krow_of(I, 3) + (int)skey) * IND);
        } else {
            kr0 = *(const v4u*)(Pk + (size_t)(krow_of(I, 2) + (int)skey) * IND); vr0 = *(const v4u*)(Pv + (size_t)(krow_of(I, 2) + (int)skey) * IND);
            kr1 = *(const v4u*)(Pk + (size_t)(krow_of(I, 3) + (int)skey) * IND); vr1 = *(const v4u*)(Pv + (size_t)(krow_of(I, 3) + (int)skey) * IND);
        }
        NaBlk A, B;
#pragma unroll
        for (int dt = 0; dt < 4; ++dt) { A.O[dt] = (f32x4){0.f, 0.f, 0.f, 0.f}; B.O[dt] = (f32x4){0.f, 0.f, 0.f, 0.f}; }
        A.m = 0.f; A.lsum = 0.f; A.first = 1; B.m = 0.f; B.lsum = 0.f; B.first = 1;
        for (int cp = 0; cp < npair; ++cp) {
            __syncthreads();
            if (cp + 1 < npair) { LAS unsigned char* nx = F.lds + ((cp + 1) & 1) * NA_SLOT;
                *(LAS v4u*)(nx + skey * NA_KROW + spart * 16) = kr0; *(LAS v4u*)(nx + 64 * NA_KROW + skey * NA_VROW + spart * 16) = vr0;
                *(LAS v4u*)(nx + NA_STAGE + skey * NA_KROW + spart * 16) = kr1; *(LAS v4u*)(nx + NA_STAGE + 64 * NA_KROW + skey * NA_VROW + spart * 16) = vr1; }
            if (cp + 2 < npair) { const int k2 = krow_of(I, 2 * cp + 4) + (int)skey, k3 = krow_of(I, 2 * cp + 5) + (int)skey;
                kr0 = *(const v4u*)(Pk + (size_t)k2 * IND); vr0 = *(const v4u*)(Pv + (size_t)k2 * IND); kr1 = *(const v4u*)(Pk + (size_t)k3 * IND); vr1 = *(const v4u*)(Pv + (size_t)k3 * IND); }
            else if (cp + 2 == npair && haven) issue_first(N);
          for (int sub = 0; sub < 2; ++sub) {
            const int ch = 2 * cp + sub;
            if (ch >= nch) break;
            LAS unsigned char* cur = F.lds + (cp & 1) * NA_SLOT + sub * NA_STAGE;
            const bool local = ch < nloc;
            const int kr = rsI + ch;
            const bool actA = !local || (kr >= rsA && kr <= rsA + 7), actB = !isctx && (!local || (kr >= rsB && kr <= rsB + 7));
            if ((!actA && !actB) || nav == 1) continue;
            auto finish = [&](f32x4* S, int nt_, NaBlk& X, unsigned (*pk)[2], float cm) {
                if (X.first || !__all(cm <= 8.f)) {
                    cm = fmaxf(cm, __shfl_xor(cm, 16)); cm = fmaxf(cm, __shfl_xor(cm, 32));
                    const float d = X.first ? cm : fmaxf(cm, 0.f);
                    if (!X.first) { const float alpha = __builtin_amdgcn_exp2f(-d); X.lsum *= alpha;
#pragma unroll
                        for (int dt = 0; dt < 4; ++dt) X.O[dt] = X.O[dt] * alpha; }
                    X.m += d; X.first = 0;
#pragma unroll
                    for (int t = 0; t < 4; ++t) if (t < nt_) S[t] = S[t] - d;
                }
                float ps = 0.f;
#pragma unroll
                for (int t = 0; t < 4; ++t) if (t < nt_) {
                    const float p0 = __builtin_amdgcn_exp2f(S[t][0]), p1 = __builtin_amdgcn_exp2f(S[t][1]), p2 = __builtin_amdgcn_exp2f(S[t][2]), p3 = __builtin_amdgcn_exp2f(S[t][3]);
                    ps += (p0 + p1) + (p2 + p3);
                    pk[t][0] = pg8::cvt_pk_bf16(p0, p1); pk[t][1] = pg8::cvt_pk_bf16(p2, p3); }
                X.lsum += ps;
            };
            unsigned pkA[4][2], pkB[4][2];
            if (local) {
                const LAS unsigned char* kb_ = cur + q16 * NA_KROW + 16 * g;
                f32x4 SA[2], SB[2];
#pragma unroll
                for (int t = 0; t < 2; ++t) { const float ma = -A.m, mb = -B.m; SA[t] = (f32x4){ma, ma, ma, ma}; SB[t] = (f32x4){mb, mb, mb, mb};
                    const int o = t == 0 ? o0 : o1;
#pragma unroll
                    for (int s_ = 0; s_ < 2; ++s_) { const s16x8 kf = *(const LAS s16x8*)(kb_ + o * NA_KROW + 64 * s_);
                        if (actA) SA[t] = __builtin_amdgcn_mfma_f32_16x16x32_bf16(kf, qfA[s_], SA[t], 0, 0, 0);
                        if (actB) SB[t] = __builtin_amdgcn_mfma_f32_16x16x32_bf16(kf, qfB[s_], SB[t], 0, 0, 0); } }
                if (nav == 2) { asm volatile("" :: "v"(SA[0]), "v"(SA[1]), "v"(SB[0]), "v"(SB[1])); continue; }
                auto soft_local = [&](f32x4 (&S)[2], NaBlk& X, unsigned (&pk)[4][2], int rq) {
                    float cm = -1.0e30f;
#pragma unroll
                    for (int t = 0; t < 2; ++t) { const LAS float* tr_ = tb + (kr - rq + 7) * 31 + lb[t];
#pragma unroll
                        for (int e = 0; e < 4; ++e) { const float v = (S[t][e] + tr_[e]) + madd[t][e]; S[t][e] = v; cm = fmaxf(cm, v); } }
                    finish(S, 2, X, pk, cm);
                };
                if (actA) soft_local(SA, A, pkA, ra);
                if (actB) soft_local(SB, B, pkB, ra + 1);
                if (nav == 3) { asm volatile("" :: "v"(pkA[0][0]), "v"(pkA[1][1]), "v"(pkB[0][0]), "v"(pkB[1][1])); continue; }
                const LAS unsigned char* vtr = cur + 64 * NA_KROW + (4 * g + (q16 >> 2)) * NA_VROW + (q16 & 3) * 8;
                const v4u bwA = {pkA[0][0], pkA[0][1], pkA[1][0], pkA[1][1]}, bwB = {pkB[0][0], pkB[0][1], pkB[1][0], pkB[1][1]};
                const s16x8 bfA = __builtin_bit_cast(s16x8, bwA), bfB = __builtin_bit_cast(s16x8, bwB);
#pragma unroll
                for (int dt = 0; dt < 4; ++dt) {
                    const s16x4 a0 = __builtin_amdgcn_ds_read_tr16_b64_v4i16((LAS s16x4*)(vtr + o0 * NA_VROW + dt * 32));
                    const s16x4 a1 = __builtin_amdgcn_ds_read_tr16_b64_v4i16((LAS s16x4*)(vtr + o1 * NA_VROW + dt * 32));
                    const s16x8 afrag = __builtin_shufflevector(a0, a1, 0, 1, 2, 3, 4, 5, 6, 7);
                    if (actA) A.O[dt] = __builtin_amdgcn_mfma_f32_16x16x32_bf16(afrag, bfA, A.O[dt], 0, 0, 0);
                    if (actB) B.O[dt] = __builtin_amdgcn_mfma_f32_16x16x32_bf16(afrag, bfB, B.O[dt], 0, 0, 0);
                }
            } else {
                const LAS unsigned char* kb_ = cur + q16 * NA_KROW + 16 * g;
                f32x4 SA[4], SB[4];
#pragma unroll
                for (int t = 0; t < 4; ++t) { const float ma = -A.m, mb = -B.m; SA[t] = (f32x4){ma, ma, ma, ma}; SB[t] = (f32x4){mb, mb, mb, mb};
#pragma unroll
                    for (int s_ = 0; s_ < 2; ++s_) { const s16x8 kf = *(const LAS s16x8*)(kb_ + t * 16 * NA_KROW + 64 * s_);
                        SA[t] = __builtin_amdgcn_mfma_f32_16x16x32_bf16(kf, qfA[s_], SA[t], 0, 0, 0);
                        if (actB) SB[t] = __builtin_amdgcn_mfma_f32_16x16x32_bf16(kf, qfB[s_], SB[t], 0, 0, 0); } }
                if (nav == 2) { asm volatile("" :: "v"(SA[0]), "v"(SA[1]), "v"(SA[2]), "v"(SA[3]), "v"(SB[0]), "v"(SB[1]), "v"(SB[2]), "v"(SB[3])); continue; }
                auto soft_ctx = [&](f32x4 (&S)[4], NaBlk& X, unsigned (&pk)[4][2]) {
                    float cm = -1.0e30f;
#pragma unroll
                    for (int t = 0; t < 4; ++t)
#pragma unroll
                        for (int e = 0; e < 4; ++e) cm = fmaxf(cm, S[t][e]);
                    finish(S, 4, X, pk, cm);
                };
                soft_ctx(SA, A, pkA);
                if (actB) soft_ctx(SB, B, pkB);
                if (nav == 3) { asm volatile("" :: "v"(pkA[0][0]), "v"(pkA[1][1]), "v"(pkA[2][0]), "v"(pkA[3][1]), "v"(pkB[0][0]), "v"(pkB[1][1]), "v"(pkB[2][0]), "v"(pkB[3][1])); continue; }
                const LAS unsigned char* vtr = cur + 64 * NA_KROW + (4 * g + (q16 >> 2)) * NA_VROW + (q16 & 3) * 8;
#pragma unroll
                for (int p = 0; p < 2; ++p) {
                    const v4u bwA = {pkA[2 * p][0], pkA[2 * p][1], pkA[2 * p + 1][0], pkA[2 * p + 1][1]}, bwB = {pkB[2 * p][0], pkB[2 * p][1], pkB[2 * p + 1][0], pkB[2 * p + 1][1]};
                    const s16x8 bfA = __builtin_bit_cast(s16x8, bwA), bfB = __builtin_bit_cast(s16x8, bwB);
#pragma unroll
                    for (int dt = 0; dt < 4; ++dt) {
                        const s16x4 a0 = __builtin_amdgcn_ds_read_tr16_b64_v4i16((LAS s16x4*)(vtr + (2 * p) * 16 * NA_VROW + dt * 32));
                        const s16x4 a1 = __builtin_amdgcn_ds_read_tr16_b64_v4i16((LAS s16x4*)(vtr + (2 * p + 1) * 16 * NA_VROW + dt * 32));
                        const s16x8 afrag = __builtin_shufflevector(a0, a1, 0, 1, 2, 3, 4, 5, 6, 7);
                        A.O[dt] = __builtin_amdgcn_mfma_f32_16x16x32_bf16(afrag, bfA, A.O[dt], 0, 0, 0);
                        if (actB) B.O[dt] = __builtin_amdgcn_mfma_f32_16x16x32_bf16(afrag, bfB, B.O[dt], 0, 0, 0);
                    }
                }
            }
          }
        }
        {
            float ls = A.lsum; ls += __shfl_xor(ls, 16); ls += __shfl_xor(ls, 32);
            const float inv = __builtin_amdgcn_rcpf(ls);
            bf16* op = MIX + (size_t)(qrow0 + q16) * D + 256 + h * HD + 4 * g;
#pragma unroll
            for (int dt = 0; dt < 4; ++dt) { v2u w; w.x = pg8::cvt_pk_bf16(A.O[dt][0] * inv, A.O[dt][1] * inv); w.y = pg8::cvt_pk_bf16(A.O[dt][2] * inv, A.O[dt][3] * inv); *(v2u*)(op + 16 * dt) = w; }
        }
        if (!isctx) {
            float ls = B.lsum; ls += __shfl_xor(ls, 16); ls += __shfl_xor(ls, 32);
            const float inv = __builtin_amdgcn_rcpf(ls);
            bf16* op = MIX + (size_t)(qrow0 + 64 + q16) * D + 256 + h * HD + 4 * g;
#pragma unroll
            for (int dt = 0; dt < 4; ++dt) { v2u w; w.x = pg8::cvt_pk_bf16(B.O[dt][0] * inv, B.O[dt][1] * inv); w.y = pg8::cvt_pk_bf16(B.O[dt][2] * inv, B.O[dt][3] * inv); *(v2u*)(op + 16 * dt) = w; }
        }
        it = itn; have = haven; I = N;
    }
}

constexpr int LRU_UCROW = 260;
constexpr int LRU_OFF_UC = 38 * 256 * 2, LRU_OFF_GT = LRU_OFF_UC + 2 * 32 * LRU_UCROW * 4;
static_assert(LRU_OFF_GT + 32 * 256 * 2 <= RING_BYTES, "LRU LDS map");
template <int PASS>
__device__ __forceinline__ void lru_phase(Frame& F, int l, int ntiles) {
    const bf16* PROJ = WSP(const bf16, WS_PROJ);
    LAS bf16* rxs = (LAS bf16*)(F.lds);
    LAS float* ucf = (LAS float*)(F.lds + LRU_OFF_UC);
    LAS bf16* gts = (LAS bf16*)(F.lds + LRU_OFF_GT);
    const int lane = F.lane, j16 = lane & 15, g = lane >> 4;
    const int kb = F.wave & 3, nh = F.wave >> 2;
    s16x8 wf[2][2][2][2];
    float cbx[2][2], cba[2][2], csp[2][2];
#pragma unroll
    for (int dir = 0; dir < 2; ++dir) {
        const int ld = l * 2 + dir;
        const bf16* WLR = WSP(const bf16, WS_WLR) + (size_t)((ld * 4 + kb) * 2) * 4096;
#pragma unroll
        for (int gt = 0; gt < 2; ++gt)
#pragma unroll
            for (int n2 = 0; n2 < 2; ++n2)
#pragma unroll
                for (int s_ = 0; s_ < 2; ++s_) wf[dir][gt][n2][s_] = *(const s16x8*)(WLR + gt * 4096 + (16 * (2 * nh + n2) + j16) * 64 + 32 * s_ + 8 * g);
#pragma unroll
        for (int n2 = 0; n2 < 2; ++n2) {
            const int e = kb * 64 + 16 * (2 * nh + n2) + j16, idx = ld * 256 + e;
            cbx[dir][n2] = INP(18)[idx]; cba[dir][n2] = INP(20)[idx];
            const float nl = -INP(21)[idx]; csp[dir][n2] = -8.f * (fmaxf(nl, 0.f) + log1pf(__expf(-fabsf(nl))));
        }
    }
    const int c = F.tid & 255, sdir = F.tid >> 8;
    const int sld = l * 2 + sdir;
    const float s1w0 = INP(15)[(sld * 4 + 0) * 256 + c], s1w1 = INP(15)[(sld * 4 + 1) * 256 + c], s1w2 = INP(15)[(sld * 4 + 2) * 256 + c], s1w3 = INP(15)[(sld * 4 + 3) * 256 + c], s1cb = INP(16)[sld * 256 + c];
    const int base = sdir == 0 ? 0 : 3;
    unsigned pre[10], pgw[8];
    auto load_tile = [&](int T) {
        const int row0 = T * 32;
        int lo, hi; if (row0 < ML) { lo = row0 & ~(SEQ - 1); hi = lo + SEQ; } else { lo = row0 & ~(CTXL - 1); hi = lo + CTXL; }
#pragma unroll
        for (int j = 0; j < 10; ++j) { const int i = F.tid + 512 * j, rr = i >> 7, cp = i & 127, row = row0 - 3 + rr;
            const bool ok = (j < 9 || F.tid < 256) && row >= lo && row < hi;
            pre[j] = ok ? *(const unsigned*)(PROJ + (size_t)row * IND + 2048 + 2 * cp) : 0u; }
        if (PASS == 1) {
#pragma unroll
            for (int j = 0; j < 8; ++j) { const int i = F.tid + 512 * j, t = i >> 7, cp = i & 127; pgw[j] = *(const unsigned*)(PROJ + (size_t)(row0 + t) * IND + 2304 + 2 * cp); }
        }
    };
    if (F.vcu < ntiles) load_tile(F.vcu);
    for (int T = F.vcu; T < ntiles; T += F.G) {
        const int row0 = T * 32;
        __syncthreads();
#pragma unroll
        for (int j = 0; j < 10; ++j) { const int i = F.tid + 512 * j; if (j < 9 || F.tid < 256) ((LAS unsigned*)rxs)[i] = pre[j]; }
        if (PASS == 1) {
#pragma unroll
            for (int j = 0; j < 8; ++j) ((LAS unsigned*)gts)[F.tid + 512 * j] = pgw[j];
        }
        if (T + F.G < ntiles) load_tile(T + F.G);
        float hst[2][2];
#pragma unroll
        for (int dir = 0; dir < 2; ++dir)
#pragma unroll
            for (int n2 = 0; n2 < 2; ++n2) hst[dir][n2] = PASS == 1 ? WSP(const float, WS_CARRY)[((size_t)dir * 1152 + T) * 256 + kb * 64 + 16 * (2 * nh + n2) + j16] : 0.f;
        __syncthreads();
        {
            float x0 = bf1(rxs[(base + 0) * 256 + c]), x1 = bf1(rxs[(base + 1) * 256 + c]), x2 = bf1(rxs[(base + 2) * 256 + c]);
#pragma unroll 8
            for (int t = 0; t < 32; ++t) {
                const float x3 = bf1(rxs[(t + base + 3) * 256 + c]);
                ucf[(sdir * 32 + t) * LRU_UCROW + c] = s1cb + s1w0 * x0 + s1w1 * x1 + s1w2 * x2 + s1w3 * x3;
                x0 = x1; x1 = x2; x2 = x3;
            }
        }
        __syncthreads();
        float hf[2][2][4];
        float Pt[2][2] = {{1.f, 1.f}, {1.f, 1.f}};
#pragma unroll
        for (int dir = 0; dir < 2; ++dir) {
            const bool sec16 = ((g & 1) != 0) != (dir != 0), sec32 = ((g >> 1) != 0) != (dir != 0);
#pragma unroll
            for (int step = 0; step < 2; ++step) {
                const int rt = dir == 0 ? step : 1 - step;
                s16x8 af[2];
#pragma unroll
                for (int s_ = 0; s_ < 2; ++s_) { const LAS float* up = ucf + (dir * 32 + 16 * rt + j16) * LRU_UCROW + kb * 64 + 32 * s_ + 8 * g;
                    const f32x4 u0 = *(const LAS f32x4*)up, u1 = *(const LAS f32x4*)(up + 4);
                    const v4u w = {pg8::cvt_pk_bf16(u0[0], u0[1]), pg8::cvt_pk_bf16(u0[2], u0[3]), pg8::cvt_pk_bf16(u1[0], u1[1]), pg8::cvt_pk_bf16(u1[2], u1[3])};
                    af[s_] = __builtin_bit_cast(s16x8, w); }
#pragma unroll
                for (int n2 = 0; n2 < 2; ++n2) {
                    f32x4 zx = {0.f, 0.f, 0.f, 0.f}, za = {0.f, 0.f, 0.f, 0.f};
#pragma unroll
                    for (int s_ = 0; s_ < 2; ++s_) { zx = __builtin_amdgcn_mfma_f32_16x16x32_bf16(af[s_], wf[dir][0][n2][s_], zx, 0, 0, 0); za = __builtin_amdgcn_mfma_f32_16x16x32_bf16(af[s_], wf[dir][1][n2][s_], za, 0, 0, 0); }
                    const int e = kb * 64 + 16 * (2 * nh + n2) + j16;
                    const LAS float* uo = ucf + (dir * 32 + 16 * rt + 4 * g) * LRU_UCROW + e;
                    float a_[4], b_[4]; unsigned abw[4];
#pragma unroll
                    for (int r = 0; r < 4; ++r) {
                        const float u = uo[r * LRU_UCROW];
                        const float gx = sigmoidf_(zx[r] + cbx[dir][n2]), ga = sigmoidf_(za[r] + cba[dir][n2]);
                        const float la = csp[dir][n2] * ga, a = __builtin_amdgcn_exp2f(1.4426950408889634f * la), y = 2.f * la;
                        const float om = y > -0.02f ? -y * (1.f + y * (0.5f + y * 0.16666667f)) : 1.f - a * a;
                        a_[r] = a; b_[r] = __builtin_amdgcn_sqrtf(om) * gx * u;
                        if (PASS == 0) {
                            const float oma = la > -0.02f ? -la * (1.f + la * (0.5f + la * 0.16666667f)) : 1.f - a;
                            abw[r] = pg8::cvt_pk_bf16(oma, b_[r]); a_[r] = 1.f - bflo(abw[r]); b_[r] = bfhi(abw[r]);
                        }
                    }
                    if (PASS == 0) WSP(v4u, WS_AB)[(((((size_t)T * 2 + dir) * 2 + rt) * 8 + F.wave) * 2 + n2) * 64 + lane] = (v4u){abw[0], abw[1], abw[2], abw[3]};
                    const float P = (a_[0] * a_[1]) * (a_[2] * a_[3]);
                    const float S = dir == 0 ? ((b_[0] * a_[1] + b_[1]) * a_[2] + b_[2]) * a_[3] + b_[3] : ((b_[3] * a_[2] + b_[2]) * a_[1] + b_[1]) * a_[0] + b_[0];
                    const float Pp = __shfl_xor(P, 16), Sp = __shfl_xor(S, 16);
                    const float e1P = sec16 ? Pp : 1.f, e1S = sec16 ? Sp : 0.f;
                    const float prP = P * Pp, prS = sec16 ? P * Sp + S : Pp * S + Sp;
                    const float Pq = __shfl_xor(prP, 32), Sq = __shfl_xor(prS, 32);
                    const float EP = sec32 ? Pq * e1P : e1P, ES = sec32 ? e1P * Sq + e1S : e1S;
                    const float TP = prP * Pq, TS = sec32 ? prP * Sq + prS : Pq * prS + Sq;
                    if (PASS == 1) {
                        float h = EP * hst[dir][n2] + ES;
                        if (dir == 0) {
#pragma unroll
                            for (int r = 0; r < 4; ++r) { h = a_[r] * h + b_[r]; hf[rt][n2][r] = h; }
                        } else {
                            float hb[4];
#pragma unroll
                            for (int r = 3; r >= 0; --r) { h = a_[r] * h + b_[r]; hb[r] = h; }
                            bf16* mp = WSP(bf16, WS_MIX) + (size_t)(row0 + 16 * rt + 4 * g) * D + 768 + e;
                            const LAS bf16* gp = gts + (16 * rt + 4 * g) * 256 + e;
#pragma unroll
                            for (int r = 0; r < 4; ++r) mp[(size_t)r * D] = (bf16)f2bf(gelu_tanh(bf1(gp[r * 256])) * (hf[rt][n2][r] + hb[r]));
                        }
                    } else Pt[dir][n2] *= TP;
                    hst[dir][n2] = TP * hst[dir][n2] + TS;
                }
            }
        }
        if (PASS == 0 && g == 0) {
#pragma unroll
            for (int dir = 0; dir < 2; ++dir)
#pragma unroll
                for (int n2 = 0; n2 < 2; ++n2) WSP(f32x2, WS_TOT)[((size_t)dir * 1152 + T) * 256 + kb * 64 + 16 * (2 * nh + n2) + j16] = (f32x2){Pt[dir][n2], hst[dir][n2]};
        }
    }
}
__device__ __forceinline__ void lru_scan_phase(Frame& F, int l, int ntiles) {
    const bf16* PROJ = WSP(const bf16, WS_PROJ);
    LAS bf16* gts = (LAS bf16*)(F.lds);
    const int lane = F.lane, j16 = lane & 15, g = lane >> 4;
    const int kb = F.wave & 3, nh = F.wave >> 2;
    const v4u* AB = WSP(const v4u, WS_AB);
    v4u pab[2][2][2]; unsigned pgw[8];
    auto load_tile = [&](int T) {
#pragma unroll
        for (int dir = 0; dir < 2; ++dir)
#pragma unroll
            for (int rt = 0; rt < 2; ++rt)
#pragma unroll
                for (int n2 = 0; n2 < 2; ++n2) pab[dir][rt][n2] = AB[(((((size_t)T * 2 + dir) * 2 + rt) * 8 + F.wave) * 2 + n2) * 64 + lane];
#pragma unroll
        for (int j = 0; j < 8; ++j) { const int i = F.tid + 512 * j, t = i >> 7, cp = i & 127; pgw[j] = *(const unsigned*)(PROJ + (size_t)(T * 32 + t) * IND + 2304 + 2 * cp); }
    };
    if (F.vcu < ntiles) load_tile(F.vcu);
    for (int T = F.vcu; T < ntiles; T += F.G) {
        const int row0 = T * 32;
        __syncthreads();
#pragma unroll
        for (int j = 0; j < 8; ++j) ((LAS unsigned*)gts)[F.tid + 512 * j] = pgw[j];
        v4u cur[2][2][2];
#pragma unroll
        for (int dir = 0; dir < 2; ++dir)
#pragma unroll
            for (int rt = 0; rt < 2; ++rt)
#pragma unroll
                for (int n2 = 0; n2 < 2; ++n2) cur[dir][rt][n2] = pab[dir][rt][n2];
        float hst[2][2];
#pragma unroll
        for (int dir = 0; dir < 2; ++dir)
#pragma unroll
            for (int n2 = 0; n2 < 2; ++n2) hst[dir][n2] = WSP(const float, WS_CARRY)[((size_t)dir * 1152 + T) * 256 + kb * 64 + 16 * (2 * nh + n2) + j16];
        if (T + F.G < ntiles) load_tile(T + F.G);
        __syncthreads();
        float hf[2][2][4];
#pragma unroll
        for (int dir = 0; dir < 2; ++dir) {
            const bool sec16 = ((g & 1) != 0) != (dir != 0), sec32 = ((g >> 1) != 0) != (dir != 0);
#pragma unroll
            for (int step = 0; step < 2; ++step) {
                const int rt = dir == 0 ? step : 1 - step;
#pragma unroll
                for (int n2 = 0; n2 < 2; ++n2) {
                    const int e = kb * 64 + 16 * (2 * nh + n2) + j16;
                    const v4u w = cur[dir][rt][n2];
                    const float a_[4] = {1.f - bflo(w.x), 1.f - bflo(w.y), 1.f - bflo(w.z), 1.f - bflo(w.w)}, b_[4] = {bfhi(w.x), bfhi(w.y), bfhi(w.z), bfhi(w.w)};
                    const float P = (a_[0] * a_[1]) * (a_[2] * a_[3]);
                    const float S = dir == 0 ? ((b_[0] * a_[1] + b_[1]) * a_[2] + b_[2]) * a_[3] + b_[3] : ((b_[3] * a_[2] + b_[2]) * a_[1] + b_[1]) * a_[0] + b_[0];
                    const float Pp = __shfl_xor(P, 16), Sp = __shfl_xor(S, 16);
                    const float e1P = sec16 ? Pp : 1.f, e1S = sec16 ? Sp : 0.f;
                    const float prP = P * Pp, prS = sec16 ? P * Sp + S : Pp * S + Sp;
                    const float Pq = __shfl_xor(prP, 32), Sq = __shfl_xor(prS, 32);
                    const float EP = sec32 ? Pq * e1P : e1P, ES = sec32 ? e1P * Sq + e1S : e1S;
                    const float TP = prP * Pq, TS = sec32 ? prP * Sq + prS : Pq * prS + Sq;
                    float h = EP * hst[dir][n2] + ES;
                    if (dir == 0) {
#pragma unroll
                        for (int r = 0; r < 4; ++r) { h = a_[r] * h + b_[r]; hf[rt][n2][r] = h; }
                    } else {
                        float hb[4];
#pragma unroll
                        for (int r = 3; r >= 0; --r) { h = a_[r] * h + b_[r]; hb[r] = h; }
                        bf16* mp = WSP(bf16, WS_MIX) + (size_t)(row0 + 16 * rt + 4 * g) * D + 768 + e;
                        const LAS bf16* gp = gts + (16 * rt + 4 * g) * 256 + e;
#pragma unroll
                        for (int r = 0; r < 4; ++r) mp[(size_t)r * D] = (bf16)f2bf(gelu_tanh(bf1(gp[r * 256])) * (hf[rt][n2][r] + hb[r]));
                    }
                    hst[dir][n2] = TP * hst[dir][n2] + TS;
                }
            }
        }
    }
}

constexpr int LQ_WVB = 35 * 128 + 32 * 144;
constexpr int LQ_WV = 72 * 1024;
constexpr int LQ_CH = TBL_OFF;
constexpr int LQ_FL = LQ_CH + 72 * 2 * 16 * 4;
constexpr int LQ_WV2 = LQ_FL + 2 * 72 * 4;
static_assert(LQ_WV + 6 * LQ_WVB <= RING_BYTES && LQ_WV2 + 2 * LQ_WVB <= LDS_BYTES && LQ_WV2 % 16 == 0, "LRU LDS map");
__device__ __forceinline__ void lru_seq_phase(Frame& F, int l, bool last) {
    const bf16* PROJ = WSP(const bf16, WS_PROJ);
    const int lane = F.lane, j16 = lane & 15, g = lane >> 4, cpn = lane & 31, hh = lane >> 5;
    LAS unsigned char* wreg = F.lds + (F.wave < 6 ? LQ_WV + F.wave * LQ_WVB : LQ_WV2 + (F.wave - 6) * LQ_WVB);
    LAS unsigned* rx32 = (LAS unsigned*)wreg;
    LAS unsigned char* ucb = wreg + 35 * 128;
    volatile LAS unsigned* cflag = (volatile LAS unsigned*)(F.lds + LQ_FL);
    volatile LAS unsigned* hflag = cflag + 72;
    LAS float* chain = (LAS float*)(F.lds + LQ_CH);
    for (int item = F.vcu; item < NB * 16; item += F.G) {
        const int b = item >> 4, cg = item & 15, kb = cg >> 2, nn = cg & 3;
        __syncthreads();
        if (F.tid < 144) cflag[F.tid] = 0u;
        __syncthreads();
        s16x8 wf[2][2][2]; float cbx[2], cba[2], csp[2]; f32x2 cw[2][4], cb[2];
#pragma unroll
        for (int dir = 0; dir < 2; ++dir) {
            const int ld = l * 2 + dir;
            const bf16* WLR = WSP(const bf16, WS_WLR) + (size_t)((ld * 4 + kb) * 2) * 4096;
#pragma unroll
            for (int gt = 0; gt < 2; ++gt)
#pragma unroll
                for (int s_ = 0; s_ < 2; ++s_) wf[dir][gt][s_] = *(const s16x8*)(WLR + gt * 4096 + (16 * nn + j16) * 64 + 32 * s_ + 8 * g);
            const int idx = ld * 256 + kb * 64 + 16 * nn + j16;
            cbx[dir] = INP(18)[idx]; cba[dir] = INP(20)[idx];
            const float nl = -INP(21)[idx]; csp[dir] = -8.f * (fmaxf(nl, 0.f) + log1pf(__expf(-fabsf(nl))));
            const int c0 = kb * 64 + 2 * cpn;
#pragma unroll
            for (int k = 0; k < 4; ++k) cw[dir][k] = (f32x2){INP(15)[(ld * 4 + k) * 256 + c0], INP(15)[(ld * 4 + k) * 256 + c0 + 1]};
            cb[dir] = (f32x2){INP(16)[ld * 256 + c0], INP(16)[ld * 256 + c0 + 1]};
        }
        auto tile_row0 = [&](int s, int dir) -> int { return s < 8 ? ML + b * CTXL + 32 * (dir == 0 ? s : 7 - s) : b * SEQ + 32 * (dir == 0 ? s - 8 : 71 - s); };
        v4u pre[5];
        auto load_rows = [&](int s, int dir) {
            const int lo = s < 8 ? ML + b * CTXL : b * SEQ, hi = lo + (s < 8 ? CTXL : SEQ);
            const int r0 = tile_row0(s, dir) - (dir == 0 ? 3 : 0);
#pragma unroll
            for (int j = 0; j < 5; ++j) { const int rr = (lane >> 3) + 8 * j, row = r0 + rr;
                const bool ok = rr < 35 && row >= lo && row < hi;
                pre[j] = ok ? *(const v4u*)(PROJ + (size_t)row * IND + 2048 + kb * 64 + 8 * (lane & 7)) : (v4u){0u, 0u, 0u, 0u}; }
        };
        load_rows(F.wave, 0);
        for (int s = F.wave; s < 72; s += 8) {
            const bool ctxs = s < 8, comb = ctxs ? s >= 4 : s >= 40, outp = !(last && ctxs);
            float A_[2][2][4], B_[2][2][4], EP[2][2], ES[2][2], TP[2][2], TS[2][2];
#pragma unroll
            for (int dir = 0; dir < 2; ++dir) {
#pragma unroll
                for (int j = 0; j < 5; ++j) { const int rr = (lane >> 3) + 8 * j; if (rr < 35) *(LAS v4u*)(wreg + rr * 128 + 16 * (lane & 7)) = pre[j]; }
                if (dir == 0) load_rows(s, 1); else if (s + 8 < 72) load_rows(s + 8, 0);
                {
                    auto up2 = [](unsigned w) -> f32x2 { return (f32x2){bflo(w), bfhi(w)}; };
                    f32x2 x0 = up2(rx32[(16 * hh + 0) * 32 + cpn]), x1 = up2(rx32[(16 * hh + 1) * 32 + cpn]), x2 = up2(rx32[(16 * hh + 2) * 32 + cpn]);
#pragma unroll
                    for (int t = 0; t < 16; ++t) {
                        const f32x2 x3 = up2(rx32[(16 * hh + t + 3) * 32 + cpn]);
                        const f32x2 acc = cb[dir] + cw[dir][0] * x0 + cw[dir][1] * x1 + cw[dir][2] * x2 + cw[dir][3] * x3;
                        *(LAS unsigned*)(ucb + (16 * hh + t) * 144 + 4 * cpn) = pg8::cvt_pk_bf16(acc[0], acc[1]);
                        x0 = x1; x1 = x2; x2 = x3;
                    }
                }
                const bool sec16 = ((g & 1) != 0) != (dir != 0), sec32 = ((g >> 1) != 0) != (dir != 0);
#pragma unroll
                for (int rt = 0; rt < 2; ++rt) {
                    f32x4 zx = {0.f, 0.f, 0.f, 0.f}, za = {0.f, 0.f, 0.f, 0.f};
#pragma unroll
                    for (int s_ = 0; s_ < 2; ++s_) { const s16x8 af = *(const LAS s16x8*)(ucb + (16 * rt + j16) * 144 + 64 * s_ + 16 * g);
                        zx = __builtin_amdgcn_mfma_f32_16x16x32_bf16(af, wf[dir][0][s_], zx, 0, 0, 0); za = __builtin_amdgcn_mfma_f32_16x16x32_bf16(af, wf[dir][1][s_], za, 0, 0, 0); }
                    float a_[4], b_[4];
#pragma unroll
                    for (int r = 0; r < 4; ++r) {
                        const float u = bf1(*(const LAS bf16*)(ucb + (16 * rt + 4 * g + r) * 144 + 2 * (16 * nn + j16)));
                        const float gx = sigmoidf_(zx[r] + cbx[dir]), ga = sigmoidf_(za[r] + cba[dir]);
                        const float la = csp[dir] * ga, a = __builtin_amdgcn_exp2f(1.4426950408889634f * la), y = 2.f * la;
                        const float om = y > -0.02f ? -y * (1.f + y * (0.5f + y * 0.16666667f)) : 1.f - a * a;
                        a_[r] = a; b_[r] = __builtin_amdgcn_sqrtf(om) * gx * u;
                        A_[dir][rt][r] = a_[r]; B_[dir][rt][r] = b_[r];
                    }
                    const float P = (a_[0] * a_[1]) * (a_[2] * a_[3]);
                    const float S = dir == 0 ? ((b_[0] * a_[1] + b_[1]) * a_[2] + b_[2]) * a_[3] + b_[3] : ((b_[3] * a_[2] + b_[2]) * a_[1] + b_[1]) * a_[0] + b_[0];
                    const float Pp = __shfl_xor(P, 16), Sp = __shfl_xor(S, 16);
                    const float e1P = sec16 ? Pp : 1.f, e1S = sec16 ? Sp : 0.f;
                    const float prP = P * Pp, prS = sec16 ? P * Sp + S : Pp * S + Sp;
                    const float Pq = __shfl_xor(prP, 32), Sq = __shfl_xor(prS, 32);
                    EP[dir][rt] = sec32 ? Pq * e1P : e1P; ES[dir][rt] = sec32 ? e1P * Sq + e1S : e1S;
                    TP[dir][rt] = prP * Pq; TS[dir][rt] = sec32 ? prP * Sq + prS : Pq * prS + Sq;
                }
            }
            bf16 gr[2][2][4];
            if (comb && outp) {
#pragma unroll
                for (int dir = 0; dir < 2; ++dir) { const bf16* gp = PROJ + (size_t)(tile_row0(s, dir) + 4 * g) * IND + 2304 + 16 * cg + j16;
#pragma unroll
                    for (int rt = 0; rt < 2; ++rt)
#pragma unroll
                        for (int r = 0; r < 4; ++r) gr[dir][rt][r] = gp[(size_t)(16 * rt + r) * IND]; }
            }
            float hin[2] = {0.f, 0.f};
            if (s > 0) {
                while (__builtin_amdgcn_readfirstlane(cflag[s - 1]) == 0u) __builtin_amdgcn_s_sleep(1);
                asm volatile("" ::: "memory");
                hin[0] = chain[((s - 1) * 2 + 0) * 16 + j16]; hin[1] = chain[((s - 1) * 2 + 1) * 16 + j16];
            }
#pragma unroll
            for (int dir = 0; dir < 2; ++dir) { const int rf = dir == 0 ? 0 : 1, rs_ = 1 - rf;
                const float hout = (TP[dir][rf] * TP[dir][rs_]) * hin[dir] + (TP[dir][rs_] * TS[dir][rf] + TS[dir][rs_]);
                if (g == 0) chain[(s * 2 + dir) * 16 + j16] = hout; }
            asm volatile("" ::: "memory");
            cflag[s] = 1u;
            asm volatile("" ::: "memory");
#pragma unroll
            for (int dir = 0; dir < 2; ++dir) { const int rf = dir == 0 ? 0 : 1, rs_ = 1 - rf;
                float hv[2][4];
                { float h = EP[dir][rf] * hin[dir] + ES[dir][rf];
                  if (dir == 0) {
#pragma unroll
                      for (int r = 0; r < 4; ++r) { h = A_[dir][rf][r] * h + B_[dir][rf][r]; hv[rf][r] = h; }
                  } else {
#pragma unroll
                      for (int r = 3; r >= 0; --r) { h = A_[dir][rf][r] * h + B_[dir][rf][r]; hv[rf][r] = h; }
                  } }
                { const float hm = TP[dir][rf] * hin[dir] + TS[dir][rf]; float h = EP[dir][rs_] * hm + ES[dir][rs_];
                  if (dir == 0) {
#pragma unroll
                      for (int r = 0; r < 4; ++r) { h = A_[dir][rs_][r] * h + B_[dir][rs_][r]; hv[rs_][r] = h; }
                  } else {
#pragma unroll
                      for (int r = 3; r >= 0; --r) { h = A_[dir][rs_][r] * h + B_[dir][rs_][r]; hv[rs_][r] = h; }
                  } }
                if (outp) {
                    const int id = s < 8 ? (dir == 0 ? s : 7 - s) : (dir == 0 ? s : 79 - s);
                    LAS v4u* hb = (LAS v4u*)(F.lds + id * 1024 + lane * 16);
                    if (!comb) {
                        *hb = (v4u){pg8::cvt_pk_bf16(hv[0][0], hv[0][1]), pg8::cvt_pk_bf16(hv[0][2], hv[0][3]), pg8::cvt_pk_bf16(hv[1][0], hv[1][1]), pg8::cvt_pk_bf16(hv[1][2], hv[1][3])};
                        asm volatile("" ::: "memory");
                        hflag[id] = 1u;
                        asm volatile("" ::: "memory");
                    } else {
                        while (__builtin_amdgcn_readfirstlane(hflag[id]) == 0u) __builtin_amdgcn_s_sleep(1);
                        asm volatile("" ::: "memory");
                        const v4u o = *hb;
                        const float ot[2][4] = {{bflo(o.x), bfhi(o.x), bflo(o.y), bfhi(o.y)}, {bflo(o.z), bfhi(o.z), bflo(o.w), bfhi(o.w)}};
                        bf16* mp = WSP(bf16, WS_MIX) + (size_t)(tile_row0(s, dir) + 4 * g) * D + 768 + 16 * cg + j16;
#pragma unroll
                        for (int rt = 0; rt < 2; ++rt)
#pragma unroll
                            for (int r = 0; r < 4; ++r) mp[(size_t)(16 * rt + r) * D] = (bf16)f2bf(gelu_tanh(bf1(gr[dir][rt][r])) * (hv[rt][r] + ot[rt][r]));
                    }
                }
            }
        }
    }
}

__device__ __forceinline__ void lru_carry(Frame& F) {
    const f32x2* TOT = WSP(const f32x2, WS_TOT); float* CARRY = WSP(float, WS_CARRY);
    for (int it = F.gw; it < NB * 2 * 4; it += F.NGW) {
        const int b = it >> 3, dir = (it >> 2) & 1, c = (it & 3) * 64 + F.lane;
        float h = 0.f;
        for (int g = 0; g < 18; ++g) {
            f32x2 ps[4]; int tl[4];
#pragma unroll
            for (int i = 0; i < 4; ++i) { const int s = g * 4 + i;
                int T; if (s < 8) T = 1024 + b * 8 + (dir == 0 ? s : 7 - s); else T = b * 64 + (dir == 0 ? s - 8 : 71 - s);
                tl[i] = T; ps[i] = TOT[((size_t)dir * 1152 + T) * 256 + c]; }
#pragma unroll
            for (int i = 0; i < 4; ++i) { CARRY[((size_t)dir * 1152 + tl[i]) * 256 + c] = h; h = ps[i][0] * h + ps[i][1]; }
        }
    }
}

__device__ __forceinline__ void ctx_finalize(Frame& F, int l) {
    bf16* XA = WSP(bf16, WS_XA); float* RSSA = WSP(float, WS_RSSA); const float* ACC = WSP(const float, WS_PART); const float* MOD = WSP(const float, WS_MOD);
    const float* go = INP(5) + (l - 1) * D; const float* gso = MOD + ((size_t)(l - 1) * 17 + NB) * MODW + 4 * D;
    const float* gn = INP(4) + l * D; const float* gsn = MOD + ((size_t)l * 17 + NB) * MODW + D;
    for (int r = F.gw; r < MC; r += F.NGW) {
        const size_t row = (size_t)ML + r;
        float ss = 0.f; f32x4 y[4];
#pragma unroll
        for (int j = 0; j < 4; ++j) { const int k = 4 * F.lane + 256 * j;
            const v2u w = *(const v2u*)(XA + row * D + k);
            const f32x4 im = *(const f32x4*)(go + k) * (*(const f32x4*)(gso + k) + 1.0f);
            const f32x4 xo = (f32x4){bflo(w.x) * __builtin_amdgcn_rcpf(im[0]), bfhi(w.x) * __builtin_amdgcn_rcpf(im[1]), bflo(w.y) * __builtin_amdgcn_rcpf(im[2]), bfhi(w.y) * __builtin_amdgcn_rcpf(im[3])};
            const float* ap = ACC + (size_t)r * D + k;
            y[j] = xo + ((*(const f32x4*)ap + *(const f32x4*)(ap + (size_t)MC * D)) + (*(const f32x4*)(ap + (size_t)2 * MC * D) + *(const f32x4*)(ap + (size_t)3 * MC * D)));
            ss += (y[j][0] * y[j][0] + y[j][1] * y[j][1]) + (y[j][2] * y[j][2] + y[j][3] * y[j][3]); }
        ss = wave_sum(ss);
        if (F.lane < 32) RSSA[row * 32 + F.lane] = (F.lane == 0) ? ss : 0.f;
#pragma unroll
        for (int j = 0; j < 4; ++j) { const int k = 4 * F.lane + 256 * j;
            const f32x4 a = y[j] * (*(const f32x4*)(gn + k) * (*(const f32x4*)(gsn + k) + 1.0f));
            v2u o; o.x = pk2(a[0], a[1]); o.y = pk2(a[2], a[3]); *(v2u*)(XA + row * D + k) = o; }
    }
}

__device__ __forceinline__ void final_rows(Frame& F) {
    const bf16* XA = WSP(const bf16, WS_XA); const float* RSS = WSP(const float, WS_RSSA);
    for (int row = F.gw; row < ML; row += 2 * F.NGW) {
        const int row2 = row + F.NGW; const bool two = row2 < ML;
        const v4u a0 = *(const v4u*)(XA + (size_t)row * D + 8 * F.lane), a1 = *(const v4u*)(XA + (size_t)row * D + 512 + 8 * F.lane);
        const float p0 = F.lane < 32 ? RSS[(size_t)row * 32 + F.lane] : 0.f;
        v4u b0 = a0, b1 = a1; float p1 = 0.f;
        if (two) { b0 = *(const v4u*)(XA + (size_t)row2 * D + 8 * F.lane); b1 = *(const v4u*)(XA + (size_t)row2 * D + 512 + 8 * F.lane); p1 = F.lane < 32 ? RSS[(size_t)row2 * 32 + F.lane] : 0.f; }
        const float rs0 = rsqrtf(wave_sum(p0) * (1.f / D) + EPS), rs1 = rsqrtf(wave_sum(p1) * (1.f / D) + EPS);
        float* o = F.out + (size_t)row * D + 8 * F.lane;
        *(f32x4*)(o) = (f32x4){bflo(a0.x), bfhi(a0.x), bflo(a0.y), bfhi(a0.y)} * rs0; *(f32x4*)(o + 4) = (f32x4){bflo(a0.z), bfhi(a0.z), bflo(a0.w), bfhi(a0.w)} * rs0;
        *(f32x4*)(o + 512) = (f32x4){bflo(a1.x), bfhi(a1.x), bflo(a1.y), bfhi(a1.y)} * rs0; *(f32x4*)(o + 516) = (f32x4){bflo(a1.z), bfhi(a1.z), bflo(a1.w), bfhi(a1.w)} * rs0;
        if (two) { float* o2 = F.out + (size_t)row2 * D + 8 * F.lane;
            *(f32x4*)(o2) = (f32x4){bflo(b0.x), bfhi(b0.x), bflo(b0.y), bfhi(b0.y)} * rs1; *(f32x4*)(o2 + 4) = (f32x4){bflo(b0.z), bfhi(b0.z), bflo(b0.w), bfhi(b0.w)} * rs1;
            *(f32x4*)(o2 + 512) = (f32x4){bflo(b1.x), bfhi(b1.x), bflo(b1.y), bfhi(b1.y)} * rs1; *(f32x4*)(o2 + 516) = (f32x4){bflo(b1.z), bfhi(b1.z), bflo(b1.w), bfhi(b1.w)} * rs1; }
    }
}

__device__ __forceinline__ void fill_res_tables(Frame& F, const pg8::Order& S, const float* gate, const float* gmg, const float* gmsc, const float* go, const float* gso) {
    LAS float* T = (LAS float*)(F.lds + TBL_OFF);
    if (F.tid < 256) {
#pragma unroll 1
        for (int i = 0; i < pg8::TBL_UNITS; ++i) { pg8::Unit u; if (!S.next(i, u)) break;
            const int brow = u.pm < ML / 256 ? (u.pm >> 3) : NB, col = u.pn * 256 + F.tid;
            T[i * 256 + F.tid] = gate[(size_t)brow * MODW + col];
            T[(pg8::TBL_UNITS + i) * 256 + F.tid] = gmg[col] * (1.f + gmsc[(size_t)brow * MODW + col]);
            T[(2 * pg8::TBL_UNITS + i) * 256 + F.tid] = __builtin_amdgcn_rcpf(go[col] * (1.f + gso[(size_t)brow * MODW + col])); }
    }
    __syncthreads();
}

template <int LDC>
__device__ __forceinline__ void fill_scale_tables(Frame& F, const pg8::Order& S, const float* RSS, const float* shw) {
    LAS float* RS_T = (LAS float*)(F.lds + TBL_OFF); LAS float* SH_T = RS_T + pg8::TBL_UNITS * 256;
    const int row = F.tid >> 1, half = F.tid & 1;
#pragma unroll 1
    for (int i0 = 0; i0 < pg8::TBL_UNITS; i0 += 3) {
        f32x4 p[3][4], sv[3]; bool ok[3];
#pragma unroll
        for (int j = 0; j < 3; ++j) { pg8::Unit u; ok[j] = S.next(i0 + j, u);
            if (ok[j]) { const float* b = RSS + ((size_t)u.pm * 256 + row) * 32 + 16 * half;
#pragma unroll
                for (int q = 0; q < 4; ++q) p[j][q] = *(const f32x4*)(b + 4 * q);
                if (F.tid < 64) sv[j] = *(const f32x4*)(shw + (size_t)(u.pm < ML / 256 ? (u.pm >> 3) : NB) * LDC + u.pn * 256 + 4 * F.tid); } }
#pragma unroll
        for (int j = 0; j < 3; ++j) if (ok[j]) {
            float s = 0.f;
#pragma unroll
            for (int q = 0; q < 4; ++q) s += (p[j][q][0] + p[j][q][1]) + (p[j][q][2] + p[j][q][3]);
            s += __shfl_xor(s, 1);
            if (half == 0) RS_T[(i0 + j) * 256 + row] = rsqrtf(s * (1.0f / D) + EPS);
            if (F.tid < 64) *(LAS f32x4*)(SH_T + (i0 + j) * 256 + 4 * F.tid) = sv[j]; }
    }
    __syncthreads();
}

constexpr int N_PHASES = 2 + 5 * DEPTH + 1;
struct Args { const float* in[25]; float* out; unsigned char* ws; int ph_lo, ph_hi; };
static_assert(sizeof(Args) == 27 * 8 + 8, "Args has no padding");

__global__ void __launch_bounds__(NWAVES * 64, 2) mega_fwd(Args args) {
    extern __shared__ __attribute__((aligned(16))) unsigned char lds[];
    Frame F;
    F.lds = (LAS unsigned char*)lds;
    const int wave_s = __builtin_amdgcn_readfirstlane((int)threadIdx.x >> 6);
    F.wave = wave_s; F.lane = (int)__builtin_amdgcn_mbcnt_hi(~0u, __builtin_amdgcn_mbcnt_lo(~0u, 0u)); F.tid = wave_s * 64 + F.lane;
    F.G = gridDim.x; { const int bx = blockIdx.x; F.vcu = (F.G % 8 == 0) ? (bx % 8) * (F.G / 8) + bx / 8 : bx; }
    F.gw = F.vcu * NWAVES + F.wave; F.NGW = F.G * NWAVES;
    F.out = args.out; F.ws = args.ws;
    volatile LAS unsigned* MISC = (volatile LAS unsigned*)(F.lds + MISC_OFF);
    for (int u = F.tid; u < (LDS_BYTES - LDSCTL_OFF) / 4; u += NWAVES * 64) ((LAS unsigned*)(F.lds + LDSCTL_OFF))[u] = 0u;
    __syncthreads();
    if (F.tid == 0) {
#pragma unroll
        for (int i = 0; i < 25; ++i) *(LAS unsigned long long*)(F.lds + PTR_OFF + 8 * i) = (unsigned long long)args.in[i];
    }
    __syncthreads();
    XcdBarrier bar = xcd_barrier_post((unsigned*)(F.ws + WS_CTL) + CW_BAR, MISC + 8, F.tid);

    const int lo = args.ph_lo, hi = args.ph_hi;
#ifdef PROBE_MASK
    bool rep_done = false;
#define PROBE_V ((((PROBE_MASK >> ph) & 1) && !rep_done) ? PROBE_VARIANT : 0)
#else
#define PROBE_V 0
#endif
    for (int ph = lo; ph < hi; ++ph) {
        { unsigned ones_ = ~0u; asm volatile("" : "+s"(ones_));
          int t_ = wave_s * 64 + (int)__builtin_amdgcn_mbcnt_hi(ones_, __builtin_amdgcn_mbcnt_lo(ones_, 0u)); asm volatile("" : "+v"(t_)); F.tid = t_; F.lane = t_ & 63; F.wave = __builtin_amdgcn_readfirstlane(t_ >> 6); F.gw = F.vcu * NWAVES + F.wave; }
        if (ph == 0) {
#ifndef NO_P0
            phase_p0a(F);
#endif
        } else if (ph == 1) {
#ifndef NO_P0
            phase_p0b(F);
#endif
        }
        else if (ph == N_PHASES - 1) final_rows(F);
        else {
            const int l = (ph - 2) / 5, k5 = (ph - 2) % 5, k = k5 < 2 ? k5 : k5 + 2; const bool last = (l == DEPTH - 1);
            const int Mx = last ? ML : MT;
            float* MOD = WSP(float, WS_MOD);
            if (k == 0) {
                if (l > 0) { ctx_finalize(F, l); xcd_barrier(bar, F.tid); }
                pg8::Gemm g{WSP(const bf16, WS_XA), WSP(const bf16, WS_WIN) + (size_t)l * IND * D, MT, IND, D};
                pg8::Order S; if (last) S.init(ML, IND, WGM_IN, (MC / 256) * 5, 1, F.G, (int)blockIdx.x); else S.init(MT, IND, WGM_IN, 0, 0, F.G, (int)blockIdx.x);
                fill_scale_tables<IND>(F, S, WSP(const float, WS_RSSA), WSP(const float, WS_SHW1) + (size_t)l * 17 * IND);
                pg8::EpiScale<0, IND, true> E{WSP(bf16, WS_PROJ), (const LAS float*)(F.lds + TBL_OFF), PROBE_V};

#ifndef NO_G0
                pg8::gemm_phase<pg8::EpiScale<0, IND, true>, pg8::Order, true, true>(F.lds + RING_OFF, g, S, E, F.tid);
#endif

            } else if (k == 1) {

#ifndef NO_LRU
                lru_seq_phase(F, l, last);
#ifdef REP_LRU0
                __syncthreads(); lru_seq_phase(F, l, last);
#endif
#endif

                __syncthreads();
#ifndef NO_CONV
                conv_phase(F, l, last ? 1024 : 1152);
                __syncthreads();
#ifdef REP_CONV
                conv_phase(F, l, last ? 1024 : 1152);
                __syncthreads();
#endif
#endif
#ifndef NO_NA
#ifdef REP_NA
                na_phase(F, l, last ? NA_ITEMS_LAT : NA_ITEMS_LAT + NA_ITEMS_CTX, REP_NA);
#else
                na_phase(F, l, last ? NA_ITEMS_LAT : NA_ITEMS_LAT + NA_ITEMS_CTX);
#endif
#ifdef REP_NA
                __syncthreads(); na_phase(F, l, last ? NA_ITEMS_LAT : NA_ITEMS_LAT + NA_ITEMS_CTX, 0);
#endif
#endif
            } else if (k == 4 || k == 6) {
                const bool dn = (k == 6);
                const int ln = (dn && !last) ? l + 1 : l;
                pg8::Gemm g{dn ? WSP(const bf16, WS_HID) : WSP(const bf16, WS_MIX), dn ? WSP(const bf16, WS_W2) + (size_t)l * D * FF : WSP(const bf16, WS_WOUT) + (size_t)l * D * D, Mx, D, dn ? FF : D};
                const bool splitk = dn && !last;
                pg8::Order S; S.init(splitk ? ML : Mx, D, dn ? WGM_DN : WGM_OUT, 0, 0, F.G, (int)blockIdx.x);
                const float* go_g = dn ? INP(5) + l * D : INP(4) + l * D;
                const float* go_s = MOD + (size_t)l * 17 * MODW + (dn ? 4 : 1) * D;
                const bool fin = dn && last;
                fill_res_tables(F, S, MOD + (size_t)l * 17 * MODW + (dn ? 5 : 2) * D, fin ? INP(24) : (dn ? INP(4) : INP(5)) + ln * D, fin ? WSP(const float, WS_ZERO) : MOD + (size_t)ln * 17 * MODW + (dn ? 1 : 4) * D, go_g, go_s);
                pg8::EpiRes<RES_NB> E{(const LAS float*)(F.lds + TBL_OFF), WSP(bf16, WS_XA), dn ? WSP(float, WS_RSSA) : WSP(float, WS_RSSB)};
#ifndef NO_GR
                pg8::gemm_phase<pg8::EpiRes<RES_NB>, pg8::Order, true, true>(F.lds + RING_OFF, g, S, E, F.tid);
                if (splitk) {
                    pg8::Order S2; S2.init(ML, 0, 4, (MC / 256) * 16, 2, F.G, (int)blockIdx.x);
                    pg8::EpiSlab E2{WSP(float, WS_PART), MOD + ((size_t)l * 17 + NB) * MODW + 5 * D};
                    pg8::gemm_phase<pg8::EpiSlab, pg8::Order, true, true, true>(F.lds + RING_OFF, g, S2, E2, F.tid);
                }
#endif
            } else if (k == 5) {
                pg8::Gemm g{WSP(const bf16, WS_XA), WSP(const bf16, WS_W1) + (size_t)l * FF * D, Mx, FF, D};
                pg8::Order S; S.init(Mx, FF, WGM_UP, 0, 0, F.G, (int)blockIdx.x);
                fill_scale_tables<FF>(F, S, WSP(const float, WS_RSSB), WSP(const float, WS_SHW2) + (size_t)l * 17 * FF);
                pg8::EpiScale<1, FF> E{WSP(bf16, WS_HID), (const LAS float*)(F.lds + TBL_OFF), PROBE_V};

#ifndef NO_G1
                pg8::gemm_phase<pg8::EpiScale<1, FF>, pg8::Order, true, true>(F.lds + RING_OFF, g, S, E, F.tid);
#endif

            }
        }
#ifdef PROBE_MASK
        if (((PROBE_MASK >> ph) & 1) && !rep_done) { rep_done = true; xcd_barrier(bar, F.tid); --ph; continue; }
        rep_done = false;
#endif
        if (ph + 1 < hi) xcd_barrier(bar, F.tid);
#ifdef PROBE_BAR2
        if (ph + 1 < hi) xcd_barrier(bar, F.tid);
#endif
    }
}

extern "C" void kernel_launch(void* const* d_in, const int* in_sizes, int n_in, void* d_out, int out_size, void* d_ws, size_t ws_size, hipStream_t stream) {
    static int grid = 0;
    if (grid == 0) {
        if (n_in != 25 || out_size != ML * D || ws_size < WS_END) { fprintf(stderr, "kernel_launch: unexpected shapes (n_in %d out %d ws %zu)\n", n_in, out_size, ws_size); grid = -1; return; }
        int dev = 0, cus = 0;
        if (hipGetDevice(&dev) != hipSuccess || hipDeviceGetAttribute(&cus, hipDeviceAttributeMultiprocessorCount, dev) != hipSuccess) { grid = -1; return; }
        if (hipFuncSetAttribute((const void*)mega_fwd, hipFuncAttributeMaxDynamicSharedMemorySize, LDS_BYTES) != hipSuccess) { fprintf(stderr, "kernel_launch: hipFuncSetAttribute failed\n"); grid = -1; return; }
        int per_cu = 0;
        if (hipOccupancyMaxActiveBlocksPerMultiprocessor(&per_cu, (const void*)mega_fwd, NWAVES * 64, LDS_BYTES) != hipSuccess || per_cu < 1) fprintf(stderr, "kernel_launch: occupancy query reports %d\n", per_cu);
        (void)hipGetLastError();
        grid = cus;
    }
    if (grid < 0) return;
    if (hipMemsetAsync((char*)d_ws + WS_CTL, 0, CTL_ZERO_BYTES, stream) != hipSuccess) return;
    Args a{};
    for (int i = 0; i < 25; ++i) a.in[i] = (const float*)d_in[i];
    a.out = (float*)d_out; a.ws = (unsigned char*)d_ws;
#if MK_N_LAUNCHES == 1
    a.ph_lo = 0; a.ph_hi = N_PHASES;
    hipLaunchKernelGGL(mega_fwd, dim3(grid), dim3(NWAVES * 64), LDS_BYTES, stream, a);
#else
    for (int ph = 0; ph < N_PHASES; ++ph) { a.ph_lo = ph; a.ph_hi = ph + 1; hipLaunchKernelGGL(mega_fwd, dim3(grid), dim3(NWAVES * 64), LDS_BYTES, stream, a); }
#endif
}
```

```cpp
#include <hip/hip_runtime.h>
#include <cstdio>
#include <cstdint>

constexpr int D = 1024, NB = 16, SEQ = 2048, CTXL = 256, DEPTH = 2;
constexpr int ML = NB * SEQ, MC = NB * CTXL, MT = ML + MC;
constexpr int IND = 2560, FF = 4096, NH = 8, HD = 64;
constexpr int MODW = 6 * D;
constexpr float EPS = 1e-6f;
#ifndef MK_N_LAUNCHES
#define MK_N_LAUNCHES 1
#endif

namespace pg8 {
#define PG8_LAS __attribute__((address_space(3)))
typedef unsigned short bf16_t;
typedef short bf16x8 __attribute__((ext_vector_type(8)));
typedef float f32x4 __attribute__((ext_vector_type(4)));
typedef unsigned u32x4 __attribute__((ext_vector_type(4)));
constexpr int BM = 256, BK = 64, HALF = 128, HTB = HALF * BK * 2, STAGE_BYTES = 8 * HTB, NXCD = 8;
constexpr int TBL_UNITS = 9;

__host__ __device__ __forceinline__ int lds_byte(int r, int c) { const int st = (r >> 4) * 2 + (c >> 5), rr = r & 15, cc = c & 31, ob = rr * 64 + cc * 2; return st * 1024 + (ob ^ (((ob >> 9) & 1) << 5)); }
__host__ __device__ __forceinline__ void stage_rc(int b, int& R, int& C) { const int st = b / 1024, sb = b % 1024, swz = sb ^ (((sb >> 9) & 1) << 5); R = (st >> 1) * 16 + swz / 64; C = (st & 1) * 32 + (swz % 64) / 2; }
__host__ __device__ __forceinline__ int perm32(int rho) { const int n = rho >> 4, i = rho & 15; return 8 * (i >> 2) + 4 * n + (i & 3); }

struct Unit { int pm, pn; };
struct Gemm { const bf16_t* A; const bf16_t* Bt; int M, N, K; };

__host__ __device__ __forceinline__ void map_tile(int wgid, int nM, int nN, int WGM, Unit& u) {
    const int nwg = nM * nN;
    { const int q = nwg / NXCD, r = nwg % NXCD, xcd = wgid % NXCD, off = wgid / NXCD; wgid = (xcd < r ? xcd * (q + 1) : r * (q + 1) + (xcd - r) * q) + off; }
    const int nig = WGM * nN, gid = wgid / nig, fm = gid * WGM, gsz = (nM - fm) < WGM ? (nM - fm) : WGM;
    u.pm = fm + ((wgid % nig) % gsz); u.pn = (wgid % nig) / gsz;
}
struct Order {
    int nM, nN, nwg, extra, mode, wgm, G, c;
    __host__ __device__ void init(int M, int N, int wgm_, int extra_, int mode_, int G_, int c_) { nM = M / BM; nN = N / BM; nwg = nM * nN; extra = extra_; mode = mode_; wgm = wgm_; G = G_; c = c_; }
    __host__ __device__ bool next(int i, Unit& u) const {
        const long L = (long)i * G + c;
        if (L < nwg) { map_tile((int)L, nM, nN, wgm, u); return true; }
        if (L < nwg + extra) { const int q = (int)L - nwg;
            if (mode == 1) { u.pm = nM + q / 5; u.pn = 4 + q % 5; }
            else { u.pm = nM + (q >> 4); u.pn = 4 + 4 * (q & 3) + ((q >> 2) & 3); }
            return true; }
        return false;
    }
    __device__ __forceinline__ void a_ready(const Unit&) const {}
    __device__ __forceinline__ void done(const Unit&) const {}
};

__device__ __forceinline__ unsigned cvt_pk_bf16(float lo, float hi) { unsigned r; asm volatile("v_cvt_pk_bf16_f32 %0, %1, %2" : "=v"(r) : "v"(lo), "v"(hi)); return r; }

template <int ACT, int LDC, bool GLU = false> struct EpiScale {
    static constexpr bool PERM = true, AFTER_DRAIN = false;
    bf16_t* O;
    const PG8_LAS float* tbl;
    int probe;
    __device__ __forceinline__ void operator()(const f32x4 (&acc)[2][2][4][2], const Unit& u, int wr, int wc, int fr, int fq, int ui) const {
        asm volatile("" : "+s"(wr), "+s"(wc));
        bf16_t* Ot = O + (size_t)u.pm * BM * LDC + u.pn * BM;
        unsigned cl = (unsigned)(wc * 32 + 8 * fq);
        unsigned rl0 = (unsigned)(wr * 64 + fr);
        asm volatile("" : "+v"(cl), "+v"(rl0));
        const PG8_LAS float* rst = tbl + ui * 256, * sht = tbl + TBL_UNITS * 256 + ui * 256;
        f32x4 sh[2][2]; float rs[2][4];
#pragma unroll
        for (int ai = 0; ai < 2; ++ai)
#pragma unroll
            for (int m = 0; m < 4; ++m) rs[ai][m] = rst[rl0 + (unsigned)(ai * HALF + m * 16)];
#pragma unroll
        for (int bj = 0; bj < 2; ++bj) { sh[bj][0] = *(const PG8_LAS f32x4*)(sht + (cl + (unsigned)(bj * HALF))); sh[bj][1] = *(const PG8_LAS f32x4*)(sht + (cl + (unsigned)(bj * HALF + 4))); }
        if (GLU && u.pn < 2) {
#pragma unroll
            for (int ai = 0; ai < 2; ++ai)
#pragma unroll
                for (int m = 0; m < 4; ++m) {
                    const f32x4 a0 = acc[ai][0][m][0] * rs[ai][m] + sh[0][0], a1 = acc[ai][0][m][1] * rs[ai][m] + sh[0][1];
                    const f32x4 g0 = acc[ai][1][m][0] * rs[ai][m] + sh[1][0], g1 = acc[ai][1][m][1] * rs[ai][m] + sh[1][1];
                    f32x4 v0, v1;
#pragma unroll
                    for (int e = 0; e < 4; ++e) { v0[e] = a0[e] * __builtin_amdgcn_rcpf(1.f + __builtin_amdgcn_exp2f(-1.4426950408889634f * g0[e])); v1[e] = a1[e] * __builtin_amdgcn_rcpf(1.f + __builtin_amdgcn_exp2f(-1.4426950408889634f * g1[e])); }
                    u32x4 w; w.x = cvt_pk_bf16(v0[0], v0[1]); w.y = cvt_pk_bf16(v0[2], v0[3]); w.z = cvt_pk_bf16(v1[0], v1[1]); w.w = cvt_pk_bf16(v1[2], v1[3]);
                    *(u32x4*)(O + (size_t)u.pm * BM * LDC + u.pn * HALF + ((rl0 + (unsigned)(ai * HALF + m * 16)) * (unsigned)LDC + cl)) = w;
                }
            return;
        }
#pragma unroll
        for (int bj = 0; bj < 2; ++bj)
#pragma unroll
            for (int ai = 0; ai < 2; ++ai)
#pragma unroll
                for (int m = 0; m < 4; ++m) {
                    f32x4 v0 = acc[ai][bj][m][0] * rs[ai][m] + sh[bj][0], v1 = acc[ai][bj][m][1] * rs[ai][m] + sh[bj][1];
                    if (ACT == 1) {
#pragma unroll
                        for (int e = 0; e < 4; ++e) { const float a = fmaxf(v0[e], 0.f), b = fmaxf(v1[e], 0.f); v0[e] = a * a; v1[e] = b * b; }
                    }
                    u32x4 w; w.x = cvt_pk_bf16(v0[0], v0[1]); w.y = cvt_pk_bf16(v0[2], v0[3]); w.z = cvt_pk_bf16(v1[0], v1[1]); w.w = cvt_pk_bf16(v1[2], v1[3]);
                    if (probe == 0) *(u32x4*)(Ot + ((rl0 + (unsigned)(ai * HALF + m * 16)) * (unsigned)LDC + cl + (unsigned)(bj * HALF))) = w;
                    else asm volatile("" :: "v"(w));
                }
    }
};
template <int NB_> struct EpiRes {
    static constexpr bool PERM = true, AFTER_DRAIN = false;
    const PG8_LAS float* tbl;
    bf16_t* XA; float* RSS;
    __device__ __forceinline__ void operator()(const f32x4 (&acc)[2][2][4][2], const Unit& u, int wr, int wc, int fr, int fq, int ui) const {
        asm volatile("" : "+s"(wr), "+s"(wc));
        bf16_t* XAt = XA + (size_t)u.pm * BM * D + u.pn * BM;
        float* RSSt = RSS + (size_t)u.pm * BM * 32 + u.pn * 8 + wc;
        unsigned cl = (unsigned)(wc * 32 + 8 * fq);
        unsigned rl0 = (unsigned)(wr * 64 + fr);
        asm volatile("" : "+v"(cl), "+v"(rl0));
        const PG8_LAS float* gT = tbl + ui * 256, * mT = tbl + (TBL_UNITS + ui) * 256, * iT = tbl + (2 * TBL_UNITS + ui) * 256;
        constexpr int BJB = 2 / NB_;
#pragma unroll
        for (int b0 = 0; b0 < 2; b0 += BJB) {
            u32x4 xb[BJB][2][4];
#pragma unroll
            for (int bb = 0; bb < BJB; ++bb)
#pragma unroll
                for (int ai = 0; ai < 2; ++ai)
#pragma unroll
                    for (int m = 0; m < 4; ++m) xb[bb][ai][m] = *(const u32x4*)(XAt + ((rl0 + (unsigned)(ai * HALF + m * 16)) * (unsigned)D + cl + (unsigned)((b0 + bb) * HALF)));
            asm volatile("" ::: "memory");
#pragma unroll
            for (int bb = 0; bb < BJB; ++bb) {
                const int bj = b0 + bb;
                const unsigned c = cl + (unsigned)(bj * HALF);
                const f32x4 g0 = *(const PG8_LAS f32x4*)(gT + c), g1 = *(const PG8_LAS f32x4*)(gT + (c + 4u)), m0 = *(const PG8_LAS f32x4*)(mT + c), m1 = *(const PG8_LAS f32x4*)(mT + (c + 4u)),
                            r0 = *(const PG8_LAS f32x4*)(iT + c), r1 = *(const PG8_LAS f32x4*)(iT + (c + 4u));
#pragma unroll
                for (int ai = 0; ai < 2; ++ai)
#pragma unroll
                    for (int m = 0; m < 4; ++m) {
                        const unsigned rl = rl0 + (unsigned)(ai * HALF + m * 16);
                        const u32x4 w = xb[bb][ai][m];
                        const f32x4 x0 = (f32x4){__uint_as_float(w.x << 16), __uint_as_float(w.x & 0xffff0000u), __uint_as_float(w.y << 16), __uint_as_float(w.y & 0xffff0000u)} * r0;
                        const f32x4 x1 = (f32x4){__uint_as_float(w.z << 16), __uint_as_float(w.z & 0xffff0000u), __uint_as_float(w.w << 16), __uint_as_float(w.w & 0xffff0000u)} * r1;
                        const f32x4 y0 = x0 + g0 * acc[ai][bj][m][0], y1 = x1 + g1 * acc[ai][bj][m][1];
                        float ss = ((y0[0] * y0[0] + y0[1] * y0[1]) + (y0[2] * y0[2] + y0[3] * y0[3])) + ((y1[0] * y1[0] + y1[1] * y1[1]) + (y1[2] * y1[2] + y1[3] * y1[3]));
                        ss += __shfl_xor(ss, 16); ss += __shfl_xor(ss, 32);
                        if (fq == 0) RSSt[rl * 32u + (unsigned)(bj * 4)] = ss;
                        const f32x4 a0 = y0 * m0, a1 = y1 * m1;
                        u32x4 o; o.x = cvt_pk_bf16(a0[0], a0[1]); o.y = cvt_pk_bf16(a0[2], a0[3]); o.z = cvt_pk_bf16(a1[0], a1[1]); o.w = cvt_pk_bf16(a1[2], a1[3]);
                        *(u32x4*)(XAt + (rl * (unsigned)D + c)) = o;
                    }
            }
            asm volatile("" ::: "memory");
        }
    }
};

struct EpiSlab {
    static constexpr bool PERM = true, AFTER_DRAIN = false;
    float* P; const float* gate;
    __device__ __forceinline__ void operator()(const f32x4 (&acc)[2][2][4][2], const Unit& u, int wr, int wc, int fr, int fq, int) const {
        asm volatile("" : "+s"(wr), "+s"(wc));
        const int ks = (u.pn - 4) >> 2, pn = u.pn & 3;
        float* At = P + ((size_t)ks * MC + (size_t)(u.pm - ML / BM) * BM) * D + pn * BM;
        const float* gtq = gate + pn * BM;
        unsigned cl = (unsigned)(wc * 32 + 8 * fq), rl0 = (unsigned)(wr * 64 + fr);
        asm volatile("" : "+v"(cl), "+v"(rl0));
        f32x4 gv[2][2];
#pragma unroll
        for (int bj = 0; bj < 2; ++bj) { gv[bj][0] = *(const f32x4*)(gtq + (cl + (unsigned)(bj * HALF))); gv[bj][1] = *(const f32x4*)(gtq + (cl + (unsigned)(bj * HALF + 4))); }
#pragma unroll
        for (int bj = 0; bj < 2; ++bj) { const unsigned c = cl + (unsigned)(bj * HALF);
#pragma unroll
            for (int ai = 0; ai < 2; ++ai)
#pragma unroll
                for (int m = 0; m < 4; ++m) { const unsigned off = (rl0 + (unsigned)(ai * HALF + m * 16)) * (unsigned)D + c;
                    *(f32x4*)(At + off) = gv[bj][0] * acc[ai][bj][m][0]; *(f32x4*)(At + (off + 4u)) = gv[bj][1] * acc[ai][bj][m][1]; } }
    }
};

template <class Epi, class Sched, bool ALIGN_EPI = false, bool SP2 = false, bool VARK = false>
__device__ __forceinline__ void gemm_phase(PG8_LAS unsigned char* lds, const Gemm g, const Sched& S, const Epi& E, const int tid) {
    const int wid = __builtin_amdgcn_readfirstlane(tid >> 6), lane = tid & 63, wr = wid >> 2, wc = wid & 3, fr = lane & 15, fq = lane >> 4;
    const int K = g.K;
    unsigned voffA[2], voffB[2];
#pragma unroll
    for (int i = 0; i < 2; ++i) { int R, C; stage_rc(tid * 16 + i * 8192, R, C); const int Rb = Epi::PERM ? ((R & ~31) + perm32(R & 31)) : R;
        voffA[i] = (unsigned)(R * K + C) * 2u; voffB[i] = (unsigned)(Rb * K + C) * 2u; }
    const size_t kstep = (size_t)(BK * 2);
    const size_t hstep = (size_t)HALF * K * 2;
    const size_t tstep = 2 * hstep;
    const unsigned ldsw = (unsigned)wid * 1024u;
    const int aoff = lds_byte(wr * 64 + fr, fq * 8), boff = lds_byte(wc * 32 + fr, fq * 8);
#define PG8_SA(b, h) (((b) * 2 + (h)) * HTB)
#define PG8_SB(b, h) ((4 + (b) * 2 + (h)) * HTB)
#define PG8_STAGE(bufoff, gbase, voff) do { _Pragma("unroll") for (int _i = 0; _i < 2; ++_i) \
        __builtin_amdgcn_global_load_lds((const unsigned*)((const char*)(gbase) + (voff)[_i]), (PG8_LAS unsigned*)(lds + (bufoff) + ldsw + _i * 8192), 16, 0, 0); } while (0)
#define PG8_LDA(dst, b, h) do { _Pragma("unroll") for (int m = 0; m < 4; ++m) _Pragma("unroll") for (int k = 0; k < 2; ++k) dst[m][k] = *(const PG8_LAS bf16x8*)(lds + PG8_SA(b, h) + aoff + m * 2048 + k * 1024); } while (0)
#define PG8_LDB(dst, b, h) do { _Pragma("unroll") for (int n = 0; n < 2; ++n) _Pragma("unroll") for (int k = 0; k < 2; ++k) dst[n][k] = *(const PG8_LAS bf16x8*)(lds + PG8_SB(b, h) + boff + n * 2048 + k * 1024); } while (0)
#define PG8_MMA(ai, bj, At, Bt) do { __builtin_amdgcn_s_setprio(1); _Pragma("unroll") for (int m = 0; m < 4; ++m) _Pragma("unroll") for (int n = 0; n < 2; ++n) _Pragma("unroll") for (int k = 0; k < 2; ++k) \
        acc[ai][bj][m][n] = __builtin_amdgcn_mfma_f32_16x16x32_bf16(Bt[n][k], At[m][k], acc[ai][bj][m][n], 0, 0, 0); __builtin_amdgcn_s_setprio(0); } while (0)
#define PG8_WAIT_V(n) asm volatile("s_waitcnt vmcnt(" #n ")" ::: "memory")
#define PG8_WAIT_L(n) asm volatile("s_waitcnt lgkmcnt(" #n ")" ::: "memory")
#define PG8_BAR __builtin_amdgcn_s_barrier()
#define PG8_SCHED __builtin_amdgcn_sched_barrier(0)
    Unit cur, nxt; int ui = 0;
    if (!S.next(0, cur)) return;
    cur.pm = __builtin_amdgcn_readfirstlane(cur.pm); cur.pn = __builtin_amdgcn_readfirstlane(cur.pn);
    f32x4 acc[2][2][4][2];
#pragma unroll
    for (int a = 0; a < 2; ++a)
#pragma unroll
        for (int b = 0; b < 2; ++b)
#pragma unroll
            for (int m = 0; m < 4; ++m)
#pragma unroll
                for (int n = 0; n < 2; ++n) acc[a][b][m][n] = (f32x4){0.f, 0.f, 0.f, 0.f};
    bf16x8 At[4][2], B0[2][2], B1[2][2];
#define PG8_KOFF(u) ((VARK && (u).pn >= 4) ? (size_t)(((u).pn - 4) >> 2) * (size_t)(K / 4) * 2 : (size_t)0)
#define PG8_PN(u) ((VARK && (u).pn >= 4) ? ((u).pn & 3) : (u).pn)
    const char* cA = (const char*)g.A + (size_t)cur.pm * tstep + PG8_KOFF(cur); const char* cB = (const char*)g.Bt + (size_t)PG8_PN(cur) * tstep + PG8_KOFF(cur);
    S.a_ready(cur);
    if constexpr (SP2) {
        PG8_STAGE(PG8_SB(0, 0), cB, voffB); PG8_STAGE(PG8_SB(0, 1), cB + hstep, voffB); PG8_STAGE(PG8_SA(0, 0), cA, voffA); PG8_STAGE(PG8_SA(0, 1), cA + hstep, voffA);
        if (wr == 1) PG8_BAR;
        PG8_WAIT_V(2); PG8_BAR;
        PG8_STAGE(PG8_SB(1, 0), cB + kstep, voffB); PG8_STAGE(PG8_SA(1, 0), cA + kstep, voffA); PG8_STAGE(PG8_SB(1, 1), cB + hstep + kstep, voffB);
        PG8_WAIT_V(6); PG8_BAR;
    } else {
        PG8_STAGE(PG8_SB(0, 0), cB, voffB); PG8_STAGE(PG8_SA(0, 0), cA, voffA); PG8_STAGE(PG8_SB(0, 1), cB + hstep, voffB); PG8_STAGE(PG8_SA(0, 1), cA + hstep, voffA);
        if (wr == 1) PG8_BAR;
        PG8_WAIT_V(4); PG8_BAR;
        PG8_STAGE(PG8_SB(1, 0), cB + kstep, voffB); PG8_STAGE(PG8_SA(1, 0), cA + kstep, voffA); PG8_STAGE(PG8_SB(1, 1), cB + hstep + kstep, voffB);
        PG8_WAIT_V(6); PG8_BAR;
    }
    for (;;) {
        const bool has_next = S.next(ui + 1, nxt);
        nxt.pm = __builtin_amdgcn_readfirstlane(nxt.pm); nxt.pn = __builtin_amdgcn_readfirstlane(nxt.pn);
        const char* nA = has_next ? (const char*)g.A + (size_t)nxt.pm * tstep + PG8_KOFF(nxt) : cA; const char* nB = has_next ? (const char*)g.Bt + (size_t)PG8_PN(nxt) * tstep + PG8_KOFF(nxt) : cB;
        const int nt = (VARK && cur.pn >= 4) ? K / BK / 4 : K / BK;
        for (int t = 0; t < nt; t += 2) {
            const bool last = (t == nt - 2);
            const char* a1 = cA + (size_t)(t + 1) * kstep;
            const char* a2 = last ? nA : cA + (size_t)(t + 2) * kstep; const char* b2 = last ? nB : cB + (size_t)(t + 2) * kstep;
            const char* a3 = a2 + kstep; const char* b3 = b2 + kstep;
            if (last && has_next) S.a_ready(nxt);
            if constexpr (SP2) {
            PG8_LDB(B0, 0, 0); PG8_LDB(B1, 0, 1); PG8_SCHED; PG8_LDA(At, 0, 0); PG8_STAGE(PG8_SA(1, 1), a1 + hstep, voffA);
            PG8_WAIT_V(8); PG8_WAIT_L(0); PG8_BAR; PG8_MMA(0, 0, At, B0); PG8_MMA(0, 1, At, B1); PG8_BAR; PG8_SCHED;
            PG8_LDA(At, 0, 1); PG8_STAGE(PG8_SB(0, 0), b2, voffB); PG8_STAGE(PG8_SB(0, 1), b2 + hstep, voffB); PG8_STAGE(PG8_SA(0, 0), a2, voffA);
            PG8_WAIT_V(8); PG8_WAIT_L(0); PG8_BAR; PG8_MMA(1, 0, At, B0); PG8_MMA(1, 1, At, B1); PG8_BAR; PG8_SCHED;
            PG8_LDB(B0, 1, 0); PG8_LDB(B1, 1, 1); PG8_SCHED; PG8_LDA(At, 1, 0); PG8_STAGE(PG8_SA(0, 1), a2 + hstep, voffA);
            PG8_WAIT_V(8); PG8_WAIT_L(0); PG8_BAR; PG8_MMA(0, 0, At, B0); PG8_MMA(0, 1, At, B1); PG8_BAR; PG8_SCHED;
            PG8_LDA(At, 1, 1); PG8_STAGE(PG8_SB(1, 0), b3, voffB); PG8_STAGE(PG8_SB(1, 1), b3 + hstep, voffB); PG8_STAGE(PG8_SA(1, 0), a3, voffA);
            PG8_WAIT_V(8); PG8_WAIT_L(0); PG8_BAR; PG8_MMA(1, 0, At, B0); PG8_MMA(1, 1, At, B1); PG8_BAR; PG8_SCHED;
            } else {
            PG8_LDB(B0, 0, 0); PG8_SCHED; PG8_LDA(At, 0, 0); PG8_STAGE(PG8_SA(1, 1), a1 + hstep, voffA);
            PG8_WAIT_L(8); PG8_BAR; PG8_WAIT_L(0); PG8_MMA(0, 0, At, B0); PG8_BAR; PG8_SCHED;
            PG8_LDB(B1, 0, 1); PG8_STAGE(PG8_SB(0, 0), b2, voffB);
            PG8_BAR; PG8_WAIT_L(0); PG8_MMA(0, 1, At, B1); PG8_BAR;
            PG8_LDA(At, 0, 1); PG8_STAGE(PG8_SA(0, 0), a2, voffA);
            PG8_BAR; PG8_WAIT_L(0); PG8_MMA(1, 0, At, B0); PG8_BAR; PG8_SCHED;
            PG8_STAGE(PG8_SB(0, 1), b2 + hstep, voffB);
            PG8_WAIT_V(6); PG8_BAR; PG8_MMA(1, 1, At, B1); PG8_BAR;
            PG8_LDB(B0, 1, 0); PG8_SCHED; PG8_LDA(At, 1, 0); PG8_STAGE(PG8_SA(0, 1), a2 + hstep, voffA);
            PG8_WAIT_L(8); PG8_BAR; PG8_WAIT_L(0); PG8_MMA(0, 0, At, B0); PG8_BAR; PG8_SCHED;
            PG8_LDB(B1, 1, 1); PG8_STAGE(PG8_SB(1, 0), b3, voffB);
            PG8_BAR; PG8_WAIT_L(0); PG8_MMA(0, 1, At, B1); PG8_BAR;
            PG8_LDA(At, 1, 1); PG8_STAGE(PG8_SA(1, 0), a3, voffA);
            PG8_BAR; PG8_WAIT_L(0); PG8_MMA(1, 0, At, B0); PG8_BAR; PG8_SCHED;
            PG8_STAGE(PG8_SB(1, 1), b3 + hstep, voffB);
            PG8_WAIT_V(6); PG8_BAR; PG8_MMA(1, 1, At, B1); PG8_BAR;
            }
        }
        if constexpr (ALIGN_EPI) { if (wr == 0) PG8_BAR; }
        if constexpr (!Epi::AFTER_DRAIN) { E(acc, cur, wr, wc, fr, fq, ui); S.done(cur); }
        if (!has_next) break;
#pragma unroll
        for (int a = 0; a < 2; ++a)
#pragma unroll
            for (int b = 0; b < 2; ++b)
#pragma unroll
                for (int m = 0; m < 4; ++m)
#pragma unroll
                    for (int n = 0; n < 2; ++n) acc[a][b][m][n] = (f32x4){0.f, 0.f, 0.f, 0.f};
        cur = nxt; cA = nA; cB = nB; ++ui;
        if constexpr (ALIGN_EPI) { if (wr == 1) PG8_BAR; }
    }
    PG8_WAIT_V(0);
    if constexpr (!ALIGN_EPI) { if (wr == 0) PG8_BAR; }
    PG8_BAR;
    if constexpr (Epi::AFTER_DRAIN) { E.fused(acc, cur, wr, wc, fr, fq, lds, wid, lane); S.done(cur); }
#undef PG8_KOFF
#undef PG8_PN
#undef PG8_SA
#undef PG8_SB
#undef PG8_STAGE
#undef PG8_LDA
#undef PG8_LDB
#undef PG8_MMA
#undef PG8_WAIT_V
#undef PG8_WAIT_L
#undef PG8_BAR
#undef PG8_SCHED
}
}

constexpr size_t MiB = 1u << 20;
constexpr size_t WS_CTL = 0, CTL_ZERO_BYTES = 1 * MiB;
constexpr size_t WS_MOD = 1 * MiB;
constexpr size_t WS_SHW1 = 2 * MiB;
constexpr size_t WS_SHW2 = 3 * MiB;
constexpr size_t WS_RSSA = 4 * MiB;
constexpr size_t WS_RSSB = 9 * MiB;
constexpr size_t WS_TOT = 14 * MiB;
constexpr size_t WS_CARRY = 19 * MiB;
constexpr size_t WS_WLR = 21 * MiB + 512 * 1024;
constexpr size_t WS_WIN = 22 * MiB;
constexpr size_t WS_WOUT = 32 * MiB;
constexpr size_t WS_W1 = 36 * MiB;
constexpr size_t WS_W2 = 52 * MiB;
constexpr size_t WS_CX = 68 * MiB;
constexpr size_t WS_XA = 84 * MiB;
constexpr size_t WS_HID = 156 * MiB;
constexpr size_t WS_PROJ = WS_HID;
constexpr size_t WS_MIX = WS_HID + 180 * MiB;
constexpr size_t WS_PART = 444 * MiB;
constexpr size_t WS_AB = 436 * MiB;
constexpr size_t WS_END = 508 * MiB;
static_assert(WS_MIX + (size_t)MT * D * 2 <= WS_PART && WS_HID + (size_t)MT * FF * 2 == WS_PART && WS_PART + (size_t)4 * MC * D * 4 == WS_END && WS_AB >= WS_MIX + (size_t)MT * D * 2 && WS_AB + (size_t)1152 * 2 * 2 * 8 * 2 * 64 * 16 == WS_END, "ws map");
constexpr size_t WS_ZERO = WS_CTL + 512 * 1024;
constexpr int CW_BAR = 4096;

#ifndef WGM_IN
#define WGM_IN 4
#endif
#ifndef WGM_OUT
#define WGM_OUT 4
#endif
#ifndef WGM_UP
#define WGM_UP 4
#endif
#ifndef WGM_DN
#define WGM_DN 4
#endif
#ifndef RES_NB
#define RES_NB 2
#endif
constexpr int NWAVES = 8;
constexpr int RING_OFF = 0, RING_BYTES = 131072;
constexpr int LDSCTL_OFF = RING_BYTES, MISC_OFF = LDSCTL_OFF + 320;
constexpr int TBL_OFF = LDSCTL_OFF + 1024;
static_assert(TBL_OFF + 3 * pg8::TBL_UNITS * 256 * 4 <= 163840, "LDS map");
constexpr int LDS_BYTES = 163840;

#define GAS __attribute__((address_space(1)))
#define LAS __attribute__((address_space(3)))
typedef unsigned short bf16;
typedef unsigned v4u __attribute__((ext_vector_type(4)));
typedef unsigned v2u __attribute__((ext_vector_type(2)));
typedef float f32x4 __attribute__((ext_vector_type(4)));
typedef float f32x2 __attribute__((ext_vector_type(2)));
typedef GAS unsigned gu32;
#define LDS_WAIT() asm volatile("s_waitcnt lgkmcnt(0)" ::: "memory")
#define VM_WAIT() asm volatile("s_waitcnt vmcnt(0)" ::: "memory")
__device__ __forceinline__ unsigned f2bf(float f) { unsigned u = __builtin_bit_cast(unsigned, f); return (u + 0x7fffu + ((u >> 16) & 1u)) >> 16; }
__device__ __forceinline__ unsigned pk2(float lo, float hi) { return f2bf(lo) | (f2bf(hi) << 16); }
__device__ __forceinline__ float bflo(unsigned w) { return __uint_as_float(w << 16); }
__device__ __forceinline__ float bfhi(unsigned w) { return __uint_as_float(w & 0xffff0000u); }
__device__ __forceinline__ float bf1(bf16 v) { return __uint_as_float((unsigned)v << 16); }
__device__ __forceinline__ float sigmoidf_(float x) { return __builtin_amdgcn_rcpf(1.f + __builtin_amdgcn_exp2f(-1.4426950408889634f * x)); }
__device__ __forceinline__ float siluf_(float x) { return x * sigmoidf_(x); }
__device__ __forceinline__ float gelu_tanh(float x) { const float u = 0.7978845608028654f * (x + 0.044715f * x * x * x); return x * sigmoidf_(2.f * u); }
__device__ __forceinline__ float wave_sum(float v) {
#pragma unroll
    for (int o = 1; o < 64; o <<= 1) v += __shfl_xor(v, o);
    return v;
}

#define XB_TMO      128
#define XB_XCNT(j)  (256  + 64 * (j))
#define XB_XSUB(j)  (1280 + 64 * (j))
#define XB_XGEN(j)  (2304 + 64 * (j))
#define XB_TOP      3328
#define XB_TOPGEN   3392
#define XCD_BAR_WORDS 3456
#define XB_SPIN_CAP (1u << 18)

__device__ __forceinline__ unsigned xb_ld(unsigned* p)              { return __hip_atomic_load(p, __ATOMIC_RELAXED, __HIP_MEMORY_SCOPE_AGENT); }
__device__ __forceinline__ unsigned xb_add(unsigned* p, unsigned v) { return __hip_atomic_fetch_add(p, v, __ATOMIC_RELAXED, __HIP_MEMORY_SCOPE_AGENT); }
__device__ __forceinline__ unsigned xb_xcc_id() { return (unsigned)__builtin_amdgcn_s_getreg((3 << 11) | 20) & 0xFu; }
#define XB_SPIN(cond, bar) do { unsigned _sp = 0; while (cond) { __builtin_amdgcn_s_sleep(1); \
    if ((++_sp & 255u) == 0u) { if (xb_ld(&(bar)[XB_TMO])) break; if (_sp > XB_SPIN_CAP) { atomicAdd(&(bar)[XB_TMO], 1u); break; } } } } while (0)

struct XcdBarrier {
    unsigned* bar; unsigned x;
    volatile LAS unsigned* st;
};

__device__ __forceinline__ XcdBarrier xcd_barrier_post(unsigned* bar, volatile LAS unsigned* st, int tid) {
    XcdBarrier b; b.bar = bar; b.x = xb_xcc_id(); b.st = st;
    if (tid == 0) (void)xb_add(&bar[XB_XCNT(b.x)], 1u);
    return b;
}
__device__ __forceinline__ void xcd_barrier_complete(unsigned* bar, unsigned x, unsigned& nloc, unsigned& nx) {
    const unsigned G = gridDim.x * gridDim.y * gridDim.z;
    unsigned sum, cnt, mine, sp = 0u;
    for (;;) {
        sum = 0u; cnt = 0u; mine = 0u;
#pragma unroll 1
        for (unsigned j = 0; j < 16; ++j) { const unsigned c = xb_ld(&bar[XB_XCNT(j)]); sum += c; cnt += (c > 0u) ? 1u : 0u; mine = (j == x) ? c : mine; }
        if (sum == G) break;
        __builtin_amdgcn_s_sleep(1);
        if ((++sp & 255u) == 0u) { if (xb_ld(&bar[XB_TMO])) break; if (sp > XB_SPIN_CAP) { atomicAdd(&bar[XB_TMO], 1u); break; } }
    }
    nloc = mine > 0u ? mine : 1u; nx = cnt > 0u ? cnt : 1u;
}

__device__ __forceinline__ void xcd_barrier(const XcdBarrier& b, int tid) {
    asm volatile("s_waitcnt vmcnt(0)" ::: "memory");
    __syncthreads();
    if (tid == 0) {
        unsigned* bar = b.bar;
        __builtin_amdgcn_s_waitcnt(0);
        unsigned nloc = b.st[0], nx = b.st[1];
        if (nloc == 0u) { xcd_barrier_complete(bar, b.x, nloc, nx); b.st[0] = nloc; b.st[1] = nx; }
        const unsigned old = xb_add(&bar[XB_XSUB(b.x)], 1u);
        const unsigned gen = old / nloc;
        if (old + 1u == (gen + 1u) * nloc) {
            __builtin_amdgcn_fence(__ATOMIC_RELEASE, "agent");
            asm volatile("s_waitcnt vmcnt(0)" ::: "memory");
            const unsigned og = xb_add(&bar[XB_TOP], 1u);
            const unsigned tg = og / nx;
            if (og + 1u == (tg + 1u) * nx) xb_add(&bar[XB_TOPGEN], 1u);
            else XB_SPIN(xb_ld(&bar[XB_TOPGEN]) == tg, bar);
            __builtin_amdgcn_fence(__ATOMIC_ACQUIRE, "agent");
            xb_add(&bar[XB_XGEN(b.x)], 1u);
            asm volatile("s_waitcnt vmcnt(0)" ::: "memory");
        } else {
            XB_SPIN(xb_ld(&bar[XB_XGEN(b.x)]) == gen, bar);
            __builtin_amdgcn_fence(__ATOMIC_ACQUIRE, "agent");
            asm volatile("s_waitcnt vmcnt(0)" ::: "memory");
        }
    }
    __syncthreads();
}

struct Frame {
    LAS unsigned char* lds;
    int tid, lane, wave;
    int vcu, G;
    int gw, NGW;
    float* out; unsigned char* ws;
};
constexpr int PTR_OFF = LDSCTL_OFF + 512;
__device__ __forceinline__ const float* inp_(LAS unsigned char* lds, int i) {
    const unsigned long long v = *(const LAS unsigned long long*)(lds + PTR_OFF + 8 * i);
    const unsigned lo = __builtin_amdgcn_readfirstlane((unsigned)v), hi = __builtin_amdgcn_readfirstlane((unsigned)(v >> 32));
    return (const float*)(((unsigned long long)hi << 32) | lo);
}
#define INP(i) inp_(F.lds, (i))
#define WSP(T, off) ((T*)(F.ws + (off)))

__device__ __forceinline__ void gemv17_item(Frame& F, const LAS float* tab, LAS float* red, const float* W, int ldw, int n0, const float* bias, float* outp, int ldo, int n0out) {
    float acc[17];
#pragma unroll
    for (int r = 0; r < 17; ++r) acc[r] = 0.f;
    const int k0 = F.wave * 128;
    const float* wp = W + (size_t)k0 * ldw + n0 + F.lane;
#pragma unroll 1
    for (int kk = 0; kk < 128; kk += 32) {
        float wv[32];
#pragma unroll
        for (int k = 0; k < 32; ++k) wv[k] = wp[(size_t)(kk + k) * ldw];
#pragma unroll
        for (int k = 0; k < 32; ++k) {
#pragma unroll
            for (int r = 0; r < 17; ++r) acc[r] += tab[r * 1024 + k0 + kk + k] * wv[k];
        }
    }
#pragma unroll
    for (int r = 0; r < 17; ++r) red[(F.wave * 17 + r) * 64 + F.lane] = acc[r];
    __syncthreads();
    for (int i = F.tid; i < 17 * 64; i += NWAVES * 64) {
        const int r = i >> 6, n = i & 63; float s = bias ? bias[n0 + n] : 0.f;
#pragma unroll
        for (int w = 0; w < 8; ++w) s += red[(w * 17 + r) * 64 + n];
        outp[(size_t)r * ldo + n0out + n] = s;
    }
    __syncthreads();
}

__host__ __device__ __forceinline__ int glu_col(int o) { return o >= 512 ? o : ((o >> 7) & 1) * 256 + (o >> 8) * 128 + (o & 127); }
__device__ __forceinline__ void p0_transpose_item(const float* W, int K, int N, bf16* WT, LAS float* scr, int item, int lane, bool glu) {
    const int nblk = N / 32, kb = item / nblk, nb = item % nblk, k0 = 64 * kb, n0 = 32 * nb;
    const int n0o = glu ? glu_col(n0) : n0;
    float tv[32];
#pragma unroll
    for (int i = 0; i < 32; ++i) { const int kk = 2 * i + (lane >> 5); tv[i] = W[(size_t)(k0 + kk) * N + n0 + (lane & 31)]; }
#pragma unroll
    for (int i = 0; i < 32; ++i) { const int kk = 2 * i + (lane >> 5); scr[kk * 33 + (lane & 31)] = tv[i]; }
    LDS_WAIT(); asm volatile("" ::: "memory");
    const int c = lane & 7;
#pragma unroll
    for (int j = 0; j < 4; ++j) { const int n = (lane >> 3) + 8 * j; const LAS float* s = scr + (8 * c) * 33 + n;
        v4u o; o.x = pk2(s[0 * 33], s[1 * 33]); o.y = pk2(s[2 * 33], s[3 * 33]); o.z = pk2(s[4 * 33], s[5 * 33]); o.w = pk2(s[6 * 33], s[7 * 33]);
        *(GAS v4u*)(WT + (size_t)(n0o + n) * K + k0 + 8 * c) = o; }
    LDS_WAIT(); asm volatile("" ::: "memory");
}

__device__ __forceinline__ void weight_items(Frame& F, int first, int last, int widx, int nw) {
    LAS float* scr = (LAS float*)(F.lds + F.wave * 16384);
    constexpr int I_IN = (D / 64) * (IND / 32), I_OUT = (D / 64) * (D / 32), I_1 = (D / 64) * (FF / 32), I_2 = (FF / 64) * (D / 32), I_L = I_IN + I_OUT + I_1 + I_2;
    for (int it = first + widx; it < last; it += nw) {
        const int l = it / I_L; int r = it % I_L;
        const float* W; bf16* WT; int K = D, N; const bool glu = r < I_IN;
        if (r < I_IN) { W = INP(8) + (size_t)l * D * IND; WT = WSP(bf16, WS_WIN) + (size_t)l * IND * D; N = IND; }
        else if (r < I_IN + I_OUT) { r -= I_IN; W = INP(9) + (size_t)l * D * D; WT = WSP(bf16, WS_WOUT) + (size_t)l * D * D; N = D; }
        else if (r < I_IN + I_OUT + I_1) { r -= I_IN + I_OUT; W = INP(22) + (size_t)l * D * FF; WT = WSP(bf16, WS_W1) + (size_t)l * FF * D; N = FF; }
        else { r -= I_IN + I_OUT + I_1; W = INP(23) + (size_t)l * FF * D; WT = WSP(bf16, WS_W2) + (size_t)l * D * FF; K = FF; N = D; }
        p0_transpose_item(W, K, N, WT, scr, r, F.lane, glu);
    }
}
constexpr int W_ITEMS = 2 * ((D / 64) * (IND / 32) + (D / 64) * (D / 32) + (D / 64) * (FF / 32) + (FF / 64) * (D / 32));
constexpr int W_EARLY = 64 * NWAVES * 3;

__device__ __forceinline__ void phase_p0a(Frame& F) {
    LAS float* tab = (LAS float*)(F.lds);
    LAS float* red = (LAS float*)(F.lds + 17 * 1024 * 4);
    float* MOD = WSP(float, WS_MOD);
    bool filled = false;
    for (int it = F.vcu; it < 2 * 96; it += F.G) {
        if (!filled) {
            for (int i = F.tid; i < 17 * 1024; i += NWAVES * 64) { const int r = i >> 10, k = i & 1023; const float v = (r < 16) ? INP(1)[r * D + k] : INP(3)[k]; tab[i] = siluf_(v); }
            __syncthreads(); filled = true;
        }
        const int l = it / 96, n0 = (it % 96) * 64;
        gemv17_item(F, tab, red, INP(6) + (size_t)l * D * MODW, MODW, n0, INP(7) + (size_t)l * MODW, MOD + (size_t)l * 17 * MODW, MODW, n0);
    }
    if (F.G == 256 && F.vcu >= 192) weight_items(F, 0, W_EARLY, (F.vcu - 192) * NWAVES + F.wave, 64 * NWAVES);
}

__device__ __forceinline__ void phase_p0b(Frame& F) {
    LAS float* tab = (LAS float*)(F.lds);
    LAS float* red = (LAS float*)(F.lds + 17 * 1024 * 4);
    const float* MOD = WSP(const float, WS_MOD);
    for (int it = F.vcu; it < 2 * 104; it += F.G) {
        const int l = it / 104, j = it % 104; const bool first = j < 40;
        const int shoff = first ? 0 : 3 * D;
        __syncthreads();
        for (int i = F.tid; i < 17 * 1024; i += NWAVES * 64) { const int r = i >> 10, k = i & 1023; tab[i] = MOD[((size_t)l * 17 + r) * MODW + shoff + k]; }
        __syncthreads();
        const int ldw = first ? IND : FF;
        gemv17_item(F, tab, red, first ? INP(8) + (size_t)l * D * IND : INP(22) + (size_t)l * D * FF, ldw, (first ? j : j - 40) * 64, nullptr,
                    first ? WSP(float, WS_SHW1) + (size_t)l * 17 * IND : WSP(float, WS_SHW2) + (size_t)l * 17 * FF, ldw, first ? glu_col(j * 64) : (j - 40) * 64);
    }
    bf16* XA = WSP(bf16, WS_XA); float* RSSA = WSP(float, WS_RSSA);
    const float* g1 = INP(4);
    for (int row = F.gw; row < MT; row += 2 * F.NGW) {
        f32x4 v[2][4]; float ss[2]; int rw[2]; const float* scp[2];
#pragma unroll
        for (int q = 0; q < 2; ++q) { int r_ = row + q * F.NGW; if (r_ >= MT) r_ = row; rw[q] = r_;
            const bool lat = r_ < ML;
            const float* xr = lat ? INP(0) + (size_t)r_ * D : INP(2) + (size_t)(r_ - ML) * D;
            scp[q] = MOD + (size_t)(lat ? (r_ >> 11) : NB) * MODW + D;
#pragma unroll
            for (int j = 0; j < 4; ++j) v[q][j] = *(const f32x4*)(xr + 4 * F.lane + 256 * j); }
#pragma unroll
        for (int q = 0; q < 2; ++q) { float s_ = 0.f;
#pragma unroll
            for (int j = 0; j < 4; ++j) s_ += (v[q][j][0] * v[q][j][0] + v[q][j][1] * v[q][j][1]) + (v[q][j][2] * v[q][j][2] + v[q][j][3] * v[q][j][3]);
            ss[q] = wave_sum(s_); }
#pragma unroll
        for (int q = 0; q < 2; ++q) { if (q == 1 && rw[1] == row) break;
            if (F.lane < 32) RSSA[(size_t)rw[q] * 32 + F.lane] = (F.lane == 0) ? ss[q] : 0.f;
#pragma unroll
            for (int j = 0; j < 4; ++j) { const int k = 4 * F.lane + 256 * j;
                const f32x4 gm = *(const f32x4*)(g1 + k) * (*(const f32x4*)(scp[q] + k) + 1.0f), a = v[q][j] * gm;
                v2u o; o.x = pk2(a[0], a[1]); o.y = pk2(a[2], a[3]); *(v2u*)(XA + (size_t)rw[q] * D + k) = o; } }
    }
    __syncthreads();
    {
        bf16* WLR = WSP(bf16, WS_WLR);
        for (int i = F.gw * 64 + F.lane; i < 2 * 2 * 4 * 2 * 4096; i += F.NGW * 64) { const int d = i & 63, e = (i >> 6) & 63, gt = (i >> 12) & 1, blk = i >> 13;
            const float* src = gt == 0 ? INP(17) : INP(19); WLR[i] = (bf16)f2bf(src[((size_t)blk * 64 + d) * 64 + e]); }
    }
    weight_items(F, (F.G == 256) ? W_EARLY : 0, W_ITEMS, F.gw, F.NGW);
}

constexpr int CV_OSROW = 260;
__device__ __forceinline__ void conv_phase(Frame& F, int l, int ntiles) {
    const bf16* PROJ = WSP(const bf16, WS_PROJ); bf16* MIX = WSP(bf16, WS_MIX);
    LAS float* us = (LAS float*)(F.lds);
    LAS float* os = (LAS float*)(F.lds + 62 * 256 * 4);
    const int c = F.tid & 255, half = F.tid >> 8;
    float w[31];
#pragma unroll
    for (int k = 0; k < 31; ++k) w[k] = INP(10)[((size_t)l * 31 + k) * 256 + c];
    const float cbias = INP(11)[l * 256 + c];
    const int lt = F.tid >> 4, lseg = F.tid & 15;
    f32x4 lg[4], lb[4];
#pragma unroll
    for (int q = 0; q < 4; ++q) { lg[q] = *(const f32x4*)(INP(12) + l * 256 + 16 * lseg + 4 * q); lb[q] = *(const f32x4*)(INP(13) + l * 256 + 16 * lseg + 4 * q); }
    auto row16_sum = [](float v) -> float {
        v += __builtin_bit_cast(float, __builtin_amdgcn_update_dpp(0, __builtin_bit_cast(int, v), 0xB1, 0xf, 0xf, true));
        v += __builtin_bit_cast(float, __builtin_amdgcn_update_dpp(0, __builtin_bit_cast(int, v), 0x4E, 0xf, 0xf, true));
        v += __builtin_bit_cast(float, __builtin_amdgcn_update_dpp(0, __builtin_bit_cast(int, v), 0x141, 0xf, 0xf, true));
        v += __builtin_bit_cast(float, __builtin_amdgcn_update_dpp(0, __builtin_bit_cast(int, v), 0x140, 0xf, 0xf, true));
        return v; };
    unsigned pv[16];
    auto load_tile = [&](int T) {
        const int row0 = T * 32;
        int lo, hi; if (row0 < ML) { lo = row0 & ~(SEQ - 1); hi = lo + SEQ; } else { lo = row0 & ~(CTXL - 1); hi = lo + CTXL; }
#pragma unroll
        for (int j = 0; j < 16; ++j) { const int i = F.tid + 512 * j, rr = i >> 7, cp = i & 127, row = row0 - 15 + rr;
            const bool ok = (j < 15 || F.tid < 256) && row >= lo && row < hi;
            pv[j] = ok ? *(const unsigned*)(PROJ + (size_t)row * IND + 2 * cp) : 0u; }
    };
    const int T0 = F.G - 1 - F.vcu;
    if (T0 < ntiles) load_tile(T0);
    for (int T = T0; T < ntiles; T += F.G) {
        const int row0 = T * 32;
        __syncthreads();
#pragma unroll
        for (int j = 0; j < 16; ++j) { const int i = F.tid + 512 * j;
            if (j < 15 || F.tid < 256) { f32x2 u; u[0] = bflo(pv[j]); u[1] = bfhi(pv[j]); *(LAS f32x2*)(us + 2 * i) = u; } }
        if (T + F.G < ntiles) load_tile(T + F.G);
        __syncthreads();
        {
            float acc[16];
#pragma unroll
            for (int j = 0; j < 16; ++j) acc[j] = cbias;
            const LAS float* up = us + (16 * half) * 256 + c;
#pragma unroll
            for (int i = 0; i < 46; ++i) { const float x = up[i * 256];
#pragma unroll
                for (int j = 0; j < 16; ++j) if (i - j >= 0 && i - j <= 30) acc[j] += w[i - j] * x; }
#pragma unroll
            for (int j = 0; j < 16; ++j) os[(16 * half + j) * CV_OSROW + c] = acc[j];
        }
        __syncthreads();
        {
            f32x4 v[4];
#pragma unroll
            for (int q = 0; q < 4; ++q) v[q] = *(const LAS f32x4*)(os + lt * CV_OSROW + 16 * lseg + 4 * q);
            float s1 = 0.f;
#pragma unroll
            for (int q = 0; q < 4; ++q) s1 += (v[q][0] + v[q][1]) + (v[q][2] + v[q][3]);
            const float mu = row16_sum(s1) * (1.f / 256.f);
            float s2 = 0.f;
#pragma unroll
            for (int q = 0; q < 4; ++q) { v[q] = v[q] - mu; s2 += (v[q][0] * v[q][0] + v[q][1] * v[q][1]) + (v[q][2] * v[q][2] + v[q][3] * v[q][3]); }
            const float rstd = rsqrtf(row16_sum(s2) * (1.f / 256.f) + EPS);
            unsigned ow[8];
#pragma unroll
            for (int q = 0; q < 4; ++q) { const f32x4 y = v[q] * rstd * lg[q] + lb[q];
                ow[2 * q] = pg8::cvt_pk_bf16(siluf_(y[0]), siluf_(y[1])); ow[2 * q + 1] = pg8::cvt_pk_bf16(siluf_(y[2]), siluf_(y[3])); }
            bf16* op = MIX + (size_t)(row0 + lt) * D + 16 * lseg;
            *(v4u*)op = (v4u){ow[0], ow[1], ow[2], ow[3]}; *(v4u*)(op + 8) = (v4u){ow[4], ow[5], ow[6], ow[7]};
        }
    }
}

typedef short s16x8 __attribute__((ext_vector_type(8)));
typedef short s16x4 __attribute__((ext_vector_type(4)));
constexpr int NA_KROW = 144, NA_VROW = 160;
constexpr int NA_STAGE = 64 * NA_KROW + 64 * NA_VROW, NA_SLOT = 2 * NA_STAGE, NA_OFF_TB = 2 * NA_SLOT;
static_assert(NA_OFF_TB + 2560 <= RING_BYTES, "NA LDS map");
constexpr int NA_ITEMS_LAT = NB * NH * 8, NA_ITEMS_CTX = NB * NH * 2;
struct NaBlk { f32x4 O[4]; float m, lsum; int first; };
__device__ __forceinline__ int na_rs(int r) { int v = r - 4; return v < 0 ? 0 : (v > 24 ? 24 : v); }
__device__ __forceinline__ s16x8 na_scale_q(v4u w, float c) {
    v4u o; o.x = pg8::cvt_pk_bf16(bflo(w.x) * c, bfhi(w.x) * c); o.y = pg8::cvt_pk_bf16(bflo(w.y) * c, bfhi(w.y) * c); o.z = pg8::cvt_pk_bf16(bflo(w.z) * c, bfhi(w.z) * c); o.w = pg8::cvt_pk_bf16(bflo(w.w) * c, bfhi(w.w) * c);
    return __builtin_bit_cast(s16x8, o);
}
__device__ __forceinline__ void na_phase(Frame& F, int l, int nitems, int nav = 0) {
    const bf16* PROJ = WSP(const bf16, WS_PROJ); bf16* MIX = WSP(bf16, WS_MIX);
    LAS float* tb = (LAS float*)(F.lds + NA_OFF_TB);
    const int lane = F.lane, q16 = lane & 15, g = lane >> 4;
    const unsigned skey = (unsigned)(F.tid >> 3), spart = (unsigned)(F.tid & 7);
    const float c1 = 0.125f * 1.4426950408889634f;
    struct NaItem { int b, h, ra, qrow0, rsI, nloc, nch, npair, isctx; };
    auto decode = [&](int it, NaItem& I) {
        I.isctx = it >= NA_ITEMS_LAT ? 1 : 0; I.ra = 0; I.rsI = 0; I.nloc = 0;
        if (!I.isctx) { const int r4 = it & 7; I.h = (it >> 3) & 7; I.b = it >> 6; const int r0 = 4 * r4; I.ra = r0 + 2 * (F.wave >> 2); I.qrow0 = I.b * SEQ + I.ra * 64 + (F.wave & 3) * 16;
            I.rsI = na_rs(r0); I.nloc = na_rs(r0 + 3) + 8 - I.rsI; }
        else { const int j = it - NA_ITEMS_LAT; const int hf = j & 1; I.h = (j >> 1) & 7; I.b = j >> 4; I.qrow0 = ML + I.b * CTXL + hf * 128 + F.wave * 16; }
        I.nch = I.nloc + 4; I.npair = (I.nch + 1) >> 1;
    };
    auto krow_of = [&](const NaItem& I, int ch) -> int { if (ch > I.nch - 1) ch = I.nch - 1; return ch < I.nloc ? I.b * SEQ + (I.rsI + ch) * 64 : ML + I.b * CTXL + (ch - I.nloc) * 64; };
    const int jq = F.wave & 3;
    const int o0 = jq == 0 ? 0 : 16 * jq - 8, o1 = jq == 0 ? 16 : (jq == 3 ? 48 : 16 * jq + 8);
    float madd[2][4]; int lb[2];
    {
        const int qc = jq * 16 + q16; int cs = qc - 8; cs = cs < 0 ? 0 : (cs > 48 ? 48 : cs);
#pragma unroll
        for (int e = 0; e < 4; ++e) { const int k0 = o0 + 4 * g + e, k1 = o1 + 4 * g + e;
            madd[0][e] = ((unsigned)(k0 - cs) < 16u) ? 0.f : -1.0e30f;
            madd[1][e] = (((unsigned)(k1 - cs) < 16u) && !(jq == 3 && k1 < 56)) ? 0.f : -1.0e30f; }
        lb[0] = 64 + o0 + 4 * g - qc + 15; lb[1] = 64 + o1 + 4 * g - qc + 15;
    }
    v4u kr0, vr0, kr1, vr1, qrA[2], qrB[2];
    auto issue_first = [&](const NaItem& I) {
        const bf16* Pk = PROJ + 1024 + I.h * HD + 8 * spart, * Pv = PROJ + 1536 + I.h * HD + 8 * spart, * Pq = PROJ + 512 + I.h * HD;
        kr0 = *(const v4u*)(Pk + (size_t)(krow_of(I, 0) + (int)skey) * IND); vr0 = *(const v4u*)(Pv + (size_t)(krow_of(I, 0) + (int)skey) * IND);
        kr1 = *(const v4u*)(Pk + (size_t)(krow_of(I, 1) + (int)skey) * IND); vr1 = *(const v4u*)(Pv + (size_t)(krow_of(I, 1) + (int)skey) * IND);
#pragma unroll
        for (int s_ = 0; s_ < 2; ++s_) { qrA[s_] = *(const v4u*)(Pq + (size_t)(I.qrow0 + q16) * IND + 32 * s_ + 8 * g);
            qrB[s_] = I.isctx ? qrA[s_] : *(const v4u*)(Pq + (size_t)(I.qrow0 + 64 + q16) * IND + 32 * s_ + 8 * g); }
    };
    NaItem I; int it = F.vcu; bool have = it < nitems; int tb_h = -1;
    if (have) { decode(it, I); issue_first(I); }
    while (have) {
        const bool isctx = I.isctx != 0;
        const int ra = I.ra, rsI = I.rsI, nloc = I.nloc, nch = I.nch, npair = I.npair, qrow0 = I.qrow0, h = I.h;
        const bf16* Pk = PROJ + 1024 + h * HD + 8 * spart, * Pv = PROJ + 1536 + h * HD + 8 * spart;
        s16x8 qfA[2], qfB[2];
#pragma unroll
        for (int s_ = 0; s_ < 2; ++s_) { qfA[s_] = na_scale_q(qrA[s_], c1); qfB[s_] = na_scale_q(qrB[s_], c1); }
        const int rsA = na_rs(ra), rsB = na_rs(ra + 1);
        NaItem N; const int itn = it + F.G; const bool haven = itn < nitems; if (haven) decode(itn, N); else N = I;
        __syncthreads();
        if (!isctx && h != tb_h) { const float* rpb = INP(14) + ((size_t)l * NH + h) * 15 * 31; tb_h = h;
            for (int i = F.tid; i < 640; i += NWAVES * 64) tb[i] = (i >= 64 && i < 64 + 465) ? rpb[i - 64] * 1.4426950408889634f : 0.f; }
        {
            LAS unsigned char* s0 = F.lds;
            *(LAS v4u*)(s0 + skey * NA_KROW + spart * 16) = kr0; *(LAS v4u*)(s0 + 64 * NA_KROW + skey * NA_VROW + spart * 16) = vr0;
            *(LAS v4u*)(s0 + NA_STAGE + skey * NA_KROW + spart * 16) = kr1; *(LAS v4u*)(s0 + NA_STAGE + 64 * NA_KROW + skey * NA_VROW + spart * 16) = vr1;
        }
        if (npair > 2) {
            kr0 = *(const v4u*)(Pk + (size_t)(krow_of(I, 2) + (int)skey) * IND); vr0 = *(const v4u*)(Pv + (size_t)(krow_of(I, 2) + (int)skey) * IND);
            kr1 = *(const v4u*)(Pk + (size_t)(krow_of(I, 3) + (int)skey) * IND); vr1 = *(const v4u*)(Pv + (size_t)(krow_of(I, 3) + (int)skey) * IND);
        } else {
            kr0 = *(const v4u*)(Pk + (size_t)(krow_of(I, 2) + (int)skey) * IND); vr0 = *(const v4u*)(Pv + (size_t)(krow_of(I, 2) + (int)skey) * IND);
            kr1 = *(const v4u*)(Pk + (size_t)(krow_of(I, 3) + (int)skey) * IND); vr1 = *(const v4u*)(Pv + (size_t)(krow_of(I, 3) + (int)skey) * IND);
        }
        NaBlk A, B;
#pragma unroll
        for (int dt = 0; dt < 4; ++dt) { A.O[dt] = (f32x4){0.f, 0.f, 0.f, 0.f}; B.O[dt] = (f32x4){0.f, 0.f, 0.f, 0.f}; }
        A.m = 0.f; A.lsum = 0.f; A.first = 1; B.m = 0.f; B.lsum = 0.f; B.first = 1;
        for (int cp = 0; cp < npair; ++cp) {
            __syncthreads();
            if (cp + 1 < npair) { LAS unsigned char* nx = F.lds + ((cp + 1) & 1) * NA_SLOT;
                *(LAS v4u*)(nx + skey * NA_KROW + spart * 16) = kr0; *(LAS v4u*)(nx + 64 * NA_KROW + skey * NA_VROW + spart * 16) = vr0;
                *(LAS v4u*)(nx + NA_STAGE + skey * NA_KROW + spart * 16) = kr1; *(LAS v4u*)(nx + NA_STAGE + 64 * NA_KROW + skey * NA_VROW + spart * 16) = vr1; }
            if (cp + 2 < npair) { const int k2 = krow_of(I, 2 * cp + 4) + (int)skey, k3 = krow_of(I, 2 * cp + 5) + (int)skey;
                kr0 = *(const v4u*)(Pk + (size_t)k2 * IND); vr0 = *(const v4u*)(Pv + (size_t)k2 * IND); kr1 = *(const v4u*)(Pk + (size_t)k3 * IND); vr1 = *(const v4u*)(Pv + (size_t)k3 * IND); }
            else if (cp + 2 == npair && haven) issue_first(N);
          for (int sub = 0; sub < 2; ++sub) {
            const int ch = 2 * cp + sub;
            if (ch >= nch) break;
            LAS unsigned char* cur = F.lds + (cp & 1) * NA_SLOT + sub * NA_STAGE;
            const bool local = ch < nloc;
            const int kr = rsI + ch;
            const bool actA = !local || (kr >= rsA && kr <= rsA + 7), actB = !isctx && (!local || (kr >= rsB && kr <= rsB + 7));
            if ((!actA && !actB) || nav == 1) continue;
            auto fix = [&](f32x4* S, int nt_, NaBlk& X, float cm) __attribute__((always_inline)) {
                cm = fmaxf(cm, __shfl_xor(cm, 16)); cm = fmaxf(cm, __shfl_xor(cm, 32));
                const float d = X.first ? cm : fmaxf(cm, 0.f);
                if (!X.first) { const float alpha = __builtin_amdgcn_exp2f(-d); X.lsum *= alpha;
#pragma unroll
                    for (int dt = 0; dt < 4; ++dt) X.O[dt] = X.O[dt] * alpha; }
                X.m += d; X.first = 0;
#pragma unroll
                for (int t = 0; t < 4; ++t) if (t < nt_) S[t] = S[t] - d;
            };
            auto probs = [&](f32x4* S, int nt_, NaBlk& X, unsigned (*pk)[2]) __attribute__((always_inline)) {
                float ps = 0.f;
#pragma unroll
                for (int t = 0; t < 4; ++t) if (t < nt_) {
                    const float p0 = __builtin_amdgcn_exp2f(S[t][0]), p1 = __builtin_amdgcn_exp2f(S[t][1]), p2 = __builtin_amdgcn_exp2f(S[t][2]), p3 = __builtin_amdgcn_exp2f(S[t][3]);
                    ps += (p0 + p1) + (p2 + p3);
                    pk[t][0] = pg8::cvt_pk_bf16(p0, p1); pk[t][1] = pg8::cvt_pk_bf16(p2, p3); }
                X.lsum += ps;
            };
            auto finish = [&](f32x4* S, int nt_, NaBlk& X, unsigned (*pk)[2], float cm) __attribute__((always_inline)) {
                if (X.first || !__all(cm <= 8.f)) fix(S, nt_, X, cm);
                probs(S, nt_, X, pk);
            };
            auto finish2 = [&](f32x4* SA, f32x4* SB, int nt_, unsigned (*pa)[2], unsigned (*pb)[2], float cmA, float cmB) __attribute__((always_inline)) {
                if (A.first || B.first || !__all(fmaxf(cmA, cmB) <= 8.f)) {
                    if (A.first || !__all(cmA <= 8.f)) fix(SA, nt_, A, cmA);
                    if (B.first || !__all(cmB <= 8.f)) fix(SB, nt_, B, cmB);
                }
                probs(SA, nt_, A, pa); probs(SB, nt_, B, pb);
            };
            auto chunk_local = [&](const bool aA, const bool aB) __attribute__((always_inline)) {
                unsigned pkA[4][2], pkB[4][2];
                const LAS unsigned char* kb_ = cur + q16 * NA_KROW + 16 * g;
                f32x4 SA[2], SB[2];
#pragma unroll
                for (int t = 0; t < 2; ++t) { const float ma = -A.m, mb = -B.m; SA[t] = (f32x4){ma, ma, ma, ma}; SB[t] = (f32x4){mb, mb, mb, mb};
                    const int o = t == 0 ? o0 : o1;
#pragma unroll
                    for (int s_ = 0; s_ < 2; ++s_) { const s16x8 kf = *(const LAS s16x8*)(kb_ + o * NA_KROW + 64 * s_);
                        if (aA) SA[t] = __builtin_amdgcn_mfma_f32_16x16x32_bf16(kf, qfA[s_], SA[t], 0, 0, 0);
                        if (aB) SB[t] = __builtin_amdgcn_mfma_f32_16x16x32_bf16(kf, qfB[s_], SB[t], 0, 0, 0); } }
                if (nav == 2) { asm volatile("" :: "v"(SA[0]), "v"(SA[1]), "v"(SB[0]), "v"(SB[1])); return; }
                auto bias_local = [&](f32x4 (&S)[2], int rq) __attribute__((always_inline)) -> float {
                    float cm = -1.0e30f;
#pragma unroll
                    for (int t = 0; t < 2; ++t) { const LAS float* tr_ = tb + (kr - rq + 7) * 31 + lb[t];
#pragma unroll
                        for (int e = 0; e < 4; ++e) { const float v = (S[t][e] + tr_[e]) + madd[t][e]; S[t][e] = v; cm = fmaxf(cm, v); } }
                    return cm;
                };
                if (aA && aB) { const float cmA = bias_local(SA, ra), cmB = bias_local(SB, ra + 1); finish2(SA, SB, 2, pkA, pkB, cmA, cmB); }
                else { if (aA) { const float cmA = bias_local(SA, ra); finish(SA, 2, A, pkA, cmA); }
                       if (aB) { const float cmB = bias_local(SB, ra + 1); finish(SB, 2, B, pkB, cmB); } }
                if (nav == 3) { asm volatile("" :: "v"(pkA[0][0]), "v"(pkA[1][1]), "v"(pkB[0][0]), "v"(pkB[1][1])); return; }
                const LAS unsigned char* vtr = cur + 64 * NA_KROW + (4 * g + (q16 >> 2)) * NA_VROW + (q16 & 3) * 8;
                const v4u bwA = {pkA[0][0], pkA[0][1], pkA[1][0], pkA[1][1]}, bwB = {pkB[0][0], pkB[0][1], pkB[1][0], pkB[1][1]};
                const s16x8 bfA = __builtin_bit_cast(s16x8, bwA), bfB = __builtin_bit_cast(s16x8, bwB);
#pragma unroll
                for (int dt = 0; dt < 4; ++dt) {
                    const s16x4 a0 = __builtin_amdgcn_ds_read_tr16_b64_v4i16((LAS s16x4*)(vtr + o0 * NA_VROW + dt * 32));
                    const s16x4 a1 = __builtin_amdgcn_ds_read_tr16_b64_v4i16((LAS s16x4*)(vtr + o1 * NA_VROW + dt * 32));
                    const s16x8 afrag = __builtin_shufflevector(a0, a1, 0, 1, 2, 3, 4, 5, 6, 7);
                    if (aA) A.O[dt] = __builtin_amdgcn_mfma_f32_16x16x32_bf16(afrag, bfA, A.O[dt], 0, 0, 0);
                    if (aB) B.O[dt] = __builtin_amdgcn_mfma_f32_16x16x32_bf16(afrag, bfB, B.O[dt], 0, 0, 0);
                }
            };
            auto chunk_ctx = [&](const bool aB) __attribute__((always_inline)) {
                unsigned pkA[4][2], pkB[4][2];
                const LAS unsigned char* kb_ = cur + q16 * NA_KROW + 16 * g;
                f32x4 SA[4], SB[4];
#pragma unroll
                for (int t = 0; t < 4; ++t) { const float ma = -A.m, mb = -B.m; SA[t] = (f32x4){ma, ma, ma, ma}; SB[t] = (f32x4){mb, mb, mb, mb};
#pragma unroll
                    for (int s_ = 0; s_ < 2; ++s_) { const s16x8 kf = *(const LAS s16x8*)(kb_ + t * 16 * NA_KROW + 64 * s_);
                        SA[t] = __builtin_amdgcn_mfma_f32_16x16x32_bf16(kf, qfA[s_], SA[t], 0, 0, 0);
                        if (aB) SB[t] = __builtin_amdgcn_mfma_f32_16x16x32_bf16(kf, qfB[s_], SB[t], 0, 0, 0); } }
                if (nav == 2) { asm volatile("" :: "v"(SA[0]), "v"(SA[1]), "v"(SA[2]), "v"(SA[3]), "v"(SB[0]), "v"(SB[1]), "v"(SB[2]), "v"(SB[3])); return; }
                auto max_ctx = [&](f32x4 (&S)[4]) __attribute__((always_inline)) -> float {
                    float cm = -1.0e30f;
#pragma unroll
                    for (int t = 0; t < 4; ++t)
#pragma unroll
                        for (int e = 0; e < 4; ++e) cm = fmaxf(cm, S[t][e]);
                    return cm;
                };
                if (aB) { const float cmA = max_ctx(SA), cmB = max_ctx(SB); finish2(SA, SB, 4, pkA, pkB, cmA, cmB); }
                else { const float cmA = max_ctx(SA); finish(SA, 4, A, pkA, cmA); }
                if (nav == 3) { asm volatile("" :: "v"(pkA[0][0]), "v"(pkA[1][1]), "v"(pkA[2][0]), "v"(pkA[3][1]), "v"(pkB[0][0]), "v"(pkB[1][1]), "v"(pkB[2][0]), "v"(pkB[3][1])); return; }
                const LAS unsigned char* vtr = cur + 64 * NA_KROW + (4 * g + (q16 >> 2)) * NA_VROW + (q16 & 3) * 8;
#pragma unroll
                for (int p = 0; p < 2; ++p) {
                    const v4u bwA = {pkA[2 * p][0], pkA[2 * p][1], pkA[2 * p + 1][0], pkA[2 * p + 1][1]}, bwB = {pkB[2 * p][0], pkB[2 * p][1], pkB[2 * p + 1][0], pkB[2 * p + 1][1]};
                    const s16x8 bfA = __builtin_bit_cast(s16x8, bwA), bfB = __builtin_bit_cast(s16x8, bwB);
#pragma unroll
                    for (int dt = 0; dt < 4; ++dt) {
                        const s16x4 a0 = __builtin_amdgcn_ds_read_tr16_b64_v4i16((LAS s16x4*)(vtr + (2 * p) * 16 * NA_VROW + dt * 32));
                        const s16x4 a1 = __builtin_amdgcn_ds_read_tr16_b64_v4i16((LAS s16x4*)(vtr + (2 * p + 1) * 16 * NA_VROW + dt * 32));
                        const s16x8 afrag = __builtin_shufflevector(a0, a1, 0, 1, 2, 3, 4, 5, 6, 7);
                        A.O[dt] = __builtin_amdgcn_mfma_f32_16x16x32_bf16(afrag, bfA, A.O[dt], 0, 0, 0);
                        if (aB) B.O[dt] = __builtin_amdgcn_mfma_f32_16x16x32_bf16(afrag, bfB, B.O[dt], 0, 0, 0);
                    }
                }
            };
            if (local) { if (actA && actB) chunk_local(true, true); else chunk_local(actA, actB); }
            else { if (actB) chunk_ctx(true); else chunk_ctx(false); }
          }
        }
        {
            float ls = A.lsum; ls += __shfl_xor(ls, 16); ls += __shfl_xor(ls, 32);
            const float inv = __builtin_amdgcn_rcpf(ls);
            bf16* op = MIX + (size_t)(qrow0 + q16) * D + 256 + h * HD + 4 * g;
#pragma unroll
            for (int dt = 0; dt < 4; ++dt) { v2u w; w.x = pg8::cvt_pk_bf16(A.O[dt][0] * inv, A.O[dt][1] * inv); w.y = pg8::cvt_pk_bf16(A.O[dt][2] * inv, A.O[dt][3] * inv); *(v2u*)(op + 16 * dt) = w; }
        }
        if (!isctx) {
            float ls = B.lsum; ls += __shfl_xor(ls, 16); ls += __shfl_xor(ls, 32);
            const float inv = __builtin_amdgcn_rcpf(ls);
            bf16* op = MIX + (size_t)(qrow0 + 64 + q16) * D + 256 + h * HD + 4 * g;
#pragma unroll
            for (int dt = 0; dt < 4; ++dt) { v2u w; w.x = pg8::cvt_pk_bf16(B.O[dt][0] * inv, B.O[dt][1] * inv); w.y = pg8::cvt_pk_bf16(B.O[dt][2] * inv, B.O[dt][3] * inv); *(v2u*)(op + 16 * dt) = w; }
        }
        it = itn; have = haven; I = N;
    }
}

constexpr int LRU_UCROW = 260;
constexpr int LRU_OFF_UC = 38 * 256 * 2, LRU_OFF_GT = LRU_OFF_UC + 2 * 32 * LRU_UCROW * 4;
static_assert(LRU_OFF_GT + 32 * 256 * 2 <= RING_BYTES, "LRU LDS map");
template <int PASS>
__device__ __forceinline__ void lru_phase(Frame& F, int l, int ntiles) {
    const bf16* PROJ = WSP(const bf16, WS_PROJ);
    LAS bf16* rxs = (LAS bf16*)(F.lds);
    LAS float* ucf = (LAS float*)(F.lds + LRU_OFF_UC);
    LAS bf16* gts = (LAS bf16*)(F.lds + LRU_OFF_GT);
    const int lane = F.lane, j16 = lane & 15, g = lane >> 4;
    const int kb = F.wave & 3, nh = F.wave >> 2;
    s16x8 wf[2][2][2][2];
    float cbx[2][2], cba[2][2], csp[2][2];
#pragma unroll
    for (int dir = 0; dir < 2; ++dir) {
        const int ld = l * 2 + dir;
        const bf16* WLR = WSP(const bf16, WS_WLR) + (size_t)((ld * 4 + kb) * 2) * 4096;
#pragma unroll
        for (int gt = 0; gt < 2; ++gt)
#pragma unroll
            for (int n2 = 0; n2 < 2; ++n2)
#pragma unroll
                for (int s_ = 0; s_ < 2; ++s_) wf[dir][gt][n2][s_] = *(const s16x8*)(WLR + gt * 4096 + (16 * (2 * nh + n2) + j16) * 64 + 32 * s_ + 8 * g);
#pragma unroll
        for (int n2 = 0; n2 < 2; ++n2) {
            const int e = kb * 64 + 16 * (2 * nh + n2) + j16, idx = ld * 256 + e;
            cbx[dir][n2] = INP(18)[idx]; cba[dir][n2] = INP(20)[idx];
            const float nl = -INP(21)[idx]; csp[dir][n2] = -8.f * (fmaxf(nl, 0.f) + log1pf(__expf(-fabsf(nl))));
        }
    }
    const int c = F.tid & 255, sdir = F.tid >> 8;
    const int sld = l * 2 + sdir;
    const float s1w0 = INP(15)[(sld * 4 + 0) * 256 + c], s1w1 = INP(15)[(sld * 4 + 1) * 256 + c], s1w2 = INP(15)[(sld * 4 + 2) * 256 + c], s1w3 = INP(15)[(sld * 4 + 3) * 256 + c], s1cb = INP(16)[sld * 256 + c];
    const int base = sdir == 0 ? 0 : 3;
    unsigned pre[10], pgw[8];
    auto load_tile = [&](int T) {
        const int row0 = T * 32;
        int lo, hi; if (row0 < ML) { lo = row0 & ~(SEQ - 1); hi = lo + SEQ; } else { lo = row0 & ~(CTXL - 1); hi = lo + CTXL; }
#pragma unroll
        for (int j = 0; j < 10; ++j) { const int i = F.tid + 512 * j, rr = i >> 7, cp = i & 127, row = row0 - 3 + rr;
            const bool ok = (j < 9 || F.tid < 256) && row >= lo && row < hi;
            pre[j] = ok ? *(const unsigned*)(PROJ + (size_t)row * IND + 2048 + 2 * cp) : 0u; }
        if (PASS == 1) {
#pragma unroll
            for (int j = 0; j < 8; ++j) { const int i = F.tid + 512 * j, t = i >> 7, cp = i & 127; pgw[j] = *(const unsigned*)(PROJ + (size_t)(row0 + t) * IND + 2304 + 2 * cp); }
        }
    };
    if (F.vcu < ntiles) load_tile(F.vcu);
    for (int T = F.vcu; T < ntiles; T += F.G) {
        const int row0 = T * 32;
        __syncthreads();
#pragma unroll
        for (int j = 0; j < 10; ++j) { const int i = F.tid + 512 * j; if (j < 9 || F.tid < 256) ((LAS unsigned*)rxs)[i] = pre[j]; }
        if (PASS == 1) {
#pragma unroll
            for (int j = 0; j < 8; ++j) ((LAS unsigned*)gts)[F.tid + 512 * j] = pgw[j];
        }
        if (T + F.G < ntiles) load_tile(T + F.G);
        float hst[2][2];
#pragma unroll
        for (int dir = 0; dir < 2; ++dir)
#pragma unroll
            for (int n2 = 0; n2 < 2; ++n2) hst[dir][n2] = PASS == 1 ? WSP(const float, WS_CARRY)[((size_t)dir * 1152 + T) * 256 + kb * 64 + 16 * (2 * nh + n2) + j16] : 0.f;
        __syncthreads();
        {
            float x0 = bf1(rxs[(base + 0) * 256 + c]), x1 = bf1(rxs[(base + 1) * 256 + c]), x2 = bf1(rxs[(base + 2) * 256 + c]);
#pragma unroll 8
            for (int t = 0; t < 32; ++t) {
                const float x3 = bf1(rxs[(t + base + 3) * 256 + c]);
                ucf[(sdir * 32 + t) * LRU_UCROW + c] = s1cb + s1w0 * x0 + s1w1 * x1 + s1w2 * x2 + s1w3 * x3;
                x0 = x1; x1 = x2; x2 = x3;
            }
        }
        __syncthreads();
        float hf[2][2][4];
        float Pt[2][2] = {{1.f, 1.f}, {1.f, 1.f}};
#pragma unroll
        for (int dir = 0; dir < 2; ++dir) {
            const bool sec16 = ((g & 1) != 0) != (dir != 0), sec32 = ((g >> 1) != 0) != (dir != 0);
#pragma unroll
            for (int step = 0; step < 2; ++step) {
                const int rt = dir == 0 ? step : 1 - step;
                s16x8 af[2];
#pragma unroll
                for (int s_ = 0; s_ < 2; ++s_) { const LAS float* up = ucf + (dir * 32 + 16 * rt + j16) * LRU_UCROW + kb * 64 + 32 * s_ + 8 * g;
                    const f32x4 u0 = *(const LAS f32x4*)up, u1 = *(const LAS f32x4*)(up + 4);
                    const v4u w = {pg8::cvt_pk_bf16(u0[0], u0[1]), pg8::cvt_pk_bf16(u0[2], u0[3]), pg8::cvt_pk_bf16(u1[0], u1[1]), pg8::cvt_pk_bf16(u1[2], u1[3])};
                    af[s_] = __builtin_bit_cast(s16x8, w); }
#pragma unroll
                for (int n2 = 0; n2 < 2; ++n2) {
                    f32x4 zx = {0.f, 0.f, 0.f, 0.f}, za = {0.f, 0.f, 0.f, 0.f};
#pragma unroll
                    for (int s_ = 0; s_ < 2; ++s_) { zx = __builtin_amdgcn_mfma_f32_16x16x32_bf16(af[s_], wf[dir][0][n2][s_], zx, 0, 0, 0); za = __builtin_amdgcn_mfma_f32_16x16x32_bf16(af[s_], wf[dir][1][n2][s_], za, 0, 0, 0); }
                    const int e = kb * 64 + 16 * (2 * nh + n2) + j16;
                    const LAS float* uo = ucf + (dir * 32 + 16 * rt + 4 * g) * LRU_UCROW + e;
                    float a_[4], b_[4]; unsigned abw[4];
#pragma unroll
                    for (int r = 0; r < 4; ++r) {
                        const float u = uo[r * LRU_UCROW];
                        const float gx = sigmoidf_(zx[r] + cbx[dir][n2]), ga = sigmoidf_(za[r] + cba[dir][n2]);
                        const float la = csp[dir][n2] * ga, a = __builtin_amdgcn_exp2f(1.4426950408889634f * la), y = 2.f * la;
                        const float om = y > -0.02f ? -y * (1.f + y * (0.5f + y * 0.16666667f)) : 1.f - a * a;
                        a_[r] = a; b_[r] = __builtin_amdgcn_sqrtf(om) * gx * u;
                        if (PASS == 0) {
                            const float oma = la > -0.02f ? -la * (1.f + la * (0.5f + la * 0.16666667f)) : 1.f - a;
                            abw[r] = pg8::cvt_pk_bf16(oma, b_[r]); a_[r] = 1.f - bflo(abw[r]); b_[r] = bfhi(abw[r]);
                        }
                    }
                    if (PASS == 0) WSP(v4u, WS_AB)[(((((size_t)T * 2 + dir) * 2 + rt) * 8 + F.wave) * 2 + n2) * 64 + lane] = (v4u){abw[0], abw[1], abw[2], abw[3]};
                    const float P = (a_[0] * a_[1]) * (a_[2] * a_[3]);
                    const float S = dir == 0 ? ((b_[0] * a_[1] + b_[1]) * a_[2] + b_[2]) * a_[3] + b_[3] : ((b_[3] * a_[2] + b_[2]) * a_[1] + b_[1]) * a_[0] + b_[0];
                    const float Pp = __shfl_xor(P, 16), Sp = __shfl_xor(S, 16);
                    const float e1P = sec16 ? Pp : 1.f, e1S = sec16 ? Sp : 0.f;
                    const float prP = P * Pp, prS = sec16 ? P * Sp + S : Pp * S + Sp;
                    const float Pq = __shfl_xor(prP, 32), Sq = __shfl_xor(prS, 32);
                    const float EP = sec32 ? Pq * e1P : e1P, ES = sec32 ? e1P * Sq + e1S : e1S;
                    const float TP = prP * Pq, TS = sec32 ? prP * Sq + prS : Pq * prS + Sq;
                    if (PASS == 1) {
                        float h = EP * hst[dir][n2] + ES;
                        if (dir == 0) {
#pragma unroll
                            for (int r = 0; r < 4; ++r) { h = a_[r] * h + b_[r]; hf[rt][n2][r] = h; }
                        } else {
                            float hb[4];
#pragma unroll
                            for (int r = 3; r >= 0; --r) { h = a_[r] * h + b_[r]; hb[r] = h; }
                            bf16* mp = WSP(bf16, WS_MIX) + (size_t)(row0 + 16 * rt + 4 * g) * D + 768 + e;
                            const LAS bf16* gp = gts + (16 * rt + 4 * g) * 256 + e;
#pragma unroll
                            for (int r = 0; r < 4; ++r) mp[(size_t)r * D] = (bf16)f2bf(gelu_tanh(bf1(gp[r * 256])) * (hf[rt][n2][r] + hb[r]));
                        }
                    } else Pt[dir][n2] *= TP;
                    hst[dir][n2] = TP * hst[dir][n2] + TS;
                }
            }
        }
        if (PASS == 0 && g == 0) {
#pragma unroll
            for (int dir = 0; dir < 2; ++dir)
#pragma unroll
                for (int n2 = 0; n2 < 2; ++n2) WSP(f32x2, WS_TOT)[((size_t)dir * 1152 + T) * 256 + kb * 64 + 16 * (2 * nh + n2) + j16] = (f32x2){Pt[dir][n2], hst[dir][n2]};
        }
    }
}
__device__ __forceinline__ void lru_scan_phase(Frame& F, int l, int ntiles) {
    const bf16* PROJ = WSP(const bf16, WS_PROJ);
    LAS bf16* gts = (LAS bf16*)(F.lds);
    const int lane = F.lane, j16 = lane & 15, g = lane >> 4;
    const int kb = F.wave & 3, nh = F.wave >> 2;
    const v4u* AB = WSP(const v4u, WS_AB);
    v4u pab[2][2][2]; unsigned pgw[8];
    auto load_tile = [&](int T) {
#pragma unroll
        for (int dir = 0; dir < 2; ++dir)
#pragma unroll
            for (int rt = 0; rt < 2; ++rt)
#pragma unroll
                for (int n2 = 0; n2 < 2; ++n2) pab[dir][rt][n2] = AB[(((((size_t)T * 2 + dir) * 2 + rt) * 8 + F.wave) * 2 + n2) * 64 + lane];
#pragma unroll
        for (int j = 0; j < 8; ++j) { const int i = F.tid + 512 * j, t = i >> 7, cp = i & 127; pgw[j] = *(const unsigned*)(PROJ + (size_t)(T * 32 + t) * IND + 2304 + 2 * cp); }
    };
    if (F.vcu < ntiles) load_tile(F.vcu);
    for (int T = F.vcu; T < ntiles; T += F.G) {
        const int row0 = T * 32;
        __syncthreads();
#pragma unroll
        for (int j = 0; j < 8; ++j) ((LAS unsigned*)gts)[F.tid + 512 * j] = pgw[j];
        v4u cur[2][2][2];
#pragma unroll
        for (int dir = 0; dir < 2; ++dir)
#pragma unroll
            for (int rt = 0; rt < 2; ++rt)
#pragma unroll
                for (int n2 = 0; n2 < 2; ++n2) cur[dir][rt][n2] = pab[dir][rt][n2];
        float hst[2][2];
#pragma unroll
        for (int dir = 0; dir < 2; ++dir)
#pragma unroll
            for (int n2 = 0; n2 < 2; ++n2) hst[dir][n2] = WSP(const float, WS_CARRY)[((size_t)dir * 1152 + T) * 256 + kb * 64 + 16 * (2 * nh + n2) + j16];
        if (T + F.G < ntiles) load_tile(T + F.G);
        __syncthreads();
        float hf[2][2][4];
#pragma unroll
        for (int dir = 0; dir < 2; ++dir) {
            const bool sec16 = ((g & 1) != 0) != (dir != 0), sec32 = ((g >> 1) != 0) != (dir != 0);
#pragma unroll
            for (int step = 0; step < 2; ++step) {
                const int rt = dir == 0 ? step : 1 - step;
#pragma unroll
                for (int n2 = 0; n2 < 2; ++n2) {
                    const int e = kb * 64 + 16 * (2 * nh + n2) + j16;
                    const v4u w = cur[dir][rt][n2];
                    const float a_[4] = {1.f - bflo(w.x), 1.f - bflo(w.y), 1.f - bflo(w.z), 1.f - bflo(w.w)}, b_[4] = {bfhi(w.x), bfhi(w.y), bfhi(w.z), bfhi(w.w)};
                    const float P = (a_[0] * a_[1]) * (a_[2] * a_[3]);
                    const float S = dir == 0 ? ((b_[0] * a_[1] + b_[1]) * a_[2] + b_[2]) * a_[3] + b_[3] : ((b_[3] * a_[2] + b_[2]) * a_[1] + b_[1]) * a_[0] + b_[0];
                    const float Pp = __shfl_xor(P, 16), Sp = __shfl_xor(S, 16);
                    const float e1P = sec16 ? Pp : 1.f, e1S = sec16 ? Sp : 0.f;
                    const float prP = P * Pp, prS = sec16 ? P * Sp + S : Pp * S + Sp;
                    const float Pq = __shfl_xor(prP, 32), Sq = __shfl_xor(prS, 32);
                    const float EP = sec32 ? Pq * e1P : e1P, ES = sec32 ? e1P * Sq + e1S : e1S;
                    const float TP = prP * Pq, TS = sec32 ? prP * Sq + prS : Pq * prS + Sq;
                    float h = EP * hst[dir][n2] + ES;
                    if (dir == 0) {
#pragma unroll
                        for (int r = 0; r < 4; ++r) { h = a_[r] * h + b_[r]; hf[rt][n2][r] = h; }
                    } else {
                        float hb[4];
#pragma unroll
                        for (int r = 3; r >= 0; --r) { h = a_[r] * h + b_[r]; hb[r] = h; }
                        bf16* mp = WSP(bf16, WS_MIX) + (size_t)(row0 + 16 * rt + 4 * g) * D + 768 + e;
                        const LAS bf16* gp = gts + (16 * rt + 4 * g) * 256 + e;
#pragma unroll
                        for (int r = 0; r < 4; ++r) mp[(size_t)r * D] = (bf16)f2bf(gelu_tanh(bf1(gp[r * 256])) * (hf[rt][n2][r] + hb[r]));
                    }
                    hst[dir][n2] = TP * hst[dir][n2] + TS;
                }
            }
        }
    }
}

constexpr int LQ_WVB = 35 * 128 + 32 * 144;
constexpr int LQ_WV = 72 * 1024;
constexpr int LQ_CH = TBL_OFF;
constexpr int LQ_FL = LQ_CH + 72 * 2 * 16 * 4;
constexpr int LQ_WV2 = LQ_FL + 2 * 72 * 4;
static_assert(LQ_WV + 6 * LQ_WVB <= RING_BYTES && LQ_WV2 + 2 * LQ_WVB <= LDS_BYTES && LQ_WV2 % 16 == 0, "LRU LDS map");
__device__ __forceinline__ void lru_seq_phase(Frame& F, int l, bool last) {
    const bf16* PROJ = WSP(const bf16, WS_PROJ);
    const int lane = F.lane, j16 = lane & 15, g = lane >> 4, cpn = lane & 31, hh = lane >> 5;
    LAS unsigned char* wreg = F.lds + (F.wave < 6 ? LQ_WV + F.wave * LQ_WVB : LQ_WV2 + (F.wave - 6) * LQ_WVB);
    LAS unsigned* rx32 = (LAS unsigned*)wreg;
    LAS unsigned char* ucb = wreg + 35 * 128;
    volatile LAS unsigned* cflag = (volatile LAS unsigned*)(F.lds + LQ_FL);
    volatile LAS unsigned* hflag = cflag + 72;
    LAS float* chain = (LAS float*)(F.lds + LQ_CH);
    for (int item = F.vcu; item < NB * 16; item += F.G) {
        const int b = item >> 4, cg = item & 15, kb = cg >> 2, nn = cg & 3;
        __syncthreads();
        if (F.tid < 144) cflag[F.tid] = 0u;
        __syncthreads();
        s16x8 wf[2][2][2]; float cbx[2], cba[2], csp[2]; f32x2 cw[2][4], cb[2];
#pragma unroll
        for (int dir = 0; dir < 2; ++dir) {
            const int ld = l * 2 + dir;
            const bf16* WLR = WSP(const bf16, WS_WLR) + (size_t)((ld * 4 + kb) * 2) * 4096;
#pragma unroll
            for (int gt = 0; gt < 2; ++gt)
#pragma unroll
                for (int s_ = 0; s_ < 2; ++s_) wf[dir][gt][s_] = *(const s16x8*)(WLR + gt * 4096 + (16 * nn + j16) * 64 + 32 * s_ + 8 * g);
            const int idx = ld * 256 + kb * 64 + 16 * nn + j16;
            cbx[dir] = INP(18)[idx]; cba[dir] = INP(20)[idx];
            const float nl = -INP(21)[idx]; csp[dir] = -8.f * (fmaxf(nl, 0.f) + log1pf(__expf(-fabsf(nl))));
            const int c0 = kb * 64 + 2 * cpn;
#pragma unroll
            for (int k = 0; k < 4; ++k) cw[dir][k] = (f32x2){INP(15)[(ld * 4 + k) * 256 + c0], INP(15)[(ld * 4 + k) * 256 + c0 + 1]};
            cb[dir] = (f32x2){INP(16)[ld * 256 + c0], INP(16)[ld * 256 + c0 + 1]};
        }
        auto tile_row0 = [&](int s, int dir) -> int { return s < 8 ? ML + b * CTXL + 32 * (dir == 0 ? s : 7 - s) : b * SEQ + 32 * (dir == 0 ? s - 8 : 71 - s); };
        v4u pre[5];
        auto load_rows = [&](int s, int dir) {
            const int lo = s < 8 ? ML + b * CTXL : b * SEQ, hi = lo + (s < 8 ? CTXL : SEQ);
            const int r0 = tile_row0(s, dir) - (dir == 0 ? 3 : 0);
#pragma unroll
            for (int j = 0; j < 5; ++j) { const int rr = (lane >> 3) + 8 * j, row = r0 + rr;
                const bool ok = rr < 35 && row >= lo && row < hi;
                pre[j] = ok ? *(const v4u*)(PROJ + (size_t)row * IND + 2048 + kb * 64 + 8 * (lane & 7)) : (v4u){0u, 0u, 0u, 0u}; }
        };
        load_rows(F.wave, 0);
        for (int s = F.wave; s < 72; s += 8) {
            const bool ctxs = s < 8, comb = ctxs ? s >= 4 : s >= 40, outp = !(last && ctxs);
            float A_[2][2][4], B_[2][2][4], EP[2][2], ES[2][2], TP[2][2], TS[2][2];
#pragma unroll
            for (int dir = 0; dir < 2; ++dir) {
#pragma unroll
                for (int j = 0; j < 5; ++j) { const int rr = (lane >> 3) + 8 * j; if (rr < 35) *(LAS v4u*)(wreg + rr * 128 + 16 * (lane & 7)) = pre[j]; }
                if (dir == 0) load_rows(s, 1); else if (s + 8 < 72) load_rows(s + 8, 0);
                {
                    auto up2 = [](unsigned w) -> f32x2 { return (f32x2){bflo(w), bfhi(w)}; };
                    f32x2 x0 = up2(rx32[(16 * hh + 0) * 32 + cpn]), x1 = up2(rx32[(16 * hh + 1) * 32 + cpn]), x2 = up2(rx32[(16 * hh + 2) * 32 + cpn]);
#pragma unroll
                    for (int t = 0; t < 16; ++t) {
                        const f32x2 x3 = up2(rx32[(16 * hh + t + 3) * 32 + cpn]);
                        const f32x2 acc = cb[dir] + cw[dir][0] * x0 + cw[dir][1] * x1 + cw[dir][2] * x2 + cw[dir][3] * x3;
                        *(LAS unsigned*)(ucb + (16 * hh + t) * 144 + 4 * cpn) = pg8::cvt_pk_bf16(acc[0], acc[1]);
                        x0 = x1; x1 = x2; x2 = x3;
                    }
                }
                const bool sec16 = ((g & 1) != 0) != (dir != 0), sec32 = ((g >> 1) != 0) != (dir != 0);
#pragma unroll
                for (int rt = 0; rt < 2; ++rt) {
                    f32x4 zx = {0.f, 0.f, 0.f, 0.f}, za = {0.f, 0.f, 0.f, 0.f};
#pragma unroll
                    for (int s_ = 0; s_ < 2; ++s_) { const s16x8 af = *(const LAS s16x8*)(ucb + (16 * rt + j16) * 144 + 64 * s_ + 16 * g);
                        zx = __builtin_amdgcn_mfma_f32_16x16x32_bf16(af, wf[dir][0][s_], zx, 0, 0, 0); za = __builtin_amdgcn_mfma_f32_16x16x32_bf16(af, wf[dir][1][s_], za, 0, 0, 0); }
                    float a_[4], b_[4];
#pragma unroll
                    for (int r = 0; r < 4; ++r) {
                        const float u = bf1(*(const LAS bf16*)(ucb + (16 * rt + 4 * g + r) * 144 + 2 * (16 * nn + j16)));
                        const float gx = sigmoidf_(zx[r] + cbx[dir]), ga = sigmoidf_(za[r] + cba[dir]);
                        const float la = csp[dir] * ga, a = __builtin_amdgcn_exp2f(1.4426950408889634f * la), y = 2.f * la;
                        const float om = y > -0.02f ? -y * (1.f + y * (0.5f + y * 0.16666667f)) : 1.f - a * a;
                        a_[r] = a; b_[r] = __builtin_amdgcn_sqrtf(om) * gx * u;
                        A_[dir][rt][r] = a_[r]; B_[dir][rt][r] = b_[r];
                    }
                    const float P = (a_[0] * a_[1]) * (a_[2] * a_[3]);
                    const float S = dir == 0 ? ((b_[0] * a_[1] + b_[1]) * a_[2] + b_[2]) * a_[3] + b_[3] : ((b_[3] * a_[2] + b_[2]) * a_[1] + b_[1]) * a_[0] + b_[0];
                    const float Pp = __shfl_xor(P, 16), Sp = __shfl_xor(S, 16);
                    const float e1P = sec16 ? Pp : 1.f, e1S = sec16 ? Sp : 0.f;
                    const float prP = P * Pp, prS = sec16 ? P * Sp + S : Pp * S + Sp;
                    const float Pq = __shfl_xor(prP, 32), Sq = __shfl_xor(prS, 32);
                    EP[dir][rt] = sec32 ? Pq * e1P : e1P; ES[dir][rt] = sec32 ? e1P * Sq + e1S : e1S;
                    TP[dir][rt] = prP * Pq; TS[dir][rt] = sec32 ? prP * Sq + prS : Pq * prS + Sq;
                }
            }
            bf16 gr[2][2][4];
            if (comb && outp) {
#pragma unroll
                for (int dir = 0; dir < 2; ++dir) { const bf16* gp = PROJ + (size_t)(tile_row0(s, dir) + 4 * g) * IND + 2304 + 16 * cg + j16;
#pragma unroll
                    for (int rt = 0; rt < 2; ++rt)
#pragma unroll
                        for (int r = 0; r < 4; ++r) gr[dir][rt][r] = gp[(size_t)(16 * rt + r) * IND]; }
            }
            float hin[2] = {0.f, 0.f};
            if (s > 0) {
                while (__builtin_amdgcn_readfirstlane(cflag[s - 1]) == 0u) __builtin_amdgcn_s_sleep(1);
                asm volatile("" ::: "memory");
                hin[0] = chain[((s - 1) * 2 + 0) * 16 + j16]; hin[1] = chain[((s - 1) * 2 + 1) * 16 + j16];
            }
#pragma unroll
            for (int dir = 0; dir < 2; ++dir) { const int rf = dir == 0 ? 0 : 1, rs_ = 1 - rf;
                const float hout = (TP[dir][rf] * TP[dir][rs_]) * hin[dir] + (TP[dir][rs_] * TS[dir][rf] + TS[dir][rs_]);
                if (g == 0) chain[(s * 2 + dir) * 16 + j16] = hout; }
            asm volatile("" ::: "memory");
            cflag[s] = 1u;
            asm volatile("" ::: "memory");
#pragma unroll
            for (int dir = 0; dir < 2; ++dir) { const int rf = dir == 0 ? 0 : 1, rs_ = 1 - rf;
                float hv[2][4];
                { float h = EP[dir][rf] * hin[dir] + ES[dir][rf];
                  if (dir == 0) {
#pragma unroll
                      for (int r = 0; r < 4; ++r) { h = A_[dir][rf][r] * h + B_[dir][rf][r]; hv[rf][r] = h; }
                  } else {
#pragma unroll
                      for (int r = 3; r >= 0; --r) { h = A_[dir][rf][r] * h + B_[dir][rf][r]; hv[rf][r] = h; }
                  } }
                { const float hm = TP[dir][rf] * hin[dir] + TS[dir][rf]; float h = EP[dir][rs_] * hm + ES[dir][rs_];
                  if (dir == 0) {
#pragma unroll
                      for (int r = 0; r < 4; ++r) { h = A_[dir][rs_][r] * h + B_[dir][rs_][r]; hv[rs_][r] = h; }
                  } else {
#pragma unroll
                      for (int r = 3; r >= 0; --r) { h = A_[dir][rs_][r] * h + B_[dir][rs_][r]; hv[rs_][r] = h; }
                  } }
                if (outp) {
                    const int id = s < 8 ? (dir == 0 ? s : 7 - s) : (dir == 0 ? s : 79 - s);
                    LAS v4u* hb = (LAS v4u*)(F.lds + id * 1024 + lane * 16);
                    if (!comb) {
                        *hb = (v4u){pg8::cvt_pk_bf16(hv[0][0], hv[0][1]), pg8::cvt_pk_bf16(hv[0][2], hv[0][3]), pg8::cvt_pk_bf16(hv[1][0], hv[1][1]), pg8::cvt_pk_bf16(hv[1][2], hv[1][3])};
                        asm volatile("" ::: "memory");
                        hflag[id] = 1u;
                        asm volatile("" ::: "memory");
                    } else {
                        while (__builtin_amdgcn_readfirstlane(hflag[id]) == 0u) __builtin_amdgcn_s_sleep(1);
                        asm volatile("" ::: "memory");
                        const v4u o = *hb;
                        const float ot[2][4] = {{bflo(o.x), bfhi(o.x), bflo(o.y), bfhi(o.y)}, {bflo(o.z), bfhi(o.z), bflo(o.w), bfhi(o.w)}};
                        bf16* mp = WSP(bf16, WS_MIX) + (size_t)(tile_row0(s, dir) + 4 * g) * D + 768 + 16 * cg + j16;
#pragma unroll
                        for (int rt = 0; rt < 2; ++rt)
#pragma unroll
                            for (int r = 0; r < 4; ++r) mp[(size_t)(16 * rt + r) * D] = (bf16)f2bf(gelu_tanh(bf1(gr[dir][rt][r])) * (hv[rt][r] + ot[rt][r]));
                    }
                }
            }
        }
    }
}

__device__ __forceinline__ void lru_carry(Frame& F) {
    const f32x2* TOT = WSP(const f32x2, WS_TOT); float* CARRY = WSP(float, WS_CARRY);
    for (int it = F.gw; it < NB * 2 * 4; it += F.NGW) {
        const int b = it >> 3, dir = (it >> 2) & 1, c = (it & 3) * 64 + F.lane;
        float h = 0.f;
        for (int g = 0; g < 18; ++g) {
            f32x2 ps[4]; int tl[4];
#pragma unroll
            for (int i = 0; i < 4; ++i) { const int s = g * 4 + i;
                int T; if (s < 8) T = 1024 + b * 8 + (dir == 0 ? s : 7 - s); else T = b * 64 + (dir == 0 ? s - 8 : 71 - s);
                tl[i] = T; ps[i] = TOT[((size_t)dir * 1152 + T) * 256 + c]; }
#pragma unroll
            for (int i = 0; i < 4; ++i) { CARRY[((size_t)dir * 1152 + tl[i]) * 256 + c] = h; h = ps[i][0] * h + ps[i][1]; }
        }
    }
}

__device__ __forceinline__ void ctx_finalize(Frame& F, int l) {
    bf16* XA = WSP(bf16, WS_XA); float* RSSA = WSP(float, WS_RSSA); const float* ACC = WSP(const float, WS_PART); const float* MOD = WSP(const float, WS_MOD);
    const float* go = INP(5) + (l - 1) * D; const float* gso = MOD + ((size_t)(l - 1) * 17 + NB) * MODW + 4 * D;
    const float* gn = INP(4) + l * D; const float* gsn = MOD + ((size_t)l * 17 + NB) * MODW + D;
    for (int r = F.gw; r < MC; r += F.NGW) {
        const size_t row = (size_t)ML + r;
        float ss = 0.f; f32x4 y[4];
#pragma unroll
        for (int j = 0; j < 4; ++j) { const int k = 4 * F.lane + 256 * j;
            const v2u w = *(const v2u*)(XA + row * D + k);
            const f32x4 im = *(const f32x4*)(go + k) * (*(const f32x4*)(gso + k) + 1.0f);
            const f32x4 xo = (f32x4){bflo(w.x) * __builtin_amdgcn_rcpf(im[0]), bfhi(w.x) * __builtin_amdgcn_rcpf(im[1]), bflo(w.y) * __builtin_amdgcn_rcpf(im[2]), bfhi(w.y) * __builtin_amdgcn_rcpf(im[3])};
            const float* ap = ACC + (size_t)r * D + k;
            y[j] = xo + ((*(const f32x4*)ap + *(const f32x4*)(ap + (size_t)MC * D)) + (*(const f32x4*)(ap + (size_t)2 * MC * D) + *(const f32x4*)(ap + (size_t)3 * MC * D)));
            ss += (y[j][0] * y[j][0] + y[j][1] * y[j][1]) + (y[j][2] * y[j][2] + y[j][3] * y[j][3]); }
        ss = wave_sum(ss);
        if (F.lane < 32) RSSA[row * 32 + F.lane] = (F.lane == 0) ? ss : 0.f;
#pragma unroll
        for (int j = 0; j < 4; ++j) { const int k = 4 * F.lane + 256 * j;
            const f32x4 a = y[j] * (*(const f32x4*)(gn + k) * (*(const f32x4*)(gsn + k) + 1.0f));
            v2u o; o.x = pk2(a[0], a[1]); o.y = pk2(a[2], a[3]); *(v2u*)(XA + row * D + k) = o; }
    }
}

__device__ __forceinline__ void final_rows(Frame& F) {
    const bf16* XA = WSP(const bf16, WS_XA); const float* RSS = WSP(const float, WS_RSSA);
    for (int row = F.gw; row < ML; row += 2 * F.NGW) {
        const int row2 = row + F.NGW; const bool two = row2 < ML;
        const v4u a0 = *(const v4u*)(XA + (size_t)row * D + 8 * F.lane), a1 = *(const v4u*)(XA + (size_t)row * D + 512 + 8 * F.lane);
        const float p0 = F.lane < 32 ? RSS[(size_t)row * 32 + F.lane] : 0.f;
        v4u b0 = a0, b1 = a1; float p1 = 0.f;
        if (two) { b0 = *(const v4u*)(XA + (size_t)row2 * D + 8 * F.lane); b1 = *(const v4u*)(XA + (size_t)row2 * D + 512 + 8 * F.lane); p1 = F.lane < 32 ? RSS[(size_t)row2 * 32 + F.lane] : 0.f; }
        const float rs0 = rsqrtf(wave_sum(p0) * (1.f / D) + EPS), rs1 = rsqrtf(wave_sum(p1) * (1.f / D) + EPS);
        float* o = F.out + (size_t)row * D + 8 * F.lane;
        *(f32x4*)(o) = (f32x4){bflo(a0.x), bfhi(a0.x), bflo(a0.y), bfhi(a0.y)} * rs0; *(f32x4*)(o + 4) = (f32x4){bflo(a0.z), bfhi(a0.z), bflo(a0.w), bfhi(a0.w)} * rs0;
        *(f32x4*)(o + 512) = (f32x4){bflo(a1.x), bfhi(a1.x), bflo(a1.y), bfhi(a1.y)} * rs0; *(f32x4*)(o + 516) = (f32x4){bflo(a1.z), bfhi(a1.z), bflo(a1.w), bfhi(a1.w)} * rs0;
        if (two) { float* o2 = F.out + (size_t)row2 * D + 8 * F.lane;
            *(f32x4*)(o2) = (f32x4){bflo(b0.x), bfhi(b0.x), bflo(b0.y), bfhi(b0.y)} * rs1; *(f32x4*)(o2 + 4) = (f32x4){bflo(b0.z), bfhi(b0.z), bflo(b0.w), bfhi(b0.w)} * rs1;
            *(f32x4*)(o2 + 512) = (f32x4){bflo(b1.x), bfhi(b1.x), bflo(b1.y), bfhi(b1.y)} * rs1; *(f32x4*)(o2 + 516) = (f32x4){bflo(b1.z), bfhi(b1.z), bflo(b1.w), bfhi(b1.w)} * rs1; }
    }
}

__device__ __forceinline__ void fill_res_tables(Frame& F, const pg8::Order& S, const float* gate, const float* gmg, const float* gmsc, const float* go, const float* gso) {
    LAS float* T = (LAS float*)(F.lds + TBL_OFF);
    if (F.tid < 256) {
#pragma unroll 1
        for (int i = 0; i < pg8::TBL_UNITS; ++i) { pg8::Unit u; if (!S.next(i, u)) break;
            const int brow = u.pm < ML / 256 ? (u.pm >> 3) : NB, col = u.pn * 256 + F.tid;
            T[i * 256 + F.tid] = gate[(size_t)brow * MODW + col];
            T[(pg8::TBL_UNITS + i) * 256 + F.tid] = gmg[col] * (1.f + gmsc[(size_t)brow * MODW + col]);
            T[(2 * pg8::TBL_UNITS + i) * 256 + F.tid] = __builtin_amdgcn_rcpf(go[col] * (1.f + gso[(size_t)brow * MODW + col])); }
    }
    __syncthreads();
}

template <int LDC>
__device__ __forceinline__ void fill_scale_tables(Frame& F, const pg8::Order& S, const float* RSS, const float* shw) {
    LAS float* RS_T = (LAS float*)(F.lds + TBL_OFF); LAS float* SH_T = RS_T + pg8::TBL_UNITS * 256;
    const int row = F.tid >> 1, half = F.tid & 1;
#pragma unroll 1
    for (int i0 = 0; i0 < pg8::TBL_UNITS; i0 += 3) {
        f32x4 p[3][4], sv[3]; bool ok[3];
#pragma unroll
        for (int j = 0; j < 3; ++j) { pg8::Unit u; ok[j] = S.next(i0 + j, u);
            if (ok[j]) { const float* b = RSS + ((size_t)u.pm * 256 + row) * 32 + 16 * half;
#pragma unroll
                for (int q = 0; q < 4; ++q) p[j][q] = *(const f32x4*)(b + 4 * q);
                if (F.tid < 64) sv[j] = *(const f32x4*)(shw + (size_t)(u.pm < ML / 256 ? (u.pm >> 3) : NB) * LDC + u.pn * 256 + 4 * F.tid); } }
#pragma unroll
        for (int j = 0; j < 3; ++j) if (ok[j]) {
            float s = 0.f;
#pragma unroll
            for (int q = 0; q < 4; ++q) s += (p[j][q][0] + p[j][q][1]) + (p[j][q][2] + p[j][q][3]);
            s += __shfl_xor(s, 1);
            if (half == 0) RS_T[(i0 + j) * 256 + row] = rsqrtf(s * (1.0f / D) + EPS);
            if (F.tid < 64) *(LAS f32x4*)(SH_T + (i0 + j) * 256 + 4 * F.tid) = sv[j]; }
    }
    __syncthreads();
}

constexpr int N_PHASES = 2 + 5 * DEPTH + 1;
struct Args { const float* in[25]; float* out; unsigned char* ws; int ph_lo, ph_hi; };
static_assert(sizeof(Args) == 27 * 8 + 8, "Args has no padding");

__global__ void __launch_bounds__(NWAVES * 64, 2) mega_fwd(Args args) {
    extern __shared__ __attribute__((aligned(16))) unsigned char lds[];
    Frame F;
    F.lds = (LAS unsigned char*)lds;
    const int wave_s = __builtin_amdgcn_readfirstlane((int)threadIdx.x >> 6);
    F.wave = wave_s; F.lane = (int)__builtin_amdgcn_mbcnt_hi(~0u, __builtin_amdgcn_mbcnt_lo(~0u, 0u)); F.tid = wave_s * 64 + F.lane;
    F.G = gridDim.x; { const int bx = blockIdx.x; F.vcu = (F.G % 8 == 0) ? (bx % 8) * (F.G / 8) + bx / 8 : bx; }
    F.gw = F.vcu * NWAVES + F.wave; F.NGW = F.G * NWAVES;
    F.out = args.out; F.ws = args.ws;
    volatile LAS unsigned* MISC = (volatile LAS unsigned*)(F.lds + MISC_OFF);
    for (int u = F.tid; u < (LDS_BYTES - LDSCTL_OFF) / 4; u += NWAVES * 64) ((LAS unsigned*)(F.lds + LDSCTL_OFF))[u] = 0u;
    __syncthreads();
    if (F.tid == 0) {
#pragma unroll
        for (int i = 0; i < 25; ++i) *(LAS unsigned long long*)(F.lds + PTR_OFF + 8 * i) = (unsigned long long)args.in[i];
    }
    __syncthreads();
    XcdBarrier bar = xcd_barrier_post((unsigned*)(F.ws + WS_CTL) + CW_BAR, MISC + 8, F.tid);

    const int lo = args.ph_lo, hi = args.ph_hi;
#ifdef PROBE_MASK
    bool rep_done = false;
#define PROBE_V ((((PROBE_MASK >> ph) & 1) && !rep_done) ? PROBE_VARIANT : 0)
#else
#define PROBE_V 0
#endif
    for (int ph = lo; ph < hi; ++ph) {
        { unsigned ones_ = ~0u; asm volatile("" : "+s"(ones_));
          int t_ = wave_s * 64 + (int)__builtin_amdgcn_mbcnt_hi(ones_, __builtin_amdgcn_mbcnt_lo(ones_, 0u)); asm volatile("" : "+v"(t_)); F.tid = t_; F.lane = t_ & 63; F.wave = __builtin_amdgcn_readfirstlane(t_ >> 6); F.gw = F.vcu * NWAVES + F.wave; }
        if (ph == 0) {
#ifndef NO_P0
            phase_p0a(F);
#endif
        } else if (ph == 1) {
#ifndef NO_P0
            phase_p0b(F);
#endif
        }
        else if (ph == N_PHASES - 1) final_rows(F);
        else {
            const int l = (ph - 2) / 5, k5 = (ph - 2) % 5, k = k5 < 2 ? k5 : k5 + 2; const bool last = (l == DEPTH - 1);
            const int Mx = last ? ML : MT;
            float* MOD = WSP(float, WS_MOD);
            if (k == 0) {
                if (l > 0) { ctx_finalize(F, l); xcd_barrier(bar, F.tid); }
                pg8::Gemm g{WSP(const bf16, WS_XA), WSP(const bf16, WS_WIN) + (size_t)l * IND * D, MT, IND, D};
                pg8::Order S; if (last) S.init(ML, IND, WGM_IN, (MC / 256) * 5, 1, F.G, (int)blockIdx.x); else S.init(MT, IND, WGM_IN, 0, 0, F.G, (int)blockIdx.x);
                fill_scale_tables<IND>(F, S, WSP(const float, WS_RSSA), WSP(const float, WS_SHW1) + (size_t)l * 17 * IND);
                pg8::EpiScale<0, IND, true> E{WSP(bf16, WS_PROJ), (const LAS float*)(F.lds + TBL_OFF), PROBE_V};

#ifndef NO_G0
                pg8::gemm_phase<pg8::EpiScale<0, IND, true>, pg8::Order, true, true>(F.lds + RING_OFF, g, S, E, F.tid);
#endif

            } else if (k == 1) {

#ifndef NO_LRU
                lru_seq_phase(F, l, last);
#ifdef REP_LRU0
                __syncthreads(); lru_seq_phase(F, l, last);
#endif
#endif

                __syncthreads();
#ifndef NO_CONV
                conv_phase(F, l, last ? 1024 : 1152);
                __syncthreads();
#ifdef REP_CONV
                conv_phase(F, l, last ? 1024 : 1152);
                __syncthreads();
#endif
#endif
#ifndef NO_NA
#ifdef REP_NA
                na_phase(F, l, last ? NA_ITEMS_LAT : NA_ITEMS_LAT + NA_ITEMS_CTX, REP_NA);
#else
                na_phase(F, l, last ? NA_ITEMS_LAT : NA_ITEMS_LAT + NA_ITEMS_CTX);
#endif
#ifdef REP_NA
                __syncthreads(); na_phase(F, l, last ? NA_ITEMS_LAT : NA_ITEMS_LAT + NA_ITEMS_CTX, 0);
#endif
#endif
            } else if (k == 4 || k == 6) {
                const bool dn = (k == 6);
                const int ln = (dn && !last) ? l + 1 : l;
                pg8::Gemm g{dn ? WSP(const bf16, WS_HID) : WSP(const bf16, WS_MIX), dn ? WSP(const bf16, WS_W2) + (size_t)l * D * FF : WSP(const bf16, WS_WOUT) + (size_t)l * D * D, Mx, D, dn ? FF : D};
                const bool splitk = dn && !last;
                pg8::Order S; S.init(splitk ? ML : Mx, D, dn ? WGM_DN : WGM_OUT, 0, 0, F.G, (int)blockIdx.x);
                const float* go_g = dn ? INP(5) + l * D : INP(4) + l * D;
                const float* go_s = MOD + (size_t)l * 17 * MODW + (dn ? 4 : 1) * D;
                const bool fin = dn && last;
                fill_res_tables(F, S, MOD + (size_t)l * 17 * MODW + (dn ? 5 : 2) * D, fin ? INP(24) : (dn ? INP(4) : INP(5)) + ln * D, fin ? WSP(const float, WS_ZERO) : MOD + (size_t)ln * 17 * MODW + (dn ? 1 : 4) * D, go_g, go_s);
                pg8::EpiRes<RES_NB> E{(const LAS float*)(F.lds + TBL_OFF), WSP(bf16, WS_XA), dn ? WSP(float, WS_RSSA) : WSP(float, WS_RSSB)};
#ifndef NO_GR
                pg8::gemm_phase<pg8::EpiRes<RES_NB>, pg8::Order, true, true>(F.lds + RING_OFF, g, S, E, F.tid);
                if (splitk) {
                    pg8::Order S2; S2.init(ML, 0, 4, (MC / 256) * 16, 2, F.G, (int)blockIdx.x);
                    pg8::EpiSlab E2{WSP(float, WS_PART), MOD + ((size_t)l * 17 + NB) * MODW + 5 * D};
                    pg8::gemm_phase<pg8::EpiSlab, pg8::Order, true, true, true>(F.lds + RING_OFF, g, S2, E2, F.tid);
                }
#endif
            } else if (k == 5) {
                pg8::Gemm g{WSP(const bf16, WS_XA), WSP(const bf16, WS_W1) + (size_t)l * FF * D, Mx, FF, D};
                pg8::Order S; S.init(Mx, FF, WGM_UP, 0, 0, F.G, (int)blockIdx.x);
                fill_scale_tables<FF>(F, S, WSP(const float, WS_RSSB), WSP(const float, WS_SHW2) + (size_t)l * 17 * FF);
                pg8::EpiScale<1, FF> E{WSP(bf16, WS_HID), (const LAS float*)(F.lds + TBL_OFF), PROBE_V};

#ifndef NO_G1
                pg8::gemm_phase<pg8::EpiScale<1, FF>, pg8::Order, true, true>(F.lds + RING_OFF, g, S, E, F.tid);
#endif

            }
        }
#ifdef PROBE_MASK
        if (((PROBE_MASK >> ph) & 1) && !rep_done) { rep_done = true; xcd_barrier(bar, F.tid); --ph; continue; }
        rep_done = false;
#endif
        if (ph + 1 < hi) xcd_barrier(bar, F.tid);
#ifdef PROBE_BAR2
        if (ph + 1 < hi) xcd_barrier(bar, F.tid);
#endif
    }
}

extern "C" void kernel_launch(void* const* d_in, const int* in_sizes, int n_in, void* d_out, int out_size, void* d_ws, size_t ws_size, hipStream_t stream) {
    static int grid = 0;
    if (grid == 0) {
        if (n_in != 25 || out_size != ML * D || ws_size < WS_END) { fprintf(stderr, "kernel_launch: unexpected shapes (n_in %d out %d ws %zu)\n", n_in, out_size, ws_size); grid = -1; return; }
        int dev = 0, cus = 0;
        if (hipGetDevice(&dev) != hipSuccess || hipDeviceGetAttribute(&cus, hipDeviceAttributeMultiprocessorCount, dev) != hipSuccess) { grid = -1; return; }
        if (hipFuncSetAttribute((const void*)mega_fwd, hipFuncAttributeMaxDynamicSharedMemorySize, LDS_BYTES) != hipSuccess) { fprintf(stderr, "kernel_launch: hipFuncSetAttribute failed\n"); grid = -1; return; }
        int per_cu = 0;
        if (hipOccupancyMaxActiveBlocksPerMultiprocessor(&per_cu, (const void*)mega_fwd, NWAVES * 64, LDS_BYTES) != hipSuccess || per_cu < 1) fprintf(stderr, "kernel_launch: occupancy query reports %d\n", per_cu);
        (void)hipGetLastError();
        grid = cus;
    }
    if (grid < 0) return;
    if (hipMemsetAsync((char*)d_ws + WS_CTL, 0, CTL_ZERO_BYTES, stream) != hipSuccess) return;
    Args a{};
    for (int i = 0; i < 25; ++i) a.in[i] = (const float*)d_in[i];
    a.out = (float*)d_out; a.ws = (unsigned char*)d_ws;
#if MK_N_LAUNCHES == 1
    a.ph_lo = 0; a.ph_hi = N_PHASES;
    hipLaunchKernelGGL(mega_fwd, dim3(grid), dim3(NWAVES * 64), LDS_BYTES, stream, a);
#else
    for (int ph = 0; ph < N_PHASES; ++ph) { a.ph_lo = ph; a.ph_hi = ph + 1; hipLaunchKernelGGL(mega_fwd, dim3(grid), dim3(NWAVES * 64), LDS_BYTES, stream, a); }
#endif
}
```

```cpp
#include <hip/hip_runtime.h>
#include <cstdio>
#include <cstdint>

constexpr int D = 1024, NB = 16, SEQ = 2048, CTXL = 256, DEPTH = 2;
constexpr int ML = NB * SEQ, MC = NB * CTXL, MT = ML + MC;
constexpr int IND = 2560, FF = 4096, NH = 8, HD = 64;
constexpr int MODW = 6 * D;
constexpr float EPS = 1e-6f;
#ifndef MK_N_LAUNCHES
#define MK_N_LAUNCHES 1
#endif

namespace pg8 {
#define PG8_LAS __attribute__((address_space(3)))
typedef unsigned short bf16_t;
typedef short bf16x8 __attribute__((ext_vector_type(8)));
typedef float f32x4 __attribute__((ext_vector_type(4)));
typedef unsigned u32x4 __attribute__((ext_vector_type(4)));
constexpr int BM = 256, BK = 64, HALF = 128, HTB = HALF * BK * 2, STAGE_BYTES = 8 * HTB, NXCD = 8;
constexpr int TBL_UNITS = 9;

__host__ __device__ __forceinline__ int lds_byte(int r, int c) { const int st = (r >> 4) * 2 + (c >> 5), rr = r & 15, cc = c & 31, ob = rr * 64 + cc * 2; return st * 1024 + (ob ^ (((ob >> 9) & 1) << 5)); }
__host__ __device__ __forceinline__ void stage_rc(int b, int& R, int& C) { const int st = b / 1024, sb = b % 1024, swz = sb ^ (((sb >> 9) & 1) << 5); R = (st >> 1) * 16 + swz / 64; C = (st & 1) * 32 + (swz % 64) / 2; }
__host__ __device__ __forceinline__ int perm32(int rho) { const int n = rho >> 4, i = rho & 15; return 8 * (i >> 2) + 4 * n + (i & 3); }

struct Unit { int pm, pn; };
struct Gemm { const bf16_t* A; const bf16_t* Bt; int M, N, K; };

__host__ __device__ __forceinline__ void map_tile(int wgid, int nM, int nN, int WGM, Unit& u) {
    const int nwg = nM * nN;
    { const int q = nwg / NXCD, r = nwg % NXCD, xcd = wgid % NXCD, off = wgid / NXCD; wgid = (xcd < r ? xcd * (q + 1) : r * (q + 1) + (xcd - r) * q) + off; }
    const int nig = WGM * nN, gid = wgid / nig, fm = gid * WGM, gsz = (nM - fm) < WGM ? (nM - fm) : WGM;
    u.pm = fm + ((wgid % nig) % gsz); u.pn = (wgid % nig) / gsz;
}
struct Order {
    int nM, nN, nwg, extra, mode, wgm, G, c;
    __host__ __device__ void init(int M, int N, int wgm_, int extra_, int mode_, int G_, int c_) { nM = M / BM; nN = N / BM; nwg = nM * nN; extra = extra_; mode = mode_; wgm = wgm_; G = G_; c = c_; }
    __host__ __device__ bool next(int i, Unit& u) const {
        const long L = (long)i * G + c;
        if (L < nwg) { map_tile((int)L, nM, nN, wgm, u); return true; }
        if (L < nwg + extra) { const int q = (int)L - nwg;
            if (mode == 1) { u.pm = nM + q / 5; u.pn = 4 + q % 5; }
            else { u.pm = nM + (q >> 4); u.pn = 4 + 4 * (q & 3) + ((q >> 2) & 3); }
            return true; }
        return false;
    }
    __device__ __forceinline__ void a_ready(const Unit&) const {}
    __device__ __forceinline__ void done(const Unit&) const {}
};

__device__ __forceinline__ unsigned cvt_pk_bf16(float lo, float hi) { unsigned r; asm volatile("v_cvt_pk_bf16_f32 %0, %1, %2" : "=v"(r) : "v"(lo), "v"(hi)); return r; }

template <int ACT, int LDC, bool GLU = false> struct EpiScale {
    static constexpr bool PERM = true, AFTER_DRAIN = false;
    bf16_t* O;
    const PG8_LAS float* tbl;
    int probe;
    __device__ __forceinline__ void operator()(const f32x4 (&acc)[2][2][4][2], const Unit& u, int wr, int wc, int fr, int fq, int ui) const {
        asm volatile("" : "+s"(wr), "+s"(wc));
        bf16_t* Ot = O + (size_t)u.pm * BM * LDC + u.pn * BM;
        unsigned cl = (unsigned)(wc * 32 + 8 * fq);
        unsigned rl0 = (unsigned)(wr * 64 + fr);
        asm volatile("" : "+v"(cl), "+v"(rl0));
        const PG8_LAS float* rst = tbl + ui * 256, * sht = tbl + TBL_UNITS * 256 + ui * 256;
        f32x4 sh[2][2]; float rs[2][4];
#pragma unroll
        for (int ai = 0; ai < 2; ++ai)
#pragma unroll
            for (int m = 0; m < 4; ++m) rs[ai][m] = rst[rl0 + (unsigned)(ai * HALF + m * 16)];
#pragma unroll
        for (int bj = 0; bj < 2; ++bj) { sh[bj][0] = *(const PG8_LAS f32x4*)(sht + (cl + (unsigned)(bj * HALF))); sh[bj][1] = *(const PG8_LAS f32x4*)(sht + (cl + (unsigned)(bj * HALF + 4))); }
        if (GLU && u.pn < 2) {
#pragma unroll
            for (int ai = 0; ai < 2; ++ai)
#pragma unroll
                for (int m = 0; m < 4; ++m) {
                    const f32x4 a0 = acc[ai][0][m][0] * rs[ai][m] + sh[0][0], a1 = acc[ai][0][m][1] * rs[ai][m] + sh[0][1];
                    const f32x4 g0 = acc[ai][1][m][0] * rs[ai][m] + sh[1][0], g1 = acc[ai][1][m][1] * rs[ai][m] + sh[1][1];
                    f32x4 v0, v1;
#pragma unroll
                    for (int e = 0; e < 4; ++e) { v0[e] = a0[e] * __builtin_amdgcn_rcpf(1.f + __builtin_amdgcn_exp2f(-1.4426950408889634f * g0[e])); v1[e] = a1[e] * __builtin_amdgcn_rcpf(1.f + __builtin_amdgcn_exp2f(-1.4426950408889634f * g1[e])); }
                    u32x4 w; w.x = cvt_pk_bf16(v0[0], v0[1]); w.y = cvt_pk_bf16(v0[2], v0[3]); w.z = cvt_pk_bf16(v1[0], v1[1]); w.w = cvt_pk_bf16(v1[2], v1[3]);
                    *(u32x4*)(O + (size_t)u.pm * BM * LDC + u.pn * HALF + ((rl0 + (unsigned)(ai * HALF + m * 16)) * (unsigned)LDC + cl)) = w;
                }
            return;
        }
#pragma unroll
        for (int bj = 0; bj < 2; ++bj)
#pragma unroll
            for (int ai = 0; ai < 2; ++ai)
#pragma unroll
                for (int m = 0; m < 4; ++m) {
                    f32x4 v0 = acc[ai][bj][m][0] * rs[ai][m] + sh[bj][0], v1 = acc[ai][bj][m][1] * rs[ai][m] + sh[bj][1];
                    if (ACT == 1) {
#pragma unroll
                        for (int e = 0; e < 4; ++e) { const float a = fmaxf(v0[e], 0.f), b = fmaxf(v1[e], 0.f); v0[e] = a * a; v1[e] = b * b; }
                    }
                    u32x4 w; w.x = cvt_pk_bf16(v0[0], v0[1]); w.y = cvt_pk_bf16(v0[2], v0[3]); w.z = cvt_pk_bf16(v1[0], v1[1]); w.w = cvt_pk_bf16(v1[2], v1[3]);
                    if (probe == 0) *(u32x4*)(Ot + ((rl0 + (unsigned)(ai * HALF + m * 16)) * (unsigned)LDC + cl + (unsigned)(bj * HALF))) = w;
                    else asm volatile("" :: "v"(w));
                }
    }
};
template <int NB_> struct EpiRes {
    static constexpr bool PERM = true, AFTER_DRAIN = false;
    const PG8_LAS float* tbl;
    bf16_t* XA; float* RSS;
    __device__ __forceinline__ void operator()(const f32x4 (&acc)[2][2][4][2], const Unit& u, int wr, int wc, int fr, int fq, int ui) const {
        asm volatile("" : "+s"(wr), "+s"(wc));
        bf16_t* XAt = XA + (size_t)u.pm * BM * D + u.pn * BM;
        float* RSSt = RSS + (size_t)u.pm * BM * 32 + u.pn * 8 + wc;
        unsigned cl = (unsigned)(wc * 32 + 8 * fq);
        unsigned rl0 = (unsigned)(wr * 64 + fr);
        asm volatile("" : "+v"(cl), "+v"(rl0));
        const PG8_LAS float* gT = tbl + ui * 256, * mT = tbl + (TBL_UNITS + ui) * 256, * iT = tbl + (2 * TBL_UNITS + ui) * 256;
        constexpr int BJB = 2 / NB_;
#pragma unroll
        for (int b0 = 0; b0 < 2; b0 += BJB) {
            u32x4 xb[BJB][2][4];
#pragma unroll
            for (int bb = 0; bb < BJB; ++bb)
#pragma unroll
                for (int ai = 0; ai < 2; ++ai)
#pragma unroll
                    for (int m = 0; m < 4; ++m) xb[bb][ai][m] = *(const u32x4*)(XAt + ((rl0 + (unsigned)(ai * HALF + m * 16)) * (unsigned)D + cl + (unsigned)((b0 + bb) * HALF)));
            asm volatile("" ::: "memory");
#pragma unroll
            for (int bb = 0; bb < BJB; ++bb) {
                const int bj = b0 + bb;
                const unsigned c = cl + (unsigned)(bj * HALF);
                const f32x4 g0 = *(const PG8_LAS f32x4*)(gT + c), g1 = *(const PG8_LAS f32x4*)(gT + (c + 4u)), m0 = *(const PG8_LAS f32x4*)(mT + c), m1 = *(const PG8_LAS f32x4*)(mT + (c + 4u)),
                            r0 = *(const PG8_LAS f32x4*)(iT + c), r1 = *(const PG8_LAS f32x4*)(iT + (c + 4u));
#pragma unroll
                for (int ai = 0; ai < 2; ++ai)
#pragma unroll
                    for (int m = 0; m < 4; ++m) {
                        const unsigned rl = rl0 + (unsigned)(ai * HALF + m * 16);
                        const u32x4 w = xb[bb][ai][m];
                        const f32x4 x0 = (f32x4){__uint_as_float(w.x << 16), __uint_as_float(w.x & 0xffff0000u), __uint_as_float(w.y << 16), __uint_as_float(w.y & 0xffff0000u)} * r0;
                        const f32x4 x1 = (f32x4){__uint_as_float(w.z << 16), __uint_as_float(w.z & 0xffff0000u), __uint_as_float(w.w << 16), __uint_as_float(w.w & 0xffff0000u)} * r1;
                        const f32x4 y0 = x0 + g0 * acc[ai][bj][m][0], y1 = x1 + g1 * acc[ai][bj][m][1];
                        float ss = ((y0[0] * y0[0] + y0[1] * y0[1]) + (y0[2] * y0[2] + y0[3] * y0[3])) + ((y1[0] * y1[0] + y1[1] * y1[1]) + (y1[2] * y1[2] + y1[3] * y1[3]));
                        ss += __shfl_xor(ss, 16); ss += __shfl_xor(ss, 32);
                        if (fq == 0) RSSt[rl * 32u + (unsigned)(bj * 4)] = ss;
                        const f32x4 a0 = y0 * m0, a1 = y1 * m1;
                        u32x4 o; o.x = cvt_pk_bf16(a0[0], a0[1]); o.y = cvt_pk_bf16(a0[2], a0[3]); o.z = cvt_pk_bf16(a1[0], a1[1]); o.w = cvt_pk_bf16(a1[2], a1[3]);
                        *(u32x4*)(XAt + (rl * (unsigned)D + c)) = o;
                    }
            }
            asm volatile("" ::: "memory");
        }
    }
};

struct EpiSlab {
    static constexpr bool PERM = true, AFTER_DRAIN = false;
    float* P; const float* gate;
    __device__ __forceinline__ void operator()(const f32x4 (&acc)[2][2][4][2], const Unit& u, int wr, int wc, int fr, int fq, int) const {
        asm volatile("" : "+s"(wr), "+s"(wc));
        const int ks = (u.pn - 4) >> 2, pn = u.pn & 3;
        float* At = P + ((size_t)ks * MC + (size_t)(u.pm - ML / BM) * BM) * D + pn * BM;
        const float* gtq = gate + pn * BM;
        unsigned cl = (unsigned)(wc * 32 + 8 * fq), rl0 = (unsigned)(wr * 64 + fr);
        asm volatile("" : "+v"(cl), "+v"(rl0));
        f32x4 gv[2][2];
#pragma unroll
        for (int bj = 0; bj < 2; ++bj) { gv[bj][0] = *(const f32x4*)(gtq + (cl + (unsigned)(bj * HALF))); gv[bj][1] = *(const f32x4*)(gtq + (cl + (unsigned)(bj * HALF + 4))); }
#pragma unroll
        for (int bj = 0; bj < 2; ++bj) { const unsigned c = cl + (unsigned)(bj * HALF);
#pragma unroll
            for (int ai = 0; ai < 2; ++ai)
#pragma unroll
                for (int m = 0; m < 4; ++m) { const unsigned off = (rl0 + (unsigned)(ai * HALF + m * 16)) * (unsigned)D + c;
                    *(f32x4*)(At + off) = gv[bj][0] * acc[ai][bj][m][0]; *(f32x4*)(At + (off + 4u)) = gv[bj][1] * acc[ai][bj][m][1]; } }
    }
};

template <class Epi, class Sched, bool ALIGN_EPI = false, bool SP2 = false, bool VARK = false>
__device__ __forceinline__ void gemm_phase(PG8_LAS unsigned char* lds, const Gemm g, const Sched& S, const Epi& E, const int tid) {
    const int wid = __builtin_amdgcn_readfirstlane(tid >> 6), lane = tid & 63, wr = wid >> 2, wc = wid & 3, fr = lane & 15, fq = lane >> 4;
    const int K = g.K;
    unsigned voffA[2], voffB[2];
#pragma unroll
    for (int i = 0; i < 2; ++i) { int R, C; stage_rc(tid * 16 + i * 8192, R, C); const int Rb = Epi::PERM ? ((R & ~31) + perm32(R & 31)) : R;
        voffA[i] = (unsigned)(R * K + C) * 2u; voffB[i] = (unsigned)(Rb * K + C) * 2u; }
    const size_t kstep = (size_t)(BK * 2);
    const size_t hstep = (size_t)HALF * K * 2;
    const size_t tstep = 2 * hstep;
    const unsigned ldsw = (unsigned)wid * 1024u;
    const int aoff = lds_byte(wr * 64 + fr, fq * 8), boff = lds_byte(wc * 32 + fr, fq * 8);
#define PG8_SA(b, h) (((b) * 2 + (h)) * HTB)
#define PG8_SB(b, h) ((4 + (b) * 2 + (h)) * HTB)
#define PG8_STAGE(bufoff, gbase, voff) do { _Pragma("unroll") for (int _i = 0; _i < 2; ++_i) \
        __builtin_amdgcn_global_load_lds((const unsigned*)((const char*)(gbase) + (voff)[_i]), (PG8_LAS unsigned*)(lds + (bufoff) + ldsw + _i * 8192), 16, 0, 0); } while (0)
#define PG8_LDA(dst, b, h) do { _Pragma("unroll") for (int m = 0; m < 4; ++m) _Pragma("unroll") for (int k = 0; k < 2; ++k) dst[m][k] = *(const PG8_LAS bf16x8*)(lds + PG8_SA(b, h) + aoff + m * 2048 + k * 1024); } while (0)
#define PG8_LDB(dst, b, h) do { _Pragma("unroll") for (int n = 0; n < 2; ++n) _Pragma("unroll") for (int k = 0; k < 2; ++k) dst[n][k] = *(const PG8_LAS bf16x8*)(lds + PG8_SB(b, h) + boff + n * 2048 + k * 1024); } while (0)
#define PG8_MMA(ai, bj, At, Bt) do { __builtin_amdgcn_s_setprio(1); _Pragma("unroll") for (int m = 0; m < 4; ++m) _Pragma("unroll") for (int n = 0; n < 2; ++n) _Pragma("unroll") for (int k = 0; k < 2; ++k) \
        acc[ai][bj][m][n] = __builtin_amdgcn_mfma_f32_16x16x32_bf16(Bt[n][k], At[m][k], acc[ai][bj][m][n], 0, 0, 0); __builtin_amdgcn_s_setprio(0); } while (0)
#define PG8_WAIT_V(n) asm volatile("s_waitcnt vmcnt(" #n ")" ::: "memory")
#define PG8_WAIT_L(n) asm volatile("s_waitcnt lgkmcnt(" #n ")" ::: "memory")
#define PG8_BAR __builtin_amdgcn_s_barrier()
#define PG8_SCHED __builtin_amdgcn_sched_barrier(0)
    Unit cur, nxt; int ui = 0;
    if (!S.next(0, cur)) return;
    cur.pm = __builtin_amdgcn_readfirstlane(cur.pm); cur.pn = __builtin_amdgcn_readfirstlane(cur.pn);
    f32x4 acc[2][2][4][2];
#pragma unroll
    for (int a = 0; a < 2; ++a)
#pragma unroll
        for (int b = 0; b < 2; ++b)
#pragma unroll
            for (int m = 0; m < 4; ++m)
#pragma unroll
                for (int n = 0; n < 2; ++n) acc[a][b][m][n] = (f32x4){0.f, 0.f, 0.f, 0.f};
    bf16x8 At[4][2], B0[2][2], B1[2][2];
#define PG8_KOFF(u) ((VARK && (u).pn >= 4) ? (size_t)(((u).pn - 4) >> 2) * (size_t)(K / 4) * 2 : (size_t)0)
#define PG8_PN(u) ((VARK && (u).pn >= 4) ? ((u).pn & 3) : (u).pn)
    const char* cA = (const char*)g.A + (size_t)cur.pm * tstep + PG8_KOFF(cur); const char* cB = (const char*)g.Bt + (size_t)PG8_PN(cur) * tstep + PG8_KOFF(cur);
    S.a_ready(cur);
    if constexpr (SP2) {
        PG8_STAGE(PG8_SB(0, 0), cB, voffB); PG8_STAGE(PG8_SB(0, 1), cB + hstep, voffB); PG8_STAGE(PG8_SA(0, 0), cA, voffA); PG8_STAGE(PG8_SA(0, 1), cA + hstep, voffA);
        if (wr == 1) PG8_BAR;
        PG8_WAIT_V(2); PG8_BAR;
        PG8_STAGE(PG8_SB(1, 0), cB + kstep, voffB); PG8_STAGE(PG8_SA(1, 0), cA + kstep, voffA); PG8_STAGE(PG8_SB(1, 1), cB + hstep + kstep, voffB);
        PG8_WAIT_V(6); PG8_BAR;
    } else {
        PG8_STAGE(PG8_SB(0, 0), cB, voffB); PG8_STAGE(PG8_SA(0, 0), cA, voffA); PG8_STAGE(PG8_SB(0, 1), cB + hstep, voffB); PG8_STAGE(PG8_SA(0, 1), cA + hstep, voffA);
        if (wr == 1) PG8_BAR;
        PG8_WAIT_V(4); PG8_BAR;
        PG8_STAGE(PG8_SB(1, 0), cB + kstep, voffB); PG8_STAGE(PG8_SA(1, 0), cA + kstep, voffA); PG8_STAGE(PG8_SB(1, 1), cB + hstep + kstep, voffB);
        PG8_WAIT_V(6); PG8_BAR;
    }
    for (;;) {
        const bool has_next = S.next(ui + 1, nxt);
        nxt.pm = __builtin_amdgcn_readfirstlane(nxt.pm); nxt.pn = __builtin_amdgcn_readfirstlane(nxt.pn);
        const char* nA = has_next ? (const char*)g.A + (size_t)nxt.pm * tstep + PG8_KOFF(nxt) : cA; const char* nB = has_next ? (const char*)g.Bt + (size_t)PG8_PN(nxt) * tstep + PG8_KOFF(nxt) : cB;
        const int nt = (VARK && cur.pn >= 4) ? K / BK / 4 : K / BK;
        for (int t = 0; t < nt; t += 2) {
            const bool last = (t == nt - 2);
            const char* a1 = cA + (size_t)(t + 1) * kstep;
            const char* a2 = last ? nA : cA + (size_t)(t + 2) * kstep; const char* b2 = last ? nB : cB + (size_t)(t + 2) * kstep;
            const char* a3 = a2 + kstep; const char* b3 = b2 + kstep;
            if (last && has_next) S.a_ready(nxt);
            if constexpr (SP2) {
            PG8_LDB(B0, 0, 0); PG8_LDB(B1, 0, 1); PG8_SCHED; PG8_LDA(At, 0, 0); PG8_STAGE(PG8_SA(1, 1), a1 + hstep, voffA);
            PG8_WAIT_V(8); PG8_WAIT_L(0); PG8_BAR; PG8_MMA(0, 0, At, B0); PG8_MMA(0, 1, At, B1); PG8_BAR; PG8_SCHED;
            PG8_LDA(At, 0, 1); PG8_STAGE(PG8_SB(0, 0), b2, voffB); PG8_STAGE(PG8_SB(0, 1), b2 + hstep, voffB); PG8_STAGE(PG8_SA(0, 0), a2, voffA);
            PG8_WAIT_V(8); PG8_WAIT_L(0); PG8_BAR; PG8_MMA(1, 0, At, B0); PG8_MMA(1, 1, At, B1); PG8_BAR; PG8_SCHED;
            PG8_LDB(B0, 1, 0); PG8_LDB(B1, 1, 1); PG8_SCHED; PG8_LDA(At, 1, 0); PG8_STAGE(PG8_SA(0, 1), a2 + hstep, voffA);
            PG8_WAIT_V(8); PG8_WAIT_L(0); PG8_BAR; PG8_MMA(0, 0, At, B0); PG8_MMA(0, 1, At, B1); PG8_BAR; PG8_SCHED;
            PG8_LDA(At, 1, 1); PG8_STAGE(PG8_SB(1, 0), b3, voffB); PG8_STAGE(PG8_SB(1, 1), b3 + hstep, voffB); PG8_STAGE(PG8_SA(1, 0), a3, voffA);
            PG8_WAIT_V(8); PG8_WAIT_L(0); PG8_BAR; PG8_MMA(1, 0, At, B0); PG8_MMA(1, 1, At, B1); PG8_BAR; PG8_SCHED;
            } else {
            PG8_LDB(B0, 0, 0); PG8_SCHED; PG8_LDA(At, 0, 0); PG8_STAGE(PG8_SA(1, 1), a1 + hstep, voffA);
            PG8_WAIT_L(8); PG8_BAR; PG8_WAIT_L(0); PG8_MMA(0, 0, At, B0); PG8_BAR; PG8_SCHED;
            PG8_LDB(B1, 0, 1); PG8_STAGE(PG8_SB(0, 0), b2, voffB);
            PG8_BAR; PG8_WAIT_L(0); PG8_MMA(0, 1, At, B1); PG8_BAR;
            PG8_LDA(At, 0, 1); PG8_STAGE(PG8_SA(0, 0), a2, voffA);
            PG8_BAR; PG8_WAIT_L(0); PG8_MMA(1, 0, At, B0); PG8_BAR; PG8_SCHED;
            PG8_STAGE(PG8_SB(0, 1), b2 + hstep, voffB);
            PG8_WAIT_V(6); PG8_BAR; PG8_MMA(1, 1, At, B1); PG8_BAR;
            PG8_LDB(B0, 1, 0); PG8_SCHED; PG8_LDA(At, 1, 0); PG8_STAGE(PG8_SA(0, 1), a2 + hstep, voffA);
            PG8_WAIT_L(8); PG8_BAR; PG8_WAIT_L(0); PG8_MMA(0, 0, At, B0); PG8_BAR; PG8_SCHED;
            PG8_LDB(B1, 1, 1); PG8_STAGE(PG8_SB(1, 0), b3, voffB);
            PG8_BAR; PG8_WAIT_L(0); PG8_MMA(0, 1, At, B1); PG8_BAR;
            PG8_LDA(At, 1, 1); PG8_STAGE(PG8_SA(1, 0), a3, voffA);
            PG8_BAR; PG8_WAIT_L(0); PG8_MMA(1, 0, At, B0); PG8_BAR; PG8_SCHED;
            PG8_STAGE(PG8_SB(1, 1), b3 + hstep, voffB);
            PG8_WAIT_V(6); PG8_BAR; PG8_MMA(1, 1, At, B1); PG8_BAR;
            }
        }
        if constexpr (ALIGN_EPI) { if (wr == 0) PG8_BAR; }
        if constexpr (!Epi::AFTER_DRAIN) { E(acc, cur, wr, wc, fr, fq, ui); S.done(cur); }
        if (!has_next) break;
#pragma unroll
        for (int a = 0; a < 2; ++a)
#pragma unroll
            for (int b = 0; b < 2; ++b)
#pragma unroll
                for (int m = 0; m < 4; ++m)
#pragma unroll
                    for (int n = 0; n < 2; ++n) acc[a][b][m][n] = (f32x4){0.f, 0.f, 0.f, 0.f};
        cur = nxt; cA = nA; cB = nB; ++ui;
        if constexpr (ALIGN_EPI) { if (wr == 1) PG8_BAR; }
    }
    PG8_WAIT_V(0);
    if constexpr (!ALIGN_EPI) { if (wr == 0) PG8_BAR; }
    PG8_BAR;
    if constexpr (Epi::AFTER_DRAIN) { E.fused(acc, cur, wr, wc, fr, fq, lds, wid, lane); S.done(cur); }
#undef PG8_KOFF
#undef PG8_PN
#undef PG8_SA
#undef PG8_SB
#undef PG8_STAGE
#undef PG8_LDA
#undef PG8_LDB
#undef PG8_MMA
#undef PG8_WAIT_V
#undef PG8_WAIT_L
#undef PG8_BAR
#undef PG8_SCHED
}
}

constexpr size_t MiB = 1u << 20;
constexpr size_t WS_CTL = 0, CTL_ZERO_BYTES = 1 * MiB;
constexpr size_t WS_MOD = 1 * MiB;
constexpr size_t WS_SHW1 = 2 * MiB;
constexpr size_t WS_SHW2 = 3 * MiB;
constexpr size_t WS_RSSA = 4 * MiB;
constexpr size_t WS_RSSB = 9 * MiB;
constexpr size_t WS_TOT = 14 * MiB;
constexpr size_t WS_CARRY = 19 * MiB;
constexpr size_t WS_WLR = 21 * MiB + 512 * 1024;
constexpr size_t WS_WIN = 22 * MiB;
constexpr size_t WS_WOUT = 32 * MiB;
constexpr size_t WS_W1 = 36 * MiB;
constexpr size_t WS_W2 = 52 * MiB;
constexpr size_t WS_CX = 68 * MiB;
constexpr size_t WS_XA = 84 * MiB;
constexpr size_t WS_HID = 156 * MiB;
constexpr size_t WS_PROJ = WS_HID;
constexpr size_t WS_MIX = WS_HID + 180 * MiB;
constexpr size_t WS_PART = 444 * MiB;
constexpr size_t WS_AB = 436 * MiB;
constexpr size_t WS_END = 508 * MiB;
static_assert(WS_MIX + (size_t)MT * D * 2 <= WS_PART && WS_HID + (size_t)MT * FF * 2 == WS_PART && WS_PART + (size_t)4 * MC * D * 4 == WS_END && WS_AB >= WS_MIX + (size_t)MT * D * 2 && WS_AB + (size_t)1152 * 2 * 2 * 8 * 2 * 64 * 16 == WS_END, "ws map");
constexpr size_t WS_ZERO = WS_CTL + 512 * 1024;
constexpr int CW_BAR = 4096;

#ifndef WGM_IN
#define WGM_IN 4
#endif
#ifndef WGM_OUT
#define WGM_OUT 4
#endif
#ifndef WGM_UP
#define WGM_UP 4
#endif
#ifndef WGM_DN
#define WGM_DN 4
#endif
#ifndef RES_NB
#define RES_NB 2
#endif
constexpr int NWAVES = 8;
constexpr int RING_OFF = 0, RING_BYTES = 131072;
constexpr int LDSCTL_OFF = RING_BYTES, MISC_OFF = LDSCTL_OFF + 320;
constexpr int TBL_OFF = LDSCTL_OFF + 1024;
static_assert(TBL_OFF + 3 * pg8::TBL_UNITS * 256 * 4 <= 163840, "LDS map");
constexpr int LDS_BYTES = 163840;

#define GAS __attribute__((address_space(1)))
#define LAS __attribute__((address_space(3)))
typedef unsigned short bf16;
typedef unsigned v4u __attribute__((ext_vector_type(4)));
typedef unsigned v2u __attribute__((ext_vector_type(2)));
typedef float f32x4 __attribute__((ext_vector_type(4)));
typedef float f32x2 __attribute__((ext_vector_type(2)));
typedef GAS unsigned gu32;
#define LDS_WAIT() asm volatile("s_waitcnt lgkmcnt(0)" ::: "memory")
#define VM_WAIT() asm volatile("s_waitcnt vmcnt(0)" ::: "memory")
__device__ __forceinline__ unsigned f2bf(float f) { unsigned u = __builtin_bit_cast(unsigned, f); return (u + 0x7fffu + ((u >> 16) & 1u)) >> 16; }
__device__ __forceinline__ unsigned pk2(float lo, float hi) { return f2bf(lo) | (f2bf(hi) << 16); }
__device__ __forceinline__ float bflo(unsigned w) { return __uint_as_float(w << 16); }
__device__ __forceinline__ float bfhi(unsigned w) { return __uint_as_float(w & 0xffff0000u); }
__device__ __forceinline__ float bf1(bf16 v) { return __uint_as_float((unsigned)v << 16); }
__device__ __forceinline__ float sigmoidf_(float x) { return __builtin_amdgcn_rcpf(1.f + __builtin_amdgcn_exp2f(-1.4426950408889634f * x)); }
__device__ __forceinline__ float siluf_(float x) { return x * sigmoidf_(x); }
__device__ __forceinline__ float gelu_tanh(float x) { const float u = 0.7978845608028654f * (x + 0.044715f * x * x * x); return x * sigmoidf_(2.f * u); }
__device__ __forceinline__ float wave_sum(float v) {
#pragma unroll
    for (int o = 1; o < 64; o <<= 1) v += __shfl_xor(v, o);
    return v;
}

#define XB_TMO      128
#define XB_XCNT(j)  (256  + 64 * (j))
#define XB_XSUB(j)  (1280 + 64 * (j))
#define XB_XGEN(j)  (2304 + 64 * (j))
#define XB_TOP      3328
#define XB_TOPGEN   3392
#define XCD_BAR_WORDS 3456
#define XB_SPIN_CAP (1u << 18)

__device__ __forceinline__ unsigned xb_ld(unsigned* p)              { return __hip_atomic_load(p, __ATOMIC_RELAXED, __HIP_MEMORY_SCOPE_AGENT); }
__device__ __forceinline__ unsigned xb_add(unsigned* p, unsigned v) { return __hip_atomic_fetch_add(p, v, __ATOMIC_RELAXED, __HIP_MEMORY_SCOPE_AGENT); }
__device__ __forceinline__ unsigned xb_xcc_id() { return (unsigned)__builtin_amdgcn_s_getreg((3 << 11) | 20) & 0xFu; }
#define XB_SPIN(cond, bar) do { unsigned _sp = 0; while (cond) { __builtin_amdgcn_s_sleep(1); \
    if ((++_sp & 255u) == 0u) { if (xb_ld(&(bar)[XB_TMO])) break; if (_sp > XB_SPIN_CAP) { atomicAdd(&(bar)[XB_TMO], 1u); break; } } } } while (0)

struct XcdBarrier {
    unsigned* bar; unsigned x;
    volatile LAS unsigned* st;
};

__device__ __forceinline__ XcdBarrier xcd_barrier_post(unsigned* bar, volatile LAS unsigned* st, int tid) {
    XcdBarrier b; b.bar = bar; b.x = xb_xcc_id(); b.st = st;
    if (tid == 0) (void)xb_add(&bar[XB_XCNT(b.x)], 1u);
    return b;
}
__device__ __forceinline__ void xcd_barrier_complete(unsigned* bar, unsigned x, unsigned& nloc, unsigned& nx) {
    const unsigned G = gridDim.x * gridDim.y * gridDim.z;
    unsigned sum, cnt, mine, sp = 0u;
    for (;;) {
        sum = 0u; cnt = 0u; mine = 0u;
#pragma unroll 1
        for (unsigned j = 0; j < 16; ++j) { const unsigned c = xb_ld(&bar[XB_XCNT(j)]); sum += c; cnt += (c > 0u) ? 1u : 0u; mine = (j == x) ? c : mine; }
        if (sum == G) break;
        __builtin_amdgcn_s_sleep(1);
        if ((++sp & 255u) == 0u) { if (xb_ld(&bar[XB_TMO])) break; if (sp > XB_SPIN_CAP) { atomicAdd(&bar[XB_TMO], 1u); break; } }
    }
    nloc = mine > 0u ? mine : 1u; nx = cnt > 0u ? cnt : 1u;
}

__device__ __forceinline__ void xcd_barrier(const XcdBarrier& b, int tid) {
    asm volatile("s_waitcnt vmcnt(0)" ::: "memory");
    __syncthreads();
    if (tid == 0) {
        unsigned* bar = b.bar;
        __builtin_amdgcn_s_waitcnt(0);
        unsigned nloc = b.st[0], nx = b.st[1];
        if (nloc == 0u) { xcd_barrier_complete(bar, b.x, nloc, nx); b.st[0] = nloc; b.st[1] = nx; }
        const unsigned old = xb_add(&bar[XB_XSUB(b.x)], 1u);
        const unsigned gen = old / nloc;
        if (old + 1u == (gen + 1u) * nloc) {
            __builtin_amdgcn_fence(__ATOMIC_RELEASE, "agent");
            asm volatile("s_waitcnt vmcnt(0)" ::: "memory");
            const unsigned og = xb_add(&bar[XB_TOP], 1u);
            const unsigned tg = og / nx;
            if (og + 1u == (tg + 1u) * nx) xb_add(&bar[XB_TOPGEN], 1u);
            else XB_SPIN(xb_ld(&bar[XB_TOPGEN]) == tg, bar);
            __builtin_amdgcn_fence(__ATOMIC_ACQUIRE, "agent");
            xb_add(&bar[XB_XGEN(b.x)], 1u);
            asm volatile("s_waitcnt vmcnt(0)" ::: "memory");
        } else {
            XB_SPIN(xb_ld(&bar[XB_XGEN(b.x)]) == gen, bar);
            __builtin_amdgcn_fence(__ATOMIC_ACQUIRE, "agent");
            asm volatile("s_waitcnt vmcnt(0)" ::: "memory");
        }
    }
    __syncthreads();
}

struct Frame {
    LAS unsigned char* lds;
    int tid, lane, wave;
    int vcu, G;
    int gw, NGW;
    float* out; unsigned char* ws;
};
constexpr int PTR_OFF = LDSCTL_OFF + 512;
__device__ __forceinline__ const float* inp_(LAS unsigned char* lds, int i) {
    const unsigned long long v = *(const LAS unsigned long long*)(lds + PTR_OFF + 8 * i);
    const unsigned lo = __builtin_amdgcn_readfirstlane((unsigned)v), hi = __builtin_amdgcn_readfirstlane((unsigned)(v >> 32));
    return (const float*)(((unsigned long long)hi << 32) | lo);
}
#define INP(i) inp_(F.lds, (i))
#define WSP(T, off) ((T*)(F.ws + (off)))

__device__ __forceinline__ void gemv17_item(Frame& F, const LAS float* tab, LAS float* red, const float* W, int ldw, int n0, const float* bias, float* outp, int ldo, int n0out) {
    float acc[17];
#pragma unroll
    for (int r = 0; r < 17; ++r) acc[r] = 0.f;
    const int k0 = F.wave * 128;
    const float* wp = W + (size_t)k0 * ldw + n0 + F.lane;
#pragma unroll 1
    for (int kk = 0; kk < 128; kk += 32) {
        float wv[32];
#pragma unroll
        for (int k = 0; k < 32; ++k) wv[k] = wp[(size_t)(kk + k) * ldw];
#pragma unroll
        for (int k = 0; k < 32; ++k) {
#pragma unroll
            for (int r = 0; r < 17; ++r) acc[r] += tab[r * 1024 + k0 + kk + k] * wv[k];
        }
    }
#pragma unroll
    for (int r = 0; r < 17; ++r) red[(F.wave * 17 + r) * 64 + F.lane] = acc[r];
    __syncthreads();
    for (int i = F.tid; i < 17 * 64; i += NWAVES * 64) {
        const int r = i >> 6, n = i & 63; float s = bias ? bias[n0 + n] : 0.f;
#pragma unroll
        for (int w = 0; w < 8; ++w) s += red[(w * 17 + r) * 64 + n];
        outp[(size_t)r * ldo + n0out + n] = s;
    }
    __syncthreads();
}

__host__ __device__ __forceinline__ int glu_col(int o) { return o >= 512 ? o : ((o >> 7) & 1) * 256 + (o >> 8) * 128 + (o & 127); }
__device__ __forceinline__ void p0_transpose_item(const float* W, int K, int N, bf16* WT, LAS float* scr, int item, int lane, bool glu) {
    const int nblk = N / 32, kb = item / nblk, nb = item % nblk, k0 = 64 * kb, n0 = 32 * nb;
    const int n0o = glu ? glu_col(n0) : n0;
    float tv[32];
#pragma unroll
    for (int i = 0; i < 32; ++i) { const int kk = 2 * i + (lane >> 5); tv[i] = W[(size_t)(k0 + kk) * N + n0 + (lane & 31)]; }
#pragma unroll
    for (int i = 0; i < 32; ++i) { const int kk = 2 * i + (lane >> 5); scr[kk * 33 + (lane & 31)] = tv[i]; }
    LDS_WAIT(); asm volatile("" ::: "memory");
    const int c = lane & 7;
#pragma unroll
    for (int j = 0; j < 4; ++j) { const int n = (lane >> 3) + 8 * j; const LAS float* s = scr + (8 * c) * 33 + n;
        v4u o; o.x = pk2(s[0 * 33], s[1 * 33]); o.y = pk2(s[2 * 33], s[3 * 33]); o.z = pk2(s[4 * 33], s[5 * 33]); o.w = pk2(s[6 * 33], s[7 * 33]);
        *(GAS v4u*)(WT + (size_t)(n0o + n) * K + k0 + 8 * c) = o; }
    LDS_WAIT(); asm volatile("" ::: "memory");
}

__device__ __forceinline__ void weight_items(Frame& F, int first, int last, int widx, int nw) {
    LAS float* scr = (LAS float*)(F.lds + F.wave * 16384);
    constexpr int I_IN = (D / 64) * (IND / 32), I_OUT = (D / 64) * (D / 32), I_1 = (D / 64) * (FF / 32), I_2 = (FF / 64) * (D / 32), I_L = I_IN + I_OUT + I_1 + I_2;
    for (int it = first + widx; it < last; it += nw) {
        const int l = it / I_L; int r = it % I_L;
        const float* W; bf16* WT; int K = D, N; const bool glu = r < I_IN;
        if (r < I_IN) { W = INP(8) + (size_t)l * D * IND; WT = WSP(bf16, WS_WIN) + (size_t)l * IND * D; N = IND; }
        else if (r < I_IN + I_OUT) { r -= I_IN; W = INP(9) + (size_t)l * D * D; WT = WSP(bf16, WS_WOUT) + (size_t)l * D * D; N = D; }
        else if (r < I_IN + I_OUT + I_1) { r -= I_IN + I_OUT; W = INP(22) + (size_t)l * D * FF; WT = WSP(bf16, WS_W1) + (size_t)l * FF * D; N = FF; }
        else { r -= I_IN + I_OUT + I_1; W = INP(23) + (size_t)l * FF * D; WT = WSP(bf16, WS_W2) + (size_t)l * D * FF; K = FF; N = D; }
        p0_transpose_item(W, K, N, WT, scr, r, F.lane, glu);
    }
}
constexpr int W_ITEMS = 2 * ((D / 64) * (IND / 32) + (D / 64) * (D / 32) + (D / 64) * (FF / 32) + (FF / 64) * (D / 32));
constexpr int W_EARLY = 64 * NWAVES * 3;

__device__ __forceinline__ void phase_p0a(Frame& F) {
    LAS float* tab = (LAS float*)(F.lds);
    LAS float* red = (LAS float*)(F.lds + 17 * 1024 * 4);
    float* MOD = WSP(float, WS_MOD);
    bool filled = false;
    for (int it = F.vcu; it < 2 * 96; it += F.G) {
        if (!filled) {
            for (int i = F.tid; i < 17 * 1024; i += NWAVES * 64) { const int r = i >> 10, k = i & 1023; const float v = (r < 16) ? INP(1)[r * D + k] : INP(3)[k]; tab[i] = siluf_(v); }
            __syncthreads(); filled = true;
        }
        const int l = it / 96, n0 = (it % 96) * 64;
        gemv17_item(F, tab, red, INP(6) + (size_t)l * D * MODW, MODW, n0, INP(7) + (size_t)l * MODW, MOD + (size_t)l * 17 * MODW, MODW, n0);
    }
    if (F.G == 256 && F.vcu >= 192) weight_items(F, 0, W_EARLY, (F.vcu - 192) * NWAVES + F.wave, 64 * NWAVES);
}

__device__ __forceinline__ void phase_p0b(Frame& F) {
    LAS float* tab = (LAS float*)(F.lds);
    LAS float* red = (LAS float*)(F.lds + 17 * 1024 * 4);
    const float* MOD = WSP(const float, WS_MOD);
    for (int it = F.vcu; it < 2 * 104; it += F.G) {
        const int l = it / 104, j = it % 104; const bool first = j < 40;
        const int shoff = first ? 0 : 3 * D;
        __syncthreads();
        for (int i = F.tid; i < 17 * 1024; i += NWAVES * 64) { const int r = i >> 10, k = i & 1023; tab[i] = MOD[((size_t)l * 17 + r) * MODW + shoff + k]; }
        __syncthreads();
        const int ldw = first ? IND : FF;
        gemv17_item(F, tab, red, first ? INP(8) + (size_t)l * D * IND : INP(22) + (size_t)l * D * FF, ldw, (first ? j : j - 40) * 64, nullptr,
                    first ? WSP(float, WS_SHW1) + (size_t)l * 17 * IND : WSP(float, WS_SHW2) + (size_t)l * 17 * FF, ldw, first ? glu_col(j * 64) : (j - 40) * 64);
    }
    bf16* XA = WSP(bf16, WS_XA); float* RSSA = WSP(float, WS_RSSA);
    const float* g1 = INP(4);
    for (int row = F.gw; row < MT; row += 2 * F.NGW) {
        f32x4 v[2][4]; float ss[2]; int rw[2]; const float* scp[2];
#pragma unroll
        for (int q = 0; q < 2; ++q) { int r_ = row + q * F.NGW; if (r_ >= MT) r_ = row; rw[q] = r_;
            const bool lat = r_ < ML;
            const float* xr = lat ? INP(0) + (size_t)r_ * D : INP(2) + (size_t)(r_ - ML) * D;
            scp[q] = MOD + (size_t)(lat ? (r_ >> 11) : NB) * MODW + D;
#pragma unroll
            for (int j = 0; j < 4; ++j) v[q][j] = *(const f32x4*)(xr + 4 * F.lane + 256 * j); }
#pragma unroll
        for (int q = 0; q < 2; ++q) { float s_ = 0.f;
#pragma unroll
            for (int j = 0; j < 4; ++j) s_ += (v[q][j][0] * v[q][j][0] + v[q][j][1] * v[q][j][1]) + (v[q][j][2] * v[q][j][2] + v[q][j][3] * v[q][j][3]);
            ss[q] = wave_sum(s_); }
#pragma unroll
        for (int q = 0; q < 2; ++q) { if (q == 1 && rw[1] == row) break;
            if (F.lane < 32) RSSA[(size_t)rw[q] * 32 + F.lane] = (F.lane == 0) ? ss[q] : 0.f;
#pragma unroll
            for (int j = 0; j < 4; ++j) { const int k = 4 * F.lane + 256 * j;
                const f32x4 gm = *(const f32x4*)(g1 + k) * (*(const f32x4*)(scp[q] + k) + 1.0f), a = v[q][j] * gm;
                v2u o; o.x = pk2(a[0], a[1]); o.y = pk2(a[2], a[3]); *(v2u*)(XA + (size_t)rw[q] * D + k) = o; } }
    }
    __syncthreads();
    {
        bf16* WLR = WSP(bf16, WS_WLR);
        for (int i = F.gw * 64 + F.lane; i < 2 * 2 * 4 * 2 * 4096; i += F.NGW * 64) { const int d = i & 63, e = (i >> 6) & 63, gt = (i >> 12) & 1, blk = i >> 13;
            const float* src = gt == 0 ? INP(17) : INP(19); WLR[i] = (bf16)f2bf(src[((size_t)blk * 64 + d) * 64 + e]); }
    }
    weight_items(F, (F.G == 256) ? W_EARLY : 0, W_ITEMS, F.gw, F.NGW);
}

constexpr int CV_OSROW = 260;
__device__ __forceinline__ void conv_phase(Frame& F, int l, int ntiles) {
    const bf16* PROJ = WSP(const bf16, WS_PROJ); bf16* MIX = WSP(bf16, WS_MIX);
    LAS float* us = (LAS float*)(F.lds);
    LAS float* os = (LAS float*)(F.lds + 62 * 256 * 4);
    const int c = F.tid & 255, half = F.tid >> 8;
    float w[31];
#pragma unroll
    for (int k = 0; k < 31; ++k) w[k] = INP(10)[((size_t)l * 31 + k) * 256 + c];
    const float cbias = INP(11)[l * 256 + c];
    const int lt = F.tid >> 4, lseg = F.tid & 15;
    f32x4 lg[4], lb[4];
#pragma unroll
    for (int q = 0; q < 4; ++q) { lg[q] = *(const f32x4*)(INP(12) + l * 256 + 16 * lseg + 4 * q); lb[q] = *(const f32x4*)(INP(13) + l * 256 + 16 * lseg + 4 * q); }
    auto row16_sum = [](float v) -> float {
        v += __builtin_bit_cast(float, __builtin_amdgcn_update_dpp(0, __builtin_bit_cast(int, v), 0xB1, 0xf, 0xf, true));
        v += __builtin_bit_cast(float, __builtin_amdgcn_update_dpp(0, __builtin_bit_cast(int, v), 0x4E, 0xf, 0xf, true));
        v += __builtin_bit_cast(float, __builtin_amdgcn_update_dpp(0, __builtin_bit_cast(int, v), 0x141, 0xf, 0xf, true));
        v += __builtin_bit_cast(float, __builtin_amdgcn_update_dpp(0, __builtin_bit_cast(int, v), 0x140, 0xf, 0xf, true));
        return v; };
    unsigned pv[16];
    auto load_tile = [&](int T) {
        const int row0 = T * 32;
        int lo, hi; if (row0 < ML) { lo = row0 & ~(SEQ - 1); hi = lo + SEQ; } else { lo = row0 & ~(CTXL - 1); hi = lo + CTXL; }
#pragma unroll
        for (int j = 0; j < 16; ++j) { const int i = F.tid + 512 * j, rr = i >> 7, cp = i & 127, row = row0 - 15 + rr;
            const bool ok = (j < 15 || F.tid < 256) && row >= lo && row < hi;
            pv[j] = ok ? *(const unsigned*)(PROJ + (size_t)row * IND + 2 * cp) : 0u; }
    };
    const int T0 = F.G - 1 - F.vcu;
    if (T0 < ntiles) load_tile(T0);
    for (int T = T0; T < ntiles; T += F.G) {
        const int row0 = T * 32;
        __syncthreads();
#pragma unroll
        for (int j = 0; j < 16; ++j) { const int i = F.tid + 512 * j;
            if (j < 15 || F.tid < 256) { f32x2 u; u[0] = bflo(pv[j]); u[1] = bfhi(pv[j]); *(LAS f32x2*)(us + 2 * i) = u; } }
        if (T + F.G < ntiles) load_tile(T + F.G);
        __syncthreads();
        {
            float acc[16];
#pragma unroll
            for (int j = 0; j < 16; ++j) acc[j] = cbias;
            const LAS float* up = us + (16 * half) * 256 + c;
#pragma unroll
            for (int i = 0; i < 46; ++i) { const float x = up[i * 256];
#pragma unroll
                for (int j = 0; j < 16; ++j) if (i - j >= 0 && i - j <= 30) acc[j] += w[i - j] * x; }
#pragma unroll
            for (int j = 0; j < 16; ++j) os[(16 * half + j) * CV_OSROW + c] = acc[j];
        }
        __syncthreads();
        {
            f32x4 v[4];
#pragma unroll
            for (int q = 0; q < 4; ++q) v[q] = *(const LAS f32x4*)(os + lt * CV_OSROW + 16 * lseg + 4 * q);
            float s1 = 0.f;
#pragma unroll
            for (int q = 0; q < 4; ++q) s1 += (v[q][0] + v[q][1]) + (v[q][2] + v[q][3]);
            const float mu = row16_sum(s1) * (1.f / 256.f);
            float s2 = 0.f;
#pragma unroll
            for (int q = 0; q < 4; ++q) { v[q] = v[q] - mu; s2 += (v[q][0] * v[q][0] + v[q][1] * v[q][1]) + (v[q][2] * v[q][2] + v[q][3] * v[q][3]); }
            const float rstd = rsqrtf(row16_sum(s2) * (1.f / 256.f) + EPS);
            unsigned ow[8];
#pragma unroll
            for (int q = 0; q < 4; ++q) { const f32x4 y = v[q] * rstd * lg[q] + lb[q];
                ow[2 * q] = pg8::cvt_pk_bf16(siluf_(y[0]), siluf_(y[1])); ow[2 * q + 1] = pg8::cvt_pk_bf16(siluf_(y[2]), siluf_(y[3])); }
            bf16* op = MIX + (size_t)(row0 + lt) * D + 16 * lseg;
            *(v4u*)op = (v4u){ow[0], ow[1], ow[2], ow[3]}; *(v4u*)(op + 8) = (v4u){ow[4], ow[5], ow[6], ow[7]};
        }
    }
}

typedef short s16x8 __attribute__((ext_vector_type(8)));
typedef short s16x4 __attribute__((ext_vector_type(4)));
constexpr int NA_KROW = 144, NA_VROW = 160;
constexpr int NA_STAGE = 64 * NA_KROW + 64 * NA_VROW, NA_SLOT = 2 * NA_STAGE, NA_OFF_TB = 2 * NA_SLOT;
static_assert(NA_OFF_TB + 2560 <= RING_BYTES, "NA LDS map");
constexpr int NA_ITEMS_LAT = NB * NH * 8, NA_ITEMS_CTX = NB * NH * 2;
struct NaBlk { f32x4 O[4]; float m, lsum; int first; };
__device__ __forceinline__ int na_rs(int r) { int v = r - 4; return v < 0 ? 0 : (v > 24 ? 24 : v); }
__device__ __forceinline__ s16x8 na_scale_q(v4u w, float c) {
    v4u o; o.x = pg8::cvt_pk_bf16(bflo(w.x) * c, bfhi(w.x) * c); o.y = pg8::cvt_pk_bf16(bflo(w.y) * c, bfhi(w.y) * c); o.z = pg8::cvt_pk_bf16(bflo(w.z) * c, bfhi(w.z) * c); o.w = pg8::cvt_pk_bf16(bflo(w.w) * c, bfhi(w.w) * c);
    return __builtin_bit_cast(s16x8, o);
}
__device__ __forceinline__ void na_phase(Frame& F, int l, int nitems, int nav = 0) {
    const bf16* PROJ = WSP(const bf16, WS_PROJ); bf16* MIX = WSP(bf16, WS_MIX);
    LAS float* tb = (LAS float*)(F.lds + NA_OFF_TB);
    const int lane = F.lane, q16 = lane & 15, g = lane >> 4;
    const unsigned skey = (unsigned)(F.tid >> 3), spart = (unsigned)(F.tid & 7);
    const float c1 = 0.125f * 1.4426950408889634f;
    struct NaItem { int b, h, ra, qrow0, rsI, nloc, nch, npair, isctx; };
    auto decode = [&](int it, NaItem& I) {
        I.isctx = it >= NA_ITEMS_LAT ? 1 : 0; I.ra = 0; I.rsI = 0; I.nloc = 0;
        if (!I.isctx) { const int r4 = it & 7; I.h = (it >> 3) & 7; I.b = it >> 6; const int r0 = 4 * r4; I.ra = r0 + 2 * (F.wave >> 2); I.qrow0 = I.b * SEQ + I.ra * 64 + (F.wave & 3) * 16;
            I.rsI = na_rs(r0); I.nloc = na_rs(r0 + 3) + 8 - I.rsI; }
        else { const int j = it - NA_ITEMS_LAT; const int hf = j & 1; I.h = (j >> 1) & 7; I.b = j >> 4; I.qrow0 = ML + I.b * CTXL + hf * 128 + F.wave * 16; }
        I.nch = I.nloc + 4; I.npair = (I.nch + 1) >> 1;
    };
    auto krow_of = [&](const NaItem& I, int ch) -> int { if (ch > I.nch - 1) ch = I.nch - 1; return ch < I.nloc ? I.b * SEQ + (I.rsI + ch) * 64 : ML + I.b * CTXL + (ch - I.nloc) * 64; };
    const int jq = F.wave & 3;
    const int o0 = jq == 0 ? 0 : 16 * jq - 8, o1 = jq == 0 ? 16 : (jq == 3 ? 48 : 16 * jq + 8);
    float madd[2][4]; int lb[2];
    {
        const int qc = jq * 16 + q16; int cs = qc - 8; cs = cs < 0 ? 0 : (cs > 48 ? 48 : cs);
#pragma unroll
        for (int e = 0; e < 4; ++e) { const int k0 = o0 + 4 * g + e, k1 = o1 + 4 * g + e;
            madd[0][e] = ((unsigned)(k0 - cs) < 16u) ? 0.f : -1.0e30f;
            madd[1][e] = (((unsigned)(k1 - cs) < 16u) && !(jq == 3 && k1 < 56)) ? 0.f : -1.0e30f; }
        lb[0] = 64 + o0 + 4 * g - qc + 15; lb[1] = 64 + o1 + 4 * g - qc + 15;
    }
    v4u kr0, vr0, kr1, vr1, qrA[2], qrB[2];
    auto issue_first = [&](const NaItem& I) {
        const bf16* Pk = PROJ + 1024 + I.h * HD + 8 * spart, * Pv = PROJ + 1536 + I.h * HD + 8 * spart, * Pq = PROJ + 512 + I.h * HD;
        kr0 = *(const v4u*)(Pk + (size_t)(krow_of(I, 0) + (int)skey) * IND); vr0 = *(const v4u*)(Pv + (size_t)(krow_of(I, 0) + (int)skey) * IND);
        kr1 = *(const v4u*)(Pk + (size_t)(krow_of(I, 1) + (int)skey) * IND); vr1 = *(const v4u*)(Pv + (size_t)(krow_of(I, 1) + (int)skey) * IND);
#pragma unroll
        for (int s_ = 0; s_ < 2; ++s_) { qrA[s_] = *(const v4u*)(Pq + (size_t)(I.qrow0 + q16) * IND + 32 * s_ + 8 * g);
            qrB[s_] = I.isctx ? qrA[s_] : *(const v4u*)(Pq + (size_t)(I.qrow0 + 64 + q16) * IND + 32 * s_ + 8 * g); }
    };
    NaItem I; int it = F.vcu; bool have = it < nitems; int tb_h = -1;
    if (have) { decode(it, I); issue_first(I); }
    while (have) {
        const bool isctx = I.isctx != 0;
        const int ra = I.ra, rsI = I.rsI, nloc = I.nloc, nch = I.nch, npair = I.npair, qrow0 = I.qrow0, h = I.h;
        const bf16* Pk = PROJ + 1024 + h * HD + 8 * spart, * Pv = PROJ + 1536 + h * HD + 8 * spart;
        s16x8 qfA[2], qfB[2];
#pragma unroll
        for (int s_ = 0; s_ < 2; ++s_) { qfA[s_] = na_scale_q(qrA[s_], c1); qfB[s_] = na_scale_q(qrB[s_], c1); }
        const int rsA = na_rs(ra), rsB = na_rs(ra + 1);
        NaItem N; const int itn = it + F.G; const bool haven = itn < nitems; if (haven) decode(itn, N); else N = I;
        __syncthreads();
        if (!isctx && h != tb_h) { const float* rpb = INP(14) + ((size_t)l * NH + h) * 15 * 31; tb_h = h;
            for (int i = F.tid; i < 640; i += NWAVES * 64) tb[i] = (i >= 64 && i < 64 + 465) ? rpb[i - 64] * 1.4426950408889634f : 0.f; }
        {
            LAS unsigned char* s0 = F.lds;
            *(LAS v4u*)(s0 + skey * NA_KROW + spart * 16) = kr0; *(LAS v4u*)(s0 + 64 * NA_KROW + skey * NA_VROW + spart * 16) = vr0;
            *(LAS v4u*)(s0 + NA_STAGE + skey * NA_KROW + spart * 16) = kr1; *(LAS v4u*)(s0 + NA_STAGE + 64 * NA_KROW + skey * NA_VROW + spart * 16) = vr1;
        }
        if (npair > 2) {
            kr0 = *(const v4u*)(Pk + (size_t)(krow_of(I, 2) + (int)skey) * IND); vr0 = *(const v4u*)(Pv + (size_t)(krow_of(I, 2) + (int)skey) * IND);
            kr1 = *(const v4u*)(Pk + (size_t)(krow_of(I, 3) + (int)skey) * IND); vr1 = *(const v4u*)(Pv + (size_t)(krow_of(I, 3) + (int)skey) * IND);
        } else {
            kr0 = *(const v4u*)(Pk + (size_t)(krow_of(I, 2) + (int)skey) * IND); vr0 = *(const v4u*)(Pv + (size_t)(krow_of(I, 2) + (int)skey) * IND);
            kr1 = *(const v4u*)(Pk + (size_t)(krow_of(I, 3) + (int)skey) * IND); vr1 = *(const v4u*)(Pv + (size_t)(krow_of(I, 3) + (int)skey) * IND);
        }
        NaBlk A, B;
#pragma unroll
        for (int dt = 0; dt < 4; ++dt) { A.O[dt] = (f32x4){0.f, 0.f, 0.f, 0.f}; B.O[dt] = (f32x4){0.f, 0.f, 0.f, 0.f}; }
        A.m = 0.f; A.lsum = 0.f; A.first = 1; B.m = 0.f; B.lsum = 0.f; B.first = 1;
        for (int cp = 0; cp < npair; ++cp) {
            __syncthreads();
            if (cp + 1 < npair) { LAS unsigned char* nx = F.lds + ((cp + 1) & 1) * NA_SLOT;
                *(LAS v4u*)(nx + skey * NA_KROW + spart * 16) = kr0; *(LAS v4u*)(nx + 64 * NA_KROW + skey * NA_VROW + spart * 16) = vr0;
                *(LAS v4u*)(nx + NA_STAGE + skey * NA_KROW + spart * 16) = kr1; *(LAS v4u*)(nx + NA_STAGE + 64 * NA_KROW + skey * NA_VROW + spart * 16) = vr1; }
            if (cp + 2 < npair) { const int k2 = krow_of(I, 2 * cp + 4) + (int)skey, k3 = krow_of(I, 2 * cp + 5) + (int)skey;
                kr0 = *(const v4u*)(Pk + (size_t)k2 * IND); vr0 = *(const v4u*)(Pv + (size_t)k2 * IND); kr1 = *(const v4u*)(Pk + (size_t)k3 * IND); vr1 = *(const v4u*)(Pv + (size_t)k3 * IND); }
            else if (cp + 2 == npair && haven) issue_first(N);
          for (int sub = 0; sub < 2; ++sub) {
            const int ch = 2 * cp + sub;
            if (ch >= nch) break;
            LAS unsigned char* cur = F.lds + (cp & 1) * NA_SLOT + sub * NA_STAGE;
            const bool local = ch < nloc;
            const int kr = rsI + ch;
            const bool actA = !local || (kr >= rsA && kr <= rsA + 7), actB = !isctx && (!local || (kr >= rsB && kr <= rsB + 7));
            if ((!actA && !actB) || nav == 1) continue;
            auto fix = [&](f32x4* S, int nt_, NaBlk& X, float cm) __attribute__((always_inline)) {
                cm = fmaxf(cm, __shfl_xor(cm, 16)); cm = fmaxf(cm, __shfl_xor(cm, 32));
                const float d = X.first ? cm : fmaxf(cm, 0.f);
                if (!X.first) { const float alpha = __builtin_amdgcn_exp2f(-d); X.lsum *= alpha;
#pragma unroll
                    for (int dt = 0; dt < 4; ++dt) X.O[dt] = X.O[dt] * alpha; }
                X.m += d; X.first = 0;
#pragma unroll
                for (int t = 0; t < 4; ++t) if (t < nt_) S[t] = S[t] - d;
            };
            auto probs = [&](f32x4* S, int nt_, NaBlk& X, unsigned (*pk)[2]) __attribute__((always_inline)) {
                float ps = 0.f;
#pragma unroll
                for (int t = 0; t < 4; ++t) if (t < nt_) {
                    const float p0 = __builtin_amdgcn_exp2f(S[t][0]), p1 = __builtin_amdgcn_exp2f(S[t][1]), p2 = __builtin_amdgcn_exp2f(S[t][2]), p3 = __builtin_amdgcn_exp2f(S[t][3]);
                    ps += (p0 + p1) + (p2 + p3);
                    pk[t][0] = pg8::cvt_pk_bf16(p0, p1); pk[t][1] = pg8::cvt_pk_bf16(p2, p3); }
                X.lsum += ps;
            };
            auto finish = [&](f32x4* S, int nt_, NaBlk& X, unsigned (*pk)[2], float cm) __attribute__((always_inline)) {
                if (X.first || !__all(cm <= 8.f)) fix(S, nt_, X, cm);
                probs(S, nt_, X, pk);
            };
            auto finish2 = [&](f32x4* SA, f32x4* SB, int nt_, unsigned (*pa)[2], unsigned (*pb)[2], float cmA, float cmB) __attribute__((always_inline)) {
                if (A.first || B.first || !__all(fmaxf(cmA, cmB) <= 8.f)) {
                    if (A.first || !__all(cmA <= 8.f)) fix(SA, nt_, A, cmA);
                    if (B.first || !__all(cmB <= 8.f)) fix(SB, nt_, B, cmB);
                }
                probs(SA, nt_, A, pa); probs(SB, nt_, B, pb);
            };
            auto bias_local = [&](f32x4 (&S)[2], int rq) __attribute__((always_inline)) -> float {
                float cm = -1.0e30f;
#pragma unroll
                for (int t = 0; t < 2; ++t) { const LAS float* tr_ = tb + (kr - rq + 7) * 31 + lb[t];
#pragma unroll
                    for (int e = 0; e < 4; ++e) { const float v = (S[t][e] + tr_[e]) + madd[t][e]; S[t][e] = v; cm = fmaxf(cm, v); } }
                return cm;
            };
            auto max_ctx = [&](f32x4 (&S)[4]) __attribute__((always_inline)) -> float {
                float cm = -1.0e30f;
#pragma unroll
                for (int t = 0; t < 4; ++t)
#pragma unroll
                    for (int e = 0; e < 4; ++e) cm = fmaxf(cm, S[t][e]);
                return cm;
            };
            const LAS unsigned char* kb_ = cur + q16 * NA_KROW + 16 * g;
            const LAS unsigned char* vtr = cur + 64 * NA_KROW + (4 * g + (q16 >> 2)) * NA_VROW + (q16 & 3) * 8;
            auto local_both = [&]() __attribute__((always_inline)) {
                unsigned pkA[4][2], pkB[4][2];
                f32x4 SA[2], SB[2];
#pragma unroll
                for (int t = 0; t < 2; ++t) { const float ma = -A.m, mb = -B.m; SA[t] = (f32x4){ma, ma, ma, ma}; SB[t] = (f32x4){mb, mb, mb, mb};
                    const int o = t == 0 ? o0 : o1;
#pragma unroll
                    for (int s_ = 0; s_ < 2; ++s_) { const s16x8 kf = *(const LAS s16x8*)(kb_ + o * NA_KROW + 64 * s_);
                        SA[t] = __builtin_amdgcn_mfma_f32_16x16x32_bf16(kf, qfA[s_], SA[t], 0, 0, 0);
                        SB[t] = __builtin_amdgcn_mfma_f32_16x16x32_bf16(kf, qfB[s_], SB[t], 0, 0, 0); } }
                if (nav == 2) { asm volatile("" :: "v"(SA[0]), "v"(SA[1]), "v"(SB[0]), "v"(SB[1])); return; }
                const float cmA = bias_local(SA, ra), cmB = bias_local(SB, ra + 1);
                finish2(SA, SB, 2, pkA, pkB, cmA, cmB);
                if (nav == 3) { asm volatile("" :: "v"(pkA[0][0]), "v"(pkA[1][1]), "v"(pkB[0][0]), "v"(pkB[1][1])); return; }
                const v4u bwA = {pkA[0][0], pkA[0][1], pkA[1][0], pkA[1][1]}, bwB = {pkB[0][0], pkB[0][1], pkB[1][0], pkB[1][1]};
                const s16x8 bfA = __builtin_bit_cast(s16x8, bwA), bfB = __builtin_bit_cast(s16x8, bwB);
#pragma unroll
                for (int dt = 0; dt < 4; ++dt) {
                    const s16x4 a0 = __builtin_amdgcn_ds_read_tr16_b64_v4i16((LAS s16x4*)(vtr + o0 * NA_VROW + dt * 32));
                    const s16x4 a1 = __builtin_amdgcn_ds_read_tr16_b64_v4i16((LAS s16x4*)(vtr + o1 * NA_VROW + dt * 32));
                    const s16x8 afrag = __builtin_shufflevector(a0, a1, 0, 1, 2, 3, 4, 5, 6, 7);
                    A.O[dt] = __builtin_amdgcn_mfma_f32_16x16x32_bf16(afrag, bfA, A.O[dt], 0, 0, 0);
                    B.O[dt] = __builtin_amdgcn_mfma_f32_16x16x32_bf16(afrag, bfB, B.O[dt], 0, 0, 0);
                }
            };
            auto local_one = [&](NaBlk& X, const s16x8 (&qf)[2], int rq) __attribute__((always_inline)) {
                unsigned pk[4][2];
                f32x4 S[2];
#pragma unroll
                for (int t = 0; t < 2; ++t) { const float mx = -X.m; S[t] = (f32x4){mx, mx, mx, mx};
                    const int o = t == 0 ? o0 : o1;
#pragma unroll
                    for (int s_ = 0; s_ < 2; ++s_) { const s16x8 kf = *(const LAS s16x8*)(kb_ + o * NA_KROW + 64 * s_);
                        S[t] = __builtin_amdgcn_mfma_f32_16x16x32_bf16(kf, qf[s_], S[t], 0, 0, 0); } }
                if (nav == 2) { asm volatile("" :: "v"(S[0]), "v"(S[1])); return; }
                const float cm = bias_local(S, rq);
                finish(S, 2, X, pk, cm);
                if (nav == 3) { asm volatile("" :: "v"(pk[0][0]), "v"(pk[1][1])); return; }
                const v4u bw = {pk[0][0], pk[0][1], pk[1][0], pk[1][1]};
                const s16x8 bf = __builtin_bit_cast(s16x8, bw);
#pragma unroll
                for (int dt = 0; dt < 4; ++dt) {
                    const s16x4 a0 = __builtin_amdgcn_ds_read_tr16_b64_v4i16((LAS s16x4*)(vtr + o0 * NA_VROW + dt * 32));
                    const s16x4 a1 = __builtin_amdgcn_ds_read_tr16_b64_v4i16((LAS s16x4*)(vtr + o1 * NA_VROW + dt * 32));
                    const s16x8 afrag = __builtin_shufflevector(a0, a1, 0, 1, 2, 3, 4, 5, 6, 7);
                    X.O[dt] = __builtin_amdgcn_mfma_f32_16x16x32_bf16(afrag, bf, X.O[dt], 0, 0, 0);
                }
            };
            auto ctx_both = [&]() __attribute__((always_inline)) {
                unsigned pkA[4][2], pkB[4][2];
                f32x4 SA[4], SB[4];
#pragma unroll
                for (int t = 0; t < 4; ++t) { const float ma = -A.m, mb = -B.m; SA[t] = (f32x4){ma, ma, ma, ma}; SB[t] = (f32x4){mb, mb, mb, mb};
#pragma unroll
                    for (int s_ = 0; s_ < 2; ++s_) { const s16x8 kf = *(const LAS s16x8*)(kb_ + t * 16 * NA_KROW + 64 * s_);
                        SA[t] = __builtin_amdgcn_mfma_f32_16x16x32_bf16(kf, qfA[s_], SA[t], 0, 0, 0);
                        SB[t] = __builtin_amdgcn_mfma_f32_16x16x32_bf16(kf, qfB[s_], SB[t], 0, 0, 0); } }
                if (nav == 2) { asm volatile("" :: "v"(SA[0]), "v"(SA[1]), "v"(SA[2]), "v"(SA[3]), "v"(SB[0]), "v"(SB[1]), "v"(SB[2]), "v"(SB[3])); return; }
                const float cmA = max_ctx(SA), cmB = max_ctx(SB);
                finish2(SA, SB, 4, pkA, pkB, cmA, cmB);
                if (nav == 3) { asm volatile("" :: "v"(pkA[0][0]), "v"(pkA[1][1]), "v"(pkA[2][0]), "v"(pkA[3][1]), "v"(pkB[0][0]), "v"(pkB[1][1]), "v"(pkB[2][0]), "v"(pkB[3][1])); return; }
#pragma unroll
                for (int p = 0; p < 2; ++p) {
                    const v4u bwA = {pkA[2 * p][0], pkA[2 * p][1], pkA[2 * p + 1][0], pkA[2 * p + 1][1]}, bwB = {pkB[2 * p][0], pkB[2 * p][1], pkB[2 * p + 1][0], pkB[2 * p + 1][1]};
                    const s16x8 bfA = __builtin_bit_cast(s16x8, bwA), bfB = __builtin_bit_cast(s16x8, bwB);
#pragma unroll
                    for (int dt = 0; dt < 4; ++dt) {
                        const s16x4 a0 = __builtin_amdgcn_ds_read_tr16_b64_v4i16((LAS s16x4*)(vtr + (2 * p) * 16 * NA_VROW + dt * 32));
                        const s16x4 a1 = __builtin_amdgcn_ds_read_tr16_b64_v4i16((LAS s16x4*)(vtr + (2 * p + 1) * 16 * NA_VROW + dt * 32));
                        const s16x8 afrag = __builtin_shufflevector(a0, a1, 0, 1, 2, 3, 4, 5, 6, 7);
                        A.O[dt] = __builtin_amdgcn_mfma_f32_16x16x32_bf16(afrag, bfA, A.O[dt], 0, 0, 0);
                        B.O[dt] = __builtin_amdgcn_mfma_f32_16x16x32_bf16(afrag, bfB, B.O[dt], 0, 0, 0);
                    }
                }
            };
            auto ctx_one = [&]() __attribute__((always_inline)) {
                unsigned pk[4][2];
                f32x4 S[4];
#pragma unroll
                for (int t = 0; t < 4; ++t) { const float ma = -A.m; S[t] = (f32x4){ma, ma, ma, ma};
#pragma unroll
                    for (int s_ = 0; s_ < 2; ++s_) { const s16x8 kf = *(const LAS s16x8*)(kb_ + t * 16 * NA_KROW + 64 * s_);
                        S[t] = __builtin_amdgcn_mfma_f32_16x16x32_bf16(kf, qfA[s_], S[t], 0, 0, 0); } }
                if (nav == 2) { asm volatile("" :: "v"(S[0]), "v"(S[1]), "v"(S[2]), "v"(S[3])); return; }
                const float cm = max_ctx(S);
                finish(S, 4, A, pk, cm);
                if (nav == 3) { asm volatile("" :: "v"(pk[0][0]), "v"(pk[1][1]), "v"(pk[2][0]), "v"(pk[3][1])); return; }
#pragma unroll
                for (int p = 0; p < 2; ++p) {
                    const v4u bw = {pk[2 * p][0], pk[2 * p][1], pk[2 * p + 1][0], pk[2 * p + 1][1]};
                    const s16x8 bf = __builtin_bit_cast(s16x8, bw);
#pragma unroll
                    for (int dt = 0; dt < 4; ++dt) {
                        const s16x4 a0 = __builtin_amdgcn_ds_read_tr16_b64_v4i16((LAS s16x4*)(vtr + (2 * p) * 16 * NA_VROW + dt * 32));
                        const s16x4 a1 = __builtin_amdgcn_ds_read_tr16_b64_v4i16((LAS s16x4*)(vtr + (2 * p + 1) * 16 * NA_VROW + dt * 32));
                        const s16x8 afrag = __builtin_shufflevector(a0, a1, 0, 1, 2, 3, 4, 5, 6, 7);
                        A.O[dt] = __builtin_amdgcn_mfma_f32_16x16x32_bf16(afrag, bf, A.O[dt], 0, 0, 0);
                    }
                }
            };
            if (local) { if (actA && actB) local_both(); else if (actA) local_one(A, qfA, ra); else local_one(B, qfB, ra + 1); }
            else { if (actB) ctx_both(); else ctx_one(); }
          }
        }
        {
            float ls = A.lsum; ls += __shfl_xor(ls, 16); ls += __shfl_xor(ls, 32);
            const float inv = __builtin_amdgcn_rcpf(ls);
            bf16* op = MIX + (size_t)(qrow0 + q16) * D + 256 + h * HD + 4 * g;
#pragma unroll
            for (int dt = 0; dt < 4; ++dt) { v2u w; w.x = pg8::cvt_pk_bf16(A.O[dt][0] * inv, A.O[dt][1] * inv); w.y = pg8::cvt_pk_bf16(A.O[dt][2] * inv, A.O[dt][3] * inv); *(v2u*)(op + 16 * dt) = w; }
        }
        if (!isctx) {
            float ls = B.lsum; ls += __shfl_xor(ls, 16); ls += __shfl_xor(ls, 32);
            const float inv = __builtin_amdgcn_rcpf(ls);
            bf16* op = MIX + (size_t)(qrow0 + 64 + q16) * D + 256 + h * HD + 4 * g;
#pragma unroll
            for (int dt = 0; dt < 4; ++dt) { v2u w; w.x = pg8::cvt_pk_bf16(B.O[dt][0] * inv, B.O[dt][1] * inv); w.y = pg8::cvt_pk_bf16(B.O[dt][2] * inv, B.O[dt][3] * inv); *(v2u*)(op + 16 * dt) = w; }
        }
        it = itn; have = haven; I = N;
    }
}

constexpr int LRU_UCROW = 260;
constexpr int LRU_OFF_UC = 38 * 256 * 2, LRU_OFF_GT = LRU_OFF_UC + 2 * 32 * LRU_UCROW * 4;
static_assert(LRU_OFF_GT + 32 * 256 * 2 <= RING_BYTES, "LRU LDS map");
template <int PASS>
__device__ __forceinline__ void lru_phase(Frame& F, int l, int ntiles) {
    const bf16* PROJ = WSP(const bf16, WS_PROJ);
    LAS bf16* rxs = (LAS bf16*)(F.lds);
    LAS float* ucf = (LAS float*)(F.lds + LRU_OFF_UC);
    LAS bf16* gts = (LAS bf16*)(F.lds + LRU_OFF_GT);
    const int lane = F.lane, j16 = lane & 15, g = lane >> 4;
    const int kb = F.wave & 3, nh = F.wave >> 2;
    s16x8 wf[2][2][2][2];
    float cbx[2][2], cba[2][2], csp[2][2];
#pragma unroll
    for (int dir = 0; dir < 2; ++dir) {
        const int ld = l * 2 + dir;
        const bf16* WLR = WSP(const bf16, WS_WLR) + (size_t)((ld * 4 + kb) * 2) * 4096;
#pragma unroll
        for (int gt = 0; gt < 2; ++gt)
#pragma unroll
            for (int n2 = 0; n2 < 2; ++n2)
#pragma unroll
                for (int s_ = 0; s_ < 2; ++s_) wf[dir][gt][n2][s_] = *(const s16x8*)(WLR + gt * 4096 + (16 * (2 * nh + n2) + j16) * 64 + 32 * s_ + 8 * g);
#pragma unroll
        for (int n2 = 0; n2 < 2; ++n2) {
            const int e = kb * 64 + 16 * (2 * nh + n2) + j16, idx = ld * 256 + e;
            cbx[dir][n2] = INP(18)[idx]; cba[dir][n2] = INP(20)[idx];
            const float nl = -INP(21)[idx]; csp[dir][n2] = -8.f * (fmaxf(nl, 0.f) + log1pf(__expf(-fabsf(nl))));
        }
    }
    const int c = F.tid & 255, sdir = F.tid >> 8;
    const int sld = l * 2 + sdir;
    const float s1w0 = INP(15)[(sld * 4 + 0) * 256 + c], s1w1 = INP(15)[(sld * 4 + 1) * 256 + c], s1w2 = INP(15)[(sld * 4 + 2) * 256 + c], s1w3 = INP(15)[(sld * 4 + 3) * 256 + c], s1cb = INP(16)[sld * 256 + c];
    const int base = sdir == 0 ? 0 : 3;
    unsigned pre[10], pgw[8];
    auto load_tile = [&](int T) {
        const int row0 = T * 32;
        int lo, hi; if (row0 < ML) { lo = row0 & ~(SEQ - 1); hi = lo + SEQ; } else { lo = row0 & ~(CTXL - 1); hi = lo + CTXL; }
#pragma unroll
        for (int j = 0; j < 10; ++j) { const int i = F.tid + 512 * j, rr = i >> 7, cp = i & 127, row = row0 - 3 + rr;
            const bool ok = (j < 9 || F.tid < 256) && row >= lo && row < hi;
            pre[j] = ok ? *(const unsigned*)(PROJ + (size_t)row * IND + 2048 + 2 * cp) : 0u; }
        if (PASS == 1) {
#pragma unroll
            for (int j = 0; j < 8; ++j) { const int i = F.tid + 512 * j, t = i >> 7, cp = i & 127; pgw[j] = *(const unsigned*)(PROJ + (size_t)(row0 + t) * IND + 2304 + 2 * cp); }
        }
    };
    if (F.vcu < ntiles) load_tile(F.vcu);
    for (int T = F.vcu; T < ntiles; T += F.G) {
        const int row0 = T * 32;
        __syncthreads();
#pragma unroll
        for (int j = 0; j < 10; ++j) { const int i = F.tid + 512 * j; if (j < 9 || F.tid < 256) ((LAS unsigned*)rxs)[i] = pre[j]; }
        if (PASS == 1) {
#pragma unroll
            for (int j = 0; j < 8; ++j) ((LAS unsigned*)gts)[F.tid + 512 * j] = pgw[j];
        }
        if (T + F.G < ntiles) load_tile(T + F.G);
        float hst[2][2];
#pragma unroll
        for (int dir = 0; dir < 2; ++dir)
#pragma unroll
            for (int n2 = 0; n2 < 2; ++n2) hst[dir][n2] = PASS == 1 ? WSP(const float, WS_CARRY)[((size_t)dir * 1152 + T) * 256 + kb * 64 + 16 * (2 * nh + n2) + j16] : 0.f;
        __syncthreads();
        {
            float x0 = bf1(rxs[(base + 0) * 256 + c]), x1 = bf1(rxs[(base + 1) * 256 + c]), x2 = bf1(rxs[(base + 2) * 256 + c]);
#pragma unroll 8
            for (int t = 0; t < 32; ++t) {
                const float x3 = bf1(rxs[(t + base + 3) * 256 + c]);
                ucf[(sdir * 32 + t) * LRU_UCROW + c] = s1cb + s1w0 * x0 + s1w1 * x1 + s1w2 * x2 + s1w3 * x3;
                x0 = x1; x1 = x2; x2 = x3;
            }
        }
        __syncthreads();
        float hf[2][2][4];
        float Pt[2][2] = {{1.f, 1.f}, {1.f, 1.f}};
#pragma unroll
        for (int dir = 0; dir < 2; ++dir) {
            const bool sec16 = ((g & 1) != 0) != (dir != 0), sec32 = ((g >> 1) != 0) != (dir != 0);
#pragma unroll
            for (int step = 0; step < 2; ++step) {
                const int rt = dir == 0 ? step : 1 - step;
                s16x8 af[2];
#pragma unroll
                for (int s_ = 0; s_ < 2; ++s_) { const LAS float* up = ucf + (dir * 32 + 16 * rt + j16) * LRU_UCROW + kb * 64 + 32 * s_ + 8 * g;
                    const f32x4 u0 = *(const LAS f32x4*)up, u1 = *(const LAS f32x4*)(up + 4);
                    const v4u w = {pg8::cvt_pk_bf16(u0[0], u0[1]), pg8::cvt_pk_bf16(u0[2], u0[3]), pg8::cvt_pk_bf16(u1[0], u1[1]), pg8::cvt_pk_bf16(u1[2], u1[3])};
                    af[s_] = __builtin_bit_cast(s16x8, w); }
#pragma unroll
                for (int n2 = 0; n2 < 2; ++n2) {
                    f32x4 zx = {0.f, 0.f, 0.f, 0.f}, za = {0.f, 0.f, 0.f, 0.f};
#pragma unroll
                    for (int s_ = 0; s_ < 2; ++s_) { zx = __builtin_amdgcn_mfma_f32_16x16x32_bf16(af[s_], wf[dir][0][n2][s_], zx, 0, 0, 0); za = __builtin_amdgcn_mfma_f32_16x16x32_bf16(af[s_], wf[dir][1][n2][s_], za, 0, 0, 0); }
                    const int e = kb * 64 + 16 * (2 * nh + n2) + j16;
                    const LAS float* uo = ucf + (dir * 32 + 16 * rt + 4 * g) * LRU_UCROW + e;
                    float a_[4], b_[4]; unsigned abw[4];
#pragma unroll
                    for (int r = 0; r < 4; ++r) {
                        const float u = uo[r * LRU_UCROW];
                        const float gx = sigmoidf_(zx[r] + cbx[dir][n2]), ga = sigmoidf_(za[r] + cba[dir][n2]);
                        const float la = csp[dir][n2] * ga, a = __builtin_amdgcn_exp2f(1.4426950408889634f * la), y = 2.f * la;
                        const float om = y > -0.02f ? -y * (1.f + y * (0.5f + y * 0.16666667f)) : 1.f - a * a;
                        a_[r] = a; b_[r] = __builtin_amdgcn_sqrtf(om) * gx * u;
                        if (PASS == 0) {
                            const float oma = la > -0.02f ? -la * (1.f + la * (0.5f + la * 0.16666667f)) : 1.f - a;
                            abw[r] = pg8::cvt_pk_bf16(oma, b_[r]); a_[r] = 1.f - bflo(abw[r]); b_[r] = bfhi(abw[r]);
                        }
                    }
                    if (PASS == 0) WSP(v4u, WS_AB)[(((((size_t)T * 2 + dir) * 2 + rt) * 8 + F.wave) * 2 + n2) * 64 + lane] = (v4u){abw[0], abw[1], abw[2], abw[3]};
                    const float P = (a_[0] * a_[1]) * (a_[2] * a_[3]);
                    const float S = dir == 0 ? ((b_[0] * a_[1] + b_[1]) * a_[2] + b_[2]) * a_[3] + b_[3] : ((b_[3] * a_[2] + b_[2]) * a_[1] + b_[1]) * a_[0] + b_[0];
                    const float Pp = __shfl_xor(P, 16), Sp = __shfl_xor(S, 16);
                    const float e1P = sec16 ? Pp : 1.f, e1S = sec16 ? Sp : 0.f;
                    const float prP = P * Pp, prS = sec16 ? P * Sp + S : Pp * S + Sp;
                    const float Pq = __shfl_xor(prP, 32), Sq = __shfl_xor(prS, 32);
                    const float EP = sec32 ? Pq * e1P : e1P, ES = sec32 ? e1P * Sq + e1S : e1S;
                    const float TP = prP * Pq, TS = sec32 ? prP * Sq + prS : Pq * prS + Sq;
                    if (PASS == 1) {
                        float h = EP * hst[dir][n2] + ES;
                        if (dir == 0) {
#pragma unroll
                            for (int r = 0; r < 4; ++r) { h = a_[r] * h + b_[r]; hf[rt][n2][r] = h; }
                        } else {
                            float hb[4];
#pragma unroll
                            for (int r = 3; r >= 0; --r) { h = a_[r] * h + b_[r]; hb[r] = h; }
                            bf16* mp = WSP(bf16, WS_MIX) + (size_t)(row0 + 16 * rt + 4 * g) * D + 768 + e;
                            const LAS bf16* gp = gts + (16 * rt + 4 * g) * 256 + e;
#pragma unroll
                            for (int r = 0; r < 4; ++r) mp[(size_t)r * D] = (bf16)f2bf(gelu_tanh(bf1(gp[r * 256])) * (hf[rt][n2][r] + hb[r]));
                        }
                    } else Pt[dir][n2] *= TP;
                    hst[dir][n2] = TP * hst[dir][n2] + TS;
                }
            }
        }
        if (PASS == 0 && g == 0) {
#pragma unroll
            for (int dir = 0; dir < 2; ++dir)
#pragma unroll
                for (int n2 = 0; n2 < 2; ++n2) WSP(f32x2, WS_TOT)[((size_t)dir * 1152 + T) * 256 + kb * 64 + 16 * (2 * nh + n2) + j16] = (f32x2){Pt[dir][n2], hst[dir][n2]};
        }
    }
}
__device__ __forceinline__ void lru_scan_phase(Frame& F, int l, int ntiles) {
    const bf16* PROJ = WSP(const bf16, WS_PROJ);
    LAS bf16* gts = (LAS bf16*)(F.lds);
    const int lane = F.lane, j16 = lane & 15, g = lane >> 4;
    const int kb = F.wave & 3, nh = F.wave >> 2;
    const v4u* AB = WSP(const v4u, WS_AB);
    v4u pab[2][2][2]; unsigned pgw[8];
    auto load_tile = [&](int T) {
#pragma unroll
        for (int dir = 0; dir < 2; ++dir)
#pragma unroll
            for (int rt = 0; rt < 2; ++rt)
#pragma unroll
                for (int n2 = 0; n2 < 2; ++n2) pab[dir][rt][n2] = AB[(((((size_t)T * 2 + dir) * 2 + rt) * 8 + F.wave) * 2 + n2) * 64 + lane];
#pragma unroll
        for (int j = 0; j < 8; ++j) { const int i = F.tid + 512 * j, t = i >> 7, cp = i & 127; pgw[j] = *(const unsigned*)(PROJ + (size_t)(T * 32 + t) * IND + 2304 + 2 * cp); }
    };
    if (F.vcu < ntiles) load_tile(F.vcu);
    for (int T = F.vcu; T < ntiles; T += F.G) {
        const int row0 = T * 32;
        __syncthreads();
#pragma unroll
        for (int j = 0; j < 8; ++j) ((LAS unsigned*)gts)[F.tid + 512 * j] = pgw[j];
        v4u cur[2][2][2];
#pragma unroll
        for (int dir = 0; dir < 2; ++dir)
#pragma unroll
            for (int rt = 0; rt < 2; ++rt)
#pragma unroll
                for (int n2 = 0; n2 < 2; ++n2) cur[dir][rt][n2] = pab[dir][rt][n2];
        float hst[2][2];
#pragma unroll
        for (int dir = 0; dir < 2; ++dir)
#pragma unroll
            for (int n2 = 0; n2 < 2; ++n2) hst[dir][n2] = WSP(const float, WS_CARRY)[((size_t)dir * 1152 + T) * 256 + kb * 64 + 16 * (2 * nh + n2) + j16];
        if (T + F.G < ntiles) load_tile(T + F.G);
        __syncthreads();
        float hf[2][2][4];
#pragma unroll
        for (int dir = 0; dir < 2; ++dir) {
            const bool sec16 = ((g & 1) != 0) != (dir != 0), sec32 = ((g >> 1) != 0) != (dir != 0);
#pragma unroll
            for (int step = 0; step < 2; ++step) {
                const int rt = dir == 0 ? step : 1 - step;
#pragma unroll
                for (int n2 = 0; n2 < 2; ++n2) {
                    const int e = kb * 64 + 16 * (2 * nh + n2) + j16;
                    const v4u w = cur[dir][rt][n2];
                    const float a_[4] = {1.f - bflo(w.x), 1.f - bflo(w.y), 1.f - bflo(w.z), 1.f - bflo(w.w)}, b_[4] = {bfhi(w.x), bfhi(w.y), bfhi(w.z), bfhi(w.w)};
                    const float P = (a_[0] * a_[1]) * (a_[2] * a_[3]);
                    const float S = dir == 0 ? ((b_[0] * a_[1] + b_[1]) * a_[2] + b_[2]) * a_[3] + b_[3] : ((b_[3] * a_[2] + b_[2]) * a_[1] + b_[1]) * a_[0] + b_[0];
                    const float Pp = __shfl_xor(P, 16), Sp = __shfl_xor(S, 16);
                    const float e1P = sec16 ? Pp : 1.f, e1S = sec16 ? Sp : 0.f;
                    const float prP = P * Pp, prS = sec16 ? P * Sp + S : Pp * S + Sp;
                    const float Pq = __shfl_xor(prP, 32), Sq = __shfl_xor(prS, 32);
                    const float EP = sec32 ? Pq * e1P : e1P, ES = sec32 ? e1P * Sq + e1S : e1S;
                    const float TP = prP * Pq, TS = sec32 ? prP * Sq + prS : Pq * prS + Sq;
                    float h = EP * hst[dir][n2] + ES;
                    if (dir == 0) {
#pragma unroll
                        for (int r = 0; r < 4; ++r) { h = a_[r] * h + b_[r]; hf[rt][n2][r] = h; }
                    } else {
                        float hb[4];
#pragma unroll
                        for (int r = 3; r >= 0; --r) { h = a_[r] * h + b_[r]; hb[r] = h; }
                        bf16* mp = WSP(bf16, WS_MIX) + (size_t)(row0 + 16 * rt + 4 * g) * D + 768 + e;
                        const LAS bf16* gp = gts + (16 * rt + 4 * g) * 256 + e;
#pragma unroll
                        for (int r = 0; r < 4; ++r) mp[(size_t)r * D] = (bf16)f2bf(gelu_tanh(bf1(gp[r * 256])) * (hf[rt][n2][r] + hb[r]));
                    }
                    hst[dir][n2] = TP * hst[dir][n2] + TS;
                }
            }
        }
    }
}

constexpr int LQ_WVB = 35 * 128 + 32 * 144;
constexpr int LQ_WV = 72 * 1024;
constexpr int LQ_CH = TBL_OFF;
constexpr int LQ_FL = LQ_CH + 72 * 2 * 16 * 4;
constexpr int LQ_WV2 = LQ_FL + 2 * 72 * 4;
static_assert(LQ_WV + 6 * LQ_WVB <= RING_BYTES && LQ_WV2 + 2 * LQ_WVB <= LDS_BYTES && LQ_WV2 % 16 == 0, "LRU LDS map");
__device__ __forceinline__ void lru_seq_phase(Frame& F, int l, bool last) {
    const bf16* PROJ = WSP(const bf16, WS_PROJ);
    const int lane = F.lane, j16 = lane & 15, g = lane >> 4, cpn = lane & 31, hh = lane >> 5;
    LAS unsigned char* wreg = F.lds + (F.wave < 6 ? LQ_WV + F.wave * LQ_WVB : LQ_WV2 + (F.wave - 6) * LQ_WVB);
    LAS unsigned* rx32 = (LAS unsigned*)wreg;
    LAS unsigned char* ucb = wreg + 35 * 128;
    volatile LAS unsigned* cflag = (volatile LAS unsigned*)(F.lds + LQ_FL);
    volatile LAS unsigned* hflag = cflag + 72;
    LAS float* chain = (LAS float*)(F.lds + LQ_CH);
    for (int item = F.vcu; item < NB * 16; item += F.G) {
        const int b = item >> 4, cg = item & 15, kb = cg >> 2, nn = cg & 3;
        __syncthreads();
        if (F.tid < 144) cflag[F.tid] = 0u;
        __syncthreads();
        s16x8 wf[2][2][2]; float cbx[2], cba[2], csp[2]; f32x2 cw[2][4], cb[2];
#pragma unroll
        for (int dir = 0; dir < 2; ++dir) {
            const int ld = l * 2 + dir;
            const bf16* WLR = WSP(const bf16, WS_WLR) + (size_t)((ld * 4 + kb) * 2) * 4096;
#pragma unroll
            for (int gt = 0; gt < 2; ++gt)
#pragma unroll
                for (int s_ = 0; s_ < 2; ++s_) wf[dir][gt][s_] = *(const s16x8*)(WLR + gt * 4096 + (16 * nn + j16) * 64 + 32 * s_ + 8 * g);
            const int idx = ld * 256 + kb * 64 + 16 * nn + j16;
            cbx[dir] = INP(18)[idx]; cba[dir] = INP(20)[idx];
            const float nl = -INP(21)[idx]; csp[dir] = -8.f * (fmaxf(nl, 0.f) + log1pf(__expf(-fabsf(nl))));
            const int c0 = kb * 64 + 2 * cpn;
#pragma unroll
            for (int k = 0; k < 4; ++k) cw[dir][k] = (f32x2){INP(15)[(ld * 4 + k) * 256 + c0], INP(15)[(ld * 4 + k) * 256 + c0 + 1]};
            cb[dir] = (f32x2){INP(16)[ld * 256 + c0], INP(16)[ld * 256 + c0 + 1]};
        }
        auto tile_row0 = [&](int s, int dir) -> int { return s < 8 ? ML + b * CTXL + 32 * (dir == 0 ? s : 7 - s) : b * SEQ + 32 * (dir == 0 ? s - 8 : 71 - s); };
        v4u pre[5];
        auto load_rows = [&](int s, int dir) {
            const int lo = s < 8 ? ML + b * CTXL : b * SEQ, hi = lo + (s < 8 ? CTXL : SEQ);
            const int r0 = tile_row0(s, dir) - (dir == 0 ? 3 : 0);
#pragma unroll
            for (int j = 0; j < 5; ++j) { const int rr = (lane >> 3) + 8 * j, row = r0 + rr;
                const bool ok = rr < 35 && row >= lo && row < hi;
                pre[j] = ok ? *(const v4u*)(PROJ + (size_t)row * IND + 2048 + kb * 64 + 8 * (lane & 7)) : (v4u){0u, 0u, 0u, 0u}; }
        };
        load_rows(F.wave, 0);
        for (int s = F.wave; s < 72; s += 8) {
            const bool ctxs = s < 8, comb = ctxs ? s >= 4 : s >= 40, outp = !(last && ctxs);
            float A_[2][2][4], B_[2][2][4], EP[2][2], ES[2][2], TP[2][2], TS[2][2];
#pragma unroll
            for (int dir = 0; dir < 2; ++dir) {
#pragma unroll
                for (int j = 0; j < 5; ++j) { const int rr = (lane >> 3) + 8 * j; if (rr < 35) *(LAS v4u*)(wreg + rr * 128 + 16 * (lane & 7)) = pre[j]; }
                if (dir == 0) load_rows(s, 1); else if (s + 8 < 72) load_rows(s + 8, 0);
                {
                    auto up2 = [](unsigned w) -> f32x2 { return (f32x2){bflo(w), bfhi(w)}; };
                    f32x2 x0 = up2(rx32[(16 * hh + 0) * 32 + cpn]), x1 = up2(rx32[(16 * hh + 1) * 32 + cpn]), x2 = up2(rx32[(16 * hh + 2) * 32 + cpn]);
#pragma unroll
                    for (int t = 0; t < 16; ++t) {
                        const f32x2 x3 = up2(rx32[(16 * hh + t + 3) * 32 + cpn]);
                        const f32x2 acc = cb[dir] + cw[dir][0] * x0 + cw[dir][1] * x1 + cw[dir][2] * x2 + cw[dir][3] * x3;
                        *(LAS unsigned*)(ucb + (16 * hh + t) * 144 + 4 * cpn) = pg8::cvt_pk_bf16(acc[0], acc[1]);
                        x0 = x1; x1 = x2; x2 = x3;
                    }
                }
                const bool sec16 = ((g & 1) != 0) != (dir != 0), sec32 = ((g >> 1) != 0) != (dir != 0);
#pragma unroll
                for (int rt = 0; rt < 2; ++rt) {
                    f32x4 zx = {0.f, 0.f, 0.f, 0.f}, za = {0.f, 0.f, 0.f, 0.f};
#pragma unroll
                    for (int s_ = 0; s_ < 2; ++s_) { const s16x8 af = *(const LAS s16x8*)(ucb + (16 * rt + j16) * 144 + 64 * s_ + 16 * g);
                        zx = __builtin_amdgcn_mfma_f32_16x16x32_bf16(af, wf[dir][0][s_], zx, 0, 0, 0); za = __builtin_amdgcn_mfma_f32_16x16x32_bf16(af, wf[dir][1][s_], za, 0, 0, 0); }
                    float a_[4], b_[4];
#pragma unroll
                    for (int r = 0; r < 4; ++r) {
                        const float u = bf1(*(const LAS bf16*)(ucb + (16 * rt + 4 * g + r) * 144 + 2 * (16 * nn + j16)));
                        const float gx = sigmoidf_(zx[r] + cbx[dir]), ga = sigmoidf_(za[r] + cba[dir]);
                        const float la = csp[dir] * ga, a = __builtin_amdgcn_exp2f(1.4426950408889634f * la), y = 2.f * la;
                        const float om = y > -0.02f ? -y * (1.f + y * (0.5f + y * 0.16666667f)) : 1.f - a * a;
                        a_[r] = a; b_[r] = __builtin_amdgcn_sqrtf(om) * gx * u;
                        A_[dir][rt][r] = a_[r]; B_[dir][rt][r] = b_[r];
                    }
                    const float P = (a_[0] * a_[1]) * (a_[2] * a_[3]);
                    const float S = dir == 0 ? ((b_[0] * a_[1] + b_[1]) * a_[2] + b_[2]) * a_[3] + b_[3] : ((b_[3] * a_[2] + b_[2]) * a_[1] + b_[1]) * a_[0] + b_[0];
                    const float Pp = __shfl_xor(P, 16), Sp = __shfl_xor(S, 16);
                    const float e1P = sec16 ? Pp : 1.f, e1S = sec16 ? Sp : 0.f;
                    const float prP = P * Pp, prS = sec16 ? P * Sp + S : Pp * S + Sp;
                    const float Pq = __shfl_xor(prP, 32), Sq = __shfl_xor(prS, 32);
                    EP[dir][rt] = sec32 ? Pq * e1P : e1P; ES[dir][rt] = sec32 ? e1P * Sq + e1S : e1S;
                    TP[dir][rt] = prP * Pq; TS[dir][rt] = sec32 ? prP * Sq + prS : Pq * prS + Sq;
                }
            }
            bf16 gr[2][2][4];
            if (comb && outp) {
#pragma unroll
                for (int dir = 0; dir < 2; ++dir) { const bf16* gp = PROJ + (size_t)(tile_row0(s, dir) + 4 * g) * IND + 2304 + 16 * cg + j16;
#pragma unroll
                    for (int rt = 0; rt < 2; ++rt)
#pragma unroll
                        for (int r = 0; r < 4; ++r) gr[dir][rt][r] = gp[(size_t)(16 * rt + r) * IND]; }
            }
            float hin[2] = {0.f, 0.f};
            if (s > 0) {
                while (__builtin_amdgcn_readfirstlane(cflag[s - 1]) == 0u) __builtin_amdgcn_s_sleep(1);
                asm volatile("" ::: "memory");
                hin[0] = chain[((s - 1) * 2 + 0) * 16 + j16]; hin[1] = chain[((s - 1) * 2 + 1) * 16 + j16];
            }
#pragma unroll
            for (int dir = 0; dir < 2; ++dir) { const int rf = dir == 0 ? 0 : 1, rs_ = 1 - rf;
                const float hout = (TP[dir][rf] * TP[dir][rs_]) * hin[dir] + (TP[dir][rs_] * TS[dir][rf] + TS[dir][rs_]);
                if (g == 0) chain[(s * 2 + dir) * 16 + j16] = hout; }
            asm volatile("" ::: "memory");
            cflag[s] = 1u;
            asm volatile("" ::: "memory");
#pragma unroll
            for (int dir = 0; dir < 2; ++dir) { const int rf = dir == 0 ? 0 : 1, rs_ = 1 - rf;
                float hv[2][4];
                { float h = EP[dir][rf] * hin[dir] + ES[dir][rf];
                  if (dir == 0) {
#pragma unroll
                      for (int r = 0; r < 4; ++r) { h = A_[dir][rf][r] * h + B_[dir][rf][r]; hv[rf][r] = h; }
                  } else {
#pragma unroll
                      for (int r = 3; r >= 0; --r) { h = A_[dir][rf][r] * h + B_[dir][rf][r]; hv[rf][r] = h; }
                  } }
                { const float hm = TP[dir][rf] * hin[dir] + TS[dir][rf]; float h = EP[dir][rs_] * hm + ES[dir][rs_];
                  if (dir == 0) {
#pragma unroll
                      for (int r = 0; r < 4; ++r) { h = A_[dir][rs_][r] * h + B_[dir][rs_][r]; hv[rs_][r] = h; }
                  } else {
#pragma unroll
                      for (int r = 3; r >= 0; --r) { h = A_[dir][rs_][r] * h + B_[dir][rs_][r]; hv[rs_][r] = h; }
                  } }
                if (outp) {
                    const int id = s < 8 ? (dir == 0 ? s : 7 - s) : (dir == 0 ? s : 79 - s);
                    LAS v4u* hb = (LAS v4u*)(F.lds + id * 1024 + lane * 16);
                    if (!comb) {
                        *hb = (v4u){pg8::cvt_pk_bf16(hv[0][0], hv[0][1]), pg8::cvt_pk_bf16(hv[0][2], hv[0][3]), pg8::cvt_pk_bf16(hv[1][0], hv[1][1]), pg8::cvt_pk_bf16(hv[1][2], hv[1][3])};
                        asm volatile("" ::: "memory");
                        hflag[id] = 1u;
                        asm volatile("" ::: "memory");
                    } else {
                        while (__builtin_amdgcn_readfirstlane(hflag[id]) == 0u) __builtin_amdgcn_s_sleep(1);
                        asm volatile("" ::: "memory");
                        const v4u o = *hb;
                        const float ot[2][4] = {{bflo(o.x), bfhi(o.x), bflo(o.y), bfhi(o.y)}, {bflo(o.z), bfhi(o.z), bflo(o.w), bfhi(o.w)}};
                        bf16* mp = WSP(bf16, WS_MIX) + (size_t)(tile_row0(s, dir) + 4 * g) * D + 768 + 16 * cg + j16;
#pragma unroll
                        for (int rt = 0; rt < 2; ++rt)
#pragma unroll
                            for (int r = 0; r < 4; ++r) mp[(size_t)(16 * rt + r) * D] = (bf16)f2bf(gelu_tanh(bf1(gr[dir][rt][r])) * (hv[rt][r] + ot[rt][r]));
                    }
                }
            }
        }
    }
}

__device__ __forceinline__ void lru_carry(Frame& F) {
    const f32x2* TOT = WSP(const f32x2, WS_TOT); float* CARRY = WSP(float, WS_CARRY);
    for (int it = F.gw; it < NB * 2 * 4; it += F.NGW) {
        const int b = it >> 3, dir = (it >> 2) & 1, c = (it & 3) * 64 + F.lane;
        float h = 0.f;
        for (int g = 0; g < 18; ++g) {
            f32x2 ps[4]; int tl[4];
#pragma unroll
            for (int i = 0; i < 4; ++i) { const int s = g * 4 + i;
                int T; if (s < 8) T = 1024 + b * 8 + (dir == 0 ? s : 7 - s); else T = b * 64 + (dir == 0 ? s - 8 : 71 - s);
                tl[i] = T; ps[i] = TOT[((size_t)dir * 1152 + T) * 256 + c]; }
#pragma unroll
            for (int i = 0; i < 4; ++i) { CARRY[((size_t)dir * 1152 + tl[i]) * 256 + c] = h; h = ps[i][0] * h + ps[i][1]; }
        }
    }
}

__device__ __forceinline__ void ctx_finalize(Frame& F, int l) {
    bf16* XA = WSP(bf16, WS_XA); float* RSSA = WSP(float, WS_RSSA); const float* ACC = WSP(const float, WS_PART); const float* MOD = WSP(const float, WS_MOD);
    const float* go = INP(5) + (l - 1) * D; const float* gso = MOD + ((size_t)(l - 1) * 17 + NB) * MODW + 4 * D;
    const float* gn = INP(4) + l * D; const float* gsn = MOD + ((size_t)l * 17 + NB) * MODW + D;
    for (int r = F.gw; r < MC; r += F.NGW) {
        const size_t row = (size_t)ML + r;
        float ss = 0.f; f32x4 y[4];
#pragma unroll
        for (int j = 0; j < 4; ++j) { const int k = 4 * F.lane + 256 * j;
            const v2u w = *(const v2u*)(XA + row * D + k);
            const f32x4 im = *(const f32x4*)(go + k) * (*(const f32x4*)(gso + k) + 1.0f);
            const f32x4 xo = (f32x4){bflo(w.x) * __builtin_amdgcn_rcpf(im[0]), bfhi(w.x) * __builtin_amdgcn_rcpf(im[1]), bflo(w.y) * __builtin_amdgcn_rcpf(im[2]), bfhi(w.y) * __builtin_amdgcn_rcpf(im[3])};
            const float* ap = ACC + (size_t)r * D + k;
            y[j] = xo + ((*(const f32x4*)ap + *(const f32x4*)(ap + (size_t)MC * D)) + (*(const f32x4*)(ap + (size_t)2 * MC * D) + *(const f32x4*)(ap + (size_t)3 * MC * D)));
            ss += (y[j][0] * y[j][0] + y[j][1] * y[j][1]) + (y[j][2] * y[j][2] + y[j][3] * y[j][3]); }
        ss = wave_sum(ss);
        if (F.lane < 32) RSSA[row * 32 + F.lane] = (F.lane == 0) ? ss : 0.f;
#pragma unroll
        for (int j = 0; j < 4; ++j) { const int k = 4 * F.lane + 256 * j;
            const f32x4 a = y[j] * (*(const f32x4*)(gn + k) * (*(const f32x4*)(gsn + k) + 1.0f));
            v2u o; o.x = pk2(a[0], a[1]); o.y = pk2(a[2], a[3]); *(v2u*)(XA + row * D + k) = o; }
    }
}

__device__ __forceinline__ void final_rows(Frame& F) {
    const bf16* XA = WSP(const bf16, WS_XA); const float* RSS = WSP(const float, WS_RSSA);
    for (int row = F.gw; row < ML; row += 2 * F.NGW) {
        const int row2 = row + F.NGW; const bool two = row2 < ML;
        const v4u a0 = *(const v4u*)(XA + (size_t)row * D + 8 * F.lane), a1 = *(const v4u*)(XA + (size_t)row * D + 512 + 8 * F.lane);
        const float p0 = F.lane < 32 ? RSS[(size_t)row * 32 + F.lane] : 0.f;
        v4u b0 = a0, b1 = a1; float p1 = 0.f;
        if (two) { b0 = *(const v4u*)(XA + (size_t)row2 * D + 8 * F.lane); b1 = *(const v4u*)(XA + (size_t)row2 * D + 512 + 8 * F.lane); p1 = F.lane < 32 ? RSS[(size_t)row2 * 32 + F.lane] : 0.f; }
        const float rs0 = rsqrtf(wave_sum(p0) * (1.f / D) + EPS), rs1 = rsqrtf(wave_sum(p1) * (1.f / D) + EPS);
        float* o = F.out + (size_t)row * D + 8 * F.lane;
        *(f32x4*)(o) = (f32x4){bflo(a0.x), bfhi(a0.x), bflo(a0.y), bfhi(a0.y)} * rs0; *(f32x4*)(o + 4) = (f32x4){bflo(a0.z), bfhi(a0.z), bflo(a0.w), bfhi(a0.w)} * rs0;
        *(f32x4*)(o + 512) = (f32x4){bflo(a1.x), bfhi(a1.x), bflo(a1.y), bfhi(a1.y)} * rs0; *(f32x4*)(o + 516) = (f32x4){bflo(a1.z), bfhi(a1.z), bflo(a1.w), bfhi(a1.w)} * rs0;
        if (two) { float* o2 = F.out + (size_t)row2 * D + 8 * F.lane;
            *(f32x4*)(o2) = (f32x4){bflo(b0.x), bfhi(b0.x), bflo(b0.y), bfhi(b0.y)} * rs1; *(f32x4*)(o2 + 4) = (f32x4){bflo(b0.z), bfhi(b0.z), bflo(b0.w), bfhi(b0.w)} * rs1;
            *(f32x4*)(o2 + 512) = (f32x4){bflo(b1.x), bfhi(b1.x), bflo(b1.y), bfhi(b1.y)} * rs1; *(f32x4*)(o2 + 516) = (f32x4){bflo(b1.z), bfhi(b1.z), bflo(b1.w), bfhi(b1.w)} * rs1; }
    }
}

__device__ __forceinline__ void fill_res_tables(Frame& F, const pg8::Order& S, const float* gate, const float* gmg, const float* gmsc, const float* go, const float* gso) {
    LAS float* T = (LAS float*)(F.lds + TBL_OFF);
    if (F.tid < 256) {
#pragma unroll 1
        for (int i = 0; i < pg8::TBL_UNITS; ++i) { pg8::Unit u; if (!S.next(i, u)) break;
            const int brow = u.pm < ML / 256 ? (u.pm >> 3) : NB, col = u.pn * 256 + F.tid;
            T[i * 256 + F.tid] = gate[(size_t)brow * MODW + col];
            T[(pg8::TBL_UNITS + i) * 256 + F.tid] = gmg[col] * (1.f + gmsc[(size_t)brow * MODW + col]);
            T[(2 * pg8::TBL_UNITS + i) * 256 + F.tid] = __builtin_amdgcn_rcpf(go[col] * (1.f + gso[(size_t)brow * MODW + col])); }
    }
    __syncthreads();
}

template <int LDC>
__device__ __forceinline__ void fill_scale_tables(Frame& F, const pg8::Order& S, const float* RSS, const float* shw) {
    LAS float* RS_T = (LAS float*)(F.lds + TBL_OFF); LAS float* SH_T = RS_T + pg8::TBL_UNITS * 256;
    const int row = F.tid >> 1, half = F.tid & 1;
#pragma unroll 1
    for (int i0 = 0; i0 < pg8::TBL_UNITS; i0 += 3) {
        f32x4 p[3][4], sv[3]; bool ok[3];
#pragma unroll
        for (int j = 0; j < 3; ++j) { pg8::Unit u; ok[j] = S.next(i0 + j, u);
            if (ok[j]) { const float* b = RSS + ((size_t)u.pm * 256 + row) * 32 + 16 * half;
#pragma unroll
                for (int q = 0; q < 4; ++q) p[j][q] = *(const f32x4*)(b + 4 * q);
                if (F.tid < 64) sv[j] = *(const f32x4*)(shw + (size_t)(u.pm < ML / 256 ? (u.pm >> 3) : NB) * LDC + u.pn * 256 + 4 * F.tid); } }
#pragma unroll
        for (int j = 0; j < 3; ++j) if (ok[j]) {
            float s = 0.f;
#pragma unroll
            for (int q = 0; q < 4; ++q) s += (p[j][q][0] + p[j][q][1]) + (p[j][q][2] + p[j][q][3]);
            s += __shfl_xor(s, 1);
            if (half == 0) RS_T[(i0 + j) * 256 + row] = rsqrtf(s * (1.0f / D) + EPS);
            if (F.tid < 64) *(LAS f32x4*)(SH_T + (i0 + j) * 256 + 4 * F.tid) = sv[j]; }
    }
    __syncthreads();
}

constexpr int N_PHASES = 2 + 5 * DEPTH + 1;
struct Args { const float* in[25]; float* out; unsigned char* ws; int ph_lo, ph_hi; };
static_assert(sizeof(Args) == 27 * 8 + 8, "Args has no padding");

__global__ void __launch_bounds__(NWAVES * 64, 2) mega_fwd(Args args) {
    extern __shared__ __attribute__((aligned(16))) unsigned char lds[];
    Frame F;
    F.lds = (LAS unsigned char*)lds;
    const int wave_s = __builtin_amdgcn_readfirstlane((int)threadIdx.x >> 6);
    F.wave = wave_s; F.lane = (int)__builtin_amdgcn_mbcnt_hi(~0u, __builtin_amdgcn_mbcnt_lo(~0u, 0u)); F.tid = wave_s * 64 + F.lane;
    F.G = gridDim.x; { const int bx = blockIdx.x; F.vcu = (F.G % 8 == 0) ? (bx % 8) * (F.G / 8) + bx / 8 : bx; }
    F.gw = F.vcu * NWAVES + F.wave; F.NGW = F.G * NWAVES;
    F.out = args.out; F.ws = args.ws;
    volatile LAS unsigned* MISC = (volatile LAS unsigned*)(F.lds + MISC_OFF);
    for (int u = F.tid; u < (LDS_BYTES - LDSCTL_OFF) / 4; u += NWAVES * 64) ((LAS unsigned*)(F.lds + LDSCTL_OFF))[u] = 0u;
    __syncthreads();
    if (F.tid == 0) {
#pragma unroll
        for (int i = 0; i < 25; ++i) *(LAS unsigned long long*)(F.lds + PTR_OFF + 8 * i) = (unsigned long long)args.in[i];
    }
    __syncthreads();
    XcdBarrier bar = xcd_barrier_post((unsigned*)(F.ws + WS_CTL) + CW_BAR, MISC + 8, F.tid);

    const int lo = args.ph_lo, hi = args.ph_hi;
#ifdef PROBE_MASK
    bool rep_done = false;
#define PROBE_V ((((PROBE_MASK >> ph) & 1) && !rep_done) ? PROBE_VARIANT : 0)
#else
#define PROBE_V 0
#endif
    for (int ph = lo; ph < hi; ++ph) {
        { unsigned ones_ = ~0u; asm volatile("" : "+s"(ones_));
          int t_ = wave_s * 64 + (int)__builtin_amdgcn_mbcnt_hi(ones_, __builtin_amdgcn_mbcnt_lo(ones_, 0u)); asm volatile("" : "+v"(t_)); F.tid = t_; F.lane = t_ & 63; F.wave = __builtin_amdgcn_readfirstlane(t_ >> 6); F.gw = F.vcu * NWAVES + F.wave; }
        if (ph == 0) {
#ifndef NO_P0
            phase_p0a(F);
#endif
        } else if (ph == 1) {
#ifndef NO_P0
            phase_p0b(F);
#endif
        }
        else if (ph == N_PHASES - 1) final_rows(F);
        else {
            const int l = (ph - 2) / 5, k5 = (ph - 2) % 5, k = k5 < 2 ? k5 : k5 + 2; const bool last = (l == DEPTH - 1);
            const int Mx = last ? ML : MT;
            float* MOD = WSP(float, WS_MOD);
            if (k == 0) {
                if (l > 0) { ctx_finalize(F, l); xcd_barrier(bar, F.tid); }
                pg8::Gemm g{WSP(const bf16, WS_XA), WSP(const bf16, WS_WIN) + (size_t)l * IND * D, MT, IND, D};
                pg8::Order S; if (last) S.init(ML, IND, WGM_IN, (MC / 256) * 5, 1, F.G, (int)blockIdx.x); else S.init(MT, IND, WGM_IN, 0, 0, F.G, (int)blockIdx.x);
                fill_scale_tables<IND>(F, S, WSP(const float, WS_RSSA), WSP(const float, WS_SHW1) + (size_t)l * 17 * IND);
                pg8::EpiScale<0, IND, true> E{WSP(bf16, WS_PROJ), (const LAS float*)(F.lds + TBL_OFF), PROBE_V};

#ifndef NO_G0
                pg8::gemm_phase<pg8::EpiScale<0, IND, true>, pg8::Order, true, true>(F.lds + RING_OFF, g, S, E, F.tid);
#endif

            } else if (k == 1) {

#ifndef NO_LRU
                lru_seq_phase(F, l, last);
#ifdef REP_LRU0
                __syncthreads(); lru_seq_phase(F, l, last);
#endif
#endif

                __syncthreads();
#ifndef NO_CONV
                conv_phase(F, l, last ? 1024 : 1152);
                __syncthreads();
#ifdef REP_CONV
                conv_phase(F, l, last ? 1024 : 1152);
                __syncthreads();
#endif
#endif
#ifndef NO_NA
#ifdef REP_NA
                na_phase(F, l, last ? NA_ITEMS_LAT : NA_ITEMS_LAT + NA_ITEMS_CTX, REP_NA);
#else
                na_phase(F, l, last ? NA_ITEMS_LAT : NA_ITEMS_LAT + NA_ITEMS_CTX);
#endif
#ifdef REP_NA
                __syncthreads(); na_phase(F, l, last ? NA_ITEMS_LAT : NA_ITEMS_LAT + NA_ITEMS_CTX, 0);
#endif
#endif
            } else if (k == 4 || k == 6) {
                const bool dn = (k == 6);
                const int ln = (dn && !last) ? l + 1 : l;
                pg8::Gemm g{dn ? WSP(const bf16, WS_HID) : WSP(const bf16, WS_MIX), dn ? WSP(const bf16, WS_W2) + (size_t)l * D * FF : WSP(const bf16, WS_WOUT) + (size_t)l * D * D, Mx, D, dn ? FF : D};
                const bool splitk = dn && !last;
                pg8::Order S; S.init(splitk ? ML : Mx, D, dn ? WGM_DN : WGM_OUT, 0, 0, F.G, (int)blockIdx.x);
                const float* go_g = dn ? INP(5) + l * D : INP(4) + l * D;
                const float* go_s = MOD + (size_t)l * 17 * MODW + (dn ? 4 : 1) * D;
                const bool fin = dn && last;
                fill_res_tables(F, S, MOD + (size_t)l * 17 * MODW + (dn ? 5 : 2) * D, fin ? INP(24) : (dn ? INP(4) : INP(5)) + ln * D, fin ? WSP(const float, WS_ZERO) : MOD + (size_t)ln * 17 * MODW + (dn ? 1 : 4) * D, go_g, go_s);
                pg8::EpiRes<RES_NB> E{(const LAS float*)(F.lds + TBL_OFF), WSP(bf16, WS_XA), dn ? WSP(float, WS_RSSA) : WSP(float, WS_RSSB)};
#ifndef NO_GR
                pg8::gemm_phase<pg8::EpiRes<RES_NB>, pg8::Order, true, true>(F.lds + RING_OFF, g, S, E, F.tid);
                if (splitk) {
                    pg8::Order S2; S2.init(ML, 0, 4, (MC / 256) * 16, 2, F.G, (int)blockIdx.x);
                    pg8::EpiSlab E2{WSP(float, WS_PART), MOD + ((size_t)l * 17 + NB) * MODW + 5 * D};
                    pg8::gemm_phase<pg8::EpiSlab, pg8::Order, true, true, true>(F.lds + RING_OFF, g, S2, E2, F.tid);
                }
#endif
            } else if (k == 5) {
                pg8::Gemm g{WSP(const bf16, WS_XA), WSP(const bf16, WS_W1) + (size_t)l * FF * D, Mx, FF, D};
                pg8::Order S; S.init(Mx, FF, WGM_UP, 0, 0, F.G, (int)blockIdx.x);
                fill_scale_tables<FF>(F, S, WSP(const float, WS_RSSB), WSP(const float, WS_SHW2) + (size_t)l * 17 * FF);
                pg8::EpiScale<1, FF> E{WSP(bf16, WS_HID), (const LAS float*)(F.lds + TBL_OFF), PROBE_V};

#ifndef NO_G1
                pg8::gemm_phase<pg8::EpiScale<1, FF>, pg8::Order, true, true>(F.lds + RING_OFF, g, S, E, F.tid);
#endif

            }
        }
#ifdef PROBE_MASK
        if (((PROBE_MASK >> ph) & 1) && !rep_done) { rep_done = true; xcd_barrier(bar, F.tid); --ph; continue; }
        rep_done = false;
#endif
        if (ph + 1 < hi) xcd_barrier(bar, F.tid);
#ifdef PROBE_BAR2
        if (ph + 1 < hi) xcd_barrier(bar, F.tid);
#endif
    }
}

extern "C" void kernel_launch(void* const* d_in, const int* in_sizes, int n_in, void* d_out, int out_size, void* d_ws, size_t ws_size, hipStream_t stream) {
    static int grid = 0;
    if (grid == 0) {
        if (n_in != 25 || out_size != ML * D || ws_size < WS_END) { fprintf(stderr, "kernel_launch: unexpected shapes (n_in %d out %d ws %zu)\n", n_in, out_size, ws_size); grid = -1; return; }
        int dev = 0, cus = 0;
        if (hipGetDevice(&dev) != hipSuccess || hipDeviceGetAttribute(&cus, hipDeviceAttributeMultiprocessorCount, dev) != hipSuccess) { grid = -1; return; }
        if (hipFuncSetAttribute((const void*)mega_fwd, hipFuncAttributeMaxDynamicSharedMemorySize, LDS_BYTES) != hipSuccess) { fprintf(stderr, "kernel_launch: hipFuncSetAttribute failed\n"); grid = -1; return; }
        int per_cu = 0;
        if (hipOccupancyMaxActiveBlocksPerMultiprocessor(&per_cu, (const void*)mega_fwd, NWAVES * 64, LDS_BYTES) != hipSuccess || per_cu < 1) fprintf(stderr, "kernel_launch: occupancy query reports %d\n", per_cu);
        (void)hipGetLastError();
        grid = cus;
    }
    if (grid < 0) return;
    if (hipMemsetAsync((char*)d_ws + WS_CTL, 0, CTL_ZERO_BYTES, stream) != hipSuccess) return;
    Args a{};
    for (int i = 0; i < 25; ++i) a.in[i] = (const float*)d_in[i];
    a.out = (float*)d_out; a.ws = (unsigned char*)d_ws;
#if MK_N_LAUNCHES == 1
    a.ph_lo = 0; a.ph_hi = N_PHASES;
    hipLaunchKernelGGL(mega_fwd, dim3(grid), dim3(NWAVES * 64), LDS_BYTES, stream, a);
#else
    for (int ph = 0; ph < N_PHASES; ++ph) { a.ph_lo = ph; a.ph_hi = ph + 1; hipLaunchKernelGGL(mega_fwd, dim3(grid), dim3(NWAVES * 64), LDS_BYTES, stream, a); }
#endif
}
```

```cpp
#include <hip/hip_runtime.h>
#include <cstdio>
#include <cstdint>

constexpr int D = 1024, NB = 16, SEQ = 2048, CTXL = 256, DEPTH = 2;
constexpr int ML = NB * SEQ, MC = NB * CTXL, MT = ML + MC;
constexpr int IND = 2560, FF = 4096, NH = 8, HD = 64;
constexpr int MODW = 6 * D;
constexpr float EPS = 1e-6f;
#ifndef MK_N_LAUNCHES
#define MK_N_LAUNCHES 1
#endif

namespace pg8 {
#define PG8_LAS __attribute__((address_space(3)))
typedef unsigned short bf16_t;
typedef short bf16x8 __attribute__((ext_vector_type(8)));
typedef float f32x4 __attribute__((ext_vector_type(4)));
typedef unsigned u32x4 __attribute__((ext_vector_type(4)));
constexpr int BM = 256, BK = 64, HALF = 128, HTB = HALF * BK * 2, STAGE_BYTES = 8 * HTB, NXCD = 8;
constexpr int TBL_UNITS = 9;

__host__ __device__ __forceinline__ int lds_byte(int r, int c) { const int st = (r >> 4) * 2 + (c >> 5), rr = r & 15, cc = c & 31, ob = rr * 64 + cc * 2; return st * 1024 + (ob ^ (((ob >> 9) & 1) << 5)); }
__host__ __device__ __forceinline__ void stage_rc(int b, int& R, int& C) { const int st = b / 1024, sb = b % 1024, swz = sb ^ (((sb >> 9) & 1) << 5); R = (st >> 1) * 16 + swz / 64; C = (st & 1) * 32 + (swz % 64) / 2; }
__host__ __device__ __forceinline__ int perm32(int rho) { const int n = rho >> 4, i = rho & 15; return 8 * (i >> 2) + 4 * n + (i & 3); }

struct Unit { int pm, pn; };
struct Gemm { const bf16_t* A; const bf16_t* Bt; int M, N, K; };

__host__ __device__ __forceinline__ void map_tile(int wgid, int nM, int nN, int WGM, Unit& u) {
    const int nwg = nM * nN;
    { const int q = nwg / NXCD, r = nwg % NXCD, xcd = wgid % NXCD, off = wgid / NXCD; wgid = (xcd < r ? xcd * (q + 1) : r * (q + 1) + (xcd - r) * q) + off; }
    const int nig = WGM * nN, gid = wgid / nig, fm = gid * WGM, gsz = (nM - fm) < WGM ? (nM - fm) : WGM;
    u.pm = fm + ((wgid % nig) % gsz); u.pn = (wgid % nig) / gsz;
}
struct Order {
    int nM, nN, nwg, extra, mode, wgm, G, c;
    __host__ __device__ void init(int M, int N, int wgm_, int extra_, int mode_, int G_, int c_) { nM = M / BM; nN = N / BM; nwg = nM * nN; extra = extra_; mode = mode_; wgm = wgm_; G = G_; c = c_; }
    __host__ __device__ bool next(int i, Unit& u) const {
        const long L = (long)i * G + c;
        if (L < nwg) { map_tile((int)L, nM, nN, wgm, u); return true; }
        if (L < nwg + extra) { const int q = (int)L - nwg;
            if (mode == 1) { u.pm = nM + q / 5; u.pn = 4 + q % 5; }
            else { u.pm = nM + (q >> 4); u.pn = 4 + 4 * (q & 3) + ((q >> 2) & 3); }
            return true; }
        return false;
    }
    __device__ __forceinline__ void a_ready(const Unit&) const {}
    __device__ __forceinline__ void done(const Unit&) const {}
};

__device__ __forceinline__ unsigned cvt_pk_bf16(float lo, float hi) { unsigned r; asm volatile("v_cvt_pk_bf16_f32 %0, %1, %2" : "=v"(r) : "v"(lo), "v"(hi)); return r; }

template <int ACT, int LDC, bool GLU = false> struct EpiScale {
    static constexpr bool PERM = true, AFTER_DRAIN = false;
    bf16_t* O;
    const PG8_LAS float* tbl;
    int probe;
    __device__ __forceinline__ void operator()(const f32x4 (&acc)[2][2][4][2], const Unit& u, int wr, int wc, int fr, int fq, int ui) const {
        asm volatile("" : "+s"(wr), "+s"(wc));
        bf16_t* Ot = O + (size_t)u.pm * BM * LDC + u.pn * BM;
        unsigned cl = (unsigned)(wc * 32 + 8 * fq);
        unsigned rl0 = (unsigned)(wr * 64 + fr);
        asm volatile("" : "+v"(cl), "+v"(rl0));
        const PG8_LAS float* rst = tbl + ui * 256, * sht = tbl + TBL_UNITS * 256 + ui * 256;
        f32x4 sh[2][2]; float rs[2][4];
#pragma unroll
        for (int ai = 0; ai < 2; ++ai)
#pragma unroll
            for (int m = 0; m < 4; ++m) rs[ai][m] = rst[rl0 + (unsigned)(ai * HALF + m * 16)];
#pragma unroll
        for (int bj = 0; bj < 2; ++bj) { sh[bj][0] = *(const PG8_LAS f32x4*)(sht + (cl + (unsigned)(bj * HALF))); sh[bj][1] = *(const PG8_LAS f32x4*)(sht + (cl + (unsigned)(bj * HALF + 4))); }
        if (GLU && u.pn < 2) {
#pragma unroll
            for (int ai = 0; ai < 2; ++ai)
#pragma unroll
                for (int m = 0; m < 4; ++m) {
                    const f32x4 a0 = acc[ai][0][m][0] * rs[ai][m] + sh[0][0], a1 = acc[ai][0][m][1] * rs[ai][m] + sh[0][1];
                    const f32x4 g0 = acc[ai][1][m][0] * rs[ai][m] + sh[1][0], g1 = acc[ai][1][m][1] * rs[ai][m] + sh[1][1];
                    f32x4 v0, v1;
#pragma unroll
                    for (int e = 0; e < 4; ++e) { v0[e] = a0[e] * __builtin_amdgcn_rcpf(1.f + __builtin_amdgcn_exp2f(-1.4426950408889634f * g0[e])); v1[e] = a1[e] * __builtin_amdgcn_rcpf(1.f + __builtin_amdgcn_exp2f(-1.4426950408889634f * g1[e])); }
                    u32x4 w; w.x = cvt_pk_bf16(v0[0], v0[1]); w.y = cvt_pk_bf16(v0[2], v0[3]); w.z = cvt_pk_bf16(v1[0], v1[1]); w.w = cvt_pk_bf16(v1[2], v1[3]);
                    *(u32x4*)(O + (size_t)u.pm * BM * LDC + u.pn * HALF + ((rl0 + (unsigned)(ai * HALF + m * 16)) * (unsigned)LDC + cl)) = w;
                }
            return;
        }
#pragma unroll
        for (int bj = 0; bj < 2; ++bj)
#pragma unroll
            for (int ai = 0; ai < 2; ++ai)
#pragma unroll
                for (int m = 0; m < 4; ++m) {
                    f32x4 v0 = acc[ai][bj][m][0] * rs[ai][m] + sh[bj][0], v1 = acc[ai][bj][m][1] * rs[ai][m] + sh[bj][1];
                    if (ACT == 1) {
#pragma unroll
                        for (int e = 0; e < 4; ++e) { const float a = fmaxf(v0[e], 0.f), b = fmaxf(v1[e], 0.f); v0[e] = a * a; v1[e] = b * b; }
                    }
                    u32x4 w; w.x = cvt_pk_bf16(v0[0], v0[1]); w.y = cvt_pk_bf16(v0[2], v0[3]); w.z = cvt_pk_bf16(v1[0], v1[1]); w.w = cvt_pk_bf16(v1[2], v1[3]);
                    if (probe == 0) *(u32x4*)(Ot + ((rl0 + (unsigned)(ai * HALF + m * 16)) * (unsigned)LDC + cl + (unsigned)(bj * HALF))) = w;
                    else asm volatile("" :: "v"(w));
                }
    }
};
__device__ __forceinline__ float rows4_sum(float x) {
    float a = x, b = x;
    asm volatile("s_nop 1\n\tv_permlane16_swap_b32 %0, %1\n\ts_nop 1" : "+v"(a), "+v"(b));
    const float s = a + b; float c = s, d = s;
    asm volatile("s_nop 1\n\tv_permlane32_swap_b32 %0, %1\n\ts_nop 1" : "+v"(c), "+v"(d));
    return c + d;
}
template <int NB_> struct EpiRes {
    static constexpr bool PERM = true, AFTER_DRAIN = false;
    const PG8_LAS float* tbl;
    bf16_t* XA; float* RSS;
    __device__ __forceinline__ void operator()(const f32x4 (&acc)[2][2][4][2], const Unit& u, int wr, int wc, int fr, int fq, int ui) const {
        asm volatile("" : "+s"(wr), "+s"(wc));
        bf16_t* XAt = XA + (size_t)u.pm * BM * D + u.pn * BM;
        float* RSSt = RSS + (size_t)u.pm * BM * 32 + u.pn * 8 + wc;
        unsigned cl = (unsigned)(wc * 32 + 8 * fq);
        unsigned rl0 = (unsigned)(wr * 64 + fr);
        asm volatile("" : "+v"(cl), "+v"(rl0));
        const PG8_LAS float* gT = tbl + ui * 256, * mT = tbl + (TBL_UNITS + ui) * 256, * iT = tbl + (2 * TBL_UNITS + ui) * 256;
        constexpr int BJB = 2 / NB_;
#pragma unroll
        for (int b0 = 0; b0 < 2; b0 += BJB) {
            u32x4 xb[BJB][2][4];
#pragma unroll
            for (int bb = 0; bb < BJB; ++bb)
#pragma unroll
                for (int ai = 0; ai < 2; ++ai)
#pragma unroll
                    for (int m = 0; m < 4; ++m) xb[bb][ai][m] = *(const u32x4*)(XAt + ((rl0 + (unsigned)(ai * HALF + m * 16)) * (unsigned)D + cl + (unsigned)((b0 + bb) * HALF)));
            asm volatile("" ::: "memory");
#pragma unroll
            for (int bb = 0; bb < BJB; ++bb) {
                const int bj = b0 + bb;
                const unsigned c = cl + (unsigned)(bj * HALF);
                const f32x4 g0 = *(const PG8_LAS f32x4*)(gT + c), g1 = *(const PG8_LAS f32x4*)(gT + (c + 4u)), m0 = *(const PG8_LAS f32x4*)(mT + c), m1 = *(const PG8_LAS f32x4*)(mT + (c + 4u)),
                            r0 = *(const PG8_LAS f32x4*)(iT + c), r1 = *(const PG8_LAS f32x4*)(iT + (c + 4u));
#pragma unroll
                for (int ai = 0; ai < 2; ++ai)
#pragma unroll
                    for (int m = 0; m < 4; ++m) {
                        const unsigned rl = rl0 + (unsigned)(ai * HALF + m * 16);
                        const u32x4 w = xb[bb][ai][m];
                        const f32x4 x0 = (f32x4){__uint_as_float(w.x << 16), __uint_as_float(w.x & 0xffff0000u), __uint_as_float(w.y << 16), __uint_as_float(w.y & 0xffff0000u)} * r0;
                        const f32x4 x1 = (f32x4){__uint_as_float(w.z << 16), __uint_as_float(w.z & 0xffff0000u), __uint_as_float(w.w << 16), __uint_as_float(w.w & 0xffff0000u)} * r1;
                        const f32x4 y0 = x0 + g0 * acc[ai][bj][m][0], y1 = x1 + g1 * acc[ai][bj][m][1];
                        float ss = ((y0[0] * y0[0] + y0[1] * y0[1]) + (y0[2] * y0[2] + y0[3] * y0[3])) + ((y1[0] * y1[0] + y1[1] * y1[1]) + (y1[2] * y1[2] + y1[3] * y1[3]));
                        ss = rows4_sum(ss);
                        if (fq == 0) RSSt[rl * 32u + (unsigned)(bj * 4)] = ss;
                        const f32x4 a0 = y0 * m0, a1 = y1 * m1;
                        u32x4 o; o.x = cvt_pk_bf16(a0[0], a0[1]); o.y = cvt_pk_bf16(a0[2], a0[3]); o.z = cvt_pk_bf16(a1[0], a1[1]); o.w = cvt_pk_bf16(a1[2], a1[3]);
                        *(u32x4*)(XAt + (rl * (unsigned)D + c)) = o;
                    }
            }
            asm volatile("" ::: "memory");
        }
    }
};

struct EpiSlab {
    static constexpr bool PERM = true, AFTER_DRAIN = false;
    float* P; const float* gate;
    __device__ __forceinline__ void operator()(const f32x4 (&acc)[2][2][4][2], const Unit& u, int wr, int wc, int fr, int fq, int) const {
        asm volatile("" : "+s"(wr), "+s"(wc));
        const int ks = (u.pn - 4) >> 2, pn = u.pn & 3;
        float* At = P + ((size_t)ks * MC + (size_t)(u.pm - ML / BM) * BM) * D + pn * BM;
        const float* gtq = gate + pn * BM;
        unsigned cl = (unsigned)(wc * 32 + 8 * fq), rl0 = (unsigned)(wr * 64 + fr);
        asm volatile("" : "+v"(cl), "+v"(rl0));
        f32x4 gv[2][2];
#pragma unroll
        for (int bj = 0; bj < 2; ++bj) { gv[bj][0] = *(const f32x4*)(gtq + (cl + (unsigned)(bj * HALF))); gv[bj][1] = *(const f32x4*)(gtq + (cl + (unsigned)(bj * HALF + 4))); }
#pragma unroll
        for (int bj = 0; bj < 2; ++bj) { const unsigned c = cl + (unsigned)(bj * HALF);
#pragma unroll
            for (int ai = 0; ai < 2; ++ai)
#pragma unroll
                for (int m = 0; m < 4; ++m) { const unsigned off = (rl0 + (unsigned)(ai * HALF + m * 16)) * (unsigned)D + c;
                    *(f32x4*)(At + off) = gv[bj][0] * acc[ai][bj][m][0]; *(f32x4*)(At + (off + 4u)) = gv[bj][1] * acc[ai][bj][m][1]; } }
    }
};

template <class Epi, class Sched, bool ALIGN_EPI = false, bool SP2 = false, bool VARK = false>
__device__ __forceinline__ void gemm_phase(PG8_LAS unsigned char* lds, const Gemm g, const Sched& S, const Epi& E, const int tid) {
    const int wid = __builtin_amdgcn_readfirstlane(tid >> 6), lane = tid & 63, wr = wid >> 2, wc = wid & 3, fr = lane & 15, fq = lane >> 4;
    const int K = g.K;
    unsigned voffA[2], voffB[2];
#pragma unroll
    for (int i = 0; i < 2; ++i) { int R, C; stage_rc(tid * 16 + i * 8192, R, C); const int Rb = Epi::PERM ? ((R & ~31) + perm32(R & 31)) : R;
        voffA[i] = (unsigned)(R * K + C) * 2u; voffB[i] = (unsigned)(Rb * K + C) * 2u; }
    const size_t kstep = (size_t)(BK * 2);
    const size_t hstep = (size_t)HALF * K * 2;
    const size_t tstep = 2 * hstep;
    const unsigned ldsw = (unsigned)wid * 1024u;
    const int aoff = lds_byte(wr * 64 + fr, fq * 8), boff = lds_byte(wc * 32 + fr, fq * 8);
#define PG8_SA(b, h) (((b) * 2 + (h)) * HTB)
#define PG8_SB(b, h) ((4 + (b) * 2 + (h)) * HTB)
#define PG8_STAGE(bufoff, gbase, voff) do { _Pragma("unroll") for (int _i = 0; _i < 2; ++_i) \
        __builtin_amdgcn_global_load_lds((const unsigned*)((const char*)(gbase) + (voff)[_i]), (PG8_LAS unsigned*)(lds + (bufoff) + ldsw + _i * 8192), 16, 0, 0); } while (0)
#define PG8_LDA(dst, b, h) do { _Pragma("unroll") for (int m = 0; m < 4; ++m) _Pragma("unroll") for (int k = 0; k < 2; ++k) dst[m][k] = *(const PG8_LAS bf16x8*)(lds + PG8_SA(b, h) + aoff + m * 2048 + k * 1024); } while (0)
#define PG8_LDB(dst, b, h) do { _Pragma("unroll") for (int n = 0; n < 2; ++n) _Pragma("unroll") for (int k = 0; k < 2; ++k) dst[n][k] = *(const PG8_LAS bf16x8*)(lds + PG8_SB(b, h) + boff + n * 2048 + k * 1024); } while (0)
#define PG8_MMA(ai, bj, At, Bt) do { __builtin_amdgcn_s_setprio(1); _Pragma("unroll") for (int m = 0; m < 4; ++m) _Pragma("unroll") for (int n = 0; n < 2; ++n) _Pragma("unroll") for (int k = 0; k < 2; ++k) \
        acc[ai][bj][m][n] = __builtin_amdgcn_mfma_f32_16x16x32_bf16(Bt[n][k], At[m][k], acc[ai][bj][m][n], 0, 0, 0); __builtin_amdgcn_s_setprio(0); } while (0)
#define PG8_WAIT_V(n) asm volatile("s_waitcnt vmcnt(" #n ")" ::: "memory")
#define PG8_WAIT_L(n) asm volatile("s_waitcnt lgkmcnt(" #n ")" ::: "memory")
#define PG8_BAR __builtin_amdgcn_s_barrier()
#define PG8_SCHED __builtin_amdgcn_sched_barrier(0)
    Unit cur, nxt; int ui = 0;
    if (!S.next(0, cur)) return;
    cur.pm = __builtin_amdgcn_readfirstlane(cur.pm); cur.pn = __builtin_amdgcn_readfirstlane(cur.pn);
    f32x4 acc[2][2][4][2];
#pragma unroll
    for (int a = 0; a < 2; ++a)
#pragma unroll
        for (int b = 0; b < 2; ++b)
#pragma unroll
            for (int m = 0; m < 4; ++m)
#pragma unroll
                for (int n = 0; n < 2; ++n) acc[a][b][m][n] = (f32x4){0.f, 0.f, 0.f, 0.f};
    bf16x8 At[4][2], B0[2][2], B1[2][2];
#define PG8_KOFF(u) ((VARK && (u).pn >= 4) ? (size_t)(((u).pn - 4) >> 2) * (size_t)(K / 4) * 2 : (size_t)0)
#define PG8_PN(u) ((VARK && (u).pn >= 4) ? ((u).pn & 3) : (u).pn)
    const char* cA = (const char*)g.A + (size_t)cur.pm * tstep + PG8_KOFF(cur); const char* cB = (const char*)g.Bt + (size_t)PG8_PN(cur) * tstep + PG8_KOFF(cur);
    S.a_ready(cur);
    if constexpr (SP2) {
        PG8_STAGE(PG8_SB(0, 0), cB, voffB); PG8_STAGE(PG8_SB(0, 1), cB + hstep, voffB); PG8_STAGE(PG8_SA(0, 0), cA, voffA); PG8_STAGE(PG8_SA(0, 1), cA + hstep, voffA);
        if (wr == 1) PG8_BAR;
        PG8_WAIT_V(2); PG8_BAR;
        PG8_STAGE(PG8_SB(1, 0), cB + kstep, voffB); PG8_STAGE(PG8_SA(1, 0), cA + kstep, voffA); PG8_STAGE(PG8_SB(1, 1), cB + hstep + kstep, voffB);
        PG8_WAIT_V(6); PG8_BAR;
    } else {
        PG8_STAGE(PG8_SB(0, 0), cB, voffB); PG8_STAGE(PG8_SA(0, 0), cA, voffA); PG8_STAGE(PG8_SB(0, 1), cB + hstep, voffB); PG8_STAGE(PG8_SA(0, 1), cA + hstep, voffA);
        if (wr == 1) PG8_BAR;
        PG8_WAIT_V(4); PG8_BAR;
        PG8_STAGE(PG8_SB(1, 0), cB + kstep, voffB); PG8_STAGE(PG8_SA(1, 0), cA + kstep, voffA); PG8_STAGE(PG8_SB(1, 1), cB + hstep + kstep, voffB);
        PG8_WAIT_V(6); PG8_BAR;
    }
    for (;;) {
        const bool has_next = S.next(ui + 1, nxt);
        nxt.pm = __builtin_amdgcn_readfirstlane(nxt.pm); nxt.pn = __builtin_amdgcn_readfirstlane(nxt.pn);
        const char* nA = has_next ? (const char*)g.A + (size_t)nxt.pm * tstep + PG8_KOFF(nxt) : cA; const char* nB = has_next ? (const char*)g.Bt + (size_t)PG8_PN(nxt) * tstep + PG8_KOFF(nxt) : cB;
        const int nt = (VARK && cur.pn >= 4) ? K / BK / 4 : K / BK;
        for (int t = 0; t < nt; t += 2) {
            const bool last = (t == nt - 2);
            const char* a1 = cA + (size_t)(t + 1) * kstep;
            const char* a2 = last ? nA : cA + (size_t)(t + 2) * kstep; const char* b2 = last ? nB : cB + (size_t)(t + 2) * kstep;
            const char* a3 = a2 + kstep; const char* b3 = b2 + kstep;
            if (last && has_next) S.a_ready(nxt);
            if constexpr (SP2) {
            PG8_LDB(B0, 0, 0); PG8_LDB(B1, 0, 1); PG8_SCHED; PG8_LDA(At, 0, 0); PG8_STAGE(PG8_SA(1, 1), a1 + hstep, voffA);
            PG8_WAIT_V(8); PG8_WAIT_L(0); PG8_BAR; PG8_MMA(0, 0, At, B0); PG8_MMA(0, 1, At, B1); PG8_BAR; PG8_SCHED;
            PG8_LDA(At, 0, 1); PG8_STAGE(PG8_SB(0, 0), b2, voffB); PG8_STAGE(PG8_SB(0, 1), b2 + hstep, voffB); PG8_STAGE(PG8_SA(0, 0), a2, voffA);
            PG8_WAIT_V(8); PG8_WAIT_L(0); PG8_BAR; PG8_MMA(1, 0, At, B0); PG8_MMA(1, 1, At, B1); PG8_BAR; PG8_SCHED;
            PG8_LDB(B0, 1, 0); PG8_LDB(B1, 1, 1); PG8_SCHED; PG8_LDA(At, 1, 0); PG8_STAGE(PG8_SA(0, 1), a2 + hstep, voffA);
            PG8_WAIT_V(8); PG8_WAIT_L(0); PG8_BAR; PG8_MMA(0, 0, At, B0); PG8_MMA(0, 1, At, B1); PG8_BAR; PG8_SCHED;
            PG8_LDA(At, 1, 1); PG8_STAGE(PG8_SB(1, 0), b3, voffB); PG8_STAGE(PG8_SB(1, 1), b3 + hstep, voffB); PG8_STAGE(PG8_SA(1, 0), a3, voffA);
            PG8_WAIT_V(8); PG8_WAIT_L(0); PG8_BAR; PG8_MMA(1, 0, At, B0); PG8_MMA(1, 1, At, B1); PG8_BAR; PG8_SCHED;
            } else {
            PG8_LDB(B0, 0, 0); PG8_SCHED; PG8_LDA(At, 0, 0); PG8_STAGE(PG8_SA(1, 1), a1 + hstep, voffA);
            PG8_WAIT_L(8); PG8_BAR; PG8_WAIT_L(0); PG8_MMA(0, 0, At, B0); PG8_BAR; PG8_SCHED;
            PG8_LDB(B1, 0, 1); PG8_STAGE(PG8_SB(0, 0), b2, voffB);
            PG8_BAR; PG8_WAIT_L(0); PG8_MMA(0, 1, At, B1); PG8_BAR;
            PG8_LDA(At, 0, 1); PG8_STAGE(PG8_SA(0, 0), a2, voffA);
            PG8_BAR; PG8_WAIT_L(0); PG8_MMA(1, 0, At, B0); PG8_BAR; PG8_SCHED;
            PG8_STAGE(PG8_SB(0, 1), b2 + hstep, voffB);
            PG8_WAIT_V(6); PG8_BAR; PG8_MMA(1, 1, At, B1); PG8_BAR;
            PG8_LDB(B0, 1, 0); PG8_SCHED; PG8_LDA(At, 1, 0); PG8_STAGE(PG8_SA(0, 1), a2 + hstep, voffA);
            PG8_WAIT_L(8); PG8_BAR; PG8_WAIT_L(0); PG8_MMA(0, 0, At, B0); PG8_BAR; PG8_SCHED;
            PG8_LDB(B1, 1, 1); PG8_STAGE(PG8_SB(1, 0), b3, voffB);
            PG8_BAR; PG8_WAIT_L(0); PG8_MMA(0, 1, At, B1); PG8_BAR;
            PG8_LDA(At, 1, 1); PG8_STAGE(PG8_SA(1, 0), a3, voffA);
            PG8_BAR; PG8_WAIT_L(0); PG8_MMA(1, 0, At, B0); PG8_BAR; PG8_SCHED;
            PG8_STAGE(PG8_SB(1, 1), b3 + hstep, voffB);
            PG8_WAIT_V(6); PG8_BAR; PG8_MMA(1, 1, At, B1); PG8_BAR;
            }
        }
        if constexpr (ALIGN_EPI) { if (wr == 0) PG8_BAR; }
        if constexpr (!Epi::AFTER_DRAIN) { E(acc, cur, wr, wc, fr, fq, ui); S.done(cur); }
        if (!has_next) break;
#pragma unroll
        for (int a = 0; a < 2; ++a)
#pragma unroll
            for (int b = 0; b < 2; ++b)
#pragma unroll
                for (int m = 0; m < 4; ++m)
#pragma unroll
                    for (int n = 0; n < 2; ++n) acc[a][b][m][n] = (f32x4){0.f, 0.f, 0.f, 0.f};
        cur = nxt; cA = nA; cB = nB; ++ui;
        if constexpr (ALIGN_EPI) { if (wr == 1) PG8_BAR; }
    }
    PG8_WAIT_V(0);
    if constexpr (!ALIGN_EPI) { if (wr == 0) PG8_BAR; }
    PG8_BAR;
    if constexpr (Epi::AFTER_DRAIN) { E.fused(acc, cur, wr, wc, fr, fq, lds, wid, lane); S.done(cur); }
#undef PG8_KOFF
#undef PG8_PN
#undef PG8_SA
#undef PG8_SB
#undef PG8_STAGE
#undef PG8_LDA
#undef PG8_LDB
#undef PG8_MMA
#undef PG8_WAIT_V
#undef PG8_WAIT_L
#undef PG8_BAR
#undef PG8_SCHED
}
}

constexpr size_t MiB = 1u << 20;
constexpr size_t WS_CTL = 0, CTL_ZERO_BYTES = 1 * MiB;
constexpr size_t WS_MOD = 1 * MiB;
constexpr size_t WS_SHW1 = 2 * MiB;
constexpr size_t WS_SHW2 = 3 * MiB;
constexpr size_t WS_RSSA = 4 * MiB;
constexpr size_t WS_RSSB = 9 * MiB;
constexpr size_t WS_TOT = 14 * MiB;
constexpr size_t WS_CARRY = 19 * MiB;
constexpr size_t WS_WLR = 21 * MiB + 512 * 1024;
constexpr size_t WS_WIN = 22 * MiB;
constexpr size_t WS_WOUT = 32 * MiB;
constexpr size_t WS_W1 = 36 * MiB;
constexpr size_t WS_W2 = 52 * MiB;
constexpr size_t WS_CX = 68 * MiB;
constexpr size_t WS_XA = 84 * MiB;
constexpr size_t WS_HID = 156 * MiB;
constexpr size_t WS_PROJ = WS_HID;
constexpr size_t WS_MIX = WS_HID + 180 * MiB;
constexpr size_t WS_PART = 444 * MiB;
constexpr size_t WS_AB = 436 * MiB;
constexpr size_t WS_END = 508 * MiB;
static_assert(WS_MIX + (size_t)MT * D * 2 <= WS_PART && WS_HID + (size_t)MT * FF * 2 == WS_PART && WS_PART + (size_t)4 * MC * D * 4 == WS_END && WS_AB >= WS_MIX + (size_t)MT * D * 2 && WS_AB + (size_t)1152 * 2 * 2 * 8 * 2 * 64 * 16 == WS_END, "ws map");
constexpr size_t WS_ZERO = WS_CTL + 512 * 1024;
constexpr int CW_BAR = 4096;

#ifndef WGM_IN
#define WGM_IN 4
#endif
#ifndef WGM_OUT
#define WGM_OUT 4
#endif
#ifndef WGM_UP
#define WGM_UP 4
#endif
#ifndef WGM_DN
#define WGM_DN 4
#endif
#ifndef RES_NB
#define RES_NB 2
#endif
constexpr int NWAVES = 8;
constexpr int RING_OFF = 0, RING_BYTES = 131072;
constexpr int LDSCTL_OFF = RING_BYTES, MISC_OFF = LDSCTL_OFF + 320;
constexpr int TBL_OFF = LDSCTL_OFF + 1024;
static_assert(TBL_OFF + 3 * pg8::TBL_UNITS * 256 * 4 <= 163840, "LDS map");
constexpr int LDS_BYTES = 163840;

#define GAS __attribute__((address_space(1)))
#define LAS __attribute__((address_space(3)))
typedef unsigned short bf16;
typedef unsigned v4u __attribute__((ext_vector_type(4)));
typedef unsigned v2u __attribute__((ext_vector_type(2)));
typedef float f32x4 __attribute__((ext_vector_type(4)));
typedef float f32x2 __attribute__((ext_vector_type(2)));
typedef GAS unsigned gu32;
#define LDS_WAIT() asm volatile("s_waitcnt lgkmcnt(0)" ::: "memory")
#define VM_WAIT() asm volatile("s_waitcnt vmcnt(0)" ::: "memory")
__device__ __forceinline__ unsigned f2bf(float f) { unsigned u = __builtin_bit_cast(unsigned, f); return (u + 0x7fffu + ((u >> 16) & 1u)) >> 16; }
__device__ __forceinline__ unsigned pk2(float lo, float hi) { return f2bf(lo) | (f2bf(hi) << 16); }
__device__ __forceinline__ float bflo(unsigned w) { return __uint_as_float(w << 16); }
__device__ __forceinline__ float bfhi(unsigned w) { return __uint_as_float(w & 0xffff0000u); }
__device__ __forceinline__ float bf1(bf16 v) { return __uint_as_float((unsigned)v << 16); }
__device__ __forceinline__ float sigmoidf_(float x) { return __builtin_amdgcn_rcpf(1.f + __builtin_amdgcn_exp2f(-1.4426950408889634f * x)); }
__device__ __forceinline__ float siluf_(float x) { return x * sigmoidf_(x); }
__device__ __forceinline__ float gelu_tanh(float x) { const float u = 0.7978845608028654f * (x + 0.044715f * x * x * x); return x * sigmoidf_(2.f * u); }
__device__ __forceinline__ float lane_xor1_sum(float v) { return v + __builtin_bit_cast(float, __builtin_amdgcn_update_dpp(0, __builtin_bit_cast(int, v), 0xB1, 0xf, 0xf, true)); }
__device__ __forceinline__ float row16_sum_(float v) {
    v += __builtin_bit_cast(float, __builtin_amdgcn_update_dpp(0, __builtin_bit_cast(int, v), 0xB1, 0xf, 0xf, true));
    v += __builtin_bit_cast(float, __builtin_amdgcn_update_dpp(0, __builtin_bit_cast(int, v), 0x4E, 0xf, 0xf, true));
    v += __builtin_bit_cast(float, __builtin_amdgcn_update_dpp(0, __builtin_bit_cast(int, v), 0x141, 0xf, 0xf, true));
    v += __builtin_bit_cast(float, __builtin_amdgcn_update_dpp(0, __builtin_bit_cast(int, v), 0x140, 0xf, 0xf, true));
    return v; }
__device__ __forceinline__ float wave_sum(float v) { v = row16_sum_(v); v += __shfl_xor(v, 16); v += __shfl_xor(v, 32); return v; }

#define XB_TMO      128
#define XB_XCNT(j)  (256  + 64 * (j))
#define XB_XSUB(j)  (1280 + 64 * (j))
#define XB_XGEN(j)  (2304 + 64 * (j))
#define XB_TOP      3328
#define XB_TOPGEN   3392
#define XCD_BAR_WORDS 3456
#define XB_SPIN_CAP (1u << 18)

__device__ __forceinline__ unsigned xb_ld(unsigned* p)              { return __hip_atomic_load(p, __ATOMIC_RELAXED, __HIP_MEMORY_SCOPE_AGENT); }
__device__ __forceinline__ unsigned xb_add(unsigned* p, unsigned v) { return __hip_atomic_fetch_add(p, v, __ATOMIC_RELAXED, __HIP_MEMORY_SCOPE_AGENT); }
__device__ __forceinline__ unsigned xb_xcc_id() { return (unsigned)__builtin_amdgcn_s_getreg((3 << 11) | 20) & 0xFu; }
#define XB_SPIN(cond, bar) do { unsigned _sp = 0; while (cond) { __builtin_amdgcn_s_sleep(1); \
    if ((++_sp & 255u) == 0u) { if (xb_ld(&(bar)[XB_TMO])) break; if (_sp > XB_SPIN_CAP) { atomicAdd(&(bar)[XB_TMO], 1u); break; } } } } while (0)

struct XcdBarrier {
    unsigned* bar; unsigned x;
    volatile LAS unsigned* st;
};

__device__ __forceinline__ XcdBarrier xcd_barrier_post(unsigned* bar, volatile LAS unsigned* st, int tid) {
    XcdBarrier b; b.bar = bar; b.x = xb_xcc_id(); b.st = st;
    if (tid == 0) (void)xb_add(&bar[XB_XCNT(b.x)], 1u);
    return b;
}
__device__ __forceinline__ void xcd_barrier_complete(unsigned* bar, unsigned x, unsigned& nloc, unsigned& nx) {
    const unsigned G = gridDim.x * gridDim.y * gridDim.z;
    unsigned sum, cnt, mine, sp = 0u;
    for (;;) {
        sum = 0u; cnt = 0u; mine = 0u;
        unsigned cv[16];
        { const unsigned* cb = &bar[XB_XCNT(0)];
          asm volatile("global_load_dword %0, %16, off sc0 sc1\n\tglobal_load_dword %1, %16, off offset:256 sc0 sc1\n\tglobal_load_dword %2, %16, off offset:512 sc0 sc1\n\tglobal_load_dword %3, %16, off offset:768 sc0 sc1\n\t"
                       "global_load_dword %4, %16, off offset:1024 sc0 sc1\n\tglobal_load_dword %5, %16, off offset:1280 sc0 sc1\n\tglobal_load_dword %6, %16, off offset:1536 sc0 sc1\n\tglobal_load_dword %7, %16, off offset:1792 sc0 sc1\n\t"
                       "global_load_dword %8, %16, off offset:2048 sc0 sc1\n\tglobal_load_dword %9, %16, off offset:2304 sc0 sc1\n\tglobal_load_dword %10, %16, off offset:2560 sc0 sc1\n\tglobal_load_dword %11, %16, off offset:2816 sc0 sc1\n\t"
                       "global_load_dword %12, %16, off offset:3072 sc0 sc1\n\tglobal_load_dword %13, %16, off offset:3328 sc0 sc1\n\tglobal_load_dword %14, %16, off offset:3584 sc0 sc1\n\tglobal_load_dword %15, %16, off offset:3840 sc0 sc1\n\t"
                       "s_waitcnt vmcnt(0)"
                       : "=&v"(cv[0]), "=&v"(cv[1]), "=&v"(cv[2]), "=&v"(cv[3]), "=&v"(cv[4]), "=&v"(cv[5]), "=&v"(cv[6]), "=&v"(cv[7]),
                         "=&v"(cv[8]), "=&v"(cv[9]), "=&v"(cv[10]), "=&v"(cv[11]), "=&v"(cv[12]), "=&v"(cv[13]), "=&v"(cv[14]), "=&v"(cv[15])
                       : "v"(cb) : "memory"); }
#pragma unroll
        for (unsigned j = 0; j < 16; ++j) { const unsigned c = cv[j]; sum += c; cnt += (c > 0u) ? 1u : 0u; mine = (j == x) ? c : mine; }
        if (sum == G) break;
        __builtin_amdgcn_s_sleep(1);
        if ((++sp & 255u) == 0u) { if (xb_ld(&bar[XB_TMO])) break; if (sp > XB_SPIN_CAP) { atomicAdd(&bar[XB_TMO], 1u); break; } }
    }
    nloc = mine > 0u ? mine : 1u; nx = cnt > 0u ? cnt : 1u;
}

__device__ __forceinline__ void xcd_barrier(const XcdBarrier& b, int tid) {
    asm volatile("s_waitcnt vmcnt(0)" ::: "memory");
    __syncthreads();
    if (tid == 0) {
        unsigned* bar = b.bar;
        __builtin_amdgcn_s_waitcnt(0);
        unsigned nloc = b.st[0], nx = b.st[1];
        if (nloc == 0u) { xcd_barrier_complete(bar, b.x, nloc, nx); b.st[0] = nloc; b.st[1] = nx; }
        const unsigned old = xb_add(&bar[XB_XSUB(b.x)], 1u);
        const unsigned gen = old / nloc;
        if (old + 1u == (gen + 1u) * nloc) {
            __builtin_amdgcn_fence(__ATOMIC_RELEASE, "agent");
            asm volatile("s_waitcnt vmcnt(0)" ::: "memory");
            const unsigned og = xb_add(&bar[XB_TOP], 1u);
            const unsigned tg = og / nx;
            if (og + 1u == (tg + 1u) * nx) xb_add(&bar[XB_TOPGEN], 1u);
            else XB_SPIN(xb_ld(&bar[XB_TOPGEN]) == tg, bar);
            __builtin_amdgcn_fence(__ATOMIC_ACQUIRE, "agent");
            xb_add(&bar[XB_XGEN(b.x)], 1u);
            asm volatile("s_waitcnt vmcnt(0)" ::: "memory");
        } else {
            XB_SPIN(xb_ld(&bar[XB_XGEN(b.x)]) == gen, bar);
            __builtin_amdgcn_fence(__ATOMIC_ACQUIRE, "agent");
            asm volatile("s_waitcnt vmcnt(0)" ::: "memory");
        }
    }
    __syncthreads();
}

struct Frame {
    LAS unsigned char* lds;
    int tid, wave;
    int vcu, G;
    int gw, NGW;
    float* out; unsigned char* ws;
};
constexpr int PTR_OFF = LDSCTL_OFF + 512;
__device__ __forceinline__ const float* inp_(LAS unsigned char* lds, int i) {
    const unsigned long long v = *(const LAS unsigned long long*)(lds + PTR_OFF + 8 * i);
    const unsigned lo = __builtin_amdgcn_readfirstlane((unsigned)v), hi = __builtin_amdgcn_readfirstlane((unsigned)(v >> 32));
    return (const float*)(((unsigned long long)hi << 32) | lo);
}
#define INP(i) inp_(F.lds, (i))
#define WSP(T, off) ((T*)(F.ws + (off)))

__device__ __forceinline__ void gemv17_item(Frame& F, const LAS float* tab, LAS float* red, const float* W, int ldw, int n0, const float* bias, float* outp, int ldo, int n0out) {
    int LN_ = F.tid & 63; asm volatile("" : "+v"(LN_));
    float acc[17];
#pragma unroll
    for (int r = 0; r < 17; ++r) acc[r] = 0.f;
    const int k0 = F.wave * 128;
    const float* wp = W + (size_t)k0 * ldw + n0 + LN_;
#pragma unroll 1
    for (int kk = 0; kk < 128; kk += 32) {
        float wv[32];
#pragma unroll
        for (int k = 0; k < 32; ++k) wv[k] = wp[(size_t)(kk + k) * ldw];
#pragma unroll
        for (int k = 0; k < 32; ++k) {
#pragma unroll
            for (int r = 0; r < 17; ++r) acc[r] += tab[r * 1024 + k0 + kk + k] * wv[k];
        }
    }
#pragma unroll
    for (int r = 0; r < 17; ++r) red[(F.wave * 17 + r) * 64 + LN_] = acc[r];
    __syncthreads();
    for (int i = F.tid; i < 17 * 64; i += NWAVES * 64) {
        const int r = i >> 6, n = i & 63; float s = bias ? bias[n0 + n] : 0.f;
#pragma unroll
        for (int w = 0; w < 8; ++w) s += red[(w * 17 + r) * 64 + n];
        outp[(size_t)r * ldo + n0out + n] = s;
    }
    __syncthreads();
}

__host__ __device__ __forceinline__ int glu_col(int o) { return o >= 512 ? o : ((o >> 7) & 1) * 256 + (o >> 8) * 128 + (o & 127); }
__device__ __forceinline__ void p0_transpose_item(const float* W, int K, int N, bf16* WT, LAS float* scr, int item, int lane, bool glu) {
    const int nblk = N / 32, kb = item / nblk, nb = item % nblk, k0 = 64 * kb, n0 = 32 * nb;
    const int n0o = glu ? glu_col(n0) : n0;
    float tv[32];
#pragma unroll
    for (int i = 0; i < 32; ++i) { const int kk = 2 * i + (lane >> 5); tv[i] = W[(size_t)(k0 + kk) * N + n0 + (lane & 31)]; }
#pragma unroll
    for (int i = 0; i < 32; ++i) { const int kk = 2 * i + (lane >> 5); scr[kk * 33 + (lane & 31)] = tv[i]; }
    LDS_WAIT(); asm volatile("" ::: "memory");
    const int c = lane & 7;
#pragma unroll
    for (int j = 0; j < 4; ++j) { const int n = (lane >> 3) + 8 * j; const LAS float* s = scr + (8 * c) * 33 + n;
        v4u o; o.x = pk2(s[0 * 33], s[1 * 33]); o.y = pk2(s[2 * 33], s[3 * 33]); o.z = pk2(s[4 * 33], s[5 * 33]); o.w = pk2(s[6 * 33], s[7 * 33]);
        *(GAS v4u*)(WT + (size_t)(n0o + n) * K + k0 + 8 * c) = o; }
    LDS_WAIT(); asm volatile("" ::: "memory");
}

__device__ __forceinline__ void weight_items(Frame& F, int first, int last, int widx, int nw) {
    int LN_ = F.tid & 63; asm volatile("" : "+v"(LN_));
    LAS float* scr = (LAS float*)(F.lds + F.wave * 16384);
    constexpr int I_IN = (D / 64) * (IND / 32), I_OUT = (D / 64) * (D / 32), I_1 = (D / 64) * (FF / 32), I_2 = (FF / 64) * (D / 32), I_L = I_IN + I_OUT + I_1 + I_2;
    for (int it = first + widx; it < last; it += nw) {
        const int l = it / I_L; int r = it % I_L;
        const float* W; bf16* WT; int K = D, N; const bool glu = r < I_IN;
        if (r < I_IN) { W = INP(8) + (size_t)l * D * IND; WT = WSP(bf16, WS_WIN) + (size_t)l * IND * D; N = IND; }
        else if (r < I_IN + I_OUT) { r -= I_IN; W = INP(9) + (size_t)l * D * D; WT = WSP(bf16, WS_WOUT) + (size_t)l * D * D; N = D; }
        else if (r < I_IN + I_OUT + I_1) { r -= I_IN + I_OUT; W = INP(22) + (size_t)l * D * FF; WT = WSP(bf16, WS_W1) + (size_t)l * FF * D; N = FF; }
        else { r -= I_IN + I_OUT + I_1; W = INP(23) + (size_t)l * FF * D; WT = WSP(bf16, WS_W2) + (size_t)l * D * FF; K = FF; N = D; }
        p0_transpose_item(W, K, N, WT, scr, r, LN_, glu);
    }
}
__device__ __forceinline__ void filler_weights(Frame& F, int total_units, int first, int last) {
    const int rem = total_units % F.G, bx = (int)blockIdx.x;
    if (F.G != 256 || rem == 0 || bx < rem) return;
    __syncthreads();
    weight_items(F, first, last, (bx - rem) * NWAVES + F.wave, (F.G - rem) * NWAVES);
}
constexpr int W_ITEMS = 2 * ((D / 64) * (IND / 32) + (D / 64) * (D / 32) + (D / 64) * (FF / 32) + (FF / 64) * (D / 32));
constexpr int W_F1 = 3840, W_F2 = 8448;
constexpr int W_EARLY = 64 * NWAVES * 3;

__device__ __forceinline__ void phase_p0a(Frame& F) {
    LAS float* tab = (LAS float*)(F.lds);
    LAS float* red = (LAS float*)(F.lds + 17 * 1024 * 4);
    float* MOD = WSP(float, WS_MOD);
    bool filled = false;
    for (int it = F.vcu; it < 2 * 96; it += F.G) {
        if (!filled) {
            {
                const float* c0 = INP(1); const float* c1 = INP(3);
#pragma unroll 1
                for (int r0 = 0; r0 < 16; r0 += 8) { float tv[16];
#pragma unroll
                    for (int j = 0; j < 16; ++j) tv[j] = c0[(r0 + (j >> 1)) * D + F.tid + 512 * (j & 1)];
#pragma unroll
                    for (int j = 0; j < 16; ++j) tab[(r0 + (j >> 1)) * 1024 + F.tid + 512 * (j & 1)] = siluf_(tv[j]); }
                { const float a = c1[F.tid], b = c1[F.tid + 512]; tab[16 * 1024 + F.tid] = siluf_(a); tab[16 * 1024 + F.tid + 512] = siluf_(b); }
            }
            __syncthreads(); filled = true;
        }
        const int l = it / 96, n0 = (it % 96) * 64;
        gemv17_item(F, tab, red, INP(6) + (size_t)l * D * MODW, MODW, n0, INP(7) + (size_t)l * MODW, MOD + (size_t)l * 17 * MODW, MODW, n0);
    }
    if (F.G == 256 && F.vcu >= 192) weight_items(F, 0, W_EARLY, (F.vcu - 192) * NWAVES + F.wave, 64 * NWAVES);
}

__device__ __forceinline__ void phase_p0b(Frame& F) {
    int LN_ = F.tid & 63; asm volatile("" : "+v"(LN_));
    LAS float* tab = (LAS float*)(F.lds);
    LAS float* red = (LAS float*)(F.lds + 17 * 1024 * 4);
    const float* MOD = WSP(const float, WS_MOD);
    bf16* XA = WSP(bf16, WS_XA); float* RSSA = WSP(float, WS_RSSA);
    const int rpw = (MT + F.NGW - 1) / F.NGW;
    auto stream_rows = [&](int slot0, int sstride, int nslots) __attribute__((always_inline)) {
        const float* g1 = INP(4);
        auto row_ptr = [&](int r_) -> const float* { return r_ < ML ? INP(0) + (size_t)r_ * D : INP(2) + (size_t)(r_ - ML) * D; };
#pragma unroll 1
        for (int sl = 0; sl < nslots; ++sl) {
            const int rbeg = (slot0 + sl * sstride) * rpw, rend = (rbeg + rpw < MT) ? rbeg + rpw : MT;
            f32x4 vn[2][4], gm[4]; int cur_b = -1;
            if (rbeg < rend) {
#pragma unroll
                for (int q = 0; q < 2; ++q) { const int r_ = (rbeg + q < rend) ? rbeg + q : rbeg; const float* xr = row_ptr(r_);
#pragma unroll
                    for (int j = 0; j < 4; ++j) vn[q][j] = *(const f32x4*)(xr + 4 * LN_ + 256 * j); }
            }
#pragma unroll 1
            for (int row = rbeg; row < rend; row += 2) {
                f32x4 v[2][4];
#pragma unroll
                for (int q = 0; q < 2; ++q)
#pragma unroll
                    for (int j = 0; j < 4; ++j) v[q][j] = vn[q][j];
                if (row + 2 < rend) {
#pragma unroll
                    for (int q = 0; q < 2; ++q) { const int r_ = (row + 2 + q < rend) ? row + 2 + q : row + 2; const float* xr = row_ptr(r_);
#pragma unroll
                        for (int j = 0; j < 4; ++j) vn[q][j] = *(const f32x4*)(xr + 4 * LN_ + 256 * j); }
                }
                float ss[2];
#pragma unroll
                for (int q = 0; q < 2; ++q) { float s_ = 0.f;
#pragma unroll
                    for (int j = 0; j < 4; ++j) s_ += (v[q][j][0] * v[q][j][0] + v[q][j][1] * v[q][j][1]) + (v[q][j][2] * v[q][j][2] + v[q][j][3] * v[q][j][3]);
                    ss[q] = wave_sum(s_); }
#pragma unroll
                for (int q = 0; q < 2; ++q) { const int r_ = row + q; if (r_ >= rend) break;
                    const int bt = r_ < ML ? (r_ >> 11) : NB;
                    if (bt != cur_b) { cur_b = bt; const float* scp = MOD + (size_t)bt * MODW + D;
#pragma unroll
                        for (int j = 0; j < 4; ++j) { const int k = 4 * LN_ + 256 * j; gm[j] = *(const f32x4*)(g1 + k) * (*(const f32x4*)(scp + k) + 1.0f); } }
                    if (LN_ < 32) RSSA[(size_t)r_ * 32 + LN_] = (LN_ == 0) ? ss[q] : 0.f;
#pragma unroll
                    for (int j = 0; j < 4; ++j) { const int k = 4 * LN_ + 256 * j; const f32x4 a = v[q][j] * gm[j];
                        v2u o; o.x = pk2(a[0], a[1]); o.y = pk2(a[2], a[3]); *(v2u*)(XA + (size_t)r_ * D + k) = o; } }
            }
        }
    };
    bool rows_done = false;
    for (int it = F.vcu; it < 2 * 104; it += F.G) {
        const int l = it / 104, j = it % 104; const bool first = j < 40;
        const int shoff = first ? 0 : 3 * D;
        __syncthreads();
        {
            const float* mrow = MOD + (size_t)l * 17 * MODW + shoff;
#pragma unroll 1
            for (int r0 = 0; r0 < 16; r0 += 8) { float tv[16];
#pragma unroll
                for (int j = 0; j < 16; ++j) tv[j] = mrow[(size_t)(r0 + (j >> 1)) * MODW + F.tid + 512 * (j & 1)];
#pragma unroll
                for (int j = 0; j < 16; ++j) tab[(r0 + (j >> 1)) * 1024 + F.tid + 512 * (j & 1)] = tv[j]; }
            { const float a = mrow[(size_t)16 * MODW + F.tid], b = mrow[(size_t)16 * MODW + F.tid + 512]; tab[16 * 1024 + F.tid] = a; tab[16 * 1024 + F.tid + 512] = b; }
        }
        __syncthreads();
        const int ldw = first ? IND : FF, n0 = (first ? j : j - 40) * 64;
        const float* W = first ? INP(8) + (size_t)l * D * IND : INP(22) + (size_t)l * D * FF;
        float* outp = first ? WSP(float, WS_SHW1) + (size_t)l * 17 * IND : WSP(float, WS_SHW2) + (size_t)l * 17 * FF;
        const int n0out = first ? glu_col(j * 64) : (j - 40) * 64;
        const bool split = !rows_done;
        float acc[17];
#pragma unroll
        for (int r = 0; r < 17; ++r) acc[r] = 0.f;
        if (split && F.wave < 4) { stream_rows(F.vcu * NWAVES + F.wave, 4, 2); }
        else {
            const int kcnt = split ? 256 : 128, k0 = split ? (F.wave - 4) * 256 : F.wave * 128;
            const float* wp = W + (size_t)k0 * ldw + n0 + LN_;
#pragma unroll 1
            for (int kk = 0; kk < kcnt; kk += 32) {
                float wv[32];
#pragma unroll
                for (int k = 0; k < 32; ++k) wv[k] = wp[(size_t)(kk + k) * ldw];
#pragma unroll
                for (int k = 0; k < 32; ++k) {
#pragma unroll
                    for (int r = 0; r < 17; ++r) acc[r] += tab[r * 1024 + k0 + kk + k] * wv[k];
                }
            }
        }
        rows_done = true;
#pragma unroll
        for (int r = 0; r < 17; ++r) red[(F.wave * 17 + r) * 64 + LN_] = acc[r];
        __syncthreads();
        for (int i = F.tid; i < 17 * 64; i += NWAVES * 64) {
            const int r = i >> 6, n = i & 63; float s_ = 0.f;
#pragma unroll
            for (int w = 0; w < 8; ++w) s_ += red[(w * 17 + r) * 64 + n];
            outp[(size_t)r * ldw + n0out + n] = s_;
        }
        __syncthreads();
    }
    if (!rows_done) stream_rows(F.vcu * NWAVES + F.wave, 0, 1);
    __syncthreads();
    {
        bf16* WLR = WSP(bf16, WS_WLR);
        for (int i = F.gw * 64 + LN_; i < 2 * 2 * 4 * 2 * 4096; i += F.NGW * 64) { const int d = i & 63, e = (i >> 6) & 63, gt = (i >> 12) & 1, blk = i >> 13;
            const float* src = gt == 0 ? INP(17) : INP(19); WLR[i] = (bf16)f2bf(src[((size_t)blk * 64 + d) * 64 + e]); }
    }
    if (F.G != 256) weight_items(F, 0, W_ITEMS, F.gw, F.NGW);
}

constexpr int CV_OSROW = 260;
__device__ __forceinline__ void conv_phase(Frame& F, int l, int ntiles) {
    const bf16* PROJ = WSP(const bf16, WS_PROJ); bf16* MIX = WSP(bf16, WS_MIX);
    LAS float* us = (LAS float*)(F.lds);
    LAS float* os = (LAS float*)(F.lds + 62 * 256 * 4);
    const int c = F.tid & 255, half = F.tid >> 8;
    float w[31];
#pragma unroll
    for (int k = 0; k < 31; ++k) w[k] = INP(10)[((size_t)l * 31 + k) * 256 + c];
    const float cbias = INP(11)[l * 256 + c];
    const int lt = F.tid >> 4, lseg = F.tid & 15;
    f32x4 lg[4], lb[4];
#pragma unroll
    for (int q = 0; q < 4; ++q) { lg[q] = *(const f32x4*)(INP(12) + l * 256 + 16 * lseg + 4 * q); lb[q] = *(const f32x4*)(INP(13) + l * 256 + 16 * lseg + 4 * q); }
    auto row16_sum = [](float v) -> float {
        v += __builtin_bit_cast(float, __builtin_amdgcn_update_dpp(0, __builtin_bit_cast(int, v), 0xB1, 0xf, 0xf, true));
        v += __builtin_bit_cast(float, __builtin_amdgcn_update_dpp(0, __builtin_bit_cast(int, v), 0x4E, 0xf, 0xf, true));
        v += __builtin_bit_cast(float, __builtin_amdgcn_update_dpp(0, __builtin_bit_cast(int, v), 0x141, 0xf, 0xf, true));
        v += __builtin_bit_cast(float, __builtin_amdgcn_update_dpp(0, __builtin_bit_cast(int, v), 0x140, 0xf, 0xf, true));
        return v; };
    unsigned pv[16];
    auto load_tile = [&](int T) {
        const int row0 = T * 32;
        int lo, hi; if (row0 < ML) { lo = row0 & ~(SEQ - 1); hi = lo + SEQ; } else { lo = row0 & ~(CTXL - 1); hi = lo + CTXL; }
#pragma unroll
        for (int j = 0; j < 16; ++j) { const int i = F.tid + 512 * j, rr = i >> 7, cp = i & 127, row = row0 - 15 + rr;
            const bool ok = (j < 15 || F.tid < 256) && row >= lo && row < hi;
            pv[j] = ok ? *(const unsigned*)(PROJ + (size_t)row * IND + 2 * cp) : 0u; }
    };
    const int T0 = F.G - 1 - F.vcu;
    if (T0 < ntiles) load_tile(T0);
    for (int T = T0; T < ntiles; T += F.G) {
        const int row0 = T * 32;
        __syncthreads();
#pragma unroll
        for (int j = 0; j < 16; ++j) { const int i = F.tid + 512 * j;
            if (j < 15 || F.tid < 256) { f32x2 u; u[0] = bflo(pv[j]); u[1] = bfhi(pv[j]); *(LAS f32x2*)(us + 2 * i) = u; } }
        if (T + F.G < ntiles) load_tile(T + F.G);
        __syncthreads();
        {
            float acc[16];
#pragma unroll
            for (int j = 0; j < 16; ++j) acc[j] = cbias;
            const LAS float* up = us + (16 * half) * 256 + c;
#pragma unroll
            for (int i = 0; i < 46; ++i) { const float x = up[i * 256];
#pragma unroll
                for (int j = 0; j < 16; ++j) if (i - j >= 0 && i - j <= 30) acc[j] += w[i - j] * x; }
#pragma unroll
            for (int j = 0; j < 16; ++j) os[(16 * half + j) * CV_OSROW + c] = acc[j];
        }
        __syncthreads();
        {
            f32x4 v[4];
#pragma unroll
            for (int q = 0; q < 4; ++q) v[q] = *(const LAS f32x4*)(os + lt * CV_OSROW + 16 * lseg + 4 * q);
            float s1 = 0.f;
#pragma unroll
            for (int q = 0; q < 4; ++q) s1 += (v[q][0] + v[q][1]) + (v[q][2] + v[q][3]);
            const float mu = row16_sum(s1) * (1.f / 256.f);
            float s2 = 0.f;
#pragma unroll
            for (int q = 0; q < 4; ++q) { v[q] = v[q] - mu; s2 += (v[q][0] * v[q][0] + v[q][1] * v[q][1]) + (v[q][2] * v[q][2] + v[q][3] * v[q][3]); }
            const float rstd = rsqrtf(row16_sum(s2) * (1.f / 256.f) + EPS);
            unsigned ow[8];
#pragma unroll
            for (int q = 0; q < 4; ++q) { const f32x4 y = v[q] * rstd * lg[q] + lb[q];
                ow[2 * q] = pg8::cvt_pk_bf16(siluf_(y[0]), siluf_(y[1])); ow[2 * q + 1] = pg8::cvt_pk_bf16(siluf_(y[2]), siluf_(y[3])); }
            bf16* op = MIX + (size_t)(row0 + lt) * D + 16 * lseg;
            *(v4u*)op = (v4u){ow[0], ow[1], ow[2], ow[3]}; *(v4u*)(op + 8) = (v4u){ow[4], ow[5], ow[6], ow[7]};
        }
    }
}

typedef short s16x8 __attribute__((ext_vector_type(8)));
typedef short s16x4 __attribute__((ext_vector_type(4)));
constexpr int NA_KROW = 144, NA_VROW = 160;
constexpr int NA_STAGE = 64 * NA_KROW + 64 * NA_VROW, NA_SLOT = 2 * NA_STAGE, NA_OFF_TB = 2 * NA_SLOT;
static_assert(NA_OFF_TB + 2560 <= RING_BYTES, "NA LDS map");
constexpr int NA_ITEMS_LAT = NB * NH * 8, NA_ITEMS_CTX = NB * NH * 2;
struct NaBlk { f32x4 O[4]; f32x4 nm4; float m, lsum; int first; };
__device__ __forceinline__ int na_rs(int r) { int v = r - 4; return v < 0 ? 0 : (v > 24 ? 24 : v); }
__device__ __forceinline__ s16x8 na_scale_q(v4u w, float c) {
    v4u o; o.x = pg8::cvt_pk_bf16(bflo(w.x) * c, bfhi(w.x) * c); o.y = pg8::cvt_pk_bf16(bflo(w.y) * c, bfhi(w.y) * c); o.z = pg8::cvt_pk_bf16(bflo(w.z) * c, bfhi(w.z) * c); o.w = pg8::cvt_pk_bf16(bflo(w.w) * c, bfhi(w.w) * c);
    return __builtin_bit_cast(s16x8, o);
}
__device__ __forceinline__ void na_phase(Frame& F, int l, int nitems, int nav = 0) {
    int LN_ = F.tid & 63; asm volatile("" : "+v"(LN_));
    const bf16* PROJ = WSP(const bf16, WS_PROJ); bf16* MIX = WSP(bf16, WS_MIX);
    LAS float* tb = (LAS float*)(F.lds + NA_OFF_TB);
    const int lane = LN_, q16 = lane & 15, g = lane >> 4;
    const unsigned skey = (unsigned)(F.tid >> 3), spart = (unsigned)(F.tid & 7);
    const float c1 = 0.125f * 1.4426950408889634f;
    struct NaItem { int b, h, ra, qrow0, rsI, nloc, nch, npair, isctx; };
    auto decode = [&](int it, NaItem& I) {
        I.isctx = it >= NA_ITEMS_LAT ? 1 : 0; I.ra = 0; I.rsI = 0; I.nloc = 0;
        if (!I.isctx) { const int r4 = (it + 2 * (it / F.G)) & 7; I.h = (it >> 3) & 7; I.b = it >> 6; const int r0 = 4 * r4; I.ra = r0 + 2 * (F.wave >> 2); I.qrow0 = I.b * SEQ + I.ra * 64 + (F.wave & 3) * 16;
            I.rsI = na_rs(r0); I.nloc = na_rs(r0 + 3) + 8 - I.rsI; }
        else { const int j = it - NA_ITEMS_LAT; const int hf = j & 1; I.h = (j >> 1) & 7; I.b = j >> 4; I.qrow0 = ML + I.b * CTXL + hf * 128 + F.wave * 16; }
        I.nch = I.nloc + 4; I.npair = (I.nch + 1) >> 1;
    };
    auto krow_of = [&](const NaItem& I, int ch) -> int { if (ch > I.nch - 1) ch = I.nch - 1; return ch < I.nloc ? I.b * SEQ + (I.rsI + ch) * 64 : ML + I.b * CTXL + (ch - I.nloc) * 64; };
    const int jq = F.wave & 3;
    const int o0 = jq == 0 ? 0 : 16 * jq - 8, o1 = jq == 0 ? 16 : (jq == 3 ? 48 : 16 * jq + 8);
    float madd[2][4]; int lb[2];
    {
        const int qc = jq * 16 + q16; int cs = qc - 8; cs = cs < 0 ? 0 : (cs > 48 ? 48 : cs);
#pragma unroll
        for (int e = 0; e < 4; ++e) { const int k0 = o0 + 4 * g + e, k1 = o1 + 4 * g + e;
            madd[0][e] = ((unsigned)(k0 - cs) < 16u) ? 0.f : -1.0e30f;
            madd[1][e] = (((unsigned)(k1 - cs) < 16u) && !(jq == 3 && k1 < 56)) ? 0.f : -1.0e30f; }
        lb[0] = 64 + o0 + 4 * g - qc + 15; lb[1] = 64 + o1 + 4 * g - qc + 15;
    }
    v4u kr0, vr0, kr1, vr1, qrA[2], qrB[2];
    auto issue_first = [&](const NaItem& I) {
        const bf16* Pk = PROJ + 1024 + I.h * HD + 8 * spart, * Pv = PROJ + 1536 + I.h * HD + 8 * spart, * Pq = PROJ + 512 + I.h * HD;
        kr0 = *(const v4u*)(Pk + (size_t)(krow_of(I, 0) + (int)skey) * IND); vr0 = *(const v4u*)(Pv + (size_t)(krow_of(I, 0) + (int)skey) * IND);
        kr1 = *(const v4u*)(Pk + (size_t)(krow_of(I, 1) + (int)skey) * IND); vr1 = *(const v4u*)(Pv + (size_t)(krow_of(I, 1) + (int)skey) * IND);
#pragma unroll
        for (int s_ = 0; s_ < 2; ++s_) { qrA[s_] = *(const v4u*)(Pq + (size_t)(I.qrow0 + q16) * IND + 32 * s_ + 8 * g);
            qrB[s_] = I.isctx ? qrA[s_] : *(const v4u*)(Pq + (size_t)(I.qrow0 + 64 + q16) * IND + 32 * s_ + 8 * g); }
    };
    NaItem I; int it = F.vcu; bool have = it < nitems; int tb_h = -1;
    if (have) { decode(it, I); issue_first(I); }
    while (have) {
        const bool isctx = I.isctx != 0;
        const int ra = I.ra, rsI = I.rsI, nloc = I.nloc, nch = I.nch, npair = I.npair, qrow0 = I.qrow0, h = I.h;
        const bf16* Pk = PROJ + 1024 + h * HD + 8 * spart, * Pv = PROJ + 1536 + h * HD + 8 * spart;
        s16x8 qfA[2], qfB[2];
#pragma unroll
        for (int s_ = 0; s_ < 2; ++s_) { qfA[s_] = na_scale_q(qrA[s_], c1); qfB[s_] = na_scale_q(qrB[s_], c1); }
        const int rsA = na_rs(ra), rsB = na_rs(ra + 1);
        NaItem N; const int itn = it + F.G; const bool haven = itn < nitems; if (haven) decode(itn, N); else N = I;
        __syncthreads();
        if (!isctx && h != tb_h) { const float* rpb = INP(14) + ((size_t)l * NH + h) * 15 * 31; tb_h = h;
            for (int i = F.tid; i < 640; i += NWAVES * 64) tb[i] = (i >= 64 && i < 64 + 465) ? rpb[i - 64] * 1.4426950408889634f : 0.f; }
        {
            LAS unsigned char* s0 = F.lds;
            *(LAS v4u*)(s0 + skey * NA_KROW + spart * 16) = kr0; *(LAS v4u*)(s0 + 64 * NA_KROW + skey * NA_VROW + spart * 16) = vr0;
            *(LAS v4u*)(s0 + NA_STAGE + skey * NA_KROW + spart * 16) = kr1; *(LAS v4u*)(s0 + NA_STAGE + 64 * NA_KROW + skey * NA_VROW + spart * 16) = vr1;
        }
        if (npair > 2) {
            kr0 = *(const v4u*)(Pk + (size_t)(krow_of(I, 2) + (int)skey) * IND); vr0 = *(const v4u*)(Pv + (size_t)(krow_of(I, 2) + (int)skey) * IND);
            kr1 = *(const v4u*)(Pk + (size_t)(krow_of(I, 3) + (int)skey) * IND); vr1 = *(const v4u*)(Pv + (size_t)(krow_of(I, 3) + (int)skey) * IND);
        } else {
            kr0 = *(const v4u*)(Pk + (size_t)(krow_of(I, 2) + (int)skey) * IND); vr0 = *(const v4u*)(Pv + (size_t)(krow_of(I, 2) + (int)skey) * IND);
            kr1 = *(const v4u*)(Pk + (size_t)(krow_of(I, 3) + (int)skey) * IND); vr1 = *(const v4u*)(Pv + (size_t)(krow_of(I, 3) + (int)skey) * IND);
        }
        NaBlk A, B;
#pragma unroll
        for (int dt = 0; dt < 4; ++dt) { A.O[dt] = (f32x4){0.f, 0.f, 0.f, 0.f}; B.O[dt] = (f32x4){0.f, 0.f, 0.f, 0.f}; }
        A.m = 0.f; A.lsum = 0.f; A.first = 1; B.m = 0.f; B.lsum = 0.f; B.first = 1; A.nm4 = (f32x4){0.f, 0.f, 0.f, 0.f}; B.nm4 = (f32x4){0.f, 0.f, 0.f, 0.f};
        for (int cp = 0; cp < npair; ++cp) {
            __syncthreads();
            if (cp + 1 < npair) { LAS unsigned char* nx = F.lds + ((cp + 1) & 1) * NA_SLOT;
                *(LAS v4u*)(nx + skey * NA_KROW + spart * 16) = kr0; *(LAS v4u*)(nx + 64 * NA_KROW + skey * NA_VROW + spart * 16) = vr0;
                *(LAS v4u*)(nx + NA_STAGE + skey * NA_KROW + spart * 16) = kr1; *(LAS v4u*)(nx + NA_STAGE + 64 * NA_KROW + skey * NA_VROW + spart * 16) = vr1; }
            if (cp + 2 < npair) { const int k2 = krow_of(I, 2 * cp + 4) + (int)skey, k3 = krow_of(I, 2 * cp + 5) + (int)skey;
                kr0 = *(const v4u*)(Pk + (size_t)k2 * IND); vr0 = *(const v4u*)(Pv + (size_t)k2 * IND); kr1 = *(const v4u*)(Pk + (size_t)k3 * IND); vr1 = *(const v4u*)(Pv + (size_t)k3 * IND); }
            else if (cp + 2 == npair && haven) issue_first(N);
          for (int sub = 0; sub < 2; ++sub) {
            const int ch = 2 * cp + sub;
            if (ch >= nch) break;
            LAS unsigned char* cur = F.lds + (cp & 1) * NA_SLOT + sub * NA_STAGE;
            const bool local = ch < nloc;
            const int kr = rsI + ch;
            const bool actA = !local || (kr >= rsA && kr <= rsA + 7), actB = !isctx && (!local || (kr >= rsB && kr <= rsB + 7));
            if ((!actA && !actB) || nav == 1) continue;
            auto fix = [&](f32x4* S, int nt_, NaBlk& X, float cm) __attribute__((always_inline)) {
                cm = fmaxf(cm, __shfl_xor(cm, 16)); cm = fmaxf(cm, __shfl_xor(cm, 32));
                const float d = X.first ? cm : fmaxf(cm, 0.f);
                if (!X.first) { const float alpha = __builtin_amdgcn_exp2f(-d); X.lsum *= alpha;
#pragma unroll
                    for (int dt = 0; dt < 4; ++dt)
#pragma unroll
                        for (int e = 0; e < 4; ++e) { float o_ = X.O[dt][e]; asm("v_mul_f32 %0, %0, %1" : "+v"(o_) : "v"(alpha)); X.O[dt][e] = o_; } }
                X.m += d; X.first = 0;
#pragma unroll
                for (int e = 0; e < 4; ++e) { float n_ = X.nm4[e]; asm("v_sub_f32 %0, %0, %1" : "+v"(n_) : "v"(d)); X.nm4[e] = n_; }
#pragma unroll
                for (int t = 0; t < 4; ++t) if (t < nt_) S[t] = S[t] - d;
            };
            auto probs = [&](f32x4* S, int nt_, NaBlk& X, unsigned (*pk)[2]) __attribute__((always_inline)) {
                float ps = 0.f;
#pragma unroll
                for (int t = 0; t < 4; ++t) if (t < nt_) {
                    const float p0 = __builtin_amdgcn_exp2f(S[t][0]), p1 = __builtin_amdgcn_exp2f(S[t][1]), p2 = __builtin_amdgcn_exp2f(S[t][2]), p3 = __builtin_amdgcn_exp2f(S[t][3]);
                    ps += (p0 + p1) + (p2 + p3);
                    pk[t][0] = pg8::cvt_pk_bf16(p0, p1); pk[t][1] = pg8::cvt_pk_bf16(p2, p3); }
                X.lsum += ps;
            };
            auto finish = [&](f32x4* S, int nt_, NaBlk& X, unsigned (*pk)[2], float cm) __attribute__((always_inline)) {
                if (__builtin_expect(X.first || !__all(cm <= 8.f), 0)) fix(S, nt_, X, cm);
                probs(S, nt_, X, pk);
            };
            auto finish2 = [&](f32x4* SA, f32x4* SB, int nt_, unsigned (*pa)[2], unsigned (*pb)[2], float cmA, float cmB) __attribute__((always_inline)) {
                if (__builtin_expect(A.first || B.first || !__all(fmaxf(cmA, cmB) <= 8.f), 0)) {
                    if (A.first || !__all(cmA <= 8.f)) fix(SA, nt_, A, cmA);
                    if (B.first || !__all(cmB <= 8.f)) fix(SB, nt_, B, cmB);
                }
                probs(SA, nt_, A, pa); probs(SB, nt_, B, pb);
            };
            auto bias_local = [&](f32x4 (&S)[2], int rq) __attribute__((always_inline)) -> float {
                float cm = -1.0e30f;
#pragma unroll
                for (int t = 0; t < 2; ++t) { const LAS float* tr_ = tb + (kr - rq + 7) * 31 + lb[t];
#pragma unroll
                    for (int e = 0; e < 4; ++e) { const float v = (S[t][e] + tr_[e]) + madd[t][e]; S[t][e] = v; cm = fmaxf(cm, v); } }
                return cm;
            };
            auto max_ctx = [&](f32x4 (&S)[4]) __attribute__((always_inline)) -> float {
                float cm = -1.0e30f;
#pragma unroll
                for (int t = 0; t < 4; ++t)
#pragma unroll
                    for (int e = 0; e < 4; ++e) cm = fmaxf(cm, S[t][e]);
                return cm;
            };
            const LAS unsigned char* kb_ = cur + q16 * NA_KROW + 16 * g;
            const LAS unsigned char* vtr = cur + 64 * NA_KROW + (4 * g + (q16 >> 2)) * NA_VROW + (q16 & 3) * 8;
            auto local_both = [&]() __attribute__((always_inline)) {
                unsigned pkA[4][2], pkB[4][2];
                f32x4 SA[2], SB[2];
                s16x8 kf[2][2];
#pragma unroll
                for (int t = 0; t < 2; ++t) { const int o = t == 0 ? o0 : o1;
#pragma unroll
                    for (int s_ = 0; s_ < 2; ++s_) kf[t][s_] = *(const LAS s16x8*)(kb_ + o * NA_KROW + 64 * s_); }
#pragma unroll
                for (int t = 0; t < 2; ++t) { SA[t] = __builtin_amdgcn_mfma_f32_16x16x32_bf16(kf[t][0], qfA[0], A.nm4, 0, 0, 0); SB[t] = __builtin_amdgcn_mfma_f32_16x16x32_bf16(kf[t][0], qfB[0], B.nm4, 0, 0, 0); }
#pragma unroll
                for (int t = 0; t < 2; ++t) { SA[t] = __builtin_amdgcn_mfma_f32_16x16x32_bf16(kf[t][1], qfA[1], SA[t], 0, 0, 0); SB[t] = __builtin_amdgcn_mfma_f32_16x16x32_bf16(kf[t][1], qfB[1], SB[t], 0, 0, 0); }
                if (nav == 2) { asm volatile("" :: "v"(SA[0]), "v"(SA[1]), "v"(SB[0]), "v"(SB[1])); return; }
                const float cmA = bias_local(SA, ra), cmB = bias_local(SB, ra + 1);
                finish2(SA, SB, 2, pkA, pkB, cmA, cmB);
                if (nav == 3) { asm volatile("" :: "v"(pkA[0][0]), "v"(pkA[1][1]), "v"(pkB[0][0]), "v"(pkB[1][1])); return; }
                const v4u bwA = {pkA[0][0], pkA[0][1], pkA[1][0], pkA[1][1]}, bwB = {pkB[0][0], pkB[0][1], pkB[1][0], pkB[1][1]};
                const s16x8 bfA = __builtin_bit_cast(s16x8, bwA), bfB = __builtin_bit_cast(s16x8, bwB);
#pragma unroll
                for (int dt = 0; dt < 4; ++dt) {
                    const s16x4 a0 = __builtin_amdgcn_ds_read_tr16_b64_v4i16((LAS s16x4*)(vtr + o0 * NA_VROW + dt * 32));
                    const s16x4 a1 = __builtin_amdgcn_ds_read_tr16_b64_v4i16((LAS s16x4*)(vtr + o1 * NA_VROW + dt * 32));
                    const s16x8 afrag = __builtin_shufflevector(a0, a1, 0, 1, 2, 3, 4, 5, 6, 7);
                    A.O[dt] = __builtin_amdgcn_mfma_f32_16x16x32_bf16(afrag, bfA, A.O[dt], 0, 0, 0);
                    B.O[dt] = __builtin_amdgcn_mfma_f32_16x16x32_bf16(afrag, bfB, B.O[dt], 0, 0, 0);
                }
            };
            auto local_one = [&](NaBlk& X, const s16x8 (&qf)[2], int rq) __attribute__((always_inline)) {
                unsigned pk[4][2];
                f32x4 S[2];
#pragma unroll
                for (int t = 0; t < 2; ++t) { S[t] = X.nm4;
                    const int o = t == 0 ? o0 : o1;
#pragma unroll
                    for (int s_ = 0; s_ < 2; ++s_) { const s16x8 kf = *(const LAS s16x8*)(kb_ + o * NA_KROW + 64 * s_);
                        S[t] = __builtin_amdgcn_mfma_f32_16x16x32_bf16(kf, qf[s_], S[t], 0, 0, 0); } }
                if (nav == 2) { asm volatile("" :: "v"(S[0]), "v"(S[1])); return; }
                const float cm = bias_local(S, rq);
                finish(S, 2, X, pk, cm);
                if (nav == 3) { asm volatile("" :: "v"(pk[0][0]), "v"(pk[1][1])); return; }
                const v4u bw = {pk[0][0], pk[0][1], pk[1][0], pk[1][1]};
                const s16x8 bf = __builtin_bit_cast(s16x8, bw);
#pragma unroll
                for (int dt = 0; dt < 4; ++dt) {
                    const s16x4 a0 = __builtin_amdgcn_ds_read_tr16_b64_v4i16((LAS s16x4*)(vtr + o0 * NA_VROW + dt * 32));
                    const s16x4 a1 = __builtin_amdgcn_ds_read_tr16_b64_v4i16((LAS s16x4*)(vtr + o1 * NA_VROW + dt * 32));
                    const s16x8 afrag = __builtin_shufflevector(a0, a1, 0, 1, 2, 3, 4, 5, 6, 7);
                    X.O[dt] = __builtin_amdgcn_mfma_f32_16x16x32_bf16(afrag, bf, X.O[dt], 0, 0, 0);
                }
            };
            auto ctx_both = [&]() __attribute__((always_inline)) {
                unsigned pkA[4][2], pkB[4][2];
                f32x4 SA[4], SB[4];
                { s16x8 kf[4][2];
#pragma unroll
                  for (int t = 0; t < 4; ++t)
#pragma unroll
                      for (int s_ = 0; s_ < 2; ++s_) kf[t][s_] = *(const LAS s16x8*)(kb_ + t * 16 * NA_KROW + 64 * s_);
#pragma unroll
                  for (int t = 0; t < 4; ++t) { SA[t] = __builtin_amdgcn_mfma_f32_16x16x32_bf16(kf[t][0], qfA[0], A.nm4, 0, 0, 0); SB[t] = __builtin_amdgcn_mfma_f32_16x16x32_bf16(kf[t][0], qfB[0], B.nm4, 0, 0, 0); }
#pragma unroll
                  for (int t = 0; t < 4; ++t) { SA[t] = __builtin_amdgcn_mfma_f32_16x16x32_bf16(kf[t][1], qfA[1], SA[t], 0, 0, 0); SB[t] = __builtin_amdgcn_mfma_f32_16x16x32_bf16(kf[t][1], qfB[1], SB[t], 0, 0, 0); } }
                if (nav == 2) { asm volatile("" :: "v"(SA[0]), "v"(SA[1]), "v"(SA[2]), "v"(SA[3]), "v"(SB[0]), "v"(SB[1]), "v"(SB[2]), "v"(SB[3])); return; }
                const float cmA = max_ctx(SA), cmB = max_ctx(SB);
                finish2(SA, SB, 4, pkA, pkB, cmA, cmB);
                if (nav == 3) { asm volatile("" :: "v"(pkA[0][0]), "v"(pkA[1][1]), "v"(pkA[2][0]), "v"(pkA[3][1]), "v"(pkB[0][0]), "v"(pkB[1][1]), "v"(pkB[2][0]), "v"(pkB[3][1])); return; }
#pragma unroll
                for (int p = 0; p < 2; ++p) {
                    const v4u bwA = {pkA[2 * p][0], pkA[2 * p][1], pkA[2 * p + 1][0], pkA[2 * p + 1][1]}, bwB = {pkB[2 * p][0], pkB[2 * p][1], pkB[2 * p + 1][0], pkB[2 * p + 1][1]};
                    const s16x8 bfA = __builtin_bit_cast(s16x8, bwA), bfB = __builtin_bit_cast(s16x8, bwB);
#pragma unroll
                    for (int dt = 0; dt < 4; ++dt) {
                        const s16x4 a0 = __builtin_amdgcn_ds_read_tr16_b64_v4i16((LAS s16x4*)(vtr + (2 * p) * 16 * NA_VROW + dt * 32));
                        const s16x4 a1 = __builtin_amdgcn_ds_read_tr16_b64_v4i16((LAS s16x4*)(vtr + (2 * p + 1) * 16 * NA_VROW + dt * 32));
                        const s16x8 afrag = __builtin_shufflevector(a0, a1, 0, 1, 2, 3, 4, 5, 6, 7);
                        A.O[dt] = __builtin_amdgcn_mfma_f32_16x16x32_bf16(afrag, bfA, A.O[dt], 0, 0, 0);
                        B.O[dt] = __builtin_amdgcn_mfma_f32_16x16x32_bf16(afrag, bfB, B.O[dt], 0, 0, 0);
                    }
                }
            };
            auto ctx_one = [&]() __attribute__((always_inline)) {
                unsigned pk[4][2];
                f32x4 S[4];
#pragma unroll
                for (int t = 0; t < 4; ++t) { S[t] = A.nm4;
#pragma unroll
                    for (int s_ = 0; s_ < 2; ++s_) { const s16x8 kf = *(const LAS s16x8*)(kb_ + t * 16 * NA_KROW + 64 * s_);
                        S[t] = __builtin_amdgcn_mfma_f32_16x16x32_bf16(kf, qfA[s_], S[t], 0, 0, 0); } }
                if (nav == 2) { asm volatile("" :: "v"(S[0]), "v"(S[1]), "v"(S[2]), "v"(S[3])); return; }
                const float cm = max_ctx(S);
                finish(S, 4, A, pk, cm);
                if (nav == 3) { asm volatile("" :: "v"(pk[0][0]), "v"(pk[1][1]), "v"(pk[2][0]), "v"(pk[3][1])); return; }
#pragma unroll
                for (int p = 0; p < 2; ++p) {
                    const v4u bw = {pk[2 * p][0], pk[2 * p][1], pk[2 * p + 1][0], pk[2 * p + 1][1]};
                    const s16x8 bf = __builtin_bit_cast(s16x8, bw);
#pragma unroll
                    for (int dt = 0; dt < 4; ++dt) {
                        const s16x4 a0 = __builtin_amdgcn_ds_read_tr16_b64_v4i16((LAS s16x4*)(vtr + (2 * p) * 16 * NA_VROW + dt * 32));
                        const s16x4 a1 = __builtin_amdgcn_ds_read_tr16_b64_v4i16((LAS s16x4*)(vtr + (2 * p + 1) * 16 * NA_VROW + dt * 32));
                        const s16x8 afrag = __builtin_shufflevector(a0, a1, 0, 1, 2, 3, 4, 5, 6, 7);
                        A.O[dt] = __builtin_amdgcn_mfma_f32_16x16x32_bf16(afrag, bf, A.O[dt], 0, 0, 0);
                    }
                }
            };
            if (local) { if (actA && actB) local_both(); else if (actA) local_one(A, qfA, ra); else local_one(B, qfB, ra + 1); }
            else { if (actB) ctx_both(); else ctx_one(); }
          }
        }
        {
            float ls = A.lsum; ls += __shfl_xor(ls, 16); ls += __shfl_xor(ls, 32);
            const float inv = __builtin_amdgcn_rcpf(ls);
            unsigned ooff = (unsigned)((q16 * D + 4 * g) * 2); asm volatile("" : "+v"(ooff));
            unsigned char* op = (unsigned char*)(MIX + (size_t)qrow0 * D + 256 + h * HD);
#pragma unroll
            for (int dt = 0; dt < 4; ++dt) { v2u w; w.x = pg8::cvt_pk_bf16(A.O[dt][0] * inv, A.O[dt][1] * inv); w.y = pg8::cvt_pk_bf16(A.O[dt][2] * inv, A.O[dt][3] * inv); *(v2u*)(op + (ooff + (unsigned)(32 * dt))) = w; }
        }
        if (!isctx) {
            float ls = B.lsum; ls += __shfl_xor(ls, 16); ls += __shfl_xor(ls, 32);
            const float inv = __builtin_amdgcn_rcpf(ls);
            unsigned ooff = (unsigned)((q16 * D + 4 * g) * 2); asm volatile("" : "+v"(ooff));
            unsigned char* op = (unsigned char*)(MIX + (size_t)(qrow0 + 64) * D + 256 + h * HD);
#pragma unroll
            for (int dt = 0; dt < 4; ++dt) { v2u w; w.x = pg8::cvt_pk_bf16(B.O[dt][0] * inv, B.O[dt][1] * inv); w.y = pg8::cvt_pk_bf16(B.O[dt][2] * inv, B.O[dt][3] * inv); *(v2u*)(op + (ooff + (unsigned)(32 * dt))) = w; }
        }
        it = itn; have = haven; I = N;
    }
}

constexpr int LRU_UCROW = 260;
constexpr int LRU_OFF_UC = 38 * 256 * 2, LRU_OFF_GT = LRU_OFF_UC + 2 * 32 * LRU_UCROW * 4;
static_assert(LRU_OFF_GT + 32 * 256 * 2 <= RING_BYTES, "LRU LDS map");
template <int PASS>
__device__ __forceinline__ void lru_phase(Frame& F, int l, int ntiles) {
    int LN_ = F.tid & 63; asm volatile("" : "+v"(LN_));
    const bf16* PROJ = WSP(const bf16, WS_PROJ);
    LAS bf16* rxs = (LAS bf16*)(F.lds);
    LAS float* ucf = (LAS float*)(F.lds + LRU_OFF_UC);
    LAS bf16* gts = (LAS bf16*)(F.lds + LRU_OFF_GT);
    const int lane = LN_, j16 = lane & 15, g = lane >> 4;
    const int kb = F.wave & 3, nh = F.wave >> 2;
    s16x8 wf[2][2][2][2];
    float cbx[2][2], cba[2][2], csp[2][2];
#pragma unroll
    for (int dir = 0; dir < 2; ++dir) {
        const int ld = l * 2 + dir;
        const bf16* WLR = WSP(const bf16, WS_WLR) + (size_t)((ld * 4 + kb) * 2) * 4096;
#pragma unroll
        for (int gt = 0; gt < 2; ++gt)
#pragma unroll
            for (int n2 = 0; n2 < 2; ++n2)
#pragma unroll
                for (int s_ = 0; s_ < 2; ++s_) wf[dir][gt][n2][s_] = *(const s16x8*)(WLR + gt * 4096 + (16 * (2 * nh + n2) + j16) * 64 + 32 * s_ + 8 * g);
#pragma unroll
        for (int n2 = 0; n2 < 2; ++n2) {
            const int e = kb * 64 + 16 * (2 * nh + n2) + j16, idx = ld * 256 + e;
            cbx[dir][n2] = INP(18)[idx]; cba[dir][n2] = INP(20)[idx];
            const float nl = -INP(21)[idx]; csp[dir][n2] = -8.f * (fmaxf(nl, 0.f) + log1pf(__expf(-fabsf(nl))));
        }
    }
    const int c = F.tid & 255, sdir = F.tid >> 8;
    const int sld = l * 2 + sdir;
    const float s1w0 = INP(15)[(sld * 4 + 0) * 256 + c], s1w1 = INP(15)[(sld * 4 + 1) * 256 + c], s1w2 = INP(15)[(sld * 4 + 2) * 256 + c], s1w3 = INP(15)[(sld * 4 + 3) * 256 + c], s1cb = INP(16)[sld * 256 + c];
    const int base = sdir == 0 ? 0 : 3;
    unsigned pre[10], pgw[8];
    auto load_tile = [&](int T) {
        const int row0 = T * 32;
        int lo, hi; if (row0 < ML) { lo = row0 & ~(SEQ - 1); hi = lo + SEQ; } else { lo = row0 & ~(CTXL - 1); hi = lo + CTXL; }
#pragma unroll
        for (int j = 0; j < 10; ++j) { const int i = F.tid + 512 * j, rr = i >> 7, cp = i & 127, row = row0 - 3 + rr;
            const bool ok = (j < 9 || F.tid < 256) && row >= lo && row < hi;
            pre[j] = ok ? *(const unsigned*)(PROJ + (size_t)row * IND + 2048 + 2 * cp) : 0u; }
        if (PASS == 1) {
#pragma unroll
            for (int j = 0; j < 8; ++j) { const int i = F.tid + 512 * j, t = i >> 7, cp = i & 127; pgw[j] = *(const unsigned*)(PROJ + (size_t)(row0 + t) * IND + 2304 + 2 * cp); }
        }
    };
    if (F.vcu < ntiles) load_tile(F.vcu);
    for (int T = F.vcu; T < ntiles; T += F.G) {
        const int row0 = T * 32;
        __syncthreads();
#pragma unroll
        for (int j = 0; j < 10; ++j) { const int i = F.tid + 512 * j; if (j < 9 || F.tid < 256) ((LAS unsigned*)rxs)[i] = pre[j]; }
        if (PASS == 1) {
#pragma unroll
            for (int j = 0; j < 8; ++j) ((LAS unsigned*)gts)[F.tid + 512 * j] = pgw[j];
        }
        if (T + F.G < ntiles) load_tile(T + F.G);
        float hst[2][2];
#pragma unroll
        for (int dir = 0; dir < 2; ++dir)
#pragma unroll
            for (int n2 = 0; n2 < 2; ++n2) hst[dir][n2] = PASS == 1 ? WSP(const float, WS_CARRY)[((size_t)dir * 1152 + T) * 256 + kb * 64 + 16 * (2 * nh + n2) + j16] : 0.f;
        __syncthreads();
        {
            float x0 = bf1(rxs[(base + 0) * 256 + c]), x1 = bf1(rxs[(base + 1) * 256 + c]), x2 = bf1(rxs[(base + 2) * 256 + c]);
#pragma unroll 8
            for (int t = 0; t < 32; ++t) {
                const float x3 = bf1(rxs[(t + base + 3) * 256 + c]);
                ucf[(sdir * 32 + t) * LRU_UCROW + c] = s1cb + s1w0 * x0 + s1w1 * x1 + s1w2 * x2 + s1w3 * x3;
                x0 = x1; x1 = x2; x2 = x3;
            }
        }
        __syncthreads();
        float hf[2][2][4];
        float Pt[2][2] = {{1.f, 1.f}, {1.f, 1.f}};
#pragma unroll
        for (int dir = 0; dir < 2; ++dir) {
            const bool sec16 = ((g & 1) != 0) != (dir != 0), sec32 = ((g >> 1) != 0) != (dir != 0);
#pragma unroll
            for (int step = 0; step < 2; ++step) {
                const int rt = dir == 0 ? step : 1 - step;
                s16x8 af[2];
#pragma unroll
                for (int s_ = 0; s_ < 2; ++s_) { const LAS float* up = ucf + (dir * 32 + 16 * rt + j16) * LRU_UCROW + kb * 64 + 32 * s_ + 8 * g;
                    const f32x4 u0 = *(const LAS f32x4*)up, u1 = *(const LAS f32x4*)(up + 4);
                    const v4u w = {pg8::cvt_pk_bf16(u0[0], u0[1]), pg8::cvt_pk_bf16(u0[2], u0[3]), pg8::cvt_pk_bf16(u1[0], u1[1]), pg8::cvt_pk_bf16(u1[2], u1[3])};
                    af[s_] = __builtin_bit_cast(s16x8, w); }
#pragma unroll
                for (int n2 = 0; n2 < 2; ++n2) {
                    f32x4 zx = {0.f, 0.f, 0.f, 0.f}, za = {0.f, 0.f, 0.f, 0.f};
#pragma unroll
                    for (int s_ = 0; s_ < 2; ++s_) { zx = __builtin_amdgcn_mfma_f32_16x16x32_bf16(af[s_], wf[dir][0][n2][s_], zx, 0, 0, 0); za = __builtin_amdgcn_mfma_f32_16x16x32_bf16(af[s_], wf[dir][1][n2][s_], za, 0, 0, 0); }
                    const int e = kb * 64 + 16 * (2 * nh + n2) + j16;
                    const LAS float* uo = ucf + (dir * 32 + 16 * rt + 4 * g) * LRU_UCROW + e;
                    float a_[4], b_[4]; unsigned abw[4];
#pragma unroll
                    for (int r = 0; r < 4; ++r) {
                        const float u = uo[r * LRU_UCROW];
                        const float gx = sigmoidf_(zx[r] + cbx[dir][n2]), ga = sigmoidf_(za[r] + cba[dir][n2]);
                        const float la = csp[dir][n2] * ga, a = __builtin_amdgcn_exp2f(1.4426950408889634f * la), y = 2.f * la;
                        const float om = y > -0.02f ? -y * (1.f + y * (0.5f + y * 0.16666667f)) : 1.f - a * a;
                        a_[r] = a; b_[r] = __builtin_amdgcn_sqrtf(om) * gx * u;
                        if (PASS == 0) {
                            const float oma = la > -0.02f ? -la * (1.f + la * (0.5f + la * 0.16666667f)) : 1.f - a;
                            abw[r] = pg8::cvt_pk_bf16(oma, b_[r]); a_[r] = 1.f - bflo(abw[r]); b_[r] = bfhi(abw[r]);
                        }
                    }
                    if (PASS == 0) WSP(v4u, WS_AB)[(((((size_t)T * 2 + dir) * 2 + rt) * 8 + F.wave) * 2 + n2) * 64 + lane] = (v4u){abw[0], abw[1], abw[2], abw[3]};
                    const float P = (a_[0] * a_[1]) * (a_[2] * a_[3]);
                    const float S = dir == 0 ? ((b_[0] * a_[1] + b_[1]) * a_[2] + b_[2]) * a_[3] + b_[3] : ((b_[3] * a_[2] + b_[2]) * a_[1] + b_[1]) * a_[0] + b_[0];
                    const float Pp = __shfl_xor(P, 16), Sp = __shfl_xor(S, 16);
                    const float e1P = sec16 ? Pp : 1.f, e1S = sec16 ? Sp : 0.f;
                    const float prP = P * Pp, prS = sec16 ? P * Sp + S : Pp * S + Sp;
                    const float Pq = __shfl_xor(prP, 32), Sq = __shfl_xor(prS, 32);
                    const float EP = sec32 ? Pq * e1P : e1P, ES = sec32 ? e1P * Sq + e1S : e1S;
                    const float TP = prP * Pq, TS = sec32 ? prP * Sq + prS : Pq * prS + Sq;
                    if (PASS == 1) {
                        float h = EP * hst[dir][n2] + ES;
                        if (dir == 0) {
#pragma unroll
                            for (int r = 0; r < 4; ++r) { h = a_[r] * h + b_[r]; hf[rt][n2][r] = h; }
                        } else {
                            float hb[4];
#pragma unroll
                            for (int r = 3; r >= 0; --r) { h = a_[r] * h + b_[r]; hb[r] = h; }
                            bf16* mp = WSP(bf16, WS_MIX) + (size_t)(row0 + 16 * rt + 4 * g) * D + 768 + e;
                            const LAS bf16* gp = gts + (16 * rt + 4 * g) * 256 + e;
#pragma unroll
                            for (int r = 0; r < 4; ++r) mp[(size_t)r * D] = (bf16)f2bf(gelu_tanh(bf1(gp[r * 256])) * (hf[rt][n2][r] + hb[r]));
                        }
                    } else Pt[dir][n2] *= TP;
                    hst[dir][n2] = TP * hst[dir][n2] + TS;
                }
            }
        }
        if (PASS == 0 && g == 0) {
#pragma unroll
            for (int dir = 0; dir < 2; ++dir)
#pragma unroll
                for (int n2 = 0; n2 < 2; ++n2) WSP(f32x2, WS_TOT)[((size_t)dir * 1152 + T) * 256 + kb * 64 + 16 * (2 * nh + n2) + j16] = (f32x2){Pt[dir][n2], hst[dir][n2]};
        }
    }
}
__device__ __forceinline__ void lru_scan_phase(Frame& F, int l, int ntiles) {
    int LN_ = F.tid & 63; asm volatile("" : "+v"(LN_));
    const bf16* PROJ = WSP(const bf16, WS_PROJ);
    LAS bf16* gts = (LAS bf16*)(F.lds);
    const int lane = LN_, j16 = lane & 15, g = lane >> 4;
    const int kb = F.wave & 3, nh = F.wave >> 2;
    const v4u* AB = WSP(const v4u, WS_AB);
    v4u pab[2][2][2]; unsigned pgw[8];
    auto load_tile = [&](int T) {
#pragma unroll
        for (int dir = 0; dir < 2; ++dir)
#pragma unroll
            for (int rt = 0; rt < 2; ++rt)
#pragma unroll
                for (int n2 = 0; n2 < 2; ++n2) pab[dir][rt][n2] = AB[(((((size_t)T * 2 + dir) * 2 + rt) * 8 + F.wave) * 2 + n2) * 64 + lane];
#pragma unroll
        for (int j = 0; j < 8; ++j) { const int i = F.tid + 512 * j, t = i >> 7, cp = i & 127; pgw[j] = *(const unsigned*)(PROJ + (size_t)(T * 32 + t) * IND + 2304 + 2 * cp); }
    };
    if (F.vcu < ntiles) load_tile(F.vcu);
    for (int T = F.vcu; T < ntiles; T += F.G) {
        const int row0 = T * 32;
        __syncthreads();
#pragma unroll
        for (int j = 0; j < 8; ++j) ((LAS unsigned*)gts)[F.tid + 512 * j] = pgw[j];
        v4u cur[2][2][2];
#pragma unroll
        for (int dir = 0; dir < 2; ++dir)
#pragma unroll
            for (int rt = 0; rt < 2; ++rt)
#pragma unroll
                for (int n2 = 0; n2 < 2; ++n2) cur[dir][rt][n2] = pab[dir][rt][n2];
        float hst[2][2];
#pragma unroll
        for (int dir = 0; dir < 2; ++dir)
#pragma unroll
            for (int n2 = 0; n2 < 2; ++n2) hst[dir][n2] = WSP(const float, WS_CARRY)[((size_t)dir * 1152 + T) * 256 + kb * 64 + 16 * (2 * nh + n2) + j16];
        if (T + F.G < ntiles) load_tile(T + F.G);
        __syncthreads();
        float hf[2][2][4];
#pragma unroll
        for (int dir = 0; dir < 2; ++dir) {
            const bool sec16 = ((g & 1) != 0) != (dir != 0), sec32 = ((g >> 1) != 0) != (dir != 0);
#pragma unroll
            for (int step = 0; step < 2; ++step) {
                const int rt = dir == 0 ? step : 1 - step;
#pragma unroll
                for (int n2 = 0; n2 < 2; ++n2) {
                    const int e = kb * 64 + 16 * (2 * nh + n2) + j16;
                    const v4u w = cur[dir][rt][n2];
                    const float a_[4] = {1.f - bflo(w.x), 1.f - bflo(w.y), 1.f - bflo(w.z), 1.f - bflo(w.w)}, b_[4] = {bfhi(w.x), bfhi(w.y), bfhi(w.z), bfhi(w.w)};
                    const float P = (a_[0] * a_[1]) * (a_[2] * a_[3]);
                    const float S = dir == 0 ? ((b_[0] * a_[1] + b_[1]) * a_[2] + b_[2]) * a_[3] + b_[3] : ((b_[3] * a_[2] + b_[2]) * a_[1] + b_[1]) * a_[0] + b_[0];
                    const float Pp = __shfl_xor(P, 16), Sp = __shfl_xor(S, 16);
                    const float e1P = sec16 ? Pp : 1.f, e1S = sec16 ? Sp : 0.f;
                    const float prP = P * Pp, prS = sec16 ? P * Sp + S : Pp * S + Sp;
                    const float Pq = __shfl_xor(prP, 32), Sq = __shfl_xor(prS, 32);
                    const float EP = sec32 ? Pq * e1P : e1P, ES = sec32 ? e1P * Sq + e1S : e1S;
                    const float TP = prP * Pq, TS = sec32 ? prP * Sq + prS : Pq * prS + Sq;
                    float h = EP * hst[dir][n2] + ES;
                    if (dir == 0) {
#pragma unroll
                        for (int r = 0; r < 4; ++r) { h = a_[r] * h + b_[r]; hf[rt][n2][r] = h; }
                    } else {
                        float hb[4];
#pragma unroll
                        for (int r = 3; r >= 0; --r) { h = a_[r] * h + b_[r]; hb[r] = h; }
                        bf16* mp = WSP(bf16, WS_MIX) + (size_t)(row0 + 16 * rt + 4 * g) * D + 768 + e;
                        const LAS bf16* gp = gts + (16 * rt + 4 * g) * 256 + e;
#pragma unroll
                        for (int r = 0; r < 4; ++r) mp[(size_t)r * D] = (bf16)f2bf(gelu_tanh(bf1(gp[r * 256])) * (hf[rt][n2][r] + hb[r]));
                    }
                    hst[dir][n2] = TP * hst[dir][n2] + TS;
                }
            }
        }
    }
}

constexpr int LQ_WVB = 35 * 128 + 32 * 144;
constexpr int LQ_WV = 72 * 1024;
constexpr int LQ_CH = TBL_OFF;
constexpr int LQ_FL = LQ_CH + 72 * 2 * 16 * 4;
constexpr int LQ_WV2 = LQ_FL + 2 * 72 * 4;
static_assert(LQ_WV + 6 * LQ_WVB <= RING_BYTES && LQ_WV2 + 2 * LQ_WVB <= LDS_BYTES && LQ_WV2 % 16 == 0, "LRU LDS map");
__device__ __forceinline__ void lru_seq_phase(Frame& F, int l, bool last) {
    int LN_ = F.tid & 63; asm volatile("" : "+v"(LN_));
    const bf16* PROJ = WSP(const bf16, WS_PROJ);
    const int lane = LN_, j16 = lane & 15, g = lane >> 4, cpn = lane & 31, hh = lane >> 5;
    LAS unsigned char* wreg = F.lds + (F.wave < 6 ? LQ_WV + F.wave * LQ_WVB : LQ_WV2 + (F.wave - 6) * LQ_WVB);
    LAS unsigned* rx32 = (LAS unsigned*)wreg;
    LAS unsigned char* ucb = wreg + 35 * 128;
    volatile LAS unsigned* cflag = (volatile LAS unsigned*)(F.lds + LQ_FL);
    volatile LAS unsigned* hflag = cflag + 72;
    LAS float* chain = (LAS float*)(F.lds + LQ_CH);
    for (int item = F.vcu; item < NB * 16; item += F.G) {
        const int b = item >> 4, cg = item & 15, kb = cg >> 2, nn = cg & 3;
        __syncthreads();
        if (F.tid < 144) cflag[F.tid] = 0u;
        __syncthreads();
        s16x8 wf[2][2][2]; float cbx[2], cba[2], csp[2]; f32x2 cw[2][4], cb[2];
#pragma unroll
        for (int dir = 0; dir < 2; ++dir) {
            const int ld = l * 2 + dir;
            const bf16* WLR = WSP(const bf16, WS_WLR) + (size_t)((ld * 4 + kb) * 2) * 4096;
#pragma unroll
            for (int gt = 0; gt < 2; ++gt)
#pragma unroll
                for (int s_ = 0; s_ < 2; ++s_) wf[dir][gt][s_] = *(const s16x8*)(WLR + gt * 4096 + (16 * nn + j16) * 64 + 32 * s_ + 8 * g);
            const int idx = ld * 256 + kb * 64 + 16 * nn + j16;
            cbx[dir] = INP(18)[idx]; cba[dir] = INP(20)[idx];
            const float nl = -INP(21)[idx]; csp[dir] = -8.f * 1.4426950408889634f * (fmaxf(nl, 0.f) + log1pf(__expf(-fabsf(nl))));
            const int c0 = kb * 64 + 2 * cpn;
#pragma unroll
            for (int k = 0; k < 4; ++k) cw[dir][k] = (f32x2){INP(15)[(ld * 4 + k) * 256 + c0], INP(15)[(ld * 4 + k) * 256 + c0 + 1]};
            cb[dir] = (f32x2){INP(16)[ld * 256 + c0], INP(16)[ld * 256 + c0 + 1]};
        }
        auto tile_row0 = [&](int s, int dir) -> int { return s < 8 ? ML + b * CTXL + 32 * (dir == 0 ? s : 7 - s) : b * SEQ + 32 * (dir == 0 ? s - 8 : 71 - s); };
        v4u pre[5];
        auto load_rows = [&](int s, int dir) {
            const unsigned roff = (unsigned)(((lane >> 3) * IND + 8 * (lane & 7)) * 2);
            const int lo = s < 8 ? ML + b * CTXL : b * SEQ, hi = lo + (s < 8 ? CTXL : SEQ);
            const int r0 = tile_row0(s, dir) - (dir == 0 ? 3 : 0);
            const unsigned char* rb = (const unsigned char*)(PROJ + (ptrdiff_t)r0 * IND + 2048 + kb * 64);
#pragma unroll
            for (int j = 0; j < 5; ++j) { const int rr = (lane >> 3) + 8 * j, row = r0 + rr;
                const bool ok = rr < 35 && row >= lo && row < hi;
                pre[j] = ok ? *(const v4u*)(rb + (roff + (unsigned)(8 * j * IND * 2))) : (v4u){0u, 0u, 0u, 0u}; }
        };
        load_rows(F.wave, 0);
        for (int s = F.wave; s < 72; s += 8) {
            const bool ctxs = s < 8, comb = ctxs ? s >= 4 : s >= 40, outp = !(last && ctxs);
            float A_[2][2][4], B_[2][2][4], EP[2][2], ES[2][2], TP[2][2], TS[2][2];
#pragma unroll
            for (int dir = 0; dir < 2; ++dir) {
#pragma unroll
                for (int j = 0; j < 5; ++j) { const int rr = (lane >> 3) + 8 * j; if (rr < 35) *(LAS v4u*)(wreg + rr * 128 + 16 * (lane & 7)) = pre[j]; }
                if (dir == 0) load_rows(s, 1); else if (s + 8 < 72) load_rows(s + 8, 0);
                {
                    auto up2 = [](unsigned w) -> f32x2 { return (f32x2){bflo(w), bfhi(w)}; };
                    f32x2 x0 = up2(rx32[(16 * hh + 0) * 32 + cpn]), x1 = up2(rx32[(16 * hh + 1) * 32 + cpn]), x2 = up2(rx32[(16 * hh + 2) * 32 + cpn]);
#pragma unroll
                    for (int t = 0; t < 16; ++t) {
                        const f32x2 x3 = up2(rx32[(16 * hh + t + 3) * 32 + cpn]);
                        const f32x2 acc = cb[dir] + cw[dir][0] * x0 + cw[dir][1] * x1 + cw[dir][2] * x2 + cw[dir][3] * x3;
                        *(LAS unsigned*)(ucb + (16 * hh + t) * 144 + 4 * cpn) = pg8::cvt_pk_bf16(acc[0], acc[1]);
                        x0 = x1; x1 = x2; x2 = x3;
                    }
                }
                const bool sec16 = ((g & 1) != 0) != (dir != 0), sec32 = ((g >> 1) != 0) != (dir != 0);
#pragma unroll
                for (int rt = 0; rt < 2; ++rt) {
                    f32x4 zx = {0.f, 0.f, 0.f, 0.f}, za = {0.f, 0.f, 0.f, 0.f};
#pragma unroll
                    for (int s_ = 0; s_ < 2; ++s_) { const s16x8 af = *(const LAS s16x8*)(ucb + (16 * rt + j16) * 144 + 64 * s_ + 16 * g);
                        zx = __builtin_amdgcn_mfma_f32_16x16x32_bf16(af, wf[dir][0][s_], zx, 0, 0, 0); za = __builtin_amdgcn_mfma_f32_16x16x32_bf16(af, wf[dir][1][s_], za, 0, 0, 0); }
                    float a_[4], b_[4];
#pragma unroll
                    for (int r = 0; r < 4; ++r) {
                        const float u = bf1(*(const LAS bf16*)(ucb + (16 * rt + 4 * g + r) * 144 + 2 * (16 * nn + j16)));
                        const float gx = sigmoidf_(zx[r] + cbx[dir]), ga = sigmoidf_(za[r] + cba[dir]);
                        const float a = __builtin_amdgcn_exp2f(csp[dir] * ga);
                        const float om = __builtin_fmaf(-a, a, 1.f);
                        a_[r] = a; b_[r] = __builtin_amdgcn_sqrtf(om) * gx * u;
                        A_[dir][rt][r] = a_[r]; B_[dir][rt][r] = b_[r];
                    }
                    const float P = (a_[0] * a_[1]) * (a_[2] * a_[3]);
                    const float S = dir == 0 ? ((b_[0] * a_[1] + b_[1]) * a_[2] + b_[2]) * a_[3] + b_[3] : ((b_[3] * a_[2] + b_[2]) * a_[1] + b_[1]) * a_[0] + b_[0];
                    const float Pp = __shfl_xor(P, 16), Sp = __shfl_xor(S, 16);
                    const float e1P = sec16 ? Pp : 1.f, e1S = sec16 ? Sp : 0.f;
                    const float prP = P * Pp, prS = sec16 ? P * Sp + S : Pp * S + Sp;
                    const float Pq = __shfl_xor(prP, 32), Sq = __shfl_xor(prS, 32);
                    EP[dir][rt] = sec32 ? Pq * e1P : e1P; ES[dir][rt] = sec32 ? e1P * Sq + e1S : e1S;
                    TP[dir][rt] = prP * Pq; TS[dir][rt] = sec32 ? prP * Sq + prS : Pq * prS + Sq;
                }
            }
            bf16 gr[2][2][4];
            if (comb && outp) {
                const unsigned goff = (unsigned)((4 * g * IND + j16) * 2);
#pragma unroll
                for (int dir = 0; dir < 2; ++dir) { const unsigned char* gp = (const unsigned char*)(PROJ + (size_t)tile_row0(s, dir) * IND + 2304 + 16 * cg);
#pragma unroll
                    for (int rt = 0; rt < 2; ++rt)
#pragma unroll
                        for (int r = 0; r < 4; ++r) gr[dir][rt][r] = *(const bf16*)(gp + (goff + (unsigned)((16 * rt + r) * IND * 2))); }
            }
            float hin[2] = {0.f, 0.f};
            if (s > 0) {
                while (__builtin_amdgcn_readfirstlane(cflag[s - 1]) == 0u) __builtin_amdgcn_s_sleep(1);
                asm volatile("" ::: "memory");
                hin[0] = chain[((s - 1) * 2 + 0) * 16 + j16]; hin[1] = chain[((s - 1) * 2 + 1) * 16 + j16];
            }
#pragma unroll
            for (int dir = 0; dir < 2; ++dir) { const int rf = dir == 0 ? 0 : 1, rs_ = 1 - rf;
                const float hout = (TP[dir][rf] * TP[dir][rs_]) * hin[dir] + (TP[dir][rs_] * TS[dir][rf] + TS[dir][rs_]);
                if (g == 0) chain[(s * 2 + dir) * 16 + j16] = hout; }
            asm volatile("" ::: "memory");
            cflag[s] = 1u;
            asm volatile("" ::: "memory");
#pragma unroll
            for (int dir = 0; dir < 2; ++dir) { const int rf = dir == 0 ? 0 : 1, rs_ = 1 - rf;
                float hv[2][4];
                { float h = EP[dir][rf] * hin[dir] + ES[dir][rf];
                  if (dir == 0) {
#pragma unroll
                      for (int r = 0; r < 4; ++r) { h = A_[dir][rf][r] * h + B_[dir][rf][r]; hv[rf][r] = h; }
                  } else {
#pragma unroll
                      for (int r = 3; r >= 0; --r) { h = A_[dir][rf][r] * h + B_[dir][rf][r]; hv[rf][r] = h; }
                  } }
                { const float hm = TP[dir][rf] * hin[dir] + TS[dir][rf]; float h = EP[dir][rs_] * hm + ES[dir][rs_];
                  if (dir == 0) {
#pragma unroll
                      for (int r = 0; r < 4; ++r) { h = A_[dir][rs_][r] * h + B_[dir][rs_][r]; hv[rs_][r] = h; }
                  } else {
#pragma unroll
                      for (int r = 3; r >= 0; --r) { h = A_[dir][rs_][r] * h + B_[dir][rs_][r]; hv[rs_][r] = h; }
                  } }
                if (outp) {
                    const int id = s < 8 ? (dir == 0 ? s : 7 - s) : (dir == 0 ? s : 79 - s);
                    LAS v4u* hb = (LAS v4u*)(F.lds + id * 1024 + lane * 16);
                    if (!comb) {
                        *hb = (v4u){pg8::cvt_pk_bf16(hv[0][0], hv[0][1]), pg8::cvt_pk_bf16(hv[0][2], hv[0][3]), pg8::cvt_pk_bf16(hv[1][0], hv[1][1]), pg8::cvt_pk_bf16(hv[1][2], hv[1][3])};
                        asm volatile("" ::: "memory");
                        hflag[id] = 1u;
                        asm volatile("" ::: "memory");
                    } else {
                        while (__builtin_amdgcn_readfirstlane(hflag[id]) == 0u) __builtin_amdgcn_s_sleep(1);
                        asm volatile("" ::: "memory");
                        const v4u o = *hb;
                        const float ot[2][4] = {{bflo(o.x), bfhi(o.x), bflo(o.y), bfhi(o.y)}, {bflo(o.z), bfhi(o.z), bflo(o.w), bfhi(o.w)}};
                        const unsigned moff = (unsigned)((4 * g * D + j16) * 2);
                        unsigned char* mp = (unsigned char*)(WSP(bf16, WS_MIX) + (size_t)tile_row0(s, dir) * D + 768 + 16 * cg);
#pragma unroll
                        for (int rt = 0; rt < 2; ++rt)
#pragma unroll
                            for (int r = 0; r < 4; ++r) *(bf16*)(mp + (moff + (unsigned)((16 * rt + r) * D * 2))) = (bf16)f2bf(gelu_tanh(bf1(gr[dir][rt][r])) * (hv[rt][r] + ot[rt][r]));
                    }
                }
            }
        }
    }
}

__device__ __forceinline__ void lru_carry(Frame& F) {
    int LN_ = F.tid & 63; asm volatile("" : "+v"(LN_));
    const f32x2* TOT = WSP(const f32x2, WS_TOT); float* CARRY = WSP(float, WS_CARRY);
    for (int it = F.gw; it < NB * 2 * 4; it += F.NGW) {
        const int b = it >> 3, dir = (it >> 2) & 1, c = (it & 3) * 64 + LN_;
        float h = 0.f;
        for (int g = 0; g < 18; ++g) {
            f32x2 ps[4]; int tl[4];
#pragma unroll
            for (int i = 0; i < 4; ++i) { const int s = g * 4 + i;
                int T; if (s < 8) T = 1024 + b * 8 + (dir == 0 ? s : 7 - s); else T = b * 64 + (dir == 0 ? s - 8 : 71 - s);
                tl[i] = T; ps[i] = TOT[((size_t)dir * 1152 + T) * 256 + c]; }
#pragma unroll
            for (int i = 0; i < 4; ++i) { CARRY[((size_t)dir * 1152 + tl[i]) * 256 + c] = h; h = ps[i][0] * h + ps[i][1]; }
        }
    }
}

__device__ __forceinline__ void ctx_finalize(Frame& F, int l) {
    int LN_ = F.tid & 63; asm volatile("" : "+v"(LN_));
    bf16* XA = WSP(bf16, WS_XA); float* RSSA = WSP(float, WS_RSSA); const float* ACC = WSP(const float, WS_PART); const float* MOD = WSP(const float, WS_MOD);
    const float* go = INP(5) + (l - 1) * D; const float* gso = MOD + ((size_t)(l - 1) * 17 + NB) * MODW + 4 * D;
    const float* gn = INP(4) + l * D; const float* gsn = MOD + ((size_t)l * 17 + NB) * MODW + D;
    for (int r = F.gw; r < MC; r += F.NGW) {
        const size_t row = (size_t)ML + r;
        float ss = 0.f; f32x4 y[4];
#pragma unroll
        for (int j = 0; j < 4; ++j) { const int k = 4 * LN_ + 256 * j;
            const v2u w = *(const v2u*)(XA + row * D + k);
            const f32x4 im = *(const f32x4*)(go + k) * (*(const f32x4*)(gso + k) + 1.0f);
            const f32x4 xo = (f32x4){bflo(w.x) * __builtin_amdgcn_rcpf(im[0]), bfhi(w.x) * __builtin_amdgcn_rcpf(im[1]), bflo(w.y) * __builtin_amdgcn_rcpf(im[2]), bfhi(w.y) * __builtin_amdgcn_rcpf(im[3])};
            const float* ap = ACC + (size_t)r * D + k;
            y[j] = xo + ((*(const f32x4*)ap + *(const f32x4*)(ap + (size_t)MC * D)) + (*(const f32x4*)(ap + (size_t)2 * MC * D) + *(const f32x4*)(ap + (size_t)3 * MC * D)));
            ss += (y[j][0] * y[j][0] + y[j][1] * y[j][1]) + (y[j][2] * y[j][2] + y[j][3] * y[j][3]); }
        ss = wave_sum(ss);
        if (LN_ < 32) RSSA[row * 32 + LN_] = (LN_ == 0) ? ss : 0.f;
#pragma unroll
        for (int j = 0; j < 4; ++j) { const int k = 4 * LN_ + 256 * j;
            const f32x4 a = y[j] * (*(const f32x4*)(gn + k) * (*(const f32x4*)(gsn + k) + 1.0f));
            v2u o; o.x = pk2(a[0], a[1]); o.y = pk2(a[2], a[3]); *(v2u*)(XA + row * D + k) = o; }
    }
}

__device__ __forceinline__ void final_rows(Frame& F) {
    int LN_ = F.tid & 63; asm volatile("" : "+v"(LN_));
    const bf16* XA = WSP(const bf16, WS_XA); const float* RSS = WSP(const float, WS_RSSA);
    for (int row = F.gw; row < ML; row += 2 * F.NGW) {
        const int row2 = row + F.NGW; const bool two = row2 < ML;
        const v4u a0 = *(const v4u*)(XA + (size_t)row * D + 8 * LN_), a1 = *(const v4u*)(XA + (size_t)row * D + 512 + 8 * LN_);
        const float p0 = LN_ < 32 ? RSS[(size_t)row * 32 + LN_] : 0.f;
        v4u b0 = a0, b1 = a1; float p1 = 0.f;
        if (two) { b0 = *(const v4u*)(XA + (size_t)row2 * D + 8 * LN_); b1 = *(const v4u*)(XA + (size_t)row2 * D + 512 + 8 * LN_); p1 = LN_ < 32 ? RSS[(size_t)row2 * 32 + LN_] : 0.f; }
        const float rs0 = rsqrtf(wave_sum(p0) * (1.f / D) + EPS), rs1 = rsqrtf(wave_sum(p1) * (1.f / D) + EPS);
        float* o = F.out + (size_t)row * D + 8 * LN_;
        *(f32x4*)(o) = (f32x4){bflo(a0.x), bfhi(a0.x), bflo(a0.y), bfhi(a0.y)} * rs0; *(f32x4*)(o + 4) = (f32x4){bflo(a0.z), bfhi(a0.z), bflo(a0.w), bfhi(a0.w)} * rs0;
        *(f32x4*)(o + 512) = (f32x4){bflo(a1.x), bfhi(a1.x), bflo(a1.y), bfhi(a1.y)} * rs0; *(f32x4*)(o + 516) = (f32x4){bflo(a1.z), bfhi(a1.z), bflo(a1.w), bfhi(a1.w)} * rs0;
        if (two) { float* o2 = F.out + (size_t)row2 * D + 8 * LN_;
            *(f32x4*)(o2) = (f32x4){bflo(b0.x), bfhi(b0.x), bflo(b0.y), bfhi(b0.y)} * rs1; *(f32x4*)(o2 + 4) = (f32x4){bflo(b0.z), bfhi(b0.z), bflo(b0.w), bfhi(b0.w)} * rs1;
            *(f32x4*)(o2 + 512) = (f32x4){bflo(b1.x), bfhi(b1.x), bflo(b1.y), bfhi(b1.y)} * rs1; *(f32x4*)(o2 + 516) = (f32x4){bflo(b1.z), bfhi(b1.z), bflo(b1.w), bfhi(b1.w)} * rs1; }
    }
}

__device__ __forceinline__ void fill_res_tables(Frame& F, const pg8::Order& S, const float* gate, const float* gmg, const float* gmsc, const float* go, const float* gso) {
    LAS float* T = (LAS float*)(F.lds + TBL_OFF);
    if (F.tid < 256) {
        float tg[3], tm[3], ts[3], to[3], tq[3]; bool ok[3];
#pragma unroll
        for (int i = 0; i < 3; ++i) { pg8::Unit u; ok[i] = S.next(i, u);
            if (ok[i]) { const int brow = u.pm < ML / 256 ? (u.pm >> 3) : NB, col = u.pn * 256 + F.tid;
                tg[i] = gate[(size_t)brow * MODW + col]; tm[i] = gmg[col]; ts[i] = gmsc[(size_t)brow * MODW + col]; to[i] = go[col]; tq[i] = gso[(size_t)brow * MODW + col]; } }
#pragma unroll
        for (int i = 0; i < 3; ++i) if (ok[i]) {
            T[i * 256 + F.tid] = tg[i];
            T[(pg8::TBL_UNITS + i) * 256 + F.tid] = tm[i] * (1.f + ts[i]);
            T[(2 * pg8::TBL_UNITS + i) * 256 + F.tid] = __builtin_amdgcn_rcpf(to[i] * (1.f + tq[i])); }
#pragma unroll 1
        for (int i = 3; i < pg8::TBL_UNITS; ++i) { pg8::Unit u; if (!S.next(i, u)) break;
            const int brow = u.pm < ML / 256 ? (u.pm >> 3) : NB, col = u.pn * 256 + F.tid;
            T[i * 256 + F.tid] = gate[(size_t)brow * MODW + col];
            T[(pg8::TBL_UNITS + i) * 256 + F.tid] = gmg[col] * (1.f + gmsc[(size_t)brow * MODW + col]);
            T[(2 * pg8::TBL_UNITS + i) * 256 + F.tid] = __builtin_amdgcn_rcpf(go[col] * (1.f + gso[(size_t)brow * MODW + col])); }
    }
    __syncthreads();
}

template <int LDC>
__device__ __forceinline__ void fill_scale_tables(Frame& F, const pg8::Order& S, const float* RSS, const float* shw) {
    LAS float* RS_T = (LAS float*)(F.lds + TBL_OFF); LAS float* SH_T = RS_T + pg8::TBL_UNITS * 256;
    const int row = F.tid >> 1, half = F.tid & 1;
    f32x4 p[2][3][4], sv[2][3]; bool ok[2][3];
    auto load_group = [&](int i0, f32x4 (&pg)[3][4], f32x4 (&sg)[3], bool (&og)[3]) __attribute__((always_inline)) {
#pragma unroll
        for (int j = 0; j < 3; ++j) { pg8::Unit u; og[j] = (i0 + j < pg8::TBL_UNITS) && S.next(i0 + j, u);
            if (og[j]) { const float* b = RSS + ((size_t)u.pm * 256 + row) * 32 + 16 * half;
#pragma unroll
                for (int q = 0; q < 4; ++q) pg[j][q] = *(const f32x4*)(b + 4 * q);
                if (F.tid < 64) sg[j] = *(const f32x4*)(shw + (size_t)(u.pm < ML / 256 ? (u.pm >> 3) : NB) * LDC + u.pn * 256 + 4 * F.tid); } }
    };
    auto reduce_group = [&](int i0, f32x4 (&pg)[3][4], f32x4 (&sg)[3], bool (&og)[3]) __attribute__((always_inline)) {
#pragma unroll
        for (int j = 0; j < 3; ++j) if (og[j]) {
            float s = 0.f;
#pragma unroll
            for (int q = 0; q < 4; ++q) s += (pg[j][q][0] + pg[j][q][1]) + (pg[j][q][2] + pg[j][q][3]);
            s = lane_xor1_sum(s);
            if (half == 0) RS_T[(i0 + j) * 256 + row] = rsqrtf(s * (1.0f / D) + EPS);
            if (F.tid < 64) *(LAS f32x4*)(SH_T + (i0 + j) * 256 + 4 * F.tid) = sg[j]; }
    };
    load_group(0, p[0], sv[0], ok[0]);
    load_group(3, p[1], sv[1], ok[1]);
    reduce_group(0, p[0], sv[0], ok[0]);
    load_group(6, p[0], sv[0], ok[0]);
    reduce_group(3, p[1], sv[1], ok[1]);
    reduce_group(6, p[0], sv[0], ok[0]);
    __syncthreads();
}

constexpr int N_PHASES = 2 + 5 * DEPTH + 1;
struct Args { const float* in[25]; float* out; unsigned char* ws; int ph_lo, ph_hi; };
static_assert(sizeof(Args) == 27 * 8 + 8, "Args has no padding");

__global__ void __launch_bounds__(NWAVES * 64, 2) mega_fwd(Args args) {
    extern __shared__ __attribute__((aligned(16))) unsigned char lds[];
    Frame F;
    F.lds = (LAS unsigned char*)lds;
    const int wave_s = __builtin_amdgcn_readfirstlane((int)threadIdx.x >> 6);
    F.wave = wave_s; F.tid = wave_s * 64 + (int)__builtin_amdgcn_mbcnt_hi(~0u, __builtin_amdgcn_mbcnt_lo(~0u, 0u));
    F.G = gridDim.x; { const int bx = blockIdx.x; F.vcu = (F.G % 8 == 0) ? (bx % 8) * (F.G / 8) + bx / 8 : bx; }
    F.gw = F.vcu * NWAVES + F.wave; F.NGW = F.G * NWAVES;
    F.out = args.out; F.ws = args.ws;
    volatile LAS unsigned* MISC = (volatile LAS unsigned*)(F.lds + MISC_OFF);
    for (int u = F.tid; u < (LDS_BYTES - LDSCTL_OFF) / 4; u += NWAVES * 64) ((LAS unsigned*)(F.lds + LDSCTL_OFF))[u] = 0u;
    __syncthreads();
    if (F.tid == 0) {
#pragma unroll
        for (int i = 0; i < 25; ++i) *(LAS unsigned long long*)(F.lds + PTR_OFF + 8 * i) = (unsigned long long)args.in[i];
    }
    __syncthreads();
    XcdBarrier bar = xcd_barrier_post((unsigned*)(F.ws + WS_CTL) + CW_BAR, MISC + 8, F.tid);

    const int lo = args.ph_lo, hi = args.ph_hi;
#ifdef PROBE_TL
    unsigned ttl_ = (unsigned)__builtin_amdgcn_readfirstlane((int)(unsigned)__builtin_amdgcn_s_memrealtime());
#endif
#ifdef PROBE_PH
    const unsigned tk0_ = (unsigned)__builtin_amdgcn_readfirstlane((int)(unsigned)__builtin_amdgcn_s_memrealtime());
#endif
#ifdef PROBE_MASK
    bool rep_done = false;
#define PROBE_V ((((PROBE_MASK >> ph) & 1) && !rep_done) ? PROBE_VARIANT : 0)
#else
#define PROBE_V 0
#endif
    for (int ph = lo; ph < hi; ++ph) {
        { unsigned ones_ = ~0u; asm volatile("" : "+s"(ones_));
          int t_ = wave_s * 64 + (int)__builtin_amdgcn_mbcnt_hi(ones_, __builtin_amdgcn_mbcnt_lo(ones_, 0u)); asm volatile("" : "+v"(t_)); F.tid = t_; F.wave = __builtin_amdgcn_readfirstlane(t_ >> 6); F.gw = F.vcu * NWAVES + F.wave; }
#ifdef PROBE_PH
        unsigned tp0_ = 0, tp1_ = 0;
        if (ph == PROBE_PH) tp0_ = (unsigned)__builtin_amdgcn_readfirstlane((int)(unsigned)__builtin_amdgcn_s_memrealtime());
#endif
        if (ph == 0) {
#ifndef NO_P0
            phase_p0a(F);
#endif
        } else if (ph == 1) {
#ifndef NO_P0
            phase_p0b(F);
#endif
        }
        else if (ph == N_PHASES - 1) { final_rows(F);
#ifdef PROBE_PH
            if (blockIdx.x == 0 && F.tid == 0) { const unsigned* pc = WSP(const unsigned, WS_CTL + 768 * 1024); unsigned v_ = __builtin_nontemporal_load(pc + (PROBE_SEL & 3)); if (PROBE_SEL == 2) v_ = 0xFFFFFFFFu - v_; if (PROBE_SEL == 4) v_ = (unsigned)__builtin_amdgcn_s_memrealtime() - tk0_; __builtin_amdgcn_s_sleep(127); F.out[0] = (float)v_ * PROBE_SCALE; }
#endif
        }
        else {
            const int l = (ph - 2) / 5, k5 = (ph - 2) % 5, k = k5 < 2 ? k5 : k5 + 2; const bool last = (l == DEPTH - 1);
            const int Mx = last ? ML : MT;
            float* MOD = WSP(float, WS_MOD);
            if (k == 0) {
                if (l > 0) { ctx_finalize(F, l); xcd_barrier(bar, F.tid); }
                pg8::Gemm g{WSP(const bf16, WS_XA), WSP(const bf16, WS_WIN) + (size_t)l * IND * D, MT, IND, D};
                pg8::Order S; if (last) S.init(ML, IND, WGM_IN, (MC / 256) * 5, 1, F.G, (int)blockIdx.x); else S.init(MT, IND, WGM_IN, 0, 0, F.G, (int)blockIdx.x);
                fill_scale_tables<IND>(F, S, WSP(const float, WS_RSSA), WSP(const float, WS_SHW1) + (size_t)l * 17 * IND);
                pg8::EpiScale<0, IND, true> E{WSP(bf16, WS_PROJ), (const LAS float*)(F.lds + TBL_OFF), PROBE_V};

#ifndef NO_G0
                pg8::gemm_phase<pg8::EpiScale<0, IND, true>, pg8::Order, true, true>(F.lds + RING_OFF, g, S, E, F.tid);
#endif
                if (!last) filler_weights(F, S.nwg + S.extra, W_EARLY, W_F1); else filler_weights(F, S.nwg + S.extra, W_F2, W_ITEMS);

            } else if (k == 1) {

#ifndef NO_LRU
                lru_seq_phase(F, l, last);
#ifdef REP_LRU0
                __syncthreads(); lru_seq_phase(F, l, last);
#endif
#endif

                __syncthreads();
#ifndef NO_CONV
                conv_phase(F, l, last ? 1024 : 1152);
                __syncthreads();
#ifdef REP_CONV
                conv_phase(F, l, last ? 1024 : 1152);
                __syncthreads();
#endif
#endif
#ifndef NO_NA
#ifdef REP_NA
                na_phase(F, l, last ? NA_ITEMS_LAT : NA_ITEMS_LAT + NA_ITEMS_CTX, REP_NA);
#else
                na_phase(F, l, last ? NA_ITEMS_LAT : NA_ITEMS_LAT + NA_ITEMS_CTX);
#endif
#ifdef REP_NA
                __syncthreads(); na_phase(F, l, last ? NA_ITEMS_LAT : NA_ITEMS_LAT + NA_ITEMS_CTX, 0);
#endif
#endif
            } else if (k == 4 || k == 6) {
                const bool dn = (k == 6);
                const int ln = (dn && !last) ? l + 1 : l;
                pg8::Gemm g{dn ? WSP(const bf16, WS_HID) : WSP(const bf16, WS_MIX), dn ? WSP(const bf16, WS_W2) + (size_t)l * D * FF : WSP(const bf16, WS_WOUT) + (size_t)l * D * D, Mx, D, dn ? FF : D};
                const bool splitk = dn && !last;
                pg8::Order S; S.init(splitk ? ML : Mx, D, dn ? WGM_DN : WGM_OUT, 0, 0, F.G, (int)blockIdx.x);
                const float* go_g = dn ? INP(5) + l * D : INP(4) + l * D;
                const float* go_s = MOD + (size_t)l * 17 * MODW + (dn ? 4 : 1) * D;
                const bool fin = dn && last;
                fill_res_tables(F, S, MOD + (size_t)l * 17 * MODW + (dn ? 5 : 2) * D, fin ? INP(24) : (dn ? INP(4) : INP(5)) + ln * D, fin ? WSP(const float, WS_ZERO) : MOD + (size_t)ln * 17 * MODW + (dn ? 1 : 4) * D, go_g, go_s);
                pg8::EpiRes<RES_NB> E{(const LAS float*)(F.lds + TBL_OFF), WSP(bf16, WS_XA), dn ? WSP(float, WS_RSSA) : WSP(float, WS_RSSB)};
#ifndef NO_GR
                pg8::gemm_phase<pg8::EpiRes<RES_NB>, pg8::Order, true, true>(F.lds + RING_OFF, g, S, E, F.tid);
                if (!dn && !last) filler_weights(F, S.nwg + S.extra, W_F1, W_F2);
                if (splitk) {
                    pg8::Order S2; S2.init(ML, 0, 4, (MC / 256) * 16, 2, F.G, (int)blockIdx.x);
                    pg8::EpiSlab E2{WSP(float, WS_PART), MOD + ((size_t)l * 17 + NB) * MODW + 5 * D};
                    pg8::gemm_phase<pg8::EpiSlab, pg8::Order, true, true, true>(F.lds + RING_OFF, g, S2, E2, F.tid);
                }
#endif
            } else if (k == 5) {
                pg8::Gemm g{WSP(const bf16, WS_XA), WSP(const bf16, WS_W1) + (size_t)l * FF * D, Mx, FF, D};
                pg8::Order S; S.init(Mx, FF, WGM_UP, 0, 0, F.G, (int)blockIdx.x);
                fill_scale_tables<FF>(F, S, WSP(const float, WS_RSSB), WSP(const float, WS_SHW2) + (size_t)l * 17 * FF);
                pg8::EpiScale<1, FF> E{WSP(bf16, WS_HID), (const LAS float*)(F.lds + TBL_OFF), PROBE_V};

#ifndef NO_G1
                pg8::gemm_phase<pg8::EpiScale<1, FF>, pg8::Order, true, true>(F.lds + RING_OFF, g, S, E, F.tid);
#endif

            }
        }
#ifdef PROBE_MASK
        if (((PROBE_MASK >> ph) & 1) && !rep_done) { rep_done = true; xcd_barrier(bar, F.tid); --ph; continue; }
        rep_done = false;
#endif
#ifdef PROBE_PH
        if (ph == PROBE_PH) { tp1_ = (unsigned)__builtin_amdgcn_readfirstlane((int)(unsigned)__builtin_amdgcn_s_memrealtime());
            if (F.tid == 0) { unsigned* pc = WSP(unsigned, WS_CTL + 768 * 1024); const unsigned w_ = tp1_ - tp0_; atomicMax(pc + 1, w_); atomicMax(pc + 2, 0xFFFFFFFFu - w_); if (blockIdx.x == 0) pc[0] = w_; } }
#endif
        if (ph + 1 < hi) xcd_barrier(bar, F.tid);
#ifdef PROBE_PH
        if (ph == PROBE_PH && blockIdx.x == 0 && F.tid == 0) { unsigned* pc = WSP(unsigned, WS_CTL + 768 * 1024); pc[3] = (unsigned)__builtin_amdgcn_s_memrealtime() - tp1_; }
#endif
#ifdef PROBE_TL
        { const unsigned tn_ = (unsigned)__builtin_amdgcn_readfirstlane((int)(unsigned)__builtin_amdgcn_s_memrealtime());
          if (blockIdx.x == 0 && F.tid == 0) WSP(unsigned, WS_CTL + 768 * 1024)[16 + ph] = tn_ - ttl_;
          ttl_ = tn_; }
        if (ph == N_PHASES - 1) {
            xcd_barrier(bar, F.tid);
            if (blockIdx.x == 0) { const unsigned* pc = WSP(const unsigned, WS_CTL + 768 * 1024);
                const float va_ = (float)__builtin_nontemporal_load(pc + 16 + PROBE_TLA) * PROBE_SA, vb_ = (float)__builtin_nontemporal_load(pc + 16 + PROBE_TLB) * PROBE_SB;
                if (F.tid == 0) F.out[0] = va_;
                for (int i = F.tid; i < 4096; i += NWAVES * 64) F.out[1024 + i] = vb_; }
        }
#endif
#ifdef PROBE_BAR2
        if (ph + 1 < hi) xcd_barrier(bar, F.tid);
#endif
    }
}

extern "C" void kernel_launch(void* const* d_in, const int* in_sizes, int n_in, void* d_out, int out_size, void* d_ws, size_t ws_size, hipStream_t stream) {
    static int grid = 0;
    if (grid == 0) {
        if (n_in != 25 || out_size != ML * D || ws_size < WS_END) { fprintf(stderr, "kernel_launch: unexpected shapes (n_in %d out %d ws %zu)\n", n_in, out_size, ws_size); grid = -1; return; }
        int dev = 0, cus = 0;
        if (hipGetDevice(&dev) != hipSuccess || hipDeviceGetAttribute(&cus, hipDeviceAttributeMultiprocessorCount, dev) != hipSuccess) { grid = -1; return; }
        if (hipFuncSetAttribute((const void*)mega_fwd, hipFuncAttributeMaxDynamicSharedMemorySize, LDS_BYTES) != hipSuccess) { fprintf(stderr, "kernel_launch: hipFuncSetAttribute failed\n"); grid = -1; return; }
        int per_cu = 0;
        if (hipOccupancyMaxActiveBlocksPerMultiprocessor(&per_cu, (const void*)mega_fwd, NWAVES * 64, LDS_BYTES) != hipSuccess || per_cu < 1) fprintf(stderr, "kernel_launch: occupancy query reports %d\n", per_cu);
        (void)hipGetLastError();
        grid = cus;
    }
    if (grid < 0) return;
    if (hipMemsetAsync((char*)d_ws + WS_CTL, 0, CTL_ZERO_BYTES, stream) != hipSuccess) return;
    Args a{};
    for (int i = 0; i < 25; ++i) a.in[i] = (const float*)d_in[i];
    a.out = (float*)d_out; a.ws = (unsigned char*)d_ws;
#if MK_N_LAUNCHES == 1
    a.ph_lo = 0; a.ph_hi = N_PHASES;
    hipLaunchKernelGGL(mega_fwd, dim3(grid), dim3(NWAVES * 64), LDS_BYTES, stream, a);
#else
    for (int ph = 0; ph < N_PHASES; ++ph) { a.ph_lo = ph; a.ph_hi = ph + 1; hipLaunchKernelGGL(mega_fwd, dim3(grid), dim3(NWAVES * 64), LDS_BYTES, stream, a); }
#endif
}
```

```cpp
#include <hip/hip_runtime.h>
#include <cstdio>
#include <cstdint>

constexpr int D = 1024, NB = 16, SEQ = 2048, CTXL = 256, DEPTH = 2;
constexpr int ML = NB * SEQ, MC = NB * CTXL, MT = ML + MC;
constexpr int IND = 2560, FF = 4096, NH = 8, HD = 64;
constexpr int MODW = 6 * D;
constexpr float EPS = 1e-6f;
#ifndef MK_N_LAUNCHES
#define MK_N_LAUNCHES 1
#endif

namespace pg8 {
#define PG8_LAS __attribute__((address_space(3)))
typedef unsigned short bf16_t;
typedef short bf16x8 __attribute__((ext_vector_type(8)));
typedef float f32x4 __attribute__((ext_vector_type(4)));
typedef unsigned u32x4 __attribute__((ext_vector_type(4)));
constexpr int BM = 256, BK = 64, HALF = 128, HTB = HALF * BK * 2, STAGE_BYTES = 8 * HTB, NXCD = 8;
constexpr int TBL_UNITS = 9;

__host__ __device__ __forceinline__ int lds_byte(int r, int c) { const int st = (r >> 4) * 2 + (c >> 5), rr = r & 15, cc = c & 31, ob = rr * 64 + cc * 2; return st * 1024 + (ob ^ (((ob >> 9) & 1) << 5)); }
__host__ __device__ __forceinline__ void stage_rc(int b, int& R, int& C) { const int st = b / 1024, sb = b % 1024, swz = sb ^ (((sb >> 9) & 1) << 5); R = (st >> 1) * 16 + swz / 64; C = (st & 1) * 32 + (swz % 64) / 2; }
__host__ __device__ __forceinline__ int perm32(int rho) { const int n = rho >> 4, i = rho & 15; return 8 * (i >> 2) + 4 * n + (i & 3); }

struct Unit { int pm, pn; };
struct Gemm { const bf16_t* A; const bf16_t* Bt; int M, N, K; };

__host__ __device__ __forceinline__ void map_tile(int wgid, int nM, int nN, int WGM, Unit& u) {
    const int nwg = nM * nN;
    { const int q = nwg / NXCD, r = nwg % NXCD, xcd = wgid % NXCD, off = wgid / NXCD; wgid = (xcd < r ? xcd * (q + 1) : r * (q + 1) + (xcd - r) * q) + off; }
    const int nig = WGM * nN, gid = wgid / nig, fm = gid * WGM, gsz = (nM - fm) < WGM ? (nM - fm) : WGM;
    u.pm = fm + ((wgid % nig) % gsz); u.pn = (wgid % nig) / gsz;
}
struct Order {
    int nM, nN, nwg, extra, mode, wgm, G, c;
    __host__ __device__ void init(int M, int N, int wgm_, int extra_, int mode_, int G_, int c_) { nM = M / BM; nN = N / BM; nwg = nM * nN; extra = extra_; mode = mode_; wgm = wgm_; G = G_; c = c_; }
    __host__ __device__ bool next(int i, Unit& u) const {
        const long L = (long)i * G + c;
        if (L < nwg) { map_tile((int)L, nM, nN, wgm, u); return true; }
        if (L < nwg + extra) { const int q = (int)L - nwg;
            if (mode == 1) { u.pm = nM + q / 5; u.pn = 4 + q % 5; }
            else { u.pm = nM + (q >> 4); u.pn = 4 + 4 * (q & 3) + ((q >> 2) & 3); }
            return true; }
        return false;
    }
    __device__ __forceinline__ void a_ready(const Unit&) const {}
    __device__ __forceinline__ void done(const Unit&) const {}
};

__device__ __forceinline__ unsigned cvt_pk_bf16(float lo, float hi) { unsigned r; asm volatile("v_cvt_pk_bf16_f32 %0, %1, %2" : "=v"(r) : "v"(lo), "v"(hi)); return r; }

template <int ACT, int LDC, bool GLU = false> struct EpiScale {
    static constexpr bool PERM = true, AFTER_DRAIN = false;
    bf16_t* O;
    const PG8_LAS float* tbl;
    int probe;
    __device__ __forceinline__ void operator()(const f32x4 (&acc)[2][2][4][2], const Unit& u, int wr, int wc, int fr, int fq, int ui) const {
        asm volatile("" : "+s"(wr), "+s"(wc));
        bf16_t* Ot = O + (size_t)u.pm * BM * LDC + u.pn * BM;
        unsigned cl = (unsigned)(wc * 32 + 8 * fq);
        unsigned rl0 = (unsigned)(wr * 64 + fr);
        asm volatile("" : "+v"(cl), "+v"(rl0));
        const PG8_LAS float* rst = tbl + ui * 256, * sht = tbl + TBL_UNITS * 256 + ui * 256;
        f32x4 sh[2][2]; float rs[2][4];
#pragma unroll
        for (int ai = 0; ai < 2; ++ai)
#pragma unroll
            for (int m = 0; m < 4; ++m) rs[ai][m] = rst[rl0 + (unsigned)(ai * HALF + m * 16)];
#pragma unroll
        for (int bj = 0; bj < 2; ++bj) { sh[bj][0] = *(const PG8_LAS f32x4*)(sht + (cl + (unsigned)(bj * HALF))); sh[bj][1] = *(const PG8_LAS f32x4*)(sht + (cl + (unsigned)(bj * HALF + 4))); }
        if (GLU && u.pn < 2) {
#pragma unroll
            for (int ai = 0; ai < 2; ++ai)
#pragma unroll
                for (int m = 0; m < 4; ++m) {
                    const f32x4 a0 = acc[ai][0][m][0] * rs[ai][m] + sh[0][0], a1 = acc[ai][0][m][1] * rs[ai][m] + sh[0][1];
                    const f32x4 g0 = acc[ai][1][m][0] * rs[ai][m] + sh[1][0], g1 = acc[ai][1][m][1] * rs[ai][m] + sh[1][1];
                    f32x4 v0, v1;
#pragma unroll
                    for (int e = 0; e < 4; ++e) { v0[e] = a0[e] * __builtin_amdgcn_rcpf(1.f + __builtin_amdgcn_exp2f(-1.4426950408889634f * g0[e])); v1[e] = a1[e] * __builtin_amdgcn_rcpf(1.f + __builtin_amdgcn_exp2f(-1.4426950408889634f * g1[e])); }
                    u32x4 w; w.x = cvt_pk_bf16(v0[0], v0[1]); w.y = cvt_pk_bf16(v0[2], v0[3]); w.z = cvt_pk_bf16(v1[0], v1[1]); w.w = cvt_pk_bf16(v1[2], v1[3]);
                    *(u32x4*)(O + (size_t)u.pm * BM * LDC + u.pn * HALF + ((rl0 + (unsigned)(ai * HALF + m * 16)) * (unsigned)LDC + cl)) = w;
                }
            return;
        }
#pragma unroll
        for (int bj = 0; bj < 2; ++bj)
#pragma unroll
            for (int ai = 0; ai < 2; ++ai)
#pragma unroll
                for (int m = 0; m < 4; ++m) {
                    f32x4 v0 = acc[ai][bj][m][0] * rs[ai][m] + sh[bj][0], v1 = acc[ai][bj][m][1] * rs[ai][m] + sh[bj][1];
                    if (ACT == 1) {
#pragma unroll
                        for (int e = 0; e < 4; ++e) { const float a = fmaxf(v0[e], 0.f), b = fmaxf(v1[e], 0.f); v0[e] = a * a; v1[e] = b * b; }
                    }
                    u32x4 w; w.x = cvt_pk_bf16(v0[0], v0[1]); w.y = cvt_pk_bf16(v0[2], v0[3]); w.z = cvt_pk_bf16(v1[0], v1[1]); w.w = cvt_pk_bf16(v1[2], v1[3]);
                    if (probe == 0) *(u32x4*)(Ot + ((rl0 + (unsigned)(ai * HALF + m * 16)) * (unsigned)LDC + cl + (unsigned)(bj * HALF))) = w;
                    else asm volatile("" :: "v"(w));
                }
    }
};
__device__ __forceinline__ float rows4_sum(float x) {
    float a = x, b = x;
    asm volatile("s_nop 1\n\tv_permlane16_swap_b32 %0, %1\n\ts_nop 1" : "+v"(a), "+v"(b));
    const float s = a + b; float c = s, d = s;
    asm volatile("s_nop 1\n\tv_permlane32_swap_b32 %0, %1\n\ts_nop 1" : "+v"(c), "+v"(d));
    return c + d;
}
template <int NB_> struct EpiRes {
    static constexpr bool PERM = true, AFTER_DRAIN = false;
    const PG8_LAS float* tbl;
    bf16_t* XA; float* RSS;
    __device__ __forceinline__ void operator()(const f32x4 (&acc)[2][2][4][2], const Unit& u, int wr, int wc, int fr, int fq, int ui) const {
        asm volatile("" : "+s"(wr), "+s"(wc));
        bf16_t* XAt = XA + (size_t)u.pm * BM * D + u.pn * BM;
        float* RSSt = RSS + (size_t)u.pm * BM * 32 + u.pn * 8 + wc;
        unsigned cl = (unsigned)(wc * 32 + 8 * fq);
        unsigned rl0 = (unsigned)(wr * 64 + fr);
        asm volatile("" : "+v"(cl), "+v"(rl0));
        const PG8_LAS float* gT = tbl + ui * 256, * mT = tbl + (TBL_UNITS + ui) * 256, * iT = tbl + (2 * TBL_UNITS + ui) * 256;
        constexpr int BJB = 2 / NB_;
#pragma unroll
        for (int b0 = 0; b0 < 2; b0 += BJB) {
            u32x4 xb[BJB][2][4];
#pragma unroll
            for (int bb = 0; bb < BJB; ++bb)
#pragma unroll
                for (int ai = 0; ai < 2; ++ai)
#pragma unroll
                    for (int m = 0; m < 4; ++m) xb[bb][ai][m] = *(const u32x4*)(XAt + ((rl0 + (unsigned)(ai * HALF + m * 16)) * (unsigned)D + cl + (unsigned)((b0 + bb) * HALF)));
            asm volatile("" ::: "memory");
#pragma unroll
            for (int bb = 0; bb < BJB; ++bb) {
                const int bj = b0 + bb;
                const unsigned c = cl + (unsigned)(bj * HALF);
                const f32x4 g0 = *(const PG8_LAS f32x4*)(gT + c), g1 = *(const PG8_LAS f32x4*)(gT + (c + 4u)), m0 = *(const PG8_LAS f32x4*)(mT + c), m1 = *(const PG8_LAS f32x4*)(mT + (c + 4u)),
                            r0 = *(const PG8_LAS f32x4*)(iT + c), r1 = *(const PG8_LAS f32x4*)(iT + (c + 4u));
#pragma unroll
                for (int ai = 0; ai < 2; ++ai)
#pragma unroll
                    for (int m = 0; m < 4; ++m) {
                        const unsigned rl = rl0 + (unsigned)(ai * HALF + m * 16);
                        const u32x4 w = xb[bb][ai][m];
                        const f32x4 x0 = (f32x4){__uint_as_float(w.x << 16), __uint_as_float(w.x & 0xffff0000u), __uint_as_float(w.y << 16), __uint_as_float(w.y & 0xffff0000u)} * r0;
                        const f32x4 x1 = (f32x4){__uint_as_float(w.z << 16), __uint_as_float(w.z & 0xffff0000u), __uint_as_float(w.w << 16), __uint_as_float(w.w & 0xffff0000u)} * r1;
                        const f32x4 y0 = x0 + g0 * acc[ai][bj][m][0], y1 = x1 + g1 * acc[ai][bj][m][1];
                        float ss = ((y0[0] * y0[0] + y0[1] * y0[1]) + (y0[2] * y0[2] + y0[3] * y0[3])) + ((y1[0] * y1[0] + y1[1] * y1[1]) + (y1[2] * y1[2] + y1[3] * y1[3]));
                        ss = rows4_sum(ss);
                        if (fq == 0) RSSt[rl * 32u + (unsigned)(bj * 4)] = ss;
                        const f32x4 a0 = y0 * m0, a1 = y1 * m1;
                        u32x4 o; o.x = cvt_pk_bf16(a0[0], a0[1]); o.y = cvt_pk_bf16(a0[2], a0[3]); o.z = cvt_pk_bf16(a1[0], a1[1]); o.w = cvt_pk_bf16(a1[2], a1[3]);
                        *(u32x4*)(XAt + (rl * (unsigned)D + c)) = o;
                    }
            }
            asm volatile("" ::: "memory");
        }
    }
};

struct EpiSlab {
    static constexpr bool PERM = true, AFTER_DRAIN = false;
    float* P; const float* gate;
    __device__ __forceinline__ void operator()(const f32x4 (&acc)[2][2][4][2], const Unit& u, int wr, int wc, int fr, int fq, int) const {
        asm volatile("" : "+s"(wr), "+s"(wc));
        const int ks = (u.pn - 4) >> 2, pn = u.pn & 3;
        float* At = P + ((size_t)ks * MC + (size_t)(u.pm - ML / BM) * BM) * D + pn * BM;
        const float* gtq = gate + pn * BM;
        unsigned cl = (unsigned)(wc * 32 + 8 * fq), rl0 = (unsigned)(wr * 64 + fr);
        asm volatile("" : "+v"(cl), "+v"(rl0));
        f32x4 gv[2][2];
#pragma unroll
        for (int bj = 0; bj < 2; ++bj) { gv[bj][0] = *(const f32x4*)(gtq + (cl + (unsigned)(bj * HALF))); gv[bj][1] = *(const f32x4*)(gtq + (cl + (unsigned)(bj * HALF + 4))); }
#pragma unroll
        for (int bj = 0; bj < 2; ++bj) { const unsigned c = cl + (unsigned)(bj * HALF);
#pragma unroll
            for (int ai = 0; ai < 2; ++ai)
#pragma unroll
                for (int m = 0; m < 4; ++m) { const unsigned off = (rl0 + (unsigned)(ai * HALF + m * 16)) * (unsigned)D + c;
                    *(f32x4*)(At + off) = gv[bj][0] * acc[ai][bj][m][0]; *(f32x4*)(At + (off + 4u)) = gv[bj][1] * acc[ai][bj][m][1]; } }
    }
};

template <class Epi, class Sched, bool ALIGN_EPI = false, bool SP2 = false, bool VARK = false>
__device__ __forceinline__ void gemm_phase(PG8_LAS unsigned char* lds, const Gemm g, const Sched& S, const Epi& E, const int tid) {
    const int wid = __builtin_amdgcn_readfirstlane(tid >> 6), lane = tid & 63, wr = wid >> 2, wc = wid & 3, fr = lane & 15, fq = lane >> 4;
    const int K = g.K;
    unsigned voffA[2], voffB[2];
#pragma unroll
    for (int i = 0; i < 2; ++i) { int R, C; stage_rc(tid * 16 + i * 8192, R, C); const int Rb = Epi::PERM ? ((R & ~31) + perm32(R & 31)) : R;
        voffA[i] = (unsigned)(R * K + C) * 2u; voffB[i] = (unsigned)(Rb * K + C) * 2u; }
    const size_t kstep = (size_t)(BK * 2);
    const size_t hstep = (size_t)HALF * K * 2;
    const size_t tstep = 2 * hstep;
    const unsigned ldsw = (unsigned)wid * 1024u;
    const int aoff = lds_byte(wr * 64 + fr, fq * 8), boff = lds_byte(wc * 32 + fr, fq * 8);
#define PG8_SA(b, h) (((b) * 2 + (h)) * HTB)
#define PG8_SB(b, h) ((4 + (b) * 2 + (h)) * HTB)
#define PG8_STAGE(bufoff, gbase, voff) do { _Pragma("unroll") for (int _i = 0; _i < 2; ++_i) \
        __builtin_amdgcn_global_load_lds((const unsigned*)((const char*)(gbase) + (voff)[_i]), (PG8_LAS unsigned*)(lds + (bufoff) + ldsw + _i * 8192), 16, 0, 0); } while (0)
#define PG8_LDA(dst, b, h) do { _Pragma("unroll") for (int m = 0; m < 4; ++m) _Pragma("unroll") for (int k = 0; k < 2; ++k) dst[m][k] = *(const PG8_LAS bf16x8*)(lds + PG8_SA(b, h) + aoff + m * 2048 + k * 1024); } while (0)
#define PG8_LDB(dst, b, h) do { _Pragma("unroll") for (int n = 0; n < 2; ++n) _Pragma("unroll") for (int k = 0; k < 2; ++k) dst[n][k] = *(const PG8_LAS bf16x8*)(lds + PG8_SB(b, h) + boff + n * 2048 + k * 1024); } while (0)
#define PG8_MMA(ai, bj, At, Bt) do { __builtin_amdgcn_s_setprio(1); _Pragma("unroll") for (int m = 0; m < 4; ++m) _Pragma("unroll") for (int n = 0; n < 2; ++n) _Pragma("unroll") for (int k = 0; k < 2; ++k) \
        acc[ai][bj][m][n] = __builtin_amdgcn_mfma_f32_16x16x32_bf16(Bt[n][k], At[m][k], acc[ai][bj][m][n], 0, 0, 0); __builtin_amdgcn_s_setprio(0); } while (0)
#define PG8_WAIT_V(n) asm volatile("s_waitcnt vmcnt(" #n ")" ::: "memory")
#define PG8_WAIT_L(n) asm volatile("s_waitcnt lgkmcnt(" #n ")" ::: "memory")
#define PG8_BAR __builtin_amdgcn_s_barrier()
#define PG8_SCHED __builtin_amdgcn_sched_barrier(0)
    Unit cur, nxt; int ui = 0;
    if (!S.next(0, cur)) return;
    cur.pm = __builtin_amdgcn_readfirstlane(cur.pm); cur.pn = __builtin_amdgcn_readfirstlane(cur.pn);
    f32x4 acc[2][2][4][2];
#pragma unroll
    for (int a = 0; a < 2; ++a)
#pragma unroll
        for (int b = 0; b < 2; ++b)
#pragma unroll
            for (int m = 0; m < 4; ++m)
#pragma unroll
                for (int n = 0; n < 2; ++n) acc[a][b][m][n] = (f32x4){0.f, 0.f, 0.f, 0.f};
    bf16x8 At[4][2], B0[2][2], B1[2][2];
#define PG8_KOFF(u) ((VARK && (u).pn >= 4) ? (size_t)(((u).pn - 4) >> 2) * (size_t)(K / 4) * 2 : (size_t)0)
#define PG8_PN(u) ((VARK && (u).pn >= 4) ? ((u).pn & 3) : (u).pn)
    const char* cA = (const char*)g.A + (size_t)cur.pm * tstep + PG8_KOFF(cur); const char* cB = (const char*)g.Bt + (size_t)PG8_PN(cur) * tstep + PG8_KOFF(cur);
    S.a_ready(cur);
    if constexpr (SP2) {
        PG8_STAGE(PG8_SB(0, 0), cB, voffB); PG8_STAGE(PG8_SB(0, 1), cB + hstep, voffB); PG8_STAGE(PG8_SA(0, 0), cA, voffA); PG8_STAGE(PG8_SA(0, 1), cA + hstep, voffA);
        if (wr == 1) PG8_BAR;
        PG8_WAIT_V(2); PG8_BAR;
        PG8_STAGE(PG8_SB(1, 0), cB + kstep, voffB); PG8_STAGE(PG8_SA(1, 0), cA + kstep, voffA); PG8_STAGE(PG8_SB(1, 1), cB + hstep + kstep, voffB);
        PG8_WAIT_V(6); PG8_BAR;
    } else {
        PG8_STAGE(PG8_SB(0, 0), cB, voffB); PG8_STAGE(PG8_SA(0, 0), cA, voffA); PG8_STAGE(PG8_SB(0, 1), cB + hstep, voffB); PG8_STAGE(PG8_SA(0, 1), cA + hstep, voffA);
        if (wr == 1) PG8_BAR;
        PG8_WAIT_V(4); PG8_BAR;
        PG8_STAGE(PG8_SB(1, 0), cB + kstep, voffB); PG8_STAGE(PG8_SA(1, 0), cA + kstep, voffA); PG8_STAGE(PG8_SB(1, 1), cB + hstep + kstep, voffB);
        PG8_WAIT_V(6); PG8_BAR;
    }
    for (;;) {
        const bool has_next = S.next(ui + 1, nxt);
        nxt.pm = __builtin_amdgcn_readfirstlane(nxt.pm); nxt.pn = __builtin_amdgcn_readfirstlane(nxt.pn);
        const char* nA = has_next ? (const char*)g.A + (size_t)nxt.pm * tstep + PG8_KOFF(nxt) : cA; const char* nB = has_next ? (const char*)g.Bt + (size_t)PG8_PN(nxt) * tstep + PG8_KOFF(nxt) : cB;
        const int nt = (VARK && cur.pn >= 4) ? K / BK / 4 : K / BK;
        for (int t = 0; t < nt; t += 2) {
            const bool last = (t == nt - 2);
            const char* a1 = cA + (size_t)(t + 1) * kstep;
            const char* a2 = last ? nA : cA + (size_t)(t + 2) * kstep; const char* b2 = last ? nB : cB + (size_t)(t + 2) * kstep;
            const char* a3 = a2 + kstep; const char* b3 = b2 + kstep;
            if (last && has_next) S.a_ready(nxt);
            if constexpr (SP2) {
            PG8_LDB(B0, 0, 0); PG8_LDB(B1, 0, 1); PG8_SCHED; PG8_LDA(At, 0, 0); PG8_STAGE(PG8_SA(1, 1), a1 + hstep, voffA);
            PG8_WAIT_V(8); PG8_WAIT_L(0); PG8_BAR; PG8_MMA(0, 0, At, B0); PG8_MMA(0, 1, At, B1); PG8_BAR; PG8_SCHED;
            PG8_LDA(At, 0, 1); PG8_STAGE(PG8_SB(0, 0), b2, voffB); PG8_STAGE(PG8_SB(0, 1), b2 + hstep, voffB); PG8_STAGE(PG8_SA(0, 0), a2, voffA);
            PG8_WAIT_V(8); PG8_WAIT_L(0); PG8_BAR; PG8_MMA(1, 0, At, B0); PG8_MMA(1, 1, At, B1); PG8_BAR; PG8_SCHED;
            PG8_LDB(B0, 1, 0); PG8_LDB(B1, 1, 1); PG8_SCHED; PG8_LDA(At, 1, 0); PG8_STAGE(PG8_SA(0, 1), a2 + hstep, voffA);
            PG8_WAIT_V(8); PG8_WAIT_L(0); PG8_BAR; PG8_MMA(0, 0, At, B0); PG8_MMA(0, 1, At, B1); PG8_BAR; PG8_SCHED;
            PG8_LDA(At, 1, 1); PG8_STAGE(PG8_SB(1, 0), b3, voffB); PG8_STAGE(PG8_SB(1, 1), b3 + hstep, voffB); PG8_STAGE(PG8_SA(1, 0), a3, voffA);
            PG8_WAIT_V(8); PG8_WAIT_L(0); PG8_BAR; PG8_MMA(1, 0, At, B0); PG8_MMA(1, 1, At, B1); PG8_BAR; PG8_SCHED;
            } else {
            PG8_LDB(B0, 0, 0); PG8_SCHED; PG8_LDA(At, 0, 0); PG8_STAGE(PG8_SA(1, 1), a1 + hstep, voffA);
            PG8_WAIT_L(8); PG8_BAR; PG8_WAIT_L(0); PG8_MMA(0, 0, At, B0); PG8_BAR; PG8_SCHED;
            PG8_LDB(B1, 0, 1); PG8_STAGE(PG8_SB(0, 0), b2, voffB);
            PG8_BAR; PG8_WAIT_L(0); PG8_MMA(0, 1, At, B1); PG8_BAR;
            PG8_LDA(At, 0, 1); PG8_STAGE(PG8_SA(0, 0), a2, voffA);
            PG8_BAR; PG8_WAIT_L(0); PG8_MMA(1, 0, At, B0); PG8_BAR; PG8_SCHED;
            PG8_STAGE(PG8_SB(0, 1), b2 + hstep, voffB);
            PG8_WAIT_V(6); PG8_BAR; PG8_MMA(1, 1, At, B1); PG8_BAR;
            PG8_LDB(B0, 1, 0); PG8_SCHED; PG8_LDA(At, 1, 0); PG8_STAGE(PG8_SA(0, 1), a2 + hstep, voffA);
            PG8_WAIT_L(8); PG8_BAR; PG8_WAIT_L(0); PG8_MMA(0, 0, At, B0); PG8_BAR; PG8_SCHED;
            PG8_LDB(B1, 1, 1); PG8_STAGE(PG8_SB(1, 0), b3, voffB);
            PG8_BAR; PG8_WAIT_L(0); PG8_MMA(0, 1, At, B1); PG8_BAR;
            PG8_LDA(At, 1, 1); PG8_STAGE(PG8_SA(1, 0), a3, voffA);
            PG8_BAR; PG8_WAIT_L(0); PG8_MMA(1, 0, At, B0); PG8_BAR; PG8_SCHED;
            PG8_STAGE(PG8_SB(1, 1), b3 + hstep, voffB);
            PG8_WAIT_V(6); PG8_BAR; PG8_MMA(1, 1, At, B1); PG8_BAR;
            }
        }
        if constexpr (ALIGN_EPI) { if (wr == 0) PG8_BAR; }
        if constexpr (!Epi::AFTER_DRAIN) { E(acc, cur, wr, wc, fr, fq, ui); S.done(cur); }
        if (!has_next) break;
#pragma unroll
        for (int a = 0; a < 2; ++a)
#pragma unroll
            for (int b = 0; b < 2; ++b)
#pragma unroll
                for (int m = 0; m < 4; ++m)
#pragma unroll
                    for (int n = 0; n < 2; ++n) acc[a][b][m][n] = (f32x4){0.f, 0.f, 0.f, 0.f};
        cur = nxt; cA = nA; cB = nB; ++ui;
        if constexpr (ALIGN_EPI) { if (wr == 1) PG8_BAR; }
    }
    PG8_WAIT_V(0);
    if constexpr (!ALIGN_EPI) { if (wr == 0) PG8_BAR; }
    PG8_BAR;
    if constexpr (Epi::AFTER_DRAIN) { E.fused(acc, cur, wr, wc, fr, fq, lds, wid, lane); S.done(cur); }
#undef PG8_KOFF
#undef PG8_PN
#undef PG8_SA
#undef PG8_SB
#undef PG8_STAGE
#undef PG8_LDA
#undef PG8_LDB
#undef PG8_MMA
#undef PG8_WAIT_V
#undef PG8_WAIT_L
#undef PG8_BAR
#undef PG8_SCHED
}
}

constexpr size_t MiB = 1u << 20;
constexpr size_t WS_CTL = 0, CTL_ZERO_BYTES = 1 * MiB;
constexpr size_t WS_MOD = 1 * MiB;
constexpr size_t WS_SHW1 = 2 * MiB;
constexpr size_t WS_SHW2 = 3 * MiB;
constexpr size_t WS_RSSA = 4 * MiB;
constexpr size_t WS_RSSB = 9 * MiB;
constexpr size_t WS_TOT = 14 * MiB;
constexpr size_t WS_CARRY = 19 * MiB;
constexpr size_t WS_WLR = 21 * MiB + 512 * 1024;
constexpr size_t WS_WIN = 22 * MiB;
constexpr size_t WS_WOUT = 32 * MiB;
constexpr size_t WS_W1 = 36 * MiB;
constexpr size_t WS_W2 = 52 * MiB;
constexpr size_t WS_CX = 68 * MiB;
constexpr size_t WS_XA = 84 * MiB;
constexpr size_t WS_HID = 156 * MiB;
constexpr size_t WS_PROJ = WS_HID;
constexpr size_t WS_MIX = WS_HID + 180 * MiB;
constexpr size_t WS_PART = 444 * MiB;
constexpr size_t WS_AB = 436 * MiB;
constexpr size_t WS_END = 508 * MiB;
static_assert(WS_MIX + (size_t)MT * D * 2 <= WS_PART && WS_HID + (size_t)MT * FF * 2 == WS_PART && WS_PART + (size_t)4 * MC * D * 4 == WS_END && WS_AB >= WS_MIX + (size_t)MT * D * 2 && WS_AB + (size_t)1152 * 2 * 2 * 8 * 2 * 64 * 16 == WS_END, "ws map");
constexpr size_t WS_ZERO = WS_CTL + 512 * 1024;
constexpr int CW_BAR = 4096;

#ifndef WGM_IN
#define WGM_IN 4
#endif
#ifndef WGM_OUT
#define WGM_OUT 4
#endif
#ifndef WGM_UP
#define WGM_UP 4
#endif
#ifndef WGM_DN
#define WGM_DN 4
#endif
#ifndef RES_NB
#define RES_NB 2
#endif
constexpr int NWAVES = 8;
constexpr int RING_OFF = 0, RING_BYTES = 131072;
constexpr int LDSCTL_OFF = RING_BYTES, MISC_OFF = LDSCTL_OFF + 320;
constexpr int TBL_OFF = LDSCTL_OFF + 1024;
static_assert(TBL_OFF + 3 * pg8::TBL_UNITS * 256 * 4 <= 163840, "LDS map");
constexpr int LDS_BYTES = 163840;

#define GAS __attribute__((address_space(1)))
#define LAS __attribute__((address_space(3)))
typedef unsigned short bf16;
typedef unsigned v4u __attribute__((ext_vector_type(4)));
typedef unsigned v2u __attribute__((ext_vector_type(2)));
typedef float f32x4 __attribute__((ext_vector_type(4)));
typedef float f32x2 __attribute__((ext_vector_type(2)));
typedef GAS unsigned gu32;
#define LDS_WAIT() asm volatile("s_waitcnt lgkmcnt(0)" ::: "memory")
#define VM_WAIT() asm volatile("s_waitcnt vmcnt(0)" ::: "memory")
__device__ __forceinline__ unsigned f2bf(float f) { unsigned u = __builtin_bit_cast(unsigned, f); return (u + 0x7fffu + ((u >> 16) & 1u)) >> 16; }
__device__ __forceinline__ unsigned pk2(float lo, float hi) { return f2bf(lo) | (f2bf(hi) << 16); }
__device__ __forceinline__ float bflo(unsigned w) { return __uint_as_float(w << 16); }
__device__ __forceinline__ float bfhi(unsigned w) { return __uint_as_float(w & 0xffff0000u); }
__device__ __forceinline__ float bf1(bf16 v) { return __uint_as_float((unsigned)v << 16); }
__device__ __forceinline__ float sigmoidf_(float x) { return __builtin_amdgcn_rcpf(1.f + __builtin_amdgcn_exp2f(-1.4426950408889634f * x)); }
__device__ __forceinline__ float siluf_(float x) { return x * sigmoidf_(x); }
__device__ __forceinline__ float gelu_tanh(float x) { const float u = 0.7978845608028654f * (x + 0.044715f * x * x * x); return x * sigmoidf_(2.f * u); }
__device__ __forceinline__ float lane_xor1_sum(float v) { return v + __builtin_bit_cast(float, __builtin_amdgcn_update_dpp(0, __builtin_bit_cast(int, v), 0xB1, 0xf, 0xf, true)); }
__device__ __forceinline__ float row16_sum_(float v) {
    v += __builtin_bit_cast(float, __builtin_amdgcn_update_dpp(0, __builtin_bit_cast(int, v), 0xB1, 0xf, 0xf, true));
    v += __builtin_bit_cast(float, __builtin_amdgcn_update_dpp(0, __builtin_bit_cast(int, v), 0x4E, 0xf, 0xf, true));
    v += __builtin_bit_cast(float, __builtin_amdgcn_update_dpp(0, __builtin_bit_cast(int, v), 0x141, 0xf, 0xf, true));
    v += __builtin_bit_cast(float, __builtin_amdgcn_update_dpp(0, __builtin_bit_cast(int, v), 0x140, 0xf, 0xf, true));
    return v; }
__device__ __forceinline__ float wave_sum(float v) { v = row16_sum_(v); v += __shfl_xor(v, 16); v += __shfl_xor(v, 32); return v; }

#define XB_TMO      128
#define XB_XCNT(j)  (256  + 64 * (j))
#define XB_XSUB(j)  (1280 + 64 * (j))
#define XB_XGEN(j)  (2304 + 64 * (j))
#define XB_TOP      3328
#define XB_TOPGEN   3392
#define XCD_BAR_WORDS 3456
#define XB_SPIN_CAP (1u << 18)

__device__ __forceinline__ unsigned xb_ld(unsigned* p)              { return __hip_atomic_load(p, __ATOMIC_RELAXED, __HIP_MEMORY_SCOPE_AGENT); }
__device__ __forceinline__ unsigned xb_add(unsigned* p, unsigned v) { return __hip_atomic_fetch_add(p, v, __ATOMIC_RELAXED, __HIP_MEMORY_SCOPE_AGENT); }
__device__ __forceinline__ unsigned xb_xcc_id() { return (unsigned)__builtin_amdgcn_s_getreg((3 << 11) | 20) & 0xFu; }
#define XB_SPIN(cond, bar) do { unsigned _sp = 0; while (cond) { __builtin_amdgcn_s_sleep(1); \
    if ((++_sp & 255u) == 0u) { if (xb_ld(&(bar)[XB_TMO])) break; if (_sp > XB_SPIN_CAP) { atomicAdd(&(bar)[XB_TMO], 1u); break; } } } } while (0)

struct XcdBarrier {
    unsigned* bar; unsigned x;
    volatile LAS unsigned* st;
};

__device__ __forceinline__ XcdBarrier xcd_barrier_post(unsigned* bar, volatile LAS unsigned* st, int tid) {
    XcdBarrier b; b.bar = bar; b.x = xb_xcc_id(); b.st = st;
    if (tid == 0) (void)xb_add(&bar[XB_XCNT(b.x)], 1u);
    return b;
}
__device__ __forceinline__ void xcd_barrier_complete(unsigned* bar, unsigned x, unsigned& nloc, unsigned& nx) {
    const unsigned G = gridDim.x * gridDim.y * gridDim.z;
    unsigned sum, cnt, mine, sp = 0u;
    for (;;) {
        sum = 0u; cnt = 0u; mine = 0u;
        unsigned cv[16];
#pragma unroll
        for (unsigned j = 0; j < 16; ++j) cv[j] = xb_ld(&bar[XB_XCNT(j)]);
#pragma unroll
        for (unsigned j = 0; j < 16; ++j) { const unsigned c = cv[j]; sum += c; cnt += (c > 0u) ? 1u : 0u; mine = (j == x) ? c : mine; }
        if (sum == G) break;
        __builtin_amdgcn_s_sleep(1);
        if ((++sp & 255u) == 0u) { if (xb_ld(&bar[XB_TMO])) break; if (sp > XB_SPIN_CAP) { atomicAdd(&bar[XB_TMO], 1u); break; } }
    }
    nloc = mine > 0u ? mine : 1u; nx = cnt > 0u ? cnt : 1u;
}

__device__ __forceinline__ void xcd_barrier(const XcdBarrier& b, int tid) {
    asm volatile("s_waitcnt vmcnt(0)" ::: "memory");
    __syncthreads();
    if (tid == 0) {
        unsigned* bar = b.bar;
        __builtin_amdgcn_s_waitcnt(0);
        unsigned nloc = b.st[0], nx = b.st[1];
        if (nloc == 0u) { xcd_barrier_complete(bar, b.x, nloc, nx); b.st[0] = nloc; b.st[1] = nx; }
        const unsigned old = xb_add(&bar[XB_XSUB(b.x)], 1u);
        const unsigned gen = old / nloc;
        if (old + 1u == (gen + 1u) * nloc) {
            __builtin_amdgcn_fence(__ATOMIC_RELEASE, "agent");
            asm volatile("s_waitcnt vmcnt(0)" ::: "memory");
            const unsigned og = xb_add(&bar[XB_TOP], 1u);
            const unsigned tg = og / nx;
            if (og + 1u == (tg + 1u) * nx) xb_add(&bar[XB_TOPGEN], 1u);
            else XB_SPIN(xb_ld(&bar[XB_TOPGEN]) == tg, bar);
            __builtin_amdgcn_fence(__ATOMIC_ACQUIRE, "agent");
            xb_add(&bar[XB_XGEN(b.x)], 1u);
            asm volatile("s_waitcnt vmcnt(0)" ::: "memory");
        } else {
            XB_SPIN(xb_ld(&bar[XB_XGEN(b.x)]) == gen, bar);
            __builtin_amdgcn_fence(__ATOMIC_ACQUIRE, "agent");
            asm volatile("s_waitcnt vmcnt(0)" ::: "memory");
        }
    }
    __syncthreads();
}

struct Frame {
    LAS unsigned char* lds;
    int tid, wave;
    int vcu, G;
    int gw, NGW;
    float* out; unsigned char* ws;
};
constexpr int PTR_OFF = LDSCTL_OFF + 512;
__device__ __forceinline__ const float* inp_(LAS unsigned char* lds, int i) {
    const unsigned long long v = *(const LAS unsigned long long*)(lds + PTR_OFF + 8 * i);
    const unsigned lo = __builtin_amdgcn_readfirstlane((unsigned)v), hi = __builtin_amdgcn_readfirstlane((unsigned)(v >> 32));
    return (const float*)(((unsigned long long)hi << 32) | lo);
}
#define INP(i) inp_(F.lds, (i))
#define WSP(T, off) ((T*)(F.ws + (off)))

__device__ __forceinline__ void gemv17_item(Frame& F, const LAS float* tab, LAS float* red, const float* W, int ldw, int n0, const float* bias, float* outp, int ldo, int n0out) {
    int LN_ = F.tid & 63; asm volatile("" : "+v"(LN_));
    float acc[17];
#pragma unroll
    for (int r = 0; r < 17; ++r) acc[r] = 0.f;
    const int k0 = F.wave * 128;
    const float* wp = W + (size_t)k0 * ldw + n0 + LN_;
#pragma unroll 1
    for (int kk = 0; kk < 128; kk += 32) {
        float wv[32];
#pragma unroll
        for (int k = 0; k < 32; ++k) wv[k] = wp[(size_t)(kk + k) * ldw];
#pragma unroll
        for (int k = 0; k < 32; ++k) {
#pragma unroll
            for (int r = 0; r < 17; ++r) acc[r] += tab[r * 1024 + k0 + kk + k] * wv[k];
        }
    }
#pragma unroll
    for (int r = 0; r < 17; ++r) red[(F.wave * 17 + r) * 64 + LN_] = acc[r];
    __syncthreads();
    for (int i = F.tid; i < 17 * 64; i += NWAVES * 64) {
        const int r = i >> 6, n = i & 63; float s = bias ? bias[n0 + n] : 0.f;
#pragma unroll
        for (int w = 0; w < 8; ++w) s += red[(w * 17 + r) * 64 + n];
        outp[(size_t)r * ldo + n0out + n] = s;
    }
    __syncthreads();
}

__host__ __device__ __forceinline__ int glu_col(int o) { return o >= 512 ? o : ((o >> 7) & 1) * 256 + (o >> 8) * 128 + (o & 127); }
__device__ __forceinline__ void p0_transpose_item(const float* W, int K, int N, bf16* WT, LAS float* scr, int item, int lane, bool glu) {
    const int nblk = N / 32, kb = item / nblk, nb = item % nblk, k0 = 64 * kb, n0 = 32 * nb;
    const int n0o = glu ? glu_col(n0) : n0;
    float tv[32];
#pragma unroll
    for (int i = 0; i < 32; ++i) { const int kk = 2 * i + (lane >> 5); tv[i] = W[(size_t)(k0 + kk) * N + n0 + (lane & 31)]; }
#pragma unroll
    for (int i = 0; i < 32; ++i) { const int kk = 2 * i + (lane >> 5); scr[kk * 33 + (lane & 31)] = tv[i]; }
    LDS_WAIT(); asm volatile("" ::: "memory");
    const int c = lane & 7;
#pragma unroll
    for (int j = 0; j < 4; ++j) { const int n = (lane >> 3) + 8 * j; const LAS float* s = scr + (8 * c) * 33 + n;
        v4u o; o.x = pk2(s[0 * 33], s[1 * 33]); o.y = pk2(s[2 * 33], s[3 * 33]); o.z = pk2(s[4 * 33], s[5 * 33]); o.w = pk2(s[6 * 33], s[7 * 33]);
        *(GAS v4u*)(WT + (size_t)(n0o + n) * K + k0 + 8 * c) = o; }
    LDS_WAIT(); asm volatile("" ::: "memory");
}

__device__ __forceinline__ void weight_items(Frame& F, int first, int last, int widx, int nw) {
    int LN_ = F.tid & 63; asm volatile("" : "+v"(LN_));
    LAS float* scr = (LAS float*)(F.lds + F.wave * 16384);
    constexpr int I_IN = (D / 64) * (IND / 32), I_OUT = (D / 64) * (D / 32), I_1 = (D / 64) * (FF / 32), I_2 = (FF / 64) * (D / 32), I_L = I_IN + I_OUT + I_1 + I_2;
    for (int it = first + widx; it < last; it += nw) {
        const int l = it / I_L; int r = it % I_L;
        const float* W; bf16* WT; int K = D, N; const bool glu = r < I_IN;
        if (r < I_IN) { W = INP(8) + (size_t)l * D * IND; WT = WSP(bf16, WS_WIN) + (size_t)l * IND * D; N = IND; }
        else if (r < I_IN + I_OUT) { r -= I_IN; W = INP(9) + (size_t)l * D * D; WT = WSP(bf16, WS_WOUT) + (size_t)l * D * D; N = D; }
        else if (r < I_IN + I_OUT + I_1) { r -= I_IN + I_OUT; W = INP(22) + (size_t)l * D * FF; WT = WSP(bf16, WS_W1) + (size_t)l * FF * D; N = FF; }
        else { r -= I_IN + I_OUT + I_1; W = INP(23) + (size_t)l * FF * D; WT = WSP(bf16, WS_W2) + (size_t)l * D * FF; K = FF; N = D; }
        p0_transpose_item(W, K, N, WT, scr, r, LN_, glu);
    }
}
__device__ __forceinline__ void filler_weights(Frame& F, int total_units, int first, int last) {
    const int rem = total_units % F.G, bx = (int)blockIdx.x;
    if (F.G != 256 || rem == 0 || bx < rem) return;
    __syncthreads();
    weight_items(F, first, last, (bx - rem) * NWAVES + F.wave, (F.G - rem) * NWAVES);
}
constexpr int W_ITEMS = 2 * ((D / 64) * (IND / 32) + (D / 64) * (D / 32) + (D / 64) * (FF / 32) + (FF / 64) * (D / 32));
constexpr int W_F1 = 3840, W_F2 = 8448;
constexpr int W_EARLY = 64 * NWAVES * 3;

__device__ __forceinline__ void phase_p0a(Frame& F) {
    LAS float* tab = (LAS float*)(F.lds);
    LAS float* red = (LAS float*)(F.lds + 17 * 1024 * 4);
    float* MOD = WSP(float, WS_MOD);
    bool filled = false;
    for (int it = F.vcu; it < 2 * 96; it += F.G) {
        if (!filled) {
            {
                const float* c0 = INP(1); const float* c1 = INP(3);
#pragma unroll 1
                for (int r0 = 0; r0 < 16; r0 += 8) { float tv[16];
#pragma unroll
                    for (int j = 0; j < 16; ++j) tv[j] = c0[(r0 + (j >> 1)) * D + F.tid + 512 * (j & 1)];
#pragma unroll
                    for (int j = 0; j < 16; ++j) tab[(r0 + (j >> 1)) * 1024 + F.tid + 512 * (j & 1)] = siluf_(tv[j]); }
                { const float a = c1[F.tid], b = c1[F.tid + 512]; tab[16 * 1024 + F.tid] = siluf_(a); tab[16 * 1024 + F.tid + 512] = siluf_(b); }
            }
            __syncthreads(); filled = true;
        }
        const int l = it / 96, n0 = (it % 96) * 64;
        gemv17_item(F, tab, red, INP(6) + (size_t)l * D * MODW, MODW, n0, INP(7) + (size_t)l * MODW, MOD + (size_t)l * 17 * MODW, MODW, n0);
    }
    if (F.G == 256 && F.vcu >= 192) weight_items(F, 0, W_EARLY, (F.vcu - 192) * NWAVES + F.wave, 64 * NWAVES);
}

__device__ __forceinline__ void phase_p0b(Frame& F) {
    int LN_ = F.tid & 63; asm volatile("" : "+v"(LN_));
    LAS float* tab = (LAS float*)(F.lds);
    LAS float* red = (LAS float*)(F.lds + 17 * 1024 * 4);
    const float* MOD = WSP(const float, WS_MOD);
    bf16* XA = WSP(bf16, WS_XA); float* RSSA = WSP(float, WS_RSSA);
    const int rpw = (MT + F.NGW - 1) / F.NGW;
    auto stream_rows = [&](int run0, int runlen) __attribute__((always_inline)) {
        const float* g1 = INP(4);
        auto row_ptr = [&](int r_) -> const float* { return r_ < ML ? INP(0) + (size_t)r_ * D : INP(2) + (size_t)(r_ - ML) * D; };
        {
            const int rbeg = run0 < MT ? run0 : MT, rend = (rbeg + runlen < MT) ? rbeg + runlen : MT;
            f32x4 vn[2][4], gm[4]; int cur_b = -1;
            if (rbeg < rend) {
#pragma unroll
                for (int q = 0; q < 2; ++q) { const int r_ = (rbeg + q < rend) ? rbeg + q : rbeg; const float* xr = row_ptr(r_);
#pragma unroll
                    for (int j = 0; j < 4; ++j) vn[q][j] = *(const f32x4*)(xr + 4 * LN_ + 256 * j); }
            }
#pragma unroll 1
            for (int row = rbeg; row < rend; row += 2) {
                f32x4 v[2][4];
#pragma unroll
                for (int q = 0; q < 2; ++q)
#pragma unroll
                    for (int j = 0; j < 4; ++j) v[q][j] = vn[q][j];
                if (row + 2 < rend) {
#pragma unroll
                    for (int q = 0; q < 2; ++q) { const int r_ = (row + 2 + q < rend) ? row + 2 + q : row + 2; const float* xr = row_ptr(r_);
#pragma unroll
                        for (int j = 0; j < 4; ++j) vn[q][j] = *(const f32x4*)(xr + 4 * LN_ + 256 * j); }
                }
                float ss[2];
#pragma unroll
                for (int q = 0; q < 2; ++q) { float s_ = 0.f;
#pragma unroll
                    for (int j = 0; j < 4; ++j) s_ += (v[q][j][0] * v[q][j][0] + v[q][j][1] * v[q][j][1]) + (v[q][j][2] * v[q][j][2] + v[q][j][3] * v[q][j][3]);
                    ss[q] = wave_sum(s_); }
#pragma unroll
                for (int q = 0; q < 2; ++q) { const int r_ = row + q; if (r_ >= rend) break;
                    const int bt = r_ < ML ? (r_ >> 11) : NB;
                    if (bt != cur_b) { cur_b = bt; const float* scp = MOD + (size_t)bt * MODW + D;
#pragma unroll
                        for (int j = 0; j < 4; ++j) { const int k = 4 * LN_ + 256 * j; gm[j] = *(const f32x4*)(g1 + k) * (*(const f32x4*)(scp + k) + 1.0f); } }
                    if (LN_ < 32) RSSA[(size_t)r_ * 32 + LN_] = (LN_ == 0) ? ss[q] : 0.f;
#pragma unroll
                    for (int j = 0; j < 4; ++j) { const int k = 4 * LN_ + 256 * j; const f32x4 a = v[q][j] * gm[j];
                        v2u o; o.x = pk2(a[0], a[1]); o.y = pk2(a[2], a[3]); *(v2u*)(XA + (size_t)r_ * D + k) = o; } }
            }
        }
    };
    bool rows_done = false;
    for (int it = F.vcu; it < 2 * 104; it += F.G) {
        const int l = it / 104, j = it % 104; const bool first = j < 40;
        const int shoff = first ? 0 : 3 * D;
        __syncthreads();
        {
            const float* mrow = MOD + (size_t)l * 17 * MODW + shoff;
#pragma unroll 1
            for (int r0 = 0; r0 < 16; r0 += 8) { float tv[16];
#pragma unroll
                for (int j = 0; j < 16; ++j) tv[j] = mrow[(size_t)(r0 + (j >> 1)) * MODW + F.tid + 512 * (j & 1)];
#pragma unroll
                for (int j = 0; j < 16; ++j) tab[(r0 + (j >> 1)) * 1024 + F.tid + 512 * (j & 1)] = tv[j]; }
            { const float a = mrow[(size_t)16 * MODW + F.tid], b = mrow[(size_t)16 * MODW + F.tid + 512]; tab[16 * 1024 + F.tid] = a; tab[16 * 1024 + F.tid + 512] = b; }
        }
        __syncthreads();
        const int ldw = first ? IND : FF, n0 = (first ? j : j - 40) * 64;
        const float* W = first ? INP(8) + (size_t)l * D * IND : INP(22) + (size_t)l * D * FF;
        float* outp = first ? WSP(float, WS_SHW1) + (size_t)l * 17 * IND : WSP(float, WS_SHW2) + (size_t)l * 17 * FF;
        const int n0out = first ? glu_col(j * 64) : (j - 40) * 64;
        const bool split = !rows_done;
        float acc[17];
#pragma unroll
        for (int r = 0; r < 17; ++r) acc[r] = 0.f;
        if (split && F.wave < 4) {
            if (F.G == 256) stream_rows((F.vcu * 4 + F.wave) * 30, 30); else stream_rows((F.vcu * 4 + F.wave) * (2 * rpw), 2 * rpw); }
        else {
            const int kcnt = split ? 256 : 128, k0 = split ? (F.wave - 4) * 256 : F.wave * 128;
            const float* wp = W + (size_t)k0 * ldw + n0 + LN_;
#pragma unroll 1
            for (int kk = 0; kk < kcnt; kk += 32) {
                float wv[32];
#pragma unroll
                for (int k = 0; k < 32; ++k) wv[k] = wp[(size_t)(kk + k) * ldw];
#pragma unroll
                for (int k = 0; k < 32; ++k) {
#pragma unroll
                    for (int r = 0; r < 17; ++r) acc[r] += tab[r * 1024 + k0 + kk + k] * wv[k];
                }
            }
        }
        rows_done = true;
#pragma unroll
        for (int r = 0; r < 17; ++r) red[(F.wave * 17 + r) * 64 + LN_] = acc[r];
        __syncthreads();
        for (int i = F.tid; i < 17 * 64; i += NWAVES * 64) {
            const int r = i >> 6, n = i & 63; float s_ = 0.f;
#pragma unroll
            for (int w = 0; w < 8; ++w) s_ += red[(w * 17 + r) * 64 + n];
            outp[(size_t)r * ldw + n0out + n] = s_;
        }
        __syncthreads();
    }
    if (!rows_done) { if (F.G == 256) stream_rows(208 * 4 * 30 + ((F.vcu - 208) * NWAVES + F.wave) * 31, 31); else stream_rows((F.vcu * NWAVES + F.wave) * rpw, rpw); }
    __syncthreads();
    {
        bf16* WLR = WSP(bf16, WS_WLR);
        for (int i = F.gw * 64 + LN_; i < 2 * 2 * 4 * 2 * 4096; i += F.NGW * 64) { const int d = i & 63, e = (i >> 6) & 63, gt = (i >> 12) & 1, blk = i >> 13;
            const float* src = gt == 0 ? INP(17) : INP(19); WLR[i] = (bf16)f2bf(src[((size_t)blk * 64 + d) * 64 + e]); }
    }
    if (F.G != 256) weight_items(F, 0, W_ITEMS, F.gw, F.NGW);
}

constexpr int CV_OSROW = 260;
__device__ __forceinline__ void conv_phase(Frame& F, int l, int ntiles) {
    const bf16* PROJ = WSP(const bf16, WS_PROJ); bf16* MIX = WSP(bf16, WS_MIX);
    LAS float* us = (LAS float*)(F.lds);
    LAS float* os = (LAS float*)(F.lds + 62 * 256 * 4);
    const int c = F.tid & 255, half = F.tid >> 8;
    float w[31];
#pragma unroll
    for (int k = 0; k < 31; ++k) w[k] = INP(10)[((size_t)l * 31 + k) * 256 + c];
    const float cbias = INP(11)[l * 256 + c];
    const int lt = F.tid >> 4, lseg = F.tid & 15;
    f32x4 lg[4], lb[4];
#pragma unroll
    for (int q = 0; q < 4; ++q) { lg[q] = *(const f32x4*)(INP(12) + l * 256 + 16 * lseg + 4 * q); lb[q] = *(const f32x4*)(INP(13) + l * 256 + 16 * lseg + 4 * q); }
    auto row16_sum = [](float v) -> float {
        v += __builtin_bit_cast(float, __builtin_amdgcn_update_dpp(0, __builtin_bit_cast(int, v), 0xB1, 0xf, 0xf, true));
        v += __builtin_bit_cast(float, __builtin_amdgcn_update_dpp(0, __builtin_bit_cast(int, v), 0x4E, 0xf, 0xf, true));
        v += __builtin_bit_cast(float, __builtin_amdgcn_update_dpp(0, __builtin_bit_cast(int, v), 0x141, 0xf, 0xf, true));
        v += __builtin_bit_cast(float, __builtin_amdgcn_update_dpp(0, __builtin_bit_cast(int, v), 0x140, 0xf, 0xf, true));
        return v; };
    unsigned pv[16];
    auto load_tile = [&](int T) {
        const int row0 = T * 32;
        int lo, hi; if (row0 < ML) { lo = row0 & ~(SEQ - 1); hi = lo + SEQ; } else { lo = row0 & ~(CTXL - 1); hi = lo + CTXL; }
#pragma unroll
        for (int j = 0; j < 16; ++j) { const int i = F.tid + 512 * j, rr = i >> 7, cp = i & 127, row = row0 - 15 + rr;
            const bool ok = (j < 15 || F.tid < 256) && row >= lo && row < hi;
            pv[j] = ok ? *(const unsigned*)(PROJ + (size_t)row * IND + 2 * cp) : 0u; }
    };
    const int T0 = F.G - 1 - F.vcu;
    if (T0 < ntiles) load_tile(T0);
    for (int T = T0; T < ntiles; T += F.G) {
        const int row0 = T * 32;
        __syncthreads();
#pragma unroll
        for (int j = 0; j < 16; ++j) { const int i = F.tid + 512 * j;
            if (j < 15 || F.tid < 256) { f32x2 u; u[0] = bflo(pv[j]); u[1] = bfhi(pv[j]); *(LAS f32x2*)(us + 2 * i) = u; } }
        if (T + F.G < ntiles) load_tile(T + F.G);
        __syncthreads();
        {
            float acc[16];
#pragma unroll
            for (int j = 0; j < 16; ++j) acc[j] = cbias;
            const LAS float* up = us + (16 * half) * 256 + c;
#pragma unroll
            for (int i = 0; i < 46; ++i) { const float x = up[i * 256];
#pragma unroll
                for (int j = 0; j < 16; ++j) if (i - j >= 0 && i - j <= 30) acc[j] += w[i - j] * x; }
#pragma unroll
            for (int j = 0; j < 16; ++j) os[(16 * half + j) * CV_OSROW + c] = acc[j];
        }
        __syncthreads();
        {
            f32x4 v[4];
#pragma unroll
            for (int q = 0; q < 4; ++q) v[q] = *(const LAS f32x4*)(os + lt * CV_OSROW + 16 * lseg + 4 * q);
            float s1 = 0.f;
#pragma unroll
            for (int q = 0; q < 4; ++q) s1 += (v[q][0] + v[q][1]) + (v[q][2] + v[q][3]);
            const float mu = row16_sum(s1) * (1.f / 256.f);
            float s2 = 0.f;
#pragma unroll
            for (int q = 0; q < 4; ++q) { v[q] = v[q] - mu; s2 += (v[q][0] * v[q][0] + v[q][1] * v[q][1]) + (v[q][2] * v[q][2] + v[q][3] * v[q][3]); }
            const float rstd = rsqrtf(row16_sum(s2) * (1.f / 256.f) + EPS);
            unsigned ow[8];
#pragma unroll
            for (int q = 0; q < 4; ++q) { const f32x4 y = v[q] * rstd * lg[q] + lb[q];
                ow[2 * q] = pg8::cvt_pk_bf16(siluf_(y[0]), siluf_(y[1])); ow[2 * q + 1] = pg8::cvt_pk_bf16(siluf_(y[2]), siluf_(y[3])); }
            bf16* op = MIX + (size_t)(row0 + lt) * D + 16 * lseg;
            *(v4u*)op = (v4u){ow[0], ow[1], ow[2], ow[3]}; *(v4u*)(op + 8) = (v4u){ow[4], ow[5], ow[6], ow[7]};
        }
    }
}

typedef short s16x8 __attribute__((ext_vector_type(8)));
typedef short s16x4 __attribute__((ext_vector_type(4)));
constexpr int NA_KROW = 144, NA_VROW = 160;
constexpr int NA_STAGE = 64 * NA_KROW + 64 * NA_VROW, NA_SLOT = 2 * NA_STAGE, NA_OFF_TB = 2 * NA_SLOT;
static_assert(NA_OFF_TB + 2560 <= RING_BYTES, "NA LDS map");
constexpr int NA_ITEMS_LAT = NB * NH * 8, NA_ITEMS_CTX = NB * NH * 2;
struct NaBlk { f32x4 O[4]; f32x4 nm4; float m, lsum; int first; };
__device__ __forceinline__ int na_rs(int r) { int v = r - 4; return v < 0 ? 0 : (v > 24 ? 24 : v); }
__device__ __forceinline__ s16x8 na_scale_q(v4u w, float c) {
    v4u o; o.x = pg8::cvt_pk_bf16(bflo(w.x) * c, bfhi(w.x) * c); o.y = pg8::cvt_pk_bf16(bflo(w.y) * c, bfhi(w.y) * c); o.z = pg8::cvt_pk_bf16(bflo(w.z) * c, bfhi(w.z) * c); o.w = pg8::cvt_pk_bf16(bflo(w.w) * c, bfhi(w.w) * c);
    return __builtin_bit_cast(s16x8, o);
}
__device__ __forceinline__ void na_phase(Frame& F, int l, int nitems, int nav = 0) {
    int LN_ = F.tid & 63; asm volatile("" : "+v"(LN_));
    const bf16* PROJ = WSP(const bf16, WS_PROJ); bf16* MIX = WSP(bf16, WS_MIX);
    LAS float* tb = (LAS float*)(F.lds + NA_OFF_TB);
    const int lane = LN_, q16 = lane & 15, g = lane >> 4;
    const unsigned skey = (unsigned)(F.tid >> 3), spart = (unsigned)(F.tid & 7);
    const float c1 = 0.125f * 1.4426950408889634f;
    struct NaItem { int b, h, ra, qrow0, rsI, nloc, nch, npair, isctx; };
    auto decode = [&](int it, NaItem& I) {
        I.isctx = it >= NA_ITEMS_LAT ? 1 : 0; I.ra = 0; I.rsI = 0; I.nloc = 0;
        if (!I.isctx) { const int r4 = (it + 2 * (it / F.G)) & 7; I.h = (it >> 3) & 7; I.b = it >> 6; const int r0 = 4 * r4; I.ra = r0 + 2 * (F.wave >> 2); I.qrow0 = I.b * SEQ + I.ra * 64 + (F.wave & 3) * 16;
            I.rsI = na_rs(r0); I.nloc = na_rs(r0 + 3) + 8 - I.rsI; }
        else { const int j = it - NA_ITEMS_LAT; const int hf = j & 1; I.h = (j >> 1) & 7; I.b = j >> 4; I.qrow0 = ML + I.b * CTXL + hf * 128 + F.wave * 16; }
        I.nch = I.nloc + 4; I.npair = (I.nch + 1) >> 1;
    };
    auto krow_of = [&](const NaItem& I, int ch) -> int { if (ch > I.nch - 1) ch = I.nch - 1; return ch < I.nloc ? I.b * SEQ + (I.rsI + ch) * 64 : ML + I.b * CTXL + (ch - I.nloc) * 64; };
    const int jq = F.wave & 3;
    const int o0 = jq == 0 ? 0 : 16 * jq - 8, o1 = jq == 0 ? 16 : (jq == 3 ? 48 : 16 * jq + 8);
    float madd[2][4]; int lb[2];
    {
        const int qc = jq * 16 + q16; int cs = qc - 8; cs = cs < 0 ? 0 : (cs > 48 ? 48 : cs);
#pragma unroll
        for (int e = 0; e < 4; ++e) { const int k0 = o0 + 4 * g + e, k1 = o1 + 4 * g + e;
            madd[0][e] = ((unsigned)(k0 - cs) < 16u) ? 0.f : -1.0e30f;
            madd[1][e] = (((unsigned)(k1 - cs) < 16u) && !(jq == 3 && k1 < 56)) ? 0.f : -1.0e30f; }
        lb[0] = 64 + o0 + 4 * g - qc + 15; lb[1] = 64 + o1 + 4 * g - qc + 15;
    }
    v4u kr0, vr0, kr1, vr1, qrA[2], qrB[2];
    auto issue_first = [&](const NaItem& I) {
        const bf16* Pk = PROJ + 1024 + I.h * HD + 8 * spart, * Pv = PROJ + 1536 + I.h * HD + 8 * spart, * Pq = PROJ + 512 + I.h * HD;
        kr0 = *(const v4u*)(Pk + (size_t)(krow_of(I, 0) + (int)skey) * IND); vr0 = *(const v4u*)(Pv + (size_t)(krow_of(I, 0) + (int)skey) * IND);
        kr1 = *(const v4u*)(Pk + (size_t)(krow_of(I, 1) + (int)skey) * IND); vr1 = *(const v4u*)(Pv + (size_t)(krow_of(I, 1) + (int)skey) * IND);
#pragma unroll
        for (int s_ = 0; s_ < 2; ++s_) { qrA[s_] = *(const v4u*)(Pq + (size_t)(I.qrow0 + q16) * IND + 32 * s_ + 8 * g);
            qrB[s_] = I.isctx ? qrA[s_] : *(const v4u*)(Pq + (size_t)(I.qrow0 + 64 + q16) * IND + 32 * s_ + 8 * g); }
    };
    NaItem I; int it = F.vcu; bool have = it < nitems; int tb_h = -1;
    if (have) { decode(it, I); issue_first(I); }
    while (have) {
        const bool isctx = I.isctx != 0;
        const int ra = I.ra, rsI = I.rsI, nloc = I.nloc, nch = I.nch, npair = I.npair, qrow0 = I.qrow0, h = I.h;
        const bf16* Pk = PROJ + 1024 + h * HD + 8 * spart, * Pv = PROJ + 1536 + h * HD + 8 * spart;
        s16x8 qfA[2], qfB[2];
#pragma unroll
        for (int s_ = 0; s_ < 2; ++s_) { qfA[s_] = na_scale_q(qrA[s_], c1); qfB[s_] = na_scale_q(qrB[s_], c1); }
        const int rsA = na_rs(ra), rsB = na_rs(ra + 1);
        NaItem N; const int itn = it + F.G; const bool haven = itn < nitems; if (haven) decode(itn, N); else N = I;
        __syncthreads();
        if (!isctx && h != tb_h) { const float* rpb = INP(14) + ((size_t)l * NH + h) * 15 * 31; tb_h = h;
            for (int i = F.tid; i < 640; i += NWAVES * 64) tb[i] = (i >= 64 && i < 64 + 465) ? rpb[i - 64] * 1.4426950408889634f : 0.f; }
        {
            LAS unsigned char* s0 = F.lds;
            *(LAS v4u*)(s0 + skey * NA_KROW + spart * 16) = kr0; *(LAS v4u*)(s0 + 64 * NA_KROW + skey * NA_VROW + spart * 16) = vr0;
            *(LAS v4u*)(s0 + NA_STAGE + skey * NA_KROW + spart * 16) = kr1; *(LAS v4u*)(s0 + NA_STAGE + 64 * NA_KROW + skey * NA_VROW + spart * 16) = vr1;
        }
        if (npair > 2) {
            kr0 = *(const v4u*)(Pk + (size_t)(krow_of(I, 2) + (int)skey) * IND); vr0 = *(const v4u*)(Pv + (size_t)(krow_of(I, 2) + (int)skey) * IND);
            kr1 = *(const v4u*)(Pk + (size_t)(krow_of(I, 3) + (int)skey) * IND); vr1 = *(const v4u*)(Pv + (size_t)(krow_of(I, 3) + (int)skey) * IND);
        } else {
            kr0 = *(const v4u*)(Pk + (size_t)(krow_of(I, 2) + (int)skey) * IND); vr0 = *(const v4u*)(Pv + (size_t)(krow_of(I, 2) + (int)skey) * IND);
            kr1 = *(const v4u*)(Pk + (size_t)(krow_of(I, 3) + (int)skey) * IND); vr1 = *(const v4u*)(Pv + (size_t)(krow_of(I, 3) + (int)skey) * IND);
        }
        NaBlk A, B;
#pragma unroll
        for (int dt = 0; dt < 4; ++dt) { A.O[dt] = (f32x4){0.f, 0.f, 0.f, 0.f}; B.O[dt] = (f32x4){0.f, 0.f, 0.f, 0.f}; }
        A.m = 0.f; A.lsum = 0.f; A.first = 1; B.m = 0.f; B.lsum = 0.f; B.first = 1; A.nm4 = (f32x4){0.f, 0.f, 0.f, 0.f}; B.nm4 = (f32x4){0.f, 0.f, 0.f, 0.f};
        for (int cp = 0; cp < npair; ++cp) {
            __syncthreads();
            if (cp + 1 < npair) { LAS unsigned char* nx = F.lds + ((cp + 1) & 1) * NA_SLOT;
                *(LAS v4u*)(nx + skey * NA_KROW + spart * 16) = kr0; *(LAS v4u*)(nx + 64 * NA_KROW + skey * NA_VROW + spart * 16) = vr0;
                *(LAS v4u*)(nx + NA_STAGE + skey * NA_KROW + spart * 16) = kr1; *(LAS v4u*)(nx + NA_STAGE + 64 * NA_KROW + skey * NA_VROW + spart * 16) = vr1; }
            if (cp + 2 < npair) { const int k2 = krow_of(I, 2 * cp + 4) + (int)skey, k3 = krow_of(I, 2 * cp + 5) + (int)skey;
                kr0 = *(const v4u*)(Pk + (size_t)k2 * IND); vr0 = *(const v4u*)(Pv + (size_t)k2 * IND); kr1 = *(const v4u*)(Pk + (size_t)k3 * IND); vr1 = *(const v4u*)(Pv + (size_t)k3 * IND); }
            else if (cp + 2 == npair && haven) issue_first(N);
          for (int sub = 0; sub < 2; ++sub) {
            const int ch = 2 * cp + sub;
            if (ch >= nch) break;
            LAS unsigned char* cur = F.lds + (cp & 1) * NA_SLOT + sub * NA_STAGE;
            const bool local = ch < nloc;
            const int kr = rsI + ch;
            const bool actA = !local || (kr >= rsA && kr <= rsA + 7), actB = !isctx && (!local || (kr >= rsB && kr <= rsB + 7));
            if ((!actA && !actB) || nav == 1) continue;
            auto fix = [&](f32x4* S, int nt_, NaBlk& X, float cm) __attribute__((always_inline)) {
                cm = fmaxf(cm, __shfl_xor(cm, 16)); cm = fmaxf(cm, __shfl_xor(cm, 32));
                const float d = X.first ? cm : fmaxf(cm, 0.f);
                if (!X.first) { const float alpha = __builtin_amdgcn_exp2f(-d); X.lsum *= alpha;
#pragma unroll
                    for (int dt = 0; dt < 4; ++dt)
#pragma unroll
                        for (int e = 0; e < 4; ++e) { float o_ = X.O[dt][e]; asm("v_mul_f32 %0, %0, %1" : "+v"(o_) : "v"(alpha)); X.O[dt][e] = o_; } }
                X.m += d; X.first = 0;
#pragma unroll
                for (int e = 0; e < 4; ++e) { float n_ = X.nm4[e]; asm("v_sub_f32 %0, %0, %1" : "+v"(n_) : "v"(d)); X.nm4[e] = n_; }
#pragma unroll
                for (int t = 0; t < 4; ++t) if (t < nt_) S[t] = S[t] - d;
            };
            auto probs = [&](f32x4* S, int nt_, NaBlk& X, unsigned (*pk)[2]) __attribute__((always_inline)) {
                float ps = 0.f;
#pragma unroll
                for (int t = 0; t < 4; ++t) if (t < nt_) {
                    const float p0 = __builtin_amdgcn_exp2f(S[t][0]), p1 = __builtin_amdgcn_exp2f(S[t][1]), p2 = __builtin_amdgcn_exp2f(S[t][2]), p3 = __builtin_amdgcn_exp2f(S[t][3]);
                    ps += (p0 + p1) + (p2 + p3);
                    pk[t][0] = pg8::cvt_pk_bf16(p0, p1); pk[t][1] = pg8::cvt_pk_bf16(p2, p3); }
                X.lsum += ps;
            };
            auto finish = [&](f32x4* S, int nt_, NaBlk& X, unsigned (*pk)[2], float cm) __attribute__((always_inline)) {
                if (__builtin_expect(X.first || !__all(cm <= 8.f), 0)) fix(S, nt_, X, cm);
                probs(S, nt_, X, pk);
            };
            auto finish2 = [&](f32x4* SA, f32x4* SB, int nt_, unsigned (*pa)[2], unsigned (*pb)[2], float cmA, float cmB) __attribute__((always_inline)) {
                if (__builtin_expect(A.first || B.first || !__all(fmaxf(cmA, cmB) <= 8.f), 0)) {
                    if (A.first || !__all(cmA <= 8.f)) fix(SA, nt_, A, cmA);
                    if (B.first || !__all(cmB <= 8.f)) fix(SB, nt_, B, cmB);
                }
                probs(SA, nt_, A, pa); probs(SB, nt_, B, pb);
            };
            auto bias_local = [&](f32x4 (&S)[2], int rq) __attribute__((always_inline)) -> float {
                float cm = -1.0e30f;
#pragma unroll
                for (int t = 0; t < 2; ++t) { const LAS float* tr_ = tb + (kr - rq + 7) * 31 + lb[t];
#pragma unroll
                    for (int e = 0; e < 4; ++e) { const float v = (S[t][e] + tr_[e]) + madd[t][e]; S[t][e] = v; cm = fmaxf(cm, v); } }
                return cm;
            };
            auto max_ctx = [&](f32x4 (&S)[4]) __attribute__((always_inline)) -> float {
                float cm = -1.0e30f;
#pragma unroll
                for (int t = 0; t < 4; ++t)
#pragma unroll
                    for (int e = 0; e < 4; ++e) cm = fmaxf(cm, S[t][e]);
                return cm;
            };
            const LAS unsigned char* kb_ = cur + q16 * NA_KROW + 16 * g;
            const LAS unsigned char* vtr = cur + 64 * NA_KROW + (4 * g + (q16 >> 2)) * NA_VROW + (q16 & 3) * 8;
            auto local_both = [&]() __attribute__((always_inline)) {
                unsigned pkA[4][2], pkB[4][2];
                f32x4 SA[2], SB[2];
                s16x8 kf[2][2];
#pragma unroll
                for (int t = 0; t < 2; ++t) { const int o = t == 0 ? o0 : o1;
#pragma unroll
                    for (int s_ = 0; s_ < 2; ++s_) kf[t][s_] = *(const LAS s16x8*)(kb_ + o * NA_KROW + 64 * s_); }
#pragma unroll
                for (int t = 0; t < 2; ++t) { SA[t] = __builtin_amdgcn_mfma_f32_16x16x32_bf16(kf[t][0], qfA[0], A.nm4, 0, 0, 0); SB[t] = __builtin_amdgcn_mfma_f32_16x16x32_bf16(kf[t][0], qfB[0], B.nm4, 0, 0, 0); }
#pragma unroll
                for (int t = 0; t < 2; ++t) { SA[t] = __builtin_amdgcn_mfma_f32_16x16x32_bf16(kf[t][1], qfA[1], SA[t], 0, 0, 0); SB[t] = __builtin_amdgcn_mfma_f32_16x16x32_bf16(kf[t][1], qfB[1], SB[t], 0, 0, 0); }
                if (nav == 2) { asm volatile("" :: "v"(SA[0]), "v"(SA[1]), "v"(SB[0]), "v"(SB[1])); return; }
                const float cmA = bias_local(SA, ra), cmB = bias_local(SB, ra + 1);
                finish2(SA, SB, 2, pkA, pkB, cmA, cmB);
                if (nav == 3) { asm volatile("" :: "v"(pkA[0][0]), "v"(pkA[1][1]), "v"(pkB[0][0]), "v"(pkB[1][1])); return; }
                const v4u bwA = {pkA[0][0], pkA[0][1], pkA[1][0], pkA[1][1]}, bwB = {pkB[0][0], pkB[0][1], pkB[1][0], pkB[1][1]};
                const s16x8 bfA = __builtin_bit_cast(s16x8, bwA), bfB = __builtin_bit_cast(s16x8, bwB);
#pragma unroll
                for (int dt = 0; dt < 4; ++dt) {
                    const s16x4 a0 = __builtin_amdgcn_ds_read_tr16_b64_v4i16((LAS s16x4*)(vtr + o0 * NA_VROW + dt * 32));
                    const s16x4 a1 = __builtin_amdgcn_ds_read_tr16_b64_v4i16((LAS s16x4*)(vtr + o1 * NA_VROW + dt * 32));
                    const s16x8 afrag = __builtin_shufflevector(a0, a1, 0, 1, 2, 3, 4, 5, 6, 7);
                    A.O[dt] = __builtin_amdgcn_mfma_f32_16x16x32_bf16(afrag, bfA, A.O[dt], 0, 0, 0);
                    B.O[dt] = __builtin_amdgcn_mfma_f32_16x16x32_bf16(afrag, bfB, B.O[dt], 0, 0, 0);
                }
            };
            auto local_one = [&](NaBlk& X, const s16x8 (&qf)[2], int rq) __attribute__((always_inline)) {
                unsigned pk[4][2];
                f32x4 S[2];
#pragma unroll
                for (int t = 0; t < 2; ++t) { S[t] = X.nm4;
                    const int o = t == 0 ? o0 : o1;
#pragma unroll
                    for (int s_ = 0; s_ < 2; ++s_) { const s16x8 kf = *(const LAS s16x8*)(kb_ + o * NA_KROW + 64 * s_);
                        S[t] = __builtin_amdgcn_mfma_f32_16x16x32_bf16(kf, qf[s_], S[t], 0, 0, 0); } }
                if (nav == 2) { asm volatile("" :: "v"(S[0]), "v"(S[1])); return; }
                const float cm = bias_local(S, rq);
                finish(S, 2, X, pk, cm);
                if (nav == 3) { asm volatile("" :: "v"(pk[0][0]), "v"(pk[1][1])); return; }
                const v4u bw = {pk[0][0], pk[0][1], pk[1][0], pk[1][1]};
                const s16x8 bf = __builtin_bit_cast(s16x8, bw);
#pragma unroll
                for (int dt = 0; dt < 4; ++dt) {
                    const s16x4 a0 = __builtin_amdgcn_ds_read_tr16_b64_v4i16((LAS s16x4*)(vtr + o0 * NA_VROW + dt * 32));
                    const s16x4 a1 = __builtin_amdgcn_ds_read_tr16_b64_v4i16((LAS s16x4*)(vtr + o1 * NA_VROW + dt * 32));
                    const s16x8 afrag = __builtin_shufflevector(a0, a1, 0, 1, 2, 3, 4, 5, 6, 7);
                    X.O[dt] = __builtin_amdgcn_mfma_f32_16x16x32_bf16(afrag, bf, X.O[dt], 0, 0, 0);
                }
            };
            auto ctx_both = [&]() __attribute__((always_inline)) {
                unsigned pkA[4][2], pkB[4][2];
                f32x4 SA[4], SB[4];
                { s16x8 kf[4][2];
#pragma unroll
                  for (int t = 0; t < 4; ++t)
#pragma unroll
                      for (int s_ = 0; s_ < 2; ++s_) kf[t][s_] = *(const LAS s16x8*)(kb_ + t * 16 * NA_KROW + 64 * s_);
#pragma unroll
                  for (int t = 0; t < 4; ++t) { SA[t] = __builtin_amdgcn_mfma_f32_16x16x32_bf16(kf[t][0], qfA[0], A.nm4, 0, 0, 0); SB[t] = __builtin_amdgcn_mfma_f32_16x16x32_bf16(kf[t][0], qfB[0], B.nm4, 0, 0, 0); }
#pragma unroll
                  for (int t = 0; t < 4; ++t) { SA[t] = __builtin_amdgcn_mfma_f32_16x16x32_bf16(kf[t][1], qfA[1], SA[t], 0, 0, 0); SB[t] = __builtin_amdgcn_mfma_f32_16x16x32_bf16(kf[t][1], qfB[1], SB[t], 0, 0, 0); } }
                if (nav == 2) { asm volatile("" :: "v"(SA[0]), "v"(SA[1]), "v"(SA[2]), "v"(SA[3]), "v"(SB[0]), "v"(SB[1]), "v"(SB[2]), "v"(SB[3])); return; }
                const float cmA = max_ctx(SA), cmB = max_ctx(SB);
                finish2(SA, SB, 4, pkA, pkB, cmA, cmB);
                if (nav == 3) { asm volatile("" :: "v"(pkA[0][0]), "v"(pkA[1][1]), "v"(pkA[2][0]), "v"(pkA[3][1]), "v"(pkB[0][0]), "v"(pkB[1][1]), "v"(pkB[2][0]), "v"(pkB[3][1])); return; }
#pragma unroll
                for (int p = 0; p < 2; ++p) {
                    const v4u bwA = {pkA[2 * p][0], pkA[2 * p][1], pkA[2 * p + 1][0], pkA[2 * p + 1][1]}, bwB = {pkB[2 * p][0], pkB[2 * p][1], pkB[2 * p + 1][0], pkB[2 * p + 1][1]};
                    const s16x8 bfA = __builtin_bit_cast(s16x8, bwA), bfB = __builtin_bit_cast(s16x8, bwB);
#pragma unroll
                    for (int dt = 0; dt < 4; ++dt) {
                        const s16x4 a0 = __builtin_amdgcn_ds_read_tr16_b64_v4i16((LAS s16x4*)(vtr + (2 * p) * 16 * NA_VROW + dt * 32));
                        const s16x4 a1 = __builtin_amdgcn_ds_read_tr16_b64_v4i16((LAS s16x4*)(vtr + (2 * p + 1) * 16 * NA_VROW + dt * 32));
                        const s16x8 afrag = __builtin_shufflevector(a0, a1, 0, 1, 2, 3, 4, 5, 6, 7);
                        A.O[dt] = __builtin_amdgcn_mfma_f32_16x16x32_bf16(afrag, bfA, A.O[dt], 0, 0, 0);
                        B.O[dt] = __builtin_amdgcn_mfma_f32_16x16x32_bf16(afrag, bfB, B.O[dt], 0, 0, 0);
                    }
                }
            };
            auto ctx_one = [&]() __attribute__((always_inline)) {
                unsigned pk[4][2];
                f32x4 S[4];
#pragma unroll
                for (int t = 0; t < 4; ++t) { S[t] = A.nm4;
#pragma unroll
                    for (int s_ = 0; s_ < 2; ++s_) { const s16x8 kf = *(const LAS s16x8*)(kb_ + t * 16 * NA_KROW + 64 * s_);
                        S[t] = __builtin_amdgcn_mfma_f32_16x16x32_bf16(kf, qfA[s_], S[t], 0, 0, 0); } }
                if (nav == 2) { asm volatile("" :: "v"(S[0]), "v"(S[1]), "v"(S[2]), "v"(S[3])); return; }
                const float cm = max_ctx(S);
                finish(S, 4, A, pk, cm);
                if (nav == 3) { asm volatile("" :: "v"(pk[0][0]), "v"(pk[1][1]), "v"(pk[2][0]), "v"(pk[3][1])); return; }
#pragma unroll
                for (int p = 0; p < 2; ++p) {
                    const v4u bw = {pk[2 * p][0], pk[2 * p][1], pk[2 * p + 1][0], pk[2 * p + 1][1]};
                    const s16x8 bf = __builtin_bit_cast(s16x8, bw);
#pragma unroll
                    for (int dt = 0; dt < 4; ++dt) {
                        const s16x4 a0 = __builtin_amdgcn_ds_read_tr16_b64_v4i16((LAS s16x4*)(vtr + (2 * p) * 16 * NA_VROW + dt * 32));
                        const s16x4 a1 = __builtin_amdgcn_ds_read_tr16_b64_v4i16((LAS s16x4*)(vtr + (2 * p + 1) * 16 * NA_VROW + dt * 32));
                        const s16x8 afrag = __builtin_shufflevector(a0, a1, 0, 1, 2, 3, 4, 5, 6, 7);
                        A.O[dt] = __builtin_amdgcn_mfma_f32_16x16x32_bf16(afrag, bf, A.O[dt], 0, 0, 0);
                    }
                }
            };
            if (local) { if (actA && actB) local_both(); else if (actA) local_one(A, qfA, ra); else local_one(B, qfB, ra + 1); }
            else { if (actB) ctx_both(); else ctx_one(); }
          }
        }
        {
            float ls = A.lsum; ls += __shfl_xor(ls, 16); ls += __shfl_xor(ls, 32);
            const float inv = __builtin_amdgcn_rcpf(ls);
            unsigned ooff = (unsigned)((q16 * D + 4 * g) * 2); asm volatile("" : "+v"(ooff));
            unsigned char* op = (unsigned char*)(MIX + (size_t)qrow0 * D + 256 + h * HD);
#pragma unroll
            for (int dt = 0; dt < 4; ++dt) { v2u w; w.x = pg8::cvt_pk_bf16(A.O[dt][0] * inv, A.O[dt][1] * inv); w.y = pg8::cvt_pk_bf16(A.O[dt][2] * inv, A.O[dt][3] * inv); *(v2u*)(op + (ooff + (unsigned)(32 * dt))) = w; }
        }
        if (!isctx) {
            float ls = B.lsum; ls += __shfl_xor(ls, 16); ls += __shfl_xor(ls, 32);
            const float inv = __builtin_amdgcn_rcpf(ls);
            unsigned ooff = (unsigned)((q16 * D + 4 * g) * 2); asm volatile("" : "+v"(ooff));
            unsigned char* op = (unsigned char*)(MIX + (size_t)(qrow0 + 64) * D + 256 + h * HD);
#pragma unroll
            for (int dt = 0; dt < 4; ++dt) { v2u w; w.x = pg8::cvt_pk_bf16(B.O[dt][0] * inv, B.O[dt][1] * inv); w.y = pg8::cvt_pk_bf16(B.O[dt][2] * inv, B.O[dt][3] * inv); *(v2u*)(op + (ooff + (unsigned)(32 * dt))) = w; }
        }
        it = itn; have = haven; I = N;
    }
}

constexpr int LRU_UCROW = 260;
constexpr int LRU_OFF_UC = 38 * 256 * 2, LRU_OFF_GT = LRU_OFF_UC + 2 * 32 * LRU_UCROW * 4;
static_assert(LRU_OFF_GT + 32 * 256 * 2 <= RING_BYTES, "LRU LDS map");
template <int PASS>
__device__ __forceinline__ void lru_phase(Frame& F, int l, int ntiles) {
    int LN_ = F.tid & 63; asm volatile("" : "+v"(LN_));
    const bf16* PROJ = WSP(const bf16, WS_PROJ);
    LAS bf16* rxs = (LAS bf16*)(F.lds);
    LAS float* ucf = (LAS float*)(F.lds + LRU_OFF_UC);
    LAS bf16* gts = (LAS bf16*)(F.lds + LRU_OFF_GT);
    const int lane = LN_, j16 = lane & 15, g = lane >> 4;
    const int kb = F.wave & 3, nh = F.wave >> 2;
    s16x8 wf[2][2][2][2];
    float cbx[2][2], cba[2][2], csp[2][2];
#pragma unroll
    for (int dir = 0; dir < 2; ++dir) {
        const int ld = l * 2 + dir;
        const bf16* WLR = WSP(const bf16, WS_WLR) + (size_t)((ld * 4 + kb) * 2) * 4096;
#pragma unroll
        for (int gt = 0; gt < 2; ++gt)
#pragma unroll
            for (int n2 = 0; n2 < 2; ++n2)
#pragma unroll
                for (int s_ = 0; s_ < 2; ++s_) wf[dir][gt][n2][s_] = *(const s16x8*)(WLR + gt * 4096 + (16 * (2 * nh + n2) + j16) * 64 + 32 * s_ + 8 * g);
#pragma unroll
        for (int n2 = 0; n2 < 2; ++n2) {
            const int e = kb * 64 + 16 * (2 * nh + n2) + j16, idx = ld * 256 + e;
            cbx[dir][n2] = INP(18)[idx]; cba[dir][n2] = INP(20)[idx];
            const float nl = -INP(21)[idx]; csp[dir][n2] = -8.f * (fmaxf(nl, 0.f) + log1pf(__expf(-fabsf(nl))));
        }
    }
    const int c = F.tid & 255, sdir = F.tid >> 8;
    const int sld = l * 2 + sdir;
    const float s1w0 = INP(15)[(sld * 4 + 0) * 256 + c], s1w1 = INP(15)[(sld * 4 + 1) * 256 + c], s1w2 = INP(15)[(sld * 4 + 2) * 256 + c], s1w3 = INP(15)[(sld * 4 + 3) * 256 + c], s1cb = INP(16)[sld * 256 + c];
    const int base = sdir == 0 ? 0 : 3;
    unsigned pre[10], pgw[8];
    auto load_tile = [&](int T) {
        const int row0 = T * 32;
        int lo, hi; if (row0 < ML) { lo = row0 & ~(SEQ - 1); hi = lo + SEQ; } else { lo = row0 & ~(CTXL - 1); hi = lo + CTXL; }
#pragma unroll
        for (int j = 0; j < 10; ++j) { const int i = F.tid + 512 * j, rr = i >> 7, cp = i & 127, row = row0 - 3 + rr;
            const bool ok = (j < 9 || F.tid < 256) && row >= lo && row < hi;
            pre[j] = ok ? *(const unsigned*)(PROJ + (size_t)row * IND + 2048 + 2 * cp) : 0u; }
        if (PASS == 1) {
#pragma unroll
            for (int j = 0; j < 8; ++j) { const int i = F.tid + 512 * j, t = i >> 7, cp = i & 127; pgw[j] = *(const unsigned*)(PROJ + (size_t)(row0 + t) * IND + 2304 + 2 * cp); }
        }
    };
    if (F.vcu < ntiles) load_tile(F.vcu);
    for (int T = F.vcu; T < ntiles; T += F.G) {
        const int row0 = T * 32;
        __syncthreads();
#pragma unroll
        for (int j = 0; j < 10; ++j) { const int i = F.tid + 512 * j; if (j < 9 || F.tid < 256) ((LAS unsigned*)rxs)[i] = pre[j]; }
        if (PASS == 1) {
#pragma unroll
            for (int j = 0; j < 8; ++j) ((LAS unsigned*)gts)[F.tid + 512 * j] = pgw[j];
        }
        if (T + F.G < ntiles) load_tile(T + F.G);
        float hst[2][2];
#pragma unroll
        for (int dir = 0; dir < 2; ++dir)
#pragma unroll
            for (int n2 = 0; n2 < 2; ++n2) hst[dir][n2] = PASS == 1 ? WSP(const float, WS_CARRY)[((size_t)dir * 1152 + T) * 256 + kb * 64 + 16 * (2 * nh + n2) + j16] : 0.f;
        __syncthreads();
        {
            float x0 = bf1(rxs[(base + 0) * 256 + c]), x1 = bf1(rxs[(base + 1) * 256 + c]), x2 = bf1(rxs[(base + 2) * 256 + c]);
#pragma unroll 8
            for (int t = 0; t < 32; ++t) {
                const float x3 = bf1(rxs[(t + base + 3) * 256 + c]);
                ucf[(sdir * 32 + t) * LRU_UCROW + c] = s1cb + s1w0 * x0 + s1w1 * x1 + s1w2 * x2 + s1w3 * x3;
                x0 = x1; x1 = x2; x2 = x3;
            }
        }
        __syncthreads();
        float hf[2][2][4];
        float Pt[2][2] = {{1.f, 1.f}, {1.f, 1.f}};
#pragma unroll
        for (int dir = 0; dir < 2; ++dir) {
            const bool sec16 = ((g & 1) != 0) != (dir != 0), sec32 = ((g >> 1) != 0) != (dir != 0);
#pragma unroll
            for (int step = 0; step < 2; ++step) {
                const int rt = dir == 0 ? step : 1 - step;
                s16x8 af[2];
#pragma unroll
                for (int s_ = 0; s_ < 2; ++s_) { const LAS float* up = ucf + (dir * 32 + 16 * rt + j16) * LRU_UCROW + kb * 64 + 32 * s_ + 8 * g;
                    const f32x4 u0 = *(const LAS f32x4*)up, u1 = *(const LAS f32x4*)(up + 4);
                    const v4u w = {pg8::cvt_pk_bf16(u0[0], u0[1]), pg8::cvt_pk_bf16(u0[2], u0[3]), pg8::cvt_pk_bf16(u1[0], u1[1]), pg8::cvt_pk_bf16(u1[2], u1[3])};
                    af[s_] = __builtin_bit_cast(s16x8, w); }
#pragma unroll
                for (int n2 = 0; n2 < 2; ++n2) {
                    f32x4 zx = {0.f, 0.f, 0.f, 0.f}, za = {0.f, 0.f, 0.f, 0.f};
#pragma unroll
                    for (int s_ = 0; s_ < 2; ++s_) { zx = __builtin_amdgcn_mfma_f32_16x16x32_bf16(af[s_], wf[dir][0][n2][s_], zx, 0, 0, 0); za = __builtin_amdgcn_mfma_f32_16x16x32_bf16(af[s_], wf[dir][1][n2][s_], za, 0, 0, 0); }
                    const int e = kb * 64 + 16 * (2 * nh + n2) + j16;
                    const LAS float* uo = ucf + (dir * 32 + 16 * rt + 4 * g) * LRU_UCROW + e;
                    float a_[4], b_[4]; unsigned abw[4];
#pragma unroll
                    for (int r = 0; r < 4; ++r) {
                        const float u = uo[r * LRU_UCROW];
                        const float gx = sigmoidf_(zx[r] + cbx[dir][n2]), ga = sigmoidf_(za[r] + cba[dir][n2]);
                        const float la = csp[dir][n2] * ga, a = __builtin_amdgcn_exp2f(1.4426950408889634f * la), y = 2.f * la;
                        const float om = y > -0.02f ? -y * (1.f + y * (0.5f + y * 0.16666667f)) : 1.f - a * a;
                        a_[r] = a; b_[r] = __builtin_amdgcn_sqrtf(om) * gx * u;
                        if (PASS == 0) {
                            const float oma = la > -0.02f ? -la * (1.f + la * (0.5f + la * 0.16666667f)) : 1.f - a;
                            abw[r] = pg8::cvt_pk_bf16(oma, b_[r]); a_[r] = 1.f - bflo(abw[r]); b_[r] = bfhi(abw[r]);
                        }
                    }
                    if (PASS == 0) WSP(v4u, WS_AB)[(((((size_t)T * 2 + dir) * 2 + rt) * 8 + F.wave) * 2 + n2) * 64 + lane] = (v4u){abw[0], abw[1], abw[2], abw[3]};
                    const float P = (a_[0] * a_[1]) * (a_[2] * a_[3]);
                    const float S = dir == 0 ? ((b_[0] * a_[1] + b_[1]) * a_[2] + b_[2]) * a_[3] + b_[3] : ((b_[3] * a_[2] + b_[2]) * a_[1] + b_[1]) * a_[0] + b_[0];
                    const float Pp = __shfl_xor(P, 16), Sp = __shfl_xor(S, 16);
                    const float e1P = sec16 ? Pp : 1.f, e1S = sec16 ? Sp : 0.f;
                    const float prP = P * Pp, prS = sec16 ? P * Sp + S : Pp * S + Sp;
                    const float Pq = __shfl_xor(prP, 32), Sq = __shfl_xor(prS, 32);
                    const float EP = sec32 ? Pq * e1P : e1P, ES = sec32 ? e1P * Sq + e1S : e1S;
                    const float TP = prP * Pq, TS = sec32 ? prP * Sq + prS : Pq * prS + Sq;
                    if (PASS == 1) {
                        float h = EP * hst[dir][n2] + ES;
                        if (dir == 0) {
#pragma unroll
                            for (int r = 0; r < 4; ++r) { h = a_[r] * h + b_[r]; hf[rt][n2][r] = h; }
                        } else {
                            float hb[4];
#pragma unroll
                            for (int r = 3; r >= 0; --r) { h = a_[r] * h + b_[r]; hb[r] = h; }
                            bf16* mp = WSP(bf16, WS_MIX) + (size_t)(row0 + 16 * rt + 4 * g) * D + 768 + e;
                            const LAS bf16* gp = gts + (16 * rt + 4 * g) * 256 + e;
#pragma unroll
                            for (int r = 0; r < 4; ++r) mp[(size_t)r * D] = (bf16)f2bf(gelu_tanh(bf1(gp[r * 256])) * (hf[rt][n2][r] + hb[r]));
                        }
                    } else Pt[dir][n2] *= TP;
                    hst[dir][n2] = TP * hst[dir][n2] + TS;
                }
            }
        }
        if (PASS == 0 && g == 0) {
#pragma unroll
            for (int dir = 0; dir < 2; ++dir)
#pragma unroll
                for (int n2 = 0; n2 < 2; ++n2) WSP(f32x2, WS_TOT)[((size_t)dir * 1152 + T) * 256 + kb * 64 + 16 * (2 * nh + n2) + j16] = (f32x2){Pt[dir][n2], hst[dir][n2]};
        }
    }
}
__device__ __forceinline__ void lru_scan_phase(Frame& F, int l, int ntiles) {
    int LN_ = F.tid & 63; asm volatile("" : "+v"(LN_));
    const bf16* PROJ = WSP(const bf16, WS_PROJ);
    LAS bf16* gts = (LAS bf16*)(F.lds);
    const int lane = LN_, j16 = lane & 15, g = lane >> 4;
    const int kb = F.wave & 3, nh = F.wave >> 2;
    const v4u* AB = WSP(const v4u, WS_AB);
    v4u pab[2][2][2]; unsigned pgw[8];
    auto load_tile = [&](int T) {
#pragma unroll
        for (int dir = 0; dir < 2; ++dir)
#pragma unroll
            for (int rt = 0; rt < 2; ++rt)
#pragma unroll
                for (int n2 = 0; n2 < 2; ++n2) pab[dir][rt][n2] = AB[(((((size_t)T * 2 + dir) * 2 + rt) * 8 + F.wave) * 2 + n2) * 64 + lane];
#pragma unroll
        for (int j = 0; j < 8; ++j) { const int i = F.tid + 512 * j, t = i >> 7, cp = i & 127; pgw[j] = *(const unsigned*)(PROJ + (size_t)(T * 32 + t) * IND + 2304 + 2 * cp); }
    };
    if (F.vcu < ntiles) load_tile(F.vcu);
    for (int T = F.vcu; T < ntiles; T += F.G) {
        const int row0 = T * 32;
        __syncthreads();
#pragma unroll
        for (int j = 0; j < 8; ++j) ((LAS unsigned*)gts)[F.tid + 512 * j] = pgw[j];
        v4u cur[2][2][2];
#pragma unroll
        for (int dir = 0; dir < 2; ++dir)
#pragma unroll
            for (int rt = 0; rt < 2; ++rt)
#pragma unroll
                for (int n2 = 0; n2 < 2; ++n2) cur[dir][rt][n2] = pab[dir][rt][n2];
        float hst[2][2];
#pragma unroll
        for (int dir = 0; dir < 2; ++dir)
#pragma unroll
            for (int n2 = 0; n2 < 2; ++n2) hst[dir][n2] = WSP(const float, WS_CARRY)[((size_t)dir * 1152 + T) * 256 + kb * 64 + 16 * (2 * nh + n2) + j16];
        if (T + F.G < ntiles) load_tile(T + F.G);
        __syncthreads();
        float hf[2][2][4];
#pragma unroll
        for (int dir = 0; dir < 2; ++dir) {
            const bool sec16 = ((g & 1) != 0) != (dir != 0), sec32 = ((g >> 1) != 0) != (dir != 0);
#pragma unroll
            for (int step = 0; step < 2; ++step) {
                const int rt = dir == 0 ? step : 1 - step;
#pragma unroll
                for (int n2 = 0; n2 < 2; ++n2) {
                    const int e = kb * 64 + 16 * (2 * nh + n2) + j16;
                    const v4u w = cur[dir][rt][n2];
                    const float a_[4] = {1.f - bflo(w.x), 1.f - bflo(w.y), 1.f - bflo(w.z), 1.f - bflo(w.w)}, b_[4] = {bfhi(w.x), bfhi(w.y), bfhi(w.z), bfhi(w.w)};
                    const float P = (a_[0] * a_[1]) * (a_[2] * a_[3]);
                    const float S = dir == 0 ? ((b_[0] * a_[1] + b_[1]) * a_[2] + b_[2]) * a_[3] + b_[3] : ((b_[3] * a_[2] + b_[2]) * a_[1] + b_[1]) * a_[0] + b_[0];
                    const float Pp = __shfl_xor(P, 16), Sp = __shfl_xor(S, 16);
                    const float e1P = sec16 ? Pp : 1.f, e1S = sec16 ? Sp : 0.f;
                    const float prP = P * Pp, prS = sec16 ? P * Sp + S : Pp * S + Sp;
                    const float Pq = __shfl_xor(prP, 32), Sq = __shfl_xor(prS, 32);
                    const float EP = sec32 ? Pq * e1P : e1P, ES = sec32 ? e1P * Sq + e1S : e1S;
                    const float TP = prP * Pq, TS = sec32 ? prP * Sq + prS : Pq * prS + Sq;
                    float h = EP * hst[dir][n2] + ES;
                    if (dir == 0) {
#pragma unroll
                        for (int r = 0; r < 4; ++r) { h = a_[r] * h + b_[r]; hf[rt][n2][r] = h; }
                    } else {
                        float hb[4];
#pragma unroll
                        for (int r = 3; r >= 0; --r) { h = a_[r] * h + b_[r]; hb[r] = h; }
                        bf16* mp = WSP(bf16, WS_MIX) + (size_t)(row0 + 16 * rt + 4 * g) * D + 768 + e;
                        const LAS bf16* gp = gts + (16 * rt + 4 * g) * 256 + e;
#pragma unroll
                        for (int r = 0; r < 4; ++r) mp[(size_t)r * D] = (bf16)f2bf(gelu_tanh(bf1(gp[r * 256])) * (hf[rt][n2][r] + hb[r]));
                    }
                    hst[dir][n2] = TP * hst[dir][n2] + TS;
                }
            }
        }
    }
}

constexpr int LQ_WVB = 35 * 128 + 32 * 144;
constexpr int LQ_WV = 72 * 1024;
constexpr int LQ_CH = TBL_OFF;
constexpr int LQ_FL = LQ_CH + 72 * 2 * 16 * 4;
constexpr int LQ_WV2 = LQ_FL + 2 * 72 * 4;
static_assert(LQ_WV + 6 * LQ_WVB <= RING_BYTES && LQ_WV2 + 2 * LQ_WVB <= LDS_BYTES && LQ_WV2 % 16 == 0, "LRU LDS map");
__device__ __forceinline__ void lru_seq_phase(Frame& F, int l, bool last) {
    int LN_ = F.tid & 63; asm volatile("" : "+v"(LN_));
    const bf16* PROJ = WSP(const bf16, WS_PROJ);
    const int lane = LN_, j16 = lane & 15, g = lane >> 4, cpn = lane & 31, hh = lane >> 5;
    LAS unsigned char* wreg = F.lds + (F.wave < 6 ? LQ_WV + F.wave * LQ_WVB : LQ_WV2 + (F.wave - 6) * LQ_WVB);
    LAS unsigned* rx32 = (LAS unsigned*)wreg;
    LAS unsigned char* ucb = wreg + 35 * 128;
    volatile LAS unsigned* cflag = (volatile LAS unsigned*)(F.lds + LQ_FL);
    volatile LAS unsigned* hflag = cflag + 72;
    LAS float* chain = (LAS float*)(F.lds + LQ_CH);
    for (int item = F.vcu; item < NB * 16; item += F.G) {
        const int b = item >> 4, cg = item & 15, kb = cg >> 2, nn = cg & 3;
        __syncthreads();
        if (F.tid < 144) cflag[F.tid] = 0u;
        __syncthreads();
        s16x8 wf[2][2][2]; float cbx[2], cba[2], csp[2]; f32x2 cw[2][4], cb[2];
#pragma unroll
        for (int dir = 0; dir < 2; ++dir) {
            const int ld = l * 2 + dir;
            const bf16* WLR = WSP(const bf16, WS_WLR) + (size_t)((ld * 4 + kb) * 2) * 4096;
#pragma unroll
            for (int gt = 0; gt < 2; ++gt)
#pragma unroll
                for (int s_ = 0; s_ < 2; ++s_) wf[dir][gt][s_] = *(const s16x8*)(WLR + gt * 4096 + (16 * nn + j16) * 64 + 32 * s_ + 8 * g);
            const int idx = ld * 256 + kb * 64 + 16 * nn + j16;
            cbx[dir] = INP(18)[idx]; cba[dir] = INP(20)[idx];
            const float nl = -INP(21)[idx]; csp[dir] = -8.f * 1.4426950408889634f * (fmaxf(nl, 0.f) + log1pf(__expf(-fabsf(nl))));
            const int c0 = kb * 64 + 2 * cpn;
#pragma unroll
            for (int k = 0; k < 4; ++k) cw[dir][k] = (f32x2){INP(15)[(ld * 4 + k) * 256 + c0], INP(15)[(ld * 4 + k) * 256 + c0 + 1]};
            cb[dir] = (f32x2){INP(16)[ld * 256 + c0], INP(16)[ld * 256 + c0 + 1]};
        }
        auto tile_row0 = [&](int s, int dir) -> int { return s < 8 ? ML + b * CTXL + 32 * (dir == 0 ? s : 7 - s) : b * SEQ + 32 * (dir == 0 ? s - 8 : 71 - s); };
        v4u pre[5];
        auto load_rows = [&](int s, int dir) {
            const unsigned roff = (unsigned)(((lane >> 3) * IND + 8 * (lane & 7)) * 2);
            const int lo = s < 8 ? ML + b * CTXL : b * SEQ, hi = lo + (s < 8 ? CTXL : SEQ);
            const int r0 = tile_row0(s, dir) - (dir == 0 ? 3 : 0);
            const unsigned char* rb = (const unsigned char*)(PROJ + (ptrdiff_t)r0 * IND + 2048 + kb * 64);
#pragma unroll
            for (int j = 0; j < 5; ++j) { const int rr = (lane >> 3) + 8 * j, row = r0 + rr;
                const bool ok = rr < 35 && row >= lo && row < hi;
                pre[j] = ok ? *(const v4u*)(rb + (roff + (unsigned)(8 * j * IND * 2))) : (v4u){0u, 0u, 0u, 0u}; }
        };
        load_rows(F.wave, 0);
        for (int s = F.wave; s < 72; s += 8) {
            const bool ctxs = s < 8, comb = ctxs ? s >= 4 : s >= 40, outp = !(last && ctxs);
            float A_[2][2][4], B_[2][2][4], EP[2][2], ES[2][2], TP[2][2], TS[2][2];
#pragma unroll
            for (int dir = 0; dir < 2; ++dir) {
#pragma unroll
                for (int j = 0; j < 5; ++j) { const int rr = (lane >> 3) + 8 * j; if (rr < 35) *(LAS v4u*)(wreg + rr * 128 + 16 * (lane & 7)) = pre[j]; }
                if (dir == 0) load_rows(s, 1); else if (s + 8 < 72) load_rows(s + 8, 0);
                {
                    auto up2 = [](unsigned w) -> f32x2 { return (f32x2){bflo(w), bfhi(w)}; };
                    f32x2 x0 = up2(rx32[(16 * hh + 0) * 32 + cpn]), x1 = up2(rx32[(16 * hh + 1) * 32 + cpn]), x2 = up2(rx32[(16 * hh + 2) * 32 + cpn]);
#pragma unroll
                    for (int t = 0; t < 16; ++t) {
                        const f32x2 x3 = up2(rx32[(16 * hh + t + 3) * 32 + cpn]);
                        const f32x2 acc = cb[dir] + cw[dir][0] * x0 + cw[dir][1] * x1 + cw[dir][2] * x2 + cw[dir][3] * x3;
                        *(LAS unsigned*)(ucb + (16 * hh + t) * 144 + 4 * cpn) = pg8::cvt_pk_bf16(acc[0], acc[1]);
                        x0 = x1; x1 = x2; x2 = x3;
                    }
                }
                const bool sec16 = ((g & 1) != 0) != (dir != 0), sec32 = ((g >> 1) != 0) != (dir != 0);
#pragma unroll
                for (int rt = 0; rt < 2; ++rt) {
                    f32x4 zx = {0.f, 0.f, 0.f, 0.f}, za = {0.f, 0.f, 0.f, 0.f};
#pragma unroll
                    for (int s_ = 0; s_ < 2; ++s_) { const s16x8 af = *(const LAS s16x8*)(ucb + (16 * rt + j16) * 144 + 64 * s_ + 16 * g);
                        zx = __builtin_amdgcn_mfma_f32_16x16x32_bf16(af, wf[dir][0][s_], zx, 0, 0, 0); za = __builtin_amdgcn_mfma_f32_16x16x32_bf16(af, wf[dir][1][s_], za, 0, 0, 0); }
                    float a_[4], b_[4];
#pragma unroll
                    for (int r = 0; r < 4; ++r) {
                        const float u = bf1(*(const LAS bf16*)(ucb + (16 * rt + 4 * g + r) * 144 + 2 * (16 * nn + j16)));
                        const float gx = sigmoidf_(zx[r] + cbx[dir]), ga = sigmoidf_(za[r] + cba[dir]);
                        const float a = __builtin_amdgcn_exp2f(csp[dir] * ga);
                        const float om = __builtin_fmaf(-a, a, 1.f);
                        a_[r] = a; b_[r] = __builtin_amdgcn_sqrtf(om) * gx * u;
                        A_[dir][rt][r] = a_[r]; B_[dir][rt][r] = b_[r];
                    }
                    const float P = (a_[0] * a_[1]) * (a_[2] * a_[3]);
                    const float S = dir == 0 ? ((b_[0] * a_[1] + b_[1]) * a_[2] + b_[2]) * a_[3] + b_[3] : ((b_[3] * a_[2] + b_[2]) * a_[1] + b_[1]) * a_[0] + b_[0];
                    const float Pp = __shfl_xor(P, 16), Sp = __shfl_xor(S, 16);
                    const float e1P = sec16 ? Pp : 1.f, e1S = sec16 ? Sp : 0.f;
                    const float prP = P * Pp, prS = sec16 ? P * Sp + S : Pp * S + Sp;
                    const float Pq = __shfl_xor(prP, 32), Sq = __shfl_xor(prS, 32);
                    EP[dir][rt] = sec32 ? Pq * e1P : e1P; ES[dir][rt] = sec32 ? e1P * Sq + e1S : e1S;
                    TP[dir][rt] = prP * Pq; TS[dir][rt] = sec32 ? prP * Sq + prS : Pq * prS + Sq;
                }
            }
            bf16 gr[2][2][4];
            if (comb && outp) {
                const unsigned goff = (unsigned)((4 * g * IND + j16) * 2);
#pragma unroll
                for (int dir = 0; dir < 2; ++dir) { const unsigned char* gp = (const unsigned char*)(PROJ + (size_t)tile_row0(s, dir) * IND + 2304 + 16 * cg);
#pragma unroll
                    for (int rt = 0; rt < 2; ++rt)
#pragma unroll
                        for (int r = 0; r < 4; ++r) gr[dir][rt][r] = *(const bf16*)(gp + (goff + (unsigned)((16 * rt + r) * IND * 2))); }
            }
            float hin[2] = {0.f, 0.f};
            if (s > 0) {
                while (__builtin_amdgcn_readfirstlane(cflag[s - 1]) == 0u) __builtin_amdgcn_s_sleep(1);
                asm volatile("" ::: "memory");
                hin[0] = chain[((s - 1) * 2 + 0) * 16 + j16]; hin[1] = chain[((s - 1) * 2 + 1) * 16 + j16];
            }
#pragma unroll
            for (int dir = 0; dir < 2; ++dir) { const int rf = dir == 0 ? 0 : 1, rs_ = 1 - rf;
                const float hout = (TP[dir][rf] * TP[dir][rs_]) * hin[dir] + (TP[dir][rs_] * TS[dir][rf] + TS[dir][rs_]);
                if (g == 0) chain[(s * 2 + dir) * 16 + j16] = hout; }
            asm volatile("" ::: "memory");
            cflag[s] = 1u;
            asm volatile("" ::: "memory");
#pragma unroll
            for (int dir = 0; dir < 2; ++dir) { const int rf = dir == 0 ? 0 : 1, rs_ = 1 - rf;
                float hv[2][4];
                { float h = EP[dir][rf] * hin[dir] + ES[dir][rf];
                  if (dir == 0) {
#pragma unroll
                      for (int r = 0; r < 4; ++r) { h = A_[dir][rf][r] * h + B_[dir][rf][r]; hv[rf][r] = h; }
                  } else {
#pragma unroll
                      for (int r = 3; r >= 0; --r) { h = A_[dir][rf][r] * h + B_[dir][rf][r]; hv[rf][r] = h; }
                  } }
                { const float hm = TP[dir][rf] * hin[dir] + TS[dir][rf]; float h = EP[dir][rs_] * hm + ES[dir][rs_];
                  if (dir == 0) {
#pragma unroll
                      for (int r = 0; r < 4; ++r) { h = A_[dir][rs_][r] * h + B_[dir][rs_][r]; hv[rs_][r] = h; }
                  } else {
#pragma unroll
                      for (int r = 3; r >= 0; --r) { h = A_[dir][rs_][r] * h + B_[dir][rs_][r]; hv[rs_][r] = h; }
                  } }
                if (outp) {
                    const int id = s < 8 ? (dir == 0 ? s : 7 - s) : (dir == 0 ? s : 79 - s);
                    LAS v4u* hb = (LAS v4u*)(F.lds + id * 1024 + lane * 16);
                    if (!comb) {
                        *hb = (v4u){pg8::cvt_pk_bf16(hv[0][0], hv[0][1]), pg8::cvt_pk_bf16(hv[0][2], hv[0][3]), pg8::cvt_pk_bf16(hv[1][0], hv[1][1]), pg8::cvt_pk_bf16(hv[1][2], hv[1][3])};
                        asm volatile("" ::: "memory");
                        hflag[id] = 1u;
                        asm volatile("" ::: "memory");
                    } else {
                        while (__builtin_amdgcn_readfirstlane(hflag[id]) == 0u) __builtin_amdgcn_s_sleep(1);
                        asm volatile("" ::: "memory");
                        const v4u o = *hb;
                        const float ot[2][4] = {{bflo(o.x), bfhi(o.x), bflo(o.y), bfhi(o.y)}, {bflo(o.z), bfhi(o.z), bflo(o.w), bfhi(o.w)}};
                        const unsigned moff = (unsigned)((4 * g * D + j16) * 2);
                        unsigned char* mp = (unsigned char*)(WSP(bf16, WS_MIX) + (size_t)tile_row0(s, dir) * D + 768 + 16 * cg);
#pragma unroll
                        for (int rt = 0; rt < 2; ++rt)
#pragma unroll
                            for (int r = 0; r < 4; ++r) *(bf16*)(mp + (moff + (unsigned)((16 * rt + r) * D * 2))) = (bf16)f2bf(gelu_tanh(bf1(gr[dir][rt][r])) * (hv[rt][r] + ot[rt][r]));
                    }
                }
            }
        }
    }
}

__device__ __forceinline__ void lru_carry(Frame& F) {
    int LN_ = F.tid & 63; asm volatile("" : "+v"(LN_));
    const f32x2* TOT = WSP(const f32x2, WS_TOT); float* CARRY = WSP(float, WS_CARRY);
    for (int it = F.gw; it < NB * 2 * 4; it += F.NGW) {
        const int b = it >> 3, dir = (it >> 2) & 1, c = (it & 3) * 64 + LN_;
        float h = 0.f;
        for (int g = 0; g < 18; ++g) {
            f32x2 ps[4]; int tl[4];
#pragma unroll
            for (int i = 0; i < 4; ++i) { const int s = g * 4 + i;
                int T; if (s < 8) T = 1024 + b * 8 + (dir == 0 ? s : 7 - s); else T = b * 64 + (dir == 0 ? s - 8 : 71 - s);
                tl[i] = T; ps[i] = TOT[((size_t)dir * 1152 + T) * 256 + c]; }
#pragma unroll
            for (int i = 0; i < 4; ++i) { CARRY[((size_t)dir * 1152 + tl[i]) * 256 + c] = h; h = ps[i][0] * h + ps[i][1]; }
        }
    }
}

__device__ __forceinline__ void ctx_finalize(Frame& F, int l) {
    int LN_ = F.tid & 63; asm volatile("" : "+v"(LN_));
    bf16* XA = WSP(bf16, WS_XA); float* RSSA = WSP(float, WS_RSSA); const float* ACC = WSP(const float, WS_PART); const float* MOD = WSP(const float, WS_MOD);
    const float* go = INP(5) + (l - 1) * D; const float* gso = MOD + ((size_t)(l - 1) * 17 + NB) * MODW + 4 * D;
    const float* gn = INP(4) + l * D; const float* gsn = MOD + ((size_t)l * 17 + NB) * MODW + D;
    for (int r = F.gw; r < MC; r += F.NGW) {
        const size_t row = (size_t)ML + r;
        float ss = 0.f; f32x4 y[4];
#pragma unroll
        for (int j = 0; j < 4; ++j) { const int k = 4 * LN_ + 256 * j;
            const v2u w = *(const v2u*)(XA + row * D + k);
            const f32x4 im = *(const f32x4*)(go + k) * (*(const f32x4*)(gso + k) + 1.0f);
            const f32x4 xo = (f32x4){bflo(w.x) * __builtin_amdgcn_rcpf(im[0]), bfhi(w.x) * __builtin_amdgcn_rcpf(im[1]), bflo(w.y) * __builtin_amdgcn_rcpf(im[2]), bfhi(w.y) * __builtin_amdgcn_rcpf(im[3])};
            const float* ap = ACC + (size_t)r * D + k;
            y[j] = xo + ((*(const f32x4*)ap + *(const f32x4*)(ap + (size_t)MC * D)) + (*(const f32x4*)(ap + (size_t)2 * MC * D) + *(const f32x4*)(ap + (size_t)3 * MC * D)));
            ss += (y[j][0] * y[j][0] + y[j][1] * y[j][1]) + (y[j][2] * y[j][2] + y[j][3] * y[j][3]); }
        ss = wave_sum(ss);
        if (LN_ < 32) RSSA[row * 32 + LN_] = (LN_ == 0) ? ss : 0.f;
#pragma unroll
        for (int j = 0; j < 4; ++j) { const int k = 4 * LN_ + 256 * j;
            const f32x4 a = y[j] * (*(const f32x4*)(gn + k) * (*(const f32x4*)(gsn + k) + 1.0f));
            v2u o; o.x = pk2(a[0], a[1]); o.y = pk2(a[2], a[3]); *(v2u*)(XA + row * D + k) = o; }
    }
}

__device__ __forceinline__ void final_rows(Frame& F) {
    int LN_ = F.tid & 63; asm volatile("" : "+v"(LN_));
    const bf16* XA = WSP(const bf16, WS_XA); const float* RSS = WSP(const float, WS_RSSA);
    for (int row = F.gw; row < ML; row += 2 * F.NGW) {
        const int row2 = row + F.NGW; const bool two = row2 < ML;
        const v4u a0 = *(const v4u*)(XA + (size_t)row * D + 8 * LN_), a1 = *(const v4u*)(XA + (size_t)row * D + 512 + 8 * LN_);
        const float p0 = LN_ < 32 ? RSS[(size_t)row * 32 + LN_] : 0.f;
        v4u b0 = a0, b1 = a1; float p1 = 0.f;
        if (two) { b0 = *(const v4u*)(XA + (size_t)row2 * D + 8 * LN_); b1 = *(const v4u*)(XA + (size_t)row2 * D + 512 + 8 * LN_); p1 = LN_ < 32 ? RSS[(size_t)row2 * 32 + LN_] : 0.f; }
        const float rs0 = rsqrtf(wave_sum(p0) * (1.f / D) + EPS), rs1 = rsqrtf(wave_sum(p1) * (1.f / D) + EPS);
        float* o = F.out + (size_t)row * D + 8 * LN_;
        *(f32x4*)(o) = (f32x4){bflo(a0.x), bfhi(a0.x), bflo(a0.y), bfhi(a0.y)} * rs0; *(f32x4*)(o + 4) = (f32x4){bflo(a0.z), bfhi(a0.z), bflo(a0.w), bfhi(a0.w)} * rs0;
        *(f32x4*)(o + 512) = (f32x4){bflo(a1.x), bfhi(a1.x), bflo(a1.y), bfhi(a1.y)} * rs0; *(f32x4*)(o + 516) = (f32x4){bflo(a1.z), bfhi(a1.z), bflo(a1.w), bfhi(a1.w)} * rs0;
        if (two) { float* o2 = F.out + (size_t)row2 * D + 8 * LN_;
            *(f32x4*)(o2) = (f32x4){bflo(b0.x), bfhi(b0.x), bflo(b0.y), bfhi(b0.y)} * rs1; *(f32x4*)(o2 + 4) = (f32x4){bflo(b0.z), bfhi(b0.z), bflo(b0.w), bfhi(b0.w)} * rs1;
            *(f32x4*)(o2 + 512) = (f32x4){bflo(b1.x), bfhi(b1.x), bflo(b1.y), bfhi(b1.y)} * rs1; *(f32x4*)(o2 + 516) = (f32x4){bflo(b1.z), bfhi(b1.z), bflo(b1.w), bfhi(b1.w)} * rs1; }
    }
}

__device__ __forceinline__ void fill_res_tables(Frame& F, const pg8::Order& S, const float* gate, const float* gmg, const float* gmsc, const float* go, const float* gso) {
    LAS float* T = (LAS float*)(F.lds + TBL_OFF);
    if (F.tid < 256) {
        float tg[3], tm[3], ts[3], to[3], tq[3]; bool ok[3];
#pragma unroll
        for (int i = 0; i < 3; ++i) { pg8::Unit u; ok[i] = S.next(i, u);
            if (ok[i]) { const int brow = u.pm < ML / 256 ? (u.pm >> 3) : NB, col = u.pn * 256 + F.tid;
                tg[i] = gate[(size_t)brow * MODW + col]; tm[i] = gmg[col]; ts[i] = gmsc[(size_t)brow * MODW + col]; to[i] = go[col]; tq[i] = gso[(size_t)brow * MODW + col]; } }
#pragma unroll
        for (int i = 0; i < 3; ++i) if (ok[i]) {
            T[i * 256 + F.tid] = tg[i];
            T[(pg8::TBL_UNITS + i) * 256 + F.tid] = tm[i] * (1.f + ts[i]);
            T[(2 * pg8::TBL_UNITS + i) * 256 + F.tid] = __builtin_amdgcn_rcpf(to[i] * (1.f + tq[i])); }
#pragma unroll 1
        for (int i = 3; i < pg8::TBL_UNITS; ++i) { pg8::Unit u; if (!S.next(i, u)) break;
            const int brow = u.pm < ML / 256 ? (u.pm >> 3) : NB, col = u.pn * 256 + F.tid;
            T[i * 256 + F.tid] = gate[(size_t)brow * MODW + col];
            T[(pg8::TBL_UNITS + i) * 256 + F.tid] = gmg[col] * (1.f + gmsc[(size_t)brow * MODW + col]);
            T[(2 * pg8::TBL_UNITS + i) * 256 + F.tid] = __builtin_amdgcn_rcpf(go[col] * (1.f + gso[(size_t)brow * MODW + col])); }
    }
    __syncthreads();
}

template <int LDC>
__device__ __forceinline__ void fill_scale_tables(Frame& F, const pg8::Order& S, const float* RSS, const float* shw) {
    LAS float* RS_T = (LAS float*)(F.lds + TBL_OFF); LAS float* SH_T = RS_T + pg8::TBL_UNITS * 256;
    const int row = F.tid >> 1, half = F.tid & 1;
    f32x4 p[2][3][4], sv[2][3]; bool ok[2][3];
    auto load_group = [&](int i0, f32x4 (&pg)[3][4], f32x4 (&sg)[3], bool (&og)[3]) __attribute__((always_inline)) {
#pragma unroll
        for (int j = 0; j < 3; ++j) { pg8::Unit u; og[j] = (i0 + j < pg8::TBL_UNITS) && S.next(i0 + j, u);
            if (og[j]) { const float* b = RSS + ((size_t)u.pm * 256 + row) * 32 + 16 * half;
#pragma unroll
                for (int q = 0; q < 4; ++q) pg[j][q] = *(const f32x4*)(b + 4 * q);
                if (F.tid < 64) sg[j] = *(const f32x4*)(shw + (size_t)(u.pm < ML / 256 ? (u.pm >> 3) : NB) * LDC + u.pn * 256 + 4 * F.tid); } }
    };
    auto reduce_group = [&](int i0, f32x4 (&pg)[3][4], f32x4 (&sg)[3], bool (&og)[3]) __attribute__((always_inline)) {
#pragma unroll
        for (int j = 0; j < 3; ++j) if (og[j]) {
            float s = 0.f;
#pragma unroll
            for (int q = 0; q < 4; ++q) s += (pg[j][q][0] + pg[j][q][1]) + (pg[j][q][2] + pg[j][q][3]);
            s = lane_xor1_sum(s);
            if (half == 0) RS_T[(i0 + j) * 256 + row] = rsqrtf(s * (1.0f / D) + EPS);
            if (F.tid < 64) *(LAS f32x4*)(SH_T + (i0 + j) * 256 + 4 * F.tid) = sg[j]; }
    };
    load_group(0, p[0], sv[0], ok[0]);
    load_group(3, p[1], sv[1], ok[1]);
    reduce_group(0, p[0], sv[0], ok[0]);
    load_group(6, p[0], sv[0], ok[0]);
    reduce_group(3, p[1], sv[1], ok[1]);
    reduce_group(6, p[0], sv[0], ok[0]);
    __syncthreads();
}

constexpr int N_PHASES = 2 + 5 * DEPTH + 1;
struct Args { const float* in[25]; float* out; unsigned char* ws; int ph_lo, ph_hi; };
static_assert(sizeof(Args) == 27 * 8 + 8, "Args has no padding");

__global__ void __launch_bounds__(NWAVES * 64, 2) mega_fwd(Args args) {
    extern __shared__ __attribute__((aligned(16))) unsigned char lds[];
    Frame F;
    F.lds = (LAS unsigned char*)lds;
    const int wave_s = __builtin_amdgcn_readfirstlane((int)threadIdx.x >> 6);
    F.wave = wave_s; F.tid = wave_s * 64 + (int)__builtin_amdgcn_mbcnt_hi(~0u, __builtin_amdgcn_mbcnt_lo(~0u, 0u));
    F.G = gridDim.x; { const int bx = blockIdx.x; F.vcu = (F.G % 8 == 0) ? (bx % 8) * (F.G / 8) + bx / 8 : bx; }
    F.gw = F.vcu * NWAVES + F.wave; F.NGW = F.G * NWAVES;
    F.out = args.out; F.ws = args.ws;
    volatile LAS unsigned* MISC = (volatile LAS unsigned*)(F.lds + MISC_OFF);
    for (int u = F.tid; u < (LDS_BYTES - LDSCTL_OFF) / 4; u += NWAVES * 64) ((LAS unsigned*)(F.lds + LDSCTL_OFF))[u] = 0u;
    __syncthreads();
    if (F.tid == 0) {
#pragma unroll
        for (int i = 0; i < 25; ++i) *(LAS unsigned long long*)(F.lds + PTR_OFF + 8 * i) = (unsigned long long)args.in[i];
    }
    __syncthreads();
    XcdBarrier bar = xcd_barrier_post((unsigned*)(F.ws + WS_CTL) + CW_BAR, MISC + 8, F.tid);

    const int lo = args.ph_lo, hi = args.ph_hi;
#ifdef PROBE_TL
    unsigned ttl_ = (unsigned)__builtin_amdgcn_readfirstlane((int)(unsigned)__builtin_amdgcn_s_memrealtime());
#endif
#ifdef PROBE_PH
    const unsigned tk0_ = (unsigned)__builtin_amdgcn_readfirstlane((int)(unsigned)__builtin_amdgcn_s_memrealtime());
#endif
#ifdef PROBE_MASK
    bool rep_done = false;
#define PROBE_V ((((PROBE_MASK >> ph) & 1) && !rep_done) ? PROBE_VARIANT : 0)
#else
#define PROBE_V 0
#endif
    for (int ph = lo; ph < hi; ++ph) {
        { unsigned ones_ = ~0u; asm volatile("" : "+s"(ones_));
          int t_ = wave_s * 64 + (int)__builtin_amdgcn_mbcnt_hi(ones_, __builtin_amdgcn_mbcnt_lo(ones_, 0u)); asm volatile("" : "+v"(t_)); F.tid = t_; F.wave = __builtin_amdgcn_readfirstlane(t_ >> 6); F.gw = F.vcu * NWAVES + F.wave; }
#ifdef PROBE_PH
        unsigned tp0_ = 0, tp1_ = 0;
        if (ph == PROBE_PH) tp0_ = (unsigned)__builtin_amdgcn_readfirstlane((int)(unsigned)__builtin_amdgcn_s_memrealtime());
#endif
        if (ph == 0) {
#ifndef NO_P0
            phase_p0a(F);
#endif
        } else if (ph == 1) {
#ifndef NO_P0
            phase_p0b(F);
#endif
        }
        else if (ph == N_PHASES - 1) { final_rows(F);
#ifdef PROBE_PH
            if (blockIdx.x == 0 && F.tid == 0) { const unsigned* pc = WSP(const unsigned, WS_CTL + 768 * 1024); unsigned v_ = __builtin_nontemporal_load(pc + (PROBE_SEL & 3)); if (PROBE_SEL == 2) v_ = 0xFFFFFFFFu - v_; if (PROBE_SEL == 4) v_ = (unsigned)__builtin_amdgcn_s_memrealtime() - tk0_; __builtin_amdgcn_s_sleep(127); F.out[0] = (float)v_ * PROBE_SCALE; }
#endif
        }
        else {
            const int l = (ph - 2) / 5, k5 = (ph - 2) % 5, k = k5 < 2 ? k5 : k5 + 2; const bool last = (l == DEPTH - 1);
            const int Mx = last ? ML : MT;
            float* MOD = WSP(float, WS_MOD);
            if (k == 0) {
                if (l > 0) { ctx_finalize(F, l); xcd_barrier(bar, F.tid); }
                pg8::Gemm g{WSP(const bf16, WS_XA), WSP(const bf16, WS_WIN) + (size_t)l * IND * D, MT, IND, D};
                pg8::Order S; if (last) S.init(ML, IND, WGM_IN, (MC / 256) * 5, 1, F.G, (int)blockIdx.x); else S.init(MT, IND, WGM_IN, 0, 0, F.G, (int)blockIdx.x);
                fill_scale_tables<IND>(F, S, WSP(const float, WS_RSSA), WSP(const float, WS_SHW1) + (size_t)l * 17 * IND);
                pg8::EpiScale<0, IND, true> E{WSP(bf16, WS_PROJ), (const LAS float*)(F.lds + TBL_OFF), PROBE_V};

#ifndef NO_G0
                pg8::gemm_phase<pg8::EpiScale<0, IND, true>, pg8::Order, true, true>(F.lds + RING_OFF, g, S, E, F.tid);
#endif
                if (!last) filler_weights(F, S.nwg + S.extra, W_EARLY, W_F1); else filler_weights(F, S.nwg + S.extra, W_F2, W_ITEMS);

            } else if (k == 1) {

#ifndef NO_LRU
                lru_seq_phase(F, l, last);
#ifdef REP_LRU0
                __syncthreads(); lru_seq_phase(F, l, last);
#endif
#endif

                __syncthreads();
#ifndef NO_CONV
                conv_phase(F, l, last ? 1024 : 1152);
                __syncthreads();
#ifdef REP_CONV
                conv_phase(F, l, last ? 1024 : 1152);
                __syncthreads();
#endif
#endif
#ifndef NO_NA
#ifdef REP_NA
                na_phase(F, l, last ? NA_ITEMS_LAT : NA_ITEMS_LAT + NA_ITEMS_CTX, REP_NA);
#else
                na_phase(F, l, last ? NA_ITEMS_LAT : NA_ITEMS_LAT + NA_ITEMS_CTX);
#endif
#ifdef REP_NA
                __syncthreads(); na_phase(F, l, last ? NA_ITEMS_LAT : NA_ITEMS_LAT + NA_ITEMS_CTX, 0);
#endif
#endif
            } else if (k == 4 || k == 6) {
                const bool dn = (k == 6);
                const int ln = (dn && !last) ? l + 1 : l;
                pg8::Gemm g{dn ? WSP(const bf16, WS_HID) : WSP(const bf16, WS_MIX), dn ? WSP(const bf16, WS_W2) + (size_t)l * D * FF : WSP(const bf16, WS_WOUT) + (size_t)l * D * D, Mx, D, dn ? FF : D};
                const bool splitk = dn && !last;
                pg8::Order S; S.init(splitk ? ML : Mx, D, dn ? WGM_DN : WGM_OUT, 0, 0, F.G, (int)blockIdx.x);
                const float* go_g = dn ? INP(5) + l * D : INP(4) + l * D;
                const float* go_s = MOD + (size_t)l * 17 * MODW + (dn ? 4 : 1) * D;
                const bool fin = dn && last;
                fill_res_tables(F, S, MOD + (size_t)l * 17 * MODW + (dn ? 5 : 2) * D, fin ? INP(24) : (dn ? INP(4) : INP(5)) + ln * D, fin ? WSP(const float, WS_ZERO) : MOD + (size_t)ln * 17 * MODW + (dn ? 1 : 4) * D, go_g, go_s);
                pg8::EpiRes<RES_NB> E{(const LAS float*)(F.lds + TBL_OFF), WSP(bf16, WS_XA), dn ? WSP(float, WS_RSSA) : WSP(float, WS_RSSB)};
#ifndef NO_GR
                pg8::gemm_phase<pg8::EpiRes<RES_NB>, pg8::Order, true, true>(F.lds + RING_OFF, g, S, E, F.tid);
                if (!dn && !last) filler_weights(F, S.nwg + S.extra, W_F1, W_F2);
                if (splitk) {
                    pg8::Order S2; S2.init(ML, 0, 4, (MC / 256) * 16, 2, F.G, (int)blockIdx.x);
                    pg8::EpiSlab E2{WSP(float, WS_PART), MOD + ((size_t)l * 17 + NB) * MODW + 5 * D};
                    pg8::gemm_phase<pg8::EpiSlab, pg8::Order, true, true, true>(F.lds + RING_OFF, g, S2, E2, F.tid);
                }
#endif
            } else if (k == 5) {
                pg8::Gemm g{WSP(const bf16, WS_XA), WSP(const bf16, WS_W1) + (size_t)l * FF * D, Mx, FF, D};
                pg8::Order S; S.init(Mx, FF, WGM_UP, 0, 0, F.G, (int)blockIdx.x);
                fill_scale_tables<FF>(F, S, WSP(const float, WS_RSSB), WSP(const float, WS_SHW2) + (size_t)l * 17 * FF);
                pg8::EpiScale<1, FF> E{WSP(bf16, WS_HID), (const LAS float*)(F.lds + TBL_OFF), PROBE_V};

#ifndef NO_G1
                pg8::gemm_phase<pg8::EpiScale<1, FF>, pg8::Order, true, true>(F.lds + RING_OFF, g, S, E, F.tid);
#endif

            }
        }
#ifdef PROBE_MASK
        if (((PROBE_MASK >> ph) & 1) && !rep_done) { rep_done = true; xcd_barrier(bar, F.tid); --ph; continue; }
        rep_done = false;
#endif
#ifdef PROBE_PH
        if (ph == PROBE_PH) { tp1_ = (unsigned)__builtin_amdgcn_readfirstlane((int)(unsigned)__builtin_amdgcn_s_memrealtime());
            if (F.tid == 0) { unsigned* pc = WSP(unsigned, WS_CTL + 768 * 1024); const unsigned w_ = tp1_ - tp0_; atomicMax(pc + 1, w_); atomicMax(pc + 2, 0xFFFFFFFFu - w_); if (blockIdx.x == 0) pc[0] = w_; } }
#endif
        if (ph + 1 < hi) xcd_barrier(bar, F.tid);
#ifdef PROBE_PH
        if (ph == PROBE_PH && blockIdx.x == 0 && F.tid == 0) { unsigned* pc = WSP(unsigned, WS_CTL + 768 * 1024); pc[3] = (unsigned)__builtin_amdgcn_s_memrealtime() - tp1_; }
#endif
#ifdef PROBE_TL
        { const unsigned tn_ = (unsigned)__builtin_amdgcn_readfirstlane((int)(unsigned)__builtin_amdgcn_s_memrealtime());
          if (blockIdx.x == 0 && F.tid == 0) WSP(unsigned, WS_CTL + 768 * 1024)[16 + ph] = tn_ - ttl_;
          ttl_ = tn_; }
        if (ph == N_PHASES - 1) {
            xcd_barrier(bar, F.tid);
            if (blockIdx.x == 0) { const unsigned* pc = WSP(const unsigned, WS_CTL + 768 * 1024);
                const float va_ = (float)__builtin_nontemporal_load(pc + 16 + PROBE_TLA) * PROBE_SA, vb_ = (float)__builtin_nontemporal_load(pc + 16 + PROBE_TLB) * PROBE_SB;
                if (F.tid == 0) F.out[0] = va_;
                for (int i = F.tid; i < 4096; i += NWAVES * 64) F.out[1024 + i] = vb_; }
        }
#endif
#ifdef PROBE_BAR2
        if (ph + 1 < hi) xcd_barrier(bar, F.tid);
#endif
    }
}

extern "C" void kernel_launch(void* const* d_in, const int* in_sizes, int n_in, void* d_out, int out_size, void* d_ws, size_t ws_size, hipStream_t stream) {
    static int grid = 0;
    if (grid == 0) {
        if (n_in != 25 || out_size != ML * D || ws_size < WS_END) { fprintf(stderr, "kernel_launch: unexpected shapes (n_in %d out %d ws %zu)\n", n_in, out_size, ws_size); grid = -1; return; }
        int dev = 0, cus = 0;
        if (hipGetDevice(&dev) != hipSuccess || hipDeviceGetAttribute(&cus, hipDeviceAttributeMultiprocessorCount, dev) != hipSuccess) { grid = -1; return; }
        if (hipFuncSetAttribute((const void*)mega_fwd, hipFuncAttributeMaxDynamicSharedMemorySize, LDS_BYTES) != hipSuccess) { fprintf(stderr, "kernel_launch: hipFuncSetAttribute failed\n"); grid = -1; return; }
        int per_cu = 0;
        if (hipOccupancyMaxActiveBlocksPerMultiprocessor(&per_cu, (const void*)mega_fwd, NWAVES * 64, LDS_BYTES) != hipSuccess || per_cu < 1) fprintf(stderr, "kernel_launch: occupancy query reports %d\n", per_cu);
        (void)hipGetLastError();
        grid = cus;
    }
    if (grid < 0) return;
    if (hipMemsetAsync((char*)d_ws + WS_CTL, 0, CTL_ZERO_BYTES, stream) != hipSuccess) return;
    Args a{};
    for (int i = 0; i < 25; ++i) a.in[i] = (const float*)d_in[i];
    a.out = (float*)d_out; a.ws = (unsigned char*)d_ws;
#if MK_N_LAUNCHES == 1
    a.ph_lo = 0; a.ph_hi = N_PHASES;
    hipLaunchKernelGGL(mega_fwd, dim3(grid), dim3(NWAVES * 64), LDS_BYTES, stream, a);
#else
    for (int ph = 0; ph < N_PHASES; ++ph) { a.ph_lo = ph; a.ph_hi = ph + 1; hipLaunchKernelGGL(mega_fwd, dim3(grid), dim3(NWAVES * 64), LDS_BYTES, stream, a); }
#endif
}
```

```cpp
#include <hip/hip_runtime.h>
#include <cstdio>
#include <cstdint>

constexpr int D = 1024, NB = 16, SEQ = 2048, CTXL = 256, DEPTH = 2;
constexpr int ML = NB * SEQ, MC = NB * CTXL, MT = ML + MC;
constexpr int IND = 2560, FF = 4096, NH = 8, HD = 64;
constexpr int MODW = 6 * D;
constexpr float EPS = 1e-6f;
#ifndef MK_N_LAUNCHES
#define MK_N_LAUNCHES 1
#endif

namespace pg8 {
#define PG8_LAS __attribute__((address_space(3)))
typedef unsigned short bf16_t;
typedef short bf16x8 __attribute__((ext_vector_type(8)));
typedef float f32x4 __attribute__((ext_vector_type(4)));
typedef unsigned u32x4 __attribute__((ext_vector_type(4)));
constexpr int BM = 256, BK = 64, HALF = 128, HTB = HALF * BK * 2, STAGE_BYTES = 8 * HTB, NXCD = 8;
constexpr int TBL_UNITS = 9;

__host__ __device__ __forceinline__ int lds_byte(int r, int c) { const int st = (r >> 4) * 2 + (c >> 5), rr = r & 15, cc = c & 31, ob = rr * 64 + cc * 2; return st * 1024 + (ob ^ (((ob >> 9) & 1) << 5)); }
__host__ __device__ __forceinline__ void stage_rc(int b, int& R, int& C) { const int st = b / 1024, sb = b % 1024, swz = sb ^ (((sb >> 9) & 1) << 5); R = (st >> 1) * 16 + swz / 64; C = (st & 1) * 32 + (swz % 64) / 2; }
__host__ __device__ __forceinline__ int perm32(int rho) { const int n = rho >> 4, i = rho & 15; return 8 * (i >> 2) + 4 * n + (i & 3); }

struct Unit { int pm, pn; };
struct Gemm { const bf16_t* A; const bf16_t* Bt; int M, N, K; };

__host__ __device__ __forceinline__ void map_tile(int wgid, int nM, int nN, int WGM, Unit& u) {
    const int nwg = nM * nN;
    { const int q = nwg / NXCD, r = nwg % NXCD, xcd = wgid % NXCD, off = wgid / NXCD; wgid = (xcd < r ? xcd * (q + 1) : r * (q + 1) + (xcd - r) * q) + off; }
    const int nig = WGM * nN, gid = wgid / nig, fm = gid * WGM, gsz = (nM - fm) < WGM ? (nM - fm) : WGM;
    u.pm = fm + ((wgid % nig) % gsz); u.pn = (wgid % nig) / gsz;
}
struct Order {
    int nM, nN, nwg, extra, mode, wgm, G, c;
    __host__ __device__ void init(int M, int N, int wgm_, int extra_, int mode_, int G_, int c_) { nM = M / BM; nN = N / BM; nwg = nM * nN; extra = extra_; mode = mode_; wgm = wgm_; G = G_; c = c_; }
    __host__ __device__ bool next(int i, Unit& u) const {
        const long L = (long)i * G + c;
        if (L < nwg) { map_tile((int)L, nM, nN, wgm, u); return true; }
        if (L < nwg + extra) { const int q = (int)L - nwg;
            if (mode == 1) { u.pm = nM + q / 5; u.pn = 4 + q % 5; }
            else { u.pm = nM + (q >> 4); u.pn = 4 + 4 * (q & 3) + ((q >> 2) & 3); }
            return true; }
        return false;
    }
    __device__ __forceinline__ void a_ready(const Unit&) const {}
    __device__ __forceinline__ void done(const Unit&) const {}
};

__device__ __forceinline__ unsigned cvt_pk_bf16(float lo, float hi) { unsigned r; asm volatile("v_cvt_pk_bf16_f32 %0, %1, %2" : "=v"(r) : "v"(lo), "v"(hi)); return r; }

template <int ACT, int LDC, bool GLU = false> struct EpiScale {
    static constexpr bool PERM = true, AFTER_DRAIN = false;
    bf16_t* O;
    const PG8_LAS float* tbl;
    int probe;
    __device__ __forceinline__ void operator()(const f32x4 (&acc)[2][2][4][2], const Unit& u, int wr, int wc, int fr, int fq, int ui) const {
        asm volatile("" : "+s"(wr), "+s"(wc));
        bf16_t* Ot = O + (size_t)u.pm * BM * LDC + u.pn * BM;
        unsigned cl = (unsigned)(wc * 32 + 8 * fq);
        unsigned rl0 = (unsigned)(wr * 64 + fr);
        asm volatile("" : "+v"(cl), "+v"(rl0));
        const PG8_LAS float* rst = tbl + ui * 256, * sht = tbl + TBL_UNITS * 256 + ui * 256;
        f32x4 sh[2][2]; float rs[2][4];
#pragma unroll
        for (int ai = 0; ai < 2; ++ai)
#pragma unroll
            for (int m = 0; m < 4; ++m) rs[ai][m] = rst[rl0 + (unsigned)(ai * HALF + m * 16)];
#pragma unroll
        for (int bj = 0; bj < 2; ++bj) { sh[bj][0] = *(const PG8_LAS f32x4*)(sht + (cl + (unsigned)(bj * HALF))); sh[bj][1] = *(const PG8_LAS f32x4*)(sht + (cl + (unsigned)(bj * HALF + 4))); }
        if (GLU && u.pn < 2) {
#pragma unroll
            for (int ai = 0; ai < 2; ++ai)
#pragma unroll
                for (int m = 0; m < 4; ++m) {
                    const f32x4 a0 = acc[ai][0][m][0] * rs[ai][m] + sh[0][0], a1 = acc[ai][0][m][1] * rs[ai][m] + sh[0][1];
                    const f32x4 g0 = acc[ai][1][m][0] * rs[ai][m] + sh[1][0], g1 = acc[ai][1][m][1] * rs[ai][m] + sh[1][1];
                    f32x4 v0, v1;
#pragma unroll
                    for (int e = 0; e < 4; ++e) { v0[e] = a0[e] * __builtin_amdgcn_rcpf(1.f + __builtin_amdgcn_exp2f(-1.4426950408889634f * g0[e])); v1[e] = a1[e] * __builtin_amdgcn_rcpf(1.f + __builtin_amdgcn_exp2f(-1.4426950408889634f * g1[e])); }
                    u32x4 w; w.x = cvt_pk_bf16(v0[0], v0[1]); w.y = cvt_pk_bf16(v0[2], v0[3]); w.z = cvt_pk_bf16(v1[0], v1[1]); w.w = cvt_pk_bf16(v1[2], v1[3]);
                    *(u32x4*)(O + (size_t)u.pm * BM * LDC + u.pn * HALF + ((rl0 + (unsigned)(ai * HALF + m * 16)) * (unsigned)LDC + cl)) = w;
                }
            return;
        }
#pragma unroll
        for (int bj = 0; bj < 2; ++bj)
#pragma unroll
            for (int ai = 0; ai < 2; ++ai)
#pragma unroll
                for (int m = 0; m < 4; ++m) {
                    f32x4 v0 = acc[ai][bj][m][0] * rs[ai][m] + sh[bj][0], v1 = acc[ai][bj][m][1] * rs[ai][m] + sh[bj][1];
                    if (ACT == 1) {
#pragma unroll
                        for (int e = 0; e < 4; ++e) { const float a = fmaxf(v0[e], 0.f), b = fmaxf(v1[e], 0.f); v0[e] = a * a; v1[e] = b * b; }
                    }
                    u32x4 w; w.x = cvt_pk_bf16(v0[0], v0[1]); w.y = cvt_pk_bf16(v0[2], v0[3]); w.z = cvt_pk_bf16(v1[0], v1[1]); w.w = cvt_pk_bf16(v1[2], v1[3]);
                    if (probe == 0) __builtin_nontemporal_store(w, (u32x4*)(Ot + ((rl0 + (unsigned)(ai * HALF + m * 16)) * (unsigned)LDC + cl + (unsigned)(bj * HALF))));
                    else asm volatile("" :: "v"(w));
                }
    }
};
__device__ __forceinline__ float rows4_sum(float x) {
    float a = x, b = x;
    asm volatile("s_nop 1\n\tv_permlane16_swap_b32 %0, %1\n\ts_nop 1" : "+v"(a), "+v"(b));
    const float s = a + b; float c = s, d = s;
    asm volatile("s_nop 1\n\tv_permlane32_swap_b32 %0, %1\n\ts_nop 1" : "+v"(c), "+v"(d));
    return c + d;
}
template <int NB_> struct EpiRes {
    static constexpr bool PERM = true, AFTER_DRAIN = false;
    const PG8_LAS float* tbl;
    bf16_t* XA; float* RSS;
    __device__ __forceinline__ void operator()(const f32x4 (&acc)[2][2][4][2], const Unit& u, int wr, int wc, int fr, int fq, int ui) const {
        asm volatile("" : "+s"(wr), "+s"(wc));
        bf16_t* XAt = XA + (size_t)u.pm * BM * D + u.pn * BM;
        float* RSSt = RSS + (size_t)u.pm * BM * 32 + u.pn * 8 + wc;
        unsigned cl = (unsigned)(wc * 32 + 8 * fq);
        unsigned rl0 = (unsigned)(wr * 64 + fr);
        asm volatile("" : "+v"(cl), "+v"(rl0));
        const PG8_LAS float* gT = tbl + ui * 256, * mT = tbl + (TBL_UNITS + ui) * 256, * iT = tbl + (2 * TBL_UNITS + ui) * 256;
        constexpr int BJB = 2 / NB_;
#pragma unroll
        for (int b0 = 0; b0 < 2; b0 += BJB) {
            u32x4 xb[BJB][2][4];
#pragma unroll
            for (int bb = 0; bb < BJB; ++bb)
#pragma unroll
                for (int ai = 0; ai < 2; ++ai)
#pragma unroll
                    for (int m = 0; m < 4; ++m) xb[bb][ai][m] = *(const u32x4*)(XAt + ((rl0 + (unsigned)(ai * HALF + m * 16)) * (unsigned)D + cl + (unsigned)((b0 + bb) * HALF)));
            asm volatile("" ::: "memory");
#pragma unroll
            for (int bb = 0; bb < BJB; ++bb) {
                const int bj = b0 + bb;
                const unsigned c = cl + (unsigned)(bj * HALF);
                const f32x4 g0 = *(const PG8_LAS f32x4*)(gT + c), g1 = *(const PG8_LAS f32x4*)(gT + (c + 4u)), m0 = *(const PG8_LAS f32x4*)(mT + c), m1 = *(const PG8_LAS f32x4*)(mT + (c + 4u)),
                            r0 = *(const PG8_LAS f32x4*)(iT + c), r1 = *(const PG8_LAS f32x4*)(iT + (c + 4u));
#pragma unroll
                for (int ai = 0; ai < 2; ++ai)
#pragma unroll
                    for (int m = 0; m < 4; ++m) {
                        const unsigned rl = rl0 + (unsigned)(ai * HALF + m * 16);
                        const u32x4 w = xb[bb][ai][m];
                        const f32x4 x0 = (f32x4){__uint_as_float(w.x << 16), __uint_as_float(w.x & 0xffff0000u), __uint_as_float(w.y << 16), __uint_as_float(w.y & 0xffff0000u)} * r0;
                        const f32x4 x1 = (f32x4){__uint_as_float(w.z << 16), __uint_as_float(w.z & 0xffff0000u), __uint_as_float(w.w << 16), __uint_as_float(w.w & 0xffff0000u)} * r1;
                        const f32x4 y0 = x0 + g0 * acc[ai][bj][m][0], y1 = x1 + g1 * acc[ai][bj][m][1];
                        float ss = ((y0[0] * y0[0] + y0[1] * y0[1]) + (y0[2] * y0[2] + y0[3] * y0[3])) + ((y1[0] * y1[0] + y1[1] * y1[1]) + (y1[2] * y1[2] + y1[3] * y1[3]));
                        ss = rows4_sum(ss);
                        if (fq == 0) RSSt[rl * 32u + (unsigned)(bj * 4)] = ss;
                        const f32x4 a0 = y0 * m0, a1 = y1 * m1;
                        u32x4 o; o.x = cvt_pk_bf16(a0[0], a0[1]); o.y = cvt_pk_bf16(a0[2], a0[3]); o.z = cvt_pk_bf16(a1[0], a1[1]); o.w = cvt_pk_bf16(a1[2], a1[3]);
                        __builtin_nontemporal_store(o, (u32x4*)(XAt + (rl * (unsigned)D + c)));
                    }
            }
            asm volatile("" ::: "memory");
        }
    }
};

struct EpiSlab {
    static constexpr bool PERM = true, AFTER_DRAIN = false;
    float* P; const float* gate;
    __device__ __forceinline__ void operator()(const f32x4 (&acc)[2][2][4][2], const Unit& u, int wr, int wc, int fr, int fq, int) const {
        asm volatile("" : "+s"(wr), "+s"(wc));
        const int ks = (u.pn - 4) >> 2, pn = u.pn & 3;
        float* At = P + ((size_t)ks * MC + (size_t)(u.pm - ML / BM) * BM) * D + pn * BM;
        const float* gtq = gate + pn * BM;
        unsigned cl = (unsigned)(wc * 32 + 8 * fq), rl0 = (unsigned)(wr * 64 + fr);
        asm volatile("" : "+v"(cl), "+v"(rl0));
        f32x4 gv[2][2];
#pragma unroll
        for (int bj = 0; bj < 2; ++bj) { gv[bj][0] = *(const f32x4*)(gtq + (cl + (unsigned)(bj * HALF))); gv[bj][1] = *(const f32x4*)(gtq + (cl + (unsigned)(bj * HALF + 4))); }
#pragma unroll
        for (int bj = 0; bj < 2; ++bj) { const unsigned c = cl + (unsigned)(bj * HALF);
#pragma unroll
            for (int ai = 0; ai < 2; ++ai)
#pragma unroll
                for (int m = 0; m < 4; ++m) { const unsigned off = (rl0 + (unsigned)(ai * HALF + m * 16)) * (unsigned)D + c;
                    *(f32x4*)(At + off) = gv[bj][0] * acc[ai][bj][m][0]; *(f32x4*)(At + (off + 4u)) = gv[bj][1] * acc[ai][bj][m][1]; } }
    }
};

struct NoPre { __device__ __forceinline__ void operator()() const {} };
template <class Epi, class Sched, bool ALIGN_EPI = false, bool SP2 = false, bool VARK = false, class Pre = NoPre>
__device__ __forceinline__ void gemm_phase(PG8_LAS unsigned char* lds, const Gemm g, const Sched& S, const Epi& E, const int tid, const Pre& pre = Pre()) {
    const int wid = __builtin_amdgcn_readfirstlane(tid >> 6), lane = tid & 63, wr = wid >> 2, wc = wid & 3, fr = lane & 15, fq = lane >> 4;
    const int K = g.K;
    unsigned voffA[2], voffB[2];
#pragma unroll
    for (int i = 0; i < 2; ++i) { int R, C; stage_rc(tid * 16 + i * 8192, R, C); const int Rb = Epi::PERM ? ((R & ~31) + perm32(R & 31)) : R;
        voffA[i] = (unsigned)(R * K + C) * 2u; voffB[i] = (unsigned)(Rb * K + C) * 2u; }
    const size_t kstep = (size_t)(BK * 2);
    const size_t hstep = (size_t)HALF * K * 2;
    const size_t tstep = 2 * hstep;
    const unsigned ldsw = (unsigned)wid * 1024u;
    const int aoff = lds_byte(wr * 64 + fr, fq * 8), boff = lds_byte(wc * 32 + fr, fq * 8);
#define PG8_SA(b, h) (((b) * 2 + (h)) * HTB)
#define PG8_SB(b, h) ((4 + (b) * 2 + (h)) * HTB)
#define PG8_STAGE(bufoff, gbase, voff) do { _Pragma("unroll") for (int _i = 0; _i < 2; ++_i) \
        __builtin_amdgcn_global_load_lds((const unsigned*)((const char*)(gbase) + (voff)[_i]), (PG8_LAS unsigned*)(lds + (bufoff) + ldsw + _i * 8192), 16, 0, 0); } while (0)
#define PG8_LDA(dst, b, h) do { _Pragma("unroll") for (int m = 0; m < 4; ++m) _Pragma("unroll") for (int k = 0; k < 2; ++k) dst[m][k] = *(const PG8_LAS bf16x8*)(lds + PG8_SA(b, h) + aoff + m * 2048 + k * 1024); } while (0)
#define PG8_LDB(dst, b, h) do { _Pragma("unroll") for (int n = 0; n < 2; ++n) _Pragma("unroll") for (int k = 0; k < 2; ++k) dst[n][k] = *(const PG8_LAS bf16x8*)(lds + PG8_SB(b, h) + boff + n * 2048 + k * 1024); } while (0)
#define PG8_MMA(ai, bj, At, Bt) do { __builtin_amdgcn_s_setprio(1); _Pragma("unroll") for (int m = 0; m < 4; ++m) _Pragma("unroll") for (int n = 0; n < 2; ++n) _Pragma("unroll") for (int k = 0; k < 2; ++k) \
        acc[ai][bj][m][n] = __builtin_amdgcn_mfma_f32_16x16x32_bf16(Bt[n][k], At[m][k], acc[ai][bj][m][n], 0, 0, 0); __builtin_amdgcn_s_setprio(0); } while (0)
#define PG8_WAIT_V(n) asm volatile("s_waitcnt vmcnt(" #n ")" ::: "memory")
#define PG8_WAIT_L(n) asm volatile("s_waitcnt lgkmcnt(" #n ")" ::: "memory")
#define PG8_BAR __builtin_amdgcn_s_barrier()
#define PG8_SCHED __builtin_amdgcn_sched_barrier(0)
    Unit cur, nxt; int ui = 0;
    if (!S.next(0, cur)) return;
    cur.pm = __builtin_amdgcn_readfirstlane(cur.pm); cur.pn = __builtin_amdgcn_readfirstlane(cur.pn);
    f32x4 acc[2][2][4][2];
#pragma unroll
    for (int a = 0; a < 2; ++a)
#pragma unroll
        for (int b = 0; b < 2; ++b)
#pragma unroll
            for (int m = 0; m < 4; ++m)
#pragma unroll
                for (int n = 0; n < 2; ++n) acc[a][b][m][n] = (f32x4){0.f, 0.f, 0.f, 0.f};
    bf16x8 At[4][2], B0[2][2], B1[2][2];
#define PG8_KOFF(u) ((VARK && (u).pn >= 4) ? (size_t)(((u).pn - 4) >> 2) * (size_t)(K / 4) * 2 : (size_t)0)
#define PG8_PN(u) ((VARK && (u).pn >= 4) ? ((u).pn & 3) : (u).pn)
    const char* cA = (const char*)g.A + (size_t)cur.pm * tstep + PG8_KOFF(cur); const char* cB = (const char*)g.Bt + (size_t)PG8_PN(cur) * tstep + PG8_KOFF(cur);
    S.a_ready(cur);
    if constexpr (SP2) {
        PG8_STAGE(PG8_SB(0, 0), cB, voffB); PG8_STAGE(PG8_SB(0, 1), cB + hstep, voffB); PG8_STAGE(PG8_SA(0, 0), cA, voffA); PG8_STAGE(PG8_SA(0, 1), cA + hstep, voffA);
        pre();
        if (wr == 1) PG8_BAR;
        PG8_WAIT_V(2); PG8_BAR;
        PG8_STAGE(PG8_SB(1, 0), cB + kstep, voffB); PG8_STAGE(PG8_SA(1, 0), cA + kstep, voffA); PG8_STAGE(PG8_SB(1, 1), cB + hstep + kstep, voffB);
        PG8_WAIT_V(6); PG8_BAR;
    } else {
        PG8_STAGE(PG8_SB(0, 0), cB, voffB); PG8_STAGE(PG8_SA(0, 0), cA, voffA); PG8_STAGE(PG8_SB(0, 1), cB + hstep, voffB); PG8_STAGE(PG8_SA(0, 1), cA + hstep, voffA);
        pre();
        if (wr == 1) PG8_BAR;
        PG8_WAIT_V(4); PG8_BAR;
        PG8_STAGE(PG8_SB(1, 0), cB + kstep, voffB); PG8_STAGE(PG8_SA(1, 0), cA + kstep, voffA); PG8_STAGE(PG8_SB(1, 1), cB + hstep + kstep, voffB);
        PG8_WAIT_V(6); PG8_BAR;
    }
    for (;;) {
        const bool has_next = S.next(ui + 1, nxt);
        nxt.pm = __builtin_amdgcn_readfirstlane(nxt.pm); nxt.pn = __builtin_amdgcn_readfirstlane(nxt.pn);
        const char* nA = has_next ? (const char*)g.A + (size_t)nxt.pm * tstep + PG8_KOFF(nxt) : cA; const char* nB = has_next ? (const char*)g.Bt + (size_t)PG8_PN(nxt) * tstep + PG8_KOFF(nxt) : cB;
        const int nt = (VARK && cur.pn >= 4) ? K / BK / 4 : K / BK;
        for (int t = 0; t < nt; t += 2) {
            const bool last = (t == nt - 2);
            const char* a1 = cA + (size_t)(t + 1) * kstep;
            const char* a2 = last ? nA : cA + (size_t)(t + 2) * kstep; const char* b2 = last ? nB : cB + (size_t)(t + 2) * kstep;
            const char* a3 = a2 + kstep; const char* b3 = b2 + kstep;
            if (last && has_next) S.a_ready(nxt);
            if constexpr (SP2) {
            PG8_LDB(B0, 0, 0); PG8_LDB(B1, 0, 1); PG8_SCHED; PG8_LDA(At, 0, 0); PG8_STAGE(PG8_SA(1, 1), a1 + hstep, voffA);
            PG8_WAIT_V(8); PG8_WAIT_L(0); PG8_BAR; PG8_MMA(0, 0, At, B0); PG8_MMA(0, 1, At, B1); PG8_BAR; PG8_SCHED;
            PG8_LDA(At, 0, 1); PG8_STAGE(PG8_SB(0, 0), b2, voffB); PG8_STAGE(PG8_SB(0, 1), b2 + hstep, voffB); PG8_STAGE(PG8_SA(0, 0), a2, voffA);
            PG8_WAIT_V(8); PG8_WAIT_L(0); PG8_BAR; PG8_MMA(1, 0, At, B0); PG8_MMA(1, 1, At, B1); PG8_BAR; PG8_SCHED;
            PG8_LDB(B0, 1, 0); PG8_LDB(B1, 1, 1); PG8_SCHED; PG8_LDA(At, 1, 0); PG8_STAGE(PG8_SA(0, 1), a2 + hstep, voffA);
            PG8_WAIT_V(8); PG8_WAIT_L(0); PG8_BAR; PG8_MMA(0, 0, At, B0); PG8_MMA(0, 1, At, B1); PG8_BAR; PG8_SCHED;
            PG8_LDA(At, 1, 1); PG8_STAGE(PG8_SB(1, 0), b3, voffB); PG8_STAGE(PG8_SB(1, 1), b3 + hstep, voffB); PG8_STAGE(PG8_SA(1, 0), a3, voffA);
            PG8_WAIT_V(8); PG8_WAIT_L(0); PG8_BAR; PG8_MMA(1, 0, At, B0); PG8_MMA(1, 1, At, B1); PG8_BAR; PG8_SCHED;
            } else {
            PG8_LDB(B0, 0, 0); PG8_SCHED; PG8_LDA(At, 0, 0); PG8_STAGE(PG8_SA(1, 1), a1 + hstep, voffA);
            PG8_WAIT_L(8); PG8_BAR; PG8_WAIT_L(0); PG8_MMA(0, 0, At, B0); PG8_BAR; PG8_SCHED;
            PG8_LDB(B1, 0, 1); PG8_STAGE(PG8_SB(0, 0), b2, voffB);
            PG8_BAR; PG8_WAIT_L(0); PG8_MMA(0, 1, At, B1); PG8_BAR;
            PG8_LDA(At, 0, 1); PG8_STAGE(PG8_SA(0, 0), a2, voffA);
            PG8_BAR; PG8_WAIT_L(0); PG8_MMA(1, 0, At, B0); PG8_BAR; PG8_SCHED;
            PG8_STAGE(PG8_SB(0, 1), b2 + hstep, voffB);
            PG8_WAIT_V(6); PG8_BAR; PG8_MMA(1, 1, At, B1); PG8_BAR;
            PG8_LDB(B0, 1, 0); PG8_SCHED; PG8_LDA(At, 1, 0); PG8_STAGE(PG8_SA(0, 1), a2 + hstep, voffA);
            PG8_WAIT_L(8); PG8_BAR; PG8_WAIT_L(0); PG8_MMA(0, 0, At, B0); PG8_BAR; PG8_SCHED;
            PG8_LDB(B1, 1, 1); PG8_STAGE(PG8_SB(1, 0), b3, voffB);
            PG8_BAR; PG8_WAIT_L(0); PG8_MMA(0, 1, At, B1); PG8_BAR;
            PG8_LDA(At, 1, 1); PG8_STAGE(PG8_SA(1, 0), a3, voffA);
            PG8_BAR; PG8_WAIT_L(0); PG8_MMA(1, 0, At, B0); PG8_BAR; PG8_SCHED;
            PG8_STAGE(PG8_SB(1, 1), b3 + hstep, voffB);
            PG8_WAIT_V(6); PG8_BAR; PG8_MMA(1, 1, At, B1); PG8_BAR;
            }
        }
        if constexpr (ALIGN_EPI) { if (wr == 0) PG8_BAR; }
        if constexpr (!Epi::AFTER_DRAIN) { E(acc, cur, wr, wc, fr, fq, ui); S.done(cur); }
        if (!has_next) break;
#pragma unroll
        for (int a = 0; a < 2; ++a)
#pragma unroll
            for (int b = 0; b < 2; ++b)
#pragma unroll
                for (int m = 0; m < 4; ++m)
#pragma unroll
                    for (int n = 0; n < 2; ++n) acc[a][b][m][n] = (f32x4){0.f, 0.f, 0.f, 0.f};
        cur = nxt; cA = nA; cB = nB; ++ui;
        if constexpr (ALIGN_EPI) { if (wr == 1) PG8_BAR; }
    }
    PG8_WAIT_V(0);
    if constexpr (!ALIGN_EPI) { if (wr == 0) PG8_BAR; }
    PG8_BAR;
    if constexpr (Epi::AFTER_DRAIN) { E.fused(acc, cur, wr, wc, fr, fq, lds, wid, lane); S.done(cur); }
#undef PG8_KOFF
#undef PG8_PN
#undef PG8_SA
#undef PG8_SB
#undef PG8_STAGE
#undef PG8_LDA
#undef PG8_LDB
#undef PG8_MMA
#undef PG8_WAIT_V
#undef PG8_WAIT_L
#undef PG8_BAR
#undef PG8_SCHED
}
}

constexpr size_t MiB = 1u << 20;
constexpr size_t WS_CTL = 0, CTL_ZERO_BYTES = 1 * MiB;
constexpr size_t WS_MOD = 1 * MiB;
constexpr size_t WS_SHW1 = 2 * MiB;
constexpr size_t WS_SHW2 = 3 * MiB;
constexpr size_t WS_RSSA = 4 * MiB;
constexpr size_t WS_RSSB = 9 * MiB;
constexpr size_t WS_TOT = 14 * MiB;
constexpr size_t WS_CARRY = 19 * MiB;
constexpr size_t WS_WLR = 21 * MiB + 512 * 1024;
constexpr size_t WS_WIN = 22 * MiB;
constexpr size_t WS_WOUT = 32 * MiB;
constexpr size_t WS_W1 = 36 * MiB;
constexpr size_t WS_W2 = 52 * MiB;
constexpr size_t WS_CX = 68 * MiB;
constexpr size_t WS_XA = 84 * MiB;
constexpr size_t WS_HID = 156 * MiB;
constexpr size_t WS_PROJ = WS_HID;
constexpr size_t WS_MIX = WS_HID + 180 * MiB;
constexpr size_t WS_PART = 444 * MiB;
constexpr size_t WS_AB = 436 * MiB;
constexpr size_t WS_END = 508 * MiB;
static_assert(WS_MIX + (size_t)MT * D * 2 <= WS_PART && WS_HID + (size_t)MT * FF * 2 == WS_PART && WS_PART + (size_t)4 * MC * D * 4 == WS_END && WS_AB >= WS_MIX + (size_t)MT * D * 2 && WS_AB + (size_t)1152 * 2 * 2 * 8 * 2 * 64 * 16 == WS_END, "ws map");
constexpr size_t WS_ZERO = WS_CTL + 512 * 1024;
constexpr int CW_BAR = 4096;

#ifndef WGM_IN
#define WGM_IN 4
#endif
#ifndef WGM_OUT
#define WGM_OUT 4
#endif
#ifndef WGM_UP
#define WGM_UP 4
#endif
#ifndef WGM_DN
#define WGM_DN 4
#endif
#ifndef RES_NB
#define RES_NB 2
#endif
constexpr int NWAVES = 8;
constexpr int RING_OFF = 0, RING_BYTES = 131072;
constexpr int LDSCTL_OFF = RING_BYTES, MISC_OFF = LDSCTL_OFF + 320;
constexpr int TBL_OFF = LDSCTL_OFF + 1024;
static_assert(TBL_OFF + 3 * pg8::TBL_UNITS * 256 * 4 <= 163840, "LDS map");
constexpr int LDS_BYTES = 163840;

#define GAS __attribute__((address_space(1)))
#define LAS __attribute__((address_space(3)))
typedef unsigned short bf16;
typedef unsigned v4u __attribute__((ext_vector_type(4)));
typedef unsigned v2u __attribute__((ext_vector_type(2)));
typedef float f32x4 __attribute__((ext_vector_type(4)));
typedef float f32x2 __attribute__((ext_vector_type(2)));
typedef GAS unsigned gu32;
#define LDS_WAIT() asm volatile("s_waitcnt lgkmcnt(0)" ::: "memory")
#define VM_WAIT() asm volatile("s_waitcnt vmcnt(0)" ::: "memory")
__device__ __forceinline__ unsigned f2bf(float f) { unsigned u = __builtin_bit_cast(unsigned, f); return (u + 0x7fffu + ((u >> 16) & 1u)) >> 16; }
__device__ __forceinline__ unsigned pk2(float lo, float hi) { return f2bf(lo) | (f2bf(hi) << 16); }
__device__ __forceinline__ float bflo(unsigned w) { return __uint_as_float(w << 16); }
__device__ __forceinline__ float bfhi(unsigned w) { return __uint_as_float(w & 0xffff0000u); }
__device__ __forceinline__ float bf1(bf16 v) { return __uint_as_float((unsigned)v << 16); }
__device__ __forceinline__ float sigmoidf_(float x) { return __builtin_amdgcn_rcpf(1.f + __builtin_amdgcn_exp2f(-1.4426950408889634f * x)); }
__device__ __forceinline__ float siluf_(float x) { return x * sigmoidf_(x); }
__device__ __forceinline__ float gelu_tanh(float x) { const float u = 0.7978845608028654f * (x + 0.044715f * x * x * x); return x * sigmoidf_(2.f * u); }
__device__ __forceinline__ float lane_xor1_sum(float v) { return v + __builtin_bit_cast(float, __builtin_amdgcn_update_dpp(0, __builtin_bit_cast(int, v), 0xB1, 0xf, 0xf, true)); }
__device__ __forceinline__ float row16_sum_(float v) {
    v += __builtin_bit_cast(float, __builtin_amdgcn_update_dpp(0, __builtin_bit_cast(int, v), 0xB1, 0xf, 0xf, true));
    v += __builtin_bit_cast(float, __builtin_amdgcn_update_dpp(0, __builtin_bit_cast(int, v), 0x4E, 0xf, 0xf, true));
    v += __builtin_bit_cast(float, __builtin_amdgcn_update_dpp(0, __builtin_bit_cast(int, v), 0x141, 0xf, 0xf, true));
    v += __builtin_bit_cast(float, __builtin_amdgcn_update_dpp(0, __builtin_bit_cast(int, v), 0x140, 0xf, 0xf, true));
    return v; }
__device__ __forceinline__ float wave_sum(float v) { v = row16_sum_(v); v += __shfl_xor(v, 16); v += __shfl_xor(v, 32); return v; }

#define XB_TMO      128
#define XB_XCNT(j)  (256  + 64 * (j))
#define XB_XSUB(j)  (1280 + 64 * (j))
#define XB_XGEN(j)  (2304 + 64 * (j))
#define XB_TOP      3328
#define XB_TOPGEN   3392
#define XCD_BAR_WORDS 3456
#define XB_SPIN_CAP (1u << 18)

__device__ __forceinline__ unsigned xb_ld(unsigned* p)              { return __hip_atomic_load(p, __ATOMIC_RELAXED, __HIP_MEMORY_SCOPE_AGENT); }
__device__ __forceinline__ unsigned xb_add(unsigned* p, unsigned v) { return __hip_atomic_fetch_add(p, v, __ATOMIC_RELAXED, __HIP_MEMORY_SCOPE_AGENT); }
__device__ __forceinline__ unsigned xb_xcc_id() { return (unsigned)__builtin_amdgcn_s_getreg((3 << 11) | 20) & 0xFu; }
#define XB_SPIN(cond, bar) do { unsigned _sp = 0; while (cond) { __builtin_amdgcn_s_sleep(1); \
    if ((++_sp & 255u) == 0u) { if (xb_ld(&(bar)[XB_TMO])) break; if (_sp > XB_SPIN_CAP) { atomicAdd(&(bar)[XB_TMO], 1u); break; } } } } while (0)

struct XcdBarrier {
    unsigned* bar; unsigned x;
    volatile LAS unsigned* st;
};

__device__ __forceinline__ XcdBarrier xcd_barrier_post(unsigned* bar, volatile LAS unsigned* st, int tid) {
    XcdBarrier b; b.bar = bar; b.x = xb_xcc_id(); b.st = st;
    if (tid == 0) (void)xb_add(&bar[XB_XCNT(b.x)], 1u);
    return b;
}
__device__ __forceinline__ void xcd_barrier_complete(unsigned* bar, unsigned x, unsigned& nloc, unsigned& nx) {
    const unsigned G = gridDim.x * gridDim.y * gridDim.z;
    unsigned sum, cnt, mine, sp = 0u;
    for (;;) {
        sum = 0u; cnt = 0u; mine = 0u;
        unsigned cv[16];
#pragma unroll
        for (unsigned j = 0; j < 16; ++j) cv[j] = xb_ld(&bar[XB_XCNT(j)]);
#pragma unroll
        for (unsigned j = 0; j < 16; ++j) { const unsigned c = cv[j]; sum += c; cnt += (c > 0u) ? 1u : 0u; mine = (j == x) ? c : mine; }
        if (sum == G) break;
        __builtin_amdgcn_s_sleep(1);
        if ((++sp & 255u) == 0u) { if (xb_ld(&bar[XB_TMO])) break; if (sp > XB_SPIN_CAP) { atomicAdd(&bar[XB_TMO], 1u); break; } }
    }
    nloc = mine > 0u ? mine : 1u; nx = cnt > 0u ? cnt : 1u;
}

__device__ __forceinline__ void xcd_barrier(const XcdBarrier& b, int tid) {
    asm volatile("s_waitcnt vmcnt(0)" ::: "memory");
    __syncthreads();
    if (tid == 0) {
        unsigned* bar = b.bar;
        __builtin_amdgcn_s_waitcnt(0);
        unsigned nloc = b.st[0], nx = b.st[1];
        if (nloc == 0u) { xcd_barrier_complete(bar, b.x, nloc, nx); b.st[0] = nloc; b.st[1] = nx; }
        const unsigned old = xb_add(&bar[XB_XSUB(b.x)], 1u);
        const unsigned gen = old / nloc;
        if (old + 1u == (gen + 1u) * nloc) {
            __builtin_amdgcn_fence(__ATOMIC_RELEASE, "agent");
            asm volatile("s_waitcnt vmcnt(0)" ::: "memory");
            const unsigned og = xb_add(&bar[XB_TOP], 1u);
            const unsigned tg = og / nx;
            if (og + 1u == (tg + 1u) * nx) xb_add(&bar[XB_TOPGEN], 1u);
            else XB_SPIN(xb_ld(&bar[XB_TOPGEN]) == tg, bar);
            __builtin_amdgcn_fence(__ATOMIC_ACQUIRE, "agent");
            xb_add(&bar[XB_XGEN(b.x)], 1u);
            asm volatile("s_waitcnt vmcnt(0)" ::: "memory");
        } else {
            XB_SPIN(xb_ld(&bar[XB_XGEN(b.x)]) == gen, bar);
            __builtin_amdgcn_fence(__ATOMIC_ACQUIRE, "agent");
            asm volatile("s_waitcnt vmcnt(0)" ::: "memory");
        }
    }
    __syncthreads();
}

struct Frame {
    LAS unsigned char* lds;
    int tid, wave;
    int vcu, G;
    int gw, NGW;
    float* out; unsigned char* ws;
};
constexpr int PTR_OFF = LDSCTL_OFF + 512;
__device__ __forceinline__ const float* inp_(LAS unsigned char* lds, int i) {
    const unsigned long long v = *(const LAS unsigned long long*)(lds + PTR_OFF + 8 * i);
    const unsigned lo = __builtin_amdgcn_readfirstlane((unsigned)v), hi = __builtin_amdgcn_readfirstlane((unsigned)(v >> 32));
    return (const float*)(((unsigned long long)hi << 32) | lo);
}
#define INP(i) inp_(F.lds, (i))
#define WSP(T, off) ((T*)(F.ws + (off)))

__device__ __forceinline__ void gemv17_item(Frame& F, const LAS float* tab, LAS float* red, const float* W, int ldw, int n0, const float* bias, float* outp, int ldo, int n0out) {
    int LN_ = F.tid & 63; asm volatile("" : "+v"(LN_));
    float acc[17];
#pragma unroll
    for (int r = 0; r < 17; ++r) acc[r] = 0.f;
    const int k0 = F.wave * 128;
    const float* wp = W + (size_t)k0 * ldw + n0 + LN_;
    float wa[16], wb[16];
#pragma unroll
    for (int k = 0; k < 16; ++k) wa[k] = __builtin_nontemporal_load(wp + (size_t)k * ldw);
#pragma unroll 1
    for (int kk = 0; kk < 128; kk += 32) {
#pragma unroll
        for (int k = 0; k < 16; ++k) wb[k] = __builtin_nontemporal_load(wp + (size_t)(kk + 16 + k) * ldw);
        asm volatile("" ::: "memory");
#pragma unroll
        for (int k = 0; k < 16; ++k) {
#pragma unroll
            for (int r = 0; r < 17; ++r) acc[r] += tab[r * 1024 + k0 + kk + k] * wa[k];
        }
        asm volatile("" ::: "memory");
        { const int kn = (kk + 32 < 128) ? kk + 32 : kk;
#pragma unroll
          for (int k = 0; k < 16; ++k) wa[k] = __builtin_nontemporal_load(wp + (size_t)(kn + k) * ldw); }
        asm volatile("" ::: "memory");
#pragma unroll
        for (int k = 0; k < 16; ++k) {
#pragma unroll
            for (int r = 0; r < 17; ++r) acc[r] += tab[r * 1024 + k0 + kk + 16 + k] * wb[k];
        }
        asm volatile("" ::: "memory");
    }
#pragma unroll
    for (int r = 0; r < 17; ++r) red[(F.wave * 17 + r) * 64 + LN_] = acc[r];
    __syncthreads();
    for (int i = F.tid; i < 17 * 64; i += NWAVES * 64) {
        const int r = i >> 6, n = i & 63; float s = bias ? bias[n0 + n] : 0.f;
#pragma unroll
        for (int w = 0; w < 8; ++w) s += red[(w * 17 + r) * 64 + n];
        outp[(size_t)r * ldo + n0out + n] = s;
    }
    __syncthreads();
}

__host__ __device__ __forceinline__ int glu_col(int o) { return o >= 512 ? o : ((o >> 7) & 1) * 256 + (o >> 8) * 128 + (o & 127); }
__device__ __forceinline__ void p0_transpose_item(const float* W, int K, int N, bf16* WT, LAS float* scr, int item, int lane, bool glu) {
    const int nblk = N / 32, kb = item / nblk, nb = item % nblk, k0 = 64 * kb, n0 = 32 * nb;
    const int n0o = glu ? glu_col(n0) : n0;
    float tv[32];
#pragma unroll
    for (int i = 0; i < 32; ++i) { const int kk = 2 * i + (lane >> 5); tv[i] = __builtin_nontemporal_load(W + (size_t)(k0 + kk) * N + n0 + (lane & 31)); }
#pragma unroll
    for (int i = 0; i < 32; ++i) { const int kk = 2 * i + (lane >> 5); scr[kk * 33 + (lane & 31)] = tv[i]; }
    LDS_WAIT(); asm volatile("" ::: "memory");
    const int c = lane & 7;
#pragma unroll
    for (int j = 0; j < 4; ++j) { const int n = (lane >> 3) + 8 * j; const LAS float* s = scr + (8 * c) * 33 + n;
        v4u o; o.x = pk2(s[0 * 33], s[1 * 33]); o.y = pk2(s[2 * 33], s[3 * 33]); o.z = pk2(s[4 * 33], s[5 * 33]); o.w = pk2(s[6 * 33], s[7 * 33]);
        *(GAS v4u*)(WT + (size_t)(n0o + n) * K + k0 + 8 * c) = o; }
    LDS_WAIT(); asm volatile("" ::: "memory");
}

__device__ __forceinline__ void weight_items(Frame& F, int first, int last, int widx, int nw) {
    int LN_ = F.tid & 63; asm volatile("" : "+v"(LN_));
    LAS float* scr = (LAS float*)(F.lds + F.wave * 16384);
    constexpr int I_IN = (D / 64) * (IND / 32), I_OUT = (D / 64) * (D / 32), I_1 = (D / 64) * (FF / 32), I_2 = (FF / 64) * (D / 32), I_L = I_IN + I_OUT + I_1 + I_2;
    for (int it = first + widx; it < last; it += nw) {
        const int l = it / I_L; int r = it % I_L;
        const float* W; bf16* WT; int K = D, N; const bool glu = r < I_IN;
        if (r < I_IN) { W = INP(8) + (size_t)l * D * IND; WT = WSP(bf16, WS_WIN) + (size_t)l * IND * D; N = IND; }
        else if (r < I_IN + I_OUT) { r -= I_IN; W = INP(9) + (size_t)l * D * D; WT = WSP(bf16, WS_WOUT) + (size_t)l * D * D; N = D; }
        else if (r < I_IN + I_OUT + I_1) { r -= I_IN + I_OUT; W = INP(22) + (size_t)l * D * FF; WT = WSP(bf16, WS_W1) + (size_t)l * FF * D; N = FF; }
        else { r -= I_IN + I_OUT + I_1; W = INP(23) + (size_t)l * FF * D; WT = WSP(bf16, WS_W2) + (size_t)l * D * FF; K = FF; N = D; }
        p0_transpose_item(W, K, N, WT, scr, r, LN_, glu);
    }
}
__device__ __forceinline__ void filler_weights(Frame& F, int total_units, int first, int last) {
    const int rem = total_units % F.G, bx = (int)blockIdx.x;
    if (F.G != 256 || rem == 0 || bx < rem) return;
    __syncthreads();
    weight_items(F, first, last, (bx - rem) * NWAVES + F.wave, (F.G - rem) * NWAVES);
}
constexpr int W_ITEMS = 2 * ((D / 64) * (IND / 32) + (D / 64) * (D / 32) + (D / 64) * (FF / 32) + (FF / 64) * (D / 32));
constexpr int W_F1 = 3840, W_F2 = 8448;
constexpr int W_EARLY = 64 * NWAVES * 3;

__device__ __forceinline__ void phase_p0a(Frame& F) {
    LAS float* tab = (LAS float*)(F.lds);
    LAS float* red = (LAS float*)(F.lds + 17 * 1024 * 4);
    float* MOD = WSP(float, WS_MOD);
    bool filled = false;
    for (int it = F.vcu; it < 2 * 96; it += F.G) {
        if (!filled) {
            {
                const float* c0 = INP(1); const float* c1 = INP(3);
#pragma unroll 1
                for (int r0 = 0; r0 < 16; r0 += 8) { float tv[16];
#pragma unroll
                    for (int j = 0; j < 16; ++j) tv[j] = c0[(r0 + (j >> 1)) * D + F.tid + 512 * (j & 1)];
#pragma unroll
                    for (int j = 0; j < 16; ++j) tab[(r0 + (j >> 1)) * 1024 + F.tid + 512 * (j & 1)] = siluf_(tv[j]); }
                { const float a = c1[F.tid], b = c1[F.tid + 512]; tab[16 * 1024 + F.tid] = siluf_(a); tab[16 * 1024 + F.tid + 512] = siluf_(b); }
            }
            __syncthreads(); filled = true;
        }
        const int l = it / 96, n0 = (it % 96) * 64;
        gemv17_item(F, tab, red, INP(6) + (size_t)l * D * MODW, MODW, n0, INP(7) + (size_t)l * MODW, MOD + (size_t)l * 17 * MODW, MODW, n0);
    }
    if (F.G == 256 && F.vcu >= 192) weight_items(F, 0, W_EARLY, (F.vcu - 192) * NWAVES + F.wave, 64 * NWAVES);
}

__device__ __forceinline__ void phase_p0b(Frame& F) {
    int LN_ = F.tid & 63; asm volatile("" : "+v"(LN_));
    LAS float* tab = (LAS float*)(F.lds);
    LAS float* red = (LAS float*)(F.lds + 17 * 1024 * 4);
    const float* MOD = WSP(const float, WS_MOD);
    bf16* XA = WSP(bf16, WS_XA); float* RSSA = WSP(float, WS_RSSA);
    const int rpw = (MT + F.NGW - 1) / F.NGW;
    auto stream_rows = [&](int run0, int runlen) __attribute__((always_inline)) {
        const float* g1 = INP(4);
        auto row_ptr = [&](int r_) -> const float* { return r_ < ML ? INP(0) + (size_t)r_ * D : INP(2) + (size_t)(r_ - ML) * D; };
        {
            const int rbeg = run0 < MT ? run0 : MT, rend = (rbeg + runlen < MT) ? rbeg + runlen : MT;
            f32x4 vn[2][4], gm[4]; int cur_b = -1;
            if (rbeg < rend) {
#pragma unroll
                for (int q = 0; q < 2; ++q) { const int r_ = (rbeg + q < rend) ? rbeg + q : rbeg; const float* xr = row_ptr(r_);
#pragma unroll
                    for (int j = 0; j < 4; ++j) vn[q][j] = __builtin_nontemporal_load((const f32x4*)(xr + 4 * LN_ + 256 * j)); }
            }
#pragma unroll 1
            for (int row = rbeg; row < rend; row += 2) {
                f32x4 v[2][4];
#pragma unroll
                for (int q = 0; q < 2; ++q)
#pragma unroll
                    for (int j = 0; j < 4; ++j) v[q][j] = vn[q][j];
                if (row + 2 < rend) {
#pragma unroll
                    for (int q = 0; q < 2; ++q) { const int r_ = (row + 2 + q < rend) ? row + 2 + q : row + 2; const float* xr = row_ptr(r_);
#pragma unroll
                        for (int j = 0; j < 4; ++j) vn[q][j] = __builtin_nontemporal_load((const f32x4*)(xr + 4 * LN_ + 256 * j)); }
                }
                float ss[2];
#pragma unroll
                for (int q = 0; q < 2; ++q) { float s_ = 0.f;
#pragma unroll
                    for (int j = 0; j < 4; ++j) s_ += (v[q][j][0] * v[q][j][0] + v[q][j][1] * v[q][j][1]) + (v[q][j][2] * v[q][j][2] + v[q][j][3] * v[q][j][3]);
                    ss[q] = wave_sum(s_); }
#pragma unroll
                for (int q = 0; q < 2; ++q) { const int r_ = row + q; if (r_ >= rend) break;
                    const int bt = r_ < ML ? (r_ >> 11) : NB;
                    if (bt != cur_b) { cur_b = bt; const float* scp = MOD + (size_t)bt * MODW + D;
#pragma unroll
                        for (int j = 0; j < 4; ++j) { const int k = 4 * LN_ + 256 * j; gm[j] = *(const f32x4*)(g1 + k) * (*(const f32x4*)(scp + k) + 1.0f); } }
                    if (LN_ < 32) RSSA[(size_t)r_ * 32 + LN_] = (LN_ == 0) ? ss[q] : 0.f;
#pragma unroll
                    for (int j = 0; j < 4; ++j) { const int k = 4 * LN_ + 256 * j; const f32x4 a = v[q][j] * gm[j];
                        v2u o; o.x = pk2(a[0], a[1]); o.y = pk2(a[2], a[3]); *(v2u*)(XA + (size_t)r_ * D + k) = o; } }
            }
        }
    };
    bool rows_done = false;
    for (int it = F.vcu; it < 2 * 104; it += F.G) {
        const int l = it / 104, j = it % 104; const bool first = j < 40;
        const int shoff = first ? 0 : 3 * D;
        __syncthreads();
        {
            const float* mrow = MOD + (size_t)l * 17 * MODW + shoff;
#pragma unroll 1
            for (int r0 = 0; r0 < 16; r0 += 8) { float tv[16];
#pragma unroll
                for (int j = 0; j < 16; ++j) tv[j] = mrow[(size_t)(r0 + (j >> 1)) * MODW + F.tid + 512 * (j & 1)];
#pragma unroll
                for (int j = 0; j < 16; ++j) tab[(r0 + (j >> 1)) * 1024 + F.tid + 512 * (j & 1)] = tv[j]; }
            { const float a = mrow[(size_t)16 * MODW + F.tid], b = mrow[(size_t)16 * MODW + F.tid + 512]; tab[16 * 1024 + F.tid] = a; tab[16 * 1024 + F.tid + 512] = b; }
        }
        __syncthreads();
        const int ldw = first ? IND : FF, n0 = (first ? j : j - 40) * 64;
        const float* W = first ? INP(8) + (size_t)l * D * IND : INP(22) + (size_t)l * D * FF;
        float* outp = first ? WSP(float, WS_SHW1) + (size_t)l * 17 * IND : WSP(float, WS_SHW2) + (size_t)l * 17 * FF;
        const int n0out = first ? glu_col(j * 64) : (j - 40) * 64;
        const bool split = !rows_done;
        float acc[17];
#pragma unroll
        for (int r = 0; r < 17; ++r) acc[r] = 0.f;
        if (split && F.wave < 4) {
            if (F.G == 256) stream_rows((F.vcu * 4 + F.wave) * 30, 30); else stream_rows((F.vcu * 4 + F.wave) * (2 * rpw), 2 * rpw); }
        else {
            const int kcnt = split ? 256 : 128, k0 = split ? (F.wave - 4) * 256 : F.wave * 128;
            const float* wp = W + (size_t)k0 * ldw + n0 + LN_;
#pragma unroll 1
            for (int kk = 0; kk < kcnt; kk += 32) {
                float wv[32];
#pragma unroll
                for (int k = 0; k < 32; ++k) wv[k] = __builtin_nontemporal_load(wp + (size_t)(kk + k) * ldw);
#pragma unroll
                for (int k = 0; k < 32; ++k) {
#pragma unroll
                    for (int r = 0; r < 17; ++r) acc[r] += tab[r * 1024 + k0 + kk + k] * wv[k];
                }
            }
        }
        rows_done = true;
#pragma unroll
        for (int r = 0; r < 17; ++r) red[(F.wave * 17 + r) * 64 + LN_] = acc[r];
        __syncthreads();
        for (int i = F.tid; i < 17 * 64; i += NWAVES * 64) {
            const int r = i >> 6, n = i & 63; float s_ = 0.f;
#pragma unroll
            for (int w = 0; w < 8; ++w) s_ += red[(w * 17 + r) * 64 + n];
            outp[(size_t)r * ldw + n0out + n] = s_;
        }
        __syncthreads();
    }
    if (!rows_done) { if (F.G == 256) stream_rows(208 * 4 * 30 + ((F.vcu - 208) * NWAVES + F.wave) * 31, 31); else stream_rows((F.vcu * NWAVES + F.wave) * rpw, rpw); }
    __syncthreads();
    {
        bf16* WLR = WSP(bf16, WS_WLR);
        for (int i = F.gw * 64 + LN_; i < 2 * 2 * 4 * 2 * 4096; i += F.NGW * 64) { const int d = i & 63, e = (i >> 6) & 63, gt = (i >> 12) & 1, blk = i >> 13;
            const float* src = gt == 0 ? INP(17) : INP(19); WLR[i] = (bf16)f2bf(src[((size_t)blk * 64 + d) * 64 + e]); }
    }
    if (F.G != 256) weight_items(F, 0, W_ITEMS, F.gw, F.NGW);
}

constexpr int CV_OSROW = 260;
__device__ __forceinline__ void conv_phase(Frame& F, int l, int ntiles) {
    const bf16* PROJ = WSP(const bf16, WS_PROJ); bf16* MIX = WSP(bf16, WS_MIX);
    LAS float* us = (LAS float*)(F.lds);
    LAS float* os = (LAS float*)(F.lds + 62 * 256 * 4);
    const int c = F.tid & 255, half = F.tid >> 8;
    float w[31];
#pragma unroll
    for (int k = 0; k < 31; ++k) w[k] = INP(10)[((size_t)l * 31 + k) * 256 + c];
    const float cbias = INP(11)[l * 256 + c];
    const int lt = F.tid >> 4, lseg = F.tid & 15;
    f32x4 lg[4], lb[4];
#pragma unroll
    for (int q = 0; q < 4; ++q) { lg[q] = *(const f32x4*)(INP(12) + l * 256 + 16 * lseg + 4 * q); lb[q] = *(const f32x4*)(INP(13) + l * 256 + 16 * lseg + 4 * q); }
    auto row16_sum = [](float v) -> float {
        v += __builtin_bit_cast(float, __builtin_amdgcn_update_dpp(0, __builtin_bit_cast(int, v), 0xB1, 0xf, 0xf, true));
        v += __builtin_bit_cast(float, __builtin_amdgcn_update_dpp(0, __builtin_bit_cast(int, v), 0x4E, 0xf, 0xf, true));
        v += __builtin_bit_cast(float, __builtin_amdgcn_update_dpp(0, __builtin_bit_cast(int, v), 0x141, 0xf, 0xf, true));
        v += __builtin_bit_cast(float, __builtin_amdgcn_update_dpp(0, __builtin_bit_cast(int, v), 0x140, 0xf, 0xf, true));
        return v; };
    unsigned pv[16];
    auto load_tile = [&](int T) {
        const int row0 = T * 32;
        int lo, hi; if (row0 < ML) { lo = row0 & ~(SEQ - 1); hi = lo + SEQ; } else { lo = row0 & ~(CTXL - 1); hi = lo + CTXL; }
#pragma unroll
        for (int j = 0; j < 16; ++j) { const int i = F.tid + 512 * j, rr = i >> 7, cp = i & 127, row = row0 - 15 + rr;
            const bool ok = (j < 15 || F.tid < 256) && row >= lo && row < hi;
            pv[j] = ok ? *(const unsigned*)(PROJ + (size_t)row * IND + 2 * cp) : 0u; }
    };
    const int T0 = F.G - 1 - F.vcu;
    if (T0 < ntiles) load_tile(T0);
    for (int T = T0; T < ntiles; T += F.G) {
        const int row0 = T * 32;
        __syncthreads();
#pragma unroll
        for (int j = 0; j < 16; ++j) { const int i = F.tid + 512 * j;
            if (j < 15 || F.tid < 256) { f32x2 u; u[0] = bflo(pv[j]); u[1] = bfhi(pv[j]); *(LAS f32x2*)(us + 2 * i) = u; } }
        if (T + F.G < ntiles) load_tile(T + F.G);
        __syncthreads();
        {
            float acc[16];
#pragma unroll
            for (int j = 0; j < 16; ++j) acc[j] = cbias;
            const LAS float* up = us + (16 * half) * 256 + c;
#pragma unroll
            for (int i = 0; i < 46; ++i) { const float x = up[i * 256];
#pragma unroll
                for (int j = 0; j < 16; ++j) if (i - j >= 0 && i - j <= 30) acc[j] += w[i - j] * x; }
#pragma unroll
            for (int j = 0; j < 16; ++j) os[(16 * half + j) * CV_OSROW + c] = acc[j];
        }
        __syncthreads();
        {
            f32x4 v[4];
#pragma unroll
            for (int q = 0; q < 4; ++q) v[q] = *(const LAS f32x4*)(os + lt * CV_OSROW + 16 * lseg + 4 * q);
            float s1 = 0.f;
#pragma unroll
            for (int q = 0; q < 4; ++q) s1 += (v[q][0] + v[q][1]) + (v[q][2] + v[q][3]);
            const float mu = row16_sum(s1) * (1.f / 256.f);
            float s2 = 0.f;
#pragma unroll
            for (int q = 0; q < 4; ++q) { v[q] = v[q] - mu; s2 += (v[q][0] * v[q][0] + v[q][1] * v[q][1]) + (v[q][2] * v[q][2] + v[q][3] * v[q][3]); }
            const float rstd = rsqrtf(row16_sum(s2) * (1.f / 256.f) + EPS);
            unsigned ow[8];
#pragma unroll
            for (int q = 0; q < 4; ++q) { const f32x4 y = v[q] * rstd * lg[q] + lb[q];
                ow[2 * q] = pg8::cvt_pk_bf16(siluf_(y[0]), siluf_(y[1])); ow[2 * q + 1] = pg8::cvt_pk_bf16(siluf_(y[2]), siluf_(y[3])); }
            bf16* op = MIX + (size_t)(row0 + lt) * D + 16 * lseg;
            *(v4u*)op = (v4u){ow[0], ow[1], ow[2], ow[3]}; *(v4u*)(op + 8) = (v4u){ow[4], ow[5], ow[6], ow[7]};
        }
    }
}

typedef short s16x8 __attribute__((ext_vector_type(8)));
typedef short s16x4 __attribute__((ext_vector_type(4)));
constexpr int NA_KROW = 144, NA_VROW = 160;
constexpr int NA_STAGE = 64 * NA_KROW + 64 * NA_VROW, NA_SLOT = 2 * NA_STAGE, NA_OFF_TB = 2 * NA_SLOT;
static_assert(NA_OFF_TB + 2560 <= RING_BYTES, "NA LDS map");
constexpr int NA_ITEMS_LAT = NB * NH * 8, NA_ITEMS_CTX = NB * NH * 2;
struct NaBlk { f32x4 O[4]; f32x4 nm4; float m, lsum; int first; };
__device__ __forceinline__ int na_rs(int r) { int v = r - 4; return v < 0 ? 0 : (v > 24 ? 24 : v); }
__device__ __forceinline__ s16x8 na_scale_q(v4u w, float c) {
    v4u o; o.x = pg8::cvt_pk_bf16(bflo(w.x) * c, bfhi(w.x) * c); o.y = pg8::cvt_pk_bf16(bflo(w.y) * c, bfhi(w.y) * c); o.z = pg8::cvt_pk_bf16(bflo(w.z) * c, bfhi(w.z) * c); o.w = pg8::cvt_pk_bf16(bflo(w.w) * c, bfhi(w.w) * c);
    return __builtin_bit_cast(s16x8, o);
}
__device__ __forceinline__ void na_phase(Frame& F, int l, int nitems, int nav = 0) {
    int LN_ = F.tid & 63; asm volatile("" : "+v"(LN_));
    const bf16* PROJ = WSP(const bf16, WS_PROJ); bf16* MIX = WSP(bf16, WS_MIX);
    LAS float* tb = (LAS float*)(F.lds + NA_OFF_TB);
    const int lane = LN_, q16 = lane & 15, g = lane >> 4;
    const unsigned skey = (unsigned)(F.tid >> 3), spart = (unsigned)(F.tid & 7);
    const float c1 = 0.125f * 1.4426950408889634f;
    struct NaItem { int b, h, ra, qrow0, rsI, nloc, nch, npair, isctx; };
    auto decode = [&](int it, NaItem& I) {
        I.isctx = it >= NA_ITEMS_LAT ? 1 : 0; I.ra = 0; I.rsI = 0; I.nloc = 0;
        if (!I.isctx) { const int r4 = (it + 2 * (it / F.G)) & 7; I.h = (it >> 3) & 7; I.b = it >> 6; const int r0 = 4 * r4; I.ra = r0 + 2 * (F.wave >> 2); I.qrow0 = I.b * SEQ + I.ra * 64 + (F.wave & 3) * 16;
            I.rsI = na_rs(r0); I.nloc = na_rs(r0 + 3) + 8 - I.rsI; }
        else { const int j = it - NA_ITEMS_LAT; const int hf = j & 1; I.h = (j >> 1) & 7; I.b = j >> 4; I.qrow0 = ML + I.b * CTXL + hf * 128 + F.wave * 16; }
        I.nch = I.nloc + 4; I.npair = (I.nch + 1) >> 1;
    };
    auto krow_of = [&](const NaItem& I, int ch) -> int { if (ch > I.nch - 1) ch = I.nch - 1; return ch < I.nloc ? I.b * SEQ + (I.rsI + ch) * 64 : ML + I.b * CTXL + (ch - I.nloc) * 64; };
    const int jq = F.wave & 3;
    const int o0 = jq == 0 ? 0 : 16 * jq - 8, o1 = jq == 0 ? 16 : (jq == 3 ? 48 : 16 * jq + 8);
    float madd[2][4]; int lb[2];
    {
        const int qc = jq * 16 + q16; int cs = qc - 8; cs = cs < 0 ? 0 : (cs > 48 ? 48 : cs);
#pragma unroll
        for (int e = 0; e < 4; ++e) { const int k0 = o0 + 4 * g + e, k1 = o1 + 4 * g + e;
            madd[0][e] = ((unsigned)(k0 - cs) < 16u) ? 0.f : -1.0e30f;
            madd[1][e] = (((unsigned)(k1 - cs) < 16u) && !(jq == 3 && k1 < 56)) ? 0.f : -1.0e30f; }
        lb[0] = 64 + o0 + 4 * g - qc + 15; lb[1] = 64 + o1 + 4 * g - qc + 15;
    }
    v4u kr0, vr0, kr1, vr1, qrA[2], qrB[2];
    auto issue_first = [&](const NaItem& I) {
        const bf16* Pk = PROJ + 1024 + I.h * HD + 8 * spart, * Pv = PROJ + 1536 + I.h * HD + 8 * spart, * Pq = PROJ + 512 + I.h * HD;
        kr0 = *(const v4u*)(Pk + (size_t)(krow_of(I, 0) + (int)skey) * IND); vr0 = *(const v4u*)(Pv + (size_t)(krow_of(I, 0) + (int)skey) * IND);
        kr1 = *(const v4u*)(Pk + (size_t)(krow_of(I, 1) + (int)skey) * IND); vr1 = *(const v4u*)(Pv + (size_t)(krow_of(I, 1) + (int)skey) * IND);
#pragma unroll
        for (int s_ = 0; s_ < 2; ++s_) { qrA[s_] = *(const v4u*)(Pq + (size_t)(I.qrow0 + q16) * IND + 32 * s_ + 8 * g);
            qrB[s_] = I.isctx ? qrA[s_] : *(const v4u*)(Pq + (size_t)(I.qrow0 + 64 + q16) * IND + 32 * s_ + 8 * g); }
    };
    NaItem I; int it = F.vcu; bool have = it < nitems; int tb_h = -1;
    if (have) { decode(it, I); issue_first(I); }
    while (have) {
        const bool isctx = I.isctx != 0;
        const int ra = I.ra, rsI = I.rsI, nloc = I.nloc, nch = I.nch, npair = I.npair, qrow0 = I.qrow0, h = I.h;
        const bf16* Pk = PROJ + 1024 + h * HD + 8 * spart, * Pv = PROJ + 1536 + h * HD + 8 * spart;
        s16x8 qfA[2], qfB[2];
#pragma unroll
        for (int s_ = 0; s_ < 2; ++s_) { qfA[s_] = na_scale_q(qrA[s_], c1); qfB[s_] = na_scale_q(qrB[s_], c1); }
        const int rsA = na_rs(ra), rsB = na_rs(ra + 1);
        NaItem N; const int itn = it + F.G; const bool haven = itn < nitems; if (haven) decode(itn, N); else N = I;
        __syncthreads();
        if (!isctx && h != tb_h) { const float* rpb = INP(14) + ((size_t)l * NH + h) * 15 * 31; tb_h = h;
            for (int i = F.tid; i < 640; i += NWAVES * 64) tb[i] = (i >= 64 && i < 64 + 465) ? rpb[i - 64] * 1.4426950408889634f : 0.f; }
        {
            LAS unsigned char* s0 = F.lds;
            *(LAS v4u*)(s0 + skey * NA_KROW + spart * 16) = kr0; *(LAS v4u*)(s0 + 64 * NA_KROW + skey * NA_VROW + spart * 16) = vr0;
            *(LAS v4u*)(s0 + NA_STAGE + skey * NA_KROW + spart * 16) = kr1; *(LAS v4u*)(s0 + NA_STAGE + 64 * NA_KROW + skey * NA_VROW + spart * 16) = vr1;
        }
        if (npair > 2) {
            kr0 = *(const v4u*)(Pk + (size_t)(krow_of(I, 2) + (int)skey) * IND); vr0 = *(const v4u*)(Pv + (size_t)(krow_of(I, 2) + (int)skey) * IND);
            kr1 = *(const v4u*)(Pk + (size_t)(krow_of(I, 3) + (int)skey) * IND); vr1 = *(const v4u*)(Pv + (size_t)(krow_of(I, 3) + (int)skey) * IND);
        } else {
            kr0 = *(const v4u*)(Pk + (size_t)(krow_of(I, 2) + (int)skey) * IND); vr0 = *(const v4u*)(Pv + (size_t)(krow_of(I, 2) + (int)skey) * IND);
            kr1 = *(const v4u*)(Pk + (size_t)(krow_of(I, 3) + (int)skey) * IND); vr1 = *(const v4u*)(Pv + (size_t)(krow_of(I, 3) + (int)skey) * IND);
        }
        NaBlk A, B;
#pragma unroll
        for (int dt = 0; dt < 4; ++dt) { A.O[dt] = (f32x4){0.f, 0.f, 0.f, 0.f}; B.O[dt] = (f32x4){0.f, 0.f, 0.f, 0.f}; }
        A.m = 0.f; A.lsum = 0.f; A.first = 1; B.m = 0.f; B.lsum = 0.f; B.first = 1; A.nm4 = (f32x4){0.f, 0.f, 0.f, 0.f}; B.nm4 = (f32x4){0.f, 0.f, 0.f, 0.f};
        for (int cp = 0; cp < npair; ++cp) {
            __syncthreads();
            if (cp + 1 < npair) { LAS unsigned char* nx = F.lds + ((cp + 1) & 1) * NA_SLOT;
                *(LAS v4u*)(nx + skey * NA_KROW + spart * 16) = kr0; *(LAS v4u*)(nx + 64 * NA_KROW + skey * NA_VROW + spart * 16) = vr0;
                *(LAS v4u*)(nx + NA_STAGE + skey * NA_KROW + spart * 16) = kr1; *(LAS v4u*)(nx + NA_STAGE + 64 * NA_KROW + skey * NA_VROW + spart * 16) = vr1; }
            if (cp + 2 < npair) { const int k2 = krow_of(I, 2 * cp + 4) + (int)skey, k3 = krow_of(I, 2 * cp + 5) + (int)skey;
                kr0 = *(const v4u*)(Pk + (size_t)k2 * IND); vr0 = *(const v4u*)(Pv + (size_t)k2 * IND); kr1 = *(const v4u*)(Pk + (size_t)k3 * IND); vr1 = *(const v4u*)(Pv + (size_t)k3 * IND); }
            else if (cp + 2 == npair && haven) issue_first(N);
          for (int sub = 0; sub < 2; ++sub) {
            const int ch = 2 * cp + sub;
            if (ch >= nch) break;
            LAS unsigned char* cur = F.lds + (cp & 1) * NA_SLOT + sub * NA_STAGE;
            const bool local = ch < nloc;
            const int kr = rsI + ch;
            const bool actA = !local || (kr >= rsA && kr <= rsA + 7), actB = !isctx && (!local || (kr >= rsB && kr <= rsB + 7));
            if ((!actA && !actB) || nav == 1) continue;
            auto fix = [&](f32x4* S, int nt_, NaBlk& X, float cm) __attribute__((always_inline)) {
                cm = fmaxf(cm, __shfl_xor(cm, 16)); cm = fmaxf(cm, __shfl_xor(cm, 32));
                const float d = X.first ? cm : fmaxf(cm, 0.f);
                if (!X.first) { const float alpha = __builtin_amdgcn_exp2f(-d); X.lsum *= alpha;
#pragma unroll
                    for (int dt = 0; dt < 4; ++dt)
#pragma unroll
                        for (int e = 0; e < 4; ++e) { float o_ = X.O[dt][e]; asm("v_mul_f32 %0, %0, %1" : "+v"(o_) : "v"(alpha)); X.O[dt][e] = o_; } }
                X.m += d; X.first = 0;
#pragma unroll
                for (int e = 0; e < 4; ++e) { float n_ = X.nm4[e]; asm("v_sub_f32 %0, %0, %1" : "+v"(n_) : "v"(d)); X.nm4[e] = n_; }
#pragma unroll
                for (int t = 0; t < 4; ++t) if (t < nt_) S[t] = S[t] - d;
            };
            auto probs = [&](f32x4* S, int nt_, NaBlk& X, unsigned (*pk)[2]) __attribute__((always_inline)) {
                float ps = 0.f;
#pragma unroll
                for (int t = 0; t < 4; ++t) if (t < nt_) {
                    const float p0 = __builtin_amdgcn_exp2f(S[t][0]), p1 = __builtin_amdgcn_exp2f(S[t][1]), p2 = __builtin_amdgcn_exp2f(S[t][2]), p3 = __builtin_amdgcn_exp2f(S[t][3]);
                    ps += (p0 + p1) + (p2 + p3);
                    pk[t][0] = pg8::cvt_pk_bf16(p0, p1); pk[t][1] = pg8::cvt_pk_bf16(p2, p3); }
                X.lsum += ps;
            };
            auto finish = [&](f32x4* S, int nt_, NaBlk& X, unsigned (*pk)[2], float cm) __attribute__((always_inline)) {
                if (__builtin_expect(X.first || !__all(cm <= 8.f), 0)) fix(S, nt_, X, cm);
                probs(S, nt_, X, pk);
            };
            auto finish2 = [&](f32x4* SA, f32x4* SB, int nt_, unsigned (*pa)[2], unsigned (*pb)[2], float cmA, float cmB) __attribute__((always_inline)) {
                if (__builtin_expect(A.first || B.first || !__all(fmaxf(cmA, cmB) <= 8.f), 0)) {
                    if (A.first || !__all(cmA <= 8.f)) fix(SA, nt_, A, cmA);
                    if (B.first || !__all(cmB <= 8.f)) fix(SB, nt_, B, cmB);
                }
                probs(SA, nt_, A, pa); probs(SB, nt_, B, pb);
            };
            auto bias_local = [&](f32x4 (&S)[2], int rq) __attribute__((always_inline)) -> float {
                float cm = -1.0e30f;
#pragma unroll
                for (int t = 0; t < 2; ++t) { const LAS float* tr_ = tb + (kr - rq + 7) * 31 + lb[t];
#pragma unroll
                    for (int e = 0; e < 4; ++e) { const float v = (S[t][e] + tr_[e]) + madd[t][e]; S[t][e] = v; cm = fmaxf(cm, v); } }
                return cm;
            };
            auto max_ctx = [&](f32x4 (&S)[4]) __attribute__((always_inline)) -> float {
                float cm = -1.0e30f;
#pragma unroll
                for (int t = 0; t < 4; ++t)
#pragma unroll
                    for (int e = 0; e < 4; ++e) cm = fmaxf(cm, S[t][e]);
                return cm;
            };
            const LAS unsigned char* kb_ = cur + q16 * NA_KROW + 16 * g;
            const LAS unsigned char* vtr = cur + 64 * NA_KROW + (4 * g + (q16 >> 2)) * NA_VROW + (q16 & 3) * 8;
            auto local_both = [&]() __attribute__((always_inline)) {
                unsigned pkA[4][2], pkB[4][2];
                f32x4 SA[2], SB[2];
                s16x8 kf[2][2];
#pragma unroll
                for (int t = 0; t < 2; ++t) { const int o = t == 0 ? o0 : o1;
#pragma unroll
                    for (int s_ = 0; s_ < 2; ++s_) kf[t][s_] = *(const LAS s16x8*)(kb_ + o * NA_KROW + 64 * s_); }
#pragma unroll
                for (int t = 0; t < 2; ++t) { SA[t] = __builtin_amdgcn_mfma_f32_16x16x32_bf16(kf[t][0], qfA[0], A.nm4, 0, 0, 0); SB[t] = __builtin_amdgcn_mfma_f32_16x16x32_bf16(kf[t][0], qfB[0], B.nm4, 0, 0, 0); }
#pragma unroll
                for (int t = 0; t < 2; ++t) { SA[t] = __builtin_amdgcn_mfma_f32_16x16x32_bf16(kf[t][1], qfA[1], SA[t], 0, 0, 0); SB[t] = __builtin_amdgcn_mfma_f32_16x16x32_bf16(kf[t][1], qfB[1], SB[t], 0, 0, 0); }
                if (nav == 2) { asm volatile("" :: "v"(SA[0]), "v"(SA[1]), "v"(SB[0]), "v"(SB[1])); return; }
                const float cmA = bias_local(SA, ra), cmB = bias_local(SB, ra + 1);
                finish2(SA, SB, 2, pkA, pkB, cmA, cmB);
                if (nav == 3) { asm volatile("" :: "v"(pkA[0][0]), "v"(pkA[1][1]), "v"(pkB[0][0]), "v"(pkB[1][1])); return; }
                const v4u bwA = {pkA[0][0], pkA[0][1], pkA[1][0], pkA[1][1]}, bwB = {pkB[0][0], pkB[0][1], pkB[1][0], pkB[1][1]};
                const s16x8 bfA = __builtin_bit_cast(s16x8, bwA), bfB = __builtin_bit_cast(s16x8, bwB);
#pragma unroll
                for (int dt = 0; dt < 4; ++dt) {
                    const s16x4 a0 = __builtin_amdgcn_ds_read_tr16_b64_v4i16((LAS s16x4*)(vtr + o0 * NA_VROW + dt * 32));
                    const s16x4 a1 = __builtin_amdgcn_ds_read_tr16_b64_v4i16((LAS s16x4*)(vtr + o1 * NA_VROW + dt * 32));
                    const s16x8 afrag = __builtin_shufflevector(a0, a1, 0, 1, 2, 3, 4, 5, 6, 7);
                    A.O[dt] = __builtin_amdgcn_mfma_f32_16x16x32_bf16(afrag, bfA, A.O[dt], 0, 0, 0);
                    B.O[dt] = __builtin_amdgcn_mfma_f32_16x16x32_bf16(afrag, bfB, B.O[dt], 0, 0, 0);
                }
            };
            auto local_one = [&](NaBlk& X, const s16x8 (&qf)[2], int rq) __attribute__((always_inline)) {
                unsigned pk[4][2];
                f32x4 S[2];
#pragma unroll
                for (int t = 0; t < 2; ++t) { S[t] = X.nm4;
                    const int o = t == 0 ? o0 : o1;
#pragma unroll
                    for (int s_ = 0; s_ < 2; ++s_) { const s16x8 kf = *(const LAS s16x8*)(kb_ + o * NA_KROW + 64 * s_);
                        S[t] = __builtin_amdgcn_mfma_f32_16x16x32_bf16(kf, qf[s_], S[t], 0, 0, 0); } }
                if (nav == 2) { asm volatile("" :: "v"(S[0]), "v"(S[1])); return; }
                const float cm = bias_local(S, rq);
                finish(S, 2, X, pk, cm);
                if (nav == 3) { asm volatile("" :: "v"(pk[0][0]), "v"(pk[1][1])); return; }
                const v4u bw = {pk[0][0], pk[0][1], pk[1][0], pk[1][1]};
                const s16x8 bf = __builtin_bit_cast(s16x8, bw);
#pragma unroll
                for (int dt = 0; dt < 4; ++dt) {
                    const s16x4 a0 = __builtin_amdgcn_ds_read_tr16_b64_v4i16((LAS s16x4*)(vtr + o0 * NA_VROW + dt * 32));
                    const s16x4 a1 = __builtin_amdgcn_ds_read_tr16_b64_v4i16((LAS s16x4*)(vtr + o1 * NA_VROW + dt * 32));
                    const s16x8 afrag = __builtin_shufflevector(a0, a1, 0, 1, 2, 3, 4, 5, 6, 7);
                    X.O[dt] = __builtin_amdgcn_mfma_f32_16x16x32_bf16(afrag, bf, X.O[dt], 0, 0, 0);
                }
            };
            auto ctx_both = [&]() __attribute__((always_inline)) {
                unsigned pkA[4][2], pkB[4][2];
                f32x4 SA[4], SB[4];
                { s16x8 kf[4][2];
#pragma unroll
                  for (int t = 0; t < 4; ++t)
#pragma unroll
                      for (int s_ = 0; s_ < 2; ++s_) kf[t][s_] = *(const LAS s16x8*)(kb_ + t * 16 * NA_KROW + 64 * s_);
#pragma unroll
                  for (int t = 0; t < 4; ++t) { SA[t] = __builtin_amdgcn_mfma_f32_16x16x32_bf16(kf[t][0], qfA[0], A.nm4, 0, 0, 0); SB[t] = __builtin_amdgcn_mfma_f32_16x16x32_bf16(kf[t][0], qfB[0], B.nm4, 0, 0, 0); }
#pragma unroll
                  for (int t = 0; t < 4; ++t) { SA[t] = __builtin_amdgcn_mfma_f32_16x16x32_bf16(kf[t][1], qfA[1], SA[t], 0, 0, 0); SB[t] = __builtin_amdgcn_mfma_f32_16x16x32_bf16(kf[t][1], qfB[1], SB[t], 0, 0, 0); } }
                if (nav == 2) { asm volatile("" :: "v"(SA[0]), "v"(SA[1]), "v"(SA[2]), "v"(SA[3]), "v"(SB[0]), "v"(SB[1]), "v"(SB[2]), "v"(SB[3])); return; }
                const float cmA = max_ctx(SA), cmB = max_ctx(SB);
                finish2(SA, SB, 4, pkA, pkB, cmA, cmB);
                if (nav == 3) { asm volatile("" :: "v"(pkA[0][0]), "v"(pkA[1][1]), "v"(pkA[2][0]), "v"(pkA[3][1]), "v"(pkB[0][0]), "v"(pkB[1][1]), "v"(pkB[2][0]), "v"(pkB[3][1])); return; }
#pragma unroll
                for (int p = 0; p < 2; ++p) {
                    const v4u bwA = {pkA[2 * p][0], pkA[2 * p][1], pkA[2 * p + 1][0], pkA[2 * p + 1][1]}, bwB = {pkB[2 * p][0], pkB[2 * p][1], pkB[2 * p + 1][0], pkB[2 * p + 1][1]};
                    const s16x8 bfA = __builtin_bit_cast(s16x8, bwA), bfB = __builtin_bit_cast(s16x8, bwB);
#pragma unroll
                    for (int dt = 0; dt < 4; ++dt) {
                        const s16x4 a0 = __builtin_amdgcn_ds_read_tr16_b64_v4i16((LAS s16x4*)(vtr + (2 * p) * 16 * NA_VROW + dt * 32));
                        const s16x4 a1 = __builtin_amdgcn_ds_read_tr16_b64_v4i16((LAS s16x4*)(vtr + (2 * p + 1) * 16 * NA_VROW + dt * 32));
                        const s16x8 afrag = __builtin_shufflevector(a0, a1, 0, 1, 2, 3, 4, 5, 6, 7);
                        A.O[dt] = __builtin_amdgcn_mfma_f32_16x16x32_bf16(afrag, bfA, A.O[dt], 0, 0, 0);
                        B.O[dt] = __builtin_amdgcn_mfma_f32_16x16x32_bf16(afrag, bfB, B.O[dt], 0, 0, 0);
                    }
                }
            };
            auto ctx_one = [&]() __attribute__((always_inline)) {
                unsigned pk[4][2];
                f32x4 S[4];
#pragma unroll
                for (int t = 0; t < 4; ++t) { S[t] = A.nm4;
#pragma unroll
                    for (int s_ = 0; s_ < 2; ++s_) { const s16x8 kf = *(const LAS s16x8*)(kb_ + t * 16 * NA_KROW + 64 * s_);
                        S[t] = __builtin_amdgcn_mfma_f32_16x16x32_bf16(kf, qfA[s_], S[t], 0, 0, 0); } }
                if (nav == 2) { asm volatile("" :: "v"(S[0]), "v"(S[1]), "v"(S[2]), "v"(S[3])); return; }
                const float cm = max_ctx(S);
                finish(S, 4, A, pk, cm);
                if (nav == 3) { asm volatile("" :: "v"(pk[0][0]), "v"(pk[1][1]), "v"(pk[2][0]), "v"(pk[3][1])); return; }
#pragma unroll
                for (int p = 0; p < 2; ++p) {
                    const v4u bw = {pk[2 * p][0], pk[2 * p][1], pk[2 * p + 1][0], pk[2 * p + 1][1]};
                    const s16x8 bf = __builtin_bit_cast(s16x8, bw);
#pragma unroll
                    for (int dt = 0; dt < 4; ++dt) {
                        const s16x4 a0 = __builtin_amdgcn_ds_read_tr16_b64_v4i16((LAS s16x4*)(vtr + (2 * p) * 16 * NA_VROW + dt * 32));
                        const s16x4 a1 = __builtin_amdgcn_ds_read_tr16_b64_v4i16((LAS s16x4*)(vtr + (2 * p + 1) * 16 * NA_VROW + dt * 32));
                        const s16x8 afrag = __builtin_shufflevector(a0, a1, 0, 1, 2, 3, 4, 5, 6, 7);
                        A.O[dt] = __builtin_amdgcn_mfma_f32_16x16x32_bf16(afrag, bf, A.O[dt], 0, 0, 0);
                    }
                }
            };
            if (local) { if (actA && actB) local_both(); else if (actA) local_one(A, qfA, ra); else local_one(B, qfB, ra + 1); }
            else { if (actB) ctx_both(); else ctx_one(); }
          }
        }
        {
            float ls = A.lsum; ls += __shfl_xor(ls, 16); ls += __shfl_xor(ls, 32);
            const float inv = __builtin_amdgcn_rcpf(ls);
            unsigned ooff = (unsigned)((q16 * D + 4 * g) * 2); asm volatile("" : "+v"(ooff));
            unsigned char* op = (unsigned char*)(MIX + (size_t)qrow0 * D + 256 + h * HD);
#pragma unroll
            for (int dt = 0; dt < 4; ++dt) { v2u w; w.x = pg8::cvt_pk_bf16(A.O[dt][0] * inv, A.O[dt][1] * inv); w.y = pg8::cvt_pk_bf16(A.O[dt][2] * inv, A.O[dt][3] * inv); *(v2u*)(op + (ooff + (unsigned)(32 * dt))) = w; }
        }
        if (!isctx) {
            float ls = B.lsum; ls += __shfl_xor(ls, 16); ls += __shfl_xor(ls, 32);
            const float inv = __builtin_amdgcn_rcpf(ls);
            unsigned ooff = (unsigned)((q16 * D + 4 * g) * 2); asm volatile("" : "+v"(ooff));
            unsigned char* op = (unsigned char*)(MIX + (size_t)(qrow0 + 64) * D + 256 + h * HD);
#pragma unroll
            for (int dt = 0; dt < 4; ++dt) { v2u w; w.x = pg8::cvt_pk_bf16(B.O[dt][0] * inv, B.O[dt][1] * inv); w.y = pg8::cvt_pk_bf16(B.O[dt][2] * inv, B.O[dt][3] * inv); *(v2u*)(op + (ooff + (unsigned)(32 * dt))) = w; }
        }
        it = itn; have = haven; I = N;
    }
}

constexpr int LRU_UCROW = 260;
constexpr int LRU_OFF_UC = 38 * 256 * 2, LRU_OFF_GT = LRU_OFF_UC + 2 * 32 * LRU_UCROW * 4;
static_assert(LRU_OFF_GT + 32 * 256 * 2 <= RING_BYTES, "LRU LDS map");
template <int PASS>
__device__ __forceinline__ void lru_phase(Frame& F, int l, int ntiles) {
    int LN_ = F.tid & 63; asm volatile("" : "+v"(LN_));
    const bf16* PROJ = WSP(const bf16, WS_PROJ);
    LAS bf16* rxs = (LAS bf16*)(F.lds);
    LAS float* ucf = (LAS float*)(F.lds + LRU_OFF_UC);
    LAS bf16* gts = (LAS bf16*)(F.lds + LRU_OFF_GT);
    const int lane = LN_, j16 = lane & 15, g = lane >> 4;
    const int kb = F.wave & 3, nh = F.wave >> 2;
    s16x8 wf[2][2][2][2];
    float cbx[2][2], cba[2][2], csp[2][2];
#pragma unroll
    for (int dir = 0; dir < 2; ++dir) {
        const int ld = l * 2 + dir;
        const bf16* WLR = WSP(const bf16, WS_WLR) + (size_t)((ld * 4 + kb) * 2) * 4096;
#pragma unroll
        for (int gt = 0; gt < 2; ++gt)
#pragma unroll
            for (int n2 = 0; n2 < 2; ++n2)
#pragma unroll
                for (int s_ = 0; s_ < 2; ++s_) wf[dir][gt][n2][s_] = *(const s16x8*)(WLR + gt * 4096 + (16 * (2 * nh + n2) + j16) * 64 + 32 * s_ + 8 * g);
#pragma unroll
        for (int n2 = 0; n2 < 2; ++n2) {
            const int e = kb * 64 + 16 * (2 * nh + n2) + j16, idx = ld * 256 + e;
            cbx[dir][n2] = INP(18)[idx]; cba[dir][n2] = INP(20)[idx];
            const float nl = -INP(21)[idx]; csp[dir][n2] = -8.f * (fmaxf(nl, 0.f) + log1pf(__expf(-fabsf(nl))));
        }
    }
    const int c = F.tid & 255, sdir = F.tid >> 8;
    const int sld = l * 2 + sdir;
    const float s1w0 = INP(15)[(sld * 4 + 0) * 256 + c], s1w1 = INP(15)[(sld * 4 + 1) * 256 + c], s1w2 = INP(15)[(sld * 4 + 2) * 256 + c], s1w3 = INP(15)[(sld * 4 + 3) * 256 + c], s1cb = INP(16)[sld * 256 + c];
    const int base = sdir == 0 ? 0 : 3;
    unsigned pre[10], pgw[8];
    auto load_tile = [&](int T) {
        const int row0 = T * 32;
        int lo, hi; if (row0 < ML) { lo = row0 & ~(SEQ - 1); hi = lo + SEQ; } else { lo = row0 & ~(CTXL - 1); hi = lo + CTXL; }
#pragma unroll
        for (int j = 0; j < 10; ++j) { const int i = F.tid + 512 * j, rr = i >> 7, cp = i & 127, row = row0 - 3 + rr;
            const bool ok = (j < 9 || F.tid < 256) && row >= lo && row < hi;
            pre[j] = ok ? *(const unsigned*)(PROJ + (size_t)row * IND + 2048 + 2 * cp) : 0u; }
        if (PASS == 1) {
#pragma unroll
            for (int j = 0; j < 8; ++j) { const int i = F.tid + 512 * j, t = i >> 7, cp = i & 127; pgw[j] = *(const unsigned*)(PROJ + (size_t)(row0 + t) * IND + 2304 + 2 * cp); }
        }
    };
    if (F.vcu < ntiles) load_tile(F.vcu);
    for (int T = F.vcu; T < ntiles; T += F.G) {
        const int row0 = T * 32;
        __syncthreads();
#pragma unroll
        for (int j = 0; j < 10; ++j) { const int i = F.tid + 512 * j; if (j < 9 || F.tid < 256) ((LAS unsigned*)rxs)[i] = pre[j]; }
        if (PASS == 1) {
#pragma unroll
            for (int j = 0; j < 8; ++j) ((LAS unsigned*)gts)[F.tid + 512 * j] = pgw[j];
        }
        if (T + F.G < ntiles) load_tile(T + F.G);
        float hst[2][2];
#pragma unroll
        for (int dir = 0; dir < 2; ++dir)
#pragma unroll
            for (int n2 = 0; n2 < 2; ++n2) hst[dir][n2] = PASS == 1 ? WSP(const float, WS_CARRY)[((size_t)dir * 1152 + T) * 256 + kb * 64 + 16 * (2 * nh + n2) + j16] : 0.f;
        __syncthreads();
        {
            float x0 = bf1(rxs[(base + 0) * 256 + c]), x1 = bf1(rxs[(base + 1) * 256 + c]), x2 = bf1(rxs[(base + 2) * 256 + c]);
#pragma unroll 8
            for (int t = 0; t < 32; ++t) {
                const float x3 = bf1(rxs[(t + base + 3) * 256 + c]);
                ucf[(sdir * 32 + t) * LRU_UCROW + c] = s1cb + s1w0 * x0 + s1w1 * x1 + s1w2 * x2 + s1w3 * x3;
                x0 = x1; x1 = x2; x2 = x3;
            }
        }
        __syncthreads();
        float hf[2][2][4];
        float Pt[2][2] = {{1.f, 1.f}, {1.f, 1.f}};
#pragma unroll
        for (int dir = 0; dir < 2; ++dir) {
            const bool sec16 = ((g & 1) != 0) != (dir != 0), sec32 = ((g >> 1) != 0) != (dir != 0);
#pragma unroll
            for (int step = 0; step < 2; ++step) {
                const int rt = dir == 0 ? step : 1 - step;
                s16x8 af[2];
#pragma unroll
                for (int s_ = 0; s_ < 2; ++s_) { const LAS float* up = ucf + (dir * 32 + 16 * rt + j16) * LRU_UCROW + kb * 64 + 32 * s_ + 8 * g;
                    const f32x4 u0 = *(const LAS f32x4*)up, u1 = *(const LAS f32x4*)(up + 4);
                    const v4u w = {pg8::cvt_pk_bf16(u0[0], u0[1]), pg8::cvt_pk_bf16(u0[2], u0[3]), pg8::cvt_pk_bf16(u1[0], u1[1]), pg8::cvt_pk_bf16(u1[2], u1[3])};
                    af[s_] = __builtin_bit_cast(s16x8, w); }
#pragma unroll
                for (int n2 = 0; n2 < 2; ++n2) {
                    f32x4 zx = {0.f, 0.f, 0.f, 0.f}, za = {0.f, 0.f, 0.f, 0.f};
#pragma unroll
                    for (int s_ = 0; s_ < 2; ++s_) { zx = __builtin_amdgcn_mfma_f32_16x16x32_bf16(af[s_], wf[dir][0][n2][s_], zx, 0, 0, 0); za = __builtin_amdgcn_mfma_f32_16x16x32_bf16(af[s_], wf[dir][1][n2][s_], za, 0, 0, 0); }
                    const int e = kb * 64 + 16 * (2 * nh + n2) + j16;
                    const LAS float* uo = ucf + (dir * 32 + 16 * rt + 4 * g) * LRU_UCROW + e;
                    float a_[4], b_[4]; unsigned abw[4];
#pragma unroll
                    for (int r = 0; r < 4; ++r) {
                        const float u = uo[r * LRU_UCROW];
                        const float gx = sigmoidf_(zx[r] + cbx[dir][n2]), ga = sigmoidf_(za[r] + cba[dir][n2]);
                        const float la = csp[dir][n2] * ga, a = __builtin_amdgcn_exp2f(1.4426950408889634f * la), y = 2.f * la;
                        const float om = y > -0.02f ? -y * (1.f + y * (0.5f + y * 0.16666667f)) : 1.f - a * a;
                        a_[r] = a; b_[r] = __builtin_amdgcn_sqrtf(om) * gx * u;
                        if (PASS == 0) {
                            const float oma = la > -0.02f ? -la * (1.f + la * (0.5f + la * 0.16666667f)) : 1.f - a;
                            abw[r] = pg8::cvt_pk_bf16(oma, b_[r]); a_[r] = 1.f - bflo(abw[r]); b_[r] = bfhi(abw[r]);
                        }
                    }
                    if (PASS == 0) WSP(v4u, WS_AB)[(((((size_t)T * 2 + dir) * 2 + rt) * 8 + F.wave) * 2 + n2) * 64 + lane] = (v4u){abw[0], abw[1], abw[2], abw[3]};
                    const float P = (a_[0] * a_[1]) * (a_[2] * a_[3]);
                    const float S = dir == 0 ? ((b_[0] * a_[1] + b_[1]) * a_[2] + b_[2]) * a_[3] + b_[3] : ((b_[3] * a_[2] + b_[2]) * a_[1] + b_[1]) * a_[0] + b_[0];
                    const float Pp = __shfl_xor(P, 16), Sp = __shfl_xor(S, 16);
                    const float e1P = sec16 ? Pp : 1.f, e1S = sec16 ? Sp : 0.f;
                    const float prP = P * Pp, prS = sec16 ? P * Sp + S : Pp * S + Sp;
                    const float Pq = __shfl_xor(prP, 32), Sq = __shfl_xor(prS, 32);
                    const float EP = sec32 ? Pq * e1P : e1P, ES = sec32 ? e1P * Sq + e1S : e1S;
                    const float TP = prP * Pq, TS = sec32 ? prP * Sq + prS : Pq * prS + Sq;
                    if (PASS == 1) {
                        float h = EP * hst[dir][n2] + ES;
                        if (dir == 0) {
#pragma unroll
                            for (int r = 0; r < 4; ++r) { h = a_[r] * h + b_[r]; hf[rt][n2][r] = h; }
                        } else {
                            float hb[4];
#pragma unroll
                            for (int r = 3; r >= 0; --r) { h = a_[r] * h + b_[r]; hb[r] = h; }
                            bf16* mp = WSP(bf16, WS_MIX) + (size_t)(row0 + 16 * rt + 4 * g) * D + 768 + e;
                            const LAS bf16* gp = gts + (16 * rt + 4 * g) * 256 + e;
#pragma unroll
                            for (int r = 0; r < 4; ++r) mp[(size_t)r * D] = (bf16)f2bf(gelu_tanh(bf1(gp[r * 256])) * (hf[rt][n2][r] + hb[r]));
                        }
                    } else Pt[dir][n2] *= TP;
                    hst[dir][n2] = TP * hst[dir][n2] + TS;
                }
            }
        }
        if (PASS == 0 && g == 0) {
#pragma unroll
            for (int dir = 0; dir < 2; ++dir)
#pragma unroll
                for (int n2 = 0; n2 < 2; ++n2) WSP(f32x2, WS_TOT)[((size_t)dir * 1152 + T) * 256 + kb * 64 + 16 * (2 * nh + n2) + j16] = (f32x2){Pt[dir][n2], hst[dir][n2]};
        }
    }
}
__device__ __forceinline__ void lru_scan_phase(Frame& F, int l, int ntiles) {
    int LN_ = F.tid & 63; asm volatile("" : "+v"(LN_));
    const bf16* PROJ = WSP(const bf16, WS_PROJ);
    LAS bf16* gts = (LAS bf16*)(F.lds);
    const int lane = LN_, j16 = lane & 15, g = lane >> 4;
    const int kb = F.wave & 3, nh = F.wave >> 2;
    const v4u* AB = WSP(const v4u, WS_AB);
    v4u pab[2][2][2]; unsigned pgw[8];
    auto load_tile = [&](int T) {
#pragma unroll
        for (int dir = 0; dir < 2; ++dir)
#pragma unroll
            for (int rt = 0; rt < 2; ++rt)
#pragma unroll
                for (int n2 = 0; n2 < 2; ++n2) pab[dir][rt][n2] = AB[(((((size_t)T * 2 + dir) * 2 + rt) * 8 + F.wave) * 2 + n2) * 64 + lane];
#pragma unroll
        for (int j = 0; j < 8; ++j) { const int i = F.tid + 512 * j, t = i >> 7, cp = i & 127; pgw[j] = *(const unsigned*)(PROJ + (size_t)(T * 32 + t) * IND + 2304 + 2 * cp); }
    };
    if (F.vcu < ntiles) load_tile(F.vcu);
    for (int T = F.vcu; T < ntiles; T += F.G) {
        const int row0 = T * 32;
        __syncthreads();
#pragma unroll
        for (int j = 0; j < 8; ++j) ((LAS unsigned*)gts)[F.tid + 512 * j] = pgw[j];
        v4u cur[2][2][2];
#pragma unroll
        for (int dir = 0; dir < 2; ++dir)
#pragma unroll
            for (int rt = 0; rt < 2; ++rt)
#pragma unroll
                for (int n2 = 0; n2 < 2; ++n2) cur[dir][rt][n2] = pab[dir][rt][n2];
        float hst[2][2];
#pragma unroll
        for (int dir = 0; dir < 2; ++dir)
#pragma unroll
            for (int n2 = 0; n2 < 2; ++n2) hst[dir][n2] = WSP(const float, WS_CARRY)[((size_t)dir * 1152 + T) * 256 + kb * 64 + 16 * (2 * nh + n2) + j16];
        if (T + F.G < ntiles) load_tile(T + F.G);
        __syncthreads();
        float hf[2][2][4];
#pragma unroll
        for (int dir = 0; dir < 2; ++dir) {
            const bool sec16 = ((g & 1) != 0) != (dir != 0), sec32 = ((g >> 1) != 0) != (dir != 0);
#pragma unroll
            for (int step = 0; step < 2; ++step) {
                const int rt = dir == 0 ? step : 1 - step;
#pragma unroll
                for (int n2 = 0; n2 < 2; ++n2) {
                    const int e = kb * 64 + 16 * (2 * nh + n2) + j16;
                    const v4u w = cur[dir][rt][n2];
                    const float a_[4] = {1.f - bflo(w.x), 1.f - bflo(w.y), 1.f - bflo(w.z), 1.f - bflo(w.w)}, b_[4] = {bfhi(w.x), bfhi(w.y), bfhi(w.z), bfhi(w.w)};
                    const float P = (a_[0] * a_[1]) * (a_[2] * a_[3]);
                    const float S = dir == 0 ? ((b_[0] * a_[1] + b_[1]) * a_[2] + b_[2]) * a_[3] + b_[3] : ((b_[3] * a_[2] + b_[2]) * a_[1] + b_[1]) * a_[0] + b_[0];
                    const float Pp = __shfl_xor(P, 16), Sp = __shfl_xor(S, 16);
                    const float e1P = sec16 ? Pp : 1.f, e1S = sec16 ? Sp : 0.f;
                    const float prP = P * Pp, prS = sec16 ? P * Sp + S : Pp * S + Sp;
                    const float Pq = __shfl_xor(prP, 32), Sq = __shfl_xor(prS, 32);
                    const float EP = sec32 ? Pq * e1P : e1P, ES = sec32 ? e1P * Sq + e1S : e1S;
                    const float TP = prP * Pq, TS = sec32 ? prP * Sq + prS : Pq * prS + Sq;
                    float h = EP * hst[dir][n2] + ES;
                    if (dir == 0) {
#pragma unroll
                        for (int r = 0; r < 4; ++r) { h = a_[r] * h + b_[r]; hf[rt][n2][r] = h; }
                    } else {
                        float hb[4];
#pragma unroll
                        for (int r = 3; r >= 0; --r) { h = a_[r] * h + b_[r]; hb[r] = h; }
                        bf16* mp = WSP(bf16, WS_MIX) + (size_t)(row0 + 16 * rt + 4 * g) * D + 768 + e;
                        const LAS bf16* gp = gts + (16 * rt + 4 * g) * 256 + e;
#pragma unroll
                        for (int r = 0; r < 4; ++r) mp[(size_t)r * D] = (bf16)f2bf(gelu_tanh(bf1(gp[r * 256])) * (hf[rt][n2][r] + hb[r]));
                    }
                    hst[dir][n2] = TP * hst[dir][n2] + TS;
                }
            }
        }
    }
}

constexpr int LQ_WVB = 35 * 128 + 32 * 144;
constexpr int LQ_WV = 72 * 1024;
constexpr int LQ_CH = TBL_OFF;
constexpr int LQ_FL = LQ_CH + 72 * 2 * 16 * 4;
constexpr int LQ_WV2 = LQ_FL + 2 * 72 * 4;
static_assert(LQ_WV + 6 * LQ_WVB <= RING_BYTES && LQ_WV2 + 2 * LQ_WVB <= LDS_BYTES && LQ_WV2 % 16 == 0, "LRU LDS map");
__device__ __forceinline__ void lru_seq_phase(Frame& F, int l, bool last) {
    int LN_ = F.tid & 63; asm volatile("" : "+v"(LN_));
    const bf16* PROJ = WSP(const bf16, WS_PROJ);
    const int lane = LN_, j16 = lane & 15, g = lane >> 4, cpn = lane & 31, hh = lane >> 5;
    LAS unsigned char* wreg = F.lds + (F.wave < 6 ? LQ_WV + F.wave * LQ_WVB : LQ_WV2 + (F.wave - 6) * LQ_WVB);
    LAS unsigned* rx32 = (LAS unsigned*)wreg;
    LAS unsigned char* ucb = wreg + 35 * 128;
    volatile LAS unsigned* cflag = (volatile LAS unsigned*)(F.lds + LQ_FL);
    volatile LAS unsigned* hflag = cflag + 72;
    LAS float* chain = (LAS float*)(F.lds + LQ_CH);
    for (int item = F.vcu; item < NB * 16; item += F.G) {
        const int b = item >> 4, cg = item & 15, kb = cg >> 2, nn = cg & 3;
        __syncthreads();
        if (F.tid < 144) cflag[F.tid] = 0u;
        __syncthreads();
        s16x8 wf[2][2][2]; float cbx[2], cba[2], csp[2]; f32x2 cw[2][4], cb[2];
#pragma unroll
        for (int dir = 0; dir < 2; ++dir) {
            const int ld = l * 2 + dir;
            const bf16* WLR = WSP(const bf16, WS_WLR) + (size_t)((ld * 4 + kb) * 2) * 4096;
#pragma unroll
            for (int gt = 0; gt < 2; ++gt)
#pragma unroll
                for (int s_ = 0; s_ < 2; ++s_) wf[dir][gt][s_] = *(const s16x8*)(WLR + gt * 4096 + (16 * nn + j16) * 64 + 32 * s_ + 8 * g);
            const int idx = ld * 256 + kb * 64 + 16 * nn + j16;
            cbx[dir] = INP(18)[idx]; cba[dir] = INP(20)[idx];
            const float nl = -INP(21)[idx]; csp[dir] = -8.f * 1.4426950408889634f * (fmaxf(nl, 0.f) + log1pf(__expf(-fabsf(nl))));
            const int c0 = kb * 64 + 2 * cpn;
#pragma unroll
            for (int k = 0; k < 4; ++k) cw[dir][k] = (f32x2){INP(15)[(ld * 4 + k) * 256 + c0], INP(15)[(ld * 4 + k) * 256 + c0 + 1]};
            cb[dir] = (f32x2){INP(16)[ld * 256 + c0], INP(16)[ld * 256 + c0 + 1]};
        }
        auto tile_row0 = [&](int s, int dir) -> int { return s < 8 ? ML + b * CTXL + 32 * (dir == 0 ? s : 7 - s) : b * SEQ + 32 * (dir == 0 ? s - 8 : 71 - s); };
        v4u pre[5];
        auto load_rows = [&](int s, int dir) {
            const unsigned roff = (unsigned)(((lane >> 3) * IND + 8 * (lane & 7)) * 2);
            const int lo = s < 8 ? ML + b * CTXL : b * SEQ, hi = lo + (s < 8 ? CTXL : SEQ);
            const int r0 = tile_row0(s, dir) - (dir == 0 ? 3 : 0);
            const unsigned char* rb = (const unsigned char*)(PROJ + (ptrdiff_t)r0 * IND + 2048 + kb * 64);
#pragma unroll
            for (int j = 0; j < 5; ++j) { const int rr = (lane >> 3) + 8 * j, row = r0 + rr;
                const bool ok = rr < 35 && row >= lo && row < hi;
                pre[j] = ok ? *(const v4u*)(rb + (roff + (unsigned)(8 * j * IND * 2))) : (v4u){0u, 0u, 0u, 0u}; }
        };
        load_rows(F.wave, 0);
        for (int s = F.wave; s < 72; s += 8) {
            const bool ctxs = s < 8, comb = ctxs ? s >= 4 : s >= 40, outp = !(last && ctxs);
            float A_[2][2][4], B_[2][2][4], EP[2][2], ES[2][2], TP[2][2], TS[2][2];
#pragma unroll
            for (int dir = 0; dir < 2; ++dir) {
#pragma unroll
                for (int j = 0; j < 5; ++j) { const int rr = (lane >> 3) + 8 * j; if (rr < 35) *(LAS v4u*)(wreg + rr * 128 + 16 * (lane & 7)) = pre[j]; }
                if (dir == 0) load_rows(s, 1); else if (s + 8 < 72) load_rows(s + 8, 0);
                {
                    auto up2 = [](unsigned w) -> f32x2 { return (f32x2){bflo(w), bfhi(w)}; };
                    f32x2 x0 = up2(rx32[(16 * hh + 0) * 32 + cpn]), x1 = up2(rx32[(16 * hh + 1) * 32 + cpn]), x2 = up2(rx32[(16 * hh + 2) * 32 + cpn]);
#pragma unroll
                    for (int t = 0; t < 16; ++t) {
                        const f32x2 x3 = up2(rx32[(16 * hh + t + 3) * 32 + cpn]);
                        const f32x2 acc = cb[dir] + cw[dir][0] * x0 + cw[dir][1] * x1 + cw[dir][2] * x2 + cw[dir][3] * x3;
                        *(LAS unsigned*)(ucb + (16 * hh + t) * 144 + 4 * cpn) = pg8::cvt_pk_bf16(acc[0], acc[1]);
                        x0 = x1; x1 = x2; x2 = x3;
                    }
                }
                const bool sec16 = ((g & 1) != 0) != (dir != 0), sec32 = ((g >> 1) != 0) != (dir != 0);
#pragma unroll
                for (int rt = 0; rt < 2; ++rt) {
                    f32x4 zx = {0.f, 0.f, 0.f, 0.f}, za = {0.f, 0.f, 0.f, 0.f};
#pragma unroll
                    for (int s_ = 0; s_ < 2; ++s_) { const s16x8 af = *(const LAS s16x8*)(ucb + (16 * rt + j16) * 144 + 64 * s_ + 16 * g);
                        zx = __builtin_amdgcn_mfma_f32_16x16x32_bf16(af, wf[dir][0][s_], zx, 0, 0, 0); za = __builtin_amdgcn_mfma_f32_16x16x32_bf16(af, wf[dir][1][s_], za, 0, 0, 0); }
                    float a_[4], b_[4];
#pragma unroll
                    for (int r = 0; r < 4; ++r) {
                        const float u = bf1(*(const LAS bf16*)(ucb + (16 * rt + 4 * g + r) * 144 + 2 * (16 * nn + j16)));
                        const float gx = sigmoidf_(zx[r] + cbx[dir]), ga = sigmoidf_(za[r] + cba[dir]);
                        const float a = __builtin_amdgcn_exp2f(csp[dir] * ga);
                        const float om = __builtin_fmaf(-a, a, 1.f);
                        a_[r] = a; b_[r] = __builtin_amdgcn_sqrtf(om) * gx * u;
                        A_[dir][rt][r] = a_[r]; B_[dir][rt][r] = b_[r];
                    }
                    const float P = (a_[0] * a_[1]) * (a_[2] * a_[3]);
                    const float S = dir == 0 ? ((b_[0] * a_[1] + b_[1]) * a_[2] + b_[2]) * a_[3] + b_[3] : ((b_[3] * a_[2] + b_[2]) * a_[1] + b_[1]) * a_[0] + b_[0];
                    const float Pp = __shfl_xor(P, 16), Sp = __shfl_xor(S, 16);
                    const float e1P = sec16 ? Pp : 1.f, e1S = sec16 ? Sp : 0.f;
                    const float prP = P * Pp, prS = sec16 ? P * Sp + S : Pp * S + Sp;
                    const float Pq = __shfl_xor(prP, 32), Sq = __shfl_xor(prS, 32);
                    EP[dir][rt] = sec32 ? Pq * e1P : e1P; ES[dir][rt] = sec32 ? e1P * Sq + e1S : e1S;
                    TP[dir][rt] = prP * Pq; TS[dir][rt] = sec32 ? prP * Sq + prS : Pq * prS + Sq;
                }
            }
            bf16 gr[2][2][4];
            if (comb && outp) {
                const unsigned goff = (unsigned)((4 * g * IND + j16) * 2);
#pragma unroll
                for (int dir = 0; dir < 2; ++dir) { const unsigned char* gp = (const unsigned char*)(PROJ + (size_t)tile_row0(s, dir) * IND + 2304 + 16 * cg);
#pragma unroll
                    for (int rt = 0; rt < 2; ++rt)
#pragma unroll
                        for (int r = 0; r < 4; ++r) gr[dir][rt][r] = *(const bf16*)(gp + (goff + (unsigned)((16 * rt + r) * IND * 2))); }
            }
            float hin[2] = {0.f, 0.f};
            if (s > 0) {
                while (__builtin_amdgcn_readfirstlane(cflag[s - 1]) == 0u) __builtin_amdgcn_s_sleep(1);
                asm volatile("" ::: "memory");
                hin[0] = chain[((s - 1) * 2 + 0) * 16 + j16]; hin[1] = chain[((s - 1) * 2 + 1) * 16 + j16];
            }
#pragma unroll
            for (int dir = 0; dir < 2; ++dir) { const int rf = dir == 0 ? 0 : 1, rs_ = 1 - rf;
                const float hout = (TP[dir][rf] * TP[dir][rs_]) * hin[dir] + (TP[dir][rs_] * TS[dir][rf] + TS[dir][rs_]);
                if (g == 0) chain[(s * 2 + dir) * 16 + j16] = hout; }
            asm volatile("" ::: "memory");
            cflag[s] = 1u;
            asm volatile("" ::: "memory");
#pragma unroll
            for (int dir = 0; dir < 2; ++dir) { const int rf = dir == 0 ? 0 : 1, rs_ = 1 - rf;
                float hv[2][4];
                { float h = EP[dir][rf] * hin[dir] + ES[dir][rf];
                  if (dir == 0) {
#pragma unroll
                      for (int r = 0; r < 4; ++r) { h = A_[dir][rf][r] * h + B_[dir][rf][r]; hv[rf][r] = h; }
                  } else {
#pragma unroll
                      for (int r = 3; r >= 0; --r) { h = A_[dir][rf][r] * h + B_[dir][rf][r]; hv[rf][r] = h; }
                  } }
                { const float hm = TP[dir][rf] * hin[dir] + TS[dir][rf]; float h = EP[dir][rs_] * hm + ES[dir][rs_];
                  if (dir == 0) {
#pragma unroll
                      for (int r = 0; r < 4; ++r) { h = A_[dir][rs_][r] * h + B_[dir][rs_][r]; hv[rs_][r] = h; }
                  } else {
#pragma unroll
                      for (int r = 3; r >= 0; --r) { h = A_[dir][rs_][r] * h + B_[dir][rs_][r]; hv[rs_][r] = h; }
                  } }
                if (outp) {
                    const int id = s < 8 ? (dir == 0 ? s : 7 - s) : (dir == 0 ? s : 79 - s);
                    LAS v4u* hb = (LAS v4u*)(F.lds + id * 1024 + lane * 16);
                    if (!comb) {
                        *hb = (v4u){pg8::cvt_pk_bf16(hv[0][0], hv[0][1]), pg8::cvt_pk_bf16(hv[0][2], hv[0][3]), pg8::cvt_pk_bf16(hv[1][0], hv[1][1]), pg8::cvt_pk_bf16(hv[1][2], hv[1][3])};
                        asm volatile("" ::: "memory");
                        hflag[id] = 1u;
                        asm volatile("" ::: "memory");
                    } else {
                        while (__builtin_amdgcn_readfirstlane(hflag[id]) == 0u) __builtin_amdgcn_s_sleep(1);
                        asm volatile("" ::: "memory");
                        const v4u o = *hb;
                        const float ot[2][4] = {{bflo(o.x), bfhi(o.x), bflo(o.y), bfhi(o.y)}, {bflo(o.z), bfhi(o.z), bflo(o.w), bfhi(o.w)}};
                        const unsigned moff = (unsigned)((4 * g * D + j16) * 2);
                        unsigned char* mp = (unsigned char*)(WSP(bf16, WS_MIX) + (size_t)tile_row0(s, dir) * D + 768 + 16 * cg);
#pragma unroll
                        for (int rt = 0; rt < 2; ++rt)
#pragma unroll
                            for (int r = 0; r < 4; ++r) *(bf16*)(mp + (moff + (unsigned)((16 * rt + r) * D * 2))) = (bf16)f2bf(gelu_tanh(bf1(gr[dir][rt][r])) * (hv[rt][r] + ot[rt][r]));
                    }
                }
            }
        }
    }
}

__device__ __forceinline__ void lru_carry(Frame& F) {
    int LN_ = F.tid & 63; asm volatile("" : "+v"(LN_));
    const f32x2* TOT = WSP(const f32x2, WS_TOT); float* CARRY = WSP(float, WS_CARRY);
    for (int it = F.gw; it < NB * 2 * 4; it += F.NGW) {
        const int b = it >> 3, dir = (it >> 2) & 1, c = (it & 3) * 64 + LN_;
        float h = 0.f;
        for (int g = 0; g < 18; ++g) {
            f32x2 ps[4]; int tl[4];
#pragma unroll
            for (int i = 0; i < 4; ++i) { const int s = g * 4 + i;
                int T; if (s < 8) T = 1024 + b * 8 + (dir == 0 ? s : 7 - s); else T = b * 64 + (dir == 0 ? s - 8 : 71 - s);
                tl[i] = T; ps[i] = TOT[((size_t)dir * 1152 + T) * 256 + c]; }
#pragma unroll
            for (int i = 0; i < 4; ++i) { CARRY[((size_t)dir * 1152 + tl[i]) * 256 + c] = h; h = ps[i][0] * h + ps[i][1]; }
        }
    }
}

__device__ __forceinline__ void ctx_finalize(Frame& F, int l) {
    int LN_ = F.tid & 63; asm volatile("" : "+v"(LN_));
    bf16* XA = WSP(bf16, WS_XA); float* RSSA = WSP(float, WS_RSSA); const float* ACC = WSP(const float, WS_PART); const float* MOD = WSP(const float, WS_MOD);
    const float* go = INP(5) + (l - 1) * D; const float* gso = MOD + ((size_t)(l - 1) * 17 + NB) * MODW + 4 * D;
    const float* gn = INP(4) + l * D; const float* gsn = MOD + ((size_t)l * 17 + NB) * MODW + D;
    for (int r = F.gw; r < MC; r += 2 * F.NGW) {
        const int r2 = (r + F.NGW < MC) ? r + F.NGW : r; const bool two = r2 != r;
        const int rr[2] = {r, r2};
        v2u w[2][4]; f32x4 sl[2][4][4];
#pragma unroll
        for (int q = 0; q < 2; ++q)
#pragma unroll
            for (int j = 0; j < 4; ++j) { const int k = 4 * LN_ + 256 * j; const float* ap = ACC + (size_t)rr[q] * D + k;
                w[q][j] = *(const v2u*)(XA + ((size_t)ML + rr[q]) * D + k);
#pragma unroll
                for (int t = 0; t < 4; ++t) sl[q][j][t] = __builtin_nontemporal_load((const f32x4*)(ap + (size_t)t * MC * D)); }
        f32x4 im[4], gnn[4];
#pragma unroll
        for (int j = 0; j < 4; ++j) { const int k = 4 * LN_ + 256 * j; im[j] = *(const f32x4*)(go + k) * (*(const f32x4*)(gso + k) + 1.0f); gnn[j] = *(const f32x4*)(gn + k) * (*(const f32x4*)(gsn + k) + 1.0f); }
#pragma unroll
        for (int q = 0; q < 2; ++q) { if (q == 1 && !two) break;
            const size_t row = (size_t)ML + rr[q];
            float ss = 0.f; f32x4 y[4];
#pragma unroll
            for (int j = 0; j < 4; ++j) {
                const f32x4 xo = (f32x4){bflo(w[q][j].x) * __builtin_amdgcn_rcpf(im[j][0]), bfhi(w[q][j].x) * __builtin_amdgcn_rcpf(im[j][1]), bflo(w[q][j].y) * __builtin_amdgcn_rcpf(im[j][2]), bfhi(w[q][j].y) * __builtin_amdgcn_rcpf(im[j][3])};
                y[j] = xo + ((sl[q][j][0] + sl[q][j][1]) + (sl[q][j][2] + sl[q][j][3]));
                ss += (y[j][0] * y[j][0] + y[j][1] * y[j][1]) + (y[j][2] * y[j][2] + y[j][3] * y[j][3]); }
            ss = wave_sum(ss);
            if (LN_ < 32) RSSA[row * 32 + LN_] = (LN_ == 0) ? ss : 0.f;
#pragma unroll
            for (int j = 0; j < 4; ++j) { const int k = 4 * LN_ + 256 * j;
                const f32x4 a_ = y[j] * gnn[j];
                v2u o; o.x = pk2(a_[0], a_[1]); o.y = pk2(a_[2], a_[3]); *(v2u*)(XA + row * D + k) = o; }
        }
    }
}

__device__ __forceinline__ void final_rows(Frame& F) {
    int LN_ = F.tid & 63; asm volatile("" : "+v"(LN_));
    const bf16* XA = WSP(const bf16, WS_XA); const float* RSS = WSP(const float, WS_RSSA);
    const int rpw = (ML + F.NGW - 1) / F.NGW, rbeg = (F.gw * rpw < ML) ? F.gw * rpw : ML, rend = (rbeg + rpw < ML) ? rbeg + rpw : ML;
    v4u na0, na1, nb0, nb1; float np0 = 0.f, np1 = 0.f;
    auto load_pair = [&](int row) __attribute__((always_inline)) {
        const int row2 = (row + 1 < rend) ? row + 1 : row;
        na0 = __builtin_nontemporal_load((const v4u*)(XA + (size_t)row * D + 8 * LN_)); na1 = __builtin_nontemporal_load((const v4u*)(XA + (size_t)row * D + 512 + 8 * LN_)); np0 = LN_ < 32 ? RSS[(size_t)row * 32 + LN_] : 0.f;
        nb0 = __builtin_nontemporal_load((const v4u*)(XA + (size_t)row2 * D + 8 * LN_)); nb1 = __builtin_nontemporal_load((const v4u*)(XA + (size_t)row2 * D + 512 + 8 * LN_)); np1 = LN_ < 32 ? RSS[(size_t)row2 * 32 + LN_] : 0.f;
    };
    if (rbeg < rend) load_pair(rbeg);
#pragma unroll 1
    for (int row = rbeg; row < rend; row += 2) {
        const v4u a0 = na0, a1 = na1, b0 = nb0, b1 = nb1; const float p0 = np0, p1 = np1;
        const bool two = row + 1 < rend;
        if (row + 2 < rend) load_pair(row + 2);
        const float rs0 = rsqrtf(wave_sum(p0) * (1.f / D) + EPS), rs1 = rsqrtf(wave_sum(p1) * (1.f / D) + EPS);
        float* o = F.out + (size_t)row * D + 8 * LN_;
        *(f32x4*)(o) = (f32x4){bflo(a0.x), bfhi(a0.x), bflo(a0.y), bfhi(a0.y)} * rs0; *(f32x4*)(o + 4) = (f32x4){bflo(a0.z), bfhi(a0.z), bflo(a0.w), bfhi(a0.w)} * rs0;
        *(f32x4*)(o + 512) = (f32x4){bflo(a1.x), bfhi(a1.x), bflo(a1.y), bfhi(a1.y)} * rs0; *(f32x4*)(o + 516) = (f32x4){bflo(a1.z), bfhi(a1.z), bflo(a1.w), bfhi(a1.w)} * rs0;
        if (two) { float* o2 = o + D;
            *(f32x4*)(o2) = (f32x4){bflo(b0.x), bfhi(b0.x), bflo(b0.y), bfhi(b0.y)} * rs1; *(f32x4*)(o2 + 4) = (f32x4){bflo(b0.z), bfhi(b0.z), bflo(b0.w), bfhi(b0.w)} * rs1;
            *(f32x4*)(o2 + 512) = (f32x4){bflo(b1.x), bfhi(b1.x), bflo(b1.y), bfhi(b1.y)} * rs1; *(f32x4*)(o2 + 516) = (f32x4){bflo(b1.z), bfhi(b1.z), bflo(b1.w), bfhi(b1.w)} * rs1; }
    }
}

__device__ __forceinline__ void fill_res_tables(Frame& F, const pg8::Order& S, const float* gate, const float* gmg, const float* gmsc, const float* go, const float* gso) {
    LAS float* T = (LAS float*)(F.lds + TBL_OFF);
    if (F.tid < 256) {
        float tg[3], tm[3], ts[3], to[3], tq[3]; bool ok[3];
#pragma unroll
        for (int i = 0; i < 3; ++i) { pg8::Unit u; ok[i] = S.next(i, u);
            if (ok[i]) { const int brow = u.pm < ML / 256 ? (u.pm >> 3) : NB, col = u.pn * 256 + F.tid;
                tg[i] = gate[(size_t)brow * MODW + col]; tm[i] = gmg[col]; ts[i] = gmsc[(size_t)brow * MODW + col]; to[i] = go[col]; tq[i] = gso[(size_t)brow * MODW + col]; } }
#pragma unroll
        for (int i = 0; i < 3; ++i) if (ok[i]) {
            T[i * 256 + F.tid] = tg[i];
            T[(pg8::TBL_UNITS + i) * 256 + F.tid] = tm[i] * (1.f + ts[i]);
            T[(2 * pg8::TBL_UNITS + i) * 256 + F.tid] = __builtin_amdgcn_rcpf(to[i] * (1.f + tq[i])); }
#pragma unroll 1
        for (int i = 3; i < pg8::TBL_UNITS; ++i) { pg8::Unit u; if (!S.next(i, u)) break;
            const int brow = u.pm < ML / 256 ? (u.pm >> 3) : NB, col = u.pn * 256 + F.tid;
            T[i * 256 + F.tid] = gate[(size_t)brow * MODW + col];
            T[(pg8::TBL_UNITS + i) * 256 + F.tid] = gmg[col] * (1.f + gmsc[(size_t)brow * MODW + col]);
            T[(2 * pg8::TBL_UNITS + i) * 256 + F.tid] = __builtin_amdgcn_rcpf(go[col] * (1.f + gso[(size_t)brow * MODW + col])); }
    }
    __syncthreads();
}

template <int LDC>
__device__ __forceinline__ void fill_scale_tables(Frame& F, const pg8::Order& S, const float* RSS, const float* shw) {
    LAS float* RS_T = (LAS float*)(F.lds + TBL_OFF); LAS float* SH_T = RS_T + pg8::TBL_UNITS * 256;
    const int row = F.tid >> 1, half = F.tid & 1;
    f32x4 p[2][3][4], sv[2][3]; bool ok[2][3];
    auto load_group = [&](int i0, f32x4 (&pg)[3][4], f32x4 (&sg)[3], bool (&og)[3]) __attribute__((always_inline)) {
#pragma unroll
        for (int j = 0; j < 3; ++j) { pg8::Unit u; og[j] = (i0 + j < pg8::TBL_UNITS) && S.next(i0 + j, u);
            if (og[j]) { const float* b = RSS + ((size_t)u.pm * 256 + row) * 32 + 16 * half;
#pragma unroll
                for (int q = 0; q < 4; ++q) pg[j][q] = *(const f32x4*)(b + 4 * q);
                if (F.tid < 64) sg[j] = *(const f32x4*)(shw + (size_t)(u.pm < ML / 256 ? (u.pm >> 3) : NB) * LDC + u.pn * 256 + 4 * F.tid); } }
    };
    auto reduce_group = [&](int i0, f32x4 (&pg)[3][4], f32x4 (&sg)[3], bool (&og)[3]) __attribute__((always_inline)) {
#pragma unroll
        for (int j = 0; j < 3; ++j) if (og[j]) {
            float s = 0.f;
#pragma unroll
            for (int q = 0; q < 4; ++q) s += (pg[j][q][0] + pg[j][q][1]) + (pg[j][q][2] + pg[j][q][3]);
            s = lane_xor1_sum(s);
            if (half == 0) RS_T[(i0 + j) * 256 + row] = rsqrtf(s * (1.0f / D) + EPS);
            if (F.tid < 64) *(LAS f32x4*)(SH_T + (i0 + j) * 256 + 4 * F.tid) = sg[j]; }
    };
    load_group(0, p[0], sv[0], ok[0]);
    load_group(3, p[1], sv[1], ok[1]);
    reduce_group(0, p[0], sv[0], ok[0]);
    load_group(6, p[0], sv[0], ok[0]);
    reduce_group(3, p[1], sv[1], ok[1]);
    reduce_group(6, p[0], sv[0], ok[0]);
    __syncthreads();
}

constexpr int N_PHASES = 2 + 5 * DEPTH + 1;
struct Args { const float* in[25]; float* out; unsigned char* ws; int ph_lo, ph_hi; };
static_assert(sizeof(Args) == 27 * 8 + 8, "Args has no padding");

__global__ void __launch_bounds__(NWAVES * 64, 2) mega_fwd(Args args) {
    extern __shared__ __attribute__((aligned(16))) unsigned char lds[];
    Frame F;
    F.lds = (LAS unsigned char*)lds;
    const int wave_s = __builtin_amdgcn_readfirstlane((int)threadIdx.x >> 6);
    F.wave = wave_s; F.tid = wave_s * 64 + (int)__builtin_amdgcn_mbcnt_hi(~0u, __builtin_amdgcn_mbcnt_lo(~0u, 0u));
    F.G = gridDim.x; { const int bx = blockIdx.x; F.vcu = (F.G % 8 == 0) ? (bx % 8) * (F.G / 8) + bx / 8 : bx; }
    F.gw = F.vcu * NWAVES + F.wave; F.NGW = F.G * NWAVES;
    F.out = args.out; F.ws = args.ws;
    volatile LAS unsigned* MISC = (volatile LAS unsigned*)(F.lds + MISC_OFF);
    for (int u = F.tid; u < (LDS_BYTES - LDSCTL_OFF) / 4; u += NWAVES * 64) ((LAS unsigned*)(F.lds + LDSCTL_OFF))[u] = 0u;
    __syncthreads();
    if (F.tid == 0) {
#pragma unroll
        for (int i = 0; i < 25; ++i) *(LAS unsigned long long*)(F.lds + PTR_OFF + 8 * i) = (unsigned long long)args.in[i];
    }
    __syncthreads();
    XcdBarrier bar = xcd_barrier_post((unsigned*)(F.ws + WS_CTL) + CW_BAR, MISC + 8, F.tid);

    const int lo = args.ph_lo, hi = args.ph_hi;
#ifdef PROBE_TL
    unsigned ttl_ = (unsigned)__builtin_amdgcn_readfirstlane((int)(unsigned)__builtin_amdgcn_s_memrealtime());
#endif
#ifdef PROBE_PH
    const unsigned tk0_ = (unsigned)__builtin_amdgcn_readfirstlane((int)(unsigned)__builtin_amdgcn_s_memrealtime());
#endif
#ifdef PROBE_MASK
    bool rep_done = false;
#define PROBE_V ((((PROBE_MASK >> ph) & 1) && !rep_done) ? PROBE_VARIANT : 0)
#else
#define PROBE_V 0
#endif
    for (int ph = lo; ph < hi; ++ph) {
        { unsigned ones_ = ~0u; asm volatile("" : "+s"(ones_));
          int t_ = wave_s * 64 + (int)__builtin_amdgcn_mbcnt_hi(ones_, __builtin_amdgcn_mbcnt_lo(ones_, 0u)); asm volatile("" : "+v"(t_)); F.tid = t_; F.wave = __builtin_amdgcn_readfirstlane(t_ >> 6); F.gw = F.vcu * NWAVES + F.wave; }
#ifdef PROBE_PH
        unsigned tp0_ = 0, tp1_ = 0;
        if (ph == PROBE_PH) tp0_ = (unsigned)__builtin_amdgcn_readfirstlane((int)(unsigned)__builtin_amdgcn_s_memrealtime());
#endif
        if (ph == 0) {
#ifndef NO_P0
            phase_p0a(F);
#endif
        } else if (ph == 1) {
#ifndef NO_P0
            phase_p0b(F);
#endif
        }
        else if (ph == N_PHASES - 1) { final_rows(F);
#ifdef PROBE_PH
            if (blockIdx.x == 0 && F.tid == 0) { const unsigned* pc = WSP(const unsigned, WS_CTL + 768 * 1024); unsigned v_ = __builtin_nontemporal_load(pc + (PROBE_SEL & 3)); if (PROBE_SEL == 2) v_ = 0xFFFFFFFFu - v_; if (PROBE_SEL == 4) v_ = (unsigned)__builtin_amdgcn_s_memrealtime() - tk0_; __builtin_amdgcn_s_sleep(127); F.out[0] = (float)v_ * PROBE_SCALE; }
#endif
        }
        else {
            const int l = (ph - 2) / 5, k5 = (ph - 2) % 5, k = k5 < 2 ? k5 : k5 + 2; const bool last = (l == DEPTH - 1);
            const int Mx = last ? ML : MT;
            float* MOD = WSP(float, WS_MOD);
            if (k == 0) {
                if (l > 0) { ctx_finalize(F, l); xcd_barrier(bar, F.tid); }
                pg8::Gemm g{WSP(const bf16, WS_XA), WSP(const bf16, WS_WIN) + (size_t)l * IND * D, MT, IND, D};
                pg8::Order S; if (last) S.init(ML, IND, WGM_IN, (MC / 256) * 5, 1, F.G, (int)blockIdx.x); else S.init(MT, IND, WGM_IN, 0, 0, F.G, (int)blockIdx.x);
                auto pre = [&]() __attribute__((always_inline)) { fill_scale_tables<IND>(F, S, WSP(const float, WS_RSSA), WSP(const float, WS_SHW1) + (size_t)l * 17 * IND); };
                pg8::EpiScale<0, IND, true> E{WSP(bf16, WS_PROJ), (const LAS float*)(F.lds + TBL_OFF), PROBE_V};

#ifndef NO_G0
                pg8::gemm_phase<pg8::EpiScale<0, IND, true>, pg8::Order, true, true, false, decltype(pre)>(F.lds + RING_OFF, g, S, E, F.tid, pre);
#endif
                if (!last) filler_weights(F, S.nwg + S.extra, W_EARLY, W_F1); else filler_weights(F, S.nwg + S.extra, W_F2, W_ITEMS);

            } else if (k == 1) {

#ifndef NO_LRU
                lru_seq_phase(F, l, last);
#ifdef REP_LRU0
                __syncthreads(); lru_seq_phase(F, l, last);
#endif
#endif

                __syncthreads();
#ifndef NO_CONV
                conv_phase(F, l, last ? 1024 : 1152);
                __syncthreads();
#ifdef REP_CONV
                conv_phase(F, l, last ? 1024 : 1152);
                __syncthreads();
#endif
#endif
#ifndef NO_NA
#ifdef REP_NA
                na_phase(F, l, last ? NA_ITEMS_LAT : NA_ITEMS_LAT + NA_ITEMS_CTX, REP_NA);
#else
                na_phase(F, l, last ? NA_ITEMS_LAT : NA_ITEMS_LAT + NA_ITEMS_CTX);
#endif
#ifdef REP_NA
                __syncthreads(); na_phase(F, l, last ? NA_ITEMS_LAT : NA_ITEMS_LAT + NA_ITEMS_CTX, 0);
#endif
#endif
            } else if (k == 4 || k == 6) {
                const bool dn = (k == 6);
                const int ln = (dn && !last) ? l + 1 : l;
                pg8::Gemm g{dn ? WSP(const bf16, WS_HID) : WSP(const bf16, WS_MIX), dn ? WSP(const bf16, WS_W2) + (size_t)l * D * FF : WSP(const bf16, WS_WOUT) + (size_t)l * D * D, Mx, D, dn ? FF : D};
                const bool splitk = dn && !last;
                pg8::Order S; S.init(splitk ? ML : Mx, D, dn ? WGM_DN : WGM_OUT, 0, 0, F.G, (int)blockIdx.x);
                const float* go_g = dn ? INP(5) + l * D : INP(4) + l * D;
                const float* go_s = MOD + (size_t)l * 17 * MODW + (dn ? 4 : 1) * D;
                const bool fin = dn && last;
                auto pre = [&]() __attribute__((always_inline)) { fill_res_tables(F, S, MOD + (size_t)l * 17 * MODW + (dn ? 5 : 2) * D, fin ? INP(24) : (dn ? INP(4) : INP(5)) + ln * D, fin ? WSP(const float, WS_ZERO) : MOD + (size_t)ln * 17 * MODW + (dn ? 1 : 4) * D, go_g, go_s); };
                pg8::EpiRes<RES_NB> E{(const LAS float*)(F.lds + TBL_OFF), WSP(bf16, WS_XA), dn ? WSP(float, WS_RSSA) : WSP(float, WS_RSSB)};
#ifndef NO_GR
                pg8::gemm_phase<pg8::EpiRes<RES_NB>, pg8::Order, true, true, false, decltype(pre)>(F.lds + RING_OFF, g, S, E, F.tid, pre);
                if (!dn && !last) filler_weights(F, S.nwg + S.extra, W_F1, W_F2);
                if (splitk) {
                    pg8::Order S2; S2.init(ML, 0, 4, (MC / 256) * 16, 2, F.G, (int)blockIdx.x);
                    pg8::EpiSlab E2{WSP(float, WS_PART), MOD + ((size_t)l * 17 + NB) * MODW + 5 * D};
                    pg8::gemm_phase<pg8::EpiSlab, pg8::Order, true, true, true>(F.lds + RING_OFF, g, S2, E2, F.tid);
                }
#endif
            } else if (k == 5) {
                pg8::Gemm g{WSP(const bf16, WS_XA), WSP(const bf16, WS_W1) + (size_t)l * FF * D, Mx, FF, D};
                pg8::Order S; S.init(Mx, FF, WGM_UP, 0, 0, F.G, (int)blockIdx.x);
                auto pre = [&]() __attribute__((always_inline)) { fill_scale_tables<FF>(F, S, WSP(const float, WS_RSSB), WSP(const float, WS_SHW2) + (size_t)l * 17 * FF); };
                pg8::EpiScale<1, FF> E{WSP(bf16, WS_HID), (const LAS float*)(F.lds + TBL_OFF), PROBE_V};

#ifndef NO_G1
                pg8::gemm_phase<pg8::EpiScale<1, FF>, pg8::Order, true, true, false, decltype(pre)>(F.lds + RING_OFF, g, S, E, F.tid, pre);
#endif

            }
        }
#ifdef PROBE_MASK
        if (((PROBE_MASK >> ph) & 1) && !rep_done) { rep_done = true; xcd_barrier(bar, F.tid); --ph; continue; }
        rep_done = false;
#endif
#ifdef PROBE_PH
        if (ph == PROBE_PH) { tp1_ = (unsigned)__builtin_amdgcn_readfirstlane((int)(unsigned)__builtin_amdgcn_s_memrealtime());
            if (F.tid == 0) { unsigned* pc = WSP(unsigned, WS_CTL + 768 * 1024); const unsigned w_ = tp1_ - tp0_; atomicMax(pc + 1, w_); atomicMax(pc + 2, 0xFFFFFFFFu - w_); if (blockIdx.x == 0) pc[0] = w_; } }
#endif
        if (ph + 1 < hi) xcd_barrier(bar, F.tid);
#ifdef PROBE_PH
        if (ph == PROBE_PH && blockIdx.x == 0 && F.tid == 0) { unsigned* pc = WSP(unsigned, WS_CTL + 768 * 1024); pc[3] = (unsigned)__builtin_amdgcn_s_memrealtime() - tp1_; }
#endif
#ifdef PROBE_TL
        { const unsigned tn_ = (unsigned)__builtin_amdgcn_readfirstlane((int)(unsigned)__builtin_amdgcn_s_memrealtime());
          if (blockIdx.x == 0 && F.tid == 0) WSP(unsigned, WS_CTL + 768 * 1024)[16 + ph] = tn_ - ttl_;
          ttl_ = tn_; }
        if (ph == N_PHASES - 1) {
            xcd_barrier(bar, F.tid);
            if (blockIdx.x == 0) { const unsigned* pc = WSP(const unsigned, WS_CTL + 768 * 1024);
                const float va_ = (float)__builtin_nontemporal_load(pc + 16 + PROBE_TLA) * PROBE_SA, vb_ = (float)__builtin_nontemporal_load(pc + 16 + PROBE_TLB) * PROBE_SB;
                if (F.tid == 0) F.out[0] = va_;
                for (int i = F.tid; i < 4096; i += NWAVES * 64) F.out[1024 + i] = vb_; }
        }
#endif
#ifdef PROBE_BAR2
        if (ph + 1 < hi) xcd_barrier(bar, F.tid);
#endif
    }
}

extern "C" void kernel_launch(void* const* d_in, const int* in_sizes, int n_in, void* d_out, int out_size, void* d_ws, size_t ws_size, hipStream_t stream) {
    static int grid = 0;
    if (grid == 0) {
        if (n_in != 25 || out_size != ML * D || ws_size < WS_END) { fprintf(stderr, "kernel_launch: unexpected shapes (n_in %d out %d ws %zu)\n", n_in, out_size, ws_size); grid = -1; return; }
        int dev = 0, cus = 0;
        if (hipGetDevice(&dev) != hipSuccess || hipDeviceGetAttribute(&cus, hipDeviceAttributeMultiprocessorCount, dev) != hipSuccess) { grid = -1; return; }
        if (hipFuncSetAttribute((const void*)mega_fwd, hipFuncAttributeMaxDynamicSharedMemorySize, LDS_BYTES) != hipSuccess) { fprintf(stderr, "kernel_launch: hipFuncSetAttribute failed\n"); grid = -1; return; }
        int per_cu = 0;
        if (hipOccupancyMaxActiveBlocksPerMultiprocessor(&per_cu, (const void*)mega_fwd, NWAVES * 64, LDS_BYTES) != hipSuccess || per_cu < 1) fprintf(stderr, "kernel_launch: occupancy query reports %d\n", per_cu);
        (void)hipGetLastError();
        grid = cus;
    }
    if (grid < 0) return;
    if (hipMemsetAsync((char*)d_ws + WS_CTL, 0, CTL_ZERO_BYTES, stream) != hipSuccess) return;
    Args a{};
    for (int i = 0; i < 25; ++i) a.in[i] = (const float*)d_in[i];
    a.out = (float*)d_out; a.ws = (unsigned char*)d_ws;
#if MK_N_LAUNCHES == 1
    a.ph_lo = 0; a.ph_hi = N_PHASES;
    hipLaunchKernelGGL(mega_fwd, dim3(grid), dim3(NWAVES * 64), LDS_BYTES, stream, a);
#else
    for (int ph = 0; ph < N_PHASES; ++ph) { a.ph_lo = ph; a.ph_hi = ph + 1; hipLaunchKernelGGL(mega_fwd, dim3(grid), dim3(NWAVES * 64), LDS_BYTES, stream, a); }
#endif
}
```
